# Optimizing an MI355X kernel written in HIP

```python
import jax, jax.numpy as jnp
from jax import lax
import numpy as np

D_MODEL = 2048
BATCH = 8
SEQ = 4096
DEPTH = 4

N_META = 16
D_MIX = D_MODEL
RWKV_WIDTH = D_MIX // 2
RWKV_HEAD = 64
RWKV_HEADS = RWKV_WIDTH // RWKV_HEAD
FOX_WIDTH = D_MIX - RWKV_WIDTH
FOX_HEAD = 128
FOX_HEADS = FOX_WIDTH // FOX_HEAD
W_LORA = 64
A_LORA = 64
G_LORA = 160
RWKV_COLS = 3 * RWKV_WIDTH + W_LORA + A_LORA + G_LORA
FOX_COLS = 3 * FOX_WIDTH + FOX_HEADS
D_IN = RWKV_COLS + FOX_COLS
D_FF = ((8 * D_MODEL // 3 + 255) // 256) * 256
Q_BLOCK = 128
NORM_EPS = 1e-6
LNX_EPS = 64e-5
L2_EPS = 1e-12
NEG_INF = -1e30

kernel_name = "hymba_rwkv7_fox_macaron_trunk"


def rmsnorm(x, g):
    xf = x.astype(jnp.float32)
    y = xf * lax.rsqrt(jnp.mean(xf * xf, axis=-1, keepdims=True) + NORM_EPS)
    return (y * g.astype(jnp.float32)).astype(x.dtype)


def swiglu_ffn(x, w_gu, w_down):
    gate, up = jnp.split(x @ w_gu, 2, axis=-1)
    return (jax.nn.silu(gate) * up) @ w_down


def token_shift(p, mu):
    prev = jnp.pad(p, ((0, 0), (1, 0), (0, 0)))[:, :-1]
    return p + (prev - p) * mu


def rwkv7_scan(r, w, k, v, a, b):
    B, L, H, N = r.shape

    def step(S, inp):
        r_t, w_t, k_t, v_t, a_t, b_t = inp
        sa = jnp.einsum('bhvk,bhk->bhv', S, a_t)
        S = (S * w_t[:, :, None, :] + sa[..., None] * b_t[:, :, None, :]
             + v_t[..., None] * k_t[:, :, None, :])
        return S, jnp.einsum('bhvk,bhk->bhv', S, r_t)

    xs = tuple(jnp.swapaxes(t, 0, 1) for t in (r, w, k, v, a, b))
    S0 = jnp.zeros((B, H, N, N), jnp.float32)
    _, ys = lax.scan(step, S0, xs)
    return jnp.swapaxes(ys, 0, 1)


def rwkv7_group(p, mu, w0, w_up, a0, a_up, g_up, k_k, k_a, r_k, lnx_w, lnx_b):
    B, L, _ = p.shape
    pf = token_shift(p.astype(jnp.float32), mu)
    c1 = RWKV_WIDTH
    c2, c3 = 2 * c1, 3 * c1
    c4 = c3 + W_LORA
    c5 = c4 + A_LORA
    r, k, v = pf[..., :c1], pf[..., c1:c2], pf[..., c2:c3]
    wd, ad, gd = pf[..., c3:c4], pf[..., c4:c5], pf[..., c5:]
    w_log = -jax.nn.softplus(-(w0 + jnp.tanh(wd) @ w_up)) - 0.5
    decay = jnp.exp(-jnp.exp(w_log))
    a = jax.nn.sigmoid(a0 + ad @ a_up)
    g = jax.nn.sigmoid(gd) @ g_up

    def heads(t):
        return t.reshape(B, L, RWKV_HEADS, RWKV_HEAD)

    kk = heads(k * k_k)
    kk = kk / jnp.maximum(jnp.sqrt(jnp.sum(kk * kk, axis=-1, keepdims=True)), L2_EPS)
    k = k * (1.0 + (a - 1.0) * k_a)
    rh, kh, vh, ah = heads(r), heads(k), heads(v), heads(a)
    y = rwkv7_scan(rh, heads(decay), kh, vh, -kk, kk * ah)
    mean = jnp.mean(y, axis=-1, keepdims=True)
    var = jnp.mean(jnp.square(y - mean), axis=-1, keepdims=True)
    y = ((y - mean) * lax.rsqrt(var + LNX_EPS)).reshape(B, L, RWKV_WIDTH) * lnx_w + lnx_b
    bonus = jnp.sum(rh * kh * r_k, axis=-1, keepdims=True) * vh
    out = (y + bonus.reshape(B, L, RWKV_WIDTH)) * g
    return out.astype(p.dtype)


def fox_group(p, b_f, out_gain):
    B, L, _ = p.shape
    W = FOX_WIDTH

    def heads(t):
        return jnp.transpose(t.reshape(B, L, FOX_HEADS, FOX_HEAD), (0, 2, 1, 3))

    q, k, v = heads(p[..., :W]), heads(p[..., W:2 * W]), heads(p[..., 2 * W:3 * W])
    log_f = jax.nn.log_sigmoid((p[..., 3 * W:] + b_f).astype(jnp.float32))
    c = jnp.transpose(jnp.cumsum(log_f, axis=1), (0, 2, 1))
    n_blocks = -(-L // Q_BLOCK)
    Lp = n_blocks * Q_BLOCK
    pad4 = ((0, 0), (0, 0), (0, Lp - L), (0, 0))
    q, k, v = [jnp.pad(t, pad4) for t in (q, k, v)]
    c = jnp.pad(c, ((0, 0), (0, 0), (0, Lp - L)))
    pos = jnp.arange(Lp)
    scale = FOX_HEAD ** -0.5
    outs = []
    for i in range(n_blocks):
        q0, q1 = i * Q_BLOCK, (i + 1) * Q_BLOCK
        s = jnp.einsum('bhqd,bhkd->bhqk', q[:, :, q0:q1], k[:, :, :q1]).astype(jnp.float32) * scale
        s = s + c[:, :, q0:q1, None] - c[:, :, None, :q1]
        mask = pos[None, :q1] <= pos[q0:q1, None]
        pr = jax.nn.softmax(jnp.where(mask, s, NEG_INF), axis=-1)
        outs.append(jnp.einsum('bhqk,bhkd->bhqd', pr.astype(v.dtype), v[:, :, :q1]))
    o = jnp.concatenate(outs, axis=2)[:, :, :L]
    o = jnp.transpose(o, (0, 2, 1, 3)).reshape(B, L, W)
    return rmsnorm(o, out_gain)


def setup_inputs(seed: int = 0) -> dict:
    key = jax.random.key(seed)
    ks = jax.random.split(key, 26)
    f32 = jnp.float32

    def nrm(k, shape, s):
        return jax.random.normal(k, shape, f32) * s

    def gain(k, shape):
        return 1.0 + 0.02 * jax.random.normal(k, shape, f32)

    return {
        "x": nrm(ks[0], (BATCH, SEQ, D_MODEL), 1.0),
        "meta_tokens": nrm(ks[1], (N_META, D_MODEL), 1.0),
        "ffn1_norm": gain(ks[2], (DEPTH, D_MODEL)),
        "ffn1_w_gu": nrm(ks[3], (DEPTH, D_MODEL, 2 * D_FF), D_MODEL ** -0.5),
        "ffn1_w_down": nrm(ks[4], (DEPTH, D_FF, D_MODEL), D_FF ** -0.5),
        "mix_norm": gain(ks[5], (DEPTH, D_MODEL)),
        "w_in": nrm(ks[6], (DEPTH, D_MODEL, D_IN), D_MODEL ** -0.5),
        "rwkv_mu": jax.random.uniform(ks[7], (DEPTH, RWKV_COLS), f32),
        "rwkv_w0": jax.random.uniform(ks[8], (DEPTH, RWKV_WIDTH), f32, -2.5, 0.5),
        "rwkv_w_up": nrm(ks[9], (DEPTH, W_LORA, RWKV_WIDTH), 0.5 * W_LORA ** -0.5),
        "rwkv_a0": nrm(ks[10], (DEPTH, RWKV_WIDTH), 0.1),
        "rwkv_a_up": nrm(ks[11], (DEPTH, A_LORA, RWKV_WIDTH), 0.5 * A_LORA ** -0.5),
        "rwkv_g_up": nrm(ks[12], (DEPTH, G_LORA, RWKV_WIDTH), G_LORA ** -0.5),
        "rwkv_k_k": 0.85 + nrm(ks[13], (DEPTH, RWKV_WIDTH), 0.05),
        "rwkv_k_a": 1.0 + nrm(ks[14], (DEPTH, RWKV_WIDTH), 0.05),
        "rwkv_r_k": nrm(ks[15], (DEPTH, RWKV_HEADS, RWKV_HEAD), 0.1),
        "rwkv_lnx_w": gain(ks[16], (DEPTH, RWKV_WIDTH)),
        "rwkv_lnx_b": nrm(ks[17], (DEPTH, RWKV_WIDTH), 0.02),
        "fox_b_f": jax.random.uniform(ks[18], (DEPTH, FOX_HEADS), f32, 1.0, 5.0),
        "fox_out_norm": gain(ks[19], (DEPTH, FOX_WIDTH)),
        "w_out": nrm(ks[20], (DEPTH, D_MIX, D_MODEL), D_MIX ** -0.5),
        "ffn2_norm": gain(ks[21], (DEPTH, D_MODEL)),
        "ffn2_w_gu": nrm(ks[22], (DEPTH, D_MODEL, 2 * D_FF), D_MODEL ** -0.5),
        "ffn2_w_down": nrm(ks[23], (DEPTH, D_FF, D_MODEL), D_FF ** -0.5),
        "final_norm": gain(ks[24], (D_MODEL,)),
    }


def reference(x, meta_tokens, ffn1_norm, ffn1_w_gu, ffn1_w_down, mix_norm, w_in,
              rwkv_mu, rwkv_w0, rwkv_w_up, rwkv_a0, rwkv_a_up, rwkv_g_up, rwkv_k_k,
              rwkv_k_a, rwkv_r_k, rwkv_lnx_w, rwkv_lnx_b, fox_b_f, fox_out_norm, w_out,
              ffn2_norm, ffn2_w_gu, ffn2_w_down, final_norm):
    B = x.shape[0]
    meta = jnp.broadcast_to(meta_tokens.astype(x.dtype)[None], (B, N_META, D_MODEL))
    h = jnp.concatenate([meta, x], axis=1)
    for l in range(DEPTH):
        h = h + 0.5 * swiglu_ffn(rmsnorm(h, ffn1_norm[l]), ffn1_w_gu[l], ffn1_w_down[l])
        p = rmsnorm(h, mix_norm[l]) @ w_in[l]
        y_rwkv = rwkv7_group(p[..., :RWKV_COLS], rwkv_mu[l], rwkv_w0[l], rwkv_w_up[l],
                             rwkv_a0[l], rwkv_a_up[l], rwkv_g_up[l], rwkv_k_k[l],
                             rwkv_k_a[l], rwkv_r_k[l], rwkv_lnx_w[l], rwkv_lnx_b[l])
        y_fox = fox_group(p[..., RWKV_COLS:], fox_b_f[l], fox_out_norm[l])
        h = h + jnp.concatenate([y_rwkv, y_fox], axis=-1) @ w_out[l]
        h = h + 0.5 * swiglu_ffn(rmsnorm(h, ffn2_norm[l]), ffn2_w_gu[l], ffn2_w_down[l])
    return rmsnorm(h, final_norm)[:, N_META:]
```

```cpp
#include <hip/hip_runtime.h>
#include <hip/hip_bf16.h>
#include <cstdio>
#include <cstdint>

#define LAS __attribute__((address_space(3)))
namespace cfg {
constexpr int DM = 2048, NBATCH = 8, SEQ = 4096, NMETA = 16, DEPTH = 4;
constexpr int MMAIN = NBATCH * SEQ;
constexpr int MROWS = MMAIN + 256;
constexpr int DFF = 5632, NGU = 2 * DFF;
constexpr int RW = 1024, RH = 64, RNH = 16;
constexpr int FW = 1024, FH = 128, FNH = 8;
constexpr int RWKV_COLS = 3360, DIN = 6440;
constexpr int NIN = 6656;
constexpr int PRW = 3072, PSW = 512, QKVW = 3072;
constexpr int SEQP = 4160;
constexpr float NORM_EPS = 1e-6f, LNX_EPS = 64e-5f;
constexpr int NSS = 13;
constexpr size_t al256(size_t x) { return (x + 255) & ~(size_t)255; }
constexpr size_t WS_CTL = 0;
constexpr size_t CTL_BYTES = 65536;
constexpr size_t WS_SS = WS_CTL + CTL_BYTES;
constexpr size_t SS_BYTES = al256((size_t)NSS * 8 * MROWS * 4);
constexpr size_t ZERO_BYTES = CTL_BYTES + SS_BYTES;
constexpr size_t WS_HMETA = WS_SS + SS_BYTES;
constexpr size_t WS_HB = WS_HMETA + (size_t)256 * DM * 4;
constexpr size_t WS_Y = WS_HB + (size_t)MROWS * DM * 2;
constexpr size_t WS_OVL = WS_Y + (size_t)MROWS * DM * 2;
constexpr size_t WS_ACT = WS_OVL;
constexpr size_t WS_PR = WS_OVL;
constexpr size_t WS_PS = WS_PR + (size_t)MROWS * PRW * 2;
constexpr size_t WS_QKV = WS_PS + (size_t)MROWS * PSW * 4;
constexpr size_t OVL_A = (size_t)MROWS * DFF * 2, OVL_B = (size_t)MROWS * PRW * 2 + (size_t)MROWS * PSW * 4 + (size_t)NBATCH * SEQP * QKVW * 2;
constexpr size_t WS_W = WS_OVL + al256(OVL_A > OVL_B ? OVL_A : OVL_B);
constexpr size_t W_GU = (size_t)NGU * DM * 2, W_D = (size_t)DM * DFF * 2, W_IN = (size_t)NIN * DM * 2, W_OUT = (size_t)DM * DM * 2;
constexpr size_t WO_GU1 = 0, WO_D1 = WO_GU1 + W_GU, WO_IN = WO_D1 + W_D, WO_OUT = WO_IN + W_IN, WO_GU2 = WO_OUT + W_OUT, WO_D2 = WO_GU2 + W_GU, W_LAYER = WO_D2 + W_D;
constexpr size_t WS_END = WS_W + (size_t)DEPTH * W_LAYER;
constexpr int LDS_BYTES = 147456;
constexpr int LDS_BARW = LDS_BYTES - 16;
}
namespace pg8 {
#define PG8_LAS __attribute__((address_space(3)))
typedef unsigned short bf16_t;
typedef short bf16x8 __attribute__((ext_vector_type(8)));
typedef float f32x4 __attribute__((ext_vector_type(4)));
typedef unsigned u32x4 __attribute__((ext_vector_type(4)));
constexpr int BM = 256, BK = 64, HALF = 128, HTB = HALF * BK * 2  , STAGE_BYTES = 8 * HTB, NXCD = 8, WGM = 8;

__host__ __device__ __forceinline__ int lds_byte(int r, int c) { const int st = (r >> 4) * 2 + (c >> 5), rr = r & 15, cc = c & 31, ob = rr * 64 + cc * 2; return st * 1024 + (ob ^ (((ob >> 9) & 1) << 5)); }
__host__ __device__ __forceinline__ void stage_rc(int b, int& R, int& C) { const int st = b / 1024, sb = b % 1024, swz = sb ^ (((sb >> 9) & 1) << 5); R = (st >> 1) * 16 + swz / 64; C = (st & 1) * 32 + (swz % 64) / 2; }
__host__ __device__ __forceinline__ int perm32(int rho) { const int n = rho >> 4, i = rho & 15; return 8 * (i >> 2) + 4 * n + (i & 3); }

struct Unit { int pm, pn; };
struct Gemm { const bf16_t* A; const bf16_t* Bt; int M, N, K; };

struct StaticOrder {
    int nM, nN, nwg, G, c;
    __host__ __device__ void init(int M, int N, int G_, int c_) { nM = M / BM; nN = N / BM; nwg = nM * nN; G = G_; c = c_; }
    __host__ __device__ bool next(int i, Unit& u) const {
        const long L = (long)i * G + c; if (L >= nwg) return false;
        int wgid = (int)L; { const int q = nwg / NXCD, r = nwg % NXCD, xcd = wgid % NXCD, off = wgid / NXCD; wgid = (xcd < r ? xcd * (q + 1) : r * (q + 1) + (xcd - r) * q) + off; }
        const int nig = WGM * nN, gid = wgid / nig, fm = gid * WGM, gsz = (nM - fm) < WGM ? (nM - fm) : WGM;
        u.pm = fm + ((wgid % nig) % gsz); u.pn = (wgid % nig) / gsz; return true;
    }
    __device__ __forceinline__ void a_ready(const Unit&) const {}
    __device__ __forceinline__ void done(const Unit&) const {}
};

__device__ __forceinline__ unsigned cvt_pk_bf16(float lo, float hi) { unsigned r; asm volatile("v_cvt_pk_bf16_f32 %0, %1, %2" : "=v"(r) : "v"(lo), "v"(hi)); return r; }
typedef float f32x2 __attribute__((ext_vector_type(2)));
__device__ __forceinline__ f32x2 gelu_pk(f32x2 v) {
    const f32x2 av = __builtin_elementwise_abs(v), d = av * 0.2316418882f + 1.0f;
    f32x2 t; t.x = __builtin_amdgcn_rcpf(d.x); t.y = __builtin_amdgcn_rcpf(d.y);
    f32x2 q = t * 0.5307027145f + (-0.7265760135f); q = q * t + 0.7107068705f; q = q * t + (-0.142248368f); q = q * t + 0.127414796f; q = q * t;
    const f32x2 s = (v * v) * (-0.72134752044f);
    f32x2 e; e.x = __builtin_amdgcn_exp2f(s.x); e.y = __builtin_amdgcn_exp2f(s.y);
    const f32x2 m = v * (q * e), r = v - m;
    f32x2 o; o.x = v.x < 0.f ? m.x : r.x; o.y = v.y < 0.f ? m.y : r.y; return o;
}
__device__ __forceinline__ float rs_of(const float* ss, int row) { float s = 0.f;
#pragma unroll
    for (int t = 0; t < 8; ++t) s += ss[(size_t)t * 33024 + row];
    return __builtin_amdgcn_rsqf(s * (1.0f / 2048.0f) + 1e-6f); }
__device__ __forceinline__ float silu_f(float x) { return x * __builtin_amdgcn_rcpf(1.0f + __builtin_amdgcn_exp2f(-1.4426950408889634f * x)); }

struct EpiGU {
    static constexpr bool PERM = true, AFTER_DRAIN = false;
    bf16_t* act; const float* ss;
    __device__ __forceinline__ void operator()(const f32x4 (&acc)[2][2][4][2], const Unit& u, int wr, int wc, int fr, int fq) const {
        const int row0 = u.pm * BM + wr * 64 + fr, col0 = u.pn * 128 + wc * 32 + 8 * fq;
#pragma unroll
        for (int ai = 0; ai < 2; ++ai)
#pragma unroll
            for (int m = 0; m < 4; ++m) { const int row = row0 + ai * HALF + m * 16; const float rs = rs_of(ss, row);
                const f32x4 g0 = acc[ai][0][m][0] * rs, g1 = acc[ai][0][m][1] * rs, u0 = acc[ai][1][m][0] * rs, u1 = acc[ai][1][m][1] * rs;
                u32x4 w;
                w.x = cvt_pk_bf16(silu_f(g0[0]) * u0[0], silu_f(g0[1]) * u0[1]); w.y = cvt_pk_bf16(silu_f(g0[2]) * u0[2], silu_f(g0[3]) * u0[3]);
                w.z = cvt_pk_bf16(silu_f(g1[0]) * u1[0], silu_f(g1[1]) * u1[1]); w.w = cvt_pk_bf16(silu_f(g1[2]) * u1[2], silu_f(g1[3]) * u1[3]);
                *(u32x4*)(act + (size_t)row * 5632 + col0) = w; }
    }
};
struct EpiRes {
    static constexpr bool PERM = false, AFTER_DRAIN = false;
    float* hmain; float* hmeta; bf16_t* hb; float* ssn; float alpha; PG8_LAS float* red;
    __device__ __forceinline__ void operator()(const f32x4 (&acc)[2][2][4][2], const Unit& u, int wr, int wc, int fr, int fq) const {
        typedef unsigned u32x2v __attribute__((ext_vector_type(2)));
        float* base = (u.pm < 128) ? hmain + (size_t)u.pm * BM * 2048 : hmeta;
        bf16_t* bbase = hb + (size_t)u.pm * BM * 2048;
        const int rl0 = wr * 64 + fr; unsigned off = (unsigned)(rl0 * 2048 + u.pn * BM + wc * 32 + 4 * fq);
#pragma unroll
        for (int ai = 0; ai < 2; ++ai)
#pragma unroll
            for (int m = 0; m < 4; ++m) { const unsigned o = off + (unsigned)((ai * HALF + m * 16) * 2048); float sq = 0.f;
#pragma unroll
                for (int bj = 0; bj < 2; ++bj)
#pragma unroll
                    for (int n = 0; n < 2; ++n) { const unsigned oo = o + bj * HALF + n * 16; f32x4 hv = *(const f32x4*)(base + oo); hv = hv + acc[ai][bj][m][n] * alpha; *(f32x4*)(base + oo) = hv;
                        sq += (hv[0] * hv[0] + hv[1] * hv[1]) + (hv[2] * hv[2] + hv[3] * hv[3]);
                        u32x2v w; w.x = cvt_pk_bf16(hv[0], hv[1]); w.y = cvt_pk_bf16(hv[2], hv[3]); *(u32x2v*)(bbase + oo) = w; }
                sq += __shfl_xor(sq, 16); sq += __shfl_xor(sq, 32);
                if (fq == 0) red[(rl0 + ai * HALF + m * 16) * 4 + wc] = sq;
                asm volatile("" ::: "memory"); }
        asm volatile("s_waitcnt lgkmcnt(0)" ::: "memory"); __builtin_amdgcn_s_barrier(); asm volatile("" ::: "memory");
        if (wr == 0) { const int row = wc * 64 + fq * 16 + fr; const float s4 = (red[row * 4] + red[row * 4 + 1]) + (red[row * 4 + 2] + red[row * 4 + 3]); ssn[(size_t)u.pn * 33024 + u.pm * BM + row] = s4; }
    }
};
struct EpiP {
    static constexpr bool PERM = true, AFTER_DRAIN = false;
    bf16_t* pr; float* ps; bf16_t* qkv; const float* ss;
    __device__ __forceinline__ void operator()(const f32x4 (&acc)[2][2][4][2], const Unit& u, int wr, int wc, int fr, int fq) const {
        const int row0 = u.pm * BM + wr * 64 + fr, cl = wc * 32 + 8 * fq;
#pragma unroll
        for (int ai = 0; ai < 2; ++ai)
#pragma unroll
            for (int m = 0; m < 4; ++m) { const int row = row0 + ai * HALF + m * 16; const float rs = rs_of(ss, row);
#pragma unroll
                for (int bj = 0; bj < 2; ++bj) { const f32x4 v0 = acc[ai][bj][m][0] * rs, v1 = acc[ai][bj][m][1] * rs;
                    if (u.pn >= 12 && u.pn < 14) { float* d = ps + (size_t)row * 512 + (u.pn - 12) * 256 + bj * HALF + cl; *(f32x4*)d = v0; *(f32x4*)(d + 4) = v1; }
                    else { u32x4 w; w.x = cvt_pk_bf16(v0[0], v0[1]); w.y = cvt_pk_bf16(v0[2], v0[3]); w.z = cvt_pk_bf16(v1[0], v1[1]); w.w = cvt_pk_bf16(v1[2], v1[3]);
                        if (u.pn < 12) *(u32x4*)(pr + (size_t)row * 3072 + u.pn * 256 + bj * HALF + cl) = w;
                        else { const int c = (u.pn - 14) * 256 + bj * HALF + cl;
                            if (u.pm < 128) { const int b = row >> 12, s = row & 4095; *(u32x4*)(qkv + ((size_t)b * 4160 + 64 + s) * 3072 + c) = w; }
                            else { const int j = row - 32768; if (j < 16) { for (int b = 0; b < 8; ++b) *(u32x4*)(qkv + ((size_t)b * 4160 + 48 + j) * 3072 + c) = w; } } } } } }
    }
};
template <class Epi, class Sched, bool ALIGN_EPI = false, bool SP2 = false>
__device__ __forceinline__ void gemm_phase(PG8_LAS unsigned char* lds, const Gemm g, const Sched& S, const Epi& E) {
    const int tid = threadIdx.x, wid = __builtin_amdgcn_readfirstlane(tid >> 6), lane = tid & 63, wr = wid >> 2, wc = wid & 3, fr = lane & 15, fq = lane >> 4;
    const int K = g.K, nt = K / BK;
    unsigned voffA[2], voffB[2];
#pragma unroll
    for (int i = 0; i < 2; ++i) { int R, C; stage_rc(tid * 16 + i * 8192, R, C); const int Rb = Epi::PERM ? ((R & ~31) + perm32(R & 31)) : R;
        voffA[i] = (unsigned)(R * K + C) * 2u; voffB[i] = (unsigned)(Rb * K + C) * 2u; }
    const size_t kstep = (size_t)(BK * 2);
    const size_t hstep = (size_t)HALF * K * 2;
    const size_t tstep = 2 * hstep;
    const unsigned ldsw = (unsigned)wid * 1024u;
    const int aoff = lds_byte(wr * 64 + fr, fq * 8), boff = lds_byte(wc * 32 + fr, fq * 8);
#define PG8_SA(b, h) (((b) * 2 + (h)) * HTB)
#define PG8_SB(b, h) ((4 + (b) * 2 + (h)) * HTB)
#define PG8_STAGE(bufoff, gbase, voff) do { _Pragma("unroll") for (int _i = 0; _i < 2; ++_i) \
        __builtin_amdgcn_global_load_lds((const unsigned*)((const char*)(gbase) + (voff)[_i]), (PG8_LAS unsigned*)(lds + (bufoff) + ldsw + _i * 8192), 16, 0, 0); } while (0)
#define PG8_LDA(dst, b, h) do { _Pragma("unroll") for (int m = 0; m < 4; ++m) _Pragma("unroll") for (int k = 0; k < 2; ++k) dst[m][k] = *(const PG8_LAS bf16x8*)(lds + PG8_SA(b, h) + aoff + m * 2048 + k * 1024); } while (0)
#define PG8_LDB(dst, b, h) do { _Pragma("unroll") for (int n = 0; n < 2; ++n) _Pragma("unroll") for (int k = 0; k < 2; ++k) dst[n][k] = *(const PG8_LAS bf16x8*)(lds + PG8_SB(b, h) + boff + n * 2048 + k * 1024); } while (0)
#define PG8_MMA(ai, bj, At, Bt) do { __builtin_amdgcn_s_setprio(1); _Pragma("unroll") for (int m = 0; m < 4; ++m) _Pragma("unroll") for (int n = 0; n < 2; ++n) _Pragma("unroll") for (int k = 0; k < 2; ++k) \
        acc[ai][bj][m][n] = __builtin_amdgcn_mfma_f32_16x16x32_bf16(Bt[n][k], At[m][k], acc[ai][bj][m][n], 0, 0, 0); __builtin_amdgcn_s_setprio(0); } while (0)
#define PG8_WAIT_V(n) asm volatile("s_waitcnt vmcnt(" #n ")" ::: "memory")
#define PG8_WAIT_L(n) asm volatile("s_waitcnt lgkmcnt(" #n ")" ::: "memory")
#define PG8_BAR __builtin_amdgcn_s_barrier()
#define PG8_SCHED __builtin_amdgcn_sched_barrier(0)
    Unit cur, nxt; int ui = 0;
    if (!S.next(0, cur)) return;
    f32x4 acc[2][2][4][2];
#pragma unroll
    for (int a = 0; a < 2; ++a)
#pragma unroll
        for (int b = 0; b < 2; ++b)
#pragma unroll
            for (int m = 0; m < 4; ++m)
#pragma unroll
                for (int n = 0; n < 2; ++n) acc[a][b][m][n] = (f32x4){0.f, 0.f, 0.f, 0.f};
    bf16x8 At[4][2], B0[2][2], B1[2][2];
    const char* cA = (const char*)g.A + (size_t)cur.pm * tstep; const char* cB = (const char*)g.Bt + (size_t)cur.pn * tstep;
    S.a_ready(cur);
    if constexpr (SP2) {
        PG8_STAGE(PG8_SB(0, 0), cB, voffB); PG8_STAGE(PG8_SB(0, 1), cB + hstep, voffB); PG8_STAGE(PG8_SA(0, 0), cA, voffA); PG8_STAGE(PG8_SA(0, 1), cA + hstep, voffA);
        if (wr == 1) PG8_BAR;
        PG8_WAIT_V(2); PG8_BAR;
        PG8_STAGE(PG8_SB(1, 0), cB + kstep, voffB); PG8_STAGE(PG8_SA(1, 0), cA + kstep, voffA); PG8_STAGE(PG8_SB(1, 1), cB + hstep + kstep, voffB);
        PG8_WAIT_V(6); PG8_BAR;
    } else {
        PG8_STAGE(PG8_SB(0, 0), cB, voffB); PG8_STAGE(PG8_SA(0, 0), cA, voffA); PG8_STAGE(PG8_SB(0, 1), cB + hstep, voffB); PG8_STAGE(PG8_SA(0, 1), cA + hstep, voffA);
        if (wr == 1) PG8_BAR;
        PG8_WAIT_V(4); PG8_BAR;
        PG8_STAGE(PG8_SB(1, 0), cB + kstep, voffB); PG8_STAGE(PG8_SA(1, 0), cA + kstep, voffA); PG8_STAGE(PG8_SB(1, 1), cB + hstep + kstep, voffB);
        PG8_WAIT_V(6); PG8_BAR;
    }
    for (;;) {
        const bool has_next = S.next(ui + 1, nxt);
        const char* nA = has_next ? (const char*)g.A + (size_t)nxt.pm * tstep : cA; const char* nB = has_next ? (const char*)g.Bt + (size_t)nxt.pn * tstep : cB;
        for (int t = 0; t < nt; t += 2) {
            const bool last = (t == nt - 2);
            const char* a1 = cA + (size_t)(t + 1) * kstep;
            const char* a2 = last ? nA : cA + (size_t)(t + 2) * kstep; const char* b2 = last ? nB : cB + (size_t)(t + 2) * kstep;
            const char* a3 = a2 + kstep; const char* b3 = b2 + kstep;
            if (last && has_next) S.a_ready(nxt);
            if constexpr (SP2) {
            PG8_LDB(B0, 0, 0); PG8_LDB(B1, 0, 1); PG8_SCHED; PG8_LDA(At, 0, 0); PG8_STAGE(PG8_SA(1, 1), a1 + hstep, voffA);
            PG8_WAIT_V(8); PG8_WAIT_L(0); PG8_BAR; PG8_MMA(0, 0, At, B0); PG8_MMA(0, 1, At, B1); PG8_BAR; PG8_SCHED;
            PG8_LDA(At, 0, 1); PG8_STAGE(PG8_SB(0, 0), b2, voffB); PG8_STAGE(PG8_SB(0, 1), b2 + hstep, voffB); PG8_STAGE(PG8_SA(0, 0), a2, voffA);
            PG8_WAIT_V(8); PG8_WAIT_L(0); PG8_BAR; PG8_MMA(1, 0, At, B0); PG8_MMA(1, 1, At, B1); PG8_BAR; PG8_SCHED;
            PG8_LDB(B0, 1, 0); PG8_LDB(B1, 1, 1); PG8_SCHED; PG8_LDA(At, 1, 0); PG8_STAGE(PG8_SA(0, 1), a2 + hstep, voffA);
            PG8_WAIT_V(8); PG8_WAIT_L(0); PG8_BAR; PG8_MMA(0, 0, At, B0); PG8_MMA(0, 1, At, B1); PG8_BAR; PG8_SCHED;
            PG8_LDA(At, 1, 1); PG8_STAGE(PG8_SB(1, 0), b3, voffB); PG8_STAGE(PG8_SB(1, 1), b3 + hstep, voffB); PG8_STAGE(PG8_SA(1, 0), a3, voffA);
            PG8_WAIT_V(8); PG8_WAIT_L(0); PG8_BAR; PG8_MMA(1, 0, At, B0); PG8_MMA(1, 1, At, B1); PG8_BAR; PG8_SCHED;
            } else {
            PG8_LDB(B0, 0, 0); PG8_SCHED; PG8_LDA(At, 0, 0); PG8_STAGE(PG8_SA(1, 1), a1 + hstep, voffA);
            PG8_WAIT_L(8); PG8_BAR; PG8_WAIT_L(0); PG8_MMA(0, 0, At, B0); PG8_BAR; PG8_SCHED;
            PG8_LDB(B1, 0, 1); PG8_STAGE(PG8_SB(0, 0), b2, voffB);
            PG8_BAR; PG8_WAIT_L(0); PG8_MMA(0, 1, At, B1); PG8_BAR;
            PG8_LDA(At, 0, 1); PG8_STAGE(PG8_SA(0, 0), a2, voffA);
            PG8_BAR; PG8_WAIT_L(0); PG8_MMA(1, 0, At, B0); PG8_BAR; PG8_SCHED;
            PG8_STAGE(PG8_SB(0, 1), b2 + hstep, voffB);
            PG8_WAIT_V(6); PG8_BAR; PG8_MMA(1, 1, At, B1); PG8_BAR;
            PG8_LDB(B0, 1, 0); PG8_SCHED; PG8_LDA(At, 1, 0); PG8_STAGE(PG8_SA(0, 1), a2 + hstep, voffA);
            PG8_WAIT_L(8); PG8_BAR; PG8_WAIT_L(0); PG8_MMA(0, 0, At, B0); PG8_BAR; PG8_SCHED;
            PG8_LDB(B1, 1, 1); PG8_STAGE(PG8_SB(1, 0), b3, voffB);
            PG8_BAR; PG8_WAIT_L(0); PG8_MMA(0, 1, At, B1); PG8_BAR;
            PG8_LDA(At, 1, 1); PG8_STAGE(PG8_SA(1, 0), a3, voffA);
            PG8_BAR; PG8_WAIT_L(0); PG8_MMA(1, 0, At, B0); PG8_BAR; PG8_SCHED;
            PG8_STAGE(PG8_SB(1, 1), b3 + hstep, voffB);
            PG8_WAIT_V(6); PG8_BAR; PG8_MMA(1, 1, At, B1); PG8_BAR;
            }
        }
        if constexpr (ALIGN_EPI) { if (wr == 0) PG8_BAR; }
        if constexpr (!Epi::AFTER_DRAIN) { E(acc, cur, wr, wc, fr, fq); S.done(cur); }
        if (!has_next) break;
#pragma unroll
        for (int a = 0; a < 2; ++a)
#pragma unroll
            for (int b = 0; b < 2; ++b)
#pragma unroll
                for (int m = 0; m < 4; ++m)
#pragma unroll
                    for (int n = 0; n < 2; ++n) acc[a][b][m][n] = (f32x4){0.f, 0.f, 0.f, 0.f};
        cur = nxt; cA = nA; cB = nB; ++ui;
        if constexpr (ALIGN_EPI) { if (wr == 1) PG8_BAR; }
    }
    PG8_WAIT_V(0);
    if constexpr (!ALIGN_EPI) { if (wr == 0) PG8_BAR; }
    PG8_BAR;
    if constexpr (Epi::AFTER_DRAIN) { E.fused(acc, cur, wr, wc, fr, fq, lds, wid, lane); S.done(cur); }
#undef PG8_SA
#undef PG8_SB
#undef PG8_STAGE
#undef PG8_LDA
#undef PG8_LDB
#undef PG8_MMA
#undef PG8_WAIT_V
#undef PG8_WAIT_L
#undef PG8_BAR
#undef PG8_SCHED
}
}


#define XB_TMO      128
#define XB_XCNT(j)  (256  + 64 * (j))
#define XB_XSUB(j)  (1280 + 64 * (j))
#define XB_XGEN(j)  (2304 + 64 * (j))
#define XB_TOP      3328
#define XB_TOPGEN   3392
#define XCD_BAR_WORDS 3456
#define XB_SPIN_CAP (1u << 22)

__device__ __forceinline__ unsigned xb_ld(unsigned* p)              { return __hip_atomic_load(p, __ATOMIC_RELAXED, __HIP_MEMORY_SCOPE_AGENT); }
__device__ __forceinline__ unsigned xb_add(unsigned* p, unsigned v) { return __hip_atomic_fetch_add(p, v, __ATOMIC_RELAXED, __HIP_MEMORY_SCOPE_AGENT); }
__device__ __forceinline__ unsigned xb_xcc_id() { return (unsigned)__builtin_amdgcn_s_getreg((3 << 11) | 20) & 0xFu; }
#define XB_SPIN(cond, bar) do { unsigned _sp = 0; while (cond) { __builtin_amdgcn_s_sleep(1); \
    if ((++_sp & 255u) == 0u) { if (xb_ld(&(bar)[XB_TMO])) break; if (_sp > XB_SPIN_CAP) { atomicAdd(&(bar)[XB_TMO], 1u); break; } } } } while (0)

struct XcdBarrier {
    unsigned* bar; unsigned x;
    volatile LAS unsigned* st;
};

__device__ __forceinline__ XcdBarrier xcd_barrier_post(unsigned* bar, volatile LAS unsigned* st) {
    XcdBarrier b; b.bar = bar; b.x = xb_xcc_id(); b.st = st;
    if (threadIdx.x == 0) (void)xb_add(&bar[XB_XCNT(b.x)], 1u);
    return b;
}
__device__ __forceinline__ void xcd_barrier_complete(unsigned* bar, unsigned x, unsigned& nloc, unsigned& nx) {
    const unsigned G = gridDim.x * gridDim.y * gridDim.z;
    unsigned sum, cnt, mine, sp = 0u;
    for (;;) {
        sum = 0u; cnt = 0u; mine = 0u;
#pragma unroll
        for (unsigned j = 0; j < 16; ++j) { const unsigned c = xb_ld(&bar[XB_XCNT(j)]); sum += c; cnt += (c > 0u) ? 1u : 0u; mine = (j == x) ? c : mine; }
        if (sum == G) break;
        __builtin_amdgcn_s_sleep(1);
        if ((++sp & 255u) == 0u) { if (xb_ld(&bar[XB_TMO])) break; if (sp > XB_SPIN_CAP) { atomicAdd(&bar[XB_TMO], 1u); break; } }
    }
    nloc = mine > 0u ? mine : 1u; nx = cnt > 0u ? cnt : 1u;
}

__device__ __forceinline__ void xcd_barrier(const XcdBarrier& b) {
    asm volatile("s_waitcnt vmcnt(0)" ::: "memory");
    __syncthreads();
    if (threadIdx.x == 0) {
        unsigned* bar = b.bar;
        __builtin_amdgcn_s_waitcnt(0);
        unsigned nloc = b.st[0], nx = b.st[1];
        if (nloc == 0u) { xcd_barrier_complete(bar, b.x, nloc, nx); b.st[0] = nloc; b.st[1] = nx; }
        const unsigned old = xb_add(&bar[XB_XSUB(b.x)], 1u);
        const unsigned gen = old / nloc;
        if (old + 1u == (gen + 1u) * nloc) {
            __builtin_amdgcn_fence(__ATOMIC_RELEASE, "agent");
            asm volatile("s_waitcnt vmcnt(0)" ::: "memory");
            const unsigned og = xb_add(&bar[XB_TOP], 1u);
            const unsigned tg = og / nx;
            if (og + 1u == (tg + 1u) * nx) xb_add(&bar[XB_TOPGEN], 1u);
            else XB_SPIN(xb_ld(&bar[XB_TOPGEN]) == tg, bar);
            __builtin_amdgcn_fence(__ATOMIC_ACQUIRE, "agent");
            xb_add(&bar[XB_XGEN(b.x)], 1u);
            asm volatile("s_waitcnt vmcnt(0)" ::: "memory");
        } else {
            XB_SPIN(xb_ld(&bar[XB_XGEN(b.x)]) == gen, bar);
            __builtin_amdgcn_fence(__ATOMIC_ACQUIRE, "agent");
            asm volatile("s_waitcnt vmcnt(0)" ::: "memory");
        }
    }
    __syncthreads();
}


typedef unsigned short bf16_t;
typedef float f32x4 __attribute__((ext_vector_type(4)));
typedef unsigned u32x4 __attribute__((ext_vector_type(4)));
typedef unsigned u32x2 __attribute__((ext_vector_type(2)));
struct Params { const float* in[25]; float* out; unsigned char* ws; int ph_lo, ph_hi; };
#define CAS __attribute__((address_space(4)))
typedef const CAS Params* PP;
__device__ __forceinline__ PP launder(PP p) { asm volatile("" : "+s"(p)); return p; }
enum { I_X = 0, I_META, I_F1N, I_F1GU, I_F1D, I_MIXN, I_WIN, I_MU, I_W0, I_WUP, I_A0, I_AUP, I_GUP, I_KK, I_KA, I_RK, I_LNW, I_LNB, I_BF, I_FON, I_WOUT, I_F2N, I_F2GU, I_F2D, I_FINN };

__device__ __forceinline__ unsigned pk_bf16(float lo, float hi) { unsigned r; asm volatile("v_cvt_pk_bf16_f32 %0, %1, %2" : "=v"(r) : "v"(lo), "v"(hi)); return r; }
__device__ __forceinline__ float bf2f(bf16_t b) { return __uint_as_float(((unsigned)b) << 16); }
__device__ __forceinline__ float wave_sum(float v) {
#pragma unroll
    for (int o = 32; o >= 1; o >>= 1) v += __shfl_xor(v, o);
    return v; }
__device__ __forceinline__ float wave_max(float v) {
#pragma unroll
    for (int o = 32; o >= 1; o >>= 1) v = fmaxf(v, __shfl_xor(v, o));
    return v; }
__device__ __forceinline__ float sigmoid_f(float x) { return __builtin_amdgcn_rcpf(1.0f + __expf(-x)); }

__device__ __forceinline__ void convert_tile(const float* __restrict__ src, bf16_t* __restrict__ dst, const float* __restrict__ gain, int K, int Nsrc, int kind, int tk, int tn, LAS float* T) {
    const int tid = threadIdx.x;
    {
        const int nl = (tid & 15) * 4, np = tn * 64 + nl; int sc;
        if (kind == 1) { const int pn = np >> 8, bj = (np >> 7) & 1, i = np & 127; sc = bj * cfg::DFF + pn * 128 + i; }
        else if (kind == 2) { sc = np < 3360 ? np : (np < 3368 ? 6432 + (np - 3360) : (np < 3584 ? -1 : 3360 + (np - 3584))); }
        else sc = np;
#pragma unroll
        for (int i = 0; i < 2; ++i) { const int kl = (tid >> 4) + 32 * i, k = tk * 64 + kl;
            f32x4 v = (f32x4){0.f, 0.f, 0.f, 0.f};
            if (sc >= 0) v = *(const f32x4*)(src + (size_t)k * Nsrc + sc);
            float g = 1.f; if (kind == 1 || kind == 2) g = gain[k]; else if (kind == 3) g = (k >= 1024) ? gain[k - 1024] : 1.f;
            T[kl * 65 + nl] = v[0] * g; T[kl * 65 + nl + 1] = v[1] * g; T[kl * 65 + nl + 2] = v[2] * g; T[kl * 65 + nl + 3] = v[3] * g; }
    }
    __syncthreads();
    {
        const int nl = tid >> 3, k8 = (tid & 7) * 8; u32x4 w;
        w.x = pk_bf16(T[(k8 + 0) * 65 + nl], T[(k8 + 1) * 65 + nl]); w.y = pk_bf16(T[(k8 + 2) * 65 + nl], T[(k8 + 3) * 65 + nl]);
        w.z = pk_bf16(T[(k8 + 4) * 65 + nl], T[(k8 + 5) * 65 + nl]); w.w = pk_bf16(T[(k8 + 6) * 65 + nl], T[(k8 + 7) * 65 + nl]);
        *(u32x4*)(dst + (size_t)(tn * 64 + nl) * K + tk * 64 + k8) = w;
    }
    __syncthreads();
}
__device__ __forceinline__ void phase_convert(PP P, LAS unsigned char* lds) {
    using namespace cfg;
    LAS float* T = (LAS float*)lds;
    constexpr int T_GU = (DM / 64) * (NGU / 64), T_D = (DFF / 64) * (DM / 64), T_IN = (DM / 64) * (NIN / 64), T_OUT = (DM / 64) * (DM / 64);
    constexpr int T_LAYER = 2 * T_GU + 2 * T_D + T_IN + T_OUT;
    for (int t = blockIdx.x; t < DEPTH * T_LAYER; t += gridDim.x) {
        const int l = t / T_LAYER; int r = t - l * T_LAYER;
        bf16_t* wl = (bf16_t*)(P->ws + WS_W + (size_t)l * W_LAYER);
        const float* src; bf16_t* dst; const float* gain = nullptr; int K, Nsrc, kind, ntn;
        if (r < T_GU) { src = P->in[I_F1GU] + (size_t)l * DM * NGU; dst = (bf16_t*)((unsigned char*)wl + WO_GU1); gain = P->in[I_F1N] + l * DM; K = DM; Nsrc = NGU; kind = 1; ntn = NGU / 64; }
        else if ((r -= T_GU) < T_D) { src = P->in[I_F1D] + (size_t)l * DFF * DM; dst = (bf16_t*)((unsigned char*)wl + WO_D1); K = DFF; Nsrc = DM; kind = 0; ntn = DM / 64; }
        else if ((r -= T_D) < T_IN) { src = P->in[I_WIN] + (size_t)l * DM * DIN; dst = (bf16_t*)((unsigned char*)wl + WO_IN); gain = P->in[I_MIXN] + l * DM; K = DM; Nsrc = DIN; kind = 2; ntn = NIN / 64; }
        else if ((r -= T_IN) < T_OUT) { src = P->in[I_WOUT] + (size_t)l * DM * DM; dst = (bf16_t*)((unsigned char*)wl + WO_OUT); gain = P->in[I_FON] + l * FW; K = DM; Nsrc = DM; kind = 3; ntn = DM / 64; }
        else if ((r -= T_OUT) < T_GU) { src = P->in[I_F2GU] + (size_t)l * DM * NGU; dst = (bf16_t*)((unsigned char*)wl + WO_GU2); gain = P->in[I_F2N] + l * DM; K = DM; Nsrc = NGU; kind = 1; ntn = NGU / 64; }
        else { r -= T_GU; src = P->in[I_F2D] + (size_t)l * DFF * DM; dst = (bf16_t*)((unsigned char*)wl + WO_D2); K = DFF; Nsrc = DM; kind = 0; ntn = DM / 64; }
        convert_tile(src, dst, gain, K, Nsrc, kind, r / ntn, r % ntn, T);
    }
}
__device__ __forceinline__ void phase_init(PP P) {
    using namespace cfg;
    const int lane = threadIdx.x & 63, gw = blockIdx.x * 8 + (threadIdx.x >> 6), nw = gridDim.x * 8;
    float* hmeta = (float*)(P->ws + WS_HMETA); bf16_t* hb = (bf16_t*)(P->ws + WS_HB); float* ss0 = (float*)(P->ws + WS_SS);
    for (int row = gw; row < MROWS; row += nw) {
        const float* s = row < MMAIN ? P->in[I_X] + (size_t)row * DM : P->in[I_META] + (size_t)(row - MMAIN) * DM;
        float* d = row < MMAIN ? P->out + (size_t)row * DM : hmeta + (size_t)(row - MMAIN) * DM;
        float sq = 0.f;
#pragma unroll
        for (int i = 0; i < 8; ++i) { f32x4 v = (f32x4){0.f, 0.f, 0.f, 0.f}; if (row < MMAIN + NMETA) v = *(const f32x4*)(s + i * 256 + lane * 4);
            *(f32x4*)(d + i * 256 + lane * 4) = v; sq += (v[0] * v[0] + v[1] * v[1]) + (v[2] * v[2] + v[3] * v[3]);
            u32x2 w; w.x = pk_bf16(v[0], v[1]); w.y = pk_bf16(v[2], v[3]); *(u32x2*)(hb + (size_t)row * DM + i * 256 + lane * 4) = w; }
        sq = wave_sum(sq);
        if (lane < 8) ss0[(size_t)lane * MROWS + row] = lane == 0 ? sq : 0.f;
    }
}
__device__ __forceinline__ void phase_foxnorm(PP P) {
    using namespace cfg;
    const int lane = threadIdx.x & 63, gw = blockIdx.x * 8 + (threadIdx.x >> 6), nw = gridDim.x * 8;
    bf16_t* y = (bf16_t*)(P->ws + WS_Y);
    for (int row = gw; row < MMAIN + NMETA; row += nw) {
        bf16_t* p = y + (size_t)row * DM + 1024 + lane * 16;
        u32x4 a = *(const u32x4*)p, b = *(const u32x4*)(p + 8); float v[16];
#pragma unroll
        for (int i = 0; i < 4; ++i) { v[2 * i] = __uint_as_float(a[i] << 16); v[2 * i + 1] = __uint_as_float(a[i] & 0xffff0000u); v[8 + 2 * i] = __uint_as_float(b[i] << 16); v[8 + 2 * i + 1] = __uint_as_float(b[i] & 0xffff0000u); }
        float sq = 0.f;
#pragma unroll
        for (int i = 0; i < 16; ++i) sq += v[i] * v[i];
        sq = wave_sum(sq); const float rs = __builtin_amdgcn_rsqf(sq * (1.0f / 1024.0f) + NORM_EPS);
#pragma unroll
        for (int i = 0; i < 4; ++i) { a[i] = pk_bf16(v[2 * i] * rs, v[2 * i + 1] * rs); b[i] = pk_bf16(v[8 + 2 * i] * rs, v[8 + 2 * i + 1] * rs); }
        *(u32x4*)p = a; *(u32x4*)(p + 8) = b;
    }
}
__device__ __forceinline__ void phase_final(PP P) {
    using namespace cfg;
    const int lane = threadIdx.x & 63, gw = blockIdx.x * 8 + (threadIdx.x >> 6), nw = gridDim.x * 8;
    const float* g = P->in[I_FINN];
    for (int row = gw; row < MMAIN; row += nw) {
        float* d = P->out + (size_t)row * DM; f32x4 v[8]; float sq = 0.f;
#pragma unroll
        for (int i = 0; i < 8; ++i) { v[i] = *(const f32x4*)(d + i * 256 + lane * 4); sq += (v[i][0] * v[i][0] + v[i][1] * v[i][1]) + (v[i][2] * v[i][2] + v[i][3] * v[i][3]); }
        sq = wave_sum(sq); const float rs = __builtin_amdgcn_rsqf(sq * (1.0f / 2048.0f) + NORM_EPS);
#pragma unroll
        for (int i = 0; i < 8; ++i) { const f32x4 gv = *(const f32x4*)(g + i * 256 + lane * 4); *(f32x4*)(d + i * 256 + lane * 4) = v[i] * rs * gv; }
    }
}

__device__ __forceinline__ void rwkv_simple(PP P, int l, int b, int h, LAS unsigned char* lds) {
    using namespace cfg;
    const int tid = threadIdx.x, lane = tid & 63, wave = tid >> 6;
    LAS bf16_t* WUP = (LAS bf16_t*)lds; LAS bf16_t* AUP = WUP + 4096; LAS bf16_t* GUP = AUP + 4096;
    LAS float* RAW = (LAS float*)(lds + 36864); LAS float* LX = RAW + 17 * 480; LAS float* Rm = LX + 16 * 288;
    LAS float* Wm = Rm + 1024; LAS float* KPm = Wm + 1024; LAS float* Vm = KPm + 1024; LAS float* Am = Vm + 1024; LAS float* Bm = Am + 1024; LAS float* Gm = Bm + 1024;
    LAS float* BON = Gm + 1024; LAS float* YR = BON + 16;
    const bf16_t* PR = (const bf16_t*)(P->ws + WS_PR); const float* PS = (const float*)(P->ws + WS_PS); bf16_t* Y = (bf16_t*)(P->ws + WS_Y);
    const float* mu = P->in[I_MU] + l * RWKV_COLS;
    for (int e = tid; e < 64 * 64; e += 512) { const int i = e >> 6, j = e & 63;
        WUP[e] = (bf16_t)(pk_bf16(P->in[I_WUP][((size_t)l * 64 + i) * RW + h * 64 + j], 0.f) & 0xffffu);
        AUP[e] = (bf16_t)(pk_bf16(P->in[I_AUP][((size_t)l * 64 + i) * RW + h * 64 + j], 0.f) & 0xffffu); }
    for (int e = tid; e < 160 * 64; e += 512) { const int i = e >> 6, j = e & 63; GUP[e] = (bf16_t)(pk_bf16(P->in[I_GUP][((size_t)l * 160 + i) * RW + h * 64 + j], 0.f) & 0xffffu); }
    for (int e = tid; e < 480; e += 512) RAW[e] = 0.f;
    const int hj = h * 64 + lane;
    const float w0 = P->in[I_W0][l * RW + hj], a0 = P->in[I_A0][l * RW + hj], kkw = P->in[I_KK][l * RW + hj], kaw = P->in[I_KA][l * RW + hj], rkw = P->in[I_RK][l * RW + hj];
    const float lnw = P->in[I_LNW][l * RW + hj], lnb = P->in[I_LNB][l * RW + hj];
    const float mur = mu[hj], muk = mu[1024 + hj], muv = mu[2048 + hj];
    float S[16];
#pragma unroll
    for (int j = 0; j < 16; ++j) S[j] = 0.f;
    __syncthreads();
    for (int c = 0; c < 257; ++c) {
        const int row0 = (c == 0) ? MMAIN : b * SEQ + (c - 1) * 16;
        for (int e = tid; e < 16 * 480; e += 512) { const int t = e / 480, cc = e - t * 480; const int row = row0 + t; float v;
            if (cc < 192) v = bf2f(PR[(size_t)row * PRW + (cc >> 6) * 1024 + h * 64 + (cc & 63)]); else v = PS[(size_t)row * PSW + (cc - 192)];
            RAW[(t + 1) * 480 + cc] = v; }
        __syncthreads();
        for (int e = tid; e < 16 * 288; e += 512) { const int t = e / 288, i = e - t * 288; const float cur = RAW[(t + 1) * 480 + 192 + i], prv = RAW[t * 480 + 192 + i];
            const float x = cur + (prv - cur) * mu[3072 + i];
            LX[e] = i < 64 ? tanhf(x) : (i < 128 ? x : sigmoid_f(x)); }
        __syncthreads();
#pragma unroll 1
        for (int rep = 0; rep < 2; ++rep) { const int t = wave + 8 * rep;
            float aw = w0, aa = a0, ag = 0.f;
            for (int i = 0; i < 64; ++i) { aw += LX[t * 288 + i] * bf2f(WUP[i * 64 + lane]); aa += LX[t * 288 + 64 + i] * bf2f(AUP[i * 64 + lane]); }
            for (int i = 0; i < 160; ++i) ag += LX[t * 288 + 128 + i] * bf2f(GUP[i * 64 + lane]);
            const float sp = (aw < 0.f ? -aw : 0.f) + log1pf(__expf(-fabsf(aw)));
            const float dec = __expf(-__expf(-sp - 0.5f));
            const float alr = sigmoid_f(aa);
            const float rc = RAW[(t + 1) * 480 + lane], rp = RAW[t * 480 + lane]; const float r = rc + (rp - rc) * mur;
            const float kc = RAW[(t + 1) * 480 + 64 + lane], kp = RAW[t * 480 + 64 + lane]; const float k = kc + (kp - kc) * muk;
            const float vc = RAW[(t + 1) * 480 + 128 + lane], vp = RAW[t * 480 + 128 + lane]; const float v = vc + (vp - vc) * muv;
            const float kkr = k * kkw; const float nrm = sqrtf(wave_sum(kkr * kkr)); const float kk = kkr / fmaxf(nrm, 1e-12f);
            const float kmod = k * (1.0f + (alr - 1.0f) * kaw);
            const float bon = wave_sum(r * kmod * rkw);
            Rm[t * 64 + lane] = r; Wm[t * 64 + lane] = dec; KPm[t * 64 + lane] = kmod; Vm[t * 64 + lane] = v; Am[t * 64 + lane] = -kk; Bm[t * 64 + lane] = kk * alr; Gm[t * 64 + lane] = ag;
            if (lane == 0) BON[t] = bon; }
        __syncthreads();
        for (int e = tid; e < 480; e += 512) RAW[e] = RAW[16 * 480 + e];
        if (wave < 4) { const int vrow = 16 * wave + (lane & 15), q = lane >> 4;
#pragma unroll 1
            for (int t = 0; t < 16; ++t) { float a[16], w[16], bb[16], kk[16], rr[16];
#pragma unroll
                for (int g = 0; g < 4; ++g) { const f32x4 av = *(const LAS f32x4*)(Am + t * 64 + 16 * q + 4 * g), wv = *(const LAS f32x4*)(Wm + t * 64 + 16 * q + 4 * g), bv = *(const LAS f32x4*)(Bm + t * 64 + 16 * q + 4 * g),
                        kv = *(const LAS f32x4*)(KPm + t * 64 + 16 * q + 4 * g), rv = *(const LAS f32x4*)(Rm + t * 64 + 16 * q + 4 * g);
#pragma unroll
                    for (int i = 0; i < 4; ++i) { a[4 * g + i] = av[i]; w[4 * g + i] = wv[i]; bb[4 * g + i] = bv[i]; kk[4 * g + i] = kv[i]; rr[4 * g + i] = rv[i]; } }
                float sa = 0.f;
#pragma unroll
                for (int j = 0; j < 16; ++j) sa += S[j] * a[j];
                sa += __shfl_xor(sa, 16); sa += __shfl_xor(sa, 32);
                const float vv = Vm[t * 64 + vrow]; float y = 0.f;
#pragma unroll
                for (int j = 0; j < 16; ++j) { S[j] = S[j] * w[j] + (sa * bb[j] + vv * kk[j]); y += S[j] * rr[j]; }
                y += __shfl_xor(y, 16); y += __shfl_xor(y, 32);
                if (q == 0) YR[t * 64 + vrow] = y; } }
        __syncthreads();
        if (c > 0 || b == 0) {
#pragma unroll 1
            for (int rep = 0; rep < 2; ++rep) { const int t = wave + 8 * rep; const float yv = YR[t * 64 + lane];
                const float mean = wave_sum(yv) * (1.0f / 64.0f); const float d = yv - mean; const float var = wave_sum(d * d) * (1.0f / 64.0f);
                const float yn = d * __builtin_amdgcn_rsqf(var + LNX_EPS) * lnw + lnb;
                const float o = (yn + BON[t] * Vm[t * 64 + lane]) * Gm[t * 64 + lane];
                Y[(size_t)(row0 + t) * DM + hj] = (bf16_t)(pk_bf16(o, 0.f) & 0xffffu); } }
        __syncthreads();
    }
}

namespace fox {
constexpr int D = 128, NW = 8, QBLK = 32, KVBLK = 64, QB = NW * QBLK;
constexpr int LDQ = cfg::QKVW, LDK = cfg::QKVW, LDO = cfg::DM;
constexpr float SCALE = 0.08838834764831845f, THR = 8.f;
constexpr bool WSKIP = false;
constexpr int SHM_V = KVBLK * D * 2, SHM_K = KVBLK * D * 2;
constexpr int ATT_LDS = 2 * SHM_V + 2 * SHM_K + NW * 64 * 4;
constexpr int BIAS_OFF = ATT_LDS;
constexpr int SCAN_OFF = BIAS_OFF + cfg::SEQP * 4;

using bf16 = __hip_bfloat16;
typedef short bf16x8 __attribute__((ext_vector_type(8)));
typedef short s16x4 __attribute__((ext_vector_type(4)));
typedef float f32x16 __attribute__((ext_vector_type(16)));
typedef float f32x4 __attribute__((ext_vector_type(4)));
typedef unsigned u32x4 __attribute__((ext_vector_type(4)));
template <class A, class Bt> struct same_t { static constexpr bool v = false; };
template <class A> struct same_t<A, A> { static constexpr bool v = true; };

#define KSWZ(row, colB) ((row) * 256 + ((colB) ^ (((row) & 7) << 4)))
#define SBAR() __builtin_amdgcn_sched_barrier(0)
__device__ __forceinline__ int v_st(int k, int c) { const int kk = (k & ~0xC) | ((k & 4) << 1) | ((k & 8) >> 1); return ((kk >> 3) * 4 + (c >> 5)) * 512 + ((kk & 7) * 32 + (c & 31)) * 2; }
__device__ __forceinline__ int v_rd_base(int lane) { return ((lane & 3) << 3) | (((lane >> 2) & 3) << 6) | (((lane >> 4) & 1) << 5) | (((lane >> 5) & 1) << 8); }
constexpr int v_rd_off(int d0, int ks, int half) { return d0 * 512 + ks * 4096 + half * 2048; }
__device__ __forceinline__ int crow(int r, int hi) { return (r & 3) + 8 * (r >> 2) + 4 * hi; }
__device__ __forceinline__ unsigned cvtpk(float lo, float hi) {
    unsigned r; asm volatile("v_cvt_pk_bf16_f32 %0, %1, %2" : "=v"(r) : "v"(lo), "v"(hi)); return r;
}
__device__ __forceinline__ bf16x8 pack8(f32x4 a, f32x4 b) {
    u32x4 w = {cvtpk(a[0], a[1]), cvtpk(a[2], a[3]), cvtpk(b[0], b[1]), cvtpk(b[2], b[3])};
    return *reinterpret_cast<bf16x8*>(&w);
}
template <class T> __device__ __forceinline__ bf16x8 load8(const T* p) {
    if constexpr (same_t<T, float>::v) { return pack8(*(const f32x4*)p, *(const f32x4*)(p + 4)); }
    else { return *reinterpret_cast<const bf16x8*>(p); }
}
__device__ __forceinline__ void mask_tile(f32x16& p0, f32x16& p1, int dq, unsigned W) {
    const float NEG = -__builtin_inff();
#pragma unroll
    for (int r = 0; r < 16; ++r) {
        const int c = (r & 3) + 8 * (r >> 2);
        if ((unsigned)(dq - c) >= W) p0[r] = NEG;
        if ((unsigned)(dq - c - 32) >= W) p1[r] = NEG;
    }
}
__device__ __forceinline__ void partialSM(f32x16& p0, f32x16& p1, float& m_reg, float& mn, float& alpha) {
    float pmax = p0[0]; for (int r = 1; r < 16; ++r) pmax = fmaxf(pmax, p0[r]); for (int r = 0; r < 16; ++r) pmax = fmaxf(pmax, p1[r]);
    { auto rr = __builtin_amdgcn_permlane32_swap(__float_as_uint(pmax), __float_as_uint(pmax), false, false);
      pmax = fmaxf(__uint_as_float(rr[0]), __uint_as_float(rr[1])); }
    constexpr float C2 = 1.4426950408889634f * SCALE;
    if (__builtin_expect(__all((pmax - m_reg) * SCALE <= THR), 1)) { mn = m_reg; alpha = 1.f; }
    else { mn = fmaxf(m_reg, pmax); alpha = __builtin_amdgcn_exp2f((m_reg - mn) * C2); m_reg = mn; }
    const float mnL = -mn * C2;
    for (int r = 0; r < 16; ++r) p0[r] = fmaf(p0[r], C2, mnL); for (int r = 0; r < 16; ++r) p1[r] = fmaf(p1[r], C2, mnL);
    for (int r = 0; r < 16; ++r) p0[r] = __builtin_amdgcn_exp2f(p0[r]);
}
__device__ __forceinline__ void finishSM(f32x16& p0, f32x16& p1, float alpha, float& l_reg, bf16x8& pa0, bf16x8& pa1, bf16x8& pa2, bf16x8& pa3) {
    for (int r = 0; r < 16; ++r) p1[r] = __builtin_amdgcn_exp2f(p1[r]);
    float ps = 0; for (int r = 0; r < 16; ++r) ps += p0[r]; for (int r = 0; r < 16; ++r) ps += p1[r];
    { auto rr = __builtin_amdgcn_permlane32_swap(__float_as_uint(ps), __float_as_uint(ps), false, false);
      ps = __uint_as_float(rr[0]) + __uint_as_float(rr[1]); }
    l_reg = l_reg * alpha + ps;
#define PK4(P, B_, OUT) do { unsigned a0 = cvtpk(P[B_+0], P[B_+1]), a1 = cvtpk(P[B_+2], P[B_+3]);                          \
        unsigned b0 = cvtpk(P[B_+4], P[B_+5]), b1 = cvtpk(P[B_+6], P[B_+7]);                                             \
        auto r0 = __builtin_amdgcn_permlane32_swap(a0, b0, false, false); auto r1 = __builtin_amdgcn_permlane32_swap(a1, b1, false, false); \
        u32x4 w = {r0[0], r1[0], r0[1], r1[1]}; OUT = *reinterpret_cast<bf16x8*>(&w); } while (0)
    PK4(p0, 0, pa0); PK4(p0, 8, pa1); PK4(p1, 0, pa2); PK4(p1, 8, pa3);
#undef PK4
}
template <int KB, bool SK>
__device__ __forceinline__ void qkt(f32x16& p0, f32x16& p1, const char* K_lds, int r32, int hi, const bf16x8* qr, bool act, const float* bias_t) {
    if (SK && !act) { const float NEG = -__builtin_inff();
#pragma unroll
        for (int r = 0; r < 16; ++r) { p0[r] = NEG; p1[r] = NEG; } return; }
    {
#pragma unroll
        for (int g_ = 0; g_ < 4; ++g_) { const f32x4 b0_ = *(const f32x4*)(bias_t + 8 * g_ + 4 * hi); const f32x4 b1_ = *(const f32x4*)(bias_t + 32 + 8 * g_ + 4 * hi);
            p0[4 * g_] = b0_[0]; p0[4 * g_ + 1] = b0_[1]; p0[4 * g_ + 2] = b0_[2]; p0[4 * g_ + 3] = b0_[3];
            p1[4 * g_] = b1_[0]; p1[4 * g_ + 1] = b1_[1]; p1[4 * g_ + 2] = b1_[2]; p1[4 * g_ + 3] = b1_[3]; } }
    const char* kb[4];
#pragma unroll
    for (int dd = 0; dd < 4; ++dd) kb[dd] = K_lds + KB * SHM_K + KSWZ(r32, (dd * 16 + hi * 8) * 2);
#pragma unroll
    for (int d0 = 0; d0 < 8; ++d0) { const char* a = kb[d0 & 3] + (d0 >> 2) * 128;
        bf16x8 b0 = *reinterpret_cast<const bf16x8*>(a);
        bf16x8 b1 = *reinterpret_cast<const bf16x8*>(a + 32 * 256);
        p0 = __builtin_amdgcn_mfma_f32_32x32x16_bf16(b0, qr[d0], p0, 0, 0, 0);
        p1 = __builtin_amdgcn_mfma_f32_32x32x16_bf16(b1, qr[d0], p1, 0, 0, 0); }
}
template <int VB, bool SK>
__device__ __forceinline__ void pv_tile(f32x16* o, int vb0, bf16x8 pa0, bf16x8 pa1, bf16x8 pa2, bf16x8 pa3, bool act) {
    if (SK && !act) return;
#define TRRD(dst, off) asm volatile("ds_read_b64_tr_b16 %0, %1 offset:%2" : "=&v"(dst) : "v"(vb0), "i"(off) : "memory")
#define PV_D0(d0) do { s16x4 l0, l1, l2, l3, h0, h1, h2, h3; constexpr int b_ = VB * SHM_V + v_rd_off(d0, 0, 0);     \
        TRRD(l0, b_); TRRD(h0, b_ + 2048); TRRD(l1, b_ + 4096); TRRD(h1, b_ + 6144); TRRD(l2, b_ + 8192); TRRD(h2, b_ + 10240); TRRD(l3, b_ + 12288); TRRD(h3, b_ + 14336); \
        asm volatile("s_waitcnt lgkmcnt(0)" ::: "memory"); SBAR();                 \
        o[d0] = __builtin_amdgcn_mfma_f32_32x32x16_bf16(pa0, (bf16x8){l0[0], l0[1], l0[2], l0[3], h0[0], h0[1], h0[2], h0[3]}, o[d0], 0, 0, 0);   \
        o[d0] = __builtin_amdgcn_mfma_f32_32x32x16_bf16(pa1, (bf16x8){l1[0], l1[1], l1[2], l1[3], h1[0], h1[1], h1[2], h1[3]}, o[d0], 0, 0, 0);   \
        o[d0] = __builtin_amdgcn_mfma_f32_32x32x16_bf16(pa2, (bf16x8){l2[0], l2[1], l2[2], l2[3], h2[0], h2[1], h2[2], h2[3]}, o[d0], 0, 0, 0);   \
        o[d0] = __builtin_amdgcn_mfma_f32_32x32x16_bf16(pa3, (bf16x8){l3[0], l3[1], l3[2], l3[3], h3[0], h3[1], h3[2], h3[3]}, o[d0], 0, 0, 0); } while (0)
    PV_D0(0); PV_D0(1); PV_D0(2); PV_D0(3);
#undef PV_D0
#undef TRRD
}

template <class TIn, class TOut> struct BlockRef { const TIn* Q; const TIn* K; const TIn* V; TOut* O; int P0; };
template <class TIn> struct Seam {
    bf16x8 qr[8];
    bf16x8 st_v0, st_v1, st_k0, st_k1; f32x4 sf0, sf1, sf2, sf3;
    f32x4 tq[16];
};
__device__ __forceinline__ int swa_jlo(int P0, int W) { const int lowk = P0 - W + 1; return lowk > 0 ? lowk / KVBLK : 0; }
#define ROW(p, k0, rr) ((p) + (size_t)((k0) + (rr)) * LDK + sc)
#define VMW() asm volatile("s_waitcnt vmcnt(0)" ::: "memory")
#define VMWN(n) asm volatile("s_waitcnt vmcnt(%0)" :: "i"(n) : "memory")
#define SLOAD_H(Kp, Vp, k0) do { S.st_v0 = load8<TIn>(ROW(Vp, k0, sr)); S.st_v1 = load8<TIn>(ROW(Vp, k0, 32 + sr));              \
                         S.st_k0 = load8<TIn>(ROW(Kp, k0, sr)); S.st_k1 = load8<TIn>(ROW(Kp, k0, 32 + sr)); } while (0)
#define SWRITE_HK(bf) do { *(bf16x8*)(K_lds + (bf) * SHM_K + kws) = S.st_k0; *(bf16x8*)(K_lds + (bf) * SHM_K + kws + 32 * 256) = S.st_k1; } while (0)
#define SWRITE_HV(bf) do { *(bf16x8*)(V_lds + (bf) * SHM_V + vst0) = S.st_v0; *(bf16x8*)(V_lds + (bf) * SHM_V + vst1) = S.st_v1; } while (0)
#define SWRITE_H(bf) do { SWRITE_HV(bf); SWRITE_HK(bf); } while (0)
#define SLOAD_F(p, k0) do { S.sf0 = *(const f32x4*)ROW(p, k0, sr); S.sf1 = *(const f32x4*)(ROW(p, k0, sr) + 4);                \
                            S.sf2 = *(const f32x4*)ROW(p, k0, 32 + sr); S.sf3 = *(const f32x4*)(ROW(p, k0, 32 + sr) + 4); } while (0)
#define SWRITE_KF(bf) do { *(bf16x8*)(K_lds + (bf) * SHM_K + kws) = pack8(S.sf0, S.sf1); *(bf16x8*)(K_lds + (bf) * SHM_K + kws + 32 * 256) = pack8(S.sf2, S.sf3); } while (0)
#define SWRITE_VF(bf) do { *(bf16x8*)(V_lds + (bf) * SHM_V + vst0) = pack8(S.sf0, S.sf1); *(bf16x8*)(V_lds + (bf) * SHM_V + vst1) = pack8(S.sf2, S.sf3); } while (0)
template <class TIn, class TOut>
__device__ __forceinline__ void causal_swa_prime(const BlockRef<TIn, TOut>& cur, int W, char* lds, Seam<TIn>& S) {
    constexpr bool F32 = same_t<TIn, float>::v;
    const int tid = threadIdx.x, wid = __builtin_amdgcn_readfirstlane(tid >> 6), lane = tid & 63, r32 = lane & 31, hi = lane >> 5;
    const int sr = tid >> 4, sc = (tid & 15) * 8, kws = KSWZ(sr, sc * 2); char* K_lds = lds + 2 * SHM_V;
    const int kb0 = swa_jlo(cur.P0, W) * KVBLK;
    for (int d0 = 0; d0 < 8; ++d0) S.qr[d0] = load8<TIn>(cur.Q + (size_t)(wid * QBLK + r32) * LDQ + d0 * 16 + hi * 8);
    if constexpr (F32) { SLOAD_F((const float*)cur.K, kb0); VMW(); SWRITE_KF(0); SBAR(); SLOAD_F((const float*)cur.V, kb0); }
    else { SLOAD_H(cur.K, cur.V, kb0); VMW(); SWRITE_HK(0); }
    __syncthreads();
}
template <class TIn, class TOut>
__device__ __forceinline__ void causal_swa_block(const BlockRef<TIn, TOut>& cur, const BlockRef<TIn, TOut>& nxt, int skv, int W, char* lds, Seam<TIn>& S, const float* bias_l) {
    constexpr bool F32 = same_t<TIn, float>::v;
    const int tid = threadIdx.x, wid = __builtin_amdgcn_readfirstlane(tid >> 6), lane = tid & 63, r32 = lane & 31, hi = lane >> 5;
    const int j_lo = swa_jlo(cur.P0, W);
    int j_hi = (cur.P0 + QB - 1) / KVBLK + 1; if (j_hi > skv / KVBLK) j_hi = skv / KVBLK;
    const int NT = j_hi - j_lo;
    const int kbn = swa_jlo(nxt.P0, W) * KVBLK;
    const int qlo = cur.P0 + wid * QBLK, qm = qlo + r32 - 4 * hi;
    char* V_lds = lds; char* K_lds = lds + 2 * SHM_V;
    float* ws = (float*)(lds + 2 * SHM_V + 2 * SHM_K) + wid * 64; float* li_l = ws, * al_l = ws + 32;
    float m_reg = -1e30f, l_reg = 0; f32x16 o[4] = {};
    const int sr = tid >> 4, sc = (tid & 15) * 8, vst0 = v_st(sr, sc), vst1 = v_st(32 + sr, sc), kws = KSWZ(sr, sc * 2);
    const int vb0 = (int)(uintptr_t)V_lds + v_rd_base(lane);
    const TIn* Kh = cur.K; const TIn* Vh = cur.V;
#define RESC(a) do { if (__any((a) < 1.f)) { if (hi == 0) al_l[r32] = (a); asm volatile("s_waitcnt lgkmcnt(0)" ::: "memory");              \
                     for (int d_ = 0; d_ < 4; ++d_) for (int r = 0; r < 16; ++r) o[d_][r] *= al_l[crow(r, hi)]; } } while (0)
#define KBASE(t) ((j_lo + (t)) * KVBLK)
#define ACT(t) (KBASE(t) <= qlo + QBLK - 1 && KBASE(t) + KVBLK - 1 >= qlo - W + 1)
#define MASKT(P0_, P1_, t) do { const int kb_ = KBASE(t); if ((!SK || ACT(t)) && (kb_ + KVBLK - 1 > qlo || kb_ <= qlo + QBLK - 1 - W)) mask_tile(P0_, P1_, qm - kb_, (unsigned)W); } while (0)
    constexpr int NQL = F32 ? 16 : 8;
    constexpr bool SK = WSKIP && !F32;
#define SEAM_K0() do { VMWN(NQL); if constexpr (F32) { SWRITE_KF(0); SBAR(); SLOAD_F((const float*)nxt.V, kbn); } else { SWRITE_HK(0); } SBAR(); } while (0)
    f32x16 pA0, pA1, pB0, pB1; float mnA, mnB, alA, alB; bf16x8 pa0, pa1, pa2, pa3;
    if constexpr (F32) { VMW(); SWRITE_VF(0); SBAR(); } else { SWRITE_HV(0); SBAR(); }
    if (NT > 1) { if constexpr (F32) SLOAD_F((const float*)Kh, KBASE(1)); else SLOAD_H(Kh, Vh, KBASE(1)); }
    SBAR(); qkt<0, SK>(pA0, pA1, K_lds, r32, hi, S.qr, ACT(0), bias_l + KBASE(0));
    if constexpr (F32) { if (NT > 1) { VMW(); SWRITE_KF(1); SBAR(); SLOAD_F((const float*)Vh, KBASE(1)); } }
    MASKT(pA0, pA1, 0); partialSM(pA0, pA1, m_reg, mnA, alA);
    if (NT > 1) { VMW(); if constexpr (F32) { SWRITE_VF(1); SBAR(); if (NT > 2) SLOAD_F((const float*)Kh, KBASE(2)); } else SWRITE_H(1); }
    __syncthreads();
#define HALF_STEP(PX0, PX1, mnX, alX, PY0, PY1, alY, t, KB, VB, SB) do {                                                      \
        SBAR(); qkt<KB, SK>(PX0, PX1, K_lds, r32, hi, S.qr, ACT(t), bias_l + KBASE(t));                                             \
        finishSM(PY0, PY1, alY, l_reg, pa0, pa1, pa2, pa3); SBAR();                                                           \
        if ((t) + 1 < NT) { if constexpr (F32) { VMW(); SWRITE_KF(SB); SBAR(); SLOAD_F((const float*)Vh, KBASE((t) + 1)); }  \
                            else { SLOAD_H(Kh, Vh, KBASE((t) + 1)); } SBAR(); }                                               \
        pv_tile<VB, SK>(o, vb0, pa0, pa1, pa2, pa3, ACT((t) - 1)); MASKT(PX0, PX1, (t)); partialSM(PX0, PX1, m_reg, mnX, alX);                                        \
        __syncthreads();                                                                                                      \
        if ((t) + 1 < NT) { VMW(); if constexpr (F32) { SWRITE_VF(SB); SBAR(); if ((t) + 2 < NT) SLOAD_F((const float*)Kh, KBASE((t) + 2)); } \
                            else { SWRITE_H(SB); } }                                                                          \
        RESC(alX); __syncthreads(); } while (0)
    for (int t = 1; t + 1 < NT; t += 2) {
        HALF_STEP(pB0, pB1, mnB, alB, pA0, pA1, alA, t, 1, 0, 0);
        HALF_STEP(pA0, pA1, mnA, alA, pB0, pB1, alB, t + 1, 0, 1, 1);
    }
    const bool even = (NT & 1) == 0;
    if (even) { SBAR(); qkt<1, SK>(pB0, pB1, K_lds, r32, hi, S.qr, ACT(NT - 1), bias_l + KBASE(NT - 1)); SBAR(); }
#define QROW(e) (nxt.Q + (size_t)(wid * QBLK + r32) * LDQ + ((e) >> 1) * 16 + hi * 8 + ((e) & 1) * 4)
    if constexpr (F32) { SLOAD_F((const float*)nxt.K, kbn); SBAR();
#pragma unroll
        for (int e = 0; e < 8; ++e) S.tq[e] = *(const f32x4*)QROW(e); }
    else { SLOAD_H(nxt.K, nxt.V, kbn); SBAR();
#pragma unroll
        for (int d0 = 0; d0 < 8; ++d0) S.qr[d0] = load8<TIn>(nxt.Q + (size_t)(wid * QBLK + r32) * LDQ + d0 * 16 + hi * 8); }
    SBAR();
    finishSM(pA0, pA1, alA, l_reg, pa0, pa1, pa2, pa3); SBAR();
    if constexpr (F32) {
#pragma unroll
        for (int e = 8; e < 16; ++e) S.tq[e] = *(const f32x4*)QROW(e); SBAR(); }
#undef QROW
    pv_tile<0, SK>(o, vb0, pa0, pa1, pa2, pa3, ACT(even ? NT - 2 : NT - 1));
    if (even) { MASKT(pB0, pB1, NT - 1); partialSM(pB0, pB1, m_reg, mnB, alB); __syncthreads(); RESC(alB);
        finishSM(pB0, pB1, alB, l_reg, pa0, pa1, pa2, pa3); SBAR(); pv_tile<1, SK>(o, vb0, pa0, pa1, pa2, pa3, ACT(NT - 1)); }
    SBAR(); SEAM_K0();
    if (hi == 0) li_l[r32] = l_reg; asm volatile("s_waitcnt lgkmcnt(0)" ::: "memory");
    float rli[16];
#pragma unroll
    for (int r = 0; r < 16; ++r) rli[r] = __builtin_amdgcn_rcpf(li_l[crow(r, hi)]);
    TOut* Ow = cur.O + (size_t)(wid * QBLK) * LDO;
#pragma unroll
    for (int r = 0; r < 16; ++r) { const int orow = crow(r, hi);
#pragma unroll
        for (int d0 = 0; d0 < 4; ++d0) { const float v = o[d0][r] * rli[r];
            if constexpr (same_t<TOut, float>::v) { Ow[(size_t)orow * LDO + d0 * 32 + r32] = v; }
            else { const float vn = __shfl_xor(v, 1);
                   if ((r32 & 1) == 0) *(unsigned*)(Ow + (size_t)orow * LDO + d0 * 32 + r32) = cvtpk(v, vn); } } }
    if constexpr (F32) {
#pragma unroll
        for (int d0 = 0; d0 < 8; ++d0) S.qr[d0] = pack8(S.tq[2 * d0], S.tq[2 * d0 + 1]); }
    __syncthreads();
#undef RESC
#undef KBASE
#undef ACT
#undef MASKT
#undef SEAM_K0
#undef HALF_STEP
}
#undef ROW
#undef VMW
#undef VMWN
#undef SLOAD_H
#undef SWRITE_HK
#undef SWRITE_HV
#undef SWRITE_H
#undef SLOAD_F
#undef SWRITE_KF

}

__device__ __forceinline__ void fox_bias(PP P, int l, int b, int h, float* bias, float* scr) {
    using namespace cfg;
    const int tid = threadIdx.x, lane = tid & 63, wave = tid >> 6;
    const float* PS = (const float*)(P->ws + WS_PS); const float bf = P->in[I_BF][l * FNH + h];
    float lf[9]; float loc = 0.f;
#pragma unroll
    for (int i = 0; i < 9; ++i) { const int pos = tid * 9 + i; float v = 0.f;
        if (pos < NMETA + SEQ) { const int row = pos < NMETA ? MMAIN + pos : b * SEQ + pos - NMETA; const float z = PS[(size_t)row * PSW + 288 + h] + bf;
            v = fminf(z, 0.f) - log1pf(__expf(-fabsf(z))); }
        loc += v; lf[i] = loc; }
    float inc = loc;
#pragma unroll
    for (int o = 1; o < 64; o <<= 1) { const float t = __shfl_up(inc, o); if (lane >= o) inc += t; }
    if (lane == 63) scr[wave] = inc;
    __syncthreads();
    float base = inc - loc;
    for (int w = 0; w < wave; ++w) base += scr[w];
    constexpr float INV = 1.0f / fox::SCALE;
#pragma unroll
    for (int i = 0; i < 9; ++i) { const int pos = tid * 9 + i; if (pos < NMETA + SEQ) bias[48 + pos] = -(base + lf[i]) * INV; }
    if (tid < 48) bias[tid] = -__builtin_inff();
    __syncthreads();
}
__device__ __forceinline__ void fox_meta(PP P, int h, const float* bias) {
    using namespace cfg;
    const int lane = threadIdx.x & 63, wave = threadIdx.x >> 6;
    const bf16_t* QKV = (const bf16_t*)(P->ws + WS_QKV); bf16_t* Y = (bf16_t*)(P->ws + WS_Y);
    for (int rep = 0; rep < 2; ++rep) { const int i = wave + 8 * rep;
        float s = -__builtin_inff();
        if (lane <= i) { const bf16_t* q = QKV + (size_t)(48 + i) * QKVW + h * 128; const bf16_t* k = QKV + (size_t)(48 + lane) * QKVW + 1024 + h * 128; float dot = 0.f;
            for (int d = 0; d < 128; ++d) dot += bf2f(q[d]) * bf2f(k[d]);
            s = (dot + bias[48 + lane]) * fox::SCALE; }
        const float m = wave_max(s); const float p = (lane <= i) ? __expf(s - m) : 0.f; const float lsum = wave_sum(p);
        float o0 = 0.f, o1 = 0.f;
        for (int j = 0; j <= i; ++j) { const float pj = __shfl(p, j); const bf16_t* v = QKV + (size_t)(48 + j) * QKVW + 2048 + h * 128; o0 += pj * bf2f(v[lane]); o1 += pj * bf2f(v[64 + lane]); }
        const float il = 1.0f / lsum;
        Y[(size_t)(MMAIN + i) * DM + 1024 + h * 128 + lane] = (bf16_t)(pk_bf16(o0 * il, 0.f) & 0xffffu);
        Y[(size_t)(MMAIN + i) * DM + 1024 + h * 128 + 64 + lane] = (bf16_t)(pk_bf16(o1 * il, 0.f) & 0xffffu); }
}
__device__ __forceinline__ fox::BlockRef<__hip_bfloat16, __hip_bfloat16> fox_mk(int a, int idx, const __hip_bfloat16* Qb, const __hip_bfloat16* Kb, const __hip_bfloat16* Vb, __hip_bfloat16* Ob) {
    const int pr = 4 * (a & 1) + (idx >> 1); const int x = (idx & 1) ? 15 - pr : pr;
    fox::BlockRef<__hip_bfloat16, __hip_bfloat16> r; r.Q = Qb + (size_t)x * 256 * cfg::QKVW; r.K = Kb; r.V = Vb; r.O = Ob + (size_t)x * 256 * cfg::DM; r.P0 = 64 + 256 * x; return r; }
__device__ __forceinline__ void fox_wg(PP P, int l, int a, char* lds) {
    using namespace cfg;
    typedef __hip_bfloat16 bf;
    const int bh = a >> 1, b = bh >> 3, h = bh & 7;
    float* bias = (float*)(lds + fox::BIAS_OFF); float* scr = (float*)(lds + fox::SCAN_OFF);
    fox_bias(P, l, b, h, bias, scr);
    const bf* QKV = (const bf*)(P->ws + WS_QKV); bf* Y = (bf*)(P->ws + WS_Y);
    const bf* Kb = QKV + (size_t)b * SEQP * QKVW + 1024 + h * 128; const bf* Vb = Kb + 1024; const bf* Qb = QKV + ((size_t)b * SEQP + 64) * QKVW + h * 128;
    bf* Ob = Y + (size_t)b * SEQ * DM + 1024 + h * 128;
    constexpr int W = 1 << 30;
    fox::Seam<bf> S;
    fox::BlockRef<bf, bf> cur = fox_mk(a, 0, Qb, Kb, Vb, Ob);
    fox::causal_swa_prime<bf, bf>(cur, W, lds, S);
#pragma unroll 1
    for (int idx = 0; idx < 8; ++idx) {
        const fox::BlockRef<bf, bf> nxt = (idx < 7) ? fox_mk(a, idx + 1, Qb, Kb, Vb, Ob) : cur;
        fox::causal_swa_block<bf, bf>(cur, nxt, SEQP, W, lds, S, bias);
        cur = nxt;
    }
    if (b == 0) fox_meta(P, h, bias);
}

#define WS_PTR(T, off) ((T*)(Q->ws + (off)))
#define KHEAD using namespace cfg; PP Q = (PP)__builtin_amdgcn_kernarg_segment_ptr(); extern __shared__ __attribute__((aligned(16))) unsigned char lds_raw[]; LAS unsigned char* lds = (LAS unsigned char*)lds_raw; (void)lds;
__global__ void __launch_bounds__(512, 2) k_conv(Params Pv) { KHEAD phase_convert(Q, lds); phase_init(Q); }
__global__ void __launch_bounds__(512, 2) k_gu(Params Pv, int l, int half) { KHEAD
    const unsigned char* wl = Q->ws + WS_W + (size_t)l * W_LAYER;
    pg8::Gemm g{WS_PTR(const bf16_t, WS_HB), (const bf16_t*)(wl + (half ? WO_GU2 : WO_GU1)), MROWS, NGU, DM}; pg8::StaticOrder S; S.init(MROWS, NGU, (int)gridDim.x, (int)blockIdx.x);
    pg8::EpiGU E{WS_PTR(bf16_t, WS_ACT), WS_PTR(const float, WS_SS) + (size_t)(3 * l + (half ? 2 : 0)) * 8 * MROWS};
    pg8::gemm_phase<pg8::EpiGU, pg8::StaticOrder, true, true>(lds, g, S, E); }
__global__ void __launch_bounds__(512, 2) k_down(Params Pv, int l, int half) { KHEAD
    const unsigned char* wl = Q->ws + WS_W + (size_t)l * W_LAYER;
    pg8::Gemm g{WS_PTR(const bf16_t, WS_ACT), (const bf16_t*)(wl + (half ? WO_D2 : WO_D1)), MROWS, DM, DFF}; pg8::StaticOrder S; S.init(MROWS, DM, (int)gridDim.x, (int)blockIdx.x);
    pg8::EpiRes E{Q->out, WS_PTR(float, WS_HMETA), WS_PTR(bf16_t, WS_HB), WS_PTR(float, WS_SS) + (size_t)(3 * l + (half ? 3 : 1)) * 8 * MROWS, 0.5f, (LAS float*)(lds + 131072)};
    pg8::gemm_phase<pg8::EpiRes, pg8::StaticOrder, true, true>(lds, g, S, E); }
__global__ void __launch_bounds__(512, 2) k_win(Params Pv, int l) { KHEAD
    const unsigned char* wl = Q->ws + WS_W + (size_t)l * W_LAYER;
    pg8::Gemm g{WS_PTR(const bf16_t, WS_HB), (const bf16_t*)(wl + WO_IN), MROWS, NIN, DM}; pg8::StaticOrder S; S.init(MROWS, NIN, (int)gridDim.x, (int)blockIdx.x);
    pg8::EpiP E{WS_PTR(bf16_t, WS_PR), WS_PTR(float, WS_PS), WS_PTR(bf16_t, WS_QKV), WS_PTR(const float, WS_SS) + (size_t)(3 * l + 1) * 8 * MROWS};
    pg8::gemm_phase<pg8::EpiP, pg8::StaticOrder, true, true>(lds, g, S, E); }
__global__ void __launch_bounds__(512, 2) k_rwkv(Params Pv, int l) { KHEAD
    if (blockIdx.x < 128) rwkv_simple(Q, l, blockIdx.x >> 4, blockIdx.x & 15, lds); }
__global__ void __launch_bounds__(512, 2) k_fox(Params Pv, int l) { KHEAD
    if (blockIdx.x < 128) fox_wg(Q, l, blockIdx.x, (char*)lds_raw); }
__global__ void __launch_bounds__(512, 2) k_foxnorm(Params Pv) { KHEAD phase_foxnorm(Q); }
__global__ void __launch_bounds__(512, 2) k_wout(Params Pv, int l) { KHEAD
    const unsigned char* wl = Q->ws + WS_W + (size_t)l * W_LAYER;
    pg8::Gemm g{WS_PTR(const bf16_t, WS_Y), (const bf16_t*)(wl + WO_OUT), MROWS, DM, DM}; pg8::StaticOrder S; S.init(MROWS, DM, (int)gridDim.x, (int)blockIdx.x);
    pg8::EpiRes E{Q->out, WS_PTR(float, WS_HMETA), WS_PTR(bf16_t, WS_HB), WS_PTR(float, WS_SS) + (size_t)(3 * l + 2) * 8 * MROWS, 1.0f, (LAS float*)(lds + 131072)};
    pg8::gemm_phase<pg8::EpiRes, pg8::StaticOrder, true, true>(lds, g, S, E); }
__global__ void __launch_bounds__(512, 2) k_final(Params Pv) { KHEAD phase_final(Q); }

extern "C" void kernel_launch(void* const* d_in, const int* in_sizes, int n_in, void* d_out, int out_size, void* d_ws, size_t ws_size, hipStream_t stream) {
    using namespace cfg;
    static int grid = 0;
    if (grid == 0) {
        if (n_in != 25 || out_size != MMAIN * DM || ws_size < WS_END) { fprintf(stderr, "kernel_launch: need 25 inputs, out %d, ws >= %zu; got n_in %d out %d ws %zu\n", MMAIN * DM, (size_t)WS_END, n_in, out_size, ws_size); grid = -1; return; }
        int dev = 0, cus = 0;
        if (hipGetDevice(&dev) != hipSuccess || hipDeviceGetAttribute(&cus, hipDeviceAttributeMultiprocessorCount, dev) != hipSuccess) { grid = -1; return; }
        const void* ks[] = {(const void*)k_conv, (const void*)k_gu, (const void*)k_down, (const void*)k_win, (const void*)k_rwkv, (const void*)k_fox, (const void*)k_foxnorm, (const void*)k_wout, (const void*)k_final};
        for (auto k : ks) if (hipFuncSetAttribute(k, hipFuncAttributeMaxDynamicSharedMemorySize, LDS_BYTES) != hipSuccess) { fprintf(stderr, "kernel_launch: hipFuncSetAttribute failed\n"); grid = -1; return; }
        grid = cus;
    }
    if (grid < 0) return;
    if (hipMemsetAsync((char*)d_ws + WS_CTL, 0, CTL_BYTES, stream) != hipSuccess) return;
    Params p{};
    for (int i = 0; i < 25; ++i) p.in[i] = (const float*)d_in[i];
    p.out = (float*)d_out; p.ws = (unsigned char*)d_ws; p.ph_lo = 0; p.ph_hi = 0;
    const dim3 G(grid), T(512);
    hipLaunchKernelGGL(k_conv, G, T, LDS_BYTES, stream, p);
    for (int l = 0; l < DEPTH; ++l) {
        hipLaunchKernelGGL(k_gu, G, T, LDS_BYTES, stream, p, l, 0);
        hipLaunchKernelGGL(k_down, G, T, LDS_BYTES, stream, p, l, 0);
        hipLaunchKernelGGL(k_win, G, T, LDS_BYTES, stream, p, l);
        hipLaunchKernelGGL(k_rwkv, dim3(128), T, LDS_BYTES, stream, p, l);
        hipLaunchKernelGGL(k_fox, dim3(128), T, LDS_BYTES, stream, p, l);
        hipLaunchKernelGGL(k_foxnorm, G, T, LDS_BYTES, stream, p);
        hipLaunchKernelGGL(k_wout, G, T, LDS_BYTES, stream, p, l);
        hipLaunchKernelGGL(k_gu, G, T, LDS_BYTES, stream, p, l, 1);
        hipLaunchKernelGGL(k_down, G, T, LDS_BYTES, stream, p, l, 1);
    }
    hipLaunchKernelGGL(k_final, G, T, LDS_BYTES, stream, p);
}
```

```cpp
#include <hip/hip_runtime.h>
#include <hip/hip_bf16.h>
#include <cstdio>
#include <cstdint>

#define LAS __attribute__((address_space(3)))
namespace cfg {
constexpr int DM = 2048, NBATCH = 8, SEQ = 4096, NMETA = 16, DEPTH = 4;
constexpr int MMAIN = NBATCH * SEQ;
constexpr int MROWS = MMAIN + 256;
constexpr int DFF = 5632, NGU = 2 * DFF;
constexpr int RW = 1024, RH = 64, RNH = 16;
constexpr int FW = 1024, FH = 128, FNH = 8;
constexpr int RWKV_COLS = 3360, DIN = 6440;
constexpr int NIN = 6656;
constexpr int PRW = 3072, PSW = 512, QKVW = 3072;
constexpr int SEQP = 4160;
constexpr float NORM_EPS = 1e-6f, LNX_EPS = 64e-5f;
constexpr int NSS = 13;
constexpr size_t al256(size_t x) { return (x + 255) & ~(size_t)255; }
constexpr size_t WS_CTL = 0;
constexpr size_t CTL_BYTES = 65536;
constexpr size_t WS_SS = WS_CTL + CTL_BYTES;
constexpr size_t SS_BYTES = al256((size_t)NSS * 8 * MROWS * 4);
constexpr size_t ZERO_BYTES = CTL_BYTES + SS_BYTES;
constexpr size_t WS_HMETA = WS_SS + SS_BYTES;
constexpr size_t WS_HB = WS_HMETA + (size_t)256 * DM * 4;
constexpr size_t WS_Y = WS_HB + (size_t)MROWS * DM * 2;
constexpr size_t WS_OVL = WS_Y + (size_t)MROWS * DM * 2;
constexpr size_t WS_ACT = WS_OVL;
constexpr size_t WS_PR = WS_OVL;
constexpr size_t WS_PS = WS_PR + (size_t)MROWS * PRW * 2;
constexpr size_t WS_QKV = WS_PS + (size_t)MROWS * PSW * 4;
constexpr size_t OVL_A = (size_t)MROWS * DFF * 2, OVL_B = (size_t)MROWS * PRW * 2 + (size_t)MROWS * PSW * 4 + (size_t)NBATCH * SEQP * QKVW * 2;
constexpr size_t WS_W = WS_OVL + al256(OVL_A > OVL_B ? OVL_A : OVL_B);
constexpr size_t W_GU = (size_t)NGU * DM * 2, W_D = (size_t)DM * DFF * 2, W_IN = (size_t)NIN * DM * 2, W_OUT = (size_t)DM * DM * 2;
constexpr size_t WO_GU1 = 0, WO_D1 = WO_GU1 + W_GU, WO_IN = WO_D1 + W_D, WO_OUT = WO_IN + W_IN, WO_GU2 = WO_OUT + W_OUT, WO_D2 = WO_GU2 + W_GU, W_LAYER = WO_D2 + W_D;
constexpr size_t WS_END = WS_W + (size_t)DEPTH * W_LAYER;
constexpr int LDS_BYTES = 147456;
constexpr int LDS_BARW = LDS_BYTES - 16;
}
__device__ __forceinline__ int ltid() { int t = (int)threadIdx.x; asm volatile("" : "+v"(t)); return t; }
__device__ __forceinline__ int lbid() { int t = (int)blockIdx.x; asm volatile("" : "+s"(t)); return t; }
__device__ __forceinline__ int lzero() { int t = 0; asm volatile("" : "+v"(t)); return t; }
namespace pg8 {
#define PG8_LAS __attribute__((address_space(3)))
typedef unsigned short bf16_t;
typedef short bf16x8 __attribute__((ext_vector_type(8)));
typedef float f32x4 __attribute__((ext_vector_type(4)));
typedef unsigned u32x4 __attribute__((ext_vector_type(4)));
constexpr int BM = 256, BK = 64, HALF = 128, HTB = HALF * BK * 2  , STAGE_BYTES = 8 * HTB, NXCD = 8, WGM = 8;

__host__ __device__ __forceinline__ int lds_byte(int r, int c) { const int st = (r >> 4) * 2 + (c >> 5), rr = r & 15, cc = c & 31, ob = rr * 64 + cc * 2; return st * 1024 + (ob ^ (((ob >> 9) & 1) << 5)); }
__host__ __device__ __forceinline__ void stage_rc(int b, int& R, int& C) { const int st = b / 1024, sb = b % 1024, swz = sb ^ (((sb >> 9) & 1) << 5); R = (st >> 1) * 16 + swz / 64; C = (st & 1) * 32 + (swz % 64) / 2; }
__host__ __device__ __forceinline__ int perm32(int rho) { const int n = rho >> 4, i = rho & 15; return 8 * (i >> 2) + 4 * n + (i & 3); }

struct Unit { int pm, pn; };
struct Gemm { const bf16_t* A; const bf16_t* Bt; int M, N, K; };

struct StaticOrder {
    int nM, nN, nwg, G, c;
    __host__ __device__ void init(int M, int N, int G_, int c_) { nM = M / BM; nN = N / BM; nwg = nM * nN; G = G_; c = c_; }
    __host__ __device__ bool next(int i, Unit& u) const {
        const long L = (long)i * G + c; if (L >= nwg) return false;
        int wgid = (int)L; { const int q = nwg / NXCD, r = nwg % NXCD, xcd = wgid % NXCD, off = wgid / NXCD; wgid = (xcd < r ? xcd * (q + 1) : r * (q + 1) + (xcd - r) * q) + off; }
        const int nig = WGM * nN, gid = wgid / nig, fm = gid * WGM, gsz = (nM - fm) < WGM ? (nM - fm) : WGM;
        u.pm = fm + ((wgid % nig) % gsz); u.pn = (wgid % nig) / gsz; return true;
    }
    __device__ __forceinline__ void a_ready(const Unit&) const {}
    __device__ __forceinline__ void done(const Unit&) const {}
};

__device__ __forceinline__ unsigned cvt_pk_bf16(float lo, float hi) { unsigned r; asm volatile("v_cvt_pk_bf16_f32 %0, %1, %2" : "=v"(r) : "v"(lo), "v"(hi)); return r; }
typedef float f32x2 __attribute__((ext_vector_type(2)));
__device__ __forceinline__ f32x2 gelu_pk(f32x2 v) {
    const f32x2 av = __builtin_elementwise_abs(v), d = av * 0.2316418882f + 1.0f;
    f32x2 t; t.x = __builtin_amdgcn_rcpf(d.x); t.y = __builtin_amdgcn_rcpf(d.y);
    f32x2 q = t * 0.5307027145f + (-0.7265760135f); q = q * t + 0.7107068705f; q = q * t + (-0.142248368f); q = q * t + 0.127414796f; q = q * t;
    const f32x2 s = (v * v) * (-0.72134752044f);
    f32x2 e; e.x = __builtin_amdgcn_exp2f(s.x); e.y = __builtin_amdgcn_exp2f(s.y);
    const f32x2 m = v * (q * e), r = v - m;
    f32x2 o; o.x = v.x < 0.f ? m.x : r.x; o.y = v.y < 0.f ? m.y : r.y; return o;
}
__device__ __forceinline__ float rs_of(const float* ss, int row) { float s = 0.f;
#pragma unroll
    for (int t = 0; t < 8; ++t) s += ss[(size_t)t * 33024 + row];
    return __builtin_amdgcn_rsqf(s * (1.0f / 2048.0f) + 1e-6f); }
__device__ __forceinline__ float silu_f(float x) { return x * __builtin_amdgcn_rcpf(1.0f + __builtin_amdgcn_exp2f(-1.4426950408889634f * x)); }

struct EpiGU {
    static constexpr bool PERM = true, AFTER_DRAIN = false;
    bf16_t* act; const float* ss;
    __device__ __forceinline__ void operator()(const f32x4 (&acc)[2][2][4][2], const Unit& u, int wr, int wc, int fr, int fq) const {
        const int row0 = u.pm * BM + wr * 64 + fr, col0 = u.pn * 128 + wc * 32 + 8 * fq;
#pragma unroll
        for (int ai = 0; ai < 2; ++ai)
#pragma unroll
            for (int m = 0; m < 4; ++m) { const int row = row0 + ai * HALF + m * 16; const float rs = rs_of(ss, row);
                const f32x4 g0 = acc[ai][0][m][0] * rs, g1 = acc[ai][0][m][1] * rs, u0 = acc[ai][1][m][0] * rs, u1 = acc[ai][1][m][1] * rs;
                u32x4 w;
                w.x = cvt_pk_bf16(silu_f(g0[0]) * u0[0], silu_f(g0[1]) * u0[1]); w.y = cvt_pk_bf16(silu_f(g0[2]) * u0[2], silu_f(g0[3]) * u0[3]);
                w.z = cvt_pk_bf16(silu_f(g1[0]) * u1[0], silu_f(g1[1]) * u1[1]); w.w = cvt_pk_bf16(silu_f(g1[2]) * u1[2], silu_f(g1[3]) * u1[3]);
                *(u32x4*)(act + (size_t)row * 5632 + col0) = w; }
    }
};
struct EpiRes {
    static constexpr bool PERM = false, AFTER_DRAIN = false;
    float* hmain; float* hmeta; bf16_t* hb; float* ssn; float alpha; PG8_LAS float* red;
    __device__ __forceinline__ void operator()(const f32x4 (&acc)[2][2][4][2], const Unit& u, int wr, int wc, int fr, int fq) const {
        typedef unsigned u32x2v __attribute__((ext_vector_type(2)));
        float* base = (u.pm < 128) ? hmain + (size_t)u.pm * BM * 2048 : hmeta;
        bf16_t* bbase = hb + (size_t)u.pm * BM * 2048;
        const int rl0 = wr * 64 + fr; unsigned off = (unsigned)(rl0 * 2048 + u.pn * BM + wc * 32 + 4 * fq);
#pragma unroll
        for (int ai = 0; ai < 2; ++ai)
#pragma unroll
            for (int m = 0; m < 4; ++m) { const unsigned o = off + (unsigned)((ai * HALF + m * 16) * 2048); float sq = 0.f;
#pragma unroll
                for (int bj = 0; bj < 2; ++bj)
#pragma unroll
                    for (int n = 0; n < 2; ++n) { const unsigned oo = o + bj * HALF + n * 16; f32x4 hv = *(const f32x4*)(base + oo); hv = hv + acc[ai][bj][m][n] * alpha; *(f32x4*)(base + oo) = hv;
                        sq += (hv[0] * hv[0] + hv[1] * hv[1]) + (hv[2] * hv[2] + hv[3] * hv[3]);
                        u32x2v w; w.x = cvt_pk_bf16(hv[0], hv[1]); w.y = cvt_pk_bf16(hv[2], hv[3]); *(u32x2v*)(bbase + oo) = w; }
                sq += __shfl_xor(sq, 16); sq += __shfl_xor(sq, 32);
                if (fq == 0) red[(rl0 + ai * HALF + m * 16) * 4 + wc] = sq;
                asm volatile("" ::: "memory"); }
        asm volatile("s_waitcnt lgkmcnt(0)" ::: "memory"); __builtin_amdgcn_s_barrier(); asm volatile("" ::: "memory");
        if (wr == 0) { const int row = wc * 64 + fq * 16 + fr; const float s4 = (red[row * 4] + red[row * 4 + 1]) + (red[row * 4 + 2] + red[row * 4 + 3]); ssn[(size_t)u.pn * 33024 + u.pm * BM + row] = s4; }
    }
};
struct EpiP {
    static constexpr bool PERM = true, AFTER_DRAIN = false;
    bf16_t* pr; float* ps; bf16_t* qkv; const float* ss;
    __device__ __forceinline__ void operator()(const f32x4 (&acc)[2][2][4][2], const Unit& u, int wr, int wc, int fr, int fq) const {
        const int row0 = u.pm * BM + wr * 64 + fr, cl = wc * 32 + 8 * fq;
#pragma unroll
        for (int ai = 0; ai < 2; ++ai)
#pragma unroll
            for (int m = 0; m < 4; ++m) { const int row = row0 + ai * HALF + m * 16; const float rs = rs_of(ss, row);
#pragma unroll
                for (int bj = 0; bj < 2; ++bj) { const f32x4 v0 = acc[ai][bj][m][0] * rs, v1 = acc[ai][bj][m][1] * rs;
                    if (u.pn >= 12 && u.pn < 14) { float* d = ps + (size_t)row * 512 + (u.pn - 12) * 256 + bj * HALF + cl; *(f32x4*)d = v0; *(f32x4*)(d + 4) = v1; }
                    else { u32x4 w; w.x = cvt_pk_bf16(v0[0], v0[1]); w.y = cvt_pk_bf16(v0[2], v0[3]); w.z = cvt_pk_bf16(v1[0], v1[1]); w.w = cvt_pk_bf16(v1[2], v1[3]);
                        if (u.pn < 12) *(u32x4*)(pr + (size_t)row * 3072 + u.pn * 256 + bj * HALF + cl) = w;
                        else { const int c = (u.pn - 14) * 256 + bj * HALF + cl;
                            if (u.pm < 128) { const int b = row >> 12, s = row & 4095; *(u32x4*)(qkv + ((size_t)b * 4160 + 64 + s) * 3072 + c) = w; }
                            else { const int j = row - 32768; if (j < 16) { for (int b = 0; b < 8; ++b) *(u32x4*)(qkv + ((size_t)b * 4160 + 48 + j) * 3072 + c) = w; } } } } } }
    }
};
template <class Epi, class Sched, bool ALIGN_EPI = false, bool SP2 = false>
__device__ __forceinline__ void gemm_phase(PG8_LAS unsigned char* lds, const Gemm g, const Sched& S, const Epi& E) {
    const int tid = ltid(), wid = __builtin_amdgcn_readfirstlane(tid >> 6), lane = tid & 63, wr = wid >> 2, wc = wid & 3, fr = lane & 15, fq = lane >> 4;
    const int K = g.K, nt = K / BK;
    unsigned voffA[2], voffB[2];
#pragma unroll
    for (int i = 0; i < 2; ++i) { int R, C; stage_rc(tid * 16 + i * 8192, R, C); const int Rb = Epi::PERM ? ((R & ~31) + perm32(R & 31)) : R;
        voffA[i] = (unsigned)(R * K + C) * 2u; voffB[i] = (unsigned)(Rb * K + C) * 2u; }
    const size_t kstep = (size_t)(BK * 2);
    const size_t hstep = (size_t)HALF * K * 2;
    const size_t tstep = 2 * hstep;
    const unsigned ldsw = (unsigned)wid * 1024u;
    const int aoff = lds_byte(wr * 64 + fr, fq * 8), boff = lds_byte(wc * 32 + fr, fq * 8);
#define PG8_SA(b, h) (((b) * 2 + (h)) * HTB)
#define PG8_SB(b, h) ((4 + (b) * 2 + (h)) * HTB)
#define PG8_STAGE(bufoff, gbase, voff) do { _Pragma("unroll") for (int _i = 0; _i < 2; ++_i) \
        __builtin_amdgcn_global_load_lds((const unsigned*)((const char*)(gbase) + (voff)[_i]), (PG8_LAS unsigned*)(lds + (bufoff) + ldsw + _i * 8192), 16, 0, 0); } while (0)
#define PG8_LDA(dst, b, h) do { _Pragma("unroll") for (int m = 0; m < 4; ++m) _Pragma("unroll") for (int k = 0; k < 2; ++k) dst[m][k] = *(const PG8_LAS bf16x8*)(lds + PG8_SA(b, h) + aoff + m * 2048 + k * 1024); } while (0)
#define PG8_LDB(dst, b, h) do { _Pragma("unroll") for (int n = 0; n < 2; ++n) _Pragma("unroll") for (int k = 0; k < 2; ++k) dst[n][k] = *(const PG8_LAS bf16x8*)(lds + PG8_SB(b, h) + boff + n * 2048 + k * 1024); } while (0)
#define PG8_MMA(ai, bj, At, Bt) do { __builtin_amdgcn_s_setprio(1); _Pragma("unroll") for (int m = 0; m < 4; ++m) _Pragma("unroll") for (int n = 0; n < 2; ++n) _Pragma("unroll") for (int k = 0; k < 2; ++k) \
        acc[ai][bj][m][n] = __builtin_amdgcn_mfma_f32_16x16x32_bf16(Bt[n][k], At[m][k], acc[ai][bj][m][n], 0, 0, 0); __builtin_amdgcn_s_setprio(0); } while (0)
#define PG8_WAIT_V(n) asm volatile("s_waitcnt vmcnt(" #n ")" ::: "memory")
#define PG8_WAIT_L(n) asm volatile("s_waitcnt lgkmcnt(" #n ")" ::: "memory")
#define PG8_BAR __builtin_amdgcn_s_barrier()
#define PG8_SCHED __builtin_amdgcn_sched_barrier(0)
    Unit cur, nxt; int ui = 0;
    if (!S.next(0, cur)) return;
    f32x4 acc[2][2][4][2];
#pragma unroll
    for (int a = 0; a < 2; ++a)
#pragma unroll
        for (int b = 0; b < 2; ++b)
#pragma unroll
            for (int m = 0; m < 4; ++m)
#pragma unroll
                for (int n = 0; n < 2; ++n) acc[a][b][m][n] = (f32x4){0.f, 0.f, 0.f, 0.f};
    bf16x8 At[4][2], B0[2][2], B1[2][2];
    const char* cA = (const char*)g.A + (size_t)cur.pm * tstep; const char* cB = (const char*)g.Bt + (size_t)cur.pn * tstep;
    S.a_ready(cur);
    if constexpr (SP2) {
        PG8_STAGE(PG8_SB(0, 0), cB, voffB); PG8_STAGE(PG8_SB(0, 1), cB + hstep, voffB); PG8_STAGE(PG8_SA(0, 0), cA, voffA); PG8_STAGE(PG8_SA(0, 1), cA + hstep, voffA);
        if (wr == 1) PG8_BAR;
        PG8_WAIT_V(2); PG8_BAR;
        PG8_STAGE(PG8_SB(1, 0), cB + kstep, voffB); PG8_STAGE(PG8_SA(1, 0), cA + kstep, voffA); PG8_STAGE(PG8_SB(1, 1), cB + hstep + kstep, voffB);
        PG8_WAIT_V(6); PG8_BAR;
    } else {
        PG8_STAGE(PG8_SB(0, 0), cB, voffB); PG8_STAGE(PG8_SA(0, 0), cA, voffA); PG8_STAGE(PG8_SB(0, 1), cB + hstep, voffB); PG8_STAGE(PG8_SA(0, 1), cA + hstep, voffA);
        if (wr == 1) PG8_BAR;
        PG8_WAIT_V(4); PG8_BAR;
        PG8_STAGE(PG8_SB(1, 0), cB + kstep, voffB); PG8_STAGE(PG8_SA(1, 0), cA + kstep, voffA); PG8_STAGE(PG8_SB(1, 1), cB + hstep + kstep, voffB);
        PG8_WAIT_V(6); PG8_BAR;
    }
    for (;;) {
        const bool has_next = S.next(ui + 1, nxt);
        const char* nA = has_next ? (const char*)g.A + (size_t)nxt.pm * tstep : cA; const char* nB = has_next ? (const char*)g.Bt + (size_t)nxt.pn * tstep : cB;
        for (int t = 0; t < nt; t += 2) {
            const bool last = (t == nt - 2);
            const char* a1 = cA + (size_t)(t + 1) * kstep;
            const char* a2 = last ? nA : cA + (size_t)(t + 2) * kstep; const char* b2 = last ? nB : cB + (size_t)(t + 2) * kstep;
            const char* a3 = a2 + kstep; const char* b3 = b2 + kstep;
            if (last && has_next) S.a_ready(nxt);
            if constexpr (SP2) {
            PG8_LDB(B0, 0, 0); PG8_LDB(B1, 0, 1); PG8_SCHED; PG8_LDA(At, 0, 0); PG8_STAGE(PG8_SA(1, 1), a1 + hstep, voffA);
            PG8_WAIT_V(8); PG8_WAIT_L(0); PG8_BAR; PG8_MMA(0, 0, At, B0); PG8_MMA(0, 1, At, B1); PG8_BAR; PG8_SCHED;
            PG8_LDA(At, 0, 1); PG8_STAGE(PG8_SB(0, 0), b2, voffB); PG8_STAGE(PG8_SB(0, 1), b2 + hstep, voffB); PG8_STAGE(PG8_SA(0, 0), a2, voffA);
            PG8_WAIT_V(8); PG8_WAIT_L(0); PG8_BAR; PG8_MMA(1, 0, At, B0); PG8_MMA(1, 1, At, B1); PG8_BAR; PG8_SCHED;
            PG8_LDB(B0, 1, 0); PG8_LDB(B1, 1, 1); PG8_SCHED; PG8_LDA(At, 1, 0); PG8_STAGE(PG8_SA(0, 1), a2 + hstep, voffA);
            PG8_WAIT_V(8); PG8_WAIT_L(0); PG8_BAR; PG8_MMA(0, 0, At, B0); PG8_MMA(0, 1, At, B1); PG8_BAR; PG8_SCHED;
            PG8_LDA(At, 1, 1); PG8_STAGE(PG8_SB(1, 0), b3, voffB); PG8_STAGE(PG8_SB(1, 1), b3 + hstep, voffB); PG8_STAGE(PG8_SA(1, 0), a3, voffA);
            PG8_WAIT_V(8); PG8_WAIT_L(0); PG8_BAR; PG8_MMA(1, 0, At, B0); PG8_MMA(1, 1, At, B1); PG8_BAR; PG8_SCHED;
            } else {
            PG8_LDB(B0, 0, 0); PG8_SCHED; PG8_LDA(At, 0, 0); PG8_STAGE(PG8_SA(1, 1), a1 + hstep, voffA);
            PG8_WAIT_L(8); PG8_BAR; PG8_WAIT_L(0); PG8_MMA(0, 0, At, B0); PG8_BAR; PG8_SCHED;
            PG8_LDB(B1, 0, 1); PG8_STAGE(PG8_SB(0, 0), b2, voffB);
            PG8_BAR; PG8_WAIT_L(0); PG8_MMA(0, 1, At, B1); PG8_BAR;
            PG8_LDA(At, 0, 1); PG8_STAGE(PG8_SA(0, 0), a2, voffA);
            PG8_BAR; PG8_WAIT_L(0); PG8_MMA(1, 0, At, B0); PG8_BAR; PG8_SCHED;
            PG8_STAGE(PG8_SB(0, 1), b2 + hstep, voffB);
            PG8_WAIT_V(6); PG8_BAR; PG8_MMA(1, 1, At, B1); PG8_BAR;
            PG8_LDB(B0, 1, 0); PG8_SCHED; PG8_LDA(At, 1, 0); PG8_STAGE(PG8_SA(0, 1), a2 + hstep, voffA);
            PG8_WAIT_L(8); PG8_BAR; PG8_WAIT_L(0); PG8_MMA(0, 0, At, B0); PG8_BAR; PG8_SCHED;
            PG8_LDB(B1, 1, 1); PG8_STAGE(PG8_SB(1, 0), b3, voffB);
            PG8_BAR; PG8_WAIT_L(0); PG8_MMA(0, 1, At, B1); PG8_BAR;
            PG8_LDA(At, 1, 1); PG8_STAGE(PG8_SA(1, 0), a3, voffA);
            PG8_BAR; PG8_WAIT_L(0); PG8_MMA(1, 0, At, B0); PG8_BAR; PG8_SCHED;
            PG8_STAGE(PG8_SB(1, 1), b3 + hstep, voffB);
            PG8_WAIT_V(6); PG8_BAR; PG8_MMA(1, 1, At, B1); PG8_BAR;
            }
        }
        if constexpr (ALIGN_EPI) { if (wr == 0) PG8_BAR; }
        if constexpr (!Epi::AFTER_DRAIN) { E(acc, cur, wr, wc, fr, fq); S.done(cur); }
        if (!has_next) break;
#pragma unroll
        for (int a = 0; a < 2; ++a)
#pragma unroll
            for (int b = 0; b < 2; ++b)
#pragma unroll
                for (int m = 0; m < 4; ++m)
#pragma unroll
                    for (int n = 0; n < 2; ++n) acc[a][b][m][n] = (f32x4){0.f, 0.f, 0.f, 0.f};
        cur = nxt; cA = nA; cB = nB; ++ui;
        if constexpr (ALIGN_EPI) { if (wr == 1) PG8_BAR; }
    }
    PG8_WAIT_V(0);
    if constexpr (!ALIGN_EPI) { if (wr == 0) PG8_BAR; }
    PG8_BAR;
    if constexpr (Epi::AFTER_DRAIN) { E.fused(acc, cur, wr, wc, fr, fq, lds, wid, lane); S.done(cur); }
#undef PG8_SA
#undef PG8_SB
#undef PG8_STAGE
#undef PG8_LDA
#undef PG8_LDB
#undef PG8_MMA
#undef PG8_WAIT_V
#undef PG8_WAIT_L
#undef PG8_BAR
#undef PG8_SCHED
}
}


#define XB_TMO      128
#define XB_XCNT(j)  (256  + 64 * (j))
#define XB_XSUB(j)  (1280 + 64 * (j))
#define XB_XGEN(j)  (2304 + 64 * (j))
#define XB_TOP      3328
#define XB_TOPGEN   3392
#define XCD_BAR_WORDS 3456
#define XB_SPIN_CAP (1u << 22)

__device__ __forceinline__ unsigned xb_ld(unsigned* p)              { return __hip_atomic_load(p, __ATOMIC_RELAXED, __HIP_MEMORY_SCOPE_AGENT); }
__device__ __forceinline__ unsigned xb_add(unsigned* p, unsigned v) { return __hip_atomic_fetch_add(p, v, __ATOMIC_RELAXED, __HIP_MEMORY_SCOPE_AGENT); }
__device__ __forceinline__ unsigned xb_xcc_id() { return (unsigned)__builtin_amdgcn_s_getreg((3 << 11) | 20) & 0xFu; }
#define XB_SPIN(cond, bar) do { unsigned _sp = 0; while (cond) { __builtin_amdgcn_s_sleep(1); \
    if ((++_sp & 255u) == 0u) { if (xb_ld(&(bar)[XB_TMO])) break; if (_sp > XB_SPIN_CAP) { atomicAdd(&(bar)[XB_TMO], 1u); break; } } } } while (0)

struct XcdBarrier {
    unsigned* bar; unsigned x;
    volatile LAS unsigned* st;
};

__device__ __forceinline__ XcdBarrier xcd_barrier_post(unsigned* bar, volatile LAS unsigned* st) {
    XcdBarrier b; b.bar = bar; b.x = xb_xcc_id(); b.st = st;
    if (threadIdx.x == 0) (void)xb_add(&bar[XB_XCNT(b.x)], 1u);
    return b;
}
__device__ __forceinline__ void xcd_barrier_complete(unsigned* bar, unsigned x, unsigned& nloc, unsigned& nx) {
    const unsigned G = gridDim.x * gridDim.y * gridDim.z;
    unsigned sum, cnt, mine, sp = 0u;
    for (;;) {
        sum = 0u; cnt = 0u; mine = 0u;
#pragma unroll
        for (unsigned j = 0; j < 16; ++j) { const unsigned c = xb_ld(&bar[XB_XCNT(j)]); sum += c; cnt += (c > 0u) ? 1u : 0u; mine = (j == x) ? c : mine; }
        if (sum == G) break;
        __builtin_amdgcn_s_sleep(1);
        if ((++sp & 255u) == 0u) { if (xb_ld(&bar[XB_TMO])) break; if (sp > XB_SPIN_CAP) { atomicAdd(&bar[XB_TMO], 1u); break; } }
    }
    nloc = mine > 0u ? mine : 1u; nx = cnt > 0u ? cnt : 1u;
}

__device__ __forceinline__ void xcd_barrier(const XcdBarrier& b) {
    asm volatile("s_waitcnt vmcnt(0)" ::: "memory");
    __syncthreads();
    if (threadIdx.x == 0) {
        unsigned* bar = b.bar;
        __builtin_amdgcn_s_waitcnt(0);
        unsigned nloc = b.st[0], nx = b.st[1];
        if (nloc == 0u) { xcd_barrier_complete(bar, b.x, nloc, nx); b.st[0] = nloc; b.st[1] = nx; }
        const unsigned old = xb_add(&bar[XB_XSUB(b.x)], 1u);
        const unsigned gen = old / nloc;
        if (old + 1u == (gen + 1u) * nloc) {
            __builtin_amdgcn_fence(__ATOMIC_RELEASE, "agent");
            asm volatile("s_waitcnt vmcnt(0)" ::: "memory");
            const unsigned og = xb_add(&bar[XB_TOP], 1u);
            const unsigned tg = og / nx;
            if (og + 1u == (tg + 1u) * nx) xb_add(&bar[XB_TOPGEN], 1u);
            else XB_SPIN(xb_ld(&bar[XB_TOPGEN]) == tg, bar);
            __builtin_amdgcn_fence(__ATOMIC_ACQUIRE, "agent");
            xb_add(&bar[XB_XGEN(b.x)], 1u);
            asm volatile("s_waitcnt vmcnt(0)" ::: "memory");
        } else {
            XB_SPIN(xb_ld(&bar[XB_XGEN(b.x)]) == gen, bar);
            __builtin_amdgcn_fence(__ATOMIC_ACQUIRE, "agent");
            asm volatile("s_waitcnt vmcnt(0)" ::: "memory");
        }
    }
    __syncthreads();
}


typedef unsigned short bf16_t;
typedef float f32x4 __attribute__((ext_vector_type(4)));
typedef unsigned u32x4 __attribute__((ext_vector_type(4)));
typedef unsigned u32x2 __attribute__((ext_vector_type(2)));
struct Params { const float* in[25]; float* out; unsigned char* ws; int ph_lo, ph_hi; };
#define CAS __attribute__((address_space(4)))
typedef const CAS Params* PP;
__device__ __forceinline__ PP launder(PP p) { asm volatile("" : "+s"(p)); return p; }
enum { I_X = 0, I_META, I_F1N, I_F1GU, I_F1D, I_MIXN, I_WIN, I_MU, I_W0, I_WUP, I_A0, I_AUP, I_GUP, I_KK, I_KA, I_RK, I_LNW, I_LNB, I_BF, I_FON, I_WOUT, I_F2N, I_F2GU, I_F2D, I_FINN };

__device__ __forceinline__ unsigned pk_bf16(float lo, float hi) { unsigned r; asm volatile("v_cvt_pk_bf16_f32 %0, %1, %2" : "=v"(r) : "v"(lo), "v"(hi)); return r; }
__device__ __forceinline__ float bf2f(bf16_t b) { return __uint_as_float(((unsigned)b) << 16); }
__device__ __forceinline__ float wave_sum(float v) {
#pragma unroll
    for (int o = 32; o >= 1; o >>= 1) v += __shfl_xor(v, o);
    return v; }
__device__ __forceinline__ float wave_max(float v) {
#pragma unroll
    for (int o = 32; o >= 1; o >>= 1) v = fmaxf(v, __shfl_xor(v, o));
    return v; }
__device__ __forceinline__ float sigmoid_f(float x) { return __builtin_amdgcn_rcpf(1.0f + __expf(-x)); }

__device__ __forceinline__ void convert_tile(const float* __restrict__ src, bf16_t* __restrict__ dst, const float* __restrict__ gain, int K, int Nsrc, int kind, int tk, int tn, LAS float* T) {
    const int tid = ltid();
    {
        const int nl = (tid & 15) * 4, np = tn * 64 + nl; int sc;
        if (kind == 1) { const int pn = np >> 8, bj = (np >> 7) & 1, i = np & 127; sc = bj * cfg::DFF + pn * 128 + i; }
        else if (kind == 2) { sc = np < 3360 ? np : (np < 3368 ? 6432 + (np - 3360) : (np < 3584 ? -1 : 3360 + (np - 3584))); }
        else sc = np;
#pragma unroll
        for (int i = 0; i < 2; ++i) { const int kl = (tid >> 4) + 32 * i, k = tk * 64 + kl;
            f32x4 v = (f32x4){0.f, 0.f, 0.f, 0.f};
            if (sc >= 0) v = *(const f32x4*)(src + (size_t)k * Nsrc + sc);
            float g = 1.f; if (kind == 1 || kind == 2) g = gain[k]; else if (kind == 3) g = (k >= 1024) ? gain[k - 1024] : 1.f;
            T[kl * 65 + nl] = v[0] * g; T[kl * 65 + nl + 1] = v[1] * g; T[kl * 65 + nl + 2] = v[2] * g; T[kl * 65 + nl + 3] = v[3] * g; }
    }
    __syncthreads();
    {
        const int nl = tid >> 3, k8 = (tid & 7) * 8; u32x4 w;
        w.x = pk_bf16(T[(k8 + 0) * 65 + nl], T[(k8 + 1) * 65 + nl]); w.y = pk_bf16(T[(k8 + 2) * 65 + nl], T[(k8 + 3) * 65 + nl]);
        w.z = pk_bf16(T[(k8 + 4) * 65 + nl], T[(k8 + 5) * 65 + nl]); w.w = pk_bf16(T[(k8 + 6) * 65 + nl], T[(k8 + 7) * 65 + nl]);
        *(u32x4*)(dst + (size_t)(tn * 64 + nl) * K + tk * 64 + k8) = w;
    }
    __syncthreads();
}
__device__ __forceinline__ void phase_convert(PP P, LAS unsigned char* lds) {
    using namespace cfg;
    LAS float* T = (LAS float*)lds;
    constexpr int T_GU = (DM / 64) * (NGU / 64), T_D = (DFF / 64) * (DM / 64), T_IN = (DM / 64) * (NIN / 64), T_OUT = (DM / 64) * (DM / 64);
    constexpr int T_LAYER = 2 * T_GU + 2 * T_D + T_IN + T_OUT;
    for (int t = lbid(); t < DEPTH * T_LAYER; t += gridDim.x) {
        const int l = t / T_LAYER; int r = t - l * T_LAYER;
        bf16_t* wl = (bf16_t*)(P->ws + WS_W + (size_t)l * W_LAYER);
        const float* src; bf16_t* dst; const float* gain = nullptr; int K, Nsrc, kind, ntn;
        if (r < T_GU) { src = P->in[I_F1GU] + (size_t)l * DM * NGU; dst = (bf16_t*)((unsigned char*)wl + WO_GU1); gain = P->in[I_F1N] + l * DM; K = DM; Nsrc = NGU; kind = 1; ntn = NGU / 64; }
        else if ((r -= T_GU) < T_D) { src = P->in[I_F1D] + (size_t)l * DFF * DM; dst = (bf16_t*)((unsigned char*)wl + WO_D1); K = DFF; Nsrc = DM; kind = 0; ntn = DM / 64; }
        else if ((r -= T_D) < T_IN) { src = P->in[I_WIN] + (size_t)l * DM * DIN; dst = (bf16_t*)((unsigned char*)wl + WO_IN); gain = P->in[I_MIXN] + l * DM; K = DM; Nsrc = DIN; kind = 2; ntn = NIN / 64; }
        else if ((r -= T_IN) < T_OUT) { src = P->in[I_WOUT] + (size_t)l * DM * DM; dst = (bf16_t*)((unsigned char*)wl + WO_OUT); gain = P->in[I_FON] + l * FW; K = DM; Nsrc = DM; kind = 3; ntn = DM / 64; }
        else if ((r -= T_OUT) < T_GU) { src = P->in[I_F2GU] + (size_t)l * DM * NGU; dst = (bf16_t*)((unsigned char*)wl + WO_GU2); gain = P->in[I_F2N] + l * DM; K = DM; Nsrc = NGU; kind = 1; ntn = NGU / 64; }
        else { r -= T_GU; src = P->in[I_F2D] + (size_t)l * DFF * DM; dst = (bf16_t*)((unsigned char*)wl + WO_D2); K = DFF; Nsrc = DM; kind = 0; ntn = DM / 64; }
        convert_tile(src, dst, gain, K, Nsrc, kind, r / ntn, r % ntn, T);
    }
}
__device__ __forceinline__ void phase_init(PP P) {
    using namespace cfg;
    const int lane = ltid() & 63, gw = lbid() * 8 + (ltid() >> 6), nw = gridDim.x * 8;
    float* hmeta = (float*)(P->ws + WS_HMETA); bf16_t* hb = (bf16_t*)(P->ws + WS_HB); float* ss0 = (float*)(P->ws + WS_SS);
    for (int row = gw; row < MROWS; row += nw) {
        const float* s = row < MMAIN ? P->in[I_X] + (size_t)row * DM : P->in[I_META] + (size_t)(row - MMAIN) * DM;
        float* d = row < MMAIN ? P->out + (size_t)row * DM : hmeta + (size_t)(row - MMAIN) * DM;
        float sq = 0.f;
#pragma unroll
        for (int i = 0; i < 8; ++i) { f32x4 v = (f32x4){0.f, 0.f, 0.f, 0.f}; if (row < MMAIN + NMETA) v = *(const f32x4*)(s + i * 256 + lane * 4);
            *(f32x4*)(d + i * 256 + lane * 4) = v; sq += (v[0] * v[0] + v[1] * v[1]) + (v[2] * v[2] + v[3] * v[3]);
            u32x2 w; w.x = pk_bf16(v[0], v[1]); w.y = pk_bf16(v[2], v[3]); *(u32x2*)(hb + (size_t)row * DM + i * 256 + lane * 4) = w; }
        sq = wave_sum(sq);
        if (lane < 8) ss0[(size_t)lane * MROWS + row] = lane == 0 ? sq : 0.f;
    }
}
__device__ __forceinline__ void phase_foxnorm(PP P) {
    using namespace cfg;
    const int lane = ltid() & 63, gw = lbid() * 8 + (ltid() >> 6), nw = gridDim.x * 8;
    bf16_t* y = (bf16_t*)(P->ws + WS_Y);
    for (int row = gw; row < MMAIN + NMETA; row += nw) {
        bf16_t* p = y + (size_t)row * DM + 1024 + lane * 16;
        u32x4 a = *(const u32x4*)p, b = *(const u32x4*)(p + 8); float v[16];
#pragma unroll
        for (int i = 0; i < 4; ++i) { v[2 * i] = __uint_as_float(a[i] << 16); v[2 * i + 1] = __uint_as_float(a[i] & 0xffff0000u); v[8 + 2 * i] = __uint_as_float(b[i] << 16); v[8 + 2 * i + 1] = __uint_as_float(b[i] & 0xffff0000u); }
        float sq = 0.f;
#pragma unroll
        for (int i = 0; i < 16; ++i) sq += v[i] * v[i];
        sq = wave_sum(sq); const float rs = __builtin_amdgcn_rsqf(sq * (1.0f / 1024.0f) + NORM_EPS);
#pragma unroll
        for (int i = 0; i < 4; ++i) { a[i] = pk_bf16(v[2 * i] * rs, v[2 * i + 1] * rs); b[i] = pk_bf16(v[8 + 2 * i] * rs, v[8 + 2 * i + 1] * rs); }
        *(u32x4*)p = a; *(u32x4*)(p + 8) = b;
    }
}
__device__ __forceinline__ void phase_final(PP P) {
    using namespace cfg;
    const int lane = ltid() & 63, gw = lbid() * 8 + (ltid() >> 6), nw = gridDim.x * 8;
    const float* g = P->in[I_FINN];
    for (int row = gw; row < MMAIN; row += nw) {
        float* d = P->out + (size_t)row * DM; f32x4 v[8]; float sq = 0.f;
#pragma unroll
        for (int i = 0; i < 8; ++i) { v[i] = *(const f32x4*)(d + i * 256 + lane * 4); sq += (v[i][0] * v[i][0] + v[i][1] * v[i][1]) + (v[i][2] * v[i][2] + v[i][3] * v[i][3]); }
        sq = wave_sum(sq); const float rs = __builtin_amdgcn_rsqf(sq * (1.0f / 2048.0f) + NORM_EPS);
#pragma unroll
        for (int i = 0; i < 8; ++i) { const f32x4 gv = *(const f32x4*)(g + i * 256 + lane * 4); *(f32x4*)(d + i * 256 + lane * 4) = v[i] * rs * gv; }
    }
}

__device__ __forceinline__ void rwkv_simple(PP P, int l, int b, int h, LAS unsigned char* lds) {
    using namespace cfg;
    const int tid = ltid(), lane = tid & 63, wave = tid >> 6;
    LAS bf16_t* WUP = (LAS bf16_t*)lds; LAS bf16_t* AUP = WUP + 4096; LAS bf16_t* GUP = AUP + 4096;
    LAS float* RAW = (LAS float*)(lds + 36864); LAS float* LX = RAW + 17 * 480; LAS float* Rm = LX + 16 * 288;
    LAS float* Wm = Rm + 1024; LAS float* KPm = Wm + 1024; LAS float* Vm = KPm + 1024; LAS float* Am = Vm + 1024; LAS float* Bm = Am + 1024; LAS float* Gm = Bm + 1024;
    LAS float* BON = Gm + 1024; LAS float* YR = BON + 16;
    const bf16_t* PR = (const bf16_t*)(P->ws + WS_PR); const float* PS = (const float*)(P->ws + WS_PS); bf16_t* Y = (bf16_t*)(P->ws + WS_Y);
    const float* mu = P->in[I_MU] + l * RWKV_COLS;
    for (int e = tid; e < 64 * 64; e += 512) { const int i = e >> 6, j = e & 63;
        WUP[e] = (bf16_t)(pk_bf16(P->in[I_WUP][((size_t)l * 64 + i) * RW + h * 64 + j], 0.f) & 0xffffu);
        AUP[e] = (bf16_t)(pk_bf16(P->in[I_AUP][((size_t)l * 64 + i) * RW + h * 64 + j], 0.f) & 0xffffu); }
    for (int e = tid; e < 160 * 64; e += 512) { const int i = e >> 6, j = e & 63; GUP[e] = (bf16_t)(pk_bf16(P->in[I_GUP][((size_t)l * 160 + i) * RW + h * 64 + j], 0.f) & 0xffffu); }
    for (int e = tid; e < 480; e += 512) RAW[e] = 0.f;
    const int hj = h * 64 + lane;
    const float w0 = P->in[I_W0][l * RW + hj], a0 = P->in[I_A0][l * RW + hj], kkw = P->in[I_KK][l * RW + hj], kaw = P->in[I_KA][l * RW + hj], rkw = P->in[I_RK][l * RW + hj];
    const float lnw = P->in[I_LNW][l * RW + hj], lnb = P->in[I_LNB][l * RW + hj];
    const float mur = mu[hj], muk = mu[1024 + hj], muv = mu[2048 + hj];
    float S[16];
#pragma unroll
    for (int j = 0; j < 16; ++j) S[j] = 0.f;
    __syncthreads();
    for (int c = 0; c < 257; ++c) {
        const int row0 = (c == 0) ? MMAIN : b * SEQ + (c - 1) * 16;
        for (int e = tid; e < 16 * 480; e += 512) { const int t = e / 480, cc = e - t * 480; const int row = row0 + t; float v;
            if (cc < 192) v = bf2f(PR[(size_t)row * PRW + (cc >> 6) * 1024 + h * 64 + (cc & 63)]); else v = PS[(size_t)row * PSW + (cc - 192)];
            RAW[(t + 1) * 480 + cc] = v; }
        __syncthreads();
        for (int e = tid; e < 16 * 288; e += 512) { const int t = e / 288, i = e - t * 288; const float cur = RAW[(t + 1) * 480 + 192 + i], prv = RAW[t * 480 + 192 + i];
            const float x = cur + (prv - cur) * mu[3072 + i];
            LX[e] = i < 64 ? tanhf(x) : (i < 128 ? x : sigmoid_f(x)); }
        __syncthreads();
#pragma unroll 1
        for (int rep = 0; rep < 2; ++rep) { const int t = wave + 8 * rep;
            float aw = w0, aa = a0, ag = 0.f;
            for (int i = 0; i < 64; ++i) { aw += LX[t * 288 + i] * bf2f(WUP[i * 64 + lane]); aa += LX[t * 288 + 64 + i] * bf2f(AUP[i * 64 + lane]); }
            for (int i = 0; i < 160; ++i) ag += LX[t * 288 + 128 + i] * bf2f(GUP[i * 64 + lane]);
            const float sp = (aw < 0.f ? -aw : 0.f) + log1pf(__expf(-fabsf(aw)));
            const float dec = __expf(-__expf(-sp - 0.5f));
            const float alr = sigmoid_f(aa);
            const float rc = RAW[(t + 1) * 480 + lane], rp = RAW[t * 480 + lane]; const float r = rc + (rp - rc) * mur;
            const float kc = RAW[(t + 1) * 480 + 64 + lane], kp = RAW[t * 480 + 64 + lane]; const float k = kc + (kp - kc) * muk;
            const float vc = RAW[(t + 1) * 480 + 128 + lane], vp = RAW[t * 480 + 128 + lane]; const float v = vc + (vp - vc) * muv;
            const float kkr = k * kkw; const float nrm = sqrtf(wave_sum(kkr * kkr)); const float kk = kkr / fmaxf(nrm, 1e-12f);
            const float kmod = k * (1.0f + (alr - 1.0f) * kaw);
            const float bon = wave_sum(r * kmod * rkw);
            Rm[t * 64 + lane] = r; Wm[t * 64 + lane] = dec; KPm[t * 64 + lane] = kmod; Vm[t * 64 + lane] = v; Am[t * 64 + lane] = -kk; Bm[t * 64 + lane] = kk * alr; Gm[t * 64 + lane] = ag;
            if (lane == 0) BON[t] = bon; }
        __syncthreads();
        for (int e = tid; e < 480; e += 512) RAW[e] = RAW[16 * 480 + e];
        if (wave < 4) { const int vrow = 16 * wave + (lane & 15), q = lane >> 4;
#pragma unroll 1
            for (int t = 0; t < 16; ++t) { float a[16], w[16], bb[16], kk[16], rr[16];
#pragma unroll
                for (int g = 0; g < 4; ++g) { const f32x4 av = *(const LAS f32x4*)(Am + t * 64 + 16 * q + 4 * g), wv = *(const LAS f32x4*)(Wm + t * 64 + 16 * q + 4 * g), bv = *(const LAS f32x4*)(Bm + t * 64 + 16 * q + 4 * g),
                        kv = *(const LAS f32x4*)(KPm + t * 64 + 16 * q + 4 * g), rv = *(const LAS f32x4*)(Rm + t * 64 + 16 * q + 4 * g);
#pragma unroll
                    for (int i = 0; i < 4; ++i) { a[4 * g + i] = av[i]; w[4 * g + i] = wv[i]; bb[4 * g + i] = bv[i]; kk[4 * g + i] = kv[i]; rr[4 * g + i] = rv[i]; } }
                float sa = 0.f;
#pragma unroll
                for (int j = 0; j < 16; ++j) sa += S[j] * a[j];
                sa += __shfl_xor(sa, 16); sa += __shfl_xor(sa, 32);
                const float vv = Vm[t * 64 + vrow]; float y = 0.f;
#pragma unroll
                for (int j = 0; j < 16; ++j) { S[j] = S[j] * w[j] + (sa * bb[j] + vv * kk[j]); y += S[j] * rr[j]; }
                y += __shfl_xor(y, 16); y += __shfl_xor(y, 32);
                if (q == 0) YR[t * 64 + vrow] = y; } }
        __syncthreads();
        if (c > 0 || b == 0) {
#pragma unroll 1
            for (int rep = 0; rep < 2; ++rep) { const int t = wave + 8 * rep; const float yv = YR[t * 64 + lane];
                const float mean = wave_sum(yv) * (1.0f / 64.0f); const float d = yv - mean; const float var = wave_sum(d * d) * (1.0f / 64.0f);
                const float yn = d * __builtin_amdgcn_rsqf(var + LNX_EPS) * lnw + lnb;
                const float o = (yn + BON[t] * Vm[t * 64 + lane]) * Gm[t * 64 + lane];
                Y[(size_t)(row0 + t) * DM + hj] = (bf16_t)(pk_bf16(o, 0.f) & 0xffffu); } }
        __syncthreads();
    }
}

namespace fox {
constexpr int D = 128, NW = 8, QBLK = 32, KVBLK = 64, QB = NW * QBLK;
constexpr int LDQ = cfg::QKVW, LDK = cfg::QKVW, LDO = cfg::DM;
constexpr float SCALE = 0.08838834764831845f, THR = 8.f;
constexpr bool WSKIP = false;
constexpr int SHM_V = KVBLK * D * 2, SHM_K = KVBLK * D * 2;
constexpr int ATT_LDS = 2 * SHM_V + 2 * SHM_K + NW * 64 * 4;
constexpr int BIAS_OFF = ATT_LDS;
constexpr int SCAN_OFF = BIAS_OFF + cfg::SEQP * 4;

using bf16 = __hip_bfloat16;
typedef short bf16x8 __attribute__((ext_vector_type(8)));
typedef short s16x4 __attribute__((ext_vector_type(4)));
typedef float f32x16 __attribute__((ext_vector_type(16)));
typedef float f32x4 __attribute__((ext_vector_type(4)));
typedef unsigned u32x4 __attribute__((ext_vector_type(4)));
template <class A, class Bt> struct same_t { static constexpr bool v = false; };
template <class A> struct same_t<A, A> { static constexpr bool v = true; };

#define KSWZ(row, colB) ((row) * 256 + ((colB) ^ (((row) & 7) << 4)))
#define SBAR() __builtin_amdgcn_sched_barrier(0)
__device__ __forceinline__ int v_st(int k, int c) { const int kk = (k & ~0xC) | ((k & 4) << 1) | ((k & 8) >> 1); return ((kk >> 3) * 4 + (c >> 5)) * 512 + ((kk & 7) * 32 + (c & 31)) * 2; }
__device__ __forceinline__ int v_rd_base(int lane) { return ((lane & 3) << 3) | (((lane >> 2) & 3) << 6) | (((lane >> 4) & 1) << 5) | (((lane >> 5) & 1) << 8); }
constexpr int v_rd_off(int d0, int ks, int half) { return d0 * 512 + ks * 4096 + half * 2048; }
__device__ __forceinline__ int crow(int r, int hi) { return (r & 3) + 8 * (r >> 2) + 4 * hi; }
__device__ __forceinline__ unsigned cvtpk(float lo, float hi) {
    unsigned r; asm volatile("v_cvt_pk_bf16_f32 %0, %1, %2" : "=v"(r) : "v"(lo), "v"(hi)); return r;
}
__device__ __forceinline__ bf16x8 pack8(f32x4 a, f32x4 b) {
    u32x4 w = {cvtpk(a[0], a[1]), cvtpk(a[2], a[3]), cvtpk(b[0], b[1]), cvtpk(b[2], b[3])};
    return *reinterpret_cast<bf16x8*>(&w);
}
template <class T> __device__ __forceinline__ bf16x8 load8(const T* p) {
    if constexpr (same_t<T, float>::v) { return pack8(*(const f32x4*)p, *(const f32x4*)(p + 4)); }
    else { return *reinterpret_cast<const bf16x8*>(p); }
}
__device__ __forceinline__ void mask_tile(f32x16& p0, f32x16& p1, int dq, unsigned W) {
    const float NEG = -__builtin_inff();
#pragma unroll
    for (int r = 0; r < 16; ++r) {
        const int c = (r & 3) + 8 * (r >> 2);
        if ((unsigned)(dq - c) >= W) p0[r] = NEG;
        if ((unsigned)(dq - c - 32) >= W) p1[r] = NEG;
    }
}
__device__ __forceinline__ void partialSM(f32x16& p0, f32x16& p1, float& m_reg, float& mn, float& alpha) {
    float pmax = p0[0]; for (int r = 1; r < 16; ++r) pmax = fmaxf(pmax, p0[r]); for (int r = 0; r < 16; ++r) pmax = fmaxf(pmax, p1[r]);
    { auto rr = __builtin_amdgcn_permlane32_swap(__float_as_uint(pmax), __float_as_uint(pmax), false, false);
      pmax = fmaxf(__uint_as_float(rr[0]), __uint_as_float(rr[1])); }
    constexpr float C2 = 1.4426950408889634f * SCALE;
    if (__builtin_expect(__all((pmax - m_reg) * SCALE <= THR), 1)) { mn = m_reg; alpha = 1.f; }
    else { mn = fmaxf(m_reg, pmax); alpha = __builtin_amdgcn_exp2f((m_reg - mn) * C2); m_reg = mn; }
    const float mnL = -mn * C2;
    for (int r = 0; r < 16; ++r) p0[r] = fmaf(p0[r], C2, mnL); for (int r = 0; r < 16; ++r) p1[r] = fmaf(p1[r], C2, mnL);
    for (int r = 0; r < 16; ++r) p0[r] = __builtin_amdgcn_exp2f(p0[r]);
}
__device__ __forceinline__ void finishSM(f32x16& p0, f32x16& p1, float alpha, float& l_reg, bf16x8& pa0, bf16x8& pa1, bf16x8& pa2, bf16x8& pa3) {
    for (int r = 0; r < 16; ++r) p1[r] = __builtin_amdgcn_exp2f(p1[r]);
    float ps = 0; for (int r = 0; r < 16; ++r) ps += p0[r]; for (int r = 0; r < 16; ++r) ps += p1[r];
    { auto rr = __builtin_amdgcn_permlane32_swap(__float_as_uint(ps), __float_as_uint(ps), false, false);
      ps = __uint_as_float(rr[0]) + __uint_as_float(rr[1]); }
    l_reg = l_reg * alpha + ps;
#define PK4(P, B_, OUT) do { unsigned a0 = cvtpk(P[B_+0], P[B_+1]), a1 = cvtpk(P[B_+2], P[B_+3]);                          \
        unsigned b0 = cvtpk(P[B_+4], P[B_+5]), b1 = cvtpk(P[B_+6], P[B_+7]);                                             \
        auto r0 = __builtin_amdgcn_permlane32_swap(a0, b0, false, false); auto r1 = __builtin_amdgcn_permlane32_swap(a1, b1, false, false); \
        u32x4 w = {r0[0], r1[0], r0[1], r1[1]}; OUT = *reinterpret_cast<bf16x8*>(&w); } while (0)
    PK4(p0, 0, pa0); PK4(p0, 8, pa1); PK4(p1, 0, pa2); PK4(p1, 8, pa3);
#undef PK4
}
template <int KB, bool SK>
__device__ __forceinline__ void qkt(f32x16& p0, f32x16& p1, const char* K_lds, int r32, int hi, const bf16x8* qr, bool act, const float* bias_t) {
    if (SK && !act) { const float NEG = -__builtin_inff();
#pragma unroll
        for (int r = 0; r < 16; ++r) { p0[r] = NEG; p1[r] = NEG; } return; }
    {
#pragma unroll
        for (int g_ = 0; g_ < 4; ++g_) { const f32x4 b0_ = *(const f32x4*)(bias_t + 8 * g_ + 4 * hi); const f32x4 b1_ = *(const f32x4*)(bias_t + 32 + 8 * g_ + 4 * hi);
            p0[4 * g_] = b0_[0]; p0[4 * g_ + 1] = b0_[1]; p0[4 * g_ + 2] = b0_[2]; p0[4 * g_ + 3] = b0_[3];
            p1[4 * g_] = b1_[0]; p1[4 * g_ + 1] = b1_[1]; p1[4 * g_ + 2] = b1_[2]; p1[4 * g_ + 3] = b1_[3]; } }
    const char* kb[4];
#pragma unroll
    for (int dd = 0; dd < 4; ++dd) kb[dd] = K_lds + KB * SHM_K + KSWZ(r32, (dd * 16 + hi * 8) * 2);
#pragma unroll
    for (int d0 = 0; d0 < 8; ++d0) { const char* a = kb[d0 & 3] + (d0 >> 2) * 128;
        bf16x8 b0 = *reinterpret_cast<const bf16x8*>(a);
        bf16x8 b1 = *reinterpret_cast<const bf16x8*>(a + 32 * 256);
        p0 = __builtin_amdgcn_mfma_f32_32x32x16_bf16(b0, qr[d0], p0, 0, 0, 0);
        p1 = __builtin_amdgcn_mfma_f32_32x32x16_bf16(b1, qr[d0], p1, 0, 0, 0); }
}
template <int VB, bool SK>
__device__ __forceinline__ void pv_tile(f32x16* o, int vb0, bf16x8 pa0, bf16x8 pa1, bf16x8 pa2, bf16x8 pa3, bool act) {
    if (SK && !act) return;
#define TRRD(dst, off) asm volatile("ds_read_b64_tr_b16 %0, %1 offset:%2" : "=&v"(dst) : "v"(vb0), "i"(off) : "memory")
#define PV_D0(d0) do { s16x4 l0, l1, l2, l3, h0, h1, h2, h3; constexpr int b_ = VB * SHM_V + v_rd_off(d0, 0, 0);     \
        TRRD(l0, b_); TRRD(h0, b_ + 2048); TRRD(l1, b_ + 4096); TRRD(h1, b_ + 6144); TRRD(l2, b_ + 8192); TRRD(h2, b_ + 10240); TRRD(l3, b_ + 12288); TRRD(h3, b_ + 14336); \
        asm volatile("s_waitcnt lgkmcnt(0)" ::: "memory"); SBAR();                 \
        o[d0] = __builtin_amdgcn_mfma_f32_32x32x16_bf16(pa0, (bf16x8){l0[0], l0[1], l0[2], l0[3], h0[0], h0[1], h0[2], h0[3]}, o[d0], 0, 0, 0);   \
        o[d0] = __builtin_amdgcn_mfma_f32_32x32x16_bf16(pa1, (bf16x8){l1[0], l1[1], l1[2], l1[3], h1[0], h1[1], h1[2], h1[3]}, o[d0], 0, 0, 0);   \
        o[d0] = __builtin_amdgcn_mfma_f32_32x32x16_bf16(pa2, (bf16x8){l2[0], l2[1], l2[2], l2[3], h2[0], h2[1], h2[2], h2[3]}, o[d0], 0, 0, 0);   \
        o[d0] = __builtin_amdgcn_mfma_f32_32x32x16_bf16(pa3, (bf16x8){l3[0], l3[1], l3[2], l3[3], h3[0], h3[1], h3[2], h3[3]}, o[d0], 0, 0, 0); } while (0)
    PV_D0(0); PV_D0(1); PV_D0(2); PV_D0(3);
#undef PV_D0
#undef TRRD
}

template <class TIn, class TOut> struct BlockRef { const TIn* Q; const TIn* K; const TIn* V; TOut* O; int P0; };
template <class TIn> struct Seam {
    bf16x8 qr[8];
    bf16x8 st_v0, st_v1, st_k0, st_k1; f32x4 sf0, sf1, sf2, sf3;
    f32x4 tq[16];
};
__device__ __forceinline__ int swa_jlo(int P0, int W) { const int lowk = P0 - W + 1; return lowk > 0 ? lowk / KVBLK : 0; }
#define ROW(p, k0, rr) ((p) + (size_t)((k0) + (rr)) * LDK + sc)
#define VMW() asm volatile("s_waitcnt vmcnt(0)" ::: "memory")
#define VMWN(n) asm volatile("s_waitcnt vmcnt(%0)" :: "i"(n) : "memory")
#define SLOAD_H(Kp, Vp, k0) do { S.st_v0 = load8<TIn>(ROW(Vp, k0, sr)); S.st_v1 = load8<TIn>(ROW(Vp, k0, 32 + sr));              \
                         S.st_k0 = load8<TIn>(ROW(Kp, k0, sr)); S.st_k1 = load8<TIn>(ROW(Kp, k0, 32 + sr)); } while (0)
#define SWRITE_HK(bf) do { *(bf16x8*)(K_lds + (bf) * SHM_K + kws) = S.st_k0; *(bf16x8*)(K_lds + (bf) * SHM_K + kws + 32 * 256) = S.st_k1; } while (0)
#define SWRITE_HV(bf) do { *(bf16x8*)(V_lds + (bf) * SHM_V + vst0) = S.st_v0; *(bf16x8*)(V_lds + (bf) * SHM_V + vst1) = S.st_v1; } while (0)
#define SWRITE_H(bf) do { SWRITE_HV(bf); SWRITE_HK(bf); } while (0)
#define SLOAD_F(p, k0) do { S.sf0 = *(const f32x4*)ROW(p, k0, sr); S.sf1 = *(const f32x4*)(ROW(p, k0, sr) + 4);                \
                            S.sf2 = *(const f32x4*)ROW(p, k0, 32 + sr); S.sf3 = *(const f32x4*)(ROW(p, k0, 32 + sr) + 4); } while (0)
#define SWRITE_KF(bf) do { *(bf16x8*)(K_lds + (bf) * SHM_K + kws) = pack8(S.sf0, S.sf1); *(bf16x8*)(K_lds + (bf) * SHM_K + kws + 32 * 256) = pack8(S.sf2, S.sf3); } while (0)
#define SWRITE_VF(bf) do { *(bf16x8*)(V_lds + (bf) * SHM_V + vst0) = pack8(S.sf0, S.sf1); *(bf16x8*)(V_lds + (bf) * SHM_V + vst1) = pack8(S.sf2, S.sf3); } while (0)
template <class TIn, class TOut>
__device__ __forceinline__ void causal_swa_prime(const BlockRef<TIn, TOut>& cur, int W, char* lds, Seam<TIn>& S) {
    constexpr bool F32 = same_t<TIn, float>::v;
    const int tid = ltid(), wid = __builtin_amdgcn_readfirstlane(tid >> 6), lane = tid & 63, r32 = lane & 31, hi = lane >> 5;
    const int sr = tid >> 4, sc = (tid & 15) * 8, kws = KSWZ(sr, sc * 2); char* K_lds = lds + 2 * SHM_V;
    const int kb0 = swa_jlo(cur.P0, W) * KVBLK;
    for (int d0 = 0; d0 < 8; ++d0) S.qr[d0] = load8<TIn>(cur.Q + (size_t)(wid * QBLK + r32) * LDQ + d0 * 16 + hi * 8);
    if constexpr (F32) { SLOAD_F((const float*)cur.K, kb0); VMW(); SWRITE_KF(0); SBAR(); SLOAD_F((const float*)cur.V, kb0); }
    else { SLOAD_H(cur.K, cur.V, kb0); VMW(); SWRITE_HK(0); }
    __syncthreads();
}
template <class TIn, class TOut>
__device__ __forceinline__ void causal_swa_block(const BlockRef<TIn, TOut>& cur, const BlockRef<TIn, TOut>& nxt, int skv, int W, char* lds, Seam<TIn>& S, const float* bias_l) {
    constexpr bool F32 = same_t<TIn, float>::v;
    const int tid = ltid(), wid = __builtin_amdgcn_readfirstlane(tid >> 6), lane = tid & 63, r32 = lane & 31, hi = lane >> 5;
    const int j_lo = swa_jlo(cur.P0, W);
    int j_hi = (cur.P0 + QB - 1) / KVBLK + 1; if (j_hi > skv / KVBLK) j_hi = skv / KVBLK;
    const int NT = j_hi - j_lo;
    const int kbn = swa_jlo(nxt.P0, W) * KVBLK;
    const int qlo = cur.P0 + wid * QBLK, qm = qlo + r32 - 4 * hi;
    char* V_lds = lds; char* K_lds = lds + 2 * SHM_V;
    float* ws = (float*)(lds + 2 * SHM_V + 2 * SHM_K) + wid * 64; float* li_l = ws, * al_l = ws + 32;
    float m_reg = -1e30f, l_reg = 0; f32x16 o[4] = {};
    const int sr = tid >> 4, sc = (tid & 15) * 8, vst0 = v_st(sr, sc), vst1 = v_st(32 + sr, sc), kws = KSWZ(sr, sc * 2);
    const int vb0 = (int)(uintptr_t)V_lds + v_rd_base(lane);
    const TIn* Kh = cur.K; const TIn* Vh = cur.V;
#define RESC(a) do { if (__any((a) < 1.f)) { if (hi == 0) al_l[r32] = (a); asm volatile("s_waitcnt lgkmcnt(0)" ::: "memory");              \
                     for (int d_ = 0; d_ < 4; ++d_) for (int r = 0; r < 16; ++r) o[d_][r] *= al_l[crow(r, hi)]; } } while (0)
#define KBASE(t) ((j_lo + (t)) * KVBLK)
#define ACT(t) (KBASE(t) <= qlo + QBLK - 1 && KBASE(t) + KVBLK - 1 >= qlo - W + 1)
#define MASKT(P0_, P1_, t) do { const int kb_ = KBASE(t); if ((!SK || ACT(t)) && (kb_ + KVBLK - 1 > qlo || kb_ <= qlo + QBLK - 1 - W)) mask_tile(P0_, P1_, qm - kb_, (unsigned)W); } while (0)
    constexpr int NQL = F32 ? 16 : 8;
    constexpr bool SK = WSKIP && !F32;
#define SEAM_K0() do { VMWN(NQL); if constexpr (F32) { SWRITE_KF(0); SBAR(); SLOAD_F((const float*)nxt.V, kbn); } else { SWRITE_HK(0); } SBAR(); } while (0)
    f32x16 pA0, pA1, pB0, pB1; float mnA, mnB, alA, alB; bf16x8 pa0, pa1, pa2, pa3;
    if constexpr (F32) { VMW(); SWRITE_VF(0); SBAR(); } else { SWRITE_HV(0); SBAR(); }
    if (NT > 1) { if constexpr (F32) SLOAD_F((const float*)Kh, KBASE(1)); else SLOAD_H(Kh, Vh, KBASE(1)); }
    SBAR(); qkt<0, SK>(pA0, pA1, K_lds, r32, hi, S.qr, ACT(0), bias_l + KBASE(0));
    if constexpr (F32) { if (NT > 1) { VMW(); SWRITE_KF(1); SBAR(); SLOAD_F((const float*)Vh, KBASE(1)); } }
    MASKT(pA0, pA1, 0); partialSM(pA0, pA1, m_reg, mnA, alA);
    if (NT > 1) { VMW(); if constexpr (F32) { SWRITE_VF(1); SBAR(); if (NT > 2) SLOAD_F((const float*)Kh, KBASE(2)); } else SWRITE_H(1); }
    __syncthreads();
#define HALF_STEP(PX0, PX1, mnX, alX, PY0, PY1, alY, t, KB, VB, SB) do {                                                      \
        SBAR(); qkt<KB, SK>(PX0, PX1, K_lds, r32, hi, S.qr, ACT(t), bias_l + KBASE(t));                                             \
        finishSM(PY0, PY1, alY, l_reg, pa0, pa1, pa2, pa3); SBAR();                                                           \
        if ((t) + 1 < NT) { if constexpr (F32) { VMW(); SWRITE_KF(SB); SBAR(); SLOAD_F((const float*)Vh, KBASE((t) + 1)); }  \
                            else { SLOAD_H(Kh, Vh, KBASE((t) + 1)); } SBAR(); }                                               \
        pv_tile<VB, SK>(o, vb0, pa0, pa1, pa2, pa3, ACT((t) - 1)); MASKT(PX0, PX1, (t)); partialSM(PX0, PX1, m_reg, mnX, alX);                                        \
        __syncthreads();                                                                                                      \
        if ((t) + 1 < NT) { VMW(); if constexpr (F32) { SWRITE_VF(SB); SBAR(); if ((t) + 2 < NT) SLOAD_F((const float*)Kh, KBASE((t) + 2)); } \
                            else { SWRITE_H(SB); } }                                                                          \
        RESC(alX); __syncthreads(); } while (0)
    for (int t = 1; t + 1 < NT; t += 2) {
        HALF_STEP(pB0, pB1, mnB, alB, pA0, pA1, alA, t, 1, 0, 0);
        HALF_STEP(pA0, pA1, mnA, alA, pB0, pB1, alB, t + 1, 0, 1, 1);
    }
    const bool even = (NT & 1) == 0;
    if (even) { SBAR(); qkt<1, SK>(pB0, pB1, K_lds, r32, hi, S.qr, ACT(NT - 1), bias_l + KBASE(NT - 1)); SBAR(); }
#define QROW(e) (nxt.Q + (size_t)(wid * QBLK + r32) * LDQ + ((e) >> 1) * 16 + hi * 8 + ((e) & 1) * 4)
    if constexpr (F32) { SLOAD_F((const float*)nxt.K, kbn); SBAR();
#pragma unroll
        for (int e = 0; e < 8; ++e) S.tq[e] = *(const f32x4*)QROW(e); }
    else { SLOAD_H(nxt.K, nxt.V, kbn); SBAR();
#pragma unroll
        for (int d0 = 0; d0 < 8; ++d0) S.qr[d0] = load8<TIn>(nxt.Q + (size_t)(wid * QBLK + r32) * LDQ + d0 * 16 + hi * 8); }
    SBAR();
    finishSM(pA0, pA1, alA, l_reg, pa0, pa1, pa2, pa3); SBAR();
    if constexpr (F32) {
#pragma unroll
        for (int e = 8; e < 16; ++e) S.tq[e] = *(const f32x4*)QROW(e); SBAR(); }
#undef QROW
    pv_tile<0, SK>(o, vb0, pa0, pa1, pa2, pa3, ACT(even ? NT - 2 : NT - 1));
    if (even) { MASKT(pB0, pB1, NT - 1); partialSM(pB0, pB1, m_reg, mnB, alB); __syncthreads(); RESC(alB);
        finishSM(pB0, pB1, alB, l_reg, pa0, pa1, pa2, pa3); SBAR(); pv_tile<1, SK>(o, vb0, pa0, pa1, pa2, pa3, ACT(NT - 1)); }
    SBAR(); SEAM_K0();
    if (hi == 0) li_l[r32] = l_reg; asm volatile("s_waitcnt lgkmcnt(0)" ::: "memory");
    float rli[16];
#pragma unroll
    for (int r = 0; r < 16; ++r) rli[r] = __builtin_amdgcn_rcpf(li_l[crow(r, hi)]);
    TOut* Ow = cur.O + (size_t)(wid * QBLK) * LDO;
#pragma unroll
    for (int r = 0; r < 16; ++r) { const int orow = crow(r, hi);
#pragma unroll
        for (int d0 = 0; d0 < 4; ++d0) { const float v = o[d0][r] * rli[r];
            if constexpr (same_t<TOut, float>::v) { Ow[(size_t)orow * LDO + d0 * 32 + r32] = v; }
            else { const float vn = __shfl_xor(v, 1);
                   if ((r32 & 1) == 0) *(unsigned*)(Ow + (size_t)orow * LDO + d0 * 32 + r32) = cvtpk(v, vn); } } }
    if constexpr (F32) {
#pragma unroll
        for (int d0 = 0; d0 < 8; ++d0) S.qr[d0] = pack8(S.tq[2 * d0], S.tq[2 * d0 + 1]); }
    __syncthreads();
#undef RESC
#undef KBASE
#undef ACT
#undef MASKT
#undef SEAM_K0
#undef HALF_STEP
}
#undef ROW
#undef VMW
#undef VMWN
#undef SLOAD_H
#undef SWRITE_HK
#undef SWRITE_HV
#undef SWRITE_H
#undef SLOAD_F
#undef SWRITE_KF

}

__device__ __forceinline__ void fox_bias(PP P, int l, int b, int h, float* bias, float* scr) {
    using namespace cfg;
    const int tid = ltid(), lane = tid & 63, wave = tid >> 6;
    const float* PS = (const float*)(P->ws + WS_PS); const float bf = P->in[I_BF][l * FNH + h];
    float lf[9]; float loc = 0.f;
#pragma unroll
    for (int i = 0; i < 9; ++i) { const int pos = tid * 9 + i; float v = 0.f;
        if (pos < NMETA + SEQ) { const int row = pos < NMETA ? MMAIN + pos : b * SEQ + pos - NMETA; const float z = PS[(size_t)row * PSW + 288 + h] + bf;
            v = fminf(z, 0.f) - log1pf(__expf(-fabsf(z))); }
        loc += v; lf[i] = loc; }
    float inc = loc;
#pragma unroll
    for (int o = 1; o < 64; o <<= 1) { const float t = __shfl_up(inc, o); if (lane >= o) inc += t; }
    if (lane == 63) scr[wave] = inc;
    __syncthreads();
    float base = inc - loc;
    for (int w = 0; w < wave; ++w) base += scr[w];
    constexpr float INV = 1.0f / fox::SCALE;
#pragma unroll
    for (int i = 0; i < 9; ++i) { const int pos = tid * 9 + i; if (pos < NMETA + SEQ) bias[48 + pos] = -(base + lf[i]) * INV; }
    if (tid < 48) bias[tid] = -__builtin_inff();
    __syncthreads();
}
__device__ __forceinline__ void fox_meta(PP P, int h, const float* bias) {
    using namespace cfg;
    const int lane = ltid() & 63, wave = ltid() >> 6;
    const bf16_t* QKV = (const bf16_t*)(P->ws + WS_QKV); bf16_t* Y = (bf16_t*)(P->ws + WS_Y);
    for (int rep = 0; rep < 2; ++rep) { const int i = wave + 8 * rep;
        float s = -__builtin_inff();
        if (lane <= i) { const bf16_t* q = QKV + (size_t)(48 + i) * QKVW + h * 128; const bf16_t* k = QKV + (size_t)(48 + lane) * QKVW + 1024 + h * 128; float dot = 0.f;
            for (int d = 0; d < 128; ++d) dot += bf2f(q[d]) * bf2f(k[d]);
            s = (dot + bias[48 + lane]) * fox::SCALE; }
        const float m = wave_max(s); const float p = (lane <= i) ? __expf(s - m) : 0.f; const float lsum = wave_sum(p);
        float o0 = 0.f, o1 = 0.f;
        for (int j = 0; j <= i; ++j) { const float pj = __shfl(p, j); const bf16_t* v = QKV + (size_t)(48 + j) * QKVW + 2048 + h * 128; o0 += pj * bf2f(v[lane]); o1 += pj * bf2f(v[64 + lane]); }
        const float il = 1.0f / lsum;
        Y[(size_t)(MMAIN + i) * DM + 1024 + h * 128 + lane] = (bf16_t)(pk_bf16(o0 * il, 0.f) & 0xffffu);
        Y[(size_t)(MMAIN + i) * DM + 1024 + h * 128 + 64 + lane] = (bf16_t)(pk_bf16(o1 * il, 0.f) & 0xffffu); }
}
__device__ __forceinline__ fox::BlockRef<__hip_bfloat16, __hip_bfloat16> fox_mk(int a, int idx, const __hip_bfloat16* Qb, const __hip_bfloat16* Kb, const __hip_bfloat16* Vb, __hip_bfloat16* Ob) {
    const int pr = 4 * (a & 1) + (idx >> 1); const int x = (idx & 1) ? 15 - pr : pr;
    fox::BlockRef<__hip_bfloat16, __hip_bfloat16> r; r.Q = Qb + (size_t)x * 256 * cfg::QKVW; r.K = Kb; r.V = Vb; r.O = Ob + (size_t)x * 256 * cfg::DM; r.P0 = 64 + 256 * x; return r; }
__device__ __forceinline__ void fox_wg(PP P, int l, int a, char* lds) {
    using namespace cfg;
    typedef __hip_bfloat16 bf;
    const int bh = a >> 1, b = bh >> 3, h = bh & 7;
    float* bias = (float*)(lds + fox::BIAS_OFF); float* scr = (float*)(lds + fox::SCAN_OFF);
    fox_bias(P, l, b, h, bias, scr);
    const bf* QKV = (const bf*)(P->ws + WS_QKV); bf* Y = (bf*)(P->ws + WS_Y);
    const bf* Kb = QKV + (size_t)b * SEQP * QKVW + 1024 + h * 128; const bf* Vb = Kb + 1024; const bf* Qb = QKV + ((size_t)b * SEQP + 64) * QKVW + h * 128;
    bf* Ob = Y + (size_t)b * SEQ * DM + 1024 + h * 128;
    constexpr int W = 1 << 30;
    fox::Seam<bf> S;
    fox::BlockRef<bf, bf> cur = fox_mk(a, 0, Qb, Kb, Vb, Ob);
    fox::causal_swa_prime<bf, bf>(cur, W, lds, S);
#pragma unroll 1
    for (int idx = 0; idx < 8; ++idx) {
        const fox::BlockRef<bf, bf> nxt = (idx < 7) ? fox_mk(a, idx + 1, Qb, Kb, Vb, Ob) : cur;
        fox::causal_swa_block<bf, bf>(cur, nxt, SEQP, W, lds, S, bias);
        cur = nxt;
    }
    if (b == 0) fox_meta(P, h, bias);
}

#define WS_PTR(T, off) ((T*)(Q->ws + (off)))
#define SEAM() do { PP Qb_ = launder(P); XcdBarrier b_; b_.bar = (unsigned*)(Qb_->ws + WS_CTL); b_.x = xb_xcc_id(); b_.st = (volatile LAS unsigned*)(lds + LDS_BARW); xcd_barrier(b_); } while (0)
__global__ void __launch_bounds__(512, 2) hymba_fwd(Params Pv) {
    using namespace cfg;
    PP P = (PP)__builtin_amdgcn_kernarg_segment_ptr();
    extern __shared__ __attribute__((aligned(16))) unsigned char lds_raw[];
    LAS unsigned char* lds = (LAS unsigned char*)lds_raw;
    if (threadIdx.x < 4) ((LAS unsigned*)(lds + LDS_BARW))[threadIdx.x] = 0u;
    __syncthreads();
    { PP Q = launder(P); (void)xcd_barrier_post((unsigned*)(Q->ws + WS_CTL), (volatile LAS unsigned*)(lds + LDS_BARW)); }

    { PP Q = launder(P); phase_convert(Q, lds); phase_init(Q); }
    SEAM();
    {
        PP Q = launder(P); const unsigned char* wl = Q->ws + WS_W + (size_t)0 * W_LAYER;
        pg8::Gemm g{WS_PTR(const bf16_t, WS_HB), (const bf16_t*)(wl + WO_GU1), MROWS, NGU, DM}; pg8::StaticOrder S; S.init(MROWS, NGU, (int)gridDim.x, lbid());
        pg8::EpiGU E{WS_PTR(bf16_t, WS_ACT), WS_PTR(const float, WS_SS) + (size_t)(0) * 8 * MROWS};
        pg8::gemm_phase<pg8::EpiGU, pg8::StaticOrder, true, true>(lds, g, S, E);
    }
    SEAM();
    {
        PP Q = launder(P); const unsigned char* wl = Q->ws + WS_W + (size_t)0 * W_LAYER;
        pg8::Gemm g{WS_PTR(const bf16_t, WS_ACT), (const bf16_t*)(wl + WO_D1), MROWS, DM, DFF}; pg8::StaticOrder S; S.init(MROWS, DM, (int)gridDim.x, lbid());
        pg8::EpiRes E{Q->out, WS_PTR(float, WS_HMETA), WS_PTR(bf16_t, WS_HB), WS_PTR(float, WS_SS) + (size_t)(1) * 8 * MROWS, 0.5f, (LAS float*)(lds + 131072)};
        pg8::gemm_phase<pg8::EpiRes, pg8::StaticOrder, true, true>(lds, g, S, E);
    }
    SEAM();
    {
        PP Q = launder(P); const unsigned char* wl = Q->ws + WS_W + (size_t)0 * W_LAYER;
        pg8::Gemm g{WS_PTR(const bf16_t, WS_HB), (const bf16_t*)(wl + WO_IN), MROWS, NIN, DM}; pg8::StaticOrder S; S.init(MROWS, NIN, (int)gridDim.x, lbid());
        pg8::EpiP E{WS_PTR(bf16_t, WS_PR), WS_PTR(float, WS_PS), WS_PTR(bf16_t, WS_QKV), WS_PTR(const float, WS_SS) + (size_t)(1) * 8 * MROWS};
        pg8::gemm_phase<pg8::EpiP, pg8::StaticOrder, true, true>(lds, g, S, E);
    }
    SEAM();
    {
        PP Q = launder(P); const int u = lbid();
        if (u < 128) rwkv_simple(Q, 0, u >> 4, u & 15, lds);
        else fox_wg(Q, 0, u - 128, (char*)lds_raw);
    }
    SEAM();
    { PP Q = launder(P); phase_foxnorm(Q); }
    SEAM();
    {
        PP Q = launder(P); const unsigned char* wl = Q->ws + WS_W + (size_t)0 * W_LAYER;
        pg8::Gemm g{WS_PTR(const bf16_t, WS_Y), (const bf16_t*)(wl + WO_OUT), MROWS, DM, DM}; pg8::StaticOrder S; S.init(MROWS, DM, (int)gridDim.x, lbid());
        pg8::EpiRes E{Q->out, WS_PTR(float, WS_HMETA), WS_PTR(bf16_t, WS_HB), WS_PTR(float, WS_SS) + (size_t)(2) * 8 * MROWS, 1.0f, (LAS float*)(lds + 131072)};
        pg8::gemm_phase<pg8::EpiRes, pg8::StaticOrder, true, true>(lds, g, S, E);
    }
    SEAM();
    {
        PP Q = launder(P); const unsigned char* wl = Q->ws + WS_W + (size_t)0 * W_LAYER;
        pg8::Gemm g{WS_PTR(const bf16_t, WS_HB), (const bf16_t*)(wl + WO_GU2), MROWS, NGU, DM}; pg8::StaticOrder S; S.init(MROWS, NGU, (int)gridDim.x, lbid());
        pg8::EpiGU E{WS_PTR(bf16_t, WS_ACT), WS_PTR(const float, WS_SS) + (size_t)(2) * 8 * MROWS};
        pg8::gemm_phase<pg8::EpiGU, pg8::StaticOrder, true, true>(lds, g, S, E);
    }
    SEAM();
    {
        PP Q = launder(P); const unsigned char* wl = Q->ws + WS_W + (size_t)0 * W_LAYER;
        pg8::Gemm g{WS_PTR(const bf16_t, WS_ACT), (const bf16_t*)(wl + WO_D2), MROWS, DM, DFF}; pg8::StaticOrder S; S.init(MROWS, DM, (int)gridDim.x, lbid());
        pg8::EpiRes E{Q->out, WS_PTR(float, WS_HMETA), WS_PTR(bf16_t, WS_HB), WS_PTR(float, WS_SS) + (size_t)(3) * 8 * MROWS, 0.5f, (LAS float*)(lds + 131072)};
        pg8::gemm_phase<pg8::EpiRes, pg8::StaticOrder, true, true>(lds, g, S, E);
    }
    SEAM();
    {
        PP Q = launder(P); const unsigned char* wl = Q->ws + WS_W + (size_t)1 * W_LAYER;
        pg8::Gemm g{WS_PTR(const bf16_t, WS_HB), (const bf16_t*)(wl + WO_GU1), MROWS, NGU, DM}; pg8::StaticOrder S; S.init(MROWS, NGU, (int)gridDim.x, lbid());
        pg8::EpiGU E{WS_PTR(bf16_t, WS_ACT), WS_PTR(const float, WS_SS) + (size_t)(3) * 8 * MROWS};
        pg8::gemm_phase<pg8::EpiGU, pg8::StaticOrder, true, true>(lds, g, S, E);
    }
    SEAM();
    {
        PP Q = launder(P); const unsigned char* wl = Q->ws + WS_W + (size_t)1 * W_LAYER;
        pg8::Gemm g{WS_PTR(const bf16_t, WS_ACT), (const bf16_t*)(wl + WO_D1), MROWS, DM, DFF}; pg8::StaticOrder S; S.init(MROWS, DM, (int)gridDim.x, lbid());
        pg8::EpiRes E{Q->out, WS_PTR(float, WS_HMETA), WS_PTR(bf16_t, WS_HB), WS_PTR(float, WS_SS) + (size_t)(4) * 8 * MROWS, 0.5f, (LAS float*)(lds + 131072)};
        pg8::gemm_phase<pg8::EpiRes, pg8::StaticOrder, true, true>(lds, g, S, E);
    }
    SEAM();
    {
        PP Q = launder(P); const unsigned char* wl = Q->ws + WS_W + (size_t)1 * W_LAYER;
        pg8::Gemm g{WS_PTR(const bf16_t, WS_HB), (const bf16_t*)(wl + WO_IN), MROWS, NIN, DM}; pg8::StaticOrder S; S.init(MROWS, NIN, (int)gridDim.x, lbid());
        pg8::EpiP E{WS_PTR(bf16_t, WS_PR), WS_PTR(float, WS_PS), WS_PTR(bf16_t, WS_QKV), WS_PTR(const float, WS_SS) + (size_t)(4) * 8 * MROWS};
        pg8::gemm_phase<pg8::EpiP, pg8::StaticOrder, true, true>(lds, g, S, E);
    }
    SEAM();
    {
        PP Q = launder(P); const int u = lbid();
        if (u < 128) rwkv_simple(Q, 1, u >> 4, u & 15, lds);
        else fox_wg(Q, 1, u - 128, (char*)lds_raw);
    }
    SEAM();
    { PP Q = launder(P); phase_foxnorm(Q); }
    SEAM();
    {
        PP Q = launder(P); const unsigned char* wl = Q->ws + WS_W + (size_t)1 * W_LAYER;
        pg8::Gemm g{WS_PTR(const bf16_t, WS_Y), (const bf16_t*)(wl + WO_OUT), MROWS, DM, DM}; pg8::StaticOrder S; S.init(MROWS, DM, (int)gridDim.x, lbid());
        pg8::EpiRes E{Q->out, WS_PTR(float, WS_HMETA), WS_PTR(bf16_t, WS_HB), WS_PTR(float, WS_SS) + (size_t)(5) * 8 * MROWS, 1.0f, (LAS float*)(lds + 131072)};
        pg8::gemm_phase<pg8::EpiRes, pg8::StaticOrder, true, true>(lds, g, S, E);
    }
    SEAM();
    {
        PP Q = launder(P); const unsigned char* wl = Q->ws + WS_W + (size_t)1 * W_LAYER;
        pg8::Gemm g{WS_PTR(const bf16_t, WS_HB), (const bf16_t*)(wl + WO_GU2), MROWS, NGU, DM}; pg8::StaticOrder S; S.init(MROWS, NGU, (int)gridDim.x, lbid());
        pg8::EpiGU E{WS_PTR(bf16_t, WS_ACT), WS_PTR(const float, WS_SS) + (size_t)(5) * 8 * MROWS};
        pg8::gemm_phase<pg8::EpiGU, pg8::StaticOrder, true, true>(lds, g, S, E);
    }
    SEAM();
    {
        PP Q = launder(P); const unsigned char* wl = Q->ws + WS_W + (size_t)1 * W_LAYER;
        pg8::Gemm g{WS_PTR(const bf16_t, WS_ACT), (const bf16_t*)(wl + WO_D2), MROWS, DM, DFF}; pg8::StaticOrder S; S.init(MROWS, DM, (int)gridDim.x, lbid());
        pg8::EpiRes E{Q->out, WS_PTR(float, WS_HMETA), WS_PTR(bf16_t, WS_HB), WS_PTR(float, WS_SS) + (size_t)(6) * 8 * MROWS, 0.5f, (LAS float*)(lds + 131072)};
        pg8::gemm_phase<pg8::EpiRes, pg8::StaticOrder, true, true>(lds, g, S, E);
    }
    SEAM();
    {
        PP Q = launder(P); const unsigned char* wl = Q->ws + WS_W + (size_t)2 * W_LAYER;
        pg8::Gemm g{WS_PTR(const bf16_t, WS_HB), (const bf16_t*)(wl + WO_GU1), MROWS, NGU, DM}; pg8::StaticOrder S; S.init(MROWS, NGU, (int)gridDim.x, lbid());
        pg8::EpiGU E{WS_PTR(bf16_t, WS_ACT), WS_PTR(const float, WS_SS) + (size_t)(6) * 8 * MROWS};
        pg8::gemm_phase<pg8::EpiGU, pg8::StaticOrder, true, true>(lds, g, S, E);
    }
    SEAM();
    {
        PP Q = launder(P); const unsigned char* wl = Q->ws + WS_W + (size_t)2 * W_LAYER;
        pg8::Gemm g{WS_PTR(const bf16_t, WS_ACT), (const bf16_t*)(wl + WO_D1), MROWS, DM, DFF}; pg8::StaticOrder S; S.init(MROWS, DM, (int)gridDim.x, lbid());
        pg8::EpiRes E{Q->out, WS_PTR(float, WS_HMETA), WS_PTR(bf16_t, WS_HB), WS_PTR(float, WS_SS) + (size_t)(7) * 8 * MROWS, 0.5f, (LAS float*)(lds + 131072)};
        pg8::gemm_phase<pg8::EpiRes, pg8::StaticOrder, true, true>(lds, g, S, E);
    }
    SEAM();
    {
        PP Q = launder(P); const unsigned char* wl = Q->ws + WS_W + (size_t)2 * W_LAYER;
        pg8::Gemm g{WS_PTR(const bf16_t, WS_HB), (const bf16_t*)(wl + WO_IN), MROWS, NIN, DM}; pg8::StaticOrder S; S.init(MROWS, NIN, (int)gridDim.x, lbid());
        pg8::EpiP E{WS_PTR(bf16_t, WS_PR), WS_PTR(float, WS_PS), WS_PTR(bf16_t, WS_QKV), WS_PTR(const float, WS_SS) + (size_t)(7) * 8 * MROWS};
        pg8::gemm_phase<pg8::EpiP, pg8::StaticOrder, true, true>(lds, g, S, E);
    }
    SEAM();
    {
        PP Q = launder(P); const int u = lbid();
        if (u < 128) rwkv_simple(Q, 2, u >> 4, u & 15, lds);
        else fox_wg(Q, 2, u - 128, (char*)lds_raw);
    }
    SEAM();
    { PP Q = launder(P); phase_foxnorm(Q); }
    SEAM();
    {
        PP Q = launder(P); const unsigned char* wl = Q->ws + WS_W + (size_t)2 * W_LAYER;
        pg8::Gemm g{WS_PTR(const bf16_t, WS_Y), (const bf16_t*)(wl + WO_OUT), MROWS, DM, DM}; pg8::StaticOrder S; S.init(MROWS, DM, (int)gridDim.x, lbid());
        pg8::EpiRes E{Q->out, WS_PTR(float, WS_HMETA), WS_PTR(bf16_t, WS_HB), WS_PTR(float, WS_SS) + (size_t)(8) * 8 * MROWS, 1.0f, (LAS float*)(lds + 131072)};
        pg8::gemm_phase<pg8::EpiRes, pg8::StaticOrder, true, true>(lds, g, S, E);
    }
    SEAM();
    {
        PP Q = launder(P); const unsigned char* wl = Q->ws + WS_W + (size_t)2 * W_LAYER;
        pg8::Gemm g{WS_PTR(const bf16_t, WS_HB), (const bf16_t*)(wl + WO_GU2), MROWS, NGU, DM}; pg8::StaticOrder S; S.init(MROWS, NGU, (int)gridDim.x, lbid());
        pg8::EpiGU E{WS_PTR(bf16_t, WS_ACT), WS_PTR(const float, WS_SS) + (size_t)(8) * 8 * MROWS};
        pg8::gemm_phase<pg8::EpiGU, pg8::StaticOrder, true, true>(lds, g, S, E);
    }
    SEAM();
    {
        PP Q = launder(P); const unsigned char* wl = Q->ws + WS_W + (size_t)2 * W_LAYER;
        pg8::Gemm g{WS_PTR(const bf16_t, WS_ACT), (const bf16_t*)(wl + WO_D2), MROWS, DM, DFF}; pg8::StaticOrder S; S.init(MROWS, DM, (int)gridDim.x, lbid());
        pg8::EpiRes E{Q->out, WS_PTR(float, WS_HMETA), WS_PTR(bf16_t, WS_HB), WS_PTR(float, WS_SS) + (size_t)(9) * 8 * MROWS, 0.5f, (LAS float*)(lds + 131072)};
        pg8::gemm_phase<pg8::EpiRes, pg8::StaticOrder, true, true>(lds, g, S, E);
    }
    SEAM();
    {
        PP Q = launder(P); const unsigned char* wl = Q->ws + WS_W + (size_t)3 * W_LAYER;
        pg8::Gemm g{WS_PTR(const bf16_t, WS_HB), (const bf16_t*)(wl + WO_GU1), MROWS, NGU, DM}; pg8::StaticOrder S; S.init(MROWS, NGU, (int)gridDim.x, lbid());
        pg8::EpiGU E{WS_PTR(bf16_t, WS_ACT), WS_PTR(const float, WS_SS) + (size_t)(9) * 8 * MROWS};
        pg8::gemm_phase<pg8::EpiGU, pg8::StaticOrder, true, true>(lds, g, S, E);
    }
    SEAM();
    {
        PP Q = launder(P); const unsigned char* wl = Q->ws + WS_W + (size_t)3 * W_LAYER;
        pg8::Gemm g{WS_PTR(const bf16_t, WS_ACT), (const bf16_t*)(wl + WO_D1), MROWS, DM, DFF}; pg8::StaticOrder S; S.init(MROWS, DM, (int)gridDim.x, lbid());
        pg8::EpiRes E{Q->out, WS_PTR(float, WS_HMETA), WS_PTR(bf16_t, WS_HB), WS_PTR(float, WS_SS) + (size_t)(10) * 8 * MROWS, 0.5f, (LAS float*)(lds + 131072)};
        pg8::gemm_phase<pg8::EpiRes, pg8::StaticOrder, true, true>(lds, g, S, E);
    }
    SEAM();
    {
        PP Q = launder(P); const unsigned char* wl = Q->ws + WS_W + (size_t)3 * W_LAYER;
        pg8::Gemm g{WS_PTR(const bf16_t, WS_HB), (const bf16_t*)(wl + WO_IN), MROWS, NIN, DM}; pg8::StaticOrder S; S.init(MROWS, NIN, (int)gridDim.x, lbid());
        pg8::EpiP E{WS_PTR(bf16_t, WS_PR), WS_PTR(float, WS_PS), WS_PTR(bf16_t, WS_QKV), WS_PTR(const float, WS_SS) + (size_t)(10) * 8 * MROWS};
        pg8::gemm_phase<pg8::EpiP, pg8::StaticOrder, true, true>(lds, g, S, E);
    }
    SEAM();
    {
        PP Q = launder(P); const int u = lbid();
        if (u < 128) rwkv_simple(Q, 3, u >> 4, u & 15, lds);
        else fox_wg(Q, 3, u - 128, (char*)lds_raw);
    }
    SEAM();
    { PP Q = launder(P); phase_foxnorm(Q); }
    SEAM();
    {
        PP Q = launder(P); const unsigned char* wl = Q->ws + WS_W + (size_t)3 * W_LAYER;
        pg8::Gemm g{WS_PTR(const bf16_t, WS_Y), (const bf16_t*)(wl + WO_OUT), MROWS, DM, DM}; pg8::StaticOrder S; S.init(MROWS, DM, (int)gridDim.x, lbid());
        pg8::EpiRes E{Q->out, WS_PTR(float, WS_HMETA), WS_PTR(bf16_t, WS_HB), WS_PTR(float, WS_SS) + (size_t)(11) * 8 * MROWS, 1.0f, (LAS float*)(lds + 131072)};
        pg8::gemm_phase<pg8::EpiRes, pg8::StaticOrder, true, true>(lds, g, S, E);
    }
    SEAM();
    {
        PP Q = launder(P); const unsigned char* wl = Q->ws + WS_W + (size_t)3 * W_LAYER;
        pg8::Gemm g{WS_PTR(const bf16_t, WS_HB), (const bf16_t*)(wl + WO_GU2), MROWS, NGU, DM}; pg8::StaticOrder S; S.init(MROWS, NGU, (int)gridDim.x, lbid());
        pg8::EpiGU E{WS_PTR(bf16_t, WS_ACT), WS_PTR(const float, WS_SS) + (size_t)(11) * 8 * MROWS};
        pg8::gemm_phase<pg8::EpiGU, pg8::StaticOrder, true, true>(lds, g, S, E);
    }
    SEAM();
    {
        PP Q = launder(P); const unsigned char* wl = Q->ws + WS_W + (size_t)3 * W_LAYER;
        pg8::Gemm g{WS_PTR(const bf16_t, WS_ACT), (const bf16_t*)(wl + WO_D2), MROWS, DM, DFF}; pg8::StaticOrder S; S.init(MROWS, DM, (int)gridDim.x, lbid());
        pg8::EpiRes E{Q->out, WS_PTR(float, WS_HMETA), WS_PTR(bf16_t, WS_HB), WS_PTR(float, WS_SS) + (size_t)(12) * 8 * MROWS, 0.5f, (LAS float*)(lds + 131072)};
        pg8::gemm_phase<pg8::EpiRes, pg8::StaticOrder, true, true>(lds, g, S, E);
    }
    SEAM();
    { PP Q = launder(P); phase_final(Q); }
}

extern "C" void kernel_launch(void* const* d_in, const int* in_sizes, int n_in, void* d_out, int out_size, void* d_ws, size_t ws_size, hipStream_t stream) {
    using namespace cfg;
    static int grid = 0;
    if (grid == 0) {
        if (n_in != 25 || out_size != MMAIN * DM || ws_size < WS_END) { fprintf(stderr, "kernel_launch: need 25 inputs, out %d, ws >= %zu; got n_in %d out %d ws %zu\n", MMAIN * DM, (size_t)WS_END, n_in, out_size, ws_size); grid = -1; return; }
        int dev = 0, cus = 0, per_cu = 0;
        if (hipGetDevice(&dev) != hipSuccess || hipDeviceGetAttribute(&cus, hipDeviceAttributeMultiprocessorCount, dev) != hipSuccess) { grid = -1; return; }
        if (hipFuncSetAttribute((const void*)hymba_fwd, hipFuncAttributeMaxDynamicSharedMemorySize, LDS_BYTES) != hipSuccess) { fprintf(stderr, "kernel_launch: hipFuncSetAttribute failed\n"); grid = -1; return; }
        if (hipOccupancyMaxActiveBlocksPerMultiprocessor(&per_cu, (const void*)hymba_fwd, 512, LDS_BYTES) != hipSuccess || per_cu < 1) fprintf(stderr, "kernel_launch: occupancy query says %d\n", per_cu);
        (void)hipGetLastError();
        if (cus < 256) { fprintf(stderr, "kernel_launch: built for a 256-CU device (one resident workgroup per CU), found %d CUs\n", cus); grid = -1; return; }
        grid = 256;
    }
    if (grid < 0) return;
    if (hipMemsetAsync((char*)d_ws + WS_CTL, 0, CTL_BYTES, stream) != hipSuccess) return;
    Params p{};
    for (int i = 0; i < 25; ++i) p.in[i] = (const float*)d_in[i];
    p.out = (float*)d_out; p.ws = (unsigned char*)d_ws; p.ph_lo = 0; p.ph_hi = 0;
    hipLaunchKernelGGL(hymba_fwd, dim3(grid), dim3(512), LDS_BYTES, stream, p);
}
```

```cpp
#include <hip/hip_runtime.h>
#include <hip/hip_bf16.h>
#include <cstdio>
#include <cstdint>

#define LAS __attribute__((address_space(3)))
namespace cfg {
constexpr int DM = 2048, NBATCH = 8, SEQ = 4096, NMETA = 16, DEPTH = 4;
constexpr int MMAIN = NBATCH * SEQ;
constexpr int MROWS = MMAIN + 256;
constexpr int DFF = 5632, NGU = 2 * DFF;
constexpr int RW = 1024, RH = 64, RNH = 16;
constexpr int FW = 1024, FH = 128, FNH = 8;
constexpr int RWKV_COLS = 3360, DIN = 6440;
constexpr int NIN = 6656;
constexpr int PRW = 3072, PSW = 512, QKVW = 3072;
constexpr int SEQP = 4160;
constexpr float NORM_EPS = 1e-6f, LNX_EPS = 64e-5f;
constexpr int NSS = 13;
constexpr size_t al256(size_t x) { return (x + 255) & ~(size_t)255; }
constexpr size_t WS_CTL = 0;
constexpr size_t CTL_BYTES = 65536;
constexpr size_t WS_SS = WS_CTL + CTL_BYTES;
constexpr size_t SS_BYTES = al256((size_t)NSS * 8 * MROWS * 4);
constexpr size_t ZERO_BYTES = CTL_BYTES + SS_BYTES;
constexpr size_t WS_HMETA = WS_SS + SS_BYTES;
constexpr size_t WS_HB = WS_HMETA + (size_t)256 * DM * 4;
constexpr size_t WS_Y = WS_HB + (size_t)MROWS * DM * 2;
constexpr size_t WS_OVL = WS_Y + (size_t)MROWS * DM * 2;
constexpr size_t WS_ACT = WS_OVL;
constexpr size_t WS_PR = WS_OVL;
constexpr size_t WS_PS = WS_PR + (size_t)MROWS * PRW * 2;
constexpr size_t WS_QKV = WS_PS + (size_t)MROWS * PSW * 4;
constexpr size_t OVL_A = (size_t)MROWS * DFF * 2, OVL_B = (size_t)MROWS * PRW * 2 + (size_t)MROWS * PSW * 4 + (size_t)NBATCH * SEQP * QKVW * 2;
constexpr size_t WS_W = WS_OVL + al256(OVL_A > OVL_B ? OVL_A : OVL_B);
constexpr size_t W_GU = (size_t)NGU * DM * 2, W_D = (size_t)DM * DFF * 2, W_IN = (size_t)NIN * DM * 2, W_OUT = (size_t)DM * DM * 2;
constexpr size_t WO_GU1 = 0, WO_D1 = WO_GU1 + W_GU, WO_IN = WO_D1 + W_D, WO_OUT = WO_IN + W_IN, WO_GU2 = WO_OUT + W_OUT, WO_D2 = WO_GU2 + W_GU, W_LAYER = WO_D2 + W_D;
constexpr size_t WS_END = WS_W + (size_t)DEPTH * W_LAYER;
constexpr int LDS_BYTES = 147456;
constexpr int LDS_BARW = LDS_BYTES - 16;
}
__device__ __forceinline__ int ltid() { int t = (int)threadIdx.x; asm volatile("" : "+v"(t)); return t; }
__device__ __forceinline__ int lbid() { int t = (int)blockIdx.x; asm volatile("" : "+s"(t)); return t; }
__device__ __forceinline__ int lzero() { int t = 0; asm volatile("" : "+v"(t)); return t; }
namespace pg8 {
#define PG8_LAS __attribute__((address_space(3)))
typedef unsigned short bf16_t;
typedef short bf16x8 __attribute__((ext_vector_type(8)));
typedef float f32x4 __attribute__((ext_vector_type(4)));
typedef unsigned u32x4 __attribute__((ext_vector_type(4)));
constexpr int BM = 256, BK = 64, HALF = 128, HTB = HALF * BK * 2  , STAGE_BYTES = 8 * HTB, NXCD = 8, WGM = 8;

__host__ __device__ __forceinline__ int lds_byte(int r, int c) { const int st = (r >> 4) * 2 + (c >> 5), rr = r & 15, cc = c & 31, ob = rr * 64 + cc * 2; return st * 1024 + (ob ^ (((ob >> 9) & 1) << 5)); }
__host__ __device__ __forceinline__ void stage_rc(int b, int& R, int& C) { const int st = b / 1024, sb = b % 1024, swz = sb ^ (((sb >> 9) & 1) << 5); R = (st >> 1) * 16 + swz / 64; C = (st & 1) * 32 + (swz % 64) / 2; }
__host__ __device__ __forceinline__ int perm32(int rho) { const int n = rho >> 4, i = rho & 15; return 8 * (i >> 2) + 4 * n + (i & 3); }

struct Unit { int pm, pn; };
struct Gemm { const bf16_t* A; const bf16_t* Bt; int M, N, K; };

struct StaticOrder {
    int nM, nN, nwg, G, c;
    __host__ __device__ void init(int M, int N, int G_, int c_) { nM = M / BM; nN = N / BM; nwg = nM * nN; G = G_; c = c_; }
    __host__ __device__ bool next(int i, Unit& u) const {
        const long L = (long)i * G + c; if (L >= nwg) return false;
        int wgid = (int)L; { const int q = nwg / NXCD, r = nwg % NXCD, xcd = wgid % NXCD, off = wgid / NXCD; wgid = (xcd < r ? xcd * (q + 1) : r * (q + 1) + (xcd - r) * q) + off; }
        const int nig = WGM * nN, gid = wgid / nig, fm = gid * WGM, gsz = (nM - fm) < WGM ? (nM - fm) : WGM;
        u.pm = fm + ((wgid % nig) % gsz); u.pn = (wgid % nig) / gsz; return true;
    }
    __device__ __forceinline__ void a_ready(const Unit&) const {}
    __device__ __forceinline__ void done(const Unit&) const {}
};

__device__ __forceinline__ unsigned cvt_pk_bf16(float lo, float hi) { unsigned r; asm volatile("v_cvt_pk_bf16_f32 %0, %1, %2" : "=v"(r) : "v"(lo), "v"(hi)); return r; }
typedef float f32x2 __attribute__((ext_vector_type(2)));
__device__ __forceinline__ f32x2 gelu_pk(f32x2 v) {
    const f32x2 av = __builtin_elementwise_abs(v), d = av * 0.2316418882f + 1.0f;
    f32x2 t; t.x = __builtin_amdgcn_rcpf(d.x); t.y = __builtin_amdgcn_rcpf(d.y);
    f32x2 q = t * 0.5307027145f + (-0.7265760135f); q = q * t + 0.7107068705f; q = q * t + (-0.142248368f); q = q * t + 0.127414796f; q = q * t;
    const f32x2 s = (v * v) * (-0.72134752044f);
    f32x2 e; e.x = __builtin_amdgcn_exp2f(s.x); e.y = __builtin_amdgcn_exp2f(s.y);
    const f32x2 m = v * (q * e), r = v - m;
    f32x2 o; o.x = v.x < 0.f ? m.x : r.x; o.y = v.y < 0.f ? m.y : r.y; return o;
}
__device__ __forceinline__ float rs_of(const float* ss, int row) { float s = 0.f;
#pragma unroll
    for (int t = 0; t < 8; ++t) s += ss[(size_t)t * 33024 + row];
    return __builtin_amdgcn_rsqf(s * (1.0f / 2048.0f) + 1e-6f); }
__device__ __forceinline__ float silu_f(float x) { return x * __builtin_amdgcn_rcpf(1.0f + __builtin_amdgcn_exp2f(-1.4426950408889634f * x)); }

struct EpiGU {
    static constexpr bool PERM = true, AFTER_DRAIN = false;
    bf16_t* act; const float* ss;
    __device__ __forceinline__ void operator()(const f32x4 (&acc)[2][2][4][2], const Unit& u, int wr, int wc, int fr, int fq) const {
        const int row0 = u.pm * BM + wr * 64 + fr, col0 = u.pn * 128 + wc * 32 + 8 * fq;
#pragma unroll
        for (int ai = 0; ai < 2; ++ai)
#pragma unroll
            for (int m = 0; m < 4; ++m) { const int row = row0 + ai * HALF + m * 16; const float rs = rs_of(ss, row);
                const f32x4 g0 = acc[ai][0][m][0] * rs, g1 = acc[ai][0][m][1] * rs, u0 = acc[ai][1][m][0] * rs, u1 = acc[ai][1][m][1] * rs;
                u32x4 w;
                w.x = cvt_pk_bf16(silu_f(g0[0]) * u0[0], silu_f(g0[1]) * u0[1]); w.y = cvt_pk_bf16(silu_f(g0[2]) * u0[2], silu_f(g0[3]) * u0[3]);
                w.z = cvt_pk_bf16(silu_f(g1[0]) * u1[0], silu_f(g1[1]) * u1[1]); w.w = cvt_pk_bf16(silu_f(g1[2]) * u1[2], silu_f(g1[3]) * u1[3]);
                *(u32x4*)(act + (size_t)row * 5632 + col0) = w; }
    }
};
struct EpiRes {
    static constexpr bool PERM = false, AFTER_DRAIN = false;
    float* hmain; float* hmeta; bf16_t* hb; float* ssn; float alpha; PG8_LAS float* red;
    __device__ __forceinline__ void operator()(const f32x4 (&acc)[2][2][4][2], const Unit& u, int wr, int wc, int fr, int fq) const {
        typedef unsigned u32x2v __attribute__((ext_vector_type(2)));
        float* base = (u.pm < 128) ? hmain + (size_t)u.pm * BM * 2048 : hmeta;
        bf16_t* bbase = hb + (size_t)u.pm * BM * 2048;
        const int rl0 = wr * 64 + fr; unsigned off = (unsigned)(rl0 * 2048 + u.pn * BM + wc * 32 + 4 * fq);
#pragma unroll
        for (int ai = 0; ai < 2; ++ai)
#pragma unroll
            for (int m = 0; m < 4; ++m) { const unsigned o = off + (unsigned)((ai * HALF + m * 16) * 2048); float sq = 0.f;
#pragma unroll
                for (int bj = 0; bj < 2; ++bj)
#pragma unroll
                    for (int n = 0; n < 2; ++n) { const unsigned oo = o + bj * HALF + n * 16; f32x4 hv = *(const f32x4*)(base + oo); hv = hv + acc[ai][bj][m][n] * alpha; *(f32x4*)(base + oo) = hv;
                        sq += (hv[0] * hv[0] + hv[1] * hv[1]) + (hv[2] * hv[2] + hv[3] * hv[3]);
                        u32x2v w; w.x = cvt_pk_bf16(hv[0], hv[1]); w.y = cvt_pk_bf16(hv[2], hv[3]); *(u32x2v*)(bbase + oo) = w; }
                sq += __shfl_xor(sq, 16); sq += __shfl_xor(sq, 32);
                if (fq == 0) red[(rl0 + ai * HALF + m * 16) * 4 + wc] = sq;
                asm volatile("" ::: "memory"); }
        asm volatile("s_waitcnt lgkmcnt(0)" ::: "memory"); __builtin_amdgcn_s_barrier(); asm volatile("" ::: "memory");
        if (wr == 0) { const int row = wc * 64 + fq * 16 + fr; const float s4 = (red[row * 4] + red[row * 4 + 1]) + (red[row * 4 + 2] + red[row * 4 + 3]); ssn[(size_t)u.pn * 33024 + u.pm * BM + row] = s4; }
    }
};
struct EpiP {
    static constexpr bool PERM = true, AFTER_DRAIN = false;
    bf16_t* pr; float* ps; bf16_t* qkv; const float* ss;
    __device__ __forceinline__ void operator()(const f32x4 (&acc)[2][2][4][2], const Unit& u, int wr, int wc, int fr, int fq) const {
        const int row0 = u.pm * BM + wr * 64 + fr, cl = wc * 32 + 8 * fq;
#pragma unroll
        for (int ai = 0; ai < 2; ++ai)
#pragma unroll
            for (int m = 0; m < 4; ++m) { const int row = row0 + ai * HALF + m * 16; const float rs = rs_of(ss, row);
#pragma unroll
                for (int bj = 0; bj < 2; ++bj) { const f32x4 v0 = acc[ai][bj][m][0] * rs, v1 = acc[ai][bj][m][1] * rs;
                    if (u.pn >= 12 && u.pn < 14) { float* d = ps + (size_t)row * 512 + (u.pn - 12) * 256 + bj * HALF + cl; *(f32x4*)d = v0; *(f32x4*)(d + 4) = v1; }
                    else { u32x4 w; w.x = cvt_pk_bf16(v0[0], v0[1]); w.y = cvt_pk_bf16(v0[2], v0[3]); w.z = cvt_pk_bf16(v1[0], v1[1]); w.w = cvt_pk_bf16(v1[2], v1[3]);
                        if (u.pn < 12) *(u32x4*)(pr + (size_t)row * 3072 + u.pn * 256 + bj * HALF + cl) = w;
                        else { const int c = (u.pn - 14) * 256 + bj * HALF + cl;
                            if (u.pm < 128) { const int b = row >> 12, s = row & 4095; *(u32x4*)(qkv + ((size_t)b * 4160 + 64 + s) * 3072 + c) = w; }
                            else { const int j = row - 32768; if (j < 16) { for (int b = 0; b < 8; ++b) *(u32x4*)(qkv + ((size_t)b * 4160 + 48 + j) * 3072 + c) = w; } } } } } }
    }
};
template <class Epi, class Sched, bool ALIGN_EPI = false, bool SP2 = false>
__device__ __forceinline__ void gemm_phase(PG8_LAS unsigned char* lds, const Gemm g, const Sched& S, const Epi& E) {
    const int tid = ltid(), wid = __builtin_amdgcn_readfirstlane(tid >> 6), lane = tid & 63, wr = wid >> 2, wc = wid & 3, fr = lane & 15, fq = lane >> 4;
    const int K = g.K, nt = K / BK;
    unsigned voffA[2], voffB[2];
#pragma unroll
    for (int i = 0; i < 2; ++i) { int R, C; stage_rc(tid * 16 + i * 8192, R, C); const int Rb = Epi::PERM ? ((R & ~31) + perm32(R & 31)) : R;
        voffA[i] = (unsigned)(R * K + C) * 2u; voffB[i] = (unsigned)(Rb * K + C) * 2u; }
    const size_t kstep = (size_t)(BK * 2);
    const size_t hstep = (size_t)HALF * K * 2;
    const size_t tstep = 2 * hstep;
    const unsigned ldsw = (unsigned)wid * 1024u;
    const int aoff = lds_byte(wr * 64 + fr, fq * 8), boff = lds_byte(wc * 32 + fr, fq * 8);
#define PG8_SA(b, h) (((b) * 2 + (h)) * HTB)
#define PG8_SB(b, h) ((4 + (b) * 2 + (h)) * HTB)
#define PG8_STAGE(bufoff, gbase, voff) do { _Pragma("unroll") for (int _i = 0; _i < 2; ++_i) \
        __builtin_amdgcn_global_load_lds((const unsigned*)((const char*)(gbase) + (voff)[_i]), (PG8_LAS unsigned*)(lds + (bufoff) + ldsw + _i * 8192), 16, 0, 0); } while (0)
#define PG8_LDA(dst, b, h) do { _Pragma("unroll") for (int m = 0; m < 4; ++m) _Pragma("unroll") for (int k = 0; k < 2; ++k) dst[m][k] = *(const PG8_LAS bf16x8*)(lds + PG8_SA(b, h) + aoff + m * 2048 + k * 1024); } while (0)
#define PG8_LDB(dst, b, h) do { _Pragma("unroll") for (int n = 0; n < 2; ++n) _Pragma("unroll") for (int k = 0; k < 2; ++k) dst[n][k] = *(const PG8_LAS bf16x8*)(lds + PG8_SB(b, h) + boff + n * 2048 + k * 1024); } while (0)
#define PG8_MMA(ai, bj, At, Bt) do { __builtin_amdgcn_s_setprio(1); _Pragma("unroll") for (int m = 0; m < 4; ++m) _Pragma("unroll") for (int n = 0; n < 2; ++n) _Pragma("unroll") for (int k = 0; k < 2; ++k) \
        acc[ai][bj][m][n] = __builtin_amdgcn_mfma_f32_16x16x32_bf16(Bt[n][k], At[m][k], acc[ai][bj][m][n], 0, 0, 0); __builtin_amdgcn_s_setprio(0); } while (0)
#define PG8_WAIT_V(n) asm volatile("s_waitcnt vmcnt(" #n ")" ::: "memory")
#define PG8_WAIT_L(n) asm volatile("s_waitcnt lgkmcnt(" #n ")" ::: "memory")
#define PG8_BAR __builtin_amdgcn_s_barrier()
#define PG8_SCHED __builtin_amdgcn_sched_barrier(0)
    Unit cur, nxt; int ui = 0;
    if (!S.next(0, cur)) return;
    f32x4 acc[2][2][4][2];
#pragma unroll
    for (int a = 0; a < 2; ++a)
#pragma unroll
        for (int b = 0; b < 2; ++b)
#pragma unroll
            for (int m = 0; m < 4; ++m)
#pragma unroll
                for (int n = 0; n < 2; ++n) acc[a][b][m][n] = (f32x4){0.f, 0.f, 0.f, 0.f};
    bf16x8 At[4][2], B0[2][2], B1[2][2];
    const char* cA = (const char*)g.A + (size_t)cur.pm * tstep; const char* cB = (const char*)g.Bt + (size_t)cur.pn * tstep;
    S.a_ready(cur);
    if constexpr (SP2) {
        PG8_STAGE(PG8_SB(0, 0), cB, voffB); PG8_STAGE(PG8_SB(0, 1), cB + hstep, voffB); PG8_STAGE(PG8_SA(0, 0), cA, voffA); PG8_STAGE(PG8_SA(0, 1), cA + hstep, voffA);
        if (wr == 1) PG8_BAR;
        PG8_WAIT_V(2); PG8_BAR;
        PG8_STAGE(PG8_SB(1, 0), cB + kstep, voffB); PG8_STAGE(PG8_SA(1, 0), cA + kstep, voffA); PG8_STAGE(PG8_SB(1, 1), cB + hstep + kstep, voffB);
        PG8_WAIT_V(6); PG8_BAR;
    } else {
        PG8_STAGE(PG8_SB(0, 0), cB, voffB); PG8_STAGE(PG8_SA(0, 0), cA, voffA); PG8_STAGE(PG8_SB(0, 1), cB + hstep, voffB); PG8_STAGE(PG8_SA(0, 1), cA + hstep, voffA);
        if (wr == 1) PG8_BAR;
        PG8_WAIT_V(4); PG8_BAR;
        PG8_STAGE(PG8_SB(1, 0), cB + kstep, voffB); PG8_STAGE(PG8_SA(1, 0), cA + kstep, voffA); PG8_STAGE(PG8_SB(1, 1), cB + hstep + kstep, voffB);
        PG8_WAIT_V(6); PG8_BAR;
    }
    for (;;) {
        const bool has_next = S.next(ui + 1, nxt);
        const char* nA = has_next ? (const char*)g.A + (size_t)nxt.pm * tstep : cA; const char* nB = has_next ? (const char*)g.Bt + (size_t)nxt.pn * tstep : cB;
        for (int t = 0; t < nt; t += 2) {
            const bool last = (t == nt - 2);
            const char* a1 = cA + (size_t)(t + 1) * kstep;
            const char* a2 = last ? nA : cA + (size_t)(t + 2) * kstep; const char* b2 = last ? nB : cB + (size_t)(t + 2) * kstep;
            const char* a3 = a2 + kstep; const char* b3 = b2 + kstep;
            if (last && has_next) S.a_ready(nxt);
            if constexpr (SP2) {
            PG8_LDB(B0, 0, 0); PG8_LDB(B1, 0, 1); PG8_SCHED; PG8_LDA(At, 0, 0); PG8_STAGE(PG8_SA(1, 1), a1 + hstep, voffA);
            PG8_WAIT_V(8); PG8_WAIT_L(0); PG8_BAR; PG8_MMA(0, 0, At, B0); PG8_MMA(0, 1, At, B1); PG8_BAR; PG8_SCHED;
            PG8_LDA(At, 0, 1); PG8_STAGE(PG8_SB(0, 0), b2, voffB); PG8_STAGE(PG8_SB(0, 1), b2 + hstep, voffB); PG8_STAGE(PG8_SA(0, 0), a2, voffA);
            PG8_WAIT_V(8); PG8_WAIT_L(0); PG8_BAR; PG8_MMA(1, 0, At, B0); PG8_MMA(1, 1, At, B1); PG8_BAR; PG8_SCHED;
            PG8_LDB(B0, 1, 0); PG8_LDB(B1, 1, 1); PG8_SCHED; PG8_LDA(At, 1, 0); PG8_STAGE(PG8_SA(0, 1), a2 + hstep, voffA);
            PG8_WAIT_V(8); PG8_WAIT_L(0); PG8_BAR; PG8_MMA(0, 0, At, B0); PG8_MMA(0, 1, At, B1); PG8_BAR; PG8_SCHED;
            PG8_LDA(At, 1, 1); PG8_STAGE(PG8_SB(1, 0), b3, voffB); PG8_STAGE(PG8_SB(1, 1), b3 + hstep, voffB); PG8_STAGE(PG8_SA(1, 0), a3, voffA);
            PG8_WAIT_V(8); PG8_WAIT_L(0); PG8_BAR; PG8_MMA(1, 0, At, B0); PG8_MMA(1, 1, At, B1); PG8_BAR; PG8_SCHED;
            } else {
            PG8_LDB(B0, 0, 0); PG8_SCHED; PG8_LDA(At, 0, 0); PG8_STAGE(PG8_SA(1, 1), a1 + hstep, voffA);
            PG8_WAIT_L(8); PG8_BAR; PG8_WAIT_L(0); PG8_MMA(0, 0, At, B0); PG8_BAR; PG8_SCHED;
            PG8_LDB(B1, 0, 1); PG8_STAGE(PG8_SB(0, 0), b2, voffB);
            PG8_BAR; PG8_WAIT_L(0); PG8_MMA(0, 1, At, B1); PG8_BAR;
            PG8_LDA(At, 0, 1); PG8_STAGE(PG8_SA(0, 0), a2, voffA);
            PG8_BAR; PG8_WAIT_L(0); PG8_MMA(1, 0, At, B0); PG8_BAR; PG8_SCHED;
            PG8_STAGE(PG8_SB(0, 1), b2 + hstep, voffB);
            PG8_WAIT_V(6); PG8_BAR; PG8_MMA(1, 1, At, B1); PG8_BAR;
            PG8_LDB(B0, 1, 0); PG8_SCHED; PG8_LDA(At, 1, 0); PG8_STAGE(PG8_SA(0, 1), a2 + hstep, voffA);
            PG8_WAIT_L(8); PG8_BAR; PG8_WAIT_L(0); PG8_MMA(0, 0, At, B0); PG8_BAR; PG8_SCHED;
            PG8_LDB(B1, 1, 1); PG8_STAGE(PG8_SB(1, 0), b3, voffB);
            PG8_BAR; PG8_WAIT_L(0); PG8_MMA(0, 1, At, B1); PG8_BAR;
            PG8_LDA(At, 1, 1); PG8_STAGE(PG8_SA(1, 0), a3, voffA);
            PG8_BAR; PG8_WAIT_L(0); PG8_MMA(1, 0, At, B0); PG8_BAR; PG8_SCHED;
            PG8_STAGE(PG8_SB(1, 1), b3 + hstep, voffB);
            PG8_WAIT_V(6); PG8_BAR; PG8_MMA(1, 1, At, B1); PG8_BAR;
            }
        }
        if constexpr (ALIGN_EPI) { if (wr == 0) PG8_BAR; }
        if constexpr (!Epi::AFTER_DRAIN) { E(acc, cur, wr, wc, fr, fq); S.done(cur); }
        if (!has_next) break;
#pragma unroll
        for (int a = 0; a < 2; ++a)
#pragma unroll
            for (int b = 0; b < 2; ++b)
#pragma unroll
                for (int m = 0; m < 4; ++m)
#pragma unroll
                    for (int n = 0; n < 2; ++n) acc[a][b][m][n] = (f32x4){0.f, 0.f, 0.f, 0.f};
        cur = nxt; cA = nA; cB = nB; ++ui;
        if constexpr (ALIGN_EPI) { if (wr == 1) PG8_BAR; }
    }
    PG8_WAIT_V(0);
    if constexpr (!ALIGN_EPI) { if (wr == 0) PG8_BAR; }
    PG8_BAR;
    if constexpr (Epi::AFTER_DRAIN) { E.fused(acc, cur, wr, wc, fr, fq, lds, wid, lane); S.done(cur); }
#undef PG8_SA
#undef PG8_SB
#undef PG8_STAGE
#undef PG8_LDA
#undef PG8_LDB
#undef PG8_MMA
#undef PG8_WAIT_V
#undef PG8_WAIT_L
#undef PG8_BAR
#undef PG8_SCHED
}
}


#define XB_TMO      128
#define XB_XCNT(j)  (256  + 64 * (j))
#define XB_XSUB(j)  (1280 + 64 * (j))
#define XB_XGEN(j)  (2304 + 64 * (j))
#define XB_TOP      3328
#define XB_TOPGEN   3392
#define XCD_BAR_WORDS 3456
#define XB_SPIN_CAP (1u << 22)

__device__ __forceinline__ unsigned xb_ld(unsigned* p)              { return __hip_atomic_load(p, __ATOMIC_RELAXED, __HIP_MEMORY_SCOPE_AGENT); }
__device__ __forceinline__ unsigned xb_add(unsigned* p, unsigned v) { return __hip_atomic_fetch_add(p, v, __ATOMIC_RELAXED, __HIP_MEMORY_SCOPE_AGENT); }
__device__ __forceinline__ unsigned xb_xcc_id() { return (unsigned)__builtin_amdgcn_s_getreg((3 << 11) | 20) & 0xFu; }
#define XB_SPIN(cond, bar) do { unsigned _sp = 0; while (cond) { __builtin_amdgcn_s_sleep(1); \
    if ((++_sp & 255u) == 0u) { if (xb_ld(&(bar)[XB_TMO])) break; if (_sp > XB_SPIN_CAP) { atomicAdd(&(bar)[XB_TMO], 1u); break; } } } } while (0)

struct XcdBarrier {
    unsigned* bar; unsigned x;
    volatile LAS unsigned* st;
};

__device__ __forceinline__ XcdBarrier xcd_barrier_post(unsigned* bar, volatile LAS unsigned* st) {
    XcdBarrier b; b.bar = bar; b.x = xb_xcc_id(); b.st = st;
    if (threadIdx.x == 0) (void)xb_add(&bar[XB_XCNT(b.x)], 1u);
    return b;
}
__device__ __forceinline__ void xcd_barrier_complete(unsigned* bar, unsigned x, unsigned& nloc, unsigned& nx) {
    const unsigned G = gridDim.x * gridDim.y * gridDim.z;
    unsigned sum, cnt, mine, sp = 0u;
    for (;;) {
        sum = 0u; cnt = 0u; mine = 0u;
#pragma unroll
        for (unsigned j = 0; j < 16; ++j) { const unsigned c = xb_ld(&bar[XB_XCNT(j)]); sum += c; cnt += (c > 0u) ? 1u : 0u; mine = (j == x) ? c : mine; }
        if (sum == G) break;
        __builtin_amdgcn_s_sleep(1);
        if ((++sp & 255u) == 0u) { if (xb_ld(&bar[XB_TMO])) break; if (sp > XB_SPIN_CAP) { atomicAdd(&bar[XB_TMO], 1u); break; } }
    }
    nloc = mine > 0u ? mine : 1u; nx = cnt > 0u ? cnt : 1u;
}

__device__ __forceinline__ void xcd_barrier(const XcdBarrier& b) {
    asm volatile("s_waitcnt vmcnt(0)" ::: "memory");
    __syncthreads();
    if (threadIdx.x == 0) {
        unsigned* bar = b.bar;
        __builtin_amdgcn_s_waitcnt(0);
        unsigned nloc = b.st[0], nx = b.st[1];
        if (nloc == 0u) { xcd_barrier_complete(bar, b.x, nloc, nx); b.st[0] = nloc; b.st[1] = nx; }
        const unsigned old = xb_add(&bar[XB_XSUB(b.x)], 1u);
        const unsigned gen = old / nloc;
        if (old + 1u == (gen + 1u) * nloc) {
            __builtin_amdgcn_fence(__ATOMIC_RELEASE, "agent");
            asm volatile("s_waitcnt vmcnt(0)" ::: "memory");
            const unsigned og = xb_add(&bar[XB_TOP], 1u);
            const unsigned tg = og / nx;
            if (og + 1u == (tg + 1u) * nx) xb_add(&bar[XB_TOPGEN], 1u);
            else XB_SPIN(xb_ld(&bar[XB_TOPGEN]) == tg, bar);
            __builtin_amdgcn_fence(__ATOMIC_ACQUIRE, "agent");
            xb_add(&bar[XB_XGEN(b.x)], 1u);
            asm volatile("s_waitcnt vmcnt(0)" ::: "memory");
        } else {
            XB_SPIN(xb_ld(&bar[XB_XGEN(b.x)]) == gen, bar);
            __builtin_amdgcn_fence(__ATOMIC_ACQUIRE, "agent");
            asm volatile("s_waitcnt vmcnt(0)" ::: "memory");
        }
    }
    __syncthreads();
}


typedef unsigned short bf16_t;
typedef float f32x4 __attribute__((ext_vector_type(4)));
typedef unsigned u32x4 __attribute__((ext_vector_type(4)));
typedef unsigned u32x2 __attribute__((ext_vector_type(2)));
struct Params { const float* in[25]; float* out; unsigned char* ws; int ph_lo, ph_hi; };
#define CAS __attribute__((address_space(4)))
typedef const CAS Params* PP;
__device__ __forceinline__ PP launder(PP p) { asm volatile("" : "+s"(p)); return p; }
enum { I_X = 0, I_META, I_F1N, I_F1GU, I_F1D, I_MIXN, I_WIN, I_MU, I_W0, I_WUP, I_A0, I_AUP, I_GUP, I_KK, I_KA, I_RK, I_LNW, I_LNB, I_BF, I_FON, I_WOUT, I_F2N, I_F2GU, I_F2D, I_FINN };

typedef float f32x2_t __attribute__((ext_vector_type(2))); typedef __bf16 bf16x2v_t __attribute__((ext_vector_type(2)));
__device__ __forceinline__ unsigned pk_bf16(float lo, float hi) { f32x2_t v = {lo, hi}; bf16x2v_t b = __builtin_convertvector(v, bf16x2v_t); return __builtin_bit_cast(unsigned, b); }
__device__ __forceinline__ float bf2f(bf16_t b) { return __uint_as_float(((unsigned)b) << 16); }
__device__ __forceinline__ float wave_sum(float v) {
#pragma unroll
    for (int o = 32; o >= 1; o >>= 1) v += __shfl_xor(v, o);
    return v; }
__device__ __forceinline__ float wave_max(float v) {
#pragma unroll
    for (int o = 32; o >= 1; o >>= 1) v = fmaxf(v, __shfl_xor(v, o));
    return v; }
__device__ __forceinline__ float sigmoid_f(float x) { return __builtin_amdgcn_rcpf(1.0f + __expf(-x)); }

__device__ __forceinline__ void convert_tile(const float* __restrict__ src, bf16_t* __restrict__ dst, const float* __restrict__ gain, int K, int Nsrc, int kind, int tk, int tn, LAS float* T) {
    const int tid = ltid();
    {
        const int nl = (tid & 15) * 4, np = tn * 64 + nl; int sc;
        if (kind == 1) { const int pn = np >> 8, bj = (np >> 7) & 1, i = np & 127; sc = bj * cfg::DFF + pn * 128 + i; }
        else if (kind == 2) { sc = np < 3360 ? np : (np < 3368 ? 6432 + (np - 3360) : (np < 3584 ? -1 : 3360 + (np - 3584))); }
        else sc = np;
#pragma unroll
        for (int i = 0; i < 2; ++i) { const int kl = (tid >> 4) + 32 * i, k = tk * 64 + kl;
            f32x4 v = (f32x4){0.f, 0.f, 0.f, 0.f};
            if (sc >= 0) v = *(const f32x4*)(src + (size_t)k * Nsrc + sc);
            float g = 1.f; if (kind == 1 || kind == 2) g = gain[k]; else if (kind == 3) g = (k >= 1024) ? gain[k - 1024] : 1.f;
            T[kl * 65 + nl] = v[0] * g; T[kl * 65 + nl + 1] = v[1] * g; T[kl * 65 + nl + 2] = v[2] * g; T[kl * 65 + nl + 3] = v[3] * g; }
    }
    __syncthreads();
    {
        const int nl = tid >> 3, k8 = (tid & 7) * 8; u32x4 w;
        w.x = pk_bf16(T[(k8 + 0) * 65 + nl], T[(k8 + 1) * 65 + nl]); w.y = pk_bf16(T[(k8 + 2) * 65 + nl], T[(k8 + 3) * 65 + nl]);
        w.z = pk_bf16(T[(k8 + 4) * 65 + nl], T[(k8 + 5) * 65 + nl]); w.w = pk_bf16(T[(k8 + 6) * 65 + nl], T[(k8 + 7) * 65 + nl]);
        *(u32x4*)(dst + (size_t)(tn * 64 + nl) * K + tk * 64 + k8) = w;
    }
    __syncthreads();
}
__device__ __forceinline__ void phase_convert(PP P, LAS unsigned char* lds) {
    using namespace cfg;
    LAS float* T = (LAS float*)lds;
    constexpr int T_GU = (DM / 64) * (NGU / 64), T_D = (DFF / 64) * (DM / 64), T_IN = (DM / 64) * (NIN / 64), T_OUT = (DM / 64) * (DM / 64);
    constexpr int T_LAYER = 2 * T_GU + 2 * T_D + T_IN + T_OUT;
    for (int t = lbid(); t < DEPTH * T_LAYER; t += gridDim.x) {
        const int l = t / T_LAYER; int r = t - l * T_LAYER;
        bf16_t* wl = (bf16_t*)(P->ws + WS_W + (size_t)l * W_LAYER);
        const float* src; bf16_t* dst; const float* gain = nullptr; int K, Nsrc, kind, ntn;
        if (r < T_GU) { src = P->in[I_F1GU] + (size_t)l * DM * NGU; dst = (bf16_t*)((unsigned char*)wl + WO_GU1); gain = P->in[I_F1N] + l * DM; K = DM; Nsrc = NGU; kind = 1; ntn = NGU / 64; }
        else if ((r -= T_GU) < T_D) { src = P->in[I_F1D] + (size_t)l * DFF * DM; dst = (bf16_t*)((unsigned char*)wl + WO_D1); K = DFF; Nsrc = DM; kind = 0; ntn = DM / 64; }
        else if ((r -= T_D) < T_IN) { src = P->in[I_WIN] + (size_t)l * DM * DIN; dst = (bf16_t*)((unsigned char*)wl + WO_IN); gain = P->in[I_MIXN] + l * DM; K = DM; Nsrc = DIN; kind = 2; ntn = NIN / 64; }
        else if ((r -= T_IN) < T_OUT) { src = P->in[I_WOUT] + (size_t)l * DM * DM; dst = (bf16_t*)((unsigned char*)wl + WO_OUT); gain = P->in[I_FON] + l * FW; K = DM; Nsrc = DM; kind = 3; ntn = DM / 64; }
        else if ((r -= T_OUT) < T_GU) { src = P->in[I_F2GU] + (size_t)l * DM * NGU; dst = (bf16_t*)((unsigned char*)wl + WO_GU2); gain = P->in[I_F2N] + l * DM; K = DM; Nsrc = NGU; kind = 1; ntn = NGU / 64; }
        else { r -= T_GU; src = P->in[I_F2D] + (size_t)l * DFF * DM; dst = (bf16_t*)((unsigned char*)wl + WO_D2); K = DFF; Nsrc = DM; kind = 0; ntn = DM / 64; }
        convert_tile(src, dst, gain, K, Nsrc, kind, r / ntn, r % ntn, T);
    }
}
__device__ __forceinline__ void phase_init(PP P) {
    using namespace cfg;
    const int lane = ltid() & 63, gw = lbid() * 8 + (ltid() >> 6), nw = gridDim.x * 8;
    float* hmeta = (float*)(P->ws + WS_HMETA); bf16_t* hb = (bf16_t*)(P->ws + WS_HB); float* ss0 = (float*)(P->ws + WS_SS);
    for (int row = gw; row < MROWS; row += nw) {
        const float* s = row < MMAIN ? P->in[I_X] + (size_t)row * DM : P->in[I_META] + (size_t)(row - MMAIN) * DM;
        float* d = row < MMAIN ? P->out + (size_t)row * DM : hmeta + (size_t)(row - MMAIN) * DM;
        float sq = 0.f;
#pragma unroll
        for (int i = 0; i < 8; ++i) { f32x4 v = (f32x4){0.f, 0.f, 0.f, 0.f}; if (row < MMAIN + NMETA) v = *(const f32x4*)(s + i * 256 + lane * 4);
            *(f32x4*)(d + i * 256 + lane * 4) = v; sq += (v[0] * v[0] + v[1] * v[1]) + (v[2] * v[2] + v[3] * v[3]);
            u32x2 w; w.x = pk_bf16(v[0], v[1]); w.y = pk_bf16(v[2], v[3]); *(u32x2*)(hb + (size_t)row * DM + i * 256 + lane * 4) = w; }
        sq = wave_sum(sq);
        if (lane < 8) ss0[(size_t)lane * MROWS + row] = lane == 0 ? sq : 0.f;
    }
}
__device__ __forceinline__ void phase_foxnorm(PP P) {
    using namespace cfg;
    const int lane = ltid() & 63, gw = lbid() * 8 + (ltid() >> 6), nw = gridDim.x * 8;
    bf16_t* y = (bf16_t*)(P->ws + WS_Y);
    for (int row = gw; row < MMAIN + NMETA; row += nw) {
        bf16_t* p = y + (size_t)row * DM + 1024 + lane * 16;
        u32x4 a = *(const u32x4*)p, b = *(const u32x4*)(p + 8); float v[16];
#pragma unroll
        for (int i = 0; i < 4; ++i) { v[2 * i] = __uint_as_float(a[i] << 16); v[2 * i + 1] = __uint_as_float(a[i] & 0xffff0000u); v[8 + 2 * i] = __uint_as_float(b[i] << 16); v[8 + 2 * i + 1] = __uint_as_float(b[i] & 0xffff0000u); }
        float sq = 0.f;
#pragma unroll
        for (int i = 0; i < 16; ++i) sq += v[i] * v[i];
        sq = wave_sum(sq); const float rs = __builtin_amdgcn_rsqf(sq * (1.0f / 1024.0f) + NORM_EPS);
#pragma unroll
        for (int i = 0; i < 4; ++i) { a[i] = pk_bf16(v[2 * i] * rs, v[2 * i + 1] * rs); b[i] = pk_bf16(v[8 + 2 * i] * rs, v[8 + 2 * i + 1] * rs); }
        *(u32x4*)p = a; *(u32x4*)(p + 8) = b;
    }
}
__device__ __forceinline__ void phase_final(PP P) {
    using namespace cfg;
    const int lane = ltid() & 63, gw = lbid() * 8 + (ltid() >> 6), nw = gridDim.x * 8;
    const float* g = P->in[I_FINN];
    for (int row = gw; row < MMAIN; row += nw) {
        float* d = P->out + (size_t)row * DM; f32x4 v[8]; float sq = 0.f;
#pragma unroll
        for (int i = 0; i < 8; ++i) { v[i] = *(const f32x4*)(d + i * 256 + lane * 4); sq += (v[i][0] * v[i][0] + v[i][1] * v[i][1]) + (v[i][2] * v[i][2] + v[i][3] * v[i][3]); }
        sq = wave_sum(sq); const float rs = __builtin_amdgcn_rsqf(sq * (1.0f / 2048.0f) + NORM_EPS);
#pragma unroll
        for (int i = 0; i < 8; ++i) { const f32x4 gv = *(const f32x4*)(g + i * 256 + lane * 4); *(f32x4*)(d + i * 256 + lane * 4) = v[i] * rs * gv; }
    }
}

__device__ __forceinline__ void rwkv_simple(PP P, int l, int b, int h, LAS unsigned char* lds) {
    using namespace cfg;
    const int tid = ltid(), lane = tid & 63, wave = tid >> 6;
    LAS bf16_t* WUP = (LAS bf16_t*)lds; LAS bf16_t* AUP = WUP + 4096; LAS bf16_t* GUP = AUP + 4096;
    LAS float* RAW = (LAS float*)(lds + 36864); LAS float* LX = RAW + 17 * 480; LAS float* Rm = LX + 16 * 288;
    LAS float* Wm = Rm + 1024; LAS float* KPm = Wm + 1024; LAS float* Vm = KPm + 1024; LAS float* Am = Vm + 1024; LAS float* Bm = Am + 1024; LAS float* Gm = Bm + 1024;
    LAS float* BON = Gm + 1024; LAS float* YR = BON + 16;
    const bf16_t* PR = (const bf16_t*)(P->ws + WS_PR); const float* PS = (const float*)(P->ws + WS_PS); bf16_t* Y = (bf16_t*)(P->ws + WS_Y);
    const float* mu = P->in[I_MU] + l * RWKV_COLS;
    for (int e = tid; e < 64 * 64; e += 512) { const int i = e >> 6, j = e & 63;
        WUP[e] = (bf16_t)(pk_bf16(P->in[I_WUP][((size_t)l * 64 + i) * RW + h * 64 + j], 0.f) & 0xffffu);
        AUP[e] = (bf16_t)(pk_bf16(P->in[I_AUP][((size_t)l * 64 + i) * RW + h * 64 + j], 0.f) & 0xffffu); }
    for (int e = tid; e < 160 * 64; e += 512) { const int i = e >> 6, j = e & 63; GUP[e] = (bf16_t)(pk_bf16(P->in[I_GUP][((size_t)l * 160 + i) * RW + h * 64 + j], 0.f) & 0xffffu); }
    for (int e = tid; e < 480; e += 512) RAW[e] = 0.f;
    const int hj = h * 64 + lane;
    const float w0 = P->in[I_W0][l * RW + hj], a0 = P->in[I_A0][l * RW + hj], kkw = P->in[I_KK][l * RW + hj], kaw = P->in[I_KA][l * RW + hj], rkw = P->in[I_RK][l * RW + hj];
    const float lnw = P->in[I_LNW][l * RW + hj], lnb = P->in[I_LNB][l * RW + hj];
    const float mur = mu[hj], muk = mu[1024 + hj], muv = mu[2048 + hj];
    float S[16];
#pragma unroll
    for (int j = 0; j < 16; ++j) S[j] = 0.f;
    __syncthreads();
    for (int c = 0; c < 257; ++c) {
        const int row0 = (c == 0) ? MMAIN : b * SEQ + (c - 1) * 16;
        for (int e = tid; e < 16 * 480; e += 512) { const int t = e / 480, cc = e - t * 480; const int row = row0 + t; float v;
            if (cc < 192) v = bf2f(PR[(size_t)row * PRW + (cc >> 6) * 1024 + h * 64 + (cc & 63)]); else v = PS[(size_t)row * PSW + (cc - 192)];
            RAW[(t + 1) * 480 + cc] = v; }
        __syncthreads();
        for (int e = tid; e < 16 * 288; e += 512) { const int t = e / 288, i = e - t * 288; const float cur = RAW[(t + 1) * 480 + 192 + i], prv = RAW[t * 480 + 192 + i];
            const float x = cur + (prv - cur) * mu[3072 + i];
            LX[e] = i < 64 ? tanhf(x) : (i < 128 ? x : sigmoid_f(x)); }
        __syncthreads();
#pragma unroll 1
        for (int rep = 0; rep < 2; ++rep) { const int t = wave + 8 * rep;
            float aw = w0, aa = a0, ag = 0.f;
            for (int i = 0; i < 64; ++i) { aw += LX[t * 288 + i] * bf2f(WUP[i * 64 + lane]); aa += LX[t * 288 + 64 + i] * bf2f(AUP[i * 64 + lane]); }
            for (int i = 0; i < 160; ++i) ag += LX[t * 288 + 128 + i] * bf2f(GUP[i * 64 + lane]);
            const float sp = (aw < 0.f ? -aw : 0.f) + log1pf(__expf(-fabsf(aw)));
            const float dec = __expf(-__expf(-sp - 0.5f));
            const float alr = sigmoid_f(aa);
            const float rc = RAW[(t + 1) * 480 + lane], rp = RAW[t * 480 + lane]; const float r = rc + (rp - rc) * mur;
            const float kc = RAW[(t + 1) * 480 + 64 + lane], kp = RAW[t * 480 + 64 + lane]; const float k = kc + (kp - kc) * muk;
            const float vc = RAW[(t + 1) * 480 + 128 + lane], vp = RAW[t * 480 + 128 + lane]; const float v = vc + (vp - vc) * muv;
            const float kkr = k * kkw; const float nrm = sqrtf(wave_sum(kkr * kkr)); const float kk = kkr / fmaxf(nrm, 1e-12f);
            const float kmod = k * (1.0f + (alr - 1.0f) * kaw);
            const float bon = wave_sum(r * kmod * rkw);
            Rm[t * 64 + lane] = r; Wm[t * 64 + lane] = dec; KPm[t * 64 + lane] = kmod; Vm[t * 64 + lane] = v; Am[t * 64 + lane] = -kk; Bm[t * 64 + lane] = kk * alr; Gm[t * 64 + lane] = ag;
            if (lane == 0) BON[t] = bon; }
        __syncthreads();
        for (int e = tid; e < 480; e += 512) RAW[e] = RAW[16 * 480 + e];
        if (wave < 4) { const int vrow = 16 * wave + (lane & 15), q = lane >> 4;
#pragma unroll 1
            for (int t = 0; t < 16; ++t) { float a[16], w[16], bb[16], kk[16], rr[16];
#pragma unroll
                for (int g = 0; g < 4; ++g) { const f32x4 av = *(const LAS f32x4*)(Am + t * 64 + 16 * q + 4 * g), wv = *(const LAS f32x4*)(Wm + t * 64 + 16 * q + 4 * g), bv = *(const LAS f32x4*)(Bm + t * 64 + 16 * q + 4 * g),
                        kv = *(const LAS f32x4*)(KPm + t * 64 + 16 * q + 4 * g), rv = *(const LAS f32x4*)(Rm + t * 64 + 16 * q + 4 * g);
#pragma unroll
                    for (int i = 0; i < 4; ++i) { a[4 * g + i] = av[i]; w[4 * g + i] = wv[i]; bb[4 * g + i] = bv[i]; kk[4 * g + i] = kv[i]; rr[4 * g + i] = rv[i]; } }
                float sa = 0.f;
#pragma unroll
                for (int j = 0; j < 16; ++j) sa += S[j] * a[j];
                sa += __shfl_xor(sa, 16); sa += __shfl_xor(sa, 32);
                const float vv = Vm[t * 64 + vrow]; float y = 0.f;
#pragma unroll
                for (int j = 0; j < 16; ++j) { S[j] = S[j] * w[j] + (sa * bb[j] + vv * kk[j]); y += S[j] * rr[j]; }
                y += __shfl_xor(y, 16); y += __shfl_xor(y, 32);
                if (q == 0) YR[t * 64 + vrow] = y; } }
        __syncthreads();
        if (c > 0 || b == 0) {
#pragma unroll 1
            for (int rep = 0; rep < 2; ++rep) { const int t = wave + 8 * rep; const float yv = YR[t * 64 + lane];
                const float mean = wave_sum(yv) * (1.0f / 64.0f); const float d = yv - mean; const float var = wave_sum(d * d) * (1.0f / 64.0f);
                const float yn = d * __builtin_amdgcn_rsqf(var + LNX_EPS) * lnw + lnb;
                const float o = (yn + BON[t] * Vm[t * 64 + lane]) * Gm[t * 64 + lane];
                Y[(size_t)(row0 + t) * DM + hj] = (bf16_t)(pk_bf16(o, 0.f) & 0xffffu); } }
        __syncthreads();
    }
}

typedef short bf16x8_t __attribute__((ext_vector_type(8)));
typedef short bf16x4_t __attribute__((ext_vector_type(4)));
namespace rk {
constexpr int RAW0 = 0, RAW1 = 30720, LXB = 61440, RS = 70656, KS = 74752, VS = 78848, KKN = 82944, ATP = 87040, RTP = 89088, BTP = 91136, KTP = 93184,
              BHT = 95232, KHT = 97280, VT = 99328, GT = 101376, AAB = 101632, AAK = 102656, RB = 103168, RKM = 103680, TINV = 104192, GG = 104704, YR = 108800, BONP = 112896, LDS_END = 113152;
}
__device__ __forceinline__ bf16_t bf1(float x) { return (bf16_t)(pk_bf16(x, 0.f) & 0xffffu); }
__device__ __forceinline__ bf16x4_t pack4(float a, float b, float c, float d) { u32x2 w; w.x = pk_bf16(a, b); w.y = pk_bf16(c, d); return __builtin_bit_cast(bf16x4_t, w); }
__device__ __forceinline__ float fast_sigmoid(float x) { return __builtin_amdgcn_rcpf(1.0f + __expf(-x)); }
__device__ __forceinline__ float fast_tanh(float x) { return 1.0f - 2.0f * __builtin_amdgcn_rcpf(__expf(2.0f * x) + 1.0f); }

__device__ __forceinline__ void rwkv_chunked(PP P, int l, int b, int h, LAS unsigned char* lds) {
    using namespace cfg;
    const int tid = ltid(), lane = tid & 63, wave = __builtin_amdgcn_readfirstlane(tid >> 6), n = lane & 15, g = lane >> 4;
    const bf16_t* PR = (const bf16_t*)(P->ws + WS_PR); const float* PS = (const float*)(P->ws + WS_PS); bf16_t* Y = (bf16_t*)(P->ws + WS_Y);
    const float* mu = P->in[I_MU] + l * RWKV_COLS;
    LAS float* RSm = (LAS float*)(lds + rk::RS); LAS float* KSm = (LAS float*)(lds + rk::KS); LAS float* VSm = (LAS float*)(lds + rk::VS); LAS float* KKNm = (LAS float*)(lds + rk::KKN);
    LAS bf16_t* LXB = (LAS bf16_t*)(lds + rk::LXB);
    LAS bf16_t* ATp = (LAS bf16_t*)(lds + rk::ATP); LAS bf16_t* RTp = (LAS bf16_t*)(lds + rk::RTP); LAS bf16_t* BTp = (LAS bf16_t*)(lds + rk::BTP); LAS bf16_t* KTp = (LAS bf16_t*)(lds + rk::KTP);
    LAS bf16_t* BHt = (LAS bf16_t*)(lds + rk::BHT); LAS bf16_t* KHt = (LAS bf16_t*)(lds + rk::KHT); LAS bf16_t* Vt = (LAS bf16_t*)(lds + rk::VT);
    LAS float* GTm = (LAS float*)(lds + rk::GT); LAS float* AABm = (LAS float*)(lds + rk::AAB);
    LAS bf16_t* AAKm = (LAS bf16_t*)(lds + rk::AAK); LAS bf16_t* RBm = (LAS bf16_t*)(lds + rk::RB); LAS bf16_t* RKm = (LAS bf16_t*)(lds + rk::RKM); LAS bf16_t* TINVm = (LAS bf16_t*)(lds + rk::TINV);
    LAS float* Gm = (LAS float*)(lds + rk::GG); LAS float* YRm = (LAS float*)(lds + rk::YR); LAS float* BONP = (LAS float*)(lds + rk::BONP);
    const int hj = h * 64 + lane;
    const float mur = mu[hj], muk = mu[1024 + hj], muv = mu[2048 + hj], kkw = P->in[I_KK][l * RW + hj], lnw = P->in[I_LNW][l * RW + hj], lnb = P->in[I_LNB][l * RW + hj];
    float mul[5];
#pragma unroll
    for (int q = 0; q < 5; ++q) mul[q] = (lane + 64 * q < 288) ? mu[3072 + lane + 64 * q] : 0.f;
    const int kw = wave & 3, key = 16 * kw + n, hk = h * 64 + key;
    const float w0k = P->in[I_W0][l * RW + hk], a0k = P->in[I_A0][l * RW + hk], kak = P->in[I_KA][l * RW + hk], rkk = P->in[I_RK][l * RW + hk];
    const int pp = 32 * (key >> 5) + 8 * ((key >> 2) & 3) + 4 * ((key >> 4) & 1) + (key & 3);
    bf16x8_t fA[2], fB[5];
    {
        const float* wu = P->in[I_WUP] + (size_t)l * 64 * RW + hk; const float* au = P->in[I_AUP] + (size_t)l * 64 * RW + hk; const float* gu = P->in[I_GUP] + (size_t)l * 160 * RW + hk;
#pragma unroll
        for (int s = 0; s < 5; ++s) { float v[8], u[8];
#pragma unroll
            for (int j = 0; j < 8; ++j) { const int k = 32 * s + 8 * g + j; v[j] = (wave < 4) ? (s < 2 ? au[(size_t)k * RW] : 0.f) : gu[(size_t)k * RW]; u[j] = (wave < 4 && s < 2) ? wu[(size_t)k * RW] : 0.f; }
            u32x4 w; w.x = pk_bf16(v[0], v[1]); w.y = pk_bf16(v[2], v[3]); w.z = pk_bf16(v[4], v[5]); w.w = pk_bf16(v[6], v[7]); fB[s] = __builtin_bit_cast(bf16x8_t, w);
            if (s < 2) { u32x4 x; x.x = pk_bf16(u[0], u[1]); x.y = pk_bf16(u[2], u[3]); x.z = pk_bf16(u[4], u[5]); x.w = pk_bf16(u[6], u[7]); fA[s] = __builtin_bit_cast(bf16x8_t, x); } }
    }
    f32x4 ST[4];
#pragma unroll
    for (int kb = 0; kb < 4; ++kb) ST[kb] = (f32x4){0.f, 0.f, 0.f, 0.f};
    const int rrow = tid / 24, rseg = (tid % 24) >> 3, rpart = tid & 7;
    u32x4 pre0 = (u32x4){0u, 0u, 0u, 0u}; f32x4 pf[3];
#define RK_LOAD(c_) do { const int row0_ = ((c_) == 0) ? MMAIN : b * SEQ + ((c_) - 1) * 16; \
        if (tid < 384) pre0 = *(const u32x4*)(PR + (size_t)(row0_ + rrow) * PRW + rseg * 1024 + h * 64 + rpart * 8); \
        _Pragma("unroll") for (int i_ = 0; i_ < 3; ++i_) { const int x_ = tid + 512 * i_; if (x_ < 1152) pf[i_] = *(const f32x4*)(PS + (size_t)(row0_ + x_ / 72) * PSW + (x_ % 72) * 4); } } while (0)
#define RK_STORE(buf_) do { LAS float* d_ = (LAS float*)(lds + (buf_)); \
        if (tid < 384) { LAS float* q_ = d_ + rrow * 480 + rseg * 64 + rpart * 8; \
            *(LAS f32x4*)q_ = (f32x4){__uint_as_float(pre0.x << 16), __uint_as_float(pre0.x & 0xffff0000u), __uint_as_float(pre0.y << 16), __uint_as_float(pre0.y & 0xffff0000u)}; \
            *(LAS f32x4*)(q_ + 4) = (f32x4){__uint_as_float(pre0.z << 16), __uint_as_float(pre0.z & 0xffff0000u), __uint_as_float(pre0.w << 16), __uint_as_float(pre0.w & 0xffff0000u)}; } \
        _Pragma("unroll") for (int i_ = 0; i_ < 3; ++i_) { const int x_ = tid + 512 * i_; if (x_ < 1152) *(LAS f32x4*)(d_ + (x_ / 72) * 480 + 192 + (x_ % 72) * 4) = pf[i_]; } } while (0)
    RK_LOAD(0);
    for (int e = tid; e < 480; e += 512) ((LAS float*)(lds + rk::RAW1))[15 * 480 + e] = 0.f;
    RK_STORE(rk::RAW0);
    __syncthreads();
#pragma unroll 1
    for (int c = 0; c < 257; ++c) {
        const int row0 = (c == 0) ? MMAIN : b * SEQ + (c - 1) * 16;
        LAS const float* cur = (LAS const float*)(lds + ((c & 1) ? rk::RAW1 : rk::RAW0)); LAS const float* oth = (LAS const float*)(lds + ((c & 1) ? rk::RAW0 : rk::RAW1));
        if (c + 1 < 257) RK_LOAD(c + 1);
#pragma unroll
        for (int rep = 0; rep < 2; ++rep) { const int t = wave + 8 * rep;
            LAS const float* ct = cur + t * 480; LAS const float* pt = (t == 0) ? oth + 15 * 480 : cur + (t - 1) * 480;
            const float rc = ct[lane], kc = ct[64 + lane], vc = ct[128 + lane];
            const float rs = rc + (pt[lane] - rc) * mur, ks = kc + (pt[64 + lane] - kc) * muk, vs = vc + (pt[128 + lane] - vc) * muv;
            RSm[t * 64 + lane] = rs; KSm[t * 64 + lane] = ks; VSm[t * 64 + lane] = vs;
            const float kkr = ks * kkw; const float n2 = wave_sum(kkr * kkr); KKNm[t * 64 + lane] = kkr / fmaxf(sqrtf(n2), 1e-12f);
#pragma unroll
            for (int q = 0; q < 5; ++q) { const int i = lane + 64 * q; if (i < 288) { const float xc = ct[192 + i]; const float x = xc + (pt[192 + i] - xc) * mul[q];
                    LXB[t * 288 + i] = bf1(q == 0 ? fast_tanh(x) : (q == 1 ? x : fast_sigmoid(x))); } } }
        __syncthreads();
        if (wave < 4) {
            f32x4 accW = (f32x4){0.f, 0.f, 0.f, 0.f}, accA = accW;
#pragma unroll
            for (int s = 0; s < 2; ++s) { const bf16x8_t aw = *(const LAS bf16x8_t*)(LXB + n * 288 + 32 * s + 8 * g), aa = *(const LAS bf16x8_t*)(LXB + n * 288 + 64 + 32 * s + 8 * g);
                accW = __builtin_amdgcn_mfma_f32_16x16x32_bf16(aw, fA[s], accW, 0, 0, 0); accA = __builtin_amdgcn_mfma_f32_16x16x32_bf16(aa, fB[s], accA, 0, 0, 0); }
            float lw[4], alr[4], pfx[4];
#pragma unroll
            for (int r = 0; r < 4; ++r) { lw[r] = -0.6065306597126334f * fast_sigmoid(accW[r] + w0k); alr[r] = fast_sigmoid(accA[r] + a0k); }
            pfx[0] = lw[0]; pfx[1] = pfx[0] + lw[1]; pfx[2] = pfx[1] + lw[2]; pfx[3] = pfx[2] + lw[3];
            const float t0 = __shfl(pfx[3], n), t1 = __shfl(pfx[3], n + 16), t2 = __shfl(pfx[3], n + 32), t3 = __shfl(pfx[3], n + 48);
            const float base = (g > 0 ? t0 : 0.f) + (g > 1 ? t1 : 0.f) + (g > 2 ? t2 : 0.f), lamT = (t0 + t1) + (t2 + t3);
            float bh[4], kh[4], bon[4];
#pragma unroll
            for (int r = 0; r < 4; ++r) { const int t = 4 * g + r; const float lam = base + pfx[r];
                const float e_pos = __expf(lam), e_neg = __expf(-lam), e_prev = __expf(lam - lw[r]), e_hat = __expf(lamT - lam);
                const float rs = RSm[t * 64 + key], ks = KSm[t * 64 + key], kk = KKNm[t * 64 + key];
                const float kmod = ks * (1.0f + (alr[r] - 1.0f) * kak), bb = kk * alr[r];
                ATp[t * 64 + pp] = bf1(-kk * e_prev); RTp[t * 64 + pp] = bf1(rs * e_pos); BTp[t * 64 + pp] = bf1(bb * e_neg); KTp[t * 64 + pp] = bf1(kmod * e_neg);
                bh[r] = bb * e_hat; kh[r] = kmod * e_hat; bon[r] = rs * kmod * rkk; }
            *(LAS bf16x4_t*)(BHt + key * 16 + 4 * g) = pack4(bh[0], bh[1], bh[2], bh[3]); *(LAS bf16x4_t*)(KHt + key * 16 + 4 * g) = pack4(kh[0], kh[1], kh[2], kh[3]);
#pragma unroll
            for (int r = 0; r < 4; ++r) { float x = bon[r]; x += __shfl_xor(x, 1); x += __shfl_xor(x, 2); x += __shfl_xor(x, 4); x += __shfl_xor(x, 8); if (n == 0) BONP[kw * 16 + 4 * g + r] = x; }
            if (g == 0) GTm[key] = __expf(lamT);
        } else {
            f32x4 accG = (f32x4){0.f, 0.f, 0.f, 0.f};
#pragma unroll
            for (int s = 0; s < 5; ++s) { const bf16x8_t ag = *(const LAS bf16x8_t*)(LXB + n * 288 + 128 + 32 * s + 8 * g); accG = __builtin_amdgcn_mfma_f32_16x16x32_bf16(ag, fB[s], accG, 0, 0, 0); }
#pragma unroll
            for (int r = 0; r < 4; ++r) Gm[(4 * g + r) * 64 + key] = accG[r];
            *(LAS bf16x4_t*)(Vt + key * 16 + 4 * g) = pack4(VSm[(4 * g) * 64 + key], VSm[(4 * g + 1) * 64 + key], VSm[(4 * g + 2) * 64 + key], VSm[(4 * g + 3) * 64 + key]);
        }
        __syncthreads();
        if (wave < 4) {
            LAS const bf16_t* X = (wave < 2) ? ATp : RTp; LAS const bf16_t* Yi = (wave & 1) ? KTp : BTp;
            f32x4 acc = (f32x4){0.f, 0.f, 0.f, 0.f};
#pragma unroll
            for (int s = 0; s < 2; ++s) { const bf16x8_t xa = *(const LAS bf16x8_t*)(X + n * 64 + 32 * s + 8 * g), yb = *(const LAS bf16x8_t*)(Yi + n * 64 + 32 * s + 8 * g);
                acc = __builtin_amdgcn_mfma_f32_16x16x32_bf16(xa, yb, acc, 0, 0, 0); }
#pragma unroll
            for (int r = 0; r < 4; ++r) { const int t = 4 * g + r; const bool keep = (wave < 2) ? (n < t) : (n <= t); const float val = keep ? acc[r] : 0.f;
                if (wave == 0) AABm[t * 16 + n] = val; else if (wave == 1) AAKm[t * 16 + n] = bf1(val); else if (wave == 2) RBm[t * 16 + n] = bf1(val); else RKm[t * 16 + n] = bf1(val); }
            if (wave == 0) {
                asm volatile("s_waitcnt lgkmcnt(0)" ::: "memory");
                float Tc[16];
#pragma unroll
                for (int t = 0; t < 16; ++t) { float a[16];
#pragma unroll
                    for (int q = 0; q < 4; ++q) { const f32x4 v = *(const LAS f32x4*)(AABm + t * 16 + 4 * q); a[4 * q] = v[0]; a[4 * q + 1] = v[1]; a[4 * q + 2] = v[2]; a[4 * q + 3] = v[3]; }
                    float val = (t == n) ? 1.0f : 0.0f;
#pragma unroll
                    for (int i = 0; i < t; ++i) val += a[i] * Tc[i];
                    Tc[t] = val; }
                if (g == 0) {
#pragma unroll
                    for (int t = 0; t < 16; ++t) TINVm[t * 16 + n] = bf1(Tc[t]); }
            }
        }
        __syncthreads();
        if (wave < 4) {
            bf16x8_t sb[2];
#pragma unroll
            for (int s = 0; s < 2; ++s) { u32x4 w; w.x = pk_bf16(ST[2 * s][0], ST[2 * s][1]); w.y = pk_bf16(ST[2 * s][2], ST[2 * s][3]); w.z = pk_bf16(ST[2 * s + 1][0], ST[2 * s + 1][1]); w.w = pk_bf16(ST[2 * s + 1][2], ST[2 * s + 1][3]);
                sb[s] = __builtin_bit_cast(bf16x8_t, w); }
            const bf16x4_t vfr = *(const LAS bf16x4_t*)(Vt + key * 16 + 4 * g);
            f32x4 W1 = (f32x4){0.f, 0.f, 0.f, 0.f}, Yc = W1;
#pragma unroll
            for (int s = 0; s < 2; ++s) { const bf16x8_t af = *(const LAS bf16x8_t*)(ATp + n * 64 + 32 * s + 8 * g), rf = *(const LAS bf16x8_t*)(RTp + n * 64 + 32 * s + 8 * g);
                W1 = __builtin_amdgcn_mfma_f32_16x16x32_bf16(af, sb[s], W1, 0, 0, 0); Yc = __builtin_amdgcn_mfma_f32_16x16x32_bf16(rf, sb[s], Yc, 0, 0, 0); }
            W1 = __builtin_amdgcn_mfma_f32_16x16x16bf16_1k(*(const LAS bf16x4_t*)(AAKm + n * 16 + 4 * g), vfr, W1, 0, 0, 0);
            const bf16x4_t w1f = pack4(W1[0], W1[1], W1[2], W1[3]);
            f32x4 U = __builtin_amdgcn_mfma_f32_16x16x16bf16_1k(*(const LAS bf16x4_t*)(TINVm + n * 16 + 4 * g), w1f, (f32x4){0.f, 0.f, 0.f, 0.f}, 0, 0, 0);
            const bf16x4_t uf = pack4(U[0], U[1], U[2], U[3]);
            Yc = __builtin_amdgcn_mfma_f32_16x16x16bf16_1k(*(const LAS bf16x4_t*)(RBm + n * 16 + 4 * g), uf, Yc, 0, 0, 0);
            Yc = __builtin_amdgcn_mfma_f32_16x16x16bf16_1k(*(const LAS bf16x4_t*)(RKm + n * 16 + 4 * g), vfr, Yc, 0, 0, 0);
#pragma unroll
            for (int r = 0; r < 4; ++r) YRm[(4 * g + r) * 64 + key] = Yc[r];
#pragma unroll
            for (int kb = 0; kb < 4; ++kb) { const f32x4 gt = *(const LAS f32x4*)(GTm + 16 * kb + 4 * g); f32x4 a = ST[kb] * gt;
                a = __builtin_amdgcn_mfma_f32_16x16x16bf16_1k(*(const LAS bf16x4_t*)(BHt + (16 * kb + n) * 16 + 4 * g), uf, a, 0, 0, 0);
                a = __builtin_amdgcn_mfma_f32_16x16x16bf16_1k(*(const LAS bf16x4_t*)(KHt + (16 * kb + n) * 16 + 4 * g), vfr, a, 0, 0, 0);
                ST[kb] = a; }
        }
        __syncthreads();
        if (c + 1 < 257) RK_STORE((c & 1) ? rk::RAW0 : rk::RAW1);
        if (c > 0 || b == 0) {
#pragma unroll
            for (int rep = 0; rep < 2; ++rep) { const int t = wave + 8 * rep; const float yv = YRm[t * 64 + lane];
                const float mean = wave_sum(yv) * (1.0f / 64.0f); const float d = yv - mean; const float var = wave_sum(d * d) * (1.0f / 64.0f);
                const float yn = d * __builtin_amdgcn_rsqf(var + LNX_EPS) * lnw + lnb;
                const float bonus = (BONP[t] + BONP[16 + t]) + (BONP[32 + t] + BONP[48 + t]);
                const float o = (yn + bonus * VSm[t * 64 + lane]) * Gm[t * 64 + lane];
                Y[(size_t)(row0 + t) * DM + hj] = bf1(o); } }
        __syncthreads();
    }
#undef RK_LOAD
#undef RK_STORE
}

namespace fox {
constexpr int D = 128, NW = 8, QBLK = 32, KVBLK = 64, QB = NW * QBLK;
constexpr int LDQ = cfg::QKVW, LDK = cfg::QKVW, LDO = cfg::DM;
constexpr float SCALE = 0.08838834764831845f, THR = 8.f;
constexpr bool WSKIP = false;
constexpr int SHM_V = KVBLK * D * 2, SHM_K = KVBLK * D * 2;
constexpr int ATT_LDS = 2 * SHM_V + 2 * SHM_K + NW * 64 * 4;
constexpr int BIAS_OFF = ATT_LDS;
constexpr int SCAN_OFF = BIAS_OFF + cfg::SEQP * 4;

using bf16 = __hip_bfloat16;
typedef short bf16x8 __attribute__((ext_vector_type(8)));
typedef short s16x4 __attribute__((ext_vector_type(4)));
typedef float f32x16 __attribute__((ext_vector_type(16)));
typedef float f32x4 __attribute__((ext_vector_type(4)));
typedef unsigned u32x4 __attribute__((ext_vector_type(4)));
template <class A, class Bt> struct same_t { static constexpr bool v = false; };
template <class A> struct same_t<A, A> { static constexpr bool v = true; };

#define KSWZ(row, colB) ((row) * 256 + ((colB) ^ (((row) & 7) << 4)))
#define SBAR() __builtin_amdgcn_sched_barrier(0)
__device__ __forceinline__ int v_st(int k, int c) { const int kk = (k & ~0xC) | ((k & 4) << 1) | ((k & 8) >> 1); return ((kk >> 3) * 4 + (c >> 5)) * 512 + ((kk & 7) * 32 + (c & 31)) * 2; }
__device__ __forceinline__ int v_rd_base(int lane) { return ((lane & 3) << 3) | (((lane >> 2) & 3) << 6) | (((lane >> 4) & 1) << 5) | (((lane >> 5) & 1) << 8); }
constexpr int v_rd_off(int d0, int ks, int half) { return d0 * 512 + ks * 4096 + half * 2048; }
__device__ __forceinline__ int crow(int r, int hi) { return (r & 3) + 8 * (r >> 2) + 4 * hi; }
__device__ __forceinline__ unsigned cvtpk(float lo, float hi) {
    unsigned r; asm volatile("v_cvt_pk_bf16_f32 %0, %1, %2" : "=v"(r) : "v"(lo), "v"(hi)); return r;
}
__device__ __forceinline__ bf16x8 pack8(f32x4 a, f32x4 b) {
    u32x4 w = {cvtpk(a[0], a[1]), cvtpk(a[2], a[3]), cvtpk(b[0], b[1]), cvtpk(b[2], b[3])};
    return *reinterpret_cast<bf16x8*>(&w);
}
template <class T> __device__ __forceinline__ bf16x8 load8(const T* p) {
    if constexpr (same_t<T, float>::v) { return pack8(*(const f32x4*)p, *(const f32x4*)(p + 4)); }
    else { return *reinterpret_cast<const bf16x8*>(p); }
}
__device__ __forceinline__ void mask_tile(f32x16& p0, f32x16& p1, int dq, unsigned W) {
    const float NEG = -__builtin_inff();
#pragma unroll
    for (int r = 0; r < 16; ++r) {
        const int c = (r & 3) + 8 * (r >> 2);
        if ((unsigned)(dq - c) >= W) p0[r] = NEG;
        if ((unsigned)(dq - c - 32) >= W) p1[r] = NEG;
    }
}
__device__ __forceinline__ void partialSM(f32x16& p0, f32x16& p1, float& m_reg, float& mn, float& alpha) {
    float pmax = p0[0]; for (int r = 1; r < 16; ++r) pmax = fmaxf(pmax, p0[r]); for (int r = 0; r < 16; ++r) pmax = fmaxf(pmax, p1[r]);
    { auto rr = __builtin_amdgcn_permlane32_swap(__float_as_uint(pmax), __float_as_uint(pmax), false, false);
      pmax = fmaxf(__uint_as_float(rr[0]), __uint_as_float(rr[1])); }
    constexpr float C2 = 1.4426950408889634f * SCALE;
    if (__builtin_expect(__all((pmax - m_reg) * SCALE <= THR), 1)) { mn = m_reg; alpha = 1.f; }
    else { mn = fmaxf(m_reg, pmax); alpha = __builtin_amdgcn_exp2f((m_reg - mn) * C2); m_reg = mn; }
    const float mnL = -mn * C2;
    for (int r = 0; r < 16; ++r) p0[r] = fmaf(p0[r], C2, mnL); for (int r = 0; r < 16; ++r) p1[r] = fmaf(p1[r], C2, mnL);
    for (int r = 0; r < 16; ++r) p0[r] = __builtin_amdgcn_exp2f(p0[r]);
}
__device__ __forceinline__ void finishSM(f32x16& p0, f32x16& p1, float alpha, float& l_reg, bf16x8& pa0, bf16x8& pa1, bf16x8& pa2, bf16x8& pa3) {
    for (int r = 0; r < 16; ++r) p1[r] = __builtin_amdgcn_exp2f(p1[r]);
    float ps = 0; for (int r = 0; r < 16; ++r) ps += p0[r]; for (int r = 0; r < 16; ++r) ps += p1[r];
    { auto rr = __builtin_amdgcn_permlane32_swap(__float_as_uint(ps), __float_as_uint(ps), false, false);
      ps = __uint_as_float(rr[0]) + __uint_as_float(rr[1]); }
    l_reg = l_reg * alpha + ps;
#define PK4(P, B_, OUT) do { unsigned a0 = cvtpk(P[B_+0], P[B_+1]), a1 = cvtpk(P[B_+2], P[B_+3]);                          \
        unsigned b0 = cvtpk(P[B_+4], P[B_+5]), b1 = cvtpk(P[B_+6], P[B_+7]);                                             \
        auto r0 = __builtin_amdgcn_permlane32_swap(a0, b0, false, false); auto r1 = __builtin_amdgcn_permlane32_swap(a1, b1, false, false); \
        u32x4 w = {r0[0], r1[0], r0[1], r1[1]}; OUT = *reinterpret_cast<bf16x8*>(&w); } while (0)
    PK4(p0, 0, pa0); PK4(p0, 8, pa1); PK4(p1, 0, pa2); PK4(p1, 8, pa3);
#undef PK4
}
template <int KB, bool SK>
__device__ __forceinline__ void qkt(f32x16& p0, f32x16& p1, const char* K_lds, int r32, int hi, const bf16x8* qr, bool act, const float* bias_t) {
    if (SK && !act) { const float NEG = -__builtin_inff();
#pragma unroll
        for (int r = 0; r < 16; ++r) { p0[r] = NEG; p1[r] = NEG; } return; }
    {
#pragma unroll
        for (int g_ = 0; g_ < 4; ++g_) { const f32x4 b0_ = *(const f32x4*)(bias_t + 8 * g_ + 4 * hi); const f32x4 b1_ = *(const f32x4*)(bias_t + 32 + 8 * g_ + 4 * hi);
            p0[4 * g_] = b0_[0]; p0[4 * g_ + 1] = b0_[1]; p0[4 * g_ + 2] = b0_[2]; p0[4 * g_ + 3] = b0_[3];
            p1[4 * g_] = b1_[0]; p1[4 * g_ + 1] = b1_[1]; p1[4 * g_ + 2] = b1_[2]; p1[4 * g_ + 3] = b1_[3]; } }
    const char* kb[4];
#pragma unroll
    for (int dd = 0; dd < 4; ++dd) kb[dd] = K_lds + KB * SHM_K + KSWZ(r32, (dd * 16 + hi * 8) * 2);
#pragma unroll
    for (int d0 = 0; d0 < 8; ++d0) { const char* a = kb[d0 & 3] + (d0 >> 2) * 128;
        bf16x8 b0 = *reinterpret_cast<const bf16x8*>(a);
        bf16x8 b1 = *reinterpret_cast<const bf16x8*>(a + 32 * 256);
        p0 = __builtin_amdgcn_mfma_f32_32x32x16_bf16(b0, qr[d0], p0, 0, 0, 0);
        p1 = __builtin_amdgcn_mfma_f32_32x32x16_bf16(b1, qr[d0], p1, 0, 0, 0); }
}
template <int VB, bool SK>
__device__ __forceinline__ void pv_tile(f32x16* o, int vb0, bf16x8 pa0, bf16x8 pa1, bf16x8 pa2, bf16x8 pa3, bool act) {
    if (SK && !act) return;
#define TRRD(dst, off) asm volatile("ds_read_b64_tr_b16 %0, %1 offset:%2" : "=&v"(dst) : "v"(vb0), "i"(off) : "memory")
#define PV_D0(d0) do { s16x4 l0, l1, l2, l3, h0, h1, h2, h3; constexpr int b_ = VB * SHM_V + v_rd_off(d0, 0, 0);     \
        TRRD(l0, b_); TRRD(h0, b_ + 2048); TRRD(l1, b_ + 4096); TRRD(h1, b_ + 6144); TRRD(l2, b_ + 8192); TRRD(h2, b_ + 10240); TRRD(l3, b_ + 12288); TRRD(h3, b_ + 14336); \
        asm volatile("s_waitcnt lgkmcnt(0)" ::: "memory"); SBAR();                 \
        o[d0] = __builtin_amdgcn_mfma_f32_32x32x16_bf16(pa0, (bf16x8){l0[0], l0[1], l0[2], l0[3], h0[0], h0[1], h0[2], h0[3]}, o[d0], 0, 0, 0);   \
        o[d0] = __builtin_amdgcn_mfma_f32_32x32x16_bf16(pa1, (bf16x8){l1[0], l1[1], l1[2], l1[3], h1[0], h1[1], h1[2], h1[3]}, o[d0], 0, 0, 0);   \
        o[d0] = __builtin_amdgcn_mfma_f32_32x32x16_bf16(pa2, (bf16x8){l2[0], l2[1], l2[2], l2[3], h2[0], h2[1], h2[2], h2[3]}, o[d0], 0, 0, 0);   \
        o[d0] = __builtin_amdgcn_mfma_f32_32x32x16_bf16(pa3, (bf16x8){l3[0], l3[1], l3[2], l3[3], h3[0], h3[1], h3[2], h3[3]}, o[d0], 0, 0, 0); } while (0)
    PV_D0(0); PV_D0(1); PV_D0(2); PV_D0(3);
#undef PV_D0
#undef TRRD
}

template <class TIn, class TOut> struct BlockRef { const TIn* Q; const TIn* K; const TIn* V; TOut* O; int P0; };
template <class TIn> struct Seam {
    bf16x8 qr[8];
    bf16x8 st_v0, st_v1, st_k0, st_k1; f32x4 sf0, sf1, sf2, sf3;
    f32x4 tq[16];
};
__device__ __forceinline__ int swa_jlo(int P0, int W) { const int lowk = P0 - W + 1; return lowk > 0 ? lowk / KVBLK : 0; }
#define ROW(p, k0, rr) ((p) + (size_t)((k0) + (rr)) * LDK + sc)
#define VMW() asm volatile("s_waitcnt vmcnt(0)" ::: "memory")
#define VMWN(n) asm volatile("s_waitcnt vmcnt(%0)" :: "i"(n) : "memory")
#define SLOAD_H(Kp, Vp, k0) do { S.st_v0 = load8<TIn>(ROW(Vp, k0, sr)); S.st_v1 = load8<TIn>(ROW(Vp, k0, 32 + sr));              \
                         S.st_k0 = load8<TIn>(ROW(Kp, k0, sr)); S.st_k1 = load8<TIn>(ROW(Kp, k0, 32 + sr)); } while (0)
#define SWRITE_HK(bf) do { *(bf16x8*)(K_lds + (bf) * SHM_K + kws) = S.st_k0; *(bf16x8*)(K_lds + (bf) * SHM_K + kws + 32 * 256) = S.st_k1; } while (0)
#define SWRITE_HV(bf) do { *(bf16x8*)(V_lds + (bf) * SHM_V + vst0) = S.st_v0; *(bf16x8*)(V_lds + (bf) * SHM_V + vst1) = S.st_v1; } while (0)
#define SWRITE_H(bf) do { SWRITE_HV(bf); SWRITE_HK(bf); } while (0)
#define SLOAD_F(p, k0) do { S.sf0 = *(const f32x4*)ROW(p, k0, sr); S.sf1 = *(const f32x4*)(ROW(p, k0, sr) + 4);                \
                            S.sf2 = *(const f32x4*)ROW(p, k0, 32 + sr); S.sf3 = *(const f32x4*)(ROW(p, k0, 32 + sr) + 4); } while (0)
#define SWRITE_KF(bf) do { *(bf16x8*)(K_lds + (bf) * SHM_K + kws) = pack8(S.sf0, S.sf1); *(bf16x8*)(K_lds + (bf) * SHM_K + kws + 32 * 256) = pack8(S.sf2, S.sf3); } while (0)
#define SWRITE_VF(bf) do { *(bf16x8*)(V_lds + (bf) * SHM_V + vst0) = pack8(S.sf0, S.sf1); *(bf16x8*)(V_lds + (bf) * SHM_V + vst1) = pack8(S.sf2, S.sf3); } while (0)
template <class TIn, class TOut>
__device__ __forceinline__ void causal_swa_prime(const BlockRef<TIn, TOut>& cur, int W, char* lds, Seam<TIn>& S) {
    constexpr bool F32 = same_t<TIn, float>::v;
    const int tid = ltid(), wid = __builtin_amdgcn_readfirstlane(tid >> 6), lane = tid & 63, r32 = lane & 31, hi = lane >> 5;
    const int sr = tid >> 4, sc = (tid & 15) * 8, kws = KSWZ(sr, sc * 2); char* K_lds = lds + 2 * SHM_V;
    const int kb0 = swa_jlo(cur.P0, W) * KVBLK;
    for (int d0 = 0; d0 < 8; ++d0) S.qr[d0] = load8<TIn>(cur.Q + (size_t)(wid * QBLK + r32) * LDQ + d0 * 16 + hi * 8);
    if constexpr (F32) { SLOAD_F((const float*)cur.K, kb0); VMW(); SWRITE_KF(0); SBAR(); SLOAD_F((const float*)cur.V, kb0); }
    else { SLOAD_H(cur.K, cur.V, kb0); VMW(); SWRITE_HK(0); }
    __syncthreads();
}
template <class TIn, class TOut>
__device__ __forceinline__ void causal_swa_block(const BlockRef<TIn, TOut>& cur, const BlockRef<TIn, TOut>& nxt, int skv, int W, char* lds, Seam<TIn>& S, const float* bias_l) {
    constexpr bool F32 = same_t<TIn, float>::v;
    const int tid = ltid(), wid = __builtin_amdgcn_readfirstlane(tid >> 6), lane = tid & 63, r32 = lane & 31, hi = lane >> 5;
    const int j_lo = swa_jlo(cur.P0, W);
    int j_hi = (cur.P0 + QB - 1) / KVBLK + 1; if (j_hi > skv / KVBLK) j_hi = skv / KVBLK;
    const int NT = j_hi - j_lo;
    const int kbn = swa_jlo(nxt.P0, W) * KVBLK;
    const int qlo = cur.P0 + wid * QBLK, qm = qlo + r32 - 4 * hi;
    char* V_lds = lds; char* K_lds = lds + 2 * SHM_V;
    float* ws = (float*)(lds + 2 * SHM_V + 2 * SHM_K) + wid * 64; float* li_l = ws, * al_l = ws + 32;
    float m_reg = -1e30f, l_reg = 0; f32x16 o[4] = {};
    const int sr = tid >> 4, sc = (tid & 15) * 8, vst0 = v_st(sr, sc), vst1 = v_st(32 + sr, sc), kws = KSWZ(sr, sc * 2);
    const int vb0 = (int)(uintptr_t)V_lds + v_rd_base(lane);
    const TIn* Kh = cur.K; const TIn* Vh = cur.V;
#define RESC(a) do { if (__any((a) < 1.f)) { if (hi == 0) al_l[r32] = (a); asm volatile("s_waitcnt lgkmcnt(0)" ::: "memory");              \
                     for (int d_ = 0; d_ < 4; ++d_) for (int r = 0; r < 16; ++r) o[d_][r] *= al_l[crow(r, hi)]; } } while (0)
#define KBASE(t) ((j_lo + (t)) * KVBLK)
#define ACT(t) (KBASE(t) <= qlo + QBLK - 1 && KBASE(t) + KVBLK - 1 >= qlo - W + 1)
#define MASKT(P0_, P1_, t) do { const int kb_ = KBASE(t); if ((!SK || ACT(t)) && (kb_ + KVBLK - 1 > qlo || kb_ <= qlo + QBLK - 1 - W)) mask_tile(P0_, P1_, qm - kb_, (unsigned)W); } while (0)
    constexpr int NQL = F32 ? 16 : 8;
    constexpr bool SK = WSKIP && !F32;
#define SEAM_K0() do { VMWN(NQL); if constexpr (F32) { SWRITE_KF(0); SBAR(); SLOAD_F((const float*)nxt.V, kbn); } else { SWRITE_HK(0); } SBAR(); } while (0)
    f32x16 pA0, pA1, pB0, pB1; float mnA, mnB, alA, alB; bf16x8 pa0, pa1, pa2, pa3;
    if constexpr (F32) { VMW(); SWRITE_VF(0); SBAR(); } else { SWRITE_HV(0); SBAR(); }
    if (NT > 1) { if constexpr (F32) SLOAD_F((const float*)Kh, KBASE(1)); else SLOAD_H(Kh, Vh, KBASE(1)); }
    SBAR(); qkt<0, SK>(pA0, pA1, K_lds, r32, hi, S.qr, ACT(0), bias_l + KBASE(0));
    if constexpr (F32) { if (NT > 1) { VMW(); SWRITE_KF(1); SBAR(); SLOAD_F((const float*)Vh, KBASE(1)); } }
    MASKT(pA0, pA1, 0); partialSM(pA0, pA1, m_reg, mnA, alA);
    if (NT > 1) { VMW(); if constexpr (F32) { SWRITE_VF(1); SBAR(); if (NT > 2) SLOAD_F((const float*)Kh, KBASE(2)); } else SWRITE_H(1); }
    __syncthreads();
#define HALF_STEP(PX0, PX1, mnX, alX, PY0, PY1, alY, t, KB, VB, SB) do {                                                      \
        SBAR(); qkt<KB, SK>(PX0, PX1, K_lds, r32, hi, S.qr, ACT(t), bias_l + KBASE(t));                                             \
        finishSM(PY0, PY1, alY, l_reg, pa0, pa1, pa2, pa3); SBAR();                                                           \
        if ((t) + 1 < NT) { if constexpr (F32) { VMW(); SWRITE_KF(SB); SBAR(); SLOAD_F((const float*)Vh, KBASE((t) + 1)); }  \
                            else { SLOAD_H(Kh, Vh, KBASE((t) + 1)); } SBAR(); }                                               \
        pv_tile<VB, SK>(o, vb0, pa0, pa1, pa2, pa3, ACT((t) - 1)); MASKT(PX0, PX1, (t)); partialSM(PX0, PX1, m_reg, mnX, alX);                                        \
        __syncthreads();                                                                                                      \
        if ((t) + 1 < NT) { VMW(); if constexpr (F32) { SWRITE_VF(SB); SBAR(); if ((t) + 2 < NT) SLOAD_F((const float*)Kh, KBASE((t) + 2)); } \
                            else { SWRITE_H(SB); } }                                                                          \
        RESC(alX); __syncthreads(); } while (0)
    for (int t = 1; t + 1 < NT; t += 2) {
        HALF_STEP(pB0, pB1, mnB, alB, pA0, pA1, alA, t, 1, 0, 0);
        HALF_STEP(pA0, pA1, mnA, alA, pB0, pB1, alB, t + 1, 0, 1, 1);
    }
    const bool even = (NT & 1) == 0;
    if (even) { SBAR(); qkt<1, SK>(pB0, pB1, K_lds, r32, hi, S.qr, ACT(NT - 1), bias_l + KBASE(NT - 1)); SBAR(); }
#define QROW(e) (nxt.Q + (size_t)(wid * QBLK + r32) * LDQ + ((e) >> 1) * 16 + hi * 8 + ((e) & 1) * 4)
    if constexpr (F32) { SLOAD_F((const float*)nxt.K, kbn); SBAR();
#pragma unroll
        for (int e = 0; e < 8; ++e) S.tq[e] = *(const f32x4*)QROW(e); }
    else { SLOAD_H(nxt.K, nxt.V, kbn); SBAR();
#pragma unroll
        for (int d0 = 0; d0 < 8; ++d0) S.qr[d0] = load8<TIn>(nxt.Q + (size_t)(wid * QBLK + r32) * LDQ + d0 * 16 + hi * 8); }
    SBAR();
    finishSM(pA0, pA1, alA, l_reg, pa0, pa1, pa2, pa3); SBAR();
    if constexpr (F32) {
#pragma unroll
        for (int e = 8; e < 16; ++e) S.tq[e] = *(const f32x4*)QROW(e); SBAR(); }
#undef QROW
    pv_tile<0, SK>(o, vb0, pa0, pa1, pa2, pa3, ACT(even ? NT - 2 : NT - 1));
    if (even) { MASKT(pB0, pB1, NT - 1); partialSM(pB0, pB1, m_reg, mnB, alB); __syncthreads(); RESC(alB);
        finishSM(pB0, pB1, alB, l_reg, pa0, pa1, pa2, pa3); SBAR(); pv_tile<1, SK>(o, vb0, pa0, pa1, pa2, pa3, ACT(NT - 1)); }
    SBAR(); SEAM_K0();
    if (hi == 0) li_l[r32] = l_reg; asm volatile("s_waitcnt lgkmcnt(0)" ::: "memory");
    float rli[16];
#pragma unroll
    for (int r = 0; r < 16; ++r) rli[r] = __builtin_amdgcn_rcpf(li_l[crow(r, hi)]);
    TOut* Ow = cur.O + (size_t)(wid * QBLK) * LDO;
#pragma unroll
    for (int r = 0; r < 16; ++r) { const int orow = crow(r, hi);
#pragma unroll
        for (int d0 = 0; d0 < 4; ++d0) { const float v = o[d0][r] * rli[r];
            if constexpr (same_t<TOut, float>::v) { Ow[(size_t)orow * LDO + d0 * 32 + r32] = v; }
            else { const float vn = __shfl_xor(v, 1);
                   if ((r32 & 1) == 0) *(unsigned*)(Ow + (size_t)orow * LDO + d0 * 32 + r32) = cvtpk(v, vn); } } }
    if constexpr (F32) {
#pragma unroll
        for (int d0 = 0; d0 < 8; ++d0) S.qr[d0] = pack8(S.tq[2 * d0], S.tq[2 * d0 + 1]); }
    __syncthreads();
#undef RESC
#undef KBASE
#undef ACT
#undef MASKT
#undef SEAM_K0
#undef HALF_STEP
}
#undef ROW
#undef VMW
#undef VMWN
#undef SLOAD_H
#undef SWRITE_HK
#undef SWRITE_HV
#undef SWRITE_H
#undef SLOAD_F
#undef SWRITE_KF

}

__device__ __forceinline__ void fox_bias(PP P, int l, int b, int h, float* bias, float* scr) {
    using namespace cfg;
    const int tid = ltid(), lane = tid & 63, wave = tid >> 6;
    const float* PS = (const float*)(P->ws + WS_PS); const float bf = P->in[I_BF][l * FNH + h];
    float lf[9]; float loc = 0.f;
#pragma unroll
    for (int i = 0; i < 9; ++i) { const int pos = tid * 9 + i; float v = 0.f;
        if (pos < NMETA + SEQ) { const int row = pos < NMETA ? MMAIN + pos : b * SEQ + pos - NMETA; const float z = PS[(size_t)row * PSW + 288 + h] + bf;
            v = fminf(z, 0.f) - log1pf(__expf(-fabsf(z))); }
        loc += v; lf[i] = loc; }
    float inc = loc;
#pragma unroll
    for (int o = 1; o < 64; o <<= 1) { const float t = __shfl_up(inc, o); if (lane >= o) inc += t; }
    if (lane == 63) scr[wave] = inc;
    __syncthreads();
    float base = inc - loc;
    for (int w = 0; w < wave; ++w) base += scr[w];
    constexpr float INV = 1.0f / fox::SCALE;
#pragma unroll
    for (int i = 0; i < 9; ++i) { const int pos = tid * 9 + i; if (pos < NMETA + SEQ) bias[48 + pos] = -(base + lf[i]) * INV; }
    if (tid < 48) bias[tid] = -__builtin_inff();
    __syncthreads();
}
__device__ __forceinline__ void fox_meta(PP P, int h, const float* bias) {
    using namespace cfg;
    const int lane = ltid() & 63, wave = ltid() >> 6;
    const bf16_t* QKV = (const bf16_t*)(P->ws + WS_QKV); bf16_t* Y = (bf16_t*)(P->ws + WS_Y);
    for (int rep = 0; rep < 2; ++rep) { const int i = wave + 8 * rep;
        float s = -__builtin_inff();
        if (lane <= i) { const bf16_t* q = QKV + (size_t)(48 + i) * QKVW + h * 128; const bf16_t* k = QKV + (size_t)(48 + lane) * QKVW + 1024 + h * 128; float dot = 0.f;
            for (int d = 0; d < 128; ++d) dot += bf2f(q[d]) * bf2f(k[d]);
            s = (dot + bias[48 + lane]) * fox::SCALE; }
        const float m = wave_max(s); const float p = (lane <= i) ? __expf(s - m) : 0.f; const float lsum = wave_sum(p);
        float o0 = 0.f, o1 = 0.f;
        for (int j = 0; j <= i; ++j) { const float pj = __shfl(p, j); const bf16_t* v = QKV + (size_t)(48 + j) * QKVW + 2048 + h * 128; o0 += pj * bf2f(v[lane]); o1 += pj * bf2f(v[64 + lane]); }
        const float il = 1.0f / lsum;
        Y[(size_t)(MMAIN + i) * DM + 1024 + h * 128 + lane] = (bf16_t)(pk_bf16(o0 * il, 0.f) & 0xffffu);
        Y[(size_t)(MMAIN + i) * DM + 1024 + h * 128 + 64 + lane] = (bf16_t)(pk_bf16(o1 * il, 0.f) & 0xffffu); }
}
__device__ __forceinline__ fox::BlockRef<__hip_bfloat16, __hip_bfloat16> fox_mk(int a, int idx, const __hip_bfloat16* Qb, const __hip_bfloat16* Kb, const __hip_bfloat16* Vb, __hip_bfloat16* Ob) {
    const int pr = 4 * (a & 1) + (idx >> 1); const int x = (idx & 1) ? 15 - pr : pr;
    fox::BlockRef<__hip_bfloat16, __hip_bfloat16> r; r.Q = Qb + (size_t)x * 256 * cfg::QKVW; r.K = Kb; r.V = Vb; r.O = Ob + (size_t)x * 256 * cfg::DM; r.P0 = 64 + 256 * x; return r; }
__device__ __forceinline__ void fox_wg(PP P, int l, int a, char* lds) {
    using namespace cfg;
    typedef __hip_bfloat16 bf;
    const int bh = a >> 1, b = bh >> 3, h = bh & 7;
    float* bias = (float*)(lds + fox::BIAS_OFF); float* scr = (float*)(lds + fox::SCAN_OFF);
    fox_bias(P, l, b, h, bias, scr);
    const bf* QKV = (const bf*)(P->ws + WS_QKV); bf* Y = (bf*)(P->ws + WS_Y);
    const bf* Kb = QKV + (size_t)b * SEQP * QKVW + 1024 + h * 128; const bf* Vb = Kb + 1024; const bf* Qb = QKV + ((size_t)b * SEQP + 64) * QKVW + h * 128;
    bf* Ob = Y + (size_t)b * SEQ * DM + 1024 + h * 128;
    constexpr int W = 1 << 30;
    fox::Seam<bf> S;
    fox::BlockRef<bf, bf> cur = fox_mk(a, 0, Qb, Kb, Vb, Ob);
    fox::causal_swa_prime<bf, bf>(cur, W, lds, S);
#pragma unroll 1
    for (int idx = 0; idx < 8; ++idx) {
        const fox::BlockRef<bf, bf> nxt = (idx < 7) ? fox_mk(a, idx + 1, Qb, Kb, Vb, Ob) : cur;
        fox::causal_swa_block<bf, bf>(cur, nxt, SEQP, W, lds, S, bias);
        cur = nxt;
    }
    if (b == 0) fox_meta(P, h, bias);
}

#define WS_PTR(T, off) ((T*)(Q->ws + (off)))
#define SEAM() do { PP Qb_ = launder(P); XcdBarrier b_; b_.bar = (unsigned*)(Qb_->ws + WS_CTL); b_.x = xb_xcc_id(); b_.st = (volatile LAS unsigned*)(lds + LDS_BARW); xcd_barrier(b_); } while (0)
__global__ void __launch_bounds__(512, 2) hymba_fwd(Params Pv) {
    using namespace cfg;
    PP P = (PP)__builtin_amdgcn_kernarg_segment_ptr();
    extern __shared__ __attribute__((aligned(16))) unsigned char lds_raw[];
    LAS unsigned char* lds = (LAS unsigned char*)lds_raw;
    if (threadIdx.x < 4) ((LAS unsigned*)(lds + LDS_BARW))[threadIdx.x] = 0u;
    __syncthreads();
    { PP Q = launder(P); (void)xcd_barrier_post((unsigned*)(Q->ws + WS_CTL), (volatile LAS unsigned*)(lds + LDS_BARW)); }

    { PP Q = launder(P); phase_convert(Q, lds); phase_init(Q); }
    SEAM();
    {
        PP Q = launder(P); const unsigned char* wl = Q->ws + WS_W + (size_t)0 * W_LAYER;
        pg8::Gemm g{WS_PTR(const bf16_t, WS_HB), (const bf16_t*)(wl + WO_GU1), MROWS, NGU, DM}; pg8::StaticOrder S; S.init(MROWS, NGU, (int)gridDim.x, lbid());
        pg8::EpiGU E{WS_PTR(bf16_t, WS_ACT), WS_PTR(const float, WS_SS) + (size_t)(0) * 8 * MROWS};
        pg8::gemm_phase<pg8::EpiGU, pg8::StaticOrder, true, true>(lds, g, S, E);
    }
    SEAM();
    {
        PP Q = launder(P); const unsigned char* wl = Q->ws + WS_W + (size_t)0 * W_LAYER;
        pg8::Gemm g{WS_PTR(const bf16_t, WS_ACT), (const bf16_t*)(wl + WO_D1), MROWS, DM, DFF}; pg8::StaticOrder S; S.init(MROWS, DM, (int)gridDim.x, lbid());
        pg8::EpiRes E{Q->out, WS_PTR(float, WS_HMETA), WS_PTR(bf16_t, WS_HB), WS_PTR(float, WS_SS) + (size_t)(1) * 8 * MROWS, 0.5f, (LAS float*)(lds + 131072)};
        pg8::gemm_phase<pg8::EpiRes, pg8::StaticOrder, true, true>(lds, g, S, E);
    }
    SEAM();
    {
        PP Q = launder(P); const unsigned char* wl = Q->ws + WS_W + (size_t)0 * W_LAYER;
        pg8::Gemm g{WS_PTR(const bf16_t, WS_HB), (const bf16_t*)(wl + WO_IN), MROWS, NIN, DM}; pg8::StaticOrder S; S.init(MROWS, NIN, (int)gridDim.x, lbid());
        pg8::EpiP E{WS_PTR(bf16_t, WS_PR), WS_PTR(float, WS_PS), WS_PTR(bf16_t, WS_QKV), WS_PTR(const float, WS_SS) + (size_t)(1) * 8 * MROWS};
        pg8::gemm_phase<pg8::EpiP, pg8::StaticOrder, true, true>(lds, g, S, E);
    }
    SEAM();
    {
        PP Q = launder(P); const int u = lbid();
        if (u < 128) rwkv_chunked(Q, 0, u >> 4, u & 15, lds);
        else fox_wg(Q, 0, u - 128, (char*)lds_raw);
    }
    SEAM();
    { PP Q = launder(P); phase_foxnorm(Q); }
    SEAM();
    {
        PP Q = launder(P); const unsigned char* wl = Q->ws + WS_W + (size_t)0 * W_LAYER;
        pg8::Gemm g{WS_PTR(const bf16_t, WS_Y), (const bf16_t*)(wl + WO_OUT), MROWS, DM, DM}; pg8::StaticOrder S; S.init(MROWS, DM, (int)gridDim.x, lbid());
        pg8::EpiRes E{Q->out, WS_PTR(float, WS_HMETA), WS_PTR(bf16_t, WS_HB), WS_PTR(float, WS_SS) + (size_t)(2) * 8 * MROWS, 1.0f, (LAS float*)(lds + 131072)};
        pg8::gemm_phase<pg8::EpiRes, pg8::StaticOrder, true, true>(lds, g, S, E);
    }
    SEAM();
    {
        PP Q = launder(P); const unsigned char* wl = Q->ws + WS_W + (size_t)0 * W_LAYER;
        pg8::Gemm g{WS_PTR(const bf16_t, WS_HB), (const bf16_t*)(wl + WO_GU2), MROWS, NGU, DM}; pg8::StaticOrder S; S.init(MROWS, NGU, (int)gridDim.x, lbid());
        pg8::EpiGU E{WS_PTR(bf16_t, WS_ACT), WS_PTR(const float, WS_SS) + (size_t)(2) * 8 * MROWS};
        pg8::gemm_phase<pg8::EpiGU, pg8::StaticOrder, true, true>(lds, g, S, E);
    }
    SEAM();
    {
        PP Q = launder(P); const unsigned char* wl = Q->ws + WS_W + (size_t)0 * W_LAYER;
        pg8::Gemm g{WS_PTR(const bf16_t, WS_ACT), (const bf16_t*)(wl + WO_D2), MROWS, DM, DFF}; pg8::StaticOrder S; S.init(MROWS, DM, (int)gridDim.x, lbid());
        pg8::EpiRes E{Q->out, WS_PTR(float, WS_HMETA), WS_PTR(bf16_t, WS_HB), WS_PTR(float, WS_SS) + (size_t)(3) * 8 * MROWS, 0.5f, (LAS float*)(lds + 131072)};
        pg8::gemm_phase<pg8::EpiRes, pg8::StaticOrder, true, true>(lds, g, S, E);
    }
    SEAM();
    {
        PP Q = launder(P); const unsigned char* wl = Q->ws + WS_W + (size_t)1 * W_LAYER;
        pg8::Gemm g{WS_PTR(const bf16_t, WS_HB), (const bf16_t*)(wl + WO_GU1), MROWS, NGU, DM}; pg8::StaticOrder S; S.init(MROWS, NGU, (int)gridDim.x, lbid());
        pg8::EpiGU E{WS_PTR(bf16_t, WS_ACT), WS_PTR(const float, WS_SS) + (size_t)(3) * 8 * MROWS};
        pg8::gemm_phase<pg8::EpiGU, pg8::StaticOrder, true, true>(lds, g, S, E);
    }
    SEAM();
    {
        PP Q = launder(P); const unsigned char* wl = Q->ws + WS_W + (size_t)1 * W_LAYER;
        pg8::Gemm g{WS_PTR(const bf16_t, WS_ACT), (const bf16_t*)(wl + WO_D1), MROWS, DM, DFF}; pg8::StaticOrder S; S.init(MROWS, DM, (int)gridDim.x, lbid());
        pg8::EpiRes E{Q->out, WS_PTR(float, WS_HMETA), WS_PTR(bf16_t, WS_HB), WS_PTR(float, WS_SS) + (size_t)(4) * 8 * MROWS, 0.5f, (LAS float*)(lds + 131072)};
        pg8::gemm_phase<pg8::EpiRes, pg8::StaticOrder, true, true>(lds, g, S, E);
    }
    SEAM();
    {
        PP Q = launder(P); const unsigned char* wl = Q->ws + WS_W + (size_t)1 * W_LAYER;
        pg8::Gemm g{WS_PTR(const bf16_t, WS_HB), (const bf16_t*)(wl + WO_IN), MROWS, NIN, DM}; pg8::StaticOrder S; S.init(MROWS, NIN, (int)gridDim.x, lbid());
        pg8::EpiP E{WS_PTR(bf16_t, WS_PR), WS_PTR(float, WS_PS), WS_PTR(bf16_t, WS_QKV), WS_PTR(const float, WS_SS) + (size_t)(4) * 8 * MROWS};
        pg8::gemm_phase<pg8::EpiP, pg8::StaticOrder, true, true>(lds, g, S, E);
    }
    SEAM();
    {
        PP Q = launder(P); const int u = lbid();
        if (u < 128) rwkv_chunked(Q, 1, u >> 4, u & 15, lds);
        else fox_wg(Q, 1, u - 128, (char*)lds_raw);
    }
    SEAM();
    { PP Q = launder(P); phase_foxnorm(Q); }
    SEAM();
    {
        PP Q = launder(P); const unsigned char* wl = Q->ws + WS_W + (size_t)1 * W_LAYER;
        pg8::Gemm g{WS_PTR(const bf16_t, WS_Y), (const bf16_t*)(wl + WO_OUT), MROWS, DM, DM}; pg8::StaticOrder S; S.init(MROWS, DM, (int)gridDim.x, lbid());
        pg8::EpiRes E{Q->out, WS_PTR(float, WS_HMETA), WS_PTR(bf16_t, WS_HB), WS_PTR(float, WS_SS) + (size_t)(5) * 8 * MROWS, 1.0f, (LAS float*)(lds + 131072)};
        pg8::gemm_phase<pg8::EpiRes, pg8::StaticOrder, true, true>(lds, g, S, E);
    }
    SEAM();
    {
        PP Q = launder(P); const unsigned char* wl = Q->ws + WS_W + (size_t)1 * W_LAYER;
        pg8::Gemm g{WS_PTR(const bf16_t, WS_HB), (const bf16_t*)(wl + WO_GU2), MROWS, NGU, DM}; pg8::StaticOrder S; S.init(MROWS, NGU, (int)gridDim.x, lbid());
        pg8::EpiGU E{WS_PTR(bf16_t, WS_ACT), WS_PTR(const float, WS_SS) + (size_t)(5) * 8 * MROWS};
        pg8::gemm_phase<pg8::EpiGU, pg8::StaticOrder, true, true>(lds, g, S, E);
    }
    SEAM();
    {
        PP Q = launder(P); const unsigned char* wl = Q->ws + WS_W + (size_t)1 * W_LAYER;
        pg8::Gemm g{WS_PTR(const bf16_t, WS_ACT), (const bf16_t*)(wl + WO_D2), MROWS, DM, DFF}; pg8::StaticOrder S; S.init(MROWS, DM, (int)gridDim.x, lbid());
        pg8::EpiRes E{Q->out, WS_PTR(float, WS_HMETA), WS_PTR(bf16_t, WS_HB), WS_PTR(float, WS_SS) + (size_t)(6) * 8 * MROWS, 0.5f, (LAS float*)(lds + 131072)};
        pg8::gemm_phase<pg8::EpiRes, pg8::StaticOrder, true, true>(lds, g, S, E);
    }
    SEAM();
    {
        PP Q = launder(P); const unsigned char* wl = Q->ws + WS_W + (size_t)2 * W_LAYER;
        pg8::Gemm g{WS_PTR(const bf16_t, WS_HB), (const bf16_t*)(wl + WO_GU1), MROWS, NGU, DM}; pg8::StaticOrder S; S.init(MROWS, NGU, (int)gridDim.x, lbid());
        pg8::EpiGU E{WS_PTR(bf16_t, WS_ACT), WS_PTR(const float, WS_SS) + (size_t)(6) * 8 * MROWS};
        pg8::gemm_phase<pg8::EpiGU, pg8::StaticOrder, true, true>(lds, g, S, E);
    }
    SEAM();
    {
        PP Q = launder(P); const unsigned char* wl = Q->ws + WS_W + (size_t)2 * W_LAYER;
        pg8::Gemm g{WS_PTR(const bf16_t, WS_ACT), (const bf16_t*)(wl + WO_D1), MROWS, DM, DFF}; pg8::StaticOrder S; S.init(MROWS, DM, (int)gridDim.x, lbid());
        pg8::EpiRes E{Q->out, WS_PTR(float, WS_HMETA), WS_PTR(bf16_t, WS_HB), WS_PTR(float, WS_SS) + (size_t)(7) * 8 * MROWS, 0.5f, (LAS float*)(lds + 131072)};
        pg8::gemm_phase<pg8::EpiRes, pg8::StaticOrder, true, true>(lds, g, S, E);
    }
    SEAM();
    {
        PP Q = launder(P); const unsigned char* wl = Q->ws + WS_W + (size_t)2 * W_LAYER;
        pg8::Gemm g{WS_PTR(const bf16_t, WS_HB), (const bf16_t*)(wl + WO_IN), MROWS, NIN, DM}; pg8::StaticOrder S; S.init(MROWS, NIN, (int)gridDim.x, lbid());
        pg8::EpiP E{WS_PTR(bf16_t, WS_PR), WS_PTR(float, WS_PS), WS_PTR(bf16_t, WS_QKV), WS_PTR(const float, WS_SS) + (size_t)(7) * 8 * MROWS};
        pg8::gemm_phase<pg8::EpiP, pg8::StaticOrder, true, true>(lds, g, S, E);
    }
    SEAM();
    {
        PP Q = launder(P); const int u = lbid();
        if (u < 128) rwkv_chunked(Q, 2, u >> 4, u & 15, lds);
        else fox_wg(Q, 2, u - 128, (char*)lds_raw);
    }
    SEAM();
    { PP Q = launder(P); phase_foxnorm(Q); }
    SEAM();
    {
        PP Q = launder(P); const unsigned char* wl = Q->ws + WS_W + (size_t)2 * W_LAYER;
        pg8::Gemm g{WS_PTR(const bf16_t, WS_Y), (const bf16_t*)(wl + WO_OUT), MROWS, DM, DM}; pg8::StaticOrder S; S.init(MROWS, DM, (int)gridDim.x, lbid());
        pg8::EpiRes E{Q->out, WS_PTR(float, WS_HMETA), WS_PTR(bf16_t, WS_HB), WS_PTR(float, WS_SS) + (size_t)(8) * 8 * MROWS, 1.0f, (LAS float*)(lds + 131072)};
        pg8::gemm_phase<pg8::EpiRes, pg8::StaticOrder, true, true>(lds, g, S, E);
    }
    SEAM();
    {
        PP Q = launder(P); const unsigned char* wl = Q->ws + WS_W + (size_t)2 * W_LAYER;
        pg8::Gemm g{WS_PTR(const bf16_t, WS_HB), (const bf16_t*)(wl + WO_GU2), MROWS, NGU, DM}; pg8::StaticOrder S; S.init(MROWS, NGU, (int)gridDim.x, lbid());
        pg8::EpiGU E{WS_PTR(bf16_t, WS_ACT), WS_PTR(const float, WS_SS) + (size_t)(8) * 8 * MROWS};
        pg8::gemm_phase<pg8::EpiGU, pg8::StaticOrder, true, true>(lds, g, S, E);
    }
    SEAM();
    {
        PP Q = launder(P); const unsigned char* wl = Q->ws + WS_W + (size_t)2 * W_LAYER;
        pg8::Gemm g{WS_PTR(const bf16_t, WS_ACT), (const bf16_t*)(wl + WO_D2), MROWS, DM, DFF}; pg8::StaticOrder S; S.init(MROWS, DM, (int)gridDim.x, lbid());
        pg8::EpiRes E{Q->out, WS_PTR(float, WS_HMETA), WS_PTR(bf16_t, WS_HB), WS_PTR(float, WS_SS) + (size_t)(9) * 8 * MROWS, 0.5f, (LAS float*)(lds + 131072)};
        pg8::gemm_phase<pg8::EpiRes, pg8::StaticOrder, true, true>(lds, g, S, E);
    }
    SEAM();
    {
        PP Q = launder(P); const unsigned char* wl = Q->ws + WS_W + (size_t)3 * W_LAYER;
        pg8::Gemm g{WS_PTR(const bf16_t, WS_HB), (const bf16_t*)(wl + WO_GU1), MROWS, NGU, DM}; pg8::StaticOrder S; S.init(MROWS, NGU, (int)gridDim.x, lbid());
        pg8::EpiGU E{WS_PTR(bf16_t, WS_ACT), WS_PTR(const float, WS_SS) + (size_t)(9) * 8 * MROWS};
        pg8::gemm_phase<pg8::EpiGU, pg8::StaticOrder, true, true>(lds, g, S, E);
    }
    SEAM();
    {
        PP Q = launder(P); const unsigned char* wl = Q->ws + WS_W + (size_t)3 * W_LAYER;
        pg8::Gemm g{WS_PTR(const bf16_t, WS_ACT), (const bf16_t*)(wl + WO_D1), MROWS, DM, DFF}; pg8::StaticOrder S; S.init(MROWS, DM, (int)gridDim.x, lbid());
        pg8::EpiRes E{Q->out, WS_PTR(float, WS_HMETA), WS_PTR(bf16_t, WS_HB), WS_PTR(float, WS_SS) + (size_t)(10) * 8 * MROWS, 0.5f, (LAS float*)(lds + 131072)};
        pg8::gemm_phase<pg8::EpiRes, pg8::StaticOrder, true, true>(lds, g, S, E);
    }
    SEAM();
    {
        PP Q = launder(P); const unsigned char* wl = Q->ws + WS_W + (size_t)3 * W_LAYER;
        pg8::Gemm g{WS_PTR(const bf16_t, WS_HB), (const bf16_t*)(wl + WO_IN), MROWS, NIN, DM}; pg8::StaticOrder S; S.init(MROWS, NIN, (int)gridDim.x, lbid());
        pg8::EpiP E{WS_PTR(bf16_t, WS_PR), WS_PTR(float, WS_PS), WS_PTR(bf16_t, WS_QKV), WS_PTR(const float, WS_SS) + (size_t)(10) * 8 * MROWS};
        pg8::gemm_phase<pg8::EpiP, pg8::StaticOrder, true, true>(lds, g, S, E);
    }
    SEAM();
    {
        PP Q = launder(P); const int u = lbid();
        if (u < 128) rwkv_chunked(Q, 3, u >> 4, u & 15, lds);
        else fox_wg(Q, 3, u - 128, (char*)lds_raw);
    }
    SEAM();
    { PP Q = launder(P); phase_foxnorm(Q); }
    SEAM();
    {
        PP Q = launder(P); const unsigned char* wl = Q->ws + WS_W + (size_t)3 * W_LAYER;
        pg8::Gemm g{WS_PTR(const bf16_t, WS_Y), (const bf16_t*)(wl + WO_OUT), MROWS, DM, DM}; pg8::StaticOrder S; S.init(MROWS, DM, (int)gridDim.x, lbid());
        pg8::EpiRes E{Q->out, WS_PTR(float, WS_HMETA), WS_PTR(bf16_t, WS_HB), WS_PTR(float, WS_SS) + (size_t)(11) * 8 * MROWS, 1.0f, (LAS float*)(lds + 131072)};
        pg8::gemm_phase<pg8::EpiRes, pg8::StaticOrder, true, true>(lds, g, S, E);
    }
    SEAM();
    {
        PP Q = launder(P); const unsigned char* wl = Q->ws + WS_W + (size_t)3 * W_LAYER;
        pg8::Gemm g{WS_PTR(const bf16_t, WS_HB), (const bf16_t*)(wl + WO_GU2), MROWS, NGU, DM}; pg8::StaticOrder S; S.init(MROWS, NGU, (int)gridDim.x, lbid());
        pg8::EpiGU E{WS_PTR(bf16_t, WS_ACT), WS_PTR(const float, WS_SS) + (size_t)(11) * 8 * MROWS};
        pg8::gemm_phase<pg8::EpiGU, pg8::StaticOrder, true, true>(lds, g, S, E);
    }
    SEAM();
    {
        PP Q = launder(P); const unsigned char* wl = Q->ws + WS_W + (size_t)3 * W_LAYER;
        pg8::Gemm g{WS_PTR(const bf16_t, WS_ACT), (const bf16_t*)(wl + WO_D2), MROWS, DM, DFF}; pg8::StaticOrder S; S.init(MROWS, DM, (int)gridDim.x, lbid());
        pg8::EpiRes E{Q->out, WS_PTR(float, WS_HMETA), WS_PTR(bf16_t, WS_HB), WS_PTR(float, WS_SS) + (size_t)(12) * 8 * MROWS, 0.5f, (LAS float*)(lds + 131072)};
        pg8::gemm_phase<pg8::EpiRes, pg8::StaticOrder, true, true>(lds, g, S, E);
    }
    SEAM();
    { PP Q = launder(P); phase_final(Q); }
}

extern "C" void kernel_launch(void* const* d_in, const int* in_sizes, int n_in, void* d_out, int out_size, void* d_ws, size_t ws_size, hipStream_t stream) {
    using namespace cfg;
    static int grid = 0;
    if (grid == 0) {
        if (n_in != 25 || out_size != MMAIN * DM || ws_size < WS_END) { fprintf(stderr, "kernel_launch: need 25 inputs, out %d, ws >= %zu; got n_in %d out %d ws %zu\n", MMAIN * DM, (size_t)WS_END, n_in, out_size, ws_size); grid = -1; return; }
        int dev = 0, cus = 0, per_cu = 0;
        if (hipGetDevice(&dev) != hipSuccess || hipDeviceGetAttribute(&cus, hipDeviceAttributeMultiprocessorCount, dev) != hipSuccess) { grid = -1; return; }
        if (hipFuncSetAttribute((const void*)hymba_fwd, hipFuncAttributeMaxDynamicSharedMemorySize, LDS_BYTES) != hipSuccess) { fprintf(stderr, "kernel_launch: hipFuncSetAttribute failed\n"); grid = -1; return; }
        if (hipOccupancyMaxActiveBlocksPerMultiprocessor(&per_cu, (const void*)hymba_fwd, 512, LDS_BYTES) != hipSuccess || per_cu < 1) fprintf(stderr, "kernel_launch: occupancy query says %d\n", per_cu);
        (void)hipGetLastError();
        if (cus < 256) { fprintf(stderr, "kernel_launch: built for a 256-CU device (one resident workgroup per CU), found %d CUs\n", cus); grid = -1; return; }
        grid = 256;
    }
    if (grid < 0) return;
    if (hipMemsetAsync((char*)d_ws + WS_CTL, 0, CTL_BYTES, stream) != hipSuccess) return;
    Params p{};
    for (int i = 0; i < 25; ++i) p.in[i] = (const float*)d_in[i];
    p.out = (float*)d_out; p.ws = (unsigned char*)d_ws; p.ph_lo = 0; p.ph_hi = 0;
    hipLaunchKernelGGL(hymba_fwd, dim3(grid), dim3(512), LDS_BYTES, stream, p);
}
```

```cpp
#include <hip/hip_runtime.h>
#include <hip/hip_bf16.h>
#include <cstdio>
#include <cstdint>

#define LAS __attribute__((address_space(3)))
namespace cfg {
constexpr int DM = 2048, NBATCH = 8, SEQ = 4096, NMETA = 16, DEPTH = 4;
constexpr int MMAIN = NBATCH * SEQ;
constexpr int MROWS = MMAIN + 256;
constexpr int DFF = 5632, NGU = 2 * DFF;
constexpr int RW = 1024, RH = 64, RNH = 16;
constexpr int FW = 1024, FH = 128, FNH = 8;
constexpr int RWKV_COLS = 3360, DIN = 6440;
constexpr int NIN = 6656;
constexpr int PRW = 3072, PSW = 512, QKVW = 3072;
constexpr int SEQP = 4160;
constexpr float NORM_EPS = 1e-6f, LNX_EPS = 64e-5f;
constexpr int NSS = 13;
constexpr size_t al256(size_t x) { return (x + 255) & ~(size_t)255; }
constexpr size_t WS_CTL = 0;
constexpr size_t CTL_BYTES = 65536;
constexpr size_t WS_SS = WS_CTL + CTL_BYTES;
constexpr size_t SS_BYTES = al256((size_t)NSS * 8 * MROWS * 4);
constexpr size_t ZERO_BYTES = CTL_BYTES + SS_BYTES;
constexpr size_t WS_SSM = WS_SS + SS_BYTES;
constexpr size_t SSM_BYTES = (size_t)NSS * 2048 * 4;
constexpr size_t WS_HMETA = WS_SSM + SSM_BYTES;
constexpr size_t WS_HB = WS_HMETA + (size_t)256 * DM * 4;
constexpr size_t WS_Y = WS_HB + (size_t)MROWS * DM * 2;
constexpr size_t WS_OVL = WS_Y + (size_t)MROWS * DM * 2;
constexpr size_t WS_ACT = WS_OVL;
constexpr size_t WS_PR = WS_OVL;
constexpr size_t WS_PS = WS_PR + (size_t)MROWS * PRW * 2;
constexpr size_t WS_QKV = WS_PS + (size_t)MROWS * PSW * 4;
constexpr size_t OVL_A = (size_t)MROWS * DFF * 2, OVL_B = (size_t)MROWS * PRW * 2 + (size_t)MROWS * PSW * 4 + (size_t)NBATCH * SEQP * QKVW * 2;
constexpr size_t WS_W = WS_OVL + al256(OVL_A > OVL_B ? OVL_A : OVL_B);
constexpr size_t W_GU = (size_t)NGU * DM * 2, W_D = (size_t)DM * DFF * 2, W_IN = (size_t)NIN * DM * 2, W_OUT = (size_t)DM * DM * 2;
constexpr size_t WO_GU1 = 0, WO_D1 = WO_GU1 + W_GU, WO_IN = WO_D1 + W_D, WO_OUT = WO_IN + W_IN, WO_GU2 = WO_OUT + W_OUT, WO_D2 = WO_GU2 + W_GU, W_LAYER = WO_D2 + W_D;
constexpr size_t WS_END = WS_W + (size_t)DEPTH * W_LAYER;
constexpr int LDS_BYTES = 147456;
constexpr int LDS_BARW = LDS_BYTES - 16;
}
__device__ __forceinline__ int ltid() { int t = (int)threadIdx.x; asm volatile("" : "+v"(t)); return t; }
__device__ __forceinline__ int lbid() { int t = (int)blockIdx.x; asm volatile("" : "+s"(t)); return t; }
__device__ __forceinline__ int lzero() { int t = 0; asm volatile("" : "+v"(t)); return t; }
namespace pg8 {
#define PG8_LAS __attribute__((address_space(3)))
typedef unsigned short bf16_t;
typedef short bf16x8 __attribute__((ext_vector_type(8)));
typedef float f32x4 __attribute__((ext_vector_type(4)));
typedef unsigned u32x4 __attribute__((ext_vector_type(4)));
constexpr int BM = 256, BK = 64, HALF = 128, HTB = HALF * BK * 2  , STAGE_BYTES = 8 * HTB, NXCD = 8, WGM = 8;

__host__ __device__ __forceinline__ int lds_byte(int r, int c) { const int st = (r >> 4) * 2 + (c >> 5), rr = r & 15, cc = c & 31, ob = rr * 64 + cc * 2; return st * 1024 + (ob ^ (((ob >> 9) & 1) << 5)); }
__host__ __device__ __forceinline__ void stage_rc(int b, int& R, int& C) { const int st = b / 1024, sb = b % 1024, swz = sb ^ (((sb >> 9) & 1) << 5); R = (st >> 1) * 16 + swz / 64; C = (st & 1) * 32 + (swz % 64) / 2; }
__host__ __device__ __forceinline__ int perm32(int rho) { const int n = rho >> 4, i = rho & 15; return 8 * (i >> 2) + 4 * n + (i & 3); }

struct Unit { int pm, pn; };
struct Gemm { const bf16_t* A; const bf16_t* Bt; int M, N, K; };

struct StaticOrder {
    int nM, nN, nwg, G, c;
    __host__ __device__ void init(int M, int N, int G_, int c_) { nM = M / BM; nN = N / BM; nwg = nM * nN; G = G_; c = c_; }
    __host__ __device__ bool next(int i, Unit& u) const {
        const long L = (long)i * G + c; if (L >= nwg) return false;
        int wgid = (int)L; { const int q = nwg / NXCD, r = nwg % NXCD, xcd = wgid % NXCD, off = wgid / NXCD; wgid = (xcd < r ? xcd * (q + 1) : r * (q + 1) + (xcd - r) * q) + off; }
        const int nig = WGM * nN, gid = wgid / nig, fm = gid * WGM, gsz = (nM - fm) < WGM ? (nM - fm) : WGM;
        u.pm = fm + ((wgid % nig) % gsz); u.pn = (wgid % nig) / gsz; return true;
    }
    __device__ __forceinline__ void a_ready(const Unit&) const {}
    __device__ __forceinline__ void done(const Unit&) const {}
};

__device__ __forceinline__ unsigned cvt_pk_bf16(float lo, float hi) { unsigned r; asm volatile("v_cvt_pk_bf16_f32 %0, %1, %2" : "=v"(r) : "v"(lo), "v"(hi)); return r; }
typedef float f32x2 __attribute__((ext_vector_type(2)));
__device__ __forceinline__ f32x2 gelu_pk(f32x2 v) {
    const f32x2 av = __builtin_elementwise_abs(v), d = av * 0.2316418882f + 1.0f;
    f32x2 t; t.x = __builtin_amdgcn_rcpf(d.x); t.y = __builtin_amdgcn_rcpf(d.y);
    f32x2 q = t * 0.5307027145f + (-0.7265760135f); q = q * t + 0.7107068705f; q = q * t + (-0.142248368f); q = q * t + 0.127414796f; q = q * t;
    const f32x2 s = (v * v) * (-0.72134752044f);
    f32x2 e; e.x = __builtin_amdgcn_exp2f(s.x); e.y = __builtin_amdgcn_exp2f(s.y);
    const f32x2 m = v * (q * e), r = v - m;
    f32x2 o; o.x = v.x < 0.f ? m.x : r.x; o.y = v.y < 0.f ? m.y : r.y; return o;
}
__device__ __forceinline__ float rs_of(const float* ss, int row) { float s = 0.f;
#pragma unroll
    for (int t = 0; t < 8; ++t) s += ss[(size_t)t * 33024 + row];
    return __builtin_amdgcn_rsqf(s * (1.0f / 2048.0f) + 1e-6f); }
__device__ __forceinline__ float silu_f(float x) { return x * __builtin_amdgcn_rcpf(1.0f + __builtin_amdgcn_exp2f(-1.4426950408889634f * x)); }

struct EpiGU {
    static constexpr bool PERM = true, AFTER_DRAIN = false;
    bf16_t* act; const float* ss;
    __device__ __forceinline__ void operator()(const f32x4 (&acc)[2][2][4][2], const Unit& u, int wr, int wc, int fr, int fq) const {
        const int row0 = u.pm * BM + wr * 64 + fr, col0 = u.pn * 128 + wc * 32 + 8 * fq;
#pragma unroll
        for (int ai = 0; ai < 2; ++ai)
#pragma unroll
            for (int m = 0; m < 4; ++m) { const int row = row0 + ai * HALF + m * 16; const float rs = rs_of(ss, row);
                const f32x4 g0 = acc[ai][0][m][0] * rs, g1 = acc[ai][0][m][1] * rs, u0 = acc[ai][1][m][0] * rs, u1 = acc[ai][1][m][1] * rs;
                u32x4 w;
                w.x = cvt_pk_bf16(silu_f(g0[0]) * u0[0], silu_f(g0[1]) * u0[1]); w.y = cvt_pk_bf16(silu_f(g0[2]) * u0[2], silu_f(g0[3]) * u0[3]);
                w.z = cvt_pk_bf16(silu_f(g1[0]) * u1[0], silu_f(g1[1]) * u1[1]); w.w = cvt_pk_bf16(silu_f(g1[2]) * u1[2], silu_f(g1[3]) * u1[3]);
                *(u32x4*)(act + (size_t)row * 5632 + col0) = w; }
    }
};
struct EpiRes {
    static constexpr bool PERM = false, AFTER_DRAIN = false;
    float* hmain; bf16_t* hb; float* ssn; float alpha; PG8_LAS float* red;
    __device__ __forceinline__ void operator()(const f32x4 (&acc)[2][2][4][2], const Unit& u, int wr, int wc, int fr, int fq) const {
        typedef unsigned u32x2v __attribute__((ext_vector_type(2)));
        float* base = hmain + (size_t)u.pm * BM * 2048;
        bf16_t* bbase = hb + (size_t)u.pm * BM * 2048;
        const int rl0 = wr * 64 + fr; unsigned off = (unsigned)(rl0 * 2048 + u.pn * BM + wc * 32 + 4 * fq);
#pragma unroll
        for (int ai = 0; ai < 2; ++ai)
#pragma unroll
            for (int m = 0; m < 4; ++m) { const unsigned o = off + (unsigned)((ai * HALF + m * 16) * 2048); float sq = 0.f;
#pragma unroll
                for (int bj = 0; bj < 2; ++bj)
#pragma unroll
                    for (int n = 0; n < 2; ++n) { const unsigned oo = o + bj * HALF + n * 16; f32x4 hv = *(const f32x4*)(base + oo); hv = hv + acc[ai][bj][m][n] * alpha; *(f32x4*)(base + oo) = hv;
                        sq += (hv[0] * hv[0] + hv[1] * hv[1]) + (hv[2] * hv[2] + hv[3] * hv[3]);
                        u32x2v w; w.x = cvt_pk_bf16(hv[0], hv[1]); w.y = cvt_pk_bf16(hv[2], hv[3]); *(u32x2v*)(bbase + oo) = w; }
                sq += __shfl_xor(sq, 16); sq += __shfl_xor(sq, 32);
                if (fq == 0) red[(rl0 + ai * HALF + m * 16) * 4 + wc] = sq;
                asm volatile("" ::: "memory"); }
        asm volatile("s_waitcnt lgkmcnt(0)" ::: "memory"); __builtin_amdgcn_s_barrier(); asm volatile("" ::: "memory");
        if (wr == 0) { const int row = wc * 64 + fq * 16 + fr; const float s4 = (red[row * 4] + red[row * 4 + 1]) + (red[row * 4 + 2] + red[row * 4 + 3]); ssn[(size_t)u.pn * 33024 + u.pm * BM + row] = s4; }
    }
};
struct EpiP {
    static constexpr bool PERM = true, AFTER_DRAIN = false;
    bf16_t* pr; float* ps; bf16_t* qkv; const float* ss;
    __device__ __forceinline__ void operator()(const f32x4 (&acc)[2][2][4][2], const Unit& u, int wr, int wc, int fr, int fq) const {
        const int row0 = u.pm * BM + wr * 64 + fr, cl = wc * 32 + 8 * fq;
#pragma unroll
        for (int ai = 0; ai < 2; ++ai)
#pragma unroll
            for (int m = 0; m < 4; ++m) { const int row = row0 + ai * HALF + m * 16; const float rs = rs_of(ss, row);
#pragma unroll
                for (int bj = 0; bj < 2; ++bj) { const f32x4 v0 = acc[ai][bj][m][0] * rs, v1 = acc[ai][bj][m][1] * rs;
                    if (u.pn >= 12 && u.pn < 14) { float* d = ps + (size_t)row * 512 + (u.pn - 12) * 256 + bj * HALF + cl; *(f32x4*)d = v0; *(f32x4*)(d + 4) = v1; }
                    else { u32x4 w; w.x = cvt_pk_bf16(v0[0], v0[1]); w.y = cvt_pk_bf16(v0[2], v0[3]); w.z = cvt_pk_bf16(v1[0], v1[1]); w.w = cvt_pk_bf16(v1[2], v1[3]);
                        if (u.pn < 12) *(u32x4*)(pr + (size_t)row * 3072 + u.pn * 256 + bj * HALF + cl) = w;
                        else { const int c = (u.pn - 14) * 256 + bj * HALF + cl;
                            const int b = row >> 12, s = row & 4095; *(u32x4*)(qkv + ((size_t)b * 4160 + 64 + s) * 3072 + c) = w; } } } }
    }
};
template <class Epi, class Sched, bool ALIGN_EPI = false, bool SP2 = false>
__device__ __forceinline__ void gemm_phase(PG8_LAS unsigned char* lds, const Gemm g, const Sched& S, const Epi& E) {
    const int tid = ltid(), wid = __builtin_amdgcn_readfirstlane(tid >> 6), lane = tid & 63, wr = wid >> 2, wc = wid & 3, fr = lane & 15, fq = lane >> 4;
    const int K = g.K, nt = K / BK;
    unsigned voffA[2], voffB[2];
#pragma unroll
    for (int i = 0; i < 2; ++i) { int R, C; stage_rc(tid * 16 + i * 8192, R, C); const int Rb = Epi::PERM ? ((R & ~31) + perm32(R & 31)) : R;
        voffA[i] = (unsigned)(R * K + C) * 2u; voffB[i] = (unsigned)(Rb * K + C) * 2u; }
    const size_t kstep = (size_t)(BK * 2);
    const size_t hstep = (size_t)HALF * K * 2;
    const size_t tstep = 2 * hstep;
    const unsigned ldsw = (unsigned)wid * 1024u;
    const int aoff = lds_byte(wr * 64 + fr, fq * 8), boff = lds_byte(wc * 32 + fr, fq * 8);
#define PG8_SA(b, h) (((b) * 2 + (h)) * HTB)
#define PG8_SB(b, h) ((4 + (b) * 2 + (h)) * HTB)
#define PG8_STAGE(bufoff, gbase, voff) do { _Pragma("unroll") for (int _i = 0; _i < 2; ++_i) \
        __builtin_amdgcn_global_load_lds((const unsigned*)((const char*)(gbase) + (voff)[_i]), (PG8_LAS unsigned*)(lds + (bufoff) + ldsw + _i * 8192), 16, 0, 0); } while (0)
#define PG8_LDA(dst, b, h) do { _Pragma("unroll") for (int m = 0; m < 4; ++m) _Pragma("unroll") for (int k = 0; k < 2; ++k) dst[m][k] = *(const PG8_LAS bf16x8*)(lds + PG8_SA(b, h) + aoff + m * 2048 + k * 1024); } while (0)
#define PG8_LDB(dst, b, h) do { _Pragma("unroll") for (int n = 0; n < 2; ++n) _Pragma("unroll") for (int k = 0; k < 2; ++k) dst[n][k] = *(const PG8_LAS bf16x8*)(lds + PG8_SB(b, h) + boff + n * 2048 + k * 1024); } while (0)
#define PG8_MMA(ai, bj, At, Bt) do { __builtin_amdgcn_s_setprio(1); _Pragma("unroll") for (int m = 0; m < 4; ++m) _Pragma("unroll") for (int n = 0; n < 2; ++n) _Pragma("unroll") for (int k = 0; k < 2; ++k) \
        acc[ai][bj][m][n] = __builtin_amdgcn_mfma_f32_16x16x32_bf16(Bt[n][k], At[m][k], acc[ai][bj][m][n], 0, 0, 0); __builtin_amdgcn_s_setprio(0); } while (0)
#define PG8_WAIT_V(n) asm volatile("s_waitcnt vmcnt(" #n ")" ::: "memory")
#define PG8_WAIT_L(n) asm volatile("s_waitcnt lgkmcnt(" #n ")" ::: "memory")
#define PG8_BAR __builtin_amdgcn_s_barrier()
#define PG8_SCHED __builtin_amdgcn_sched_barrier(0)
    Unit cur, nxt; int ui = 0;
    if (!S.next(0, cur)) return;
    f32x4 acc[2][2][4][2];
#pragma unroll
    for (int a = 0; a < 2; ++a)
#pragma unroll
        for (int b = 0; b < 2; ++b)
#pragma unroll
            for (int m = 0; m < 4; ++m)
#pragma unroll
                for (int n = 0; n < 2; ++n) acc[a][b][m][n] = (f32x4){0.f, 0.f, 0.f, 0.f};
    bf16x8 At[4][2], B0[2][2], B1[2][2];
    const char* cA = (const char*)g.A + (size_t)cur.pm * tstep; const char* cB = (const char*)g.Bt + (size_t)cur.pn * tstep;
    S.a_ready(cur);
    if constexpr (SP2) {
        PG8_STAGE(PG8_SB(0, 0), cB, voffB); PG8_STAGE(PG8_SB(0, 1), cB + hstep, voffB); PG8_STAGE(PG8_SA(0, 0), cA, voffA); PG8_STAGE(PG8_SA(0, 1), cA + hstep, voffA);
        if (wr == 1) PG8_BAR;
        PG8_WAIT_V(2); PG8_BAR;
        PG8_STAGE(PG8_SB(1, 0), cB + kstep, voffB); PG8_STAGE(PG8_SA(1, 0), cA + kstep, voffA); PG8_STAGE(PG8_SB(1, 1), cB + hstep + kstep, voffB);
        PG8_WAIT_V(6); PG8_BAR;
    } else {
        PG8_STAGE(PG8_SB(0, 0), cB, voffB); PG8_STAGE(PG8_SA(0, 0), cA, voffA); PG8_STAGE(PG8_SB(0, 1), cB + hstep, voffB); PG8_STAGE(PG8_SA(0, 1), cA + hstep, voffA);
        if (wr == 1) PG8_BAR;
        PG8_WAIT_V(4); PG8_BAR;
        PG8_STAGE(PG8_SB(1, 0), cB + kstep, voffB); PG8_STAGE(PG8_SA(1, 0), cA + kstep, voffA); PG8_STAGE(PG8_SB(1, 1), cB + hstep + kstep, voffB);
        PG8_WAIT_V(6); PG8_BAR;
    }
    for (;;) {
        const bool has_next = S.next(ui + 1, nxt);
        const char* nA = has_next ? (const char*)g.A + (size_t)nxt.pm * tstep : cA; const char* nB = has_next ? (const char*)g.Bt + (size_t)nxt.pn * tstep : cB;
        for (int t = 0; t < nt; t += 2) {
            const bool last = (t == nt - 2);
            const char* a1 = cA + (size_t)(t + 1) * kstep;
            const char* a2 = last ? nA : cA + (size_t)(t + 2) * kstep; const char* b2 = last ? nB : cB + (size_t)(t + 2) * kstep;
            const char* a3 = a2 + kstep; const char* b3 = b2 + kstep;
            if (last && has_next) S.a_ready(nxt);
            if constexpr (SP2) {
            PG8_LDB(B0, 0, 0); PG8_LDB(B1, 0, 1); PG8_SCHED; PG8_LDA(At, 0, 0); PG8_STAGE(PG8_SA(1, 1), a1 + hstep, voffA);
            PG8_WAIT_V(8); PG8_WAIT_L(0); PG8_BAR; PG8_MMA(0, 0, At, B0); PG8_MMA(0, 1, At, B1); PG8_BAR; PG8_SCHED;
            PG8_LDA(At, 0, 1); PG8_STAGE(PG8_SB(0, 0), b2, voffB); PG8_STAGE(PG8_SB(0, 1), b2 + hstep, voffB); PG8_STAGE(PG8_SA(0, 0), a2, voffA);
            PG8_WAIT_V(8); PG8_WAIT_L(0); PG8_BAR; PG8_MMA(1, 0, At, B0); PG8_MMA(1, 1, At, B1); PG8_BAR; PG8_SCHED;
            PG8_LDB(B0, 1, 0); PG8_LDB(B1, 1, 1); PG8_SCHED; PG8_LDA(At, 1, 0); PG8_STAGE(PG8_SA(0, 1), a2 + hstep, voffA);
            PG8_WAIT_V(8); PG8_WAIT_L(0); PG8_BAR; PG8_MMA(0, 0, At, B0); PG8_MMA(0, 1, At, B1); PG8_BAR; PG8_SCHED;
            PG8_LDA(At, 1, 1); PG8_STAGE(PG8_SB(1, 0), b3, voffB); PG8_STAGE(PG8_SB(1, 1), b3 + hstep, voffB); PG8_STAGE(PG8_SA(1, 0), a3, voffA);
            PG8_WAIT_V(8); PG8_WAIT_L(0); PG8_BAR; PG8_MMA(1, 0, At, B0); PG8_MMA(1, 1, At, B1); PG8_BAR; PG8_SCHED;
            } else {
            PG8_LDB(B0, 0, 0); PG8_SCHED; PG8_LDA(At, 0, 0); PG8_STAGE(PG8_SA(1, 1), a1 + hstep, voffA);
            PG8_WAIT_L(8); PG8_BAR; PG8_WAIT_L(0); PG8_MMA(0, 0, At, B0); PG8_BAR; PG8_SCHED;
            PG8_LDB(B1, 0, 1); PG8_STAGE(PG8_SB(0, 0), b2, voffB);
            PG8_BAR; PG8_WAIT_L(0); PG8_MMA(0, 1, At, B1); PG8_BAR;
            PG8_LDA(At, 0, 1); PG8_STAGE(PG8_SA(0, 0), a2, voffA);
            PG8_BAR; PG8_WAIT_L(0); PG8_MMA(1, 0, At, B0); PG8_BAR; PG8_SCHED;
            PG8_STAGE(PG8_SB(0, 1), b2 + hstep, voffB);
            PG8_WAIT_V(6); PG8_BAR; PG8_MMA(1, 1, At, B1); PG8_BAR;
            PG8_LDB(B0, 1, 0); PG8_SCHED; PG8_LDA(At, 1, 0); PG8_STAGE(PG8_SA(0, 1), a2 + hstep, voffA);
            PG8_WAIT_L(8); PG8_BAR; PG8_WAIT_L(0); PG8_MMA(0, 0, At, B0); PG8_BAR; PG8_SCHED;
            PG8_LDB(B1, 1, 1); PG8_STAGE(PG8_SB(1, 0), b3, voffB);
            PG8_BAR; PG8_WAIT_L(0); PG8_MMA(0, 1, At, B1); PG8_BAR;
            PG8_LDA(At, 1, 1); PG8_STAGE(PG8_SA(1, 0), a3, voffA);
            PG8_BAR; PG8_WAIT_L(0); PG8_MMA(1, 0, At, B0); PG8_BAR; PG8_SCHED;
            PG8_STAGE(PG8_SB(1, 1), b3 + hstep, voffB);
            PG8_WAIT_V(6); PG8_BAR; PG8_MMA(1, 1, At, B1); PG8_BAR;
            }
        }
        if constexpr (ALIGN_EPI) { if (wr == 0) PG8_BAR; }
        if constexpr (!Epi::AFTER_DRAIN) { E(acc, cur, wr, wc, fr, fq); S.done(cur); }
        if (!has_next) break;
#pragma unroll
        for (int a = 0; a < 2; ++a)
#pragma unroll
            for (int b = 0; b < 2; ++b)
#pragma unroll
                for (int m = 0; m < 4; ++m)
#pragma unroll
                    for (int n = 0; n < 2; ++n) acc[a][b][m][n] = (f32x4){0.f, 0.f, 0.f, 0.f};
        cur = nxt; cA = nA; cB = nB; ++ui;
        if constexpr (ALIGN_EPI) { if (wr == 1) PG8_BAR; }
    }
    PG8_WAIT_V(0);
    if constexpr (!ALIGN_EPI) { if (wr == 0) PG8_BAR; }
    PG8_BAR;
    if constexpr (Epi::AFTER_DRAIN) { E.fused(acc, cur, wr, wc, fr, fq, lds, wid, lane); S.done(cur); }
#undef PG8_SA
#undef PG8_SB
#undef PG8_STAGE
#undef PG8_LDA
#undef PG8_LDB
#undef PG8_MMA
#undef PG8_WAIT_V
#undef PG8_WAIT_L
#undef PG8_BAR
#undef PG8_SCHED
}
}


#define XB_TMO      128
#define XB_XCNT(j)  (256  + 64 * (j))
#define XB_XSUB(j)  (1280 + 64 * (j))
#define XB_XGEN(j)  (2304 + 64 * (j))
#define XB_TOP      3328
#define XB_TOPGEN   3392
#define XCD_BAR_WORDS 3456
#define XB_SPIN_CAP (1u << 22)

__device__ __forceinline__ unsigned xb_ld(unsigned* p)              { return __hip_atomic_load(p, __ATOMIC_RELAXED, __HIP_MEMORY_SCOPE_AGENT); }
__device__ __forceinline__ unsigned xb_add(unsigned* p, unsigned v) { return __hip_atomic_fetch_add(p, v, __ATOMIC_RELAXED, __HIP_MEMORY_SCOPE_AGENT); }
__device__ __forceinline__ unsigned xb_xcc_id() { return (unsigned)__builtin_amdgcn_s_getreg((3 << 11) | 20) & 0xFu; }
#define XB_SPIN(cond, bar) do { unsigned _sp = 0; while (cond) { __builtin_amdgcn_s_sleep(1); \
    if ((++_sp & 255u) == 0u) { if (xb_ld(&(bar)[XB_TMO])) break; if (_sp > XB_SPIN_CAP) { atomicAdd(&(bar)[XB_TMO], 1u); break; } } } } while (0)

struct XcdBarrier {
    unsigned* bar; unsigned x;
    volatile LAS unsigned* st;
};

__device__ __forceinline__ XcdBarrier xcd_barrier_post(unsigned* bar, volatile LAS unsigned* st) {
    XcdBarrier b; b.bar = bar; b.x = xb_xcc_id(); b.st = st;
    if (threadIdx.x == 0) (void)xb_add(&bar[XB_XCNT(b.x)], 1u);
    return b;
}
__device__ __forceinline__ void xcd_barrier_complete(unsigned* bar, unsigned x, unsigned& nloc, unsigned& nx) {
    const unsigned G = gridDim.x * gridDim.y * gridDim.z;
    unsigned sum, cnt, mine, sp = 0u;
    for (;;) {
        sum = 0u; cnt = 0u; mine = 0u;
#pragma unroll
        for (unsigned j = 0; j < 16; ++j) { const unsigned c = xb_ld(&bar[XB_XCNT(j)]); sum += c; cnt += (c > 0u) ? 1u : 0u; mine = (j == x) ? c : mine; }
        if (sum == G) break;
        __builtin_amdgcn_s_sleep(1);
        if ((++sp & 255u) == 0u) { if (xb_ld(&bar[XB_TMO])) break; if (sp > XB_SPIN_CAP) { atomicAdd(&bar[XB_TMO], 1u); break; } }
    }
    nloc = mine > 0u ? mine : 1u; nx = cnt > 0u ? cnt : 1u;
}

__device__ __forceinline__ void xcd_barrier(const XcdBarrier& b) {
    asm volatile("s_waitcnt vmcnt(0)" ::: "memory");
    __syncthreads();
    if (threadIdx.x == 0) {
        unsigned* bar = b.bar;
        __builtin_amdgcn_s_waitcnt(0);
        unsigned nloc = b.st[0], nx = b.st[1];
        if (nloc == 0u) { xcd_barrier_complete(bar, b.x, nloc, nx); b.st[0] = nloc; b.st[1] = nx; }
        const unsigned old = xb_add(&bar[XB_XSUB(b.x)], 1u);
        const unsigned gen = old / nloc;
        if (old + 1u == (gen + 1u) * nloc) {
            __builtin_amdgcn_fence(__ATOMIC_RELEASE, "agent");
            asm volatile("s_waitcnt vmcnt(0)" ::: "memory");
            const unsigned og = xb_add(&bar[XB_TOP], 1u);
            const unsigned tg = og / nx;
            if (og + 1u == (tg + 1u) * nx) xb_add(&bar[XB_TOPGEN], 1u);
            else XB_SPIN(xb_ld(&bar[XB_TOPGEN]) == tg, bar);
            __builtin_amdgcn_fence(__ATOMIC_ACQUIRE, "agent");
            xb_add(&bar[XB_XGEN(b.x)], 1u);
            asm volatile("s_waitcnt vmcnt(0)" ::: "memory");
        } else {
            XB_SPIN(xb_ld(&bar[XB_XGEN(b.x)]) == gen, bar);
            __builtin_amdgcn_fence(__ATOMIC_ACQUIRE, "agent");
            asm volatile("s_waitcnt vmcnt(0)" ::: "memory");
        }
    }
    __syncthreads();
}


typedef unsigned short bf16_t;
typedef float f32x4 __attribute__((ext_vector_type(4)));
typedef unsigned u32x4 __attribute__((ext_vector_type(4)));
typedef unsigned u32x2 __attribute__((ext_vector_type(2)));
struct Params { const float* in[25]; float* out; unsigned char* ws; int ph_lo, ph_hi; };
#define CAS __attribute__((address_space(4)))
typedef const CAS Params* PP;
__device__ __forceinline__ PP launder(PP p) { asm volatile("" : "+s"(p)); return p; }
enum { I_X = 0, I_META, I_F1N, I_F1GU, I_F1D, I_MIXN, I_WIN, I_MU, I_W0, I_WUP, I_A0, I_AUP, I_GUP, I_KK, I_KA, I_RK, I_LNW, I_LNB, I_BF, I_FON, I_WOUT, I_F2N, I_F2GU, I_F2D, I_FINN };

typedef float f32x2_t __attribute__((ext_vector_type(2))); typedef __bf16 bf16x2v_t __attribute__((ext_vector_type(2)));
__device__ __forceinline__ unsigned pk_bf16(float lo, float hi) { f32x2_t v = {lo, hi}; bf16x2v_t b = __builtin_convertvector(v, bf16x2v_t); return __builtin_bit_cast(unsigned, b); }
__device__ __forceinline__ float bf2f(bf16_t b) { return __uint_as_float(((unsigned)b) << 16); }
__device__ __forceinline__ float wave_sum(float v) {
#pragma unroll
    for (int o = 32; o >= 1; o >>= 1) v += __shfl_xor(v, o);
    return v; }
__device__ __forceinline__ float wave_max(float v) {
#pragma unroll
    for (int o = 32; o >= 1; o >>= 1) v = fmaxf(v, __shfl_xor(v, o));
    return v; }
__device__ __forceinline__ float sigmoid_f(float x) { return __builtin_amdgcn_rcpf(1.0f + __expf(-x)); }

__device__ __forceinline__ void convert_tile(const float* __restrict__ src, bf16_t* __restrict__ dst, const float* __restrict__ gain, int K, int Nsrc, int kind, int tk, int tn, LAS float* T) {
    const int tid = ltid();
    {
        const int nl = (tid & 15) * 4, np = tn * 64 + nl; int sc;
        if (kind == 1) { const int pn = np >> 8, bj = (np >> 7) & 1, i = np & 127; sc = bj * cfg::DFF + pn * 128 + i; }
        else if (kind == 2) { sc = np < 3360 ? np : (np < 3368 ? 6432 + (np - 3360) : (np < 3584 ? -1 : 3360 + (np - 3584))); }
        else sc = np;
#pragma unroll
        for (int i = 0; i < 2; ++i) { const int kl = (tid >> 4) + 32 * i, k = tk * 64 + kl;
            f32x4 v = (f32x4){0.f, 0.f, 0.f, 0.f};
            if (sc >= 0) v = *(const f32x4*)(src + (size_t)k * Nsrc + sc);
            float g = 1.f; if (kind == 1 || kind == 2) g = gain[k]; else if (kind == 3) g = (k >= 1024) ? gain[k - 1024] : 1.f;
            T[kl * 65 + nl] = v[0] * g; T[kl * 65 + nl + 1] = v[1] * g; T[kl * 65 + nl + 2] = v[2] * g; T[kl * 65 + nl + 3] = v[3] * g; }
    }
    __syncthreads();
    {
        const int nl = tid >> 3, k8 = (tid & 7) * 8; u32x4 w;
        w.x = pk_bf16(T[(k8 + 0) * 65 + nl], T[(k8 + 1) * 65 + nl]); w.y = pk_bf16(T[(k8 + 2) * 65 + nl], T[(k8 + 3) * 65 + nl]);
        w.z = pk_bf16(T[(k8 + 4) * 65 + nl], T[(k8 + 5) * 65 + nl]); w.w = pk_bf16(T[(k8 + 6) * 65 + nl], T[(k8 + 7) * 65 + nl]);
        *(u32x4*)(dst + (size_t)(tn * 64 + nl) * K + tk * 64 + k8) = w;
    }
    __syncthreads();
}
__device__ __forceinline__ void phase_convert(PP P, LAS unsigned char* lds) {
    using namespace cfg;
    LAS float* T = (LAS float*)lds;
    constexpr int T_GU = (DM / 64) * (NGU / 64), T_D = (DFF / 64) * (DM / 64), T_IN = (DM / 64) * (NIN / 64), T_OUT = (DM / 64) * (DM / 64);
    constexpr int T_LAYER = 2 * T_GU + 2 * T_D + T_IN + T_OUT;
    for (int t = lbid(); t < DEPTH * T_LAYER; t += gridDim.x) {
        const int l = t / T_LAYER; int r = t - l * T_LAYER;
        bf16_t* wl = (bf16_t*)(P->ws + WS_W + (size_t)l * W_LAYER);
        const float* src; bf16_t* dst; const float* gain = nullptr; int K, Nsrc, kind, ntn;
        if (r < T_GU) { src = P->in[I_F1GU] + (size_t)l * DM * NGU; dst = (bf16_t*)((unsigned char*)wl + WO_GU1); gain = P->in[I_F1N] + l * DM; K = DM; Nsrc = NGU; kind = 1; ntn = NGU / 64; }
        else if ((r -= T_GU) < T_D) { src = P->in[I_F1D] + (size_t)l * DFF * DM; dst = (bf16_t*)((unsigned char*)wl + WO_D1); K = DFF; Nsrc = DM; kind = 0; ntn = DM / 64; }
        else if ((r -= T_D) < T_IN) { src = P->in[I_WIN] + (size_t)l * DM * DIN; dst = (bf16_t*)((unsigned char*)wl + WO_IN); gain = P->in[I_MIXN] + l * DM; K = DM; Nsrc = DIN; kind = 2; ntn = NIN / 64; }
        else if ((r -= T_IN) < T_OUT) { src = P->in[I_WOUT] + (size_t)l * DM * DM; dst = (bf16_t*)((unsigned char*)wl + WO_OUT); gain = P->in[I_FON] + l * FW; K = DM; Nsrc = DM; kind = 3; ntn = DM / 64; }
        else if ((r -= T_OUT) < T_GU) { src = P->in[I_F2GU] + (size_t)l * DM * NGU; dst = (bf16_t*)((unsigned char*)wl + WO_GU2); gain = P->in[I_F2N] + l * DM; K = DM; Nsrc = NGU; kind = 1; ntn = NGU / 64; }
        else { r -= T_GU; src = P->in[I_F2D] + (size_t)l * DFF * DM; dst = (bf16_t*)((unsigned char*)wl + WO_D2); K = DFF; Nsrc = DM; kind = 0; ntn = DM / 64; }
        convert_tile(src, dst, gain, K, Nsrc, kind, r / ntn, r % ntn, T);
    }
}
__device__ __forceinline__ void phase_init(PP P) {
    using namespace cfg;
    const int lane = ltid() & 63, gw = lbid() * 8 + (ltid() >> 6), nw = gridDim.x * 8;
    float* hmeta = (float*)(P->ws + WS_HMETA); bf16_t* hb = (bf16_t*)(P->ws + WS_HB); float* ss0 = (float*)(P->ws + WS_SS);
    for (int row = gw; row < MROWS; row += nw) {
        const float* s = row < MMAIN ? P->in[I_X] + (size_t)row * DM : P->in[I_META] + (size_t)(row - MMAIN) * DM;
        float* d = row < MMAIN ? P->out + (size_t)row * DM : hmeta + (size_t)(row - MMAIN) * DM;
        float sq = 0.f;
#pragma unroll
        for (int i = 0; i < 8; ++i) { f32x4 v = (f32x4){0.f, 0.f, 0.f, 0.f}; if (row < MMAIN + NMETA) v = *(const f32x4*)(s + i * 256 + lane * 4);
            *(f32x4*)(d + i * 256 + lane * 4) = v; sq += (v[0] * v[0] + v[1] * v[1]) + (v[2] * v[2] + v[3] * v[3]);
            u32x2 w; w.x = pk_bf16(v[0], v[1]); w.y = pk_bf16(v[2], v[3]); *(u32x2*)(hb + (size_t)row * DM + i * 256 + lane * 4) = w; }
        sq = wave_sum(sq);
        if (lane < 8) ss0[(size_t)lane * MROWS + row] = lane == 0 ? sq : 0.f;
        if (row >= MMAIN && row < MMAIN + NMETA) { float* ssm0 = (float*)(P->ws + WS_SSM); ssm0[lane * 16 + (row - MMAIN)] = lane == 0 ? sq : 0.f; ssm0[(64 + lane) * 16 + (row - MMAIN)] = 0.f; }
    }
}
__device__ __forceinline__ void phase_foxnorm(PP P) {
    using namespace cfg;
    const int lane = ltid() & 63, gw = lbid() * 8 + (ltid() >> 6), nw = gridDim.x * 8;
    bf16_t* y = (bf16_t*)(P->ws + WS_Y);
    for (int row = gw; row < MMAIN + NMETA; row += nw) {
        bf16_t* p = y + (size_t)row * DM + 1024 + lane * 16;
        u32x4 a = *(const u32x4*)p, b = *(const u32x4*)(p + 8); float v[16];
#pragma unroll
        for (int i = 0; i < 4; ++i) { v[2 * i] = __uint_as_float(a[i] << 16); v[2 * i + 1] = __uint_as_float(a[i] & 0xffff0000u); v[8 + 2 * i] = __uint_as_float(b[i] << 16); v[8 + 2 * i + 1] = __uint_as_float(b[i] & 0xffff0000u); }
        float sq = 0.f;
#pragma unroll
        for (int i = 0; i < 16; ++i) sq += v[i] * v[i];
        sq = wave_sum(sq); const float rs = __builtin_amdgcn_rsqf(sq * (1.0f / 1024.0f) + NORM_EPS);
#pragma unroll
        for (int i = 0; i < 4; ++i) { a[i] = pk_bf16(v[2 * i] * rs, v[2 * i + 1] * rs); b[i] = pk_bf16(v[8 + 2 * i] * rs, v[8 + 2 * i + 1] * rs); }
        *(u32x4*)p = a; *(u32x4*)(p + 8) = b;
    }
}
__device__ __forceinline__ void phase_final(PP P) {
    using namespace cfg;
    const int lane = ltid() & 63, gw = lbid() * 8 + (ltid() >> 6), nw = gridDim.x * 8;
    const float* g = P->in[I_FINN];
    for (int row = gw; row < MMAIN; row += nw) {
        float* d = P->out + (size_t)row * DM; f32x4 v[8]; float sq = 0.f;
#pragma unroll
        for (int i = 0; i < 8; ++i) { v[i] = *(const f32x4*)(d + i * 256 + lane * 4); sq += (v[i][0] * v[i][0] + v[i][1] * v[i][1]) + (v[i][2] * v[i][2] + v[i][3] * v[i][3]); }
        sq = wave_sum(sq); const float rs = __builtin_amdgcn_rsqf(sq * (1.0f / 2048.0f) + NORM_EPS);
#pragma unroll
        for (int i = 0; i < 8; ++i) { const f32x4 gv = *(const f32x4*)(g + i * 256 + lane * 4); *(f32x4*)(d + i * 256 + lane * 4) = v[i] * rs * gv; }
    }
}

__device__ __forceinline__ void rwkv_simple(PP P, int l, int b, int h, LAS unsigned char* lds) {
    using namespace cfg;
    const int tid = ltid(), lane = tid & 63, wave = tid >> 6;
    LAS bf16_t* WUP = (LAS bf16_t*)lds; LAS bf16_t* AUP = WUP + 4096; LAS bf16_t* GUP = AUP + 4096;
    LAS float* RAW = (LAS float*)(lds + 36864); LAS float* LX = RAW + 17 * 480; LAS float* Rm = LX + 16 * 288;
    LAS float* Wm = Rm + 1024; LAS float* KPm = Wm + 1024; LAS float* Vm = KPm + 1024; LAS float* Am = Vm + 1024; LAS float* Bm = Am + 1024; LAS float* Gm = Bm + 1024;
    LAS float* BON = Gm + 1024; LAS float* YR = BON + 16;
    const bf16_t* PR = (const bf16_t*)(P->ws + WS_PR); const float* PS = (const float*)(P->ws + WS_PS); bf16_t* Y = (bf16_t*)(P->ws + WS_Y);
    const float* mu = P->in[I_MU] + l * RWKV_COLS;
    for (int e = tid; e < 64 * 64; e += 512) { const int i = e >> 6, j = e & 63;
        WUP[e] = (bf16_t)(pk_bf16(P->in[I_WUP][((size_t)l * 64 + i) * RW + h * 64 + j], 0.f) & 0xffffu);
        AUP[e] = (bf16_t)(pk_bf16(P->in[I_AUP][((size_t)l * 64 + i) * RW + h * 64 + j], 0.f) & 0xffffu); }
    for (int e = tid; e < 160 * 64; e += 512) { const int i = e >> 6, j = e & 63; GUP[e] = (bf16_t)(pk_bf16(P->in[I_GUP][((size_t)l * 160 + i) * RW + h * 64 + j], 0.f) & 0xffffu); }
    for (int e = tid; e < 480; e += 512) RAW[e] = 0.f;
    const int hj = h * 64 + lane;
    const float w0 = P->in[I_W0][l * RW + hj], a0 = P->in[I_A0][l * RW + hj], kkw = P->in[I_KK][l * RW + hj], kaw = P->in[I_KA][l * RW + hj], rkw = P->in[I_RK][l * RW + hj];
    const float lnw = P->in[I_LNW][l * RW + hj], lnb = P->in[I_LNB][l * RW + hj];
    const float mur = mu[hj], muk = mu[1024 + hj], muv = mu[2048 + hj];
    float S[16];
#pragma unroll
    for (int j = 0; j < 16; ++j) S[j] = 0.f;
    __syncthreads();
    for (int c = 0; c < 257; ++c) {
        const int row0 = (c == 0) ? MMAIN : b * SEQ + (c - 1) * 16;
        for (int e = tid; e < 16 * 480; e += 512) { const int t = e / 480, cc = e - t * 480; const int row = row0 + t; float v;
            if (cc < 192) v = bf2f(PR[(size_t)row * PRW + (cc >> 6) * 1024 + h * 64 + (cc & 63)]); else v = PS[(size_t)row * PSW + (cc - 192)];
            RAW[(t + 1) * 480 + cc] = v; }
        __syncthreads();
        for (int e = tid; e < 16 * 288; e += 512) { const int t = e / 288, i = e - t * 288; const float cur = RAW[(t + 1) * 480 + 192 + i], prv = RAW[t * 480 + 192 + i];
            const float x = cur + (prv - cur) * mu[3072 + i];
            LX[e] = i < 64 ? tanhf(x) : (i < 128 ? x : sigmoid_f(x)); }
        __syncthreads();
#pragma unroll 1
        for (int rep = 0; rep < 2; ++rep) { const int t = wave + 8 * rep;
            float aw = w0, aa = a0, ag = 0.f;
            for (int i = 0; i < 64; ++i) { aw += LX[t * 288 + i] * bf2f(WUP[i * 64 + lane]); aa += LX[t * 288 + 64 + i] * bf2f(AUP[i * 64 + lane]); }
            for (int i = 0; i < 160; ++i) ag += LX[t * 288 + 128 + i] * bf2f(GUP[i * 64 + lane]);
            const float sp = (aw < 0.f ? -aw : 0.f) + log1pf(__expf(-fabsf(aw)));
            const float dec = __expf(-__expf(-sp - 0.5f));
            const float alr = sigmoid_f(aa);
            const float rc = RAW[(t + 1) * 480 + lane], rp = RAW[t * 480 + lane]; const float r = rc + (rp - rc) * mur;
            const float kc = RAW[(t + 1) * 480 + 64 + lane], kp = RAW[t * 480 + 64 + lane]; const float k = kc + (kp - kc) * muk;
            const float vc = RAW[(t + 1) * 480 + 128 + lane], vp = RAW[t * 480 + 128 + lane]; const float v = vc + (vp - vc) * muv;
            const float kkr = k * kkw; const float nrm = sqrtf(wave_sum(kkr * kkr)); const float kk = kkr / fmaxf(nrm, 1e-12f);
            const float kmod = k * (1.0f + (alr - 1.0f) * kaw);
            const float bon = wave_sum(r * kmod * rkw);
            Rm[t * 64 + lane] = r; Wm[t * 64 + lane] = dec; KPm[t * 64 + lane] = kmod; Vm[t * 64 + lane] = v; Am[t * 64 + lane] = -kk; Bm[t * 64 + lane] = kk * alr; Gm[t * 64 + lane] = ag;
            if (lane == 0) BON[t] = bon; }
        __syncthreads();
        for (int e = tid; e < 480; e += 512) RAW[e] = RAW[16 * 480 + e];
        if (wave < 4) { const int vrow = 16 * wave + (lane & 15), q = lane >> 4;
#pragma unroll 1
            for (int t = 0; t < 16; ++t) { float a[16], w[16], bb[16], kk[16], rr[16];
#pragma unroll
                for (int g = 0; g < 4; ++g) { const f32x4 av = *(const LAS f32x4*)(Am + t * 64 + 16 * q + 4 * g), wv = *(const LAS f32x4*)(Wm + t * 64 + 16 * q + 4 * g), bv = *(const LAS f32x4*)(Bm + t * 64 + 16 * q + 4 * g),
                        kv = *(const LAS f32x4*)(KPm + t * 64 + 16 * q + 4 * g), rv = *(const LAS f32x4*)(Rm + t * 64 + 16 * q + 4 * g);
#pragma unroll
                    for (int i = 0; i < 4; ++i) { a[4 * g + i] = av[i]; w[4 * g + i] = wv[i]; bb[4 * g + i] = bv[i]; kk[4 * g + i] = kv[i]; rr[4 * g + i] = rv[i]; } }
                float sa = 0.f;
#pragma unroll
                for (int j = 0; j < 16; ++j) sa += S[j] * a[j];
                sa += __shfl_xor(sa, 16); sa += __shfl_xor(sa, 32);
                const float vv = Vm[t * 64 + vrow]; float y = 0.f;
#pragma unroll
                for (int j = 0; j < 16; ++j) { S[j] = S[j] * w[j] + (sa * bb[j] + vv * kk[j]); y += S[j] * rr[j]; }
                y += __shfl_xor(y, 16); y += __shfl_xor(y, 32);
                if (q == 0) YR[t * 64 + vrow] = y; } }
        __syncthreads();
        if (c > 0 || b == 0) {
#pragma unroll 1
            for (int rep = 0; rep < 2; ++rep) { const int t = wave + 8 * rep; const float yv = YR[t * 64 + lane];
                const float mean = wave_sum(yv) * (1.0f / 64.0f); const float d = yv - mean; const float var = wave_sum(d * d) * (1.0f / 64.0f);
                const float yn = d * __builtin_amdgcn_rsqf(var + LNX_EPS) * lnw + lnb;
                const float o = (yn + BON[t] * Vm[t * 64 + lane]) * Gm[t * 64 + lane];
                Y[(size_t)(row0 + t) * DM + hj] = (bf16_t)(pk_bf16(o, 0.f) & 0xffffu); } }
        __syncthreads();
    }
}

typedef short bf16x8_t __attribute__((ext_vector_type(8)));
typedef short bf16x4_t __attribute__((ext_vector_type(4)));
namespace rk {
constexpr int RAWF0 = 0, RAWF1 = 18432, RAWH0 = 36864, RAWH1 = 43008, LXB = 49152, RS = 58368, KS = 62464, VS = 66560, KKN = 70656, ATP = 74752, RTP = 76800, BTP = 78848, KTP = 80896,
              BHT = 82944, KHT = 84992, VT = 87040, GT = 89088, AAK = 89344, RB = 89856, RKM = 90368, TINV = 90880, GG = 91392, YR = 95488, BONP = 99584, LDS_END = 99840;
}
template <int CTRL> __device__ __forceinline__ float dpp_f(float v) { return __builtin_bit_cast(float, __builtin_amdgcn_update_dpp(0, __builtin_bit_cast(int, v), CTRL, 0xf, 0xf, true)); }
__device__ __forceinline__ float row_sum16(float v) { v += dpp_f<0xB1>(v); v += dpp_f<0x4E>(v); v += dpp_f<0x141>(v); v += dpp_f<0x140>(v); return v; }
__device__ __forceinline__ float rdlane(float v, int l) { return __builtin_bit_cast(float, __builtin_amdgcn_readlane(__builtin_bit_cast(int, v), l)); }
__device__ __forceinline__ float wave_sum_dpp(float v) { v = row_sum16(v); return (rdlane(v, 0) + rdlane(v, 16)) + (rdlane(v, 32) + rdlane(v, 48)); }
#define RK_BAR() do { asm volatile("s_waitcnt lgkmcnt(0)" ::: "memory"); __builtin_amdgcn_s_barrier(); asm volatile("" ::: "memory"); } while (0)
__device__ __forceinline__ bf16_t bf1(float x) { return (bf16_t)(pk_bf16(x, 0.f) & 0xffffu); }
__device__ __forceinline__ bf16x4_t pack4(float a, float b, float c, float d) { u32x2 w; w.x = pk_bf16(a, b); w.y = pk_bf16(c, d); return __builtin_bit_cast(bf16x4_t, w); }
__device__ __forceinline__ float fast_sigmoid(float x) { return __builtin_amdgcn_rcpf(1.0f + __expf(-x)); }
__device__ __forceinline__ float fast_tanh(float x) { return 1.0f - 2.0f * __builtin_amdgcn_rcpf(__expf(2.0f * x) + 1.0f); }

__device__ __forceinline__ void rwkv_chunked(PP P, int l, int b, int h, LAS unsigned char* lds) {
    using namespace cfg;
    const int tid = ltid(), lane = tid & 63, wave = __builtin_amdgcn_readfirstlane(tid >> 6), n = lane & 15, g = lane >> 4;
    const bf16_t* PR = (const bf16_t*)(P->ws + WS_PR); const float* PS = (const float*)(P->ws + WS_PS); bf16_t* Y = (bf16_t*)(P->ws + WS_Y);
    const float* mu = P->in[I_MU] + l * RWKV_COLS;
    LAS float* RSm = (LAS float*)(lds + rk::RS); LAS float* KSm = (LAS float*)(lds + rk::KS); LAS float* VSm = (LAS float*)(lds + rk::VS); LAS float* KKNm = (LAS float*)(lds + rk::KKN);
    LAS bf16_t* LXB = (LAS bf16_t*)(lds + rk::LXB);
    LAS bf16_t* ATp = (LAS bf16_t*)(lds + rk::ATP); LAS bf16_t* RTp = (LAS bf16_t*)(lds + rk::RTP); LAS bf16_t* BTp = (LAS bf16_t*)(lds + rk::BTP); LAS bf16_t* KTp = (LAS bf16_t*)(lds + rk::KTP);
    LAS bf16_t* BHt = (LAS bf16_t*)(lds + rk::BHT); LAS bf16_t* KHt = (LAS bf16_t*)(lds + rk::KHT); LAS bf16_t* Vt = (LAS bf16_t*)(lds + rk::VT);
    LAS float* GTm = (LAS float*)(lds + rk::GT);
    LAS bf16_t* AAKm = (LAS bf16_t*)(lds + rk::AAK); LAS bf16_t* RBm = (LAS bf16_t*)(lds + rk::RB); LAS bf16_t* RKm = (LAS bf16_t*)(lds + rk::RKM); LAS bf16_t* TINVm = (LAS bf16_t*)(lds + rk::TINV);
    LAS float* Gm = (LAS float*)(lds + rk::GG); LAS float* YRm = (LAS float*)(lds + rk::YR); LAS float* BONP = (LAS float*)(lds + rk::BONP);
    const int hj = h * 64 + lane;
    const float mur = mu[hj], muk = mu[1024 + hj], muv = mu[2048 + hj], kkw = P->in[I_KK][l * RW + hj], lnw = P->in[I_LNW][l * RW + hj], lnb = P->in[I_LNB][l * RW + hj];
    float mul[5];
#pragma unroll
    for (int q = 0; q < 5; ++q) mul[q] = (lane + 64 * q < 288) ? mu[3072 + lane + 64 * q] : 0.f;
    const int kw = wave & 3, key = 16 * kw + n, hk = h * 64 + key;
    const float w0k = P->in[I_W0][l * RW + hk], a0k = P->in[I_A0][l * RW + hk], kak = P->in[I_KA][l * RW + hk], rkk = P->in[I_RK][l * RW + hk];
    const int pp = 32 * (key >> 5) + 8 * ((key >> 2) & 3) + 4 * ((key >> 4) & 1) + (key & 3);
    bf16x8_t fA[2], fB[5];
    {
        const float* wu = P->in[I_WUP] + (size_t)l * 64 * RW + hk; const float* au = P->in[I_AUP] + (size_t)l * 64 * RW + hk; const float* gu = P->in[I_GUP] + (size_t)l * 160 * RW + hk;
#pragma unroll
        for (int s = 0; s < 5; ++s) { float v[8], u[8];
#pragma unroll
            for (int j = 0; j < 8; ++j) { const int k = 32 * s + 8 * g + j; v[j] = (wave < 4) ? (s < 2 ? au[(size_t)k * RW] : 0.f) : gu[(size_t)k * RW]; u[j] = (wave < 4 && s < 2) ? wu[(size_t)k * RW] : 0.f; }
            u32x4 w; w.x = pk_bf16(v[0], v[1]); w.y = pk_bf16(v[2], v[3]); w.z = pk_bf16(v[4], v[5]); w.w = pk_bf16(v[6], v[7]); fB[s] = __builtin_bit_cast(bf16x8_t, w);
            if (s < 2) { u32x4 x; x.x = pk_bf16(u[0], u[1]); x.y = pk_bf16(u[2], u[3]); x.z = pk_bf16(u[4], u[5]); x.w = pk_bf16(u[6], u[7]); fA[s] = __builtin_bit_cast(bf16x8_t, x); } }
    }
    f32x4 ST[4];
#pragma unroll
    for (int kb = 0; kb < 4; ++kb) ST[kb] = (f32x4){0.f, 0.f, 0.f, 0.f};
#define RK_DMA(c_, fbuf_, hbuf_) do { const int row0_ = ((c_) == 0) ? MMAIN : b * SEQ + ((c_) - 1) * 16; \
        _Pragma("unroll") for (int i_ = 0; i_ < 3; ++i_) { const int wp_ = wave + 8 * i_; if (wp_ < 18) { const int x_ = wp_ * 64 + lane; \
            __builtin_amdgcn_global_load_lds((const unsigned*)(PS + (size_t)(row0_ + x_ / 72) * PSW + (x_ % 72) * 4), (LAS unsigned*)(lds + (fbuf_) + wp_ * 1024), 16, 0, 0); } } \
        if (wave < 6) { const int y_ = wave * 64 + lane; \
            __builtin_amdgcn_global_load_lds((const unsigned*)(PR + (size_t)(row0_ + y_ / 24) * PRW + ((y_ % 24) >> 3) * 1024 + h * 64 + (y_ & 7) * 8), (LAS unsigned*)(lds + (hbuf_) + wave * 1024), 16, 0, 0); } } while (0)
    RK_DMA(0, rk::RAWF0, rk::RAWH0);
    for (int e = tid; e < 288; e += 512) ((LAS float*)(lds + rk::RAWF1))[15 * 288 + e] = 0.f;
    for (int e = tid; e < 96; e += 512) ((LAS unsigned*)(lds + rk::RAWH1))[15 * 96 + e] = 0u;
    asm volatile("s_waitcnt vmcnt(0)" ::: "memory");
    RK_BAR();
#pragma unroll 1
    for (int c = 0; c < 257; ++c) {
        const int row0 = (c == 0) ? MMAIN : b * SEQ + (c - 1) * 16;
        LAS const float* curF = (LAS const float*)(lds + ((c & 1) ? rk::RAWF1 : rk::RAWF0)); LAS const float* othF = (LAS const float*)(lds + ((c & 1) ? rk::RAWF0 : rk::RAWF1));
        LAS const bf16_t* curH = (LAS const bf16_t*)(lds + ((c & 1) ? rk::RAWH1 : rk::RAWH0)); LAS const bf16_t* othH = (LAS const bf16_t*)(lds + ((c & 1) ? rk::RAWH0 : rk::RAWH1));
#pragma unroll
        for (int rep = 0; rep < 2; ++rep) { const int t = wave + 8 * rep;
            LAS const float* ctF = curF + t * 288; LAS const float* ptF = (t == 0) ? othF + 15 * 288 : curF + (t - 1) * 288;
            LAS const bf16_t* ctH = curH + t * 192; LAS const bf16_t* ptH = (t == 0) ? othH + 15 * 192 : curH + (t - 1) * 192;
            const float rc = bf2f(ctH[lane]), kc = bf2f(ctH[64 + lane]), vc = bf2f(ctH[128 + lane]);
            const float rs = rc + (bf2f(ptH[lane]) - rc) * mur, ks = kc + (bf2f(ptH[64 + lane]) - kc) * muk, vs = vc + (bf2f(ptH[128 + lane]) - vc) * muv;
            RSm[t * 64 + lane] = rs; KSm[t * 64 + lane] = ks; VSm[t * 64 + lane] = vs;
            const float kkr = ks * kkw; const float n2 = wave_sum_dpp(kkr * kkr); KKNm[t * 64 + lane] = kkr * __builtin_amdgcn_rsqf(fmaxf(n2, 1e-24f));
#pragma unroll
            for (int q = 0; q < 5; ++q) { const int i = lane + 64 * q; if (i < 288) { const float xc = ctF[i]; const float x = xc + (ptF[i] - xc) * mul[q];
                    LXB[t * 288 + i] = bf1(q == 0 ? fast_tanh(x) : (q == 1 ? x : fast_sigmoid(x))); } } }
        RK_BAR();
        if (c + 1 < 257) { if (c & 1) RK_DMA(c + 1, rk::RAWF0, rk::RAWH0); else RK_DMA(c + 1, rk::RAWF1, rk::RAWH1); }
        if (wave < 4) {
            f32x4 accW = (f32x4){0.f, 0.f, 0.f, 0.f}, accA = accW;
#pragma unroll
            for (int s = 0; s < 2; ++s) { const bf16x8_t aw = *(const LAS bf16x8_t*)(LXB + n * 288 + 32 * s + 8 * g), aa = *(const LAS bf16x8_t*)(LXB + n * 288 + 64 + 32 * s + 8 * g);
                accW = __builtin_amdgcn_mfma_f32_16x16x32_bf16(aw, fA[s], accW, 0, 0, 0); accA = __builtin_amdgcn_mfma_f32_16x16x32_bf16(aa, fB[s], accA, 0, 0, 0); }
            float lw[4], alr[4], pfx[4];
#pragma unroll
            for (int r = 0; r < 4; ++r) { lw[r] = -0.6065306597126334f * fast_sigmoid(accW[r] + w0k); alr[r] = fast_sigmoid(accA[r] + a0k); }
            pfx[0] = lw[0]; pfx[1] = pfx[0] + lw[1]; pfx[2] = pfx[1] + lw[2]; pfx[3] = pfx[2] + lw[3];
            const float t0 = __shfl(pfx[3], n), t1 = __shfl(pfx[3], n + 16), t2 = __shfl(pfx[3], n + 32), t3 = __shfl(pfx[3], n + 48);
            const float base = (g > 0 ? t0 : 0.f) + (g > 1 ? t1 : 0.f) + (g > 2 ? t2 : 0.f), lamT = (t0 + t1) + (t2 + t3);
            float bh[4], kh[4], bon[4], epos[4];
            const float eb = __expf(base), eT = __expf(lamT);
#pragma unroll
            for (int r = 0; r < 4; ++r) epos[r] = __expf(base + pfx[r]);
#pragma unroll
            for (int r = 0; r < 4; ++r) { const int t = 4 * g + r;
                const float e_pos = epos[r], e_neg = __builtin_amdgcn_rcpf(epos[r]), e_prev = (r == 0) ? eb : epos[r > 0 ? r - 1 : 0], e_hat = eT * e_neg;
                const float rs = RSm[t * 64 + key], ks = KSm[t * 64 + key], kk = KKNm[t * 64 + key];
                const float kmod = ks * (1.0f + (alr[r] - 1.0f) * kak), bb = kk * alr[r];
                ATp[t * 64 + pp] = bf1(-kk * e_prev); RTp[t * 64 + pp] = bf1(rs * e_pos); BTp[t * 64 + pp] = bf1(bb * e_neg); KTp[t * 64 + pp] = bf1(kmod * e_neg);
                bh[r] = bb * e_hat; kh[r] = kmod * e_hat; bon[r] = rs * kmod * rkk; }
            *(LAS bf16x4_t*)(BHt + key * 16 + 4 * g) = pack4(bh[0], bh[1], bh[2], bh[3]); *(LAS bf16x4_t*)(KHt + key * 16 + 4 * g) = pack4(kh[0], kh[1], kh[2], kh[3]);
#pragma unroll
            for (int r = 0; r < 4; ++r) { const float x = row_sum16(bon[r]); if (n == 0) BONP[kw * 16 + 4 * g + r] = x; }
            if (g == 0) GTm[key] = eT;
        } else {
            f32x4 accG = (f32x4){0.f, 0.f, 0.f, 0.f};
#pragma unroll
            for (int s = 0; s < 5; ++s) { const bf16x8_t ag = *(const LAS bf16x8_t*)(LXB + n * 288 + 128 + 32 * s + 8 * g); accG = __builtin_amdgcn_mfma_f32_16x16x32_bf16(ag, fB[s], accG, 0, 0, 0); }
#pragma unroll
            for (int r = 0; r < 4; ++r) Gm[(4 * g + r) * 64 + key] = accG[r];
            *(LAS bf16x4_t*)(Vt + key * 16 + 4 * g) = pack4(VSm[(4 * g) * 64 + key], VSm[(4 * g + 1) * 64 + key], VSm[(4 * g + 2) * 64 + key], VSm[(4 * g + 3) * 64 + key]);
        }
        RK_BAR();
        if (wave < 4) {
            LAS const bf16_t* X = (wave < 2) ? ATp : RTp; LAS const bf16_t* Yi = (wave & 1) ? KTp : BTp;
            f32x4 acc = (f32x4){0.f, 0.f, 0.f, 0.f};
#pragma unroll
            for (int s = 0; s < 2; ++s) { const bf16x8_t xa = *(const LAS bf16x8_t*)(X + n * 64 + 32 * s + 8 * g), yb = *(const LAS bf16x8_t*)(Yi + n * 64 + 32 * s + 8 * g);
                acc = __builtin_amdgcn_mfma_f32_16x16x32_bf16(xa, yb, acc, 0, 0, 0); }
            float mv[4];
#pragma unroll
            for (int r = 0; r < 4; ++r) { const int t = 4 * g + r; const bool keep = (wave < 2) ? (n < t) : (n <= t); mv[r] = keep ? acc[r] : 0.f;
                if (wave == 1) AAKm[t * 16 + n] = bf1(mv[r]); else if (wave == 2) RBm[t * 16 + n] = bf1(mv[r]); else if (wave == 3) RKm[t * 16 + n] = bf1(mv[r]); }
            if (wave == 0) {
                float Tc[16];
#pragma unroll
                for (int t = 0; t < 16; ++t) { float val = (t == n) ? 1.0f : 0.0f;
#pragma unroll
                    for (int i = 0; i < t; ++i) val += rdlane(mv[t & 3], i + 16 * (t >> 2)) * Tc[i];
                    Tc[t] = val; }
                if (g == 0) {
#pragma unroll
                    for (int t = 0; t < 16; ++t) TINVm[t * 16 + n] = bf1(Tc[t]); }
            }
        }
        RK_BAR();
        if (wave < 4) {
            bf16x8_t sb[2];
#pragma unroll
            for (int s = 0; s < 2; ++s) { u32x4 w; w.x = pk_bf16(ST[2 * s][0], ST[2 * s][1]); w.y = pk_bf16(ST[2 * s][2], ST[2 * s][3]); w.z = pk_bf16(ST[2 * s + 1][0], ST[2 * s + 1][1]); w.w = pk_bf16(ST[2 * s + 1][2], ST[2 * s + 1][3]);
                sb[s] = __builtin_bit_cast(bf16x8_t, w); }
            const bf16x4_t vfr = *(const LAS bf16x4_t*)(Vt + key * 16 + 4 * g);
            f32x4 W1 = (f32x4){0.f, 0.f, 0.f, 0.f}, Yc = W1;
#pragma unroll
            for (int s = 0; s < 2; ++s) { const bf16x8_t af = *(const LAS bf16x8_t*)(ATp + n * 64 + 32 * s + 8 * g), rf = *(const LAS bf16x8_t*)(RTp + n * 64 + 32 * s + 8 * g);
                W1 = __builtin_amdgcn_mfma_f32_16x16x32_bf16(af, sb[s], W1, 0, 0, 0); Yc = __builtin_amdgcn_mfma_f32_16x16x32_bf16(rf, sb[s], Yc, 0, 0, 0); }
            W1 = __builtin_amdgcn_mfma_f32_16x16x16bf16_1k(*(const LAS bf16x4_t*)(AAKm + n * 16 + 4 * g), vfr, W1, 0, 0, 0);
            const bf16x4_t w1f = pack4(W1[0], W1[1], W1[2], W1[3]);
            f32x4 U = __builtin_amdgcn_mfma_f32_16x16x16bf16_1k(*(const LAS bf16x4_t*)(TINVm + n * 16 + 4 * g), w1f, (f32x4){0.f, 0.f, 0.f, 0.f}, 0, 0, 0);
            const bf16x4_t uf = pack4(U[0], U[1], U[2], U[3]);
            Yc = __builtin_amdgcn_mfma_f32_16x16x16bf16_1k(*(const LAS bf16x4_t*)(RBm + n * 16 + 4 * g), uf, Yc, 0, 0, 0);
            Yc = __builtin_amdgcn_mfma_f32_16x16x16bf16_1k(*(const LAS bf16x4_t*)(RKm + n * 16 + 4 * g), vfr, Yc, 0, 0, 0);
#pragma unroll
            for (int r = 0; r < 4; ++r) YRm[(4 * g + r) * 64 + key] = Yc[r];
#pragma unroll
            for (int kb = 0; kb < 4; ++kb) { const f32x4 gt = *(const LAS f32x4*)(GTm + 16 * kb + 4 * g); f32x4 a = ST[kb] * gt;
                a = __builtin_amdgcn_mfma_f32_16x16x16bf16_1k(*(const LAS bf16x4_t*)(BHt + (16 * kb + n) * 16 + 4 * g), uf, a, 0, 0, 0);
                a = __builtin_amdgcn_mfma_f32_16x16x16bf16_1k(*(const LAS bf16x4_t*)(KHt + (16 * kb + n) * 16 + 4 * g), vfr, a, 0, 0, 0);
                ST[kb] = a; }
        }
        RK_BAR();
        if (c > 0 || b == 0) {
#pragma unroll
            for (int rep = 0; rep < 2; ++rep) { const int t = wave + 8 * rep; const float yv = YRm[t * 64 + lane];
                const float mean = wave_sum_dpp(yv) * (1.0f / 64.0f); const float d = yv - mean; const float var = wave_sum_dpp(d * d) * (1.0f / 64.0f);
                const float yn = d * __builtin_amdgcn_rsqf(var + LNX_EPS) * lnw + lnb;
                const float bonus = (BONP[t] + BONP[16 + t]) + (BONP[32 + t] + BONP[48 + t]);
                const float o = (yn + bonus * VSm[t * 64 + lane]) * Gm[t * 64 + lane];
                Y[(size_t)(row0 + t) * DM + hj] = bf1(o); } }
        asm volatile("s_waitcnt vmcnt(0)" ::: "memory");
        RK_BAR();
    }
#undef RK_DMA
}

__device__ __forceinline__ f32x4 sk_dot(const bf16_t* a, const bf16_t* b, int nsteps) {
    f32x4 acc = (f32x4){0.f, 0.f, 0.f, 0.f};
#pragma unroll 4
    for (int s = 0; s < nsteps; ++s) { const bf16x8_t av = *(const bf16x8_t*)(a + 32 * s), bv = *(const bf16x8_t*)(b + 32 * s); acc = __builtin_amdgcn_mfma_f32_16x16x32_bf16(av, bv, acc, 0, 0, 0); }
    return acc; }
__device__ __forceinline__ void meta_rs(const float* ssm, int lane, float (&rs)[4]) {
    const int row = lane & 15, part = lane >> 4; float s = 0.f;
#pragma unroll 8
    for (int i = 0; i < 32; ++i) s += ssm[(part + 4 * i) * 16 + row];
    s = s + __shfl_xor(s, 16); s = s + __shfl_xor(s, 32);
    const float rv = __builtin_amdgcn_rsqf(s * (1.0f / 2048.0f) + 1e-6f);
#pragma unroll
    for (int r = 0; r < 4; ++r) rs[r] = __shfl(rv, 4 * part + r); }
#define SK_HEAD const int tid = ltid(), lane = tid & 63, wave = __builtin_amdgcn_readfirstlane(tid >> 6), n = lane & 15, g = lane >> 4, kq = wave & 3, ti = lbid() + 256 * (wave >> 2); LAS f32x4* part = (LAS f32x4*)lds;
#define SK_COMBINE(dst, slot) do { dst = (part[((wave) * 2 + (slot)) * 64 + lane] + part[((wave + 1) * 2 + (slot)) * 64 + lane]) + (part[((wave + 2) * 2 + (slot)) * 64 + lane] + part[((wave + 3) * 2 + (slot)) * 64 + lane]); } while (0)
__device__ __forceinline__ void skinny_gu(const bf16_t* hb, const bf16_t* Bt, const float* ssm, bf16_t* act, LAS unsigned char* lds) {
    using namespace cfg; SK_HEAD
    if (ti < DFF / 16) { const int c0 = 16 * ti, brow = (c0 >> 7) * 256 + (c0 & 127) + n; const bf16_t* a = hb + (size_t)(MMAIN + n) * DM + 512 * kq + 8 * g;
        part[(wave * 2) * 64 + lane] = sk_dot(a, Bt + (size_t)brow * DM + 512 * kq + 8 * g, 16); part[(wave * 2 + 1) * 64 + lane] = sk_dot(a, Bt + (size_t)(brow + 128) * DM + 512 * kq + 8 * g, 16); }
    __syncthreads();
    if (ti < DFF / 16 && kq == 0) { f32x4 gt, up; SK_COMBINE(gt, 0); SK_COMBINE(up, 1); float rs[4]; meta_rs(ssm, lane, rs);
#pragma unroll
        for (int r = 0; r < 4; ++r) { const float gv = gt[r] * rs[r], uv = up[r] * rs[r]; act[(size_t)(MMAIN + 4 * g + r) * DFF + 16 * ti + n] = bf1(gv * __builtin_amdgcn_rcpf(1.0f + __builtin_amdgcn_exp2f(-1.4426950408889634f * gv)) * uv); } }
    __syncthreads();
}
__device__ __forceinline__ void skinny_res(const bf16_t* A16, int K, const bf16_t* Bt, float* hmeta, bf16_t* hb, float* ssm_out, float alpha, LAS unsigned char* lds) {
    using namespace cfg; SK_HEAD
    const int kqs = K / 4;
    if (ti < DM / 16) part[(wave * 2) * 64 + lane] = sk_dot(A16 + (size_t)n * K + kqs * kq + 8 * g, Bt + (size_t)(16 * ti + n) * K + kqs * kq + 8 * g, kqs / 32);
    __syncthreads();
    if (ti < DM / 16 && kq == 0) { f32x4 acc; SK_COMBINE(acc, 0);
#pragma unroll
        for (int r = 0; r < 4; ++r) { const int m = 4 * g + r, col = 16 * ti + n; const float hv = hmeta[m * DM + col] + alpha * acc[r]; hmeta[m * DM + col] = hv; hb[(size_t)(MMAIN + m) * DM + col] = bf1(hv);
            const float sq = row_sum16(hv * hv); if (n == 0) ssm_out[ti * 16 + m] = sq; } }
    __syncthreads();
}
__device__ __forceinline__ void skinny_p(const bf16_t* hb, const bf16_t* Bt, const float* ssm, bf16_t* pr, float* ps, bf16_t* qkv, LAS unsigned char* lds) {
    using namespace cfg; SK_HEAD
    if (ti < NIN / 16) part[(wave * 2) * 64 + lane] = sk_dot(hb + (size_t)(MMAIN + n) * DM + 512 * kq + 8 * g, Bt + (size_t)(16 * ti + n) * DM + 512 * kq + 8 * g, 16);
    __syncthreads();
    if (ti < NIN / 16 && kq == 0) { f32x4 acc; SK_COMBINE(acc, 0); float rs[4]; meta_rs(ssm, lane, rs); const int np = 16 * ti + n;
#pragma unroll
        for (int r = 0; r < 4; ++r) { const int m = 4 * g + r; const float v = acc[r] * rs[r];
            if (np < 3072) pr[(size_t)(MMAIN + m) * PRW + np] = bf1(v);
            else if (np < 3584) ps[(size_t)(MMAIN + m) * PSW + (np - 3072)] = v;
            else { const bf16_t w = bf1(v);
#pragma unroll
                for (int b = 0; b < NBATCH; ++b) qkv[((size_t)b * SEQP + 48 + m) * QKVW + (np - 3584)] = w; } } }
    __syncthreads();
}
#undef SK_HEAD
#undef SK_COMBINE

namespace fox {
constexpr int D = 128, NW = 8, QBLK = 32, KVBLK = 64, QB = NW * QBLK;
constexpr int LDQ = cfg::QKVW, LDK = cfg::QKVW, LDO = cfg::DM;
constexpr float SCALE = 0.08838834764831845f, THR = 8.f;
constexpr bool WSKIP = false;
constexpr int SHM_V = KVBLK * D * 2, SHM_K = KVBLK * D * 2;
constexpr int ATT_LDS = 2 * SHM_V + 2 * SHM_K + NW * 64 * 4;
constexpr int BIAS_OFF = ATT_LDS;
constexpr int SCAN_OFF = BIAS_OFF + cfg::SEQP * 4;

using bf16 = __hip_bfloat16;
typedef short bf16x8 __attribute__((ext_vector_type(8)));
typedef short s16x4 __attribute__((ext_vector_type(4)));
typedef float f32x16 __attribute__((ext_vector_type(16)));
typedef float f32x4 __attribute__((ext_vector_type(4)));
typedef unsigned u32x4 __attribute__((ext_vector_type(4)));
template <class A, class Bt> struct same_t { static constexpr bool v = false; };
template <class A> struct same_t<A, A> { static constexpr bool v = true; };

#define KSWZ(row, colB) ((row) * 256 + ((colB) ^ (((row) & 7) << 4)))
#define SBAR() __builtin_amdgcn_sched_barrier(0)
__device__ __forceinline__ int v_st(int k, int c) { const int kk = (k & ~0xC) | ((k & 4) << 1) | ((k & 8) >> 1); return ((kk >> 3) * 4 + (c >> 5)) * 512 + ((kk & 7) * 32 + (c & 31)) * 2; }
__device__ __forceinline__ int v_rd_base(int lane) { return ((lane & 3) << 3) | (((lane >> 2) & 3) << 6) | (((lane >> 4) & 1) << 5) | (((lane >> 5) & 1) << 8); }
constexpr int v_rd_off(int d0, int ks, int half) { return d0 * 512 + ks * 4096 + half * 2048; }
__device__ __forceinline__ int crow(int r, int hi) { return (r & 3) + 8 * (r >> 2) + 4 * hi; }
__device__ __forceinline__ unsigned cvtpk(float lo, float hi) {
    unsigned r; asm volatile("v_cvt_pk_bf16_f32 %0, %1, %2" : "=v"(r) : "v"(lo), "v"(hi)); return r;
}
__device__ __forceinline__ bf16x8 pack8(f32x4 a, f32x4 b) {
    u32x4 w = {cvtpk(a[0], a[1]), cvtpk(a[2], a[3]), cvtpk(b[0], b[1]), cvtpk(b[2], b[3])};
    return *reinterpret_cast<bf16x8*>(&w);
}
template <class T> __device__ __forceinline__ bf16x8 load8(const T* p) {
    if constexpr (same_t<T, float>::v) { return pack8(*(const f32x4*)p, *(const f32x4*)(p + 4)); }
    else { return *reinterpret_cast<const bf16x8*>(p); }
}
__device__ __forceinline__ void mask_tile(f32x16& p0, f32x16& p1, int dq, unsigned W) {
    const float NEG = -__builtin_inff();
#pragma unroll
    for (int r = 0; r < 16; ++r) {
        const int c = (r & 3) + 8 * (r >> 2);
        if ((unsigned)(dq - c) >= W) p0[r] = NEG;
        if ((unsigned)(dq - c - 32) >= W) p1[r] = NEG;
    }
}
__device__ __forceinline__ void partialSM(f32x16& p0, f32x16& p1, float& m_reg, float& mn, float& alpha) {
    float pmax = p0[0]; for (int r = 1; r < 16; ++r) pmax = fmaxf(pmax, p0[r]); for (int r = 0; r < 16; ++r) pmax = fmaxf(pmax, p1[r]);
    { auto rr = __builtin_amdgcn_permlane32_swap(__float_as_uint(pmax), __float_as_uint(pmax), false, false);
      pmax = fmaxf(__uint_as_float(rr[0]), __uint_as_float(rr[1])); }
    constexpr float C2 = 1.4426950408889634f * SCALE;
    if (__builtin_expect(__all((pmax - m_reg) * SCALE <= THR), 1)) { mn = m_reg; alpha = 1.f; }
    else { mn = fmaxf(m_reg, pmax); alpha = __builtin_amdgcn_exp2f((m_reg - mn) * C2); m_reg = mn; }
    const float mnL = -mn * C2;
    for (int r = 0; r < 16; ++r) p0[r] = fmaf(p0[r], C2, mnL); for (int r = 0; r < 16; ++r) p1[r] = fmaf(p1[r], C2, mnL);
    for (int r = 0; r < 16; ++r) p0[r] = __builtin_amdgcn_exp2f(p0[r]);
}
__device__ __forceinline__ void finishSM(f32x16& p0, f32x16& p1, float alpha, float& l_reg, bf16x8& pa0, bf16x8& pa1, bf16x8& pa2, bf16x8& pa3) {
    for (int r = 0; r < 16; ++r) p1[r] = __builtin_amdgcn_exp2f(p1[r]);
    float ps = 0; for (int r = 0; r < 16; ++r) ps += p0[r]; for (int r = 0; r < 16; ++r) ps += p1[r];
    { auto rr = __builtin_amdgcn_permlane32_swap(__float_as_uint(ps), __float_as_uint(ps), false, false);
      ps = __uint_as_float(rr[0]) + __uint_as_float(rr[1]); }
    l_reg = l_reg * alpha + ps;
#define PK4(P, B_, OUT) do { unsigned a0 = cvtpk(P[B_+0], P[B_+1]), a1 = cvtpk(P[B_+2], P[B_+3]);                          \
        unsigned b0 = cvtpk(P[B_+4], P[B_+5]), b1 = cvtpk(P[B_+6], P[B_+7]);                                             \
        auto r0 = __builtin_amdgcn_permlane32_swap(a0, b0, false, false); auto r1 = __builtin_amdgcn_permlane32_swap(a1, b1, false, false); \
        u32x4 w = {r0[0], r1[0], r0[1], r1[1]}; OUT = *reinterpret_cast<bf16x8*>(&w); } while (0)
    PK4(p0, 0, pa0); PK4(p0, 8, pa1); PK4(p1, 0, pa2); PK4(p1, 8, pa3);
#undef PK4
}
template <int KB, bool SK>
__device__ __forceinline__ void qkt(f32x16& p0, f32x16& p1, const char* K_lds, int r32, int hi, const bf16x8* qr, bool act, const float* bias_t) {
    if (SK && !act) { const float NEG = -__builtin_inff();
#pragma unroll
        for (int r = 0; r < 16; ++r) { p0[r] = NEG; p1[r] = NEG; } return; }
    {
#pragma unroll
        for (int g_ = 0; g_ < 4; ++g_) { const f32x4 b0_ = *(const f32x4*)(bias_t + 8 * g_ + 4 * hi); const f32x4 b1_ = *(const f32x4*)(bias_t + 32 + 8 * g_ + 4 * hi);
            p0[4 * g_] = b0_[0]; p0[4 * g_ + 1] = b0_[1]; p0[4 * g_ + 2] = b0_[2]; p0[4 * g_ + 3] = b0_[3];
            p1[4 * g_] = b1_[0]; p1[4 * g_ + 1] = b1_[1]; p1[4 * g_ + 2] = b1_[2]; p1[4 * g_ + 3] = b1_[3]; } }
    const char* kb[4];
#pragma unroll
    for (int dd = 0; dd < 4; ++dd) kb[dd] = K_lds + KB * SHM_K + KSWZ(r32, (dd * 16 + hi * 8) * 2);
#pragma unroll
    for (int d0 = 0; d0 < 8; ++d0) { const char* a = kb[d0 & 3] + (d0 >> 2) * 128;
        bf16x8 b0 = *reinterpret_cast<const bf16x8*>(a);
        bf16x8 b1 = *reinterpret_cast<const bf16x8*>(a + 32 * 256);
        p0 = __builtin_amdgcn_mfma_f32_32x32x16_bf16(b0, qr[d0], p0, 0, 0, 0);
        p1 = __builtin_amdgcn_mfma_f32_32x32x16_bf16(b1, qr[d0], p1, 0, 0, 0); }
}
template <int VB, bool SK>
__device__ __forceinline__ void pv_tile(f32x16* o, int vb0, bf16x8 pa0, bf16x8 pa1, bf16x8 pa2, bf16x8 pa3, bool act) {
    if (SK && !act) return;
#define TRRD(dst, off) asm volatile("ds_read_b64_tr_b16 %0, %1 offset:%2" : "=&v"(dst) : "v"(vb0), "i"(off) : "memory")
#define PV_D0(d0) do { s16x4 l0, l1, l2, l3, h0, h1, h2, h3; constexpr int b_ = VB * SHM_V + v_rd_off(d0, 0, 0);     \
        TRRD(l0, b_); TRRD(h0, b_ + 2048); TRRD(l1, b_ + 4096); TRRD(h1, b_ + 6144); TRRD(l2, b_ + 8192); TRRD(h2, b_ + 10240); TRRD(l3, b_ + 12288); TRRD(h3, b_ + 14336); \
        asm volatile("s_waitcnt lgkmcnt(0)" ::: "memory"); SBAR();                 \
        o[d0] = __builtin_amdgcn_mfma_f32_32x32x16_bf16(pa0, (bf16x8){l0[0], l0[1], l0[2], l0[3], h0[0], h0[1], h0[2], h0[3]}, o[d0], 0, 0, 0);   \
        o[d0] = __builtin_amdgcn_mfma_f32_32x32x16_bf16(pa1, (bf16x8){l1[0], l1[1], l1[2], l1[3], h1[0], h1[1], h1[2], h1[3]}, o[d0], 0, 0, 0);   \
        o[d0] = __builtin_amdgcn_mfma_f32_32x32x16_bf16(pa2, (bf16x8){l2[0], l2[1], l2[2], l2[3], h2[0], h2[1], h2[2], h2[3]}, o[d0], 0, 0, 0);   \
        o[d0] = __builtin_amdgcn_mfma_f32_32x32x16_bf16(pa3, (bf16x8){l3[0], l3[1], l3[2], l3[3], h3[0], h3[1], h3[2], h3[3]}, o[d0], 0, 0, 0); } while (0)
    PV_D0(0); PV_D0(1); PV_D0(2); PV_D0(3);
#undef PV_D0
#undef TRRD
}

template <class TIn, class TOut> struct BlockRef { const TIn* Q; const TIn* K; const TIn* V; TOut* O; int P0; };
template <class TIn> struct Seam {
    bf16x8 qr[8];
    bf16x8 st_v0, st_v1, st_k0, st_k1; f32x4 sf0, sf1, sf2, sf3;
    f32x4 tq[16];
};
__device__ __forceinline__ int swa_jlo(int P0, int W) { const int lowk = P0 - W + 1; return lowk > 0 ? lowk / KVBLK : 0; }
#define ROW(p, k0, rr) ((p) + (size_t)((k0) + (rr)) * LDK + sc)
#define VMW() asm volatile("s_waitcnt vmcnt(0)" ::: "memory")
#define VMWN(n) asm volatile("s_waitcnt vmcnt(%0)" :: "i"(n) : "memory")
#define SLOAD_H(Kp, Vp, k0) do { S.st_v0 = load8<TIn>(ROW(Vp, k0, sr)); S.st_v1 = load8<TIn>(ROW(Vp, k0, 32 + sr));              \
                         S.st_k0 = load8<TIn>(ROW(Kp, k0, sr)); S.st_k1 = load8<TIn>(ROW(Kp, k0, 32 + sr)); } while (0)
#define SWRITE_HK(bf) do { *(bf16x8*)(K_lds + (bf) * SHM_K + kws) = S.st_k0; *(bf16x8*)(K_lds + (bf) * SHM_K + kws + 32 * 256) = S.st_k1; } while (0)
#define SWRITE_HV(bf) do { *(bf16x8*)(V_lds + (bf) * SHM_V + vst0) = S.st_v0; *(bf16x8*)(V_lds + (bf) * SHM_V + vst1) = S.st_v1; } while (0)
#define SWRITE_H(bf) do { SWRITE_HV(bf); SWRITE_HK(bf); } while (0)
#define SLOAD_F(p, k0) do { S.sf0 = *(const f32x4*)ROW(p, k0, sr); S.sf1 = *(const f32x4*)(ROW(p, k0, sr) + 4);                \
                            S.sf2 = *(const f32x4*)ROW(p, k0, 32 + sr); S.sf3 = *(const f32x4*)(ROW(p, k0, 32 + sr) + 4); } while (0)
#define SWRITE_KF(bf) do { *(bf16x8*)(K_lds + (bf) * SHM_K + kws) = pack8(S.sf0, S.sf1); *(bf16x8*)(K_lds + (bf) * SHM_K + kws + 32 * 256) = pack8(S.sf2, S.sf3); } while (0)
#define SWRITE_VF(bf) do { *(bf16x8*)(V_lds + (bf) * SHM_V + vst0) = pack8(S.sf0, S.sf1); *(bf16x8*)(V_lds + (bf) * SHM_V + vst1) = pack8(S.sf2, S.sf3); } while (0)
template <class TIn, class TOut>
__device__ __forceinline__ void causal_swa_prime(const BlockRef<TIn, TOut>& cur, int W, char* lds, Seam<TIn>& S) {
    constexpr bool F32 = same_t<TIn, float>::v;
    const int tid = ltid(), wid = __builtin_amdgcn_readfirstlane(tid >> 6), lane = tid & 63, r32 = lane & 31, hi = lane >> 5;
    const int sr = tid >> 4, sc = (tid & 15) * 8, kws = KSWZ(sr, sc * 2); char* K_lds = lds + 2 * SHM_V;
    const int kb0 = swa_jlo(cur.P0, W) * KVBLK;
    for (int d0 = 0; d0 < 8; ++d0) S.qr[d0] = load8<TIn>(cur.Q + (size_t)(wid * QBLK + r32) * LDQ + d0 * 16 + hi * 8);
    if constexpr (F32) { SLOAD_F((const float*)cur.K, kb0); VMW(); SWRITE_KF(0); SBAR(); SLOAD_F((const float*)cur.V, kb0); }
    else { SLOAD_H(cur.K, cur.V, kb0); VMW(); SWRITE_HK(0); }
    __syncthreads();
}
template <class TIn, class TOut>
__device__ __forceinline__ void causal_swa_block(const BlockRef<TIn, TOut>& cur, const BlockRef<TIn, TOut>& nxt, int skv, int W, char* lds, Seam<TIn>& S, const float* bias_l) {
    constexpr bool F32 = same_t<TIn, float>::v;
    const int tid = ltid(), wid = __builtin_amdgcn_readfirstlane(tid >> 6), lane = tid & 63, r32 = lane & 31, hi = lane >> 5;
    const int j_lo = swa_jlo(cur.P0, W);
    int j_hi = (cur.P0 + QB - 1) / KVBLK + 1; if (j_hi > skv / KVBLK) j_hi = skv / KVBLK;
    const int NT = j_hi - j_lo;
    const int kbn = swa_jlo(nxt.P0, W) * KVBLK;
    const int qlo = cur.P0 + wid * QBLK, qm = qlo + r32 - 4 * hi;
    char* V_lds = lds; char* K_lds = lds + 2 * SHM_V;
    float* ws = (float*)(lds + 2 * SHM_V + 2 * SHM_K) + wid * 64; float* li_l = ws, * al_l = ws + 32;
    float m_reg = -1e30f, l_reg = 0; f32x16 o[4] = {};
    const int sr = tid >> 4, sc = (tid & 15) * 8, vst0 = v_st(sr, sc), vst1 = v_st(32 + sr, sc), kws = KSWZ(sr, sc * 2);
    const int vb0 = (int)(uintptr_t)V_lds + v_rd_base(lane);
    const TIn* Kh = cur.K; const TIn* Vh = cur.V;
#define RESC(a) do { if (__any((a) < 1.f)) { if (hi == 0) al_l[r32] = (a); asm volatile("s_waitcnt lgkmcnt(0)" ::: "memory");              \
                     for (int d_ = 0; d_ < 4; ++d_) for (int r = 0; r < 16; ++r) o[d_][r] *= al_l[crow(r, hi)]; } } while (0)
#define KBASE(t) ((j_lo + (t)) * KVBLK)
#define ACT(t) (KBASE(t) <= qlo + QBLK - 1 && KBASE(t) + KVBLK - 1 >= qlo - W + 1)
#define MASKT(P0_, P1_, t) do { const int kb_ = KBASE(t); if ((!SK || ACT(t)) && (kb_ + KVBLK - 1 > qlo || kb_ <= qlo + QBLK - 1 - W)) mask_tile(P0_, P1_, qm - kb_, (unsigned)W); } while (0)
    constexpr int NQL = F32 ? 16 : 8;
    constexpr bool SK = WSKIP && !F32;
#define SEAM_K0() do { VMWN(NQL); if constexpr (F32) { SWRITE_KF(0); SBAR(); SLOAD_F((const float*)nxt.V, kbn); } else { SWRITE_HK(0); } SBAR(); } while (0)
    f32x16 pA0, pA1, pB0, pB1; float mnA, mnB, alA, alB; bf16x8 pa0, pa1, pa2, pa3;
    if constexpr (F32) { VMW(); SWRITE_VF(0); SBAR(); } else { SWRITE_HV(0); SBAR(); }
    if (NT > 1) { if constexpr (F32) SLOAD_F((const float*)Kh, KBASE(1)); else SLOAD_H(Kh, Vh, KBASE(1)); }
    SBAR(); qkt<0, SK>(pA0, pA1, K_lds, r32, hi, S.qr, ACT(0), bias_l + KBASE(0));
    if constexpr (F32) { if (NT > 1) { VMW(); SWRITE_KF(1); SBAR(); SLOAD_F((const float*)Vh, KBASE(1)); } }
    MASKT(pA0, pA1, 0); partialSM(pA0, pA1, m_reg, mnA, alA);
    if (NT > 1) { VMW(); if constexpr (F32) { SWRITE_VF(1); SBAR(); if (NT > 2) SLOAD_F((const float*)Kh, KBASE(2)); } else SWRITE_H(1); }
    __syncthreads();
#define HALF_STEP(PX0, PX1, mnX, alX, PY0, PY1, alY, t, KB, VB, SB) do {                                                      \
        SBAR(); qkt<KB, SK>(PX0, PX1, K_lds, r32, hi, S.qr, ACT(t), bias_l + KBASE(t));                                             \
        finishSM(PY0, PY1, alY, l_reg, pa0, pa1, pa2, pa3); SBAR();                                                           \
        if ((t) + 1 < NT) { if constexpr (F32) { VMW(); SWRITE_KF(SB); SBAR(); SLOAD_F((const float*)Vh, KBASE((t) + 1)); }  \
                            else { SLOAD_H(Kh, Vh, KBASE((t) + 1)); } SBAR(); }                                               \
        pv_tile<VB, SK>(o, vb0, pa0, pa1, pa2, pa3, ACT((t) - 1)); MASKT(PX0, PX1, (t)); partialSM(PX0, PX1, m_reg, mnX, alX);                                        \
        __syncthreads();                                                                                                      \
        if ((t) + 1 < NT) { VMW(); if constexpr (F32) { SWRITE_VF(SB); SBAR(); if ((t) + 2 < NT) SLOAD_F((const float*)Kh, KBASE((t) + 2)); } \
                            else { SWRITE_H(SB); } }                                                                          \
        RESC(alX); __syncthreads(); } while (0)
    for (int t = 1; t + 1 < NT; t += 2) {
        HALF_STEP(pB0, pB1, mnB, alB, pA0, pA1, alA, t, 1, 0, 0);
        HALF_STEP(pA0, pA1, mnA, alA, pB0, pB1, alB, t + 1, 0, 1, 1);
    }
    const bool even = (NT & 1) == 0;
    if (even) { SBAR(); qkt<1, SK>(pB0, pB1, K_lds, r32, hi, S.qr, ACT(NT - 1), bias_l + KBASE(NT - 1)); SBAR(); }
#define QROW(e) (nxt.Q + (size_t)(wid * QBLK + r32) * LDQ + ((e) >> 1) * 16 + hi * 8 + ((e) & 1) * 4)
    if constexpr (F32) { SLOAD_F((const float*)nxt.K, kbn); SBAR();
#pragma unroll
        for (int e = 0; e < 8; ++e) S.tq[e] = *(const f32x4*)QROW(e); }
    else { SLOAD_H(nxt.K, nxt.V, kbn); SBAR();
#pragma unroll
        for (int d0 = 0; d0 < 8; ++d0) S.qr[d0] = load8<TIn>(nxt.Q + (size_t)(wid * QBLK + r32) * LDQ + d0 * 16 + hi * 8); }
    SBAR();
    finishSM(pA0, pA1, alA, l_reg, pa0, pa1, pa2, pa3); SBAR();
    if constexpr (F32) {
#pragma unroll
        for (int e = 8; e < 16; ++e) S.tq[e] = *(const f32x4*)QROW(e); SBAR(); }
#undef QROW
    pv_tile<0, SK>(o, vb0, pa0, pa1, pa2, pa3, ACT(even ? NT - 2 : NT - 1));
    if (even) { MASKT(pB0, pB1, NT - 1); partialSM(pB0, pB1, m_reg, mnB, alB); __syncthreads(); RESC(alB);
        finishSM(pB0, pB1, alB, l_reg, pa0, pa1, pa2, pa3); SBAR(); pv_tile<1, SK>(o, vb0, pa0, pa1, pa2, pa3, ACT(NT - 1)); }
    SBAR(); SEAM_K0();
    if (hi == 0) li_l[r32] = l_reg; asm volatile("s_waitcnt lgkmcnt(0)" ::: "memory");
    float rli[16];
#pragma unroll
    for (int r = 0; r < 16; ++r) rli[r] = __builtin_amdgcn_rcpf(li_l[crow(r, hi)]);
    TOut* Ow = cur.O + (size_t)(wid * QBLK) * LDO;
#pragma unroll
    for (int r = 0; r < 16; ++r) { const int orow = crow(r, hi);
#pragma unroll
        for (int d0 = 0; d0 < 4; ++d0) { const float v = o[d0][r] * rli[r];
            if constexpr (same_t<TOut, float>::v) { Ow[(size_t)orow * LDO + d0 * 32 + r32] = v; }
            else { const float vn = __shfl_xor(v, 1);
                   if ((r32 & 1) == 0) *(unsigned*)(Ow + (size_t)orow * LDO + d0 * 32 + r32) = cvtpk(v, vn); } } }
    if constexpr (F32) {
#pragma unroll
        for (int d0 = 0; d0 < 8; ++d0) S.qr[d0] = pack8(S.tq[2 * d0], S.tq[2 * d0 + 1]); }
    __syncthreads();
#undef RESC
#undef KBASE
#undef ACT
#undef MASKT
#undef SEAM_K0
#undef HALF_STEP
}
#undef ROW
#undef VMW
#undef VMWN
#undef SLOAD_H
#undef SWRITE_HK
#undef SWRITE_HV
#undef SWRITE_H
#undef SLOAD_F
#undef SWRITE_KF

}

__device__ __forceinline__ void fox_bias(PP P, int l, int b, int h, float* bias, float* scr) {
    using namespace cfg;
    const int tid = ltid(), lane = tid & 63, wave = tid >> 6;
    const float* PS = (const float*)(P->ws + WS_PS); const float bf = P->in[I_BF][l * FNH + h];
    float lf[9]; float loc = 0.f;
#pragma unroll
    for (int i = 0; i < 9; ++i) { const int pos = tid * 9 + i; float v = 0.f;
        if (pos < NMETA + SEQ) { const int row = pos < NMETA ? MMAIN + pos : b * SEQ + pos - NMETA; const float z = PS[(size_t)row * PSW + 288 + h] + bf;
            v = fminf(z, 0.f) - log1pf(__expf(-fabsf(z))); }
        loc += v; lf[i] = loc; }
    float inc = loc;
#pragma unroll
    for (int o = 1; o < 64; o <<= 1) { const float t = __shfl_up(inc, o); if (lane >= o) inc += t; }
    if (lane == 63) scr[wave] = inc;
    __syncthreads();
    float base = inc - loc;
    for (int w = 0; w < wave; ++w) base += scr[w];
    constexpr float INV = 1.0f / fox::SCALE;
#pragma unroll
    for (int i = 0; i < 9; ++i) { const int pos = tid * 9 + i; if (pos < NMETA + SEQ) bias[48 + pos] = -(base + lf[i]) * INV; }
    if (tid < 48) bias[tid] = -__builtin_inff();
    __syncthreads();
}
__device__ __forceinline__ void fox_meta(PP P, int h, const float* bias) {
    using namespace cfg;
    const int lane = ltid() & 63, wave = ltid() >> 6;
    const bf16_t* QKV = (const bf16_t*)(P->ws + WS_QKV); bf16_t* Y = (bf16_t*)(P->ws + WS_Y);
    for (int rep = 0; rep < 2; ++rep) { const int i = wave + 8 * rep;
        float s = -__builtin_inff();
        if (lane <= i) { const bf16_t* q = QKV + (size_t)(48 + i) * QKVW + h * 128; const bf16_t* k = QKV + (size_t)(48 + lane) * QKVW + 1024 + h * 128; float dot = 0.f;
            for (int d = 0; d < 128; ++d) dot += bf2f(q[d]) * bf2f(k[d]);
            s = (dot + bias[48 + lane]) * fox::SCALE; }
        const float m = wave_max(s); const float p = (lane <= i) ? __expf(s - m) : 0.f; const float lsum = wave_sum(p);
        float o0 = 0.f, o1 = 0.f;
        for (int j = 0; j <= i; ++j) { const float pj = __shfl(p, j); const bf16_t* v = QKV + (size_t)(48 + j) * QKVW + 2048 + h * 128; o0 += pj * bf2f(v[lane]); o1 += pj * bf2f(v[64 + lane]); }
        const float il = 1.0f / lsum;
        Y[(size_t)(MMAIN + i) * DM + 1024 + h * 128 + lane] = (bf16_t)(pk_bf16(o0 * il, 0.f) & 0xffffu);
        Y[(size_t)(MMAIN + i) * DM + 1024 + h * 128 + 64 + lane] = (bf16_t)(pk_bf16(o1 * il, 0.f) & 0xffffu); }
}
__device__ __forceinline__ fox::BlockRef<__hip_bfloat16, __hip_bfloat16> fox_mk(int a, int idx, const __hip_bfloat16* Qb, const __hip_bfloat16* Kb, const __hip_bfloat16* Vb, __hip_bfloat16* Ob) {
    const int pr = 4 * (a & 1) + (idx >> 1); const int x = (idx & 1) ? 15 - pr : pr;
    fox::BlockRef<__hip_bfloat16, __hip_bfloat16> r; r.Q = Qb + (size_t)x * 256 * cfg::QKVW; r.K = Kb; r.V = Vb; r.O = Ob + (size_t)x * 256 * cfg::DM; r.P0 = 64 + 256 * x; return r; }
__device__ __forceinline__ void fox_wg(PP P, int l, int a, char* lds) {
    using namespace cfg;
    typedef __hip_bfloat16 bf;
    const int bh = a >> 1, b = bh >> 3, h = bh & 7;
    float* bias = (float*)(lds + fox::BIAS_OFF); float* scr = (float*)(lds + fox::SCAN_OFF);
    fox_bias(P, l, b, h, bias, scr);
    const bf* QKV = (const bf*)(P->ws + WS_QKV); bf* Y = (bf*)(P->ws + WS_Y);
    const bf* Kb = QKV + (size_t)b * SEQP * QKVW + 1024 + h * 128; const bf* Vb = Kb + 1024; const bf* Qb = QKV + ((size_t)b * SEQP + 64) * QKVW + h * 128;
    bf* Ob = Y + (size_t)b * SEQ * DM + 1024 + h * 128;
    constexpr int W = 1 << 30;
    fox::Seam<bf> S;
    fox::BlockRef<bf, bf> cur = fox_mk(a, 0, Qb, Kb, Vb, Ob);
    fox::causal_swa_prime<bf, bf>(cur, W, lds, S);
#pragma unroll 1
    for (int idx = 0; idx < 8; ++idx) {
        const fox::BlockRef<bf, bf> nxt = (idx < 7) ? fox_mk(a, idx + 1, Qb, Kb, Vb, Ob) : cur;
        fox::causal_swa_block<bf, bf>(cur, nxt, SEQP, W, lds, S, bias);
        cur = nxt;
    }
    if (b == 0) fox_meta(P, h, bias);
}

#define WS_PTR(T, off) ((T*)(Q->ws + (off)))
#define SEAM() do { PP Qb_ = launder(P); XcdBarrier b_; b_.bar = (unsigned*)(Qb_->ws + WS_CTL); b_.x = xb_xcc_id(); b_.st = (volatile LAS unsigned*)(lds + LDS_BARW); xcd_barrier(b_); } while (0)
__global__ void __launch_bounds__(512, 2) hymba_fwd(Params Pv) {
    using namespace cfg;
    PP P = (PP)__builtin_amdgcn_kernarg_segment_ptr();
    extern __shared__ __attribute__((aligned(16))) unsigned char lds_raw[];
    LAS unsigned char* lds = (LAS unsigned char*)lds_raw;
    if (threadIdx.x < 4) ((LAS unsigned*)(lds + LDS_BARW))[threadIdx.x] = 0u;
    __syncthreads();
    { PP Q = launder(P); (void)xcd_barrier_post((unsigned*)(Q->ws + WS_CTL), (volatile LAS unsigned*)(lds + LDS_BARW)); }

    { PP Q = launder(P); phase_convert(Q, lds); phase_init(Q); }
    SEAM();
    {
        PP Q = launder(P); const unsigned char* wl = Q->ws + WS_W + (size_t)0 * W_LAYER;
        pg8::Gemm g{WS_PTR(const bf16_t, WS_HB), (const bf16_t*)(wl + WO_GU1), MMAIN, NGU, DM}; pg8::StaticOrder S; S.init(MMAIN, NGU, (int)gridDim.x, lbid());
        pg8::EpiGU E{WS_PTR(bf16_t, WS_ACT), WS_PTR(const float, WS_SS) + (size_t)(0) * 8 * MROWS};
        pg8::gemm_phase<pg8::EpiGU, pg8::StaticOrder, true, true>(lds, g, S, E);
        skinny_gu(WS_PTR(const bf16_t, WS_HB), g.Bt, WS_PTR(const float, WS_SSM) + (0) * 2048, WS_PTR(bf16_t, WS_ACT), lds);
    }
    SEAM();
    {
        PP Q = launder(P); const unsigned char* wl = Q->ws + WS_W + (size_t)0 * W_LAYER;
        pg8::Gemm g{WS_PTR(const bf16_t, WS_ACT), (const bf16_t*)(wl + WO_D1), MMAIN, DM, DFF}; pg8::StaticOrder S; S.init(MMAIN, DM, (int)gridDim.x, lbid());
        pg8::EpiRes E{Q->out, WS_PTR(bf16_t, WS_HB), WS_PTR(float, WS_SS) + (size_t)(1) * 8 * MROWS, 0.5f, (LAS float*)(lds + 131072)};
        pg8::gemm_phase<pg8::EpiRes, pg8::StaticOrder, true, true>(lds, g, S, E);
        skinny_res(WS_PTR(const bf16_t, WS_ACT) + (size_t)MMAIN * DFF, DFF, g.Bt, WS_PTR(float, WS_HMETA), WS_PTR(bf16_t, WS_HB), WS_PTR(float, WS_SSM) + (1) * 2048, 0.5f, lds);
    }
    SEAM();
    {
        PP Q = launder(P); const unsigned char* wl = Q->ws + WS_W + (size_t)0 * W_LAYER;
        pg8::Gemm g{WS_PTR(const bf16_t, WS_HB), (const bf16_t*)(wl + WO_IN), MMAIN, NIN, DM}; pg8::StaticOrder S; S.init(MMAIN, NIN, (int)gridDim.x, lbid());
        pg8::EpiP E{WS_PTR(bf16_t, WS_PR), WS_PTR(float, WS_PS), WS_PTR(bf16_t, WS_QKV), WS_PTR(const float, WS_SS) + (size_t)(1) * 8 * MROWS};
        pg8::gemm_phase<pg8::EpiP, pg8::StaticOrder, true, true>(lds, g, S, E);
        skinny_p(WS_PTR(const bf16_t, WS_HB), g.Bt, WS_PTR(const float, WS_SSM) + (1) * 2048, WS_PTR(bf16_t, WS_PR), WS_PTR(float, WS_PS), WS_PTR(bf16_t, WS_QKV), lds);
    }
    SEAM();
    {
        PP Q = launder(P); const int u = lbid();
        if (u < 128) rwkv_chunked(Q, 0, u >> 4, u & 15, lds);
        else fox_wg(Q, 0, u - 128, (char*)lds_raw);
    }
    SEAM();
    { PP Q = launder(P); phase_foxnorm(Q); }
    SEAM();
    {
        PP Q = launder(P); const unsigned char* wl = Q->ws + WS_W + (size_t)0 * W_LAYER;
        pg8::Gemm g{WS_PTR(const bf16_t, WS_Y), (const bf16_t*)(wl + WO_OUT), MMAIN, DM, DM}; pg8::StaticOrder S; S.init(MMAIN, DM, (int)gridDim.x, lbid());
        pg8::EpiRes E{Q->out, WS_PTR(bf16_t, WS_HB), WS_PTR(float, WS_SS) + (size_t)(2) * 8 * MROWS, 1.0f, (LAS float*)(lds + 131072)};
        pg8::gemm_phase<pg8::EpiRes, pg8::StaticOrder, true, true>(lds, g, S, E);
        skinny_res(WS_PTR(const bf16_t, WS_Y) + (size_t)MMAIN * DM, DM, g.Bt, WS_PTR(float, WS_HMETA), WS_PTR(bf16_t, WS_HB), WS_PTR(float, WS_SSM) + (2) * 2048, 1.0f, lds);
    }
    SEAM();
    {
        PP Q = launder(P); const unsigned char* wl = Q->ws + WS_W + (size_t)0 * W_LAYER;
        pg8::Gemm g{WS_PTR(const bf16_t, WS_HB), (const bf16_t*)(wl + WO_GU2), MMAIN, NGU, DM}; pg8::StaticOrder S; S.init(MMAIN, NGU, (int)gridDim.x, lbid());
        pg8::EpiGU E{WS_PTR(bf16_t, WS_ACT), WS_PTR(const float, WS_SS) + (size_t)(2) * 8 * MROWS};
        pg8::gemm_phase<pg8::EpiGU, pg8::StaticOrder, true, true>(lds, g, S, E);
        skinny_gu(WS_PTR(const bf16_t, WS_HB), g.Bt, WS_PTR(const float, WS_SSM) + (2) * 2048, WS_PTR(bf16_t, WS_ACT), lds);
    }
    SEAM();
    {
        PP Q = launder(P); const unsigned char* wl = Q->ws + WS_W + (size_t)0 * W_LAYER;
        pg8::Gemm g{WS_PTR(const bf16_t, WS_ACT), (const bf16_t*)(wl + WO_D2), MMAIN, DM, DFF}; pg8::StaticOrder S; S.init(MMAIN, DM, (int)gridDim.x, lbid());
        pg8::EpiRes E{Q->out, WS_PTR(bf16_t, WS_HB), WS_PTR(float, WS_SS) + (size_t)(3) * 8 * MROWS, 0.5f, (LAS float*)(lds + 131072)};
        pg8::gemm_phase<pg8::EpiRes, pg8::StaticOrder, true, true>(lds, g, S, E);
        skinny_res(WS_PTR(const bf16_t, WS_ACT) + (size_t)MMAIN * DFF, DFF, g.Bt, WS_PTR(float, WS_HMETA), WS_PTR(bf16_t, WS_HB), WS_PTR(float, WS_SSM) + (3) * 2048, 0.5f, lds);
    }
    SEAM();
    {
        PP Q = launder(P); const unsigned char* wl = Q->ws + WS_W + (size_t)1 * W_LAYER;
        pg8::Gemm g{WS_PTR(const bf16_t, WS_HB), (const bf16_t*)(wl + WO_GU1), MMAIN, NGU, DM}; pg8::StaticOrder S; S.init(MMAIN, NGU, (int)gridDim.x, lbid());
        pg8::EpiGU E{WS_PTR(bf16_t, WS_ACT), WS_PTR(const float, WS_SS) + (size_t)(3) * 8 * MROWS};
        pg8::gemm_phase<pg8::EpiGU, pg8::StaticOrder, true, true>(lds, g, S, E);
        skinny_gu(WS_PTR(const bf16_t, WS_HB), g.Bt, WS_PTR(const float, WS_SSM) + (3) * 2048, WS_PTR(bf16_t, WS_ACT), lds);
    }
    SEAM();
    {
        PP Q = launder(P); const unsigned char* wl = Q->ws + WS_W + (size_t)1 * W_LAYER;
        pg8::Gemm g{WS_PTR(const bf16_t, WS_ACT), (const bf16_t*)(wl + WO_D1), MMAIN, DM, DFF}; pg8::StaticOrder S; S.init(MMAIN, DM, (int)gridDim.x, lbid());
        pg8::EpiRes E{Q->out, WS_PTR(bf16_t, WS_HB), WS_PTR(float, WS_SS) + (size_t)(4) * 8 * MROWS, 0.5f, (LAS float*)(lds + 131072)};
        pg8::gemm_phase<pg8::EpiRes, pg8::StaticOrder, true, true>(lds, g, S, E);
        skinny_res(WS_PTR(const bf16_t, WS_ACT) + (size_t)MMAIN * DFF, DFF, g.Bt, WS_PTR(float, WS_HMETA), WS_PTR(bf16_t, WS_HB), WS_PTR(float, WS_SSM) + (4) * 2048, 0.5f, lds);
    }
    SEAM();
    {
        PP Q = launder(P); const unsigned char* wl = Q->ws + WS_W + (size_t)1 * W_LAYER;
        pg8::Gemm g{WS_PTR(const bf16_t, WS_HB), (const bf16_t*)(wl + WO_IN), MMAIN, NIN, DM}; pg8::StaticOrder S; S.init(MMAIN, NIN, (int)gridDim.x, lbid());
        pg8::EpiP E{WS_PTR(bf16_t, WS_PR), WS_PTR(float, WS_PS), WS_PTR(bf16_t, WS_QKV), WS_PTR(const float, WS_SS) + (size_t)(4) * 8 * MROWS};
        pg8::gemm_phase<pg8::EpiP, pg8::StaticOrder, true, true>(lds, g, S, E);
        skinny_p(WS_PTR(const bf16_t, WS_HB), g.Bt, WS_PTR(const float, WS_SSM) + (4) * 2048, WS_PTR(bf16_t, WS_PR), WS_PTR(float, WS_PS), WS_PTR(bf16_t, WS_QKV), lds);
    }
    SEAM();
    {
        PP Q = launder(P); const int u = lbid();
        if (u < 128) rwkv_chunked(Q, 1, u >> 4, u & 15, lds);
        else fox_wg(Q, 1, u - 128, (char*)lds_raw);
    }
    SEAM();
    { PP Q = launder(P); phase_foxnorm(Q); }
    SEAM();
    {
        PP Q = launder(P); const unsigned char* wl = Q->ws + WS_W + (size_t)1 * W_LAYER;
        pg8::Gemm g{WS_PTR(const bf16_t, WS_Y), (const bf16_t*)(wl + WO_OUT), MMAIN, DM, DM}; pg8::StaticOrder S; S.init(MMAIN, DM, (int)gridDim.x, lbid());
        pg8::EpiRes E{Q->out, WS_PTR(bf16_t, WS_HB), WS_PTR(float, WS_SS) + (size_t)(5) * 8 * MROWS, 1.0f, (LAS float*)(lds + 131072)};
        pg8::gemm_phase<pg8::EpiRes, pg8::StaticOrder, true, true>(lds, g, S, E);
        skinny_res(WS_PTR(const bf16_t, WS_Y) + (size_t)MMAIN * DM, DM, g.Bt, WS_PTR(float, WS_HMETA), WS_PTR(bf16_t, WS_HB), WS_PTR(float, WS_SSM) + (5) * 2048, 1.0f, lds);
    }
    SEAM();
    {
        PP Q = launder(P); const unsigned char* wl = Q->ws + WS_W + (size_t)1 * W_LAYER;
        pg8::Gemm g{WS_PTR(const bf16_t, WS_HB), (const bf16_t*)(wl + WO_GU2), MMAIN, NGU, DM}; pg8::StaticOrder S; S.init(MMAIN, NGU, (int)gridDim.x, lbid());
        pg8::EpiGU E{WS_PTR(bf16_t, WS_ACT), WS_PTR(const float, WS_SS) + (size_t)(5) * 8 * MROWS};
        pg8::gemm_phase<pg8::EpiGU, pg8::StaticOrder, true, true>(lds, g, S, E);
        skinny_gu(WS_PTR(const bf16_t, WS_HB), g.Bt, WS_PTR(const float, WS_SSM) + (5) * 2048, WS_PTR(bf16_t, WS_ACT), lds);
    }
    SEAM();
    {
        PP Q = launder(P); const unsigned char* wl = Q->ws + WS_W + (size_t)1 * W_LAYER;
        pg8::Gemm g{WS_PTR(const bf16_t, WS_ACT), (const bf16_t*)(wl + WO_D2), MMAIN, DM, DFF}; pg8::StaticOrder S; S.init(MMAIN, DM, (int)gridDim.x, lbid());
        pg8::EpiRes E{Q->out, WS_PTR(bf16_t, WS_HB), WS_PTR(float, WS_SS) + (size_t)(6) * 8 * MROWS, 0.5f, (LAS float*)(lds + 131072)};
        pg8::gemm_phase<pg8::EpiRes, pg8::StaticOrder, true, true>(lds, g, S, E);
        skinny_res(WS_PTR(const bf16_t, WS_ACT) + (size_t)MMAIN * DFF, DFF, g.Bt, WS_PTR(float, WS_HMETA), WS_PTR(bf16_t, WS_HB), WS_PTR(float, WS_SSM) + (6) * 2048, 0.5f, lds);
    }
    SEAM();
    {
        PP Q = launder(P); const unsigned char* wl = Q->ws + WS_W + (size_t)2 * W_LAYER;
        pg8::Gemm g{WS_PTR(const bf16_t, WS_HB), (const bf16_t*)(wl + WO_GU1), MMAIN, NGU, DM}; pg8::StaticOrder S; S.init(MMAIN, NGU, (int)gridDim.x, lbid());
        pg8::EpiGU E{WS_PTR(bf16_t, WS_ACT), WS_PTR(const float, WS_SS) + (size_t)(6) * 8 * MROWS};
        pg8::gemm_phase<pg8::EpiGU, pg8::StaticOrder, true, true>(lds, g, S, E);
        skinny_gu(WS_PTR(const bf16_t, WS_HB), g.Bt, WS_PTR(const float, WS_SSM) + (6) * 2048, WS_PTR(bf16_t, WS_ACT), lds);
    }
    SEAM();
    {
        PP Q = launder(P); const unsigned char* wl = Q->ws + WS_W + (size_t)2 * W_LAYER;
        pg8::Gemm g{WS_PTR(const bf16_t, WS_ACT), (const bf16_t*)(wl + WO_D1), MMAIN, DM, DFF}; pg8::StaticOrder S; S.init(MMAIN, DM, (int)gridDim.x, lbid());
        pg8::EpiRes E{Q->out, WS_PTR(bf16_t, WS_HB), WS_PTR(float, WS_SS) + (size_t)(7) * 8 * MROWS, 0.5f, (LAS float*)(lds + 131072)};
        pg8::gemm_phase<pg8::EpiRes, pg8::StaticOrder, true, true>(lds, g, S, E);
        skinny_res(WS_PTR(const bf16_t, WS_ACT) + (size_t)MMAIN * DFF, DFF, g.Bt, WS_PTR(float, WS_HMETA), WS_PTR(bf16_t, WS_HB), WS_PTR(float, WS_SSM) + (7) * 2048, 0.5f, lds);
    }
    SEAM();
    {
        PP Q = launder(P); const unsigned char* wl = Q->ws + WS_W + (size_t)2 * W_LAYER;
        pg8::Gemm g{WS_PTR(const bf16_t, WS_HB), (const bf16_t*)(wl + WO_IN), MMAIN, NIN, DM}; pg8::StaticOrder S; S.init(MMAIN, NIN, (int)gridDim.x, lbid());
        pg8::EpiP E{WS_PTR(bf16_t, WS_PR), WS_PTR(float, WS_PS), WS_PTR(bf16_t, WS_QKV), WS_PTR(const float, WS_SS) + (size_t)(7) * 8 * MROWS};
        pg8::gemm_phase<pg8::EpiP, pg8::StaticOrder, true, true>(lds, g, S, E);
        skinny_p(WS_PTR(const bf16_t, WS_HB), g.Bt, WS_PTR(const float, WS_SSM) + (7) * 2048, WS_PTR(bf16_t, WS_PR), WS_PTR(float, WS_PS), WS_PTR(bf16_t, WS_QKV), lds);
    }
    SEAM();
    {
        PP Q = launder(P); const int u = lbid();
        if (u < 128) rwkv_chunked(Q, 2, u >> 4, u & 15, lds);
        else fox_wg(Q, 2, u - 128, (char*)lds_raw);
    }
    SEAM();
    { PP Q = launder(P); phase_foxnorm(Q); }
    SEAM();
    {
        PP Q = launder(P); const unsigned char* wl = Q->ws + WS_W + (size_t)2 * W_LAYER;
        pg8::Gemm g{WS_PTR(const bf16_t, WS_Y), (const bf16_t*)(wl + WO_OUT), MMAIN, DM, DM}; pg8::StaticOrder S; S.init(MMAIN, DM, (int)gridDim.x, lbid());
        pg8::EpiRes E{Q->out, WS_PTR(bf16_t, WS_HB), WS_PTR(float, WS_SS) + (size_t)(8) * 8 * MROWS, 1.0f, (LAS float*)(lds + 131072)};
        pg8::gemm_phase<pg8::EpiRes, pg8::StaticOrder, true, true>(lds, g, S, E);
        skinny_res(WS_PTR(const bf16_t, WS_Y) + (size_t)MMAIN * DM, DM, g.Bt, WS_PTR(float, WS_HMETA), WS_PTR(bf16_t, WS_HB), WS_PTR(float, WS_SSM) + (8) * 2048, 1.0f, lds);
    }
    SEAM();
    {
        PP Q = launder(P); const unsigned char* wl = Q->ws + WS_W + (size_t)2 * W_LAYER;
        pg8::Gemm g{WS_PTR(const bf16_t, WS_HB), (const bf16_t*)(wl + WO_GU2), MMAIN, NGU, DM}; pg8::StaticOrder S; S.init(MMAIN, NGU, (int)gridDim.x, lbid());
        pg8::EpiGU E{WS_PTR(bf16_t, WS_ACT), WS_PTR(const float, WS_SS) + (size_t)(8) * 8 * MROWS};
        pg8::gemm_phase<pg8::EpiGU, pg8::StaticOrder, true, true>(lds, g, S, E);
        skinny_gu(WS_PTR(const bf16_t, WS_HB), g.Bt, WS_PTR(const float, WS_SSM) + (8) * 2048, WS_PTR(bf16_t, WS_ACT), lds);
    }
    SEAM();
    {
        PP Q = launder(P); const unsigned char* wl = Q->ws + WS_W + (size_t)2 * W_LAYER;
        pg8::Gemm g{WS_PTR(const bf16_t, WS_ACT), (const bf16_t*)(wl + WO_D2), MMAIN, DM, DFF}; pg8::StaticOrder S; S.init(MMAIN, DM, (int)gridDim.x, lbid());
        pg8::EpiRes E{Q->out, WS_PTR(bf16_t, WS_HB), WS_PTR(float, WS_SS) + (size_t)(9) * 8 * MROWS, 0.5f, (LAS float*)(lds + 131072)};
        pg8::gemm_phase<pg8::EpiRes, pg8::StaticOrder, true, true>(lds, g, S, E);
        skinny_res(WS_PTR(const bf16_t, WS_ACT) + (size_t)MMAIN * DFF, DFF, g.Bt, WS_PTR(float, WS_HMETA), WS_PTR(bf16_t, WS_HB), WS_PTR(float, WS_SSM) + (9) * 2048, 0.5f, lds);
    }
    SEAM();
    {
        PP Q = launder(P); const unsigned char* wl = Q->ws + WS_W + (size_t)3 * W_LAYER;
        pg8::Gemm g{WS_PTR(const bf16_t, WS_HB), (const bf16_t*)(wl + WO_GU1), MMAIN, NGU, DM}; pg8::StaticOrder S; S.init(MMAIN, NGU, (int)gridDim.x, lbid());
        pg8::EpiGU E{WS_PTR(bf16_t, WS_ACT), WS_PTR(const float, WS_SS) + (size_t)(9) * 8 * MROWS};
        pg8::gemm_phase<pg8::EpiGU, pg8::StaticOrder, true, true>(lds, g, S, E);
        skinny_gu(WS_PTR(const bf16_t, WS_HB), g.Bt, WS_PTR(const float, WS_SSM) + (9) * 2048, WS_PTR(bf16_t, WS_ACT), lds);
    }
    SEAM();
    {
        PP Q = launder(P); const unsigned char* wl = Q->ws + WS_W + (size_t)3 * W_LAYER;
        pg8::Gemm g{WS_PTR(const bf16_t, WS_ACT), (const bf16_t*)(wl + WO_D1), MMAIN, DM, DFF}; pg8::StaticOrder S; S.init(MMAIN, DM, (int)gridDim.x, lbid());
        pg8::EpiRes E{Q->out, WS_PTR(bf16_t, WS_HB), WS_PTR(float, WS_SS) + (size_t)(10) * 8 * MROWS, 0.5f, (LAS float*)(lds + 131072)};
        pg8::gemm_phase<pg8::EpiRes, pg8::StaticOrder, true, true>(lds, g, S, E);
        skinny_res(WS_PTR(const bf16_t, WS_ACT) + (size_t)MMAIN * DFF, DFF, g.Bt, WS_PTR(float, WS_HMETA), WS_PTR(bf16_t, WS_HB), WS_PTR(float, WS_SSM) + (10) * 2048, 0.5f, lds);
    }
    SEAM();
    {
        PP Q = launder(P); const unsigned char* wl = Q->ws + WS_W + (size_t)3 * W_LAYER;
        pg8::Gemm g{WS_PTR(const bf16_t, WS_HB), (const bf16_t*)(wl + WO_IN), MMAIN, NIN, DM}; pg8::StaticOrder S; S.init(MMAIN, NIN, (int)gridDim.x, lbid());
        pg8::EpiP E{WS_PTR(bf16_t, WS_PR), WS_PTR(float, WS_PS), WS_PTR(bf16_t, WS_QKV), WS_PTR(const float, WS_SS) + (size_t)(10) * 8 * MROWS};
        pg8::gemm_phase<pg8::EpiP, pg8::StaticOrder, true, true>(lds, g, S, E);
        skinny_p(WS_PTR(const bf16_t, WS_HB), g.Bt, WS_PTR(const float, WS_SSM) + (10) * 2048, WS_PTR(bf16_t, WS_PR), WS_PTR(float, WS_PS), WS_PTR(bf16_t, WS_QKV), lds);
    }
    SEAM();
    {
        PP Q = launder(P); const int u = lbid();
        if (u < 128) rwkv_chunked(Q, 3, u >> 4, u & 15, lds);
        else fox_wg(Q, 3, u - 128, (char*)lds_raw);
    }
    SEAM();
    { PP Q = launder(P); phase_foxnorm(Q); }
    SEAM();
    {
        PP Q = launder(P); const unsigned char* wl = Q->ws + WS_W + (size_t)3 * W_LAYER;
        pg8::Gemm g{WS_PTR(const bf16_t, WS_Y), (const bf16_t*)(wl + WO_OUT), MMAIN, DM, DM}; pg8::StaticOrder S; S.init(MMAIN, DM, (int)gridDim.x, lbid());
        pg8::EpiRes E{Q->out, WS_PTR(bf16_t, WS_HB), WS_PTR(float, WS_SS) + (size_t)(11) * 8 * MROWS, 1.0f, (LAS float*)(lds + 131072)};
        pg8::gemm_phase<pg8::EpiRes, pg8::StaticOrder, true, true>(lds, g, S, E);
        skinny_res(WS_PTR(const bf16_t, WS_Y) + (size_t)MMAIN * DM, DM, g.Bt, WS_PTR(float, WS_HMETA), WS_PTR(bf16_t, WS_HB), WS_PTR(float, WS_SSM) + (11) * 2048, 1.0f, lds);
    }
    SEAM();
    {
        PP Q = launder(P); const unsigned char* wl = Q->ws + WS_W + (size_t)3 * W_LAYER;
        pg8::Gemm g{WS_PTR(const bf16_t, WS_HB), (const bf16_t*)(wl + WO_GU2), MMAIN, NGU, DM}; pg8::StaticOrder S; S.init(MMAIN, NGU, (int)gridDim.x, lbid());
        pg8::EpiGU E{WS_PTR(bf16_t, WS_ACT), WS_PTR(const float, WS_SS) + (size_t)(11) * 8 * MROWS};
        pg8::gemm_phase<pg8::EpiGU, pg8::StaticOrder, true, true>(lds, g, S, E);
        skinny_gu(WS_PTR(const bf16_t, WS_HB), g.Bt, WS_PTR(const float, WS_SSM) + (11) * 2048, WS_PTR(bf16_t, WS_ACT), lds);
    }
    SEAM();
    {
        PP Q = launder(P); const unsigned char* wl = Q->ws + WS_W + (size_t)3 * W_LAYER;
        pg8::Gemm g{WS_PTR(const bf16_t, WS_ACT), (const bf16_t*)(wl + WO_D2), MMAIN, DM, DFF}; pg8::StaticOrder S; S.init(MMAIN, DM, (int)gridDim.x, lbid());
        pg8::EpiRes E{Q->out, WS_PTR(bf16_t, WS_HB), WS_PTR(float, WS_SS) + (size_t)(12) * 8 * MROWS, 0.5f, (LAS float*)(lds + 131072)};
        pg8::gemm_phase<pg8::EpiRes, pg8::StaticOrder, true, true>(lds, g, S, E);
        skinny_res(WS_PTR(const bf16_t, WS_ACT) + (size_t)MMAIN * DFF, DFF, g.Bt, WS_PTR(float, WS_HMETA), WS_PTR(bf16_t, WS_HB), WS_PTR(float, WS_SSM) + (12) * 2048, 0.5f, lds);
    }
    SEAM();
    { PP Q = launder(P); phase_final(Q); }
}

extern "C" void kernel_launch(void* const* d_in, const int* in_sizes, int n_in, void* d_out, int out_size, void* d_ws, size_t ws_size, hipStream_t stream) {
    using namespace cfg;
    static int grid = 0;
    if (grid == 0) {
        if (n_in != 25 || out_size != MMAIN * DM || ws_size < WS_END) { fprintf(stderr, "kernel_launch: need 25 inputs, out %d, ws >= %zu; got n_in %d out %d ws %zu\n", MMAIN * DM, (size_t)WS_END, n_in, out_size, ws_size); grid = -1; return; }
        int dev = 0, cus = 0, per_cu = 0;
        if (hipGetDevice(&dev) != hipSuccess || hipDeviceGetAttribute(&cus, hipDeviceAttributeMultiprocessorCount, dev) != hipSuccess) { grid = -1; return; }
        if (hipFuncSetAttribute((const void*)hymba_fwd, hipFuncAttributeMaxDynamicSharedMemorySize, LDS_BYTES) != hipSuccess) { fprintf(stderr, "kernel_launch: hipFuncSetAttribute failed\n"); grid = -1; return; }
        if (hipOccupancyMaxActiveBlocksPerMultiprocessor(&per_cu, (const void*)hymba_fwd, 512, LDS_BYTES) != hipSuccess || per_cu < 1) fprintf(stderr, "kernel_launch: occupancy query says %d\n", per_cu);
        (void)hipGetLastError();
        if (cus < 256) { fprintf(stderr, "kernel_launch: built for a 256-CU device (one resident workgroup per CU), found %d CUs\n", cus); grid = -1; return; }
        grid = 256;
    }
    if (grid < 0) return;
    if (hipMemsetAsync((char*)d_ws + WS_CTL, 0, CTL_BYTES, stream) != hipSuccess) return;
    Params p{};
    for (int i = 0; i < 25; ++i) p.in[i] = (const float*)d_in[i];
    p.out = (float*)d_out; p.ws = (unsigned char*)d_ws; p.ph_lo = 0; p.ph_hi = 0;
    hipLaunchKernelGGL(hymba_fwd, dim3(grid), dim3(512), LDS_BYTES, stream, p);
}
```

```cpp
#include <hip/hip_runtime.h>
#include <hip/hip_bf16.h>
#include <cstdio>
#include <cstdint>

#define LAS __attribute__((address_space(3)))
namespace cfg {
constexpr int DM = 2048, NBATCH = 8, SEQ = 4096, NMETA = 16, DEPTH = 4;
constexpr int MMAIN = NBATCH * SEQ;
constexpr int MROWS = MMAIN + 256;
constexpr int DFF = 5632, NGU = 2 * DFF;
constexpr int RW = 1024, RH = 64, RNH = 16;
constexpr int FW = 1024, FH = 128, FNH = 8;
constexpr int RWKV_COLS = 3360, DIN = 6440;
constexpr int NIN = 6656;
constexpr int PRW = 3072, PSW = 512, QKVW = 3072;
constexpr int SEQP = 4160;
constexpr float NORM_EPS = 1e-6f, LNX_EPS = 64e-5f;
constexpr int NSS = 13;
constexpr size_t al256(size_t x) { return (x + 255) & ~(size_t)255; }
constexpr size_t WS_CTL = 0;
constexpr size_t CTL_BYTES = 65536;
constexpr size_t WS_SS = WS_CTL + CTL_BYTES;
constexpr size_t SS_BYTES = al256((size_t)NSS * 8 * MROWS * 4);
constexpr size_t ZERO_BYTES = CTL_BYTES + SS_BYTES;
constexpr size_t WS_SSM = WS_SS + SS_BYTES;
constexpr size_t SSM_BYTES = (size_t)NSS * 2048 * 4;
constexpr size_t WS_HMETA = WS_SSM + SSM_BYTES;
constexpr size_t WS_HB = WS_HMETA + (size_t)256 * DM * 4;
constexpr size_t WS_Y = WS_HB + (size_t)MROWS * DM * 2;
constexpr size_t WS_OVL = WS_Y + (size_t)MROWS * DM * 2;
constexpr size_t WS_ACT = WS_OVL;
constexpr size_t WS_PR = WS_OVL;
constexpr size_t WS_PS = WS_PR + (size_t)MROWS * PRW * 2;
constexpr size_t WS_QKV = WS_PS + (size_t)MROWS * PSW * 4;
constexpr size_t OVL_A = (size_t)MROWS * DFF * 2, OVL_B = (size_t)MROWS * PRW * 2 + (size_t)MROWS * PSW * 4 + (size_t)NBATCH * SEQP * QKVW * 2;
constexpr size_t WS_W = WS_OVL + al256(OVL_A > OVL_B ? OVL_A : OVL_B);
constexpr size_t W_GU = (size_t)NGU * DM * 2, W_D = (size_t)DM * DFF * 2, W_IN = (size_t)NIN * DM * 2, W_OUT = (size_t)DM * DM * 2;
constexpr size_t WO_GU1 = 0, WO_D1 = WO_GU1 + W_GU, WO_IN = WO_D1 + W_D, WO_OUT = WO_IN + W_IN, WO_GU2 = WO_OUT + W_OUT, WO_D2 = WO_GU2 + W_GU, W_LAYER = WO_D2 + W_D;
constexpr size_t WS_END = WS_W + (size_t)DEPTH * W_LAYER;
constexpr int LDS_BYTES = 147456;
constexpr int LDS_BARW = LDS_BYTES - 16;
}
__device__ __forceinline__ int ltid() { int t = (int)threadIdx.x; asm volatile("" : "+v"(t)); return t; }
__device__ __forceinline__ int lbid() { int t = (int)blockIdx.x; asm volatile("" : "+s"(t)); return t; }
__device__ __forceinline__ int lzero() { int t = 0; asm volatile("" : "+v"(t)); return t; }
namespace pg8 {
#define PG8_LAS __attribute__((address_space(3)))
typedef unsigned short bf16_t;
typedef short bf16x8 __attribute__((ext_vector_type(8)));
typedef float f32x4 __attribute__((ext_vector_type(4)));
typedef unsigned u32x4 __attribute__((ext_vector_type(4)));
constexpr int BM = 256, BK = 64, HALF = 128, HTB = HALF * BK * 2  , STAGE_BYTES = 8 * HTB, NXCD = 8, WGM = 8;

__host__ __device__ __forceinline__ int lds_byte(int r, int c) { const int st = (r >> 4) * 2 + (c >> 5), rr = r & 15, cc = c & 31, ob = rr * 64 + cc * 2; return st * 1024 + (ob ^ (((ob >> 9) & 1) << 5)); }
__host__ __device__ __forceinline__ void stage_rc(int b, int& R, int& C) { const int st = b / 1024, sb = b % 1024, swz = sb ^ (((sb >> 9) & 1) << 5); R = (st >> 1) * 16 + swz / 64; C = (st & 1) * 32 + (swz % 64) / 2; }
__host__ __device__ __forceinline__ int perm32(int rho) { const int n = rho >> 4, i = rho & 15; return 8 * (i >> 2) + 4 * n + (i & 3); }

struct Unit { int pm, pn; };
struct Gemm { const bf16_t* A; const bf16_t* Bt; int M, N, K; };

struct StaticOrder {
    int nM, nN, nwg, G, c;
    __host__ __device__ void init(int M, int N, int G_, int c_) { nM = M / BM; nN = N / BM; nwg = nM * nN; G = G_; c = c_; }
    __host__ __device__ bool next(int i, Unit& u) const {
        const long L = (long)i * G + c; if (L >= nwg) return false;
        int wgid = (int)L; { const int q = nwg / NXCD, r = nwg % NXCD, xcd = wgid % NXCD, off = wgid / NXCD; wgid = (xcd < r ? xcd * (q + 1) : r * (q + 1) + (xcd - r) * q) + off; }
        const int nig = WGM * nN, gid = wgid / nig, fm = gid * WGM, gsz = (nM - fm) < WGM ? (nM - fm) : WGM;
        u.pm = fm + ((wgid % nig) % gsz); u.pn = (wgid % nig) / gsz; return true;
    }
    __device__ __forceinline__ void a_ready(const Unit&) const {}
    __device__ __forceinline__ void done(const Unit&) const {}
};

__device__ __forceinline__ unsigned cvt_pk_bf16(float lo, float hi) { unsigned r; asm volatile("v_cvt_pk_bf16_f32 %0, %1, %2" : "=v"(r) : "v"(lo), "v"(hi)); return r; }
typedef float f32x2 __attribute__((ext_vector_type(2)));
__device__ __forceinline__ f32x2 gelu_pk(f32x2 v) {
    const f32x2 av = __builtin_elementwise_abs(v), d = av * 0.2316418882f + 1.0f;
    f32x2 t; t.x = __builtin_amdgcn_rcpf(d.x); t.y = __builtin_amdgcn_rcpf(d.y);
    f32x2 q = t * 0.5307027145f + (-0.7265760135f); q = q * t + 0.7107068705f; q = q * t + (-0.142248368f); q = q * t + 0.127414796f; q = q * t;
    const f32x2 s = (v * v) * (-0.72134752044f);
    f32x2 e; e.x = __builtin_amdgcn_exp2f(s.x); e.y = __builtin_amdgcn_exp2f(s.y);
    const f32x2 m = v * (q * e), r = v - m;
    f32x2 o; o.x = v.x < 0.f ? m.x : r.x; o.y = v.y < 0.f ? m.y : r.y; return o;
}
__device__ __forceinline__ float rs_of(const float* ss, int row) { float s = 0.f;
#pragma unroll
    for (int t = 0; t < 8; ++t) s += ss[(size_t)t * 33024 + row];
    return __builtin_amdgcn_rsqf(s * (1.0f / 2048.0f) + 1e-6f); }
__device__ __forceinline__ float silu_f(float x) { return x * __builtin_amdgcn_rcpf(1.0f + __builtin_amdgcn_exp2f(-1.4426950408889634f * x)); }

struct EpiGU {
    static constexpr bool PERM = true, AFTER_DRAIN = false;
    bf16_t* act; const float* ss;
    __device__ __forceinline__ void operator()(const f32x4 (&acc)[2][2][4][2], const Unit& u, int wr, int wc, int fr, int fq) const {
        const int row0 = u.pm * BM + wr * 64 + fr, col0 = u.pn * 128 + wc * 32 + 8 * fq;
#pragma unroll
        for (int ai = 0; ai < 2; ++ai)
#pragma unroll
            for (int m = 0; m < 4; ++m) { const int row = row0 + ai * HALF + m * 16; const float rs = rs_of(ss, row);
                const f32x4 g0 = acc[ai][0][m][0] * rs, g1 = acc[ai][0][m][1] * rs, u0 = acc[ai][1][m][0] * rs, u1 = acc[ai][1][m][1] * rs;
                u32x4 w;
                w.x = cvt_pk_bf16(silu_f(g0[0]) * u0[0], silu_f(g0[1]) * u0[1]); w.y = cvt_pk_bf16(silu_f(g0[2]) * u0[2], silu_f(g0[3]) * u0[3]);
                w.z = cvt_pk_bf16(silu_f(g1[0]) * u1[0], silu_f(g1[1]) * u1[1]); w.w = cvt_pk_bf16(silu_f(g1[2]) * u1[2], silu_f(g1[3]) * u1[3]);
                *(u32x4*)(act + (size_t)row * 5632 + col0) = w; }
    }
};
struct EpiRes {
    static constexpr bool PERM = true, AFTER_DRAIN = false;
    bf16_t* hb; float* ssn; float alpha; PG8_LAS float* red;
    __device__ __forceinline__ void operator()(const f32x4 (&acc)[2][2][4][2], const Unit& u, int wr, int wc, int fr, int fq) const {
        bf16_t* bbase = hb + (size_t)u.pm * BM * 2048;
        const int rl0 = wr * 64 + fr; unsigned off = (unsigned)(rl0 * 2048 + u.pn * BM + wc * 32 + 8 * fq);
#pragma unroll
        for (int ai = 0; ai < 2; ++ai) {
            u32x4 hv[4][2];
#pragma unroll
            for (int m = 0; m < 4; ++m)
#pragma unroll
                for (int bj = 0; bj < 2; ++bj) hv[m][bj] = *(const u32x4*)(bbase + (off + (unsigned)((ai * HALF + m * 16) * 2048) + bj * HALF));
#pragma unroll
            for (int m = 0; m < 4; ++m) { const unsigned o = off + (unsigned)((ai * HALF + m * 16) * 2048); float sq = 0.f;
#pragma unroll
                for (int bj = 0; bj < 2; ++bj) { const u32x4 x = hv[m][bj];
                    const f32x4 h0 = (f32x4){__uint_as_float(x.x << 16), __uint_as_float(x.x & 0xffff0000u), __uint_as_float(x.y << 16), __uint_as_float(x.y & 0xffff0000u)} + acc[ai][bj][m][0] * alpha;
                    const f32x4 h1 = (f32x4){__uint_as_float(x.z << 16), __uint_as_float(x.z & 0xffff0000u), __uint_as_float(x.w << 16), __uint_as_float(x.w & 0xffff0000u)} + acc[ai][bj][m][1] * alpha;
                    sq += ((h0[0] * h0[0] + h0[1] * h0[1]) + (h0[2] * h0[2] + h0[3] * h0[3])) + ((h1[0] * h1[0] + h1[1] * h1[1]) + (h1[2] * h1[2] + h1[3] * h1[3]));
                    u32x4 w; w.x = cvt_pk_bf16(h0[0], h0[1]); w.y = cvt_pk_bf16(h0[2], h0[3]); w.z = cvt_pk_bf16(h1[0], h1[1]); w.w = cvt_pk_bf16(h1[2], h1[3]); *(u32x4*)(bbase + o + bj * HALF) = w; }
                sq += __shfl_xor(sq, 16); sq += __shfl_xor(sq, 32);
                if (fq == 0) red[(rl0 + ai * HALF + m * 16) * 4 + wc] = sq; }
            asm volatile("" ::: "memory"); }
        asm volatile("s_waitcnt lgkmcnt(0)" ::: "memory"); __builtin_amdgcn_s_barrier(); asm volatile("" ::: "memory");
        if (wr == 0) { const int row = wc * 64 + fq * 16 + fr; const float s4 = (red[row * 4] + red[row * 4 + 1]) + (red[row * 4 + 2] + red[row * 4 + 3]); ssn[(size_t)u.pn * 33024 + u.pm * BM + row] = s4; }
    }
};
struct EpiP {
    static constexpr bool PERM = true, AFTER_DRAIN = false;
    bf16_t* pr; float* ps; bf16_t* qkv; const float* ss;
    __device__ __forceinline__ void operator()(const f32x4 (&acc)[2][2][4][2], const Unit& u, int wr, int wc, int fr, int fq) const {
        const int row0 = u.pm * BM + wr * 64 + fr, cl = wc * 32 + 8 * fq;
#pragma unroll
        for (int ai = 0; ai < 2; ++ai)
#pragma unroll
            for (int m = 0; m < 4; ++m) { const int row = row0 + ai * HALF + m * 16; const float rs = rs_of(ss, row);
#pragma unroll
                for (int bj = 0; bj < 2; ++bj) { const f32x4 v0 = acc[ai][bj][m][0] * rs, v1 = acc[ai][bj][m][1] * rs;
                    if (u.pn >= 12 && u.pn < 14) { float* d = ps + (size_t)row * 512 + (u.pn - 12) * 256 + bj * HALF + cl; *(f32x4*)d = v0; *(f32x4*)(d + 4) = v1; }
                    else { u32x4 w; w.x = cvt_pk_bf16(v0[0], v0[1]); w.y = cvt_pk_bf16(v0[2], v0[3]); w.z = cvt_pk_bf16(v1[0], v1[1]); w.w = cvt_pk_bf16(v1[2], v1[3]);
                        if (u.pn < 12) *(u32x4*)(pr + (size_t)row * 3072 + u.pn * 256 + bj * HALF + cl) = w;
                        else { const int c = (u.pn - 14) * 256 + bj * HALF + cl;
                            const int b = row >> 12, s = row & 4095; *(u32x4*)(qkv + ((size_t)b * 4160 + 64 + s) * 3072 + c) = w; } } } }
    }
};
template <class Epi, class Sched, bool ALIGN_EPI = false, bool SP2 = false>
__device__ __forceinline__ void gemm_phase(PG8_LAS unsigned char* lds, const Gemm g, const Sched& S, const Epi& E) {
    const int tid = ltid(), wid = __builtin_amdgcn_readfirstlane(tid >> 6), lane = tid & 63, wr = wid >> 2, wc = wid & 3, fr = lane & 15, fq = lane >> 4;
    const int K = g.K, nt = K / BK;
    unsigned voffA[2], voffB[2];
#pragma unroll
    for (int i = 0; i < 2; ++i) { int R, C; stage_rc(tid * 16 + i * 8192, R, C); const int Rb = Epi::PERM ? ((R & ~31) + perm32(R & 31)) : R;
        voffA[i] = (unsigned)(R * K + C) * 2u; voffB[i] = (unsigned)(Rb * K + C) * 2u; }
    const size_t kstep = (size_t)(BK * 2);
    const size_t hstep = (size_t)HALF * K * 2;
    const size_t tstep = 2 * hstep;
    const unsigned ldsw = (unsigned)wid * 1024u;
    const int aoff = lds_byte(wr * 64 + fr, fq * 8), boff = lds_byte(wc * 32 + fr, fq * 8);
#define PG8_SA(b, h) (((b) * 2 + (h)) * HTB)
#define PG8_SB(b, h) ((4 + (b) * 2 + (h)) * HTB)
#define PG8_STAGE(bufoff, gbase, voff) do { _Pragma("unroll") for (int _i = 0; _i < 2; ++_i) \
        __builtin_amdgcn_global_load_lds((const unsigned*)((const char*)(gbase) + (voff)[_i]), (PG8_LAS unsigned*)(lds + (bufoff) + ldsw + _i * 8192), 16, 0, 0); } while (0)
#define PG8_LDA(dst, b, h) do { _Pragma("unroll") for (int m = 0; m < 4; ++m) _Pragma("unroll") for (int k = 0; k < 2; ++k) dst[m][k] = *(const PG8_LAS bf16x8*)(lds + PG8_SA(b, h) + aoff + m * 2048 + k * 1024); } while (0)
#define PG8_LDB(dst, b, h) do { _Pragma("unroll") for (int n = 0; n < 2; ++n) _Pragma("unroll") for (int k = 0; k < 2; ++k) dst[n][k] = *(const PG8_LAS bf16x8*)(lds + PG8_SB(b, h) + boff + n * 2048 + k * 1024); } while (0)
#define PG8_MMA(ai, bj, At, Bt) do { __builtin_amdgcn_s_setprio(1); _Pragma("unroll") for (int m = 0; m < 4; ++m) _Pragma("unroll") for (int n = 0; n < 2; ++n) _Pragma("unroll") for (int k = 0; k < 2; ++k) \
        acc[ai][bj][m][n] = __builtin_amdgcn_mfma_f32_16x16x32_bf16(Bt[n][k], At[m][k], acc[ai][bj][m][n], 0, 0, 0); __builtin_amdgcn_s_setprio(0); } while (0)
#define PG8_WAIT_V(n) asm volatile("s_waitcnt vmcnt(" #n ")" ::: "memory")
#define PG8_WAIT_L(n) asm volatile("s_waitcnt lgkmcnt(" #n ")" ::: "memory")
#define PG8_BAR __builtin_amdgcn_s_barrier()
#define PG8_SCHED __builtin_amdgcn_sched_barrier(0)
    Unit cur, nxt; int ui = 0;
    if (!S.next(0, cur)) return;
    f32x4 acc[2][2][4][2];
#pragma unroll
    for (int a = 0; a < 2; ++a)
#pragma unroll
        for (int b = 0; b < 2; ++b)
#pragma unroll
            for (int m = 0; m < 4; ++m)
#pragma unroll
                for (int n = 0; n < 2; ++n) acc[a][b][m][n] = (f32x4){0.f, 0.f, 0.f, 0.f};
    bf16x8 At[4][2], B0[2][2], B1[2][2];
    const char* cA = (const char*)g.A + (size_t)cur.pm * tstep; const char* cB = (const char*)g.Bt + (size_t)cur.pn * tstep;
    S.a_ready(cur);
    if constexpr (SP2) {
        PG8_STAGE(PG8_SB(0, 0), cB, voffB); PG8_STAGE(PG8_SB(0, 1), cB + hstep, voffB); PG8_STAGE(PG8_SA(0, 0), cA, voffA); PG8_STAGE(PG8_SA(0, 1), cA + hstep, voffA);
        if (wr == 1) PG8_BAR;
        PG8_WAIT_V(2); PG8_BAR;
        PG8_STAGE(PG8_SB(1, 0), cB + kstep, voffB); PG8_STAGE(PG8_SA(1, 0), cA + kstep, voffA); PG8_STAGE(PG8_SB(1, 1), cB + hstep + kstep, voffB);
        PG8_WAIT_V(6); PG8_BAR;
    } else {
        PG8_STAGE(PG8_SB(0, 0), cB, voffB); PG8_STAGE(PG8_SA(0, 0), cA, voffA); PG8_STAGE(PG8_SB(0, 1), cB + hstep, voffB); PG8_STAGE(PG8_SA(0, 1), cA + hstep, voffA);
        if (wr == 1) PG8_BAR;
        PG8_WAIT_V(4); PG8_BAR;
        PG8_STAGE(PG8_SB(1, 0), cB + kstep, voffB); PG8_STAGE(PG8_SA(1, 0), cA + kstep, voffA); PG8_STAGE(PG8_SB(1, 1), cB + hstep + kstep, voffB);
        PG8_WAIT_V(6); PG8_BAR;
    }
    for (;;) {
        const bool has_next = S.next(ui + 1, nxt);
        const char* nA = has_next ? (const char*)g.A + (size_t)nxt.pm * tstep : cA; const char* nB = has_next ? (const char*)g.Bt + (size_t)nxt.pn * tstep : cB;
        for (int t = 0; t < nt; t += 2) {
            const bool last = (t == nt - 2);
            const char* a1 = cA + (size_t)(t + 1) * kstep;
            const char* a2 = last ? nA : cA + (size_t)(t + 2) * kstep; const char* b2 = last ? nB : cB + (size_t)(t + 2) * kstep;
            const char* a3 = a2 + kstep; const char* b3 = b2 + kstep;
            if (last && has_next) S.a_ready(nxt);
            if constexpr (SP2) {
            PG8_LDB(B0, 0, 0); PG8_LDB(B1, 0, 1); PG8_SCHED; PG8_LDA(At, 0, 0); PG8_STAGE(PG8_SA(1, 1), a1 + hstep, voffA);
            PG8_WAIT_V(8); PG8_WAIT_L(0); PG8_BAR; PG8_MMA(0, 0, At, B0); PG8_MMA(0, 1, At, B1); PG8_BAR; PG8_SCHED;
            PG8_LDA(At, 0, 1); PG8_STAGE(PG8_SB(0, 0), b2, voffB); PG8_STAGE(PG8_SB(0, 1), b2 + hstep, voffB); PG8_STAGE(PG8_SA(0, 0), a2, voffA);
            PG8_WAIT_V(8); PG8_WAIT_L(0); PG8_BAR; PG8_MMA(1, 0, At, B0); PG8_MMA(1, 1, At, B1); PG8_BAR; PG8_SCHED;
            PG8_LDB(B0, 1, 0); PG8_LDB(B1, 1, 1); PG8_SCHED; PG8_LDA(At, 1, 0); PG8_STAGE(PG8_SA(0, 1), a2 + hstep, voffA);
            PG8_WAIT_V(8); PG8_WAIT_L(0); PG8_BAR; PG8_MMA(0, 0, At, B0); PG8_MMA(0, 1, At, B1); PG8_BAR; PG8_SCHED;
            PG8_LDA(At, 1, 1); PG8_STAGE(PG8_SB(1, 0), b3, voffB); PG8_STAGE(PG8_SB(1, 1), b3 + hstep, voffB); PG8_STAGE(PG8_SA(1, 0), a3, voffA);
            PG8_WAIT_V(8); PG8_WAIT_L(0); PG8_BAR; PG8_MMA(1, 0, At, B0); PG8_MMA(1, 1, At, B1); PG8_BAR; PG8_SCHED;
            } else {
            PG8_LDB(B0, 0, 0); PG8_SCHED; PG8_LDA(At, 0, 0); PG8_STAGE(PG8_SA(1, 1), a1 + hstep, voffA);
            PG8_WAIT_L(8); PG8_BAR; PG8_WAIT_L(0); PG8_MMA(0, 0, At, B0); PG8_BAR; PG8_SCHED;
            PG8_LDB(B1, 0, 1); PG8_STAGE(PG8_SB(0, 0), b2, voffB);
            PG8_BAR; PG8_WAIT_L(0); PG8_MMA(0, 1, At, B1); PG8_BAR;
            PG8_LDA(At, 0, 1); PG8_STAGE(PG8_SA(0, 0), a2, voffA);
            PG8_BAR; PG8_WAIT_L(0); PG8_MMA(1, 0, At, B0); PG8_BAR; PG8_SCHED;
            PG8_STAGE(PG8_SB(0, 1), b2 + hstep, voffB);
            PG8_WAIT_V(6); PG8_BAR; PG8_MMA(1, 1, At, B1); PG8_BAR;
            PG8_LDB(B0, 1, 0); PG8_SCHED; PG8_LDA(At, 1, 0); PG8_STAGE(PG8_SA(0, 1), a2 + hstep, voffA);
            PG8_WAIT_L(8); PG8_BAR; PG8_WAIT_L(0); PG8_MMA(0, 0, At, B0); PG8_BAR; PG8_SCHED;
            PG8_LDB(B1, 1, 1); PG8_STAGE(PG8_SB(1, 0), b3, voffB);
            PG8_BAR; PG8_WAIT_L(0); PG8_MMA(0, 1, At, B1); PG8_BAR;
            PG8_LDA(At, 1, 1); PG8_STAGE(PG8_SA(1, 0), a3, voffA);
            PG8_BAR; PG8_WAIT_L(0); PG8_MMA(1, 0, At, B0); PG8_BAR; PG8_SCHED;
            PG8_STAGE(PG8_SB(1, 1), b3 + hstep, voffB);
            PG8_WAIT_V(6); PG8_BAR; PG8_MMA(1, 1, At, B1); PG8_BAR;
            }
        }
        if constexpr (ALIGN_EPI) { if (wr == 0) PG8_BAR; }
        if constexpr (!Epi::AFTER_DRAIN) { E(acc, cur, wr, wc, fr, fq); S.done(cur); }
        if (!has_next) break;
#pragma unroll
        for (int a = 0; a < 2; ++a)
#pragma unroll
            for (int b = 0; b < 2; ++b)
#pragma unroll
                for (int m = 0; m < 4; ++m)
#pragma unroll
                    for (int n = 0; n < 2; ++n) acc[a][b][m][n] = (f32x4){0.f, 0.f, 0.f, 0.f};
        cur = nxt; cA = nA; cB = nB; ++ui;
        if constexpr (ALIGN_EPI) { if (wr == 1) PG8_BAR; }
    }
    PG8_WAIT_V(0);
    if constexpr (!ALIGN_EPI) { if (wr == 0) PG8_BAR; }
    PG8_BAR;
    if constexpr (Epi::AFTER_DRAIN) { E.fused(acc, cur, wr, wc, fr, fq, lds, wid, lane); S.done(cur); }
#undef PG8_SA
#undef PG8_SB
#undef PG8_STAGE
#undef PG8_LDA
#undef PG8_LDB
#undef PG8_MMA
#undef PG8_WAIT_V
#undef PG8_WAIT_L
#undef PG8_BAR
#undef PG8_SCHED
}
}


#define XB_TMO      128
#define XB_XCNT(j)  (256  + 64 * (j))
#define XB_XSUB(j)  (1280 + 64 * (j))
#define XB_XGEN(j)  (2304 + 64 * (j))
#define XB_TOP      3328
#define XB_TOPGEN   3392
#define XCD_BAR_WORDS 3456
#define XB_SPIN_CAP (1u << 22)

__device__ __forceinline__ unsigned xb_ld(unsigned* p)              { return __hip_atomic_load(p, __ATOMIC_RELAXED, __HIP_MEMORY_SCOPE_AGENT); }
__device__ __forceinline__ unsigned xb_add(unsigned* p, unsigned v) { return __hip_atomic_fetch_add(p, v, __ATOMIC_RELAXED, __HIP_MEMORY_SCOPE_AGENT); }
__device__ __forceinline__ unsigned xb_xcc_id() { return (unsigned)__builtin_amdgcn_s_getreg((3 << 11) | 20) & 0xFu; }
#define XB_SPIN(cond, bar) do { unsigned _sp = 0; while (cond) { __builtin_amdgcn_s_sleep(1); \
    if ((++_sp & 255u) == 0u) { if (xb_ld(&(bar)[XB_TMO])) break; if (_sp > XB_SPIN_CAP) { atomicAdd(&(bar)[XB_TMO], 1u); break; } } } } while (0)

struct XcdBarrier {
    unsigned* bar; unsigned x;
    volatile LAS unsigned* st;
};

__device__ __forceinline__ XcdBarrier xcd_barrier_post(unsigned* bar, volatile LAS unsigned* st) {
    XcdBarrier b; b.bar = bar; b.x = xb_xcc_id(); b.st = st;
    if (threadIdx.x == 0) (void)xb_add(&bar[XB_XCNT(b.x)], 1u);
    return b;
}
__device__ __forceinline__ void xcd_barrier_complete(unsigned* bar, unsigned x, unsigned& nloc, unsigned& nx) {
    const unsigned G = gridDim.x * gridDim.y * gridDim.z;
    unsigned sum, cnt, mine, sp = 0u;
    for (;;) {
        sum = 0u; cnt = 0u; mine = 0u;
#pragma unroll
        for (unsigned j = 0; j < 16; ++j) { const unsigned c = xb_ld(&bar[XB_XCNT(j)]); sum += c; cnt += (c > 0u) ? 1u : 0u; mine = (j == x) ? c : mine; }
        if (sum == G) break;
        __builtin_amdgcn_s_sleep(1);
        if ((++sp & 255u) == 0u) { if (xb_ld(&bar[XB_TMO])) break; if (sp > XB_SPIN_CAP) { atomicAdd(&bar[XB_TMO], 1u); break; } }
    }
    nloc = mine > 0u ? mine : 1u; nx = cnt > 0u ? cnt : 1u;
}

__device__ __forceinline__ void xcd_barrier(const XcdBarrier& b) {
    asm volatile("s_waitcnt vmcnt(0)" ::: "memory");
    __syncthreads();
    if (threadIdx.x == 0) {
        unsigned* bar = b.bar;
        __builtin_amdgcn_s_waitcnt(0);
        unsigned nloc = b.st[0], nx = b.st[1];
        if (nloc == 0u) { xcd_barrier_complete(bar, b.x, nloc, nx); b.st[0] = nloc; b.st[1] = nx; }
        const unsigned old = xb_add(&bar[XB_XSUB(b.x)], 1u);
        const unsigned gen = old / nloc;
        if (old + 1u == (gen + 1u) * nloc) {
            __builtin_amdgcn_fence(__ATOMIC_RELEASE, "agent");
            asm volatile("s_waitcnt vmcnt(0)" ::: "memory");
            const unsigned og = xb_add(&bar[XB_TOP], 1u);
            const unsigned tg = og / nx;
            if (og + 1u == (tg + 1u) * nx) xb_add(&bar[XB_TOPGEN], 1u);
            else XB_SPIN(xb_ld(&bar[XB_TOPGEN]) == tg, bar);
            __builtin_amdgcn_fence(__ATOMIC_ACQUIRE, "agent");
            xb_add(&bar[XB_XGEN(b.x)], 1u);
            asm volatile("s_waitcnt vmcnt(0)" ::: "memory");
        } else {
            XB_SPIN(xb_ld(&bar[XB_XGEN(b.x)]) == gen, bar);
            __builtin_amdgcn_fence(__ATOMIC_ACQUIRE, "agent");
            asm volatile("s_waitcnt vmcnt(0)" ::: "memory");
        }
    }
    __syncthreads();
}


typedef unsigned short bf16_t;
typedef float f32x4 __attribute__((ext_vector_type(4)));
typedef unsigned u32x4 __attribute__((ext_vector_type(4)));
typedef unsigned u32x2 __attribute__((ext_vector_type(2)));
struct Params { const float* in[25]; float* out; unsigned char* ws; int ph_lo, ph_hi; };
#define CAS __attribute__((address_space(4)))
typedef const CAS Params* PP;
__device__ __forceinline__ PP launder(PP p) { asm volatile("" : "+s"(p)); return p; }
enum { I_X = 0, I_META, I_F1N, I_F1GU, I_F1D, I_MIXN, I_WIN, I_MU, I_W0, I_WUP, I_A0, I_AUP, I_GUP, I_KK, I_KA, I_RK, I_LNW, I_LNB, I_BF, I_FON, I_WOUT, I_F2N, I_F2GU, I_F2D, I_FINN };

typedef float f32x2_t __attribute__((ext_vector_type(2))); typedef __bf16 bf16x2v_t __attribute__((ext_vector_type(2)));
__device__ __forceinline__ unsigned pk_bf16(float lo, float hi) { f32x2_t v = {lo, hi}; bf16x2v_t b = __builtin_convertvector(v, bf16x2v_t); return __builtin_bit_cast(unsigned, b); }
__device__ __forceinline__ float bf2f(bf16_t b) { return __uint_as_float(((unsigned)b) << 16); }
__device__ __forceinline__ float wave_sum(float v) {
#pragma unroll
    for (int o = 32; o >= 1; o >>= 1) v += __shfl_xor(v, o);
    return v; }
__device__ __forceinline__ float wave_max(float v) {
#pragma unroll
    for (int o = 32; o >= 1; o >>= 1) v = fmaxf(v, __shfl_xor(v, o));
    return v; }
__device__ __forceinline__ float sigmoid_f(float x) { return __builtin_amdgcn_rcpf(1.0f + __expf(-x)); }

__device__ __forceinline__ void convert_tile(const float* __restrict__ src, bf16_t* __restrict__ dst, const float* __restrict__ gain, int K, int Nsrc, int kind, int tk, int tn, LAS float* T) {
    const int tid = ltid();
    {
        const int nl = (tid & 15) * 4, np = tn * 64 + nl; int sc;
        if (kind == 1) { const int pn = np >> 8, bj = (np >> 7) & 1, i = np & 127; sc = bj * cfg::DFF + pn * 128 + i; }
        else if (kind == 2) { sc = np < 3360 ? np : (np < 3368 ? 6432 + (np - 3360) : (np < 3584 ? -1 : 3360 + (np - 3584))); }
        else sc = np;
#pragma unroll
        for (int i = 0; i < 2; ++i) { const int kl = (tid >> 4) + 32 * i, k = tk * 64 + kl;
            f32x4 v = (f32x4){0.f, 0.f, 0.f, 0.f};
            if (sc >= 0) v = *(const f32x4*)(src + (size_t)k * Nsrc + sc);
            float g = 1.f; if (kind == 1 || kind == 2) g = gain[k]; else if (kind == 3) g = (k >= 1024) ? gain[k - 1024] : 1.f;
            T[kl * 65 + nl] = v[0] * g; T[kl * 65 + nl + 1] = v[1] * g; T[kl * 65 + nl + 2] = v[2] * g; T[kl * 65 + nl + 3] = v[3] * g; }
    }
    __syncthreads();
    {
        const int nl = tid >> 3, k8 = (tid & 7) * 8; u32x4 w;
        w.x = pk_bf16(T[(k8 + 0) * 65 + nl], T[(k8 + 1) * 65 + nl]); w.y = pk_bf16(T[(k8 + 2) * 65 + nl], T[(k8 + 3) * 65 + nl]);
        w.z = pk_bf16(T[(k8 + 4) * 65 + nl], T[(k8 + 5) * 65 + nl]); w.w = pk_bf16(T[(k8 + 6) * 65 + nl], T[(k8 + 7) * 65 + nl]);
        *(u32x4*)(dst + (size_t)(tn * 64 + nl) * K + tk * 64 + k8) = w;
    }
    __syncthreads();
}
__device__ __forceinline__ void phase_convert(PP P, LAS unsigned char* lds) {
    using namespace cfg;
    LAS float* T = (LAS float*)lds;
    constexpr int T_GU = (DM / 64) * (NGU / 64), T_D = (DFF / 64) * (DM / 64), T_IN = (DM / 64) * (NIN / 64), T_OUT = (DM / 64) * (DM / 64);
    constexpr int T_LAYER = 2 * T_GU + 2 * T_D + T_IN + T_OUT;
    for (int t = lbid(); t < DEPTH * T_LAYER; t += gridDim.x) {
        const int l = t / T_LAYER; int r = t - l * T_LAYER;
        bf16_t* wl = (bf16_t*)(P->ws + WS_W + (size_t)l * W_LAYER);
        const float* src; bf16_t* dst; const float* gain = nullptr; int K, Nsrc, kind, ntn;
        if (r < T_GU) { src = P->in[I_F1GU] + (size_t)l * DM * NGU; dst = (bf16_t*)((unsigned char*)wl + WO_GU1); gain = P->in[I_F1N] + l * DM; K = DM; Nsrc = NGU; kind = 1; ntn = NGU / 64; }
        else if ((r -= T_GU) < T_D) { src = P->in[I_F1D] + (size_t)l * DFF * DM; dst = (bf16_t*)((unsigned char*)wl + WO_D1); K = DFF; Nsrc = DM; kind = 0; ntn = DM / 64; }
        else if ((r -= T_D) < T_IN) { src = P->in[I_WIN] + (size_t)l * DM * DIN; dst = (bf16_t*)((unsigned char*)wl + WO_IN); gain = P->in[I_MIXN] + l * DM; K = DM; Nsrc = DIN; kind = 2; ntn = NIN / 64; }
        else if ((r -= T_IN) < T_OUT) { src = P->in[I_WOUT] + (size_t)l * DM * DM; dst = (bf16_t*)((unsigned char*)wl + WO_OUT); gain = P->in[I_FON] + l * FW; K = DM; Nsrc = DM; kind = 3; ntn = DM / 64; }
        else if ((r -= T_OUT) < T_GU) { src = P->in[I_F2GU] + (size_t)l * DM * NGU; dst = (bf16_t*)((unsigned char*)wl + WO_GU2); gain = P->in[I_F2N] + l * DM; K = DM; Nsrc = NGU; kind = 1; ntn = NGU / 64; }
        else { r -= T_GU; src = P->in[I_F2D] + (size_t)l * DFF * DM; dst = (bf16_t*)((unsigned char*)wl + WO_D2); K = DFF; Nsrc = DM; kind = 0; ntn = DM / 64; }
        convert_tile(src, dst, gain, K, Nsrc, kind, r / ntn, r % ntn, T);
    }
}
__device__ __forceinline__ void phase_init(PP P) {
    using namespace cfg;
    const int lane = ltid() & 63, gw = lbid() * 8 + (ltid() >> 6), nw = gridDim.x * 8;
    bf16_t* hb = (bf16_t*)(P->ws + WS_HB); float* ss0 = (float*)(P->ws + WS_SS);
    for (int row = gw; row < MROWS; row += nw) {
        const float* s = row < MMAIN ? P->in[I_X] + (size_t)row * DM : P->in[I_META] + (size_t)(row - MMAIN) * DM;
        float sq = 0.f;
#pragma unroll
        for (int i = 0; i < 4; ++i) { f32x4 v0 = (f32x4){0.f, 0.f, 0.f, 0.f}, v1 = v0; if (row < MMAIN + NMETA) { v0 = *(const f32x4*)(s + i * 512 + lane * 8); v1 = *(const f32x4*)(s + i * 512 + lane * 8 + 4); }
            sq += ((v0[0] * v0[0] + v0[1] * v0[1]) + (v0[2] * v0[2] + v0[3] * v0[3])) + ((v1[0] * v1[0] + v1[1] * v1[1]) + (v1[2] * v1[2] + v1[3] * v1[3]));
            u32x4 w; w.x = pk_bf16(v0[0], v0[1]); w.y = pk_bf16(v0[2], v0[3]); w.z = pk_bf16(v1[0], v1[1]); w.w = pk_bf16(v1[2], v1[3]); *(u32x4*)(hb + (size_t)row * DM + i * 512 + lane * 8) = w; }
        sq = wave_sum(sq);
        if (lane < 8) ss0[(size_t)lane * MROWS + row] = lane == 0 ? sq : 0.f;
        if (row >= MMAIN && row < MMAIN + NMETA) { float* ssm0 = (float*)(P->ws + WS_SSM); ssm0[lane * 16 + (row - MMAIN)] = lane == 0 ? sq : 0.f; ssm0[(64 + lane) * 16 + (row - MMAIN)] = 0.f; }
    }
}
__device__ __forceinline__ void phase_foxnorm(PP P) {
    using namespace cfg;
    const int lane = ltid() & 63, gw = lbid() * 8 + (ltid() >> 6), nw = gridDim.x * 8;
    bf16_t* y = (bf16_t*)(P->ws + WS_Y);
    for (int row = gw; row < MMAIN + NMETA; row += nw) {
        bf16_t* p = y + (size_t)row * DM + 1024 + lane * 16;
        u32x4 a = *(const u32x4*)p, b = *(const u32x4*)(p + 8); float v[16];
#pragma unroll
        for (int i = 0; i < 4; ++i) { v[2 * i] = __uint_as_float(a[i] << 16); v[2 * i + 1] = __uint_as_float(a[i] & 0xffff0000u); v[8 + 2 * i] = __uint_as_float(b[i] << 16); v[8 + 2 * i + 1] = __uint_as_float(b[i] & 0xffff0000u); }
        float sq = 0.f;
#pragma unroll
        for (int i = 0; i < 16; ++i) sq += v[i] * v[i];
        sq = wave_sum(sq); const float rs = __builtin_amdgcn_rsqf(sq * (1.0f / 1024.0f) + NORM_EPS);
#pragma unroll
        for (int i = 0; i < 4; ++i) { a[i] = pk_bf16(v[2 * i] * rs, v[2 * i + 1] * rs); b[i] = pk_bf16(v[8 + 2 * i] * rs, v[8 + 2 * i + 1] * rs); }
        *(u32x4*)p = a; *(u32x4*)(p + 8) = b;
    }
}
__device__ __forceinline__ void phase_final(PP P) {
    using namespace cfg;
    const int lane = ltid() & 63, gw = lbid() * 8 + (ltid() >> 6), nw = gridDim.x * 8;
    const float* g = P->in[I_FINN]; const bf16_t* hb = (const bf16_t*)(P->ws + WS_HB);
    for (int row = gw; row < MMAIN; row += nw) {
        float* d = P->out + (size_t)row * DM; f32x4 v[8]; float sq = 0.f;
#pragma unroll
        for (int i = 0; i < 4; ++i) { const u32x4 x = *(const u32x4*)(hb + (size_t)row * DM + i * 512 + lane * 8);
            v[2 * i] = (f32x4){__uint_as_float(x.x << 16), __uint_as_float(x.x & 0xffff0000u), __uint_as_float(x.y << 16), __uint_as_float(x.y & 0xffff0000u)};
            v[2 * i + 1] = (f32x4){__uint_as_float(x.z << 16), __uint_as_float(x.z & 0xffff0000u), __uint_as_float(x.w << 16), __uint_as_float(x.w & 0xffff0000u)}; }
#pragma unroll
        for (int i = 0; i < 8; ++i) sq += (v[i][0] * v[i][0] + v[i][1] * v[i][1]) + (v[i][2] * v[i][2] + v[i][3] * v[i][3]);
        sq = wave_sum(sq); const float rs = __builtin_amdgcn_rsqf(sq * (1.0f / 2048.0f) + NORM_EPS);
#pragma unroll
        for (int i = 0; i < 4; ++i) { const f32x4 g0 = *(const f32x4*)(g + i * 512 + lane * 8), g1 = *(const f32x4*)(g + i * 512 + lane * 8 + 4);
            *(f32x4*)(d + i * 512 + lane * 8) = v[2 * i] * rs * g0; *(f32x4*)(d + i * 512 + lane * 8 + 4) = v[2 * i + 1] * rs * g1; }
    }
}

__device__ __forceinline__ void rwkv_simple(PP P, int l, int b, int h, LAS unsigned char* lds) {
    using namespace cfg;
    const int tid = ltid(), lane = tid & 63, wave = tid >> 6;
    LAS bf16_t* WUP = (LAS bf16_t*)lds; LAS bf16_t* AUP = WUP + 4096; LAS bf16_t* GUP = AUP + 4096;
    LAS float* RAW = (LAS float*)(lds + 36864); LAS float* LX = RAW + 17 * 480; LAS float* Rm = LX + 16 * 288;
    LAS float* Wm = Rm + 1024; LAS float* KPm = Wm + 1024; LAS float* Vm = KPm + 1024; LAS float* Am = Vm + 1024; LAS float* Bm = Am + 1024; LAS float* Gm = Bm + 1024;
    LAS float* BON = Gm + 1024; LAS float* YR = BON + 16;
    const bf16_t* PR = (const bf16_t*)(P->ws + WS_PR); const float* PS = (const float*)(P->ws + WS_PS); bf16_t* Y = (bf16_t*)(P->ws + WS_Y);
    const float* mu = P->in[I_MU] + l * RWKV_COLS;
    for (int e = tid; e < 64 * 64; e += 512) { const int i = e >> 6, j = e & 63;
        WUP[e] = (bf16_t)(pk_bf16(P->in[I_WUP][((size_t)l * 64 + i) * RW + h * 64 + j], 0.f) & 0xffffu);
        AUP[e] = (bf16_t)(pk_bf16(P->in[I_AUP][((size_t)l * 64 + i) * RW + h * 64 + j], 0.f) & 0xffffu); }
    for (int e = tid; e < 160 * 64; e += 512) { const int i = e >> 6, j = e & 63; GUP[e] = (bf16_t)(pk_bf16(P->in[I_GUP][((size_t)l * 160 + i) * RW + h * 64 + j], 0.f) & 0xffffu); }
    for (int e = tid; e < 480; e += 512) RAW[e] = 0.f;
    const int hj = h * 64 + lane;
    const float w0 = P->in[I_W0][l * RW + hj], a0 = P->in[I_A0][l * RW + hj], kkw = P->in[I_KK][l * RW + hj], kaw = P->in[I_KA][l * RW + hj], rkw = P->in[I_RK][l * RW + hj];
    const float lnw = P->in[I_LNW][l * RW + hj], lnb = P->in[I_LNB][l * RW + hj];
    const float mur = mu[hj], muk = mu[1024 + hj], muv = mu[2048 + hj];
    float S[16];
#pragma unroll
    for (int j = 0; j < 16; ++j) S[j] = 0.f;
    __syncthreads();
    for (int c = 0; c < 257; ++c) {
        const int row0 = (c == 0) ? MMAIN : b * SEQ + (c - 1) * 16;
        for (int e = tid; e < 16 * 480; e += 512) { const int t = e / 480, cc = e - t * 480; const int row = row0 + t; float v;
            if (cc < 192) v = bf2f(PR[(size_t)row * PRW + (cc >> 6) * 1024 + h * 64 + (cc & 63)]); else v = PS[(size_t)row * PSW + (cc - 192)];
            RAW[(t + 1) * 480 + cc] = v; }
        __syncthreads();
        for (int e = tid; e < 16 * 288; e += 512) { const int t = e / 288, i = e - t * 288; const float cur = RAW[(t + 1) * 480 + 192 + i], prv = RAW[t * 480 + 192 + i];
            const float x = cur + (prv - cur) * mu[3072 + i];
            LX[e] = i < 64 ? tanhf(x) : (i < 128 ? x : sigmoid_f(x)); }
        __syncthreads();
#pragma unroll 1
        for (int rep = 0; rep < 2; ++rep) { const int t = wave + 8 * rep;
            float aw = w0, aa = a0, ag = 0.f;
            for (int i = 0; i < 64; ++i) { aw += LX[t * 288 + i] * bf2f(WUP[i * 64 + lane]); aa += LX[t * 288 + 64 + i] * bf2f(AUP[i * 64 + lane]); }
            for (int i = 0; i < 160; ++i) ag += LX[t * 288 + 128 + i] * bf2f(GUP[i * 64 + lane]);
            const float sp = (aw < 0.f ? -aw : 0.f) + log1pf(__expf(-fabsf(aw)));
            const float dec = __expf(-__expf(-sp - 0.5f));
            const float alr = sigmoid_f(aa);
            const float rc = RAW[(t + 1) * 480 + lane], rp = RAW[t * 480 + lane]; const float r = rc + (rp - rc) * mur;
            const float kc = RAW[(t + 1) * 480 + 64 + lane], kp = RAW[t * 480 + 64 + lane]; const float k = kc + (kp - kc) * muk;
            const float vc = RAW[(t + 1) * 480 + 128 + lane], vp = RAW[t * 480 + 128 + lane]; const float v = vc + (vp - vc) * muv;
            const float kkr = k * kkw; const float nrm = sqrtf(wave_sum(kkr * kkr)); const float kk = kkr / fmaxf(nrm, 1e-12f);
            const float kmod = k * (1.0f + (alr - 1.0f) * kaw);
            const float bon = wave_sum(r * kmod * rkw);
            Rm[t * 64 + lane] = r; Wm[t * 64 + lane] = dec; KPm[t * 64 + lane] = kmod; Vm[t * 64 + lane] = v; Am[t * 64 + lane] = -kk; Bm[t * 64 + lane] = kk * alr; Gm[t * 64 + lane] = ag;
            if (lane == 0) BON[t] = bon; }
        __syncthreads();
        for (int e = tid; e < 480; e += 512) RAW[e] = RAW[16 * 480 + e];
        if (wave < 4) { const int vrow = 16 * wave + (lane & 15), q = lane >> 4;
#pragma unroll 1
            for (int t = 0; t < 16; ++t) { float a[16], w[16], bb[16], kk[16], rr[16];
#pragma unroll
                for (int g = 0; g < 4; ++g) { const f32x4 av = *(const LAS f32x4*)(Am + t * 64 + 16 * q + 4 * g), wv = *(const LAS f32x4*)(Wm + t * 64 + 16 * q + 4 * g), bv = *(const LAS f32x4*)(Bm + t * 64 + 16 * q + 4 * g),
                        kv = *(const LAS f32x4*)(KPm + t * 64 + 16 * q + 4 * g), rv = *(const LAS f32x4*)(Rm + t * 64 + 16 * q + 4 * g);
#pragma unroll
                    for (int i = 0; i < 4; ++i) { a[4 * g + i] = av[i]; w[4 * g + i] = wv[i]; bb[4 * g + i] = bv[i]; kk[4 * g + i] = kv[i]; rr[4 * g + i] = rv[i]; } }
                float sa = 0.f;
#pragma unroll
                for (int j = 0; j < 16; ++j) sa += S[j] * a[j];
                sa += __shfl_xor(sa, 16); sa += __shfl_xor(sa, 32);
                const float vv = Vm[t * 64 + vrow]; float y = 0.f;
#pragma unroll
                for (int j = 0; j < 16; ++j) { S[j] = S[j] * w[j] + (sa * bb[j] + vv * kk[j]); y += S[j] * rr[j]; }
                y += __shfl_xor(y, 16); y += __shfl_xor(y, 32);
                if (q == 0) YR[t * 64 + vrow] = y; } }
        __syncthreads();
        if (c > 0 || b == 0) {
#pragma unroll 1
            for (int rep = 0; rep < 2; ++rep) { const int t = wave + 8 * rep; const float yv = YR[t * 64 + lane];
                const float mean = wave_sum(yv) * (1.0f / 64.0f); const float d = yv - mean; const float var = wave_sum(d * d) * (1.0f / 64.0f);
                const float yn = d * __builtin_amdgcn_rsqf(var + LNX_EPS) * lnw + lnb;
                const float o = (yn + BON[t] * Vm[t * 64 + lane]) * Gm[t * 64 + lane];
                Y[(size_t)(row0 + t) * DM + hj] = (bf16_t)(pk_bf16(o, 0.f) & 0xffffu); } }
        __syncthreads();
    }
}

typedef short bf16x8_t __attribute__((ext_vector_type(8)));
typedef short bf16x4_t __attribute__((ext_vector_type(4)));
namespace rk {
constexpr int RAWF = 0, RAWF_SZ = 18432, RAWH = 55296, RAWH_SZ = 6144, LXB = 73728, RS = 82944, KS = 87040, VS = 91136, KKN = 95232, ATP = 99328, RTP = 101376, BTP = 103424, KTP = 105472,
              BHT = 107520, KHT = 109568, VT = 111616, GT = 113664, AAK = 113920, RB = 114432, RKM = 114944, TINV = 115456, GG = 115968  , VF = 124160  , YR = 132352, BONP = 136448  , LDS_END = 136960;
}
template <int CTRL> __device__ __forceinline__ float dpp_f(float v) { return __builtin_bit_cast(float, __builtin_amdgcn_update_dpp(0, __builtin_bit_cast(int, v), CTRL, 0xf, 0xf, true)); }
__device__ __forceinline__ float row_sum16(float v) { v += dpp_f<0xB1>(v); v += dpp_f<0x4E>(v); v += dpp_f<0x141>(v); v += dpp_f<0x140>(v); return v; }
__device__ __forceinline__ float rdlane(float v, int l) { return __builtin_bit_cast(float, __builtin_amdgcn_readlane(__builtin_bit_cast(int, v), l)); }
__device__ __forceinline__ float wave_sum_dpp(float v) { v = row_sum16(v); return (rdlane(v, 0) + rdlane(v, 16)) + (rdlane(v, 32) + rdlane(v, 48)); }
#define RK_BAR() do { asm volatile("s_waitcnt lgkmcnt(0)" ::: "memory"); __builtin_amdgcn_s_barrier(); asm volatile("" ::: "memory"); } while (0)
__device__ __forceinline__ bf16_t bf1(float x) { return (bf16_t)(pk_bf16(x, 0.f) & 0xffffu); }
__device__ __forceinline__ bf16x4_t pack4(float a, float b, float c, float d) { u32x2 w; w.x = pk_bf16(a, b); w.y = pk_bf16(c, d); return __builtin_bit_cast(bf16x4_t, w); }
__device__ __forceinline__ float fast_sigmoid(float x) { return __builtin_amdgcn_rcpf(1.0f + __expf(-x)); }
__device__ __forceinline__ float fast_tanh(float x) { return 1.0f - 2.0f * __builtin_amdgcn_rcpf(__expf(2.0f * x) + 1.0f); }

__device__ __forceinline__ void rwkv_chunked(PP P, int l, int b, int h, LAS unsigned char* lds) {
    using namespace cfg;
    const int tid = ltid(), lane = tid & 63, wave = __builtin_amdgcn_readfirstlane(tid >> 6), n = lane & 15, g = lane >> 4;
    const bf16_t* PR = (const bf16_t*)(P->ws + WS_PR); const float* PS = (const float*)(P->ws + WS_PS); bf16_t* Y = (bf16_t*)(P->ws + WS_Y);
    const float* mu = P->in[I_MU] + l * RWKV_COLS;
    LAS float* RSm = (LAS float*)(lds + rk::RS); LAS float* KSm = (LAS float*)(lds + rk::KS); LAS float* VSm = (LAS float*)(lds + rk::VS); LAS float* KKNm = (LAS float*)(lds + rk::KKN);
    LAS bf16_t* LXB = (LAS bf16_t*)(lds + rk::LXB);
    LAS bf16_t* ATp = (LAS bf16_t*)(lds + rk::ATP); LAS bf16_t* RTp = (LAS bf16_t*)(lds + rk::RTP); LAS bf16_t* BTp = (LAS bf16_t*)(lds + rk::BTP); LAS bf16_t* KTp = (LAS bf16_t*)(lds + rk::KTP);
    LAS bf16_t* BHt = (LAS bf16_t*)(lds + rk::BHT); LAS bf16_t* KHt = (LAS bf16_t*)(lds + rk::KHT); LAS bf16_t* Vt = (LAS bf16_t*)(lds + rk::VT);
    LAS float* GTm = (LAS float*)(lds + rk::GT);
    LAS bf16_t* AAKm = (LAS bf16_t*)(lds + rk::AAK); LAS bf16_t* RBm = (LAS bf16_t*)(lds + rk::RB); LAS bf16_t* RKm = (LAS bf16_t*)(lds + rk::RKM); LAS bf16_t* TINVm = (LAS bf16_t*)(lds + rk::TINV);
    LAS float* YRm = (LAS float*)(lds + rk::YR);
    const int hj = h * 64 + lane;
    const float mur = mu[hj], muk = mu[1024 + hj], muv = mu[2048 + hj], kkw = P->in[I_KK][l * RW + hj], lnw = P->in[I_LNW][l * RW + hj], lnb = P->in[I_LNB][l * RW + hj];
    float mul[5];
#pragma unroll
    for (int q = 0; q < 5; ++q) mul[q] = (lane + 64 * q < 288) ? mu[3072 + lane + 64 * q] : 0.f;
    const int kw = wave & 3, key = 16 * kw + n, hk = h * 64 + key;
    const float w0k = P->in[I_W0][l * RW + hk], a0k = P->in[I_A0][l * RW + hk], kak = P->in[I_KA][l * RW + hk], rkk = P->in[I_RK][l * RW + hk];
    const int pp = 32 * (key >> 5) + 8 * ((key >> 2) & 3) + 4 * ((key >> 4) & 1) + (key & 3);
    bf16x8_t fA[2], fB[5];
    {
        const float* wu = P->in[I_WUP] + (size_t)l * 64 * RW + hk; const float* au = P->in[I_AUP] + (size_t)l * 64 * RW + hk; const float* gu = P->in[I_GUP] + (size_t)l * 160 * RW + hk;
#pragma unroll
        for (int s = 0; s < 5; ++s) { float v[8], u[8];
#pragma unroll
            for (int j = 0; j < 8; ++j) { const int k = 32 * s + 8 * g + j; v[j] = (wave < 4) ? (s < 2 ? au[(size_t)k * RW] : 0.f) : gu[(size_t)k * RW]; u[j] = (wave < 4 && s < 2) ? wu[(size_t)k * RW] : 0.f; }
            u32x4 w; w.x = pk_bf16(v[0], v[1]); w.y = pk_bf16(v[2], v[3]); w.z = pk_bf16(v[4], v[5]); w.w = pk_bf16(v[6], v[7]); fB[s] = __builtin_bit_cast(bf16x8_t, w);
            if (s < 2) { u32x4 x; x.x = pk_bf16(u[0], u[1]); x.y = pk_bf16(u[2], u[3]); x.z = pk_bf16(u[4], u[5]); x.w = pk_bf16(u[6], u[7]); fA[s] = __builtin_bit_cast(bf16x8_t, x); } }
    }
    f32x4 ST[4];
#pragma unroll
    for (int kb = 0; kb < 4; ++kb) ST[kb] = (f32x4){0.f, 0.f, 0.f, 0.f};
#define RK_DMA(c_) do { const int cc_ = (c_); const int row0_ = (cc_ == 0) ? MMAIN : b * SEQ + (cc_ - 1) * 16; const int bi_ = cc_ % 3; \
        _Pragma("unroll") for (int i_ = 0; i_ < 3; ++i_) { const int wp_ = wave + 8 * i_; if (wp_ < 18) { const int x_ = wp_ * 64 + lane; \
            __builtin_amdgcn_global_load_lds((const unsigned*)(PS + (size_t)(row0_ + x_ / 72) * PSW + (x_ % 72) * 4), (LAS unsigned*)(lds + rk::RAWF + bi_ * rk::RAWF_SZ + wp_ * 1024), 16, 0, 0); } } \
        if (wave < 6) { const int y_ = wave * 64 + lane; \
            __builtin_amdgcn_global_load_lds((const unsigned*)(PR + (size_t)(row0_ + y_ / 24) * PRW + ((y_ % 24) >> 3) * 1024 + h * 64 + (y_ & 7) * 8), (LAS unsigned*)(lds + rk::RAWH + bi_ * rk::RAWH_SZ + wave * 1024), 16, 0, 0); } } while (0)
#define RK_STAGE_A(ca_, t_) do { const int t = (t_); const int bc_ = (ca_) % 3, bp_ = ((ca_) + 2) % 3; \
        LAS const float* cF_ = (LAS const float*)(lds + rk::RAWF + bc_ * rk::RAWF_SZ); LAS const float* pF_ = (LAS const float*)(lds + rk::RAWF + bp_ * rk::RAWF_SZ); \
        LAS const bf16_t* cH_ = (LAS const bf16_t*)(lds + rk::RAWH + bc_ * rk::RAWH_SZ); LAS const bf16_t* pH_ = (LAS const bf16_t*)(lds + rk::RAWH + bp_ * rk::RAWH_SZ); \
        LAS const float* ctF = cF_ + t * 288; LAS const float* ptF = (t == 0) ? pF_ + 15 * 288 : cF_ + (t - 1) * 288; \
        LAS const bf16_t* ctH = cH_ + t * 192; LAS const bf16_t* ptH = (t == 0) ? pH_ + 15 * 192 : cH_ + (t - 1) * 192; \
        const float rc = bf2f(ctH[lane]), kc = bf2f(ctH[64 + lane]), vc = bf2f(ctH[128 + lane]); \
        const float rs = rc + (bf2f(ptH[lane]) - rc) * mur, ks = kc + (bf2f(ptH[64 + lane]) - kc) * muk, vs = vc + (bf2f(ptH[128 + lane]) - vc) * muv; \
        RSm[t * 64 + lane] = rs; KSm[t * 64 + lane] = ks; VSm[t * 64 + lane] = vs; \
        const float kkr = ks * kkw; const float n2 = wave_sum_dpp(kkr * kkr); KKNm[t * 64 + lane] = kkr * __builtin_amdgcn_rsqf(fmaxf(n2, 1e-24f)); \
        _Pragma("unroll") for (int q = 0; q < 5; ++q) { const int i = lane + 64 * q; if (i < 288) { const float xc = ctF[i]; const float x = xc + (ptF[i] - xc) * mul[q]; \
                LXB[t * 288 + i] = bf1(q == 0 ? fast_tanh(x) : (q == 1 ? x : fast_sigmoid(x))); } } } while (0)
#define RK_STAGE_F(cf_, t_) do { const int t = (t_); const int par_ = (cf_) & 1; const int rowF_ = ((cf_) == 0) ? MMAIN : b * SEQ + ((cf_) - 1) * 16; \
        LAS const float* Gp_ = (LAS const float*)(lds + rk::GG + par_ * 4096); LAS const float* Vp_ = (LAS const float*)(lds + rk::VF + par_ * 4096); LAS const float* Bp_ = (LAS const float*)(lds + rk::BONP + par_ * 256); \
        const float yv = YRm[t * 64 + lane]; \
        const float mean = wave_sum_dpp(yv) * (1.0f / 64.0f); const float d = yv - mean; const float var = wave_sum_dpp(d * d) * (1.0f / 64.0f); \
        const float yn = d * __builtin_amdgcn_rsqf(var + LNX_EPS) * lnw + lnb; \
        const float bonus = (Bp_[t] + Bp_[16 + t]) + (Bp_[32 + t] + Bp_[48 + t]); \
        const float o = (yn + bonus * Vp_[t * 64 + lane]) * Gp_[t * 64 + lane]; \
        if ((cf_) > 0 || b == 0) Y[(size_t)(rowF_ + t) * DM + hj] = bf1(o); } while (0)
    RK_DMA(0); RK_DMA(1);
    for (int e = tid; e < 288; e += 512) ((LAS float*)(lds + rk::RAWF + 2 * rk::RAWF_SZ))[15 * 288 + e] = 0.f;
    for (int e = tid; e < 96; e += 512) ((LAS unsigned*)(lds + rk::RAWH + 2 * rk::RAWH_SZ))[15 * 96 + e] = 0u;
    asm volatile("s_waitcnt vmcnt(0)" ::: "memory");
    RK_BAR();
    RK_STAGE_A(0, wave); RK_STAGE_A(0, wave + 8);
    RK_BAR();
#pragma unroll 1
    for (int c = 0; c < 257; ++c) {
        if (wave < 4) {
            LAS float* BONPc = (LAS float*)(lds + rk::BONP + (c & 1) * 256);
            f32x4 accW = (f32x4){0.f, 0.f, 0.f, 0.f}, accA = accW;
#pragma unroll
            for (int s = 0; s < 2; ++s) { const bf16x8_t aw = *(const LAS bf16x8_t*)(LXB + n * 288 + 32 * s + 8 * g), aa = *(const LAS bf16x8_t*)(LXB + n * 288 + 64 + 32 * s + 8 * g);
                accW = __builtin_amdgcn_mfma_f32_16x16x32_bf16(aw, fA[s], accW, 0, 0, 0); accA = __builtin_amdgcn_mfma_f32_16x16x32_bf16(aa, fB[s], accA, 0, 0, 0); }
            float lw[4], alr[4], pfx[4];
#pragma unroll
            for (int r = 0; r < 4; ++r) { lw[r] = -0.6065306597126334f * fast_sigmoid(accW[r] + w0k); alr[r] = fast_sigmoid(accA[r] + a0k); }
            pfx[0] = lw[0]; pfx[1] = pfx[0] + lw[1]; pfx[2] = pfx[1] + lw[2]; pfx[3] = pfx[2] + lw[3];
            const float t0 = __shfl(pfx[3], n), t1 = __shfl(pfx[3], n + 16), t2 = __shfl(pfx[3], n + 32), t3 = __shfl(pfx[3], n + 48);
            const float base = (g > 0 ? t0 : 0.f) + (g > 1 ? t1 : 0.f) + (g > 2 ? t2 : 0.f), lamT = (t0 + t1) + (t2 + t3);
            float bh[4], kh[4], bon[4], epos[4];
            const float eb = __expf(base), eT = __expf(lamT);
#pragma unroll
            for (int r = 0; r < 4; ++r) epos[r] = __expf(base + pfx[r]);
#pragma unroll
            for (int r = 0; r < 4; ++r) { const int t = 4 * g + r;
                const float e_pos = epos[r], e_neg = __builtin_amdgcn_rcpf(epos[r]), e_prev = (r == 0) ? eb : epos[r > 0 ? r - 1 : 0], e_hat = eT * e_neg;
                const float rs = RSm[t * 64 + key], ks = KSm[t * 64 + key], kk = KKNm[t * 64 + key];
                const float kmod = ks * (1.0f + (alr[r] - 1.0f) * kak), bb = kk * alr[r];
                ATp[t * 64 + pp] = bf1(-kk * e_prev); RTp[t * 64 + pp] = bf1(rs * e_pos); BTp[t * 64 + pp] = bf1(bb * e_neg); KTp[t * 64 + pp] = bf1(kmod * e_neg);
                bh[r] = bb * e_hat; kh[r] = kmod * e_hat; bon[r] = rs * kmod * rkk; }
            *(LAS bf16x4_t*)(BHt + key * 16 + 4 * g) = pack4(bh[0], bh[1], bh[2], bh[3]); *(LAS bf16x4_t*)(KHt + key * 16 + 4 * g) = pack4(kh[0], kh[1], kh[2], kh[3]);
#pragma unroll
            for (int r = 0; r < 4; ++r) { const float x = row_sum16(bon[r]); if (n == 0) BONPc[kw * 16 + 4 * g + r] = x; }
            if (g == 0) GTm[key] = eT;
        } else {
            LAS float* Gc = (LAS float*)(lds + rk::GG + (c & 1) * 4096); LAS float* VFc = (LAS float*)(lds + rk::VF + (c & 1) * 4096);
            f32x4 accG = (f32x4){0.f, 0.f, 0.f, 0.f};
#pragma unroll
            for (int s = 0; s < 5; ++s) { const bf16x8_t ag = *(const LAS bf16x8_t*)(LXB + n * 288 + 128 + 32 * s + 8 * g); accG = __builtin_amdgcn_mfma_f32_16x16x32_bf16(ag, fB[s], accG, 0, 0, 0); }
            float vv[4];
#pragma unroll
            for (int r = 0; r < 4; ++r) { Gc[(4 * g + r) * 64 + key] = accG[r]; vv[r] = VSm[(4 * g + r) * 64 + key]; VFc[(4 * g + r) * 64 + key] = vv[r]; }
            *(LAS bf16x4_t*)(Vt + key * 16 + 4 * g) = pack4(vv[0], vv[1], vv[2], vv[3]);
        }
        asm volatile("s_waitcnt vmcnt(0)" ::: "memory");
        RK_BAR();
        if (c + 2 < 257) RK_DMA(c + 2);
        if (wave < 4) {
            LAS const bf16_t* X = (wave < 2) ? ATp : RTp; LAS const bf16_t* Yi = (wave & 1) ? KTp : BTp;
            f32x4 acc = (f32x4){0.f, 0.f, 0.f, 0.f};
#pragma unroll
            for (int s = 0; s < 2; ++s) { const bf16x8_t xa = *(const LAS bf16x8_t*)(X + n * 64 + 32 * s + 8 * g), yb = *(const LAS bf16x8_t*)(Yi + n * 64 + 32 * s + 8 * g);
                acc = __builtin_amdgcn_mfma_f32_16x16x32_bf16(xa, yb, acc, 0, 0, 0); }
            float mv[4];
#pragma unroll
            for (int r = 0; r < 4; ++r) { const int t = 4 * g + r; const bool keep = (wave < 2) ? (n < t) : (n <= t); mv[r] = keep ? acc[r] : 0.f;
                if (wave == 1) AAKm[t * 16 + n] = bf1(mv[r]); else if (wave == 2) RBm[t * 16 + n] = bf1(mv[r]); else if (wave == 3) RKm[t * 16 + n] = bf1(mv[r]); }
            if (wave == 0) {
                float Tc[16];
#pragma unroll
                for (int t = 0; t < 16; ++t) { float v0 = (t == n) ? 1.0f : 0.0f, v1 = 0.f;
#pragma unroll
                    for (int i = 0; i < t; ++i) { const float a = rdlane(mv[t & 3], i + 16 * (t >> 2)); if (i & 1) v1 += a * Tc[i]; else v0 += a * Tc[i]; }
                    Tc[t] = v0 + v1; __builtin_amdgcn_sched_barrier(0); }
                if (g == 0) {
#pragma unroll
                    for (int t = 0; t < 16; ++t) TINVm[t * 16 + n] = bf1(Tc[t]); }
            }
        }
        if (wave >= 1) {
            if (c + 1 < 257) { RK_STAGE_A(c + 1, wave - 1); RK_STAGE_A(c + 1, wave + 6); if (wave < 3) RK_STAGE_A(c + 1, wave + 13); }
            if (c >= 1) { RK_STAGE_F(c - 1, wave - 1); RK_STAGE_F(c - 1, wave + 6); if (wave < 3) RK_STAGE_F(c - 1, wave + 13); }
        }
        RK_BAR();
        if (wave < 4) {
            bf16x8_t sb[2];
#pragma unroll
            for (int s = 0; s < 2; ++s) { u32x4 w; w.x = pk_bf16(ST[2 * s][0], ST[2 * s][1]); w.y = pk_bf16(ST[2 * s][2], ST[2 * s][3]); w.z = pk_bf16(ST[2 * s + 1][0], ST[2 * s + 1][1]); w.w = pk_bf16(ST[2 * s + 1][2], ST[2 * s + 1][3]);
                sb[s] = __builtin_bit_cast(bf16x8_t, w); }
            const bf16x4_t vfr = *(const LAS bf16x4_t*)(Vt + key * 16 + 4 * g);
            f32x4 W1 = (f32x4){0.f, 0.f, 0.f, 0.f}, Yc = W1;
#pragma unroll
            for (int s = 0; s < 2; ++s) { const bf16x8_t af = *(const LAS bf16x8_t*)(ATp + n * 64 + 32 * s + 8 * g), rf = *(const LAS bf16x8_t*)(RTp + n * 64 + 32 * s + 8 * g);
                W1 = __builtin_amdgcn_mfma_f32_16x16x32_bf16(af, sb[s], W1, 0, 0, 0); Yc = __builtin_amdgcn_mfma_f32_16x16x32_bf16(rf, sb[s], Yc, 0, 0, 0); }
            W1 = __builtin_amdgcn_mfma_f32_16x16x16bf16_1k(*(const LAS bf16x4_t*)(AAKm + n * 16 + 4 * g), vfr, W1, 0, 0, 0);
            const bf16x4_t w1f = pack4(W1[0], W1[1], W1[2], W1[3]);
            f32x4 U = __builtin_amdgcn_mfma_f32_16x16x16bf16_1k(*(const LAS bf16x4_t*)(TINVm + n * 16 + 4 * g), w1f, (f32x4){0.f, 0.f, 0.f, 0.f}, 0, 0, 0);
            const bf16x4_t uf = pack4(U[0], U[1], U[2], U[3]);
            Yc = __builtin_amdgcn_mfma_f32_16x16x16bf16_1k(*(const LAS bf16x4_t*)(RBm + n * 16 + 4 * g), uf, Yc, 0, 0, 0);
            Yc = __builtin_amdgcn_mfma_f32_16x16x16bf16_1k(*(const LAS bf16x4_t*)(RKm + n * 16 + 4 * g), vfr, Yc, 0, 0, 0);
#pragma unroll
            for (int r = 0; r < 4; ++r) YRm[(4 * g + r) * 64 + key] = Yc[r];
#pragma unroll
            for (int kb = 0; kb < 4; ++kb) { const f32x4 gt = *(const LAS f32x4*)(GTm + 16 * kb + 4 * g); f32x4 a = ST[kb] * gt;
                a = __builtin_amdgcn_mfma_f32_16x16x16bf16_1k(*(const LAS bf16x4_t*)(BHt + (16 * kb + n) * 16 + 4 * g), uf, a, 0, 0, 0);
                a = __builtin_amdgcn_mfma_f32_16x16x16bf16_1k(*(const LAS bf16x4_t*)(KHt + (16 * kb + n) * 16 + 4 * g), vfr, a, 0, 0, 0);
                ST[kb] = a; }
        }
        RK_BAR();
    }
    RK_STAGE_F(256, wave); RK_STAGE_F(256, wave + 8);
    asm volatile("s_waitcnt vmcnt(0)" ::: "memory");
    RK_BAR();
#undef RK_DMA
#undef RK_STAGE_A
#undef RK_STAGE_F
}

__device__ __forceinline__ f32x4 sk_dot(const bf16_t* a, const bf16_t* b, int nsteps) {
    f32x4 acc = (f32x4){0.f, 0.f, 0.f, 0.f};
#pragma unroll 4
    for (int s = 0; s < nsteps; ++s) { const bf16x8_t av = *(const bf16x8_t*)(a + 32 * s), bv = *(const bf16x8_t*)(b + 32 * s); acc = __builtin_amdgcn_mfma_f32_16x16x32_bf16(av, bv, acc, 0, 0, 0); }
    return acc; }
__device__ __forceinline__ void meta_rs(const float* ssm, int lane, float (&rs)[4]) {
    const int row = lane & 15, part = lane >> 4; float s = 0.f;
#pragma unroll 8
    for (int i = 0; i < 32; ++i) s += ssm[(part + 4 * i) * 16 + row];
    s = s + __shfl_xor(s, 16); s = s + __shfl_xor(s, 32);
    const float rv = __builtin_amdgcn_rsqf(s * (1.0f / 2048.0f) + 1e-6f);
#pragma unroll
    for (int r = 0; r < 4; ++r) rs[r] = __shfl(rv, 4 * part + r); }
#define SK_HEAD const int tid = ltid(), lane = tid & 63, wave = __builtin_amdgcn_readfirstlane(tid >> 6), n = lane & 15, g = lane >> 4, kq = wave & 3, ti = lbid() + 256 * (wave >> 2); LAS f32x4* part = (LAS f32x4*)lds;
#define SK_COMBINE(dst, slot) do { dst = (part[((wave) * 2 + (slot)) * 64 + lane] + part[((wave + 1) * 2 + (slot)) * 64 + lane]) + (part[((wave + 2) * 2 + (slot)) * 64 + lane] + part[((wave + 3) * 2 + (slot)) * 64 + lane]); } while (0)
__device__ __forceinline__ void skinny_gu(const bf16_t* hb, const bf16_t* Bt, const float* ssm, bf16_t* act, LAS unsigned char* lds) {
    using namespace cfg; SK_HEAD
    if (ti < DFF / 16) { const int c0 = 16 * ti, brow = (c0 >> 7) * 256 + (c0 & 127) + n; const bf16_t* a = hb + (size_t)(MMAIN + n) * DM + 512 * kq + 8 * g;
        part[(wave * 2) * 64 + lane] = sk_dot(a, Bt + (size_t)brow * DM + 512 * kq + 8 * g, 16); part[(wave * 2 + 1) * 64 + lane] = sk_dot(a, Bt + (size_t)(brow + 128) * DM + 512 * kq + 8 * g, 16); }
    __syncthreads();
    if (ti < DFF / 16 && kq == 0) { f32x4 gt, up; SK_COMBINE(gt, 0); SK_COMBINE(up, 1); float rs[4]; meta_rs(ssm, lane, rs);
#pragma unroll
        for (int r = 0; r < 4; ++r) { const float gv = gt[r] * rs[r], uv = up[r] * rs[r]; act[(size_t)(MMAIN + 4 * g + r) * DFF + 16 * ti + n] = bf1(gv * __builtin_amdgcn_rcpf(1.0f + __builtin_amdgcn_exp2f(-1.4426950408889634f * gv)) * uv); } }
    __syncthreads();
}
__device__ __forceinline__ void skinny_res(const bf16_t* A16, int K, const bf16_t* Bt, bf16_t* hb, float* ssm_out, float alpha, LAS unsigned char* lds) {
    using namespace cfg; SK_HEAD
    const int kqs = K / 4;
    if (ti < DM / 16) part[(wave * 2) * 64 + lane] = sk_dot(A16 + (size_t)n * K + kqs * kq + 8 * g, Bt + (size_t)(16 * ti + n) * K + kqs * kq + 8 * g, kqs / 32);
    __syncthreads();
    if (ti < DM / 16 && kq == 0) { f32x4 acc; SK_COMBINE(acc, 0);
#pragma unroll
        for (int r = 0; r < 4; ++r) { const int m = 4 * g + r, col = 16 * ti + n; bf16_t* p = hb + (size_t)(MMAIN + m) * DM + col; const float hv = bf2f(*p) + alpha * acc[r]; *p = bf1(hv);
            const float sq = row_sum16(hv * hv); if (n == 0) ssm_out[ti * 16 + m] = sq; } }
    __syncthreads();
}
__device__ __forceinline__ void skinny_p(const bf16_t* hb, const bf16_t* Bt, const float* ssm, bf16_t* pr, float* ps, bf16_t* qkv, LAS unsigned char* lds) {
    using namespace cfg; SK_HEAD
    if (ti < NIN / 16) part[(wave * 2) * 64 + lane] = sk_dot(hb + (size_t)(MMAIN + n) * DM + 512 * kq + 8 * g, Bt + (size_t)(16 * ti + n) * DM + 512 * kq + 8 * g, 16);
    __syncthreads();
    if (ti < NIN / 16 && kq == 0) { f32x4 acc; SK_COMBINE(acc, 0); float rs[4]; meta_rs(ssm, lane, rs); const int np = 16 * ti + n;
#pragma unroll
        for (int r = 0; r < 4; ++r) { const int m = 4 * g + r; const float v = acc[r] * rs[r];
            if (np < 3072) pr[(size_t)(MMAIN + m) * PRW + np] = bf1(v);
            else if (np < 3584) ps[(size_t)(MMAIN + m) * PSW + (np - 3072)] = v;
            else { const bf16_t w = bf1(v);
#pragma unroll
                for (int b = 0; b < NBATCH; ++b) qkv[((size_t)b * SEQP + 48 + m) * QKVW + (np - 3584)] = w; } } }
    __syncthreads();
}
#undef SK_HEAD
#undef SK_COMBINE

namespace fox {
constexpr int D = 128, NW = 8, QBLK = 32, KVBLK = 64, QB = NW * QBLK;
constexpr int LDQ = cfg::QKVW, LDK = cfg::QKVW, LDO = cfg::DM;
constexpr float SCALE = 0.08838834764831845f, THR = 8.f;
constexpr bool WSKIP = false;
constexpr int SHM_V = KVBLK * D * 2, SHM_K = KVBLK * D * 2;
constexpr int ATT_LDS = 2 * SHM_V + 2 * SHM_K + NW * 64 * 4;
constexpr int BIAS_OFF = ATT_LDS;
constexpr int SCAN_OFF = BIAS_OFF + cfg::SEQP * 4;

using bf16 = __hip_bfloat16;
typedef short bf16x8 __attribute__((ext_vector_type(8)));
typedef short s16x4 __attribute__((ext_vector_type(4)));
typedef float f32x16 __attribute__((ext_vector_type(16)));
typedef float f32x4 __attribute__((ext_vector_type(4)));
typedef unsigned u32x4 __attribute__((ext_vector_type(4)));
template <class A, class Bt> struct same_t { static constexpr bool v = false; };
template <class A> struct same_t<A, A> { static constexpr bool v = true; };

#define KSWZ(row, colB) ((row) * 256 + ((colB) ^ (((row) & 7) << 4)))
#define SBAR() __builtin_amdgcn_sched_barrier(0)
__device__ __forceinline__ int v_st(int k, int c) { const int kk = (k & ~0xC) | ((k & 4) << 1) | ((k & 8) >> 1); return ((kk >> 3) * 4 + (c >> 5)) * 512 + ((kk & 7) * 32 + (c & 31)) * 2; }
__device__ __forceinline__ int v_rd_base(int lane) { return ((lane & 3) << 3) | (((lane >> 2) & 3) << 6) | (((lane >> 4) & 1) << 5) | (((lane >> 5) & 1) << 8); }
constexpr int v_rd_off(int d0, int ks, int half) { return d0 * 512 + ks * 4096 + half * 2048; }
__device__ __forceinline__ int crow(int r, int hi) { return (r & 3) + 8 * (r >> 2) + 4 * hi; }
__device__ __forceinline__ unsigned cvtpk(float lo, float hi) {
    unsigned r; asm volatile("v_cvt_pk_bf16_f32 %0, %1, %2" : "=v"(r) : "v"(lo), "v"(hi)); return r;
}
__device__ __forceinline__ bf16x8 pack8(f32x4 a, f32x4 b) {
    u32x4 w = {cvtpk(a[0], a[1]), cvtpk(a[2], a[3]), cvtpk(b[0], b[1]), cvtpk(b[2], b[3])};
    return *reinterpret_cast<bf16x8*>(&w);
}
template <class T> __device__ __forceinline__ bf16x8 load8(const T* p) {
    if constexpr (same_t<T, float>::v) { return pack8(*(const f32x4*)p, *(const f32x4*)(p + 4)); }
    else { return *reinterpret_cast<const bf16x8*>(p); }
}
__device__ __forceinline__ void mask_tile(f32x16& p0, f32x16& p1, int dq, unsigned W) {
    const float NEG = -__builtin_inff();
#pragma unroll
    for (int r = 0; r < 16; ++r) {
        const int c = (r & 3) + 8 * (r >> 2);
        if ((unsigned)(dq - c) >= W) p0[r] = NEG;
        if ((unsigned)(dq - c - 32) >= W) p1[r] = NEG;
    }
}
__device__ __forceinline__ void partialSM(f32x16& p0, f32x16& p1, float& m_reg, float& mn, float& alpha) {
    float pmax = p0[0]; for (int r = 1; r < 16; ++r) pmax = fmaxf(pmax, p0[r]); for (int r = 0; r < 16; ++r) pmax = fmaxf(pmax, p1[r]);
    { auto rr = __builtin_amdgcn_permlane32_swap(__float_as_uint(pmax), __float_as_uint(pmax), false, false);
      pmax = fmaxf(__uint_as_float(rr[0]), __uint_as_float(rr[1])); }
    constexpr float C2 = 1.4426950408889634f * SCALE;
    if (__builtin_expect(__all((pmax - m_reg) * SCALE <= THR), 1)) { mn = m_reg; alpha = 1.f; }
    else { mn = fmaxf(m_reg, pmax); alpha = __builtin_amdgcn_exp2f((m_reg - mn) * C2); m_reg = mn; }
    const float mnL = -mn * C2;
    for (int r = 0; r < 16; ++r) p0[r] = fmaf(p0[r], C2, mnL); for (int r = 0; r < 16; ++r) p1[r] = fmaf(p1[r], C2, mnL);
    for (int r = 0; r < 16; ++r) p0[r] = __builtin_amdgcn_exp2f(p0[r]);
}
__device__ __forceinline__ void finishSM(f32x16& p0, f32x16& p1, float alpha, float& l_reg, bf16x8& pa0, bf16x8& pa1, bf16x8& pa2, bf16x8& pa3) {
    for (int r = 0; r < 16; ++r) p1[r] = __builtin_amdgcn_exp2f(p1[r]);
    float ps = 0; for (int r = 0; r < 16; ++r) ps += p0[r]; for (int r = 0; r < 16; ++r) ps += p1[r];
    { auto rr = __builtin_amdgcn_permlane32_swap(__float_as_uint(ps), __float_as_uint(ps), false, false);
      ps = __uint_as_float(rr[0]) + __uint_as_float(rr[1]); }
    l_reg = l_reg * alpha + ps;
#define PK4(P, B_, OUT) do { unsigned a0 = cvtpk(P[B_+0], P[B_+1]), a1 = cvtpk(P[B_+2], P[B_+3]);                          \
        unsigned b0 = cvtpk(P[B_+4], P[B_+5]), b1 = cvtpk(P[B_+6], P[B_+7]);                                             \
        auto r0 = __builtin_amdgcn_permlane32_swap(a0, b0, false, false); auto r1 = __builtin_amdgcn_permlane32_swap(a1, b1, false, false); \
        u32x4 w = {r0[0], r1[0], r0[1], r1[1]}; OUT = *reinterpret_cast<bf16x8*>(&w); } while (0)
    PK4(p0, 0, pa0); PK4(p0, 8, pa1); PK4(p1, 0, pa2); PK4(p1, 8, pa3);
#undef PK4
}
template <int KB, bool SK>
__device__ __forceinline__ void qkt(f32x16& p0, f32x16& p1, const char* K_lds, int r32, int hi, const bf16x8* qr, bool act, const float* bias_t) {
    if (SK && !act) { const float NEG = -__builtin_inff();
#pragma unroll
        for (int r = 0; r < 16; ++r) { p0[r] = NEG; p1[r] = NEG; } return; }
    {
#pragma unroll
        for (int g_ = 0; g_ < 4; ++g_) { const f32x4 b0_ = *(const f32x4*)(bias_t + 8 * g_ + 4 * hi); const f32x4 b1_ = *(const f32x4*)(bias_t + 32 + 8 * g_ + 4 * hi);
            p0[4 * g_] = b0_[0]; p0[4 * g_ + 1] = b0_[1]; p0[4 * g_ + 2] = b0_[2]; p0[4 * g_ + 3] = b0_[3];
            p1[4 * g_] = b1_[0]; p1[4 * g_ + 1] = b1_[1]; p1[4 * g_ + 2] = b1_[2]; p1[4 * g_ + 3] = b1_[3]; } }
    const char* kb[4];
#pragma unroll
    for (int dd = 0; dd < 4; ++dd) kb[dd] = K_lds + KB * SHM_K + KSWZ(r32, (dd * 16 + hi * 8) * 2);
#pragma unroll
    for (int d0 = 0; d0 < 8; ++d0) { const char* a = kb[d0 & 3] + (d0 >> 2) * 128;
        bf16x8 b0 = *reinterpret_cast<const bf16x8*>(a);
        bf16x8 b1 = *reinterpret_cast<const bf16x8*>(a + 32 * 256);
        p0 = __builtin_amdgcn_mfma_f32_32x32x16_bf16(b0, qr[d0], p0, 0, 0, 0);
        p1 = __builtin_amdgcn_mfma_f32_32x32x16_bf16(b1, qr[d0], p1, 0, 0, 0); }
}
template <int VB, bool SK>
__device__ __forceinline__ void pv_tile(f32x16* o, int vb0, bf16x8 pa0, bf16x8 pa1, bf16x8 pa2, bf16x8 pa3, bool act) {
    if (SK && !act) return;
#define TRRD(dst, off) asm volatile("ds_read_b64_tr_b16 %0, %1 offset:%2" : "=&v"(dst) : "v"(vb0), "i"(off) : "memory")
#define PV_D0(d0) do { s16x4 l0, l1, l2, l3, h0, h1, h2, h3; constexpr int b_ = VB * SHM_V + v_rd_off(d0, 0, 0);     \
        TRRD(l0, b_); TRRD(h0, b_ + 2048); TRRD(l1, b_ + 4096); TRRD(h1, b_ + 6144); TRRD(l2, b_ + 8192); TRRD(h2, b_ + 10240); TRRD(l3, b_ + 12288); TRRD(h3, b_ + 14336); \
        asm volatile("s_waitcnt lgkmcnt(0)" ::: "memory"); SBAR();                 \
        o[d0] = __builtin_amdgcn_mfma_f32_32x32x16_bf16(pa0, (bf16x8){l0[0], l0[1], l0[2], l0[3], h0[0], h0[1], h0[2], h0[3]}, o[d0], 0, 0, 0);   \
        o[d0] = __builtin_amdgcn_mfma_f32_32x32x16_bf16(pa1, (bf16x8){l1[0], l1[1], l1[2], l1[3], h1[0], h1[1], h1[2], h1[3]}, o[d0], 0, 0, 0);   \
        o[d0] = __builtin_amdgcn_mfma_f32_32x32x16_bf16(pa2, (bf16x8){l2[0], l2[1], l2[2], l2[3], h2[0], h2[1], h2[2], h2[3]}, o[d0], 0, 0, 0);   \
        o[d0] = __builtin_amdgcn_mfma_f32_32x32x16_bf16(pa3, (bf16x8){l3[0], l3[1], l3[2], l3[3], h3[0], h3[1], h3[2], h3[3]}, o[d0], 0, 0, 0); } while (0)
    PV_D0(0); PV_D0(1); PV_D0(2); PV_D0(3);
#undef PV_D0
#undef TRRD
}

template <class TIn, class TOut> struct BlockRef { const TIn* Q; const TIn* K; const TIn* V; TOut* O; int P0; };
template <class TIn> struct Seam {
    bf16x8 qr[8];
    bf16x8 st_v0, st_v1, st_k0, st_k1; f32x4 sf0, sf1, sf2, sf3;
    f32x4 tq[16];
};
__device__ __forceinline__ int swa_jlo(int P0, int W) { const int lowk = P0 - W + 1; return lowk > 0 ? lowk / KVBLK : 0; }
#define ROW(p, k0, rr) ((p) + (size_t)((k0) + (rr)) * LDK + sc)
#define VMW() asm volatile("s_waitcnt vmcnt(0)" ::: "memory")
#define VMWN(n) asm volatile("s_waitcnt vmcnt(%0)" :: "i"(n) : "memory")
#define SLOAD_H(Kp, Vp, k0) do { S.st_v0 = load8<TIn>(ROW(Vp, k0, sr)); S.st_v1 = load8<TIn>(ROW(Vp, k0, 32 + sr));              \
                         S.st_k0 = load8<TIn>(ROW(Kp, k0, sr)); S.st_k1 = load8<TIn>(ROW(Kp, k0, 32 + sr)); } while (0)
#define SWRITE_HK(bf) do { *(bf16x8*)(K_lds + (bf) * SHM_K + kws) = S.st_k0; *(bf16x8*)(K_lds + (bf) * SHM_K + kws + 32 * 256) = S.st_k1; } while (0)
#define SWRITE_HV(bf) do { *(bf16x8*)(V_lds + (bf) * SHM_V + vst0) = S.st_v0; *(bf16x8*)(V_lds + (bf) * SHM_V + vst1) = S.st_v1; } while (0)
#define SWRITE_H(bf) do { SWRITE_HV(bf); SWRITE_HK(bf); } while (0)
#define SLOAD_F(p, k0) do { S.sf0 = *(const f32x4*)ROW(p, k0, sr); S.sf1 = *(const f32x4*)(ROW(p, k0, sr) + 4);                \
                            S.sf2 = *(const f32x4*)ROW(p, k0, 32 + sr); S.sf3 = *(const f32x4*)(ROW(p, k0, 32 + sr) + 4); } while (0)
#define SWRITE_KF(bf) do { *(bf16x8*)(K_lds + (bf) * SHM_K + kws) = pack8(S.sf0, S.sf1); *(bf16x8*)(K_lds + (bf) * SHM_K + kws + 32 * 256) = pack8(S.sf2, S.sf3); } while (0)
#define SWRITE_VF(bf) do { *(bf16x8*)(V_lds + (bf) * SHM_V + vst0) = pack8(S.sf0, S.sf1); *(bf16x8*)(V_lds + (bf) * SHM_V + vst1) = pack8(S.sf2, S.sf3); } while (0)
template <class TIn, class TOut>
__device__ __forceinline__ void causal_swa_prime(const BlockRef<TIn, TOut>& cur, int W, char* lds, Seam<TIn>& S) {
    constexpr bool F32 = same_t<TIn, float>::v;
    const int tid = ltid(), wid = __builtin_amdgcn_readfirstlane(tid >> 6), lane = tid & 63, r32 = lane & 31, hi = lane >> 5;
    const int sr = tid >> 4, sc = (tid & 15) * 8, kws = KSWZ(sr, sc * 2); char* K_lds = lds + 2 * SHM_V;
    const int kb0 = swa_jlo(cur.P0, W) * KVBLK;
    for (int d0 = 0; d0 < 8; ++d0) S.qr[d0] = load8<TIn>(cur.Q + (size_t)(wid * QBLK + r32) * LDQ + d0 * 16 + hi * 8);
    if constexpr (F32) { SLOAD_F((const float*)cur.K, kb0); VMW(); SWRITE_KF(0); SBAR(); SLOAD_F((const float*)cur.V, kb0); }
    else { SLOAD_H(cur.K, cur.V, kb0); VMW(); SWRITE_HK(0); }
    __syncthreads();
}
template <class TIn, class TOut>
__device__ __forceinline__ void causal_swa_block(const BlockRef<TIn, TOut>& cur, const BlockRef<TIn, TOut>& nxt, int skv, int W, char* lds, Seam<TIn>& S, const float* bias_l) {
    constexpr bool F32 = same_t<TIn, float>::v;
    const int tid = ltid(), wid = __builtin_amdgcn_readfirstlane(tid >> 6), lane = tid & 63, r32 = lane & 31, hi = lane >> 5;
    const int j_lo = swa_jlo(cur.P0, W);
    int j_hi = (cur.P0 + QB - 1) / KVBLK + 1; if (j_hi > skv / KVBLK) j_hi = skv / KVBLK;
    const int NT = j_hi - j_lo;
    const int kbn = swa_jlo(nxt.P0, W) * KVBLK;
    const int qlo = cur.P0 + wid * QBLK, qm = qlo + r32 - 4 * hi;
    char* V_lds = lds; char* K_lds = lds + 2 * SHM_V;
    float* ws = (float*)(lds + 2 * SHM_V + 2 * SHM_K) + wid * 64; float* li_l = ws, * al_l = ws + 32;
    float m_reg = -1e30f, l_reg = 0; f32x16 o[4] = {};
    const int sr = tid >> 4, sc = (tid & 15) * 8, vst0 = v_st(sr, sc), vst1 = v_st(32 + sr, sc), kws = KSWZ(sr, sc * 2);
    const int vb0 = (int)(uintptr_t)V_lds + v_rd_base(lane);
    const TIn* Kh = cur.K; const TIn* Vh = cur.V;
#define RESC(a) do { if (__any((a) < 1.f)) { if (hi == 0) al_l[r32] = (a); asm volatile("s_waitcnt lgkmcnt(0)" ::: "memory");              \
                     for (int d_ = 0; d_ < 4; ++d_) for (int r = 0; r < 16; ++r) o[d_][r] *= al_l[crow(r, hi)]; } } while (0)
#define KBASE(t) ((j_lo + (t)) * KVBLK)
#define ACT(t) (KBASE(t) <= qlo + QBLK - 1 && KBASE(t) + KVBLK - 1 >= qlo - W + 1)
#define MASKT(P0_, P1_, t) do { const int kb_ = KBASE(t); if ((!SK || ACT(t)) && (kb_ + KVBLK - 1 > qlo || kb_ <= qlo + QBLK - 1 - W)) mask_tile(P0_, P1_, qm - kb_, (unsigned)W); } while (0)
    constexpr int NQL = F32 ? 16 : 8;
    constexpr bool SK = WSKIP && !F32;
#define SEAM_K0() do { VMWN(NQL); if constexpr (F32) { SWRITE_KF(0); SBAR(); SLOAD_F((const float*)nxt.V, kbn); } else { SWRITE_HK(0); } SBAR(); } while (0)
    f32x16 pA0, pA1, pB0, pB1; float mnA, mnB, alA, alB; bf16x8 pa0, pa1, pa2, pa3;
    if constexpr (F32) { VMW(); SWRITE_VF(0); SBAR(); } else { SWRITE_HV(0); SBAR(); }
    if (NT > 1) { if constexpr (F32) SLOAD_F((const float*)Kh, KBASE(1)); else SLOAD_H(Kh, Vh, KBASE(1)); }
    SBAR(); qkt<0, SK>(pA0, pA1, K_lds, r32, hi, S.qr, ACT(0), bias_l + KBASE(0));
    if constexpr (F32) { if (NT > 1) { VMW(); SWRITE_KF(1); SBAR(); SLOAD_F((const float*)Vh, KBASE(1)); } }
    MASKT(pA0, pA1, 0); partialSM(pA0, pA1, m_reg, mnA, alA);
    if (NT > 1) { VMW(); if constexpr (F32) { SWRITE_VF(1); SBAR(); if (NT > 2) SLOAD_F((const float*)Kh, KBASE(2)); } else SWRITE_H(1); }
    __syncthreads();
#define HALF_STEP(PX0, PX1, mnX, alX, PY0, PY1, alY, t, KB, VB, SB) do {                                                      \
        SBAR(); qkt<KB, SK>(PX0, PX1, K_lds, r32, hi, S.qr, ACT(t), bias_l + KBASE(t));                                             \
        finishSM(PY0, PY1, alY, l_reg, pa0, pa1, pa2, pa3); SBAR();                                                           \
        if ((t) + 1 < NT) { if constexpr (F32) { VMW(); SWRITE_KF(SB); SBAR(); SLOAD_F((const float*)Vh, KBASE((t) + 1)); }  \
                            else { SLOAD_H(Kh, Vh, KBASE((t) + 1)); } SBAR(); }                                               \
        pv_tile<VB, SK>(o, vb0, pa0, pa1, pa2, pa3, ACT((t) - 1)); MASKT(PX0, PX1, (t)); partialSM(PX0, PX1, m_reg, mnX, alX);                                        \
        __syncthreads();                                                                                                      \
        if ((t) + 1 < NT) { VMW(); if constexpr (F32) { SWRITE_VF(SB); SBAR(); if ((t) + 2 < NT) SLOAD_F((const float*)Kh, KBASE((t) + 2)); } \
                            else { SWRITE_H(SB); } }                                                                          \
        RESC(alX); __syncthreads(); } while (0)
    for (int t = 1; t + 1 < NT; t += 2) {
        HALF_STEP(pB0, pB1, mnB, alB, pA0, pA1, alA, t, 1, 0, 0);
        HALF_STEP(pA0, pA1, mnA, alA, pB0, pB1, alB, t + 1, 0, 1, 1);
    }
    const bool even = (NT & 1) == 0;
    if (even) { SBAR(); qkt<1, SK>(pB0, pB1, K_lds, r32, hi, S.qr, ACT(NT - 1), bias_l + KBASE(NT - 1)); SBAR(); }
#define QROW(e) (nxt.Q + (size_t)(wid * QBLK + r32) * LDQ + ((e) >> 1) * 16 + hi * 8 + ((e) & 1) * 4)
    if constexpr (F32) { SLOAD_F((const float*)nxt.K, kbn); SBAR();
#pragma unroll
        for (int e = 0; e < 8; ++e) S.tq[e] = *(const f32x4*)QROW(e); }
    else { SLOAD_H(nxt.K, nxt.V, kbn); SBAR();
#pragma unroll
        for (int d0 = 0; d0 < 8; ++d0) S.qr[d0] = load8<TIn>(nxt.Q + (size_t)(wid * QBLK + r32) * LDQ + d0 * 16 + hi * 8); }
    SBAR();
    finishSM(pA0, pA1, alA, l_reg, pa0, pa1, pa2, pa3); SBAR();
    if constexpr (F32) {
#pragma unroll
        for (int e = 8; e < 16; ++e) S.tq[e] = *(const f32x4*)QROW(e); SBAR(); }
#undef QROW
    pv_tile<0, SK>(o, vb0, pa0, pa1, pa2, pa3, ACT(even ? NT - 2 : NT - 1));
    if (even) { MASKT(pB0, pB1, NT - 1); partialSM(pB0, pB1, m_reg, mnB, alB); __syncthreads(); RESC(alB);
        finishSM(pB0, pB1, alB, l_reg, pa0, pa1, pa2, pa3); SBAR(); pv_tile<1, SK>(o, vb0, pa0, pa1, pa2, pa3, ACT(NT - 1)); }
    SBAR(); SEAM_K0();
    if (hi == 0) li_l[r32] = l_reg; asm volatile("s_waitcnt lgkmcnt(0)" ::: "memory");
    float rli[16];
#pragma unroll
    for (int r = 0; r < 16; ++r) rli[r] = __builtin_amdgcn_rcpf(li_l[crow(r, hi)]);
    TOut* Ow = cur.O + (size_t)(wid * QBLK) * LDO;
#pragma unroll
    for (int r = 0; r < 16; ++r) { const int orow = crow(r, hi);
#pragma unroll
        for (int d0 = 0; d0 < 4; ++d0) { const float v = o[d0][r] * rli[r];
            if constexpr (same_t<TOut, float>::v) { Ow[(size_t)orow * LDO + d0 * 32 + r32] = v; }
            else { const float vn = __shfl_xor(v, 1);
                   if ((r32 & 1) == 0) *(unsigned*)(Ow + (size_t)orow * LDO + d0 * 32 + r32) = cvtpk(v, vn); } } }
    if constexpr (F32) {
#pragma unroll
        for (int d0 = 0; d0 < 8; ++d0) S.qr[d0] = pack8(S.tq[2 * d0], S.tq[2 * d0 + 1]); }
    __syncthreads();
#undef RESC
#undef KBASE
#undef ACT
#undef MASKT
#undef SEAM_K0
#undef HALF_STEP
}
#undef ROW
#undef VMW
#undef VMWN
#undef SLOAD_H
#undef SWRITE_HK
#undef SWRITE_HV
#undef SWRITE_H
#undef SLOAD_F
#undef SWRITE_KF

}

__device__ __forceinline__ void fox_bias(PP P, int l, int b, int h, float* bias, float* scr) {
    using namespace cfg;
    const int tid = ltid(), lane = tid & 63, wave = tid >> 6;
    const float* PS = (const float*)(P->ws + WS_PS); const float bf = P->in[I_BF][l * FNH + h];
    float lf[9]; float loc = 0.f;
#pragma unroll
    for (int i = 0; i < 9; ++i) { const int pos = tid * 9 + i; float v = 0.f;
        if (pos < NMETA + SEQ) { const int row = pos < NMETA ? MMAIN + pos : b * SEQ + pos - NMETA; const float z = PS[(size_t)row * PSW + 288 + h] + bf;
            v = fminf(z, 0.f) - log1pf(__expf(-fabsf(z))); }
        loc += v; lf[i] = loc; }
    float inc = loc;
#pragma unroll
    for (int o = 1; o < 64; o <<= 1) { const float t = __shfl_up(inc, o); if (lane >= o) inc += t; }
    if (lane == 63) scr[wave] = inc;
    __syncthreads();
    float base = inc - loc;
    for (int w = 0; w < wave; ++w) base += scr[w];
    constexpr float INV = 1.0f / fox::SCALE;
#pragma unroll
    for (int i = 0; i < 9; ++i) { const int pos = tid * 9 + i; if (pos < NMETA + SEQ) bias[48 + pos] = -(base + lf[i]) * INV; }
    if (tid < 48) bias[tid] = -__builtin_inff();
    __syncthreads();
}
__device__ __forceinline__ void fox_meta(PP P, int h, const float* bias) {
    using namespace cfg;
    const int lane = ltid() & 63, wave = ltid() >> 6;
    const bf16_t* QKV = (const bf16_t*)(P->ws + WS_QKV); bf16_t* Y = (bf16_t*)(P->ws + WS_Y);
    for (int rep = 0; rep < 2; ++rep) { const int i = wave + 8 * rep;
        float s = -__builtin_inff();
        if (lane <= i) { const bf16_t* q = QKV + (size_t)(48 + i) * QKVW + h * 128; const bf16_t* k = QKV + (size_t)(48 + lane) * QKVW + 1024 + h * 128; float dot = 0.f;
            for (int d = 0; d < 128; ++d) dot += bf2f(q[d]) * bf2f(k[d]);
            s = (dot + bias[48 + lane]) * fox::SCALE; }
        const float m = wave_max(s); const float p = (lane <= i) ? __expf(s - m) : 0.f; const float lsum = wave_sum(p);
        float o0 = 0.f, o1 = 0.f;
        for (int j = 0; j <= i; ++j) { const float pj = __shfl(p, j); const bf16_t* v = QKV + (size_t)(48 + j) * QKVW + 2048 + h * 128; o0 += pj * bf2f(v[lane]); o1 += pj * bf2f(v[64 + lane]); }
        const float il = 1.0f / lsum;
        Y[(size_t)(MMAIN + i) * DM + 1024 + h * 128 + lane] = (bf16_t)(pk_bf16(o0 * il, 0.f) & 0xffffu);
        Y[(size_t)(MMAIN + i) * DM + 1024 + h * 128 + 64 + lane] = (bf16_t)(pk_bf16(o1 * il, 0.f) & 0xffffu); }
}
__device__ __forceinline__ fox::BlockRef<__hip_bfloat16, __hip_bfloat16> fox_mk(int a, int idx, const __hip_bfloat16* Qb, const __hip_bfloat16* Kb, const __hip_bfloat16* Vb, __hip_bfloat16* Ob) {
    const int pr = 4 * (a & 1) + (idx >> 1); const int x = (idx & 1) ? 15 - pr : pr;
    fox::BlockRef<__hip_bfloat16, __hip_bfloat16> r; r.Q = Qb + (size_t)x * 256 * cfg::QKVW; r.K = Kb; r.V = Vb; r.O = Ob + (size_t)x * 256 * cfg::DM; r.P0 = 64 + 256 * x; return r; }
__device__ __forceinline__ void fox_wg(PP P, int l, int a, char* lds) {
    using namespace cfg;
    typedef __hip_bfloat16 bf;
    const int bh = a >> 1, b = bh >> 3, h = bh & 7;
    float* bias = (float*)(lds + fox::BIAS_OFF); float* scr = (float*)(lds + fox::SCAN_OFF);
    fox_bias(P, l, b, h, bias, scr);
    const bf* QKV = (const bf*)(P->ws + WS_QKV); bf* Y = (bf*)(P->ws + WS_Y);
    const bf* Kb = QKV + (size_t)b * SEQP * QKVW + 1024 + h * 128; const bf* Vb = Kb + 1024; const bf* Qb = QKV + ((size_t)b * SEQP + 64) * QKVW + h * 128;
    bf* Ob = Y + (size_t)b * SEQ * DM + 1024 + h * 128;
    constexpr int W = 1 << 30;
    fox::Seam<bf> S;
    fox::BlockRef<bf, bf> cur = fox_mk(a, 0, Qb, Kb, Vb, Ob);
    fox::causal_swa_prime<bf, bf>(cur, W, lds, S);
#pragma unroll 1
    for (int idx = 0; idx < 8; ++idx) {
        const fox::BlockRef<bf, bf> nxt = (idx < 7) ? fox_mk(a, idx + 1, Qb, Kb, Vb, Ob) : cur;
        fox::causal_swa_block<bf, bf>(cur, nxt, SEQP, W, lds, S, bias);
        cur = nxt;
    }
    if (b == 0) fox_meta(P, h, bias);
}

#define WS_PTR(T, off) ((T*)(Q->ws + (off)))
#define SEAM() do { PP Qb_ = launder(P); XcdBarrier b_; b_.bar = (unsigned*)(Qb_->ws + WS_CTL); b_.x = xb_xcc_id(); b_.st = (volatile LAS unsigned*)(lds + LDS_BARW); xcd_barrier(b_); } while (0)
__global__ void __launch_bounds__(512, 2) hymba_fwd(Params Pv) {
    using namespace cfg;
    PP P = (PP)__builtin_amdgcn_kernarg_segment_ptr();
    extern __shared__ __attribute__((aligned(16))) unsigned char lds_raw[];
    LAS unsigned char* lds = (LAS unsigned char*)lds_raw;
    if (threadIdx.x < 4) ((LAS unsigned*)(lds + LDS_BARW))[threadIdx.x] = 0u;
    __syncthreads();
    { PP Q = launder(P); (void)xcd_barrier_post((unsigned*)(Q->ws + WS_CTL), (volatile LAS unsigned*)(lds + LDS_BARW)); }

    { PP Q = launder(P); phase_convert(Q, lds); phase_init(Q); }
    SEAM();
    {
        PP Q = launder(P); const unsigned char* wl = Q->ws + WS_W + (size_t)0 * W_LAYER;
        pg8::Gemm g{WS_PTR(const bf16_t, WS_HB), (const bf16_t*)(wl + WO_GU1), MMAIN, NGU, DM}; pg8::StaticOrder S; S.init(MMAIN, NGU, (int)gridDim.x, lbid());
        pg8::EpiGU E{WS_PTR(bf16_t, WS_ACT), WS_PTR(const float, WS_SS) + (size_t)(0) * 8 * MROWS};
        pg8::gemm_phase<pg8::EpiGU, pg8::StaticOrder, true, true>(lds, g, S, E);
        skinny_gu(WS_PTR(const bf16_t, WS_HB), g.Bt, WS_PTR(const float, WS_SSM) + (0) * 2048, WS_PTR(bf16_t, WS_ACT), lds);
    }
    SEAM();
    {
        PP Q = launder(P); const unsigned char* wl = Q->ws + WS_W + (size_t)0 * W_LAYER;
        pg8::Gemm g{WS_PTR(const bf16_t, WS_ACT), (const bf16_t*)(wl + WO_D1), MMAIN, DM, DFF}; pg8::StaticOrder S; S.init(MMAIN, DM, (int)gridDim.x, lbid());
        pg8::EpiRes E{WS_PTR(bf16_t, WS_HB), WS_PTR(float, WS_SS) + (size_t)(1) * 8 * MROWS, 0.5f, (LAS float*)(lds + 131072)};
        pg8::gemm_phase<pg8::EpiRes, pg8::StaticOrder, true, true>(lds, g, S, E);
        skinny_res(WS_PTR(const bf16_t, WS_ACT) + (size_t)MMAIN * DFF, DFF, g.Bt, WS_PTR(bf16_t, WS_HB), WS_PTR(float, WS_SSM) + (1) * 2048, 0.5f, lds);
    }
    SEAM();
    {
        PP Q = launder(P); const unsigned char* wl = Q->ws + WS_W + (size_t)0 * W_LAYER;
        pg8::Gemm g{WS_PTR(const bf16_t, WS_HB), (const bf16_t*)(wl + WO_IN), MMAIN, NIN, DM}; pg8::StaticOrder S; S.init(MMAIN, NIN, (int)gridDim.x, lbid());
        pg8::EpiP E{WS_PTR(bf16_t, WS_PR), WS_PTR(float, WS_PS), WS_PTR(bf16_t, WS_QKV), WS_PTR(const float, WS_SS) + (size_t)(1) * 8 * MROWS};
        pg8::gemm_phase<pg8::EpiP, pg8::StaticOrder, true, true>(lds, g, S, E);
        skinny_p(WS_PTR(const bf16_t, WS_HB), g.Bt, WS_PTR(const float, WS_SSM) + (1) * 2048, WS_PTR(bf16_t, WS_PR), WS_PTR(float, WS_PS), WS_PTR(bf16_t, WS_QKV), lds);
    }
    SEAM();
    {
        PP Q = launder(P); const int u = lbid();
        if (u < 128) rwkv_chunked(Q, 0, u >> 4, u & 15, lds);
        else fox_wg(Q, 0, u - 128, (char*)lds_raw);
    }
    SEAM();
    { PP Q = launder(P); phase_foxnorm(Q); }
    SEAM();
    {
        PP Q = launder(P); const unsigned char* wl = Q->ws + WS_W + (size_t)0 * W_LAYER;
        pg8::Gemm g{WS_PTR(const bf16_t, WS_Y), (const bf16_t*)(wl + WO_OUT), MMAIN, DM, DM}; pg8::StaticOrder S; S.init(MMAIN, DM, (int)gridDim.x, lbid());
        pg8::EpiRes E{WS_PTR(bf16_t, WS_HB), WS_PTR(float, WS_SS) + (size_t)(2) * 8 * MROWS, 1.0f, (LAS float*)(lds + 131072)};
        pg8::gemm_phase<pg8::EpiRes, pg8::StaticOrder, true, true>(lds, g, S, E);
        skinny_res(WS_PTR(const bf16_t, WS_Y) + (size_t)MMAIN * DM, DM, g.Bt, WS_PTR(bf16_t, WS_HB), WS_PTR(float, WS_SSM) + (2) * 2048, 1.0f, lds);
    }
    SEAM();
    {
        PP Q = launder(P); const unsigned char* wl = Q->ws + WS_W + (size_t)0 * W_LAYER;
        pg8::Gemm g{WS_PTR(const bf16_t, WS_HB), (const bf16_t*)(wl + WO_GU2), MMAIN, NGU, DM}; pg8::StaticOrder S; S.init(MMAIN, NGU, (int)gridDim.x, lbid());
        pg8::EpiGU E{WS_PTR(bf16_t, WS_ACT), WS_PTR(const float, WS_SS) + (size_t)(2) * 8 * MROWS};
        pg8::gemm_phase<pg8::EpiGU, pg8::StaticOrder, true, true>(lds, g, S, E);
        skinny_gu(WS_PTR(const bf16_t, WS_HB), g.Bt, WS_PTR(const float, WS_SSM) + (2) * 2048, WS_PTR(bf16_t, WS_ACT), lds);
    }
    SEAM();
    {
        PP Q = launder(P); const unsigned char* wl = Q->ws + WS_W + (size_t)0 * W_LAYER;
        pg8::Gemm g{WS_PTR(const bf16_t, WS_ACT), (const bf16_t*)(wl + WO_D2), MMAIN, DM, DFF}; pg8::StaticOrder S; S.init(MMAIN, DM, (int)gridDim.x, lbid());
        pg8::EpiRes E{WS_PTR(bf16_t, WS_HB), WS_PTR(float, WS_SS) + (size_t)(3) * 8 * MROWS, 0.5f, (LAS float*)(lds + 131072)};
        pg8::gemm_phase<pg8::EpiRes, pg8::StaticOrder, true, true>(lds, g, S, E);
        skinny_res(WS_PTR(const bf16_t, WS_ACT) + (size_t)MMAIN * DFF, DFF, g.Bt, WS_PTR(bf16_t, WS_HB), WS_PTR(float, WS_SSM) + (3) * 2048, 0.5f, lds);
    }
    SEAM();
    {
        PP Q = launder(P); const unsigned char* wl = Q->ws + WS_W + (size_t)1 * W_LAYER;
        pg8::Gemm g{WS_PTR(const bf16_t, WS_HB), (const bf16_t*)(wl + WO_GU1), MMAIN, NGU, DM}; pg8::StaticOrder S; S.init(MMAIN, NGU, (int)gridDim.x, lbid());
        pg8::EpiGU E{WS_PTR(bf16_t, WS_ACT), WS_PTR(const float, WS_SS) + (size_t)(3) * 8 * MROWS};
        pg8::gemm_phase<pg8::EpiGU, pg8::StaticOrder, true, true>(lds, g, S, E);
        skinny_gu(WS_PTR(const bf16_t, WS_HB), g.Bt, WS_PTR(const float, WS_SSM) + (3) * 2048, WS_PTR(bf16_t, WS_ACT), lds);
    }
    SEAM();
    {
        PP Q = launder(P); const unsigned char* wl = Q->ws + WS_W + (size_t)1 * W_LAYER;
        pg8::Gemm g{WS_PTR(const bf16_t, WS_ACT), (const bf16_t*)(wl + WO_D1), MMAIN, DM, DFF}; pg8::StaticOrder S; S.init(MMAIN, DM, (int)gridDim.x, lbid());
        pg8::EpiRes E{WS_PTR(bf16_t, WS_HB), WS_PTR(float, WS_SS) + (size_t)(4) * 8 * MROWS, 0.5f, (LAS float*)(lds + 131072)};
        pg8::gemm_phase<pg8::EpiRes, pg8::StaticOrder, true, true>(lds, g, S, E);
        skinny_res(WS_PTR(const bf16_t, WS_ACT) + (size_t)MMAIN * DFF, DFF, g.Bt, WS_PTR(bf16_t, WS_HB), WS_PTR(float, WS_SSM) + (4) * 2048, 0.5f, lds);
    }
    SEAM();
    {
        PP Q = launder(P); const unsigned char* wl = Q->ws + WS_W + (size_t)1 * W_LAYER;
        pg8::Gemm g{WS_PTR(const bf16_t, WS_HB), (const bf16_t*)(wl + WO_IN), MMAIN, NIN, DM}; pg8::StaticOrder S; S.init(MMAIN, NIN, (int)gridDim.x, lbid());
        pg8::EpiP E{WS_PTR(bf16_t, WS_PR), WS_PTR(float, WS_PS), WS_PTR(bf16_t, WS_QKV), WS_PTR(const float, WS_SS) + (size_t)(4) * 8 * MROWS};
        pg8::gemm_phase<pg8::EpiP, pg8::StaticOrder, true, true>(lds, g, S, E);
        skinny_p(WS_PTR(const bf16_t, WS_HB), g.Bt, WS_PTR(const float, WS_SSM) + (4) * 2048, WS_PTR(bf16_t, WS_PR), WS_PTR(float, WS_PS), WS_PTR(bf16_t, WS_QKV), lds);
    }
    SEAM();
    {
        PP Q = launder(P); const int u = lbid();
        if (u < 128) rwkv_chunked(Q, 1, u >> 4, u & 15, lds);
        else fox_wg(Q, 1, u - 128, (char*)lds_raw);
    }
    SEAM();
    { PP Q = launder(P); phase_foxnorm(Q); }
    SEAM();
    {
        PP Q = launder(P); const unsigned char* wl = Q->ws + WS_W + (size_t)1 * W_LAYER;
        pg8::Gemm g{WS_PTR(const bf16_t, WS_Y), (const bf16_t*)(wl + WO_OUT), MMAIN, DM, DM}; pg8::StaticOrder S; S.init(MMAIN, DM, (int)gridDim.x, lbid());
        pg8::EpiRes E{WS_PTR(bf16_t, WS_HB), WS_PTR(float, WS_SS) + (size_t)(5) * 8 * MROWS, 1.0f, (LAS float*)(lds + 131072)};
        pg8::gemm_phase<pg8::EpiRes, pg8::StaticOrder, true, true>(lds, g, S, E);
        skinny_res(WS_PTR(const bf16_t, WS_Y) + (size_t)MMAIN * DM, DM, g.Bt, WS_PTR(bf16_t, WS_HB), WS_PTR(float, WS_SSM) + (5) * 2048, 1.0f, lds);
    }
    SEAM();
    {
        PP Q = launder(P); const unsigned char* wl = Q->ws + WS_W + (size_t)1 * W_LAYER;
        pg8::Gemm g{WS_PTR(const bf16_t, WS_HB), (const bf16_t*)(wl + WO_GU2), MMAIN, NGU, DM}; pg8::StaticOrder S; S.init(MMAIN, NGU, (int)gridDim.x, lbid());
        pg8::EpiGU E{WS_PTR(bf16_t, WS_ACT), WS_PTR(const float, WS_SS) + (size_t)(5) * 8 * MROWS};
        pg8::gemm_phase<pg8::EpiGU, pg8::StaticOrder, true, true>(lds, g, S, E);
        skinny_gu(WS_PTR(const bf16_t, WS_HB), g.Bt, WS_PTR(const float, WS_SSM) + (5) * 2048, WS_PTR(bf16_t, WS_ACT), lds);
    }
    SEAM();
    {
        PP Q = launder(P); const unsigned char* wl = Q->ws + WS_W + (size_t)1 * W_LAYER;
        pg8::Gemm g{WS_PTR(const bf16_t, WS_ACT), (const bf16_t*)(wl + WO_D2), MMAIN, DM, DFF}; pg8::StaticOrder S; S.init(MMAIN, DM, (int)gridDim.x, lbid());
        pg8::EpiRes E{WS_PTR(bf16_t, WS_HB), WS_PTR(float, WS_SS) + (size_t)(6) * 8 * MROWS, 0.5f, (LAS float*)(lds + 131072)};
        pg8::gemm_phase<pg8::EpiRes, pg8::StaticOrder, true, true>(lds, g, S, E);
        skinny_res(WS_PTR(const bf16_t, WS_ACT) + (size_t)MMAIN * DFF, DFF, g.Bt, WS_PTR(bf16_t, WS_HB), WS_PTR(float, WS_SSM) + (6) * 2048, 0.5f, lds);
    }
    SEAM();
    {
        PP Q = launder(P); const unsigned char* wl = Q->ws + WS_W + (size_t)2 * W_LAYER;
        pg8::Gemm g{WS_PTR(const bf16_t, WS_HB), (const bf16_t*)(wl + WO_GU1), MMAIN, NGU, DM}; pg8::StaticOrder S; S.init(MMAIN, NGU, (int)gridDim.x, lbid());
        pg8::EpiGU E{WS_PTR(bf16_t, WS_ACT), WS_PTR(const float, WS_SS) + (size_t)(6) * 8 * MROWS};
        pg8::gemm_phase<pg8::EpiGU, pg8::StaticOrder, true, true>(lds, g, S, E);
        skinny_gu(WS_PTR(const bf16_t, WS_HB), g.Bt, WS_PTR(const float, WS_SSM) + (6) * 2048, WS_PTR(bf16_t, WS_ACT), lds);
    }
    SEAM();
    {
        PP Q = launder(P); const unsigned char* wl = Q->ws + WS_W + (size_t)2 * W_LAYER;
        pg8::Gemm g{WS_PTR(const bf16_t, WS_ACT), (const bf16_t*)(wl + WO_D1), MMAIN, DM, DFF}; pg8::StaticOrder S; S.init(MMAIN, DM, (int)gridDim.x, lbid());
        pg8::EpiRes E{WS_PTR(bf16_t, WS_HB), WS_PTR(float, WS_SS) + (size_t)(7) * 8 * MROWS, 0.5f, (LAS float*)(lds + 131072)};
        pg8::gemm_phase<pg8::EpiRes, pg8::StaticOrder, true, true>(lds, g, S, E);
        skinny_res(WS_PTR(const bf16_t, WS_ACT) + (size_t)MMAIN * DFF, DFF, g.Bt, WS_PTR(bf16_t, WS_HB), WS_PTR(float, WS_SSM) + (7) * 2048, 0.5f, lds);
    }
    SEAM();
    {
        PP Q = launder(P); const unsigned char* wl = Q->ws + WS_W + (size_t)2 * W_LAYER;
        pg8::Gemm g{WS_PTR(const bf16_t, WS_HB), (const bf16_t*)(wl + WO_IN), MMAIN, NIN, DM}; pg8::StaticOrder S; S.init(MMAIN, NIN, (int)gridDim.x, lbid());
        pg8::EpiP E{WS_PTR(bf16_t, WS_PR), WS_PTR(float, WS_PS), WS_PTR(bf16_t, WS_QKV), WS_PTR(const float, WS_SS) + (size_t)(7) * 8 * MROWS};
        pg8::gemm_phase<pg8::EpiP, pg8::StaticOrder, true, true>(lds, g, S, E);
        skinny_p(WS_PTR(const bf16_t, WS_HB), g.Bt, WS_PTR(const float, WS_SSM) + (7) * 2048, WS_PTR(bf16_t, WS_PR), WS_PTR(float, WS_PS), WS_PTR(bf16_t, WS_QKV), lds);
    }
    SEAM();
    {
        PP Q = launder(P); const int u = lbid();
        if (u < 128) rwkv_chunked(Q, 2, u >> 4, u & 15, lds);
        else fox_wg(Q, 2, u - 128, (char*)lds_raw);
    }
    SEAM();
    { PP Q = launder(P); phase_foxnorm(Q); }
    SEAM();
    {
        PP Q = launder(P); const unsigned char* wl = Q->ws + WS_W + (size_t)2 * W_LAYER;
        pg8::Gemm g{WS_PTR(const bf16_t, WS_Y), (const bf16_t*)(wl + WO_OUT), MMAIN, DM, DM}; pg8::StaticOrder S; S.init(MMAIN, DM, (int)gridDim.x, lbid());
        pg8::EpiRes E{WS_PTR(bf16_t, WS_HB), WS_PTR(float, WS_SS) + (size_t)(8) * 8 * MROWS, 1.0f, (LAS float*)(lds + 131072)};
        pg8::gemm_phase<pg8::EpiRes, pg8::StaticOrder, true, true>(lds, g, S, E);
        skinny_res(WS_PTR(const bf16_t, WS_Y) + (size_t)MMAIN * DM, DM, g.Bt, WS_PTR(bf16_t, WS_HB), WS_PTR(float, WS_SSM) + (8) * 2048, 1.0f, lds);
    }
    SEAM();
    {
        PP Q = launder(P); const unsigned char* wl = Q->ws + WS_W + (size_t)2 * W_LAYER;
        pg8::Gemm g{WS_PTR(const bf16_t, WS_HB), (const bf16_t*)(wl + WO_GU2), MMAIN, NGU, DM}; pg8::StaticOrder S; S.init(MMAIN, NGU, (int)gridDim.x, lbid());
        pg8::EpiGU E{WS_PTR(bf16_t, WS_ACT), WS_PTR(const float, WS_SS) + (size_t)(8) * 8 * MROWS};
        pg8::gemm_phase<pg8::EpiGU, pg8::StaticOrder, true, true>(lds, g, S, E);
        skinny_gu(WS_PTR(const bf16_t, WS_HB), g.Bt, WS_PTR(const float, WS_SSM) + (8) * 2048, WS_PTR(bf16_t, WS_ACT), lds);
    }
    SEAM();
    {
        PP Q = launder(P); const unsigned char* wl = Q->ws + WS_W + (size_t)2 * W_LAYER;
        pg8::Gemm g{WS_PTR(const bf16_t, WS_ACT), (const bf16_t*)(wl + WO_D2), MMAIN, DM, DFF}; pg8::StaticOrder S; S.init(MMAIN, DM, (int)gridDim.x, lbid());
        pg8::EpiRes E{WS_PTR(bf16_t, WS_HB), WS_PTR(float, WS_SS) + (size_t)(9) * 8 * MROWS, 0.5f, (LAS float*)(lds + 131072)};
        pg8::gemm_phase<pg8::EpiRes, pg8::StaticOrder, true, true>(lds, g, S, E);
        skinny_res(WS_PTR(const bf16_t, WS_ACT) + (size_t)MMAIN * DFF, DFF, g.Bt, WS_PTR(bf16_t, WS_HB), WS_PTR(float, WS_SSM) + (9) * 2048, 0.5f, lds);
    }
    SEAM();
    {
        PP Q = launder(P); const unsigned char* wl = Q->ws + WS_W + (size_t)3 * W_LAYER;
        pg8::Gemm g{WS_PTR(const bf16_t, WS_HB), (const bf16_t*)(wl + WO_GU1), MMAIN, NGU, DM}; pg8::StaticOrder S; S.init(MMAIN, NGU, (int)gridDim.x, lbid());
        pg8::EpiGU E{WS_PTR(bf16_t, WS_ACT), WS_PTR(const float, WS_SS) + (size_t)(9) * 8 * MROWS};
        pg8::gemm_phase<pg8::EpiGU, pg8::StaticOrder, true, true>(lds, g, S, E);
        skinny_gu(WS_PTR(const bf16_t, WS_HB), g.Bt, WS_PTR(const float, WS_SSM) + (9) * 2048, WS_PTR(bf16_t, WS_ACT), lds);
    }
    SEAM();
    {
        PP Q = launder(P); const unsigned char* wl = Q->ws + WS_W + (size_t)3 * W_LAYER;
        pg8::Gemm g{WS_PTR(const bf16_t, WS_ACT), (const bf16_t*)(wl + WO_D1), MMAIN, DM, DFF}; pg8::StaticOrder S; S.init(MMAIN, DM, (int)gridDim.x, lbid());
        pg8::EpiRes E{WS_PTR(bf16_t, WS_HB), WS_PTR(float, WS_SS) + (size_t)(10) * 8 * MROWS, 0.5f, (LAS float*)(lds + 131072)};
        pg8::gemm_phase<pg8::EpiRes, pg8::StaticOrder, true, true>(lds, g, S, E);
        skinny_res(WS_PTR(const bf16_t, WS_ACT) + (size_t)MMAIN * DFF, DFF, g.Bt, WS_PTR(bf16_t, WS_HB), WS_PTR(float, WS_SSM) + (10) * 2048, 0.5f, lds);
    }
    SEAM();
    {
        PP Q = launder(P); const unsigned char* wl = Q->ws + WS_W + (size_t)3 * W_LAYER;
        pg8::Gemm g{WS_PTR(const bf16_t, WS_HB), (const bf16_t*)(wl + WO_IN), MMAIN, NIN, DM}; pg8::StaticOrder S; S.init(MMAIN, NIN, (int)gridDim.x, lbid());
        pg8::EpiP E{WS_PTR(bf16_t, WS_PR), WS_PTR(float, WS_PS), WS_PTR(bf16_t, WS_QKV), WS_PTR(const float, WS_SS) + (size_t)(10) * 8 * MROWS};
        pg8::gemm_phase<pg8::EpiP, pg8::StaticOrder, true, true>(lds, g, S, E);
        skinny_p(WS_PTR(const bf16_t, WS_HB), g.Bt, WS_PTR(const float, WS_SSM) + (10) * 2048, WS_PTR(bf16_t, WS_PR), WS_PTR(float, WS_PS), WS_PTR(bf16_t, WS_QKV), lds);
    }
    SEAM();
    {
        PP Q = launder(P); const int u = lbid();
        if (u < 128) rwkv_chunked(Q, 3, u >> 4, u & 15, lds);
        else fox_wg(Q, 3, u - 128, (char*)lds_raw);
    }
    SEAM();
    { PP Q = launder(P); phase_foxnorm(Q); }
    SEAM();
    {
        PP Q = launder(P); const unsigned char* wl = Q->ws + WS_W + (size_t)3 * W_LAYER;
        pg8::Gemm g{WS_PTR(const bf16_t, WS_Y), (const bf16_t*)(wl + WO_OUT), MMAIN, DM, DM}; pg8::StaticOrder S; S.init(MMAIN, DM, (int)gridDim.x, lbid());
        pg8::EpiRes E{WS_PTR(bf16_t, WS_HB), WS_PTR(float, WS_SS) + (size_t)(11) * 8 * MROWS, 1.0f, (LAS float*)(lds + 131072)};
        pg8::gemm_phase<pg8::EpiRes, pg8::StaticOrder, true, true>(lds, g, S, E);
        skinny_res(WS_PTR(const bf16_t, WS_Y) + (size_t)MMAIN * DM, DM, g.Bt, WS_PTR(bf16_t, WS_HB), WS_PTR(float, WS_SSM) + (11) * 2048, 1.0f, lds);
    }
    SEAM();
    {
        PP Q = launder(P); const unsigned char* wl = Q->ws + WS_W + (size_t)3 * W_LAYER;
        pg8::Gemm g{WS_PTR(const bf16_t, WS_HB), (const bf16_t*)(wl + WO_GU2), MMAIN, NGU, DM}; pg8::StaticOrder S; S.init(MMAIN, NGU, (int)gridDim.x, lbid());
        pg8::EpiGU E{WS_PTR(bf16_t, WS_ACT), WS_PTR(const float, WS_SS) + (size_t)(11) * 8 * MROWS};
        pg8::gemm_phase<pg8::EpiGU, pg8::StaticOrder, true, true>(lds, g, S, E);
        skinny_gu(WS_PTR(const bf16_t, WS_HB), g.Bt, WS_PTR(const float, WS_SSM) + (11) * 2048, WS_PTR(bf16_t, WS_ACT), lds);
    }
    SEAM();
    {
        PP Q = launder(P); const unsigned char* wl = Q->ws + WS_W + (size_t)3 * W_LAYER;
        pg8::Gemm g{WS_PTR(const bf16_t, WS_ACT), (const bf16_t*)(wl + WO_D2), MMAIN, DM, DFF}; pg8::StaticOrder S; S.init(MMAIN, DM, (int)gridDim.x, lbid());
        pg8::EpiRes E{WS_PTR(bf16_t, WS_HB), WS_PTR(float, WS_SS) + (size_t)(12) * 8 * MROWS, 0.5f, (LAS float*)(lds + 131072)};
        pg8::gemm_phase<pg8::EpiRes, pg8::StaticOrder, true, true>(lds, g, S, E);
        skinny_res(WS_PTR(const bf16_t, WS_ACT) + (size_t)MMAIN * DFF, DFF, g.Bt, WS_PTR(bf16_t, WS_HB), WS_PTR(float, WS_SSM) + (12) * 2048, 0.5f, lds);
    }
    SEAM();
    { PP Q = launder(P); phase_final(Q); }
}

extern "C" void kernel_launch(void* const* d_in, const int* in_sizes, int n_in, void* d_out, int out_size, void* d_ws, size_t ws_size, hipStream_t stream) {
    using namespace cfg;
    static int grid = 0;
    if (grid == 0) {
        if (n_in != 25 || out_size != MMAIN * DM || ws_size < WS_END) { fprintf(stderr, "kernel_launch: need 25 inputs, out %d, ws >= %zu; got n_in %d out %d ws %zu\n", MMAIN * DM, (size_t)WS_END, n_in, out_size, ws_size); grid = -1; return; }
        int dev = 0, cus = 0, per_cu = 0;
        if (hipGetDevice(&dev) != hipSuccess || hipDeviceGetAttribute(&cus, hipDeviceAttributeMultiprocessorCount, dev) != hipSuccess) { grid = -1; return; }
        if (hipFuncSetAttribute((const void*)hymba_fwd, hipFuncAttributeMaxDynamicSharedMemorySize, LDS_BYTES) != hipSuccess) { fprintf(stderr, "kernel_launch: hipFuncSetAttribute failed\n"); grid = -1; return; }
        if (hipOccupancyMaxActiveBlocksPerMultiprocessor(&per_cu, (const void*)hymba_fwd, 512, LDS_BYTES) != hipSuccess || per_cu < 1) fprintf(stderr, "kernel_launch: occupancy query says %d\n", per_cu);
        (void)hipGetLastError();
        if (cus < 256) { fprintf(stderr, "kernel_launch: built for a 256-CU device (one resident workgroup per CU), found %d CUs\n", cus); grid = -1; return; }
        grid = 256;
    }
    if (grid < 0) return;
    if (hipMemsetAsync((char*)d_ws + WS_CTL, 0, CTL_BYTES, stream) != hipSuccess) return;
    Params p{};
    for (int i = 0; i < 25; ++i) p.in[i] = (const float*)d_in[i];
    p.out = (float*)d_out; p.ws = (unsigned char*)d_ws; p.ph_lo = 0; p.ph_hi = 0;
    hipLaunchKernelGGL(hymba_fwd, dim3(grid), dim3(512), LDS_BYTES, stream, p);
}
```

```cpp
#include <hip/hip_runtime.h>
#include <hip/hip_bf16.h>
#include <cstdio>
#include <cstdint>

#define LAS __attribute__((address_space(3)))
namespace cfg {
constexpr int DM = 2048, NBATCH = 8, SEQ = 4096, NMETA = 16, DEPTH = 4;
constexpr int MMAIN = NBATCH * SEQ;
constexpr int MROWS = MMAIN + 256;
constexpr int DFF = 5632, NGU = 2 * DFF;
constexpr int RW = 1024, RH = 64, RNH = 16;
constexpr int FW = 1024, FH = 128, FNH = 8;
constexpr int RWKV_COLS = 3360, DIN = 6440;
constexpr int NIN = 6656;
constexpr int PRW = 3072, PSW = 512, QKVW = 3072;
constexpr int SEQP = 4160;
constexpr float NORM_EPS = 1e-6f, LNX_EPS = 64e-5f;
constexpr int NSS = 13;
constexpr size_t al256(size_t x) { return (x + 255) & ~(size_t)255; }
constexpr size_t WS_CTL = 0;
constexpr size_t CTL_BYTES = 65536;
constexpr size_t WS_SS = WS_CTL + CTL_BYTES;
constexpr size_t SS_BYTES = al256((size_t)NSS * 8 * MROWS * 4);
constexpr size_t ZERO_BYTES = CTL_BYTES + SS_BYTES;
constexpr size_t WS_SSM = WS_SS + SS_BYTES;
constexpr size_t SSM_BYTES = (size_t)NSS * 2048 * 4;
constexpr size_t WS_HMETA = WS_SSM + SSM_BYTES;
constexpr size_t WS_HB = WS_HMETA + (size_t)256 * DM * 4;
constexpr size_t WS_Y = WS_HB + (size_t)MROWS * DM * 2;
constexpr size_t WS_OVL = WS_Y + (size_t)MROWS * DM * 2;
constexpr size_t WS_ACT = WS_OVL;
constexpr size_t WS_PR = WS_OVL;
constexpr size_t WS_PS = WS_PR + (size_t)MROWS * PRW * 2;
constexpr size_t WS_QKV = WS_PS + (size_t)MROWS * PSW * 4;
constexpr size_t OVL_A = (size_t)MROWS * DFF * 2, OVL_B = (size_t)MROWS * PRW * 2 + (size_t)MROWS * PSW * 4 + (size_t)NBATCH * SEQP * QKVW * 2;
constexpr size_t WS_W = WS_OVL + al256(OVL_A > OVL_B ? OVL_A : OVL_B);
constexpr size_t W_GU = (size_t)NGU * DM * 2, W_D = (size_t)DM * DFF * 2, W_IN = (size_t)NIN * DM * 2, W_OUT = (size_t)DM * DM * 2;
constexpr size_t WO_GU1 = 0, WO_D1 = WO_GU1 + W_GU, WO_IN = WO_D1 + W_D, WO_OUT = WO_IN + W_IN, WO_GU2 = WO_OUT + W_OUT, WO_D2 = WO_GU2 + W_GU, W_LAYER = WO_D2 + W_D;
constexpr size_t WS_LXG = WS_W + (size_t)DEPTH * W_LAYER;
constexpr size_t WS_END = WS_LXG + (size_t)DEPTH * MROWS * 320 * 2;
constexpr int LDS_BYTES = 147456;
constexpr int LDS_BARW = LDS_BYTES - 16;
}
__device__ __forceinline__ int ltid() { int t = (int)threadIdx.x; asm volatile("" : "+v"(t)); return t; }
__device__ __forceinline__ int lbid() { int t = (int)blockIdx.x; asm volatile("" : "+s"(t)); return t; }
__device__ __forceinline__ int lzero() { int t = 0; asm volatile("" : "+v"(t)); return t; }
namespace pg8 {
#define PG8_LAS __attribute__((address_space(3)))
typedef unsigned short bf16_t;
typedef short bf16x8 __attribute__((ext_vector_type(8)));
typedef float f32x4 __attribute__((ext_vector_type(4)));
typedef unsigned u32x4 __attribute__((ext_vector_type(4)));
constexpr int BM = 256, BK = 64, HALF = 128, HTB = HALF * BK * 2  , STAGE_BYTES = 8 * HTB, NXCD = 8, WGM = 8;

__host__ __device__ __forceinline__ int lds_byte(int r, int c) { const int st = (r >> 4) * 2 + (c >> 5), rr = r & 15, cc = c & 31, ob = rr * 64 + cc * 2; return st * 1024 + (ob ^ (((ob >> 9) & 1) << 5)); }
__host__ __device__ __forceinline__ void stage_rc(int b, int& R, int& C) { const int st = b / 1024, sb = b % 1024, swz = sb ^ (((sb >> 9) & 1) << 5); R = (st >> 1) * 16 + swz / 64; C = (st & 1) * 32 + (swz % 64) / 2; }
__host__ __device__ __forceinline__ int perm32(int rho) { const int n = rho >> 4, i = rho & 15; return 8 * (i >> 2) + 4 * n + (i & 3); }

struct Unit { int pm, pn; };
struct Gemm { const bf16_t* A; const bf16_t* Bt; int M, N, K; };

struct StaticOrder {
    int nM, nN, nwg, G, c;
    __host__ __device__ void init(int M, int N, int G_, int c_) { nM = M / BM; nN = N / BM; nwg = nM * nN; G = G_; c = c_; }
    __host__ __device__ bool next(int i, Unit& u) const {
        const long L = (long)i * G + c; if (L >= nwg) return false;
        int wgid = (int)L; { const int q = nwg / NXCD, r = nwg % NXCD, xcd = wgid % NXCD, off = wgid / NXCD; wgid = (xcd < r ? xcd * (q + 1) : r * (q + 1) + (xcd - r) * q) + off; }
        const int nig = WGM * nN, gid = wgid / nig, fm = gid * WGM, gsz = (nM - fm) < WGM ? (nM - fm) : WGM;
        u.pm = fm + ((wgid % nig) % gsz); u.pn = (wgid % nig) / gsz; return true;
    }
    __device__ __forceinline__ void a_ready(const Unit&) const {}
    __device__ __forceinline__ void done(const Unit&) const {}
};

__device__ __forceinline__ unsigned cvt_pk_bf16(float lo, float hi) { unsigned r; asm volatile("v_cvt_pk_bf16_f32 %0, %1, %2" : "=v"(r) : "v"(lo), "v"(hi)); return r; }
typedef float f32x2 __attribute__((ext_vector_type(2)));
__device__ __forceinline__ f32x2 gelu_pk(f32x2 v) {
    const f32x2 av = __builtin_elementwise_abs(v), d = av * 0.2316418882f + 1.0f;
    f32x2 t; t.x = __builtin_amdgcn_rcpf(d.x); t.y = __builtin_amdgcn_rcpf(d.y);
    f32x2 q = t * 0.5307027145f + (-0.7265760135f); q = q * t + 0.7107068705f; q = q * t + (-0.142248368f); q = q * t + 0.127414796f; q = q * t;
    const f32x2 s = (v * v) * (-0.72134752044f);
    f32x2 e; e.x = __builtin_amdgcn_exp2f(s.x); e.y = __builtin_amdgcn_exp2f(s.y);
    const f32x2 m = v * (q * e), r = v - m;
    f32x2 o; o.x = v.x < 0.f ? m.x : r.x; o.y = v.y < 0.f ? m.y : r.y; return o;
}
__device__ __forceinline__ float rs_of(const float* ss, int row) { float s = 0.f;
#pragma unroll
    for (int t = 0; t < 8; ++t) s += ss[(size_t)t * 33024 + row];
    return __builtin_amdgcn_rsqf(s * (1.0f / 2048.0f) + 1e-6f); }
__device__ __forceinline__ float silu_f(float x) { return x * __builtin_amdgcn_rcpf(1.0f + __builtin_amdgcn_exp2f(-1.4426950408889634f * x)); }

struct EpiGU {
    static constexpr bool PERM = true, AFTER_DRAIN = false;
    bf16_t* act; const float* ss;
    __device__ __forceinline__ void operator()(const f32x4 (&acc)[2][2][4][2], const Unit& u, int wr, int wc, int fr, int fq) const {
        const int row0 = u.pm * BM + wr * 64 + fr, col0 = u.pn * 128 + wc * 32 + 8 * fq;
#pragma unroll
        for (int ai = 0; ai < 2; ++ai)
#pragma unroll
            for (int m = 0; m < 4; ++m) { const int row = row0 + ai * HALF + m * 16; const float rs = rs_of(ss, row);
                const f32x4 g0 = acc[ai][0][m][0] * rs, g1 = acc[ai][0][m][1] * rs, u0 = acc[ai][1][m][0] * rs, u1 = acc[ai][1][m][1] * rs;
                u32x4 w;
                w.x = cvt_pk_bf16(silu_f(g0[0]) * u0[0], silu_f(g0[1]) * u0[1]); w.y = cvt_pk_bf16(silu_f(g0[2]) * u0[2], silu_f(g0[3]) * u0[3]);
                w.z = cvt_pk_bf16(silu_f(g1[0]) * u1[0], silu_f(g1[1]) * u1[1]); w.w = cvt_pk_bf16(silu_f(g1[2]) * u1[2], silu_f(g1[3]) * u1[3]);
                *(u32x4*)(act + (size_t)row * 5632 + col0) = w; }
    }
};
struct EpiRes {
    static constexpr bool PERM = true, AFTER_DRAIN = false;
    bf16_t* hb; float* ssn; float alpha; PG8_LAS float* red;
    __device__ __forceinline__ void operator()(const f32x4 (&acc)[2][2][4][2], const Unit& u, int wr, int wc, int fr, int fq) const {
        bf16_t* bbase = hb + (size_t)u.pm * BM * 2048;
        const int rl0 = wr * 64 + fr; unsigned off = (unsigned)(rl0 * 2048 + u.pn * BM + wc * 32 + 8 * fq);
#pragma unroll
        for (int ai = 0; ai < 2; ++ai) {
            u32x4 hv[4][2];
#pragma unroll
            for (int m = 0; m < 4; ++m)
#pragma unroll
                for (int bj = 0; bj < 2; ++bj) hv[m][bj] = *(const u32x4*)(bbase + (off + (unsigned)((ai * HALF + m * 16) * 2048) + bj * HALF));
#pragma unroll
            for (int m = 0; m < 4; ++m) { const unsigned o = off + (unsigned)((ai * HALF + m * 16) * 2048); float sq = 0.f;
#pragma unroll
                for (int bj = 0; bj < 2; ++bj) { const u32x4 x = hv[m][bj];
                    const f32x4 h0 = (f32x4){__uint_as_float(x.x << 16), __uint_as_float(x.x & 0xffff0000u), __uint_as_float(x.y << 16), __uint_as_float(x.y & 0xffff0000u)} + acc[ai][bj][m][0] * alpha;
                    const f32x4 h1 = (f32x4){__uint_as_float(x.z << 16), __uint_as_float(x.z & 0xffff0000u), __uint_as_float(x.w << 16), __uint_as_float(x.w & 0xffff0000u)} + acc[ai][bj][m][1] * alpha;
                    sq += ((h0[0] * h0[0] + h0[1] * h0[1]) + (h0[2] * h0[2] + h0[3] * h0[3])) + ((h1[0] * h1[0] + h1[1] * h1[1]) + (h1[2] * h1[2] + h1[3] * h1[3]));
                    u32x4 w; w.x = cvt_pk_bf16(h0[0], h0[1]); w.y = cvt_pk_bf16(h0[2], h0[3]); w.z = cvt_pk_bf16(h1[0], h1[1]); w.w = cvt_pk_bf16(h1[2], h1[3]); *(u32x4*)(bbase + o + bj * HALF) = w; }
                sq += __shfl_xor(sq, 16); sq += __shfl_xor(sq, 32);
                if (fq == 0) red[(rl0 + ai * HALF + m * 16) * 4 + wc] = sq; }
            asm volatile("" ::: "memory"); }
        asm volatile("s_waitcnt lgkmcnt(0)" ::: "memory"); __builtin_amdgcn_s_barrier(); asm volatile("" ::: "memory");
        if (wr == 0) { const int row = wc * 64 + fq * 16 + fr; const float s4 = (red[row * 4] + red[row * 4 + 1]) + (red[row * 4 + 2] + red[row * 4 + 3]); ssn[(size_t)u.pn * 33024 + u.pm * BM + row] = s4; }
    }
};
struct EpiP {
    static constexpr bool PERM = true, AFTER_DRAIN = false;
    bf16_t* pr; float* ps; bf16_t* qkv; const float* ss;
    __device__ __forceinline__ void operator()(const f32x4 (&acc)[2][2][4][2], const Unit& u, int wr, int wc, int fr, int fq) const {
        const int row0 = u.pm * BM + wr * 64 + fr, cl = wc * 32 + 8 * fq;
#pragma unroll
        for (int ai = 0; ai < 2; ++ai)
#pragma unroll
            for (int m = 0; m < 4; ++m) { const int row = row0 + ai * HALF + m * 16; const float rs = rs_of(ss, row);
#pragma unroll
                for (int bj = 0; bj < 2; ++bj) { const f32x4 v0 = acc[ai][bj][m][0] * rs, v1 = acc[ai][bj][m][1] * rs;
                    if (u.pn >= 12 && u.pn < 14) { float* d = ps + (size_t)row * 512 + (u.pn - 12) * 256 + bj * HALF + cl; *(f32x4*)d = v0; *(f32x4*)(d + 4) = v1; }
                    else { u32x4 w; w.x = cvt_pk_bf16(v0[0], v0[1]); w.y = cvt_pk_bf16(v0[2], v0[3]); w.z = cvt_pk_bf16(v1[0], v1[1]); w.w = cvt_pk_bf16(v1[2], v1[3]);
                        if (u.pn < 12) *(u32x4*)(pr + (size_t)row * 3072 + u.pn * 256 + bj * HALF + cl) = w;
                        else { const int c = (u.pn - 14) * 256 + bj * HALF + cl;
                            const int b = row >> 12, s = row & 4095; *(u32x4*)(qkv + ((size_t)b * 4160 + 64 + s) * 3072 + c) = w; } } } }
    }
};
template <class Epi, class Sched, bool ALIGN_EPI = false, bool SP2 = false>
__device__ __forceinline__ void gemm_phase(PG8_LAS unsigned char* lds, const Gemm g, const Sched& S, const Epi& E) {
    const int tid = ltid(), wid = __builtin_amdgcn_readfirstlane(tid >> 6), lane = tid & 63, wr = wid >> 2, wc = wid & 3, fr = lane & 15, fq = lane >> 4;
    const int K = g.K, nt = K / BK;
    unsigned voffA[2], voffB[2];
#pragma unroll
    for (int i = 0; i < 2; ++i) { int R, C; stage_rc(tid * 16 + i * 8192, R, C); const int Rb = Epi::PERM ? ((R & ~31) + perm32(R & 31)) : R;
        voffA[i] = (unsigned)(R * K + C) * 2u; voffB[i] = (unsigned)(Rb * K + C) * 2u; }
    const size_t kstep = (size_t)(BK * 2);
    const size_t hstep = (size_t)HALF * K * 2;
    const size_t tstep = 2 * hstep;
    const unsigned ldsw = (unsigned)wid * 1024u;
    const int aoff = lds_byte(wr * 64 + fr, fq * 8), boff = lds_byte(wc * 32 + fr, fq * 8);
#define PG8_SA(b, h) (((b) * 2 + (h)) * HTB)
#define PG8_SB(b, h) ((4 + (b) * 2 + (h)) * HTB)
#define PG8_STAGE(bufoff, gbase, voff) do { _Pragma("unroll") for (int _i = 0; _i < 2; ++_i) \
        __builtin_amdgcn_global_load_lds((const unsigned*)((const char*)(gbase) + (voff)[_i]), (PG8_LAS unsigned*)(lds + (bufoff) + ldsw + _i * 8192), 16, 0, 0); } while (0)
#define PG8_LDA(dst, b, h) do { _Pragma("unroll") for (int m = 0; m < 4; ++m) _Pragma("unroll") for (int k = 0; k < 2; ++k) dst[m][k] = *(const PG8_LAS bf16x8*)(lds + PG8_SA(b, h) + aoff + m * 2048 + k * 1024); } while (0)
#define PG8_LDB(dst, b, h) do { _Pragma("unroll") for (int n = 0; n < 2; ++n) _Pragma("unroll") for (int k = 0; k < 2; ++k) dst[n][k] = *(const PG8_LAS bf16x8*)(lds + PG8_SB(b, h) + boff + n * 2048 + k * 1024); } while (0)
#define PG8_MMA(ai, bj, At, Bt) do { __builtin_amdgcn_s_setprio(1); _Pragma("unroll") for (int m = 0; m < 4; ++m) _Pragma("unroll") for (int n = 0; n < 2; ++n) _Pragma("unroll") for (int k = 0; k < 2; ++k) \
        acc[ai][bj][m][n] = __builtin_amdgcn_mfma_f32_16x16x32_bf16(Bt[n][k], At[m][k], acc[ai][bj][m][n], 0, 0, 0); __builtin_amdgcn_s_setprio(0); } while (0)
#define PG8_WAIT_V(n) asm volatile("s_waitcnt vmcnt(" #n ")" ::: "memory")
#define PG8_WAIT_L(n) asm volatile("s_waitcnt lgkmcnt(" #n ")" ::: "memory")
#define PG8_BAR __builtin_amdgcn_s_barrier()
#define PG8_SCHED __builtin_amdgcn_sched_barrier(0)
    Unit cur, nxt; int ui = 0;
    if (!S.next(0, cur)) return;
    f32x4 acc[2][2][4][2];
#pragma unroll
    for (int a = 0; a < 2; ++a)
#pragma unroll
        for (int b = 0; b < 2; ++b)
#pragma unroll
            for (int m = 0; m < 4; ++m)
#pragma unroll
                for (int n = 0; n < 2; ++n) acc[a][b][m][n] = (f32x4){0.f, 0.f, 0.f, 0.f};
    bf16x8 At[4][2], B0[2][2], B1[2][2];
    const char* cA = (const char*)g.A + (size_t)cur.pm * tstep; const char* cB = (const char*)g.Bt + (size_t)cur.pn * tstep;
    S.a_ready(cur);
    if constexpr (SP2) {
        PG8_STAGE(PG8_SB(0, 0), cB, voffB); PG8_STAGE(PG8_SB(0, 1), cB + hstep, voffB); PG8_STAGE(PG8_SA(0, 0), cA, voffA); PG8_STAGE(PG8_SA(0, 1), cA + hstep, voffA);
        if (wr == 1) PG8_BAR;
        PG8_WAIT_V(2); PG8_BAR;
        PG8_STAGE(PG8_SB(1, 0), cB + kstep, voffB); PG8_STAGE(PG8_SA(1, 0), cA + kstep, voffA); PG8_STAGE(PG8_SB(1, 1), cB + hstep + kstep, voffB);
        PG8_WAIT_V(6); PG8_BAR;
    } else {
        PG8_STAGE(PG8_SB(0, 0), cB, voffB); PG8_STAGE(PG8_SA(0, 0), cA, voffA); PG8_STAGE(PG8_SB(0, 1), cB + hstep, voffB); PG8_STAGE(PG8_SA(0, 1), cA + hstep, voffA);
        if (wr == 1) PG8_BAR;
        PG8_WAIT_V(4); PG8_BAR;
        PG8_STAGE(PG8_SB(1, 0), cB + kstep, voffB); PG8_STAGE(PG8_SA(1, 0), cA + kstep, voffA); PG8_STAGE(PG8_SB(1, 1), cB + hstep + kstep, voffB);
        PG8_WAIT_V(6); PG8_BAR;
    }
    for (;;) {
        const bool has_next = S.next(ui + 1, nxt);
        const char* nA = has_next ? (const char*)g.A + (size_t)nxt.pm * tstep : cA; const char* nB = has_next ? (const char*)g.Bt + (size_t)nxt.pn * tstep : cB;
        for (int t = 0; t < nt; t += 2) {
            const bool last = (t == nt - 2);
            const char* a1 = cA + (size_t)(t + 1) * kstep;
            const char* a2 = last ? nA : cA + (size_t)(t + 2) * kstep; const char* b2 = last ? nB : cB + (size_t)(t + 2) * kstep;
            const char* a3 = a2 + kstep; const char* b3 = b2 + kstep;
            if (last && has_next) S.a_ready(nxt);
            if constexpr (SP2) {
            PG8_LDB(B0, 0, 0); PG8_LDB(B1, 0, 1); PG8_SCHED; PG8_LDA(At, 0, 0); PG8_STAGE(PG8_SA(1, 1), a1 + hstep, voffA);
            PG8_WAIT_V(8); PG8_WAIT_L(0); PG8_BAR; PG8_MMA(0, 0, At, B0); PG8_MMA(0, 1, At, B1); PG8_BAR; PG8_SCHED;
            PG8_LDA(At, 0, 1); PG8_STAGE(PG8_SB(0, 0), b2, voffB); PG8_STAGE(PG8_SB(0, 1), b2 + hstep, voffB); PG8_STAGE(PG8_SA(0, 0), a2, voffA);
            PG8_WAIT_V(8); PG8_WAIT_L(0); PG8_BAR; PG8_MMA(1, 0, At, B0); PG8_MMA(1, 1, At, B1); PG8_BAR; PG8_SCHED;
            PG8_LDB(B0, 1, 0); PG8_LDB(B1, 1, 1); PG8_SCHED; PG8_LDA(At, 1, 0); PG8_STAGE(PG8_SA(0, 1), a2 + hstep, voffA);
            PG8_WAIT_V(8); PG8_WAIT_L(0); PG8_BAR; PG8_MMA(0, 0, At, B0); PG8_MMA(0, 1, At, B1); PG8_BAR; PG8_SCHED;
            PG8_LDA(At, 1, 1); PG8_STAGE(PG8_SB(1, 0), b3, voffB); PG8_STAGE(PG8_SB(1, 1), b3 + hstep, voffB); PG8_STAGE(PG8_SA(1, 0), a3, voffA);
            PG8_WAIT_V(8); PG8_WAIT_L(0); PG8_BAR; PG8_MMA(1, 0, At, B0); PG8_MMA(1, 1, At, B1); PG8_BAR; PG8_SCHED;
            } else {
            PG8_LDB(B0, 0, 0); PG8_SCHED; PG8_LDA(At, 0, 0); PG8_STAGE(PG8_SA(1, 1), a1 + hstep, voffA);
            PG8_WAIT_L(8); PG8_BAR; PG8_WAIT_L(0); PG8_MMA(0, 0, At, B0); PG8_BAR; PG8_SCHED;
            PG8_LDB(B1, 0, 1); PG8_STAGE(PG8_SB(0, 0), b2, voffB);
            PG8_BAR; PG8_WAIT_L(0); PG8_MMA(0, 1, At, B1); PG8_BAR;
            PG8_LDA(At, 0, 1); PG8_STAGE(PG8_SA(0, 0), a2, voffA);
            PG8_BAR; PG8_WAIT_L(0); PG8_MMA(1, 0, At, B0); PG8_BAR; PG8_SCHED;
            PG8_STAGE(PG8_SB(0, 1), b2 + hstep, voffB);
            PG8_WAIT_V(6); PG8_BAR; PG8_MMA(1, 1, At, B1); PG8_BAR;
            PG8_LDB(B0, 1, 0); PG8_SCHED; PG8_LDA(At, 1, 0); PG8_STAGE(PG8_SA(0, 1), a2 + hstep, voffA);
            PG8_WAIT_L(8); PG8_BAR; PG8_WAIT_L(0); PG8_MMA(0, 0, At, B0); PG8_BAR; PG8_SCHED;
            PG8_LDB(B1, 1, 1); PG8_STAGE(PG8_SB(1, 0), b3, voffB);
            PG8_BAR; PG8_WAIT_L(0); PG8_MMA(0, 1, At, B1); PG8_BAR;
            PG8_LDA(At, 1, 1); PG8_STAGE(PG8_SA(1, 0), a3, voffA);
            PG8_BAR; PG8_WAIT_L(0); PG8_MMA(1, 0, At, B0); PG8_BAR; PG8_SCHED;
            PG8_STAGE(PG8_SB(1, 1), b3 + hstep, voffB);
            PG8_WAIT_V(6); PG8_BAR; PG8_MMA(1, 1, At, B1); PG8_BAR;
            }
        }
        if constexpr (ALIGN_EPI) { if (wr == 0) PG8_BAR; }
        if constexpr (!Epi::AFTER_DRAIN) { E(acc, cur, wr, wc, fr, fq); S.done(cur); }
        if (!has_next) break;
#pragma unroll
        for (int a = 0; a < 2; ++a)
#pragma unroll
            for (int b = 0; b < 2; ++b)
#pragma unroll
                for (int m = 0; m < 4; ++m)
#pragma unroll
                    for (int n = 0; n < 2; ++n) acc[a][b][m][n] = (f32x4){0.f, 0.f, 0.f, 0.f};
        cur = nxt; cA = nA; cB = nB; ++ui;
        if constexpr (ALIGN_EPI) { if (wr == 1) PG8_BAR; }
    }
    PG8_WAIT_V(0);
    if constexpr (!ALIGN_EPI) { if (wr == 0) PG8_BAR; }
    PG8_BAR;
    if constexpr (Epi::AFTER_DRAIN) { E.fused(acc, cur, wr, wc, fr, fq, lds, wid, lane); S.done(cur); }
#undef PG8_SA
#undef PG8_SB
#undef PG8_STAGE
#undef PG8_LDA
#undef PG8_LDB
#undef PG8_MMA
#undef PG8_WAIT_V
#undef PG8_WAIT_L
#undef PG8_BAR
#undef PG8_SCHED
}
}


#define XB_TMO      128
#define XB_XCNT(j)  (256  + 64 * (j))
#define XB_XSUB(j)  (1280 + 64 * (j))
#define XB_XGEN(j)  (2304 + 64 * (j))
#define XB_TOP      3328
#define XB_TOPGEN   3392
#define XCD_BAR_WORDS 3456
#define XB_SPIN_CAP (1u << 22)

__device__ __forceinline__ unsigned xb_ld(unsigned* p)              { return __hip_atomic_load(p, __ATOMIC_RELAXED, __HIP_MEMORY_SCOPE_AGENT); }
__device__ __forceinline__ unsigned xb_add(unsigned* p, unsigned v) { return __hip_atomic_fetch_add(p, v, __ATOMIC_RELAXED, __HIP_MEMORY_SCOPE_AGENT); }
__device__ __forceinline__ unsigned xb_xcc_id() { return (unsigned)__builtin_amdgcn_s_getreg((3 << 11) | 20) & 0xFu; }
#define XB_SPIN(cond, bar) do { unsigned _sp = 0; while (cond) { __builtin_amdgcn_s_sleep(1); \
    if ((++_sp & 255u) == 0u) { if (xb_ld(&(bar)[XB_TMO])) break; if (_sp > XB_SPIN_CAP) { atomicAdd(&(bar)[XB_TMO], 1u); break; } } } } while (0)

struct XcdBarrier {
    unsigned* bar; unsigned x;
    volatile LAS unsigned* st;
};

__device__ __forceinline__ XcdBarrier xcd_barrier_post(unsigned* bar, volatile LAS unsigned* st) {
    XcdBarrier b; b.bar = bar; b.x = xb_xcc_id(); b.st = st;
    if (threadIdx.x == 0) (void)xb_add(&bar[XB_XCNT(b.x)], 1u);
    return b;
}
__device__ __forceinline__ void xcd_barrier_complete(unsigned* bar, unsigned x, unsigned& nloc, unsigned& nx) {
    const unsigned G = gridDim.x * gridDim.y * gridDim.z;
    unsigned sum, cnt, mine, sp = 0u;
    for (;;) {
        sum = 0u; cnt = 0u; mine = 0u;
#pragma unroll
        for (unsigned j = 0; j < 16; ++j) { const unsigned c = xb_ld(&bar[XB_XCNT(j)]); sum += c; cnt += (c > 0u) ? 1u : 0u; mine = (j == x) ? c : mine; }
        if (sum == G) break;
        __builtin_amdgcn_s_sleep(1);
        if ((++sp & 255u) == 0u) { if (xb_ld(&bar[XB_TMO])) break; if (sp > XB_SPIN_CAP) { atomicAdd(&bar[XB_TMO], 1u); break; } }
    }
    nloc = mine > 0u ? mine : 1u; nx = cnt > 0u ? cnt : 1u;
}

__device__ __forceinline__ void xcd_barrier(const XcdBarrier& b) {
    asm volatile("s_waitcnt vmcnt(0)" ::: "memory");
    __syncthreads();
    if (threadIdx.x == 0) {
        unsigned* bar = b.bar;
        __builtin_amdgcn_s_waitcnt(0);
        unsigned nloc = b.st[0], nx = b.st[1];
        if (nloc == 0u) { xcd_barrier_complete(bar, b.x, nloc, nx); b.st[0] = nloc; b.st[1] = nx; }
        const unsigned old = xb_add(&bar[XB_XSUB(b.x)], 1u);
        const unsigned gen = old / nloc;
        if (old + 1u == (gen + 1u) * nloc) {
            __builtin_amdgcn_fence(__ATOMIC_RELEASE, "agent");
            asm volatile("s_waitcnt vmcnt(0)" ::: "memory");
            const unsigned og = xb_add(&bar[XB_TOP], 1u);
            const unsigned tg = og / nx;
            if (og + 1u == (tg + 1u) * nx) xb_add(&bar[XB_TOPGEN], 1u);
            else XB_SPIN(xb_ld(&bar[XB_TOPGEN]) == tg, bar);
            __builtin_amdgcn_fence(__ATOMIC_ACQUIRE, "agent");
            xb_add(&bar[XB_XGEN(b.x)], 1u);
            asm volatile("s_waitcnt vmcnt(0)" ::: "memory");
        } else {
            XB_SPIN(xb_ld(&bar[XB_XGEN(b.x)]) == gen, bar);
            __builtin_amdgcn_fence(__ATOMIC_ACQUIRE, "agent");
            asm volatile("s_waitcnt vmcnt(0)" ::: "memory");
        }
    }
    __syncthreads();
}


typedef unsigned short bf16_t;
typedef float f32x4 __attribute__((ext_vector_type(4)));
typedef unsigned u32x4 __attribute__((ext_vector_type(4)));
typedef unsigned u32x2 __attribute__((ext_vector_type(2)));
struct Params { const float* in[25]; float* out; unsigned char* ws; int ph_lo, ph_hi; };
#define CAS __attribute__((address_space(4)))
typedef const CAS Params* PP;
__device__ __forceinline__ PP launder(PP p) { asm volatile("" : "+s"(p)); return p; }
enum { I_X = 0, I_META, I_F1N, I_F1GU, I_F1D, I_MIXN, I_WIN, I_MU, I_W0, I_WUP, I_A0, I_AUP, I_GUP, I_KK, I_KA, I_RK, I_LNW, I_LNB, I_BF, I_FON, I_WOUT, I_F2N, I_F2GU, I_F2D, I_FINN };

typedef float f32x2_t __attribute__((ext_vector_type(2))); typedef __bf16 bf16x2v_t __attribute__((ext_vector_type(2)));
__device__ __forceinline__ unsigned pk_bf16(float lo, float hi) { f32x2_t v = {lo, hi}; bf16x2v_t b = __builtin_convertvector(v, bf16x2v_t); return __builtin_bit_cast(unsigned, b); }
__device__ __forceinline__ float bf2f(bf16_t b) { return __uint_as_float(((unsigned)b) << 16); }
__device__ __forceinline__ float wave_sum(float v) {
#pragma unroll
    for (int o = 32; o >= 1; o >>= 1) v += __shfl_xor(v, o);
    return v; }
__device__ __forceinline__ float wave_max(float v) {
#pragma unroll
    for (int o = 32; o >= 1; o >>= 1) v = fmaxf(v, __shfl_xor(v, o));
    return v; }
__device__ __forceinline__ float sigmoid_f(float x) { return __builtin_amdgcn_rcpf(1.0f + __expf(-x)); }

__device__ __forceinline__ void convert_tile(const float* __restrict__ src, bf16_t* __restrict__ dst, const float* __restrict__ gain, int K, int Nsrc, int kind, int tk, int tn, LAS float* T) {
    const int tid = ltid();
    {
        const int nl = (tid & 15) * 4, np = tn * 64 + nl; int sc;
        if (kind == 1) { const int pn = np >> 8, bj = (np >> 7) & 1, i = np & 127; sc = bj * cfg::DFF + pn * 128 + i; }
        else if (kind == 2) { sc = np < 3360 ? np : (np < 3368 ? 6432 + (np - 3360) : (np < 3584 ? -1 : 3360 + (np - 3584))); }
        else sc = np;
#pragma unroll
        for (int i = 0; i < 2; ++i) { const int kl = (tid >> 4) + 32 * i, k = tk * 64 + kl;
            f32x4 v = (f32x4){0.f, 0.f, 0.f, 0.f};
            if (sc >= 0) v = *(const f32x4*)(src + (size_t)k * Nsrc + sc);
            float g = 1.f; if (kind == 1 || kind == 2) g = gain[k]; else if (kind == 3) g = (k >= 1024) ? gain[k - 1024] : 1.f;
            T[kl * 65 + nl] = v[0] * g; T[kl * 65 + nl + 1] = v[1] * g; T[kl * 65 + nl + 2] = v[2] * g; T[kl * 65 + nl + 3] = v[3] * g; }
    }
    __syncthreads();
    {
        const int nl = tid >> 3, k8 = (tid & 7) * 8; u32x4 w;
        w.x = pk_bf16(T[(k8 + 0) * 65 + nl], T[(k8 + 1) * 65 + nl]); w.y = pk_bf16(T[(k8 + 2) * 65 + nl], T[(k8 + 3) * 65 + nl]);
        w.z = pk_bf16(T[(k8 + 4) * 65 + nl], T[(k8 + 5) * 65 + nl]); w.w = pk_bf16(T[(k8 + 6) * 65 + nl], T[(k8 + 7) * 65 + nl]);
        *(u32x4*)(dst + (size_t)(tn * 64 + nl) * K + tk * 64 + k8) = w;
    }
    __syncthreads();
}
__device__ __forceinline__ void phase_convert(PP P, LAS unsigned char* lds, int l0, int l1, int first, int nwg) {
    using namespace cfg;
    LAS float* T = (LAS float*)lds;
    constexpr int T_GU = (DM / 64) * (NGU / 64), T_D = (DFF / 64) * (DM / 64), T_IN = (DM / 64) * (NIN / 64), T_OUT = (DM / 64) * (DM / 64);
    constexpr int T_LAYER = 2 * T_GU + 2 * T_D + T_IN + T_OUT;
    for (int t = l0 * T_LAYER + first; t < l1 * T_LAYER; t += nwg) {
        const int l = t / T_LAYER; int r = t - l * T_LAYER;
        bf16_t* wl = (bf16_t*)(P->ws + WS_W + (size_t)l * W_LAYER);
        const float* src; bf16_t* dst; const float* gain = nullptr; int K, Nsrc, kind, ntn;
        if (r < T_GU) { src = P->in[I_F1GU] + (size_t)l * DM * NGU; dst = (bf16_t*)((unsigned char*)wl + WO_GU1); gain = P->in[I_F1N] + l * DM; K = DM; Nsrc = NGU; kind = 1; ntn = NGU / 64; }
        else if ((r -= T_GU) < T_D) { src = P->in[I_F1D] + (size_t)l * DFF * DM; dst = (bf16_t*)((unsigned char*)wl + WO_D1); K = DFF; Nsrc = DM; kind = 0; ntn = DM / 64; }
        else if ((r -= T_D) < T_IN) { src = P->in[I_WIN] + (size_t)l * DM * DIN; dst = (bf16_t*)((unsigned char*)wl + WO_IN); gain = P->in[I_MIXN] + l * DM; K = DM; Nsrc = DIN; kind = 2; ntn = NIN / 64; }
        else if ((r -= T_IN) < T_OUT) { src = P->in[I_WOUT] + (size_t)l * DM * DM; dst = (bf16_t*)((unsigned char*)wl + WO_OUT); gain = P->in[I_FON] + l * FW; K = DM; Nsrc = DM; kind = 3; ntn = DM / 64; }
        else if ((r -= T_OUT) < T_GU) { src = P->in[I_F2GU] + (size_t)l * DM * NGU; dst = (bf16_t*)((unsigned char*)wl + WO_GU2); gain = P->in[I_F2N] + l * DM; K = DM; Nsrc = NGU; kind = 1; ntn = NGU / 64; }
        else { r -= T_GU; src = P->in[I_F2D] + (size_t)l * DFF * DM; dst = (bf16_t*)((unsigned char*)wl + WO_D2); K = DFF; Nsrc = DM; kind = 0; ntn = DM / 64; }
        convert_tile(src, dst, gain, K, Nsrc, kind, r / ntn, r % ntn, T);
    }
}
__device__ __forceinline__ void phase_init(PP P) {
    using namespace cfg;
    const int lane = ltid() & 63, gw = lbid() * 8 + (ltid() >> 6), nw = gridDim.x * 8;
    bf16_t* hb = (bf16_t*)(P->ws + WS_HB); float* ss0 = (float*)(P->ws + WS_SS);
    for (int row = gw; row < MROWS; row += nw) {
        const float* s = row < MMAIN ? P->in[I_X] + (size_t)row * DM : P->in[I_META] + (size_t)(row - MMAIN) * DM;
        float sq = 0.f;
#pragma unroll
        for (int i = 0; i < 4; ++i) { f32x4 v0 = (f32x4){0.f, 0.f, 0.f, 0.f}, v1 = v0; if (row < MMAIN + NMETA) { v0 = *(const f32x4*)(s + i * 512 + lane * 8); v1 = *(const f32x4*)(s + i * 512 + lane * 8 + 4); }
            sq += ((v0[0] * v0[0] + v0[1] * v0[1]) + (v0[2] * v0[2] + v0[3] * v0[3])) + ((v1[0] * v1[0] + v1[1] * v1[1]) + (v1[2] * v1[2] + v1[3] * v1[3]));
            u32x4 w; w.x = pk_bf16(v0[0], v0[1]); w.y = pk_bf16(v0[2], v0[3]); w.z = pk_bf16(v1[0], v1[1]); w.w = pk_bf16(v1[2], v1[3]); *(u32x4*)(hb + (size_t)row * DM + i * 512 + lane * 8) = w; }
        sq = wave_sum(sq);
        if (lane < 8) ss0[(size_t)lane * MROWS + row] = lane == 0 ? sq : 0.f;
        if (row >= MMAIN && row < MMAIN + NMETA) { float* ssm0 = (float*)(P->ws + WS_SSM); ssm0[lane * 16 + (row - MMAIN)] = lane == 0 ? sq : 0.f; ssm0[(64 + lane) * 16 + (row - MMAIN)] = 0.f; }
    }
}
__device__ __forceinline__ void phase_foxnorm(PP P) {
    using namespace cfg;
    const int lane = ltid() & 63, gw = lbid() * 8 + (ltid() >> 6), nw = gridDim.x * 8;
    bf16_t* y = (bf16_t*)(P->ws + WS_Y);
    for (int row = gw; row < MMAIN + NMETA; row += nw) {
        bf16_t* p = y + (size_t)row * DM + 1024 + lane * 16;
        u32x4 a = *(const u32x4*)p, b = *(const u32x4*)(p + 8); float v[16];
#pragma unroll
        for (int i = 0; i < 4; ++i) { v[2 * i] = __uint_as_float(a[i] << 16); v[2 * i + 1] = __uint_as_float(a[i] & 0xffff0000u); v[8 + 2 * i] = __uint_as_float(b[i] << 16); v[8 + 2 * i + 1] = __uint_as_float(b[i] & 0xffff0000u); }
        float sq = 0.f;
#pragma unroll
        for (int i = 0; i < 16; ++i) sq += v[i] * v[i];
        sq = wave_sum(sq); const float rs = __builtin_amdgcn_rsqf(sq * (1.0f / 1024.0f) + NORM_EPS);
#pragma unroll
        for (int i = 0; i < 4; ++i) { a[i] = pk_bf16(v[2 * i] * rs, v[2 * i + 1] * rs); b[i] = pk_bf16(v[8 + 2 * i] * rs, v[8 + 2 * i + 1] * rs); }
        *(u32x4*)p = a; *(u32x4*)(p + 8) = b;
    }
}
__device__ __forceinline__ void phase_final(PP P) {
    using namespace cfg;
    const int lane = ltid() & 63, gw = lbid() * 8 + (ltid() >> 6), nw = gridDim.x * 8;
    const float* g = P->in[I_FINN]; const bf16_t* hb = (const bf16_t*)(P->ws + WS_HB);
    for (int row = gw; row < MMAIN; row += nw) {
        float* d = P->out + (size_t)row * DM; f32x4 v[8]; float sq = 0.f;
#pragma unroll
        for (int i = 0; i < 4; ++i) { const u32x4 x = *(const u32x4*)(hb + (size_t)row * DM + i * 512 + lane * 8);
            v[2 * i] = (f32x4){__uint_as_float(x.x << 16), __uint_as_float(x.x & 0xffff0000u), __uint_as_float(x.y << 16), __uint_as_float(x.y & 0xffff0000u)};
            v[2 * i + 1] = (f32x4){__uint_as_float(x.z << 16), __uint_as_float(x.z & 0xffff0000u), __uint_as_float(x.w << 16), __uint_as_float(x.w & 0xffff0000u)}; }
#pragma unroll
        for (int i = 0; i < 8; ++i) sq += (v[i][0] * v[i][0] + v[i][1] * v[i][1]) + (v[i][2] * v[i][2] + v[i][3] * v[i][3]);
        sq = wave_sum(sq); const float rs = __builtin_amdgcn_rsqf(sq * (1.0f / 2048.0f) + NORM_EPS);
#pragma unroll
        for (int i = 0; i < 4; ++i) { const f32x4 g0 = *(const f32x4*)(g + i * 512 + lane * 8), g1 = *(const f32x4*)(g + i * 512 + lane * 8 + 4);
            *(f32x4*)(d + i * 512 + lane * 8) = v[2 * i] * rs * g0; *(f32x4*)(d + i * 512 + lane * 8 + 4) = v[2 * i + 1] * rs * g1; }
    }
}

__device__ __forceinline__ void phase_lx(PP P, int l) {
    using namespace cfg;
    const int lane = ltid() & 63, gw = lbid() * 8 + (ltid() >> 6), nw = gridDim.x * 8;
    const float* PS = (const float*)(P->ws + WS_PS); bf16_t* LXG = (bf16_t*)(P->ws + WS_LXG) + (size_t)l * MROWS * 320; const float* mu = P->in[I_MU] + l * RWKV_COLS + 3072;
    if (lane < 36) {
        const f32x4 m0 = *(const f32x4*)(mu + lane * 8), m1 = *(const f32x4*)(mu + lane * 8 + 4);
        for (int row = gw; row < MMAIN + NMETA; row += nw) {
            int prev; if (row >= MMAIN) prev = (row == MMAIN) ? -1 : row - 1; else prev = ((row & (SEQ - 1)) == 0) ? MMAIN + NMETA - 1 : row - 1;
            const f32x4 c0 = *(const f32x4*)(PS + (size_t)row * PSW + lane * 8), c1 = *(const f32x4*)(PS + (size_t)row * PSW + lane * 8 + 4);
            f32x4 p0 = (f32x4){0.f, 0.f, 0.f, 0.f}, p1 = p0; if (prev >= 0) { p0 = *(const f32x4*)(PS + (size_t)prev * PSW + lane * 8); p1 = *(const f32x4*)(PS + (size_t)prev * PSW + lane * 8 + 4); }
            float x[8];
#pragma unroll
            for (int j = 0; j < 4; ++j) { x[j] = c0[j] + (p0[j] - c0[j]) * m0[j]; x[4 + j] = c1[j] + (p1[j] - c1[j]) * m1[j]; }
#pragma unroll
            for (int j = 0; j < 8; ++j) x[j] = lane < 8 ? 1.0f - 2.0f * __builtin_amdgcn_rcpf(__expf(2.0f * x[j]) + 1.0f) : (lane < 16 ? x[j] : __builtin_amdgcn_rcpf(1.0f + __expf(-x[j])));
            u32x4 w; w.x = pk_bf16(x[0], x[1]); w.y = pk_bf16(x[2], x[3]); w.z = pk_bf16(x[4], x[5]); w.w = pk_bf16(x[6], x[7]);
            *(u32x4*)(LXG + (size_t)row * 320 + lane * 8) = w;
        }
    }
}

__device__ __forceinline__ void rwkv_simple(PP P, int l, int b, int h, LAS unsigned char* lds) {
    using namespace cfg;
    const int tid = ltid(), lane = tid & 63, wave = tid >> 6;
    LAS bf16_t* WUP = (LAS bf16_t*)lds; LAS bf16_t* AUP = WUP + 4096; LAS bf16_t* GUP = AUP + 4096;
    LAS float* RAW = (LAS float*)(lds + 36864); LAS float* LX = RAW + 17 * 480; LAS float* Rm = LX + 16 * 288;
    LAS float* Wm = Rm + 1024; LAS float* KPm = Wm + 1024; LAS float* Vm = KPm + 1024; LAS float* Am = Vm + 1024; LAS float* Bm = Am + 1024; LAS float* Gm = Bm + 1024;
    LAS float* BON = Gm + 1024; LAS float* YR = BON + 16;
    const bf16_t* PR = (const bf16_t*)(P->ws + WS_PR); const float* PS = (const float*)(P->ws + WS_PS); bf16_t* Y = (bf16_t*)(P->ws + WS_Y);
    const float* mu = P->in[I_MU] + l * RWKV_COLS;
    for (int e = tid; e < 64 * 64; e += 512) { const int i = e >> 6, j = e & 63;
        WUP[e] = (bf16_t)(pk_bf16(P->in[I_WUP][((size_t)l * 64 + i) * RW + h * 64 + j], 0.f) & 0xffffu);
        AUP[e] = (bf16_t)(pk_bf16(P->in[I_AUP][((size_t)l * 64 + i) * RW + h * 64 + j], 0.f) & 0xffffu); }
    for (int e = tid; e < 160 * 64; e += 512) { const int i = e >> 6, j = e & 63; GUP[e] = (bf16_t)(pk_bf16(P->in[I_GUP][((size_t)l * 160 + i) * RW + h * 64 + j], 0.f) & 0xffffu); }
    for (int e = tid; e < 480; e += 512) RAW[e] = 0.f;
    const int hj = h * 64 + lane;
    const float w0 = P->in[I_W0][l * RW + hj], a0 = P->in[I_A0][l * RW + hj], kkw = P->in[I_KK][l * RW + hj], kaw = P->in[I_KA][l * RW + hj], rkw = P->in[I_RK][l * RW + hj];
    const float lnw = P->in[I_LNW][l * RW + hj], lnb = P->in[I_LNB][l * RW + hj];
    const float mur = mu[hj], muk = mu[1024 + hj], muv = mu[2048 + hj];
    float S[16];
#pragma unroll
    for (int j = 0; j < 16; ++j) S[j] = 0.f;
    __syncthreads();
    for (int c = 0; c < 257; ++c) {
        const int row0 = (c == 0) ? MMAIN : b * SEQ + (c - 1) * 16;
        for (int e = tid; e < 16 * 480; e += 512) { const int t = e / 480, cc = e - t * 480; const int row = row0 + t; float v;
            if (cc < 192) v = bf2f(PR[(size_t)row * PRW + (cc >> 6) * 1024 + h * 64 + (cc & 63)]); else v = PS[(size_t)row * PSW + (cc - 192)];
            RAW[(t + 1) * 480 + cc] = v; }
        __syncthreads();
        for (int e = tid; e < 16 * 288; e += 512) { const int t = e / 288, i = e - t * 288; const float cur = RAW[(t + 1) * 480 + 192 + i], prv = RAW[t * 480 + 192 + i];
            const float x = cur + (prv - cur) * mu[3072 + i];
            LX[e] = i < 64 ? tanhf(x) : (i < 128 ? x : sigmoid_f(x)); }
        __syncthreads();
#pragma unroll 1
        for (int rep = 0; rep < 2; ++rep) { const int t = wave + 8 * rep;
            float aw = w0, aa = a0, ag = 0.f;
            for (int i = 0; i < 64; ++i) { aw += LX[t * 288 + i] * bf2f(WUP[i * 64 + lane]); aa += LX[t * 288 + 64 + i] * bf2f(AUP[i * 64 + lane]); }
            for (int i = 0; i < 160; ++i) ag += LX[t * 288 + 128 + i] * bf2f(GUP[i * 64 + lane]);
            const float sp = (aw < 0.f ? -aw : 0.f) + log1pf(__expf(-fabsf(aw)));
            const float dec = __expf(-__expf(-sp - 0.5f));
            const float alr = sigmoid_f(aa);
            const float rc = RAW[(t + 1) * 480 + lane], rp = RAW[t * 480 + lane]; const float r = rc + (rp - rc) * mur;
            const float kc = RAW[(t + 1) * 480 + 64 + lane], kp = RAW[t * 480 + 64 + lane]; const float k = kc + (kp - kc) * muk;
            const float vc = RAW[(t + 1) * 480 + 128 + lane], vp = RAW[t * 480 + 128 + lane]; const float v = vc + (vp - vc) * muv;
            const float kkr = k * kkw; const float nrm = sqrtf(wave_sum(kkr * kkr)); const float kk = kkr / fmaxf(nrm, 1e-12f);
            const float kmod = k * (1.0f + (alr - 1.0f) * kaw);
            const float bon = wave_sum(r * kmod * rkw);
            Rm[t * 64 + lane] = r; Wm[t * 64 + lane] = dec; KPm[t * 64 + lane] = kmod; Vm[t * 64 + lane] = v; Am[t * 64 + lane] = -kk; Bm[t * 64 + lane] = kk * alr; Gm[t * 64 + lane] = ag;
            if (lane == 0) BON[t] = bon; }
        __syncthreads();
        for (int e = tid; e < 480; e += 512) RAW[e] = RAW[16 * 480 + e];
        if (wave < 4) { const int vrow = 16 * wave + (lane & 15), q = lane >> 4;
#pragma unroll 1
            for (int t = 0; t < 16; ++t) { float a[16], w[16], bb[16], kk[16], rr[16];
#pragma unroll
                for (int g = 0; g < 4; ++g) { const f32x4 av = *(const LAS f32x4*)(Am + t * 64 + 16 * q + 4 * g), wv = *(const LAS f32x4*)(Wm + t * 64 + 16 * q + 4 * g), bv = *(const LAS f32x4*)(Bm + t * 64 + 16 * q + 4 * g),
                        kv = *(const LAS f32x4*)(KPm + t * 64 + 16 * q + 4 * g), rv = *(const LAS f32x4*)(Rm + t * 64 + 16 * q + 4 * g);
#pragma unroll
                    for (int i = 0; i < 4; ++i) { a[4 * g + i] = av[i]; w[4 * g + i] = wv[i]; bb[4 * g + i] = bv[i]; kk[4 * g + i] = kv[i]; rr[4 * g + i] = rv[i]; } }
                float sa = 0.f;
#pragma unroll
                for (int j = 0; j < 16; ++j) sa += S[j] * a[j];
                sa += __shfl_xor(sa, 16); sa += __shfl_xor(sa, 32);
                const float vv = Vm[t * 64 + vrow]; float y = 0.f;
#pragma unroll
                for (int j = 0; j < 16; ++j) { S[j] = S[j] * w[j] + (sa * bb[j] + vv * kk[j]); y += S[j] * rr[j]; }
                y += __shfl_xor(y, 16); y += __shfl_xor(y, 32);
                if (q == 0) YR[t * 64 + vrow] = y; } }
        __syncthreads();
        if (c > 0 || b == 0) {
#pragma unroll 1
            for (int rep = 0; rep < 2; ++rep) { const int t = wave + 8 * rep; const float yv = YR[t * 64 + lane];
                const float mean = wave_sum(yv) * (1.0f / 64.0f); const float d = yv - mean; const float var = wave_sum(d * d) * (1.0f / 64.0f);
                const float yn = d * __builtin_amdgcn_rsqf(var + LNX_EPS) * lnw + lnb;
                const float o = (yn + BON[t] * Vm[t * 64 + lane]) * Gm[t * 64 + lane];
                Y[(size_t)(row0 + t) * DM + hj] = (bf16_t)(pk_bf16(o, 0.f) & 0xffffu); } }
        __syncthreads();
    }
}

typedef short bf16x8_t __attribute__((ext_vector_type(8)));
typedef short bf16x4_t __attribute__((ext_vector_type(4)));
namespace rk {
constexpr int RAWF = 0, RAWF_SZ = 18432, RAWH = 55296, RAWH_SZ = 6144, LXB = 73728, RS = 82944, KS = 87040, VS = 91136, KKN = 95232, ATP = 99328, RTP = 101376, BTP = 103424, KTP = 105472,
              BHT = 107520, KHT = 109568, VT = 111616, GT = 113664, AAK = 113920, RB = 114432, RKM = 114944, TINV = 115456, GG = 115968  , VF = 124160  , YR = 132352, BONP = 136448  , LDS_END = 136960;
}
template <int CTRL> __device__ __forceinline__ float dpp_f(float v) { return __builtin_bit_cast(float, __builtin_amdgcn_update_dpp(0, __builtin_bit_cast(int, v), CTRL, 0xf, 0xf, true)); }
__device__ __forceinline__ float row_sum16(float v) { v += dpp_f<0xB1>(v); v += dpp_f<0x4E>(v); v += dpp_f<0x141>(v); v += dpp_f<0x140>(v); return v; }
__device__ __forceinline__ float rdlane(float v, int l) { return __builtin_bit_cast(float, __builtin_amdgcn_readlane(__builtin_bit_cast(int, v), l)); }
__device__ __forceinline__ float wave_sum_dpp(float v) { v = row_sum16(v); return (rdlane(v, 0) + rdlane(v, 16)) + (rdlane(v, 32) + rdlane(v, 48)); }
#define RK_BAR() do { asm volatile("s_waitcnt lgkmcnt(0)" ::: "memory"); __builtin_amdgcn_s_barrier(); asm volatile("" ::: "memory"); } while (0)
__device__ __forceinline__ bf16_t bf1(float x) { return (bf16_t)(pk_bf16(x, 0.f) & 0xffffu); }
__device__ __forceinline__ bf16x4_t pack4(float a, float b, float c, float d) { u32x2 w; w.x = pk_bf16(a, b); w.y = pk_bf16(c, d); return __builtin_bit_cast(bf16x4_t, w); }
__device__ __forceinline__ float fast_sigmoid(float x) { return __builtin_amdgcn_rcpf(1.0f + __expf(-x)); }
__device__ __forceinline__ float fast_tanh(float x) { return 1.0f - 2.0f * __builtin_amdgcn_rcpf(__expf(2.0f * x) + 1.0f); }

__device__ __forceinline__ void rwkv_chunked(PP P, int l, int b, int h, LAS unsigned char* lds) {
    using namespace cfg;
    const int tid = ltid(), lane = tid & 63, wave = __builtin_amdgcn_readfirstlane(tid >> 6), n = lane & 15, g = lane >> 4;
    const bf16_t* PR = (const bf16_t*)(P->ws + WS_PR); const float* PS = (const float*)(P->ws + WS_PS); bf16_t* Y = (bf16_t*)(P->ws + WS_Y);
    const float* mu = P->in[I_MU] + l * RWKV_COLS;
    LAS float* RSm = (LAS float*)(lds + rk::RS); LAS float* KSm = (LAS float*)(lds + rk::KS); LAS float* VSm = (LAS float*)(lds + rk::VS); LAS float* KKNm = (LAS float*)(lds + rk::KKN);
    LAS bf16_t* LXB = (LAS bf16_t*)(lds + rk::LXB);
    LAS bf16_t* ATp = (LAS bf16_t*)(lds + rk::ATP); LAS bf16_t* RTp = (LAS bf16_t*)(lds + rk::RTP); LAS bf16_t* BTp = (LAS bf16_t*)(lds + rk::BTP); LAS bf16_t* KTp = (LAS bf16_t*)(lds + rk::KTP);
    LAS bf16_t* BHt = (LAS bf16_t*)(lds + rk::BHT); LAS bf16_t* KHt = (LAS bf16_t*)(lds + rk::KHT); LAS bf16_t* Vt = (LAS bf16_t*)(lds + rk::VT);
    LAS float* GTm = (LAS float*)(lds + rk::GT);
    LAS bf16_t* AAKm = (LAS bf16_t*)(lds + rk::AAK); LAS bf16_t* RBm = (LAS bf16_t*)(lds + rk::RB); LAS bf16_t* RKm = (LAS bf16_t*)(lds + rk::RKM); LAS bf16_t* TINVm = (LAS bf16_t*)(lds + rk::TINV);
    LAS float* YRm = (LAS float*)(lds + rk::YR);
    const int hj = h * 64 + lane;
    const float mur = mu[hj], muk = mu[1024 + hj], muv = mu[2048 + hj], kkw = P->in[I_KK][l * RW + hj], lnw = P->in[I_LNW][l * RW + hj], lnb = P->in[I_LNB][l * RW + hj];
    float mul[5];
#pragma unroll
    for (int q = 0; q < 5; ++q) mul[q] = (lane + 64 * q < 288) ? mu[3072 + lane + 64 * q] : 0.f;
    const int kw = wave & 3, key = 16 * kw + n, hk = h * 64 + key;
    const float w0k = P->in[I_W0][l * RW + hk], a0k = P->in[I_A0][l * RW + hk], kak = P->in[I_KA][l * RW + hk], rkk = P->in[I_RK][l * RW + hk];
    const int pp = 32 * (key >> 5) + 8 * ((key >> 2) & 3) + 4 * ((key >> 4) & 1) + (key & 3);
    bf16x8_t fA[2], fB[5];
    {
        const float* wu = P->in[I_WUP] + (size_t)l * 64 * RW + hk; const float* au = P->in[I_AUP] + (size_t)l * 64 * RW + hk; const float* gu = P->in[I_GUP] + (size_t)l * 160 * RW + hk;
#pragma unroll
        for (int s = 0; s < 5; ++s) { float v[8], u[8];
#pragma unroll
            for (int j = 0; j < 8; ++j) { const int k = 32 * s + 8 * g + j; v[j] = (wave < 4) ? (s < 2 ? au[(size_t)k * RW] : 0.f) : gu[(size_t)k * RW]; u[j] = (wave < 4 && s < 2) ? wu[(size_t)k * RW] : 0.f; }
            u32x4 w; w.x = pk_bf16(v[0], v[1]); w.y = pk_bf16(v[2], v[3]); w.z = pk_bf16(v[4], v[5]); w.w = pk_bf16(v[6], v[7]); fB[s] = __builtin_bit_cast(bf16x8_t, w);
            if (s < 2) { u32x4 x; x.x = pk_bf16(u[0], u[1]); x.y = pk_bf16(u[2], u[3]); x.z = pk_bf16(u[4], u[5]); x.w = pk_bf16(u[6], u[7]); fA[s] = __builtin_bit_cast(bf16x8_t, x); } }
    }
    f32x4 ST[4];
#pragma unroll
    for (int kb = 0; kb < 4; ++kb) ST[kb] = (f32x4){0.f, 0.f, 0.f, 0.f};
#define RK_DMA(c_) do { const int cc_ = (c_); const int row0_ = (cc_ == 0) ? MMAIN : b * SEQ + (cc_ - 1) * 16; const int bi_ = cc_ % 3; \
        _Pragma("unroll") for (int i_ = 0; i_ < 3; ++i_) { const int wp_ = wave + 8 * i_; if (wp_ < 18) { const int x_ = wp_ * 64 + lane; \
            __builtin_amdgcn_global_load_lds((const unsigned*)(PS + (size_t)(row0_ + x_ / 72) * PSW + (x_ % 72) * 4), (LAS unsigned*)(lds + rk::RAWF + bi_ * rk::RAWF_SZ + wp_ * 1024), 16, 0, 0); } } \
        if (wave < 6) { const int y_ = wave * 64 + lane; \
            __builtin_amdgcn_global_load_lds((const unsigned*)(PR + (size_t)(row0_ + y_ / 24) * PRW + ((y_ % 24) >> 3) * 1024 + h * 64 + (y_ & 7) * 8), (LAS unsigned*)(lds + rk::RAWH + bi_ * rk::RAWH_SZ + wave * 1024), 16, 0, 0); } } while (0)
#define RK_STAGE_A(ca_, t_) do { const int t = (t_); const int bc_ = (ca_) % 3, bp_ = ((ca_) + 2) % 3; \
        LAS const float* cF_ = (LAS const float*)(lds + rk::RAWF + bc_ * rk::RAWF_SZ); LAS const float* pF_ = (LAS const float*)(lds + rk::RAWF + bp_ * rk::RAWF_SZ); \
        LAS const bf16_t* cH_ = (LAS const bf16_t*)(lds + rk::RAWH + bc_ * rk::RAWH_SZ); LAS const bf16_t* pH_ = (LAS const bf16_t*)(lds + rk::RAWH + bp_ * rk::RAWH_SZ); \
        LAS const float* ctF = cF_ + t * 288; LAS const float* ptF = (t == 0) ? pF_ + 15 * 288 : cF_ + (t - 1) * 288; \
        LAS const bf16_t* ctH = cH_ + t * 192; LAS const bf16_t* ptH = (t == 0) ? pH_ + 15 * 192 : cH_ + (t - 1) * 192; \
        const float rc = bf2f(ctH[lane]), kc = bf2f(ctH[64 + lane]), vc = bf2f(ctH[128 + lane]); \
        const float rs = rc + (bf2f(ptH[lane]) - rc) * mur, ks = kc + (bf2f(ptH[64 + lane]) - kc) * muk, vs = vc + (bf2f(ptH[128 + lane]) - vc) * muv; \
        RSm[t * 64 + lane] = rs; KSm[t * 64 + lane] = ks; VSm[t * 64 + lane] = vs; \
        const float kkr = ks * kkw; const float n2 = wave_sum_dpp(kkr * kkr); KKNm[t * 64 + lane] = kkr * __builtin_amdgcn_rsqf(fmaxf(n2, 1e-24f)); \
        _Pragma("unroll") for (int q = 0; q < 5; ++q) { const int i = lane + 64 * q; if (i < 288) { const float xc = ctF[i]; const float x = xc + (ptF[i] - xc) * mul[q]; \
                LXB[t * 288 + i] = bf1(q == 0 ? fast_tanh(x) : (q == 1 ? x : fast_sigmoid(x))); } } } while (0)
#define RK_STAGE_F(cf_, t_) do { const int t = (t_); const int par_ = (cf_) & 1; const int rowF_ = ((cf_) == 0) ? MMAIN : b * SEQ + ((cf_) - 1) * 16; \
        LAS const float* Gp_ = (LAS const float*)(lds + rk::GG + par_ * 4096); LAS const float* Vp_ = (LAS const float*)(lds + rk::VF + par_ * 4096); LAS const float* Bp_ = (LAS const float*)(lds + rk::BONP + par_ * 256); \
        const float yv = YRm[t * 64 + lane]; \
        const float mean = wave_sum_dpp(yv) * (1.0f / 64.0f); const float d = yv - mean; const float var = wave_sum_dpp(d * d) * (1.0f / 64.0f); \
        const float yn = d * __builtin_amdgcn_rsqf(var + LNX_EPS) * lnw + lnb; \
        const float bonus = (Bp_[t] + Bp_[16 + t]) + (Bp_[32 + t] + Bp_[48 + t]); \
        const float o = (yn + bonus * Vp_[t * 64 + lane]) * Gp_[t * 64 + lane]; \
        if ((cf_) > 0 || b == 0) Y[(size_t)(rowF_ + t) * DM + hj] = bf1(o); } while (0)
    RK_DMA(0); RK_DMA(1);
    for (int e = tid; e < 288; e += 512) ((LAS float*)(lds + rk::RAWF + 2 * rk::RAWF_SZ))[15 * 288 + e] = 0.f;
    for (int e = tid; e < 96; e += 512) ((LAS unsigned*)(lds + rk::RAWH + 2 * rk::RAWH_SZ))[15 * 96 + e] = 0u;
    asm volatile("s_waitcnt vmcnt(0)" ::: "memory");
    RK_BAR();
    RK_STAGE_A(0, wave); RK_STAGE_A(0, wave + 8);
    RK_BAR();
#pragma unroll 1
    for (int c = 0; c < 257; ++c) {
        if (wave < 4) {
            LAS float* BONPc = (LAS float*)(lds + rk::BONP + (c & 1) * 256);
            f32x4 accW = (f32x4){0.f, 0.f, 0.f, 0.f}, accA = accW;
#pragma unroll
            for (int s = 0; s < 2; ++s) { const bf16x8_t aw = *(const LAS bf16x8_t*)(LXB + n * 288 + 32 * s + 8 * g), aa = *(const LAS bf16x8_t*)(LXB + n * 288 + 64 + 32 * s + 8 * g);
                accW = __builtin_amdgcn_mfma_f32_16x16x32_bf16(aw, fA[s], accW, 0, 0, 0); accA = __builtin_amdgcn_mfma_f32_16x16x32_bf16(aa, fB[s], accA, 0, 0, 0); }
            float lw[4], alr[4], pfx[4];
#pragma unroll
            for (int r = 0; r < 4; ++r) { lw[r] = -0.6065306597126334f * fast_sigmoid(accW[r] + w0k); alr[r] = fast_sigmoid(accA[r] + a0k); }
            pfx[0] = lw[0]; pfx[1] = pfx[0] + lw[1]; pfx[2] = pfx[1] + lw[2]; pfx[3] = pfx[2] + lw[3];
            const float t0 = __shfl(pfx[3], n), t1 = __shfl(pfx[3], n + 16), t2 = __shfl(pfx[3], n + 32), t3 = __shfl(pfx[3], n + 48);
            const float base = (g > 0 ? t0 : 0.f) + (g > 1 ? t1 : 0.f) + (g > 2 ? t2 : 0.f), lamT = (t0 + t1) + (t2 + t3);
            float bh[4], kh[4], bon[4], epos[4];
            const float eb = __expf(base), eT = __expf(lamT);
#pragma unroll
            for (int r = 0; r < 4; ++r) epos[r] = __expf(base + pfx[r]);
#pragma unroll
            for (int r = 0; r < 4; ++r) { const int t = 4 * g + r;
                const float e_pos = epos[r], e_neg = __builtin_amdgcn_rcpf(epos[r]), e_prev = (r == 0) ? eb : epos[r > 0 ? r - 1 : 0], e_hat = eT * e_neg;
                const float rs = RSm[t * 64 + key], ks = KSm[t * 64 + key], kk = KKNm[t * 64 + key];
                const float kmod = ks * (1.0f + (alr[r] - 1.0f) * kak), bb = kk * alr[r];
                ATp[t * 64 + pp] = bf1(-kk * e_prev); RTp[t * 64 + pp] = bf1(rs * e_pos); BTp[t * 64 + pp] = bf1(bb * e_neg); KTp[t * 64 + pp] = bf1(kmod * e_neg);
                bh[r] = bb * e_hat; kh[r] = kmod * e_hat; bon[r] = rs * kmod * rkk; }
            *(LAS bf16x4_t*)(BHt + key * 16 + 4 * g) = pack4(bh[0], bh[1], bh[2], bh[3]); *(LAS bf16x4_t*)(KHt + key * 16 + 4 * g) = pack4(kh[0], kh[1], kh[2], kh[3]);
#pragma unroll
            for (int r = 0; r < 4; ++r) { const float x = row_sum16(bon[r]); if (n == 0) BONPc[kw * 16 + 4 * g + r] = x; }
            if (g == 0) GTm[key] = eT;
        } else {
            LAS float* Gc = (LAS float*)(lds + rk::GG + (c & 1) * 4096); LAS float* VFc = (LAS float*)(lds + rk::VF + (c & 1) * 4096);
            f32x4 accG = (f32x4){0.f, 0.f, 0.f, 0.f};
#pragma unroll
            for (int s = 0; s < 5; ++s) { const bf16x8_t ag = *(const LAS bf16x8_t*)(LXB + n * 288 + 128 + 32 * s + 8 * g); accG = __builtin_amdgcn_mfma_f32_16x16x32_bf16(ag, fB[s], accG, 0, 0, 0); }
            float vv[4];
#pragma unroll
            for (int r = 0; r < 4; ++r) { Gc[(4 * g + r) * 64 + key] = accG[r]; vv[r] = VSm[(4 * g + r) * 64 + key]; VFc[(4 * g + r) * 64 + key] = vv[r]; }
            *(LAS bf16x4_t*)(Vt + key * 16 + 4 * g) = pack4(vv[0], vv[1], vv[2], vv[3]);
        }
        asm volatile("s_waitcnt vmcnt(0)" ::: "memory");
        RK_BAR();
        if (c + 2 < 257) RK_DMA(c + 2);
        if (wave < 4) {
            LAS const bf16_t* X = (wave < 2) ? ATp : RTp; LAS const bf16_t* Yi = (wave & 1) ? KTp : BTp;
            f32x4 acc = (f32x4){0.f, 0.f, 0.f, 0.f};
#pragma unroll
            for (int s = 0; s < 2; ++s) { const bf16x8_t xa = *(const LAS bf16x8_t*)(X + n * 64 + 32 * s + 8 * g), yb = *(const LAS bf16x8_t*)(Yi + n * 64 + 32 * s + 8 * g);
                acc = __builtin_amdgcn_mfma_f32_16x16x32_bf16(xa, yb, acc, 0, 0, 0); }
            float mv[4];
#pragma unroll
            for (int r = 0; r < 4; ++r) { const int t = 4 * g + r; const bool keep = (wave < 2) ? (n < t) : (n <= t); mv[r] = keep ? acc[r] : 0.f;
                if (wave == 1) AAKm[t * 16 + n] = bf1(mv[r]); else if (wave == 2) RBm[t * 16 + n] = bf1(mv[r]); else if (wave == 3) RKm[t * 16 + n] = bf1(mv[r]); }
            if (wave == 0) {
                float Tc[16];
#pragma unroll
                for (int t = 0; t < 16; ++t) { float v0 = (t == n) ? 1.0f : 0.0f, v1 = 0.f;
#pragma unroll
                    for (int i = 0; i < t; ++i) { const float a = rdlane(mv[t & 3], i + 16 * (t >> 2)); if (i & 1) v1 += a * Tc[i]; else v0 += a * Tc[i]; }
                    Tc[t] = v0 + v1; __builtin_amdgcn_sched_barrier(0); }
                if (g == 0) {
#pragma unroll
                    for (int t = 0; t < 16; ++t) TINVm[t * 16 + n] = bf1(Tc[t]); }
            }
        }
        if (wave >= 1) {
            if (c + 1 < 257) { RK_STAGE_A(c + 1, wave - 1); RK_STAGE_A(c + 1, wave + 6); if (wave < 3) RK_STAGE_A(c + 1, wave + 13); }
            if (c >= 1) { RK_STAGE_F(c - 1, wave - 1); RK_STAGE_F(c - 1, wave + 6); if (wave < 3) RK_STAGE_F(c - 1, wave + 13); }
        }
        RK_BAR();
        if (wave < 4) {
            bf16x8_t sb[2];
#pragma unroll
            for (int s = 0; s < 2; ++s) { u32x4 w; w.x = pk_bf16(ST[2 * s][0], ST[2 * s][1]); w.y = pk_bf16(ST[2 * s][2], ST[2 * s][3]); w.z = pk_bf16(ST[2 * s + 1][0], ST[2 * s + 1][1]); w.w = pk_bf16(ST[2 * s + 1][2], ST[2 * s + 1][3]);
                sb[s] = __builtin_bit_cast(bf16x8_t, w); }
            const bf16x4_t vfr = *(const LAS bf16x4_t*)(Vt + key * 16 + 4 * g);
            f32x4 W1 = (f32x4){0.f, 0.f, 0.f, 0.f}, Yc = W1;
#pragma unroll
            for (int s = 0; s < 2; ++s) { const bf16x8_t af = *(const LAS bf16x8_t*)(ATp + n * 64 + 32 * s + 8 * g), rf = *(const LAS bf16x8_t*)(RTp + n * 64 + 32 * s + 8 * g);
                W1 = __builtin_amdgcn_mfma_f32_16x16x32_bf16(af, sb[s], W1, 0, 0, 0); Yc = __builtin_amdgcn_mfma_f32_16x16x32_bf16(rf, sb[s], Yc, 0, 0, 0); }
            W1 = __builtin_amdgcn_mfma_f32_16x16x16bf16_1k(*(const LAS bf16x4_t*)(AAKm + n * 16 + 4 * g), vfr, W1, 0, 0, 0);
            const bf16x4_t w1f = pack4(W1[0], W1[1], W1[2], W1[3]);
            f32x4 U = __builtin_amdgcn_mfma_f32_16x16x16bf16_1k(*(const LAS bf16x4_t*)(TINVm + n * 16 + 4 * g), w1f, (f32x4){0.f, 0.f, 0.f, 0.f}, 0, 0, 0);
            const bf16x4_t uf = pack4(U[0], U[1], U[2], U[3]);
            Yc = __builtin_amdgcn_mfma_f32_16x16x16bf16_1k(*(const LAS bf16x4_t*)(RBm + n * 16 + 4 * g), uf, Yc, 0, 0, 0);
            Yc = __builtin_amdgcn_mfma_f32_16x16x16bf16_1k(*(const LAS bf16x4_t*)(RKm + n * 16 + 4 * g), vfr, Yc, 0, 0, 0);
#pragma unroll
            for (int r = 0; r < 4; ++r) YRm[(4 * g + r) * 64 + key] = Yc[r];
#pragma unroll
            for (int kb = 0; kb < 4; ++kb) { const f32x4 gt = *(const LAS f32x4*)(GTm + 16 * kb + 4 * g); f32x4 a = ST[kb] * gt;
                a = __builtin_amdgcn_mfma_f32_16x16x16bf16_1k(*(const LAS bf16x4_t*)(BHt + (16 * kb + n) * 16 + 4 * g), uf, a, 0, 0, 0);
                a = __builtin_amdgcn_mfma_f32_16x16x16bf16_1k(*(const LAS bf16x4_t*)(KHt + (16 * kb + n) * 16 + 4 * g), vfr, a, 0, 0, 0);
                ST[kb] = a; }
        }
        RK_BAR();
    }
    RK_STAGE_F(256, wave); RK_STAGE_F(256, wave + 8);
    asm volatile("s_waitcnt vmcnt(0)" ::: "memory");
    RK_BAR();
#undef RK_DMA
#undef RK_STAGE_A
#undef RK_STAGE_F
}

__device__ __forceinline__ f32x4 sk_dot(const bf16_t* a, const bf16_t* b, int nsteps) {
    f32x4 acc = (f32x4){0.f, 0.f, 0.f, 0.f};
#pragma unroll 4
    for (int s = 0; s < nsteps; ++s) { const bf16x8_t av = *(const bf16x8_t*)(a + 32 * s), bv = *(const bf16x8_t*)(b + 32 * s); acc = __builtin_amdgcn_mfma_f32_16x16x32_bf16(av, bv, acc, 0, 0, 0); }
    return acc; }
__device__ __forceinline__ void meta_rs(const float* ssm, int lane, float (&rs)[4]) {
    const int row = lane & 15, part = lane >> 4; float s = 0.f;
#pragma unroll 8
    for (int i = 0; i < 32; ++i) s += ssm[(part + 4 * i) * 16 + row];
    s = s + __shfl_xor(s, 16); s = s + __shfl_xor(s, 32);
    const float rv = __builtin_amdgcn_rsqf(s * (1.0f / 2048.0f) + 1e-6f);
#pragma unroll
    for (int r = 0; r < 4; ++r) rs[r] = __shfl(rv, 4 * part + r); }
#define SK_HEAD const int tid = ltid(), lane = tid & 63, wave = __builtin_amdgcn_readfirstlane(tid >> 6), n = lane & 15, g = lane >> 4, kq = wave & 3, ti = lbid() + 256 * (wave >> 2); LAS f32x4* part = (LAS f32x4*)lds;
#define SK_COMBINE(dst, slot) do { dst = (part[((wave) * 2 + (slot)) * 64 + lane] + part[((wave + 1) * 2 + (slot)) * 64 + lane]) + (part[((wave + 2) * 2 + (slot)) * 64 + lane] + part[((wave + 3) * 2 + (slot)) * 64 + lane]); } while (0)
__device__ __forceinline__ void skinny_gu(const bf16_t* hb, const bf16_t* Bt, const float* ssm, bf16_t* act, LAS unsigned char* lds) {
    using namespace cfg; SK_HEAD
    if (ti < DFF / 16) { const int c0 = 16 * ti, brow = (c0 >> 7) * 256 + (c0 & 127) + n; const bf16_t* a = hb + (size_t)(MMAIN + n) * DM + 512 * kq + 8 * g;
        part[(wave * 2) * 64 + lane] = sk_dot(a, Bt + (size_t)brow * DM + 512 * kq + 8 * g, 16); part[(wave * 2 + 1) * 64 + lane] = sk_dot(a, Bt + (size_t)(brow + 128) * DM + 512 * kq + 8 * g, 16); }
    __syncthreads();
    if (ti < DFF / 16 && kq == 0) { f32x4 gt, up; SK_COMBINE(gt, 0); SK_COMBINE(up, 1); float rs[4]; meta_rs(ssm, lane, rs);
#pragma unroll
        for (int r = 0; r < 4; ++r) { const float gv = gt[r] * rs[r], uv = up[r] * rs[r]; act[(size_t)(MMAIN + 4 * g + r) * DFF + 16 * ti + n] = bf1(gv * __builtin_amdgcn_rcpf(1.0f + __builtin_amdgcn_exp2f(-1.4426950408889634f * gv)) * uv); } }
    __syncthreads();
}
__device__ __forceinline__ void skinny_res(const bf16_t* A16, int K, const bf16_t* Bt, bf16_t* hb, float* ssm_out, float alpha, LAS unsigned char* lds) {
    using namespace cfg; SK_HEAD
    const int kqs = K / 4;
    if (ti < DM / 16) part[(wave * 2) * 64 + lane] = sk_dot(A16 + (size_t)n * K + kqs * kq + 8 * g, Bt + (size_t)(16 * ti + n) * K + kqs * kq + 8 * g, kqs / 32);
    __syncthreads();
    if (ti < DM / 16 && kq == 0) { f32x4 acc; SK_COMBINE(acc, 0);
#pragma unroll
        for (int r = 0; r < 4; ++r) { const int m = 4 * g + r, col = 16 * ti + n; bf16_t* p = hb + (size_t)(MMAIN + m) * DM + col; const float hv = bf2f(*p) + alpha * acc[r]; *p = bf1(hv);
            const float sq = row_sum16(hv * hv); if (n == 0) ssm_out[ti * 16 + m] = sq; } }
    __syncthreads();
}
__device__ __forceinline__ void skinny_p(const bf16_t* hb, const bf16_t* Bt, const float* ssm, bf16_t* pr, float* ps, bf16_t* qkv, LAS unsigned char* lds) {
    using namespace cfg; SK_HEAD
    if (ti < NIN / 16) part[(wave * 2) * 64 + lane] = sk_dot(hb + (size_t)(MMAIN + n) * DM + 512 * kq + 8 * g, Bt + (size_t)(16 * ti + n) * DM + 512 * kq + 8 * g, 16);
    __syncthreads();
    if (ti < NIN / 16 && kq == 0) { f32x4 acc; SK_COMBINE(acc, 0); float rs[4]; meta_rs(ssm, lane, rs); const int np = 16 * ti + n;
#pragma unroll
        for (int r = 0; r < 4; ++r) { const int m = 4 * g + r; const float v = acc[r] * rs[r];
            if (np < 3072) pr[(size_t)(MMAIN + m) * PRW + np] = bf1(v);
            else if (np < 3584) ps[(size_t)(MMAIN + m) * PSW + (np - 3072)] = v;
            else { const bf16_t w = bf1(v);
#pragma unroll
                for (int b = 0; b < NBATCH; ++b) qkv[((size_t)b * SEQP + 48 + m) * QKVW + (np - 3584)] = w; } } }
    __syncthreads();
}
#undef SK_HEAD
#undef SK_COMBINE

namespace fox {
constexpr int D = 128, NW = 8, QBLK = 32, KVBLK = 64, QB = NW * QBLK;
constexpr int LDQ = cfg::QKVW, LDK = cfg::QKVW, LDO = cfg::DM;
constexpr float SCALE = 0.08838834764831845f, THR = 8.f;
constexpr bool WSKIP = false;
constexpr int SHM_V = KVBLK * D * 2, SHM_K = KVBLK * D * 2;
constexpr int ATT_LDS = 2 * SHM_V + 2 * SHM_K + NW * 64 * 4;
constexpr int BIAS_OFF = ATT_LDS;
constexpr int SCAN_OFF = BIAS_OFF + cfg::SEQP * 4;

using bf16 = __hip_bfloat16;
typedef short bf16x8 __attribute__((ext_vector_type(8)));
typedef short s16x4 __attribute__((ext_vector_type(4)));
typedef float f32x16 __attribute__((ext_vector_type(16)));
typedef float f32x4 __attribute__((ext_vector_type(4)));
typedef unsigned u32x4 __attribute__((ext_vector_type(4)));
template <class A, class Bt> struct same_t { static constexpr bool v = false; };
template <class A> struct same_t<A, A> { static constexpr bool v = true; };

#define KSWZ(row, colB) ((row) * 256 + ((colB) ^ (((row) & 7) << 4)))
#define SBAR() __builtin_amdgcn_sched_barrier(0)
__device__ __forceinline__ int v_st(int k, int c) { const int kk = (k & ~0xC) | ((k & 4) << 1) | ((k & 8) >> 1); return ((kk >> 3) * 4 + (c >> 5)) * 512 + ((kk & 7) * 32 + (c & 31)) * 2; }
__device__ __forceinline__ int v_rd_base(int lane) { return ((lane & 3) << 3) | (((lane >> 2) & 3) << 6) | (((lane >> 4) & 1) << 5) | (((lane >> 5) & 1) << 8); }
constexpr int v_rd_off(int d0, int ks, int half) { return d0 * 512 + ks * 4096 + half * 2048; }
__device__ __forceinline__ int crow(int r, int hi) { return (r & 3) + 8 * (r >> 2) + 4 * hi; }
__device__ __forceinline__ unsigned cvtpk(float lo, float hi) {
    unsigned r; asm volatile("v_cvt_pk_bf16_f32 %0, %1, %2" : "=v"(r) : "v"(lo), "v"(hi)); return r;
}
__device__ __forceinline__ bf16x8 pack8(f32x4 a, f32x4 b) {
    u32x4 w = {cvtpk(a[0], a[1]), cvtpk(a[2], a[3]), cvtpk(b[0], b[1]), cvtpk(b[2], b[3])};
    return *reinterpret_cast<bf16x8*>(&w);
}
template <class T> __device__ __forceinline__ bf16x8 load8(const T* p) {
    if constexpr (same_t<T, float>::v) { return pack8(*(const f32x4*)p, *(const f32x4*)(p + 4)); }
    else { return *reinterpret_cast<const bf16x8*>(p); }
}
__device__ __forceinline__ void mask_tile(f32x16& p0, f32x16& p1, int dq, unsigned W) {
    const float NEG = -__builtin_inff();
#pragma unroll
    for (int r = 0; r < 16; ++r) {
        const int c = (r & 3) + 8 * (r >> 2);
        if ((unsigned)(dq - c) >= W) p0[r] = NEG;
        if ((unsigned)(dq - c - 32) >= W) p1[r] = NEG;
    }
}
__device__ __forceinline__ void partialSM(f32x16& p0, f32x16& p1, float& m_reg, float& mn, float& alpha) {
    float pmax = p0[0]; for (int r = 1; r < 16; ++r) pmax = fmaxf(pmax, p0[r]); for (int r = 0; r < 16; ++r) pmax = fmaxf(pmax, p1[r]);
    { auto rr = __builtin_amdgcn_permlane32_swap(__float_as_uint(pmax), __float_as_uint(pmax), false, false);
      pmax = fmaxf(__uint_as_float(rr[0]), __uint_as_float(rr[1])); }
    constexpr float C2 = 1.4426950408889634f * SCALE;
    if (__builtin_expect(__all((pmax - m_reg) * SCALE <= THR), 1)) { mn = m_reg; alpha = 1.f; }
    else { mn = fmaxf(m_reg, pmax); alpha = __builtin_amdgcn_exp2f((m_reg - mn) * C2); m_reg = mn; }
    const float mnL = -mn * C2;
    for (int r = 0; r < 16; ++r) p0[r] = fmaf(p0[r], C2, mnL); for (int r = 0; r < 16; ++r) p1[r] = fmaf(p1[r], C2, mnL);
    for (int r = 0; r < 16; ++r) p0[r] = __builtin_amdgcn_exp2f(p0[r]);
}
__device__ __forceinline__ void finishSM(f32x16& p0, f32x16& p1, float alpha, float& l_reg, bf16x8& pa0, bf16x8& pa1, bf16x8& pa2, bf16x8& pa3) {
    for (int r = 0; r < 16; ++r) p1[r] = __builtin_amdgcn_exp2f(p1[r]);
    float ps = 0; for (int r = 0; r < 16; ++r) ps += p0[r]; for (int r = 0; r < 16; ++r) ps += p1[r];
    { auto rr = __builtin_amdgcn_permlane32_swap(__float_as_uint(ps), __float_as_uint(ps), false, false);
      ps = __uint_as_float(rr[0]) + __uint_as_float(rr[1]); }
    l_reg = l_reg * alpha + ps;
#define PK4(P, B_, OUT) do { unsigned a0 = cvtpk(P[B_+0], P[B_+1]), a1 = cvtpk(P[B_+2], P[B_+3]);                          \
        unsigned b0 = cvtpk(P[B_+4], P[B_+5]), b1 = cvtpk(P[B_+6], P[B_+7]);                                             \
        auto r0 = __builtin_amdgcn_permlane32_swap(a0, b0, false, false); auto r1 = __builtin_amdgcn_permlane32_swap(a1, b1, false, false); \
        u32x4 w = {r0[0], r1[0], r0[1], r1[1]}; OUT = *reinterpret_cast<bf16x8*>(&w); } while (0)
    PK4(p0, 0, pa0); PK4(p0, 8, pa1); PK4(p1, 0, pa2); PK4(p1, 8, pa3);
#undef PK4
}
template <int KB, bool SK>
__device__ __forceinline__ void qkt(f32x16& p0, f32x16& p1, const char* K_lds, int r32, int hi, const bf16x8* qr, bool act, const float* bias_t) {
    if (SK && !act) { const float NEG = -__builtin_inff();
#pragma unroll
        for (int r = 0; r < 16; ++r) { p0[r] = NEG; p1[r] = NEG; } return; }
    {
#pragma unroll
        for (int g_ = 0; g_ < 4; ++g_) { const f32x4 b0_ = *(const f32x4*)(bias_t + 8 * g_ + 4 * hi); const f32x4 b1_ = *(const f32x4*)(bias_t + 32 + 8 * g_ + 4 * hi);
            p0[4 * g_] = b0_[0]; p0[4 * g_ + 1] = b0_[1]; p0[4 * g_ + 2] = b0_[2]; p0[4 * g_ + 3] = b0_[3];
            p1[4 * g_] = b1_[0]; p1[4 * g_ + 1] = b1_[1]; p1[4 * g_ + 2] = b1_[2]; p1[4 * g_ + 3] = b1_[3]; } }
    const char* kb[4];
#pragma unroll
    for (int dd = 0; dd < 4; ++dd) kb[dd] = K_lds + KB * SHM_K + KSWZ(r32, (dd * 16 + hi * 8) * 2);
#pragma unroll
    for (int d0 = 0; d0 < 8; ++d0) { const char* a = kb[d0 & 3] + (d0 >> 2) * 128;
        bf16x8 b0 = *reinterpret_cast<const bf16x8*>(a);
        bf16x8 b1 = *reinterpret_cast<const bf16x8*>(a + 32 * 256);
        p0 = __builtin_amdgcn_mfma_f32_32x32x16_bf16(b0, qr[d0], p0, 0, 0, 0);
        p1 = __builtin_amdgcn_mfma_f32_32x32x16_bf16(b1, qr[d0], p1, 0, 0, 0); }
}
template <int VB, bool SK>
__device__ __forceinline__ void pv_tile(f32x16* o, int vb0, bf16x8 pa0, bf16x8 pa1, bf16x8 pa2, bf16x8 pa3, bool act) {
    if (SK && !act) return;
#define TRRD(dst, off) asm volatile("ds_read_b64_tr_b16 %0, %1 offset:%2" : "=&v"(dst) : "v"(vb0), "i"(off) : "memory")
#define PV_D0(d0) do { s16x4 l0, l1, l2, l3, h0, h1, h2, h3; constexpr int b_ = VB * SHM_V + v_rd_off(d0, 0, 0);     \
        TRRD(l0, b_); TRRD(h0, b_ + 2048); TRRD(l1, b_ + 4096); TRRD(h1, b_ + 6144); TRRD(l2, b_ + 8192); TRRD(h2, b_ + 10240); TRRD(l3, b_ + 12288); TRRD(h3, b_ + 14336); \
        asm volatile("s_waitcnt lgkmcnt(0)" ::: "memory"); SBAR();                 \
        o[d0] = __builtin_amdgcn_mfma_f32_32x32x16_bf16(pa0, (bf16x8){l0[0], l0[1], l0[2], l0[3], h0[0], h0[1], h0[2], h0[3]}, o[d0], 0, 0, 0);   \
        o[d0] = __builtin_amdgcn_mfma_f32_32x32x16_bf16(pa1, (bf16x8){l1[0], l1[1], l1[2], l1[3], h1[0], h1[1], h1[2], h1[3]}, o[d0], 0, 0, 0);   \
        o[d0] = __builtin_amdgcn_mfma_f32_32x32x16_bf16(pa2, (bf16x8){l2[0], l2[1], l2[2], l2[3], h2[0], h2[1], h2[2], h2[3]}, o[d0], 0, 0, 0);   \
        o[d0] = __builtin_amdgcn_mfma_f32_32x32x16_bf16(pa3, (bf16x8){l3[0], l3[1], l3[2], l3[3], h3[0], h3[1], h3[2], h3[3]}, o[d0], 0, 0, 0); } while (0)
    PV_D0(0); PV_D0(1); PV_D0(2); PV_D0(3);
#undef PV_D0
#undef TRRD
}

template <class TIn, class TOut> struct BlockRef { const TIn* Q; const TIn* K; const TIn* V; TOut* O; int P0; };
template <class TIn> struct Seam {
    bf16x8 qr[8];
    bf16x8 st_v0, st_v1, st_k0, st_k1; f32x4 sf0, sf1, sf2, sf3;
    f32x4 tq[16];
};
__device__ __forceinline__ int swa_jlo(int P0, int W) { const int lowk = P0 - W + 1; return lowk > 0 ? lowk / KVBLK : 0; }
#define ROW(p, k0, rr) ((p) + (size_t)((k0) + (rr)) * LDK + sc)
#define VMW() asm volatile("s_waitcnt vmcnt(0)" ::: "memory")
#define VMWN(n) asm volatile("s_waitcnt vmcnt(%0)" :: "i"(n) : "memory")
#define SLOAD_H(Kp, Vp, k0) do { S.st_v0 = load8<TIn>(ROW(Vp, k0, sr)); S.st_v1 = load8<TIn>(ROW(Vp, k0, 32 + sr));              \
                         S.st_k0 = load8<TIn>(ROW(Kp, k0, sr)); S.st_k1 = load8<TIn>(ROW(Kp, k0, 32 + sr)); } while (0)
#define SWRITE_HK(bf) do { *(bf16x8*)(K_lds + (bf) * SHM_K + kws) = S.st_k0; *(bf16x8*)(K_lds + (bf) * SHM_K + kws + 32 * 256) = S.st_k1; } while (0)
#define SWRITE_HV(bf) do { *(bf16x8*)(V_lds + (bf) * SHM_V + vst0) = S.st_v0; *(bf16x8*)(V_lds + (bf) * SHM_V + vst1) = S.st_v1; } while (0)
#define SWRITE_H(bf) do { SWRITE_HV(bf); SWRITE_HK(bf); } while (0)
#define SLOAD_F(p, k0) do { S.sf0 = *(const f32x4*)ROW(p, k0, sr); S.sf1 = *(const f32x4*)(ROW(p, k0, sr) + 4);                \
                            S.sf2 = *(const f32x4*)ROW(p, k0, 32 + sr); S.sf3 = *(const f32x4*)(ROW(p, k0, 32 + sr) + 4); } while (0)
#define SWRITE_KF(bf) do { *(bf16x8*)(K_lds + (bf) * SHM_K + kws) = pack8(S.sf0, S.sf1); *(bf16x8*)(K_lds + (bf) * SHM_K + kws + 32 * 256) = pack8(S.sf2, S.sf3); } while (0)
#define SWRITE_VF(bf) do { *(bf16x8*)(V_lds + (bf) * SHM_V + vst0) = pack8(S.sf0, S.sf1); *(bf16x8*)(V_lds + (bf) * SHM_V + vst1) = pack8(S.sf2, S.sf3); } while (0)
template <class TIn, class TOut>
__device__ __forceinline__ void causal_swa_prime(const BlockRef<TIn, TOut>& cur, int W, char* lds, Seam<TIn>& S) {
    constexpr bool F32 = same_t<TIn, float>::v;
    const int tid = ltid(), wid = __builtin_amdgcn_readfirstlane(tid >> 6), lane = tid & 63, r32 = lane & 31, hi = lane >> 5;
    const int sr = tid >> 4, sc = (tid & 15) * 8, kws = KSWZ(sr, sc * 2); char* K_lds = lds + 2 * SHM_V;
    const int kb0 = swa_jlo(cur.P0, W) * KVBLK;
    for (int d0 = 0; d0 < 8; ++d0) S.qr[d0] = load8<TIn>(cur.Q + (size_t)(wid * QBLK + r32) * LDQ + d0 * 16 + hi * 8);
    if constexpr (F32) { SLOAD_F((const float*)cur.K, kb0); VMW(); SWRITE_KF(0); SBAR(); SLOAD_F((const float*)cur.V, kb0); }
    else { SLOAD_H(cur.K, cur.V, kb0); VMW(); SWRITE_HK(0); }
    __syncthreads();
}
template <class TIn, class TOut>
__device__ __forceinline__ void causal_swa_block(const BlockRef<TIn, TOut>& cur, const BlockRef<TIn, TOut>& nxt, int skv, int W, char* lds, Seam<TIn>& S, const float* bias_l) {
    constexpr bool F32 = same_t<TIn, float>::v;
    const int tid = ltid(), wid = __builtin_amdgcn_readfirstlane(tid >> 6), lane = tid & 63, r32 = lane & 31, hi = lane >> 5;
    const int j_lo = swa_jlo(cur.P0, W);
    int j_hi = (cur.P0 + QB - 1) / KVBLK + 1; if (j_hi > skv / KVBLK) j_hi = skv / KVBLK;
    const int NT = j_hi - j_lo;
    const int kbn = swa_jlo(nxt.P0, W) * KVBLK;
    const int qlo = cur.P0 + wid * QBLK, qm = qlo + r32 - 4 * hi;
    char* V_lds = lds; char* K_lds = lds + 2 * SHM_V;
    float* ws = (float*)(lds + 2 * SHM_V + 2 * SHM_K) + wid * 64; float* li_l = ws, * al_l = ws + 32;
    float m_reg = -1e30f, l_reg = 0; f32x16 o[4] = {};
    const int sr = tid >> 4, sc = (tid & 15) * 8, vst0 = v_st(sr, sc), vst1 = v_st(32 + sr, sc), kws = KSWZ(sr, sc * 2);
    const int vb0 = (int)(uintptr_t)V_lds + v_rd_base(lane);
    const TIn* Kh = cur.K; const TIn* Vh = cur.V;
#define RESC(a) do { if (__any((a) < 1.f)) { if (hi == 0) al_l[r32] = (a); asm volatile("s_waitcnt lgkmcnt(0)" ::: "memory");              \
                     for (int d_ = 0; d_ < 4; ++d_) for (int r = 0; r < 16; ++r) o[d_][r] *= al_l[crow(r, hi)]; } } while (0)
#define KBASE(t) ((j_lo + (t)) * KVBLK)
#define ACT(t) (KBASE(t) <= qlo + QBLK - 1 && KBASE(t) + KVBLK - 1 >= qlo - W + 1)
#define MASKT(P0_, P1_, t) do { const int kb_ = KBASE(t); if ((!SK || ACT(t)) && (kb_ + KVBLK - 1 > qlo || kb_ <= qlo + QBLK - 1 - W)) mask_tile(P0_, P1_, qm - kb_, (unsigned)W); } while (0)
    constexpr int NQL = F32 ? 16 : 8;
    constexpr bool SK = WSKIP && !F32;
#define SEAM_K0() do { VMWN(NQL); if constexpr (F32) { SWRITE_KF(0); SBAR(); SLOAD_F((const float*)nxt.V, kbn); } else { SWRITE_HK(0); } SBAR(); } while (0)
    f32x16 pA0, pA1, pB0, pB1; float mnA, mnB, alA, alB; bf16x8 pa0, pa1, pa2, pa3;
    if constexpr (F32) { VMW(); SWRITE_VF(0); SBAR(); } else { SWRITE_HV(0); SBAR(); }
    if (NT > 1) { if constexpr (F32) SLOAD_F((const float*)Kh, KBASE(1)); else SLOAD_H(Kh, Vh, KBASE(1)); }
    SBAR(); qkt<0, SK>(pA0, pA1, K_lds, r32, hi, S.qr, ACT(0), bias_l + KBASE(0));
    if constexpr (F32) { if (NT > 1) { VMW(); SWRITE_KF(1); SBAR(); SLOAD_F((const float*)Vh, KBASE(1)); } }
    MASKT(pA0, pA1, 0); partialSM(pA0, pA1, m_reg, mnA, alA);
    if (NT > 1) { VMW(); if constexpr (F32) { SWRITE_VF(1); SBAR(); if (NT > 2) SLOAD_F((const float*)Kh, KBASE(2)); } else SWRITE_H(1); }
    __syncthreads();
#define HALF_STEP(PX0, PX1, mnX, alX, PY0, PY1, alY, t, KB, VB, SB) do {                                                      \
        SBAR(); qkt<KB, SK>(PX0, PX1, K_lds, r32, hi, S.qr, ACT(t), bias_l + KBASE(t));                                             \
        finishSM(PY0, PY1, alY, l_reg, pa0, pa1, pa2, pa3); SBAR();                                                           \
        if ((t) + 1 < NT) { if constexpr (F32) { VMW(); SWRITE_KF(SB); SBAR(); SLOAD_F((const float*)Vh, KBASE((t) + 1)); }  \
                            else { SLOAD_H(Kh, Vh, KBASE((t) + 1)); } SBAR(); }                                               \
        pv_tile<VB, SK>(o, vb0, pa0, pa1, pa2, pa3, ACT((t) - 1)); MASKT(PX0, PX1, (t)); partialSM(PX0, PX1, m_reg, mnX, alX);                                        \
        __syncthreads();                                                                                                      \
        if ((t) + 1 < NT) { VMW(); if constexpr (F32) { SWRITE_VF(SB); SBAR(); if ((t) + 2 < NT) SLOAD_F((const float*)Kh, KBASE((t) + 2)); } \
                            else { SWRITE_H(SB); } }                                                                          \
        RESC(alX); __syncthreads(); } while (0)
    for (int t = 1; t + 1 < NT; t += 2) {
        HALF_STEP(pB0, pB1, mnB, alB, pA0, pA1, alA, t, 1, 0, 0);
        HALF_STEP(pA0, pA1, mnA, alA, pB0, pB1, alB, t + 1, 0, 1, 1);
    }
    const bool even = (NT & 1) == 0;
    if (even) { SBAR(); qkt<1, SK>(pB0, pB1, K_lds, r32, hi, S.qr, ACT(NT - 1), bias_l + KBASE(NT - 1)); SBAR(); }
#define QROW(e) (nxt.Q + (size_t)(wid * QBLK + r32) * LDQ + ((e) >> 1) * 16 + hi * 8 + ((e) & 1) * 4)
    if constexpr (F32) { SLOAD_F((const float*)nxt.K, kbn); SBAR();
#pragma unroll
        for (int e = 0; e < 8; ++e) S.tq[e] = *(const f32x4*)QROW(e); }
    else { SLOAD_H(nxt.K, nxt.V, kbn); SBAR();
#pragma unroll
        for (int d0 = 0; d0 < 8; ++d0) S.qr[d0] = load8<TIn>(nxt.Q + (size_t)(wid * QBLK + r32) * LDQ + d0 * 16 + hi * 8); }
    SBAR();
    finishSM(pA0, pA1, alA, l_reg, pa0, pa1, pa2, pa3); SBAR();
    if constexpr (F32) {
#pragma unroll
        for (int e = 8; e < 16; ++e) S.tq[e] = *(const f32x4*)QROW(e); SBAR(); }
#undef QROW
    pv_tile<0, SK>(o, vb0, pa0, pa1, pa2, pa3, ACT(even ? NT - 2 : NT - 1));
    if (even) { MASKT(pB0, pB1, NT - 1); partialSM(pB0, pB1, m_reg, mnB, alB); __syncthreads(); RESC(alB);
        finishSM(pB0, pB1, alB, l_reg, pa0, pa1, pa2, pa3); SBAR(); pv_tile<1, SK>(o, vb0, pa0, pa1, pa2, pa3, ACT(NT - 1)); }
    SBAR(); SEAM_K0();
    if (hi == 0) li_l[r32] = l_reg; asm volatile("s_waitcnt lgkmcnt(0)" ::: "memory");
    float rli[16];
#pragma unroll
    for (int r = 0; r < 16; ++r) rli[r] = __builtin_amdgcn_rcpf(li_l[crow(r, hi)]);
    TOut* Ow = cur.O + (size_t)(wid * QBLK) * LDO;
#pragma unroll
    for (int r = 0; r < 16; ++r) { const int orow = crow(r, hi);
#pragma unroll
        for (int d0 = 0; d0 < 4; ++d0) { const float v = o[d0][r] * rli[r];
            if constexpr (same_t<TOut, float>::v) { Ow[(size_t)orow * LDO + d0 * 32 + r32] = v; }
            else { const float vn = __shfl_xor(v, 1);
                   if ((r32 & 1) == 0) *(unsigned*)(Ow + (size_t)orow * LDO + d0 * 32 + r32) = cvtpk(v, vn); } } }
    if constexpr (F32) {
#pragma unroll
        for (int d0 = 0; d0 < 8; ++d0) S.qr[d0] = pack8(S.tq[2 * d0], S.tq[2 * d0 + 1]); }
    __syncthreads();
#undef RESC
#undef KBASE
#undef ACT
#undef MASKT
#undef SEAM_K0
#undef HALF_STEP
}
#undef ROW
#undef VMW
#undef VMWN
#undef SLOAD_H
#undef SWRITE_HK
#undef SWRITE_HV
#undef SWRITE_H
#undef SLOAD_F
#undef SWRITE_KF

}

__device__ __forceinline__ void fox_bias(PP P, int l, int b, int h, float* bias, float* scr) {
    using namespace cfg;
    const int tid = ltid(), lane = tid & 63, wave = tid >> 6;
    const float* PS = (const float*)(P->ws + WS_PS); const float bf = P->in[I_BF][l * FNH + h];
    float lf[9]; float loc = 0.f;
#pragma unroll
    for (int i = 0; i < 9; ++i) { const int pos = tid * 9 + i; float v = 0.f;
        if (pos < NMETA + SEQ) { const int row = pos < NMETA ? MMAIN + pos : b * SEQ + pos - NMETA; const float z = PS[(size_t)row * PSW + 288 + h] + bf;
            v = fminf(z, 0.f) - log1pf(__expf(-fabsf(z))); }
        loc += v; lf[i] = loc; }
    float inc = loc;
#pragma unroll
    for (int o = 1; o < 64; o <<= 1) { const float t = __shfl_up(inc, o); if (lane >= o) inc += t; }
    if (lane == 63) scr[wave] = inc;
    __syncthreads();
    float base = inc - loc;
    for (int w = 0; w < wave; ++w) base += scr[w];
    constexpr float INV = 1.0f / fox::SCALE;
#pragma unroll
    for (int i = 0; i < 9; ++i) { const int pos = tid * 9 + i; if (pos < NMETA + SEQ) bias[48 + pos] = -(base + lf[i]) * INV; }
    if (tid < 48) bias[tid] = -__builtin_inff();
    __syncthreads();
}
__device__ __forceinline__ void fox_meta(PP P, int h, const float* bias) {
    using namespace cfg;
    const int lane = ltid() & 63, wave = ltid() >> 6;
    const bf16_t* QKV = (const bf16_t*)(P->ws + WS_QKV); bf16_t* Y = (bf16_t*)(P->ws + WS_Y);
    for (int rep = 0; rep < 2; ++rep) { const int i = wave + 8 * rep;
        float s = -__builtin_inff();
        if (lane <= i) { const bf16_t* q = QKV + (size_t)(48 + i) * QKVW + h * 128; const bf16_t* k = QKV + (size_t)(48 + lane) * QKVW + 1024 + h * 128; float dot = 0.f;
            for (int d = 0; d < 128; ++d) dot += bf2f(q[d]) * bf2f(k[d]);
            s = (dot + bias[48 + lane]) * fox::SCALE; }
        const float m = wave_max(s); const float p = (lane <= i) ? __expf(s - m) : 0.f; const float lsum = wave_sum(p);
        float o0 = 0.f, o1 = 0.f;
        for (int j = 0; j <= i; ++j) { const float pj = __shfl(p, j); const bf16_t* v = QKV + (size_t)(48 + j) * QKVW + 2048 + h * 128; o0 += pj * bf2f(v[lane]); o1 += pj * bf2f(v[64 + lane]); }
        const float il = 1.0f / lsum;
        Y[(size_t)(MMAIN + i) * DM + 1024 + h * 128 + lane] = (bf16_t)(pk_bf16(o0 * il, 0.f) & 0xffffu);
        Y[(size_t)(MMAIN + i) * DM + 1024 + h * 128 + 64 + lane] = (bf16_t)(pk_bf16(o1 * il, 0.f) & 0xffffu); }
}
__device__ __forceinline__ fox::BlockRef<__hip_bfloat16, __hip_bfloat16> fox_mk(int a, int idx, const __hip_bfloat16* Qb, const __hip_bfloat16* Kb, const __hip_bfloat16* Vb, __hip_bfloat16* Ob) {
    const int pr = 4 * (a & 1) + (idx >> 1); const int x = (idx & 1) ? 15 - pr : pr;
    fox::BlockRef<__hip_bfloat16, __hip_bfloat16> r; r.Q = Qb + (size_t)x * 256 * cfg::QKVW; r.K = Kb; r.V = Vb; r.O = Ob + (size_t)x * 256 * cfg::DM; r.P0 = 64 + 256 * x; return r; }
__device__ __forceinline__ void fox_wg(PP P, int l, int a, char* lds) {
    using namespace cfg;
    typedef __hip_bfloat16 bf;
    const int bh = a >> 1, b = bh >> 3, h = bh & 7;
    float* bias = (float*)(lds + fox::BIAS_OFF); float* scr = (float*)(lds + fox::SCAN_OFF);
    fox_bias(P, l, b, h, bias, scr);
    const bf* QKV = (const bf*)(P->ws + WS_QKV); bf* Y = (bf*)(P->ws + WS_Y);
    const bf* Kb = QKV + (size_t)b * SEQP * QKVW + 1024 + h * 128; const bf* Vb = Kb + 1024; const bf* Qb = QKV + ((size_t)b * SEQP + 64) * QKVW + h * 128;
    bf* Ob = Y + (size_t)b * SEQ * DM + 1024 + h * 128;
    constexpr int W = 1 << 30;
    fox::Seam<bf> S;
    fox::BlockRef<bf, bf> cur = fox_mk(a, 0, Qb, Kb, Vb, Ob);
    fox::causal_swa_prime<bf, bf>(cur, W, lds, S);
#pragma unroll 1
    for (int idx = 0; idx < 8; ++idx) {
        const fox::BlockRef<bf, bf> nxt = (idx < 7) ? fox_mk(a, idx + 1, Qb, Kb, Vb, Ob) : cur;
        fox::causal_swa_block<bf, bf>(cur, nxt, SEQP, W, lds, S, bias);
        cur = nxt;
    }
    if (b == 0) fox_meta(P, h, bias);
}

#define WS_PTR(T, off) ((T*)(Q->ws + (off)))
#define SEAM() do { PP Qb_ = launder(P); XcdBarrier b_; b_.bar = (unsigned*)(Qb_->ws + WS_CTL); b_.x = xb_xcc_id(); b_.st = (volatile LAS unsigned*)(lds + LDS_BARW); xcd_barrier(b_); } while (0)
__global__ void __launch_bounds__(512, 2) hymba_fwd(Params Pv) {
    using namespace cfg;
    PP P = (PP)__builtin_amdgcn_kernarg_segment_ptr();
    extern __shared__ __attribute__((aligned(16))) unsigned char lds_raw[];
    LAS unsigned char* lds = (LAS unsigned char*)lds_raw;
    if (threadIdx.x < 4) ((LAS unsigned*)(lds + LDS_BARW))[threadIdx.x] = 0u;
    __syncthreads();
    { PP Q = launder(P); (void)xcd_barrier_post((unsigned*)(Q->ws + WS_CTL), (volatile LAS unsigned*)(lds + LDS_BARW)); }

    { PP Q = launder(P); phase_convert(Q, lds, 0, 1, lbid(), (int)gridDim.x); phase_init(Q); }
    SEAM();
    {
        PP Q = launder(P); const unsigned char* wl = Q->ws + WS_W + (size_t)0 * W_LAYER;
        pg8::Gemm g{WS_PTR(const bf16_t, WS_HB), (const bf16_t*)(wl + WO_GU1), MMAIN, NGU, DM}; pg8::StaticOrder S; S.init(MMAIN, NGU, (int)gridDim.x, lbid());
        pg8::EpiGU E{WS_PTR(bf16_t, WS_ACT), WS_PTR(const float, WS_SS) + (size_t)(0) * 8 * MROWS};
        pg8::gemm_phase<pg8::EpiGU, pg8::StaticOrder, true, true>(lds, g, S, E);
        skinny_gu(WS_PTR(const bf16_t, WS_HB), g.Bt, WS_PTR(const float, WS_SSM) + (0) * 2048, WS_PTR(bf16_t, WS_ACT), lds);
    }
    SEAM();
    {
        PP Q = launder(P); const unsigned char* wl = Q->ws + WS_W + (size_t)0 * W_LAYER;
        pg8::Gemm g{WS_PTR(const bf16_t, WS_ACT), (const bf16_t*)(wl + WO_D1), MMAIN, DM, DFF}; pg8::StaticOrder S; S.init(MMAIN, DM, (int)gridDim.x, lbid());
        pg8::EpiRes E{WS_PTR(bf16_t, WS_HB), WS_PTR(float, WS_SS) + (size_t)(1) * 8 * MROWS, 0.5f, (LAS float*)(lds + 131072)};
        pg8::gemm_phase<pg8::EpiRes, pg8::StaticOrder, true, true>(lds, g, S, E);
        skinny_res(WS_PTR(const bf16_t, WS_ACT) + (size_t)MMAIN * DFF, DFF, g.Bt, WS_PTR(bf16_t, WS_HB), WS_PTR(float, WS_SSM) + (1) * 2048, 0.5f, lds);
    }
    SEAM();
    {
        PP Q = launder(P); const unsigned char* wl = Q->ws + WS_W + (size_t)0 * W_LAYER;
        pg8::Gemm g{WS_PTR(const bf16_t, WS_HB), (const bf16_t*)(wl + WO_IN), MMAIN, NIN, DM}; pg8::StaticOrder S; S.init(MMAIN, NIN, (int)gridDim.x, lbid());
        pg8::EpiP E{WS_PTR(bf16_t, WS_PR), WS_PTR(float, WS_PS), WS_PTR(bf16_t, WS_QKV), WS_PTR(const float, WS_SS) + (size_t)(1) * 8 * MROWS};
        pg8::gemm_phase<pg8::EpiP, pg8::StaticOrder, true, true>(lds, g, S, E);
        skinny_p(WS_PTR(const bf16_t, WS_HB), g.Bt, WS_PTR(const float, WS_SSM) + (1) * 2048, WS_PTR(bf16_t, WS_PR), WS_PTR(float, WS_PS), WS_PTR(bf16_t, WS_QKV), lds);
    }
    SEAM();
    {
        PP Q = launder(P); const int u = lbid();
        if (u < 128) rwkv_chunked(Q, 0, u >> 4, u & 15, lds);
        else { fox_wg(Q, 0, u - 128, (char*)lds_raw); __syncthreads(); phase_convert(launder(P), lds, 1, 2, u - 128, 128); }
    }
    SEAM();
    { PP Q = launder(P); phase_foxnorm(Q); }
    SEAM();
    {
        PP Q = launder(P); const unsigned char* wl = Q->ws + WS_W + (size_t)0 * W_LAYER;
        pg8::Gemm g{WS_PTR(const bf16_t, WS_Y), (const bf16_t*)(wl + WO_OUT), MMAIN, DM, DM}; pg8::StaticOrder S; S.init(MMAIN, DM, (int)gridDim.x, lbid());
        pg8::EpiRes E{WS_PTR(bf16_t, WS_HB), WS_PTR(float, WS_SS) + (size_t)(2) * 8 * MROWS, 1.0f, (LAS float*)(lds + 131072)};
        pg8::gemm_phase<pg8::EpiRes, pg8::StaticOrder, true, true>(lds, g, S, E);
        skinny_res(WS_PTR(const bf16_t, WS_Y) + (size_t)MMAIN * DM, DM, g.Bt, WS_PTR(bf16_t, WS_HB), WS_PTR(float, WS_SSM) + (2) * 2048, 1.0f, lds);
    }
    SEAM();
    {
        PP Q = launder(P); const unsigned char* wl = Q->ws + WS_W + (size_t)0 * W_LAYER;
        pg8::Gemm g{WS_PTR(const bf16_t, WS_HB), (const bf16_t*)(wl + WO_GU2), MMAIN, NGU, DM}; pg8::StaticOrder S; S.init(MMAIN, NGU, (int)gridDim.x, lbid());
        pg8::EpiGU E{WS_PTR(bf16_t, WS_ACT), WS_PTR(const float, WS_SS) + (size_t)(2) * 8 * MROWS};
        pg8::gemm_phase<pg8::EpiGU, pg8::StaticOrder, true, true>(lds, g, S, E);
        skinny_gu(WS_PTR(const bf16_t, WS_HB), g.Bt, WS_PTR(const float, WS_SSM) + (2) * 2048, WS_PTR(bf16_t, WS_ACT), lds);
    }
    SEAM();
    {
        PP Q = launder(P); const unsigned char* wl = Q->ws + WS_W + (size_t)0 * W_LAYER;
        pg8::Gemm g{WS_PTR(const bf16_t, WS_ACT), (const bf16_t*)(wl + WO_D2), MMAIN, DM, DFF}; pg8::StaticOrder S; S.init(MMAIN, DM, (int)gridDim.x, lbid());
        pg8::EpiRes E{WS_PTR(bf16_t, WS_HB), WS_PTR(float, WS_SS) + (size_t)(3) * 8 * MROWS, 0.5f, (LAS float*)(lds + 131072)};
        pg8::gemm_phase<pg8::EpiRes, pg8::StaticOrder, true, true>(lds, g, S, E);
        skinny_res(WS_PTR(const bf16_t, WS_ACT) + (size_t)MMAIN * DFF, DFF, g.Bt, WS_PTR(bf16_t, WS_HB), WS_PTR(float, WS_SSM) + (3) * 2048, 0.5f, lds);
    }
    SEAM();
    {
        PP Q = launder(P); const unsigned char* wl = Q->ws + WS_W + (size_t)1 * W_LAYER;
        pg8::Gemm g{WS_PTR(const bf16_t, WS_HB), (const bf16_t*)(wl + WO_GU1), MMAIN, NGU, DM}; pg8::StaticOrder S; S.init(MMAIN, NGU, (int)gridDim.x, lbid());
        pg8::EpiGU E{WS_PTR(bf16_t, WS_ACT), WS_PTR(const float, WS_SS) + (size_t)(3) * 8 * MROWS};
        pg8::gemm_phase<pg8::EpiGU, pg8::StaticOrder, true, true>(lds, g, S, E);
        skinny_gu(WS_PTR(const bf16_t, WS_HB), g.Bt, WS_PTR(const float, WS_SSM) + (3) * 2048, WS_PTR(bf16_t, WS_ACT), lds);
    }
    SEAM();
    {
        PP Q = launder(P); const unsigned char* wl = Q->ws + WS_W + (size_t)1 * W_LAYER;
        pg8::Gemm g{WS_PTR(const bf16_t, WS_ACT), (const bf16_t*)(wl + WO_D1), MMAIN, DM, DFF}; pg8::StaticOrder S; S.init(MMAIN, DM, (int)gridDim.x, lbid());
        pg8::EpiRes E{WS_PTR(bf16_t, WS_HB), WS_PTR(float, WS_SS) + (size_t)(4) * 8 * MROWS, 0.5f, (LAS float*)(lds + 131072)};
        pg8::gemm_phase<pg8::EpiRes, pg8::StaticOrder, true, true>(lds, g, S, E);
        skinny_res(WS_PTR(const bf16_t, WS_ACT) + (size_t)MMAIN * DFF, DFF, g.Bt, WS_PTR(bf16_t, WS_HB), WS_PTR(float, WS_SSM) + (4) * 2048, 0.5f, lds);
    }
    SEAM();
    {
        PP Q = launder(P); const unsigned char* wl = Q->ws + WS_W + (size_t)1 * W_LAYER;
        pg8::Gemm g{WS_PTR(const bf16_t, WS_HB), (const bf16_t*)(wl + WO_IN), MMAIN, NIN, DM}; pg8::StaticOrder S; S.init(MMAIN, NIN, (int)gridDim.x, lbid());
        pg8::EpiP E{WS_PTR(bf16_t, WS_PR), WS_PTR(float, WS_PS), WS_PTR(bf16_t, WS_QKV), WS_PTR(const float, WS_SS) + (size_t)(4) * 8 * MROWS};
        pg8::gemm_phase<pg8::EpiP, pg8::StaticOrder, true, true>(lds, g, S, E);
        skinny_p(WS_PTR(const bf16_t, WS_HB), g.Bt, WS_PTR(const float, WS_SSM) + (4) * 2048, WS_PTR(bf16_t, WS_PR), WS_PTR(float, WS_PS), WS_PTR(bf16_t, WS_QKV), lds);
    }
    SEAM();
    {
        PP Q = launder(P); const int u = lbid();
        if (u < 128) rwkv_chunked(Q, 1, u >> 4, u & 15, lds);
        else { fox_wg(Q, 1, u - 128, (char*)lds_raw); __syncthreads(); phase_convert(launder(P), lds, 2, 3, u - 128, 128); }
    }
    SEAM();
    { PP Q = launder(P); phase_foxnorm(Q); }
    SEAM();
    {
        PP Q = launder(P); const unsigned char* wl = Q->ws + WS_W + (size_t)1 * W_LAYER;
        pg8::Gemm g{WS_PTR(const bf16_t, WS_Y), (const bf16_t*)(wl + WO_OUT), MMAIN, DM, DM}; pg8::StaticOrder S; S.init(MMAIN, DM, (int)gridDim.x, lbid());
        pg8::EpiRes E{WS_PTR(bf16_t, WS_HB), WS_PTR(float, WS_SS) + (size_t)(5) * 8 * MROWS, 1.0f, (LAS float*)(lds + 131072)};
        pg8::gemm_phase<pg8::EpiRes, pg8::StaticOrder, true, true>(lds, g, S, E);
        skinny_res(WS_PTR(const bf16_t, WS_Y) + (size_t)MMAIN * DM, DM, g.Bt, WS_PTR(bf16_t, WS_HB), WS_PTR(float, WS_SSM) + (5) * 2048, 1.0f, lds);
    }
    SEAM();
    {
        PP Q = launder(P); const unsigned char* wl = Q->ws + WS_W + (size_t)1 * W_LAYER;
        pg8::Gemm g{WS_PTR(const bf16_t, WS_HB), (const bf16_t*)(wl + WO_GU2), MMAIN, NGU, DM}; pg8::StaticOrder S; S.init(MMAIN, NGU, (int)gridDim.x, lbid());
        pg8::EpiGU E{WS_PTR(bf16_t, WS_ACT), WS_PTR(const float, WS_SS) + (size_t)(5) * 8 * MROWS};
        pg8::gemm_phase<pg8::EpiGU, pg8::StaticOrder, true, true>(lds, g, S, E);
        skinny_gu(WS_PTR(const bf16_t, WS_HB), g.Bt, WS_PTR(const float, WS_SSM) + (5) * 2048, WS_PTR(bf16_t, WS_ACT), lds);
    }
    SEAM();
    {
        PP Q = launder(P); const unsigned char* wl = Q->ws + WS_W + (size_t)1 * W_LAYER;
        pg8::Gemm g{WS_PTR(const bf16_t, WS_ACT), (const bf16_t*)(wl + WO_D2), MMAIN, DM, DFF}; pg8::StaticOrder S; S.init(MMAIN, DM, (int)gridDim.x, lbid());
        pg8::EpiRes E{WS_PTR(bf16_t, WS_HB), WS_PTR(float, WS_SS) + (size_t)(6) * 8 * MROWS, 0.5f, (LAS float*)(lds + 131072)};
        pg8::gemm_phase<pg8::EpiRes, pg8::StaticOrder, true, true>(lds, g, S, E);
        skinny_res(WS_PTR(const bf16_t, WS_ACT) + (size_t)MMAIN * DFF, DFF, g.Bt, WS_PTR(bf16_t, WS_HB), WS_PTR(float, WS_SSM) + (6) * 2048, 0.5f, lds);
    }
    SEAM();
    {
        PP Q = launder(P); const unsigned char* wl = Q->ws + WS_W + (size_t)2 * W_LAYER;
        pg8::Gemm g{WS_PTR(const bf16_t, WS_HB), (const bf16_t*)(wl + WO_GU1), MMAIN, NGU, DM}; pg8::StaticOrder S; S.init(MMAIN, NGU, (int)gridDim.x, lbid());
        pg8::EpiGU E{WS_PTR(bf16_t, WS_ACT), WS_PTR(const float, WS_SS) + (size_t)(6) * 8 * MROWS};
        pg8::gemm_phase<pg8::EpiGU, pg8::StaticOrder, true, true>(lds, g, S, E);
        skinny_gu(WS_PTR(const bf16_t, WS_HB), g.Bt, WS_PTR(const float, WS_SSM) + (6) * 2048, WS_PTR(bf16_t, WS_ACT), lds);
    }
    SEAM();
    {
        PP Q = launder(P); const unsigned char* wl = Q->ws + WS_W + (size_t)2 * W_LAYER;
        pg8::Gemm g{WS_PTR(const bf16_t, WS_ACT), (const bf16_t*)(wl + WO_D1), MMAIN, DM, DFF}; pg8::StaticOrder S; S.init(MMAIN, DM, (int)gridDim.x, lbid());
        pg8::EpiRes E{WS_PTR(bf16_t, WS_HB), WS_PTR(float, WS_SS) + (size_t)(7) * 8 * MROWS, 0.5f, (LAS float*)(lds + 131072)};
        pg8::gemm_phase<pg8::EpiRes, pg8::StaticOrder, true, true>(lds, g, S, E);
        skinny_res(WS_PTR(const bf16_t, WS_ACT) + (size_t)MMAIN * DFF, DFF, g.Bt, WS_PTR(bf16_t, WS_HB), WS_PTR(float, WS_SSM) + (7) * 2048, 0.5f, lds);
    }
    SEAM();
    {
        PP Q = launder(P); const unsigned char* wl = Q->ws + WS_W + (size_t)2 * W_LAYER;
        pg8::Gemm g{WS_PTR(const bf16_t, WS_HB), (const bf16_t*)(wl + WO_IN), MMAIN, NIN, DM}; pg8::StaticOrder S; S.init(MMAIN, NIN, (int)gridDim.x, lbid());
        pg8::EpiP E{WS_PTR(bf16_t, WS_PR), WS_PTR(float, WS_PS), WS_PTR(bf16_t, WS_QKV), WS_PTR(const float, WS_SS) + (size_t)(7) * 8 * MROWS};
        pg8::gemm_phase<pg8::EpiP, pg8::StaticOrder, true, true>(lds, g, S, E);
        skinny_p(WS_PTR(const bf16_t, WS_HB), g.Bt, WS_PTR(const float, WS_SSM) + (7) * 2048, WS_PTR(bf16_t, WS_PR), WS_PTR(float, WS_PS), WS_PTR(bf16_t, WS_QKV), lds);
    }
    SEAM();
    {
        PP Q = launder(P); const int u = lbid();
        if (u < 128) rwkv_chunked(Q, 2, u >> 4, u & 15, lds);
        else { fox_wg(Q, 2, u - 128, (char*)lds_raw); __syncthreads(); phase_convert(launder(P), lds, 3, 4, u - 128, 128); }
    }
    SEAM();
    { PP Q = launder(P); phase_foxnorm(Q); }
    SEAM();
    {
        PP Q = launder(P); const unsigned char* wl = Q->ws + WS_W + (size_t)2 * W_LAYER;
        pg8::Gemm g{WS_PTR(const bf16_t, WS_Y), (const bf16_t*)(wl + WO_OUT), MMAIN, DM, DM}; pg8::StaticOrder S; S.init(MMAIN, DM, (int)gridDim.x, lbid());
        pg8::EpiRes E{WS_PTR(bf16_t, WS_HB), WS_PTR(float, WS_SS) + (size_t)(8) * 8 * MROWS, 1.0f, (LAS float*)(lds + 131072)};
        pg8::gemm_phase<pg8::EpiRes, pg8::StaticOrder, true, true>(lds, g, S, E);
        skinny_res(WS_PTR(const bf16_t, WS_Y) + (size_t)MMAIN * DM, DM, g.Bt, WS_PTR(bf16_t, WS_HB), WS_PTR(float, WS_SSM) + (8) * 2048, 1.0f, lds);
    }
    SEAM();
    {
        PP Q = launder(P); const unsigned char* wl = Q->ws + WS_W + (size_t)2 * W_LAYER;
        pg8::Gemm g{WS_PTR(const bf16_t, WS_HB), (const bf16_t*)(wl + WO_GU2), MMAIN, NGU, DM}; pg8::StaticOrder S; S.init(MMAIN, NGU, (int)gridDim.x, lbid());
        pg8::EpiGU E{WS_PTR(bf16_t, WS_ACT), WS_PTR(const float, WS_SS) + (size_t)(8) * 8 * MROWS};
        pg8::gemm_phase<pg8::EpiGU, pg8::StaticOrder, true, true>(lds, g, S, E);
        skinny_gu(WS_PTR(const bf16_t, WS_HB), g.Bt, WS_PTR(const float, WS_SSM) + (8) * 2048, WS_PTR(bf16_t, WS_ACT), lds);
    }
    SEAM();
    {
        PP Q = launder(P); const unsigned char* wl = Q->ws + WS_W + (size_t)2 * W_LAYER;
        pg8::Gemm g{WS_PTR(const bf16_t, WS_ACT), (const bf16_t*)(wl + WO_D2), MMAIN, DM, DFF}; pg8::StaticOrder S; S.init(MMAIN, DM, (int)gridDim.x, lbid());
        pg8::EpiRes E{WS_PTR(bf16_t, WS_HB), WS_PTR(float, WS_SS) + (size_t)(9) * 8 * MROWS, 0.5f, (LAS float*)(lds + 131072)};
        pg8::gemm_phase<pg8::EpiRes, pg8::StaticOrder, true, true>(lds, g, S, E);
        skinny_res(WS_PTR(const bf16_t, WS_ACT) + (size_t)MMAIN * DFF, DFF, g.Bt, WS_PTR(bf16_t, WS_HB), WS_PTR(float, WS_SSM) + (9) * 2048, 0.5f, lds);
    }
    SEAM();
    {
        PP Q = launder(P); const unsigned char* wl = Q->ws + WS_W + (size_t)3 * W_LAYER;
        pg8::Gemm g{WS_PTR(const bf16_t, WS_HB), (const bf16_t*)(wl + WO_GU1), MMAIN, NGU, DM}; pg8::StaticOrder S; S.init(MMAIN, NGU, (int)gridDim.x, lbid());
        pg8::EpiGU E{WS_PTR(bf16_t, WS_ACT), WS_PTR(const float, WS_SS) + (size_t)(9) * 8 * MROWS};
        pg8::gemm_phase<pg8::EpiGU, pg8::StaticOrder, true, true>(lds, g, S, E);
        skinny_gu(WS_PTR(const bf16_t, WS_HB), g.Bt, WS_PTR(const float, WS_SSM) + (9) * 2048, WS_PTR(bf16_t, WS_ACT), lds);
    }
    SEAM();
    {
        PP Q = launder(P); const unsigned char* wl = Q->ws + WS_W + (size_t)3 * W_LAYER;
        pg8::Gemm g{WS_PTR(const bf16_t, WS_ACT), (const bf16_t*)(wl + WO_D1), MMAIN, DM, DFF}; pg8::StaticOrder S; S.init(MMAIN, DM, (int)gridDim.x, lbid());
        pg8::EpiRes E{WS_PTR(bf16_t, WS_HB), WS_PTR(float, WS_SS) + (size_t)(10) * 8 * MROWS, 0.5f, (LAS float*)(lds + 131072)};
        pg8::gemm_phase<pg8::EpiRes, pg8::StaticOrder, true, true>(lds, g, S, E);
        skinny_res(WS_PTR(const bf16_t, WS_ACT) + (size_t)MMAIN * DFF, DFF, g.Bt, WS_PTR(bf16_t, WS_HB), WS_PTR(float, WS_SSM) + (10) * 2048, 0.5f, lds);
    }
    SEAM();
    {
        PP Q = launder(P); const unsigned char* wl = Q->ws + WS_W + (size_t)3 * W_LAYER;
        pg8::Gemm g{WS_PTR(const bf16_t, WS_HB), (const bf16_t*)(wl + WO_IN), MMAIN, NIN, DM}; pg8::StaticOrder S; S.init(MMAIN, NIN, (int)gridDim.x, lbid());
        pg8::EpiP E{WS_PTR(bf16_t, WS_PR), WS_PTR(float, WS_PS), WS_PTR(bf16_t, WS_QKV), WS_PTR(const float, WS_SS) + (size_t)(10) * 8 * MROWS};
        pg8::gemm_phase<pg8::EpiP, pg8::StaticOrder, true, true>(lds, g, S, E);
        skinny_p(WS_PTR(const bf16_t, WS_HB), g.Bt, WS_PTR(const float, WS_SSM) + (10) * 2048, WS_PTR(bf16_t, WS_PR), WS_PTR(float, WS_PS), WS_PTR(bf16_t, WS_QKV), lds);
    }
    SEAM();
    {
        PP Q = launder(P); const int u = lbid();
        if (u < 128) rwkv_chunked(Q, 3, u >> 4, u & 15, lds);
        else { fox_wg(Q, 3, u - 128, (char*)lds_raw);  }
    }
    SEAM();
    { PP Q = launder(P); phase_foxnorm(Q); }
    SEAM();
    {
        PP Q = launder(P); const unsigned char* wl = Q->ws + WS_W + (size_t)3 * W_LAYER;
        pg8::Gemm g{WS_PTR(const bf16_t, WS_Y), (const bf16_t*)(wl + WO_OUT), MMAIN, DM, DM}; pg8::StaticOrder S; S.init(MMAIN, DM, (int)gridDim.x, lbid());
        pg8::EpiRes E{WS_PTR(bf16_t, WS_HB), WS_PTR(float, WS_SS) + (size_t)(11) * 8 * MROWS, 1.0f, (LAS float*)(lds + 131072)};
        pg8::gemm_phase<pg8::EpiRes, pg8::StaticOrder, true, true>(lds, g, S, E);
        skinny_res(WS_PTR(const bf16_t, WS_Y) + (size_t)MMAIN * DM, DM, g.Bt, WS_PTR(bf16_t, WS_HB), WS_PTR(float, WS_SSM) + (11) * 2048, 1.0f, lds);
    }
    SEAM();
    {
        PP Q = launder(P); const unsigned char* wl = Q->ws + WS_W + (size_t)3 * W_LAYER;
        pg8::Gemm g{WS_PTR(const bf16_t, WS_HB), (const bf16_t*)(wl + WO_GU2), MMAIN, NGU, DM}; pg8::StaticOrder S; S.init(MMAIN, NGU, (int)gridDim.x, lbid());
        pg8::EpiGU E{WS_PTR(bf16_t, WS_ACT), WS_PTR(const float, WS_SS) + (size_t)(11) * 8 * MROWS};
        pg8::gemm_phase<pg8::EpiGU, pg8::StaticOrder, true, true>(lds, g, S, E);
        skinny_gu(WS_PTR(const bf16_t, WS_HB), g.Bt, WS_PTR(const float, WS_SSM) + (11) * 2048, WS_PTR(bf16_t, WS_ACT), lds);
    }
    SEAM();
    {
        PP Q = launder(P); const unsigned char* wl = Q->ws + WS_W + (size_t)3 * W_LAYER;
        pg8::Gemm g{WS_PTR(const bf16_t, WS_ACT), (const bf16_t*)(wl + WO_D2), MMAIN, DM, DFF}; pg8::StaticOrder S; S.init(MMAIN, DM, (int)gridDim.x, lbid());
        pg8::EpiRes E{WS_PTR(bf16_t, WS_HB), WS_PTR(float, WS_SS) + (size_t)(12) * 8 * MROWS, 0.5f, (LAS float*)(lds + 131072)};
        pg8::gemm_phase<pg8::EpiRes, pg8::StaticOrder, true, true>(lds, g, S, E);
        skinny_res(WS_PTR(const bf16_t, WS_ACT) + (size_t)MMAIN * DFF, DFF, g.Bt, WS_PTR(bf16_t, WS_HB), WS_PTR(float, WS_SSM) + (12) * 2048, 0.5f, lds);
    }
    SEAM();
    { PP Q = launder(P); phase_final(Q); }
}

extern "C" void kernel_launch(void* const* d_in, const int* in_sizes, int n_in, void* d_out, int out_size, void* d_ws, size_t ws_size, hipStream_t stream) {
    using namespace cfg;
    static int grid = 0;
    if (grid == 0) {
        if (n_in != 25 || out_size != MMAIN * DM || ws_size < WS_END) { fprintf(stderr, "kernel_launch: need 25 inputs, out %d, ws >= %zu; got n_in %d out %d ws %zu\n", MMAIN * DM, (size_t)WS_END, n_in, out_size, ws_size); grid = -1; return; }
        int dev = 0, cus = 0, per_cu = 0;
        if (hipGetDevice(&dev) != hipSuccess || hipDeviceGetAttribute(&cus, hipDeviceAttributeMultiprocessorCount, dev) != hipSuccess) { grid = -1; return; }
        if (hipFuncSetAttribute((const void*)hymba_fwd, hipFuncAttributeMaxDynamicSharedMemorySize, LDS_BYTES) != hipSuccess) { fprintf(stderr, "kernel_launch: hipFuncSetAttribute failed\n"); grid = -1; return; }
        if (hipOccupancyMaxActiveBlocksPerMultiprocessor(&per_cu, (const void*)hymba_fwd, 512, LDS_BYTES) != hipSuccess || per_cu < 1) fprintf(stderr, "kernel_launch: occupancy query says %d\n", per_cu);
        (void)hipGetLastError();
        if (cus < 256) { fprintf(stderr, "kernel_launch: built for a 256-CU device (one resident workgroup per CU), found %d CUs\n", cus); grid = -1; return; }
        grid = 256;
    }
    if (grid < 0) return;
    if (hipMemsetAsync((char*)d_ws + WS_CTL, 0, CTL_BYTES, stream) != hipSuccess) return;
    Params p{};
    for (int i = 0; i < 25; ++i) p.in[i] = (const float*)d_in[i];
    p.out = (float*)d_out; p.ws = (unsigned char*)d_ws; p.ph_lo = 0; p.ph_hi = 0;
    hipLaunchKernelGGL(hymba_fwd, dim3(grid), dim3(512), LDS_BYTES, stream, p);
}
```

```cpp
#include <hip/hip_runtime.h>
#include <hip/hip_bf16.h>
#include <cstdio>
#include <cstdint>

#define LAS __attribute__((address_space(3)))
namespace cfg {
constexpr int DM = 2048, NBATCH = 8, SEQ = 4096, NMETA = 16, DEPTH = 4;
constexpr int MMAIN = NBATCH * SEQ;
constexpr int MROWS = MMAIN + 256;
constexpr int DFF = 5632, NGU = 2 * DFF;
constexpr int RW = 1024, RH = 64, RNH = 16;
constexpr int FW = 1024, FH = 128, FNH = 8;
constexpr int RWKV_COLS = 3360, DIN = 6440;
constexpr int NIN = 6656;
constexpr int PRW = 3072, PSW = 512, QKVW = 3072;
constexpr int SEQP = 4160;
constexpr float NORM_EPS = 1e-6f, LNX_EPS = 64e-5f;
constexpr int NSS = 13;
constexpr size_t al256(size_t x) { return (x + 255) & ~(size_t)255; }
constexpr size_t WS_CTL = 0;
constexpr size_t CTL_BYTES = 65536;
constexpr size_t WS_SS = WS_CTL + CTL_BYTES;
constexpr size_t SS_BYTES = al256((size_t)NSS * 8 * MROWS * 4);
constexpr size_t ZERO_BYTES = CTL_BYTES + SS_BYTES;
constexpr size_t WS_SSM = WS_SS + SS_BYTES;
constexpr size_t SSM_BYTES = (size_t)NSS * 2048 * 4;
constexpr size_t WS_HMETA = WS_SSM + SSM_BYTES;
constexpr size_t WS_HB = WS_HMETA + (size_t)256 * DM * 4;
constexpr size_t WS_Y = WS_HB + (size_t)MROWS * DM * 2;
constexpr size_t WS_OVL = WS_Y + (size_t)MROWS * DM * 2;
constexpr size_t WS_ACT = WS_OVL;
constexpr size_t WS_PR = WS_OVL;
constexpr size_t WS_PS = WS_PR + (size_t)MROWS * PRW * 2;
constexpr size_t WS_QKV = WS_PS + (size_t)MROWS * PSW * 4;
constexpr size_t OVL_A = (size_t)MROWS * DFF * 2, OVL_B = (size_t)MROWS * PRW * 2 + (size_t)MROWS * PSW * 4 + (size_t)NBATCH * SEQP * QKVW * 2;
constexpr size_t WS_W = WS_OVL + al256(OVL_A > OVL_B ? OVL_A : OVL_B);
constexpr size_t W_GU = (size_t)NGU * DM * 2, W_D = (size_t)DM * DFF * 2, W_IN = (size_t)NIN * DM * 2, W_OUT = (size_t)DM * DM * 2;
constexpr size_t WO_GU1 = 0, WO_D1 = WO_GU1 + W_GU, WO_IN = WO_D1 + W_D, WO_OUT = WO_IN + W_IN, WO_GU2 = WO_OUT + W_OUT, WO_D2 = WO_GU2 + W_GU, W_LAYER = WO_D2 + W_D;
constexpr size_t WS_LXG = WS_W + (size_t)DEPTH * W_LAYER;
constexpr size_t WS_END = WS_LXG + (size_t)DEPTH * MROWS * 320 * 2;
constexpr int LDS_BYTES = 147456;
constexpr int LDS_BARW = LDS_BYTES - 16;
}
__device__ __forceinline__ int ltid() { int t = (int)threadIdx.x; asm volatile("" : "+v"(t)); return t; }
__device__ __forceinline__ int lbid() { int t = (int)blockIdx.x; asm volatile("" : "+s"(t)); return t; }
__device__ __forceinline__ int lzero() { int t = 0; asm volatile("" : "+v"(t)); return t; }
namespace pg8 {
#define PG8_LAS __attribute__((address_space(3)))
typedef unsigned short bf16_t;
typedef short bf16x8 __attribute__((ext_vector_type(8)));
typedef float f32x4 __attribute__((ext_vector_type(4)));
typedef unsigned u32x4 __attribute__((ext_vector_type(4)));
constexpr int BM = 256, BK = 64, HALF = 128, HTB = HALF * BK * 2  , STAGE_BYTES = 8 * HTB, NXCD = 8, WGM = 8;

__host__ __device__ __forceinline__ int lds_byte(int r, int c) { const int st = (r >> 4) * 2 + (c >> 5), rr = r & 15, cc = c & 31, ob = rr * 64 + cc * 2; return st * 1024 + (ob ^ (((ob >> 9) & 1) << 5)); }
__host__ __device__ __forceinline__ void stage_rc(int b, int& R, int& C) { const int st = b / 1024, sb = b % 1024, swz = sb ^ (((sb >> 9) & 1) << 5); R = (st >> 1) * 16 + swz / 64; C = (st & 1) * 32 + (swz % 64) / 2; }
__host__ __device__ __forceinline__ int perm32(int rho) { const int n = rho >> 4, i = rho & 15; return 8 * (i >> 2) + 4 * n + (i & 3); }

struct Unit { int pm, pn; };
struct Gemm { const bf16_t* A; const bf16_t* Bt; int M, N, K; };

struct StaticOrder {
    int nM, nN, nwg, G, c;
    __host__ __device__ void init(int M, int N, int G_, int c_) { nM = M / BM; nN = N / BM; nwg = nM * nN; G = G_; c = c_; }
    __host__ __device__ bool next(int i, Unit& u) const {
        const long L = (long)i * G + c; if (L >= nwg) return false;
        int wgid = (int)L; { const int q = nwg / NXCD, r = nwg % NXCD, xcd = wgid % NXCD, off = wgid / NXCD; wgid = (xcd < r ? xcd * (q + 1) : r * (q + 1) + (xcd - r) * q) + off; }
        const int nig = WGM * nN, gid = wgid / nig, fm = gid * WGM, gsz = (nM - fm) < WGM ? (nM - fm) : WGM;
        u.pm = fm + ((wgid % nig) % gsz); u.pn = (wgid % nig) / gsz; return true;
    }
    __device__ __forceinline__ void a_ready(const Unit&) const {}
    __device__ __forceinline__ void done(const Unit&) const {}
};

__device__ __forceinline__ unsigned cvt_pk_bf16(float lo, float hi) { unsigned r; asm volatile("v_cvt_pk_bf16_f32 %0, %1, %2" : "=v"(r) : "v"(lo), "v"(hi)); return r; }
typedef float f32x2 __attribute__((ext_vector_type(2)));
__device__ __forceinline__ f32x2 gelu_pk(f32x2 v) {
    const f32x2 av = __builtin_elementwise_abs(v), d = av * 0.2316418882f + 1.0f;
    f32x2 t; t.x = __builtin_amdgcn_rcpf(d.x); t.y = __builtin_amdgcn_rcpf(d.y);
    f32x2 q = t * 0.5307027145f + (-0.7265760135f); q = q * t + 0.7107068705f; q = q * t + (-0.142248368f); q = q * t + 0.127414796f; q = q * t;
    const f32x2 s = (v * v) * (-0.72134752044f);
    f32x2 e; e.x = __builtin_amdgcn_exp2f(s.x); e.y = __builtin_amdgcn_exp2f(s.y);
    const f32x2 m = v * (q * e), r = v - m;
    f32x2 o; o.x = v.x < 0.f ? m.x : r.x; o.y = v.y < 0.f ? m.y : r.y; return o;
}
__device__ __forceinline__ float rs_of(const float* ss, int row) { float s = 0.f;
#pragma unroll
    for (int t = 0; t < 8; ++t) s += ss[(size_t)t * 33024 + row];
    return __builtin_amdgcn_rsqf(s * (1.0f / 2048.0f) + 1e-6f); }
__device__ __forceinline__ float silu_f(float x) { return x * __builtin_amdgcn_rcpf(1.0f + __builtin_amdgcn_exp2f(-1.4426950408889634f * x)); }

struct EpiGU {
    static constexpr bool PERM = true, AFTER_DRAIN = false;
    bf16_t* act; const float* ss; PG8_LAS float* rsb;
    __device__ __forceinline__ void operator()(const f32x4 (&acc)[2][2][4][2], const Unit& u, int wr, int wc, int fr, int fq) const {
        if (wr == 0) { const int rl = wc * 64 + fq * 16 + fr; rsb[rl] = rs_of(ss, u.pm * BM + rl); }
        asm volatile("s_waitcnt lgkmcnt(0)" ::: "memory"); __builtin_amdgcn_s_barrier(); asm volatile("" ::: "memory");
        const int rl0 = wr * 64 + fr, row0 = u.pm * BM + rl0, col0 = u.pn * 128 + wc * 32 + 8 * fq;
#pragma unroll
        for (int ai = 0; ai < 2; ++ai)
#pragma unroll
            for (int m = 0; m < 4; ++m) { const int row = row0 + ai * HALF + m * 16; const float rs = rsb[rl0 + ai * HALF + m * 16];
                const f32x4 g0 = acc[ai][0][m][0] * rs, g1 = acc[ai][0][m][1] * rs, u0 = acc[ai][1][m][0] * rs, u1 = acc[ai][1][m][1] * rs;
                u32x4 w;
                w.x = cvt_pk_bf16(silu_f(g0[0]) * u0[0], silu_f(g0[1]) * u0[1]); w.y = cvt_pk_bf16(silu_f(g0[2]) * u0[2], silu_f(g0[3]) * u0[3]);
                w.z = cvt_pk_bf16(silu_f(g1[0]) * u1[0], silu_f(g1[1]) * u1[1]); w.w = cvt_pk_bf16(silu_f(g1[2]) * u1[2], silu_f(g1[3]) * u1[3]);
                *(u32x4*)(act + (size_t)row * 5632 + col0) = w; }
        asm volatile("s_waitcnt lgkmcnt(0)" ::: "memory"); __builtin_amdgcn_s_barrier(); asm volatile("" ::: "memory");
    }
};
struct EpiRes {
    static constexpr bool PERM = true, AFTER_DRAIN = false;
    bf16_t* hb; float* ssn; float alpha; PG8_LAS float* red;
    __device__ __forceinline__ void operator()(const f32x4 (&acc)[2][2][4][2], const Unit& u, int wr, int wc, int fr, int fq) const {
        bf16_t* bbase = hb + (size_t)u.pm * BM * 2048;
        const int rl0 = wr * 64 + fr; unsigned off = (unsigned)(rl0 * 2048 + u.pn * BM + wc * 32 + 8 * fq);
#pragma unroll
        for (int ai = 0; ai < 2; ++ai) {
            u32x4 hv[4][2];
#pragma unroll
            for (int m = 0; m < 4; ++m)
#pragma unroll
                for (int bj = 0; bj < 2; ++bj) hv[m][bj] = *(const u32x4*)(bbase + (off + (unsigned)((ai * HALF + m * 16) * 2048) + bj * HALF));
#pragma unroll
            for (int m = 0; m < 4; ++m) { const unsigned o = off + (unsigned)((ai * HALF + m * 16) * 2048); float sq = 0.f;
#pragma unroll
                for (int bj = 0; bj < 2; ++bj) { const u32x4 x = hv[m][bj];
                    const f32x4 h0 = (f32x4){__uint_as_float(x.x << 16), __uint_as_float(x.x & 0xffff0000u), __uint_as_float(x.y << 16), __uint_as_float(x.y & 0xffff0000u)} + acc[ai][bj][m][0] * alpha;
                    const f32x4 h1 = (f32x4){__uint_as_float(x.z << 16), __uint_as_float(x.z & 0xffff0000u), __uint_as_float(x.w << 16), __uint_as_float(x.w & 0xffff0000u)} + acc[ai][bj][m][1] * alpha;
                    sq += ((h0[0] * h0[0] + h0[1] * h0[1]) + (h0[2] * h0[2] + h0[3] * h0[3])) + ((h1[0] * h1[0] + h1[1] * h1[1]) + (h1[2] * h1[2] + h1[3] * h1[3]));
                    u32x4 w; w.x = cvt_pk_bf16(h0[0], h0[1]); w.y = cvt_pk_bf16(h0[2], h0[3]); w.z = cvt_pk_bf16(h1[0], h1[1]); w.w = cvt_pk_bf16(h1[2], h1[3]); *(u32x4*)(bbase + o + bj * HALF) = w; }
                sq += __shfl_xor(sq, 16); sq += __shfl_xor(sq, 32);
                if (fq == 0) red[(rl0 + ai * HALF + m * 16) * 4 + wc] = sq; }
            asm volatile("" ::: "memory"); }
        asm volatile("s_waitcnt lgkmcnt(0)" ::: "memory"); __builtin_amdgcn_s_barrier(); asm volatile("" ::: "memory");
        if (wr == 0) { const int row = wc * 64 + fq * 16 + fr; const float s4 = (red[row * 4] + red[row * 4 + 1]) + (red[row * 4 + 2] + red[row * 4 + 3]); ssn[(size_t)u.pn * 33024 + u.pm * BM + row] = s4; }
    }
};
struct EpiP {
    static constexpr bool PERM = true, AFTER_DRAIN = false;
    bf16_t* pr; float* ps; bf16_t* qkv; const float* ss; PG8_LAS float* rsb;
    __device__ __forceinline__ void operator()(const f32x4 (&acc)[2][2][4][2], const Unit& u, int wr, int wc, int fr, int fq) const {
        if (wr == 0) { const int rl = wc * 64 + fq * 16 + fr; rsb[rl] = rs_of(ss, u.pm * BM + rl); }
        asm volatile("s_waitcnt lgkmcnt(0)" ::: "memory"); __builtin_amdgcn_s_barrier(); asm volatile("" ::: "memory");
        const int rl0 = wr * 64 + fr, row0 = u.pm * BM + rl0, cl = wc * 32 + 8 * fq;
#pragma unroll
        for (int ai = 0; ai < 2; ++ai)
#pragma unroll
            for (int m = 0; m < 4; ++m) { const int row = row0 + ai * HALF + m * 16; const float rs = rsb[rl0 + ai * HALF + m * 16];
#pragma unroll
                for (int bj = 0; bj < 2; ++bj) { const f32x4 v0 = acc[ai][bj][m][0] * rs, v1 = acc[ai][bj][m][1] * rs;
                    if (u.pn >= 12 && u.pn < 14) { float* d = ps + (size_t)row * 512 + (u.pn - 12) * 256 + bj * HALF + cl; *(f32x4*)d = v0; *(f32x4*)(d + 4) = v1; }
                    else { u32x4 w; w.x = cvt_pk_bf16(v0[0], v0[1]); w.y = cvt_pk_bf16(v0[2], v0[3]); w.z = cvt_pk_bf16(v1[0], v1[1]); w.w = cvt_pk_bf16(v1[2], v1[3]);
                        if (u.pn < 12) *(u32x4*)(pr + (size_t)row * 3072 + u.pn * 256 + bj * HALF + cl) = w;
                        else { const int c = (u.pn - 14) * 256 + bj * HALF + cl;
                            const int b = row >> 12, s = row & 4095; *(u32x4*)(qkv + ((size_t)b * 4160 + 64 + s) * 3072 + c) = w; } } } }
        asm volatile("s_waitcnt lgkmcnt(0)" ::: "memory"); __builtin_amdgcn_s_barrier(); asm volatile("" ::: "memory");
    }
};
template <class Epi, class Sched, bool ALIGN_EPI = false, bool SP2 = false>
__device__ __forceinline__ void gemm_phase(PG8_LAS unsigned char* lds, const Gemm g, const Sched& S, const Epi& E) {
    const int tid = ltid(), wid = __builtin_amdgcn_readfirstlane(tid >> 6), lane = tid & 63, wr = wid >> 2, wc = wid & 3, fr = lane & 15, fq = lane >> 4;
    const int K = g.K, nt = K / BK;
    unsigned voffA[2], voffB[2];
#pragma unroll
    for (int i = 0; i < 2; ++i) { int R, C; stage_rc(tid * 16 + i * 8192, R, C); const int Rb = Epi::PERM ? ((R & ~31) + perm32(R & 31)) : R;
        voffA[i] = (unsigned)(R * K + C) * 2u; voffB[i] = (unsigned)(Rb * K + C) * 2u; }
    const size_t kstep = (size_t)(BK * 2);
    const size_t hstep = (size_t)HALF * K * 2;
    const size_t tstep = 2 * hstep;
    const unsigned ldsw = (unsigned)wid * 1024u;
    const int aoff = lds_byte(wr * 64 + fr, fq * 8), boff = lds_byte(wc * 32 + fr, fq * 8);
#define PG8_SA(b, h) (((b) * 2 + (h)) * HTB)
#define PG8_SB(b, h) ((4 + (b) * 2 + (h)) * HTB)
#define PG8_STAGE(bufoff, gbase, voff) do { _Pragma("unroll") for (int _i = 0; _i < 2; ++_i) \
        __builtin_amdgcn_global_load_lds((const unsigned*)((const char*)(gbase) + (voff)[_i]), (PG8_LAS unsigned*)(lds + (bufoff) + ldsw + _i * 8192), 16, 0, 0); } while (0)
#define PG8_LDA(dst, b, h) do { _Pragma("unroll") for (int m = 0; m < 4; ++m) _Pragma("unroll") for (int k = 0; k < 2; ++k) dst[m][k] = *(const PG8_LAS bf16x8*)(lds + PG8_SA(b, h) + aoff + m * 2048 + k * 1024); } while (0)
#define PG8_LDB(dst, b, h) do { _Pragma("unroll") for (int n = 0; n < 2; ++n) _Pragma("unroll") for (int k = 0; k < 2; ++k) dst[n][k] = *(const PG8_LAS bf16x8*)(lds + PG8_SB(b, h) + boff + n * 2048 + k * 1024); } while (0)
#define PG8_MMA(ai, bj, At, Bt) do { __builtin_amdgcn_s_setprio(1); _Pragma("unroll") for (int m = 0; m < 4; ++m) _Pragma("unroll") for (int n = 0; n < 2; ++n) _Pragma("unroll") for (int k = 0; k < 2; ++k) \
        acc[ai][bj][m][n] = __builtin_amdgcn_mfma_f32_16x16x32_bf16(Bt[n][k], At[m][k], acc[ai][bj][m][n], 0, 0, 0); __builtin_amdgcn_s_setprio(0); } while (0)
#define PG8_WAIT_V(n) asm volatile("s_waitcnt vmcnt(" #n ")" ::: "memory")
#define PG8_WAIT_L(n) asm volatile("s_waitcnt lgkmcnt(" #n ")" ::: "memory")
#define PG8_BAR __builtin_amdgcn_s_barrier()
#define PG8_SCHED __builtin_amdgcn_sched_barrier(0)
    Unit cur, nxt; int ui = 0;
    if (!S.next(0, cur)) return;
    f32x4 acc[2][2][4][2];
#pragma unroll
    for (int a = 0; a < 2; ++a)
#pragma unroll
        for (int b = 0; b < 2; ++b)
#pragma unroll
            for (int m = 0; m < 4; ++m)
#pragma unroll
                for (int n = 0; n < 2; ++n) acc[a][b][m][n] = (f32x4){0.f, 0.f, 0.f, 0.f};
    bf16x8 At[4][2], B0[2][2], B1[2][2];
    const char* cA = (const char*)g.A + (size_t)cur.pm * tstep; const char* cB = (const char*)g.Bt + (size_t)cur.pn * tstep;
    S.a_ready(cur);
    if constexpr (SP2) {
        PG8_STAGE(PG8_SB(0, 0), cB, voffB); PG8_STAGE(PG8_SB(0, 1), cB + hstep, voffB); PG8_STAGE(PG8_SA(0, 0), cA, voffA); PG8_STAGE(PG8_SA(0, 1), cA + hstep, voffA);
        if (wr == 1) PG8_BAR;
        PG8_WAIT_V(2); PG8_BAR;
        PG8_STAGE(PG8_SB(1, 0), cB + kstep, voffB); PG8_STAGE(PG8_SA(1, 0), cA + kstep, voffA); PG8_STAGE(PG8_SB(1, 1), cB + hstep + kstep, voffB);
        PG8_WAIT_V(6); PG8_BAR;
    } else {
        PG8_STAGE(PG8_SB(0, 0), cB, voffB); PG8_STAGE(PG8_SA(0, 0), cA, voffA); PG8_STAGE(PG8_SB(0, 1), cB + hstep, voffB); PG8_STAGE(PG8_SA(0, 1), cA + hstep, voffA);
        if (wr == 1) PG8_BAR;
        PG8_WAIT_V(4); PG8_BAR;
        PG8_STAGE(PG8_SB(1, 0), cB + kstep, voffB); PG8_STAGE(PG8_SA(1, 0), cA + kstep, voffA); PG8_STAGE(PG8_SB(1, 1), cB + hstep + kstep, voffB);
        PG8_WAIT_V(6); PG8_BAR;
    }
    for (;;) {
        const bool has_next = S.next(ui + 1, nxt);
        const char* nA = has_next ? (const char*)g.A + (size_t)nxt.pm * tstep : cA; const char* nB = has_next ? (const char*)g.Bt + (size_t)nxt.pn * tstep : cB;
        for (int t = 0; t < nt; t += 2) {
            const bool last = (t == nt - 2);
            const char* a1 = cA + (size_t)(t + 1) * kstep;
            const char* a2 = last ? nA : cA + (size_t)(t + 2) * kstep; const char* b2 = last ? nB : cB + (size_t)(t + 2) * kstep;
            const char* a3 = a2 + kstep; const char* b3 = b2 + kstep;
            if (last && has_next) S.a_ready(nxt);
            if constexpr (SP2) {
            PG8_LDB(B0, 0, 0); PG8_LDB(B1, 0, 1); PG8_SCHED; PG8_LDA(At, 0, 0); PG8_STAGE(PG8_SA(1, 1), a1 + hstep, voffA);
            PG8_WAIT_V(8); PG8_WAIT_L(0); PG8_BAR; PG8_MMA(0, 0, At, B0); PG8_MMA(0, 1, At, B1); PG8_BAR; PG8_SCHED;
            PG8_LDA(At, 0, 1); PG8_STAGE(PG8_SB(0, 0), b2, voffB); PG8_STAGE(PG8_SB(0, 1), b2 + hstep, voffB); PG8_STAGE(PG8_SA(0, 0), a2, voffA);
            PG8_WAIT_V(8); PG8_WAIT_L(0); PG8_BAR; PG8_MMA(1, 0, At, B0); PG8_MMA(1, 1, At, B1); PG8_BAR; PG8_SCHED;
            PG8_LDB(B0, 1, 0); PG8_LDB(B1, 1, 1); PG8_SCHED; PG8_LDA(At, 1, 0); PG8_STAGE(PG8_SA(0, 1), a2 + hstep, voffA);
            PG8_WAIT_V(8); PG8_WAIT_L(0); PG8_BAR; PG8_MMA(0, 0, At, B0); PG8_MMA(0, 1, At, B1); PG8_BAR; PG8_SCHED;
            PG8_LDA(At, 1, 1); PG8_STAGE(PG8_SB(1, 0), b3, voffB); PG8_STAGE(PG8_SB(1, 1), b3 + hstep, voffB); PG8_STAGE(PG8_SA(1, 0), a3, voffA);
            PG8_WAIT_V(8); PG8_WAIT_L(0); PG8_BAR; PG8_MMA(1, 0, At, B0); PG8_MMA(1, 1, At, B1); PG8_BAR; PG8_SCHED;
            } else {
            PG8_LDB(B0, 0, 0); PG8_SCHED; PG8_LDA(At, 0, 0); PG8_STAGE(PG8_SA(1, 1), a1 + hstep, voffA);
            PG8_WAIT_L(8); PG8_BAR; PG8_WAIT_L(0); PG8_MMA(0, 0, At, B0); PG8_BAR; PG8_SCHED;
            PG8_LDB(B1, 0, 1); PG8_STAGE(PG8_SB(0, 0), b2, voffB);
            PG8_BAR; PG8_WAIT_L(0); PG8_MMA(0, 1, At, B1); PG8_BAR;
            PG8_LDA(At, 0, 1); PG8_STAGE(PG8_SA(0, 0), a2, voffA);
            PG8_BAR; PG8_WAIT_L(0); PG8_MMA(1, 0, At, B0); PG8_BAR; PG8_SCHED;
            PG8_STAGE(PG8_SB(0, 1), b2 + hstep, voffB);
            PG8_WAIT_V(6); PG8_BAR; PG8_MMA(1, 1, At, B1); PG8_BAR;
            PG8_LDB(B0, 1, 0); PG8_SCHED; PG8_LDA(At, 1, 0); PG8_STAGE(PG8_SA(0, 1), a2 + hstep, voffA);
            PG8_WAIT_L(8); PG8_BAR; PG8_WAIT_L(0); PG8_MMA(0, 0, At, B0); PG8_BAR; PG8_SCHED;
            PG8_LDB(B1, 1, 1); PG8_STAGE(PG8_SB(1, 0), b3, voffB);
            PG8_BAR; PG8_WAIT_L(0); PG8_MMA(0, 1, At, B1); PG8_BAR;
            PG8_LDA(At, 1, 1); PG8_STAGE(PG8_SA(1, 0), a3, voffA);
            PG8_BAR; PG8_WAIT_L(0); PG8_MMA(1, 0, At, B0); PG8_BAR; PG8_SCHED;
            PG8_STAGE(PG8_SB(1, 1), b3 + hstep, voffB);
            PG8_WAIT_V(6); PG8_BAR; PG8_MMA(1, 1, At, B1); PG8_BAR;
            }
        }
        if constexpr (ALIGN_EPI) { if (wr == 0) PG8_BAR; }
        if constexpr (!Epi::AFTER_DRAIN) { E(acc, cur, wr, wc, fr, fq); S.done(cur); }
        if (!has_next) break;
#pragma unroll
        for (int a = 0; a < 2; ++a)
#pragma unroll
            for (int b = 0; b < 2; ++b)
#pragma unroll
                for (int m = 0; m < 4; ++m)
#pragma unroll
                    for (int n = 0; n < 2; ++n) acc[a][b][m][n] = (f32x4){0.f, 0.f, 0.f, 0.f};
        cur = nxt; cA = nA; cB = nB; ++ui;
        if constexpr (ALIGN_EPI) { if (wr == 1) PG8_BAR; }
    }
    PG8_WAIT_V(0);
    if constexpr (!ALIGN_EPI) { if (wr == 0) PG8_BAR; }
    PG8_BAR;
    if constexpr (Epi::AFTER_DRAIN) { E.fused(acc, cur, wr, wc, fr, fq, lds, wid, lane); S.done(cur); }
#undef PG8_SA
#undef PG8_SB
#undef PG8_STAGE
#undef PG8_LDA
#undef PG8_LDB
#undef PG8_MMA
#undef PG8_WAIT_V
#undef PG8_WAIT_L
#undef PG8_BAR
#undef PG8_SCHED
}
}


#define XB_TMO      128
#define XB_XCNT(j)  (256  + 64 * (j))
#define XB_XSUB(j)  (1280 + 64 * (j))
#define XB_XGEN(j)  (2304 + 64 * (j))
#define XB_TOP      3328
#define XB_TOPGEN   3392
#define XCD_BAR_WORDS 3456
#define XB_SPIN_CAP (1u << 22)

__device__ __forceinline__ unsigned xb_ld(unsigned* p)              { return __hip_atomic_load(p, __ATOMIC_RELAXED, __HIP_MEMORY_SCOPE_AGENT); }
__device__ __forceinline__ unsigned xb_add(unsigned* p, unsigned v) { return __hip_atomic_fetch_add(p, v, __ATOMIC_RELAXED, __HIP_MEMORY_SCOPE_AGENT); }
__device__ __forceinline__ unsigned xb_xcc_id() { return (unsigned)__builtin_amdgcn_s_getreg((3 << 11) | 20) & 0xFu; }
#define XB_SPIN(cond, bar) do { unsigned _sp = 0; while (cond) { __builtin_amdgcn_s_sleep(1); \
    if ((++_sp & 255u) == 0u) { if (xb_ld(&(bar)[XB_TMO])) break; if (_sp > XB_SPIN_CAP) { atomicAdd(&(bar)[XB_TMO], 1u); break; } } } } while (0)

struct XcdBarrier {
    unsigned* bar; unsigned x;
    volatile LAS unsigned* st;
};

__device__ __forceinline__ XcdBarrier xcd_barrier_post(unsigned* bar, volatile LAS unsigned* st) {
    XcdBarrier b; b.bar = bar; b.x = xb_xcc_id(); b.st = st;
    if (threadIdx.x == 0) (void)xb_add(&bar[XB_XCNT(b.x)], 1u);
    return b;
}
__device__ __forceinline__ void xcd_barrier_complete(unsigned* bar, unsigned x, unsigned& nloc, unsigned& nx) {
    const unsigned G = gridDim.x * gridDim.y * gridDim.z;
    unsigned sum, cnt, mine, sp = 0u;
    for (;;) {
        sum = 0u; cnt = 0u; mine = 0u;
#pragma unroll
        for (unsigned j = 0; j < 16; ++j) { const unsigned c = xb_ld(&bar[XB_XCNT(j)]); sum += c; cnt += (c > 0u) ? 1u : 0u; mine = (j == x) ? c : mine; }
        if (sum == G) break;
        __builtin_amdgcn_s_sleep(1);
        if ((++sp & 255u) == 0u) { if (xb_ld(&bar[XB_TMO])) break; if (sp > XB_SPIN_CAP) { atomicAdd(&bar[XB_TMO], 1u); break; } }
    }
    nloc = mine > 0u ? mine : 1u; nx = cnt > 0u ? cnt : 1u;
}

__device__ __forceinline__ void xcd_barrier(const XcdBarrier& b) {
    asm volatile("s_waitcnt vmcnt(0)" ::: "memory");
    __syncthreads();
    if (threadIdx.x == 0) {
        unsigned* bar = b.bar;
        __builtin_amdgcn_s_waitcnt(0);
        unsigned nloc = b.st[0], nx = b.st[1];
        if (nloc == 0u) { xcd_barrier_complete(bar, b.x, nloc, nx); b.st[0] = nloc; b.st[1] = nx; }
        const unsigned old = xb_add(&bar[XB_XSUB(b.x)], 1u);
        const unsigned gen = old / nloc;
        if (old + 1u == (gen + 1u) * nloc) {
            __builtin_amdgcn_fence(__ATOMIC_RELEASE, "agent");
            asm volatile("s_waitcnt vmcnt(0)" ::: "memory");
            const unsigned og = xb_add(&bar[XB_TOP], 1u);
            const unsigned tg = og / nx;
            if (og + 1u == (tg + 1u) * nx) xb_add(&bar[XB_TOPGEN], 1u);
            else XB_SPIN(xb_ld(&bar[XB_TOPGEN]) == tg, bar);
            __builtin_amdgcn_fence(__ATOMIC_ACQUIRE, "agent");
            xb_add(&bar[XB_XGEN(b.x)], 1u);
            asm volatile("s_waitcnt vmcnt(0)" ::: "memory");
        } else {
            XB_SPIN(xb_ld(&bar[XB_XGEN(b.x)]) == gen, bar);
            __builtin_amdgcn_fence(__ATOMIC_ACQUIRE, "agent");
            asm volatile("s_waitcnt vmcnt(0)" ::: "memory");
        }
    }
    __syncthreads();
}


typedef unsigned short bf16_t;
typedef float f32x4 __attribute__((ext_vector_type(4)));
typedef unsigned u32x4 __attribute__((ext_vector_type(4)));
typedef unsigned u32x2 __attribute__((ext_vector_type(2)));
struct Params { const float* in[25]; float* out; unsigned char* ws; int ph_lo, ph_hi; };
#define CAS __attribute__((address_space(4)))
typedef const CAS Params* PP;
__device__ __forceinline__ PP launder(PP p) { asm volatile("" : "+s"(p)); return p; }
enum { I_X = 0, I_META, I_F1N, I_F1GU, I_F1D, I_MIXN, I_WIN, I_MU, I_W0, I_WUP, I_A0, I_AUP, I_GUP, I_KK, I_KA, I_RK, I_LNW, I_LNB, I_BF, I_FON, I_WOUT, I_F2N, I_F2GU, I_F2D, I_FINN };

typedef float f32x2_t __attribute__((ext_vector_type(2))); typedef __bf16 bf16x2v_t __attribute__((ext_vector_type(2)));
__device__ __forceinline__ unsigned pk_bf16(float lo, float hi) { f32x2_t v = {lo, hi}; bf16x2v_t b = __builtin_convertvector(v, bf16x2v_t); return __builtin_bit_cast(unsigned, b); }
__device__ __forceinline__ float bf2f(bf16_t b) { return __uint_as_float(((unsigned)b) << 16); }
__device__ __forceinline__ float wave_sum(float v) {
#pragma unroll
    for (int o = 32; o >= 1; o >>= 1) v += __shfl_xor(v, o);
    return v; }
__device__ __forceinline__ float wave_max(float v) {
#pragma unroll
    for (int o = 32; o >= 1; o >>= 1) v = fmaxf(v, __shfl_xor(v, o));
    return v; }
__device__ __forceinline__ float sigmoid_f(float x) { return __builtin_amdgcn_rcpf(1.0f + __expf(-x)); }

__device__ __forceinline__ void convert_tile(const float* __restrict__ src, bf16_t* __restrict__ dst, const float* __restrict__ gain, int K, int Nsrc, int kind, int tk, int tn, LAS float* T) {
    const int tid = ltid();
    {
        const int nl = (tid & 15) * 4, np = tn * 64 + nl; int sc;
        if (kind == 1) { const int pn = np >> 8, bj = (np >> 7) & 1, i = np & 127; sc = bj * cfg::DFF + pn * 128 + i; }
        else if (kind == 2) { sc = np < 3360 ? np : (np < 3368 ? 6432 + (np - 3360) : (np < 3584 ? -1 : 3360 + (np - 3584))); }
        else sc = np;
#pragma unroll
        for (int i = 0; i < 2; ++i) { const int kl = (tid >> 4) + 32 * i, k = tk * 64 + kl;
            f32x4 v = (f32x4){0.f, 0.f, 0.f, 0.f};
            if (sc >= 0) v = *(const f32x4*)(src + (size_t)k * Nsrc + sc);
            float g = 1.f; if (kind == 1 || kind == 2) g = gain[k]; else if (kind == 3) g = (k >= 1024) ? gain[k - 1024] : 1.f;
            T[kl * 65 + nl] = v[0] * g; T[kl * 65 + nl + 1] = v[1] * g; T[kl * 65 + nl + 2] = v[2] * g; T[kl * 65 + nl + 3] = v[3] * g; }
    }
    __syncthreads();
    {
        const int nl = tid >> 3, k8 = (tid & 7) * 8; u32x4 w;
        w.x = pk_bf16(T[(k8 + 0) * 65 + nl], T[(k8 + 1) * 65 + nl]); w.y = pk_bf16(T[(k8 + 2) * 65 + nl], T[(k8 + 3) * 65 + nl]);
        w.z = pk_bf16(T[(k8 + 4) * 65 + nl], T[(k8 + 5) * 65 + nl]); w.w = pk_bf16(T[(k8 + 6) * 65 + nl], T[(k8 + 7) * 65 + nl]);
        *(u32x4*)(dst + (size_t)(tn * 64 + nl) * K + tk * 64 + k8) = w;
    }
    __syncthreads();
}
__device__ __forceinline__ void phase_convert(PP P, LAS unsigned char* lds, int l0, int l1, int first, int nwg, int t0 = 0, int t1 = 0) {
    using namespace cfg;
    LAS float* T = (LAS float*)lds;
    constexpr int T_GU = (DM / 64) * (NGU / 64), T_D = (DFF / 64) * (DM / 64), T_IN = (DM / 64) * (NIN / 64), T_OUT = (DM / 64) * (DM / 64);
    constexpr int T_LAYER = 2 * T_GU + 2 * T_D + T_IN + T_OUT;
    if (t1 <= 0) t1 = T_LAYER;
    for (int t = l0 * T_LAYER + first; t < l1 * T_LAYER; t += nwg) {
        const int l = t / T_LAYER; int r = t - l * T_LAYER; if (r < t0 || r >= t1) continue;
        bf16_t* wl = (bf16_t*)(P->ws + WS_W + (size_t)l * W_LAYER);
        const float* src; bf16_t* dst; const float* gain = nullptr; int K, Nsrc, kind, ntn;
        if (r < T_GU) { src = P->in[I_F1GU] + (size_t)l * DM * NGU; dst = (bf16_t*)((unsigned char*)wl + WO_GU1); gain = P->in[I_F1N] + l * DM; K = DM; Nsrc = NGU; kind = 1; ntn = NGU / 64; }
        else if ((r -= T_GU) < T_D) { src = P->in[I_F1D] + (size_t)l * DFF * DM; dst = (bf16_t*)((unsigned char*)wl + WO_D1); K = DFF; Nsrc = DM; kind = 0; ntn = DM / 64; }
        else if ((r -= T_D) < T_IN) { src = P->in[I_WIN] + (size_t)l * DM * DIN; dst = (bf16_t*)((unsigned char*)wl + WO_IN); gain = P->in[I_MIXN] + l * DM; K = DM; Nsrc = DIN; kind = 2; ntn = NIN / 64; }
        else if ((r -= T_IN) < T_OUT) { src = P->in[I_WOUT] + (size_t)l * DM * DM; dst = (bf16_t*)((unsigned char*)wl + WO_OUT); gain = P->in[I_FON] + l * FW; K = DM; Nsrc = DM; kind = 3; ntn = DM / 64; }
        else if ((r -= T_OUT) < T_GU) { src = P->in[I_F2GU] + (size_t)l * DM * NGU; dst = (bf16_t*)((unsigned char*)wl + WO_GU2); gain = P->in[I_F2N] + l * DM; K = DM; Nsrc = NGU; kind = 1; ntn = NGU / 64; }
        else { r -= T_GU; src = P->in[I_F2D] + (size_t)l * DFF * DM; dst = (bf16_t*)((unsigned char*)wl + WO_D2); K = DFF; Nsrc = DM; kind = 0; ntn = DM / 64; }
        convert_tile(src, dst, gain, K, Nsrc, kind, r / ntn, r % ntn, T);
    }
}
__device__ __forceinline__ void phase_init(PP P) {
    using namespace cfg;
    const int lane = ltid() & 63, gw = lbid() * 8 + (ltid() >> 6), nw = gridDim.x * 8;
    bf16_t* hb = (bf16_t*)(P->ws + WS_HB); float* ss0 = (float*)(P->ws + WS_SS);
    for (int row = gw; row < MROWS; row += nw) {
        const float* s = row < MMAIN ? P->in[I_X] + (size_t)row * DM : P->in[I_META] + (size_t)(row - MMAIN) * DM;
        float sq = 0.f;
#pragma unroll
        for (int i = 0; i < 4; ++i) { f32x4 v0 = (f32x4){0.f, 0.f, 0.f, 0.f}, v1 = v0; if (row < MMAIN + NMETA) { v0 = *(const f32x4*)(s + i * 512 + lane * 8); v1 = *(const f32x4*)(s + i * 512 + lane * 8 + 4); }
            sq += ((v0[0] * v0[0] + v0[1] * v0[1]) + (v0[2] * v0[2] + v0[3] * v0[3])) + ((v1[0] * v1[0] + v1[1] * v1[1]) + (v1[2] * v1[2] + v1[3] * v1[3]));
            u32x4 w; w.x = pk_bf16(v0[0], v0[1]); w.y = pk_bf16(v0[2], v0[3]); w.z = pk_bf16(v1[0], v1[1]); w.w = pk_bf16(v1[2], v1[3]); *(u32x4*)(hb + (size_t)row * DM + i * 512 + lane * 8) = w; }
        sq = wave_sum(sq);
        if (lane < 8) ss0[(size_t)lane * MROWS + row] = lane == 0 ? sq : 0.f;
        if (row >= MMAIN && row < MMAIN + NMETA) { float* ssm0 = (float*)(P->ws + WS_SSM); ssm0[lane * 16 + (row - MMAIN)] = lane == 0 ? sq : 0.f; ssm0[(64 + lane) * 16 + (row - MMAIN)] = 0.f; }
    }
}
__device__ __forceinline__ void phase_foxnorm(PP P) {
    using namespace cfg;
    const int lane = ltid() & 63, gw = lbid() * 8 + (ltid() >> 6), nw = gridDim.x * 8;
    bf16_t* y = (bf16_t*)(P->ws + WS_Y);
    for (int row = gw; row < MMAIN + NMETA; row += nw) {
        bf16_t* p = y + (size_t)row * DM + 1024 + lane * 16;
        u32x4 a = *(const u32x4*)p, b = *(const u32x4*)(p + 8); float v[16];
#pragma unroll
        for (int i = 0; i < 4; ++i) { v[2 * i] = __uint_as_float(a[i] << 16); v[2 * i + 1] = __uint_as_float(a[i] & 0xffff0000u); v[8 + 2 * i] = __uint_as_float(b[i] << 16); v[8 + 2 * i + 1] = __uint_as_float(b[i] & 0xffff0000u); }
        float sq = 0.f;
#pragma unroll
        for (int i = 0; i < 16; ++i) sq += v[i] * v[i];
        sq = wave_sum(sq); const float rs = __builtin_amdgcn_rsqf(sq * (1.0f / 1024.0f) + NORM_EPS);
#pragma unroll
        for (int i = 0; i < 4; ++i) { a[i] = pk_bf16(v[2 * i] * rs, v[2 * i + 1] * rs); b[i] = pk_bf16(v[8 + 2 * i] * rs, v[8 + 2 * i + 1] * rs); }
        *(u32x4*)p = a; *(u32x4*)(p + 8) = b;
    }
}
__device__ __forceinline__ void phase_final(PP P) {
    using namespace cfg;
    const int lane = ltid() & 63, gw = lbid() * 8 + (ltid() >> 6), nw = gridDim.x * 8;
    const float* g = P->in[I_FINN]; const bf16_t* hb = (const bf16_t*)(P->ws + WS_HB);
    for (int row = gw; row < MMAIN; row += nw) {
        float* d = P->out + (size_t)row * DM; f32x4 v[8]; float sq = 0.f;
#pragma unroll
        for (int i = 0; i < 4; ++i) { const u32x4 x = *(const u32x4*)(hb + (size_t)row * DM + i * 512 + lane * 8);
            v[2 * i] = (f32x4){__uint_as_float(x.x << 16), __uint_as_float(x.x & 0xffff0000u), __uint_as_float(x.y << 16), __uint_as_float(x.y & 0xffff0000u)};
            v[2 * i + 1] = (f32x4){__uint_as_float(x.z << 16), __uint_as_float(x.z & 0xffff0000u), __uint_as_float(x.w << 16), __uint_as_float(x.w & 0xffff0000u)}; }
#pragma unroll
        for (int i = 0; i < 8; ++i) sq += (v[i][0] * v[i][0] + v[i][1] * v[i][1]) + (v[i][2] * v[i][2] + v[i][3] * v[i][3]);
        sq = wave_sum(sq); const float rs = __builtin_amdgcn_rsqf(sq * (1.0f / 2048.0f) + NORM_EPS);
#pragma unroll
        for (int i = 0; i < 4; ++i) { const f32x4 g0 = *(const f32x4*)(g + i * 512 + lane * 8), g1 = *(const f32x4*)(g + i * 512 + lane * 8 + 4);
            *(f32x4*)(d + i * 512 + lane * 8) = v[2 * i] * rs * g0; *(f32x4*)(d + i * 512 + lane * 8 + 4) = v[2 * i + 1] * rs * g1; }
    }
}

__device__ __forceinline__ void phase_lx(PP P, int l) {
    using namespace cfg;
    const int lane = ltid() & 63, gw = lbid() * 8 + (ltid() >> 6), nw = gridDim.x * 8;
    const float* PS = (const float*)(P->ws + WS_PS); bf16_t* LXG = (bf16_t*)(P->ws + WS_LXG) + (size_t)l * MROWS * 320; const float* mu = P->in[I_MU] + l * RWKV_COLS + 3072;
    if (lane < 36) {
        const f32x4 m0 = *(const f32x4*)(mu + lane * 8), m1 = *(const f32x4*)(mu + lane * 8 + 4);
        for (int row = gw; row < MMAIN + NMETA; row += nw) {
            int prev; if (row >= MMAIN) prev = (row == MMAIN) ? -1 : row - 1; else prev = ((row & (SEQ - 1)) == 0) ? MMAIN + NMETA - 1 : row - 1;
            const f32x4 c0 = *(const f32x4*)(PS + (size_t)row * PSW + lane * 8), c1 = *(const f32x4*)(PS + (size_t)row * PSW + lane * 8 + 4);
            f32x4 p0 = (f32x4){0.f, 0.f, 0.f, 0.f}, p1 = p0; if (prev >= 0) { p0 = *(const f32x4*)(PS + (size_t)prev * PSW + lane * 8); p1 = *(const f32x4*)(PS + (size_t)prev * PSW + lane * 8 + 4); }
            float x[8];
#pragma unroll
            for (int j = 0; j < 4; ++j) { x[j] = c0[j] + (p0[j] - c0[j]) * m0[j]; x[4 + j] = c1[j] + (p1[j] - c1[j]) * m1[j]; }
#pragma unroll
            for (int j = 0; j < 8; ++j) x[j] = lane < 8 ? 1.0f - 2.0f * __builtin_amdgcn_rcpf(__expf(2.0f * x[j]) + 1.0f) : (lane < 16 ? x[j] : __builtin_amdgcn_rcpf(1.0f + __expf(-x[j])));
            u32x4 w; w.x = pk_bf16(x[0], x[1]); w.y = pk_bf16(x[2], x[3]); w.z = pk_bf16(x[4], x[5]); w.w = pk_bf16(x[6], x[7]);
            *(u32x4*)(LXG + (size_t)row * 320 + lane * 8) = w;
        }
    }
}

__device__ __forceinline__ void rwkv_simple(PP P, int l, int b, int h, LAS unsigned char* lds) {
    using namespace cfg;
    const int tid = ltid(), lane = tid & 63, wave = tid >> 6;
    LAS bf16_t* WUP = (LAS bf16_t*)lds; LAS bf16_t* AUP = WUP + 4096; LAS bf16_t* GUP = AUP + 4096;
    LAS float* RAW = (LAS float*)(lds + 36864); LAS float* LX = RAW + 17 * 480; LAS float* Rm = LX + 16 * 288;
    LAS float* Wm = Rm + 1024; LAS float* KPm = Wm + 1024; LAS float* Vm = KPm + 1024; LAS float* Am = Vm + 1024; LAS float* Bm = Am + 1024; LAS float* Gm = Bm + 1024;
    LAS float* BON = Gm + 1024; LAS float* YR = BON + 16;
    const bf16_t* PR = (const bf16_t*)(P->ws + WS_PR); const float* PS = (const float*)(P->ws + WS_PS); bf16_t* Y = (bf16_t*)(P->ws + WS_Y);
    const float* mu = P->in[I_MU] + l * RWKV_COLS;
    for (int e = tid; e < 64 * 64; e += 512) { const int i = e >> 6, j = e & 63;
        WUP[e] = (bf16_t)(pk_bf16(P->in[I_WUP][((size_t)l * 64 + i) * RW + h * 64 + j], 0.f) & 0xffffu);
        AUP[e] = (bf16_t)(pk_bf16(P->in[I_AUP][((size_t)l * 64 + i) * RW + h * 64 + j], 0.f) & 0xffffu); }
    for (int e = tid; e < 160 * 64; e += 512) { const int i = e >> 6, j = e & 63; GUP[e] = (bf16_t)(pk_bf16(P->in[I_GUP][((size_t)l * 160 + i) * RW + h * 64 + j], 0.f) & 0xffffu); }
    for (int e = tid; e < 480; e += 512) RAW[e] = 0.f;
    const int hj = h * 64 + lane;
    const float w0 = P->in[I_W0][l * RW + hj], a0 = P->in[I_A0][l * RW + hj], kkw = P->in[I_KK][l * RW + hj], kaw = P->in[I_KA][l * RW + hj], rkw = P->in[I_RK][l * RW + hj];
    const float lnw = P->in[I_LNW][l * RW + hj], lnb = P->in[I_LNB][l * RW + hj];
    const float mur = mu[hj], muk = mu[1024 + hj], muv = mu[2048 + hj];
    float S[16];
#pragma unroll
    for (int j = 0; j < 16; ++j) S[j] = 0.f;
    __syncthreads();
    for (int c = 0; c < 257; ++c) {
        const int row0 = (c == 0) ? MMAIN : b * SEQ + (c - 1) * 16;
        for (int e = tid; e < 16 * 480; e += 512) { const int t = e / 480, cc = e - t * 480; const int row = row0 + t; float v;
            if (cc < 192) v = bf2f(PR[(size_t)row * PRW + (cc >> 6) * 1024 + h * 64 + (cc & 63)]); else v = PS[(size_t)row * PSW + (cc - 192)];
            RAW[(t + 1) * 480 + cc] = v; }
        __syncthreads();
        for (int e = tid; e < 16 * 288; e += 512) { const int t = e / 288, i = e - t * 288; const float cur = RAW[(t + 1) * 480 + 192 + i], prv = RAW[t * 480 + 192 + i];
            const float x = cur + (prv - cur) * mu[3072 + i];
            LX[e] = i < 64 ? tanhf(x) : (i < 128 ? x : sigmoid_f(x)); }
        __syncthreads();
#pragma unroll 1
        for (int rep = 0; rep < 2; ++rep) { const int t = wave + 8 * rep;
            float aw = w0, aa = a0, ag = 0.f;
            for (int i = 0; i < 64; ++i) { aw += LX[t * 288 + i] * bf2f(WUP[i * 64 + lane]); aa += LX[t * 288 + 64 + i] * bf2f(AUP[i * 64 + lane]); }
            for (int i = 0; i < 160; ++i) ag += LX[t * 288 + 128 + i] * bf2f(GUP[i * 64 + lane]);
            const float sp = (aw < 0.f ? -aw : 0.f) + log1pf(__expf(-fabsf(aw)));
            const float dec = __expf(-__expf(-sp - 0.5f));
            const float alr = sigmoid_f(aa);
            const float rc = RAW[(t + 1) * 480 + lane], rp = RAW[t * 480 + lane]; const float r = rc + (rp - rc) * mur;
            const float kc = RAW[(t + 1) * 480 + 64 + lane], kp = RAW[t * 480 + 64 + lane]; const float k = kc + (kp - kc) * muk;
            const float vc = RAW[(t + 1) * 480 + 128 + lane], vp = RAW[t * 480 + 128 + lane]; const float v = vc + (vp - vc) * muv;
            const float kkr = k * kkw; const float nrm = sqrtf(wave_sum(kkr * kkr)); const float kk = kkr / fmaxf(nrm, 1e-12f);
            const float kmod = k * (1.0f + (alr - 1.0f) * kaw);
            const float bon = wave_sum(r * kmod * rkw);
            Rm[t * 64 + lane] = r; Wm[t * 64 + lane] = dec; KPm[t * 64 + lane] = kmod; Vm[t * 64 + lane] = v; Am[t * 64 + lane] = -kk; Bm[t * 64 + lane] = kk * alr; Gm[t * 64 + lane] = ag;
            if (lane == 0) BON[t] = bon; }
        __syncthreads();
        for (int e = tid; e < 480; e += 512) RAW[e] = RAW[16 * 480 + e];
        if (wave < 4) { const int vrow = 16 * wave + (lane & 15), q = lane >> 4;
#pragma unroll 1
            for (int t = 0; t < 16; ++t) { float a[16], w[16], bb[16], kk[16], rr[16];
#pragma unroll
                for (int g = 0; g < 4; ++g) { const f32x4 av = *(const LAS f32x4*)(Am + t * 64 + 16 * q + 4 * g), wv = *(const LAS f32x4*)(Wm + t * 64 + 16 * q + 4 * g), bv = *(const LAS f32x4*)(Bm + t * 64 + 16 * q + 4 * g),
                        kv = *(const LAS f32x4*)(KPm + t * 64 + 16 * q + 4 * g), rv = *(const LAS f32x4*)(Rm + t * 64 + 16 * q + 4 * g);
#pragma unroll
                    for (int i = 0; i < 4; ++i) { a[4 * g + i] = av[i]; w[4 * g + i] = wv[i]; bb[4 * g + i] = bv[i]; kk[4 * g + i] = kv[i]; rr[4 * g + i] = rv[i]; } }
                float sa = 0.f;
#pragma unroll
                for (int j = 0; j < 16; ++j) sa += S[j] * a[j];
                sa += __shfl_xor(sa, 16); sa += __shfl_xor(sa, 32);
                const float vv = Vm[t * 64 + vrow]; float y = 0.f;
#pragma unroll
                for (int j = 0; j < 16; ++j) { S[j] = S[j] * w[j] + (sa * bb[j] + vv * kk[j]); y += S[j] * rr[j]; }
                y += __shfl_xor(y, 16); y += __shfl_xor(y, 32);
                if (q == 0) YR[t * 64 + vrow] = y; } }
        __syncthreads();
        if (c > 0 || b == 0) {
#pragma unroll 1
            for (int rep = 0; rep < 2; ++rep) { const int t = wave + 8 * rep; const float yv = YR[t * 64 + lane];
                const float mean = wave_sum(yv) * (1.0f / 64.0f); const float d = yv - mean; const float var = wave_sum(d * d) * (1.0f / 64.0f);
                const float yn = d * __builtin_amdgcn_rsqf(var + LNX_EPS) * lnw + lnb;
                const float o = (yn + BON[t] * Vm[t * 64 + lane]) * Gm[t * 64 + lane];
                Y[(size_t)(row0 + t) * DM + hj] = (bf16_t)(pk_bf16(o, 0.f) & 0xffffu); } }
        __syncthreads();
    }
}

typedef short bf16x8_t __attribute__((ext_vector_type(8)));
typedef short bf16x4_t __attribute__((ext_vector_type(4)));
namespace rk {
constexpr int RAWF = 0, RAWF_SZ = 18432, RAWH = 55296, RAWH_SZ = 6144, LXB = 73728, RS = 82944, KS = 87040, VS = 91136, KKN = 95232, ATP = 99328, RTP = 101376, BTP = 103424, KTP = 105472,
              BHT = 107520, KHT = 109568, VT = 111616, GT = 113664, AAK = 113920, RB = 114432, RKM = 114944, TINV = 115456, GG = 115968  , VF = 124160  , YR = 132352, BONP = 136448  , LDS_END = 136960;
}
template <int CTRL> __device__ __forceinline__ float dpp_f(float v) { return __builtin_bit_cast(float, __builtin_amdgcn_update_dpp(0, __builtin_bit_cast(int, v), CTRL, 0xf, 0xf, true)); }
__device__ __forceinline__ float row_sum16(float v) { v += dpp_f<0xB1>(v); v += dpp_f<0x4E>(v); v += dpp_f<0x141>(v); v += dpp_f<0x140>(v); return v; }
__device__ __forceinline__ float rdlane(float v, int l) { return __builtin_bit_cast(float, __builtin_amdgcn_readlane(__builtin_bit_cast(int, v), l)); }
__device__ __forceinline__ float wave_sum_dpp(float v) { v = row_sum16(v); return (rdlane(v, 0) + rdlane(v, 16)) + (rdlane(v, 32) + rdlane(v, 48)); }
#define RK_BAR() do { asm volatile("s_waitcnt lgkmcnt(0)" ::: "memory"); __builtin_amdgcn_s_barrier(); asm volatile("" ::: "memory"); } while (0)
__device__ __forceinline__ bf16_t bf1(float x) { return (bf16_t)(pk_bf16(x, 0.f) & 0xffffu); }
__device__ __forceinline__ bf16x4_t pack4(float a, float b, float c, float d) { u32x2 w; w.x = pk_bf16(a, b); w.y = pk_bf16(c, d); return __builtin_bit_cast(bf16x4_t, w); }
__device__ __forceinline__ float fast_sigmoid(float x) { return __builtin_amdgcn_rcpf(1.0f + __expf(-x)); }
__device__ __forceinline__ float fast_tanh(float x) { return 1.0f - 2.0f * __builtin_amdgcn_rcpf(__expf(2.0f * x) + 1.0f); }

__device__ __forceinline__ void rwkv_chunked(PP P, int l, int b, int h, LAS unsigned char* lds) {
    using namespace cfg;
    const int tid = ltid(), lane = tid & 63, wave = __builtin_amdgcn_readfirstlane(tid >> 6), n = lane & 15, g = lane >> 4;
    const bf16_t* PR = (const bf16_t*)(P->ws + WS_PR); const float* PS = (const float*)(P->ws + WS_PS); bf16_t* Y = (bf16_t*)(P->ws + WS_Y);
    const float* mu = P->in[I_MU] + l * RWKV_COLS;
    LAS float* RSm = (LAS float*)(lds + rk::RS); LAS float* KSm = (LAS float*)(lds + rk::KS); LAS float* VSm = (LAS float*)(lds + rk::VS); LAS float* KKNm = (LAS float*)(lds + rk::KKN);
    LAS bf16_t* LXB = (LAS bf16_t*)(lds + rk::LXB);
    LAS bf16_t* ATp = (LAS bf16_t*)(lds + rk::ATP); LAS bf16_t* RTp = (LAS bf16_t*)(lds + rk::RTP); LAS bf16_t* BTp = (LAS bf16_t*)(lds + rk::BTP); LAS bf16_t* KTp = (LAS bf16_t*)(lds + rk::KTP);
    LAS bf16_t* BHt = (LAS bf16_t*)(lds + rk::BHT); LAS bf16_t* KHt = (LAS bf16_t*)(lds + rk::KHT); LAS bf16_t* Vt = (LAS bf16_t*)(lds + rk::VT);
    LAS float* GTm = (LAS float*)(lds + rk::GT);
    LAS bf16_t* AAKm = (LAS bf16_t*)(lds + rk::AAK); LAS bf16_t* RBm = (LAS bf16_t*)(lds + rk::RB); LAS bf16_t* RKm = (LAS bf16_t*)(lds + rk::RKM); LAS bf16_t* TINVm = (LAS bf16_t*)(lds + rk::TINV);
    LAS float* YRm = (LAS float*)(lds + rk::YR);
    const int hj = h * 64 + lane;
    const float mur = mu[hj], muk = mu[1024 + hj], muv = mu[2048 + hj], kkw = P->in[I_KK][l * RW + hj], lnw = P->in[I_LNW][l * RW + hj], lnb = P->in[I_LNB][l * RW + hj];
    float mul[5];
#pragma unroll
    for (int q = 0; q < 5; ++q) mul[q] = (lane + 64 * q < 288) ? mu[3072 + lane + 64 * q] : 0.f;
    const int kw = wave & 3, key = 16 * kw + n, hk = h * 64 + key;
    const float w0k = P->in[I_W0][l * RW + hk], a0k = P->in[I_A0][l * RW + hk], kak = P->in[I_KA][l * RW + hk], rkk = P->in[I_RK][l * RW + hk];
    const int pp = 32 * (key >> 5) + 8 * ((key >> 2) & 3) + 4 * ((key >> 4) & 1) + (key & 3);
    bf16x8_t fA[2], fB[5];
    {
        const float* wu = P->in[I_WUP] + (size_t)l * 64 * RW + hk; const float* au = P->in[I_AUP] + (size_t)l * 64 * RW + hk; const float* gu = P->in[I_GUP] + (size_t)l * 160 * RW + hk;
#pragma unroll
        for (int s = 0; s < 5; ++s) { float v[8], u[8];
#pragma unroll
            for (int j = 0; j < 8; ++j) { const int k = 32 * s + 8 * g + j; v[j] = (wave < 4) ? (s < 2 ? au[(size_t)k * RW] : 0.f) : gu[(size_t)k * RW]; u[j] = (wave < 4 && s < 2) ? wu[(size_t)k * RW] : 0.f; }
            u32x4 w; w.x = pk_bf16(v[0], v[1]); w.y = pk_bf16(v[2], v[3]); w.z = pk_bf16(v[4], v[5]); w.w = pk_bf16(v[6], v[7]); fB[s] = __builtin_bit_cast(bf16x8_t, w);
            if (s < 2) { u32x4 x; x.x = pk_bf16(u[0], u[1]); x.y = pk_bf16(u[2], u[3]); x.z = pk_bf16(u[4], u[5]); x.w = pk_bf16(u[6], u[7]); fA[s] = __builtin_bit_cast(bf16x8_t, x); } }
    }
    f32x4 ST[4];
#pragma unroll
    for (int kb = 0; kb < 4; ++kb) ST[kb] = (f32x4){0.f, 0.f, 0.f, 0.f};
#define RK_DMA(c_) do { const int cc_ = (c_); const int row0_ = (cc_ == 0) ? MMAIN : b * SEQ + (cc_ - 1) * 16; const int bi_ = cc_ % 3; \
        _Pragma("unroll") for (int i_ = 0; i_ < 3; ++i_) { const int wp_ = wave + 8 * i_; if (wp_ < 18) { const int x_ = wp_ * 64 + lane; \
            __builtin_amdgcn_global_load_lds((const unsigned*)(PS + (size_t)(row0_ + x_ / 72) * PSW + (x_ % 72) * 4), (LAS unsigned*)(lds + rk::RAWF + bi_ * rk::RAWF_SZ + wp_ * 1024), 16, 0, 0); } } \
        if (wave < 6) { const int y_ = wave * 64 + lane; \
            __builtin_amdgcn_global_load_lds((const unsigned*)(PR + (size_t)(row0_ + y_ / 24) * PRW + ((y_ % 24) >> 3) * 1024 + h * 64 + (y_ & 7) * 8), (LAS unsigned*)(lds + rk::RAWH + bi_ * rk::RAWH_SZ + wave * 1024), 16, 0, 0); } } while (0)
#define RK_STAGE_A(ca_, t_) do { const int t = (t_); const int bc_ = (ca_) % 3, bp_ = ((ca_) + 2) % 3; \
        LAS const float* cF_ = (LAS const float*)(lds + rk::RAWF + bc_ * rk::RAWF_SZ); LAS const float* pF_ = (LAS const float*)(lds + rk::RAWF + bp_ * rk::RAWF_SZ); \
        LAS const bf16_t* cH_ = (LAS const bf16_t*)(lds + rk::RAWH + bc_ * rk::RAWH_SZ); LAS const bf16_t* pH_ = (LAS const bf16_t*)(lds + rk::RAWH + bp_ * rk::RAWH_SZ); \
        LAS const float* ctF = cF_ + t * 288; LAS const float* ptF = (t == 0) ? pF_ + 15 * 288 : cF_ + (t - 1) * 288; \
        LAS const bf16_t* ctH = cH_ + t * 192; LAS const bf16_t* ptH = (t == 0) ? pH_ + 15 * 192 : cH_ + (t - 1) * 192; \
        const float rc = bf2f(ctH[lane]), kc = bf2f(ctH[64 + lane]), vc = bf2f(ctH[128 + lane]); \
        const float rs = rc + (bf2f(ptH[lane]) - rc) * mur, ks = kc + (bf2f(ptH[64 + lane]) - kc) * muk, vs = vc + (bf2f(ptH[128 + lane]) - vc) * muv; \
        RSm[t * 64 + lane] = rs; KSm[t * 64 + lane] = ks; VSm[t * 64 + lane] = vs; \
        const float kkr = ks * kkw; const float n2 = wave_sum_dpp(kkr * kkr); KKNm[t * 64 + lane] = kkr * __builtin_amdgcn_rsqf(fmaxf(n2, 1e-24f)); \
        _Pragma("unroll") for (int q = 0; q < 5; ++q) { const int i = lane + 64 * q; if (i < 288) { const float xc = ctF[i]; const float x = xc + (ptF[i] - xc) * mul[q]; \
                LXB[t * 288 + i] = bf1(q == 0 ? fast_tanh(x) : (q == 1 ? x : fast_sigmoid(x))); } } } while (0)
#define RK_STAGE_F(cf_, t_) do { const int t = (t_); const int par_ = (cf_) & 1; const int rowF_ = ((cf_) == 0) ? MMAIN : b * SEQ + ((cf_) - 1) * 16; \
        LAS const float* Gp_ = (LAS const float*)(lds + rk::GG + par_ * 4096); LAS const float* Vp_ = (LAS const float*)(lds + rk::VF + par_ * 4096); LAS const float* Bp_ = (LAS const float*)(lds + rk::BONP + par_ * 256); \
        const float yv = YRm[t * 64 + lane]; \
        const float mean = wave_sum_dpp(yv) * (1.0f / 64.0f); const float d = yv - mean; const float var = wave_sum_dpp(d * d) * (1.0f / 64.0f); \
        const float yn = d * __builtin_amdgcn_rsqf(var + LNX_EPS) * lnw + lnb; \
        const float bonus = (Bp_[t] + Bp_[16 + t]) + (Bp_[32 + t] + Bp_[48 + t]); \
        const float o = (yn + bonus * Vp_[t * 64 + lane]) * Gp_[t * 64 + lane]; \
        if ((cf_) > 0 || b == 0) Y[(size_t)(rowF_ + t) * DM + hj] = bf1(o); } while (0)
    RK_DMA(0); RK_DMA(1);
    for (int e = tid; e < 288; e += 512) ((LAS float*)(lds + rk::RAWF + 2 * rk::RAWF_SZ))[15 * 288 + e] = 0.f;
    for (int e = tid; e < 96; e += 512) ((LAS unsigned*)(lds + rk::RAWH + 2 * rk::RAWH_SZ))[15 * 96 + e] = 0u;
    asm volatile("s_waitcnt vmcnt(0)" ::: "memory");
    RK_BAR();
    RK_STAGE_A(0, wave); RK_STAGE_A(0, wave + 8);
    RK_BAR();
#pragma unroll 1
    for (int c = 0; c < 257; ++c) {
        if (wave < 4) {
            LAS float* BONPc = (LAS float*)(lds + rk::BONP + (c & 1) * 256);
            f32x4 accW = (f32x4){0.f, 0.f, 0.f, 0.f}, accA = accW;
#pragma unroll
            for (int s = 0; s < 2; ++s) { const bf16x8_t aw = *(const LAS bf16x8_t*)(LXB + n * 288 + 32 * s + 8 * g), aa = *(const LAS bf16x8_t*)(LXB + n * 288 + 64 + 32 * s + 8 * g);
                accW = __builtin_amdgcn_mfma_f32_16x16x32_bf16(aw, fA[s], accW, 0, 0, 0); accA = __builtin_amdgcn_mfma_f32_16x16x32_bf16(aa, fB[s], accA, 0, 0, 0); }
            float lw[4], alr[4], pfx[4];
#pragma unroll
            for (int r = 0; r < 4; ++r) { lw[r] = -0.6065306597126334f * fast_sigmoid(accW[r] + w0k); alr[r] = fast_sigmoid(accA[r] + a0k); }
            pfx[0] = lw[0]; pfx[1] = pfx[0] + lw[1]; pfx[2] = pfx[1] + lw[2]; pfx[3] = pfx[2] + lw[3];
            const float t0 = __shfl(pfx[3], n), t1 = __shfl(pfx[3], n + 16), t2 = __shfl(pfx[3], n + 32), t3 = __shfl(pfx[3], n + 48);
            const float base = (g > 0 ? t0 : 0.f) + (g > 1 ? t1 : 0.f) + (g > 2 ? t2 : 0.f), lamT = (t0 + t1) + (t2 + t3);
            float bh[4], kh[4], bon[4], epos[4];
            const float eb = __expf(base), eT = __expf(lamT);
#pragma unroll
            for (int r = 0; r < 4; ++r) epos[r] = __expf(base + pfx[r]);
#pragma unroll
            for (int r = 0; r < 4; ++r) { const int t = 4 * g + r;
                const float e_pos = epos[r], e_neg = __builtin_amdgcn_rcpf(epos[r]), e_prev = (r == 0) ? eb : epos[r > 0 ? r - 1 : 0], e_hat = eT * e_neg;
                const float rs = RSm[t * 64 + key], ks = KSm[t * 64 + key], kk = KKNm[t * 64 + key];
                const float kmod = ks * (1.0f + (alr[r] - 1.0f) * kak), bb = kk * alr[r];
                ATp[t * 64 + pp] = bf1(-kk * e_prev); RTp[t * 64 + pp] = bf1(rs * e_pos); BTp[t * 64 + pp] = bf1(bb * e_neg); KTp[t * 64 + pp] = bf1(kmod * e_neg);
                bh[r] = bb * e_hat; kh[r] = kmod * e_hat; bon[r] = rs * kmod * rkk; }
            *(LAS bf16x4_t*)(BHt + key * 16 + 4 * g) = pack4(bh[0], bh[1], bh[2], bh[3]); *(LAS bf16x4_t*)(KHt + key * 16 + 4 * g) = pack4(kh[0], kh[1], kh[2], kh[3]);
#pragma unroll
            for (int r = 0; r < 4; ++r) { const float x = row_sum16(bon[r]); if (n == 0) BONPc[kw * 16 + 4 * g + r] = x; }
            if (g == 0) GTm[key] = eT;
        } else {
            LAS float* Gc = (LAS float*)(lds + rk::GG + (c & 1) * 4096); LAS float* VFc = (LAS float*)(lds + rk::VF + (c & 1) * 4096);
            f32x4 accG = (f32x4){0.f, 0.f, 0.f, 0.f};
#pragma unroll
            for (int s = 0; s < 5; ++s) { const bf16x8_t ag = *(const LAS bf16x8_t*)(LXB + n * 288 + 128 + 32 * s + 8 * g); accG = __builtin_amdgcn_mfma_f32_16x16x32_bf16(ag, fB[s], accG, 0, 0, 0); }
            float vv[4];
#pragma unroll
            for (int r = 0; r < 4; ++r) { Gc[(4 * g + r) * 64 + key] = accG[r]; vv[r] = VSm[(4 * g + r) * 64 + key]; VFc[(4 * g + r) * 64 + key] = vv[r]; }
            *(LAS bf16x4_t*)(Vt + key * 16 + 4 * g) = pack4(vv[0], vv[1], vv[2], vv[3]);
            if (c >= 1) { RK_STAGE_F(c - 1, 4 * kw); RK_STAGE_F(c - 1, 4 * kw + 1); RK_STAGE_F(c - 1, 4 * kw + 2); RK_STAGE_F(c - 1, 4 * kw + 3); }
        }
        asm volatile("s_waitcnt vmcnt(0)" ::: "memory");
        RK_BAR();
        if (c + 2 < 257) RK_DMA(c + 2);
        if (wave < 4) {
            LAS const bf16_t* X = (wave < 2) ? ATp : RTp; LAS const bf16_t* Yi = (wave & 1) ? KTp : BTp;
            f32x4 acc = (f32x4){0.f, 0.f, 0.f, 0.f};
#pragma unroll
            for (int s = 0; s < 2; ++s) { const bf16x8_t xa = *(const LAS bf16x8_t*)(X + n * 64 + 32 * s + 8 * g), yb = *(const LAS bf16x8_t*)(Yi + n * 64 + 32 * s + 8 * g);
                acc = __builtin_amdgcn_mfma_f32_16x16x32_bf16(xa, yb, acc, 0, 0, 0); }
            float mv[4];
#pragma unroll
            for (int r = 0; r < 4; ++r) { const int t = 4 * g + r; const bool keep = (wave < 2) ? (n < t) : (n <= t); mv[r] = keep ? acc[r] : 0.f;
                if (wave == 1) AAKm[t * 16 + n] = bf1(mv[r]); else if (wave == 2) RBm[t * 16 + n] = bf1(mv[r]); else if (wave == 3) RKm[t * 16 + n] = bf1(mv[r]); }
            if (wave == 0) {
                float Tc[16];
#pragma unroll
                for (int t = 0; t < 16; ++t) { float v0 = (t == n) ? 1.0f : 0.0f, v1 = 0.f;
#pragma unroll
                    for (int i = 0; i < t; ++i) { const float a = rdlane(mv[t & 3], i + 16 * (t >> 2)); if (i & 1) v1 += a * Tc[i]; else v0 += a * Tc[i]; }
                    Tc[t] = v0 + v1; __builtin_amdgcn_sched_barrier(0); }
                if (g == 0) {
#pragma unroll
                    for (int t = 0; t < 16; ++t) TINVm[t * 16 + n] = bf1(Tc[t]); }
            }
        }
        if (wave >= 1) {
            if (c + 1 < 257) { RK_STAGE_A(c + 1, wave - 1); RK_STAGE_A(c + 1, wave + 6); if (wave < 3) RK_STAGE_A(c + 1, wave + 13); }
        }
        RK_BAR();
        if (wave < 4) {
            bf16x8_t sb[2];
#pragma unroll
            for (int s = 0; s < 2; ++s) { u32x4 w; w.x = pk_bf16(ST[2 * s][0], ST[2 * s][1]); w.y = pk_bf16(ST[2 * s][2], ST[2 * s][3]); w.z = pk_bf16(ST[2 * s + 1][0], ST[2 * s + 1][1]); w.w = pk_bf16(ST[2 * s + 1][2], ST[2 * s + 1][3]);
                sb[s] = __builtin_bit_cast(bf16x8_t, w); }
            const bf16x4_t vfr = *(const LAS bf16x4_t*)(Vt + key * 16 + 4 * g);
            f32x4 W1 = (f32x4){0.f, 0.f, 0.f, 0.f}, Yc = W1;
#pragma unroll
            for (int s = 0; s < 2; ++s) { const bf16x8_t af = *(const LAS bf16x8_t*)(ATp + n * 64 + 32 * s + 8 * g), rf = *(const LAS bf16x8_t*)(RTp + n * 64 + 32 * s + 8 * g);
                W1 = __builtin_amdgcn_mfma_f32_16x16x32_bf16(af, sb[s], W1, 0, 0, 0); Yc = __builtin_amdgcn_mfma_f32_16x16x32_bf16(rf, sb[s], Yc, 0, 0, 0); }
            W1 = __builtin_amdgcn_mfma_f32_16x16x16bf16_1k(*(const LAS bf16x4_t*)(AAKm + n * 16 + 4 * g), vfr, W1, 0, 0, 0);
            const bf16x4_t w1f = pack4(W1[0], W1[1], W1[2], W1[3]);
            f32x4 U = __builtin_amdgcn_mfma_f32_16x16x16bf16_1k(*(const LAS bf16x4_t*)(TINVm + n * 16 + 4 * g), w1f, (f32x4){0.f, 0.f, 0.f, 0.f}, 0, 0, 0);
            const bf16x4_t uf = pack4(U[0], U[1], U[2], U[3]);
            Yc = __builtin_amdgcn_mfma_f32_16x16x16bf16_1k(*(const LAS bf16x4_t*)(RBm + n * 16 + 4 * g), uf, Yc, 0, 0, 0);
            Yc = __builtin_amdgcn_mfma_f32_16x16x16bf16_1k(*(const LAS bf16x4_t*)(RKm + n * 16 + 4 * g), vfr, Yc, 0, 0, 0);
#pragma unroll
            for (int r = 0; r < 4; ++r) YRm[(4 * g + r) * 64 + key] = Yc[r];
#pragma unroll
            for (int kb = 0; kb < 4; ++kb) { const f32x4 gt = *(const LAS f32x4*)(GTm + 16 * kb + 4 * g); f32x4 a = ST[kb] * gt;
                a = __builtin_amdgcn_mfma_f32_16x16x16bf16_1k(*(const LAS bf16x4_t*)(BHt + (16 * kb + n) * 16 + 4 * g), uf, a, 0, 0, 0);
                a = __builtin_amdgcn_mfma_f32_16x16x16bf16_1k(*(const LAS bf16x4_t*)(KHt + (16 * kb + n) * 16 + 4 * g), vfr, a, 0, 0, 0);
                ST[kb] = a; }
        }
        RK_BAR();
    }
    RK_STAGE_F(256, wave); RK_STAGE_F(256, wave + 8);
    asm volatile("s_waitcnt vmcnt(0)" ::: "memory");
    RK_BAR();
#undef RK_DMA
#undef RK_STAGE_A
#undef RK_STAGE_F
}

__device__ __forceinline__ f32x4 sk_dot(const bf16_t* a, const bf16_t* b, int nsteps) {
    f32x4 acc = (f32x4){0.f, 0.f, 0.f, 0.f};
#pragma unroll 4
    for (int s = 0; s < nsteps; ++s) { const bf16x8_t av = *(const bf16x8_t*)(a + 32 * s), bv = *(const bf16x8_t*)(b + 32 * s); acc = __builtin_amdgcn_mfma_f32_16x16x32_bf16(av, bv, acc, 0, 0, 0); }
    return acc; }
__device__ __forceinline__ void meta_rs(const float* ssm, int lane, float (&rs)[4]) {
    const int row = lane & 15, part = lane >> 4; float s = 0.f;
#pragma unroll 8
    for (int i = 0; i < 32; ++i) s += ssm[(part + 4 * i) * 16 + row];
    s = s + __shfl_xor(s, 16); s = s + __shfl_xor(s, 32);
    const float rv = __builtin_amdgcn_rsqf(s * (1.0f / 2048.0f) + 1e-6f);
#pragma unroll
    for (int r = 0; r < 4; ++r) rs[r] = __shfl(rv, 4 * part + r); }
#define SK_HEAD const int tid = ltid(), lane = tid & 63, wave = __builtin_amdgcn_readfirstlane(tid >> 6), n = lane & 15, g = lane >> 4, kq = wave & 3, ti = lbid() + 256 * (wave >> 2); LAS f32x4* part = (LAS f32x4*)lds;
#define SK_COMBINE(dst, slot) do { dst = (part[((wave) * 2 + (slot)) * 64 + lane] + part[((wave + 1) * 2 + (slot)) * 64 + lane]) + (part[((wave + 2) * 2 + (slot)) * 64 + lane] + part[((wave + 3) * 2 + (slot)) * 64 + lane]); } while (0)
__device__ __forceinline__ void skinny_gu(const bf16_t* hb, const bf16_t* Bt, const float* ssm, bf16_t* act, LAS unsigned char* lds) {
    using namespace cfg; SK_HEAD
    if (ti < DFF / 16) { const int c0 = 16 * ti, brow = (c0 >> 7) * 256 + (c0 & 127) + n; const bf16_t* a = hb + (size_t)(MMAIN + n) * DM + 512 * kq + 8 * g;
        part[(wave * 2) * 64 + lane] = sk_dot(a, Bt + (size_t)brow * DM + 512 * kq + 8 * g, 16); part[(wave * 2 + 1) * 64 + lane] = sk_dot(a, Bt + (size_t)(brow + 128) * DM + 512 * kq + 8 * g, 16); }
    __syncthreads();
    if (ti < DFF / 16 && kq == 0) { f32x4 gt, up; SK_COMBINE(gt, 0); SK_COMBINE(up, 1); float rs[4]; meta_rs(ssm, lane, rs);
#pragma unroll
        for (int r = 0; r < 4; ++r) { const float gv = gt[r] * rs[r], uv = up[r] * rs[r]; act[(size_t)(MMAIN + 4 * g + r) * DFF + 16 * ti + n] = bf1(gv * __builtin_amdgcn_rcpf(1.0f + __builtin_amdgcn_exp2f(-1.4426950408889634f * gv)) * uv); } }
    __syncthreads();
}
__device__ __forceinline__ void skinny_res(const bf16_t* A16, int K, const bf16_t* Bt, bf16_t* hb, float* ssm_out, float alpha, LAS unsigned char* lds) {
    using namespace cfg; SK_HEAD
    const int kqs = K / 4;
    if (ti < DM / 16) part[(wave * 2) * 64 + lane] = sk_dot(A16 + (size_t)n * K + kqs * kq + 8 * g, Bt + (size_t)(16 * ti + n) * K + kqs * kq + 8 * g, kqs / 32);
    __syncthreads();
    if (ti < DM / 16 && kq == 0) { f32x4 acc; SK_COMBINE(acc, 0);
#pragma unroll
        for (int r = 0; r < 4; ++r) { const int m = 4 * g + r, col = 16 * ti + n; bf16_t* p = hb + (size_t)(MMAIN + m) * DM + col; const float hv = bf2f(*p) + alpha * acc[r]; *p = bf1(hv);
            const float sq = row_sum16(hv * hv); if (n == 0) ssm_out[ti * 16 + m] = sq; } }
    __syncthreads();
}
__device__ __forceinline__ void skinny_p(const bf16_t* hb, const bf16_t* Bt, const float* ssm, bf16_t* pr, float* ps, bf16_t* qkv, LAS unsigned char* lds) {
    using namespace cfg; SK_HEAD
    if (ti < NIN / 16) part[(wave * 2) * 64 + lane] = sk_dot(hb + (size_t)(MMAIN + n) * DM + 512 * kq + 8 * g, Bt + (size_t)(16 * ti + n) * DM + 512 * kq + 8 * g, 16);
    __syncthreads();
    if (ti < NIN / 16 && kq == 0) { f32x4 acc; SK_COMBINE(acc, 0); float rs[4]; meta_rs(ssm, lane, rs); const int np = 16 * ti + n;
#pragma unroll
        for (int r = 0; r < 4; ++r) { const int m = 4 * g + r; const float v = acc[r] * rs[r];
            if (np < 3072) pr[(size_t)(MMAIN + m) * PRW + np] = bf1(v);
            else if (np < 3584) ps[(size_t)(MMAIN + m) * PSW + (np - 3072)] = v;
            else { const bf16_t w = bf1(v);
#pragma unroll
                for (int b = 0; b < NBATCH; ++b) qkv[((size_t)b * SEQP + 48 + m) * QKVW + (np - 3584)] = w; } } }
    __syncthreads();
}
#undef SK_HEAD
#undef SK_COMBINE

namespace fox {
constexpr int D = 128, NW = 8, QBLK = 32, KVBLK = 64, QB = NW * QBLK;
constexpr int LDQ = cfg::QKVW, LDK = cfg::QKVW, LDO = cfg::DM;
constexpr float SCALE = 0.08838834764831845f, THR = 8.f;
constexpr bool WSKIP = false;
constexpr int SHM_V = KVBLK * D * 2, SHM_K = KVBLK * D * 2;
constexpr int ATT_LDS = 2 * SHM_V + 2 * SHM_K + NW * 64 * 4;
constexpr int BIAS_OFF = ATT_LDS;
constexpr int SCAN_OFF = BIAS_OFF + cfg::SEQP * 4;

using bf16 = __hip_bfloat16;
typedef short bf16x8 __attribute__((ext_vector_type(8)));
typedef short s16x4 __attribute__((ext_vector_type(4)));
typedef float f32x16 __attribute__((ext_vector_type(16)));
typedef float f32x4 __attribute__((ext_vector_type(4)));
typedef unsigned u32x4 __attribute__((ext_vector_type(4)));
template <class A, class Bt> struct same_t { static constexpr bool v = false; };
template <class A> struct same_t<A, A> { static constexpr bool v = true; };

#define KSWZ(row, colB) ((row) * 256 + ((colB) ^ (((row) & 7) << 4)))
#define SBAR() __builtin_amdgcn_sched_barrier(0)
__device__ __forceinline__ int v_st(int k, int c) { const int kk = (k & ~0xC) | ((k & 4) << 1) | ((k & 8) >> 1); return ((kk >> 3) * 4 + (c >> 5)) * 512 + ((kk & 7) * 32 + (c & 31)) * 2; }
__device__ __forceinline__ int v_rd_base(int lane) { return ((lane & 3) << 3) | (((lane >> 2) & 3) << 6) | (((lane >> 4) & 1) << 5) | (((lane >> 5) & 1) << 8); }
constexpr int v_rd_off(int d0, int ks, int half) { return d0 * 512 + ks * 4096 + half * 2048; }
__device__ __forceinline__ int crow(int r, int hi) { return (r & 3) + 8 * (r >> 2) + 4 * hi; }
__device__ __forceinline__ unsigned cvtpk(float lo, float hi) {
    unsigned r; asm volatile("v_cvt_pk_bf16_f32 %0, %1, %2" : "=v"(r) : "v"(lo), "v"(hi)); return r;
}
__device__ __forceinline__ bf16x8 pack8(f32x4 a, f32x4 b) {
    u32x4 w = {cvtpk(a[0], a[1]), cvtpk(a[2], a[3]), cvtpk(b[0], b[1]), cvtpk(b[2], b[3])};
    return *reinterpret_cast<bf16x8*>(&w);
}
template <class T> __device__ __forceinline__ bf16x8 load8(const T* p) {
    if constexpr (same_t<T, float>::v) { return pack8(*(const f32x4*)p, *(const f32x4*)(p + 4)); }
    else { return *reinterpret_cast<const bf16x8*>(p); }
}
__device__ __forceinline__ void mask_tile(f32x16& p0, f32x16& p1, int dq, unsigned W) {
    const float NEG = -__builtin_inff();
#pragma unroll
    for (int r = 0; r < 16; ++r) {
        const int c = (r & 3) + 8 * (r >> 2);
        if ((unsigned)(dq - c) >= W) p0[r] = NEG;
        if ((unsigned)(dq - c - 32) >= W) p1[r] = NEG;
    }
}
__device__ __forceinline__ void partialSM(f32x16& p0, f32x16& p1, float& m_reg, float& mn, float& alpha) {
    float pmax = p0[0]; for (int r = 1; r < 16; ++r) pmax = fmaxf(pmax, p0[r]); for (int r = 0; r < 16; ++r) pmax = fmaxf(pmax, p1[r]);
    { auto rr = __builtin_amdgcn_permlane32_swap(__float_as_uint(pmax), __float_as_uint(pmax), false, false);
      pmax = fmaxf(__uint_as_float(rr[0]), __uint_as_float(rr[1])); }
    constexpr float C2 = 1.4426950408889634f * SCALE;
    if (__builtin_expect(__all((pmax - m_reg) * SCALE <= THR), 1)) { mn = m_reg; alpha = 1.f; }
    else { mn = fmaxf(m_reg, pmax); alpha = __builtin_amdgcn_exp2f((m_reg - mn) * C2); m_reg = mn; }
    const float mnL = -mn * C2;
    for (int r = 0; r < 16; ++r) p0[r] = fmaf(p0[r], C2, mnL); for (int r = 0; r < 16; ++r) p1[r] = fmaf(p1[r], C2, mnL);
    for (int r = 0; r < 16; ++r) p0[r] = __builtin_amdgcn_exp2f(p0[r]);
}
__device__ __forceinline__ void finishSM(f32x16& p0, f32x16& p1, float alpha, float& l_reg, bf16x8& pa0, bf16x8& pa1, bf16x8& pa2, bf16x8& pa3) {
    for (int r = 0; r < 16; ++r) p1[r] = __builtin_amdgcn_exp2f(p1[r]);
    float ps = 0; for (int r = 0; r < 16; ++r) ps += p0[r]; for (int r = 0; r < 16; ++r) ps += p1[r];
    { auto rr = __builtin_amdgcn_permlane32_swap(__float_as_uint(ps), __float_as_uint(ps), false, false);
      ps = __uint_as_float(rr[0]) + __uint_as_float(rr[1]); }
    l_reg = l_reg * alpha + ps;
#define PK4(P, B_, OUT) do { unsigned a0 = cvtpk(P[B_+0], P[B_+1]), a1 = cvtpk(P[B_+2], P[B_+3]);                          \
        unsigned b0 = cvtpk(P[B_+4], P[B_+5]), b1 = cvtpk(P[B_+6], P[B_+7]);                                             \
        auto r0 = __builtin_amdgcn_permlane32_swap(a0, b0, false, false); auto r1 = __builtin_amdgcn_permlane32_swap(a1, b1, false, false); \
        u32x4 w = {r0[0], r1[0], r0[1], r1[1]}; OUT = *reinterpret_cast<bf16x8*>(&w); } while (0)
    PK4(p0, 0, pa0); PK4(p0, 8, pa1); PK4(p1, 0, pa2); PK4(p1, 8, pa3);
#undef PK4
}
template <int KB, bool SK>
__device__ __forceinline__ void qkt(f32x16& p0, f32x16& p1, const char* K_lds, int r32, int hi, const bf16x8* qr, bool act, const float* bias_t) {
    if (SK && !act) { const float NEG = -__builtin_inff();
#pragma unroll
        for (int r = 0; r < 16; ++r) { p0[r] = NEG; p1[r] = NEG; } return; }
    {
#pragma unroll
        for (int g_ = 0; g_ < 4; ++g_) { const f32x4 b0_ = *(const f32x4*)(bias_t + 8 * g_ + 4 * hi); const f32x4 b1_ = *(const f32x4*)(bias_t + 32 + 8 * g_ + 4 * hi);
            p0[4 * g_] = b0_[0]; p0[4 * g_ + 1] = b0_[1]; p0[4 * g_ + 2] = b0_[2]; p0[4 * g_ + 3] = b0_[3];
            p1[4 * g_] = b1_[0]; p1[4 * g_ + 1] = b1_[1]; p1[4 * g_ + 2] = b1_[2]; p1[4 * g_ + 3] = b1_[3]; } }
    const char* kb[4];
#pragma unroll
    for (int dd = 0; dd < 4; ++dd) kb[dd] = K_lds + KB * SHM_K + KSWZ(r32, (dd * 16 + hi * 8) * 2);
#pragma unroll
    for (int d0 = 0; d0 < 8; ++d0) { const char* a = kb[d0 & 3] + (d0 >> 2) * 128;
        bf16x8 b0 = *reinterpret_cast<const bf16x8*>(a);
        bf16x8 b1 = *reinterpret_cast<const bf16x8*>(a + 32 * 256);
        p0 = __builtin_amdgcn_mfma_f32_32x32x16_bf16(b0, qr[d0], p0, 0, 0, 0);
        p1 = __builtin_amdgcn_mfma_f32_32x32x16_bf16(b1, qr[d0], p1, 0, 0, 0); }
}
template <int VB, bool SK>
__device__ __forceinline__ void pv_tile(f32x16* o, int vb0, bf16x8 pa0, bf16x8 pa1, bf16x8 pa2, bf16x8 pa3, bool act) {
    if (SK && !act) return;
#define TRRD(dst, off) asm volatile("ds_read_b64_tr_b16 %0, %1 offset:%2" : "=&v"(dst) : "v"(vb0), "i"(off) : "memory")
#define PV_D0(d0) do { s16x4 l0, l1, l2, l3, h0, h1, h2, h3; constexpr int b_ = VB * SHM_V + v_rd_off(d0, 0, 0);     \
        TRRD(l0, b_); TRRD(h0, b_ + 2048); TRRD(l1, b_ + 4096); TRRD(h1, b_ + 6144); TRRD(l2, b_ + 8192); TRRD(h2, b_ + 10240); TRRD(l3, b_ + 12288); TRRD(h3, b_ + 14336); \
        asm volatile("s_waitcnt lgkmcnt(0)" ::: "memory"); SBAR();                 \
        o[d0] = __builtin_amdgcn_mfma_f32_32x32x16_bf16(pa0, (bf16x8){l0[0], l0[1], l0[2], l0[3], h0[0], h0[1], h0[2], h0[3]}, o[d0], 0, 0, 0);   \
        o[d0] = __builtin_amdgcn_mfma_f32_32x32x16_bf16(pa1, (bf16x8){l1[0], l1[1], l1[2], l1[3], h1[0], h1[1], h1[2], h1[3]}, o[d0], 0, 0, 0);   \
        o[d0] = __builtin_amdgcn_mfma_f32_32x32x16_bf16(pa2, (bf16x8){l2[0], l2[1], l2[2], l2[3], h2[0], h2[1], h2[2], h2[3]}, o[d0], 0, 0, 0);   \
        o[d0] = __builtin_amdgcn_mfma_f32_32x32x16_bf16(pa3, (bf16x8){l3[0], l3[1], l3[2], l3[3], h3[0], h3[1], h3[2], h3[3]}, o[d0], 0, 0, 0); } while (0)
    PV_D0(0); PV_D0(1); PV_D0(2); PV_D0(3);
#undef PV_D0
#undef TRRD
}

template <class TIn, class TOut> struct BlockRef { const TIn* Q; const TIn* K; const TIn* V; TOut* O; int P0; };
template <class TIn> struct Seam {
    bf16x8 qr[8];
    bf16x8 st_v0, st_v1, st_k0, st_k1; f32x4 sf0, sf1, sf2, sf3;
    f32x4 tq[16];
};
__device__ __forceinline__ int swa_jlo(int P0, int W) { const int lowk = P0 - W + 1; return lowk > 0 ? lowk / KVBLK : 0; }
#define ROW(p, k0, rr) ((p) + (size_t)((k0) + (rr)) * LDK + sc)
#define VMW() asm volatile("s_waitcnt vmcnt(0)" ::: "memory")
#define VMWN(n) asm volatile("s_waitcnt vmcnt(%0)" :: "i"(n) : "memory")
#define SLOAD_H(Kp, Vp, k0) do { S.st_v0 = load8<TIn>(ROW(Vp, k0, sr)); S.st_v1 = load8<TIn>(ROW(Vp, k0, 32 + sr));              \
                         S.st_k0 = load8<TIn>(ROW(Kp, k0, sr)); S.st_k1 = load8<TIn>(ROW(Kp, k0, 32 + sr)); } while (0)
#define SWRITE_HK(bf) do { *(bf16x8*)(K_lds + (bf) * SHM_K + kws) = S.st_k0; *(bf16x8*)(K_lds + (bf) * SHM_K + kws + 32 * 256) = S.st_k1; } while (0)
#define SWRITE_HV(bf) do { *(bf16x8*)(V_lds + (bf) * SHM_V + vst0) = S.st_v0; *(bf16x8*)(V_lds + (bf) * SHM_V + vst1) = S.st_v1; } while (0)
#define SWRITE_H(bf) do { SWRITE_HV(bf); SWRITE_HK(bf); } while (0)
#define SLOAD_F(p, k0) do { S.sf0 = *(const f32x4*)ROW(p, k0, sr); S.sf1 = *(const f32x4*)(ROW(p, k0, sr) + 4);                \
                            S.sf2 = *(const f32x4*)ROW(p, k0, 32 + sr); S.sf3 = *(const f32x4*)(ROW(p, k0, 32 + sr) + 4); } while (0)
#define SWRITE_KF(bf) do { *(bf16x8*)(K_lds + (bf) * SHM_K + kws) = pack8(S.sf0, S.sf1); *(bf16x8*)(K_lds + (bf) * SHM_K + kws + 32 * 256) = pack8(S.sf2, S.sf3); } while (0)
#define SWRITE_VF(bf) do { *(bf16x8*)(V_lds + (bf) * SHM_V + vst0) = pack8(S.sf0, S.sf1); *(bf16x8*)(V_lds + (bf) * SHM_V + vst1) = pack8(S.sf2, S.sf3); } while (0)
template <class TIn, class TOut>
__device__ __forceinline__ void causal_swa_prime(const BlockRef<TIn, TOut>& cur, int W, char* lds, Seam<TIn>& S) {
    constexpr bool F32 = same_t<TIn, float>::v;
    const int tid = ltid(), wid = __builtin_amdgcn_readfirstlane(tid >> 6), lane = tid & 63, r32 = lane & 31, hi = lane >> 5;
    const int sr = tid >> 4, sc = (tid & 15) * 8, kws = KSWZ(sr, sc * 2); char* K_lds = lds + 2 * SHM_V;
    const int kb0 = swa_jlo(cur.P0, W) * KVBLK;
    for (int d0 = 0; d0 < 8; ++d0) S.qr[d0] = load8<TIn>(cur.Q + (size_t)(wid * QBLK + r32) * LDQ + d0 * 16 + hi * 8);
    if constexpr (F32) { SLOAD_F((const float*)cur.K, kb0); VMW(); SWRITE_KF(0); SBAR(); SLOAD_F((const float*)cur.V, kb0); }
    else { SLOAD_H(cur.K, cur.V, kb0); VMW(); SWRITE_HK(0); }
    __syncthreads();
}
template <class TIn, class TOut>
__device__ __forceinline__ void causal_swa_block(const BlockRef<TIn, TOut>& cur, const BlockRef<TIn, TOut>& nxt, int skv, int W, char* lds, Seam<TIn>& S, const float* bias_l) {
    constexpr bool F32 = same_t<TIn, float>::v;
    const int tid = ltid(), wid = __builtin_amdgcn_readfirstlane(tid >> 6), lane = tid & 63, r32 = lane & 31, hi = lane >> 5;
    const int j_lo = swa_jlo(cur.P0, W);
    int j_hi = (cur.P0 + QB - 1) / KVBLK + 1; if (j_hi > skv / KVBLK) j_hi = skv / KVBLK;
    const int NT = j_hi - j_lo;
    const int kbn = swa_jlo(nxt.P0, W) * KVBLK;
    const int qlo = cur.P0 + wid * QBLK, qm = qlo + r32 - 4 * hi;
    char* V_lds = lds; char* K_lds = lds + 2 * SHM_V;
    float* ws = (float*)(lds + 2 * SHM_V + 2 * SHM_K) + wid * 64; float* li_l = ws, * al_l = ws + 32;
    float m_reg = -1e30f, l_reg = 0; f32x16 o[4] = {};
    const int sr = tid >> 4, sc = (tid & 15) * 8, vst0 = v_st(sr, sc), vst1 = v_st(32 + sr, sc), kws = KSWZ(sr, sc * 2);
    const int vb0 = (int)(uintptr_t)V_lds + v_rd_base(lane);
    const TIn* Kh = cur.K; const TIn* Vh = cur.V;
#define RESC(a) do { if (__any((a) < 1.f)) { if (hi == 0) al_l[r32] = (a); asm volatile("s_waitcnt lgkmcnt(0)" ::: "memory");              \
                     for (int d_ = 0; d_ < 4; ++d_) for (int r = 0; r < 16; ++r) o[d_][r] *= al_l[crow(r, hi)]; } } while (0)
#define KBASE(t) ((j_lo + (t)) * KVBLK)
#define ACT(t) (KBASE(t) <= qlo + QBLK - 1 && KBASE(t) + KVBLK - 1 >= qlo - W + 1)
#define MASKT(P0_, P1_, t) do { const int kb_ = KBASE(t); if ((!SK || ACT(t)) && (kb_ + KVBLK - 1 > qlo || kb_ <= qlo + QBLK - 1 - W)) mask_tile(P0_, P1_, qm - kb_, (unsigned)W); } while (0)
    constexpr int NQL = F32 ? 16 : 8;
    constexpr bool SK = WSKIP && !F32;
#define SEAM_K0() do { VMWN(NQL); if constexpr (F32) { SWRITE_KF(0); SBAR(); SLOAD_F((const float*)nxt.V, kbn); } else { SWRITE_HK(0); } SBAR(); } while (0)
    f32x16 pA0, pA1, pB0, pB1; float mnA, mnB, alA, alB; bf16x8 pa0, pa1, pa2, pa3;
    if constexpr (F32) { VMW(); SWRITE_VF(0); SBAR(); } else { SWRITE_HV(0); SBAR(); }
    if (NT > 1) { if constexpr (F32) SLOAD_F((const float*)Kh, KBASE(1)); else SLOAD_H(Kh, Vh, KBASE(1)); }
    SBAR(); qkt<0, SK>(pA0, pA1, K_lds, r32, hi, S.qr, ACT(0), bias_l + KBASE(0));
    if constexpr (F32) { if (NT > 1) { VMW(); SWRITE_KF(1); SBAR(); SLOAD_F((const float*)Vh, KBASE(1)); } }
    MASKT(pA0, pA1, 0); partialSM(pA0, pA1, m_reg, mnA, alA);
    if (NT > 1) { VMW(); if constexpr (F32) { SWRITE_VF(1); SBAR(); if (NT > 2) SLOAD_F((const float*)Kh, KBASE(2)); } else SWRITE_H(1); }
    __syncthreads();
#define HALF_STEP(PX0, PX1, mnX, alX, PY0, PY1, alY, t, KB, VB, SB) do {                                                      \
        SBAR(); qkt<KB, SK>(PX0, PX1, K_lds, r32, hi, S.qr, ACT(t), bias_l + KBASE(t));                                             \
        finishSM(PY0, PY1, alY, l_reg, pa0, pa1, pa2, pa3); SBAR();                                                           \
        if ((t) + 1 < NT) { if constexpr (F32) { VMW(); SWRITE_KF(SB); SBAR(); SLOAD_F((const float*)Vh, KBASE((t) + 1)); }  \
                            else { SLOAD_H(Kh, Vh, KBASE((t) + 1)); } SBAR(); }                                               \
        pv_tile<VB, SK>(o, vb0, pa0, pa1, pa2, pa3, ACT((t) - 1)); MASKT(PX0, PX1, (t)); partialSM(PX0, PX1, m_reg, mnX, alX);                                        \
        __syncthreads();                                                                                                      \
        if ((t) + 1 < NT) { VMW(); if constexpr (F32) { SWRITE_VF(SB); SBAR(); if ((t) + 2 < NT) SLOAD_F((const float*)Kh, KBASE((t) + 2)); } \
                            else { SWRITE_H(SB); } }                                                                          \
        RESC(alX); __syncthreads(); } while (0)
    for (int t = 1; t + 1 < NT; t += 2) {
        HALF_STEP(pB0, pB1, mnB, alB, pA0, pA1, alA, t, 1, 0, 0);
        HALF_STEP(pA0, pA1, mnA, alA, pB0, pB1, alB, t + 1, 0, 1, 1);
    }
    const bool even = (NT & 1) == 0;
    if (even) { SBAR(); qkt<1, SK>(pB0, pB1, K_lds, r32, hi, S.qr, ACT(NT - 1), bias_l + KBASE(NT - 1)); SBAR(); }
#define QROW(e) (nxt.Q + (size_t)(wid * QBLK + r32) * LDQ + ((e) >> 1) * 16 + hi * 8 + ((e) & 1) * 4)
    if constexpr (F32) { SLOAD_F((const float*)nxt.K, kbn); SBAR();
#pragma unroll
        for (int e = 0; e < 8; ++e) S.tq[e] = *(const f32x4*)QROW(e); }
    else { SLOAD_H(nxt.K, nxt.V, kbn); SBAR();
#pragma unroll
        for (int d0 = 0; d0 < 8; ++d0) S.qr[d0] = load8<TIn>(nxt.Q + (size_t)(wid * QBLK + r32) * LDQ + d0 * 16 + hi * 8); }
    SBAR();
    finishSM(pA0, pA1, alA, l_reg, pa0, pa1, pa2, pa3); SBAR();
    if constexpr (F32) {
#pragma unroll
        for (int e = 8; e < 16; ++e) S.tq[e] = *(const f32x4*)QROW(e); SBAR(); }
#undef QROW
    pv_tile<0, SK>(o, vb0, pa0, pa1, pa2, pa3, ACT(even ? NT - 2 : NT - 1));
    if (even) { MASKT(pB0, pB1, NT - 1); partialSM(pB0, pB1, m_reg, mnB, alB); __syncthreads(); RESC(alB);
        finishSM(pB0, pB1, alB, l_reg, pa0, pa1, pa2, pa3); SBAR(); pv_tile<1, SK>(o, vb0, pa0, pa1, pa2, pa3, ACT(NT - 1)); }
    SBAR(); SEAM_K0();
    if (hi == 0) li_l[r32] = l_reg; asm volatile("s_waitcnt lgkmcnt(0)" ::: "memory");
    float rli[16];
#pragma unroll
    for (int r = 0; r < 16; ++r) rli[r] = __builtin_amdgcn_rcpf(li_l[crow(r, hi)]);
    TOut* Ow = cur.O + (size_t)(wid * QBLK) * LDO;
#pragma unroll
    for (int r = 0; r < 16; ++r) { const int orow = crow(r, hi);
#pragma unroll
        for (int d0 = 0; d0 < 4; ++d0) { const float v = o[d0][r] * rli[r];
            if constexpr (same_t<TOut, float>::v) { Ow[(size_t)orow * LDO + d0 * 32 + r32] = v; }
            else { const float vn = __shfl_xor(v, 1);
                   if ((r32 & 1) == 0) *(unsigned*)(Ow + (size_t)orow * LDO + d0 * 32 + r32) = cvtpk(v, vn); } } }
    if constexpr (F32) {
#pragma unroll
        for (int d0 = 0; d0 < 8; ++d0) S.qr[d0] = pack8(S.tq[2 * d0], S.tq[2 * d0 + 1]); }
    __syncthreads();
#undef RESC
#undef KBASE
#undef ACT
#undef MASKT
#undef SEAM_K0
#undef HALF_STEP
}
#undef ROW
#undef VMW
#undef VMWN
#undef SLOAD_H
#undef SWRITE_HK
#undef SWRITE_HV
#undef SWRITE_H
#undef SLOAD_F
#undef SWRITE_KF

}

__device__ __forceinline__ void fox_bias(PP P, int l, int b, int h, float* bias, float* scr) {
    using namespace cfg;
    const int tid = ltid(), lane = tid & 63, wave = tid >> 6;
    const float* PS = (const float*)(P->ws + WS_PS); const float bf = P->in[I_BF][l * FNH + h];
    float lf[9]; float loc = 0.f;
#pragma unroll
    for (int i = 0; i < 9; ++i) { const int pos = tid * 9 + i; float v = 0.f;
        if (pos < NMETA + SEQ) { const int row = pos < NMETA ? MMAIN + pos : b * SEQ + pos - NMETA; const float z = PS[(size_t)row * PSW + 288 + h] + bf;
            v = fminf(z, 0.f) - log1pf(__expf(-fabsf(z))); }
        loc += v; lf[i] = loc; }
    float inc = loc;
#pragma unroll
    for (int o = 1; o < 64; o <<= 1) { const float t = __shfl_up(inc, o); if (lane >= o) inc += t; }
    if (lane == 63) scr[wave] = inc;
    __syncthreads();
    float base = inc - loc;
    for (int w = 0; w < wave; ++w) base += scr[w];
    constexpr float INV = 1.0f / fox::SCALE;
#pragma unroll
    for (int i = 0; i < 9; ++i) { const int pos = tid * 9 + i; if (pos < NMETA + SEQ) bias[48 + pos] = -(base + lf[i]) * INV; }
    if (tid < 48) bias[tid] = -__builtin_inff();
    __syncthreads();
}
__device__ __forceinline__ void fox_meta(PP P, int h, const float* bias) {
    using namespace cfg;
    const int lane = ltid() & 63, wave = ltid() >> 6;
    const bf16_t* QKV = (const bf16_t*)(P->ws + WS_QKV); bf16_t* Y = (bf16_t*)(P->ws + WS_Y);
    for (int rep = 0; rep < 2; ++rep) { const int i = wave + 8 * rep;
        float s = -__builtin_inff();
        if (lane <= i) { const bf16_t* q = QKV + (size_t)(48 + i) * QKVW + h * 128; const bf16_t* k = QKV + (size_t)(48 + lane) * QKVW + 1024 + h * 128; float dot = 0.f;
            for (int d = 0; d < 128; ++d) dot += bf2f(q[d]) * bf2f(k[d]);
            s = (dot + bias[48 + lane]) * fox::SCALE; }
        const float m = wave_max(s); const float p = (lane <= i) ? __expf(s - m) : 0.f; const float lsum = wave_sum(p);
        float o0 = 0.f, o1 = 0.f;
        for (int j = 0; j <= i; ++j) { const float pj = __shfl(p, j); const bf16_t* v = QKV + (size_t)(48 + j) * QKVW + 2048 + h * 128; o0 += pj * bf2f(v[lane]); o1 += pj * bf2f(v[64 + lane]); }
        const float il = 1.0f / lsum;
        Y[(size_t)(MMAIN + i) * DM + 1024 + h * 128 + lane] = (bf16_t)(pk_bf16(o0 * il, 0.f) & 0xffffu);
        Y[(size_t)(MMAIN + i) * DM + 1024 + h * 128 + 64 + lane] = (bf16_t)(pk_bf16(o1 * il, 0.f) & 0xffffu); }
}
__device__ __forceinline__ fox::BlockRef<__hip_bfloat16, __hip_bfloat16> fox_mk(int a, int idx, const __hip_bfloat16* Qb, const __hip_bfloat16* Kb, const __hip_bfloat16* Vb, __hip_bfloat16* Ob) {
    const int pr = 4 * (a & 1) + (idx >> 1); const int x = (idx & 1) ? 15 - pr : pr;
    fox::BlockRef<__hip_bfloat16, __hip_bfloat16> r; r.Q = Qb + (size_t)x * 256 * cfg::QKVW; r.K = Kb; r.V = Vb; r.O = Ob + (size_t)x * 256 * cfg::DM; r.P0 = 64 + 256 * x; return r; }
__device__ __forceinline__ void fox_wg(PP P, int l, int a, char* lds) {
    using namespace cfg;
    typedef __hip_bfloat16 bf;
    const int bh = a >> 1, b = bh >> 3, h = bh & 7;
    float* bias = (float*)(lds + fox::BIAS_OFF); float* scr = (float*)(lds + fox::SCAN_OFF);
    fox_bias(P, l, b, h, bias, scr);
    const bf* QKV = (const bf*)(P->ws + WS_QKV); bf* Y = (bf*)(P->ws + WS_Y);
    const bf* Kb = QKV + (size_t)b * SEQP * QKVW + 1024 + h * 128; const bf* Vb = Kb + 1024; const bf* Qb = QKV + ((size_t)b * SEQP + 64) * QKVW + h * 128;
    bf* Ob = Y + (size_t)b * SEQ * DM + 1024 + h * 128;
    constexpr int W = 1 << 30;
    fox::Seam<bf> S;
    fox::BlockRef<bf, bf> cur = fox_mk(a, 0, Qb, Kb, Vb, Ob);
    fox::causal_swa_prime<bf, bf>(cur, W, lds, S);
#pragma unroll 1
    for (int idx = 0; idx < 8; ++idx) {
        const fox::BlockRef<bf, bf> nxt = (idx < 7) ? fox_mk(a, idx + 1, Qb, Kb, Vb, Ob) : cur;
        fox::causal_swa_block<bf, bf>(cur, nxt, SEQP, W, lds, S, bias);
        cur = nxt;
    }
    if (b == 0) fox_meta(P, h, bias);
}

#define WS_PTR(T, off) ((T*)(Q->ws + (off)))
#define SEAM() do { PP Qb_ = launder(P); XcdBarrier b_; b_.bar = (unsigned*)(Qb_->ws + WS_CTL); b_.x = xb_xcc_id(); b_.st = (volatile LAS unsigned*)(lds + LDS_BARW); xcd_barrier(b_); } while (0)
__global__ void __launch_bounds__(512, 2) hymba_fwd(Params Pv) {
    using namespace cfg;
    PP P = (PP)__builtin_amdgcn_kernarg_segment_ptr();
    extern __shared__ __attribute__((aligned(16))) unsigned char lds_raw[];
    LAS unsigned char* lds = (LAS unsigned char*)lds_raw;
    if (threadIdx.x < 4) ((LAS unsigned*)(lds + LDS_BARW))[threadIdx.x] = 0u;
    __syncthreads();
    { PP Q = launder(P); (void)xcd_barrier_post((unsigned*)(Q->ws + WS_CTL), (volatile LAS unsigned*)(lds + LDS_BARW)); }

    { PP Q = launder(P); phase_convert(Q, lds, 0, 1, lbid(), (int)gridDim.x); phase_init(Q); }
    SEAM();
    {
        PP Q = launder(P); const unsigned char* wl = Q->ws + WS_W + (size_t)0 * W_LAYER;
        pg8::Gemm g{WS_PTR(const bf16_t, WS_HB), (const bf16_t*)(wl + WO_GU1), MMAIN, NGU, DM}; pg8::StaticOrder S; S.init(MMAIN, NGU, (int)gridDim.x, lbid());
        pg8::EpiGU E{WS_PTR(bf16_t, WS_ACT), WS_PTR(const float, WS_SS) + (size_t)(0) * 8 * MROWS, (LAS float*)(lds + 131072 + 4096)};
        pg8::gemm_phase<pg8::EpiGU, pg8::StaticOrder, true, true>(lds, g, S, E);
        skinny_gu(WS_PTR(const bf16_t, WS_HB), g.Bt, WS_PTR(const float, WS_SSM) + (0) * 2048, WS_PTR(bf16_t, WS_ACT), lds);
    }
    SEAM();
    {
        PP Q = launder(P); const unsigned char* wl = Q->ws + WS_W + (size_t)0 * W_LAYER;
        pg8::Gemm g{WS_PTR(const bf16_t, WS_ACT), (const bf16_t*)(wl + WO_D1), MMAIN, DM, DFF}; pg8::StaticOrder S; S.init(MMAIN, DM, (int)gridDim.x, lbid());
        pg8::EpiRes E{WS_PTR(bf16_t, WS_HB), WS_PTR(float, WS_SS) + (size_t)(1) * 8 * MROWS, 0.5f, (LAS float*)(lds + 131072)};
        pg8::gemm_phase<pg8::EpiRes, pg8::StaticOrder, true, true>(lds, g, S, E);
        skinny_res(WS_PTR(const bf16_t, WS_ACT) + (size_t)MMAIN * DFF, DFF, g.Bt, WS_PTR(bf16_t, WS_HB), WS_PTR(float, WS_SSM) + (1) * 2048, 0.5f, lds);
    }
    SEAM();
    {
        PP Q = launder(P); const unsigned char* wl = Q->ws + WS_W + (size_t)0 * W_LAYER;
        pg8::Gemm g{WS_PTR(const bf16_t, WS_HB), (const bf16_t*)(wl + WO_IN), MMAIN, NIN, DM}; pg8::StaticOrder S; S.init(MMAIN, NIN, (int)gridDim.x, lbid());
        pg8::EpiP E{WS_PTR(bf16_t, WS_PR), WS_PTR(float, WS_PS), WS_PTR(bf16_t, WS_QKV), WS_PTR(const float, WS_SS) + (size_t)(1) * 8 * MROWS, (LAS float*)(lds + 131072 + 4096)};
        pg8::gemm_phase<pg8::EpiP, pg8::StaticOrder, true, true>(lds, g, S, E);
        skinny_p(WS_PTR(const bf16_t, WS_HB), g.Bt, WS_PTR(const float, WS_SSM) + (1) * 2048, WS_PTR(bf16_t, WS_PR), WS_PTR(float, WS_PS), WS_PTR(bf16_t, WS_QKV), lds);
    }
    SEAM();
    {
        PP Q = launder(P); const int u = lbid();
        if (u < 128) { rwkv_chunked(Q, 0, u >> 4, u & 15, lds); __syncthreads(); phase_convert(launder(P), lds, 1, 2, u, 128, 16896, 21248); }
        else { fox_wg(Q, 0, u - 128, (char*)lds_raw); __syncthreads(); phase_convert(launder(P), lds, 1, 2, u - 128, 128, 0, 16896); }
    }
    SEAM();
    { PP Q = launder(P); phase_foxnorm(Q); }
    SEAM();
    {
        PP Q = launder(P); const unsigned char* wl = Q->ws + WS_W + (size_t)0 * W_LAYER;
        pg8::Gemm g{WS_PTR(const bf16_t, WS_Y), (const bf16_t*)(wl + WO_OUT), MMAIN, DM, DM}; pg8::StaticOrder S; S.init(MMAIN, DM, (int)gridDim.x, lbid());
        pg8::EpiRes E{WS_PTR(bf16_t, WS_HB), WS_PTR(float, WS_SS) + (size_t)(2) * 8 * MROWS, 1.0f, (LAS float*)(lds + 131072)};
        pg8::gemm_phase<pg8::EpiRes, pg8::StaticOrder, true, true>(lds, g, S, E);
        skinny_res(WS_PTR(const bf16_t, WS_Y) + (size_t)MMAIN * DM, DM, g.Bt, WS_PTR(bf16_t, WS_HB), WS_PTR(float, WS_SSM) + (2) * 2048, 1.0f, lds);
    }
    SEAM();
    {
        PP Q = launder(P); const unsigned char* wl = Q->ws + WS_W + (size_t)0 * W_LAYER;
        pg8::Gemm g{WS_PTR(const bf16_t, WS_HB), (const bf16_t*)(wl + WO_GU2), MMAIN, NGU, DM}; pg8::StaticOrder S; S.init(MMAIN, NGU, (int)gridDim.x, lbid());
        pg8::EpiGU E{WS_PTR(bf16_t, WS_ACT), WS_PTR(const float, WS_SS) + (size_t)(2) * 8 * MROWS, (LAS float*)(lds + 131072 + 4096)};
        pg8::gemm_phase<pg8::EpiGU, pg8::StaticOrder, true, true>(lds, g, S, E);
        skinny_gu(WS_PTR(const bf16_t, WS_HB), g.Bt, WS_PTR(const float, WS_SSM) + (2) * 2048, WS_PTR(bf16_t, WS_ACT), lds);
    }
    SEAM();
    {
        PP Q = launder(P); const unsigned char* wl = Q->ws + WS_W + (size_t)0 * W_LAYER;
        pg8::Gemm g{WS_PTR(const bf16_t, WS_ACT), (const bf16_t*)(wl + WO_D2), MMAIN, DM, DFF}; pg8::StaticOrder S; S.init(MMAIN, DM, (int)gridDim.x, lbid());
        pg8::EpiRes E{WS_PTR(bf16_t, WS_HB), WS_PTR(float, WS_SS) + (size_t)(3) * 8 * MROWS, 0.5f, (LAS float*)(lds + 131072)};
        pg8::gemm_phase<pg8::EpiRes, pg8::StaticOrder, true, true>(lds, g, S, E);
        skinny_res(WS_PTR(const bf16_t, WS_ACT) + (size_t)MMAIN * DFF, DFF, g.Bt, WS_PTR(bf16_t, WS_HB), WS_PTR(float, WS_SSM) + (3) * 2048, 0.5f, lds);
    }
    SEAM();
    {
        PP Q = launder(P); const unsigned char* wl = Q->ws + WS_W + (size_t)1 * W_LAYER;
        pg8::Gemm g{WS_PTR(const bf16_t, WS_HB), (const bf16_t*)(wl + WO_GU1), MMAIN, NGU, DM}; pg8::StaticOrder S; S.init(MMAIN, NGU, (int)gridDim.x, lbid());
        pg8::EpiGU E{WS_PTR(bf16_t, WS_ACT), WS_PTR(const float, WS_SS) + (size_t)(3) * 8 * MROWS, (LAS float*)(lds + 131072 + 4096)};
        pg8::gemm_phase<pg8::EpiGU, pg8::StaticOrder, true, true>(lds, g, S, E);
        skinny_gu(WS_PTR(const bf16_t, WS_HB), g.Bt, WS_PTR(const float, WS_SSM) + (3) * 2048, WS_PTR(bf16_t, WS_ACT), lds);
    }
    SEAM();
    {
        PP Q = launder(P); const unsigned char* wl = Q->ws + WS_W + (size_t)1 * W_LAYER;
        pg8::Gemm g{WS_PTR(const bf16_t, WS_ACT), (const bf16_t*)(wl + WO_D1), MMAIN, DM, DFF}; pg8::StaticOrder S; S.init(MMAIN, DM, (int)gridDim.x, lbid());
        pg8::EpiRes E{WS_PTR(bf16_t, WS_HB), WS_PTR(float, WS_SS) + (size_t)(4) * 8 * MROWS, 0.5f, (LAS float*)(lds + 131072)};
        pg8::gemm_phase<pg8::EpiRes, pg8::StaticOrder, true, true>(lds, g, S, E);
        skinny_res(WS_PTR(const bf16_t, WS_ACT) + (size_t)MMAIN * DFF, DFF, g.Bt, WS_PTR(bf16_t, WS_HB), WS_PTR(float, WS_SSM) + (4) * 2048, 0.5f, lds);
    }
    SEAM();
    {
        PP Q = launder(P); const unsigned char* wl = Q->ws + WS_W + (size_t)1 * W_LAYER;
        pg8::Gemm g{WS_PTR(const bf16_t, WS_HB), (const bf16_t*)(wl + WO_IN), MMAIN, NIN, DM}; pg8::StaticOrder S; S.init(MMAIN, NIN, (int)gridDim.x, lbid());
        pg8::EpiP E{WS_PTR(bf16_t, WS_PR), WS_PTR(float, WS_PS), WS_PTR(bf16_t, WS_QKV), WS_PTR(const float, WS_SS) + (size_t)(4) * 8 * MROWS, (LAS float*)(lds + 131072 + 4096)};
        pg8::gemm_phase<pg8::EpiP, pg8::StaticOrder, true, true>(lds, g, S, E);
        skinny_p(WS_PTR(const bf16_t, WS_HB), g.Bt, WS_PTR(const float, WS_SSM) + (4) * 2048, WS_PTR(bf16_t, WS_PR), WS_PTR(float, WS_PS), WS_PTR(bf16_t, WS_QKV), lds);
    }
    SEAM();
    {
        PP Q = launder(P); const int u = lbid();
        if (u < 128) { rwkv_chunked(Q, 1, u >> 4, u & 15, lds); __syncthreads(); phase_convert(launder(P), lds, 2, 3, u, 128, 16896, 21248); }
        else { fox_wg(Q, 1, u - 128, (char*)lds_raw); __syncthreads(); phase_convert(launder(P), lds, 2, 3, u - 128, 128, 0, 16896); }
    }
    SEAM();
    { PP Q = launder(P); phase_foxnorm(Q); }
    SEAM();
    {
        PP Q = launder(P); const unsigned char* wl = Q->ws + WS_W + (size_t)1 * W_LAYER;
        pg8::Gemm g{WS_PTR(const bf16_t, WS_Y), (const bf16_t*)(wl + WO_OUT), MMAIN, DM, DM}; pg8::StaticOrder S; S.init(MMAIN, DM, (int)gridDim.x, lbid());
        pg8::EpiRes E{WS_PTR(bf16_t, WS_HB), WS_PTR(float, WS_SS) + (size_t)(5) * 8 * MROWS, 1.0f, (LAS float*)(lds + 131072)};
        pg8::gemm_phase<pg8::EpiRes, pg8::StaticOrder, true, true>(lds, g, S, E);
        skinny_res(WS_PTR(const bf16_t, WS_Y) + (size_t)MMAIN * DM, DM, g.Bt, WS_PTR(bf16_t, WS_HB), WS_PTR(float, WS_SSM) + (5) * 2048, 1.0f, lds);
    }
    SEAM();
    {
        PP Q = launder(P); const unsigned char* wl = Q->ws + WS_W + (size_t)1 * W_LAYER;
        pg8::Gemm g{WS_PTR(const bf16_t, WS_HB), (const bf16_t*)(wl + WO_GU2), MMAIN, NGU, DM}; pg8::StaticOrder S; S.init(MMAIN, NGU, (int)gridDim.x, lbid());
        pg8::EpiGU E{WS_PTR(bf16_t, WS_ACT), WS_PTR(const float, WS_SS) + (size_t)(5) * 8 * MROWS, (LAS float*)(lds + 131072 + 4096)};
        pg8::gemm_phase<pg8::EpiGU, pg8::StaticOrder, true, true>(lds, g, S, E);
        skinny_gu(WS_PTR(const bf16_t, WS_HB), g.Bt, WS_PTR(const float, WS_SSM) + (5) * 2048, WS_PTR(bf16_t, WS_ACT), lds);
    }
    SEAM();
    {
        PP Q = launder(P); const unsigned char* wl = Q->ws + WS_W + (size_t)1 * W_LAYER;
        pg8::Gemm g{WS_PTR(const bf16_t, WS_ACT), (const bf16_t*)(wl + WO_D2), MMAIN, DM, DFF}; pg8::StaticOrder S; S.init(MMAIN, DM, (int)gridDim.x, lbid());
        pg8::EpiRes E{WS_PTR(bf16_t, WS_HB), WS_PTR(float, WS_SS) + (size_t)(6) * 8 * MROWS, 0.5f, (LAS float*)(lds + 131072)};
        pg8::gemm_phase<pg8::EpiRes, pg8::StaticOrder, true, true>(lds, g, S, E);
        skinny_res(WS_PTR(const bf16_t, WS_ACT) + (size_t)MMAIN * DFF, DFF, g.Bt, WS_PTR(bf16_t, WS_HB), WS_PTR(float, WS_SSM) + (6) * 2048, 0.5f, lds);
    }
    SEAM();
    {
        PP Q = launder(P); const unsigned char* wl = Q->ws + WS_W + (size_t)2 * W_LAYER;
        pg8::Gemm g{WS_PTR(const bf16_t, WS_HB), (const bf16_t*)(wl + WO_GU1), MMAIN, NGU, DM}; pg8::StaticOrder S; S.init(MMAIN, NGU, (int)gridDim.x, lbid());
        pg8::EpiGU E{WS_PTR(bf16_t, WS_ACT), WS_PTR(const float, WS_SS) + (size_t)(6) * 8 * MROWS, (LAS float*)(lds + 131072 + 4096)};
        pg8::gemm_phase<pg8::EpiGU, pg8::StaticOrder, true, true>(lds, g, S, E);
        skinny_gu(WS_PTR(const bf16_t, WS_HB), g.Bt, WS_PTR(const float, WS_SSM) + (6) * 2048, WS_PTR(bf16_t, WS_ACT), lds);
    }
    SEAM();
    {
        PP Q = launder(P); const unsigned char* wl = Q->ws + WS_W + (size_t)2 * W_LAYER;
        pg8::Gemm g{WS_PTR(const bf16_t, WS_ACT), (const bf16_t*)(wl + WO_D1), MMAIN, DM, DFF}; pg8::StaticOrder S; S.init(MMAIN, DM, (int)gridDim.x, lbid());
        pg8::EpiRes E{WS_PTR(bf16_t, WS_HB), WS_PTR(float, WS_SS) + (size_t)(7) * 8 * MROWS, 0.5f, (LAS float*)(lds + 131072)};
        pg8::gemm_phase<pg8::EpiRes, pg8::StaticOrder, true, true>(lds, g, S, E);
        skinny_res(WS_PTR(const bf16_t, WS_ACT) + (size_t)MMAIN * DFF, DFF, g.Bt, WS_PTR(bf16_t, WS_HB), WS_PTR(float, WS_SSM) + (7) * 2048, 0.5f, lds);
    }
    SEAM();
    {
        PP Q = launder(P); const unsigned char* wl = Q->ws + WS_W + (size_t)2 * W_LAYER;
        pg8::Gemm g{WS_PTR(const bf16_t, WS_HB), (const bf16_t*)(wl + WO_IN), MMAIN, NIN, DM}; pg8::StaticOrder S; S.init(MMAIN, NIN, (int)gridDim.x, lbid());
        pg8::EpiP E{WS_PTR(bf16_t, WS_PR), WS_PTR(float, WS_PS), WS_PTR(bf16_t, WS_QKV), WS_PTR(const float, WS_SS) + (size_t)(7) * 8 * MROWS, (LAS float*)(lds + 131072 + 4096)};
        pg8::gemm_phase<pg8::EpiP, pg8::StaticOrder, true, true>(lds, g, S, E);
        skinny_p(WS_PTR(const bf16_t, WS_HB), g.Bt, WS_PTR(const float, WS_SSM) + (7) * 2048, WS_PTR(bf16_t, WS_PR), WS_PTR(float, WS_PS), WS_PTR(bf16_t, WS_QKV), lds);
    }
    SEAM();
    {
        PP Q = launder(P); const int u = lbid();
        if (u < 128) { rwkv_chunked(Q, 2, u >> 4, u & 15, lds); __syncthreads(); phase_convert(launder(P), lds, 3, 4, u, 128, 16896, 21248); }
        else { fox_wg(Q, 2, u - 128, (char*)lds_raw); __syncthreads(); phase_convert(launder(P), lds, 3, 4, u - 128, 128, 0, 16896); }
    }
    SEAM();
    { PP Q = launder(P); phase_foxnorm(Q); }
    SEAM();
    {
        PP Q = launder(P); const unsigned char* wl = Q->ws + WS_W + (size_t)2 * W_LAYER;
        pg8::Gemm g{WS_PTR(const bf16_t, WS_Y), (const bf16_t*)(wl + WO_OUT), MMAIN, DM, DM}; pg8::StaticOrder S; S.init(MMAIN, DM, (int)gridDim.x, lbid());
        pg8::EpiRes E{WS_PTR(bf16_t, WS_HB), WS_PTR(float, WS_SS) + (size_t)(8) * 8 * MROWS, 1.0f, (LAS float*)(lds + 131072)};
        pg8::gemm_phase<pg8::EpiRes, pg8::StaticOrder, true, true>(lds, g, S, E);
        skinny_res(WS_PTR(const bf16_t, WS_Y) + (size_t)MMAIN * DM, DM, g.Bt, WS_PTR(bf16_t, WS_HB), WS_PTR(float, WS_SSM) + (8) * 2048, 1.0f, lds);
    }
    SEAM();
    {
        PP Q = launder(P); const unsigned char* wl = Q->ws + WS_W + (size_t)2 * W_LAYER;
        pg8::Gemm g{WS_PTR(const bf16_t, WS_HB), (const bf16_t*)(wl + WO_GU2), MMAIN, NGU, DM}; pg8::StaticOrder S; S.init(MMAIN, NGU, (int)gridDim.x, lbid());
        pg8::EpiGU E{WS_PTR(bf16_t, WS_ACT), WS_PTR(const float, WS_SS) + (size_t)(8) * 8 * MROWS, (LAS float*)(lds + 131072 + 4096)};
        pg8::gemm_phase<pg8::EpiGU, pg8::StaticOrder, true, true>(lds, g, S, E);
        skinny_gu(WS_PTR(const bf16_t, WS_HB), g.Bt, WS_PTR(const float, WS_SSM) + (8) * 2048, WS_PTR(bf16_t, WS_ACT), lds);
    }
    SEAM();
    {
        PP Q = launder(P); const unsigned char* wl = Q->ws + WS_W + (size_t)2 * W_LAYER;
        pg8::Gemm g{WS_PTR(const bf16_t, WS_ACT), (const bf16_t*)(wl + WO_D2), MMAIN, DM, DFF}; pg8::StaticOrder S; S.init(MMAIN, DM, (int)gridDim.x, lbid());
        pg8::EpiRes E{WS_PTR(bf16_t, WS_HB), WS_PTR(float, WS_SS) + (size_t)(9) * 8 * MROWS, 0.5f, (LAS float*)(lds + 131072)};
        pg8::gemm_phase<pg8::EpiRes, pg8::StaticOrder, true, true>(lds, g, S, E);
        skinny_res(WS_PTR(const bf16_t, WS_ACT) + (size_t)MMAIN * DFF, DFF, g.Bt, WS_PTR(bf16_t, WS_HB), WS_PTR(float, WS_SSM) + (9) * 2048, 0.5f, lds);
    }
    SEAM();
    {
        PP Q = launder(P); const unsigned char* wl = Q->ws + WS_W + (size_t)3 * W_LAYER;
        pg8::Gemm g{WS_PTR(const bf16_t, WS_HB), (const bf16_t*)(wl + WO_GU1), MMAIN, NGU, DM}; pg8::StaticOrder S; S.init(MMAIN, NGU, (int)gridDim.x, lbid());
        pg8::EpiGU E{WS_PTR(bf16_t, WS_ACT), WS_PTR(const float, WS_SS) + (size_t)(9) * 8 * MROWS, (LAS float*)(lds + 131072 + 4096)};
        pg8::gemm_phase<pg8::EpiGU, pg8::StaticOrder, true, true>(lds, g, S, E);
        skinny_gu(WS_PTR(const bf16_t, WS_HB), g.Bt, WS_PTR(const float, WS_SSM) + (9) * 2048, WS_PTR(bf16_t, WS_ACT), lds);
    }
    SEAM();
    {
        PP Q = launder(P); const unsigned char* wl = Q->ws + WS_W + (size_t)3 * W_LAYER;
        pg8::Gemm g{WS_PTR(const bf16_t, WS_ACT), (const bf16_t*)(wl + WO_D1), MMAIN, DM, DFF}; pg8::StaticOrder S; S.init(MMAIN, DM, (int)gridDim.x, lbid());
        pg8::EpiRes E{WS_PTR(bf16_t, WS_HB), WS_PTR(float, WS_SS) + (size_t)(10) * 8 * MROWS, 0.5f, (LAS float*)(lds + 131072)};
        pg8::gemm_phase<pg8::EpiRes, pg8::StaticOrder, true, true>(lds, g, S, E);
        skinny_res(WS_PTR(const bf16_t, WS_ACT) + (size_t)MMAIN * DFF, DFF, g.Bt, WS_PTR(bf16_t, WS_HB), WS_PTR(float, WS_SSM) + (10) * 2048, 0.5f, lds);
    }
    SEAM();
    {
        PP Q = launder(P); const unsigned char* wl = Q->ws + WS_W + (size_t)3 * W_LAYER;
        pg8::Gemm g{WS_PTR(const bf16_t, WS_HB), (const bf16_t*)(wl + WO_IN), MMAIN, NIN, DM}; pg8::StaticOrder S; S.init(MMAIN, NIN, (int)gridDim.x, lbid());
        pg8::EpiP E{WS_PTR(bf16_t, WS_PR), WS_PTR(float, WS_PS), WS_PTR(bf16_t, WS_QKV), WS_PTR(const float, WS_SS) + (size_t)(10) * 8 * MROWS, (LAS float*)(lds + 131072 + 4096)};
        pg8::gemm_phase<pg8::EpiP, pg8::StaticOrder, true, true>(lds, g, S, E);
        skinny_p(WS_PTR(const bf16_t, WS_HB), g.Bt, WS_PTR(const float, WS_SSM) + (10) * 2048, WS_PTR(bf16_t, WS_PR), WS_PTR(float, WS_PS), WS_PTR(bf16_t, WS_QKV), lds);
    }
    SEAM();
    {
        PP Q = launder(P); const int u = lbid();
        if (u < 128) { rwkv_chunked(Q, 3, u >> 4, u & 15, lds); }
        else { fox_wg(Q, 3, u - 128, (char*)lds_raw);  }
    }
    SEAM();
    { PP Q = launder(P); phase_foxnorm(Q); }
    SEAM();
    {
        PP Q = launder(P); const unsigned char* wl = Q->ws + WS_W + (size_t)3 * W_LAYER;
        pg8::Gemm g{WS_PTR(const bf16_t, WS_Y), (const bf16_t*)(wl + WO_OUT), MMAIN, DM, DM}; pg8::StaticOrder S; S.init(MMAIN, DM, (int)gridDim.x, lbid());
        pg8::EpiRes E{WS_PTR(bf16_t, WS_HB), WS_PTR(float, WS_SS) + (size_t)(11) * 8 * MROWS, 1.0f, (LAS float*)(lds + 131072)};
        pg8::gemm_phase<pg8::EpiRes, pg8::StaticOrder, true, true>(lds, g, S, E);
        skinny_res(WS_PTR(const bf16_t, WS_Y) + (size_t)MMAIN * DM, DM, g.Bt, WS_PTR(bf16_t, WS_HB), WS_PTR(float, WS_SSM) + (11) * 2048, 1.0f, lds);
    }
    SEAM();
    {
        PP Q = launder(P); const unsigned char* wl = Q->ws + WS_W + (size_t)3 * W_LAYER;
        pg8::Gemm g{WS_PTR(const bf16_t, WS_HB), (const bf16_t*)(wl + WO_GU2), MMAIN, NGU, DM}; pg8::StaticOrder S; S.init(MMAIN, NGU, (int)gridDim.x, lbid());
        pg8::EpiGU E{WS_PTR(bf16_t, WS_ACT), WS_PTR(const float, WS_SS) + (size_t)(11) * 8 * MROWS, (LAS float*)(lds + 131072 + 4096)};
        pg8::gemm_phase<pg8::EpiGU, pg8::StaticOrder, true, true>(lds, g, S, E);
        skinny_gu(WS_PTR(const bf16_t, WS_HB), g.Bt, WS_PTR(const float, WS_SSM) + (11) * 2048, WS_PTR(bf16_t, WS_ACT), lds);
    }
    SEAM();
    {
        PP Q = launder(P); const unsigned char* wl = Q->ws + WS_W + (size_t)3 * W_LAYER;
        pg8::Gemm g{WS_PTR(const bf16_t, WS_ACT), (const bf16_t*)(wl + WO_D2), MMAIN, DM, DFF}; pg8::StaticOrder S; S.init(MMAIN, DM, (int)gridDim.x, lbid());
        pg8::EpiRes E{WS_PTR(bf16_t, WS_HB), WS_PTR(float, WS_SS) + (size_t)(12) * 8 * MROWS, 0.5f, (LAS float*)(lds + 131072)};
        pg8::gemm_phase<pg8::EpiRes, pg8::StaticOrder, true, true>(lds, g, S, E);
        skinny_res(WS_PTR(const bf16_t, WS_ACT) + (size_t)MMAIN * DFF, DFF, g.Bt, WS_PTR(bf16_t, WS_HB), WS_PTR(float, WS_SSM) + (12) * 2048, 0.5f, lds);
    }
    SEAM();
    { PP Q = launder(P); phase_final(Q); }
}

extern "C" void kernel_launch(void* const* d_in, const int* in_sizes, int n_in, void* d_out, int out_size, void* d_ws, size_t ws_size, hipStream_t stream) {
    using namespace cfg;
    static int grid = 0;
    if (grid == 0) {
        if (n_in != 25 || out_size != MMAIN * DM || ws_size < WS_END) { fprintf(stderr, "kernel_launch: need 25 inputs, out %d, ws >= %zu; got n_in %d out %d ws %zu\n", MMAIN * DM, (size_t)WS_END, n_in, out_size, ws_size); grid = -1; return; }
        int dev = 0, cus = 0, per_cu = 0;
        if (hipGetDevice(&dev) != hipSuccess || hipDeviceGetAttribute(&cus, hipDeviceAttributeMultiprocessorCount, dev) != hipSuccess) { grid = -1; return; }
        if (hipFuncSetAttribute((const void*)hymba_fwd, hipFuncAttributeMaxDynamicSharedMemorySize, LDS_BYTES) != hipSuccess) { fprintf(stderr, "kernel_launch: hipFuncSetAttribute failed\n"); grid = -1; return; }
        if (hipOccupancyMaxActiveBlocksPerMultiprocessor(&per_cu, (const void*)hymba_fwd, 512, LDS_BYTES) != hipSuccess || per_cu < 1) fprintf(stderr, "kernel_launch: occupancy query says %d\n", per_cu);
        (void)hipGetLastError();
        if (cus < 256) { fprintf(stderr, "kernel_launch: built for a 256-CU device (one resident workgroup per CU), found %d CUs\n", cus); grid = -1; return; }
        grid = 256;
    }
    if (grid < 0) return;
    if (hipMemsetAsync((char*)d_ws + WS_CTL, 0, CTL_BYTES, stream) != hipSuccess) return;
    Params p{};
    for (int i = 0; i < 25; ++i) p.in[i] = (const float*)d_in[i];
    p.out = (float*)d_out; p.ws = (unsigned char*)d_ws; p.ph_lo = 0; p.ph_hi = 0;
    hipLaunchKernelGGL(hymba_fwd, dim3(grid), dim3(512), LDS_BYTES, stream, p);
}
```

```cpp
#include <hip/hip_runtime.h>
#include <hip/hip_bf16.h>
#include <cstdio>
#include <cstdint>

#define LAS __attribute__((address_space(3)))
namespace cfg {
constexpr int DM = 2048, NBATCH = 8, SEQ = 4096, NMETA = 16, DEPTH = 4;
constexpr int MMAIN = NBATCH * SEQ;
constexpr int MROWS = MMAIN + 256;
constexpr int DFF = 5632, NGU = 2 * DFF;
constexpr int RW = 1024, RH = 64, RNH = 16;
constexpr int FW = 1024, FH = 128, FNH = 8;
constexpr int RWKV_COLS = 3360, DIN = 6440;
constexpr int NIN = 6656;
constexpr int PRW = 3072, PSW = 512, QKVW = 3072;
constexpr int SEQP = 4160;
constexpr float NORM_EPS = 1e-6f, LNX_EPS = 64e-5f;
constexpr int NSS = 13;
constexpr size_t al256(size_t x) { return (x + 255) & ~(size_t)255; }
constexpr size_t WS_CTL = 0;
constexpr size_t CTL_BYTES = 65536;
constexpr size_t WS_SS = WS_CTL + CTL_BYTES;
constexpr size_t SS_BYTES = al256((size_t)NSS * 8 * MROWS * 4);
constexpr size_t ZERO_BYTES = CTL_BYTES + SS_BYTES;
constexpr size_t WS_SSM = WS_SS + SS_BYTES;
constexpr size_t SSM_BYTES = (size_t)NSS * 2048 * 4;
constexpr size_t WS_HMETA = WS_SSM + SSM_BYTES;
constexpr size_t WS_HB = WS_HMETA + (size_t)256 * DM * 4;
constexpr size_t WS_Y = WS_HB + (size_t)MROWS * DM * 2;
constexpr size_t WS_OVL = WS_Y + (size_t)MROWS * DM * 2;
constexpr size_t WS_ACT = WS_OVL;
constexpr size_t WS_PR = WS_OVL;
constexpr size_t WS_PS = WS_PR + (size_t)MROWS * PRW * 2;
constexpr size_t WS_QKV = WS_PS + (size_t)MROWS * PSW * 4;
constexpr size_t OVL_A = (size_t)MROWS * DFF * 2, OVL_B = (size_t)MROWS * PRW * 2 + (size_t)MROWS * PSW * 4 + (size_t)NBATCH * SEQP * QKVW * 2;
constexpr size_t WS_W = WS_OVL + al256(OVL_A > OVL_B ? OVL_A : OVL_B);
constexpr size_t W_GU = (size_t)NGU * DM * 2, W_D = (size_t)DM * DFF * 2, W_IN = (size_t)NIN * DM * 2, W_OUT = (size_t)DM * DM * 2;
constexpr size_t WO_GU1 = 0, WO_D1 = WO_GU1 + W_GU, WO_IN = WO_D1 + W_D, WO_OUT = WO_IN + W_IN, WO_GU2 = WO_OUT + W_OUT, WO_D2 = WO_GU2 + W_GU, W_LAYER = WO_D2 + W_D;
constexpr size_t WS_END = WS_W + (size_t)DEPTH * W_LAYER;
constexpr int LDS_BYTES = 147456;
constexpr int LDS_BARW = LDS_BYTES - 16;
}
__device__ __forceinline__ int ltid() { int t = (int)threadIdx.x; asm volatile("" : "+v"(t)); return t; }
__device__ __forceinline__ int lbid() { int t = (int)blockIdx.x; asm volatile("" : "+s"(t)); return t; }
__device__ __forceinline__ int lzero() { int t = 0; asm volatile("" : "+v"(t)); return t; }
namespace pg8 {
#define PG8_LAS __attribute__((address_space(3)))
typedef unsigned short bf16_t;
typedef short bf16x8 __attribute__((ext_vector_type(8)));
typedef float f32x4 __attribute__((ext_vector_type(4)));
typedef unsigned u32x4 __attribute__((ext_vector_type(4)));
constexpr int BM = 256, BK = 64, HALF = 128, HTB = HALF * BK * 2  , STAGE_BYTES = 8 * HTB, NXCD = 8, WGM = 8;

__host__ __device__ __forceinline__ int lds_byte(int r, int c) { const int st = (r >> 4) * 2 + (c >> 5), rr = r & 15, cc = c & 31, ob = rr * 64 + cc * 2; return st * 1024 + (ob ^ (((ob >> 9) & 1) << 5)); }
__host__ __device__ __forceinline__ void stage_rc(int b, int& R, int& C) { const int st = b / 1024, sb = b % 1024, swz = sb ^ (((sb >> 9) & 1) << 5); R = (st >> 1) * 16 + swz / 64; C = (st & 1) * 32 + (swz % 64) / 2; }
__host__ __device__ __forceinline__ int perm32(int rho) { const int n = rho >> 4, i = rho & 15; return 8 * (i >> 2) + 4 * n + (i & 3); }

struct Unit { int pm, pn; };
struct Gemm { const bf16_t* A; const bf16_t* Bt; int M, N, K; };

struct StaticOrder {
    int nM, nN, nwg, G, c;
    __host__ __device__ void init(int M, int N, int G_, int c_) { nM = M / BM; nN = N / BM; nwg = nM * nN; G = G_; c = c_; }
    __host__ __device__ bool next(int i, Unit& u) const {
        const long L = (long)i * G + c; if (L >= nwg) return false;
        int wgid = (int)L; { const int q = nwg / NXCD, r = nwg % NXCD, xcd = wgid % NXCD, off = wgid / NXCD; wgid = (xcd < r ? xcd * (q + 1) : r * (q + 1) + (xcd - r) * q) + off; }
        const int nig = WGM * nN, gid = wgid / nig, fm = gid * WGM, gsz = (nM - fm) < WGM ? (nM - fm) : WGM;
        u.pm = fm + ((wgid % nig) % gsz); u.pn = (wgid % nig) / gsz; return true;
    }
    __device__ __forceinline__ void a_ready(const Unit&) const {}
    __device__ __forceinline__ void done(const Unit&) const {}
};

__device__ __forceinline__ unsigned cvt_pk_bf16(float lo, float hi) { unsigned r; asm volatile("v_cvt_pk_bf16_f32 %0, %1, %2" : "=v"(r) : "v"(lo), "v"(hi)); return r; }
typedef float f32x2 __attribute__((ext_vector_type(2)));
__device__ __forceinline__ f32x2 gelu_pk(f32x2 v) {
    const f32x2 av = __builtin_elementwise_abs(v), d = av * 0.2316418882f + 1.0f;
    f32x2 t; t.x = __builtin_amdgcn_rcpf(d.x); t.y = __builtin_amdgcn_rcpf(d.y);
    f32x2 q = t * 0.5307027145f + (-0.7265760135f); q = q * t + 0.7107068705f; q = q * t + (-0.142248368f); q = q * t + 0.127414796f; q = q * t;
    const f32x2 s = (v * v) * (-0.72134752044f);
    f32x2 e; e.x = __builtin_amdgcn_exp2f(s.x); e.y = __builtin_amdgcn_exp2f(s.y);
    const f32x2 m = v * (q * e), r = v - m;
    f32x2 o; o.x = v.x < 0.f ? m.x : r.x; o.y = v.y < 0.f ? m.y : r.y; return o;
}
__device__ __forceinline__ float rs_of(const float* ss, int row) { float s = 0.f;
#pragma unroll
    for (int t = 0; t < 8; ++t) s += ss[(size_t)t * 33024 + row];
    return __builtin_amdgcn_rsqf(s * (1.0f / 2048.0f) + 1e-6f); }
__device__ __forceinline__ float silu_f(float x) { return x * __builtin_amdgcn_rcpf(1.0f + __builtin_amdgcn_exp2f(-1.4426950408889634f * x)); }

struct EpiGU {
    static constexpr bool PERM = true, AFTER_DRAIN = false;
    bf16_t* act; const float* ss; PG8_LAS float* rsb;
    __device__ __forceinline__ void operator()(const f32x4 (&acc)[2][2][4][2], const Unit& u, int wr, int wc, int fr, int fq) const {
        if (wr == 0) { const int rl = wc * 64 + fq * 16 + fr; rsb[rl] = rs_of(ss, u.pm * BM + rl); }
        asm volatile("s_waitcnt lgkmcnt(0)" ::: "memory"); __builtin_amdgcn_s_barrier(); asm volatile("" ::: "memory");
        const int rl0 = wr * 64 + fr, row0 = u.pm * BM + rl0, col0 = u.pn * 128 + wc * 32 + 8 * fq;
#pragma unroll
        for (int ai = 0; ai < 2; ++ai)
#pragma unroll
            for (int m = 0; m < 4; ++m) { const int row = row0 + ai * HALF + m * 16; const float rs = rsb[rl0 + ai * HALF + m * 16];
                const f32x4 g0 = acc[ai][0][m][0] * rs, g1 = acc[ai][0][m][1] * rs, u0 = acc[ai][1][m][0] * rs, u1 = acc[ai][1][m][1] * rs;
                u32x4 w;
                w.x = cvt_pk_bf16(silu_f(g0[0]) * u0[0], silu_f(g0[1]) * u0[1]); w.y = cvt_pk_bf16(silu_f(g0[2]) * u0[2], silu_f(g0[3]) * u0[3]);
                w.z = cvt_pk_bf16(silu_f(g1[0]) * u1[0], silu_f(g1[1]) * u1[1]); w.w = cvt_pk_bf16(silu_f(g1[2]) * u1[2], silu_f(g1[3]) * u1[3]);
                *(u32x4*)(act + (size_t)row * 5632 + col0) = w; }
        asm volatile("s_waitcnt lgkmcnt(0)" ::: "memory"); __builtin_amdgcn_s_barrier(); asm volatile("" ::: "memory");
    }
};
struct EpiRes {
    static constexpr bool PERM = true, AFTER_DRAIN = false;
    bf16_t* hb; float* ssn; float alpha; PG8_LAS float* red;
    __device__ __forceinline__ void operator()(const f32x4 (&acc)[2][2][4][2], const Unit& u, int wr, int wc, int fr, int fq) const {
        bf16_t* bbase = hb + (size_t)u.pm * BM * 2048;
        const int rl0 = wr * 64 + fr; unsigned off = (unsigned)(rl0 * 2048 + u.pn * BM + wc * 32 + 8 * fq);
#pragma unroll
        for (int ai = 0; ai < 2; ++ai) {
            u32x4 hv[4][2];
#pragma unroll
            for (int m = 0; m < 4; ++m)
#pragma unroll
                for (int bj = 0; bj < 2; ++bj) hv[m][bj] = *(const u32x4*)(bbase + (off + (unsigned)((ai * HALF + m * 16) * 2048) + bj * HALF));
#pragma unroll
            for (int m = 0; m < 4; ++m) { const unsigned o = off + (unsigned)((ai * HALF + m * 16) * 2048); float sq = 0.f;
#pragma unroll
                for (int bj = 0; bj < 2; ++bj) { const u32x4 x = hv[m][bj];
                    const f32x4 h0 = (f32x4){__uint_as_float(x.x << 16), __uint_as_float(x.x & 0xffff0000u), __uint_as_float(x.y << 16), __uint_as_float(x.y & 0xffff0000u)} + acc[ai][bj][m][0] * alpha;
                    const f32x4 h1 = (f32x4){__uint_as_float(x.z << 16), __uint_as_float(x.z & 0xffff0000u), __uint_as_float(x.w << 16), __uint_as_float(x.w & 0xffff0000u)} + acc[ai][bj][m][1] * alpha;
                    sq += ((h0[0] * h0[0] + h0[1] * h0[1]) + (h0[2] * h0[2] + h0[3] * h0[3])) + ((h1[0] * h1[0] + h1[1] * h1[1]) + (h1[2] * h1[2] + h1[3] * h1[3]));
                    u32x4 w; w.x = cvt_pk_bf16(h0[0], h0[1]); w.y = cvt_pk_bf16(h0[2], h0[3]); w.z = cvt_pk_bf16(h1[0], h1[1]); w.w = cvt_pk_bf16(h1[2], h1[3]); *(u32x4*)(bbase + o + bj * HALF) = w; }
                sq += __shfl_xor(sq, 16); sq += __shfl_xor(sq, 32);
                if (fq == 0) red[(rl0 + ai * HALF + m * 16) * 4 + wc] = sq; }
            asm volatile("" ::: "memory"); }
        asm volatile("s_waitcnt lgkmcnt(0)" ::: "memory"); __builtin_amdgcn_s_barrier(); asm volatile("" ::: "memory");
        if (wr == 0) { const int row = wc * 64 + fq * 16 + fr; const float s4 = (red[row * 4] + red[row * 4 + 1]) + (red[row * 4 + 2] + red[row * 4 + 3]); ssn[(size_t)u.pn * 33024 + u.pm * BM + row] = s4; }
    }
};
struct EpiP {
    static constexpr bool PERM = true, AFTER_DRAIN = false;
    bf16_t* pr; float* ps; bf16_t* qkv; const float* ss; PG8_LAS float* rsb;
    __device__ __forceinline__ void operator()(const f32x4 (&acc)[2][2][4][2], const Unit& u, int wr, int wc, int fr, int fq) const {
        if (wr == 0) { const int rl = wc * 64 + fq * 16 + fr; rsb[rl] = rs_of(ss, u.pm * BM + rl); }
        asm volatile("s_waitcnt lgkmcnt(0)" ::: "memory"); __builtin_amdgcn_s_barrier(); asm volatile("" ::: "memory");
        const int rl0 = wr * 64 + fr, row0 = u.pm * BM + rl0, cl = wc * 32 + 8 * fq;
#pragma unroll
        for (int ai = 0; ai < 2; ++ai)
#pragma unroll
            for (int m = 0; m < 4; ++m) { const int row = row0 + ai * HALF + m * 16; const float rs = rsb[rl0 + ai * HALF + m * 16];
#pragma unroll
                for (int bj = 0; bj < 2; ++bj) { const f32x4 v0 = acc[ai][bj][m][0] * rs, v1 = acc[ai][bj][m][1] * rs;
                    if (u.pn >= 12 && u.pn < 14) { float* d = ps + (size_t)row * 512 + (u.pn - 12) * 256 + bj * HALF + cl; *(f32x4*)d = v0; *(f32x4*)(d + 4) = v1; }
                    else { u32x4 w; w.x = cvt_pk_bf16(v0[0], v0[1]); w.y = cvt_pk_bf16(v0[2], v0[3]); w.z = cvt_pk_bf16(v1[0], v1[1]); w.w = cvt_pk_bf16(v1[2], v1[3]);
                        if (u.pn < 12) *(u32x4*)(pr + (size_t)row * 3072 + u.pn * 256 + bj * HALF + cl) = w;
                        else { const int c = (u.pn - 14) * 256 + bj * HALF + cl;
                            const int b = row >> 12, s = row & 4095; *(u32x4*)(qkv + ((size_t)b * 4160 + 64 + s) * 3072 + c) = w; } } } }
        asm volatile("s_waitcnt lgkmcnt(0)" ::: "memory"); __builtin_amdgcn_s_barrier(); asm volatile("" ::: "memory");
    }
};
template <class Epi, class Sched, bool ALIGN_EPI = false, bool SP2 = false>
__device__ __forceinline__ void gemm_phase(PG8_LAS unsigned char* lds, const Gemm g, const Sched& S, const Epi& E) {
    const int tid = ltid(), wid = __builtin_amdgcn_readfirstlane(tid >> 6), lane = tid & 63, wr = wid >> 2, wc = wid & 3, fr = lane & 15, fq = lane >> 4;
    const int K = g.K, nt = K / BK;
    unsigned voffA[2], voffB[2];
#pragma unroll
    for (int i = 0; i < 2; ++i) { int R, C; stage_rc(tid * 16 + i * 8192, R, C); const int Rb = Epi::PERM ? ((R & ~31) + perm32(R & 31)) : R;
        voffA[i] = (unsigned)(R * K + C) * 2u; voffB[i] = (unsigned)(Rb * K + C) * 2u; }
    const size_t kstep = (size_t)(BK * 2);
    const size_t hstep = (size_t)HALF * K * 2;
    const size_t tstep = 2 * hstep;
    const unsigned ldsw = (unsigned)wid * 1024u;
    const int aoff = lds_byte(wr * 64 + fr, fq * 8), boff = lds_byte(wc * 32 + fr, fq * 8);
#define PG8_SA(b, h) (((b) * 2 + (h)) * HTB)
#define PG8_SB(b, h) ((4 + (b) * 2 + (h)) * HTB)
#define PG8_STAGE(bufoff, gbase, voff) do { _Pragma("unroll") for (int _i = 0; _i < 2; ++_i) \
        __builtin_amdgcn_global_load_lds((const unsigned*)((const char*)(gbase) + (voff)[_i]), (PG8_LAS unsigned*)(lds + (bufoff) + ldsw + _i * 8192), 16, 0, 0); } while (0)
#define PG8_LDA(dst, b, h) do { _Pragma("unroll") for (int m = 0; m < 4; ++m) _Pragma("unroll") for (int k = 0; k < 2; ++k) dst[m][k] = *(const PG8_LAS bf16x8*)(lds + PG8_SA(b, h) + aoff + m * 2048 + k * 1024); } while (0)
#define PG8_LDB(dst, b, h) do { _Pragma("unroll") for (int n = 0; n < 2; ++n) _Pragma("unroll") for (int k = 0; k < 2; ++k) dst[n][k] = *(const PG8_LAS bf16x8*)(lds + PG8_SB(b, h) + boff + n * 2048 + k * 1024); } while (0)
#define PG8_MMA(ai, bj, At, Bt) do { __builtin_amdgcn_s_setprio(1); _Pragma("unroll") for (int m = 0; m < 4; ++m) _Pragma("unroll") for (int n = 0; n < 2; ++n) _Pragma("unroll") for (int k = 0; k < 2; ++k) \
        acc[ai][bj][m][n] = __builtin_amdgcn_mfma_f32_16x16x32_bf16(Bt[n][k], At[m][k], acc[ai][bj][m][n], 0, 0, 0); __builtin_amdgcn_s_setprio(0); } while (0)
#define PG8_WAIT_V(n) asm volatile("s_waitcnt vmcnt(" #n ")" ::: "memory")
#define PG8_WAIT_L(n) asm volatile("s_waitcnt lgkmcnt(" #n ")" ::: "memory")
#define PG8_BAR __builtin_amdgcn_s_barrier()
#define PG8_SCHED __builtin_amdgcn_sched_barrier(0)
    Unit cur, nxt; int ui = 0;
    if (!S.next(0, cur)) return;
    f32x4 acc[2][2][4][2];
#pragma unroll
    for (int a = 0; a < 2; ++a)
#pragma unroll
        for (int b = 0; b < 2; ++b)
#pragma unroll
            for (int m = 0; m < 4; ++m)
#pragma unroll
                for (int n = 0; n < 2; ++n) acc[a][b][m][n] = (f32x4){0.f, 0.f, 0.f, 0.f};
    bf16x8 At[4][2], B0[2][2], B1[2][2];
    const char* cA = (const char*)g.A + (size_t)cur.pm * tstep; const char* cB = (const char*)g.Bt + (size_t)cur.pn * tstep;
    S.a_ready(cur);
    if constexpr (SP2) {
        PG8_STAGE(PG8_SB(0, 0), cB, voffB); PG8_STAGE(PG8_SB(0, 1), cB + hstep, voffB); PG8_STAGE(PG8_SA(0, 0), cA, voffA); PG8_STAGE(PG8_SA(0, 1), cA + hstep, voffA);
        if (wr == 1) PG8_BAR;
        PG8_WAIT_V(2); PG8_BAR;
        PG8_STAGE(PG8_SB(1, 0), cB + kstep, voffB); PG8_STAGE(PG8_SA(1, 0), cA + kstep, voffA); PG8_STAGE(PG8_SB(1, 1), cB + hstep + kstep, voffB);
        PG8_WAIT_V(6); PG8_BAR;
    } else {
        PG8_STAGE(PG8_SB(0, 0), cB, voffB); PG8_STAGE(PG8_SA(0, 0), cA, voffA); PG8_STAGE(PG8_SB(0, 1), cB + hstep, voffB); PG8_STAGE(PG8_SA(0, 1), cA + hstep, voffA);
        if (wr == 1) PG8_BAR;
        PG8_WAIT_V(4); PG8_BAR;
        PG8_STAGE(PG8_SB(1, 0), cB + kstep, voffB); PG8_STAGE(PG8_SA(1, 0), cA + kstep, voffA); PG8_STAGE(PG8_SB(1, 1), cB + hstep + kstep, voffB);
        PG8_WAIT_V(6); PG8_BAR;
    }
    for (;;) {
        const bool has_next = S.next(ui + 1, nxt);
        const char* nA = has_next ? (const char*)g.A + (size_t)nxt.pm * tstep : cA; const char* nB = has_next ? (const char*)g.Bt + (size_t)nxt.pn * tstep : cB;
        for (int t = 0; t < nt; t += 2) {
            const bool last = (t == nt - 2);
            const char* a1 = cA + (size_t)(t + 1) * kstep;
            const char* a2 = last ? nA : cA + (size_t)(t + 2) * kstep; const char* b2 = last ? nB : cB + (size_t)(t + 2) * kstep;
            const char* a3 = a2 + kstep; const char* b3 = b2 + kstep;
            if (last && has_next) S.a_ready(nxt);
            if constexpr (SP2) {
            PG8_LDB(B0, 0, 0); PG8_LDB(B1, 0, 1); PG8_SCHED; PG8_LDA(At, 0, 0); PG8_STAGE(PG8_SA(1, 1), a1 + hstep, voffA);
            PG8_WAIT_V(8); PG8_WAIT_L(0); PG8_BAR; PG8_MMA(0, 0, At, B0); PG8_MMA(0, 1, At, B1); PG8_BAR; PG8_SCHED;
            PG8_LDA(At, 0, 1); PG8_STAGE(PG8_SB(0, 0), b2, voffB); PG8_STAGE(PG8_SB(0, 1), b2 + hstep, voffB); PG8_STAGE(PG8_SA(0, 0), a2, voffA);
            PG8_WAIT_V(8); PG8_WAIT_L(0); PG8_BAR; PG8_MMA(1, 0, At, B0); PG8_MMA(1, 1, At, B1); PG8_BAR; PG8_SCHED;
            PG8_LDB(B0, 1, 0); PG8_LDB(B1, 1, 1); PG8_SCHED; PG8_LDA(At, 1, 0); PG8_STAGE(PG8_SA(0, 1), a2 + hstep, voffA);
            PG8_WAIT_V(8); PG8_WAIT_L(0); PG8_BAR; PG8_MMA(0, 0, At, B0); PG8_MMA(0, 1, At, B1); PG8_BAR; PG8_SCHED;
            PG8_LDA(At, 1, 1); PG8_STAGE(PG8_SB(1, 0), b3, voffB); PG8_STAGE(PG8_SB(1, 1), b3 + hstep, voffB); PG8_STAGE(PG8_SA(1, 0), a3, voffA);
            PG8_WAIT_V(8); PG8_WAIT_L(0); PG8_BAR; PG8_MMA(1, 0, At, B0); PG8_MMA(1, 1, At, B1); PG8_BAR; PG8_SCHED;
            } else {
            PG8_LDB(B0, 0, 0); PG8_SCHED; PG8_LDA(At, 0, 0); PG8_STAGE(PG8_SA(1, 1), a1 + hstep, voffA);
            PG8_WAIT_L(8); PG8_BAR; PG8_WAIT_L(0); PG8_MMA(0, 0, At, B0); PG8_BAR; PG8_SCHED;
            PG8_LDB(B1, 0, 1); PG8_STAGE(PG8_SB(0, 0), b2, voffB);
            PG8_BAR; PG8_WAIT_L(0); PG8_MMA(0, 1, At, B1); PG8_BAR;
            PG8_LDA(At, 0, 1); PG8_STAGE(PG8_SA(0, 0), a2, voffA);
            PG8_BAR; PG8_WAIT_L(0); PG8_MMA(1, 0, At, B0); PG8_BAR; PG8_SCHED;
            PG8_STAGE(PG8_SB(0, 1), b2 + hstep, voffB);
            PG8_WAIT_V(6); PG8_BAR; PG8_MMA(1, 1, At, B1); PG8_BAR;
            PG8_LDB(B0, 1, 0); PG8_SCHED; PG8_LDA(At, 1, 0); PG8_STAGE(PG8_SA(0, 1), a2 + hstep, voffA);
            PG8_WAIT_L(8); PG8_BAR; PG8_WAIT_L(0); PG8_MMA(0, 0, At, B0); PG8_BAR; PG8_SCHED;
            PG8_LDB(B1, 1, 1); PG8_STAGE(PG8_SB(1, 0), b3, voffB);
            PG8_BAR; PG8_WAIT_L(0); PG8_MMA(0, 1, At, B1); PG8_BAR;
            PG8_LDA(At, 1, 1); PG8_STAGE(PG8_SA(1, 0), a3, voffA);
            PG8_BAR; PG8_WAIT_L(0); PG8_MMA(1, 0, At, B0); PG8_BAR; PG8_SCHED;
            PG8_STAGE(PG8_SB(1, 1), b3 + hstep, voffB);
            PG8_WAIT_V(6); PG8_BAR; PG8_MMA(1, 1, At, B1); PG8_BAR;
            }
        }
        if constexpr (ALIGN_EPI) { if (wr == 0) PG8_BAR; }
        if constexpr (!Epi::AFTER_DRAIN) { E(acc, cur, wr, wc, fr, fq); S.done(cur); }
        if (!has_next) break;
#pragma unroll
        for (int a = 0; a < 2; ++a)
#pragma unroll
            for (int b = 0; b < 2; ++b)
#pragma unroll
                for (int m = 0; m < 4; ++m)
#pragma unroll
                    for (int n = 0; n < 2; ++n) acc[a][b][m][n] = (f32x4){0.f, 0.f, 0.f, 0.f};
        cur = nxt; cA = nA; cB = nB; ++ui;
        if constexpr (ALIGN_EPI) { if (wr == 1) PG8_BAR; }
    }
    PG8_WAIT_V(0);
    if constexpr (!ALIGN_EPI) { if (wr == 0) PG8_BAR; }
    PG8_BAR;
    if constexpr (Epi::AFTER_DRAIN) { E.fused(acc, cur, wr, wc, fr, fq, lds, wid, lane); S.done(cur); }
#undef PG8_SA
#undef PG8_SB
#undef PG8_STAGE
#undef PG8_LDA
#undef PG8_LDB
#undef PG8_MMA
#undef PG8_WAIT_V
#undef PG8_WAIT_L
#undef PG8_BAR
#undef PG8_SCHED
}
}


#define XB_TMO      128
#define XB_XCNT(j)  (256  + 64 * (j))
#define XB_XSUB(j)  (1280 + 64 * (j))
#define XB_XGEN(j)  (2304 + 64 * (j))
#define XB_TOP      3328
#define XB_TOPGEN   3392
#define XCD_BAR_WORDS 3456
#define XB_SPIN_CAP (1u << 22)

__device__ __forceinline__ unsigned xb_ld(unsigned* p)              { return __hip_atomic_load(p, __ATOMIC_RELAXED, __HIP_MEMORY_SCOPE_AGENT); }
__device__ __forceinline__ unsigned xb_add(unsigned* p, unsigned v) { return __hip_atomic_fetch_add(p, v, __ATOMIC_RELAXED, __HIP_MEMORY_SCOPE_AGENT); }
__device__ __forceinline__ unsigned xb_xcc_id() { return (unsigned)__builtin_amdgcn_s_getreg((3 << 11) | 20) & 0xFu; }
#define XB_SPIN(cond, bar) do { unsigned _sp = 0; while (cond) { __builtin_amdgcn_s_sleep(1); \
    if ((++_sp & 255u) == 0u) { if (xb_ld(&(bar)[XB_TMO])) break; if (_sp > XB_SPIN_CAP) { atomicAdd(&(bar)[XB_TMO], 1u); break; } } } } while (0)

struct XcdBarrier {
    unsigned* bar; unsigned x;
    volatile LAS unsigned* st;
};

__device__ __forceinline__ XcdBarrier xcd_barrier_post(unsigned* bar, volatile LAS unsigned* st) {
    XcdBarrier b; b.bar = bar; b.x = xb_xcc_id(); b.st = st;
    if (threadIdx.x == 0) (void)xb_add(&bar[XB_XCNT(b.x)], 1u);
    return b;
}
__device__ __forceinline__ void xcd_barrier_complete(unsigned* bar, unsigned x, unsigned& nloc, unsigned& nx) {
    const unsigned G = gridDim.x * gridDim.y * gridDim.z;
    unsigned sum, cnt, mine, sp = 0u;
    for (;;) {
        sum = 0u; cnt = 0u; mine = 0u;
#pragma unroll
        for (unsigned j = 0; j < 16; ++j) { const unsigned c = xb_ld(&bar[XB_XCNT(j)]); sum += c; cnt += (c > 0u) ? 1u : 0u; mine = (j == x) ? c : mine; }
        if (sum == G) break;
        __builtin_amdgcn_s_sleep(1);
        if ((++sp & 255u) == 0u) { if (xb_ld(&bar[XB_TMO])) break; if (sp > XB_SPIN_CAP) { atomicAdd(&bar[XB_TMO], 1u); break; } }
    }
    nloc = mine > 0u ? mine : 1u; nx = cnt > 0u ? cnt : 1u;
}

__device__ __forceinline__ void xcd_barrier(const XcdBarrier& b) {
    asm volatile("s_waitcnt vmcnt(0)" ::: "memory");
    __syncthreads();
    if (threadIdx.x == 0) {
        unsigned* bar = b.bar;
        __builtin_amdgcn_s_waitcnt(0);
        unsigned nloc = b.st[0], nx = b.st[1];
        if (nloc == 0u) { xcd_barrier_complete(bar, b.x, nloc, nx); b.st[0] = nloc; b.st[1] = nx; }
        const unsigned old = xb_add(&bar[XB_XSUB(b.x)], 1u);
        const unsigned gen = old / nloc;
        if (old + 1u == (gen + 1u) * nloc) {
            __builtin_amdgcn_fence(__ATOMIC_RELEASE, "agent");
            asm volatile("s_waitcnt vmcnt(0)" ::: "memory");
            const unsigned og = xb_add(&bar[XB_TOP], 1u);
            const unsigned tg = og / nx;
            if (og + 1u == (tg + 1u) * nx) xb_add(&bar[XB_TOPGEN], 1u);
            else XB_SPIN(xb_ld(&bar[XB_TOPGEN]) == tg, bar);
            __builtin_amdgcn_fence(__ATOMIC_ACQUIRE, "agent");
            xb_add(&bar[XB_XGEN(b.x)], 1u);
            asm volatile("s_waitcnt vmcnt(0)" ::: "memory");
        } else {
            XB_SPIN(xb_ld(&bar[XB_XGEN(b.x)]) == gen, bar);
            __builtin_amdgcn_fence(__ATOMIC_ACQUIRE, "agent");
            asm volatile("s_waitcnt vmcnt(0)" ::: "memory");
        }
    }
    __syncthreads();
}


typedef unsigned short bf16_t;
typedef float f32x4 __attribute__((ext_vector_type(4)));
typedef unsigned u32x4 __attribute__((ext_vector_type(4)));
typedef unsigned u32x2 __attribute__((ext_vector_type(2)));
struct Params { const float* in[25]; float* out; unsigned char* ws; int ph_lo, ph_hi; };
#define CAS __attribute__((address_space(4)))
typedef const CAS Params* PP;
__device__ __forceinline__ PP launder(PP p) { asm volatile("" : "+s"(p)); return p; }
enum { I_X = 0, I_META, I_F1N, I_F1GU, I_F1D, I_MIXN, I_WIN, I_MU, I_W0, I_WUP, I_A0, I_AUP, I_GUP, I_KK, I_KA, I_RK, I_LNW, I_LNB, I_BF, I_FON, I_WOUT, I_F2N, I_F2GU, I_F2D, I_FINN };

typedef float f32x2_t __attribute__((ext_vector_type(2))); typedef __bf16 bf16x2v_t __attribute__((ext_vector_type(2)));
__device__ __forceinline__ unsigned pk_bf16(float lo, float hi) { f32x2_t v = {lo, hi}; bf16x2v_t b = __builtin_convertvector(v, bf16x2v_t); return __builtin_bit_cast(unsigned, b); }
__device__ __forceinline__ float bf2f(bf16_t b) { return __uint_as_float(((unsigned)b) << 16); }
__device__ __forceinline__ float wave_sum(float v) {
#pragma unroll
    for (int o = 32; o >= 1; o >>= 1) v += __shfl_xor(v, o);
    return v; }
__device__ __forceinline__ float wave_max(float v) {
#pragma unroll
    for (int o = 32; o >= 1; o >>= 1) v = fmaxf(v, __shfl_xor(v, o));
    return v; }
__device__ __forceinline__ float sigmoid_f(float x) { return __builtin_amdgcn_rcpf(1.0f + __expf(-x)); }

__device__ __forceinline__ void convert_tile(const float* __restrict__ src, bf16_t* __restrict__ dst, const float* __restrict__ gain, int K, int Nsrc, int kind, int tk, int tn, LAS float* T) {
    const int tid = ltid();
    {
        const int nl = (tid & 15) * 4, np = tn * 64 + nl; int sc;
        if (kind == 1) { const int pn = np >> 8, bj = (np >> 7) & 1, i = np & 127; sc = bj * cfg::DFF + pn * 128 + i; }
        else if (kind == 2) { sc = np < 3360 ? np : (np < 3368 ? 6432 + (np - 3360) : (np < 3584 ? -1 : 3360 + (np - 3584))); }
        else sc = np;
#pragma unroll
        for (int i = 0; i < 2; ++i) { const int kl = (tid >> 4) + 32 * i, k = tk * 64 + kl;
            f32x4 v = (f32x4){0.f, 0.f, 0.f, 0.f};
            if (sc >= 0) v = *(const f32x4*)(src + (size_t)k * Nsrc + sc);
            float g = 1.f; if (kind == 1 || kind == 2) g = gain[k]; else if (kind == 3) g = (k >= 1024) ? gain[k - 1024] : 1.f;
            T[kl * 65 + nl] = v[0] * g; T[kl * 65 + nl + 1] = v[1] * g; T[kl * 65 + nl + 2] = v[2] * g; T[kl * 65 + nl + 3] = v[3] * g; }
    }
    __syncthreads();
    {
        const int nl = tid >> 3, k8 = (tid & 7) * 8; u32x4 w;
        w.x = pk_bf16(T[(k8 + 0) * 65 + nl], T[(k8 + 1) * 65 + nl]); w.y = pk_bf16(T[(k8 + 2) * 65 + nl], T[(k8 + 3) * 65 + nl]);
        w.z = pk_bf16(T[(k8 + 4) * 65 + nl], T[(k8 + 5) * 65 + nl]); w.w = pk_bf16(T[(k8 + 6) * 65 + nl], T[(k8 + 7) * 65 + nl]);
        *(u32x4*)(dst + (size_t)(tn * 64 + nl) * K + tk * 64 + k8) = w;
    }
    __syncthreads();
}
__device__ __forceinline__ void phase_convert(PP P, LAS unsigned char* lds, int l0, int l1, int first, int nwg, int t0 = 0, int t1 = 0) {
    using namespace cfg;
    LAS float* T = (LAS float*)lds;
    constexpr int T_GU = (DM / 64) * (NGU / 64), T_D = (DFF / 64) * (DM / 64), T_IN = (DM / 64) * (NIN / 64), T_OUT = (DM / 64) * (DM / 64);
    constexpr int T_LAYER = 2 * T_GU + 2 * T_D + T_IN + T_OUT;
    if (t1 <= 0) t1 = T_LAYER;
    for (int t = l0 * T_LAYER + first; t < l1 * T_LAYER; t += nwg) {
        const int l = t / T_LAYER; int r = t - l * T_LAYER; if (r < t0 || r >= t1) continue;
        bf16_t* wl = (bf16_t*)(P->ws + WS_W + (size_t)l * W_LAYER);
        const float* src; bf16_t* dst; const float* gain = nullptr; int K, Nsrc, kind, ntn;
        if (r < T_GU) { src = P->in[I_F1GU] + (size_t)l * DM * NGU; dst = (bf16_t*)((unsigned char*)wl + WO_GU1); gain = P->in[I_F1N] + l * DM; K = DM; Nsrc = NGU; kind = 1; ntn = NGU / 64; }
        else if ((r -= T_GU) < T_D) { src = P->in[I_F1D] + (size_t)l * DFF * DM; dst = (bf16_t*)((unsigned char*)wl + WO_D1); K = DFF; Nsrc = DM; kind = 0; ntn = DM / 64; }
        else if ((r -= T_D) < T_IN) { src = P->in[I_WIN] + (size_t)l * DM * DIN; dst = (bf16_t*)((unsigned char*)wl + WO_IN); gain = P->in[I_MIXN] + l * DM; K = DM; Nsrc = DIN; kind = 2; ntn = NIN / 64; }
        else if ((r -= T_IN) < T_OUT) { src = P->in[I_WOUT] + (size_t)l * DM * DM; dst = (bf16_t*)((unsigned char*)wl + WO_OUT); gain = P->in[I_FON] + l * FW; K = DM; Nsrc = DM; kind = 3; ntn = DM / 64; }
        else if ((r -= T_OUT) < T_GU) { src = P->in[I_F2GU] + (size_t)l * DM * NGU; dst = (bf16_t*)((unsigned char*)wl + WO_GU2); gain = P->in[I_F2N] + l * DM; K = DM; Nsrc = NGU; kind = 1; ntn = NGU / 64; }
        else { r -= T_GU; src = P->in[I_F2D] + (size_t)l * DFF * DM; dst = (bf16_t*)((unsigned char*)wl + WO_D2); K = DFF; Nsrc = DM; kind = 0; ntn = DM / 64; }
        convert_tile(src, dst, gain, K, Nsrc, kind, r / ntn, r % ntn, T);
    }
}
__device__ __forceinline__ void phase_init(PP P) {
    using namespace cfg;
    const int lane = ltid() & 63, gw = lbid() * 8 + (ltid() >> 6), nw = gridDim.x * 8;
    bf16_t* hb = (bf16_t*)(P->ws + WS_HB); float* ss0 = (float*)(P->ws + WS_SS);
    for (int row = gw; row < MROWS; row += nw) {
        const float* s = row < MMAIN ? P->in[I_X] + (size_t)row * DM : P->in[I_META] + (size_t)(row - MMAIN) * DM;
        float sq = 0.f;
#pragma unroll
        for (int i = 0; i < 4; ++i) { f32x4 v0 = (f32x4){0.f, 0.f, 0.f, 0.f}, v1 = v0; if (row < MMAIN + NMETA) { v0 = *(const f32x4*)(s + i * 512 + lane * 8); v1 = *(const f32x4*)(s + i * 512 + lane * 8 + 4); }
            sq += ((v0[0] * v0[0] + v0[1] * v0[1]) + (v0[2] * v0[2] + v0[3] * v0[3])) + ((v1[0] * v1[0] + v1[1] * v1[1]) + (v1[2] * v1[2] + v1[3] * v1[3]));
            u32x4 w; w.x = pk_bf16(v0[0], v0[1]); w.y = pk_bf16(v0[2], v0[3]); w.z = pk_bf16(v1[0], v1[1]); w.w = pk_bf16(v1[2], v1[3]); *(u32x4*)(hb + (size_t)row * DM + i * 512 + lane * 8) = w; }
        sq = wave_sum(sq);
        if (lane < 8) ss0[(size_t)lane * MROWS + row] = lane == 0 ? sq : 0.f;
        if (row >= MMAIN && row < MMAIN + NMETA) { float* ssm0 = (float*)(P->ws + WS_SSM); ssm0[lane * 16 + (row - MMAIN)] = lane == 0 ? sq : 0.f; ssm0[(64 + lane) * 16 + (row - MMAIN)] = 0.f; }
    }
}
__device__ __forceinline__ void phase_foxnorm(PP P) {
    using namespace cfg;
    const int lane = ltid() & 63, gw = lbid() * 8 + (ltid() >> 6), nw = gridDim.x * 8;
    bf16_t* y = (bf16_t*)(P->ws + WS_Y);
    for (int row = gw; row < MMAIN + NMETA; row += nw) {
        bf16_t* p = y + (size_t)row * DM + 1024 + lane * 16;
        u32x4 a = *(const u32x4*)p, b = *(const u32x4*)(p + 8); float v[16];
#pragma unroll
        for (int i = 0; i < 4; ++i) { v[2 * i] = __uint_as_float(a[i] << 16); v[2 * i + 1] = __uint_as_float(a[i] & 0xffff0000u); v[8 + 2 * i] = __uint_as_float(b[i] << 16); v[8 + 2 * i + 1] = __uint_as_float(b[i] & 0xffff0000u); }
        float sq = 0.f;
#pragma unroll
        for (int i = 0; i < 16; ++i) sq += v[i] * v[i];
        sq = wave_sum(sq); const float rs = __builtin_amdgcn_rsqf(sq * (1.0f / 1024.0f) + NORM_EPS);
#pragma unroll
        for (int i = 0; i < 4; ++i) { a[i] = pk_bf16(v[2 * i] * rs, v[2 * i + 1] * rs); b[i] = pk_bf16(v[8 + 2 * i] * rs, v[8 + 2 * i + 1] * rs); }
        *(u32x4*)p = a; *(u32x4*)(p + 8) = b;
    }
}
__device__ __forceinline__ void phase_final(PP P) {
    using namespace cfg;
    const int lane = ltid() & 63, gw = lbid() * 8 + (ltid() >> 6), nw = gridDim.x * 8;
    const float* g = P->in[I_FINN]; const bf16_t* hb = (const bf16_t*)(P->ws + WS_HB);
    for (int row = gw; row < MMAIN; row += nw) {
        float* d = P->out + (size_t)row * DM; f32x4 v[8]; float sq = 0.f;
#pragma unroll
        for (int i = 0; i < 4; ++i) { const u32x4 x = *(const u32x4*)(hb + (size_t)row * DM + i * 512 + lane * 8);
            v[2 * i] = (f32x4){__uint_as_float(x.x << 16), __uint_as_float(x.x & 0xffff0000u), __uint_as_float(x.y << 16), __uint_as_float(x.y & 0xffff0000u)};
            v[2 * i + 1] = (f32x4){__uint_as_float(x.z << 16), __uint_as_float(x.z & 0xffff0000u), __uint_as_float(x.w << 16), __uint_as_float(x.w & 0xffff0000u)}; }
#pragma unroll
        for (int i = 0; i < 8; ++i) sq += (v[i][0] * v[i][0] + v[i][1] * v[i][1]) + (v[i][2] * v[i][2] + v[i][3] * v[i][3]);
        sq = wave_sum(sq); const float rs = __builtin_amdgcn_rsqf(sq * (1.0f / 2048.0f) + NORM_EPS);
#pragma unroll
        for (int i = 0; i < 4; ++i) { const f32x4 g0 = *(const f32x4*)(g + i * 512 + lane * 8), g1 = *(const f32x4*)(g + i * 512 + lane * 8 + 4);
            *(f32x4*)(d + i * 512 + lane * 8) = v[2 * i] * rs * g0; *(f32x4*)(d + i * 512 + lane * 8 + 4) = v[2 * i + 1] * rs * g1; }
    }
}


typedef short bf16x8_t __attribute__((ext_vector_type(8)));
typedef short bf16x4_t __attribute__((ext_vector_type(4)));
namespace rk {
constexpr int RAWF = 0, RAWF_SZ = 18432, RAWH = 55296, RAWH_SZ = 6144, LXB = 73728, RS = 82944, KS = 87040, VS = 91136, KKN = 95232, ATP = 99328, RTP = 101376, BTP = 103424, KTP = 105472,
              BHT = 107520, KHT = 109568, VT = 111616, GT = 113664, AAK = 113920, RB = 114432, RKM = 114944, TINV = 115456, GG = 115968  , VF = 124160  , YR = 132352, BONP = 136448  , LDS_END = 136960;
}
template <int CTRL> __device__ __forceinline__ float dpp_f(float v) { return __builtin_bit_cast(float, __builtin_amdgcn_update_dpp(0, __builtin_bit_cast(int, v), CTRL, 0xf, 0xf, true)); }
__device__ __forceinline__ float row_sum16(float v) { v += dpp_f<0xB1>(v); v += dpp_f<0x4E>(v); v += dpp_f<0x141>(v); v += dpp_f<0x140>(v); return v; }
__device__ __forceinline__ float rdlane(float v, int l) { return __builtin_bit_cast(float, __builtin_amdgcn_readlane(__builtin_bit_cast(int, v), l)); }
__device__ __forceinline__ float wave_sum_dpp(float v) { v = row_sum16(v); return (rdlane(v, 0) + rdlane(v, 16)) + (rdlane(v, 32) + rdlane(v, 48)); }
#define RK_BAR() do { asm volatile("s_waitcnt lgkmcnt(0)" ::: "memory"); __builtin_amdgcn_s_barrier(); asm volatile("" ::: "memory"); } while (0)
__device__ __forceinline__ bf16_t bf1(float x) { return (bf16_t)(pk_bf16(x, 0.f) & 0xffffu); }
__device__ __forceinline__ bf16x4_t pack4(float a, float b, float c, float d) { u32x2 w; w.x = pk_bf16(a, b); w.y = pk_bf16(c, d); return __builtin_bit_cast(bf16x4_t, w); }
__device__ __forceinline__ float fast_sigmoid(float x) { return __builtin_amdgcn_rcpf(1.0f + __expf(-x)); }
__device__ __forceinline__ float fast_tanh(float x) { return 1.0f - 2.0f * __builtin_amdgcn_rcpf(__expf(2.0f * x) + 1.0f); }

__device__ __forceinline__ void rwkv_chunked(PP P, int l, int b, int h, LAS unsigned char* lds) {
    using namespace cfg;
    const int tid = ltid(), lane = tid & 63, wave = __builtin_amdgcn_readfirstlane(tid >> 6), n = lane & 15, g = lane >> 4;
    const bf16_t* PR = (const bf16_t*)(P->ws + WS_PR); const float* PS = (const float*)(P->ws + WS_PS); bf16_t* Y = (bf16_t*)(P->ws + WS_Y);
    const float* mu = P->in[I_MU] + l * RWKV_COLS;
    LAS float* RSm = (LAS float*)(lds + rk::RS); LAS float* KSm = (LAS float*)(lds + rk::KS); LAS float* VSm = (LAS float*)(lds + rk::VS); LAS float* KKNm = (LAS float*)(lds + rk::KKN);
    LAS bf16_t* LXB = (LAS bf16_t*)(lds + rk::LXB);
    LAS bf16_t* ATp = (LAS bf16_t*)(lds + rk::ATP); LAS bf16_t* RTp = (LAS bf16_t*)(lds + rk::RTP); LAS bf16_t* BTp = (LAS bf16_t*)(lds + rk::BTP); LAS bf16_t* KTp = (LAS bf16_t*)(lds + rk::KTP);
    LAS bf16_t* BHt = (LAS bf16_t*)(lds + rk::BHT); LAS bf16_t* KHt = (LAS bf16_t*)(lds + rk::KHT); LAS bf16_t* Vt = (LAS bf16_t*)(lds + rk::VT);
    LAS float* GTm = (LAS float*)(lds + rk::GT);
    LAS bf16_t* AAKm = (LAS bf16_t*)(lds + rk::AAK); LAS bf16_t* RBm = (LAS bf16_t*)(lds + rk::RB); LAS bf16_t* RKm = (LAS bf16_t*)(lds + rk::RKM); LAS bf16_t* TINVm = (LAS bf16_t*)(lds + rk::TINV);
    LAS float* YRm = (LAS float*)(lds + rk::YR);
    const int hj = h * 64 + lane;
    const float mur = mu[hj], muk = mu[1024 + hj], muv = mu[2048 + hj], kkw = P->in[I_KK][l * RW + hj], lnw = P->in[I_LNW][l * RW + hj], lnb = P->in[I_LNB][l * RW + hj];
    float mul[5];
#pragma unroll
    for (int q = 0; q < 5; ++q) mul[q] = (lane + 64 * q < 288) ? mu[3072 + lane + 64 * q] : 0.f;
    const int kw = wave & 3, key = 16 * kw + n, hk = h * 64 + key;
    const float w0k = P->in[I_W0][l * RW + hk], a0k = P->in[I_A0][l * RW + hk], kak = P->in[I_KA][l * RW + hk], rkk = P->in[I_RK][l * RW + hk];
    const int pp = 32 * (key >> 5) + 8 * ((key >> 2) & 3) + 4 * ((key >> 4) & 1) + (key & 3);
    bf16x8_t fA[2], fB[5];
    {
        const float* wu = P->in[I_WUP] + (size_t)l * 64 * RW + hk; const float* au = P->in[I_AUP] + (size_t)l * 64 * RW + hk; const float* gu = P->in[I_GUP] + (size_t)l * 160 * RW + hk;
#pragma unroll
        for (int s = 0; s < 5; ++s) { float v[8], u[8];
#pragma unroll
            for (int j = 0; j < 8; ++j) { const int k = 32 * s + 8 * g + j; v[j] = (wave < 4) ? (s < 2 ? au[(size_t)k * RW] : 0.f) : gu[(size_t)k * RW]; u[j] = (wave < 4 && s < 2) ? wu[(size_t)k * RW] : 0.f; }
            u32x4 w; w.x = pk_bf16(v[0], v[1]); w.y = pk_bf16(v[2], v[3]); w.z = pk_bf16(v[4], v[5]); w.w = pk_bf16(v[6], v[7]); fB[s] = __builtin_bit_cast(bf16x8_t, w);
            if (s < 2) { u32x4 x; x.x = pk_bf16(u[0], u[1]); x.y = pk_bf16(u[2], u[3]); x.z = pk_bf16(u[4], u[5]); x.w = pk_bf16(u[6], u[7]); fA[s] = __builtin_bit_cast(bf16x8_t, x); } }
    }
    f32x4 ST[4];
#pragma unroll
    for (int kb = 0; kb < 4; ++kb) ST[kb] = (f32x4){0.f, 0.f, 0.f, 0.f};
#define RK_DMA(c_) do { const int cc_ = (c_); const int row0_ = (cc_ == 0) ? MMAIN : b * SEQ + (cc_ - 1) * 16; const int bi_ = cc_ % 3; \
        _Pragma("unroll") for (int i_ = 0; i_ < 3; ++i_) { const int wp_ = wave + 8 * i_; if (wp_ < 18) { const int x_ = wp_ * 64 + lane; \
            __builtin_amdgcn_global_load_lds((const unsigned*)(PS + (size_t)(row0_ + x_ / 72) * PSW + (x_ % 72) * 4), (LAS unsigned*)(lds + rk::RAWF + bi_ * rk::RAWF_SZ + wp_ * 1024), 16, 0, 0); } } \
        if (wave < 6) { const int y_ = wave * 64 + lane; \
            __builtin_amdgcn_global_load_lds((const unsigned*)(PR + (size_t)(row0_ + y_ / 24) * PRW + ((y_ % 24) >> 3) * 1024 + h * 64 + (y_ & 7) * 8), (LAS unsigned*)(lds + rk::RAWH + bi_ * rk::RAWH_SZ + wave * 1024), 16, 0, 0); } } while (0)
#define RK_STAGE_A(ca_, t_) do { const int t = (t_); const int bc_ = (ca_) % 3, bp_ = ((ca_) + 2) % 3; \
        LAS const float* cF_ = (LAS const float*)(lds + rk::RAWF + bc_ * rk::RAWF_SZ); LAS const float* pF_ = (LAS const float*)(lds + rk::RAWF + bp_ * rk::RAWF_SZ); \
        LAS const bf16_t* cH_ = (LAS const bf16_t*)(lds + rk::RAWH + bc_ * rk::RAWH_SZ); LAS const bf16_t* pH_ = (LAS const bf16_t*)(lds + rk::RAWH + bp_ * rk::RAWH_SZ); \
        LAS const float* ctF = cF_ + t * 288; LAS const float* ptF = (t == 0) ? pF_ + 15 * 288 : cF_ + (t - 1) * 288; \
        LAS const bf16_t* ctH = cH_ + t * 192; LAS const bf16_t* ptH = (t == 0) ? pH_ + 15 * 192 : cH_ + (t - 1) * 192; \
        const float rc = bf2f(ctH[lane]), kc = bf2f(ctH[64 + lane]), vc = bf2f(ctH[128 + lane]); \
        const float rs = rc + (bf2f(ptH[lane]) - rc) * mur, ks = kc + (bf2f(ptH[64 + lane]) - kc) * muk, vs = vc + (bf2f(ptH[128 + lane]) - vc) * muv; \
        RSm[t * 64 + lane] = rs; KSm[t * 64 + lane] = ks; VSm[t * 64 + lane] = vs; \
        const float kkr = ks * kkw; const float n2 = wave_sum_dpp(kkr * kkr); KKNm[t * 64 + lane] = kkr * __builtin_amdgcn_rsqf(fmaxf(n2, 1e-24f)); \
        _Pragma("unroll") for (int q = 0; q < 5; ++q) { const int i = lane + 64 * q; if (i < 288) { const float xc = ctF[i]; const float x = xc + (ptF[i] - xc) * mul[q]; \
                LXB[t * 288 + i] = bf1(q == 0 ? fast_tanh(x) : (q == 1 ? x : fast_sigmoid(x))); } } } while (0)
#define RK_STAGE_F(cf_, t_) do { const int t = (t_); const int par_ = (cf_) & 1; const int rowF_ = ((cf_) == 0) ? MMAIN : b * SEQ + ((cf_) - 1) * 16; \
        LAS const float* Gp_ = (LAS const float*)(lds + rk::GG + par_ * 4096); LAS const float* Vp_ = (LAS const float*)(lds + rk::VF + par_ * 4096); LAS const float* Bp_ = (LAS const float*)(lds + rk::BONP + par_ * 256); \
        const float yv = YRm[t * 64 + lane]; \
        const float mean = wave_sum_dpp(yv) * (1.0f / 64.0f); const float d = yv - mean; const float var = wave_sum_dpp(d * d) * (1.0f / 64.0f); \
        const float yn = d * __builtin_amdgcn_rsqf(var + LNX_EPS) * lnw + lnb; \
        const float bonus = (Bp_[t] + Bp_[16 + t]) + (Bp_[32 + t] + Bp_[48 + t]); \
        const float o = (yn + bonus * Vp_[t * 64 + lane]) * Gp_[t * 64 + lane]; \
        if ((cf_) > 0 || b == 0) Y[(size_t)(rowF_ + t) * DM + hj] = bf1(o); } while (0)
    RK_DMA(0); RK_DMA(1);
    for (int e = tid; e < 288; e += 512) ((LAS float*)(lds + rk::RAWF + 2 * rk::RAWF_SZ))[15 * 288 + e] = 0.f;
    for (int e = tid; e < 96; e += 512) ((LAS unsigned*)(lds + rk::RAWH + 2 * rk::RAWH_SZ))[15 * 96 + e] = 0u;
    asm volatile("s_waitcnt vmcnt(0)" ::: "memory");
    RK_BAR();
    RK_STAGE_A(0, wave); RK_STAGE_A(0, wave + 8);
    RK_BAR();
#pragma unroll 1
    for (int c = 0; c < 257; ++c) {
        if (wave < 4) {
            LAS float* BONPc = (LAS float*)(lds + rk::BONP + (c & 1) * 256);
            f32x4 accW = (f32x4){0.f, 0.f, 0.f, 0.f}, accA = accW;
#pragma unroll
            for (int s = 0; s < 2; ++s) { const bf16x8_t aw = *(const LAS bf16x8_t*)(LXB + n * 288 + 32 * s + 8 * g), aa = *(const LAS bf16x8_t*)(LXB + n * 288 + 64 + 32 * s + 8 * g);
                accW = __builtin_amdgcn_mfma_f32_16x16x32_bf16(aw, fA[s], accW, 0, 0, 0); accA = __builtin_amdgcn_mfma_f32_16x16x32_bf16(aa, fB[s], accA, 0, 0, 0); }
            float lw[4], alr[4], pfx[4];
#pragma unroll
            for (int r = 0; r < 4; ++r) { lw[r] = -0.6065306597126334f * fast_sigmoid(accW[r] + w0k); alr[r] = fast_sigmoid(accA[r] + a0k); }
            pfx[0] = lw[0]; pfx[1] = pfx[0] + lw[1]; pfx[2] = pfx[1] + lw[2]; pfx[3] = pfx[2] + lw[3];
            const float t0 = __shfl(pfx[3], n), t1 = __shfl(pfx[3], n + 16), t2 = __shfl(pfx[3], n + 32), t3 = __shfl(pfx[3], n + 48);
            const float base = (g > 0 ? t0 : 0.f) + (g > 1 ? t1 : 0.f) + (g > 2 ? t2 : 0.f), lamT = (t0 + t1) + (t2 + t3);
            float bh[4], kh[4], bon[4], epos[4];
            const float eb = __expf(base), eT = __expf(lamT);
#pragma unroll
            for (int r = 0; r < 4; ++r) epos[r] = __expf(base + pfx[r]);
#pragma unroll
            for (int r = 0; r < 4; ++r) { const int t = 4 * g + r;
                const float e_pos = epos[r], e_neg = __builtin_amdgcn_rcpf(epos[r]), e_prev = (r == 0) ? eb : epos[r > 0 ? r - 1 : 0], e_hat = eT * e_neg;
                const float rs = RSm[t * 64 + key], ks = KSm[t * 64 + key], kk = KKNm[t * 64 + key];
                const float kmod = ks * (1.0f + (alr[r] - 1.0f) * kak), bb = kk * alr[r];
                ATp[t * 64 + pp] = bf1(-kk * e_prev); RTp[t * 64 + pp] = bf1(rs * e_pos); BTp[t * 64 + pp] = bf1(bb * e_neg); KTp[t * 64 + pp] = bf1(kmod * e_neg);
                bh[r] = bb * e_hat; kh[r] = kmod * e_hat; bon[r] = rs * kmod * rkk; }
            *(LAS bf16x4_t*)(BHt + key * 16 + 4 * g) = pack4(bh[0], bh[1], bh[2], bh[3]); *(LAS bf16x4_t*)(KHt + key * 16 + 4 * g) = pack4(kh[0], kh[1], kh[2], kh[3]);
#pragma unroll
            for (int r = 0; r < 4; ++r) { const float x = row_sum16(bon[r]); if (n == 0) BONPc[kw * 16 + 4 * g + r] = x; }
            if (g == 0) GTm[key] = eT;
        } else {
            LAS float* Gc = (LAS float*)(lds + rk::GG + (c & 1) * 4096); LAS float* VFc = (LAS float*)(lds + rk::VF + (c & 1) * 4096);
            f32x4 accG = (f32x4){0.f, 0.f, 0.f, 0.f};
#pragma unroll
            for (int s = 0; s < 5; ++s) { const bf16x8_t ag = *(const LAS bf16x8_t*)(LXB + n * 288 + 128 + 32 * s + 8 * g); accG = __builtin_amdgcn_mfma_f32_16x16x32_bf16(ag, fB[s], accG, 0, 0, 0); }
            float vv[4];
#pragma unroll
            for (int r = 0; r < 4; ++r) { Gc[(4 * g + r) * 64 + key] = accG[r]; vv[r] = VSm[(4 * g + r) * 64 + key]; VFc[(4 * g + r) * 64 + key] = vv[r]; }
            *(LAS bf16x4_t*)(Vt + key * 16 + 4 * g) = pack4(vv[0], vv[1], vv[2], vv[3]);
            if (c >= 1) { RK_STAGE_F(c - 1, 4 * kw); RK_STAGE_F(c - 1, 4 * kw + 1); RK_STAGE_F(c - 1, 4 * kw + 2); RK_STAGE_F(c - 1, 4 * kw + 3); }
        }
        asm volatile("s_waitcnt vmcnt(0)" ::: "memory");
        RK_BAR();
        if (c + 2 < 257) RK_DMA(c + 2);
        if (wave < 4) {
            LAS const bf16_t* X = (wave < 2) ? ATp : RTp; LAS const bf16_t* Yi = (wave & 1) ? KTp : BTp;
            f32x4 acc = (f32x4){0.f, 0.f, 0.f, 0.f};
#pragma unroll
            for (int s = 0; s < 2; ++s) { const bf16x8_t xa = *(const LAS bf16x8_t*)(X + n * 64 + 32 * s + 8 * g), yb = *(const LAS bf16x8_t*)(Yi + n * 64 + 32 * s + 8 * g);
                acc = __builtin_amdgcn_mfma_f32_16x16x32_bf16(xa, yb, acc, 0, 0, 0); }
            float mv[4];
#pragma unroll
            for (int r = 0; r < 4; ++r) { const int t = 4 * g + r; const bool keep = (wave < 2) ? (n < t) : (n <= t); mv[r] = keep ? acc[r] : 0.f;
                if (wave == 1) AAKm[t * 16 + n] = bf1(mv[r]); else if (wave == 2) RBm[t * 16 + n] = bf1(mv[r]); else if (wave == 3) RKm[t * 16 + n] = bf1(mv[r]); }
            if (wave == 0) {
                float Tc[16];
#pragma unroll
                for (int t = 0; t < 16; ++t) { float v0 = (t == n) ? 1.0f : 0.0f, v1 = 0.f;
#pragma unroll
                    for (int i = 0; i < t; ++i) { const float a = rdlane(mv[t & 3], i + 16 * (t >> 2)); if (i & 1) v1 += a * Tc[i]; else v0 += a * Tc[i]; }
                    Tc[t] = v0 + v1; __builtin_amdgcn_sched_barrier(0); }
                if (g == 0) {
#pragma unroll
                    for (int t = 0; t < 16; ++t) TINVm[t * 16 + n] = bf1(Tc[t]); }
            }
        }
        if (wave >= 1) {
            if (c + 1 < 257) { RK_STAGE_A(c + 1, wave - 1); RK_STAGE_A(c + 1, wave + 6); if (wave < 3) RK_STAGE_A(c + 1, wave + 13); }
        }
        RK_BAR();
        if (wave < 4) {
            bf16x8_t sb[2];
#pragma unroll
            for (int s = 0; s < 2; ++s) { u32x4 w; w.x = pk_bf16(ST[2 * s][0], ST[2 * s][1]); w.y = pk_bf16(ST[2 * s][2], ST[2 * s][3]); w.z = pk_bf16(ST[2 * s + 1][0], ST[2 * s + 1][1]); w.w = pk_bf16(ST[2 * s + 1][2], ST[2 * s + 1][3]);
                sb[s] = __builtin_bit_cast(bf16x8_t, w); }
            const bf16x4_t vfr = *(const LAS bf16x4_t*)(Vt + key * 16 + 4 * g);
            f32x4 W1 = (f32x4){0.f, 0.f, 0.f, 0.f}, Yc = W1;
#pragma unroll
            for (int s = 0; s < 2; ++s) { const bf16x8_t af = *(const LAS bf16x8_t*)(ATp + n * 64 + 32 * s + 8 * g), rf = *(const LAS bf16x8_t*)(RTp + n * 64 + 32 * s + 8 * g);
                W1 = __builtin_amdgcn_mfma_f32_16x16x32_bf16(af, sb[s], W1, 0, 0, 0); Yc = __builtin_amdgcn_mfma_f32_16x16x32_bf16(rf, sb[s], Yc, 0, 0, 0); }
            W1 = __builtin_amdgcn_mfma_f32_16x16x16bf16_1k(*(const LAS bf16x4_t*)(AAKm + n * 16 + 4 * g), vfr, W1, 0, 0, 0);
            const bf16x4_t w1f = pack4(W1[0], W1[1], W1[2], W1[3]);
            f32x4 U = __builtin_amdgcn_mfma_f32_16x16x16bf16_1k(*(const LAS bf16x4_t*)(TINVm + n * 16 + 4 * g), w1f, (f32x4){0.f, 0.f, 0.f, 0.f}, 0, 0, 0);
            const bf16x4_t uf = pack4(U[0], U[1], U[2], U[3]);
            Yc = __builtin_amdgcn_mfma_f32_16x16x16bf16_1k(*(const LAS bf16x4_t*)(RBm + n * 16 + 4 * g), uf, Yc, 0, 0, 0);
            Yc = __builtin_amdgcn_mfma_f32_16x16x16bf16_1k(*(const LAS bf16x4_t*)(RKm + n * 16 + 4 * g), vfr, Yc, 0, 0, 0);
#pragma unroll
            for (int r = 0; r < 4; ++r) YRm[(4 * g + r) * 64 + key] = Yc[r];
#pragma unroll
            for (int kb = 0; kb < 4; ++kb) { const f32x4 gt = *(const LAS f32x4*)(GTm + 16 * kb + 4 * g); f32x4 a = ST[kb] * gt;
                a = __builtin_amdgcn_mfma_f32_16x16x16bf16_1k(*(const LAS bf16x4_t*)(BHt + (16 * kb + n) * 16 + 4 * g), uf, a, 0, 0, 0);
                a = __builtin_amdgcn_mfma_f32_16x16x16bf16_1k(*(const LAS bf16x4_t*)(KHt + (16 * kb + n) * 16 + 4 * g), vfr, a, 0, 0, 0);
                ST[kb] = a; }
        }
        RK_BAR();
    }
    RK_STAGE_F(256, wave); RK_STAGE_F(256, wave + 8);
    asm volatile("s_waitcnt vmcnt(0)" ::: "memory");
    RK_BAR();
#undef RK_DMA
#undef RK_STAGE_A
#undef RK_STAGE_F
}

__device__ __forceinline__ f32x4 sk_dot(const bf16_t* a, const bf16_t* b, int nsteps) {
    f32x4 acc = (f32x4){0.f, 0.f, 0.f, 0.f};
#pragma unroll 8
    for (int s = 0; s < nsteps; ++s) { const bf16x8_t av = *(const bf16x8_t*)(a + 32 * s), bv = *(const bf16x8_t*)(b + 32 * s); acc = __builtin_amdgcn_mfma_f32_16x16x32_bf16(av, bv, acc, 0, 0, 0); }
    return acc; }
__device__ __forceinline__ void meta_rs(const float* ssm, int lane, float (&rs)[4]) {
    const int row = lane & 15, part = lane >> 4; float s = 0.f;
#pragma unroll 8
    for (int i = 0; i < 32; ++i) s += ssm[(part + 4 * i) * 16 + row];
    s = s + __shfl_xor(s, 16); s = s + __shfl_xor(s, 32);
    const float rv = __builtin_amdgcn_rsqf(s * (1.0f / 2048.0f) + 1e-6f);
#pragma unroll
    for (int r = 0; r < 4; ++r) rs[r] = __shfl(rv, 4 * part + r); }
#define SK_HEAD const int tid = ltid(), lane = tid & 63, wave = __builtin_amdgcn_readfirstlane(tid >> 6), n = lane & 15, g = lane >> 4, kq = wave & 3, ti = lbid() + 256 * (wave >> 2); LAS f32x4* part = (LAS f32x4*)lds;
#define SK_COMBINE(dst, slot) do { dst = (part[((wave) * 2 + (slot)) * 64 + lane] + part[((wave + 1) * 2 + (slot)) * 64 + lane]) + (part[((wave + 2) * 2 + (slot)) * 64 + lane] + part[((wave + 3) * 2 + (slot)) * 64 + lane]); } while (0)
__device__ __forceinline__ void skinny_gu(const bf16_t* hb, const bf16_t* Bt, const float* ssm, bf16_t* act, LAS unsigned char* lds) {
    using namespace cfg; SK_HEAD
    if (ti < DFF / 16) { const int c0 = 16 * ti, brow = (c0 >> 7) * 256 + (c0 & 127) + n; const bf16_t* a = hb + (size_t)(MMAIN + n) * DM + 512 * kq + 8 * g;
        part[(wave * 2) * 64 + lane] = sk_dot(a, Bt + (size_t)brow * DM + 512 * kq + 8 * g, 16); part[(wave * 2 + 1) * 64 + lane] = sk_dot(a, Bt + (size_t)(brow + 128) * DM + 512 * kq + 8 * g, 16); }
    __syncthreads();
    if (ti < DFF / 16 && kq == 0) { f32x4 gt, up; SK_COMBINE(gt, 0); SK_COMBINE(up, 1); float rs[4]; meta_rs(ssm, lane, rs);
#pragma unroll
        for (int r = 0; r < 4; ++r) { const float gv = gt[r] * rs[r], uv = up[r] * rs[r]; act[(size_t)(MMAIN + 4 * g + r) * DFF + 16 * ti + n] = bf1(gv * __builtin_amdgcn_rcpf(1.0f + __builtin_amdgcn_exp2f(-1.4426950408889634f * gv)) * uv); } }
    __syncthreads();
}
__device__ __forceinline__ void skinny_res(const bf16_t* A16, int K, const bf16_t* Bt, bf16_t* hb, float* ssm_out, float alpha, LAS unsigned char* lds) {
    using namespace cfg;
    const int tid = ltid(), lane = tid & 63, wave = __builtin_amdgcn_readfirstlane(tid >> 6), n = lane & 15, g = lane >> 4, ti = lbid(); LAS f32x4* part = (LAS f32x4*)lds;
    const int k8 = K / 8;
    if (ti < DM / 16) part[wave * 64 + lane] = sk_dot(A16 + (size_t)n * K + k8 * wave + 8 * g, Bt + (size_t)(16 * ti + n) * K + k8 * wave + 8 * g, k8 / 32);
    __syncthreads();
    if (ti < DM / 16 && wave == 0) { const f32x4 acc = ((part[lane] + part[64 + lane]) + (part[128 + lane] + part[192 + lane])) + ((part[256 + lane] + part[320 + lane]) + (part[384 + lane] + part[448 + lane]));
#pragma unroll
        for (int r = 0; r < 4; ++r) { const int m = 4 * g + r, col = 16 * ti + n; bf16_t* p = hb + (size_t)(MMAIN + m) * DM + col; const float hv = bf2f(*p) + alpha * acc[r]; *p = bf1(hv);
            const float sq = row_sum16(hv * hv); if (n == 0) ssm_out[ti * 16 + m] = sq; } }
    __syncthreads();
}
__device__ __forceinline__ void skinny_p(const bf16_t* hb, const bf16_t* Bt, const float* ssm, bf16_t* pr, float* ps, bf16_t* qkv, LAS unsigned char* lds) {
    using namespace cfg; SK_HEAD
    if (ti < NIN / 16) part[(wave * 2) * 64 + lane] = sk_dot(hb + (size_t)(MMAIN + n) * DM + 512 * kq + 8 * g, Bt + (size_t)(16 * ti + n) * DM + 512 * kq + 8 * g, 16);
    __syncthreads();
    if (ti < NIN / 16 && kq == 0) { f32x4 acc; SK_COMBINE(acc, 0); float rs[4]; meta_rs(ssm, lane, rs); const int np = 16 * ti + n;
#pragma unroll
        for (int r = 0; r < 4; ++r) { const int m = 4 * g + r; const float v = acc[r] * rs[r];
            if (np < 3072) pr[(size_t)(MMAIN + m) * PRW + np] = bf1(v);
            else if (np < 3584) ps[(size_t)(MMAIN + m) * PSW + (np - 3072)] = v;
            else { const bf16_t w = bf1(v);
#pragma unroll
                for (int b = 0; b < NBATCH; ++b) qkv[((size_t)b * SEQP + 48 + m) * QKVW + (np - 3584)] = w; } } }
    __syncthreads();
}
#undef SK_HEAD
#undef SK_COMBINE

namespace fox {
constexpr int D = 128, NW = 8, QBLK = 32, KVBLK = 64, QB = NW * QBLK;
constexpr int LDQ = cfg::QKVW, LDK = cfg::QKVW, LDO = cfg::DM;
constexpr float SCALE = 0.08838834764831845f, THR = 8.f;
constexpr bool WSKIP = false;
constexpr int SHM_V = KVBLK * D * 2, SHM_K = KVBLK * D * 2;
constexpr int ATT_LDS = 2 * SHM_V + 2 * SHM_K + NW * 64 * 4;
constexpr int BIAS_OFF = ATT_LDS;
constexpr int SCAN_OFF = BIAS_OFF + cfg::SEQP * 4;

using bf16 = __hip_bfloat16;
typedef short bf16x8 __attribute__((ext_vector_type(8)));
typedef short s16x4 __attribute__((ext_vector_type(4)));
typedef float f32x16 __attribute__((ext_vector_type(16)));
typedef float f32x4 __attribute__((ext_vector_type(4)));
typedef unsigned u32x4 __attribute__((ext_vector_type(4)));
template <class A, class Bt> struct same_t { static constexpr bool v = false; };
template <class A> struct same_t<A, A> { static constexpr bool v = true; };

#define KSWZ(row, colB) ((row) * 256 + ((colB) ^ (((row) & 7) << 4)))
#define SBAR() __builtin_amdgcn_sched_barrier(0)
__device__ __forceinline__ int v_st(int k, int c) { const int kk = (k & ~0xC) | ((k & 4) << 1) | ((k & 8) >> 1); return ((kk >> 3) * 4 + (c >> 5)) * 512 + ((kk & 7) * 32 + (c & 31)) * 2; }
__device__ __forceinline__ int v_rd_base(int lane) { return ((lane & 3) << 3) | (((lane >> 2) & 3) << 6) | (((lane >> 4) & 1) << 5) | (((lane >> 5) & 1) << 8); }
constexpr int v_rd_off(int d0, int ks, int half) { return d0 * 512 + ks * 4096 + half * 2048; }
__device__ __forceinline__ int crow(int r, int hi) { return (r & 3) + 8 * (r >> 2) + 4 * hi; }
__device__ __forceinline__ unsigned cvtpk(float lo, float hi) {
    unsigned r; asm volatile("v_cvt_pk_bf16_f32 %0, %1, %2" : "=v"(r) : "v"(lo), "v"(hi)); return r;
}
__device__ __forceinline__ bf16x8 pack8(f32x4 a, f32x4 b) {
    u32x4 w = {cvtpk(a[0], a[1]), cvtpk(a[2], a[3]), cvtpk(b[0], b[1]), cvtpk(b[2], b[3])};
    return *reinterpret_cast<bf16x8*>(&w);
}
template <class T> __device__ __forceinline__ bf16x8 load8(const T* p) {
    if constexpr (same_t<T, float>::v) { return pack8(*(const f32x4*)p, *(const f32x4*)(p + 4)); }
    else { return *reinterpret_cast<const bf16x8*>(p); }
}
__device__ __forceinline__ void mask_tile(f32x16& p0, f32x16& p1, int dq, unsigned W) {
    const float NEG = -__builtin_inff();
#pragma unroll
    for (int r = 0; r < 16; ++r) {
        const int c = (r & 3) + 8 * (r >> 2);
        if ((unsigned)(dq - c) >= W) p0[r] = NEG;
        if ((unsigned)(dq - c - 32) >= W) p1[r] = NEG;
    }
}
__device__ __forceinline__ void partialSM(f32x16& p0, f32x16& p1, float& m_reg, float& mn, float& alpha) {
    float pmax = p0[0]; for (int r = 1; r < 16; ++r) pmax = fmaxf(pmax, p0[r]); for (int r = 0; r < 16; ++r) pmax = fmaxf(pmax, p1[r]);
    { auto rr = __builtin_amdgcn_permlane32_swap(__float_as_uint(pmax), __float_as_uint(pmax), false, false);
      pmax = fmaxf(__uint_as_float(rr[0]), __uint_as_float(rr[1])); }
    constexpr float C2 = 1.4426950408889634f * SCALE;
    if (__builtin_expect(__all((pmax - m_reg) * SCALE <= THR), 1)) { mn = m_reg; alpha = 1.f; }
    else { mn = fmaxf(m_reg, pmax); alpha = __builtin_amdgcn_exp2f((m_reg - mn) * C2); m_reg = mn; }
    const float mnL = -mn * C2;
    for (int r = 0; r < 16; ++r) p0[r] = fmaf(p0[r], C2, mnL); for (int r = 0; r < 16; ++r) p1[r] = fmaf(p1[r], C2, mnL);
    for (int r = 0; r < 16; ++r) p0[r] = __builtin_amdgcn_exp2f(p0[r]);
}
__device__ __forceinline__ void finishSM(f32x16& p0, f32x16& p1, float alpha, float& l_reg, bf16x8& pa0, bf16x8& pa1, bf16x8& pa2, bf16x8& pa3) {
    for (int r = 0; r < 16; ++r) p1[r] = __builtin_amdgcn_exp2f(p1[r]);
    float ps = 0; for (int r = 0; r < 16; ++r) ps += p0[r]; for (int r = 0; r < 16; ++r) ps += p1[r];
    { auto rr = __builtin_amdgcn_permlane32_swap(__float_as_uint(ps), __float_as_uint(ps), false, false);
      ps = __uint_as_float(rr[0]) + __uint_as_float(rr[1]); }
    l_reg = l_reg * alpha + ps;
#define PK4(P, B_, OUT) do { unsigned a0 = cvtpk(P[B_+0], P[B_+1]), a1 = cvtpk(P[B_+2], P[B_+3]);                          \
        unsigned b0 = cvtpk(P[B_+4], P[B_+5]), b1 = cvtpk(P[B_+6], P[B_+7]);                                             \
        auto r0 = __builtin_amdgcn_permlane32_swap(a0, b0, false, false); auto r1 = __builtin_amdgcn_permlane32_swap(a1, b1, false, false); \
        u32x4 w = {r0[0], r1[0], r0[1], r1[1]}; OUT = *reinterpret_cast<bf16x8*>(&w); } while (0)
    PK4(p0, 0, pa0); PK4(p0, 8, pa1); PK4(p1, 0, pa2); PK4(p1, 8, pa3);
#undef PK4
}
template <int KB, bool SK>
__device__ __forceinline__ void qkt(f32x16& p0, f32x16& p1, const char* K_lds, int r32, int hi, const bf16x8* qr, bool act, const float* bias_t) {
    if (SK && !act) { const float NEG = -__builtin_inff();
#pragma unroll
        for (int r = 0; r < 16; ++r) { p0[r] = NEG; p1[r] = NEG; } return; }
    {
#pragma unroll
        for (int g_ = 0; g_ < 4; ++g_) { const f32x4 b0_ = *(const f32x4*)(bias_t + 8 * g_ + 4 * hi); const f32x4 b1_ = *(const f32x4*)(bias_t + 32 + 8 * g_ + 4 * hi);
            p0[4 * g_] = b0_[0]; p0[4 * g_ + 1] = b0_[1]; p0[4 * g_ + 2] = b0_[2]; p0[4 * g_ + 3] = b0_[3];
            p1[4 * g_] = b1_[0]; p1[4 * g_ + 1] = b1_[1]; p1[4 * g_ + 2] = b1_[2]; p1[4 * g_ + 3] = b1_[3]; } }
    const char* kb[4];
#pragma unroll
    for (int dd = 0; dd < 4; ++dd) kb[dd] = K_lds + KB * SHM_K + KSWZ(r32, (dd * 16 + hi * 8) * 2);
#pragma unroll
    for (int d0 = 0; d0 < 8; ++d0) { const char* a = kb[d0 & 3] + (d0 >> 2) * 128;
        bf16x8 b0 = *reinterpret_cast<const bf16x8*>(a);
        bf16x8 b1 = *reinterpret_cast<const bf16x8*>(a + 32 * 256);
        p0 = __builtin_amdgcn_mfma_f32_32x32x16_bf16(b0, qr[d0], p0, 0, 0, 0);
        p1 = __builtin_amdgcn_mfma_f32_32x32x16_bf16(b1, qr[d0], p1, 0, 0, 0); }
}
template <int VB, bool SK>
__device__ __forceinline__ void pv_tile(f32x16* o, int vb0, bf16x8 pa0, bf16x8 pa1, bf16x8 pa2, bf16x8 pa3, bool act) {
    if (SK && !act) return;
#define TRRD(dst, off) asm volatile("ds_read_b64_tr_b16 %0, %1 offset:%2" : "=&v"(dst) : "v"(vb0), "i"(off) : "memory")
#define PV_D0(d0) do { s16x4 l0, l1, l2, l3, h0, h1, h2, h3; constexpr int b_ = VB * SHM_V + v_rd_off(d0, 0, 0);     \
        TRRD(l0, b_); TRRD(h0, b_ + 2048); TRRD(l1, b_ + 4096); TRRD(h1, b_ + 6144); TRRD(l2, b_ + 8192); TRRD(h2, b_ + 10240); TRRD(l3, b_ + 12288); TRRD(h3, b_ + 14336); \
        asm volatile("s_waitcnt lgkmcnt(0)" ::: "memory"); SBAR();                 \
        o[d0] = __builtin_amdgcn_mfma_f32_32x32x16_bf16(pa0, (bf16x8){l0[0], l0[1], l0[2], l0[3], h0[0], h0[1], h0[2], h0[3]}, o[d0], 0, 0, 0);   \
        o[d0] = __builtin_amdgcn_mfma_f32_32x32x16_bf16(pa1, (bf16x8){l1[0], l1[1], l1[2], l1[3], h1[0], h1[1], h1[2], h1[3]}, o[d0], 0, 0, 0);   \
        o[d0] = __builtin_amdgcn_mfma_f32_32x32x16_bf16(pa2, (bf16x8){l2[0], l2[1], l2[2], l2[3], h2[0], h2[1], h2[2], h2[3]}, o[d0], 0, 0, 0);   \
        o[d0] = __builtin_amdgcn_mfma_f32_32x32x16_bf16(pa3, (bf16x8){l3[0], l3[1], l3[2], l3[3], h3[0], h3[1], h3[2], h3[3]}, o[d0], 0, 0, 0); } while (0)
    PV_D0(0); PV_D0(1); PV_D0(2); PV_D0(3);
#undef PV_D0
#undef TRRD
}

template <class TIn, class TOut> struct BlockRef { const TIn* Q; const TIn* K; const TIn* V; TOut* O; int P0; };
template <class TIn> struct Seam {
    bf16x8 qr[8];
    bf16x8 st_v0, st_v1, st_k0, st_k1; f32x4 sf0, sf1, sf2, sf3;
    f32x4 tq[16];
};
__device__ __forceinline__ int swa_jlo(int P0, int W) { const int lowk = P0 - W + 1; return lowk > 0 ? lowk / KVBLK : 0; }
#define ROW(p, k0, rr) ((p) + (size_t)((k0) + (rr)) * LDK + sc)
#define VMW() asm volatile("s_waitcnt vmcnt(0)" ::: "memory")
#define VMWN(n) asm volatile("s_waitcnt vmcnt(%0)" :: "i"(n) : "memory")
#define SLOAD_H(Kp, Vp, k0) do { S.st_v0 = load8<TIn>(ROW(Vp, k0, sr)); S.st_v1 = load8<TIn>(ROW(Vp, k0, 32 + sr));              \
                         S.st_k0 = load8<TIn>(ROW(Kp, k0, sr)); S.st_k1 = load8<TIn>(ROW(Kp, k0, 32 + sr)); } while (0)
#define SWRITE_HK(bf) do { *(bf16x8*)(K_lds + (bf) * SHM_K + kws) = S.st_k0; *(bf16x8*)(K_lds + (bf) * SHM_K + kws + 32 * 256) = S.st_k1; } while (0)
#define SWRITE_HV(bf) do { *(bf16x8*)(V_lds + (bf) * SHM_V + vst0) = S.st_v0; *(bf16x8*)(V_lds + (bf) * SHM_V + vst1) = S.st_v1; } while (0)
#define SWRITE_H(bf) do { SWRITE_HV(bf); SWRITE_HK(bf); } while (0)
#define SLOAD_F(p, k0) do { S.sf0 = *(const f32x4*)ROW(p, k0, sr); S.sf1 = *(const f32x4*)(ROW(p, k0, sr) + 4);                \
                            S.sf2 = *(const f32x4*)ROW(p, k0, 32 + sr); S.sf3 = *(const f32x4*)(ROW(p, k0, 32 + sr) + 4); } while (0)
#define SWRITE_KF(bf) do { *(bf16x8*)(K_lds + (bf) * SHM_K + kws) = pack8(S.sf0, S.sf1); *(bf16x8*)(K_lds + (bf) * SHM_K + kws + 32 * 256) = pack8(S.sf2, S.sf3); } while (0)
#define SWRITE_VF(bf) do { *(bf16x8*)(V_lds + (bf) * SHM_V + vst0) = pack8(S.sf0, S.sf1); *(bf16x8*)(V_lds + (bf) * SHM_V + vst1) = pack8(S.sf2, S.sf3); } while (0)
template <class TIn, class TOut>
__device__ __forceinline__ void causal_swa_prime(const BlockRef<TIn, TOut>& cur, int W, char* lds, Seam<TIn>& S) {
    constexpr bool F32 = same_t<TIn, float>::v;
    const int tid = ltid(), wid = __builtin_amdgcn_readfirstlane(tid >> 6), lane = tid & 63, r32 = lane & 31, hi = lane >> 5;
    const int sr = tid >> 4, sc = (tid & 15) * 8, kws = KSWZ(sr, sc * 2); char* K_lds = lds + 2 * SHM_V;
    const int kb0 = swa_jlo(cur.P0, W) * KVBLK;
    for (int d0 = 0; d0 < 8; ++d0) S.qr[d0] = load8<TIn>(cur.Q + (size_t)(wid * QBLK + r32) * LDQ + d0 * 16 + hi * 8);
    if constexpr (F32) { SLOAD_F((const float*)cur.K, kb0); VMW(); SWRITE_KF(0); SBAR(); SLOAD_F((const float*)cur.V, kb0); }
    else { SLOAD_H(cur.K, cur.V, kb0); VMW(); SWRITE_HK(0); }
    __syncthreads();
}
template <class TIn, class TOut>
__device__ __forceinline__ void causal_swa_block(const BlockRef<TIn, TOut>& cur, const BlockRef<TIn, TOut>& nxt, int skv, int W, char* lds, Seam<TIn>& S, const float* bias_l) {
    constexpr bool F32 = same_t<TIn, float>::v;
    const int tid = ltid(), wid = __builtin_amdgcn_readfirstlane(tid >> 6), lane = tid & 63, r32 = lane & 31, hi = lane >> 5;
    const int j_lo = swa_jlo(cur.P0, W);
    int j_hi = (cur.P0 + QB - 1) / KVBLK + 1; if (j_hi > skv / KVBLK) j_hi = skv / KVBLK;
    const int NT = j_hi - j_lo;
    const int kbn = swa_jlo(nxt.P0, W) * KVBLK;
    const int qlo = cur.P0 + wid * QBLK, qm = qlo + r32 - 4 * hi;
    char* V_lds = lds; char* K_lds = lds + 2 * SHM_V;
    float* ws = (float*)(lds + 2 * SHM_V + 2 * SHM_K) + wid * 64; float* li_l = ws, * al_l = ws + 32;
    float m_reg = -1e30f, l_reg = 0; f32x16 o[4] = {};
    const int sr = tid >> 4, sc = (tid & 15) * 8, vst0 = v_st(sr, sc), vst1 = v_st(32 + sr, sc), kws = KSWZ(sr, sc * 2);
    const int vb0 = (int)(uintptr_t)V_lds + v_rd_base(lane);
    const TIn* Kh = cur.K; const TIn* Vh = cur.V;
#define RESC(a) do { if (__any((a) < 1.f)) { if (hi == 0) al_l[r32] = (a); asm volatile("s_waitcnt lgkmcnt(0)" ::: "memory");              \
                     for (int d_ = 0; d_ < 4; ++d_) for (int r = 0; r < 16; ++r) o[d_][r] *= al_l[crow(r, hi)]; } } while (0)
#define KBASE(t) ((j_lo + (t)) * KVBLK)
#define ACT(t) (KBASE(t) <= qlo + QBLK - 1 && KBASE(t) + KVBLK - 1 >= qlo - W + 1)
#define MASKT(P0_, P1_, t) do { const int kb_ = KBASE(t); if ((!SK || ACT(t)) && (kb_ + KVBLK - 1 > qlo || kb_ <= qlo + QBLK - 1 - W)) mask_tile(P0_, P1_, qm - kb_, (unsigned)W); } while (0)
    constexpr int NQL = F32 ? 16 : 8;
    constexpr bool SK = WSKIP && !F32;
#define SEAM_K0() do { VMWN(NQL); if constexpr (F32) { SWRITE_KF(0); SBAR(); SLOAD_F((const float*)nxt.V, kbn); } else { SWRITE_HK(0); } SBAR(); } while (0)
    f32x16 pA0, pA1, pB0, pB1; float mnA, mnB, alA, alB; bf16x8 pa0, pa1, pa2, pa3;
    if constexpr (F32) { VMW(); SWRITE_VF(0); SBAR(); } else { SWRITE_HV(0); SBAR(); }
    if (NT > 1) { if constexpr (F32) SLOAD_F((const float*)Kh, KBASE(1)); else SLOAD_H(Kh, Vh, KBASE(1)); }
    SBAR(); qkt<0, SK>(pA0, pA1, K_lds, r32, hi, S.qr, ACT(0), bias_l + KBASE(0));
    if constexpr (F32) { if (NT > 1) { VMW(); SWRITE_KF(1); SBAR(); SLOAD_F((const float*)Vh, KBASE(1)); } }
    MASKT(pA0, pA1, 0); partialSM(pA0, pA1, m_reg, mnA, alA);
    if (NT > 1) { VMW(); if constexpr (F32) { SWRITE_VF(1); SBAR(); if (NT > 2) SLOAD_F((const float*)Kh, KBASE(2)); } else SWRITE_H(1); }
    __syncthreads();
#define HALF_STEP(PX0, PX1, mnX, alX, PY0, PY1, alY, t, KB, VB, SB) do {                                                      \
        SBAR(); qkt<KB, SK>(PX0, PX1, K_lds, r32, hi, S.qr, ACT(t), bias_l + KBASE(t));                                             \
        finishSM(PY0, PY1, alY, l_reg, pa0, pa1, pa2, pa3); SBAR();                                                           \
        if ((t) + 1 < NT) { if constexpr (F32) { VMW(); SWRITE_KF(SB); SBAR(); SLOAD_F((const float*)Vh, KBASE((t) + 1)); }  \
                            else { SLOAD_H(Kh, Vh, KBASE((t) + 1)); } SBAR(); }                                               \
        pv_tile<VB, SK>(o, vb0, pa0, pa1, pa2, pa3, ACT((t) - 1)); MASKT(PX0, PX1, (t)); partialSM(PX0, PX1, m_reg, mnX, alX);                                        \
        __syncthreads();                                                                                                      \
        if ((t) + 1 < NT) { VMW(); if constexpr (F32) { SWRITE_VF(SB); SBAR(); if ((t) + 2 < NT) SLOAD_F((const float*)Kh, KBASE((t) + 2)); } \
                            else { SWRITE_H(SB); } }                                                                          \
        RESC(alX); __syncthreads(); } while (0)
    for (int t = 1; t + 1 < NT; t += 2) {
        HALF_STEP(pB0, pB1, mnB, alB, pA0, pA1, alA, t, 1, 0, 0);
        HALF_STEP(pA0, pA1, mnA, alA, pB0, pB1, alB, t + 1, 0, 1, 1);
    }
    const bool even = (NT & 1) == 0;
    if (even) { SBAR(); qkt<1, SK>(pB0, pB1, K_lds, r32, hi, S.qr, ACT(NT - 1), bias_l + KBASE(NT - 1)); SBAR(); }
#define QROW(e) (nxt.Q + (size_t)(wid * QBLK + r32) * LDQ + ((e) >> 1) * 16 + hi * 8 + ((e) & 1) * 4)
    if constexpr (F32) { SLOAD_F((const float*)nxt.K, kbn); SBAR();
#pragma unroll
        for (int e = 0; e < 8; ++e) S.tq[e] = *(const f32x4*)QROW(e); }
    else { SLOAD_H(nxt.K, nxt.V, kbn); SBAR();
#pragma unroll
        for (int d0 = 0; d0 < 8; ++d0) S.qr[d0] = load8<TIn>(nxt.Q + (size_t)(wid * QBLK + r32) * LDQ + d0 * 16 + hi * 8); }
    SBAR();
    finishSM(pA0, pA1, alA, l_reg, pa0, pa1, pa2, pa3); SBAR();
    if constexpr (F32) {
#pragma unroll
        for (int e = 8; e < 16; ++e) S.tq[e] = *(const f32x4*)QROW(e); SBAR(); }
#undef QROW
    pv_tile<0, SK>(o, vb0, pa0, pa1, pa2, pa3, ACT(even ? NT - 2 : NT - 1));
    if (even) { MASKT(pB0, pB1, NT - 1); partialSM(pB0, pB1, m_reg, mnB, alB); __syncthreads(); RESC(alB);
        finishSM(pB0, pB1, alB, l_reg, pa0, pa1, pa2, pa3); SBAR(); pv_tile<1, SK>(o, vb0, pa0, pa1, pa2, pa3, ACT(NT - 1)); }
    SBAR(); SEAM_K0();
    if (hi == 0) li_l[r32] = l_reg; asm volatile("s_waitcnt lgkmcnt(0)" ::: "memory");
    float rli[16];
#pragma unroll
    for (int r = 0; r < 16; ++r) rli[r] = __builtin_amdgcn_rcpf(li_l[crow(r, hi)]);
    TOut* Ow = cur.O + (size_t)(wid * QBLK) * LDO;
#pragma unroll
    for (int r = 0; r < 16; ++r) { const int orow = crow(r, hi);
#pragma unroll
        for (int d0 = 0; d0 < 4; ++d0) { const float v = o[d0][r] * rli[r];
            if constexpr (same_t<TOut, float>::v) { Ow[(size_t)orow * LDO + d0 * 32 + r32] = v; }
            else { const float vn = __shfl_xor(v, 1);
                   if ((r32 & 1) == 0) *(unsigned*)(Ow + (size_t)orow * LDO + d0 * 32 + r32) = cvtpk(v, vn); } } }
    if constexpr (F32) {
#pragma unroll
        for (int d0 = 0; d0 < 8; ++d0) S.qr[d0] = pack8(S.tq[2 * d0], S.tq[2 * d0 + 1]); }
    __syncthreads();
#undef RESC
#undef KBASE
#undef ACT
#undef MASKT
#undef SEAM_K0
#undef HALF_STEP
}
#undef ROW
#undef VMW
#undef VMWN
#undef SLOAD_H
#undef SWRITE_HK
#undef SWRITE_HV
#undef SWRITE_H
#undef SLOAD_F
#undef SWRITE_KF

}

__device__ __forceinline__ void fox_bias(PP P, int l, int b, int h, float* bias, float* scr) {
    using namespace cfg;
    const int tid = ltid(), lane = tid & 63, wave = tid >> 6;
    const float* PS = (const float*)(P->ws + WS_PS); const float bf = P->in[I_BF][l * FNH + h];
    float lf[9]; float loc = 0.f;
#pragma unroll
    for (int i = 0; i < 9; ++i) { const int pos = tid * 9 + i; float v = 0.f;
        if (pos < NMETA + SEQ) { const int row = pos < NMETA ? MMAIN + pos : b * SEQ + pos - NMETA; const float z = PS[(size_t)row * PSW + 288 + h] + bf;
            v = fminf(z, 0.f) - log1pf(__expf(-fabsf(z))); }
        loc += v; lf[i] = loc; }
    float inc = loc;
#pragma unroll
    for (int o = 1; o < 64; o <<= 1) { const float t = __shfl_up(inc, o); if (lane >= o) inc += t; }
    if (lane == 63) scr[wave] = inc;
    __syncthreads();
    float base = inc - loc;
    for (int w = 0; w < wave; ++w) base += scr[w];
    constexpr float INV = 1.0f / fox::SCALE;
#pragma unroll
    for (int i = 0; i < 9; ++i) { const int pos = tid * 9 + i; if (pos < NMETA + SEQ) bias[48 + pos] = -(base + lf[i]) * INV; }
    if (tid < 48) bias[tid] = -__builtin_inff();
    __syncthreads();
}
__device__ __forceinline__ void fox_meta(PP P, int h, const float* bias) {
    using namespace cfg;
    const int lane = ltid() & 63, wave = ltid() >> 6;
    const bf16_t* QKV = (const bf16_t*)(P->ws + WS_QKV); bf16_t* Y = (bf16_t*)(P->ws + WS_Y);
    for (int rep = 0; rep < 2; ++rep) { const int i = wave + 8 * rep;
        float s = -__builtin_inff();
        if (lane <= i) { const bf16_t* q = QKV + (size_t)(48 + i) * QKVW + h * 128; const bf16_t* k = QKV + (size_t)(48 + lane) * QKVW + 1024 + h * 128; float dot = 0.f;
            for (int d = 0; d < 128; ++d) dot += bf2f(q[d]) * bf2f(k[d]);
            s = (dot + bias[48 + lane]) * fox::SCALE; }
        const float m = wave_max(s); const float p = (lane <= i) ? __expf(s - m) : 0.f; const float lsum = wave_sum(p);
        float o0 = 0.f, o1 = 0.f;
        for (int j = 0; j <= i; ++j) { const float pj = __shfl(p, j); const bf16_t* v = QKV + (size_t)(48 + j) * QKVW + 2048 + h * 128; o0 += pj * bf2f(v[lane]); o1 += pj * bf2f(v[64 + lane]); }
        const float il = 1.0f / lsum;
        Y[(size_t)(MMAIN + i) * DM + 1024 + h * 128 + lane] = (bf16_t)(pk_bf16(o0 * il, 0.f) & 0xffffu);
        Y[(size_t)(MMAIN + i) * DM + 1024 + h * 128 + 64 + lane] = (bf16_t)(pk_bf16(o1 * il, 0.f) & 0xffffu); }
}
__device__ __forceinline__ fox::BlockRef<__hip_bfloat16, __hip_bfloat16> fox_mk(int a, int idx, const __hip_bfloat16* Qb, const __hip_bfloat16* Kb, const __hip_bfloat16* Vb, __hip_bfloat16* Ob) {
    const int pr = 4 * (a & 1) + (idx >> 1); const int x = (idx & 1) ? 15 - pr : pr;
    fox::BlockRef<__hip_bfloat16, __hip_bfloat16> r; r.Q = Qb + (size_t)x * 256 * cfg::QKVW; r.K = Kb; r.V = Vb; r.O = Ob + (size_t)x * 256 * cfg::DM; r.P0 = 64 + 256 * x; return r; }
__device__ __forceinline__ void fox_wg(PP P, int l, int a, char* lds) {
    using namespace cfg;
    typedef __hip_bfloat16 bf;
    const int bh = a >> 1, b = bh >> 3, h = bh & 7;
    float* bias = (float*)(lds + fox::BIAS_OFF); float* scr = (float*)(lds + fox::SCAN_OFF);
    fox_bias(P, l, b, h, bias, scr);
    const bf* QKV = (const bf*)(P->ws + WS_QKV); bf* Y = (bf*)(P->ws + WS_Y);
    const bf* Kb = QKV + (size_t)b * SEQP * QKVW + 1024 + h * 128; const bf* Vb = Kb + 1024; const bf* Qb = QKV + ((size_t)b * SEQP + 64) * QKVW + h * 128;
    bf* Ob = Y + (size_t)b * SEQ * DM + 1024 + h * 128;
    constexpr int W = 1 << 30;
    fox::Seam<bf> S;
    fox::BlockRef<bf, bf> cur = fox_mk(a, 0, Qb, Kb, Vb, Ob);
    fox::causal_swa_prime<bf, bf>(cur, W, lds, S);
#pragma unroll 1
    for (int idx = 0; idx < 8; ++idx) {
        const fox::BlockRef<bf, bf> nxt = (idx < 7) ? fox_mk(a, idx + 1, Qb, Kb, Vb, Ob) : cur;
        fox::causal_swa_block<bf, bf>(cur, nxt, SEQP, W, lds, S, bias);
        cur = nxt;
    }
    if (b == 0) fox_meta(P, h, bias);
}

#define WS_PTR(T, off) ((T*)(Q->ws + (off)))
#define SEAM() do { PP Qb_ = launder(P); XcdBarrier b_; b_.bar = (unsigned*)(Qb_->ws + WS_CTL); b_.x = xb_xcc_id(); b_.st = (volatile LAS unsigned*)(lds + LDS_BARW); xcd_barrier(b_); } while (0)
__global__ void __launch_bounds__(512, 2) hymba_fwd(Params Pv) {
    using namespace cfg;
    PP P = (PP)__builtin_amdgcn_kernarg_segment_ptr();
    extern __shared__ __attribute__((aligned(16))) unsigned char lds_raw[];
    LAS unsigned char* lds = (LAS unsigned char*)lds_raw;
    if (threadIdx.x < 4) ((LAS unsigned*)(lds + LDS_BARW))[threadIdx.x] = 0u;
    __syncthreads();
    { PP Q = launder(P); (void)xcd_barrier_post((unsigned*)(Q->ws + WS_CTL), (volatile LAS unsigned*)(lds + LDS_BARW)); }

    { PP Q = launder(P); phase_convert(Q, lds, 0, 1, lbid(), (int)gridDim.x); phase_init(Q); }
    SEAM();
    {
        PP Q = launder(P); const unsigned char* wl = Q->ws + WS_W + (size_t)0 * W_LAYER;
        pg8::Gemm g{WS_PTR(const bf16_t, WS_HB), (const bf16_t*)(wl + WO_GU1), MMAIN, NGU, DM}; pg8::StaticOrder S; S.init(MMAIN, NGU, (int)gridDim.x, lbid());
        pg8::EpiGU E{WS_PTR(bf16_t, WS_ACT), WS_PTR(const float, WS_SS) + (size_t)(0) * 8 * MROWS, (LAS float*)(lds + 131072 + 4096)};
        pg8::gemm_phase<pg8::EpiGU, pg8::StaticOrder, true, true>(lds, g, S, E);
        skinny_gu(WS_PTR(const bf16_t, WS_HB), g.Bt, WS_PTR(const float, WS_SSM) + (0) * 2048, WS_PTR(bf16_t, WS_ACT), lds);
    }
    SEAM();
    {
        PP Q = launder(P); const unsigned char* wl = Q->ws + WS_W + (size_t)0 * W_LAYER;
        pg8::Gemm g{WS_PTR(const bf16_t, WS_ACT), (const bf16_t*)(wl + WO_D1), MMAIN, DM, DFF}; pg8::StaticOrder S; S.init(MMAIN, DM, (int)gridDim.x, lbid());
        pg8::EpiRes E{WS_PTR(bf16_t, WS_HB), WS_PTR(float, WS_SS) + (size_t)(1) * 8 * MROWS, 0.5f, (LAS float*)(lds + 131072)};
        pg8::gemm_phase<pg8::EpiRes, pg8::StaticOrder, true, true>(lds, g, S, E);
        skinny_res(WS_PTR(const bf16_t, WS_ACT) + (size_t)MMAIN * DFF, DFF, g.Bt, WS_PTR(bf16_t, WS_HB), WS_PTR(float, WS_SSM) + (1) * 2048, 0.5f, lds);
    }
    SEAM();
    {
        PP Q = launder(P); const unsigned char* wl = Q->ws + WS_W + (size_t)0 * W_LAYER;
        pg8::Gemm g{WS_PTR(const bf16_t, WS_HB), (const bf16_t*)(wl + WO_IN), MMAIN, NIN, DM}; pg8::StaticOrder S; S.init(MMAIN, NIN, (int)gridDim.x, lbid());
        pg8::EpiP E{WS_PTR(bf16_t, WS_PR), WS_PTR(float, WS_PS), WS_PTR(bf16_t, WS_QKV), WS_PTR(const float, WS_SS) + (size_t)(1) * 8 * MROWS, (LAS float*)(lds + 131072 + 4096)};
        pg8::gemm_phase<pg8::EpiP, pg8::StaticOrder, true, true>(lds, g, S, E);
        skinny_p(WS_PTR(const bf16_t, WS_HB), g.Bt, WS_PTR(const float, WS_SSM) + (1) * 2048, WS_PTR(bf16_t, WS_PR), WS_PTR(float, WS_PS), WS_PTR(bf16_t, WS_QKV), lds);
    }
    SEAM();
    {
        PP Q = launder(P); const int u = lbid();
        if (u < 128) { rwkv_chunked(Q, 0, u >> 4, u & 15, lds); __syncthreads(); phase_convert(launder(P), lds, 1, 2, u, 128, 21248, 21248); }
        else { fox_wg(Q, 0, u - 128, (char*)lds_raw); __syncthreads(); phase_convert(launder(P), lds, 1, 2, u - 128, 128, 0, 21248); }
    }
    SEAM();
    { PP Q = launder(P); phase_foxnorm(Q); }
    SEAM();
    {
        PP Q = launder(P); const unsigned char* wl = Q->ws + WS_W + (size_t)0 * W_LAYER;
        pg8::Gemm g{WS_PTR(const bf16_t, WS_Y), (const bf16_t*)(wl + WO_OUT), MMAIN, DM, DM}; pg8::StaticOrder S; S.init(MMAIN, DM, (int)gridDim.x, lbid());
        pg8::EpiRes E{WS_PTR(bf16_t, WS_HB), WS_PTR(float, WS_SS) + (size_t)(2) * 8 * MROWS, 1.0f, (LAS float*)(lds + 131072)};
        pg8::gemm_phase<pg8::EpiRes, pg8::StaticOrder, true, true>(lds, g, S, E);
        skinny_res(WS_PTR(const bf16_t, WS_Y) + (size_t)MMAIN * DM, DM, g.Bt, WS_PTR(bf16_t, WS_HB), WS_PTR(float, WS_SSM) + (2) * 2048, 1.0f, lds);
    }
    SEAM();
    {
        PP Q = launder(P); const unsigned char* wl = Q->ws + WS_W + (size_t)0 * W_LAYER;
        pg8::Gemm g{WS_PTR(const bf16_t, WS_HB), (const bf16_t*)(wl + WO_GU2), MMAIN, NGU, DM}; pg8::StaticOrder S; S.init(MMAIN, NGU, (int)gridDim.x, lbid());
        pg8::EpiGU E{WS_PTR(bf16_t, WS_ACT), WS_PTR(const float, WS_SS) + (size_t)(2) * 8 * MROWS, (LAS float*)(lds + 131072 + 4096)};
        pg8::gemm_phase<pg8::EpiGU, pg8::StaticOrder, true, true>(lds, g, S, E);
        skinny_gu(WS_PTR(const bf16_t, WS_HB), g.Bt, WS_PTR(const float, WS_SSM) + (2) * 2048, WS_PTR(bf16_t, WS_ACT), lds);
    }
    SEAM();
    {
        PP Q = launder(P); const unsigned char* wl = Q->ws + WS_W + (size_t)0 * W_LAYER;
        pg8::Gemm g{WS_PTR(const bf16_t, WS_ACT), (const bf16_t*)(wl + WO_D2), MMAIN, DM, DFF}; pg8::StaticOrder S; S.init(MMAIN, DM, (int)gridDim.x, lbid());
        pg8::EpiRes E{WS_PTR(bf16_t, WS_HB), WS_PTR(float, WS_SS) + (size_t)(3) * 8 * MROWS, 0.5f, (LAS float*)(lds + 131072)};
        pg8::gemm_phase<pg8::EpiRes, pg8::StaticOrder, true, true>(lds, g, S, E);
        skinny_res(WS_PTR(const bf16_t, WS_ACT) + (size_t)MMAIN * DFF, DFF, g.Bt, WS_PTR(bf16_t, WS_HB), WS_PTR(float, WS_SSM) + (3) * 2048, 0.5f, lds);
    }
    SEAM();
    {
        PP Q = launder(P); const unsigned char* wl = Q->ws + WS_W + (size_t)1 * W_LAYER;
        pg8::Gemm g{WS_PTR(const bf16_t, WS_HB), (const bf16_t*)(wl + WO_GU1), MMAIN, NGU, DM}; pg8::StaticOrder S; S.init(MMAIN, NGU, (int)gridDim.x, lbid());
        pg8::EpiGU E{WS_PTR(bf16_t, WS_ACT), WS_PTR(const float, WS_SS) + (size_t)(3) * 8 * MROWS, (LAS float*)(lds + 131072 + 4096)};
        pg8::gemm_phase<pg8::EpiGU, pg8::StaticOrder, true, true>(lds, g, S, E);
        skinny_gu(WS_PTR(const bf16_t, WS_HB), g.Bt, WS_PTR(const float, WS_SSM) + (3) * 2048, WS_PTR(bf16_t, WS_ACT), lds);
    }
    SEAM();
    {
        PP Q = launder(P); const unsigned char* wl = Q->ws + WS_W + (size_t)1 * W_LAYER;
        pg8::Gemm g{WS_PTR(const bf16_t, WS_ACT), (const bf16_t*)(wl + WO_D1), MMAIN, DM, DFF}; pg8::StaticOrder S; S.init(MMAIN, DM, (int)gridDim.x, lbid());
        pg8::EpiRes E{WS_PTR(bf16_t, WS_HB), WS_PTR(float, WS_SS) + (size_t)(4) * 8 * MROWS, 0.5f, (LAS float*)(lds + 131072)};
        pg8::gemm_phase<pg8::EpiRes, pg8::StaticOrder, true, true>(lds, g, S, E);
        skinny_res(WS_PTR(const bf16_t, WS_ACT) + (size_t)MMAIN * DFF, DFF, g.Bt, WS_PTR(bf16_t, WS_HB), WS_PTR(float, WS_SSM) + (4) * 2048, 0.5f, lds);
    }
    SEAM();
    {
        PP Q = launder(P); const unsigned char* wl = Q->ws + WS_W + (size_t)1 * W_LAYER;
        pg8::Gemm g{WS_PTR(const bf16_t, WS_HB), (const bf16_t*)(wl + WO_IN), MMAIN, NIN, DM}; pg8::StaticOrder S; S.init(MMAIN, NIN, (int)gridDim.x, lbid());
        pg8::EpiP E{WS_PTR(bf16_t, WS_PR), WS_PTR(float, WS_PS), WS_PTR(bf16_t, WS_QKV), WS_PTR(const float, WS_SS) + (size_t)(4) * 8 * MROWS, (LAS float*)(lds + 131072 + 4096)};
        pg8::gemm_phase<pg8::EpiP, pg8::StaticOrder, true, true>(lds, g, S, E);
        skinny_p(WS_PTR(const bf16_t, WS_HB), g.Bt, WS_PTR(const float, WS_SSM) + (4) * 2048, WS_PTR(bf16_t, WS_PR), WS_PTR(float, WS_PS), WS_PTR(bf16_t, WS_QKV), lds);
    }
    SEAM();
    {
        PP Q = launder(P); const int u = lbid();
        if (u < 128) { rwkv_chunked(Q, 1, u >> 4, u & 15, lds); __syncthreads(); phase_convert(launder(P), lds, 2, 3, u, 128, 21248, 21248); }
        else { fox_wg(Q, 1, u - 128, (char*)lds_raw); __syncthreads(); phase_convert(launder(P), lds, 2, 3, u - 128, 128, 0, 21248); }
    }
    SEAM();
    { PP Q = launder(P); phase_foxnorm(Q); }
    SEAM();
    {
        PP Q = launder(P); const unsigned char* wl = Q->ws + WS_W + (size_t)1 * W_LAYER;
        pg8::Gemm g{WS_PTR(const bf16_t, WS_Y), (const bf16_t*)(wl + WO_OUT), MMAIN, DM, DM}; pg8::StaticOrder S; S.init(MMAIN, DM, (int)gridDim.x, lbid());
        pg8::EpiRes E{WS_PTR(bf16_t, WS_HB), WS_PTR(float, WS_SS) + (size_t)(5) * 8 * MROWS, 1.0f, (LAS float*)(lds + 131072)};
        pg8::gemm_phase<pg8::EpiRes, pg8::StaticOrder, true, true>(lds, g, S, E);
        skinny_res(WS_PTR(const bf16_t, WS_Y) + (size_t)MMAIN * DM, DM, g.Bt, WS_PTR(bf16_t, WS_HB), WS_PTR(float, WS_SSM) + (5) * 2048, 1.0f, lds);
    }
    SEAM();
    {
        PP Q = launder(P); const unsigned char* wl = Q->ws + WS_W + (size_t)1 * W_LAYER;
        pg8::Gemm g{WS_PTR(const bf16_t, WS_HB), (const bf16_t*)(wl + WO_GU2), MMAIN, NGU, DM}; pg8::StaticOrder S; S.init(MMAIN, NGU, (int)gridDim.x, lbid());
        pg8::EpiGU E{WS_PTR(bf16_t, WS_ACT), WS_PTR(const float, WS_SS) + (size_t)(5) * 8 * MROWS, (LAS float*)(lds + 131072 + 4096)};
        pg8::gemm_phase<pg8::EpiGU, pg8::StaticOrder, true, true>(lds, g, S, E);
        skinny_gu(WS_PTR(const bf16_t, WS_HB), g.Bt, WS_PTR(const float, WS_SSM) + (5) * 2048, WS_PTR(bf16_t, WS_ACT), lds);
    }
    SEAM();
    {
        PP Q = launder(P); const unsigned char* wl = Q->ws + WS_W + (size_t)1 * W_LAYER;
        pg8::Gemm g{WS_PTR(const bf16_t, WS_ACT), (const bf16_t*)(wl + WO_D2), MMAIN, DM, DFF}; pg8::StaticOrder S; S.init(MMAIN, DM, (int)gridDim.x, lbid());
        pg8::EpiRes E{WS_PTR(bf16_t, WS_HB), WS_PTR(float, WS_SS) + (size_t)(6) * 8 * MROWS, 0.5f, (LAS float*)(lds + 131072)};
        pg8::gemm_phase<pg8::EpiRes, pg8::StaticOrder, true, true>(lds, g, S, E);
        skinny_res(WS_PTR(const bf16_t, WS_ACT) + (size_t)MMAIN * DFF, DFF, g.Bt, WS_PTR(bf16_t, WS_HB), WS_PTR(float, WS_SSM) + (6) * 2048, 0.5f, lds);
    }
    SEAM();
    {
        PP Q = launder(P); const unsigned char* wl = Q->ws + WS_W + (size_t)2 * W_LAYER;
        pg8::Gemm g{WS_PTR(const bf16_t, WS_HB), (const bf16_t*)(wl + WO_GU1), MMAIN, NGU, DM}; pg8::StaticOrder S; S.init(MMAIN, NGU, (int)gridDim.x, lbid());
        pg8::EpiGU E{WS_PTR(bf16_t, WS_ACT), WS_PTR(const float, WS_SS) + (size_t)(6) * 8 * MROWS, (LAS float*)(lds + 131072 + 4096)};
        pg8::gemm_phase<pg8::EpiGU, pg8::StaticOrder, true, true>(lds, g, S, E);
        skinny_gu(WS_PTR(const bf16_t, WS_HB), g.Bt, WS_PTR(const float, WS_SSM) + (6) * 2048, WS_PTR(bf16_t, WS_ACT), lds);
    }
    SEAM();
    {
        PP Q = launder(P); const unsigned char* wl = Q->ws + WS_W + (size_t)2 * W_LAYER;
        pg8::Gemm g{WS_PTR(const bf16_t, WS_ACT), (const bf16_t*)(wl + WO_D1), MMAIN, DM, DFF}; pg8::StaticOrder S; S.init(MMAIN, DM, (int)gridDim.x, lbid());
        pg8::EpiRes E{WS_PTR(bf16_t, WS_HB), WS_PTR(float, WS_SS) + (size_t)(7) * 8 * MROWS, 0.5f, (LAS float*)(lds + 131072)};
        pg8::gemm_phase<pg8::EpiRes, pg8::StaticOrder, true, true>(lds, g, S, E);
        skinny_res(WS_PTR(const bf16_t, WS_ACT) + (size_t)MMAIN * DFF, DFF, g.Bt, WS_PTR(bf16_t, WS_HB), WS_PTR(float, WS_SSM) + (7) * 2048, 0.5f, lds);
    }
    SEAM();
    {
        PP Q = launder(P); const unsigned char* wl = Q->ws + WS_W + (size_t)2 * W_LAYER;
        pg8::Gemm g{WS_PTR(const bf16_t, WS_HB), (const bf16_t*)(wl + WO_IN), MMAIN, NIN, DM}; pg8::StaticOrder S; S.init(MMAIN, NIN, (int)gridDim.x, lbid());
        pg8::EpiP E{WS_PTR(bf16_t, WS_PR), WS_PTR(float, WS_PS), WS_PTR(bf16_t, WS_QKV), WS_PTR(const float, WS_SS) + (size_t)(7) * 8 * MROWS, (LAS float*)(lds + 131072 + 4096)};
        pg8::gemm_phase<pg8::EpiP, pg8::StaticOrder, true, true>(lds, g, S, E);
        skinny_p(WS_PTR(const bf16_t, WS_HB), g.Bt, WS_PTR(const float, WS_SSM) + (7) * 2048, WS_PTR(bf16_t, WS_PR), WS_PTR(float, WS_PS), WS_PTR(bf16_t, WS_QKV), lds);
    }
    SEAM();
    {
        PP Q = launder(P); const int u = lbid();
        if (u < 128) { rwkv_chunked(Q, 2, u >> 4, u & 15, lds); __syncthreads(); phase_convert(launder(P), lds, 3, 4, u, 128, 21248, 21248); }
        else { fox_wg(Q, 2, u - 128, (char*)lds_raw); __syncthreads(); phase_convert(launder(P), lds, 3, 4, u - 128, 128, 0, 21248); }
    }
    SEAM();
    { PP Q = launder(P); phase_foxnorm(Q); }
    SEAM();
    {
        PP Q = launder(P); const unsigned char* wl = Q->ws + WS_W + (size_t)2 * W_LAYER;
        pg8::Gemm g{WS_PTR(const bf16_t, WS_Y), (const bf16_t*)(wl + WO_OUT), MMAIN, DM, DM}; pg8::StaticOrder S; S.init(MMAIN, DM, (int)gridDim.x, lbid());
        pg8::EpiRes E{WS_PTR(bf16_t, WS_HB), WS_PTR(float, WS_SS) + (size_t)(8) * 8 * MROWS, 1.0f, (LAS float*)(lds + 131072)};
        pg8::gemm_phase<pg8::EpiRes, pg8::StaticOrder, true, true>(lds, g, S, E);
        skinny_res(WS_PTR(const bf16_t, WS_Y) + (size_t)MMAIN * DM, DM, g.Bt, WS_PTR(bf16_t, WS_HB), WS_PTR(float, WS_SSM) + (8) * 2048, 1.0f, lds);
    }
    SEAM();
    {
        PP Q = launder(P); const unsigned char* wl = Q->ws + WS_W + (size_t)2 * W_LAYER;
        pg8::Gemm g{WS_PTR(const bf16_t, WS_HB), (const bf16_t*)(wl + WO_GU2), MMAIN, NGU, DM}; pg8::StaticOrder S; S.init(MMAIN, NGU, (int)gridDim.x, lbid());
        pg8::EpiGU E{WS_PTR(bf16_t, WS_ACT), WS_PTR(const float, WS_SS) + (size_t)(8) * 8 * MROWS, (LAS float*)(lds + 131072 + 4096)};
        pg8::gemm_phase<pg8::EpiGU, pg8::StaticOrder, true, true>(lds, g, S, E);
        skinny_gu(WS_PTR(const bf16_t, WS_HB), g.Bt, WS_PTR(const float, WS_SSM) + (8) * 2048, WS_PTR(bf16_t, WS_ACT), lds);
    }
    SEAM();
    {
        PP Q = launder(P); const unsigned char* wl = Q->ws + WS_W + (size_t)2 * W_LAYER;
        pg8::Gemm g{WS_PTR(const bf16_t, WS_ACT), (const bf16_t*)(wl + WO_D2), MMAIN, DM, DFF}; pg8::StaticOrder S; S.init(MMAIN, DM, (int)gridDim.x, lbid());
        pg8::EpiRes E{WS_PTR(bf16_t, WS_HB), WS_PTR(float, WS_SS) + (size_t)(9) * 8 * MROWS, 0.5f, (LAS float*)(lds + 131072)};
        pg8::gemm_phase<pg8::EpiRes, pg8::StaticOrder, true, true>(lds, g, S, E);
        skinny_res(WS_PTR(const bf16_t, WS_ACT) + (size_t)MMAIN * DFF, DFF, g.Bt, WS_PTR(bf16_t, WS_HB), WS_PTR(float, WS_SSM) + (9) * 2048, 0.5f, lds);
    }
    SEAM();
    {
        PP Q = launder(P); const unsigned char* wl = Q->ws + WS_W + (size_t)3 * W_LAYER;
        pg8::Gemm g{WS_PTR(const bf16_t, WS_HB), (const bf16_t*)(wl + WO_GU1), MMAIN, NGU, DM}; pg8::StaticOrder S; S.init(MMAIN, NGU, (int)gridDim.x, lbid());
        pg8::EpiGU E{WS_PTR(bf16_t, WS_ACT), WS_PTR(const float, WS_SS) + (size_t)(9) * 8 * MROWS, (LAS float*)(lds + 131072 + 4096)};
        pg8::gemm_phase<pg8::EpiGU, pg8::StaticOrder, true, true>(lds, g, S, E);
        skinny_gu(WS_PTR(const bf16_t, WS_HB), g.Bt, WS_PTR(const float, WS_SSM) + (9) * 2048, WS_PTR(bf16_t, WS_ACT), lds);
    }
    SEAM();
    {
        PP Q = launder(P); const unsigned char* wl = Q->ws + WS_W + (size_t)3 * W_LAYER;
        pg8::Gemm g{WS_PTR(const bf16_t, WS_ACT), (const bf16_t*)(wl + WO_D1), MMAIN, DM, DFF}; pg8::StaticOrder S; S.init(MMAIN, DM, (int)gridDim.x, lbid());
        pg8::EpiRes E{WS_PTR(bf16_t, WS_HB), WS_PTR(float, WS_SS) + (size_t)(10) * 8 * MROWS, 0.5f, (LAS float*)(lds + 131072)};
        pg8::gemm_phase<pg8::EpiRes, pg8::StaticOrder, true, true>(lds, g, S, E);
        skinny_res(WS_PTR(const bf16_t, WS_ACT) + (size_t)MMAIN * DFF, DFF, g.Bt, WS_PTR(bf16_t, WS_HB), WS_PTR(float, WS_SSM) + (10) * 2048, 0.5f, lds);
    }
    SEAM();
    {
        PP Q = launder(P); const unsigned char* wl = Q->ws + WS_W + (size_t)3 * W_LAYER;
        pg8::Gemm g{WS_PTR(const bf16_t, WS_HB), (const bf16_t*)(wl + WO_IN), MMAIN, NIN, DM}; pg8::StaticOrder S; S.init(MMAIN, NIN, (int)gridDim.x, lbid());
        pg8::EpiP E{WS_PTR(bf16_t, WS_PR), WS_PTR(float, WS_PS), WS_PTR(bf16_t, WS_QKV), WS_PTR(const float, WS_SS) + (size_t)(10) * 8 * MROWS, (LAS float*)(lds + 131072 + 4096)};
        pg8::gemm_phase<pg8::EpiP, pg8::StaticOrder, true, true>(lds, g, S, E);
        skinny_p(WS_PTR(const bf16_t, WS_HB), g.Bt, WS_PTR(const float, WS_SSM) + (10) * 2048, WS_PTR(bf16_t, WS_PR), WS_PTR(float, WS_PS), WS_PTR(bf16_t, WS_QKV), lds);
    }
    SEAM();
    {
        PP Q = launder(P); const int u = lbid();
        if (u < 128) { rwkv_chunked(Q, 3, u >> 4, u & 15, lds); }
        else { fox_wg(Q, 3, u - 128, (char*)lds_raw);  }
    }
    SEAM();
    { PP Q = launder(P); phase_foxnorm(Q); }
    SEAM();
    {
        PP Q = launder(P); const unsigned char* wl = Q->ws + WS_W + (size_t)3 * W_LAYER;
        pg8::Gemm g{WS_PTR(const bf16_t, WS_Y), (const bf16_t*)(wl + WO_OUT), MMAIN, DM, DM}; pg8::StaticOrder S; S.init(MMAIN, DM, (int)gridDim.x, lbid());
        pg8::EpiRes E{WS_PTR(bf16_t, WS_HB), WS_PTR(float, WS_SS) + (size_t)(11) * 8 * MROWS, 1.0f, (LAS float*)(lds + 131072)};
        pg8::gemm_phase<pg8::EpiRes, pg8::StaticOrder, true, true>(lds, g, S, E);
        skinny_res(WS_PTR(const bf16_t, WS_Y) + (size_t)MMAIN * DM, DM, g.Bt, WS_PTR(bf16_t, WS_HB), WS_PTR(float, WS_SSM) + (11) * 2048, 1.0f, lds);
    }
    SEAM();
    {
        PP Q = launder(P); const unsigned char* wl = Q->ws + WS_W + (size_t)3 * W_LAYER;
        pg8::Gemm g{WS_PTR(const bf16_t, WS_HB), (const bf16_t*)(wl + WO_GU2), MMAIN, NGU, DM}; pg8::StaticOrder S; S.init(MMAIN, NGU, (int)gridDim.x, lbid());
        pg8::EpiGU E{WS_PTR(bf16_t, WS_ACT), WS_PTR(const float, WS_SS) + (size_t)(11) * 8 * MROWS, (LAS float*)(lds + 131072 + 4096)};
        pg8::gemm_phase<pg8::EpiGU, pg8::StaticOrder, true, true>(lds, g, S, E);
        skinny_gu(WS_PTR(const bf16_t, WS_HB), g.Bt, WS_PTR(const float, WS_SSM) + (11) * 2048, WS_PTR(bf16_t, WS_ACT), lds);
    }
    SEAM();
    {
        PP Q = launder(P); const unsigned char* wl = Q->ws + WS_W + (size_t)3 * W_LAYER;
        pg8::Gemm g{WS_PTR(const bf16_t, WS_ACT), (const bf16_t*)(wl + WO_D2), MMAIN, DM, DFF}; pg8::StaticOrder S; S.init(MMAIN, DM, (int)gridDim.x, lbid());
        pg8::EpiRes E{WS_PTR(bf16_t, WS_HB), WS_PTR(float, WS_SS) + (size_t)(12) * 8 * MROWS, 0.5f, (LAS float*)(lds + 131072)};
        pg8::gemm_phase<pg8::EpiRes, pg8::StaticOrder, true, true>(lds, g, S, E);
        skinny_res(WS_PTR(const bf16_t, WS_ACT) + (size_t)MMAIN * DFF, DFF, g.Bt, WS_PTR(bf16_t, WS_HB), WS_PTR(float, WS_SSM) + (12) * 2048, 0.5f, lds);
    }
    SEAM();
    { PP Q = launder(P); phase_final(Q); }
}

extern "C" void kernel_launch(void* const* d_in, const int* in_sizes, int n_in, void* d_out, int out_size, void* d_ws, size_t ws_size, hipStream_t stream) {
    using namespace cfg;
    static int grid = 0;
    if (grid == 0) {
        if (n_in != 25 || out_size != MMAIN * DM || ws_size < WS_END) { fprintf(stderr, "kernel_launch: need 25 inputs, out %d, ws >= %zu; got n_in %d out %d ws %zu\n", MMAIN * DM, (size_t)WS_END, n_in, out_size, ws_size); grid = -1; return; }
        int dev = 0, cus = 0, per_cu = 0;
        if (hipGetDevice(&dev) != hipSuccess || hipDeviceGetAttribute(&cus, hipDeviceAttributeMultiprocessorCount, dev) != hipSuccess) { grid = -1; return; }
        if (hipFuncSetAttribute((const void*)hymba_fwd, hipFuncAttributeMaxDynamicSharedMemorySize, LDS_BYTES) != hipSuccess) { fprintf(stderr, "kernel_launch: hipFuncSetAttribute failed\n"); grid = -1; return; }
        if (hipOccupancyMaxActiveBlocksPerMultiprocessor(&per_cu, (const void*)hymba_fwd, 512, LDS_BYTES) != hipSuccess || per_cu < 1) fprintf(stderr, "kernel_launch: occupancy query says %d\n", per_cu);
        (void)hipGetLastError();
        if (cus < 256) { fprintf(stderr, "kernel_launch: built for a 256-CU device (one resident workgroup per CU), found %d CUs\n", cus); grid = -1; return; }
        grid = 256;
    }
    if (grid < 0) return;
    if (hipMemsetAsync((char*)d_ws + WS_CTL, 0, CTL_BYTES, stream) != hipSuccess) return;
    Params p{};
    for (int i = 0; i < 25; ++i) p.in[i] = (const float*)d_in[i];
    p.out = (float*)d_out; p.ws = (unsigned char*)d_ws; p.ph_lo = 0; p.ph_hi = 0;
    hipLaunchKernelGGL(hymba_fwd, dim3(grid), dim3(512), LDS_BYTES, stream, p);
}
```

```cpp
#include <hip/hip_runtime.h>
#include <hip/hip_bf16.h>
#include <cstdio>
#include <cstdint>

#define LAS __attribute__((address_space(3)))
namespace cfg {
constexpr int DM = 2048, NBATCH = 8, SEQ = 4096, NMETA = 16, DEPTH = 4;
constexpr int MMAIN = NBATCH * SEQ;
constexpr int MROWS = MMAIN + 256;
constexpr int DFF = 5632, NGU = 2 * DFF;
constexpr int RW = 1024, RH = 64, RNH = 16;
constexpr int FW = 1024, FH = 128, FNH = 8;
constexpr int RWKV_COLS = 3360, DIN = 6440;
constexpr int NIN = 6656;
constexpr int PRW = 3072, PSW = 512, QKVW = 3072;
constexpr int SEQP = 4160;
constexpr float NORM_EPS = 1e-6f, LNX_EPS = 64e-5f;
constexpr int NSS = 13;
constexpr size_t al256(size_t x) { return (x + 255) & ~(size_t)255; }
constexpr size_t WS_CTL = 0;
constexpr size_t CTL_BYTES = 65536;
constexpr size_t WS_SS = WS_CTL + CTL_BYTES;
constexpr size_t SS_BYTES = al256((size_t)NSS * 8 * MROWS * 4);
constexpr size_t ZERO_BYTES = CTL_BYTES + SS_BYTES;
constexpr size_t WS_SSM = WS_SS + SS_BYTES;
constexpr size_t SSM_BYTES = (size_t)NSS * 2048 * 4;
constexpr size_t WS_HMETA = WS_SSM + SSM_BYTES;
constexpr size_t WS_HB = WS_HMETA + (size_t)256 * DM * 4;
constexpr size_t WS_Y = WS_HB + (size_t)MROWS * DM * 2;
constexpr size_t WS_OVL = WS_Y + (size_t)MROWS * DM * 2;
constexpr size_t WS_ACT = WS_OVL;
constexpr size_t WS_PR = WS_OVL;
constexpr size_t WS_PS = WS_PR + (size_t)MROWS * PRW * 2;
constexpr size_t WS_QKV = WS_PS + (size_t)MROWS * PSW * 4;
constexpr size_t OVL_A = (size_t)MROWS * DFF * 2, OVL_B = (size_t)MROWS * PRW * 2 + (size_t)MROWS * PSW * 4 + (size_t)NBATCH * SEQP * QKVW * 2;
constexpr size_t WS_W = WS_OVL + al256(OVL_A > OVL_B ? OVL_A : OVL_B);
constexpr size_t W_GU = (size_t)NGU * DM * 2, W_D = (size_t)DM * DFF * 2, W_IN = (size_t)NIN * DM * 2, W_OUT = (size_t)DM * DM * 2;
constexpr size_t WO_GU1 = 0, WO_D1 = WO_GU1 + W_GU, WO_IN = WO_D1 + W_D, WO_OUT = WO_IN + W_IN, WO_GU2 = WO_OUT + W_OUT, WO_D2 = WO_GU2 + W_GU, W_LAYER = WO_D2 + W_D;
constexpr size_t WS_LXG = WS_W + (size_t)DEPTH * W_LAYER;
constexpr size_t WS_END = WS_LXG + (size_t)MROWS * 320 * 2;
constexpr int LDS_BYTES = 147456;
constexpr int LDS_BARW = LDS_BYTES - 16;
}
__device__ __forceinline__ int ltid() { int t = (int)threadIdx.x; asm volatile("" : "+v"(t)); return t; }
__device__ __forceinline__ int lbid() { int t = (int)blockIdx.x; asm volatile("" : "+s"(t)); return t; }
__device__ __forceinline__ int lzero() { int t = 0; asm volatile("" : "+v"(t)); return t; }
namespace pg8 {
#define PG8_LAS __attribute__((address_space(3)))
typedef unsigned short bf16_t;
typedef short bf16x8 __attribute__((ext_vector_type(8)));
typedef float f32x4 __attribute__((ext_vector_type(4)));
typedef unsigned u32x4 __attribute__((ext_vector_type(4)));
constexpr int BM = 256, BK = 64, HALF = 128, HTB = HALF * BK * 2  , STAGE_BYTES = 8 * HTB, NXCD = 8, WGM = 8;

__host__ __device__ __forceinline__ int lds_byte(int r, int c) { const int st = (r >> 4) * 2 + (c >> 5), rr = r & 15, cc = c & 31, ob = rr * 64 + cc * 2; return st * 1024 + (ob ^ (((ob >> 9) & 1) << 5)); }
__host__ __device__ __forceinline__ void stage_rc(int b, int& R, int& C) { const int st = b / 1024, sb = b % 1024, swz = sb ^ (((sb >> 9) & 1) << 5); R = (st >> 1) * 16 + swz / 64; C = (st & 1) * 32 + (swz % 64) / 2; }
__host__ __device__ __forceinline__ int perm32(int rho) { const int n = rho >> 4, i = rho & 15; return 8 * (i >> 2) + 4 * n + (i & 3); }

struct Unit { int pm, pn; };
struct Gemm { const bf16_t* A; const bf16_t* Bt; int M, N, K; };

struct StaticOrder {
    int nM, nN, nwg, G, c;
    __host__ __device__ void init(int M, int N, int G_, int c_) { nM = M / BM; nN = N / BM; nwg = nM * nN; G = G_; c = c_; }
    __host__ __device__ bool next(int i, Unit& u) const {
        const long L = (long)i * G + c; if (L >= nwg) return false;
        int wgid = (int)L; { const int q = nwg / NXCD, r = nwg % NXCD, xcd = wgid % NXCD, off = wgid / NXCD; wgid = (xcd < r ? xcd * (q + 1) : r * (q + 1) + (xcd - r) * q) + off; }
        const int nig = WGM * nN, gid = wgid / nig, fm = gid * WGM, gsz = (nM - fm) < WGM ? (nM - fm) : WGM;
        u.pm = fm + ((wgid % nig) % gsz); u.pn = (wgid % nig) / gsz; return true;
    }
    __device__ __forceinline__ void a_ready(const Unit&) const {}
    __device__ __forceinline__ void done(const Unit&) const {}
};

__device__ __forceinline__ unsigned cvt_pk_bf16(float lo, float hi) { unsigned r; asm volatile("v_cvt_pk_bf16_f32 %0, %1, %2" : "=v"(r) : "v"(lo), "v"(hi)); return r; }
typedef float f32x2 __attribute__((ext_vector_type(2)));
__device__ __forceinline__ f32x2 gelu_pk(f32x2 v) {
    const f32x2 av = __builtin_elementwise_abs(v), d = av * 0.2316418882f + 1.0f;
    f32x2 t; t.x = __builtin_amdgcn_rcpf(d.x); t.y = __builtin_amdgcn_rcpf(d.y);
    f32x2 q = t * 0.5307027145f + (-0.7265760135f); q = q * t + 0.7107068705f; q = q * t + (-0.142248368f); q = q * t + 0.127414796f; q = q * t;
    const f32x2 s = (v * v) * (-0.72134752044f);
    f32x2 e; e.x = __builtin_amdgcn_exp2f(s.x); e.y = __builtin_amdgcn_exp2f(s.y);
    const f32x2 m = v * (q * e), r = v - m;
    f32x2 o; o.x = v.x < 0.f ? m.x : r.x; o.y = v.y < 0.f ? m.y : r.y; return o;
}
__device__ __forceinline__ float rs_of(const float* ss, int row) { float s = 0.f;
#pragma unroll
    for (int t = 0; t < 8; ++t) s += ss[(size_t)t * 33024 + row];
    return __builtin_amdgcn_rsqf(s * (1.0f / 2048.0f) + 1e-6f); }
__device__ __forceinline__ float silu_f(float x) { return x * __builtin_amdgcn_rcpf(1.0f + __builtin_amdgcn_exp2f(-1.4426950408889634f * x)); }

struct EpiGU {
    static constexpr bool PERM = true, AFTER_DRAIN = false;
    bf16_t* act; const float* ss; PG8_LAS float* rsb;
    __device__ __forceinline__ void operator()(const f32x4 (&acc)[2][2][4][2], const Unit& u, int wr, int wc, int fr, int fq) const {
        if (wr == 0) { const int rl = wc * 64 + fq * 16 + fr; rsb[rl] = rs_of(ss, u.pm * BM + rl); }
        asm volatile("s_waitcnt lgkmcnt(0)" ::: "memory"); __builtin_amdgcn_s_barrier(); asm volatile("" ::: "memory");
        const int rl0 = wr * 64 + fr, row0 = u.pm * BM + rl0, col0 = u.pn * 128 + wc * 32 + 8 * fq;
#pragma unroll
        for (int ai = 0; ai < 2; ++ai)
#pragma unroll
            for (int m = 0; m < 4; ++m) { const int row = row0 + ai * HALF + m * 16; const float rs = rsb[rl0 + ai * HALF + m * 16];
                const f32x4 g0 = acc[ai][0][m][0] * rs, g1 = acc[ai][0][m][1] * rs, u0 = acc[ai][1][m][0] * rs, u1 = acc[ai][1][m][1] * rs;
                u32x4 w;
                w.x = cvt_pk_bf16(silu_f(g0[0]) * u0[0], silu_f(g0[1]) * u0[1]); w.y = cvt_pk_bf16(silu_f(g0[2]) * u0[2], silu_f(g0[3]) * u0[3]);
                w.z = cvt_pk_bf16(silu_f(g1[0]) * u1[0], silu_f(g1[1]) * u1[1]); w.w = cvt_pk_bf16(silu_f(g1[2]) * u1[2], silu_f(g1[3]) * u1[3]);
                *(u32x4*)(act + (size_t)row * 5632 + col0) = w; }
        asm volatile("s_waitcnt lgkmcnt(0)" ::: "memory"); __builtin_amdgcn_s_barrier(); asm volatile("" ::: "memory");
    }
};
struct EpiRes {
    static constexpr bool PERM = true, AFTER_DRAIN = false;
    bf16_t* hb; float* ssn; float alpha; PG8_LAS float* red;
    __device__ __forceinline__ void operator()(const f32x4 (&acc)[2][2][4][2], const Unit& u, int wr, int wc, int fr, int fq) const {
        bf16_t* bbase = hb + (size_t)u.pm * BM * 2048;
        const int rl0 = wr * 64 + fr; unsigned off = (unsigned)(rl0 * 2048 + u.pn * BM + wc * 32 + 8 * fq);
#pragma unroll
        for (int ai = 0; ai < 2; ++ai) {
            u32x4 hv[4][2];
#pragma unroll
            for (int m = 0; m < 4; ++m)
#pragma unroll
                for (int bj = 0; bj < 2; ++bj) hv[m][bj] = *(const u32x4*)(bbase + (off + (unsigned)((ai * HALF + m * 16) * 2048) + bj * HALF));
#pragma unroll
            for (int m = 0; m < 4; ++m) { const unsigned o = off + (unsigned)((ai * HALF + m * 16) * 2048); float sq = 0.f;
#pragma unroll
                for (int bj = 0; bj < 2; ++bj) { const u32x4 x = hv[m][bj];
                    const f32x4 h0 = (f32x4){__uint_as_float(x.x << 16), __uint_as_float(x.x & 0xffff0000u), __uint_as_float(x.y << 16), __uint_as_float(x.y & 0xffff0000u)} + acc[ai][bj][m][0] * alpha;
                    const f32x4 h1 = (f32x4){__uint_as_float(x.z << 16), __uint_as_float(x.z & 0xffff0000u), __uint_as_float(x.w << 16), __uint_as_float(x.w & 0xffff0000u)} + acc[ai][bj][m][1] * alpha;
                    sq += ((h0[0] * h0[0] + h0[1] * h0[1]) + (h0[2] * h0[2] + h0[3] * h0[3])) + ((h1[0] * h1[0] + h1[1] * h1[1]) + (h1[2] * h1[2] + h1[3] * h1[3]));
                    u32x4 w; w.x = cvt_pk_bf16(h0[0], h0[1]); w.y = cvt_pk_bf16(h0[2], h0[3]); w.z = cvt_pk_bf16(h1[0], h1[1]); w.w = cvt_pk_bf16(h1[2], h1[3]); *(u32x4*)(bbase + o + bj * HALF) = w; }
                sq += __shfl_xor(sq, 16); sq += __shfl_xor(sq, 32);
                if (fq == 0) red[(rl0 + ai * HALF + m * 16) * 4 + wc] = sq; }
            asm volatile("" ::: "memory"); }
        asm volatile("s_waitcnt lgkmcnt(0)" ::: "memory"); __builtin_amdgcn_s_barrier(); asm volatile("" ::: "memory");
        if (wr == 0) { const int row = wc * 64 + fq * 16 + fr; const float s4 = (red[row * 4] + red[row * 4 + 1]) + (red[row * 4 + 2] + red[row * 4 + 3]); ssn[(size_t)u.pn * 33024 + u.pm * BM + row] = s4; }
    }
};
struct EpiP {
    static constexpr bool PERM = true, AFTER_DRAIN = false;
    bf16_t* pr; float* ps; bf16_t* qkv; const float* ss; PG8_LAS float* rsb;
    __device__ __forceinline__ void operator()(const f32x4 (&acc)[2][2][4][2], const Unit& u, int wr, int wc, int fr, int fq) const {
        if (wr == 0) { const int rl = wc * 64 + fq * 16 + fr; rsb[rl] = rs_of(ss, u.pm * BM + rl); }
        asm volatile("s_waitcnt lgkmcnt(0)" ::: "memory"); __builtin_amdgcn_s_barrier(); asm volatile("" ::: "memory");
        const int rl0 = wr * 64 + fr, row0 = u.pm * BM + rl0, cl = wc * 32 + 8 * fq;
#pragma unroll
        for (int ai = 0; ai < 2; ++ai)
#pragma unroll
            for (int m = 0; m < 4; ++m) { const int row = row0 + ai * HALF + m * 16; const float rs = rsb[rl0 + ai * HALF + m * 16];
#pragma unroll
                for (int bj = 0; bj < 2; ++bj) { const f32x4 v0 = acc[ai][bj][m][0] * rs, v1 = acc[ai][bj][m][1] * rs;
                    if (u.pn >= 12 && u.pn < 14) { float* d = ps + (size_t)row * 512 + (u.pn - 12) * 256 + bj * HALF + cl; *(f32x4*)d = v0; *(f32x4*)(d + 4) = v1; }
                    else { u32x4 w; w.x = cvt_pk_bf16(v0[0], v0[1]); w.y = cvt_pk_bf16(v0[2], v0[3]); w.z = cvt_pk_bf16(v1[0], v1[1]); w.w = cvt_pk_bf16(v1[2], v1[3]);
                        if (u.pn < 12) *(u32x4*)(pr + (size_t)row * 3072 + u.pn * 256 + bj * HALF + cl) = w;
                        else { const int c = (u.pn - 14) * 256 + bj * HALF + cl;
                            const int b = row >> 12, s = row & 4095; *(u32x4*)(qkv + ((size_t)b * 4160 + 64 + s) * 3072 + c) = w; } } } }
        asm volatile("s_waitcnt lgkmcnt(0)" ::: "memory"); __builtin_amdgcn_s_barrier(); asm volatile("" ::: "memory");
    }
};
template <class Epi, class Sched, bool ALIGN_EPI = false, bool SP2 = false>
__device__ __forceinline__ void gemm_phase(PG8_LAS unsigned char* lds, const Gemm g, const Sched& S, const Epi& E) {
    const int tid = ltid(), wid = __builtin_amdgcn_readfirstlane(tid >> 6), lane = tid & 63, wr = wid >> 2, wc = wid & 3, fr = lane & 15, fq = lane >> 4;
    const int K = g.K, nt = K / BK;
    unsigned voffA[2], voffB[2];
#pragma unroll
    for (int i = 0; i < 2; ++i) { int R, C; stage_rc(tid * 16 + i * 8192, R, C); const int Rb = Epi::PERM ? ((R & ~31) + perm32(R & 31)) : R;
        voffA[i] = (unsigned)(R * K + C) * 2u; voffB[i] = (unsigned)(Rb * K + C) * 2u; }
    const size_t kstep = (size_t)(BK * 2);
    const size_t hstep = (size_t)HALF * K * 2;
    const size_t tstep = 2 * hstep;
    const unsigned ldsw = (unsigned)wid * 1024u;
    const int aoff = lds_byte(wr * 64 + fr, fq * 8), boff = lds_byte(wc * 32 + fr, fq * 8);
#define PG8_SA(b, h) (((b) * 2 + (h)) * HTB)
#define PG8_SB(b, h) ((4 + (b) * 2 + (h)) * HTB)
#define PG8_STAGE(bufoff, gbase, voff) do { _Pragma("unroll") for (int _i = 0; _i < 2; ++_i) \
        __builtin_amdgcn_global_load_lds((const unsigned*)((const char*)(gbase) + (voff)[_i]), (PG8_LAS unsigned*)(lds + (bufoff) + ldsw + _i * 8192), 16, 0, 0); } while (0)
#define PG8_LDA(dst, b, h) do { _Pragma("unroll") for (int m = 0; m < 4; ++m) _Pragma("unroll") for (int k = 0; k < 2; ++k) dst[m][k] = *(const PG8_LAS bf16x8*)(lds + PG8_SA(b, h) + aoff + m * 2048 + k * 1024); } while (0)
#define PG8_LDB(dst, b, h) do { _Pragma("unroll") for (int n = 0; n < 2; ++n) _Pragma("unroll") for (int k = 0; k < 2; ++k) dst[n][k] = *(const PG8_LAS bf16x8*)(lds + PG8_SB(b, h) + boff + n * 2048 + k * 1024); } while (0)
#define PG8_MMA(ai, bj, At, Bt) do { __builtin_amdgcn_s_setprio(1); _Pragma("unroll") for (int m = 0; m < 4; ++m) _Pragma("unroll") for (int n = 0; n < 2; ++n) _Pragma("unroll") for (int k = 0; k < 2; ++k) \
        acc[ai][bj][m][n] = __builtin_amdgcn_mfma_f32_16x16x32_bf16(Bt[n][k], At[m][k], acc[ai][bj][m][n], 0, 0, 0); __builtin_amdgcn_s_setprio(0); } while (0)
#define PG8_WAIT_V(n) asm volatile("s_waitcnt vmcnt(" #n ")" ::: "memory")
#define PG8_WAIT_L(n) asm volatile("s_waitcnt lgkmcnt(" #n ")" ::: "memory")
#define PG8_BAR __builtin_amdgcn_s_barrier()
#define PG8_SCHED __builtin_amdgcn_sched_barrier(0)
    Unit cur, nxt; int ui = 0;
    if (!S.next(0, cur)) return;
    f32x4 acc[2][2][4][2];
#pragma unroll
    for (int a = 0; a < 2; ++a)
#pragma unroll
        for (int b = 0; b < 2; ++b)
#pragma unroll
            for (int m = 0; m < 4; ++m)
#pragma unroll
                for (int n = 0; n < 2; ++n) acc[a][b][m][n] = (f32x4){0.f, 0.f, 0.f, 0.f};
    bf16x8 At[4][2], B0[2][2], B1[2][2];
    const char* cA = (const char*)g.A + (size_t)cur.pm * tstep; const char* cB = (const char*)g.Bt + (size_t)cur.pn * tstep;
    S.a_ready(cur);
    if constexpr (SP2) {
        PG8_STAGE(PG8_SB(0, 0), cB, voffB); PG8_STAGE(PG8_SB(0, 1), cB + hstep, voffB); PG8_STAGE(PG8_SA(0, 0), cA, voffA); PG8_STAGE(PG8_SA(0, 1), cA + hstep, voffA);
        if (wr == 1) PG8_BAR;
        PG8_WAIT_V(2); PG8_BAR;
        PG8_STAGE(PG8_SB(1, 0), cB + kstep, voffB); PG8_STAGE(PG8_SA(1, 0), cA + kstep, voffA); PG8_STAGE(PG8_SB(1, 1), cB + hstep + kstep, voffB);
        PG8_WAIT_V(6); PG8_BAR;
    } else {
        PG8_STAGE(PG8_SB(0, 0), cB, voffB); PG8_STAGE(PG8_SA(0, 0), cA, voffA); PG8_STAGE(PG8_SB(0, 1), cB + hstep, voffB); PG8_STAGE(PG8_SA(0, 1), cA + hstep, voffA);
        if (wr == 1) PG8_BAR;
        PG8_WAIT_V(4); PG8_BAR;
        PG8_STAGE(PG8_SB(1, 0), cB + kstep, voffB); PG8_STAGE(PG8_SA(1, 0), cA + kstep, voffA); PG8_STAGE(PG8_SB(1, 1), cB + hstep + kstep, voffB);
        PG8_WAIT_V(6); PG8_BAR;
    }
    for (;;) {
        const bool has_next = S.next(ui + 1, nxt);
        const char* nA = has_next ? (const char*)g.A + (size_t)nxt.pm * tstep : cA; const char* nB = has_next ? (const char*)g.Bt + (size_t)nxt.pn * tstep : cB;
        for (int t = 0; t < nt; t += 2) {
            const bool last = (t == nt - 2);
            const char* a1 = cA + (size_t)(t + 1) * kstep;
            const char* a2 = last ? nA : cA + (size_t)(t + 2) * kstep; const char* b2 = last ? nB : cB + (size_t)(t + 2) * kstep;
            const char* a3 = a2 + kstep; const char* b3 = b2 + kstep;
            if (last && has_next) S.a_ready(nxt);
            if constexpr (SP2) {
            PG8_LDB(B0, 0, 0); PG8_LDB(B1, 0, 1); PG8_SCHED; PG8_LDA(At, 0, 0); PG8_STAGE(PG8_SA(1, 1), a1 + hstep, voffA);
            PG8_WAIT_V(8); PG8_WAIT_L(0); PG8_BAR; PG8_MMA(0, 0, At, B0); PG8_MMA(0, 1, At, B1); PG8_BAR; PG8_SCHED;
            PG8_LDA(At, 0, 1); PG8_STAGE(PG8_SB(0, 0), b2, voffB); PG8_STAGE(PG8_SB(0, 1), b2 + hstep, voffB); PG8_STAGE(PG8_SA(0, 0), a2, voffA);
            PG8_WAIT_V(8); PG8_WAIT_L(0); PG8_BAR; PG8_MMA(1, 0, At, B0); PG8_MMA(1, 1, At, B1); PG8_BAR; PG8_SCHED;
            PG8_LDB(B0, 1, 0); PG8_LDB(B1, 1, 1); PG8_SCHED; PG8_LDA(At, 1, 0); PG8_STAGE(PG8_SA(0, 1), a2 + hstep, voffA);
            PG8_WAIT_V(8); PG8_WAIT_L(0); PG8_BAR; PG8_MMA(0, 0, At, B0); PG8_MMA(0, 1, At, B1); PG8_BAR; PG8_SCHED;
            PG8_LDA(At, 1, 1); PG8_STAGE(PG8_SB(1, 0), b3, voffB); PG8_STAGE(PG8_SB(1, 1), b3 + hstep, voffB); PG8_STAGE(PG8_SA(1, 0), a3, voffA);
            PG8_WAIT_V(8); PG8_WAIT_L(0); PG8_BAR; PG8_MMA(1, 0, At, B0); PG8_MMA(1, 1, At, B1); PG8_BAR; PG8_SCHED;
            } else {
            PG8_LDB(B0, 0, 0); PG8_SCHED; PG8_LDA(At, 0, 0); PG8_STAGE(PG8_SA(1, 1), a1 + hstep, voffA);
            PG8_WAIT_L(8); PG8_BAR; PG8_WAIT_L(0); PG8_MMA(0, 0, At, B0); PG8_BAR; PG8_SCHED;
            PG8_LDB(B1, 0, 1); PG8_STAGE(PG8_SB(0, 0), b2, voffB);
            PG8_BAR; PG8_WAIT_L(0); PG8_MMA(0, 1, At, B1); PG8_BAR;
            PG8_LDA(At, 0, 1); PG8_STAGE(PG8_SA(0, 0), a2, voffA);
            PG8_BAR; PG8_WAIT_L(0); PG8_MMA(1, 0, At, B0); PG8_BAR; PG8_SCHED;
            PG8_STAGE(PG8_SB(0, 1), b2 + hstep, voffB);
            PG8_WAIT_V(6); PG8_BAR; PG8_MMA(1, 1, At, B1); PG8_BAR;
            PG8_LDB(B0, 1, 0); PG8_SCHED; PG8_LDA(At, 1, 0); PG8_STAGE(PG8_SA(0, 1), a2 + hstep, voffA);
            PG8_WAIT_L(8); PG8_BAR; PG8_WAIT_L(0); PG8_MMA(0, 0, At, B0); PG8_BAR; PG8_SCHED;
            PG8_LDB(B1, 1, 1); PG8_STAGE(PG8_SB(1, 0), b3, voffB);
            PG8_BAR; PG8_WAIT_L(0); PG8_MMA(0, 1, At, B1); PG8_BAR;
            PG8_LDA(At, 1, 1); PG8_STAGE(PG8_SA(1, 0), a3, voffA);
            PG8_BAR; PG8_WAIT_L(0); PG8_MMA(1, 0, At, B0); PG8_BAR; PG8_SCHED;
            PG8_STAGE(PG8_SB(1, 1), b3 + hstep, voffB);
            PG8_WAIT_V(6); PG8_BAR; PG8_MMA(1, 1, At, B1); PG8_BAR;
            }
        }
        if constexpr (ALIGN_EPI) { if (wr == 0) PG8_BAR; }
        if constexpr (!Epi::AFTER_DRAIN) { E(acc, cur, wr, wc, fr, fq); S.done(cur); }
        if (!has_next) break;
#pragma unroll
        for (int a = 0; a < 2; ++a)
#pragma unroll
            for (int b = 0; b < 2; ++b)
#pragma unroll
                for (int m = 0; m < 4; ++m)
#pragma unroll
                    for (int n = 0; n < 2; ++n) acc[a][b][m][n] = (f32x4){0.f, 0.f, 0.f, 0.f};
        cur = nxt; cA = nA; cB = nB; ++ui;
        if constexpr (ALIGN_EPI) { if (wr == 1) PG8_BAR; }
    }
    PG8_WAIT_V(0);
    if constexpr (!ALIGN_EPI) { if (wr == 0) PG8_BAR; }
    PG8_BAR;
    if constexpr (Epi::AFTER_DRAIN) { E.fused(acc, cur, wr, wc, fr, fq, lds, wid, lane); S.done(cur); }
#undef PG8_SA
#undef PG8_SB
#undef PG8_STAGE
#undef PG8_LDA
#undef PG8_LDB
#undef PG8_MMA
#undef PG8_WAIT_V
#undef PG8_WAIT_L
#undef PG8_BAR
#undef PG8_SCHED
}
}


#define XB_TMO      128
#define XB_XCNT(j)  (256  + 64 * (j))
#define XB_XSUB(j)  (1280 + 64 * (j))
#define XB_XGEN(j)  (2304 + 64 * (j))
#define XB_TOP      3328
#define XB_TOPGEN   3392
#define XCD_BAR_WORDS 3456
#define XB_SPIN_CAP (1u << 22)

__device__ __forceinline__ unsigned xb_ld(unsigned* p)              { return __hip_atomic_load(p, __ATOMIC_RELAXED, __HIP_MEMORY_SCOPE_AGENT); }
__device__ __forceinline__ unsigned xb_add(unsigned* p, unsigned v) { return __hip_atomic_fetch_add(p, v, __ATOMIC_RELAXED, __HIP_MEMORY_SCOPE_AGENT); }
__device__ __forceinline__ unsigned xb_xcc_id() { return (unsigned)__builtin_amdgcn_s_getreg((3 << 11) | 20) & 0xFu; }
#define XB_SPIN(cond, bar) do { unsigned _sp = 0; while (cond) { __builtin_amdgcn_s_sleep(1); \
    if ((++_sp & 255u) == 0u) { if (xb_ld(&(bar)[XB_TMO])) break; if (_sp > XB_SPIN_CAP) { atomicAdd(&(bar)[XB_TMO], 1u); break; } } } } while (0)

struct XcdBarrier {
    unsigned* bar; unsigned x;
    volatile LAS unsigned* st;
};

__device__ __forceinline__ XcdBarrier xcd_barrier_post(unsigned* bar, volatile LAS unsigned* st) {
    XcdBarrier b; b.bar = bar; b.x = xb_xcc_id(); b.st = st;
    if (threadIdx.x == 0) (void)xb_add(&bar[XB_XCNT(b.x)], 1u);
    return b;
}
__device__ __forceinline__ void xcd_barrier_complete(unsigned* bar, unsigned x, unsigned& nloc, unsigned& nx) {
    const unsigned G = gridDim.x * gridDim.y * gridDim.z;
    unsigned sum, cnt, mine, sp = 0u;
    for (;;) {
        sum = 0u; cnt = 0u; mine = 0u;
#pragma unroll
        for (unsigned j = 0; j < 16; ++j) { const unsigned c = xb_ld(&bar[XB_XCNT(j)]); sum += c; cnt += (c > 0u) ? 1u : 0u; mine = (j == x) ? c : mine; }
        if (sum == G) break;
        __builtin_amdgcn_s_sleep(1);
        if ((++sp & 255u) == 0u) { if (xb_ld(&bar[XB_TMO])) break; if (sp > XB_SPIN_CAP) { atomicAdd(&bar[XB_TMO], 1u); break; } }
    }
    nloc = mine > 0u ? mine : 1u; nx = cnt > 0u ? cnt : 1u;
}

__device__ __forceinline__ void xcd_barrier(const XcdBarrier& b) {
    asm volatile("s_waitcnt vmcnt(0)" ::: "memory");
    __syncthreads();
    if (threadIdx.x == 0) {
        unsigned* bar = b.bar;
        __builtin_amdgcn_s_waitcnt(0);
        unsigned nloc = b.st[0], nx = b.st[1];
        if (nloc == 0u) { xcd_barrier_complete(bar, b.x, nloc, nx); b.st[0] = nloc; b.st[1] = nx; }
        const unsigned old = xb_add(&bar[XB_XSUB(b.x)], 1u);
        const unsigned gen = old / nloc;
        if (old + 1u == (gen + 1u) * nloc) {
            __builtin_amdgcn_fence(__ATOMIC_RELEASE, "agent");
            asm volatile("s_waitcnt vmcnt(0)" ::: "memory");
            const unsigned og = xb_add(&bar[XB_TOP], 1u);
            const unsigned tg = og / nx;
            if (og + 1u == (tg + 1u) * nx) xb_add(&bar[XB_TOPGEN], 1u);
            else XB_SPIN(xb_ld(&bar[XB_TOPGEN]) == tg, bar);
            __builtin_amdgcn_fence(__ATOMIC_ACQUIRE, "agent");
            xb_add(&bar[XB_XGEN(b.x)], 1u);
            asm volatile("s_waitcnt vmcnt(0)" ::: "memory");
        } else {
            XB_SPIN(xb_ld(&bar[XB_XGEN(b.x)]) == gen, bar);
            __builtin_amdgcn_fence(__ATOMIC_ACQUIRE, "agent");
            asm volatile("s_waitcnt vmcnt(0)" ::: "memory");
        }
    }
    __syncthreads();
}


typedef unsigned short bf16_t;
typedef float f32x4 __attribute__((ext_vector_type(4)));
typedef unsigned u32x4 __attribute__((ext_vector_type(4)));
typedef unsigned u32x2 __attribute__((ext_vector_type(2)));
struct Params { const float* in[25]; float* out; unsigned char* ws; int ph_lo, ph_hi; };
#define CAS __attribute__((address_space(4)))
typedef const CAS Params* PP;
__device__ __forceinline__ PP launder(PP p) { asm volatile("" : "+s"(p)); return p; }
enum { I_X = 0, I_META, I_F1N, I_F1GU, I_F1D, I_MIXN, I_WIN, I_MU, I_W0, I_WUP, I_A0, I_AUP, I_GUP, I_KK, I_KA, I_RK, I_LNW, I_LNB, I_BF, I_FON, I_WOUT, I_F2N, I_F2GU, I_F2D, I_FINN };

typedef float f32x2_t __attribute__((ext_vector_type(2))); typedef __bf16 bf16x2v_t __attribute__((ext_vector_type(2)));
__device__ __forceinline__ unsigned pk_bf16(float lo, float hi) { f32x2_t v = {lo, hi}; bf16x2v_t b = __builtin_convertvector(v, bf16x2v_t); return __builtin_bit_cast(unsigned, b); }
__device__ __forceinline__ float bf2f(bf16_t b) { return __uint_as_float(((unsigned)b) << 16); }
__device__ __forceinline__ float wave_sum(float v) {
#pragma unroll
    for (int o = 32; o >= 1; o >>= 1) v += __shfl_xor(v, o);
    return v; }
__device__ __forceinline__ float wave_max(float v) {
#pragma unroll
    for (int o = 32; o >= 1; o >>= 1) v = fmaxf(v, __shfl_xor(v, o));
    return v; }
__device__ __forceinline__ float sigmoid_f(float x) { return __builtin_amdgcn_rcpf(1.0f + __expf(-x)); }

__device__ __forceinline__ void convert_tile(const float* __restrict__ src, bf16_t* __restrict__ dst, const float* __restrict__ gain, int K, int Nsrc, int kind, int tk, int tn, LAS float* T) {
    const int tid = ltid();
    {
        const int nl = (tid & 15) * 4, np = tn * 64 + nl; int sc;
        if (kind == 1) { const int pn = np >> 8, bj = (np >> 7) & 1, i = np & 127; sc = bj * cfg::DFF + pn * 128 + i; }
        else if (kind == 2) { sc = np < 3360 ? np : (np < 3368 ? 6432 + (np - 3360) : (np < 3584 ? -1 : 3360 + (np - 3584))); }
        else sc = np;
#pragma unroll
        for (int i = 0; i < 2; ++i) { const int kl = (tid >> 4) + 32 * i, k = tk * 64 + kl;
            f32x4 v = (f32x4){0.f, 0.f, 0.f, 0.f};
            if (sc >= 0) v = *(const f32x4*)(src + (size_t)k * Nsrc + sc);
            float g = 1.f; if (kind == 1 || kind == 2) g = gain[k]; else if (kind == 3) g = (k >= 1024) ? gain[k - 1024] : 1.f;
            T[kl * 65 + nl] = v[0] * g; T[kl * 65 + nl + 1] = v[1] * g; T[kl * 65 + nl + 2] = v[2] * g; T[kl * 65 + nl + 3] = v[3] * g; }
    }
    __syncthreads();
    {
        const int nl = tid >> 3, k8 = (tid & 7) * 8; u32x4 w;
        w.x = pk_bf16(T[(k8 + 0) * 65 + nl], T[(k8 + 1) * 65 + nl]); w.y = pk_bf16(T[(k8 + 2) * 65 + nl], T[(k8 + 3) * 65 + nl]);
        w.z = pk_bf16(T[(k8 + 4) * 65 + nl], T[(k8 + 5) * 65 + nl]); w.w = pk_bf16(T[(k8 + 6) * 65 + nl], T[(k8 + 7) * 65 + nl]);
        *(u32x4*)(dst + (size_t)(tn * 64 + nl) * K + tk * 64 + k8) = w;
    }
    __syncthreads();
}
__device__ __forceinline__ void phase_convert(PP P, LAS unsigned char* lds, int l0, int l1, int first, int nwg, int t0 = 0, int t1 = 0) {
    using namespace cfg;
    LAS float* T = (LAS float*)lds;
    constexpr int T_GU = (DM / 64) * (NGU / 64), T_D = (DFF / 64) * (DM / 64), T_IN = (DM / 64) * (NIN / 64), T_OUT = (DM / 64) * (DM / 64);
    constexpr int T_LAYER = 2 * T_GU + 2 * T_D + T_IN + T_OUT;
    if (t1 <= 0) t1 = T_LAYER;
    for (int t = l0 * T_LAYER + first; t < l1 * T_LAYER; t += nwg) {
        const int l = t / T_LAYER; int r = t - l * T_LAYER; if (r < t0 || r >= t1) continue;
        bf16_t* wl = (bf16_t*)(P->ws + WS_W + (size_t)l * W_LAYER);
        const float* src; bf16_t* dst; const float* gain = nullptr; int K, Nsrc, kind, ntn;
        if (r < T_GU) { src = P->in[I_F1GU] + (size_t)l * DM * NGU; dst = (bf16_t*)((unsigned char*)wl + WO_GU1); gain = P->in[I_F1N] + l * DM; K = DM; Nsrc = NGU; kind = 1; ntn = NGU / 64; }
        else if ((r -= T_GU) < T_D) { src = P->in[I_F1D] + (size_t)l * DFF * DM; dst = (bf16_t*)((unsigned char*)wl + WO_D1); K = DFF; Nsrc = DM; kind = 0; ntn = DM / 64; }
        else if ((r -= T_D) < T_IN) { src = P->in[I_WIN] + (size_t)l * DM * DIN; dst = (bf16_t*)((unsigned char*)wl + WO_IN); gain = P->in[I_MIXN] + l * DM; K = DM; Nsrc = DIN; kind = 2; ntn = NIN / 64; }
        else if ((r -= T_IN) < T_OUT) { src = P->in[I_WOUT] + (size_t)l * DM * DM; dst = (bf16_t*)((unsigned char*)wl + WO_OUT); gain = P->in[I_FON] + l * FW; K = DM; Nsrc = DM; kind = 3; ntn = DM / 64; }
        else if ((r -= T_OUT) < T_GU) { src = P->in[I_F2GU] + (size_t)l * DM * NGU; dst = (bf16_t*)((unsigned char*)wl + WO_GU2); gain = P->in[I_F2N] + l * DM; K = DM; Nsrc = NGU; kind = 1; ntn = NGU / 64; }
        else { r -= T_GU; src = P->in[I_F2D] + (size_t)l * DFF * DM; dst = (bf16_t*)((unsigned char*)wl + WO_D2); K = DFF; Nsrc = DM; kind = 0; ntn = DM / 64; }
        convert_tile(src, dst, gain, K, Nsrc, kind, r / ntn, r % ntn, T);
    }
}
__device__ __forceinline__ void phase_init(PP P) {
    using namespace cfg;
    const int lane = ltid() & 63, gw = lbid() * 8 + (ltid() >> 6), nw = gridDim.x * 8;
    bf16_t* hb = (bf16_t*)(P->ws + WS_HB); float* ss0 = (float*)(P->ws + WS_SS);
    for (int row = gw; row < MROWS; row += nw) {
        const float* s = row < MMAIN ? P->in[I_X] + (size_t)row * DM : P->in[I_META] + (size_t)(row - MMAIN) * DM;
        float sq = 0.f;
#pragma unroll
        for (int i = 0; i < 4; ++i) { f32x4 v0 = (f32x4){0.f, 0.f, 0.f, 0.f}, v1 = v0; if (row < MMAIN + NMETA) { v0 = *(const f32x4*)(s + i * 512 + lane * 8); v1 = *(const f32x4*)(s + i * 512 + lane * 8 + 4); }
            sq += ((v0[0] * v0[0] + v0[1] * v0[1]) + (v0[2] * v0[2] + v0[3] * v0[3])) + ((v1[0] * v1[0] + v1[1] * v1[1]) + (v1[2] * v1[2] + v1[3] * v1[3]));
            u32x4 w; w.x = pk_bf16(v0[0], v0[1]); w.y = pk_bf16(v0[2], v0[3]); w.z = pk_bf16(v1[0], v1[1]); w.w = pk_bf16(v1[2], v1[3]); *(u32x4*)(hb + (size_t)row * DM + i * 512 + lane * 8) = w; }
        sq = wave_sum(sq);
        if (lane < 8) ss0[(size_t)lane * MROWS + row] = lane == 0 ? sq : 0.f;
        if (row >= MMAIN && row < MMAIN + NMETA) { float* ssm0 = (float*)(P->ws + WS_SSM); ssm0[lane * 16 + (row - MMAIN)] = lane == 0 ? sq : 0.f; ssm0[(64 + lane) * 16 + (row - MMAIN)] = 0.f; }
    }
}
__device__ __forceinline__ void phase_foxnorm(PP P) {
    using namespace cfg;
    const int lane = ltid() & 63, gw = lbid() * 8 + (ltid() >> 6), nw = gridDim.x * 8;
    bf16_t* y = (bf16_t*)(P->ws + WS_Y);
    for (int row = gw; row < MMAIN + NMETA; row += nw) {
        bf16_t* p = y + (size_t)row * DM + 1024 + lane * 16;
        u32x4 a = *(const u32x4*)p, b = *(const u32x4*)(p + 8); float v[16];
#pragma unroll
        for (int i = 0; i < 4; ++i) { v[2 * i] = __uint_as_float(a[i] << 16); v[2 * i + 1] = __uint_as_float(a[i] & 0xffff0000u); v[8 + 2 * i] = __uint_as_float(b[i] << 16); v[8 + 2 * i + 1] = __uint_as_float(b[i] & 0xffff0000u); }
        float sq = 0.f;
#pragma unroll
        for (int i = 0; i < 16; ++i) sq += v[i] * v[i];
        sq = wave_sum(sq); const float rs = __builtin_amdgcn_rsqf(sq * (1.0f / 1024.0f) + NORM_EPS);
#pragma unroll
        for (int i = 0; i < 4; ++i) { a[i] = pk_bf16(v[2 * i] * rs, v[2 * i + 1] * rs); b[i] = pk_bf16(v[8 + 2 * i] * rs, v[8 + 2 * i + 1] * rs); }
        *(u32x4*)p = a; *(u32x4*)(p + 8) = b;
    }
}
__device__ __forceinline__ void phase_final(PP P) {
    using namespace cfg;
    const int lane = ltid() & 63, gw = lbid() * 8 + (ltid() >> 6), nw = gridDim.x * 8;
    const float* g = P->in[I_FINN]; const bf16_t* hb = (const bf16_t*)(P->ws + WS_HB);
    for (int row = gw; row < MMAIN; row += nw) {
        float* d = P->out + (size_t)row * DM; f32x4 v[8]; float sq = 0.f;
#pragma unroll
        for (int i = 0; i < 4; ++i) { const u32x4 x = *(const u32x4*)(hb + (size_t)row * DM + i * 512 + lane * 8);
            v[2 * i] = (f32x4){__uint_as_float(x.x << 16), __uint_as_float(x.x & 0xffff0000u), __uint_as_float(x.y << 16), __uint_as_float(x.y & 0xffff0000u)};
            v[2 * i + 1] = (f32x4){__uint_as_float(x.z << 16), __uint_as_float(x.z & 0xffff0000u), __uint_as_float(x.w << 16), __uint_as_float(x.w & 0xffff0000u)}; }
#pragma unroll
        for (int i = 0; i < 8; ++i) sq += (v[i][0] * v[i][0] + v[i][1] * v[i][1]) + (v[i][2] * v[i][2] + v[i][3] * v[i][3]);
        sq = wave_sum(sq); const float rs = __builtin_amdgcn_rsqf(sq * (1.0f / 2048.0f) + NORM_EPS);
#pragma unroll
        for (int i = 0; i < 4; ++i) { const f32x4 g0 = *(const f32x4*)(g + i * 512 + lane * 8), g1 = *(const f32x4*)(g + i * 512 + lane * 8 + 4);
            *(f32x4*)(d + i * 512 + lane * 8) = v[2 * i] * rs * g0; *(f32x4*)(d + i * 512 + lane * 8 + 4) = v[2 * i + 1] * rs * g1; }
    }
}


__device__ __forceinline__ void phase_lx(PP P, int l) {
    using namespace cfg;
    const int lane = ltid() & 63, gw = lbid() * 8 + (ltid() >> 6), nw = gridDim.x * 8;
    const float* PS = (const float*)(P->ws + WS_PS); bf16_t* LXG = (bf16_t*)(P->ws + WS_LXG); const float* mu = P->in[I_MU] + l * RWKV_COLS + 3072;
    if (lane < 36) {
        const f32x4 m0 = *(const f32x4*)(mu + lane * 8), m1 = *(const f32x4*)(mu + lane * 8 + 4);
#pragma unroll 4
        for (int row = gw; row < MMAIN + NMETA; row += nw) {
            int prev; if (row >= MMAIN) prev = (row == MMAIN) ? -1 : row - 1; else prev = ((row & (SEQ - 1)) == 0) ? MMAIN + NMETA - 1 : row - 1;
            const f32x4 c0 = *(const f32x4*)(PS + (size_t)row * PSW + lane * 8), c1 = *(const f32x4*)(PS + (size_t)row * PSW + lane * 8 + 4);
            f32x4 p0 = (f32x4){0.f, 0.f, 0.f, 0.f}, p1 = p0; if (prev >= 0) { p0 = *(const f32x4*)(PS + (size_t)prev * PSW + lane * 8); p1 = *(const f32x4*)(PS + (size_t)prev * PSW + lane * 8 + 4); }
            float x[8];
#pragma unroll
            for (int j = 0; j < 4; ++j) { x[j] = c0[j] + (p0[j] - c0[j]) * m0[j]; x[4 + j] = c1[j] + (p1[j] - c1[j]) * m1[j]; }
#pragma unroll
            for (int j = 0; j < 8; ++j) x[j] = lane < 8 ? 1.0f - 2.0f * __builtin_amdgcn_rcpf(__expf(2.0f * x[j]) + 1.0f) : (lane < 16 ? x[j] : __builtin_amdgcn_rcpf(1.0f + __expf(-x[j])));
            u32x4 w; w.x = pk_bf16(x[0], x[1]); w.y = pk_bf16(x[2], x[3]); w.z = pk_bf16(x[4], x[5]); w.w = pk_bf16(x[6], x[7]);
            *(u32x4*)(LXG + (size_t)row * 320 + lane * 8) = w;
        }
    }
}

typedef short bf16x8_t __attribute__((ext_vector_type(8)));
typedef short bf16x4_t __attribute__((ext_vector_type(4)));
namespace rk {
constexpr int RAWF = 0, RAWF_SZ = 18432, RAWH = 55296, RAWH_SZ = 6144, LXB = 73728, RS = 82944, KS = 87040, VS = 91136, KKN = 95232, ATP = 99328, RTP = 101376, BTP = 103424, KTP = 105472,
              BHT = 107520, KHT = 109568, VT = 111616, GT = 113664, AAK = 113920, RB = 114432, RKM = 114944, TINV = 115456, GG = 115968  , VF = 124160  , YR = 132352, BONP = 136448  , LDS_END = 136960;
}
template <int CTRL> __device__ __forceinline__ float dpp_f(float v) { return __builtin_bit_cast(float, __builtin_amdgcn_update_dpp(0, __builtin_bit_cast(int, v), CTRL, 0xf, 0xf, true)); }
__device__ __forceinline__ float row_sum16(float v) { v += dpp_f<0xB1>(v); v += dpp_f<0x4E>(v); v += dpp_f<0x141>(v); v += dpp_f<0x140>(v); return v; }
__device__ __forceinline__ float rdlane(float v, int l) { return __builtin_bit_cast(float, __builtin_amdgcn_readlane(__builtin_bit_cast(int, v), l)); }
__device__ __forceinline__ float wave_sum_dpp(float v) { v = row_sum16(v); return (rdlane(v, 0) + rdlane(v, 16)) + (rdlane(v, 32) + rdlane(v, 48)); }
#define RK_BAR() do { asm volatile("s_waitcnt lgkmcnt(0)" ::: "memory"); __builtin_amdgcn_s_barrier(); asm volatile("" ::: "memory"); } while (0)
__device__ __forceinline__ bf16_t bf1(float x) { return (bf16_t)(pk_bf16(x, 0.f) & 0xffffu); }
__device__ __forceinline__ bf16x4_t pack4(float a, float b, float c, float d) { u32x2 w; w.x = pk_bf16(a, b); w.y = pk_bf16(c, d); return __builtin_bit_cast(bf16x4_t, w); }
__device__ __forceinline__ float fast_sigmoid(float x) { return __builtin_amdgcn_rcpf(1.0f + __expf(-x)); }
__device__ __forceinline__ float fast_tanh(float x) { return 1.0f - 2.0f * __builtin_amdgcn_rcpf(__expf(2.0f * x) + 1.0f); }

__device__ __forceinline__ void rwkv_chunked(PP P, int l, int b, int h, LAS unsigned char* lds) {
    using namespace cfg;
    const int tid = ltid(), lane = tid & 63, wave = __builtin_amdgcn_readfirstlane(tid >> 6), n = lane & 15, g = lane >> 4;
    const bf16_t* PR = (const bf16_t*)(P->ws + WS_PR); const float* PS = (const float*)(P->ws + WS_PS); bf16_t* Y = (bf16_t*)(P->ws + WS_Y);
    const float* mu = P->in[I_MU] + l * RWKV_COLS; const bf16_t* LXGp = (const bf16_t*)(P->ws + WS_LXG);
    LAS float* RSm = (LAS float*)(lds + rk::RS); LAS float* KSm = (LAS float*)(lds + rk::KS); LAS float* VSm = (LAS float*)(lds + rk::VS); LAS float* KKNm = (LAS float*)(lds + rk::KKN);
    LAS bf16_t* ATp = (LAS bf16_t*)(lds + rk::ATP); LAS bf16_t* RTp = (LAS bf16_t*)(lds + rk::RTP); LAS bf16_t* BTp = (LAS bf16_t*)(lds + rk::BTP); LAS bf16_t* KTp = (LAS bf16_t*)(lds + rk::KTP);
    LAS bf16_t* BHt = (LAS bf16_t*)(lds + rk::BHT); LAS bf16_t* KHt = (LAS bf16_t*)(lds + rk::KHT); LAS bf16_t* Vt = (LAS bf16_t*)(lds + rk::VT);
    LAS float* GTm = (LAS float*)(lds + rk::GT);
    LAS bf16_t* AAKm = (LAS bf16_t*)(lds + rk::AAK); LAS bf16_t* RBm = (LAS bf16_t*)(lds + rk::RB); LAS bf16_t* RKm = (LAS bf16_t*)(lds + rk::RKM); LAS bf16_t* TINVm = (LAS bf16_t*)(lds + rk::TINV);
    LAS float* YRm = (LAS float*)(lds + rk::YR);
    const int hj = h * 64 + lane;
    const float mur = mu[hj], muk = mu[1024 + hj], muv = mu[2048 + hj], kkw = P->in[I_KK][l * RW + hj], lnw = P->in[I_LNW][l * RW + hj], lnb = P->in[I_LNB][l * RW + hj];
    float mul[5];
#pragma unroll
    for (int q = 0; q < 5; ++q) mul[q] = (lane + 64 * q < 288) ? mu[3072 + lane + 64 * q] : 0.f;
    const int kw = wave & 3, key = 16 * kw + n, hk = h * 64 + key;
    const float w0k = P->in[I_W0][l * RW + hk], a0k = P->in[I_A0][l * RW + hk], kak = P->in[I_KA][l * RW + hk], rkk = P->in[I_RK][l * RW + hk];
    const int pp = 32 * (key >> 5) + 8 * ((key >> 2) & 3) + 4 * ((key >> 4) & 1) + (key & 3);
    bf16x8_t fA[2], fB[5];
    {
        const float* wu = P->in[I_WUP] + (size_t)l * 64 * RW + hk; const float* au = P->in[I_AUP] + (size_t)l * 64 * RW + hk; const float* gu = P->in[I_GUP] + (size_t)l * 160 * RW + hk;
#pragma unroll
        for (int s = 0; s < 5; ++s) { float v[8], u[8];
#pragma unroll
            for (int j = 0; j < 8; ++j) { const int k = 32 * s + 8 * g + j; v[j] = (wave < 4) ? (s < 2 ? au[(size_t)k * RW] : 0.f) : gu[(size_t)k * RW]; u[j] = (wave < 4 && s < 2) ? wu[(size_t)k * RW] : 0.f; }
            u32x4 w; w.x = pk_bf16(v[0], v[1]); w.y = pk_bf16(v[2], v[3]); w.z = pk_bf16(v[4], v[5]); w.w = pk_bf16(v[6], v[7]); fB[s] = __builtin_bit_cast(bf16x8_t, w);
            if (s < 2) { u32x4 x; x.x = pk_bf16(u[0], u[1]); x.y = pk_bf16(u[2], u[3]); x.z = pk_bf16(u[4], u[5]); x.w = pk_bf16(u[6], u[7]); fA[s] = __builtin_bit_cast(bf16x8_t, x); } }
    }
    f32x4 ST[4];
#pragma unroll
    for (int kb = 0; kb < 4; ++kb) ST[kb] = (f32x4){0.f, 0.f, 0.f, 0.f};
#define RK_DMA(c_) do { const int cc_ = (c_); const int row0_ = (cc_ == 0) ? MMAIN : b * SEQ + (cc_ - 1) * 16; const int bi_ = cc_ % 3; \
        _Pragma("unroll") for (int i_ = 0; i_ < 2; ++i_) { const int wp_ = (i_ == 0) ? wave : 8; if (i_ == 0 || wave == 6) { const int x_ = wp_ * 64 + lane; \
            __builtin_amdgcn_global_load_lds((const unsigned*)(LXGp + (size_t)(row0_ + x_ / 36) * 320 + (x_ % 36) * 8), (LAS unsigned*)(lds + rk::RAWF + (cc_ & 1) * rk::RAWF_SZ + wp_ * 1024), 16, 0, 0); } } \
        if (wave < 6) { const int y_ = wave * 64 + lane; \
            __builtin_amdgcn_global_load_lds((const unsigned*)(PR + (size_t)(row0_ + y_ / 24) * PRW + ((y_ % 24) >> 3) * 1024 + h * 64 + (y_ & 7) * 8), (LAS unsigned*)(lds + rk::RAWH + bi_ * rk::RAWH_SZ + wave * 1024), 16, 0, 0); } } while (0)
#define RK_STAGE_A(ca_, t_) do { const int t = (t_); const int bc_ = (ca_) % 3, bp_ = ((ca_) + 2) % 3; \
        LAS const float* cF_ = (LAS const float*)(lds + rk::RAWF + bc_ * rk::RAWF_SZ); LAS const float* pF_ = (LAS const float*)(lds + rk::RAWF + bp_ * rk::RAWF_SZ); \
        LAS const bf16_t* cH_ = (LAS const bf16_t*)(lds + rk::RAWH + bc_ * rk::RAWH_SZ); LAS const bf16_t* pH_ = (LAS const bf16_t*)(lds + rk::RAWH + bp_ * rk::RAWH_SZ); \
        LAS const float* ctF = cF_ + t * 288; LAS const float* ptF = (t == 0) ? pF_ + 15 * 288 : cF_ + (t - 1) * 288; \
        LAS const bf16_t* ctH = cH_ + t * 192; LAS const bf16_t* ptH = (t == 0) ? pH_ + 15 * 192 : cH_ + (t - 1) * 192; \
        const float rc = bf2f(ctH[lane]), kc = bf2f(ctH[64 + lane]), vc = bf2f(ctH[128 + lane]); \
        const float rs = rc + (bf2f(ptH[lane]) - rc) * mur, ks = kc + (bf2f(ptH[64 + lane]) - kc) * muk, vs = vc + (bf2f(ptH[128 + lane]) - vc) * muv; \
        RSm[t * 64 + lane] = rs; KSm[t * 64 + lane] = ks; VSm[t * 64 + lane] = vs; \
        const float kkr = ks * kkw; const float n2 = wave_sum_dpp(kkr * kkr); KKNm[t * 64 + lane] = kkr * __builtin_amdgcn_rsqf(fmaxf(n2, 1e-24f)); } while (0)
#define RK_STAGE_F(cf_, t_) do { const int t = (t_); const int par_ = (cf_) & 1; const int rowF_ = ((cf_) == 0) ? MMAIN : b * SEQ + ((cf_) - 1) * 16; \
        LAS const float* Gp_ = (LAS const float*)(lds + rk::GG + par_ * 4096); LAS const float* Vp_ = (LAS const float*)(lds + rk::VF + par_ * 4096); LAS const float* Bp_ = (LAS const float*)(lds + rk::BONP + par_ * 256); \
        const float yv = YRm[t * 64 + lane]; \
        const float mean = wave_sum_dpp(yv) * (1.0f / 64.0f); const float d = yv - mean; const float var = wave_sum_dpp(d * d) * (1.0f / 64.0f); \
        const float yn = d * __builtin_amdgcn_rsqf(var + LNX_EPS) * lnw + lnb; \
        const float bonus = (Bp_[t] + Bp_[16 + t]) + (Bp_[32 + t] + Bp_[48 + t]); \
        const float o = (yn + bonus * Vp_[t * 64 + lane]) * Gp_[t * 64 + lane]; \
        if ((cf_) > 0 || b == 0) Y[(size_t)(rowF_ + t) * DM + hj] = bf1(o); } while (0)
    RK_DMA(0); RK_DMA(1);
    for (int e = tid; e < 96; e += 512) ((LAS unsigned*)(lds + rk::RAWH + 2 * rk::RAWH_SZ))[15 * 96 + e] = 0u;
    asm volatile("s_waitcnt vmcnt(0)" ::: "memory");
    RK_BAR();
    RK_STAGE_A(0, wave); RK_STAGE_A(0, wave + 8);
    RK_BAR();
#pragma unroll 1
    for (int c = 0; c < 257; ++c) {
        if (wave < 4) {
            LAS float* BONPc = (LAS float*)(lds + rk::BONP + (c & 1) * 256); LAS const bf16_t* LXB = (LAS const bf16_t*)(lds + rk::RAWF + (c & 1) * rk::RAWF_SZ);
            f32x4 accW = (f32x4){0.f, 0.f, 0.f, 0.f}, accA = accW;
#pragma unroll
            for (int s = 0; s < 2; ++s) { const bf16x8_t aw = *(const LAS bf16x8_t*)(LXB + n * 288 + 32 * s + 8 * g), aa = *(const LAS bf16x8_t*)(LXB + n * 288 + 64 + 32 * s + 8 * g);
                accW = __builtin_amdgcn_mfma_f32_16x16x32_bf16(aw, fA[s], accW, 0, 0, 0); accA = __builtin_amdgcn_mfma_f32_16x16x32_bf16(aa, fB[s], accA, 0, 0, 0); }
            float lw[4], alr[4], pfx[4];
#pragma unroll
            for (int r = 0; r < 4; ++r) { lw[r] = -0.6065306597126334f * fast_sigmoid(accW[r] + w0k); alr[r] = fast_sigmoid(accA[r] + a0k); }
            pfx[0] = lw[0]; pfx[1] = pfx[0] + lw[1]; pfx[2] = pfx[1] + lw[2]; pfx[3] = pfx[2] + lw[3];
            const float t0 = __shfl(pfx[3], n), t1 = __shfl(pfx[3], n + 16), t2 = __shfl(pfx[3], n + 32), t3 = __shfl(pfx[3], n + 48);
            const float base = (g > 0 ? t0 : 0.f) + (g > 1 ? t1 : 0.f) + (g > 2 ? t2 : 0.f), lamT = (t0 + t1) + (t2 + t3);
            float bh[4], kh[4], bon[4], epos[4];
            const float eb = __expf(base), eT = __expf(lamT);
#pragma unroll
            for (int r = 0; r < 4; ++r) epos[r] = __expf(base + pfx[r]);
#pragma unroll
            for (int r = 0; r < 4; ++r) { const int t = 4 * g + r;
                const float e_pos = epos[r], e_neg = __builtin_amdgcn_rcpf(epos[r]), e_prev = (r == 0) ? eb : epos[r > 0 ? r - 1 : 0], e_hat = eT * e_neg;
                const float rs = RSm[t * 64 + key], ks = KSm[t * 64 + key], kk = KKNm[t * 64 + key];
                const float kmod = ks * (1.0f + (alr[r] - 1.0f) * kak), bb = kk * alr[r];
                ATp[t * 64 + pp] = bf1(-kk * e_prev); RTp[t * 64 + pp] = bf1(rs * e_pos); BTp[t * 64 + pp] = bf1(bb * e_neg); KTp[t * 64 + pp] = bf1(kmod * e_neg);
                bh[r] = bb * e_hat; kh[r] = kmod * e_hat; bon[r] = rs * kmod * rkk; }
            *(LAS bf16x4_t*)(BHt + key * 16 + 4 * g) = pack4(bh[0], bh[1], bh[2], bh[3]); *(LAS bf16x4_t*)(KHt + key * 16 + 4 * g) = pack4(kh[0], kh[1], kh[2], kh[3]);
#pragma unroll
            for (int r = 0; r < 4; ++r) { const float x = row_sum16(bon[r]); if (n == 0) BONPc[kw * 16 + 4 * g + r] = x; }
            if (g == 0) GTm[key] = eT;
        } else {
            LAS float* Gc = (LAS float*)(lds + rk::GG + (c & 1) * 4096); LAS float* VFc = (LAS float*)(lds + rk::VF + (c & 1) * 4096); LAS const bf16_t* LXB = (LAS const bf16_t*)(lds + rk::RAWF + (c & 1) * rk::RAWF_SZ);
            f32x4 accG = (f32x4){0.f, 0.f, 0.f, 0.f};
#pragma unroll
            for (int s = 0; s < 5; ++s) { const bf16x8_t ag = *(const LAS bf16x8_t*)(LXB + n * 288 + 128 + 32 * s + 8 * g); accG = __builtin_amdgcn_mfma_f32_16x16x32_bf16(ag, fB[s], accG, 0, 0, 0); }
            float vv[4];
#pragma unroll
            for (int r = 0; r < 4; ++r) { Gc[(4 * g + r) * 64 + key] = accG[r]; vv[r] = VSm[(4 * g + r) * 64 + key]; VFc[(4 * g + r) * 64 + key] = vv[r]; }
            *(LAS bf16x4_t*)(Vt + key * 16 + 4 * g) = pack4(vv[0], vv[1], vv[2], vv[3]);
            if (c >= 1) { RK_STAGE_F(c - 1, 4 * kw); RK_STAGE_F(c - 1, 4 * kw + 1); RK_STAGE_F(c - 1, 4 * kw + 2); RK_STAGE_F(c - 1, 4 * kw + 3); }
        }
        asm volatile("s_waitcnt vmcnt(0)" ::: "memory");
        RK_BAR();
        if (c + 2 < 257) RK_DMA(c + 2);
        if (wave < 4) {
            LAS const bf16_t* X = (wave < 2) ? ATp : RTp; LAS const bf16_t* Yi = (wave & 1) ? KTp : BTp;
            f32x4 acc = (f32x4){0.f, 0.f, 0.f, 0.f};
#pragma unroll
            for (int s = 0; s < 2; ++s) { const bf16x8_t xa = *(const LAS bf16x8_t*)(X + n * 64 + 32 * s + 8 * g), yb = *(const LAS bf16x8_t*)(Yi + n * 64 + 32 * s + 8 * g);
                acc = __builtin_amdgcn_mfma_f32_16x16x32_bf16(xa, yb, acc, 0, 0, 0); }
            float mv[4];
#pragma unroll
            for (int r = 0; r < 4; ++r) { const int t = 4 * g + r; const bool keep = (wave < 2) ? (n < t) : (n <= t); mv[r] = keep ? acc[r] : 0.f;
                if (wave == 1) AAKm[t * 16 + n] = bf1(mv[r]); else if (wave == 2) RBm[t * 16 + n] = bf1(mv[r]); else if (wave == 3) RKm[t * 16 + n] = bf1(mv[r]); }
            if (wave == 0) {
                float Tc[16];
#pragma unroll
                for (int t = 0; t < 16; ++t) { float v0 = (t == n) ? 1.0f : 0.0f, v1 = 0.f;
#pragma unroll
                    for (int i = 0; i < t; ++i) { const float a = rdlane(mv[t & 3], i + 16 * (t >> 2)); if (i & 1) v1 += a * Tc[i]; else v0 += a * Tc[i]; }
                    Tc[t] = v0 + v1; __builtin_amdgcn_sched_barrier(0); }
                if (g == 0) {
#pragma unroll
                    for (int t = 0; t < 16; ++t) TINVm[t * 16 + n] = bf1(Tc[t]); }
            }
        }
        if (wave >= 1) {
            if (c + 1 < 257) { RK_STAGE_A(c + 1, wave - 1); RK_STAGE_A(c + 1, wave + 6); if (wave < 3) RK_STAGE_A(c + 1, wave + 13); }
        }
        RK_BAR();
        if (wave < 4) {
            bf16x8_t sb[2];
#pragma unroll
            for (int s = 0; s < 2; ++s) { u32x4 w; w.x = pk_bf16(ST[2 * s][0], ST[2 * s][1]); w.y = pk_bf16(ST[2 * s][2], ST[2 * s][3]); w.z = pk_bf16(ST[2 * s + 1][0], ST[2 * s + 1][1]); w.w = pk_bf16(ST[2 * s + 1][2], ST[2 * s + 1][3]);
                sb[s] = __builtin_bit_cast(bf16x8_t, w); }
            const bf16x4_t vfr = *(const LAS bf16x4_t*)(Vt + key * 16 + 4 * g);
            f32x4 W1 = (f32x4){0.f, 0.f, 0.f, 0.f}, Yc = W1;
#pragma unroll
            for (int s = 0; s < 2; ++s) { const bf16x8_t af = *(const LAS bf16x8_t*)(ATp + n * 64 + 32 * s + 8 * g), rf = *(const LAS bf16x8_t*)(RTp + n * 64 + 32 * s + 8 * g);
                W1 = __builtin_amdgcn_mfma_f32_16x16x32_bf16(af, sb[s], W1, 0, 0, 0); Yc = __builtin_amdgcn_mfma_f32_16x16x32_bf16(rf, sb[s], Yc, 0, 0, 0); }
            W1 = __builtin_amdgcn_mfma_f32_16x16x16bf16_1k(*(const LAS bf16x4_t*)(AAKm + n * 16 + 4 * g), vfr, W1, 0, 0, 0);
            const bf16x4_t w1f = pack4(W1[0], W1[1], W1[2], W1[3]);
            f32x4 U = __builtin_amdgcn_mfma_f32_16x16x16bf16_1k(*(const LAS bf16x4_t*)(TINVm + n * 16 + 4 * g), w1f, (f32x4){0.f, 0.f, 0.f, 0.f}, 0, 0, 0);
            const bf16x4_t uf = pack4(U[0], U[1], U[2], U[3]);
            Yc = __builtin_amdgcn_mfma_f32_16x16x16bf16_1k(*(const LAS bf16x4_t*)(RBm + n * 16 + 4 * g), uf, Yc, 0, 0, 0);
            Yc = __builtin_amdgcn_mfma_f32_16x16x16bf16_1k(*(const LAS bf16x4_t*)(RKm + n * 16 + 4 * g), vfr, Yc, 0, 0, 0);
#pragma unroll
            for (int r = 0; r < 4; ++r) YRm[(4 * g + r) * 64 + key] = Yc[r];
#pragma unroll
            for (int kb = 0; kb < 4; ++kb) { const f32x4 gt = *(const LAS f32x4*)(GTm + 16 * kb + 4 * g); f32x4 a = ST[kb] * gt;
                a = __builtin_amdgcn_mfma_f32_16x16x16bf16_1k(*(const LAS bf16x4_t*)(BHt + (16 * kb + n) * 16 + 4 * g), uf, a, 0, 0, 0);
                a = __builtin_amdgcn_mfma_f32_16x16x16bf16_1k(*(const LAS bf16x4_t*)(KHt + (16 * kb + n) * 16 + 4 * g), vfr, a, 0, 0, 0);
                ST[kb] = a; }
        }
        RK_BAR();
    }
    RK_STAGE_F(256, wave); RK_STAGE_F(256, wave + 8);
    asm volatile("s_waitcnt vmcnt(0)" ::: "memory");
    RK_BAR();
#undef RK_DMA
#undef RK_STAGE_A
#undef RK_STAGE_F
}

__device__ __forceinline__ f32x4 sk_dot(const bf16_t* a, const bf16_t* b, int nsteps) {
    f32x4 acc = (f32x4){0.f, 0.f, 0.f, 0.f};
#pragma unroll 8
    for (int s = 0; s < nsteps; ++s) { const bf16x8_t av = *(const bf16x8_t*)(a + 32 * s), bv = *(const bf16x8_t*)(b + 32 * s); acc = __builtin_amdgcn_mfma_f32_16x16x32_bf16(av, bv, acc, 0, 0, 0); }
    return acc; }
__device__ __forceinline__ void meta_rs(const float* ssm, int lane, float (&rs)[4]) {
    const int row = lane & 15, part = lane >> 4; float s = 0.f;
#pragma unroll 8
    for (int i = 0; i < 32; ++i) s += ssm[(part + 4 * i) * 16 + row];
    s = s + __shfl_xor(s, 16); s = s + __shfl_xor(s, 32);
    const float rv = __builtin_amdgcn_rsqf(s * (1.0f / 2048.0f) + 1e-6f);
#pragma unroll
    for (int r = 0; r < 4; ++r) rs[r] = __shfl(rv, 4 * part + r); }
#define SK_HEAD const int tid = ltid(), lane = tid & 63, wave = __builtin_amdgcn_readfirstlane(tid >> 6), n = lane & 15, g = lane >> 4, kq = wave & 3, ti = lbid() + 256 * (wave >> 2); LAS f32x4* part = (LAS f32x4*)lds;
#define SK_COMBINE(dst, slot) do { dst = (part[((wave) * 2 + (slot)) * 64 + lane] + part[((wave + 1) * 2 + (slot)) * 64 + lane]) + (part[((wave + 2) * 2 + (slot)) * 64 + lane] + part[((wave + 3) * 2 + (slot)) * 64 + lane]); } while (0)
__device__ __forceinline__ void skinny_gu(const bf16_t* hb, const bf16_t* Bt, const float* ssm, bf16_t* act, LAS unsigned char* lds) {
    using namespace cfg; SK_HEAD
    if (ti < DFF / 16) { const int c0 = 16 * ti, brow = (c0 >> 7) * 256 + (c0 & 127) + n; const bf16_t* a = hb + (size_t)(MMAIN + n) * DM + 512 * kq + 8 * g;
        part[(wave * 2) * 64 + lane] = sk_dot(a, Bt + (size_t)brow * DM + 512 * kq + 8 * g, 16); part[(wave * 2 + 1) * 64 + lane] = sk_dot(a, Bt + (size_t)(brow + 128) * DM + 512 * kq + 8 * g, 16); }
    __syncthreads();
    if (ti < DFF / 16 && kq == 0) { f32x4 gt, up; SK_COMBINE(gt, 0); SK_COMBINE(up, 1); float rs[4]; meta_rs(ssm, lane, rs);
#pragma unroll
        for (int r = 0; r < 4; ++r) { const float gv = gt[r] * rs[r], uv = up[r] * rs[r]; act[(size_t)(MMAIN + 4 * g + r) * DFF + 16 * ti + n] = bf1(gv * __builtin_amdgcn_rcpf(1.0f + __builtin_amdgcn_exp2f(-1.4426950408889634f * gv)) * uv); } }
    __syncthreads();
}
__device__ __forceinline__ void skinny_res(const bf16_t* A16, int K, const bf16_t* Bt, bf16_t* hb, float* ssm_out, float alpha, LAS unsigned char* lds) {
    using namespace cfg;
    const int tid = ltid(), lane = tid & 63, wave = __builtin_amdgcn_readfirstlane(tid >> 6), n = lane & 15, g = lane >> 4, ti = lbid(); LAS f32x4* part = (LAS f32x4*)lds;
    const int k8 = K / 8;
    if (ti < DM / 16) part[wave * 64 + lane] = sk_dot(A16 + (size_t)n * K + k8 * wave + 8 * g, Bt + (size_t)(16 * ti + n) * K + k8 * wave + 8 * g, k8 / 32);
    __syncthreads();
    if (ti < DM / 16 && wave == 0) { const f32x4 acc = ((part[lane] + part[64 + lane]) + (part[128 + lane] + part[192 + lane])) + ((part[256 + lane] + part[320 + lane]) + (part[384 + lane] + part[448 + lane]));
#pragma unroll
        for (int r = 0; r < 4; ++r) { const int m = 4 * g + r, col = 16 * ti + n; bf16_t* p = hb + (size_t)(MMAIN + m) * DM + col; const float hv = bf2f(*p) + alpha * acc[r]; *p = bf1(hv);
            const float sq = row_sum16(hv * hv); if (n == 0) ssm_out[ti * 16 + m] = sq; } }
    __syncthreads();
}
__device__ __forceinline__ void skinny_p(const bf16_t* hb, const bf16_t* Bt, const float* ssm, bf16_t* pr, float* ps, bf16_t* qkv, LAS unsigned char* lds) {
    using namespace cfg; SK_HEAD
    if (ti < NIN / 16) part[(wave * 2) * 64 + lane] = sk_dot(hb + (size_t)(MMAIN + n) * DM + 512 * kq + 8 * g, Bt + (size_t)(16 * ti + n) * DM + 512 * kq + 8 * g, 16);
    __syncthreads();
    if (ti < NIN / 16 && kq == 0) { f32x4 acc; SK_COMBINE(acc, 0); float rs[4]; meta_rs(ssm, lane, rs); const int np = 16 * ti + n;
#pragma unroll
        for (int r = 0; r < 4; ++r) { const int m = 4 * g + r; const float v = acc[r] * rs[r];
            if (np < 3072) pr[(size_t)(MMAIN + m) * PRW + np] = bf1(v);
            else if (np < 3584) ps[(size_t)(MMAIN + m) * PSW + (np - 3072)] = v;
            else { const bf16_t w = bf1(v);
#pragma unroll
                for (int b = 0; b < NBATCH; ++b) qkv[((size_t)b * SEQP + 48 + m) * QKVW + (np - 3584)] = w; } } }
    __syncthreads();
}
#undef SK_HEAD
#undef SK_COMBINE

namespace fox {
constexpr int D = 128, NW = 8, QBLK = 32, KVBLK = 64, QB = NW * QBLK;
constexpr int LDQ = cfg::QKVW, LDK = cfg::QKVW, LDO = cfg::DM;
constexpr float SCALE = 0.08838834764831845f, THR = 8.f;
constexpr bool WSKIP = false;
constexpr int SHM_V = KVBLK * D * 2, SHM_K = KVBLK * D * 2;
constexpr int ATT_LDS = 2 * SHM_V + 2 * SHM_K + NW * 64 * 4;
constexpr int BIAS_OFF = ATT_LDS;
constexpr int SCAN_OFF = BIAS_OFF + cfg::SEQP * 4;

using bf16 = __hip_bfloat16;
typedef short bf16x8 __attribute__((ext_vector_type(8)));
typedef short s16x4 __attribute__((ext_vector_type(4)));
typedef float f32x16 __attribute__((ext_vector_type(16)));
typedef float f32x4 __attribute__((ext_vector_type(4)));
typedef unsigned u32x4 __attribute__((ext_vector_type(4)));
template <class A, class Bt> struct same_t { static constexpr bool v = false; };
template <class A> struct same_t<A, A> { static constexpr bool v = true; };

#define KSWZ(row, colB) ((row) * 256 + ((colB) ^ (((row) & 7) << 4)))
#define SBAR() __builtin_amdgcn_sched_barrier(0)
__device__ __forceinline__ int v_st(int k, int c) { const int kk = (k & ~0xC) | ((k & 4) << 1) | ((k & 8) >> 1); return ((kk >> 3) * 4 + (c >> 5)) * 512 + ((kk & 7) * 32 + (c & 31)) * 2; }
__device__ __forceinline__ int v_rd_base(int lane) { return ((lane & 3) << 3) | (((lane >> 2) & 3) << 6) | (((lane >> 4) & 1) << 5) | (((lane >> 5) & 1) << 8); }
constexpr int v_rd_off(int d0, int ks, int half) { return d0 * 512 + ks * 4096 + half * 2048; }
__device__ __forceinline__ int crow(int r, int hi) { return (r & 3) + 8 * (r >> 2) + 4 * hi; }
__device__ __forceinline__ unsigned cvtpk(float lo, float hi) {
    unsigned r; asm volatile("v_cvt_pk_bf16_f32 %0, %1, %2" : "=v"(r) : "v"(lo), "v"(hi)); return r;
}
__device__ __forceinline__ bf16x8 pack8(f32x4 a, f32x4 b) {
    u32x4 w = {cvtpk(a[0], a[1]), cvtpk(a[2], a[3]), cvtpk(b[0], b[1]), cvtpk(b[2], b[3])};
    return *reinterpret_cast<bf16x8*>(&w);
}
template <class T> __device__ __forceinline__ bf16x8 load8(const T* p) {
    if constexpr (same_t<T, float>::v) { return pack8(*(const f32x4*)p, *(const f32x4*)(p + 4)); }
    else { return *reinterpret_cast<const bf16x8*>(p); }
}
__device__ __forceinline__ void mask_tile(f32x16& p0, f32x16& p1, int dq, unsigned W) {
    const float NEG = -__builtin_inff();
#pragma unroll
    for (int r = 0; r < 16; ++r) {
        const int c = (r & 3) + 8 * (r >> 2);
        if ((unsigned)(dq - c) >= W) p0[r] = NEG;
        if ((unsigned)(dq - c - 32) >= W) p1[r] = NEG;
    }
}
__device__ __forceinline__ void partialSM(f32x16& p0, f32x16& p1, float& m_reg, float& mn, float& alpha) {
    float pmax = p0[0]; for (int r = 1; r < 16; ++r) pmax = fmaxf(pmax, p0[r]); for (int r = 0; r < 16; ++r) pmax = fmaxf(pmax, p1[r]);
    { auto rr = __builtin_amdgcn_permlane32_swap(__float_as_uint(pmax), __float_as_uint(pmax), false, false);
      pmax = fmaxf(__uint_as_float(rr[0]), __uint_as_float(rr[1])); }
    constexpr float C2 = 1.4426950408889634f * SCALE;
    if (__builtin_expect(__all((pmax - m_reg) * SCALE <= THR), 1)) { mn = m_reg; alpha = 1.f; }
    else { mn = fmaxf(m_reg, pmax); alpha = __builtin_amdgcn_exp2f((m_reg - mn) * C2); m_reg = mn; }
    const float mnL = -mn * C2;
    for (int r = 0; r < 16; ++r) p0[r] = fmaf(p0[r], C2, mnL); for (int r = 0; r < 16; ++r) p1[r] = fmaf(p1[r], C2, mnL);
    for (int r = 0; r < 16; ++r) p0[r] = __builtin_amdgcn_exp2f(p0[r]);
}
__device__ __forceinline__ void finishSM(f32x16& p0, f32x16& p1, float alpha, float& l_reg, bf16x8& pa0, bf16x8& pa1, bf16x8& pa2, bf16x8& pa3) {
    for (int r = 0; r < 16; ++r) p1[r] = __builtin_amdgcn_exp2f(p1[r]);
    float ps = 0; for (int r = 0; r < 16; ++r) ps += p0[r]; for (int r = 0; r < 16; ++r) ps += p1[r];
    { auto rr = __builtin_amdgcn_permlane32_swap(__float_as_uint(ps), __float_as_uint(ps), false, false);
      ps = __uint_as_float(rr[0]) + __uint_as_float(rr[1]); }
    l_reg = l_reg * alpha + ps;
#define PK4(P, B_, OUT) do { unsigned a0 = cvtpk(P[B_+0], P[B_+1]), a1 = cvtpk(P[B_+2], P[B_+3]);                          \
        unsigned b0 = cvtpk(P[B_+4], P[B_+5]), b1 = cvtpk(P[B_+6], P[B_+7]);                                             \
        auto r0 = __builtin_amdgcn_permlane32_swap(a0, b0, false, false); auto r1 = __builtin_amdgcn_permlane32_swap(a1, b1, false, false); \
        u32x4 w = {r0[0], r1[0], r0[1], r1[1]}; OUT = *reinterpret_cast<bf16x8*>(&w); } while (0)
    PK4(p0, 0, pa0); PK4(p0, 8, pa1); PK4(p1, 0, pa2); PK4(p1, 8, pa3);
#undef PK4
}
template <int KB, bool SK>
__device__ __forceinline__ void qkt(f32x16& p0, f32x16& p1, const char* K_lds, int r32, int hi, const bf16x8* qr, bool act, const float* bias_t) {
    if (SK && !act) { const float NEG = -__builtin_inff();
#pragma unroll
        for (int r = 0; r < 16; ++r) { p0[r] = NEG; p1[r] = NEG; } return; }
    {
#pragma unroll
        for (int g_ = 0; g_ < 4; ++g_) { const f32x4 b0_ = *(const f32x4*)(bias_t + 8 * g_ + 4 * hi); const f32x4 b1_ = *(const f32x4*)(bias_t + 32 + 8 * g_ + 4 * hi);
            p0[4 * g_] = b0_[0]; p0[4 * g_ + 1] = b0_[1]; p0[4 * g_ + 2] = b0_[2]; p0[4 * g_ + 3] = b0_[3];
            p1[4 * g_] = b1_[0]; p1[4 * g_ + 1] = b1_[1]; p1[4 * g_ + 2] = b1_[2]; p1[4 * g_ + 3] = b1_[3]; } }
    const char* kb[4];
#pragma unroll
    for (int dd = 0; dd < 4; ++dd) kb[dd] = K_lds + KB * SHM_K + KSWZ(r32, (dd * 16 + hi * 8) * 2);
#pragma unroll
    for (int d0 = 0; d0 < 8; ++d0) { const char* a = kb[d0 & 3] + (d0 >> 2) * 128;
        bf16x8 b0 = *reinterpret_cast<const bf16x8*>(a);
        bf16x8 b1 = *reinterpret_cast<const bf16x8*>(a + 32 * 256);
        p0 = __builtin_amdgcn_mfma_f32_32x32x16_bf16(b0, qr[d0], p0, 0, 0, 0);
        p1 = __builtin_amdgcn_mfma_f32_32x32x16_bf16(b1, qr[d0], p1, 0, 0, 0); }
}
template <int VB, bool SK>
__device__ __forceinline__ void pv_tile(f32x16* o, int vb0, bf16x8 pa0, bf16x8 pa1, bf16x8 pa2, bf16x8 pa3, bool act) {
    if (SK && !act) return;
#define TRRD(dst, off) asm volatile("ds_read_b64_tr_b16 %0, %1 offset:%2" : "=&v"(dst) : "v"(vb0), "i"(off) : "memory")
#define PV_D0(d0) do { s16x4 l0, l1, l2, l3, h0, h1, h2, h3; constexpr int b_ = VB * SHM_V + v_rd_off(d0, 0, 0);     \
        TRRD(l0, b_); TRRD(h0, b_ + 2048); TRRD(l1, b_ + 4096); TRRD(h1, b_ + 6144); TRRD(l2, b_ + 8192); TRRD(h2, b_ + 10240); TRRD(l3, b_ + 12288); TRRD(h3, b_ + 14336); \
        asm volatile("s_waitcnt lgkmcnt(0)" ::: "memory"); SBAR();                 \
        o[d0] = __builtin_amdgcn_mfma_f32_32x32x16_bf16(pa0, (bf16x8){l0[0], l0[1], l0[2], l0[3], h0[0], h0[1], h0[2], h0[3]}, o[d0], 0, 0, 0);   \
        o[d0] = __builtin_amdgcn_mfma_f32_32x32x16_bf16(pa1, (bf16x8){l1[0], l1[1], l1[2], l1[3], h1[0], h1[1], h1[2], h1[3]}, o[d0], 0, 0, 0);   \
        o[d0] = __builtin_amdgcn_mfma_f32_32x32x16_bf16(pa2, (bf16x8){l2[0], l2[1], l2[2], l2[3], h2[0], h2[1], h2[2], h2[3]}, o[d0], 0, 0, 0);   \
        o[d0] = __builtin_amdgcn_mfma_f32_32x32x16_bf16(pa3, (bf16x8){l3[0], l3[1], l3[2], l3[3], h3[0], h3[1], h3[2], h3[3]}, o[d0], 0, 0, 0); } while (0)
    PV_D0(0); PV_D0(1); PV_D0(2); PV_D0(3);
#undef PV_D0
#undef TRRD
}

template <class TIn, class TOut> struct BlockRef { const TIn* Q; const TIn* K; const TIn* V; TOut* O; int P0; };
template <class TIn> struct Seam {
    bf16x8 qr[8];
    bf16x8 st_v0, st_v1, st_k0, st_k1; f32x4 sf0, sf1, sf2, sf3;
    f32x4 tq[16];
};
__device__ __forceinline__ int swa_jlo(int P0, int W) { const int lowk = P0 - W + 1; return lowk > 0 ? lowk / KVBLK : 0; }
#define ROW(p, k0, rr) ((p) + (size_t)((k0) + (rr)) * LDK + sc)
#define VMW() asm volatile("s_waitcnt vmcnt(0)" ::: "memory")
#define VMWN(n) asm volatile("s_waitcnt vmcnt(%0)" :: "i"(n) : "memory")
#define SLOAD_H(Kp, Vp, k0) do { S.st_v0 = load8<TIn>(ROW(Vp, k0, sr)); S.st_v1 = load8<TIn>(ROW(Vp, k0, 32 + sr));              \
                         S.st_k0 = load8<TIn>(ROW(Kp, k0, sr)); S.st_k1 = load8<TIn>(ROW(Kp, k0, 32 + sr)); } while (0)
#define SWRITE_HK(bf) do { *(bf16x8*)(K_lds + (bf) * SHM_K + kws) = S.st_k0; *(bf16x8*)(K_lds + (bf) * SHM_K + kws + 32 * 256) = S.st_k1; } while (0)
#define SWRITE_HV(bf) do { *(bf16x8*)(V_lds + (bf) * SHM_V + vst0) = S.st_v0; *(bf16x8*)(V_lds + (bf) * SHM_V + vst1) = S.st_v1; } while (0)
#define SWRITE_H(bf) do { SWRITE_HV(bf); SWRITE_HK(bf); } while (0)
#define SLOAD_F(p, k0) do { S.sf0 = *(const f32x4*)ROW(p, k0, sr); S.sf1 = *(const f32x4*)(ROW(p, k0, sr) + 4);                \
                            S.sf2 = *(const f32x4*)ROW(p, k0, 32 + sr); S.sf3 = *(const f32x4*)(ROW(p, k0, 32 + sr) + 4); } while (0)
#define SWRITE_KF(bf) do { *(bf16x8*)(K_lds + (bf) * SHM_K + kws) = pack8(S.sf0, S.sf1); *(bf16x8*)(K_lds + (bf) * SHM_K + kws + 32 * 256) = pack8(S.sf2, S.sf3); } while (0)
#define SWRITE_VF(bf) do { *(bf16x8*)(V_lds + (bf) * SHM_V + vst0) = pack8(S.sf0, S.sf1); *(bf16x8*)(V_lds + (bf) * SHM_V + vst1) = pack8(S.sf2, S.sf3); } while (0)
template <class TIn, class TOut>
__device__ __forceinline__ void causal_swa_prime(const BlockRef<TIn, TOut>& cur, int W, char* lds, Seam<TIn>& S) {
    constexpr bool F32 = same_t<TIn, float>::v;
    const int tid = ltid(), wid = __builtin_amdgcn_readfirstlane(tid >> 6), lane = tid & 63, r32 = lane & 31, hi = lane >> 5;
    const int sr = tid >> 4, sc = (tid & 15) * 8, kws = KSWZ(sr, sc * 2); char* K_lds = lds + 2 * SHM_V;
    const int kb0 = swa_jlo(cur.P0, W) * KVBLK;
    for (int d0 = 0; d0 < 8; ++d0) S.qr[d0] = load8<TIn>(cur.Q + (size_t)(wid * QBLK + r32) * LDQ + d0 * 16 + hi * 8);
    if constexpr (F32) { SLOAD_F((const float*)cur.K, kb0); VMW(); SWRITE_KF(0); SBAR(); SLOAD_F((const float*)cur.V, kb0); }
    else { SLOAD_H(cur.K, cur.V, kb0); VMW(); SWRITE_HK(0); }
    __syncthreads();
}
template <class TIn, class TOut>
__device__ __forceinline__ void causal_swa_block(const BlockRef<TIn, TOut>& cur, const BlockRef<TIn, TOut>& nxt, int skv, int W, char* lds, Seam<TIn>& S, const float* bias_l) {
    constexpr bool F32 = same_t<TIn, float>::v;
    const int tid = ltid(), wid = __builtin_amdgcn_readfirstlane(tid >> 6), lane = tid & 63, r32 = lane & 31, hi = lane >> 5;
    const int j_lo = swa_jlo(cur.P0, W);
    int j_hi = (cur.P0 + QB - 1) / KVBLK + 1; if (j_hi > skv / KVBLK) j_hi = skv / KVBLK;
    const int NT = j_hi - j_lo;
    const int kbn = swa_jlo(nxt.P0, W) * KVBLK;
    const int qlo = cur.P0 + wid * QBLK, qm = qlo + r32 - 4 * hi;
    char* V_lds = lds; char* K_lds = lds + 2 * SHM_V;
    float* ws = (float*)(lds + 2 * SHM_V + 2 * SHM_K) + wid * 64; float* li_l = ws, * al_l = ws + 32;
    float m_reg = -1e30f, l_reg = 0; f32x16 o[4] = {};
    const int sr = tid >> 4, sc = (tid & 15) * 8, vst0 = v_st(sr, sc), vst1 = v_st(32 + sr, sc), kws = KSWZ(sr, sc * 2);
    const int vb0 = (int)(uintptr_t)V_lds + v_rd_base(lane);
    const TIn* Kh = cur.K; const TIn* Vh = cur.V;
#define RESC(a) do { if (__any((a) < 1.f)) { if (hi == 0) al_l[r32] = (a); asm volatile("s_waitcnt lgkmcnt(0)" ::: "memory");              \
                     for (int d_ = 0; d_ < 4; ++d_) for (int r = 0; r < 16; ++r) o[d_][r] *= al_l[crow(r, hi)]; } } while (0)
#define KBASE(t) ((j_lo + (t)) * KVBLK)
#define ACT(t) (KBASE(t) <= qlo + QBLK - 1 && KBASE(t) + KVBLK - 1 >= qlo - W + 1)
#define MASKT(P0_, P1_, t) do { const int kb_ = KBASE(t); if ((!SK || ACT(t)) && (kb_ + KVBLK - 1 > qlo || kb_ <= qlo + QBLK - 1 - W)) mask_tile(P0_, P1_, qm - kb_, (unsigned)W); } while (0)
    constexpr int NQL = F32 ? 16 : 8;
    constexpr bool SK = WSKIP && !F32;
#define SEAM_K0() do { VMWN(NQL); if constexpr (F32) { SWRITE_KF(0); SBAR(); SLOAD_F((const float*)nxt.V, kbn); } else { SWRITE_HK(0); } SBAR(); } while (0)
    f32x16 pA0, pA1, pB0, pB1; float mnA, mnB, alA, alB; bf16x8 pa0, pa1, pa2, pa3;
    if constexpr (F32) { VMW(); SWRITE_VF(0); SBAR(); } else { SWRITE_HV(0); SBAR(); }
    if (NT > 1) { if constexpr (F32) SLOAD_F((const float*)Kh, KBASE(1)); else SLOAD_H(Kh, Vh, KBASE(1)); }
    SBAR(); qkt<0, SK>(pA0, pA1, K_lds, r32, hi, S.qr, ACT(0), bias_l + KBASE(0));
    if constexpr (F32) { if (NT > 1) { VMW(); SWRITE_KF(1); SBAR(); SLOAD_F((const float*)Vh, KBASE(1)); } }
    MASKT(pA0, pA1, 0); partialSM(pA0, pA1, m_reg, mnA, alA);
    if (NT > 1) { VMW(); if constexpr (F32) { SWRITE_VF(1); SBAR(); if (NT > 2) SLOAD_F((const float*)Kh, KBASE(2)); } else SWRITE_H(1); }
    __syncthreads();
#define HALF_STEP(PX0, PX1, mnX, alX, PY0, PY1, alY, t, KB, VB, SB) do {                                                      \
        SBAR(); qkt<KB, SK>(PX0, PX1, K_lds, r32, hi, S.qr, ACT(t), bias_l + KBASE(t));                                             \
        finishSM(PY0, PY1, alY, l_reg, pa0, pa1, pa2, pa3); SBAR();                                                           \
        if ((t) + 1 < NT) { if constexpr (F32) { VMW(); SWRITE_KF(SB); SBAR(); SLOAD_F((const float*)Vh, KBASE((t) + 1)); }  \
                            else { SLOAD_H(Kh, Vh, KBASE((t) + 1)); } SBAR(); }                                               \
        pv_tile<VB, SK>(o, vb0, pa0, pa1, pa2, pa3, ACT((t) - 1)); MASKT(PX0, PX1, (t)); partialSM(PX0, PX1, m_reg, mnX, alX);                                        \
        __syncthreads();                                                                                                      \
        if ((t) + 1 < NT) { VMW(); if constexpr (F32) { SWRITE_VF(SB); SBAR(); if ((t) + 2 < NT) SLOAD_F((const float*)Kh, KBASE((t) + 2)); } \
                            else { SWRITE_H(SB); } }                                                                          \
        RESC(alX); __syncthreads(); } while (0)
    for (int t = 1; t + 1 < NT; t += 2) {
        HALF_STEP(pB0, pB1, mnB, alB, pA0, pA1, alA, t, 1, 0, 0);
        HALF_STEP(pA0, pA1, mnA, alA, pB0, pB1, alB, t + 1, 0, 1, 1);
    }
    const bool even = (NT & 1) == 0;
    if (even) { SBAR(); qkt<1, SK>(pB0, pB1, K_lds, r32, hi, S.qr, ACT(NT - 1), bias_l + KBASE(NT - 1)); SBAR(); }
#define QROW(e) (nxt.Q + (size_t)(wid * QBLK + r32) * LDQ + ((e) >> 1) * 16 + hi * 8 + ((e) & 1) * 4)
    if constexpr (F32) { SLOAD_F((const float*)nxt.K, kbn); SBAR();
#pragma unroll
        for (int e = 0; e < 8; ++e) S.tq[e] = *(const f32x4*)QROW(e); }
    else { SLOAD_H(nxt.K, nxt.V, kbn); SBAR();
#pragma unroll
        for (int d0 = 0; d0 < 8; ++d0) S.qr[d0] = load8<TIn>(nxt.Q + (size_t)(wid * QBLK + r32) * LDQ + d0 * 16 + hi * 8); }
    SBAR();
    finishSM(pA0, pA1, alA, l_reg, pa0, pa1, pa2, pa3); SBAR();
    if constexpr (F32) {
#pragma unroll
        for (int e = 8; e < 16; ++e) S.tq[e] = *(const f32x4*)QROW(e); SBAR(); }
#undef QROW
    pv_tile<0, SK>(o, vb0, pa0, pa1, pa2, pa3, ACT(even ? NT - 2 : NT - 1));
    if (even) { MASKT(pB0, pB1, NT - 1); partialSM(pB0, pB1, m_reg, mnB, alB); __syncthreads(); RESC(alB);
        finishSM(pB0, pB1, alB, l_reg, pa0, pa1, pa2, pa3); SBAR(); pv_tile<1, SK>(o, vb0, pa0, pa1, pa2, pa3, ACT(NT - 1)); }
    SBAR(); SEAM_K0();
    if (hi == 0) li_l[r32] = l_reg; asm volatile("s_waitcnt lgkmcnt(0)" ::: "memory");
    float rli[16];
#pragma unroll
    for (int r = 0; r < 16; ++r) rli[r] = __builtin_amdgcn_rcpf(li_l[crow(r, hi)]);
    TOut* Ow = cur.O + (size_t)(wid * QBLK) * LDO;
#pragma unroll
    for (int r = 0; r < 16; ++r) { const int orow = crow(r, hi);
#pragma unroll
        for (int d0 = 0; d0 < 4; ++d0) { const float v = o[d0][r] * rli[r];
            if constexpr (same_t<TOut, float>::v) { Ow[(size_t)orow * LDO + d0 * 32 + r32] = v; }
            else { const float vn = __shfl_xor(v, 1);
                   if ((r32 & 1) == 0) *(unsigned*)(Ow + (size_t)orow * LDO + d0 * 32 + r32) = cvtpk(v, vn); } } }
    if constexpr (F32) {
#pragma unroll
        for (int d0 = 0; d0 < 8; ++d0) S.qr[d0] = pack8(S.tq[2 * d0], S.tq[2 * d0 + 1]); }
    __syncthreads();
#undef RESC
#undef KBASE
#undef ACT
#undef MASKT
#undef SEAM_K0
#undef HALF_STEP
}
#undef ROW
#undef VMW
#undef VMWN
#undef SLOAD_H
#undef SWRITE_HK
#undef SWRITE_HV
#undef SWRITE_H
#undef SLOAD_F
#undef SWRITE_KF

}

__device__ __forceinline__ void fox_bias(PP P, int l, int b, int h, float* bias, float* scr) {
    using namespace cfg;
    const int tid = ltid(), lane = tid & 63, wave = tid >> 6;
    const float* PS = (const float*)(P->ws + WS_PS); const float bf = P->in[I_BF][l * FNH + h];
    float lf[9]; float loc = 0.f;
#pragma unroll
    for (int i = 0; i < 9; ++i) { const int pos = tid * 9 + i; float v = 0.f;
        if (pos < NMETA + SEQ) { const int row = pos < NMETA ? MMAIN + pos : b * SEQ + pos - NMETA; const float z = PS[(size_t)row * PSW + 288 + h] + bf;
            v = fminf(z, 0.f) - log1pf(__expf(-fabsf(z))); }
        loc += v; lf[i] = loc; }
    float inc = loc;
#pragma unroll
    for (int o = 1; o < 64; o <<= 1) { const float t = __shfl_up(inc, o); if (lane >= o) inc += t; }
    if (lane == 63) scr[wave] = inc;
    __syncthreads();
    float base = inc - loc;
    for (int w = 0; w < wave; ++w) base += scr[w];
    constexpr float INV = 1.0f / fox::SCALE;
#pragma unroll
    for (int i = 0; i < 9; ++i) { const int pos = tid * 9 + i; if (pos < NMETA + SEQ) bias[48 + pos] = -(base + lf[i]) * INV; }
    if (tid < 48) bias[tid] = -__builtin_inff();
    __syncthreads();
}
__device__ __forceinline__ void fox_meta(PP P, int h, const float* bias) {
    using namespace cfg;
    const int lane = ltid() & 63, wave = ltid() >> 6;
    const bf16_t* QKV = (const bf16_t*)(P->ws + WS_QKV); bf16_t* Y = (bf16_t*)(P->ws + WS_Y);
    for (int rep = 0; rep < 2; ++rep) { const int i = wave + 8 * rep;
        float s = -__builtin_inff();
        if (lane <= i) { const bf16_t* q = QKV + (size_t)(48 + i) * QKVW + h * 128; const bf16_t* k = QKV + (size_t)(48 + lane) * QKVW + 1024 + h * 128; float dot = 0.f;
            for (int d = 0; d < 128; ++d) dot += bf2f(q[d]) * bf2f(k[d]);
            s = (dot + bias[48 + lane]) * fox::SCALE; }
        const float m = wave_max(s); const float p = (lane <= i) ? __expf(s - m) : 0.f; const float lsum = wave_sum(p);
        float o0 = 0.f, o1 = 0.f;
        for (int j = 0; j <= i; ++j) { const float pj = __shfl(p, j); const bf16_t* v = QKV + (size_t)(48 + j) * QKVW + 2048 + h * 128; o0 += pj * bf2f(v[lane]); o1 += pj * bf2f(v[64 + lane]); }
        const float il = 1.0f / lsum;
        Y[(size_t)(MMAIN + i) * DM + 1024 + h * 128 + lane] = (bf16_t)(pk_bf16(o0 * il, 0.f) & 0xffffu);
        Y[(size_t)(MMAIN + i) * DM + 1024 + h * 128 + 64 + lane] = (bf16_t)(pk_bf16(o1 * il, 0.f) & 0xffffu); }
}
__device__ __forceinline__ fox::BlockRef<__hip_bfloat16, __hip_bfloat16> fox_mk(int a, int idx, const __hip_bfloat16* Qb, const __hip_bfloat16* Kb, const __hip_bfloat16* Vb, __hip_bfloat16* Ob) {
    const int pr = 4 * (a & 1) + (idx >> 1); const int x = (idx & 1) ? 15 - pr : pr;
    fox::BlockRef<__hip_bfloat16, __hip_bfloat16> r; r.Q = Qb + (size_t)x * 256 * cfg::QKVW; r.K = Kb; r.V = Vb; r.O = Ob + (size_t)x * 256 * cfg::DM; r.P0 = 64 + 256 * x; return r; }
__device__ __forceinline__ void fox_wg(PP P, int l, int a, char* lds) {
    using namespace cfg;
    typedef __hip_bfloat16 bf;
    const int bh = a >> 1, b = bh >> 3, h = bh & 7;
    float* bias = (float*)(lds + fox::BIAS_OFF); float* scr = (float*)(lds + fox::SCAN_OFF);
    fox_bias(P, l, b, h, bias, scr);
    const bf* QKV = (const bf*)(P->ws + WS_QKV); bf* Y = (bf*)(P->ws + WS_Y);
    const bf* Kb = QKV + (size_t)b * SEQP * QKVW + 1024 + h * 128; const bf* Vb = Kb + 1024; const bf* Qb = QKV + ((size_t)b * SEQP + 64) * QKVW + h * 128;
    bf* Ob = Y + (size_t)b * SEQ * DM + 1024 + h * 128;
    constexpr int W = 1 << 30;
    fox::Seam<bf> S;
    fox::BlockRef<bf, bf> cur = fox_mk(a, 0, Qb, Kb, Vb, Ob);
    fox::causal_swa_prime<bf, bf>(cur, W, lds, S);
#pragma unroll 1
    for (int idx = 0; idx < 8; ++idx) {
        const fox::BlockRef<bf, bf> nxt = (idx < 7) ? fox_mk(a, idx + 1, Qb, Kb, Vb, Ob) : cur;
        fox::causal_swa_block<bf, bf>(cur, nxt, SEQP, W, lds, S, bias);
        cur = nxt;
    }
    if (b == 0) fox_meta(P, h, bias);
}

#define WS_PTR(T, off) ((T*)(Q->ws + (off)))
#define SEAM() do { PP Qb_ = launder(P); XcdBarrier b_; b_.bar = (unsigned*)(Qb_->ws + WS_CTL); b_.x = xb_xcc_id(); b_.st = (volatile LAS unsigned*)(lds + LDS_BARW); xcd_barrier(b_); } while (0)
__global__ void __launch_bounds__(512, 2) hymba_fwd(Params Pv) {
    using namespace cfg;
    PP P = (PP)__builtin_amdgcn_kernarg_segment_ptr();
    extern __shared__ __attribute__((aligned(16))) unsigned char lds_raw[];
    LAS unsigned char* lds = (LAS unsigned char*)lds_raw;
    if (threadIdx.x < 4) ((LAS unsigned*)(lds + LDS_BARW))[threadIdx.x] = 0u;
    __syncthreads();
    { PP Q = launder(P); (void)xcd_barrier_post((unsigned*)(Q->ws + WS_CTL), (volatile LAS unsigned*)(lds + LDS_BARW)); }

    { PP Q = launder(P); phase_convert(Q, lds, 0, 1, lbid(), (int)gridDim.x); phase_init(Q); }
    SEAM();
    {
        PP Q = launder(P); const unsigned char* wl = Q->ws + WS_W + (size_t)0 * W_LAYER;
        pg8::Gemm g{WS_PTR(const bf16_t, WS_HB), (const bf16_t*)(wl + WO_GU1), MMAIN, NGU, DM}; pg8::StaticOrder S; S.init(MMAIN, NGU, (int)gridDim.x, lbid());
        pg8::EpiGU E{WS_PTR(bf16_t, WS_ACT), WS_PTR(const float, WS_SS) + (size_t)(0) * 8 * MROWS, (LAS float*)(lds + 131072 + 4096)};
        pg8::gemm_phase<pg8::EpiGU, pg8::StaticOrder, true, true>(lds, g, S, E);
        skinny_gu(WS_PTR(const bf16_t, WS_HB), g.Bt, WS_PTR(const float, WS_SSM) + (0) * 2048, WS_PTR(bf16_t, WS_ACT), lds);
    }
    SEAM();
    {
        PP Q = launder(P); const unsigned char* wl = Q->ws + WS_W + (size_t)0 * W_LAYER;
        pg8::Gemm g{WS_PTR(const bf16_t, WS_ACT), (const bf16_t*)(wl + WO_D1), MMAIN, DM, DFF}; pg8::StaticOrder S; S.init(MMAIN, DM, (int)gridDim.x, lbid());
        pg8::EpiRes E{WS_PTR(bf16_t, WS_HB), WS_PTR(float, WS_SS) + (size_t)(1) * 8 * MROWS, 0.5f, (LAS float*)(lds + 131072)};
        pg8::gemm_phase<pg8::EpiRes, pg8::StaticOrder, true, true>(lds, g, S, E);
        skinny_res(WS_PTR(const bf16_t, WS_ACT) + (size_t)MMAIN * DFF, DFF, g.Bt, WS_PTR(bf16_t, WS_HB), WS_PTR(float, WS_SSM) + (1) * 2048, 0.5f, lds);
    }
    SEAM();
    {
        PP Q = launder(P); const unsigned char* wl = Q->ws + WS_W + (size_t)0 * W_LAYER;
        pg8::Gemm g{WS_PTR(const bf16_t, WS_HB), (const bf16_t*)(wl + WO_IN), MMAIN, NIN, DM}; pg8::StaticOrder S; S.init(MMAIN, NIN, (int)gridDim.x, lbid());
        pg8::EpiP E{WS_PTR(bf16_t, WS_PR), WS_PTR(float, WS_PS), WS_PTR(bf16_t, WS_QKV), WS_PTR(const float, WS_SS) + (size_t)(1) * 8 * MROWS, (LAS float*)(lds + 131072 + 4096)};
        pg8::gemm_phase<pg8::EpiP, pg8::StaticOrder, true, true>(lds, g, S, E);
        skinny_p(WS_PTR(const bf16_t, WS_HB), g.Bt, WS_PTR(const float, WS_SSM) + (1) * 2048, WS_PTR(bf16_t, WS_PR), WS_PTR(float, WS_PS), WS_PTR(bf16_t, WS_QKV), lds);
    }
    SEAM();
    { PP Q = launder(P); phase_lx(Q, 0); }
    SEAM();
    {
        PP Q = launder(P); const int u = lbid();
        if (u < 128) { rwkv_chunked(Q, 0, u >> 4, u & 15, lds); __syncthreads(); phase_convert(launder(P), lds, 1, 2, u, 128, 17024, 21248); }
        else { fox_wg(Q, 0, u - 128, (char*)lds_raw); __syncthreads(); phase_convert(launder(P), lds, 1, 2, u - 128, 128, 0, 17024); }
    }
    SEAM();
    { PP Q = launder(P); phase_foxnorm(Q); }
    SEAM();
    {
        PP Q = launder(P); const unsigned char* wl = Q->ws + WS_W + (size_t)0 * W_LAYER;
        pg8::Gemm g{WS_PTR(const bf16_t, WS_Y), (const bf16_t*)(wl + WO_OUT), MMAIN, DM, DM}; pg8::StaticOrder S; S.init(MMAIN, DM, (int)gridDim.x, lbid());
        pg8::EpiRes E{WS_PTR(bf16_t, WS_HB), WS_PTR(float, WS_SS) + (size_t)(2) * 8 * MROWS, 1.0f, (LAS float*)(lds + 131072)};
        pg8::gemm_phase<pg8::EpiRes, pg8::StaticOrder, true, true>(lds, g, S, E);
        skinny_res(WS_PTR(const bf16_t, WS_Y) + (size_t)MMAIN * DM, DM, g.Bt, WS_PTR(bf16_t, WS_HB), WS_PTR(float, WS_SSM) + (2) * 2048, 1.0f, lds);
    }
    SEAM();
    {
        PP Q = launder(P); const unsigned char* wl = Q->ws + WS_W + (size_t)0 * W_LAYER;
        pg8::Gemm g{WS_PTR(const bf16_t, WS_HB), (const bf16_t*)(wl + WO_GU2), MMAIN, NGU, DM}; pg8::StaticOrder S; S.init(MMAIN, NGU, (int)gridDim.x, lbid());
        pg8::EpiGU E{WS_PTR(bf16_t, WS_ACT), WS_PTR(const float, WS_SS) + (size_t)(2) * 8 * MROWS, (LAS float*)(lds + 131072 + 4096)};
        pg8::gemm_phase<pg8::EpiGU, pg8::StaticOrder, true, true>(lds, g, S, E);
        skinny_gu(WS_PTR(const bf16_t, WS_HB), g.Bt, WS_PTR(const float, WS_SSM) + (2) * 2048, WS_PTR(bf16_t, WS_ACT), lds);
    }
    SEAM();
    {
        PP Q = launder(P); const unsigned char* wl = Q->ws + WS_W + (size_t)0 * W_LAYER;
        pg8::Gemm g{WS_PTR(const bf16_t, WS_ACT), (const bf16_t*)(wl + WO_D2), MMAIN, DM, DFF}; pg8::StaticOrder S; S.init(MMAIN, DM, (int)gridDim.x, lbid());
        pg8::EpiRes E{WS_PTR(bf16_t, WS_HB), WS_PTR(float, WS_SS) + (size_t)(3) * 8 * MROWS, 0.5f, (LAS float*)(lds + 131072)};
        pg8::gemm_phase<pg8::EpiRes, pg8::StaticOrder, true, true>(lds, g, S, E);
        skinny_res(WS_PTR(const bf16_t, WS_ACT) + (size_t)MMAIN * DFF, DFF, g.Bt, WS_PTR(bf16_t, WS_HB), WS_PTR(float, WS_SSM) + (3) * 2048, 0.5f, lds);
    }
    SEAM();
    {
        PP Q = launder(P); const unsigned char* wl = Q->ws + WS_W + (size_t)1 * W_LAYER;
        pg8::Gemm g{WS_PTR(const bf16_t, WS_HB), (const bf16_t*)(wl + WO_GU1), MMAIN, NGU, DM}; pg8::StaticOrder S; S.init(MMAIN, NGU, (int)gridDim.x, lbid());
        pg8::EpiGU E{WS_PTR(bf16_t, WS_ACT), WS_PTR(const float, WS_SS) + (size_t)(3) * 8 * MROWS, (LAS float*)(lds + 131072 + 4096)};
        pg8::gemm_phase<pg8::EpiGU, pg8::StaticOrder, true, true>(lds, g, S, E);
        skinny_gu(WS_PTR(const bf16_t, WS_HB), g.Bt, WS_PTR(const float, WS_SSM) + (3) * 2048, WS_PTR(bf16_t, WS_ACT), lds);
    }
    SEAM();
    {
        PP Q = launder(P); const unsigned char* wl = Q->ws + WS_W + (size_t)1 * W_LAYER;
        pg8::Gemm g{WS_PTR(const bf16_t, WS_ACT), (const bf16_t*)(wl + WO_D1), MMAIN, DM, DFF}; pg8::StaticOrder S; S.init(MMAIN, DM, (int)gridDim.x, lbid());
        pg8::EpiRes E{WS_PTR(bf16_t, WS_HB), WS_PTR(float, WS_SS) + (size_t)(4) * 8 * MROWS, 0.5f, (LAS float*)(lds + 131072)};
        pg8::gemm_phase<pg8::EpiRes, pg8::StaticOrder, true, true>(lds, g, S, E);
        skinny_res(WS_PTR(const bf16_t, WS_ACT) + (size_t)MMAIN * DFF, DFF, g.Bt, WS_PTR(bf16_t, WS_HB), WS_PTR(float, WS_SSM) + (4) * 2048, 0.5f, lds);
    }
    SEAM();
    {
        PP Q = launder(P); const unsigned char* wl = Q->ws + WS_W + (size_t)1 * W_LAYER;
        pg8::Gemm g{WS_PTR(const bf16_t, WS_HB), (const bf16_t*)(wl + WO_IN), MMAIN, NIN, DM}; pg8::StaticOrder S; S.init(MMAIN, NIN, (int)gridDim.x, lbid());
        pg8::EpiP E{WS_PTR(bf16_t, WS_PR), WS_PTR(float, WS_PS), WS_PTR(bf16_t, WS_QKV), WS_PTR(const float, WS_SS) + (size_t)(4) * 8 * MROWS, (LAS float*)(lds + 131072 + 4096)};
        pg8::gemm_phase<pg8::EpiP, pg8::StaticOrder, true, true>(lds, g, S, E);
        skinny_p(WS_PTR(const bf16_t, WS_HB), g.Bt, WS_PTR(const float, WS_SSM) + (4) * 2048, WS_PTR(bf16_t, WS_PR), WS_PTR(float, WS_PS), WS_PTR(bf16_t, WS_QKV), lds);
    }
    SEAM();
    { PP Q = launder(P); phase_lx(Q, 1); }
    SEAM();
    {
        PP Q = launder(P); const int u = lbid();
        if (u < 128) { rwkv_chunked(Q, 1, u >> 4, u & 15, lds); __syncthreads(); phase_convert(launder(P), lds, 2, 3, u, 128, 17024, 21248); }
        else { fox_wg(Q, 1, u - 128, (char*)lds_raw); __syncthreads(); phase_convert(launder(P), lds, 2, 3, u - 128, 128, 0, 17024); }
    }
    SEAM();
    { PP Q = launder(P); phase_foxnorm(Q); }
    SEAM();
    {
        PP Q = launder(P); const unsigned char* wl = Q->ws + WS_W + (size_t)1 * W_LAYER;
        pg8::Gemm g{WS_PTR(const bf16_t, WS_Y), (const bf16_t*)(wl + WO_OUT), MMAIN, DM, DM}; pg8::StaticOrder S; S.init(MMAIN, DM, (int)gridDim.x, lbid());
        pg8::EpiRes E{WS_PTR(bf16_t, WS_HB), WS_PTR(float, WS_SS) + (size_t)(5) * 8 * MROWS, 1.0f, (LAS float*)(lds + 131072)};
        pg8::gemm_phase<pg8::EpiRes, pg8::StaticOrder, true, true>(lds, g, S, E);
        skinny_res(WS_PTR(const bf16_t, WS_Y) + (size_t)MMAIN * DM, DM, g.Bt, WS_PTR(bf16_t, WS_HB), WS_PTR(float, WS_SSM) + (5) * 2048, 1.0f, lds);
    }
    SEAM();
    {
        PP Q = launder(P); const unsigned char* wl = Q->ws + WS_W + (size_t)1 * W_LAYER;
        pg8::Gemm g{WS_PTR(const bf16_t, WS_HB), (const bf16_t*)(wl + WO_GU2), MMAIN, NGU, DM}; pg8::StaticOrder S; S.init(MMAIN, NGU, (int)gridDim.x, lbid());
        pg8::EpiGU E{WS_PTR(bf16_t, WS_ACT), WS_PTR(const float, WS_SS) + (size_t)(5) * 8 * MROWS, (LAS float*)(lds + 131072 + 4096)};
        pg8::gemm_phase<pg8::EpiGU, pg8::StaticOrder, true, true>(lds, g, S, E);
        skinny_gu(WS_PTR(const bf16_t, WS_HB), g.Bt, WS_PTR(const float, WS_SSM) + (5) * 2048, WS_PTR(bf16_t, WS_ACT), lds);
    }
    SEAM();
    {
        PP Q = launder(P); const unsigned char* wl = Q->ws + WS_W + (size_t)1 * W_LAYER;
        pg8::Gemm g{WS_PTR(const bf16_t, WS_ACT), (const bf16_t*)(wl + WO_D2), MMAIN, DM, DFF}; pg8::StaticOrder S; S.init(MMAIN, DM, (int)gridDim.x, lbid());
        pg8::EpiRes E{WS_PTR(bf16_t, WS_HB), WS_PTR(float, WS_SS) + (size_t)(6) * 8 * MROWS, 0.5f, (LAS float*)(lds + 131072)};
        pg8::gemm_phase<pg8::EpiRes, pg8::StaticOrder, true, true>(lds, g, S, E);
        skinny_res(WS_PTR(const bf16_t, WS_ACT) + (size_t)MMAIN * DFF, DFF, g.Bt, WS_PTR(bf16_t, WS_HB), WS_PTR(float, WS_SSM) + (6) * 2048, 0.5f, lds);
    }
    SEAM();
    {
        PP Q = launder(P); const unsigned char* wl = Q->ws + WS_W + (size_t)2 * W_LAYER;
        pg8::Gemm g{WS_PTR(const bf16_t, WS_HB), (const bf16_t*)(wl + WO_GU1), MMAIN, NGU, DM}; pg8::StaticOrder S; S.init(MMAIN, NGU, (int)gridDim.x, lbid());
        pg8::EpiGU E{WS_PTR(bf16_t, WS_ACT), WS_PTR(const float, WS_SS) + (size_t)(6) * 8 * MROWS, (LAS float*)(lds + 131072 + 4096)};
        pg8::gemm_phase<pg8::EpiGU, pg8::StaticOrder, true, true>(lds, g, S, E);
        skinny_gu(WS_PTR(const bf16_t, WS_HB), g.Bt, WS_PTR(const float, WS_SSM) + (6) * 2048, WS_PTR(bf16_t, WS_ACT), lds);
    }
    SEAM();
    {
        PP Q = launder(P); const unsigned char* wl = Q->ws + WS_W + (size_t)2 * W_LAYER;
        pg8::Gemm g{WS_PTR(const bf16_t, WS_ACT), (const bf16_t*)(wl + WO_D1), MMAIN, DM, DFF}; pg8::StaticOrder S; S.init(MMAIN, DM, (int)gridDim.x, lbid());
        pg8::EpiRes E{WS_PTR(bf16_t, WS_HB), WS_PTR(float, WS_SS) + (size_t)(7) * 8 * MROWS, 0.5f, (LAS float*)(lds + 131072)};
        pg8::gemm_phase<pg8::EpiRes, pg8::StaticOrder, true, true>(lds, g, S, E);
        skinny_res(WS_PTR(const bf16_t, WS_ACT) + (size_t)MMAIN * DFF, DFF, g.Bt, WS_PTR(bf16_t, WS_HB), WS_PTR(float, WS_SSM) + (7) * 2048, 0.5f, lds);
    }
    SEAM();
    {
        PP Q = launder(P); const unsigned char* wl = Q->ws + WS_W + (size_t)2 * W_LAYER;
        pg8::Gemm g{WS_PTR(const bf16_t, WS_HB), (const bf16_t*)(wl + WO_IN), MMAIN, NIN, DM}; pg8::StaticOrder S; S.init(MMAIN, NIN, (int)gridDim.x, lbid());
        pg8::EpiP E{WS_PTR(bf16_t, WS_PR), WS_PTR(float, WS_PS), WS_PTR(bf16_t, WS_QKV), WS_PTR(const float, WS_SS) + (size_t)(7) * 8 * MROWS, (LAS float*)(lds + 131072 + 4096)};
        pg8::gemm_phase<pg8::EpiP, pg8::StaticOrder, true, true>(lds, g, S, E);
        skinny_p(WS_PTR(const bf16_t, WS_HB), g.Bt, WS_PTR(const float, WS_SSM) + (7) * 2048, WS_PTR(bf16_t, WS_PR), WS_PTR(float, WS_PS), WS_PTR(bf16_t, WS_QKV), lds);
    }
    SEAM();
    { PP Q = launder(P); phase_lx(Q, 2); }
    SEAM();
    {
        PP Q = launder(P); const int u = lbid();
        if (u < 128) { rwkv_chunked(Q, 2, u >> 4, u & 15, lds); __syncthreads(); phase_convert(launder(P), lds, 3, 4, u, 128, 17024, 21248); }
        else { fox_wg(Q, 2, u - 128, (char*)lds_raw); __syncthreads(); phase_convert(launder(P), lds, 3, 4, u - 128, 128, 0, 17024); }
    }
    SEAM();
    { PP Q = launder(P); phase_foxnorm(Q); }
    SEAM();
    {
        PP Q = launder(P); const unsigned char* wl = Q->ws + WS_W + (size_t)2 * W_LAYER;
        pg8::Gemm g{WS_PTR(const bf16_t, WS_Y), (const bf16_t*)(wl + WO_OUT), MMAIN, DM, DM}; pg8::StaticOrder S; S.init(MMAIN, DM, (int)gridDim.x, lbid());
        pg8::EpiRes E{WS_PTR(bf16_t, WS_HB), WS_PTR(float, WS_SS) + (size_t)(8) * 8 * MROWS, 1.0f, (LAS float*)(lds + 131072)};
        pg8::gemm_phase<pg8::EpiRes, pg8::StaticOrder, true, true>(lds, g, S, E);
        skinny_res(WS_PTR(const bf16_t, WS_Y) + (size_t)MMAIN * DM, DM, g.Bt, WS_PTR(bf16_t, WS_HB), WS_PTR(float, WS_SSM) + (8) * 2048, 1.0f, lds);
    }
    SEAM();
    {
        PP Q = launder(P); const unsigned char* wl = Q->ws + WS_W + (size_t)2 * W_LAYER;
        pg8::Gemm g{WS_PTR(const bf16_t, WS_HB), (const bf16_t*)(wl + WO_GU2), MMAIN, NGU, DM}; pg8::StaticOrder S; S.init(MMAIN, NGU, (int)gridDim.x, lbid());
        pg8::EpiGU E{WS_PTR(bf16_t, WS_ACT), WS_PTR(const float, WS_SS) + (size_t)(8) * 8 * MROWS, (LAS float*)(lds + 131072 + 4096)};
        pg8::gemm_phase<pg8::EpiGU, pg8::StaticOrder, true, true>(lds, g, S, E);
        skinny_gu(WS_PTR(const bf16_t, WS_HB), g.Bt, WS_PTR(const float, WS_SSM) + (8) * 2048, WS_PTR(bf16_t, WS_ACT), lds);
    }
    SEAM();
    {
        PP Q = launder(P); const unsigned char* wl = Q->ws + WS_W + (size_t)2 * W_LAYER;
        pg8::Gemm g{WS_PTR(const bf16_t, WS_ACT), (const bf16_t*)(wl + WO_D2), MMAIN, DM, DFF}; pg8::StaticOrder S; S.init(MMAIN, DM, (int)gridDim.x, lbid());
        pg8::EpiRes E{WS_PTR(bf16_t, WS_HB), WS_PTR(float, WS_SS) + (size_t)(9) * 8 * MROWS, 0.5f, (LAS float*)(lds + 131072)};
        pg8::gemm_phase<pg8::EpiRes, pg8::StaticOrder, true, true>(lds, g, S, E);
        skinny_res(WS_PTR(const bf16_t, WS_ACT) + (size_t)MMAIN * DFF, DFF, g.Bt, WS_PTR(bf16_t, WS_HB), WS_PTR(float, WS_SSM) + (9) * 2048, 0.5f, lds);
    }
    SEAM();
    {
        PP Q = launder(P); const unsigned char* wl = Q->ws + WS_W + (size_t)3 * W_LAYER;
        pg8::Gemm g{WS_PTR(const bf16_t, WS_HB), (const bf16_t*)(wl + WO_GU1), MMAIN, NGU, DM}; pg8::StaticOrder S; S.init(MMAIN, NGU, (int)gridDim.x, lbid());
        pg8::EpiGU E{WS_PTR(bf16_t, WS_ACT), WS_PTR(const float, WS_SS) + (size_t)(9) * 8 * MROWS, (LAS float*)(lds + 131072 + 4096)};
        pg8::gemm_phase<pg8::EpiGU, pg8::StaticOrder, true, true>(lds, g, S, E);
        skinny_gu(WS_PTR(const bf16_t, WS_HB), g.Bt, WS_PTR(const float, WS_SSM) + (9) * 2048, WS_PTR(bf16_t, WS_ACT), lds);
    }
    SEAM();
    {
        PP Q = launder(P); const unsigned char* wl = Q->ws + WS_W + (size_t)3 * W_LAYER;
        pg8::Gemm g{WS_PTR(const bf16_t, WS_ACT), (const bf16_t*)(wl + WO_D1), MMAIN, DM, DFF}; pg8::StaticOrder S; S.init(MMAIN, DM, (int)gridDim.x, lbid());
        pg8::EpiRes E{WS_PTR(bf16_t, WS_HB), WS_PTR(float, WS_SS) + (size_t)(10) * 8 * MROWS, 0.5f, (LAS float*)(lds + 131072)};
        pg8::gemm_phase<pg8::EpiRes, pg8::StaticOrder, true, true>(lds, g, S, E);
        skinny_res(WS_PTR(const bf16_t, WS_ACT) + (size_t)MMAIN * DFF, DFF, g.Bt, WS_PTR(bf16_t, WS_HB), WS_PTR(float, WS_SSM) + (10) * 2048, 0.5f, lds);
    }
    SEAM();
    {
        PP Q = launder(P); const unsigned char* wl = Q->ws + WS_W + (size_t)3 * W_LAYER;
        pg8::Gemm g{WS_PTR(const bf16_t, WS_HB), (const bf16_t*)(wl + WO_IN), MMAIN, NIN, DM}; pg8::StaticOrder S; S.init(MMAIN, NIN, (int)gridDim.x, lbid());
        pg8::EpiP E{WS_PTR(bf16_t, WS_PR), WS_PTR(float, WS_PS), WS_PTR(bf16_t, WS_QKV), WS_PTR(const float, WS_SS) + (size_t)(10) * 8 * MROWS, (LAS float*)(lds + 131072 + 4096)};
        pg8::gemm_phase<pg8::EpiP, pg8::StaticOrder, true, true>(lds, g, S, E);
        skinny_p(WS_PTR(const bf16_t, WS_HB), g.Bt, WS_PTR(const float, WS_SSM) + (10) * 2048, WS_PTR(bf16_t, WS_PR), WS_PTR(float, WS_PS), WS_PTR(bf16_t, WS_QKV), lds);
    }
    SEAM();
    { PP Q = launder(P); phase_lx(Q, 3); }
    SEAM();
    {
        PP Q = launder(P); const int u = lbid();
        if (u < 128) { rwkv_chunked(Q, 3, u >> 4, u & 15, lds); }
        else { fox_wg(Q, 3, u - 128, (char*)lds_raw);  }
    }
    SEAM();
    { PP Q = launder(P); phase_foxnorm(Q); }
    SEAM();
    {
        PP Q = launder(P); const unsigned char* wl = Q->ws + WS_W + (size_t)3 * W_LAYER;
        pg8::Gemm g{WS_PTR(const bf16_t, WS_Y), (const bf16_t*)(wl + WO_OUT), MMAIN, DM, DM}; pg8::StaticOrder S; S.init(MMAIN, DM, (int)gridDim.x, lbid());
        pg8::EpiRes E{WS_PTR(bf16_t, WS_HB), WS_PTR(float, WS_SS) + (size_t)(11) * 8 * MROWS, 1.0f, (LAS float*)(lds + 131072)};
        pg8::gemm_phase<pg8::EpiRes, pg8::StaticOrder, true, true>(lds, g, S, E);
        skinny_res(WS_PTR(const bf16_t, WS_Y) + (size_t)MMAIN * DM, DM, g.Bt, WS_PTR(bf16_t, WS_HB), WS_PTR(float, WS_SSM) + (11) * 2048, 1.0f, lds);
    }
    SEAM();
    {
        PP Q = launder(P); const unsigned char* wl = Q->ws + WS_W + (size_t)3 * W_LAYER;
        pg8::Gemm g{WS_PTR(const bf16_t, WS_HB), (const bf16_t*)(wl + WO_GU2), MMAIN, NGU, DM}; pg8::StaticOrder S; S.init(MMAIN, NGU, (int)gridDim.x, lbid());
        pg8::EpiGU E{WS_PTR(bf16_t, WS_ACT), WS_PTR(const float, WS_SS) + (size_t)(11) * 8 * MROWS, (LAS float*)(lds + 131072 + 4096)};
        pg8::gemm_phase<pg8::EpiGU, pg8::StaticOrder, true, true>(lds, g, S, E);
        skinny_gu(WS_PTR(const bf16_t, WS_HB), g.Bt, WS_PTR(const float, WS_SSM) + (11) * 2048, WS_PTR(bf16_t, WS_ACT), lds);
    }
    SEAM();
    {
        PP Q = launder(P); const unsigned char* wl = Q->ws + WS_W + (size_t)3 * W_LAYER;
        pg8::Gemm g{WS_PTR(const bf16_t, WS_ACT), (const bf16_t*)(wl + WO_D2), MMAIN, DM, DFF}; pg8::StaticOrder S; S.init(MMAIN, DM, (int)gridDim.x, lbid());
        pg8::EpiRes E{WS_PTR(bf16_t, WS_HB), WS_PTR(float, WS_SS) + (size_t)(12) * 8 * MROWS, 0.5f, (LAS float*)(lds + 131072)};
        pg8::gemm_phase<pg8::EpiRes, pg8::StaticOrder, true, true>(lds, g, S, E);
        skinny_res(WS_PTR(const bf16_t, WS_ACT) + (size_t)MMAIN * DFF, DFF, g.Bt, WS_PTR(bf16_t, WS_HB), WS_PTR(float, WS_SSM) + (12) * 2048, 0.5f, lds);
    }
    SEAM();
    { PP Q = launder(P); phase_final(Q); }
}

extern "C" void kernel_launch(void* const* d_in, const int* in_sizes, int n_in, void* d_out, int out_size, void* d_ws, size_t ws_size, hipStream_t stream) {
    using namespace cfg;
    static int grid = 0;
    if (grid == 0) {
        if (n_in != 25 || out_size != MMAIN * DM || ws_size < WS_END) { fprintf(stderr, "kernel_launch: need 25 inputs, out %d, ws >= %zu; got n_in %d out %d ws %zu\n", MMAIN * DM, (size_t)WS_END, n_in, out_size, ws_size); grid = -1; return; }
        int dev = 0, cus = 0, per_cu = 0;
        if (hipGetDevice(&dev) != hipSuccess || hipDeviceGetAttribute(&cus, hipDeviceAttributeMultiprocessorCount, dev) != hipSuccess) { grid = -1; return; }
        if (hipFuncSetAttribute((const void*)hymba_fwd, hipFuncAttributeMaxDynamicSharedMemorySize, LDS_BYTES) != hipSuccess) { fprintf(stderr, "kernel_launch: hipFuncSetAttribute failed\n"); grid = -1; return; }
        if (hipOccupancyMaxActiveBlocksPerMultiprocessor(&per_cu, (const void*)hymba_fwd, 512, LDS_BYTES) != hipSuccess || per_cu < 1) fprintf(stderr, "kernel_launch: occupancy query says %d\n", per_cu);
        (void)hipGetLastError();
        if (cus < 256) { fprintf(stderr, "kernel_launch: built for a 256-CU device (one resident workgroup per CU), found %d CUs\n", cus); grid = -1; return; }
        grid = 256;
    }
    if (grid < 0) return;
    if (hipMemsetAsync((char*)d_ws + WS_CTL, 0, CTL_BYTES, stream) != hipSuccess) return;
    Params p{};
    for (int i = 0; i < 25; ++i) p.in[i] = (const float*)d_in[i];
    p.out = (float*)d_out; p.ws = (unsigned char*)d_ws; p.ph_lo = 0; p.ph_hi = 0;
    hipLaunchKernelGGL(hymba_fwd, dim3(grid), dim3(512), LDS_BYTES, stream, p);
}
```

```cpp
#include <hip/hip_runtime.h>
#include <hip/hip_bf16.h>
#include <cstdio>
#include <cstdint>

#define LAS __attribute__((address_space(3)))
namespace cfg {
constexpr int DM = 2048, NBATCH = 8, SEQ = 4096, NMETA = 16, DEPTH = 4;
constexpr int MMAIN = NBATCH * SEQ;
constexpr int MROWS = MMAIN + 256;
constexpr int DFF = 5632, NGU = 2 * DFF;
constexpr int RW = 1024, RH = 64, RNH = 16;
constexpr int FW = 1024, FH = 128, FNH = 8;
constexpr int RWKV_COLS = 3360, DIN = 6440;
constexpr int NIN = 6656;
constexpr int PRW = 3072, PSW = 512, QKVW = 3072;
constexpr int SEQP = 4160;
constexpr float NORM_EPS = 1e-6f, LNX_EPS = 64e-5f;
constexpr int NSS = 13;
constexpr size_t al256(size_t x) { return (x + 255) & ~(size_t)255; }
constexpr size_t WS_CTL = 0;
constexpr size_t CTL_BYTES = 65536;
constexpr size_t WS_SS = WS_CTL + CTL_BYTES;
constexpr size_t SS_BYTES = al256((size_t)NSS * 8 * MROWS * 4);
constexpr size_t ZERO_BYTES = CTL_BYTES + SS_BYTES;
constexpr size_t WS_SSM = WS_SS + SS_BYTES;
constexpr size_t SSM_BYTES = (size_t)NSS * 2048 * 4;
constexpr size_t WS_HMETA = WS_SSM + SSM_BYTES;
constexpr size_t WS_HB = WS_HMETA + (size_t)256 * DM * 4;
constexpr size_t WS_Y = WS_HB + (size_t)MROWS * DM * 2;
constexpr size_t WS_OVL = WS_Y + (size_t)MROWS * DM * 2;
constexpr size_t WS_ACT = WS_OVL;
constexpr size_t WS_PR = WS_OVL;
constexpr size_t WS_PS = WS_PR + (size_t)MROWS * PRW * 2;
constexpr size_t WS_QKV = WS_PS + (size_t)MROWS * PSW * 4;
constexpr size_t OVL_A = (size_t)MROWS * DFF * 2, OVL_B = (size_t)MROWS * PRW * 2 + (size_t)MROWS * PSW * 4 + (size_t)NBATCH * SEQP * QKVW * 2;
constexpr size_t WS_W = WS_OVL + al256(OVL_A > OVL_B ? OVL_A : OVL_B);
constexpr size_t W_GU = (size_t)NGU * DM * 2, W_D = (size_t)DM * DFF * 2, W_IN = (size_t)NIN * DM * 2, W_OUT = (size_t)DM * DM * 2;
constexpr size_t WO_GU1 = 0, WO_D1 = WO_GU1 + W_GU, WO_IN = WO_D1 + W_D, WO_OUT = WO_IN + W_IN, WO_GU2 = WO_OUT + W_OUT, WO_D2 = WO_GU2 + W_GU, W_LAYER = WO_D2 + W_D;
constexpr size_t WS_LXG = WS_W + (size_t)DEPTH * W_LAYER;
constexpr size_t WS_END = WS_LXG + (size_t)MROWS * 320 * 2;
constexpr int LDS_BYTES = 147456;
constexpr int LDS_BARW = LDS_BYTES - 16;
}
__device__ __forceinline__ int ltid() { int t = (int)threadIdx.x; asm volatile("" : "+v"(t)); return t; }
__device__ __forceinline__ int lbid() { int t = (int)blockIdx.x; asm volatile("" : "+s"(t)); return t; }
__device__ __forceinline__ int lzero() { int t = 0; asm volatile("" : "+v"(t)); return t; }
namespace pg8 {
#define PG8_LAS __attribute__((address_space(3)))
typedef unsigned short bf16_t;
typedef short bf16x8 __attribute__((ext_vector_type(8)));
typedef float f32x4 __attribute__((ext_vector_type(4)));
typedef unsigned u32x4 __attribute__((ext_vector_type(4)));
constexpr int BM = 256, BK = 64, HALF = 128, HTB = HALF * BK * 2  , STAGE_BYTES = 8 * HTB, NXCD = 8, WGM = 8;

__host__ __device__ __forceinline__ int lds_byte(int r, int c) { const int st = (r >> 4) * 2 + (c >> 5), rr = r & 15, cc = c & 31, ob = rr * 64 + cc * 2; return st * 1024 + (ob ^ (((ob >> 9) & 1) << 5)); }
__host__ __device__ __forceinline__ void stage_rc(int b, int& R, int& C) { const int st = b / 1024, sb = b % 1024, swz = sb ^ (((sb >> 9) & 1) << 5); R = (st >> 1) * 16 + swz / 64; C = (st & 1) * 32 + (swz % 64) / 2; }
__host__ __device__ __forceinline__ int perm32(int rho) { const int n = rho >> 4, i = rho & 15; return 8 * (i >> 2) + 4 * n + (i & 3); }

struct Unit { int pm, pn; };
struct Gemm { const bf16_t* A; const bf16_t* Bt; int M, N, K; };

struct StaticOrder {
    int nM, nN, nwg, G, c;
    __host__ __device__ void init(int M, int N, int G_, int c_) { nM = M / BM; nN = N / BM; nwg = nM * nN; G = G_; c = c_; }
    __host__ __device__ bool next(int i, Unit& u) const {
        const long L = (long)i * G + c; if (L >= nwg) return false;
        int wgid = (int)L; { const int q = nwg / NXCD, r = nwg % NXCD, xcd = wgid % NXCD, off = wgid / NXCD; wgid = (xcd < r ? xcd * (q + 1) : r * (q + 1) + (xcd - r) * q) + off; }
        const int nig = WGM * nN, gid = wgid / nig, fm = gid * WGM, gsz = (nM - fm) < WGM ? (nM - fm) : WGM;
        u.pm = fm + ((wgid % nig) % gsz); u.pn = (wgid % nig) / gsz; return true;
    }
    __device__ __forceinline__ void a_ready(const Unit&) const {}
    __device__ __forceinline__ void done(const Unit&) const {}
};

__device__ __forceinline__ unsigned cvt_pk_bf16(float lo, float hi) { unsigned r; asm volatile("v_cvt_pk_bf16_f32 %0, %1, %2" : "=v"(r) : "v"(lo), "v"(hi)); return r; }
typedef float f32x2 __attribute__((ext_vector_type(2)));
__device__ __forceinline__ f32x2 gelu_pk(f32x2 v) {
    const f32x2 av = __builtin_elementwise_abs(v), d = av * 0.2316418882f + 1.0f;
    f32x2 t; t.x = __builtin_amdgcn_rcpf(d.x); t.y = __builtin_amdgcn_rcpf(d.y);
    f32x2 q = t * 0.5307027145f + (-0.7265760135f); q = q * t + 0.7107068705f; q = q * t + (-0.142248368f); q = q * t + 0.127414796f; q = q * t;
    const f32x2 s = (v * v) * (-0.72134752044f);
    f32x2 e; e.x = __builtin_amdgcn_exp2f(s.x); e.y = __builtin_amdgcn_exp2f(s.y);
    const f32x2 m = v * (q * e), r = v - m;
    f32x2 o; o.x = v.x < 0.f ? m.x : r.x; o.y = v.y < 0.f ? m.y : r.y; return o;
}
__device__ __forceinline__ float rs_of(const float* ss, int row) { float s = 0.f;
#pragma unroll
    for (int t = 0; t < 8; ++t) s += ss[(size_t)t * 33024 + row];
    return __builtin_amdgcn_rsqf(s * (1.0f / 2048.0f) + 1e-6f); }
__device__ __forceinline__ float silu_f(float x) { return x * __builtin_amdgcn_rcpf(1.0f + __builtin_amdgcn_exp2f(-1.4426950408889634f * x)); }

struct EpiGU {
    static constexpr bool PERM = true, AFTER_DRAIN = false;
    bf16_t* act; const float* ss; PG8_LAS float* rsb;
    __device__ __forceinline__ void operator()(const f32x4 (&acc)[2][2][4][2], const Unit& u, int wr, int wc, int fr, int fq) const {
        if (wr == 0) { const int rl = wc * 64 + fq * 16 + fr; rsb[rl] = rs_of(ss, u.pm * BM + rl); }
        asm volatile("s_waitcnt lgkmcnt(0)" ::: "memory"); __builtin_amdgcn_s_barrier(); asm volatile("" ::: "memory");
        const int rl0 = wr * 64 + fr, row0 = u.pm * BM + rl0, col0 = u.pn * 128 + wc * 32 + 8 * fq;
#pragma unroll
        for (int ai = 0; ai < 2; ++ai)
#pragma unroll
            for (int m = 0; m < 4; ++m) { const int row = row0 + ai * HALF + m * 16; const float rs = rsb[rl0 + ai * HALF + m * 16];
                const f32x4 g0 = acc[ai][0][m][0] * rs, g1 = acc[ai][0][m][1] * rs, u0 = acc[ai][1][m][0] * rs, u1 = acc[ai][1][m][1] * rs;
                u32x4 w;
                w.x = cvt_pk_bf16(silu_f(g0[0]) * u0[0], silu_f(g0[1]) * u0[1]); w.y = cvt_pk_bf16(silu_f(g0[2]) * u0[2], silu_f(g0[3]) * u0[3]);
                w.z = cvt_pk_bf16(silu_f(g1[0]) * u1[0], silu_f(g1[1]) * u1[1]); w.w = cvt_pk_bf16(silu_f(g1[2]) * u1[2], silu_f(g1[3]) * u1[3]);
                *(u32x4*)(act + (size_t)row * 5632 + col0) = w; }
        asm volatile("s_waitcnt lgkmcnt(0)" ::: "memory"); __builtin_amdgcn_s_barrier(); asm volatile("" ::: "memory");
    }
};
struct EpiRes {
    static constexpr bool PERM = true, AFTER_DRAIN = false;
    bf16_t* hb; float* ssn; float alpha; PG8_LAS float* red;
    __device__ __forceinline__ void operator()(const f32x4 (&acc)[2][2][4][2], const Unit& u, int wr, int wc, int fr, int fq) const {
        bf16_t* bbase = hb + (size_t)u.pm * BM * 2048;
        const int rl0 = wr * 64 + fr; unsigned off = (unsigned)(rl0 * 2048 + u.pn * BM + wc * 32 + 8 * fq);
#pragma unroll
        for (int ai = 0; ai < 2; ++ai) {
            u32x4 hv[4][2];
#pragma unroll
            for (int m = 0; m < 4; ++m)
#pragma unroll
                for (int bj = 0; bj < 2; ++bj) hv[m][bj] = *(const u32x4*)(bbase + (off + (unsigned)((ai * HALF + m * 16) * 2048) + bj * HALF));
#pragma unroll
            for (int m = 0; m < 4; ++m) { const unsigned o = off + (unsigned)((ai * HALF + m * 16) * 2048); float sq = 0.f;
#pragma unroll
                for (int bj = 0; bj < 2; ++bj) { const u32x4 x = hv[m][bj];
                    const f32x4 h0 = (f32x4){__uint_as_float(x.x << 16), __uint_as_float(x.x & 0xffff0000u), __uint_as_float(x.y << 16), __uint_as_float(x.y & 0xffff0000u)} + acc[ai][bj][m][0] * alpha;
                    const f32x4 h1 = (f32x4){__uint_as_float(x.z << 16), __uint_as_float(x.z & 0xffff0000u), __uint_as_float(x.w << 16), __uint_as_float(x.w & 0xffff0000u)} + acc[ai][bj][m][1] * alpha;
                    sq += ((h0[0] * h0[0] + h0[1] * h0[1]) + (h0[2] * h0[2] + h0[3] * h0[3])) + ((h1[0] * h1[0] + h1[1] * h1[1]) + (h1[2] * h1[2] + h1[3] * h1[3]));
                    u32x4 w; w.x = cvt_pk_bf16(h0[0], h0[1]); w.y = cvt_pk_bf16(h0[2], h0[3]); w.z = cvt_pk_bf16(h1[0], h1[1]); w.w = cvt_pk_bf16(h1[2], h1[3]); *(u32x4*)(bbase + o + bj * HALF) = w; }
                sq += __shfl_xor(sq, 16); sq += __shfl_xor(sq, 32);
                if (fq == 0) red[(rl0 + ai * HALF + m * 16) * 4 + wc] = sq; }
            asm volatile("" ::: "memory"); }
        asm volatile("s_waitcnt lgkmcnt(0)" ::: "memory"); __builtin_amdgcn_s_barrier(); asm volatile("" ::: "memory");
        if (wr == 0) { const int row = wc * 64 + fq * 16 + fr; const float s4 = (red[row * 4] + red[row * 4 + 1]) + (red[row * 4 + 2] + red[row * 4 + 3]); ssn[(size_t)u.pn * 33024 + u.pm * BM + row] = s4; }
    }
};
struct EpiP {
    static constexpr bool PERM = true, AFTER_DRAIN = false;
    bf16_t* pr; float* ps; bf16_t* qkv; const float* ss; PG8_LAS float* rsb;
    __device__ __forceinline__ void operator()(const f32x4 (&acc)[2][2][4][2], const Unit& u, int wr, int wc, int fr, int fq) const {
        if (wr == 0) { const int rl = wc * 64 + fq * 16 + fr; rsb[rl] = rs_of(ss, u.pm * BM + rl); }
        asm volatile("s_waitcnt lgkmcnt(0)" ::: "memory"); __builtin_amdgcn_s_barrier(); asm volatile("" ::: "memory");
        const int rl0 = wr * 64 + fr, row0 = u.pm * BM + rl0, cl = wc * 32 + 8 * fq;
#pragma unroll
        for (int ai = 0; ai < 2; ++ai)
#pragma unroll
            for (int m = 0; m < 4; ++m) { const int row = row0 + ai * HALF + m * 16; const float rs = rsb[rl0 + ai * HALF + m * 16];
#pragma unroll
                for (int bj = 0; bj < 2; ++bj) { const f32x4 v0 = acc[ai][bj][m][0] * rs, v1 = acc[ai][bj][m][1] * rs;
                    if (u.pn >= 12 && u.pn < 14) { float* d = ps + (size_t)row * 512 + (u.pn - 12) * 256 + bj * HALF + cl; *(f32x4*)d = v0; *(f32x4*)(d + 4) = v1; }
                    else { u32x4 w; w.x = cvt_pk_bf16(v0[0], v0[1]); w.y = cvt_pk_bf16(v0[2], v0[3]); w.z = cvt_pk_bf16(v1[0], v1[1]); w.w = cvt_pk_bf16(v1[2], v1[3]);
                        if (u.pn < 12) *(u32x4*)(pr + (size_t)row * 3072 + u.pn * 256 + bj * HALF + cl) = w;
                        else { const int c = (u.pn - 14) * 256 + bj * HALF + cl;
                            const int b = row >> 12, s = row & 4095; *(u32x4*)(qkv + ((size_t)b * 4160 + 64 + s) * 3072 + c) = w; } } } }
        asm volatile("s_waitcnt lgkmcnt(0)" ::: "memory"); __builtin_amdgcn_s_barrier(); asm volatile("" ::: "memory");
    }
};
template <class Epi, class Sched, bool ALIGN_EPI = false, bool SP2 = false>
__device__ __forceinline__ void gemm_phase(PG8_LAS unsigned char* lds, const Gemm g, const Sched& S, const Epi& E) {
    const int tid = ltid(), wid = __builtin_amdgcn_readfirstlane(tid >> 6), lane = tid & 63, wr = wid >> 2, wc = wid & 3, fr = lane & 15, fq = lane >> 4;
    const int K = g.K, nt = K / BK;
    unsigned voffA[2], voffB[2];
#pragma unroll
    for (int i = 0; i < 2; ++i) { int R, C; stage_rc(tid * 16 + i * 8192, R, C); const int Rb = Epi::PERM ? ((R & ~31) + perm32(R & 31)) : R;
        voffA[i] = (unsigned)(R * K + C) * 2u; voffB[i] = (unsigned)(Rb * K + C) * 2u; }
    const size_t kstep = (size_t)(BK * 2);
    const size_t hstep = (size_t)HALF * K * 2;
    const size_t tstep = 2 * hstep;
    const unsigned ldsw = (unsigned)wid * 1024u;
    const int aoff = lds_byte(wr * 64 + fr, fq * 8), boff = lds_byte(wc * 32 + fr, fq * 8);
#define PG8_SA(b, h) (((b) * 2 + (h)) * HTB)
#define PG8_SB(b, h) ((4 + (b) * 2 + (h)) * HTB)
#define PG8_STAGE(bufoff, gbase, voff) do { _Pragma("unroll") for (int _i = 0; _i < 2; ++_i) \
        __builtin_amdgcn_global_load_lds((const unsigned*)((const char*)(gbase) + (voff)[_i]), (PG8_LAS unsigned*)(lds + (bufoff) + ldsw + _i * 8192), 16, 0, 0); } while (0)
#define PG8_LDA(dst, b, h) do { _Pragma("unroll") for (int m = 0; m < 4; ++m) _Pragma("unroll") for (int k = 0; k < 2; ++k) dst[m][k] = *(const PG8_LAS bf16x8*)(lds + PG8_SA(b, h) + aoff + m * 2048 + k * 1024); } while (0)
#define PG8_LDB(dst, b, h) do { _Pragma("unroll") for (int n = 0; n < 2; ++n) _Pragma("unroll") for (int k = 0; k < 2; ++k) dst[n][k] = *(const PG8_LAS bf16x8*)(lds + PG8_SB(b, h) + boff + n * 2048 + k * 1024); } while (0)
#define PG8_MMA(ai, bj, At, Bt) do { __builtin_amdgcn_s_setprio(1); _Pragma("unroll") for (int m = 0; m < 4; ++m) _Pragma("unroll") for (int n = 0; n < 2; ++n) _Pragma("unroll") for (int k = 0; k < 2; ++k) \
        acc[ai][bj][m][n] = __builtin_amdgcn_mfma_f32_16x16x32_bf16(Bt[n][k], At[m][k], acc[ai][bj][m][n], 0, 0, 0); __builtin_amdgcn_s_setprio(0); } while (0)
#define PG8_WAIT_V(n) asm volatile("s_waitcnt vmcnt(" #n ")" ::: "memory")
#define PG8_WAIT_L(n) asm volatile("s_waitcnt lgkmcnt(" #n ")" ::: "memory")
#define PG8_BAR __builtin_amdgcn_s_barrier()
#define PG8_SCHED __builtin_amdgcn_sched_barrier(0)
    Unit cur, nxt; int ui = 0;
    if (!S.next(0, cur)) return;
    f32x4 acc[2][2][4][2];
#pragma unroll
    for (int a = 0; a < 2; ++a)
#pragma unroll
        for (int b = 0; b < 2; ++b)
#pragma unroll
            for (int m = 0; m < 4; ++m)
#pragma unroll
                for (int n = 0; n < 2; ++n) acc[a][b][m][n] = (f32x4){0.f, 0.f, 0.f, 0.f};
    bf16x8 At[4][2], B0[2][2], B1[2][2];
    const char* cA = (const char*)g.A + (size_t)cur.pm * tstep; const char* cB = (const char*)g.Bt + (size_t)cur.pn * tstep;
    S.a_ready(cur);
    if constexpr (SP2) {
        PG8_STAGE(PG8_SB(0, 0), cB, voffB); PG8_STAGE(PG8_SB(0, 1), cB + hstep, voffB); PG8_STAGE(PG8_SA(0, 0), cA, voffA); PG8_STAGE(PG8_SA(0, 1), cA + hstep, voffA);
        if (wr == 1) PG8_BAR;
        PG8_WAIT_V(2); PG8_BAR;
        PG8_STAGE(PG8_SB(1, 0), cB + kstep, voffB); PG8_STAGE(PG8_SA(1, 0), cA + kstep, voffA); PG8_STAGE(PG8_SB(1, 1), cB + hstep + kstep, voffB);
        PG8_WAIT_V(6); PG8_BAR;
    } else {
        PG8_STAGE(PG8_SB(0, 0), cB, voffB); PG8_STAGE(PG8_SA(0, 0), cA, voffA); PG8_STAGE(PG8_SB(0, 1), cB + hstep, voffB); PG8_STAGE(PG8_SA(0, 1), cA + hstep, voffA);
        if (wr == 1) PG8_BAR;
        PG8_WAIT_V(4); PG8_BAR;
        PG8_STAGE(PG8_SB(1, 0), cB + kstep, voffB); PG8_STAGE(PG8_SA(1, 0), cA + kstep, voffA); PG8_STAGE(PG8_SB(1, 1), cB + hstep + kstep, voffB);
        PG8_WAIT_V(6); PG8_BAR;
    }
    for (;;) {
        const bool has_next = S.next(ui + 1, nxt);
        const char* nA = has_next ? (const char*)g.A + (size_t)nxt.pm * tstep : cA; const char* nB = has_next ? (const char*)g.Bt + (size_t)nxt.pn * tstep : cB;
        for (int t = 0; t < nt; t += 2) {
            const bool last = (t == nt - 2);
            const char* a1 = cA + (size_t)(t + 1) * kstep;
            const char* a2 = last ? nA : cA + (size_t)(t + 2) * kstep; const char* b2 = last ? nB : cB + (size_t)(t + 2) * kstep;
            const char* a3 = a2 + kstep; const char* b3 = b2 + kstep;
            if (last && has_next) S.a_ready(nxt);
            if constexpr (SP2) {
            PG8_LDB(B0, 0, 0); PG8_LDB(B1, 0, 1); PG8_SCHED; PG8_LDA(At, 0, 0); PG8_STAGE(PG8_SA(1, 1), a1 + hstep, voffA);
            PG8_WAIT_V(8); PG8_WAIT_L(0); PG8_BAR; PG8_MMA(0, 0, At, B0); PG8_MMA(0, 1, At, B1); PG8_BAR; PG8_SCHED;
            PG8_LDA(At, 0, 1); PG8_STAGE(PG8_SB(0, 0), b2, voffB); PG8_STAGE(PG8_SB(0, 1), b2 + hstep, voffB); PG8_STAGE(PG8_SA(0, 0), a2, voffA);
            PG8_WAIT_V(8); PG8_WAIT_L(0); PG8_BAR; PG8_MMA(1, 0, At, B0); PG8_MMA(1, 1, At, B1); PG8_BAR; PG8_SCHED;
            PG8_LDB(B0, 1, 0); PG8_LDB(B1, 1, 1); PG8_SCHED; PG8_LDA(At, 1, 0); PG8_STAGE(PG8_SA(0, 1), a2 + hstep, voffA);
            PG8_WAIT_V(8); PG8_WAIT_L(0); PG8_BAR; PG8_MMA(0, 0, At, B0); PG8_MMA(0, 1, At, B1); PG8_BAR; PG8_SCHED;
            PG8_LDA(At, 1, 1); PG8_STAGE(PG8_SB(1, 0), b3, voffB); PG8_STAGE(PG8_SB(1, 1), b3 + hstep, voffB); PG8_STAGE(PG8_SA(1, 0), a3, voffA);
            PG8_WAIT_V(8); PG8_WAIT_L(0); PG8_BAR; PG8_MMA(1, 0, At, B0); PG8_MMA(1, 1, At, B1); PG8_BAR; PG8_SCHED;
            } else {
            PG8_LDB(B0, 0, 0); PG8_SCHED; PG8_LDA(At, 0, 0); PG8_STAGE(PG8_SA(1, 1), a1 + hstep, voffA);
            PG8_WAIT_L(8); PG8_BAR; PG8_WAIT_L(0); PG8_MMA(0, 0, At, B0); PG8_BAR; PG8_SCHED;
            PG8_LDB(B1, 0, 1); PG8_STAGE(PG8_SB(0, 0), b2, voffB);
            PG8_BAR; PG8_WAIT_L(0); PG8_MMA(0, 1, At, B1); PG8_BAR;
            PG8_LDA(At, 0, 1); PG8_STAGE(PG8_SA(0, 0), a2, voffA);
            PG8_BAR; PG8_WAIT_L(0); PG8_MMA(1, 0, At, B0); PG8_BAR; PG8_SCHED;
            PG8_STAGE(PG8_SB(0, 1), b2 + hstep, voffB);
            PG8_WAIT_V(6); PG8_BAR; PG8_MMA(1, 1, At, B1); PG8_BAR;
            PG8_LDB(B0, 1, 0); PG8_SCHED; PG8_LDA(At, 1, 0); PG8_STAGE(PG8_SA(0, 1), a2 + hstep, voffA);
            PG8_WAIT_L(8); PG8_BAR; PG8_WAIT_L(0); PG8_MMA(0, 0, At, B0); PG8_BAR; PG8_SCHED;
            PG8_LDB(B1, 1, 1); PG8_STAGE(PG8_SB(1, 0), b3, voffB);
            PG8_BAR; PG8_WAIT_L(0); PG8_MMA(0, 1, At, B1); PG8_BAR;
            PG8_LDA(At, 1, 1); PG8_STAGE(PG8_SA(1, 0), a3, voffA);
            PG8_BAR; PG8_WAIT_L(0); PG8_MMA(1, 0, At, B0); PG8_BAR; PG8_SCHED;
            PG8_STAGE(PG8_SB(1, 1), b3 + hstep, voffB);
            PG8_WAIT_V(6); PG8_BAR; PG8_MMA(1, 1, At, B1); PG8_BAR;
            }
        }
        if constexpr (ALIGN_EPI) { if (wr == 0) PG8_BAR; }
        if constexpr (!Epi::AFTER_DRAIN) { E(acc, cur, wr, wc, fr, fq); S.done(cur); }
        if (!has_next) break;
#pragma unroll
        for (int a = 0; a < 2; ++a)
#pragma unroll
            for (int b = 0; b < 2; ++b)
#pragma unroll
                for (int m = 0; m < 4; ++m)
#pragma unroll
                    for (int n = 0; n < 2; ++n) acc[a][b][m][n] = (f32x4){0.f, 0.f, 0.f, 0.f};
        cur = nxt; cA = nA; cB = nB; ++ui;
        if constexpr (ALIGN_EPI) { if (wr == 1) PG8_BAR; }
    }
    PG8_WAIT_V(0);
    if constexpr (!ALIGN_EPI) { if (wr == 0) PG8_BAR; }
    PG8_BAR;
    if constexpr (Epi::AFTER_DRAIN) { E.fused(acc, cur, wr, wc, fr, fq, lds, wid, lane); S.done(cur); }
#undef PG8_SA
#undef PG8_SB
#undef PG8_STAGE
#undef PG8_LDA
#undef PG8_LDB
#undef PG8_MMA
#undef PG8_WAIT_V
#undef PG8_WAIT_L
#undef PG8_BAR
#undef PG8_SCHED
}
}


#define XB_TMO      128
#define XB_XCNT(j)  (256  + 64 * (j))
#define XB_XSUB(j)  (1280 + 64 * (j))
#define XB_XGEN(j)  (2304 + 64 * (j))
#define XB_TOP      3328
#define XB_TOPGEN   3392
#define XCD_BAR_WORDS 3456
#define XB_SPIN_CAP (1u << 22)

__device__ __forceinline__ unsigned xb_ld(unsigned* p)              { return __hip_atomic_load(p, __ATOMIC_RELAXED, __HIP_MEMORY_SCOPE_AGENT); }
__device__ __forceinline__ unsigned xb_add(unsigned* p, unsigned v) { return __hip_atomic_fetch_add(p, v, __ATOMIC_RELAXED, __HIP_MEMORY_SCOPE_AGENT); }
__device__ __forceinline__ unsigned xb_xcc_id() { return (unsigned)__builtin_amdgcn_s_getreg((3 << 11) | 20) & 0xFu; }
#define XB_SPIN(cond, bar) do { unsigned _sp = 0; while (cond) { __builtin_amdgcn_s_sleep(1); \
    if ((++_sp & 255u) == 0u) { if (xb_ld(&(bar)[XB_TMO])) break; if (_sp > XB_SPIN_CAP) { atomicAdd(&(bar)[XB_TMO], 1u); break; } } } } while (0)

struct XcdBarrier {
    unsigned* bar; unsigned x;
    volatile LAS unsigned* st;
};

__device__ __forceinline__ XcdBarrier xcd_barrier_post(unsigned* bar, volatile LAS unsigned* st) {
    XcdBarrier b; b.bar = bar; b.x = xb_xcc_id(); b.st = st;
    if (threadIdx.x == 0) (void)xb_add(&bar[XB_XCNT(b.x)], 1u);
    return b;
}
__device__ __forceinline__ void xcd_barrier_complete(unsigned* bar, unsigned x, unsigned& nloc, unsigned& nx) {
    const unsigned G = gridDim.x * gridDim.y * gridDim.z;
    unsigned sum, cnt, mine, sp = 0u;
    for (;;) {
        sum = 0u; cnt = 0u; mine = 0u;
#pragma unroll
        for (unsigned j = 0; j < 16; ++j) { const unsigned c = xb_ld(&bar[XB_XCNT(j)]); sum += c; cnt += (c > 0u) ? 1u : 0u; mine = (j == x) ? c : mine; }
        if (sum == G) break;
        __builtin_amdgcn_s_sleep(1);
        if ((++sp & 255u) == 0u) { if (xb_ld(&bar[XB_TMO])) break; if (sp > XB_SPIN_CAP) { atomicAdd(&bar[XB_TMO], 1u); break; } }
    }
    nloc = mine > 0u ? mine : 1u; nx = cnt > 0u ? cnt : 1u;
}

__device__ __forceinline__ void xcd_barrier(const XcdBarrier& b) {
    asm volatile("s_waitcnt vmcnt(0)" ::: "memory");
    __syncthreads();
    if (threadIdx.x == 0) {
        unsigned* bar = b.bar;
        __builtin_amdgcn_s_waitcnt(0);
        unsigned nloc = b.st[0], nx = b.st[1];
        if (nloc == 0u) { xcd_barrier_complete(bar, b.x, nloc, nx); b.st[0] = nloc; b.st[1] = nx; }
        const unsigned old = xb_add(&bar[XB_XSUB(b.x)], 1u);
        const unsigned gen = old / nloc;
        if (old + 1u == (gen + 1u) * nloc) {
            __builtin_amdgcn_fence(__ATOMIC_RELEASE, "agent");
            asm volatile("s_waitcnt vmcnt(0)" ::: "memory");
            const unsigned og = xb_add(&bar[XB_TOP], 1u);
            const unsigned tg = og / nx;
            if (og + 1u == (tg + 1u) * nx) xb_add(&bar[XB_TOPGEN], 1u);
            else XB_SPIN(xb_ld(&bar[XB_TOPGEN]) == tg, bar);
            __builtin_amdgcn_fence(__ATOMIC_ACQUIRE, "agent");
            xb_add(&bar[XB_XGEN(b.x)], 1u);
            asm volatile("s_waitcnt vmcnt(0)" ::: "memory");
        } else {
            XB_SPIN(xb_ld(&bar[XB_XGEN(b.x)]) == gen, bar);
            __builtin_amdgcn_fence(__ATOMIC_ACQUIRE, "agent");
            asm volatile("s_waitcnt vmcnt(0)" ::: "memory");
        }
    }
    __syncthreads();
}


typedef unsigned short bf16_t;
typedef float f32x4 __attribute__((ext_vector_type(4)));
typedef unsigned u32x4 __attribute__((ext_vector_type(4)));
typedef unsigned u32x2 __attribute__((ext_vector_type(2)));
struct Params { const float* in[25]; float* out; unsigned char* ws; int ph_lo, ph_hi; };
#define CAS __attribute__((address_space(4)))
typedef const CAS Params* PP;
__device__ __forceinline__ PP launder(PP p) { asm volatile("" : "+s"(p)); return p; }
enum { I_X = 0, I_META, I_F1N, I_F1GU, I_F1D, I_MIXN, I_WIN, I_MU, I_W0, I_WUP, I_A0, I_AUP, I_GUP, I_KK, I_KA, I_RK, I_LNW, I_LNB, I_BF, I_FON, I_WOUT, I_F2N, I_F2GU, I_F2D, I_FINN };

typedef float f32x2_t __attribute__((ext_vector_type(2))); typedef __bf16 bf16x2v_t __attribute__((ext_vector_type(2)));
__device__ __forceinline__ unsigned pk_bf16(float lo, float hi) { f32x2_t v = {lo, hi}; bf16x2v_t b = __builtin_convertvector(v, bf16x2v_t); return __builtin_bit_cast(unsigned, b); }
__device__ __forceinline__ float bf2f(bf16_t b) { return __uint_as_float(((unsigned)b) << 16); }
__device__ __forceinline__ float wave_sum(float v) {
#pragma unroll
    for (int o = 32; o >= 1; o >>= 1) v += __shfl_xor(v, o);
    return v; }
__device__ __forceinline__ float wave_max(float v) {
#pragma unroll
    for (int o = 32; o >= 1; o >>= 1) v = fmaxf(v, __shfl_xor(v, o));
    return v; }
template <int CTRL> __device__ __forceinline__ float dpp_f(float v) { return __builtin_bit_cast(float, __builtin_amdgcn_update_dpp(0, __builtin_bit_cast(int, v), CTRL, 0xf, 0xf, true)); }
__device__ __forceinline__ float row_sum16(float v) { v += dpp_f<0xB1>(v); v += dpp_f<0x4E>(v); v += dpp_f<0x141>(v); v += dpp_f<0x140>(v); return v; }
__device__ __forceinline__ float rdlane(float v, int l) { return __builtin_bit_cast(float, __builtin_amdgcn_readlane(__builtin_bit_cast(int, v), l)); }
__device__ __forceinline__ float wave_sum_dpp(float v) { v = row_sum16(v); return (rdlane(v, 0) + rdlane(v, 16)) + (rdlane(v, 32) + rdlane(v, 48)); }
__device__ __forceinline__ float sigmoid_f(float x) { return __builtin_amdgcn_rcpf(1.0f + __expf(-x)); }

__device__ __forceinline__ void convert_tile(const float* __restrict__ src, bf16_t* __restrict__ dst, const float* __restrict__ gain, int K, int Nsrc, int kind, int tk, int tn, LAS float* T) {
    const int tid = ltid();
    {
        const int nl = (tid & 15) * 4, np = tn * 64 + nl; int sc;
        if (kind == 1) { const int pn = np >> 8, bj = (np >> 7) & 1, i = np & 127; sc = bj * cfg::DFF + pn * 128 + i; }
        else if (kind == 2) { sc = np < 3360 ? np : (np < 3368 ? 6432 + (np - 3360) : (np < 3584 ? -1 : 3360 + (np - 3584))); }
        else sc = np;
#pragma unroll
        for (int i = 0; i < 2; ++i) { const int kl = (tid >> 4) + 32 * i, k = tk * 64 + kl;
            f32x4 v = (f32x4){0.f, 0.f, 0.f, 0.f};
            if (sc >= 0) v = *(const f32x4*)(src + (size_t)k * Nsrc + sc);
            float g = 1.f; if (kind == 1 || kind == 2) g = gain[k]; else if (kind == 3) g = (k >= 1024) ? gain[k - 1024] : 1.f;
            T[kl * 65 + nl] = v[0] * g; T[kl * 65 + nl + 1] = v[1] * g; T[kl * 65 + nl + 2] = v[2] * g; T[kl * 65 + nl + 3] = v[3] * g; }
    }
    __syncthreads();
    {
        const int nl = tid >> 3, k8 = (tid & 7) * 8; u32x4 w;
        w.x = pk_bf16(T[(k8 + 0) * 65 + nl], T[(k8 + 1) * 65 + nl]); w.y = pk_bf16(T[(k8 + 2) * 65 + nl], T[(k8 + 3) * 65 + nl]);
        w.z = pk_bf16(T[(k8 + 4) * 65 + nl], T[(k8 + 5) * 65 + nl]); w.w = pk_bf16(T[(k8 + 6) * 65 + nl], T[(k8 + 7) * 65 + nl]);
        *(u32x4*)(dst + (size_t)(tn * 64 + nl) * K + tk * 64 + k8) = w;
    }
    __syncthreads();
}
__device__ __forceinline__ void phase_convert(PP P, LAS unsigned char* lds, int l0, int l1, int first, int nwg, int t0 = 0, int t1 = 0) {
    using namespace cfg;
    LAS float* T = (LAS float*)lds;
    constexpr int T_GU = (DM / 64) * (NGU / 64), T_D = (DFF / 64) * (DM / 64), T_IN = (DM / 64) * (NIN / 64), T_OUT = (DM / 64) * (DM / 64);
    constexpr int T_LAYER = 2 * T_GU + 2 * T_D + T_IN + T_OUT;
    if (t1 <= 0) t1 = T_LAYER;
    for (int t = l0 * T_LAYER + first; t < l1 * T_LAYER; t += nwg) {
        const int l = t / T_LAYER; int r = t - l * T_LAYER; if (r < t0 || r >= t1) continue;
        bf16_t* wl = (bf16_t*)(P->ws + WS_W + (size_t)l * W_LAYER);
        const float* src; bf16_t* dst; const float* gain = nullptr; int K, Nsrc, kind, ntn;
        if (r < T_GU) { src = P->in[I_F1GU] + (size_t)l * DM * NGU; dst = (bf16_t*)((unsigned char*)wl + WO_GU1); gain = P->in[I_F1N] + l * DM; K = DM; Nsrc = NGU; kind = 1; ntn = NGU / 64; }
        else if ((r -= T_GU) < T_D) { src = P->in[I_F1D] + (size_t)l * DFF * DM; dst = (bf16_t*)((unsigned char*)wl + WO_D1); K = DFF; Nsrc = DM; kind = 0; ntn = DM / 64; }
        else if ((r -= T_D) < T_IN) { src = P->in[I_WIN] + (size_t)l * DM * DIN; dst = (bf16_t*)((unsigned char*)wl + WO_IN); gain = P->in[I_MIXN] + l * DM; K = DM; Nsrc = DIN; kind = 2; ntn = NIN / 64; }
        else if ((r -= T_IN) < T_OUT) { src = P->in[I_WOUT] + (size_t)l * DM * DM; dst = (bf16_t*)((unsigned char*)wl + WO_OUT); gain = P->in[I_FON] + l * FW; K = DM; Nsrc = DM; kind = 3; ntn = DM / 64; }
        else if ((r -= T_OUT) < T_GU) { src = P->in[I_F2GU] + (size_t)l * DM * NGU; dst = (bf16_t*)((unsigned char*)wl + WO_GU2); gain = P->in[I_F2N] + l * DM; K = DM; Nsrc = NGU; kind = 1; ntn = NGU / 64; }
        else { r -= T_GU; src = P->in[I_F2D] + (size_t)l * DFF * DM; dst = (bf16_t*)((unsigned char*)wl + WO_D2); K = DFF; Nsrc = DM; kind = 0; ntn = DM / 64; }
        convert_tile(src, dst, gain, K, Nsrc, kind, r / ntn, r % ntn, T);
    }
}
__device__ __forceinline__ void phase_init(PP P) {
    using namespace cfg;
    const int lane = ltid() & 63, gw = lbid() * 8 + (ltid() >> 6), nw = gridDim.x * 8;
    bf16_t* hb = (bf16_t*)(P->ws + WS_HB); float* ss0 = (float*)(P->ws + WS_SS);
    for (int row = gw; row < MROWS; row += nw) {
        const float* s = row < MMAIN ? P->in[I_X] + (size_t)row * DM : P->in[I_META] + (size_t)(row - MMAIN) * DM;
        float sq = 0.f;
#pragma unroll
        for (int i = 0; i < 4; ++i) { f32x4 v0 = (f32x4){0.f, 0.f, 0.f, 0.f}, v1 = v0; if (row < MMAIN + NMETA) { v0 = *(const f32x4*)(s + i * 512 + lane * 8); v1 = *(const f32x4*)(s + i * 512 + lane * 8 + 4); }
            sq += ((v0[0] * v0[0] + v0[1] * v0[1]) + (v0[2] * v0[2] + v0[3] * v0[3])) + ((v1[0] * v1[0] + v1[1] * v1[1]) + (v1[2] * v1[2] + v1[3] * v1[3]));
            u32x4 w; w.x = pk_bf16(v0[0], v0[1]); w.y = pk_bf16(v0[2], v0[3]); w.z = pk_bf16(v1[0], v1[1]); w.w = pk_bf16(v1[2], v1[3]); *(u32x4*)(hb + (size_t)row * DM + i * 512 + lane * 8) = w; }
        sq = wave_sum(sq);
        if (lane < 8) ss0[(size_t)lane * MROWS + row] = lane == 0 ? sq : 0.f;
        if (row >= MMAIN && row < MMAIN + NMETA) { float* ssm0 = (float*)(P->ws + WS_SSM); ssm0[lane * 16 + (row - MMAIN)] = lane == 0 ? sq : 0.f; ssm0[(64 + lane) * 16 + (row - MMAIN)] = 0.f; }
    }
}
__device__ __forceinline__ void phase_foxnorm(PP P) {
    using namespace cfg;
    const int lane = ltid() & 63, gw = lbid() * 8 + (ltid() >> 6), nw = gridDim.x * 8;
    bf16_t* y = (bf16_t*)(P->ws + WS_Y);
    for (int row0 = gw; row0 < MMAIN + NMETA; row0 += 4 * nw) {
        u32x4 a[4], b[4];
#pragma unroll
        for (int j = 0; j < 4; ++j) { const int row = row0 + j * nw; if (row < MMAIN + NMETA) { const bf16_t* p = y + (size_t)row * DM + 1024 + lane * 16; a[j] = *(const u32x4*)p; b[j] = *(const u32x4*)(p + 8); } else { a[j] = (u32x4){0u, 0u, 0u, 0u}; b[j] = a[j]; } }
#pragma unroll
        for (int j = 0; j < 4; ++j) { const int row = row0 + j * nw; float v[16];
#pragma unroll
            for (int i = 0; i < 4; ++i) { v[2 * i] = __uint_as_float(a[j][i] << 16); v[2 * i + 1] = __uint_as_float(a[j][i] & 0xffff0000u); v[8 + 2 * i] = __uint_as_float(b[j][i] << 16); v[8 + 2 * i + 1] = __uint_as_float(b[j][i] & 0xffff0000u); }
            float sq = 0.f;
#pragma unroll
            for (int i = 0; i < 16; ++i) sq += v[i] * v[i];
            sq = wave_sum_dpp(sq); const float rs = __builtin_amdgcn_rsqf(sq * (1.0f / 1024.0f) + NORM_EPS);
            u32x4 oa, ob;
#pragma unroll
            for (int i = 0; i < 4; ++i) { oa[i] = pk_bf16(v[2 * i] * rs, v[2 * i + 1] * rs); ob[i] = pk_bf16(v[8 + 2 * i] * rs, v[8 + 2 * i + 1] * rs); }
            if (row < MMAIN + NMETA) { bf16_t* p = y + (size_t)row * DM + 1024 + lane * 16; *(u32x4*)p = oa; *(u32x4*)(p + 8) = ob; } }
    }
}
__device__ __forceinline__ void phase_final(PP P) {
    using namespace cfg;
    const int lane = ltid() & 63, gw = lbid() * 8 + (ltid() >> 6), nw = gridDim.x * 8;
    const float* g = P->in[I_FINN]; const bf16_t* hb = (const bf16_t*)(P->ws + WS_HB);
    for (int row = gw; row < MMAIN; row += nw) {
        float* d = P->out + (size_t)row * DM; f32x4 v[8]; float sq = 0.f;
#pragma unroll
        for (int i = 0; i < 4; ++i) { const u32x4 x = *(const u32x4*)(hb + (size_t)row * DM + i * 512 + lane * 8);
            v[2 * i] = (f32x4){__uint_as_float(x.x << 16), __uint_as_float(x.x & 0xffff0000u), __uint_as_float(x.y << 16), __uint_as_float(x.y & 0xffff0000u)};
            v[2 * i + 1] = (f32x4){__uint_as_float(x.z << 16), __uint_as_float(x.z & 0xffff0000u), __uint_as_float(x.w << 16), __uint_as_float(x.w & 0xffff0000u)}; }
#pragma unroll
        for (int i = 0; i < 8; ++i) sq += (v[i][0] * v[i][0] + v[i][1] * v[i][1]) + (v[i][2] * v[i][2] + v[i][3] * v[i][3]);
        sq = wave_sum(sq); const float rs = __builtin_amdgcn_rsqf(sq * (1.0f / 2048.0f) + NORM_EPS);
#pragma unroll
        for (int i = 0; i < 4; ++i) { const f32x4 g0 = *(const f32x4*)(g + i * 512 + lane * 8), g1 = *(const f32x4*)(g + i * 512 + lane * 8 + 4);
            *(f32x4*)(d + i * 512 + lane * 8) = v[2 * i] * rs * g0; *(f32x4*)(d + i * 512 + lane * 8 + 4) = v[2 * i + 1] * rs * g1; }
    }
}


__device__ __forceinline__ void phase_lx(PP P, int l) {
    using namespace cfg;
    const int lane = ltid() & 63, gw = lbid() * 8 + (ltid() >> 6), nw = gridDim.x * 8;
    const float* PS = (const float*)(P->ws + WS_PS); bf16_t* LXG = (bf16_t*)(P->ws + WS_LXG); const float* mu = P->in[I_MU] + l * RWKV_COLS + 3072;
    if (lane < 36) {
        const f32x4 m0 = *(const f32x4*)(mu + lane * 8), m1 = *(const f32x4*)(mu + lane * 8 + 4);
#pragma unroll 4
        for (int row = gw; row < MMAIN + NMETA; row += nw) {
            int prev; if (row >= MMAIN) prev = (row == MMAIN) ? -1 : row - 1; else prev = ((row & (SEQ - 1)) == 0) ? MMAIN + NMETA - 1 : row - 1;
            const f32x4 c0 = *(const f32x4*)(PS + (size_t)row * PSW + lane * 8), c1 = *(const f32x4*)(PS + (size_t)row * PSW + lane * 8 + 4);
            f32x4 p0 = (f32x4){0.f, 0.f, 0.f, 0.f}, p1 = p0; if (prev >= 0) { p0 = *(const f32x4*)(PS + (size_t)prev * PSW + lane * 8); p1 = *(const f32x4*)(PS + (size_t)prev * PSW + lane * 8 + 4); }
            float x[8];
#pragma unroll
            for (int j = 0; j < 4; ++j) { x[j] = c0[j] + (p0[j] - c0[j]) * m0[j]; x[4 + j] = c1[j] + (p1[j] - c1[j]) * m1[j]; }
#pragma unroll
            for (int j = 0; j < 8; ++j) x[j] = lane < 8 ? 1.0f - 2.0f * __builtin_amdgcn_rcpf(__expf(2.0f * x[j]) + 1.0f) : (lane < 16 ? x[j] : __builtin_amdgcn_rcpf(1.0f + __expf(-x[j])));
            u32x4 w; w.x = pk_bf16(x[0], x[1]); w.y = pk_bf16(x[2], x[3]); w.z = pk_bf16(x[4], x[5]); w.w = pk_bf16(x[6], x[7]);
            *(u32x4*)(LXG + (size_t)row * 320 + lane * 8) = w;
        }
    }
}

typedef short bf16x8_t __attribute__((ext_vector_type(8)));
typedef short bf16x4_t __attribute__((ext_vector_type(4)));
namespace rk {
constexpr int RAWF = 0, RAWF_SZ = 18432, RAWH = 55296, RAWH_SZ = 6144, LXB = 73728, RS = 82944, KS = 87040, VS = 91136, KKN = 95232, ATP = 99328, RTP = 101376, BTP = 103424, KTP = 105472,
              BHT = 107520, KHT = 109568, VT = 111616, GT = 113664, AAK = 113920, RB = 114432, RKM = 114944, TINV = 115456, GG = 115968  , VF = 124160  , YR = 132352, BONP = 136448  , LDS_END = 136960;
}
#define RK_BAR() do { asm volatile("s_waitcnt lgkmcnt(0)" ::: "memory"); __builtin_amdgcn_s_barrier(); asm volatile("" ::: "memory"); } while (0)
__device__ __forceinline__ bf16_t bf1(float x) { return (bf16_t)(pk_bf16(x, 0.f) & 0xffffu); }
__device__ __forceinline__ bf16x4_t pack4(float a, float b, float c, float d) { u32x2 w; w.x = pk_bf16(a, b); w.y = pk_bf16(c, d); return __builtin_bit_cast(bf16x4_t, w); }
__device__ __forceinline__ float fast_sigmoid(float x) { return __builtin_amdgcn_rcpf(1.0f + __expf(-x)); }
__device__ __forceinline__ float fast_tanh(float x) { return 1.0f - 2.0f * __builtin_amdgcn_rcpf(__expf(2.0f * x) + 1.0f); }

__device__ __forceinline__ void rwkv_chunked(PP P, int l, int b, int h, LAS unsigned char* lds) {
    using namespace cfg;
    const int tid = ltid(), lane = tid & 63, wave = __builtin_amdgcn_readfirstlane(tid >> 6), n = lane & 15, g = lane >> 4;
    const bf16_t* PR = (const bf16_t*)(P->ws + WS_PR); const float* PS = (const float*)(P->ws + WS_PS); bf16_t* Y = (bf16_t*)(P->ws + WS_Y);
    const float* mu = P->in[I_MU] + l * RWKV_COLS; const bf16_t* LXGp = (const bf16_t*)(P->ws + WS_LXG);
    LAS float* RSm = (LAS float*)(lds + rk::RS); LAS float* KSm = (LAS float*)(lds + rk::KS); LAS float* VSm = (LAS float*)(lds + rk::VS); LAS float* KKNm = (LAS float*)(lds + rk::KKN);
    LAS bf16_t* ATp = (LAS bf16_t*)(lds + rk::ATP); LAS bf16_t* RTp = (LAS bf16_t*)(lds + rk::RTP); LAS bf16_t* BTp = (LAS bf16_t*)(lds + rk::BTP); LAS bf16_t* KTp = (LAS bf16_t*)(lds + rk::KTP);
    LAS bf16_t* BHt = (LAS bf16_t*)(lds + rk::BHT); LAS bf16_t* KHt = (LAS bf16_t*)(lds + rk::KHT); LAS bf16_t* Vt = (LAS bf16_t*)(lds + rk::VT);
    LAS float* GTm = (LAS float*)(lds + rk::GT);
    LAS bf16_t* AAKm = (LAS bf16_t*)(lds + rk::AAK); LAS bf16_t* RBm = (LAS bf16_t*)(lds + rk::RB); LAS bf16_t* RKm = (LAS bf16_t*)(lds + rk::RKM); LAS bf16_t* TINVm = (LAS bf16_t*)(lds + rk::TINV);
    LAS float* YRm = (LAS float*)(lds + rk::YR);
    const int hj = h * 64 + lane;
    const float mur = mu[hj], muk = mu[1024 + hj], muv = mu[2048 + hj], kkw = P->in[I_KK][l * RW + hj], lnw = P->in[I_LNW][l * RW + hj], lnb = P->in[I_LNB][l * RW + hj];
    float mul[5];
#pragma unroll
    for (int q = 0; q < 5; ++q) mul[q] = (lane + 64 * q < 288) ? mu[3072 + lane + 64 * q] : 0.f;
    const int kw = wave & 3, key = 16 * kw + n, hk = h * 64 + key;
    const float w0k = P->in[I_W0][l * RW + hk], a0k = P->in[I_A0][l * RW + hk], kak = P->in[I_KA][l * RW + hk], rkk = P->in[I_RK][l * RW + hk];
    const int pp = 32 * (key >> 5) + 8 * ((key >> 2) & 3) + 4 * ((key >> 4) & 1) + (key & 3);
    bf16x8_t fA[2], fB[5];
    {
        const float* wu = P->in[I_WUP] + (size_t)l * 64 * RW + hk; const float* au = P->in[I_AUP] + (size_t)l * 64 * RW + hk; const float* gu = P->in[I_GUP] + (size_t)l * 160 * RW + hk;
#pragma unroll
        for (int s = 0; s < 5; ++s) { float v[8], u[8];
#pragma unroll
            for (int j = 0; j < 8; ++j) { const int k = 32 * s + 8 * g + j; v[j] = (wave < 4) ? (s < 2 ? au[(size_t)k * RW] : 0.f) : gu[(size_t)k * RW]; u[j] = (wave < 4 && s < 2) ? wu[(size_t)k * RW] : 0.f; }
            u32x4 w; w.x = pk_bf16(v[0], v[1]); w.y = pk_bf16(v[2], v[3]); w.z = pk_bf16(v[4], v[5]); w.w = pk_bf16(v[6], v[7]); fB[s] = __builtin_bit_cast(bf16x8_t, w);
            if (s < 2) { u32x4 x; x.x = pk_bf16(u[0], u[1]); x.y = pk_bf16(u[2], u[3]); x.z = pk_bf16(u[4], u[5]); x.w = pk_bf16(u[6], u[7]); fA[s] = __builtin_bit_cast(bf16x8_t, x); } }
    }
    f32x4 ST[4];
#pragma unroll
    for (int kb = 0; kb < 4; ++kb) ST[kb] = (f32x4){0.f, 0.f, 0.f, 0.f};
#define RK_DMA(c_) do { const int cc_ = (c_); const int row0_ = (cc_ == 0) ? MMAIN : b * SEQ + (cc_ - 1) * 16; const int bi_ = cc_ % 3; \
        _Pragma("unroll") for (int i_ = 0; i_ < 2; ++i_) { const int wp_ = (i_ == 0) ? wave : 8; if (i_ == 0 || wave == 6) { const int x_ = wp_ * 64 + lane; \
            __builtin_amdgcn_global_load_lds((const unsigned*)(LXGp + (size_t)(row0_ + x_ / 36) * 320 + (x_ % 36) * 8), (LAS unsigned*)(lds + rk::RAWF + (cc_ & 1) * rk::RAWF_SZ + wp_ * 1024), 16, 0, 0); } } \
        if (wave < 6) { const int y_ = wave * 64 + lane; \
            __builtin_amdgcn_global_load_lds((const unsigned*)(PR + (size_t)(row0_ + y_ / 24) * PRW + ((y_ % 24) >> 3) * 1024 + h * 64 + (y_ & 7) * 8), (LAS unsigned*)(lds + rk::RAWH + bi_ * rk::RAWH_SZ + wave * 1024), 16, 0, 0); } } while (0)
#define RK_STAGE_A(ca_, t_) do { const int t = (t_); const int bc_ = (ca_) % 3, bp_ = ((ca_) + 2) % 3; \
        LAS const float* cF_ = (LAS const float*)(lds + rk::RAWF + bc_ * rk::RAWF_SZ); LAS const float* pF_ = (LAS const float*)(lds + rk::RAWF + bp_ * rk::RAWF_SZ); \
        LAS const bf16_t* cH_ = (LAS const bf16_t*)(lds + rk::RAWH + bc_ * rk::RAWH_SZ); LAS const bf16_t* pH_ = (LAS const bf16_t*)(lds + rk::RAWH + bp_ * rk::RAWH_SZ); \
        LAS const float* ctF = cF_ + t * 288; LAS const float* ptF = (t == 0) ? pF_ + 15 * 288 : cF_ + (t - 1) * 288; \
        LAS const bf16_t* ctH = cH_ + t * 192; LAS const bf16_t* ptH = (t == 0) ? pH_ + 15 * 192 : cH_ + (t - 1) * 192; \
        const float rc = bf2f(ctH[lane]), kc = bf2f(ctH[64 + lane]), vc = bf2f(ctH[128 + lane]); \
        const float rs = rc + (bf2f(ptH[lane]) - rc) * mur, ks = kc + (bf2f(ptH[64 + lane]) - kc) * muk, vs = vc + (bf2f(ptH[128 + lane]) - vc) * muv; \
        RSm[t * 64 + lane] = rs; KSm[t * 64 + lane] = ks; VSm[t * 64 + lane] = vs; \
        const float kkr = ks * kkw; const float n2 = wave_sum_dpp(kkr * kkr); KKNm[t * 64 + lane] = kkr * __builtin_amdgcn_rsqf(fmaxf(n2, 1e-24f)); } while (0)
#define RK_STAGE_F(cf_, t_) do { const int t = (t_); const int par_ = (cf_) & 1; const int rowF_ = ((cf_) == 0) ? MMAIN : b * SEQ + ((cf_) - 1) * 16; \
        LAS const float* Gp_ = (LAS const float*)(lds + rk::GG + par_ * 4096); LAS const float* Vp_ = (LAS const float*)(lds + rk::VF + par_ * 4096); LAS const float* Bp_ = (LAS const float*)(lds + rk::BONP + par_ * 256); \
        const float yv = YRm[t * 64 + lane]; \
        const float mean = wave_sum_dpp(yv) * (1.0f / 64.0f); const float d = yv - mean; const float var = wave_sum_dpp(d * d) * (1.0f / 64.0f); \
        const float yn = d * __builtin_amdgcn_rsqf(var + LNX_EPS) * lnw + lnb; \
        const float bonus = (Bp_[t] + Bp_[16 + t]) + (Bp_[32 + t] + Bp_[48 + t]); \
        const float o = (yn + bonus * Vp_[t * 64 + lane]) * Gp_[t * 64 + lane]; \
        if ((cf_) > 0 || b == 0) Y[(size_t)(rowF_ + t) * DM + hj] = bf1(o); } while (0)
    RK_DMA(0); RK_DMA(1);
    for (int e = tid; e < 96; e += 512) ((LAS unsigned*)(lds + rk::RAWH + 2 * rk::RAWH_SZ))[15 * 96 + e] = 0u;
    asm volatile("s_waitcnt vmcnt(0)" ::: "memory");
    RK_BAR();
    RK_STAGE_A(0, wave); RK_STAGE_A(0, wave + 8);
    RK_BAR();
#pragma unroll 1
    for (int c = 0; c < 257; ++c) {
        if (wave < 4) {
            LAS float* BONPc = (LAS float*)(lds + rk::BONP + (c & 1) * 256); LAS const bf16_t* LXB = (LAS const bf16_t*)(lds + rk::RAWF + (c & 1) * rk::RAWF_SZ);
            f32x4 accW = (f32x4){0.f, 0.f, 0.f, 0.f}, accA = accW;
#pragma unroll
            for (int s = 0; s < 2; ++s) { const bf16x8_t aw = *(const LAS bf16x8_t*)(LXB + n * 288 + 32 * s + 8 * g), aa = *(const LAS bf16x8_t*)(LXB + n * 288 + 64 + 32 * s + 8 * g);
                accW = __builtin_amdgcn_mfma_f32_16x16x32_bf16(aw, fA[s], accW, 0, 0, 0); accA = __builtin_amdgcn_mfma_f32_16x16x32_bf16(aa, fB[s], accA, 0, 0, 0); }
            float lw[4], alr[4], pfx[4];
#pragma unroll
            for (int r = 0; r < 4; ++r) { lw[r] = -0.6065306597126334f * fast_sigmoid(accW[r] + w0k); alr[r] = fast_sigmoid(accA[r] + a0k); }
            pfx[0] = lw[0]; pfx[1] = pfx[0] + lw[1]; pfx[2] = pfx[1] + lw[2]; pfx[3] = pfx[2] + lw[3];
            const float t0 = __shfl(pfx[3], n), t1 = __shfl(pfx[3], n + 16), t2 = __shfl(pfx[3], n + 32), t3 = __shfl(pfx[3], n + 48);
            const float base = (g > 0 ? t0 : 0.f) + (g > 1 ? t1 : 0.f) + (g > 2 ? t2 : 0.f), lamT = (t0 + t1) + (t2 + t3);
            float bh[4], kh[4], bon[4], epos[4];
            const float eb = __expf(base), eT = __expf(lamT);
#pragma unroll
            for (int r = 0; r < 4; ++r) epos[r] = __expf(base + pfx[r]);
#pragma unroll
            for (int r = 0; r < 4; ++r) { const int t = 4 * g + r;
                const float e_pos = epos[r], e_neg = __builtin_amdgcn_rcpf(epos[r]), e_prev = (r == 0) ? eb : epos[r > 0 ? r - 1 : 0], e_hat = eT * e_neg;
                const float rs = RSm[t * 64 + key], ks = KSm[t * 64 + key], kk = KKNm[t * 64 + key];
                const float kmod = ks * (1.0f + (alr[r] - 1.0f) * kak), bb = kk * alr[r];
                ATp[t * 64 + pp] = bf1(-kk * e_prev); RTp[t * 64 + pp] = bf1(rs * e_pos); BTp[t * 64 + pp] = bf1(bb * e_neg); KTp[t * 64 + pp] = bf1(kmod * e_neg);
                bh[r] = bb * e_hat; kh[r] = kmod * e_hat; bon[r] = rs * kmod * rkk; }
            *(LAS bf16x4_t*)(BHt + key * 16 + 4 * g) = pack4(bh[0], bh[1], bh[2], bh[3]); *(LAS bf16x4_t*)(KHt + key * 16 + 4 * g) = pack4(kh[0], kh[1], kh[2], kh[3]);
#pragma unroll
            for (int r = 0; r < 4; ++r) { const float x = row_sum16(bon[r]); if (n == 0) BONPc[kw * 16 + 4 * g + r] = x; }
            if (g == 0) GTm[key] = eT;
        } else {
            LAS float* Gc = (LAS float*)(lds + rk::GG + (c & 1) * 4096); LAS float* VFc = (LAS float*)(lds + rk::VF + (c & 1) * 4096); LAS const bf16_t* LXB = (LAS const bf16_t*)(lds + rk::RAWF + (c & 1) * rk::RAWF_SZ);
            f32x4 accG = (f32x4){0.f, 0.f, 0.f, 0.f};
#pragma unroll
            for (int s = 0; s < 5; ++s) { const bf16x8_t ag = *(const LAS bf16x8_t*)(LXB + n * 288 + 128 + 32 * s + 8 * g); accG = __builtin_amdgcn_mfma_f32_16x16x32_bf16(ag, fB[s], accG, 0, 0, 0); }
            float vv[4];
#pragma unroll
            for (int r = 0; r < 4; ++r) { Gc[(4 * g + r) * 64 + key] = accG[r]; vv[r] = VSm[(4 * g + r) * 64 + key]; VFc[(4 * g + r) * 64 + key] = vv[r]; }
            *(LAS bf16x4_t*)(Vt + key * 16 + 4 * g) = pack4(vv[0], vv[1], vv[2], vv[3]);
            if (c >= 1) { RK_STAGE_F(c - 1, 4 * kw); RK_STAGE_F(c - 1, 4 * kw + 1); RK_STAGE_F(c - 1, 4 * kw + 2); RK_STAGE_F(c - 1, 4 * kw + 3); }
        }
        asm volatile("s_waitcnt vmcnt(0)" ::: "memory");
        RK_BAR();
        if (c + 2 < 257) RK_DMA(c + 2);
        if (wave < 4) {
            LAS const bf16_t* X = (wave < 2) ? ATp : RTp; LAS const bf16_t* Yi = (wave & 1) ? KTp : BTp;
            f32x4 acc = (f32x4){0.f, 0.f, 0.f, 0.f};
#pragma unroll
            for (int s = 0; s < 2; ++s) { const bf16x8_t xa = *(const LAS bf16x8_t*)(X + n * 64 + 32 * s + 8 * g), yb = *(const LAS bf16x8_t*)(Yi + n * 64 + 32 * s + 8 * g);
                acc = __builtin_amdgcn_mfma_f32_16x16x32_bf16(xa, yb, acc, 0, 0, 0); }
            float mv[4];
#pragma unroll
            for (int r = 0; r < 4; ++r) { const int t = 4 * g + r; const bool keep = (wave < 2) ? (n < t) : (n <= t); mv[r] = keep ? acc[r] : 0.f;
                if (wave == 1) AAKm[t * 16 + n] = bf1(mv[r]); else if (wave == 2) RBm[t * 16 + n] = bf1(mv[r]); else if (wave == 3) RKm[t * 16 + n] = bf1(mv[r]); }
            if (wave == 0) {
                float Tc[16];
#pragma unroll
                for (int t = 0; t < 16; ++t) { float v0 = (t == n) ? 1.0f : 0.0f, v1 = 0.f;
#pragma unroll
                    for (int i = 0; i < t; ++i) { const float a = rdlane(mv[t & 3], i + 16 * (t >> 2)); if (i & 1) v1 += a * Tc[i]; else v0 += a * Tc[i]; }
                    Tc[t] = v0 + v1; __builtin_amdgcn_sched_barrier(0); }
                if (g == 0) {
#pragma unroll
                    for (int t = 0; t < 16; ++t) TINVm[t * 16 + n] = bf1(Tc[t]); }
            }
        }
        if (wave >= 1) {
            if (c + 1 < 257) { RK_STAGE_A(c + 1, wave - 1); RK_STAGE_A(c + 1, wave + 6); if (wave < 3) RK_STAGE_A(c + 1, wave + 13); }
        }
        RK_BAR();
        if (wave < 4) {
            bf16x8_t sb[2];
#pragma unroll
            for (int s = 0; s < 2; ++s) { u32x4 w; w.x = pk_bf16(ST[2 * s][0], ST[2 * s][1]); w.y = pk_bf16(ST[2 * s][2], ST[2 * s][3]); w.z = pk_bf16(ST[2 * s + 1][0], ST[2 * s + 1][1]); w.w = pk_bf16(ST[2 * s + 1][2], ST[2 * s + 1][3]);
                sb[s] = __builtin_bit_cast(bf16x8_t, w); }
            const bf16x4_t vfr = *(const LAS bf16x4_t*)(Vt + key * 16 + 4 * g);
            f32x4 W1 = (f32x4){0.f, 0.f, 0.f, 0.f}, Yc = W1;
#pragma unroll
            for (int s = 0; s < 2; ++s) { const bf16x8_t af = *(const LAS bf16x8_t*)(ATp + n * 64 + 32 * s + 8 * g), rf = *(const LAS bf16x8_t*)(RTp + n * 64 + 32 * s + 8 * g);
                W1 = __builtin_amdgcn_mfma_f32_16x16x32_bf16(af, sb[s], W1, 0, 0, 0); Yc = __builtin_amdgcn_mfma_f32_16x16x32_bf16(rf, sb[s], Yc, 0, 0, 0); }
            W1 = __builtin_amdgcn_mfma_f32_16x16x16bf16_1k(*(const LAS bf16x4_t*)(AAKm + n * 16 + 4 * g), vfr, W1, 0, 0, 0);
            const bf16x4_t w1f = pack4(W1[0], W1[1], W1[2], W1[3]);
            f32x4 U = __builtin_amdgcn_mfma_f32_16x16x16bf16_1k(*(const LAS bf16x4_t*)(TINVm + n * 16 + 4 * g), w1f, (f32x4){0.f, 0.f, 0.f, 0.f}, 0, 0, 0);
            const bf16x4_t uf = pack4(U[0], U[1], U[2], U[3]);
            Yc = __builtin_amdgcn_mfma_f32_16x16x16bf16_1k(*(const LAS bf16x4_t*)(RBm + n * 16 + 4 * g), uf, Yc, 0, 0, 0);
            Yc = __builtin_amdgcn_mfma_f32_16x16x16bf16_1k(*(const LAS bf16x4_t*)(RKm + n * 16 + 4 * g), vfr, Yc, 0, 0, 0);
#pragma unroll
            for (int r = 0; r < 4; ++r) YRm[(4 * g + r) * 64 + key] = Yc[r];
#pragma unroll
            for (int kb = 0; kb < 4; ++kb) { const f32x4 gt = *(const LAS f32x4*)(GTm + 16 * kb + 4 * g); f32x4 a = ST[kb] * gt;
                a = __builtin_amdgcn_mfma_f32_16x16x16bf16_1k(*(const LAS bf16x4_t*)(BHt + (16 * kb + n) * 16 + 4 * g), uf, a, 0, 0, 0);
                a = __builtin_amdgcn_mfma_f32_16x16x16bf16_1k(*(const LAS bf16x4_t*)(KHt + (16 * kb + n) * 16 + 4 * g), vfr, a, 0, 0, 0);
                ST[kb] = a; }
        }
        RK_BAR();
    }
    RK_STAGE_F(256, wave); RK_STAGE_F(256, wave + 8);
    asm volatile("s_waitcnt vmcnt(0)" ::: "memory");
    RK_BAR();
#undef RK_DMA
#undef RK_STAGE_A
#undef RK_STAGE_F
}

__device__ __forceinline__ f32x4 sk_dot(const bf16_t* a, const bf16_t* b, int nsteps) {
    f32x4 acc = (f32x4){0.f, 0.f, 0.f, 0.f};
#pragma unroll 8
    for (int s = 0; s < nsteps; ++s) { const bf16x8_t av = *(const bf16x8_t*)(a + 32 * s), bv = *(const bf16x8_t*)(b + 32 * s); acc = __builtin_amdgcn_mfma_f32_16x16x32_bf16(av, bv, acc, 0, 0, 0); }
    return acc; }
__device__ __forceinline__ void meta_rs(const float* ssm, int lane, float (&rs)[4]) {
    const int row = lane & 15, part = lane >> 4; float s = 0.f;
#pragma unroll 8
    for (int i = 0; i < 32; ++i) s += ssm[(part + 4 * i) * 16 + row];
    s = s + __shfl_xor(s, 16); s = s + __shfl_xor(s, 32);
    const float rv = __builtin_amdgcn_rsqf(s * (1.0f / 2048.0f) + 1e-6f);
#pragma unroll
    for (int r = 0; r < 4; ++r) rs[r] = __shfl(rv, 4 * part + r); }
#define SK_HEAD const int tid = ltid(), lane = tid & 63, wave = __builtin_amdgcn_readfirstlane(tid >> 6), n = lane & 15, g = lane >> 4, kq = wave & 3, ti = lbid() + 256 * (wave >> 2); LAS f32x4* part = (LAS f32x4*)lds;
#define SK_COMBINE(dst, slot) do { dst = (part[((wave) * 2 + (slot)) * 64 + lane] + part[((wave + 1) * 2 + (slot)) * 64 + lane]) + (part[((wave + 2) * 2 + (slot)) * 64 + lane] + part[((wave + 3) * 2 + (slot)) * 64 + lane]); } while (0)
__device__ __forceinline__ void skinny_gu(const bf16_t* hb, const bf16_t* Bt, const float* ssm, bf16_t* act, LAS unsigned char* lds) {
    using namespace cfg; SK_HEAD
    if (ti < DFF / 16) { const int c0 = 16 * ti, brow = (c0 >> 7) * 256 + (c0 & 127) + n; const bf16_t* a = hb + (size_t)(MMAIN + n) * DM + 512 * kq + 8 * g;
        part[(wave * 2) * 64 + lane] = sk_dot(a, Bt + (size_t)brow * DM + 512 * kq + 8 * g, 16); part[(wave * 2 + 1) * 64 + lane] = sk_dot(a, Bt + (size_t)(brow + 128) * DM + 512 * kq + 8 * g, 16); }
    __syncthreads();
    if (ti < DFF / 16 && kq == 0) { f32x4 gt, up; SK_COMBINE(gt, 0); SK_COMBINE(up, 1); float rs[4]; meta_rs(ssm, lane, rs);
#pragma unroll
        for (int r = 0; r < 4; ++r) { const float gv = gt[r] * rs[r], uv = up[r] * rs[r]; act[(size_t)(MMAIN + 4 * g + r) * DFF + 16 * ti + n] = bf1(gv * __builtin_amdgcn_rcpf(1.0f + __builtin_amdgcn_exp2f(-1.4426950408889634f * gv)) * uv); } }
    __syncthreads();
}
__device__ __forceinline__ void skinny_res(const bf16_t* A16, int K, const bf16_t* Bt, bf16_t* hb, float* ssm_out, float alpha, LAS unsigned char* lds) {
    using namespace cfg;
    const int tid = ltid(), lane = tid & 63, wave = __builtin_amdgcn_readfirstlane(tid >> 6), n = lane & 15, g = lane >> 4, ti = lbid(); LAS f32x4* part = (LAS f32x4*)lds;
    const int k8 = K / 8;
    if (ti < DM / 16) part[wave * 64 + lane] = sk_dot(A16 + (size_t)n * K + k8 * wave + 8 * g, Bt + (size_t)(16 * ti + n) * K + k8 * wave + 8 * g, k8 / 32);
    __syncthreads();
    if (ti < DM / 16 && wave == 0) { const f32x4 acc = ((part[lane] + part[64 + lane]) + (part[128 + lane] + part[192 + lane])) + ((part[256 + lane] + part[320 + lane]) + (part[384 + lane] + part[448 + lane]));
#pragma unroll
        for (int r = 0; r < 4; ++r) { const int m = 4 * g + r, col = 16 * ti + n; bf16_t* p = hb + (size_t)(MMAIN + m) * DM + col; const float hv = bf2f(*p) + alpha * acc[r]; *p = bf1(hv);
            const float sq = row_sum16(hv * hv); if (n == 0) ssm_out[ti * 16 + m] = sq; } }
    __syncthreads();
}
__device__ __forceinline__ void skinny_p(const bf16_t* hb, const bf16_t* Bt, const float* ssm, bf16_t* pr, float* ps, bf16_t* qkv, LAS unsigned char* lds) {
    using namespace cfg; SK_HEAD
    if (ti < NIN / 16) part[(wave * 2) * 64 + lane] = sk_dot(hb + (size_t)(MMAIN + n) * DM + 512 * kq + 8 * g, Bt + (size_t)(16 * ti + n) * DM + 512 * kq + 8 * g, 16);
    __syncthreads();
    if (ti < NIN / 16 && kq == 0) { f32x4 acc; SK_COMBINE(acc, 0); float rs[4]; meta_rs(ssm, lane, rs); const int np = 16 * ti + n;
#pragma unroll
        for (int r = 0; r < 4; ++r) { const int m = 4 * g + r; const float v = acc[r] * rs[r];
            if (np < 3072) pr[(size_t)(MMAIN + m) * PRW + np] = bf1(v);
            else if (np < 3584) ps[(size_t)(MMAIN + m) * PSW + (np - 3072)] = v;
            else { const bf16_t w = bf1(v);
#pragma unroll
                for (int b = 0; b < NBATCH; ++b) qkv[((size_t)b * SEQP + 48 + m) * QKVW + (np - 3584)] = w; } } }
    __syncthreads();
}
#undef SK_HEAD
#undef SK_COMBINE

namespace fox {
constexpr int D = 128, NW = 8, QBLK = 32, KVBLK = 64, QB = NW * QBLK;
constexpr int LDQ = cfg::QKVW, LDK = cfg::QKVW, LDO = cfg::DM;
constexpr float SCALE = 0.08838834764831845f, THR = 8.f;
constexpr bool WSKIP = false;
constexpr int SHM_V = KVBLK * D * 2, SHM_K = KVBLK * D * 2;
constexpr int ATT_LDS = 2 * SHM_V + 2 * SHM_K + NW * 64 * 4;
constexpr int BIAS_OFF = ATT_LDS;
constexpr int SCAN_OFF = BIAS_OFF + cfg::SEQP * 4;

using bf16 = __hip_bfloat16;
typedef short bf16x8 __attribute__((ext_vector_type(8)));
typedef short s16x4 __attribute__((ext_vector_type(4)));
typedef float f32x16 __attribute__((ext_vector_type(16)));
typedef float f32x4 __attribute__((ext_vector_type(4)));
typedef unsigned u32x4 __attribute__((ext_vector_type(4)));
template <class A, class Bt> struct same_t { static constexpr bool v = false; };
template <class A> struct same_t<A, A> { static constexpr bool v = true; };

#define KSWZ(row, colB) ((row) * 256 + ((colB) ^ (((row) & 7) << 4)))
#define SBAR() __builtin_amdgcn_sched_barrier(0)
__device__ __forceinline__ int v_st(int k, int c) { const int kk = (k & ~0xC) | ((k & 4) << 1) | ((k & 8) >> 1); return ((kk >> 3) * 4 + (c >> 5)) * 512 + ((kk & 7) * 32 + (c & 31)) * 2; }
__device__ __forceinline__ int v_rd_base(int lane) { return ((lane & 3) << 3) | (((lane >> 2) & 3) << 6) | (((lane >> 4) & 1) << 5) | (((lane >> 5) & 1) << 8); }
constexpr int v_rd_off(int d0, int ks, int half) { return d0 * 512 + ks * 4096 + half * 2048; }
__device__ __forceinline__ int crow(int r, int hi) { return (r & 3) + 8 * (r >> 2) + 4 * hi; }
__device__ __forceinline__ unsigned cvtpk(float lo, float hi) {
    unsigned r; asm volatile("v_cvt_pk_bf16_f32 %0, %1, %2" : "=v"(r) : "v"(lo), "v"(hi)); return r;
}
__device__ __forceinline__ bf16x8 pack8(f32x4 a, f32x4 b) {
    u32x4 w = {cvtpk(a[0], a[1]), cvtpk(a[2], a[3]), cvtpk(b[0], b[1]), cvtpk(b[2], b[3])};
    return *reinterpret_cast<bf16x8*>(&w);
}
template <class T> __device__ __forceinline__ bf16x8 load8(const T* p) {
    if constexpr (same_t<T, float>::v) { return pack8(*(const f32x4*)p, *(const f32x4*)(p + 4)); }
    else { return *reinterpret_cast<const bf16x8*>(p); }
}
__device__ __forceinline__ void mask_tile(f32x16& p0, f32x16& p1, int dq, unsigned W) {
    const float NEG = -__builtin_inff();
#pragma unroll
    for (int r = 0; r < 16; ++r) {
        const int c = (r & 3) + 8 * (r >> 2);
        if ((unsigned)(dq - c) >= W) p0[r] = NEG;
        if ((unsigned)(dq - c - 32) >= W) p1[r] = NEG;
    }
}
__device__ __forceinline__ void partialSM(f32x16& p0, f32x16& p1, float& m_reg, float& mn, float& alpha) {
    float pmax = p0[0]; for (int r = 1; r < 16; ++r) pmax = fmaxf(pmax, p0[r]); for (int r = 0; r < 16; ++r) pmax = fmaxf(pmax, p1[r]);
    { auto rr = __builtin_amdgcn_permlane32_swap(__float_as_uint(pmax), __float_as_uint(pmax), false, false);
      pmax = fmaxf(__uint_as_float(rr[0]), __uint_as_float(rr[1])); }
    constexpr float C2 = 1.4426950408889634f * SCALE;
    if (__builtin_expect(__all((pmax - m_reg) * SCALE <= THR), 1)) { mn = m_reg; alpha = 1.f; }
    else { mn = fmaxf(m_reg, pmax); alpha = __builtin_amdgcn_exp2f((m_reg - mn) * C2); m_reg = mn; }
    const float mnL = -mn * C2;
    for (int r = 0; r < 16; ++r) p0[r] = fmaf(p0[r], C2, mnL); for (int r = 0; r < 16; ++r) p1[r] = fmaf(p1[r], C2, mnL);
    for (int r = 0; r < 16; ++r) p0[r] = __builtin_amdgcn_exp2f(p0[r]);
}
__device__ __forceinline__ void finishSM(f32x16& p0, f32x16& p1, float alpha, float& l_reg, bf16x8& pa0, bf16x8& pa1, bf16x8& pa2, bf16x8& pa3) {
    for (int r = 0; r < 16; ++r) p1[r] = __builtin_amdgcn_exp2f(p1[r]);
    float ps = 0; for (int r = 0; r < 16; ++r) ps += p0[r]; for (int r = 0; r < 16; ++r) ps += p1[r];
    { auto rr = __builtin_amdgcn_permlane32_swap(__float_as_uint(ps), __float_as_uint(ps), false, false);
      ps = __uint_as_float(rr[0]) + __uint_as_float(rr[1]); }
    l_reg = l_reg * alpha + ps;
#define PK4(P, B_, OUT) do { unsigned a0 = cvtpk(P[B_+0], P[B_+1]), a1 = cvtpk(P[B_+2], P[B_+3]);                          \
        unsigned b0 = cvtpk(P[B_+4], P[B_+5]), b1 = cvtpk(P[B_+6], P[B_+7]);                                             \
        auto r0 = __builtin_amdgcn_permlane32_swap(a0, b0, false, false); auto r1 = __builtin_amdgcn_permlane32_swap(a1, b1, false, false); \
        u32x4 w = {r0[0], r1[0], r0[1], r1[1]}; OUT = *reinterpret_cast<bf16x8*>(&w); } while (0)
    PK4(p0, 0, pa0); PK4(p0, 8, pa1); PK4(p1, 0, pa2); PK4(p1, 8, pa3);
#undef PK4
}
template <int KB, bool SK>
__device__ __forceinline__ void qkt(f32x16& p0, f32x16& p1, const char* K_lds, int r32, int hi, const bf16x8* qr, bool act, const float* bias_t) {
    if (SK && !act) { const float NEG = -__builtin_inff();
#pragma unroll
        for (int r = 0; r < 16; ++r) { p0[r] = NEG; p1[r] = NEG; } return; }
    {
#pragma unroll
        for (int g_ = 0; g_ < 4; ++g_) { const f32x4 b0_ = *(const f32x4*)(bias_t + 8 * g_ + 4 * hi); const f32x4 b1_ = *(const f32x4*)(bias_t + 32 + 8 * g_ + 4 * hi);
            p0[4 * g_] = b0_[0]; p0[4 * g_ + 1] = b0_[1]; p0[4 * g_ + 2] = b0_[2]; p0[4 * g_ + 3] = b0_[3];
            p1[4 * g_] = b1_[0]; p1[4 * g_ + 1] = b1_[1]; p1[4 * g_ + 2] = b1_[2]; p1[4 * g_ + 3] = b1_[3]; } }
    const char* kb[4];
#pragma unroll
    for (int dd = 0; dd < 4; ++dd) kb[dd] = K_lds + KB * SHM_K + KSWZ(r32, (dd * 16 + hi * 8) * 2);
#pragma unroll
    for (int d0 = 0; d0 < 8; ++d0) { const char* a = kb[d0 & 3] + (d0 >> 2) * 128;
        bf16x8 b0 = *reinterpret_cast<const bf16x8*>(a);
        bf16x8 b1 = *reinterpret_cast<const bf16x8*>(a + 32 * 256);
        p0 = __builtin_amdgcn_mfma_f32_32x32x16_bf16(b0, qr[d0], p0, 0, 0, 0);
        p1 = __builtin_amdgcn_mfma_f32_32x32x16_bf16(b1, qr[d0], p1, 0, 0, 0); }
}
template <int VB, bool SK>
__device__ __forceinline__ void pv_tile(f32x16* o, int vb0, bf16x8 pa0, bf16x8 pa1, bf16x8 pa2, bf16x8 pa3, bool act) {
    if (SK && !act) return;
#define TRRD(dst, off) asm volatile("ds_read_b64_tr_b16 %0, %1 offset:%2" : "=&v"(dst) : "v"(vb0), "i"(off) : "memory")
#define PV_D0(d0) do { s16x4 l0, l1, l2, l3, h0, h1, h2, h3; constexpr int b_ = VB * SHM_V + v_rd_off(d0, 0, 0);     \
        TRRD(l0, b_); TRRD(h0, b_ + 2048); TRRD(l1, b_ + 4096); TRRD(h1, b_ + 6144); TRRD(l2, b_ + 8192); TRRD(h2, b_ + 10240); TRRD(l3, b_ + 12288); TRRD(h3, b_ + 14336); \
        asm volatile("s_waitcnt lgkmcnt(0)" ::: "memory"); SBAR();                 \
        o[d0] = __builtin_amdgcn_mfma_f32_32x32x16_bf16(pa0, (bf16x8){l0[0], l0[1], l0[2], l0[3], h0[0], h0[1], h0[2], h0[3]}, o[d0], 0, 0, 0);   \
        o[d0] = __builtin_amdgcn_mfma_f32_32x32x16_bf16(pa1, (bf16x8){l1[0], l1[1], l1[2], l1[3], h1[0], h1[1], h1[2], h1[3]}, o[d0], 0, 0, 0);   \
        o[d0] = __builtin_amdgcn_mfma_f32_32x32x16_bf16(pa2, (bf16x8){l2[0], l2[1], l2[2], l2[3], h2[0], h2[1], h2[2], h2[3]}, o[d0], 0, 0, 0);   \
        o[d0] = __builtin_amdgcn_mfma_f32_32x32x16_bf16(pa3, (bf16x8){l3[0], l3[1], l3[2], l3[3], h3[0], h3[1], h3[2], h3[3]}, o[d0], 0, 0, 0); } while (0)
    PV_D0(0); PV_D0(1); PV_D0(2); PV_D0(3);
#undef PV_D0
#undef TRRD
}

template <class TIn, class TOut> struct BlockRef { const TIn* Q; const TIn* K; const TIn* V; TOut* O; int P0; };
template <class TIn> struct Seam {
    bf16x8 qr[8];
    bf16x8 st_v0, st_v1, st_k0, st_k1; f32x4 sf0, sf1, sf2, sf3;
    f32x4 tq[16];
};
__device__ __forceinline__ int swa_jlo(int P0, int W) { const int lowk = P0 - W + 1; return lowk > 0 ? lowk / KVBLK : 0; }
#define ROW(p, k0, rr) ((p) + (size_t)((k0) + (rr)) * LDK + sc)
#define VMW() asm volatile("s_waitcnt vmcnt(0)" ::: "memory")
#define VMWN(n) asm volatile("s_waitcnt vmcnt(%0)" :: "i"(n) : "memory")
#define SLOAD_H(Kp, Vp, k0) do { S.st_v0 = load8<TIn>(ROW(Vp, k0, sr)); S.st_v1 = load8<TIn>(ROW(Vp, k0, 32 + sr));              \
                         S.st_k0 = load8<TIn>(ROW(Kp, k0, sr)); S.st_k1 = load8<TIn>(ROW(Kp, k0, 32 + sr)); } while (0)
#define SWRITE_HK(bf) do { *(bf16x8*)(K_lds + (bf) * SHM_K + kws) = S.st_k0; *(bf16x8*)(K_lds + (bf) * SHM_K + kws + 32 * 256) = S.st_k1; } while (0)
#define SWRITE_HV(bf) do { *(bf16x8*)(V_lds + (bf) * SHM_V + vst0) = S.st_v0; *(bf16x8*)(V_lds + (bf) * SHM_V + vst1) = S.st_v1; } while (0)
#define SWRITE_H(bf) do { SWRITE_HV(bf); SWRITE_HK(bf); } while (0)
#define SLOAD_F(p, k0) do { S.sf0 = *(const f32x4*)ROW(p, k0, sr); S.sf1 = *(const f32x4*)(ROW(p, k0, sr) + 4);                \
                            S.sf2 = *(const f32x4*)ROW(p, k0, 32 + sr); S.sf3 = *(const f32x4*)(ROW(p, k0, 32 + sr) + 4); } while (0)
#define SWRITE_KF(bf) do { *(bf16x8*)(K_lds + (bf) * SHM_K + kws) = pack8(S.sf0, S.sf1); *(bf16x8*)(K_lds + (bf) * SHM_K + kws + 32 * 256) = pack8(S.sf2, S.sf3); } while (0)
#define SWRITE_VF(bf) do { *(bf16x8*)(V_lds + (bf) * SHM_V + vst0) = pack8(S.sf0, S.sf1); *(bf16x8*)(V_lds + (bf) * SHM_V + vst1) = pack8(S.sf2, S.sf3); } while (0)
template <class TIn, class TOut>
__device__ __forceinline__ void causal_swa_prime(const BlockRef<TIn, TOut>& cur, int W, char* lds, Seam<TIn>& S) {
    constexpr bool F32 = same_t<TIn, float>::v;
    const int tid = ltid(), wid = __builtin_amdgcn_readfirstlane(tid >> 6), lane = tid & 63, r32 = lane & 31, hi = lane >> 5;
    const int sr = tid >> 4, sc = (tid & 15) * 8, kws = KSWZ(sr, sc * 2); char* K_lds = lds + 2 * SHM_V;
    const int kb0 = swa_jlo(cur.P0, W) * KVBLK;
    for (int d0 = 0; d0 < 8; ++d0) S.qr[d0] = load8<TIn>(cur.Q + (size_t)(wid * QBLK + r32) * LDQ + d0 * 16 + hi * 8);
    if constexpr (F32) { SLOAD_F((const float*)cur.K, kb0); VMW(); SWRITE_KF(0); SBAR(); SLOAD_F((const float*)cur.V, kb0); }
    else { SLOAD_H(cur.K, cur.V, kb0); VMW(); SWRITE_HK(0); }
    __syncthreads();
}
template <class TIn, class TOut>
__device__ __forceinline__ void causal_swa_block(const BlockRef<TIn, TOut>& cur, const BlockRef<TIn, TOut>& nxt, int skv, int W, char* lds, Seam<TIn>& S, const float* bias_l) {
    constexpr bool F32 = same_t<TIn, float>::v;
    const int tid = ltid(), wid = __builtin_amdgcn_readfirstlane(tid >> 6), lane = tid & 63, r32 = lane & 31, hi = lane >> 5;
    const int j_lo = swa_jlo(cur.P0, W);
    int j_hi = (cur.P0 + QB - 1) / KVBLK + 1; if (j_hi > skv / KVBLK) j_hi = skv / KVBLK;
    const int NT = j_hi - j_lo;
    const int kbn = swa_jlo(nxt.P0, W) * KVBLK;
    const int qlo = cur.P0 + wid * QBLK, qm = qlo + r32 - 4 * hi;
    char* V_lds = lds; char* K_lds = lds + 2 * SHM_V;
    float* ws = (float*)(lds + 2 * SHM_V + 2 * SHM_K) + wid * 64; float* li_l = ws, * al_l = ws + 32;
    float m_reg = -1e30f, l_reg = 0; f32x16 o[4] = {};
    const int sr = tid >> 4, sc = (tid & 15) * 8, vst0 = v_st(sr, sc), vst1 = v_st(32 + sr, sc), kws = KSWZ(sr, sc * 2);
    const int vb0 = (int)(uintptr_t)V_lds + v_rd_base(lane);
    const TIn* Kh = cur.K; const TIn* Vh = cur.V;
#define RESC(a) do { if (__any((a) < 1.f)) { if (hi == 0) al_l[r32] = (a); asm volatile("s_waitcnt lgkmcnt(0)" ::: "memory");              \
                     for (int d_ = 0; d_ < 4; ++d_) for (int r = 0; r < 16; ++r) o[d_][r] *= al_l[crow(r, hi)]; } } while (0)
#define KBASE(t) ((j_lo + (t)) * KVBLK)
#define ACT(t) (KBASE(t) <= qlo + QBLK - 1 && KBASE(t) + KVBLK - 1 >= qlo - W + 1)
#define MASKT(P0_, P1_, t) do { const int kb_ = KBASE(t); if ((!SK || ACT(t)) && (kb_ + KVBLK - 1 > qlo || kb_ <= qlo + QBLK - 1 - W)) mask_tile(P0_, P1_, qm - kb_, (unsigned)W); } while (0)
    constexpr int NQL = F32 ? 16 : 8;
    constexpr bool SK = WSKIP && !F32;
#define SEAM_K0() do { VMWN(NQL); if constexpr (F32) { SWRITE_KF(0); SBAR(); SLOAD_F((const float*)nxt.V, kbn); } else { SWRITE_HK(0); } SBAR(); } while (0)
    f32x16 pA0, pA1, pB0, pB1; float mnA, mnB, alA, alB; bf16x8 pa0, pa1, pa2, pa3;
    if constexpr (F32) { VMW(); SWRITE_VF(0); SBAR(); } else { SWRITE_HV(0); SBAR(); }
    if (NT > 1) { if constexpr (F32) SLOAD_F((const float*)Kh, KBASE(1)); else SLOAD_H(Kh, Vh, KBASE(1)); }
    SBAR(); qkt<0, SK>(pA0, pA1, K_lds, r32, hi, S.qr, ACT(0), bias_l + KBASE(0));
    if constexpr (F32) { if (NT > 1) { VMW(); SWRITE_KF(1); SBAR(); SLOAD_F((const float*)Vh, KBASE(1)); } }
    MASKT(pA0, pA1, 0); partialSM(pA0, pA1, m_reg, mnA, alA);
    if (NT > 1) { VMW(); if constexpr (F32) { SWRITE_VF(1); SBAR(); if (NT > 2) SLOAD_F((const float*)Kh, KBASE(2)); } else SWRITE_H(1); }
    __syncthreads();
#define HALF_STEP(PX0, PX1, mnX, alX, PY0, PY1, alY, t, KB, VB, SB) do {                                                      \
        SBAR(); qkt<KB, SK>(PX0, PX1, K_lds, r32, hi, S.qr, ACT(t), bias_l + KBASE(t));                                             \
        finishSM(PY0, PY1, alY, l_reg, pa0, pa1, pa2, pa3); SBAR();                                                           \
        if ((t) + 1 < NT) { if constexpr (F32) { VMW(); SWRITE_KF(SB); SBAR(); SLOAD_F((const float*)Vh, KBASE((t) + 1)); }  \
                            else { SLOAD_H(Kh, Vh, KBASE((t) + 1)); } SBAR(); }                                               \
        pv_tile<VB, SK>(o, vb0, pa0, pa1, pa2, pa3, ACT((t) - 1)); MASKT(PX0, PX1, (t)); partialSM(PX0, PX1, m_reg, mnX, alX);                                        \
        __syncthreads();                                                                                                      \
        if ((t) + 1 < NT) { VMW(); if constexpr (F32) { SWRITE_VF(SB); SBAR(); if ((t) + 2 < NT) SLOAD_F((const float*)Kh, KBASE((t) + 2)); } \
                            else { SWRITE_H(SB); } }                                                                          \
        RESC(alX); __syncthreads(); } while (0)
    for (int t = 1; t + 1 < NT; t += 2) {
        HALF_STEP(pB0, pB1, mnB, alB, pA0, pA1, alA, t, 1, 0, 0);
        HALF_STEP(pA0, pA1, mnA, alA, pB0, pB1, alB, t + 1, 0, 1, 1);
    }
    const bool even = (NT & 1) == 0;
    if (even) { SBAR(); qkt<1, SK>(pB0, pB1, K_lds, r32, hi, S.qr, ACT(NT - 1), bias_l + KBASE(NT - 1)); SBAR(); }
#define QROW(e) (nxt.Q + (size_t)(wid * QBLK + r32) * LDQ + ((e) >> 1) * 16 + hi * 8 + ((e) & 1) * 4)
    if constexpr (F32) { SLOAD_F((const float*)nxt.K, kbn); SBAR();
#pragma unroll
        for (int e = 0; e < 8; ++e) S.tq[e] = *(const f32x4*)QROW(e); }
    else { SLOAD_H(nxt.K, nxt.V, kbn); SBAR();
#pragma unroll
        for (int d0 = 0; d0 < 8; ++d0) S.qr[d0] = load8<TIn>(nxt.Q + (size_t)(wid * QBLK + r32) * LDQ + d0 * 16 + hi * 8); }
    SBAR();
    finishSM(pA0, pA1, alA, l_reg, pa0, pa1, pa2, pa3); SBAR();
    if constexpr (F32) {
#pragma unroll
        for (int e = 8; e < 16; ++e) S.tq[e] = *(const f32x4*)QROW(e); SBAR(); }
#undef QROW
    pv_tile<0, SK>(o, vb0, pa0, pa1, pa2, pa3, ACT(even ? NT - 2 : NT - 1));
    if (even) { MASKT(pB0, pB1, NT - 1); partialSM(pB0, pB1, m_reg, mnB, alB); __syncthreads(); RESC(alB);
        finishSM(pB0, pB1, alB, l_reg, pa0, pa1, pa2, pa3); SBAR(); pv_tile<1, SK>(o, vb0, pa0, pa1, pa2, pa3, ACT(NT - 1)); }
    SBAR(); SEAM_K0();
    if (hi == 0) li_l[r32] = l_reg; asm volatile("s_waitcnt lgkmcnt(0)" ::: "memory");
    float rli[16];
#pragma unroll
    for (int r = 0; r < 16; ++r) rli[r] = __builtin_amdgcn_rcpf(li_l[crow(r, hi)]);
    TOut* Ow = cur.O + (size_t)(wid * QBLK) * LDO;
#pragma unroll
    for (int r = 0; r < 16; ++r) { const int orow = crow(r, hi);
#pragma unroll
        for (int d0 = 0; d0 < 4; ++d0) { const float v = o[d0][r] * rli[r];
            if constexpr (same_t<TOut, float>::v) { Ow[(size_t)orow * LDO + d0 * 32 + r32] = v; }
            else { const float vn = __shfl_xor(v, 1);
                   if ((r32 & 1) == 0) *(unsigned*)(Ow + (size_t)orow * LDO + d0 * 32 + r32) = cvtpk(v, vn); } } }
    if constexpr (F32) {
#pragma unroll
        for (int d0 = 0; d0 < 8; ++d0) S.qr[d0] = pack8(S.tq[2 * d0], S.tq[2 * d0 + 1]); }
    __syncthreads();
#undef RESC
#undef KBASE
#undef ACT
#undef MASKT
#undef SEAM_K0
#undef HALF_STEP
}
#undef ROW
#undef VMW
#undef VMWN
#undef SLOAD_H
#undef SWRITE_HK
#undef SWRITE_HV
#undef SWRITE_H
#undef SLOAD_F
#undef SWRITE_KF

}

__device__ __forceinline__ void fox_bias(PP P, int l, int b, int h, float* bias, float* scr) {
    using namespace cfg;
    const int tid = ltid(), lane = tid & 63, wave = tid >> 6;
    const float* PS = (const float*)(P->ws + WS_PS); const float bf = P->in[I_BF][l * FNH + h];
    float lf[9]; float loc = 0.f;
#pragma unroll
    for (int i = 0; i < 9; ++i) { const int pos = tid * 9 + i; float v = 0.f;
        if (pos < NMETA + SEQ) { const int row = pos < NMETA ? MMAIN + pos : b * SEQ + pos - NMETA; const float z = PS[(size_t)row * PSW + 288 + h] + bf;
            v = fminf(z, 0.f) - log1pf(__expf(-fabsf(z))); }
        loc += v; lf[i] = loc; }
    float inc = loc;
#pragma unroll
    for (int o = 1; o < 64; o <<= 1) { const float t = __shfl_up(inc, o); if (lane >= o) inc += t; }
    if (lane == 63) scr[wave] = inc;
    __syncthreads();
    float base = inc - loc;
    for (int w = 0; w < wave; ++w) base += scr[w];
    constexpr float INV = 1.0f / fox::SCALE;
#pragma unroll
    for (int i = 0; i < 9; ++i) { const int pos = tid * 9 + i; if (pos < NMETA + SEQ) bias[48 + pos] = -(base + lf[i]) * INV; }
    if (tid < 48) bias[tid] = -__builtin_inff();
    __syncthreads();
}
__device__ __forceinline__ void fox_meta(PP P, int h, const float* bias) {
    using namespace cfg;
    const int lane = ltid() & 63, wave = ltid() >> 6;
    const bf16_t* QKV = (const bf16_t*)(P->ws + WS_QKV); bf16_t* Y = (bf16_t*)(P->ws + WS_Y);
    for (int rep = 0; rep < 2; ++rep) { const int i = wave + 8 * rep;
        float s = -__builtin_inff();
        if (lane <= i) { const bf16_t* q = QKV + (size_t)(48 + i) * QKVW + h * 128; const bf16_t* k = QKV + (size_t)(48 + lane) * QKVW + 1024 + h * 128; float dot = 0.f;
            for (int d = 0; d < 128; ++d) dot += bf2f(q[d]) * bf2f(k[d]);
            s = (dot + bias[48 + lane]) * fox::SCALE; }
        const float m = wave_max(s); const float p = (lane <= i) ? __expf(s - m) : 0.f; const float lsum = wave_sum(p);
        float o0 = 0.f, o1 = 0.f;
        for (int j = 0; j <= i; ++j) { const float pj = __shfl(p, j); const bf16_t* v = QKV + (size_t)(48 + j) * QKVW + 2048 + h * 128; o0 += pj * bf2f(v[lane]); o1 += pj * bf2f(v[64 + lane]); }
        const float il = 1.0f / lsum;
        Y[(size_t)(MMAIN + i) * DM + 1024 + h * 128 + lane] = (bf16_t)(pk_bf16(o0 * il, 0.f) & 0xffffu);
        Y[(size_t)(MMAIN + i) * DM + 1024 + h * 128 + 64 + lane] = (bf16_t)(pk_bf16(o1 * il, 0.f) & 0xffffu); }
}
__device__ __forceinline__ fox::BlockRef<__hip_bfloat16, __hip_bfloat16> fox_mk(int a, int idx, const __hip_bfloat16* Qb, const __hip_bfloat16* Kb, const __hip_bfloat16* Vb, __hip_bfloat16* Ob) {
    const int pr = 4 * (a & 1) + (idx >> 1); const int x = (idx & 1) ? 15 - pr : pr;
    fox::BlockRef<__hip_bfloat16, __hip_bfloat16> r; r.Q = Qb + (size_t)x * 256 * cfg::QKVW; r.K = Kb; r.V = Vb; r.O = Ob + (size_t)x * 256 * cfg::DM; r.P0 = 64 + 256 * x; return r; }
__device__ __forceinline__ void fox_wg(PP P, int l, int a, char* lds) {
    using namespace cfg;
    typedef __hip_bfloat16 bf;
    const int bh = a >> 1, b = bh >> 3, h = bh & 7;
    float* bias = (float*)(lds + fox::BIAS_OFF); float* scr = (float*)(lds + fox::SCAN_OFF);
    fox_bias(P, l, b, h, bias, scr);
    const bf* QKV = (const bf*)(P->ws + WS_QKV); bf* Y = (bf*)(P->ws + WS_Y);
    const bf* Kb = QKV + (size_t)b * SEQP * QKVW + 1024 + h * 128; const bf* Vb = Kb + 1024; const bf* Qb = QKV + ((size_t)b * SEQP + 64) * QKVW + h * 128;
    bf* Ob = Y + (size_t)b * SEQ * DM + 1024 + h * 128;
    constexpr int W = 1 << 30;
    fox::Seam<bf> S;
    fox::BlockRef<bf, bf> cur = fox_mk(a, 0, Qb, Kb, Vb, Ob);
    fox::causal_swa_prime<bf, bf>(cur, W, lds, S);
#pragma unroll 1
    for (int idx = 0; idx < 8; ++idx) {
        const fox::BlockRef<bf, bf> nxt = (idx < 7) ? fox_mk(a, idx + 1, Qb, Kb, Vb, Ob) : cur;
        fox::causal_swa_block<bf, bf>(cur, nxt, SEQP, W, lds, S, bias);
        cur = nxt;
    }
    if (b == 0) fox_meta(P, h, bias);
}

#define WS_PTR(T, off) ((T*)(Q->ws + (off)))
#define SEAM() do { PP Qb_ = launder(P); XcdBarrier b_; b_.bar = (unsigned*)(Qb_->ws + WS_CTL); b_.x = xb_xcc_id(); b_.st = (volatile LAS unsigned*)(lds + LDS_BARW); xcd_barrier(b_); } while (0)
__global__ void __launch_bounds__(512, 2) hymba_fwd(Params Pv) {
    using namespace cfg;
    PP P = (PP)__builtin_amdgcn_kernarg_segment_ptr();
    extern __shared__ __attribute__((aligned(16))) unsigned char lds_raw[];
    LAS unsigned char* lds = (LAS unsigned char*)lds_raw;
    if (threadIdx.x < 4) ((LAS unsigned*)(lds + LDS_BARW))[threadIdx.x] = 0u;
    __syncthreads();
    { PP Q = launder(P); (void)xcd_barrier_post((unsigned*)(Q->ws + WS_CTL), (volatile LAS unsigned*)(lds + LDS_BARW)); }

    { PP Q = launder(P); phase_convert(Q, lds, 0, 1, lbid(), (int)gridDim.x); phase_init(Q); }
    SEAM();
    {
        PP Q = launder(P); const unsigned char* wl = Q->ws + WS_W + (size_t)0 * W_LAYER;
        pg8::Gemm g{WS_PTR(const bf16_t, WS_HB), (const bf16_t*)(wl + WO_GU1), MMAIN, NGU, DM}; pg8::StaticOrder S; S.init(MMAIN, NGU, (int)gridDim.x, lbid());
        pg8::EpiGU E{WS_PTR(bf16_t, WS_ACT), WS_PTR(const float, WS_SS) + (size_t)(0) * 8 * MROWS, (LAS float*)(lds + 131072 + 4096)};
        pg8::gemm_phase<pg8::EpiGU, pg8::StaticOrder, true, true>(lds, g, S, E);
        skinny_gu(WS_PTR(const bf16_t, WS_HB), g.Bt, WS_PTR(const float, WS_SSM) + (0) * 2048, WS_PTR(bf16_t, WS_ACT), lds);
    }
    SEAM();
    {
        PP Q = launder(P); const unsigned char* wl = Q->ws + WS_W + (size_t)0 * W_LAYER;
        pg8::Gemm g{WS_PTR(const bf16_t, WS_ACT), (const bf16_t*)(wl + WO_D1), MMAIN, DM, DFF}; pg8::StaticOrder S; S.init(MMAIN, DM, (int)gridDim.x, lbid());
        pg8::EpiRes E{WS_PTR(bf16_t, WS_HB), WS_PTR(float, WS_SS) + (size_t)(1) * 8 * MROWS, 0.5f, (LAS float*)(lds + 131072)};
        pg8::gemm_phase<pg8::EpiRes, pg8::StaticOrder, true, true>(lds, g, S, E);
        skinny_res(WS_PTR(const bf16_t, WS_ACT) + (size_t)MMAIN * DFF, DFF, g.Bt, WS_PTR(bf16_t, WS_HB), WS_PTR(float, WS_SSM) + (1) * 2048, 0.5f, lds);
    }
    SEAM();
    {
        PP Q = launder(P); const unsigned char* wl = Q->ws + WS_W + (size_t)0 * W_LAYER;
        pg8::Gemm g{WS_PTR(const bf16_t, WS_HB), (const bf16_t*)(wl + WO_IN), MMAIN, NIN, DM}; pg8::StaticOrder S; S.init(MMAIN, NIN, (int)gridDim.x, lbid());
        pg8::EpiP E{WS_PTR(bf16_t, WS_PR), WS_PTR(float, WS_PS), WS_PTR(bf16_t, WS_QKV), WS_PTR(const float, WS_SS) + (size_t)(1) * 8 * MROWS, (LAS float*)(lds + 131072 + 4096)};
        pg8::gemm_phase<pg8::EpiP, pg8::StaticOrder, true, true>(lds, g, S, E);
        skinny_p(WS_PTR(const bf16_t, WS_HB), g.Bt, WS_PTR(const float, WS_SSM) + (1) * 2048, WS_PTR(bf16_t, WS_PR), WS_PTR(float, WS_PS), WS_PTR(bf16_t, WS_QKV), lds);
    }
    SEAM();
    { PP Q = launder(P); phase_lx(Q, 0); }
    SEAM();
    {
        PP Q = launder(P); const int u = lbid();
        if (u < 128) { rwkv_chunked(Q, 0, u >> 4, u & 15, lds); __syncthreads(); phase_convert(launder(P), lds, 1, 2, u, 128, 17024, 21248); }
        else { fox_wg(Q, 0, u - 128, (char*)lds_raw); __syncthreads(); phase_convert(launder(P), lds, 1, 2, u - 128, 128, 0, 17024); }
    }
    SEAM();
    { PP Q = launder(P); phase_foxnorm(Q); }
    SEAM();
    {
        PP Q = launder(P); const unsigned char* wl = Q->ws + WS_W + (size_t)0 * W_LAYER;
        pg8::Gemm g{WS_PTR(const bf16_t, WS_Y), (const bf16_t*)(wl + WO_OUT), MMAIN, DM, DM}; pg8::StaticOrder S; S.init(MMAIN, DM, (int)gridDim.x, lbid());
        pg8::EpiRes E{WS_PTR(bf16_t, WS_HB), WS_PTR(float, WS_SS) + (size_t)(2) * 8 * MROWS, 1.0f, (LAS float*)(lds + 131072)};
        pg8::gemm_phase<pg8::EpiRes, pg8::StaticOrder, true, true>(lds, g, S, E);
        skinny_res(WS_PTR(const bf16_t, WS_Y) + (size_t)MMAIN * DM, DM, g.Bt, WS_PTR(bf16_t, WS_HB), WS_PTR(float, WS_SSM) + (2) * 2048, 1.0f, lds);
    }
    SEAM();
    {
        PP Q = launder(P); const unsigned char* wl = Q->ws + WS_W + (size_t)0 * W_LAYER;
        pg8::Gemm g{WS_PTR(const bf16_t, WS_HB), (const bf16_t*)(wl + WO_GU2), MMAIN, NGU, DM}; pg8::StaticOrder S; S.init(MMAIN, NGU, (int)gridDim.x, lbid());
        pg8::EpiGU E{WS_PTR(bf16_t, WS_ACT), WS_PTR(const float, WS_SS) + (size_t)(2) * 8 * MROWS, (LAS float*)(lds + 131072 + 4096)};
        pg8::gemm_phase<pg8::EpiGU, pg8::StaticOrder, true, true>(lds, g, S, E);
        skinny_gu(WS_PTR(const bf16_t, WS_HB), g.Bt, WS_PTR(const float, WS_SSM) + (2) * 2048, WS_PTR(bf16_t, WS_ACT), lds);
    }
    SEAM();
    {
        PP Q = launder(P); const unsigned char* wl = Q->ws + WS_W + (size_t)0 * W_LAYER;
        pg8::Gemm g{WS_PTR(const bf16_t, WS_ACT), (const bf16_t*)(wl + WO_D2), MMAIN, DM, DFF}; pg8::StaticOrder S; S.init(MMAIN, DM, (int)gridDim.x, lbid());
        pg8::EpiRes E{WS_PTR(bf16_t, WS_HB), WS_PTR(float, WS_SS) + (size_t)(3) * 8 * MROWS, 0.5f, (LAS float*)(lds + 131072)};
        pg8::gemm_phase<pg8::EpiRes, pg8::StaticOrder, true, true>(lds, g, S, E);
        skinny_res(WS_PTR(const bf16_t, WS_ACT) + (size_t)MMAIN * DFF, DFF, g.Bt, WS_PTR(bf16_t, WS_HB), WS_PTR(float, WS_SSM) + (3) * 2048, 0.5f, lds);
    }
    SEAM();
    {
        PP Q = launder(P); const unsigned char* wl = Q->ws + WS_W + (size_t)1 * W_LAYER;
        pg8::Gemm g{WS_PTR(const bf16_t, WS_HB), (const bf16_t*)(wl + WO_GU1), MMAIN, NGU, DM}; pg8::StaticOrder S; S.init(MMAIN, NGU, (int)gridDim.x, lbid());
        pg8::EpiGU E{WS_PTR(bf16_t, WS_ACT), WS_PTR(const float, WS_SS) + (size_t)(3) * 8 * MROWS, (LAS float*)(lds + 131072 + 4096)};
        pg8::gemm_phase<pg8::EpiGU, pg8::StaticOrder, true, true>(lds, g, S, E);
        skinny_gu(WS_PTR(const bf16_t, WS_HB), g.Bt, WS_PTR(const float, WS_SSM) + (3) * 2048, WS_PTR(bf16_t, WS_ACT), lds);
    }
    SEAM();
    {
        PP Q = launder(P); const unsigned char* wl = Q->ws + WS_W + (size_t)1 * W_LAYER;
        pg8::Gemm g{WS_PTR(const bf16_t, WS_ACT), (const bf16_t*)(wl + WO_D1), MMAIN, DM, DFF}; pg8::StaticOrder S; S.init(MMAIN, DM, (int)gridDim.x, lbid());
        pg8::EpiRes E{WS_PTR(bf16_t, WS_HB), WS_PTR(float, WS_SS) + (size_t)(4) * 8 * MROWS, 0.5f, (LAS float*)(lds + 131072)};
        pg8::gemm_phase<pg8::EpiRes, pg8::StaticOrder, true, true>(lds, g, S, E);
        skinny_res(WS_PTR(const bf16_t, WS_ACT) + (size_t)MMAIN * DFF, DFF, g.Bt, WS_PTR(bf16_t, WS_HB), WS_PTR(float, WS_SSM) + (4) * 2048, 0.5f, lds);
    }
    SEAM();
    {
        PP Q = launder(P); const unsigned char* wl = Q->ws + WS_W + (size_t)1 * W_LAYER;
        pg8::Gemm g{WS_PTR(const bf16_t, WS_HB), (const bf16_t*)(wl + WO_IN), MMAIN, NIN, DM}; pg8::StaticOrder S; S.init(MMAIN, NIN, (int)gridDim.x, lbid());
        pg8::EpiP E{WS_PTR(bf16_t, WS_PR), WS_PTR(float, WS_PS), WS_PTR(bf16_t, WS_QKV), WS_PTR(const float, WS_SS) + (size_t)(4) * 8 * MROWS, (LAS float*)(lds + 131072 + 4096)};
        pg8::gemm_phase<pg8::EpiP, pg8::StaticOrder, true, true>(lds, g, S, E);
        skinny_p(WS_PTR(const bf16_t, WS_HB), g.Bt, WS_PTR(const float, WS_SSM) + (4) * 2048, WS_PTR(bf16_t, WS_PR), WS_PTR(float, WS_PS), WS_PTR(bf16_t, WS_QKV), lds);
    }
    SEAM();
    { PP Q = launder(P); phase_lx(Q, 1); }
    SEAM();
    {
        PP Q = launder(P); const int u = lbid();
        if (u < 128) { rwkv_chunked(Q, 1, u >> 4, u & 15, lds); __syncthreads(); phase_convert(launder(P), lds, 2, 3, u, 128, 17024, 21248); }
        else { fox_wg(Q, 1, u - 128, (char*)lds_raw); __syncthreads(); phase_convert(launder(P), lds, 2, 3, u - 128, 128, 0, 17024); }
    }
    SEAM();
    { PP Q = launder(P); phase_foxnorm(Q); }
    SEAM();
    {
        PP Q = launder(P); const unsigned char* wl = Q->ws + WS_W + (size_t)1 * W_LAYER;
        pg8::Gemm g{WS_PTR(const bf16_t, WS_Y), (const bf16_t*)(wl + WO_OUT), MMAIN, DM, DM}; pg8::StaticOrder S; S.init(MMAIN, DM, (int)gridDim.x, lbid());
        pg8::EpiRes E{WS_PTR(bf16_t, WS_HB), WS_PTR(float, WS_SS) + (size_t)(5) * 8 * MROWS, 1.0f, (LAS float*)(lds + 131072)};
        pg8::gemm_phase<pg8::EpiRes, pg8::StaticOrder, true, true>(lds, g, S, E);
        skinny_res(WS_PTR(const bf16_t, WS_Y) + (size_t)MMAIN * DM, DM, g.Bt, WS_PTR(bf16_t, WS_HB), WS_PTR(float, WS_SSM) + (5) * 2048, 1.0f, lds);
    }
    SEAM();
    {
        PP Q = launder(P); const unsigned char* wl = Q->ws + WS_W + (size_t)1 * W_LAYER;
        pg8::Gemm g{WS_PTR(const bf16_t, WS_HB), (const bf16_t*)(wl + WO_GU2), MMAIN, NGU, DM}; pg8::StaticOrder S; S.init(MMAIN, NGU, (int)gridDim.x, lbid());
        pg8::EpiGU E{WS_PTR(bf16_t, WS_ACT), WS_PTR(const float, WS_SS) + (size_t)(5) * 8 * MROWS, (LAS float*)(lds + 131072 + 4096)};
        pg8::gemm_phase<pg8::EpiGU, pg8::StaticOrder, true, true>(lds, g, S, E);
        skinny_gu(WS_PTR(const bf16_t, WS_HB), g.Bt, WS_PTR(const float, WS_SSM) + (5) * 2048, WS_PTR(bf16_t, WS_ACT), lds);
    }
    SEAM();
    {
        PP Q = launder(P); const unsigned char* wl = Q->ws + WS_W + (size_t)1 * W_LAYER;
        pg8::Gemm g{WS_PTR(const bf16_t, WS_ACT), (const bf16_t*)(wl + WO_D2), MMAIN, DM, DFF}; pg8::StaticOrder S; S.init(MMAIN, DM, (int)gridDim.x, lbid());
        pg8::EpiRes E{WS_PTR(bf16_t, WS_HB), WS_PTR(float, WS_SS) + (size_t)(6) * 8 * MROWS, 0.5f, (LAS float*)(lds + 131072)};
        pg8::gemm_phase<pg8::EpiRes, pg8::StaticOrder, true, true>(lds, g, S, E);
        skinny_res(WS_PTR(const bf16_t, WS_ACT) + (size_t)MMAIN * DFF, DFF, g.Bt, WS_PTR(bf16_t, WS_HB), WS_PTR(float, WS_SSM) + (6) * 2048, 0.5f, lds);
    }
    SEAM();
    {
        PP Q = launder(P); const unsigned char* wl = Q->ws + WS_W + (size_t)2 * W_LAYER;
        pg8::Gemm g{WS_PTR(const bf16_t, WS_HB), (const bf16_t*)(wl + WO_GU1), MMAIN, NGU, DM}; pg8::StaticOrder S; S.init(MMAIN, NGU, (int)gridDim.x, lbid());
        pg8::EpiGU E{WS_PTR(bf16_t, WS_ACT), WS_PTR(const float, WS_SS) + (size_t)(6) * 8 * MROWS, (LAS float*)(lds + 131072 + 4096)};
        pg8::gemm_phase<pg8::EpiGU, pg8::StaticOrder, true, true>(lds, g, S, E);
        skinny_gu(WS_PTR(const bf16_t, WS_HB), g.Bt, WS_PTR(const float, WS_SSM) + (6) * 2048, WS_PTR(bf16_t, WS_ACT), lds);
    }
    SEAM();
    {
        PP Q = launder(P); const unsigned char* wl = Q->ws + WS_W + (size_t)2 * W_LAYER;
        pg8::Gemm g{WS_PTR(const bf16_t, WS_ACT), (const bf16_t*)(wl + WO_D1), MMAIN, DM, DFF}; pg8::StaticOrder S; S.init(MMAIN, DM, (int)gridDim.x, lbid());
        pg8::EpiRes E{WS_PTR(bf16_t, WS_HB), WS_PTR(float, WS_SS) + (size_t)(7) * 8 * MROWS, 0.5f, (LAS float*)(lds + 131072)};
        pg8::gemm_phase<pg8::EpiRes, pg8::StaticOrder, true, true>(lds, g, S, E);
        skinny_res(WS_PTR(const bf16_t, WS_ACT) + (size_t)MMAIN * DFF, DFF, g.Bt, WS_PTR(bf16_t, WS_HB), WS_PTR(float, WS_SSM) + (7) * 2048, 0.5f, lds);
    }
    SEAM();
    {
        PP Q = launder(P); const unsigned char* wl = Q->ws + WS_W + (size_t)2 * W_LAYER;
        pg8::Gemm g{WS_PTR(const bf16_t, WS_HB), (const bf16_t*)(wl + WO_IN), MMAIN, NIN, DM}; pg8::StaticOrder S; S.init(MMAIN, NIN, (int)gridDim.x, lbid());
        pg8::EpiP E{WS_PTR(bf16_t, WS_PR), WS_PTR(float, WS_PS), WS_PTR(bf16_t, WS_QKV), WS_PTR(const float, WS_SS) + (size_t)(7) * 8 * MROWS, (LAS float*)(lds + 131072 + 4096)};
        pg8::gemm_phase<pg8::EpiP, pg8::StaticOrder, true, true>(lds, g, S, E);
        skinny_p(WS_PTR(const bf16_t, WS_HB), g.Bt, WS_PTR(const float, WS_SSM) + (7) * 2048, WS_PTR(bf16_t, WS_PR), WS_PTR(float, WS_PS), WS_PTR(bf16_t, WS_QKV), lds);
    }
    SEAM();
    { PP Q = launder(P); phase_lx(Q, 2); }
    SEAM();
    {
        PP Q = launder(P); const int u = lbid();
        if (u < 128) { rwkv_chunked(Q, 2, u >> 4, u & 15, lds); __syncthreads(); phase_convert(launder(P), lds, 3, 4, u, 128, 17024, 21248); }
        else { fox_wg(Q, 2, u - 128, (char*)lds_raw); __syncthreads(); phase_convert(launder(P), lds, 3, 4, u - 128, 128, 0, 17024); }
    }
    SEAM();
    { PP Q = launder(P); phase_foxnorm(Q); }
    SEAM();
    {
        PP Q = launder(P); const unsigned char* wl = Q->ws + WS_W + (size_t)2 * W_LAYER;
        pg8::Gemm g{WS_PTR(const bf16_t, WS_Y), (const bf16_t*)(wl + WO_OUT), MMAIN, DM, DM}; pg8::StaticOrder S; S.init(MMAIN, DM, (int)gridDim.x, lbid());
        pg8::EpiRes E{WS_PTR(bf16_t, WS_HB), WS_PTR(float, WS_SS) + (size_t)(8) * 8 * MROWS, 1.0f, (LAS float*)(lds + 131072)};
        pg8::gemm_phase<pg8::EpiRes, pg8::StaticOrder, true, true>(lds, g, S, E);
        skinny_res(WS_PTR(const bf16_t, WS_Y) + (size_t)MMAIN * DM, DM, g.Bt, WS_PTR(bf16_t, WS_HB), WS_PTR(float, WS_SSM) + (8) * 2048, 1.0f, lds);
    }
    SEAM();
    {
        PP Q = launder(P); const unsigned char* wl = Q->ws + WS_W + (size_t)2 * W_LAYER;
        pg8::Gemm g{WS_PTR(const bf16_t, WS_HB), (const bf16_t*)(wl + WO_GU2), MMAIN, NGU, DM}; pg8::StaticOrder S; S.init(MMAIN, NGU, (int)gridDim.x, lbid());
        pg8::EpiGU E{WS_PTR(bf16_t, WS_ACT), WS_PTR(const float, WS_SS) + (size_t)(8) * 8 * MROWS, (LAS float*)(lds + 131072 + 4096)};
        pg8::gemm_phase<pg8::EpiGU, pg8::StaticOrder, true, true>(lds, g, S, E);
        skinny_gu(WS_PTR(const bf16_t, WS_HB), g.Bt, WS_PTR(const float, WS_SSM) + (8) * 2048, WS_PTR(bf16_t, WS_ACT), lds);
    }
    SEAM();
    {
        PP Q = launder(P); const unsigned char* wl = Q->ws + WS_W + (size_t)2 * W_LAYER;
        pg8::Gemm g{WS_PTR(const bf16_t, WS_ACT), (const bf16_t*)(wl + WO_D2), MMAIN, DM, DFF}; pg8::StaticOrder S; S.init(MMAIN, DM, (int)gridDim.x, lbid());
        pg8::EpiRes E{WS_PTR(bf16_t, WS_HB), WS_PTR(float, WS_SS) + (size_t)(9) * 8 * MROWS, 0.5f, (LAS float*)(lds + 131072)};
        pg8::gemm_phase<pg8::EpiRes, pg8::StaticOrder, true, true>(lds, g, S, E);
        skinny_res(WS_PTR(const bf16_t, WS_ACT) + (size_t)MMAIN * DFF, DFF, g.Bt, WS_PTR(bf16_t, WS_HB), WS_PTR(float, WS_SSM) + (9) * 2048, 0.5f, lds);
    }
    SEAM();
    {
        PP Q = launder(P); const unsigned char* wl = Q->ws + WS_W + (size_t)3 * W_LAYER;
        pg8::Gemm g{WS_PTR(const bf16_t, WS_HB), (const bf16_t*)(wl + WO_GU1), MMAIN, NGU, DM}; pg8::StaticOrder S; S.init(MMAIN, NGU, (int)gridDim.x, lbid());
        pg8::EpiGU E{WS_PTR(bf16_t, WS_ACT), WS_PTR(const float, WS_SS) + (size_t)(9) * 8 * MROWS, (LAS float*)(lds + 131072 + 4096)};
        pg8::gemm_phase<pg8::EpiGU, pg8::StaticOrder, true, true>(lds, g, S, E);
        skinny_gu(WS_PTR(const bf16_t, WS_HB), g.Bt, WS_PTR(const float, WS_SSM) + (9) * 2048, WS_PTR(bf16_t, WS_ACT), lds);
    }
    SEAM();
    {
        PP Q = launder(P); const unsigned char* wl = Q->ws + WS_W + (size_t)3 * W_LAYER;
        pg8::Gemm g{WS_PTR(const bf16_t, WS_ACT), (const bf16_t*)(wl + WO_D1), MMAIN, DM, DFF}; pg8::StaticOrder S; S.init(MMAIN, DM, (int)gridDim.x, lbid());
        pg8::EpiRes E{WS_PTR(bf16_t, WS_HB), WS_PTR(float, WS_SS) + (size_t)(10) * 8 * MROWS, 0.5f, (LAS float*)(lds + 131072)};
        pg8::gemm_phase<pg8::EpiRes, pg8::StaticOrder, true, true>(lds, g, S, E);
        skinny_res(WS_PTR(const bf16_t, WS_ACT) + (size_t)MMAIN * DFF, DFF, g.Bt, WS_PTR(bf16_t, WS_HB), WS_PTR(float, WS_SSM) + (10) * 2048, 0.5f, lds);
    }
    SEAM();
    {
        PP Q = launder(P); const unsigned char* wl = Q->ws + WS_W + (size_t)3 * W_LAYER;
        pg8::Gemm g{WS_PTR(const bf16_t, WS_HB), (const bf16_t*)(wl + WO_IN), MMAIN, NIN, DM}; pg8::StaticOrder S; S.init(MMAIN, NIN, (int)gridDim.x, lbid());
        pg8::EpiP E{WS_PTR(bf16_t, WS_PR), WS_PTR(float, WS_PS), WS_PTR(bf16_t, WS_QKV), WS_PTR(const float, WS_SS) + (size_t)(10) * 8 * MROWS, (LAS float*)(lds + 131072 + 4096)};
        pg8::gemm_phase<pg8::EpiP, pg8::StaticOrder, true, true>(lds, g, S, E);
        skinny_p(WS_PTR(const bf16_t, WS_HB), g.Bt, WS_PTR(const float, WS_SSM) + (10) * 2048, WS_PTR(bf16_t, WS_PR), WS_PTR(float, WS_PS), WS_PTR(bf16_t, WS_QKV), lds);
    }
    SEAM();
    { PP Q = launder(P); phase_lx(Q, 3); }
    SEAM();
    {
        PP Q = launder(P); const int u = lbid();
        if (u < 128) { rwkv_chunked(Q, 3, u >> 4, u & 15, lds); }
        else { fox_wg(Q, 3, u - 128, (char*)lds_raw);  }
    }
    SEAM();
    { PP Q = launder(P); phase_foxnorm(Q); }
    SEAM();
    {
        PP Q = launder(P); const unsigned char* wl = Q->ws + WS_W + (size_t)3 * W_LAYER;
        pg8::Gemm g{WS_PTR(const bf16_t, WS_Y), (const bf16_t*)(wl + WO_OUT), MMAIN, DM, DM}; pg8::StaticOrder S; S.init(MMAIN, DM, (int)gridDim.x, lbid());
        pg8::EpiRes E{WS_PTR(bf16_t, WS_HB), WS_PTR(float, WS_SS) + (size_t)(11) * 8 * MROWS, 1.0f, (LAS float*)(lds + 131072)};
        pg8::gemm_phase<pg8::EpiRes, pg8::StaticOrder, true, true>(lds, g, S, E);
        skinny_res(WS_PTR(const bf16_t, WS_Y) + (size_t)MMAIN * DM, DM, g.Bt, WS_PTR(bf16_t, WS_HB), WS_PTR(float, WS_SSM) + (11) * 2048, 1.0f, lds);
    }
    SEAM();
    {
        PP Q = launder(P); const unsigned char* wl = Q->ws + WS_W + (size_t)3 * W_LAYER;
        pg8::Gemm g{WS_PTR(const bf16_t, WS_HB), (const bf16_t*)(wl + WO_GU2), MMAIN, NGU, DM}; pg8::StaticOrder S; S.init(MMAIN, NGU, (int)gridDim.x, lbid());
        pg8::EpiGU E{WS_PTR(bf16_t, WS_ACT), WS_PTR(const float, WS_SS) + (size_t)(11) * 8 * MROWS, (LAS float*)(lds + 131072 + 4096)};
        pg8::gemm_phase<pg8::EpiGU, pg8::StaticOrder, true, true>(lds, g, S, E);
        skinny_gu(WS_PTR(const bf16_t, WS_HB), g.Bt, WS_PTR(const float, WS_SSM) + (11) * 2048, WS_PTR(bf16_t, WS_ACT), lds);
    }
    SEAM();
    {
        PP Q = launder(P); const unsigned char* wl = Q->ws + WS_W + (size_t)3 * W_LAYER;
        pg8::Gemm g{WS_PTR(const bf16_t, WS_ACT), (const bf16_t*)(wl + WO_D2), MMAIN, DM, DFF}; pg8::StaticOrder S; S.init(MMAIN, DM, (int)gridDim.x, lbid());
        pg8::EpiRes E{WS_PTR(bf16_t, WS_HB), WS_PTR(float, WS_SS) + (size_t)(12) * 8 * MROWS, 0.5f, (LAS float*)(lds + 131072)};
        pg8::gemm_phase<pg8::EpiRes, pg8::StaticOrder, true, true>(lds, g, S, E);
        skinny_res(WS_PTR(const bf16_t, WS_ACT) + (size_t)MMAIN * DFF, DFF, g.Bt, WS_PTR(bf16_t, WS_HB), WS_PTR(float, WS_SSM) + (12) * 2048, 0.5f, lds);
    }
    SEAM();
    { PP Q = launder(P); phase_final(Q); }
}

extern "C" void kernel_launch(void* const* d_in, const int* in_sizes, int n_in, void* d_out, int out_size, void* d_ws, size_t ws_size, hipStream_t stream) {
    using namespace cfg;
    static int grid = 0;
    if (grid == 0) {
        if (n_in != 25 || out_size != MMAIN * DM || ws_size < WS_END) { fprintf(stderr, "kernel_launch: need 25 inputs, out %d, ws >= %zu; got n_in %d out %d ws %zu\n", MMAIN * DM, (size_t)WS_END, n_in, out_size, ws_size); grid = -1; return; }
        int dev = 0, cus = 0, per_cu = 0;
        if (hipGetDevice(&dev) != hipSuccess || hipDeviceGetAttribute(&cus, hipDeviceAttributeMultiprocessorCount, dev) != hipSuccess) { grid = -1; return; }
        if (hipFuncSetAttribute((const void*)hymba_fwd, hipFuncAttributeMaxDynamicSharedMemorySize, LDS_BYTES) != hipSuccess) { fprintf(stderr, "kernel_launch: hipFuncSetAttribute failed\n"); grid = -1; return; }
        if (hipOccupancyMaxActiveBlocksPerMultiprocessor(&per_cu, (const void*)hymba_fwd, 512, LDS_BYTES) != hipSuccess || per_cu < 1) fprintf(stderr, "kernel_launch: occupancy query says %d\n", per_cu);
        (void)hipGetLastError();
        if (cus < 256) { fprintf(stderr, "kernel_launch: built for a 256-CU device (one resident workgroup per CU), found %d CUs\n", cus); grid = -1; return; }
        grid = 256;
    }
    if (grid < 0) return;
    if (hipMemsetAsync((char*)d_ws + WS_CTL, 0, CTL_BYTES, stream) != hipSuccess) return;
    Params p{};
    for (int i = 0; i < 25; ++i) p.in[i] = (const float*)d_in[i];
    p.out = (float*)d_out; p.ws = (unsigned char*)d_ws; p.ph_lo = 0; p.ph_hi = 0;
    hipLaunchKernelGGL(hymba_fwd, dim3(grid), dim3(512), LDS_BYTES, stream, p);
}
```

```cpp
#include <hip/hip_runtime.h>
#include <hip/hip_bf16.h>
#include <cstdio>
#include <cstdint>

#define LAS __attribute__((address_space(3)))
namespace cfg {
constexpr int DM = 2048, NBATCH = 8, SEQ = 4096, NMETA = 16, DEPTH = 4;
constexpr int MMAIN = NBATCH * SEQ;
constexpr int MROWS = MMAIN + 256;
constexpr int DFF = 5632, NGU = 2 * DFF;
constexpr int RW = 1024, RH = 64, RNH = 16;
constexpr int FW = 1024, FH = 128, FNH = 8;
constexpr int RWKV_COLS = 3360, DIN = 6440;
constexpr int NIN = 6656;
constexpr int PRW = 3072, PSW = 512, QKVW = 3072;
constexpr int SEQP = 4160;
constexpr float NORM_EPS = 1e-6f, LNX_EPS = 64e-5f;
constexpr int NSS = 13;
constexpr size_t al256(size_t x) { return (x + 255) & ~(size_t)255; }
constexpr size_t WS_CTL = 0;
constexpr size_t CTL_BYTES = 65536;
constexpr size_t WS_SS = WS_CTL + CTL_BYTES;
constexpr size_t SS_BYTES = al256((size_t)NSS * 8 * MROWS * 4);
constexpr size_t ZERO_BYTES = CTL_BYTES + SS_BYTES;
constexpr size_t WS_SSM = WS_SS + SS_BYTES;
constexpr size_t SSM_BYTES = (size_t)NSS * 2048 * 4;
constexpr size_t WS_HMETA = WS_SSM + SSM_BYTES;
constexpr size_t WS_HB = WS_HMETA + (size_t)256 * DM * 4;
constexpr size_t WS_Y = WS_HB + (size_t)MROWS * DM * 2;
constexpr size_t WS_OVL = WS_Y + (size_t)MROWS * DM * 2;
constexpr size_t WS_ACT = WS_OVL;
constexpr size_t WS_PR = WS_OVL;
constexpr size_t WS_PS = WS_PR + (size_t)MROWS * PRW * 2;
constexpr size_t WS_QKV = WS_PS + (size_t)MROWS * PSW * 4;
constexpr size_t OVL_A = (size_t)MROWS * DFF * 2, OVL_B = (size_t)MROWS * PRW * 2 + (size_t)MROWS * PSW * 4 + (size_t)NBATCH * SEQP * QKVW * 2;
constexpr size_t WS_W = WS_OVL + al256(OVL_A > OVL_B ? OVL_A : OVL_B);
constexpr size_t W_GU = (size_t)NGU * DM * 2, W_D = (size_t)DM * DFF * 2, W_IN = (size_t)NIN * DM * 2, W_OUT = (size_t)DM * DM * 2;
constexpr size_t WO_GU1 = 0, WO_D1 = WO_GU1 + W_GU, WO_IN = WO_D1 + W_D, WO_OUT = WO_IN + W_IN, WO_GU2 = WO_OUT + W_OUT, WO_D2 = WO_GU2 + W_GU, W_LAYER = WO_D2 + W_D;
constexpr size_t WS_LXG = WS_W + (size_t)DEPTH * W_LAYER;
constexpr size_t WS_END = WS_LXG + (size_t)MROWS * 320 * 2;
constexpr int LDS_BYTES = 147456;
constexpr int LDS_BARW = LDS_BYTES - 16;
}
__device__ __forceinline__ int ltid() { int t = (int)threadIdx.x; asm volatile("" : "+v"(t)); return t; }
__device__ __forceinline__ int lbid() { int t = (int)blockIdx.x; asm volatile("" : "+s"(t)); return t; }
__device__ __forceinline__ int lzero() { int t = 0; asm volatile("" : "+v"(t)); return t; }
namespace pg8 {
#define PG8_LAS __attribute__((address_space(3)))
typedef unsigned short bf16_t;
typedef short bf16x8 __attribute__((ext_vector_type(8)));
typedef float f32x4 __attribute__((ext_vector_type(4)));
typedef unsigned u32x4 __attribute__((ext_vector_type(4)));
constexpr int BM = 256, BK = 64, HALF = 128, HTB = HALF * BK * 2  , STAGE_BYTES = 8 * HTB, NXCD = 8, WGM = 8;

__host__ __device__ __forceinline__ int lds_byte(int r, int c) { const int st = (r >> 4) * 2 + (c >> 5), rr = r & 15, cc = c & 31, ob = rr * 64 + cc * 2; return st * 1024 + (ob ^ (((ob >> 9) & 1) << 5)); }
__host__ __device__ __forceinline__ void stage_rc(int b, int& R, int& C) { const int st = b / 1024, sb = b % 1024, swz = sb ^ (((sb >> 9) & 1) << 5); R = (st >> 1) * 16 + swz / 64; C = (st & 1) * 32 + (swz % 64) / 2; }
__host__ __device__ __forceinline__ int perm32(int rho) { const int n = rho >> 4, i = rho & 15; return 8 * (i >> 2) + 4 * n + (i & 3); }

struct Unit { int pm, pn; };
struct Gemm { const bf16_t* A; const bf16_t* Bt; int M, N, K; };

struct StaticOrder {
    int nM, nN, nwg, G, c;
    __host__ __device__ void init(int M, int N, int G_, int c_) { nM = M / BM; nN = N / BM; nwg = nM * nN; G = G_; c = c_; }
    __host__ __device__ bool next(int i, Unit& u) const {
        const long L = (long)i * G + c; if (L >= nwg) return false;
        int wgid = (int)L; { const int q = nwg / NXCD, r = nwg % NXCD, xcd = wgid % NXCD, off = wgid / NXCD; wgid = (xcd < r ? xcd * (q + 1) : r * (q + 1) + (xcd - r) * q) + off; }
        const int nig = WGM * nN, gid = wgid / nig, fm = gid * WGM, gsz = (nM - fm) < WGM ? (nM - fm) : WGM;
        u.pm = fm + ((wgid % nig) % gsz); u.pn = (wgid % nig) / gsz; return true;
    }
    __device__ __forceinline__ void a_ready(const Unit&) const {}
    __device__ __forceinline__ void done(const Unit&) const {}
};

__device__ __forceinline__ unsigned cvt_pk_bf16(float lo, float hi) { unsigned r; asm volatile("v_cvt_pk_bf16_f32 %0, %1, %2" : "=v"(r) : "v"(lo), "v"(hi)); return r; }
typedef float f32x2 __attribute__((ext_vector_type(2)));
__device__ __forceinline__ f32x2 gelu_pk(f32x2 v) {
    const f32x2 av = __builtin_elementwise_abs(v), d = av * 0.2316418882f + 1.0f;
    f32x2 t; t.x = __builtin_amdgcn_rcpf(d.x); t.y = __builtin_amdgcn_rcpf(d.y);
    f32x2 q = t * 0.5307027145f + (-0.7265760135f); q = q * t + 0.7107068705f; q = q * t + (-0.142248368f); q = q * t + 0.127414796f; q = q * t;
    const f32x2 s = (v * v) * (-0.72134752044f);
    f32x2 e; e.x = __builtin_amdgcn_exp2f(s.x); e.y = __builtin_amdgcn_exp2f(s.y);
    const f32x2 m = v * (q * e), r = v - m;
    f32x2 o; o.x = v.x < 0.f ? m.x : r.x; o.y = v.y < 0.f ? m.y : r.y; return o;
}
__device__ __forceinline__ float rs_of(const float* ss, int row) { float s = 0.f;
#pragma unroll
    for (int t = 0; t < 8; ++t) s += ss[(size_t)t * 33024 + row];
    return __builtin_amdgcn_rsqf(s * (1.0f / 2048.0f) + 1e-6f); }
__device__ __forceinline__ float silu_f(float x) { return x * __builtin_amdgcn_rcpf(1.0f + __builtin_amdgcn_exp2f(-1.4426950408889634f * x)); }

struct EpiGU {
    static constexpr bool PERM = true, AFTER_DRAIN = false;
    bf16_t* act; const float* ss; PG8_LAS float* rsb;
    __device__ __forceinline__ void operator()(const f32x4 (&acc)[2][2][4][2], const Unit& u, int wr, int wc, int fr, int fq) const {
        if (wr == 0) { const int rl = wc * 64 + fq * 16 + fr; rsb[rl] = rs_of(ss, u.pm * BM + rl); }
        asm volatile("s_waitcnt lgkmcnt(0)" ::: "memory"); __builtin_amdgcn_s_barrier(); asm volatile("" ::: "memory");
        const int rl0 = wr * 64 + fr, row0 = u.pm * BM + rl0, col0 = u.pn * 128 + wc * 32 + 8 * fq;
#pragma unroll
        for (int ai = 0; ai < 2; ++ai)
#pragma unroll
            for (int m = 0; m < 4; ++m) { const int row = row0 + ai * HALF + m * 16; const float rs = rsb[rl0 + ai * HALF + m * 16];
                const f32x4 g0 = acc[ai][0][m][0] * rs, g1 = acc[ai][0][m][1] * rs, u0 = acc[ai][1][m][0] * rs, u1 = acc[ai][1][m][1] * rs;
                u32x4 w;
                w.x = cvt_pk_bf16(silu_f(g0[0]) * u0[0], silu_f(g0[1]) * u0[1]); w.y = cvt_pk_bf16(silu_f(g0[2]) * u0[2], silu_f(g0[3]) * u0[3]);
                w.z = cvt_pk_bf16(silu_f(g1[0]) * u1[0], silu_f(g1[1]) * u1[1]); w.w = cvt_pk_bf16(silu_f(g1[2]) * u1[2], silu_f(g1[3]) * u1[3]);
                *(u32x4*)(act + (size_t)row * 5632 + col0) = w; }
        asm volatile("s_waitcnt lgkmcnt(0)" ::: "memory"); __builtin_amdgcn_s_barrier(); asm volatile("" ::: "memory");
    }
};
struct EpiRes {
    static constexpr bool PERM = true, AFTER_DRAIN = false;
    bf16_t* hb; float* ssn; float alpha; PG8_LAS float* red;
    __device__ __forceinline__ void operator()(const f32x4 (&acc)[2][2][4][2], const Unit& u, int wr, int wc, int fr, int fq) const {
        bf16_t* bbase = hb + (size_t)u.pm * BM * 2048;
        const int rl0 = wr * 64 + fr; unsigned off = (unsigned)(rl0 * 2048 + u.pn * BM + wc * 32 + 8 * fq);
#pragma unroll
        for (int ai = 0; ai < 2; ++ai) {
            u32x4 hv[4][2];
#pragma unroll
            for (int m = 0; m < 4; ++m)
#pragma unroll
                for (int bj = 0; bj < 2; ++bj) hv[m][bj] = *(const u32x4*)(bbase + (off + (unsigned)((ai * HALF + m * 16) * 2048) + bj * HALF));
#pragma unroll
            for (int m = 0; m < 4; ++m) { const unsigned o = off + (unsigned)((ai * HALF + m * 16) * 2048); float sq = 0.f;
#pragma unroll
                for (int bj = 0; bj < 2; ++bj) { const u32x4 x = hv[m][bj];
                    const f32x4 h0 = (f32x4){__uint_as_float(x.x << 16), __uint_as_float(x.x & 0xffff0000u), __uint_as_float(x.y << 16), __uint_as_float(x.y & 0xffff0000u)} + acc[ai][bj][m][0] * alpha;
                    const f32x4 h1 = (f32x4){__uint_as_float(x.z << 16), __uint_as_float(x.z & 0xffff0000u), __uint_as_float(x.w << 16), __uint_as_float(x.w & 0xffff0000u)} + acc[ai][bj][m][1] * alpha;
                    sq += ((h0[0] * h0[0] + h0[1] * h0[1]) + (h0[2] * h0[2] + h0[3] * h0[3])) + ((h1[0] * h1[0] + h1[1] * h1[1]) + (h1[2] * h1[2] + h1[3] * h1[3]));
                    u32x4 w; w.x = cvt_pk_bf16(h0[0], h0[1]); w.y = cvt_pk_bf16(h0[2], h0[3]); w.z = cvt_pk_bf16(h1[0], h1[1]); w.w = cvt_pk_bf16(h1[2], h1[3]); *(u32x4*)(bbase + o + bj * HALF) = w; }
                sq += __shfl_xor(sq, 16); sq += __shfl_xor(sq, 32);
                if (fq == 0) red[(rl0 + ai * HALF + m * 16) * 4 + wc] = sq; }
            asm volatile("" ::: "memory"); }
        asm volatile("s_waitcnt lgkmcnt(0)" ::: "memory"); __builtin_amdgcn_s_barrier(); asm volatile("" ::: "memory");
        if (wr == 0) { const int row = wc * 64 + fq * 16 + fr; const float s4 = (red[row * 4] + red[row * 4 + 1]) + (red[row * 4 + 2] + red[row * 4 + 3]); ssn[(size_t)u.pn * 33024 + u.pm * BM + row] = s4; }
    }
};
struct EpiP {
    static constexpr bool PERM = true, AFTER_DRAIN = false;
    bf16_t* pr; float* ps; bf16_t* qkv; const float* ss; PG8_LAS float* rsb;
    __device__ __forceinline__ void operator()(const f32x4 (&acc)[2][2][4][2], const Unit& u, int wr, int wc, int fr, int fq) const {
        if (wr == 0) { const int rl = wc * 64 + fq * 16 + fr; rsb[rl] = rs_of(ss, u.pm * BM + rl); }
        asm volatile("s_waitcnt lgkmcnt(0)" ::: "memory"); __builtin_amdgcn_s_barrier(); asm volatile("" ::: "memory");
        const int rl0 = wr * 64 + fr, row0 = u.pm * BM + rl0, cl = wc * 32 + 8 * fq;
#pragma unroll
        for (int ai = 0; ai < 2; ++ai)
#pragma unroll
            for (int m = 0; m < 4; ++m) { const int row = row0 + ai * HALF + m * 16; const float rs = rsb[rl0 + ai * HALF + m * 16];
#pragma unroll
                for (int bj = 0; bj < 2; ++bj) { const f32x4 v0 = acc[ai][bj][m][0] * rs, v1 = acc[ai][bj][m][1] * rs;
                    if (u.pn >= 12 && u.pn < 14) { float* d = ps + (size_t)row * 512 + (u.pn - 12) * 256 + bj * HALF + cl; *(f32x4*)d = v0; *(f32x4*)(d + 4) = v1; }
                    else { u32x4 w; w.x = cvt_pk_bf16(v0[0], v0[1]); w.y = cvt_pk_bf16(v0[2], v0[3]); w.z = cvt_pk_bf16(v1[0], v1[1]); w.w = cvt_pk_bf16(v1[2], v1[3]);
                        if (u.pn < 12) *(u32x4*)(pr + (size_t)row * 3072 + u.pn * 256 + bj * HALF + cl) = w;
                        else { const int c = (u.pn - 14) * 256 + bj * HALF + cl;
                            const int b = row >> 12, s = row & 4095; *(u32x4*)(qkv + ((size_t)b * 4160 + 64 + s) * 3072 + c) = w; } } } }
        asm volatile("s_waitcnt lgkmcnt(0)" ::: "memory"); __builtin_amdgcn_s_barrier(); asm volatile("" ::: "memory");
    }
};
template <class Epi, class Sched, bool ALIGN_EPI = false, bool SP2 = false>
__device__ __forceinline__ void gemm_phase(PG8_LAS unsigned char* lds, const Gemm g, const Sched& S, const Epi& E) {
    const int tid = ltid(), wid = __builtin_amdgcn_readfirstlane(tid >> 6), lane = tid & 63, wr = wid >> 2, wc = wid & 3, fr = lane & 15, fq = lane >> 4;
    const int K = g.K, nt = K / BK;
    unsigned voffA[2], voffB[2];
#pragma unroll
    for (int i = 0; i < 2; ++i) { int R, C; stage_rc(tid * 16 + i * 8192, R, C); const int Rb = Epi::PERM ? ((R & ~31) + perm32(R & 31)) : R;
        voffA[i] = (unsigned)(R * K + C) * 2u; voffB[i] = (unsigned)(Rb * K + C) * 2u; }
    const size_t kstep = (size_t)(BK * 2);
    const size_t hstep = (size_t)HALF * K * 2;
    const size_t tstep = 2 * hstep;
    const unsigned ldsw = (unsigned)wid * 1024u;
    const int aoff = lds_byte(wr * 64 + fr, fq * 8), boff = lds_byte(wc * 32 + fr, fq * 8);
#define PG8_SA(b, h) (((b) * 2 + (h)) * HTB)
#define PG8_SB(b, h) ((4 + (b) * 2 + (h)) * HTB)
#define PG8_STAGE(bufoff, gbase, voff) do { _Pragma("unroll") for (int _i = 0; _i < 2; ++_i) \
        __builtin_amdgcn_global_load_lds((const unsigned*)((const char*)(gbase) + (voff)[_i]), (PG8_LAS unsigned*)(lds + (bufoff) + ldsw + _i * 8192), 16, 0, 0); } while (0)
#define PG8_LDA(dst, b, h) do { _Pragma("unroll") for (int m = 0; m < 4; ++m) _Pragma("unroll") for (int k = 0; k < 2; ++k) dst[m][k] = *(const PG8_LAS bf16x8*)(lds + PG8_SA(b, h) + aoff + m * 2048 + k * 1024); } while (0)
#define PG8_LDB(dst, b, h) do { _Pragma("unroll") for (int n = 0; n < 2; ++n) _Pragma("unroll") for (int k = 0; k < 2; ++k) dst[n][k] = *(const PG8_LAS bf16x8*)(lds + PG8_SB(b, h) + boff + n * 2048 + k * 1024); } while (0)
#define PG8_MMA(ai, bj, At, Bt) do { __builtin_amdgcn_s_setprio(1); _Pragma("unroll") for (int m = 0; m < 4; ++m) _Pragma("unroll") for (int n = 0; n < 2; ++n) _Pragma("unroll") for (int k = 0; k < 2; ++k) \
        acc[ai][bj][m][n] = __builtin_amdgcn_mfma_f32_16x16x32_bf16(Bt[n][k], At[m][k], acc[ai][bj][m][n], 0, 0, 0); __builtin_amdgcn_s_setprio(0); } while (0)
#define PG8_WAIT_V(n) asm volatile("s_waitcnt vmcnt(" #n ")" ::: "memory")
#define PG8_WAIT_L(n) asm volatile("s_waitcnt lgkmcnt(" #n ")" ::: "memory")
#define PG8_BAR __builtin_amdgcn_s_barrier()
#define PG8_SCHED __builtin_amdgcn_sched_barrier(0)
    Unit cur, nxt; int ui = 0;
    if (!S.next(0, cur)) return;
    f32x4 acc[2][2][4][2];
#pragma unroll
    for (int a = 0; a < 2; ++a)
#pragma unroll
        for (int b = 0; b < 2; ++b)
#pragma unroll
            for (int m = 0; m < 4; ++m)
#pragma unroll
                for (int n = 0; n < 2; ++n) acc[a][b][m][n] = (f32x4){0.f, 0.f, 0.f, 0.f};
    bf16x8 At[4][2], B0[2][2], B1[2][2];
    const char* cA = (const char*)g.A + (size_t)cur.pm * tstep; const char* cB = (const char*)g.Bt + (size_t)cur.pn * tstep;
    S.a_ready(cur);
    if constexpr (SP2) {
        PG8_STAGE(PG8_SB(0, 0), cB, voffB); PG8_STAGE(PG8_SB(0, 1), cB + hstep, voffB); PG8_STAGE(PG8_SA(0, 0), cA, voffA); PG8_STAGE(PG8_SA(0, 1), cA + hstep, voffA);
        if (wr == 1) PG8_BAR;
        PG8_WAIT_V(2); PG8_BAR;
        PG8_STAGE(PG8_SB(1, 0), cB + kstep, voffB); PG8_STAGE(PG8_SA(1, 0), cA + kstep, voffA); PG8_STAGE(PG8_SB(1, 1), cB + hstep + kstep, voffB);
        PG8_WAIT_V(6); PG8_BAR;
    } else {
        PG8_STAGE(PG8_SB(0, 0), cB, voffB); PG8_STAGE(PG8_SA(0, 0), cA, voffA); PG8_STAGE(PG8_SB(0, 1), cB + hstep, voffB); PG8_STAGE(PG8_SA(0, 1), cA + hstep, voffA);
        if (wr == 1) PG8_BAR;
        PG8_WAIT_V(4); PG8_BAR;
        PG8_STAGE(PG8_SB(1, 0), cB + kstep, voffB); PG8_STAGE(PG8_SA(1, 0), cA + kstep, voffA); PG8_STAGE(PG8_SB(1, 1), cB + hstep + kstep, voffB);
        PG8_WAIT_V(6); PG8_BAR;
    }
    for (;;) {
        const bool has_next = S.next(ui + 1, nxt);
        const char* nA = has_next ? (const char*)g.A + (size_t)nxt.pm * tstep : cA; const char* nB = has_next ? (const char*)g.Bt + (size_t)nxt.pn * tstep : cB;
        for (int t = 0; t < nt; t += 2) {
            const bool last = (t == nt - 2);
            const char* a1 = cA + (size_t)(t + 1) * kstep;
            const char* a2 = last ? nA : cA + (size_t)(t + 2) * kstep; const char* b2 = last ? nB : cB + (size_t)(t + 2) * kstep;
            const char* a3 = a2 + kstep; const char* b3 = b2 + kstep;
            if (last && has_next) S.a_ready(nxt);
            if constexpr (SP2) {
            PG8_LDB(B0, 0, 0); PG8_LDB(B1, 0, 1); PG8_SCHED; PG8_LDA(At, 0, 0); PG8_STAGE(PG8_SA(1, 1), a1 + hstep, voffA);
            PG8_WAIT_V(8); PG8_WAIT_L(0); PG8_BAR; PG8_MMA(0, 0, At, B0); PG8_MMA(0, 1, At, B1); PG8_BAR; PG8_SCHED;
            PG8_LDA(At, 0, 1); PG8_STAGE(PG8_SB(0, 0), b2, voffB); PG8_STAGE(PG8_SB(0, 1), b2 + hstep, voffB); PG8_STAGE(PG8_SA(0, 0), a2, voffA);
            PG8_WAIT_V(8); PG8_WAIT_L(0); PG8_BAR; PG8_MMA(1, 0, At, B0); PG8_MMA(1, 1, At, B1); PG8_BAR; PG8_SCHED;
            PG8_LDB(B0, 1, 0); PG8_LDB(B1, 1, 1); PG8_SCHED; PG8_LDA(At, 1, 0); PG8_STAGE(PG8_SA(0, 1), a2 + hstep, voffA);
            PG8_WAIT_V(8); PG8_WAIT_L(0); PG8_BAR; PG8_MMA(0, 0, At, B0); PG8_MMA(0, 1, At, B1); PG8_BAR; PG8_SCHED;
            PG8_LDA(At, 1, 1); PG8_STAGE(PG8_SB(1, 0), b3, voffB); PG8_STAGE(PG8_SB(1, 1), b3 + hstep, voffB); PG8_STAGE(PG8_SA(1, 0), a3, voffA);
            PG8_WAIT_V(8); PG8_WAIT_L(0); PG8_BAR; PG8_MMA(1, 0, At, B0); PG8_MMA(1, 1, At, B1); PG8_BAR; PG8_SCHED;
            } else {
            PG8_LDB(B0, 0, 0); PG8_SCHED; PG8_LDA(At, 0, 0); PG8_STAGE(PG8_SA(1, 1), a1 + hstep, voffA);
            PG8_WAIT_L(8); PG8_BAR; PG8_WAIT_L(0); PG8_MMA(0, 0, At, B0); PG8_BAR; PG8_SCHED;
            PG8_LDB(B1, 0, 1); PG8_STAGE(PG8_SB(0, 0), b2, voffB);
            PG8_BAR; PG8_WAIT_L(0); PG8_MMA(0, 1, At, B1); PG8_BAR;
            PG8_LDA(At, 0, 1); PG8_STAGE(PG8_SA(0, 0), a2, voffA);
            PG8_BAR; PG8_WAIT_L(0); PG8_MMA(1, 0, At, B0); PG8_BAR; PG8_SCHED;
            PG8_STAGE(PG8_SB(0, 1), b2 + hstep, voffB);
            PG8_WAIT_V(6); PG8_BAR; PG8_MMA(1, 1, At, B1); PG8_BAR;
            PG8_LDB(B0, 1, 0); PG8_SCHED; PG8_LDA(At, 1, 0); PG8_STAGE(PG8_SA(0, 1), a2 + hstep, voffA);
            PG8_WAIT_L(8); PG8_BAR; PG8_WAIT_L(0); PG8_MMA(0, 0, At, B0); PG8_BAR; PG8_SCHED;
            PG8_LDB(B1, 1, 1); PG8_STAGE(PG8_SB(1, 0), b3, voffB);
            PG8_BAR; PG8_WAIT_L(0); PG8_MMA(0, 1, At, B1); PG8_BAR;
            PG8_LDA(At, 1, 1); PG8_STAGE(PG8_SA(1, 0), a3, voffA);
            PG8_BAR; PG8_WAIT_L(0); PG8_MMA(1, 0, At, B0); PG8_BAR; PG8_SCHED;
            PG8_STAGE(PG8_SB(1, 1), b3 + hstep, voffB);
            PG8_WAIT_V(6); PG8_BAR; PG8_MMA(1, 1, At, B1); PG8_BAR;
            }
        }
        if constexpr (ALIGN_EPI) { if (wr == 0) PG8_BAR; }
        if constexpr (!Epi::AFTER_DRAIN) { E(acc, cur, wr, wc, fr, fq); S.done(cur); }
        if (!has_next) break;
#pragma unroll
        for (int a = 0; a < 2; ++a)
#pragma unroll
            for (int b = 0; b < 2; ++b)
#pragma unroll
                for (int m = 0; m < 4; ++m)
#pragma unroll
                    for (int n = 0; n < 2; ++n) acc[a][b][m][n] = (f32x4){0.f, 0.f, 0.f, 0.f};
        cur = nxt; cA = nA; cB = nB; ++ui;
        if constexpr (ALIGN_EPI) { if (wr == 1) PG8_BAR; }
    }
    PG8_WAIT_V(0);
    if constexpr (!ALIGN_EPI) { if (wr == 0) PG8_BAR; }
    PG8_BAR;
    if constexpr (Epi::AFTER_DRAIN) { E.fused(acc, cur, wr, wc, fr, fq, lds, wid, lane); S.done(cur); }
#undef PG8_SA
#undef PG8_SB
#undef PG8_STAGE
#undef PG8_LDA
#undef PG8_LDB
#undef PG8_MMA
#undef PG8_WAIT_V
#undef PG8_WAIT_L
#undef PG8_BAR
#undef PG8_SCHED
}
}


#define XB_TMO      128
#define XB_XCNT(j)  (256  + 64 * (j))
#define XB_XSUB(j)  (1280 + 64 * (j))
#define XB_XGEN(j)  (2304 + 64 * (j))
#define XB_TOP      3328
#define XB_TOPGEN   3392
#define XCD_BAR_WORDS 3456
#define XB_SPIN_CAP (1u << 22)

__device__ __forceinline__ unsigned xb_ld(unsigned* p)              { return __hip_atomic_load(p, __ATOMIC_RELAXED, __HIP_MEMORY_SCOPE_AGENT); }
__device__ __forceinline__ unsigned xb_add(unsigned* p, unsigned v) { return __hip_atomic_fetch_add(p, v, __ATOMIC_RELAXED, __HIP_MEMORY_SCOPE_AGENT); }
__device__ __forceinline__ unsigned xb_xcc_id() { return (unsigned)__builtin_amdgcn_s_getreg((3 << 11) | 20) & 0xFu; }
#define XB_SPIN(cond, bar) do { unsigned _sp = 0; while (cond) { __builtin_amdgcn_s_sleep(1); \
    if ((++_sp & 255u) == 0u) { if (xb_ld(&(bar)[XB_TMO])) break; if (_sp > XB_SPIN_CAP) { atomicAdd(&(bar)[XB_TMO], 1u); break; } } } } while (0)

struct XcdBarrier {
    unsigned* bar; unsigned x;
    volatile LAS unsigned* st;
};

__device__ __forceinline__ XcdBarrier xcd_barrier_post(unsigned* bar, volatile LAS unsigned* st) {
    XcdBarrier b; b.bar = bar; b.x = xb_xcc_id(); b.st = st;
    if (threadIdx.x == 0) (void)xb_add(&bar[XB_XCNT(b.x)], 1u);
    return b;
}
__device__ __forceinline__ void xcd_barrier_complete(unsigned* bar, unsigned x, unsigned& nloc, unsigned& nx) {
    const unsigned G = gridDim.x * gridDim.y * gridDim.z;
    unsigned sum, cnt, mine, sp = 0u;
    for (;;) {
        sum = 0u; cnt = 0u; mine = 0u;
#pragma unroll
        for (unsigned j = 0; j < 16; ++j) { const unsigned c = xb_ld(&bar[XB_XCNT(j)]); sum += c; cnt += (c > 0u) ? 1u : 0u; mine = (j == x) ? c : mine; }
        if (sum == G) break;
        __builtin_amdgcn_s_sleep(1);
        if ((++sp & 255u) == 0u) { if (xb_ld(&bar[XB_TMO])) break; if (sp > XB_SPIN_CAP) { atomicAdd(&bar[XB_TMO], 1u); break; } }
    }
    nloc = mine > 0u ? mine : 1u; nx = cnt > 0u ? cnt : 1u;
}

__device__ __forceinline__ void xcd_barrier(const XcdBarrier& b) {
    asm volatile("s_waitcnt vmcnt(0)" ::: "memory");
    __syncthreads();
    if (threadIdx.x == 0) {
        unsigned* bar = b.bar;
        __builtin_amdgcn_s_waitcnt(0);
        unsigned nloc = b.st[0], nx = b.st[1];
        if (nloc == 0u) { xcd_barrier_complete(bar, b.x, nloc, nx); b.st[0] = nloc; b.st[1] = nx; }
        const unsigned old = xb_add(&bar[XB_XSUB(b.x)], 1u);
        const unsigned gen = old / nloc;
        if (old + 1u == (gen + 1u) * nloc) {
            __builtin_amdgcn_fence(__ATOMIC_RELEASE, "agent");
            asm volatile("s_waitcnt vmcnt(0)" ::: "memory");
            const unsigned og = xb_add(&bar[XB_TOP], 1u);
            const unsigned tg = og / nx;
            if (og + 1u == (tg + 1u) * nx) xb_add(&bar[XB_TOPGEN], 1u);
            else XB_SPIN(xb_ld(&bar[XB_TOPGEN]) == tg, bar);
            __builtin_amdgcn_fence(__ATOMIC_ACQUIRE, "agent");
            xb_add(&bar[XB_XGEN(b.x)], 1u);
            asm volatile("s_waitcnt vmcnt(0)" ::: "memory");
        } else {
            XB_SPIN(xb_ld(&bar[XB_XGEN(b.x)]) == gen, bar);
            __builtin_amdgcn_fence(__ATOMIC_ACQUIRE, "agent");
            asm volatile("s_waitcnt vmcnt(0)" ::: "memory");
        }
    }
    __syncthreads();
}


typedef unsigned short bf16_t;
typedef float f32x4 __attribute__((ext_vector_type(4)));
typedef unsigned u32x4 __attribute__((ext_vector_type(4)));
typedef unsigned u32x2 __attribute__((ext_vector_type(2)));
struct Params { const float* in[25]; float* out; unsigned char* ws; int ph_lo, ph_hi; };
#define CAS __attribute__((address_space(4)))
typedef const CAS Params* PP;
__device__ __forceinline__ PP launder(PP p) { asm volatile("" : "+s"(p)); return p; }
enum { I_X = 0, I_META, I_F1N, I_F1GU, I_F1D, I_MIXN, I_WIN, I_MU, I_W0, I_WUP, I_A0, I_AUP, I_GUP, I_KK, I_KA, I_RK, I_LNW, I_LNB, I_BF, I_FON, I_WOUT, I_F2N, I_F2GU, I_F2D, I_FINN };

typedef float f32x2_t __attribute__((ext_vector_type(2))); typedef __bf16 bf16x2v_t __attribute__((ext_vector_type(2)));
__device__ __forceinline__ unsigned pk_bf16(float lo, float hi) { f32x2_t v = {lo, hi}; bf16x2v_t b = __builtin_convertvector(v, bf16x2v_t); return __builtin_bit_cast(unsigned, b); }
__device__ __forceinline__ float bf2f(bf16_t b) { return __uint_as_float(((unsigned)b) << 16); }
__device__ __forceinline__ float wave_sum(float v) {
#pragma unroll
    for (int o = 32; o >= 1; o >>= 1) v += __shfl_xor(v, o);
    return v; }
__device__ __forceinline__ float wave_max(float v) {
#pragma unroll
    for (int o = 32; o >= 1; o >>= 1) v = fmaxf(v, __shfl_xor(v, o));
    return v; }
template <int CTRL> __device__ __forceinline__ float dpp_f(float v) { return __builtin_bit_cast(float, __builtin_amdgcn_update_dpp(0, __builtin_bit_cast(int, v), CTRL, 0xf, 0xf, true)); }
__device__ __forceinline__ float row_sum16(float v) { v += dpp_f<0xB1>(v); v += dpp_f<0x4E>(v); v += dpp_f<0x141>(v); v += dpp_f<0x140>(v); return v; }
__device__ __forceinline__ float rdlane(float v, int l) { return __builtin_bit_cast(float, __builtin_amdgcn_readlane(__builtin_bit_cast(int, v), l)); }
__device__ __forceinline__ float wave_sum_dpp(float v) { v = row_sum16(v); return (rdlane(v, 0) + rdlane(v, 16)) + (rdlane(v, 32) + rdlane(v, 48)); }
__device__ __forceinline__ float sigmoid_f(float x) { return __builtin_amdgcn_rcpf(1.0f + __expf(-x)); }

__device__ __forceinline__ void convert_tile(const float* __restrict__ src, bf16_t* __restrict__ dst, const float* __restrict__ gain, int K, int Nsrc, int kind, int tk, int tn, LAS float* T) {
    const int tid = ltid();
    {
        const int nl = (tid & 15) * 4, np = tn * 64 + nl; int sc;
        if (kind == 1) { const int pn = np >> 8, bj = (np >> 7) & 1, i = np & 127; sc = bj * cfg::DFF + pn * 128 + i; }
        else if (kind == 2) { sc = np < 3360 ? np : (np < 3368 ? 6432 + (np - 3360) : (np < 3584 ? -1 : 3360 + (np - 3584))); }
        else sc = np;
#pragma unroll
        for (int i = 0; i < 2; ++i) { const int kl = (tid >> 4) + 32 * i, k = tk * 64 + kl;
            f32x4 v = (f32x4){0.f, 0.f, 0.f, 0.f};
            if (sc >= 0) v = *(const f32x4*)(src + (size_t)k * Nsrc + sc);
            float g = 1.f; if (kind == 1 || kind == 2) g = gain[k]; else if (kind == 3) g = (k >= 1024) ? gain[k - 1024] : 1.f;
            T[kl * 65 + nl] = v[0] * g; T[kl * 65 + nl + 1] = v[1] * g; T[kl * 65 + nl + 2] = v[2] * g; T[kl * 65 + nl + 3] = v[3] * g; }
    }
    __syncthreads();
    {
        const int nl = tid >> 3, k8 = (tid & 7) * 8; u32x4 w;
        w.x = pk_bf16(T[(k8 + 0) * 65 + nl], T[(k8 + 1) * 65 + nl]); w.y = pk_bf16(T[(k8 + 2) * 65 + nl], T[(k8 + 3) * 65 + nl]);
        w.z = pk_bf16(T[(k8 + 4) * 65 + nl], T[(k8 + 5) * 65 + nl]); w.w = pk_bf16(T[(k8 + 6) * 65 + nl], T[(k8 + 7) * 65 + nl]);
        *(u32x4*)(dst + (size_t)(tn * 64 + nl) * K + tk * 64 + k8) = w;
    }
    __syncthreads();
}
__device__ __forceinline__ void phase_convert(PP P, LAS unsigned char* lds, int l0, int l1, int first, int nwg, int t0 = 0, int t1 = 0) {
    using namespace cfg;
    LAS float* T = (LAS float*)lds;
    constexpr int T_GU = (DM / 64) * (NGU / 64), T_D = (DFF / 64) * (DM / 64), T_IN = (DM / 64) * (NIN / 64), T_OUT = (DM / 64) * (DM / 64);
    constexpr int T_LAYER = 2 * T_GU + 2 * T_D + T_IN + T_OUT;
    if (t1 <= 0) t1 = T_LAYER;
    for (int t = l0 * T_LAYER + first; t < l1 * T_LAYER; t += nwg) {
        const int l = t / T_LAYER; int r = t - l * T_LAYER; if (r < t0 || r >= t1) continue;
        bf16_t* wl = (bf16_t*)(P->ws + WS_W + (size_t)l * W_LAYER);
        const float* src; bf16_t* dst; const float* gain = nullptr; int K, Nsrc, kind, ntn;
        if (r < T_GU) { src = P->in[I_F1GU] + (size_t)l * DM * NGU; dst = (bf16_t*)((unsigned char*)wl + WO_GU1); gain = P->in[I_F1N] + l * DM; K = DM; Nsrc = NGU; kind = 1; ntn = NGU / 64; }
        else if ((r -= T_GU) < T_D) { src = P->in[I_F1D] + (size_t)l * DFF * DM; dst = (bf16_t*)((unsigned char*)wl + WO_D1); K = DFF; Nsrc = DM; kind = 0; ntn = DM / 64; }
        else if ((r -= T_D) < T_IN) { src = P->in[I_WIN] + (size_t)l * DM * DIN; dst = (bf16_t*)((unsigned char*)wl + WO_IN); gain = P->in[I_MIXN] + l * DM; K = DM; Nsrc = DIN; kind = 2; ntn = NIN / 64; }
        else if ((r -= T_IN) < T_OUT) { src = P->in[I_WOUT] + (size_t)l * DM * DM; dst = (bf16_t*)((unsigned char*)wl + WO_OUT); gain = P->in[I_FON] + l * FW; K = DM; Nsrc = DM; kind = 3; ntn = DM / 64; }
        else if ((r -= T_OUT) < T_GU) { src = P->in[I_F2GU] + (size_t)l * DM * NGU; dst = (bf16_t*)((unsigned char*)wl + WO_GU2); gain = P->in[I_F2N] + l * DM; K = DM; Nsrc = NGU; kind = 1; ntn = NGU / 64; }
        else { r -= T_GU; src = P->in[I_F2D] + (size_t)l * DFF * DM; dst = (bf16_t*)((unsigned char*)wl + WO_D2); K = DFF; Nsrc = DM; kind = 0; ntn = DM / 64; }
        convert_tile(src, dst, gain, K, Nsrc, kind, r / ntn, r % ntn, T);
    }
}
__device__ __forceinline__ void phase_init(PP P) {
    using namespace cfg;
    const int lane = ltid() & 63, gw = lbid() * 8 + (ltid() >> 6), nw = gridDim.x * 8;
    bf16_t* hb = (bf16_t*)(P->ws + WS_HB); float* ss0 = (float*)(P->ws + WS_SS);
    for (int row = gw; row < MROWS; row += nw) {
        const float* s = row < MMAIN ? P->in[I_X] + (size_t)row * DM : P->in[I_META] + (size_t)(row - MMAIN) * DM;
        float sq = 0.f;
#pragma unroll
        for (int i = 0; i < 4; ++i) { f32x4 v0 = (f32x4){0.f, 0.f, 0.f, 0.f}, v1 = v0; if (row < MMAIN + NMETA) { v0 = *(const f32x4*)(s + i * 512 + lane * 8); v1 = *(const f32x4*)(s + i * 512 + lane * 8 + 4); }
            sq += ((v0[0] * v0[0] + v0[1] * v0[1]) + (v0[2] * v0[2] + v0[3] * v0[3])) + ((v1[0] * v1[0] + v1[1] * v1[1]) + (v1[2] * v1[2] + v1[3] * v1[3]));
            u32x4 w; w.x = pk_bf16(v0[0], v0[1]); w.y = pk_bf16(v0[2], v0[3]); w.z = pk_bf16(v1[0], v1[1]); w.w = pk_bf16(v1[2], v1[3]); *(u32x4*)(hb + (size_t)row * DM + i * 512 + lane * 8) = w; }
        sq = wave_sum(sq);
        if (lane < 8) ss0[(size_t)lane * MROWS + row] = lane == 0 ? sq : 0.f;
        if (row >= MMAIN && row < MMAIN + NMETA) { float* ssm0 = (float*)(P->ws + WS_SSM); ssm0[lane * 16 + (row - MMAIN)] = lane == 0 ? sq : 0.f; ssm0[(64 + lane) * 16 + (row - MMAIN)] = 0.f; }
    }
}
__device__ __forceinline__ void phase_foxnorm(PP P) {
    using namespace cfg;
    const int lane = ltid() & 63, gw = lbid() * 8 + (ltid() >> 6), nw = gridDim.x * 8;
    bf16_t* y = (bf16_t*)(P->ws + WS_Y);
    for (int row0 = gw; row0 < MMAIN + NMETA; row0 += 4 * nw) {
        u32x4 a[4], b[4];
#pragma unroll
        for (int j = 0; j < 4; ++j) { const int row = row0 + j * nw; if (row < MMAIN + NMETA) { const bf16_t* p = y + (size_t)row * DM + 1024 + lane * 16; a[j] = *(const u32x4*)p; b[j] = *(const u32x4*)(p + 8); } else { a[j] = (u32x4){0u, 0u, 0u, 0u}; b[j] = a[j]; } }
#pragma unroll
        for (int j = 0; j < 4; ++j) { const int row = row0 + j * nw; float v[16];
#pragma unroll
            for (int i = 0; i < 4; ++i) { v[2 * i] = __uint_as_float(a[j][i] << 16); v[2 * i + 1] = __uint_as_float(a[j][i] & 0xffff0000u); v[8 + 2 * i] = __uint_as_float(b[j][i] << 16); v[8 + 2 * i + 1] = __uint_as_float(b[j][i] & 0xffff0000u); }
            float sq = 0.f;
#pragma unroll
            for (int i = 0; i < 16; ++i) sq += v[i] * v[i];
            sq = wave_sum_dpp(sq); const float rs = __builtin_amdgcn_rsqf(sq * (1.0f / 1024.0f) + NORM_EPS);
            u32x4 oa, ob;
#pragma unroll
            for (int i = 0; i < 4; ++i) { oa[i] = pk_bf16(v[2 * i] * rs, v[2 * i + 1] * rs); ob[i] = pk_bf16(v[8 + 2 * i] * rs, v[8 + 2 * i + 1] * rs); }
            if (row < MMAIN + NMETA) { bf16_t* p = y + (size_t)row * DM + 1024 + lane * 16; *(u32x4*)p = oa; *(u32x4*)(p + 8) = ob; } }
    }
}
__device__ __forceinline__ void phase_final(PP P) {
    using namespace cfg;
    const int lane = ltid() & 63, gw = lbid() * 8 + (ltid() >> 6), nw = gridDim.x * 8;
    const float* g = P->in[I_FINN]; const bf16_t* hb = (const bf16_t*)(P->ws + WS_HB);
    for (int row = gw; row < MMAIN; row += nw) {
        float* d = P->out + (size_t)row * DM; f32x4 v[8]; float sq = 0.f;
#pragma unroll
        for (int i = 0; i < 4; ++i) { const u32x4 x = *(const u32x4*)(hb + (size_t)row * DM + i * 512 + lane * 8);
            v[2 * i] = (f32x4){__uint_as_float(x.x << 16), __uint_as_float(x.x & 0xffff0000u), __uint_as_float(x.y << 16), __uint_as_float(x.y & 0xffff0000u)};
            v[2 * i + 1] = (f32x4){__uint_as_float(x.z << 16), __uint_as_float(x.z & 0xffff0000u), __uint_as_float(x.w << 16), __uint_as_float(x.w & 0xffff0000u)}; }
#pragma unroll
        for (int i = 0; i < 8; ++i) sq += (v[i][0] * v[i][0] + v[i][1] * v[i][1]) + (v[i][2] * v[i][2] + v[i][3] * v[i][3]);
        sq = wave_sum(sq); const float rs = __builtin_amdgcn_rsqf(sq * (1.0f / 2048.0f) + NORM_EPS);
#pragma unroll
        for (int i = 0; i < 4; ++i) { const f32x4 g0 = *(const f32x4*)(g + i * 512 + lane * 8), g1 = *(const f32x4*)(g + i * 512 + lane * 8 + 4);
            *(f32x4*)(d + i * 512 + lane * 8) = v[2 * i] * rs * g0; *(f32x4*)(d + i * 512 + lane * 8 + 4) = v[2 * i + 1] * rs * g1; }
    }
}


__device__ __forceinline__ void phase_lx(PP P, int l) {
    using namespace cfg;
    const int lane = ltid() & 63, gw = lbid() * 8 + (ltid() >> 6), nw = gridDim.x * 8;
    const float* PS = (const float*)(P->ws + WS_PS); bf16_t* LXG = (bf16_t*)(P->ws + WS_LXG); const float* mu = P->in[I_MU] + l * RWKV_COLS + 3072;
    if (lane < 36) {
        const f32x4 m0 = *(const f32x4*)(mu + lane * 8), m1 = *(const f32x4*)(mu + lane * 8 + 4);
#pragma unroll 4
        for (int row = gw; row < MMAIN + NMETA; row += nw) {
            int prev; if (row >= MMAIN) prev = (row == MMAIN) ? -1 : row - 1; else prev = ((row & (SEQ - 1)) == 0) ? MMAIN + NMETA - 1 : row - 1;
            const f32x4 c0 = *(const f32x4*)(PS + (size_t)row * PSW + lane * 8), c1 = *(const f32x4*)(PS + (size_t)row * PSW + lane * 8 + 4);
            f32x4 p0 = (f32x4){0.f, 0.f, 0.f, 0.f}, p1 = p0; if (prev >= 0) { p0 = *(const f32x4*)(PS + (size_t)prev * PSW + lane * 8); p1 = *(const f32x4*)(PS + (size_t)prev * PSW + lane * 8 + 4); }
            float x[8];
#pragma unroll
            for (int j = 0; j < 4; ++j) { x[j] = c0[j] + (p0[j] - c0[j]) * m0[j]; x[4 + j] = c1[j] + (p1[j] - c1[j]) * m1[j]; }
#pragma unroll
            for (int j = 0; j < 8; ++j) x[j] = lane < 8 ? 1.0f - 2.0f * __builtin_amdgcn_rcpf(__expf(2.0f * x[j]) + 1.0f) : (lane < 16 ? x[j] : __builtin_amdgcn_rcpf(1.0f + __expf(-x[j])));
            u32x4 w; w.x = pk_bf16(x[0], x[1]); w.y = pk_bf16(x[2], x[3]); w.z = pk_bf16(x[4], x[5]); w.w = pk_bf16(x[6], x[7]);
            *(u32x4*)(LXG + (size_t)row * 320 + lane * 8) = w;
        }
    }
}

typedef short bf16x8_t __attribute__((ext_vector_type(8)));
typedef short bf16x4_t __attribute__((ext_vector_type(4)));
namespace rk {
constexpr int RAWF = 0, RAWF_SZ = 18432, RAWH = 55296, RAWH_SZ = 6144, LXB = 73728, RS = 82944, KS = 87040, VS = 91136, KKN = 95232, ATP = 99328, RTP = 101376, BTP = 103424, KTP = 105472,
              BHT = 107520, KHT = 109568, VT = 111616, GT = 113664, AAK = 113920, RB = 114432, RKM = 114944, TINV = 115456, GG = 115968  , VF = 124160  , YR = 132352, BONP = 136448  , LDS_END = 136960;
}
#define RK_BAR() do { asm volatile("s_waitcnt lgkmcnt(0)" ::: "memory"); __builtin_amdgcn_s_barrier(); asm volatile("" ::: "memory"); } while (0)
__device__ __forceinline__ bf16_t bf1(float x) { return (bf16_t)(pk_bf16(x, 0.f) & 0xffffu); }
__device__ __forceinline__ bf16x4_t pack4(float a, float b, float c, float d) { u32x2 w; w.x = pk_bf16(a, b); w.y = pk_bf16(c, d); return __builtin_bit_cast(bf16x4_t, w); }
__device__ __forceinline__ float fast_sigmoid(float x) { return __builtin_amdgcn_rcpf(1.0f + __expf(-x)); }
__device__ __forceinline__ float fast_tanh(float x) { return 1.0f - 2.0f * __builtin_amdgcn_rcpf(__expf(2.0f * x) + 1.0f); }

__device__ __forceinline__ void rwkv_chunked(PP P, int l, int b, int h, LAS unsigned char* lds) {
    using namespace cfg;
    const int tid = ltid(), lane = tid & 63, wave = __builtin_amdgcn_readfirstlane(tid >> 6), n = lane & 15, g = lane >> 4;
    const bf16_t* PR = (const bf16_t*)(P->ws + WS_PR); const float* PS = (const float*)(P->ws + WS_PS); bf16_t* Y = (bf16_t*)(P->ws + WS_Y);
    const float* mu = P->in[I_MU] + l * RWKV_COLS; const bf16_t* LXGp = (const bf16_t*)(P->ws + WS_LXG);
    LAS float* RSm = (LAS float*)(lds + rk::RS); LAS float* KSm = (LAS float*)(lds + rk::KS); LAS float* VSm = (LAS float*)(lds + rk::VS); LAS float* KKNm = (LAS float*)(lds + rk::KKN);
    LAS bf16_t* ATp = (LAS bf16_t*)(lds + rk::ATP); LAS bf16_t* RTp = (LAS bf16_t*)(lds + rk::RTP); LAS bf16_t* BTp = (LAS bf16_t*)(lds + rk::BTP); LAS bf16_t* KTp = (LAS bf16_t*)(lds + rk::KTP);
    LAS bf16_t* BHt = (LAS bf16_t*)(lds + rk::BHT); LAS bf16_t* KHt = (LAS bf16_t*)(lds + rk::KHT); LAS bf16_t* Vt = (LAS bf16_t*)(lds + rk::VT);
    LAS float* GTm = (LAS float*)(lds + rk::GT);
    LAS bf16_t* AAKm = (LAS bf16_t*)(lds + rk::AAK); LAS bf16_t* RBm = (LAS bf16_t*)(lds + rk::RB); LAS bf16_t* RKm = (LAS bf16_t*)(lds + rk::RKM); LAS bf16_t* TINVm = (LAS bf16_t*)(lds + rk::TINV);
    LAS float* YRm = (LAS float*)(lds + rk::YR);
    const int hj = h * 64 + lane;
    const float mur = mu[hj], muk = mu[1024 + hj], muv = mu[2048 + hj], kkw = P->in[I_KK][l * RW + hj], lnw = P->in[I_LNW][l * RW + hj], lnb = P->in[I_LNB][l * RW + hj];
    float mul[5];
#pragma unroll
    for (int q = 0; q < 5; ++q) mul[q] = (lane + 64 * q < 288) ? mu[3072 + lane + 64 * q] : 0.f;
    const int kw = wave & 3, key = 16 * kw + n, hk = h * 64 + key;
    const float w0k = P->in[I_W0][l * RW + hk], a0k = P->in[I_A0][l * RW + hk], kak = P->in[I_KA][l * RW + hk], rkk = P->in[I_RK][l * RW + hk];
    const int pp = 32 * (key >> 5) + 8 * ((key >> 2) & 3) + 4 * ((key >> 4) & 1) + (key & 3);
    bf16x8_t fA[2], fB[5];
    {
        const float* wu = P->in[I_WUP] + (size_t)l * 64 * RW + hk; const float* au = P->in[I_AUP] + (size_t)l * 64 * RW + hk; const float* gu = P->in[I_GUP] + (size_t)l * 160 * RW + hk;
#pragma unroll
        for (int s = 0; s < 5; ++s) { float v[8], u[8];
#pragma unroll
            for (int j = 0; j < 8; ++j) { const int k = 32 * s + 8 * g + j; v[j] = (wave < 4) ? (s < 2 ? au[(size_t)k * RW] : 0.f) : gu[(size_t)k * RW]; u[j] = (wave < 4 && s < 2) ? wu[(size_t)k * RW] : 0.f; }
            u32x4 w; w.x = pk_bf16(v[0], v[1]); w.y = pk_bf16(v[2], v[3]); w.z = pk_bf16(v[4], v[5]); w.w = pk_bf16(v[6], v[7]); fB[s] = __builtin_bit_cast(bf16x8_t, w);
            if (s < 2) { u32x4 x; x.x = pk_bf16(u[0], u[1]); x.y = pk_bf16(u[2], u[3]); x.z = pk_bf16(u[4], u[5]); x.w = pk_bf16(u[6], u[7]); fA[s] = __builtin_bit_cast(bf16x8_t, x); } }
    }
    f32x4 ST[4];
#pragma unroll
    for (int kb = 0; kb < 4; ++kb) ST[kb] = (f32x4){0.f, 0.f, 0.f, 0.f};
#define RK_DMA(c_) do { const int cc_ = (c_); const int row0_ = (cc_ == 0) ? MMAIN : b * SEQ + (cc_ - 1) * 16; const int bi_ = cc_ % 3; \
        _Pragma("unroll") for (int i_ = 0; i_ < 2; ++i_) { const int wp_ = (i_ == 0) ? wave : 8; if (i_ == 0 || wave == 6) { const int x_ = wp_ * 64 + lane; \
            __builtin_amdgcn_global_load_lds((const unsigned*)(LXGp + (size_t)(row0_ + x_ / 36) * 320 + (x_ % 36) * 8), (LAS unsigned*)(lds + rk::RAWF + (cc_ & 1) * rk::RAWF_SZ + wp_ * 1024), 16, 0, 0); } } \
        if (wave < 6) { const int y_ = wave * 64 + lane; \
            __builtin_amdgcn_global_load_lds((const unsigned*)(PR + (size_t)(row0_ + y_ / 24) * PRW + ((y_ % 24) >> 3) * 1024 + h * 64 + (y_ & 7) * 8), (LAS unsigned*)(lds + rk::RAWH + bi_ * rk::RAWH_SZ + wave * 1024), 16, 0, 0); } } while (0)
#define RK_STAGE_A(ca_, t_) do { const int t = (t_); const int bc_ = (ca_) % 3, bp_ = ((ca_) + 2) % 3; \
        LAS const float* cF_ = (LAS const float*)(lds + rk::RAWF + bc_ * rk::RAWF_SZ); LAS const float* pF_ = (LAS const float*)(lds + rk::RAWF + bp_ * rk::RAWF_SZ); \
        LAS const bf16_t* cH_ = (LAS const bf16_t*)(lds + rk::RAWH + bc_ * rk::RAWH_SZ); LAS const bf16_t* pH_ = (LAS const bf16_t*)(lds + rk::RAWH + bp_ * rk::RAWH_SZ); \
        LAS const float* ctF = cF_ + t * 288; LAS const float* ptF = (t == 0) ? pF_ + 15 * 288 : cF_ + (t - 1) * 288; \
        LAS const bf16_t* ctH = cH_ + t * 192; LAS const bf16_t* ptH = (t == 0) ? pH_ + 15 * 192 : cH_ + (t - 1) * 192; \
        const float rc = bf2f(ctH[lane]), kc = bf2f(ctH[64 + lane]), vc = bf2f(ctH[128 + lane]); \
        const float rs = rc + (bf2f(ptH[lane]) - rc) * mur, ks = kc + (bf2f(ptH[64 + lane]) - kc) * muk, vs = vc + (bf2f(ptH[128 + lane]) - vc) * muv; \
        RSm[t * 64 + lane] = rs; KSm[t * 64 + lane] = ks; VSm[t * 64 + lane] = vs; \
        const float kkr = ks * kkw; const float n2 = wave_sum_dpp(kkr * kkr); KKNm[t * 64 + lane] = kkr * __builtin_amdgcn_rsqf(fmaxf(n2, 1e-24f)); } while (0)
#define RK_STAGE_F(cf_, t_) do { const int t = (t_); const int par_ = (cf_) & 1; const int rowF_ = ((cf_) == 0) ? MMAIN : b * SEQ + ((cf_) - 1) * 16; \
        LAS const float* Gp_ = (LAS const float*)(lds + rk::GG + par_ * 4096); LAS const float* Vp_ = (LAS const float*)(lds + rk::VF + par_ * 4096); LAS const float* Bp_ = (LAS const float*)(lds + rk::BONP + par_ * 256); \
        const float yv = YRm[t * 64 + lane]; \
        const float mean = wave_sum_dpp(yv) * (1.0f / 64.0f); const float d = yv - mean; const float var = wave_sum_dpp(d * d) * (1.0f / 64.0f); \
        const float yn = d * __builtin_amdgcn_rsqf(var + LNX_EPS) * lnw + lnb; \
        const float bonus = (Bp_[t] + Bp_[16 + t]) + (Bp_[32 + t] + Bp_[48 + t]); \
        const float o = (yn + bonus * Vp_[t * 64 + lane]) * Gp_[t * 64 + lane]; \
        if ((cf_) > 0 || b == 0) Y[(size_t)(rowF_ + t) * DM + hj] = bf1(o); } while (0)
    RK_DMA(0); RK_DMA(1);
    for (int e = tid; e < 96; e += 512) ((LAS unsigned*)(lds + rk::RAWH + 2 * rk::RAWH_SZ))[15 * 96 + e] = 0u;
    asm volatile("s_waitcnt vmcnt(0)" ::: "memory");
    RK_BAR();
    RK_STAGE_A(0, wave); RK_STAGE_A(0, wave + 8);
    RK_BAR();
#pragma unroll 1
    for (int c = 0; c < 257; ++c) {
        if (wave < 4) {
            LAS float* BONPc = (LAS float*)(lds + rk::BONP + (c & 1) * 256); LAS const bf16_t* LXB = (LAS const bf16_t*)(lds + rk::RAWF + (c & 1) * rk::RAWF_SZ);
            f32x4 accW = (f32x4){0.f, 0.f, 0.f, 0.f}, accA = accW;
#pragma unroll
            for (int s = 0; s < 2; ++s) { const bf16x8_t aw = *(const LAS bf16x8_t*)(LXB + n * 288 + 32 * s + 8 * g), aa = *(const LAS bf16x8_t*)(LXB + n * 288 + 64 + 32 * s + 8 * g);
                accW = __builtin_amdgcn_mfma_f32_16x16x32_bf16(aw, fA[s], accW, 0, 0, 0); accA = __builtin_amdgcn_mfma_f32_16x16x32_bf16(aa, fB[s], accA, 0, 0, 0); }
            float lw[4], alr[4], pfx[4];
#pragma unroll
            for (int r = 0; r < 4; ++r) { lw[r] = -0.6065306597126334f * fast_sigmoid(accW[r] + w0k); alr[r] = fast_sigmoid(accA[r] + a0k); }
            pfx[0] = lw[0]; pfx[1] = pfx[0] + lw[1]; pfx[2] = pfx[1] + lw[2]; pfx[3] = pfx[2] + lw[3];
            const float t0 = __shfl(pfx[3], n), t1 = __shfl(pfx[3], n + 16), t2 = __shfl(pfx[3], n + 32), t3 = __shfl(pfx[3], n + 48);
            const float base = (g > 0 ? t0 : 0.f) + (g > 1 ? t1 : 0.f) + (g > 2 ? t2 : 0.f), lamT = (t0 + t1) + (t2 + t3);
            float bh[4], kh[4], bon[4], epos[4];
            const float eb = __expf(base), eT = __expf(lamT);
#pragma unroll
            for (int r = 0; r < 4; ++r) epos[r] = __expf(base + pfx[r]);
#pragma unroll
            for (int r = 0; r < 4; ++r) { const int t = 4 * g + r;
                const float e_pos = epos[r], e_neg = __builtin_amdgcn_rcpf(epos[r]), e_prev = (r == 0) ? eb : epos[r > 0 ? r - 1 : 0], e_hat = eT * e_neg;
                const float rs = RSm[t * 64 + key], ks = KSm[t * 64 + key], kk = KKNm[t * 64 + key];
                const float kmod = ks * (1.0f + (alr[r] - 1.0f) * kak), bb = kk * alr[r];
                ATp[t * 64 + pp] = bf1(-kk * e_prev); RTp[t * 64 + pp] = bf1(rs * e_pos); BTp[t * 64 + pp] = bf1(bb * e_neg); KTp[t * 64 + pp] = bf1(kmod * e_neg);
                bh[r] = bb * e_hat; kh[r] = kmod * e_hat; bon[r] = rs * kmod * rkk; }
            *(LAS bf16x4_t*)(BHt + key * 16 + 4 * g) = pack4(bh[0], bh[1], bh[2], bh[3]); *(LAS bf16x4_t*)(KHt + key * 16 + 4 * g) = pack4(kh[0], kh[1], kh[2], kh[3]);
#pragma unroll
            for (int r = 0; r < 4; ++r) { const float x = row_sum16(bon[r]); if (n == 0) BONPc[kw * 16 + 4 * g + r] = x; }
            if (g == 0) GTm[key] = eT;
        } else {
            LAS float* Gc = (LAS float*)(lds + rk::GG + (c & 1) * 4096); LAS float* VFc = (LAS float*)(lds + rk::VF + (c & 1) * 4096); LAS const bf16_t* LXB = (LAS const bf16_t*)(lds + rk::RAWF + (c & 1) * rk::RAWF_SZ);
            f32x4 accG = (f32x4){0.f, 0.f, 0.f, 0.f};
#pragma unroll
            for (int s = 0; s < 5; ++s) { const bf16x8_t ag = *(const LAS bf16x8_t*)(LXB + n * 288 + 128 + 32 * s + 8 * g); accG = __builtin_amdgcn_mfma_f32_16x16x32_bf16(ag, fB[s], accG, 0, 0, 0); }
            float vv[4];
#pragma unroll
            for (int r = 0; r < 4; ++r) { Gc[(4 * g + r) * 64 + key] = accG[r]; vv[r] = VSm[(4 * g + r) * 64 + key]; VFc[(4 * g + r) * 64 + key] = vv[r]; }
            *(LAS bf16x4_t*)(Vt + key * 16 + 4 * g) = pack4(vv[0], vv[1], vv[2], vv[3]);
            if (c >= 1) { RK_STAGE_F(c - 1, 4 * kw); RK_STAGE_F(c - 1, 4 * kw + 1); RK_STAGE_F(c - 1, 4 * kw + 2); RK_STAGE_F(c - 1, 4 * kw + 3); }
        }
        asm volatile("s_waitcnt vmcnt(0)" ::: "memory");
        RK_BAR();
        if (c + 2 < 257) RK_DMA(c + 2);
        if (wave < 4) {
            LAS const bf16_t* X = (wave < 2) ? ATp : RTp; LAS const bf16_t* Yi = (wave & 1) ? KTp : BTp;
            f32x4 acc = (f32x4){0.f, 0.f, 0.f, 0.f};
#pragma unroll
            for (int s = 0; s < 2; ++s) { const bf16x8_t xa = *(const LAS bf16x8_t*)(X + n * 64 + 32 * s + 8 * g), yb = *(const LAS bf16x8_t*)(Yi + n * 64 + 32 * s + 8 * g);
                acc = __builtin_amdgcn_mfma_f32_16x16x32_bf16(xa, yb, acc, 0, 0, 0); }
            float mv[4];
#pragma unroll
            for (int r = 0; r < 4; ++r) { const int t = 4 * g + r; const bool keep = (wave < 2) ? (n < t) : (n <= t); mv[r] = keep ? acc[r] : 0.f;
                if (wave == 1) AAKm[t * 16 + n] = bf1(mv[r]); else if (wave == 2) RBm[t * 16 + n] = bf1(mv[r]); else if (wave == 3) RKm[t * 16 + n] = bf1(mv[r]); }
            if (wave == 0) {
                float Tc[16];
#pragma unroll
                for (int t = 0; t < 16; ++t) { float v0 = (t == n) ? 1.0f : 0.0f, v1 = 0.f;
#pragma unroll
                    for (int i = 0; i < t; ++i) { const float a = rdlane(mv[t & 3], i + 16 * (t >> 2)); if (i & 1) v1 += a * Tc[i]; else v0 += a * Tc[i]; }
                    Tc[t] = v0 + v1; asm volatile("" : "+v"(mv[0]), "+v"(mv[1]), "+v"(mv[2]), "+v"(mv[3]));     }
                if (g == 0) {
#pragma unroll
                    for (int t = 0; t < 16; ++t) TINVm[t * 16 + n] = bf1(Tc[t]); }
            }
        }
        if (wave >= 1) {
            if (c + 1 < 257 && wave != 4) { const int t0_ = (wave < 4) ? 3 * (wave - 1) : (wave == 5 ? 9 : 12 + 2 * (wave - 6));
                RK_STAGE_A(c + 1, t0_); RK_STAGE_A(c + 1, t0_ + 1); if (wave < 6) RK_STAGE_A(c + 1, t0_ + 2); }
        }
        RK_BAR();
        if (wave < 4) {
            bf16x8_t sb[2];
#pragma unroll
            for (int s = 0; s < 2; ++s) { u32x4 w; w.x = pk_bf16(ST[2 * s][0], ST[2 * s][1]); w.y = pk_bf16(ST[2 * s][2], ST[2 * s][3]); w.z = pk_bf16(ST[2 * s + 1][0], ST[2 * s + 1][1]); w.w = pk_bf16(ST[2 * s + 1][2], ST[2 * s + 1][3]);
                sb[s] = __builtin_bit_cast(bf16x8_t, w); }
            const bf16x4_t vfr = *(const LAS bf16x4_t*)(Vt + key * 16 + 4 * g);
            f32x4 W1 = (f32x4){0.f, 0.f, 0.f, 0.f}, Yc = W1;
#pragma unroll
            for (int s = 0; s < 2; ++s) { const bf16x8_t af = *(const LAS bf16x8_t*)(ATp + n * 64 + 32 * s + 8 * g), rf = *(const LAS bf16x8_t*)(RTp + n * 64 + 32 * s + 8 * g);
                W1 = __builtin_amdgcn_mfma_f32_16x16x32_bf16(af, sb[s], W1, 0, 0, 0); Yc = __builtin_amdgcn_mfma_f32_16x16x32_bf16(rf, sb[s], Yc, 0, 0, 0); }
            W1 = __builtin_amdgcn_mfma_f32_16x16x16bf16_1k(*(const LAS bf16x4_t*)(AAKm + n * 16 + 4 * g), vfr, W1, 0, 0, 0);
            const bf16x4_t w1f = pack4(W1[0], W1[1], W1[2], W1[3]);
            f32x4 U = __builtin_amdgcn_mfma_f32_16x16x16bf16_1k(*(const LAS bf16x4_t*)(TINVm + n * 16 + 4 * g), w1f, (f32x4){0.f, 0.f, 0.f, 0.f}, 0, 0, 0);
            const bf16x4_t uf = pack4(U[0], U[1], U[2], U[3]);
            Yc = __builtin_amdgcn_mfma_f32_16x16x16bf16_1k(*(const LAS bf16x4_t*)(RBm + n * 16 + 4 * g), uf, Yc, 0, 0, 0);
            Yc = __builtin_amdgcn_mfma_f32_16x16x16bf16_1k(*(const LAS bf16x4_t*)(RKm + n * 16 + 4 * g), vfr, Yc, 0, 0, 0);
#pragma unroll
            for (int r = 0; r < 4; ++r) YRm[(4 * g + r) * 64 + key] = Yc[r];
#pragma unroll
            for (int kb = 0; kb < 4; ++kb) { const f32x4 gt = *(const LAS f32x4*)(GTm + 16 * kb + 4 * g); f32x4 a = ST[kb] * gt;
                a = __builtin_amdgcn_mfma_f32_16x16x16bf16_1k(*(const LAS bf16x4_t*)(BHt + (16 * kb + n) * 16 + 4 * g), uf, a, 0, 0, 0);
                a = __builtin_amdgcn_mfma_f32_16x16x16bf16_1k(*(const LAS bf16x4_t*)(KHt + (16 * kb + n) * 16 + 4 * g), vfr, a, 0, 0, 0);
                ST[kb] = a; }
        }
        RK_BAR();
    }
    RK_STAGE_F(256, wave); RK_STAGE_F(256, wave + 8);
    asm volatile("s_waitcnt vmcnt(0)" ::: "memory");
    RK_BAR();
#undef RK_DMA
#undef RK_STAGE_A
#undef RK_STAGE_F
}

__device__ __forceinline__ f32x4 sk_dot(const bf16_t* a, const bf16_t* b, int nsteps) {
    f32x4 acc = (f32x4){0.f, 0.f, 0.f, 0.f};
#pragma unroll 8
    for (int s = 0; s < nsteps; ++s) { const bf16x8_t av = *(const bf16x8_t*)(a + 32 * s), bv = *(const bf16x8_t*)(b + 32 * s); acc = __builtin_amdgcn_mfma_f32_16x16x32_bf16(av, bv, acc, 0, 0, 0); }
    return acc; }
__device__ __forceinline__ void meta_rs(const float* ssm, int lane, float (&rs)[4]) {
    const int row = lane & 15, part = lane >> 4; float s = 0.f;
#pragma unroll 8
    for (int i = 0; i < 32; ++i) s += ssm[(part + 4 * i) * 16 + row];
    s = s + __shfl_xor(s, 16); s = s + __shfl_xor(s, 32);
    const float rv = __builtin_amdgcn_rsqf(s * (1.0f / 2048.0f) + 1e-6f);
#pragma unroll
    for (int r = 0; r < 4; ++r) rs[r] = __shfl(rv, 4 * part + r); }
#define SK_HEAD const int tid = ltid(), lane = tid & 63, wave = __builtin_amdgcn_readfirstlane(tid >> 6), n = lane & 15, g = lane >> 4, kq = wave & 3, ti = lbid() + 256 * (wave >> 2); LAS f32x4* part = (LAS f32x4*)lds;
#define SK_COMBINE(dst, slot) do { dst = (part[((wave) * 2 + (slot)) * 64 + lane] + part[((wave + 1) * 2 + (slot)) * 64 + lane]) + (part[((wave + 2) * 2 + (slot)) * 64 + lane] + part[((wave + 3) * 2 + (slot)) * 64 + lane]); } while (0)
__device__ __forceinline__ void skinny_gu(const bf16_t* hb, const bf16_t* Bt, const float* ssm, bf16_t* act, LAS unsigned char* lds) {
    using namespace cfg; SK_HEAD
    if (ti < DFF / 16) { const int c0 = 16 * ti, brow = (c0 >> 7) * 256 + (c0 & 127) + n; const bf16_t* a = hb + (size_t)(MMAIN + n) * DM + 512 * kq + 8 * g;
        part[(wave * 2) * 64 + lane] = sk_dot(a, Bt + (size_t)brow * DM + 512 * kq + 8 * g, 16); part[(wave * 2 + 1) * 64 + lane] = sk_dot(a, Bt + (size_t)(brow + 128) * DM + 512 * kq + 8 * g, 16); }
    __syncthreads();
    if (ti < DFF / 16 && kq == 0) { f32x4 gt, up; SK_COMBINE(gt, 0); SK_COMBINE(up, 1); float rs[4]; meta_rs(ssm, lane, rs);
#pragma unroll
        for (int r = 0; r < 4; ++r) { const float gv = gt[r] * rs[r], uv = up[r] * rs[r]; act[(size_t)(MMAIN + 4 * g + r) * DFF + 16 * ti + n] = bf1(gv * __builtin_amdgcn_rcpf(1.0f + __builtin_amdgcn_exp2f(-1.4426950408889634f * gv)) * uv); } }
    __syncthreads();
}
__device__ __forceinline__ void skinny_res(const bf16_t* A16, int K, const bf16_t* Bt, bf16_t* hb, float* ssm_out, float alpha, LAS unsigned char* lds) {
    using namespace cfg;
    const int tid = ltid(), lane = tid & 63, wave = __builtin_amdgcn_readfirstlane(tid >> 6), n = lane & 15, g = lane >> 4, ti = lbid(); LAS f32x4* part = (LAS f32x4*)lds;
    const int k8 = K / 8;
    if (ti < DM / 16) part[wave * 64 + lane] = sk_dot(A16 + (size_t)n * K + k8 * wave + 8 * g, Bt + (size_t)(16 * ti + n) * K + k8 * wave + 8 * g, k8 / 32);
    __syncthreads();
    if (ti < DM / 16 && wave == 0) { const f32x4 acc = ((part[lane] + part[64 + lane]) + (part[128 + lane] + part[192 + lane])) + ((part[256 + lane] + part[320 + lane]) + (part[384 + lane] + part[448 + lane]));
#pragma unroll
        for (int r = 0; r < 4; ++r) { const int m = 4 * g + r, col = 16 * ti + n; bf16_t* p = hb + (size_t)(MMAIN + m) * DM + col; const float hv = bf2f(*p) + alpha * acc[r]; *p = bf1(hv);
            const float sq = row_sum16(hv * hv); if (n == 0) ssm_out[ti * 16 + m] = sq; } }
    __syncthreads();
}
__device__ __forceinline__ void skinny_p(const bf16_t* hb, const bf16_t* Bt, const float* ssm, bf16_t* pr, float* ps, bf16_t* qkv, LAS unsigned char* lds) {
    using namespace cfg; SK_HEAD
    if (ti < NIN / 16) part[(wave * 2) * 64 + lane] = sk_dot(hb + (size_t)(MMAIN + n) * DM + 512 * kq + 8 * g, Bt + (size_t)(16 * ti + n) * DM + 512 * kq + 8 * g, 16);
    __syncthreads();
    if (ti < NIN / 16 && kq == 0) { f32x4 acc; SK_COMBINE(acc, 0); float rs[4]; meta_rs(ssm, lane, rs); const int np = 16 * ti + n;
#pragma unroll
        for (int r = 0; r < 4; ++r) { const int m = 4 * g + r; const float v = acc[r] * rs[r];
            if (np < 3072) pr[(size_t)(MMAIN + m) * PRW + np] = bf1(v);
            else if (np < 3584) ps[(size_t)(MMAIN + m) * PSW + (np - 3072)] = v;
            else { const bf16_t w = bf1(v);
#pragma unroll
                for (int b = 0; b < NBATCH; ++b) qkv[((size_t)b * SEQP + 48 + m) * QKVW + (np - 3584)] = w; } } }
    __syncthreads();
}
#undef SK_HEAD
#undef SK_COMBINE

namespace fox {
constexpr int D = 128, NW = 8, QBLK = 32, KVBLK = 64, QB = NW * QBLK;
constexpr int LDQ = cfg::QKVW, LDK = cfg::QKVW, LDO = cfg::DM;
constexpr float SCALE = 0.08838834764831845f, THR = 8.f;
constexpr bool WSKIP = false;
constexpr int SHM_V = KVBLK * D * 2, SHM_K = KVBLK * D * 2;
constexpr int ATT_LDS = 2 * SHM_V + 2 * SHM_K + NW * 64 * 4;
constexpr int BIAS_OFF = ATT_LDS;
constexpr int SCAN_OFF = BIAS_OFF + cfg::SEQP * 4;

using bf16 = __hip_bfloat16;
typedef short bf16x8 __attribute__((ext_vector_type(8)));
typedef short s16x4 __attribute__((ext_vector_type(4)));
typedef float f32x16 __attribute__((ext_vector_type(16)));
typedef float f32x4 __attribute__((ext_vector_type(4)));
typedef unsigned u32x4 __attribute__((ext_vector_type(4)));
template <class A, class Bt> struct same_t { static constexpr bool v = false; };
template <class A> struct same_t<A, A> { static constexpr bool v = true; };

#define KSWZ(row, colB) ((row) * 256 + ((colB) ^ (((row) & 7) << 4)))
#define SBAR() __builtin_amdgcn_sched_barrier(0)
__device__ __forceinline__ int v_st(int k, int c) { const int kk = (k & ~0xC) | ((k & 4) << 1) | ((k & 8) >> 1); return ((kk >> 3) * 4 + (c >> 5)) * 512 + ((kk & 7) * 32 + (c & 31)) * 2; }
__device__ __forceinline__ int v_rd_base(int lane) { return ((lane & 3) << 3) | (((lane >> 2) & 3) << 6) | (((lane >> 4) & 1) << 5) | (((lane >> 5) & 1) << 8); }
constexpr int v_rd_off(int d0, int ks, int half) { return d0 * 512 + ks * 4096 + half * 2048; }
__device__ __forceinline__ int crow(int r, int hi) { return (r & 3) + 8 * (r >> 2) + 4 * hi; }
__device__ __forceinline__ unsigned cvtpk(float lo, float hi) {
    unsigned r; asm volatile("v_cvt_pk_bf16_f32 %0, %1, %2" : "=v"(r) : "v"(lo), "v"(hi)); return r;
}
__device__ __forceinline__ bf16x8 pack8(f32x4 a, f32x4 b) {
    u32x4 w = {cvtpk(a[0], a[1]), cvtpk(a[2], a[3]), cvtpk(b[0], b[1]), cvtpk(b[2], b[3])};
    return *reinterpret_cast<bf16x8*>(&w);
}
template <class T> __device__ __forceinline__ bf16x8 load8(const T* p) {
    if constexpr (same_t<T, float>::v) { return pack8(*(const f32x4*)p, *(const f32x4*)(p + 4)); }
    else { return *reinterpret_cast<const bf16x8*>(p); }
}
__device__ __forceinline__ void mask_tile(f32x16& p0, f32x16& p1, int dq, unsigned W) {
    const float NEG = -__builtin_inff();
#pragma unroll
    for (int r = 0; r < 16; ++r) {
        const int c = (r & 3) + 8 * (r >> 2);
        if ((unsigned)(dq - c) >= W) p0[r] = NEG;
        if ((unsigned)(dq - c - 32) >= W) p1[r] = NEG;
    }
}
__device__ __forceinline__ void partialSM(f32x16& p0, f32x16& p1, float& m_reg, float& mn, float& alpha) {
    float pmax = p0[0]; for (int r = 1; r < 16; ++r) pmax = fmaxf(pmax, p0[r]); for (int r = 0; r < 16; ++r) pmax = fmaxf(pmax, p1[r]);
    { auto rr = __builtin_amdgcn_permlane32_swap(__float_as_uint(pmax), __float_as_uint(pmax), false, false);
      pmax = fmaxf(__uint_as_float(rr[0]), __uint_as_float(rr[1])); }
    constexpr float C2 = 1.4426950408889634f * SCALE;
    if (__builtin_expect(__all((pmax - m_reg) * SCALE <= THR), 1)) { mn = m_reg; alpha = 1.f; }
    else { mn = fmaxf(m_reg, pmax); alpha = __builtin_amdgcn_exp2f((m_reg - mn) * C2); m_reg = mn; }
    const float mnL = -mn * C2;
    for (int r = 0; r < 16; ++r) p0[r] = fmaf(p0[r], C2, mnL); for (int r = 0; r < 16; ++r) p1[r] = fmaf(p1[r], C2, mnL);
    for (int r = 0; r < 16; ++r) p0[r] = __builtin_amdgcn_exp2f(p0[r]);
}
__device__ __forceinline__ void finishSM(f32x16& p0, f32x16& p1, float alpha, float& l_reg, bf16x8& pa0, bf16x8& pa1, bf16x8& pa2, bf16x8& pa3) {
    for (int r = 0; r < 16; ++r) p1[r] = __builtin_amdgcn_exp2f(p1[r]);
    float ps = 0; for (int r = 0; r < 16; ++r) ps += p0[r]; for (int r = 0; r < 16; ++r) ps += p1[r];
    { auto rr = __builtin_amdgcn_permlane32_swap(__float_as_uint(ps), __float_as_uint(ps), false, false);
      ps = __uint_as_float(rr[0]) + __uint_as_float(rr[1]); }
    l_reg = l_reg * alpha + ps;
#define PK4(P, B_, OUT) do { unsigned a0 = cvtpk(P[B_+0], P[B_+1]), a1 = cvtpk(P[B_+2], P[B_+3]);                          \
        unsigned b0 = cvtpk(P[B_+4], P[B_+5]), b1 = cvtpk(P[B_+6], P[B_+7]);                                             \
        auto r0 = __builtin_amdgcn_permlane32_swap(a0, b0, false, false); auto r1 = __builtin_amdgcn_permlane32_swap(a1, b1, false, false); \
        u32x4 w = {r0[0], r1[0], r0[1], r1[1]}; OUT = *reinterpret_cast<bf16x8*>(&w); } while (0)
    PK4(p0, 0, pa0); PK4(p0, 8, pa1); PK4(p1, 0, pa2); PK4(p1, 8, pa3);
#undef PK4
}
template <int KB, bool SK>
__device__ __forceinline__ void qkt(f32x16& p0, f32x16& p1, const char* K_lds, int r32, int hi, const bf16x8* qr, bool act, const float* bias_t) {
    if (SK && !act) { const float NEG = -__builtin_inff();
#pragma unroll
        for (int r = 0; r < 16; ++r) { p0[r] = NEG; p1[r] = NEG; } return; }
    {
#pragma unroll
        for (int g_ = 0; g_ < 4; ++g_) { const f32x4 b0_ = *(const f32x4*)(bias_t + 8 * g_ + 4 * hi); const f32x4 b1_ = *(const f32x4*)(bias_t + 32 + 8 * g_ + 4 * hi);
            p0[4 * g_] = b0_[0]; p0[4 * g_ + 1] = b0_[1]; p0[4 * g_ + 2] = b0_[2]; p0[4 * g_ + 3] = b0_[3];
            p1[4 * g_] = b1_[0]; p1[4 * g_ + 1] = b1_[1]; p1[4 * g_ + 2] = b1_[2]; p1[4 * g_ + 3] = b1_[3]; } }
    const char* kb[4];
#pragma unroll
    for (int dd = 0; dd < 4; ++dd) kb[dd] = K_lds + KB * SHM_K + KSWZ(r32, (dd * 16 + hi * 8) * 2);
#pragma unroll
    for (int d0 = 0; d0 < 8; ++d0) { const char* a = kb[d0 & 3] + (d0 >> 2) * 128;
        bf16x8 b0 = *reinterpret_cast<const bf16x8*>(a);
        bf16x8 b1 = *reinterpret_cast<const bf16x8*>(a + 32 * 256);
        p0 = __builtin_amdgcn_mfma_f32_32x32x16_bf16(b0, qr[d0], p0, 0, 0, 0);
        p1 = __builtin_amdgcn_mfma_f32_32x32x16_bf16(b1, qr[d0], p1, 0, 0, 0); }
}
template <int VB, bool SK>
__device__ __forceinline__ void pv_tile(f32x16* o, int vb0, bf16x8 pa0, bf16x8 pa1, bf16x8 pa2, bf16x8 pa3, bool act) {
    if (SK && !act) return;
#define TRRD(dst, off) asm volatile("ds_read_b64_tr_b16 %0, %1 offset:%2" : "=&v"(dst) : "v"(vb0), "i"(off) : "memory")
#define PV_D0(d0) do { s16x4 l0, l1, l2, l3, h0, h1, h2, h3; constexpr int b_ = VB * SHM_V + v_rd_off(d0, 0, 0);     \
        TRRD(l0, b_); TRRD(h0, b_ + 2048); TRRD(l1, b_ + 4096); TRRD(h1, b_ + 6144); TRRD(l2, b_ + 8192); TRRD(h2, b_ + 10240); TRRD(l3, b_ + 12288); TRRD(h3, b_ + 14336); \
        asm volatile("s_waitcnt lgkmcnt(0)" ::: "memory"); SBAR();                 \
        o[d0] = __builtin_amdgcn_mfma_f32_32x32x16_bf16(pa0, (bf16x8){l0[0], l0[1], l0[2], l0[3], h0[0], h0[1], h0[2], h0[3]}, o[d0], 0, 0, 0);   \
        o[d0] = __builtin_amdgcn_mfma_f32_32x32x16_bf16(pa1, (bf16x8){l1[0], l1[1], l1[2], l1[3], h1[0], h1[1], h1[2], h1[3]}, o[d0], 0, 0, 0);   \
        o[d0] = __builtin_amdgcn_mfma_f32_32x32x16_bf16(pa2, (bf16x8){l2[0], l2[1], l2[2], l2[3], h2[0], h2[1], h2[2], h2[3]}, o[d0], 0, 0, 0);   \
        o[d0] = __builtin_amdgcn_mfma_f32_32x32x16_bf16(pa3, (bf16x8){l3[0], l3[1], l3[2], l3[3], h3[0], h3[1], h3[2], h3[3]}, o[d0], 0, 0, 0); } while (0)
    PV_D0(0); PV_D0(1); PV_D0(2); PV_D0(3);
#undef PV_D0
#undef TRRD
}

template <class TIn, class TOut> struct BlockRef { const TIn* Q; const TIn* K; const TIn* V; TOut* O; int P0; };
template <class TIn> struct Seam {
    bf16x8 qr[8];
    bf16x8 st_v0, st_v1, st_k0, st_k1; f32x4 sf0, sf1, sf2, sf3;
    f32x4 tq[16];
};
__device__ __forceinline__ int swa_jlo(int P0, int W) { const int lowk = P0 - W + 1; return lowk > 0 ? lowk / KVBLK : 0; }
#define ROW(p, k0, rr) ((p) + (size_t)((k0) + (rr)) * LDK + sc)
#define VMW() asm volatile("s_waitcnt vmcnt(0)" ::: "memory")
#define VMWN(n) asm volatile("s_waitcnt vmcnt(%0)" :: "i"(n) : "memory")
#define SLOAD_H(Kp, Vp, k0) do { S.st_v0 = load8<TIn>(ROW(Vp, k0, sr)); S.st_v1 = load8<TIn>(ROW(Vp, k0, 32 + sr));              \
                         S.st_k0 = load8<TIn>(ROW(Kp, k0, sr)); S.st_k1 = load8<TIn>(ROW(Kp, k0, 32 + sr)); } while (0)
#define SWRITE_HK(bf) do { *(bf16x8*)(K_lds + (bf) * SHM_K + kws) = S.st_k0; *(bf16x8*)(K_lds + (bf) * SHM_K + kws + 32 * 256) = S.st_k1; } while (0)
#define SWRITE_HV(bf) do { *(bf16x8*)(V_lds + (bf) * SHM_V + vst0) = S.st_v0; *(bf16x8*)(V_lds + (bf) * SHM_V + vst1) = S.st_v1; } while (0)
#define SWRITE_H(bf) do { SWRITE_HV(bf); SWRITE_HK(bf); } while (0)
#define SLOAD_F(p, k0) do { S.sf0 = *(const f32x4*)ROW(p, k0, sr); S.sf1 = *(const f32x4*)(ROW(p, k0, sr) + 4);                \
                            S.sf2 = *(const f32x4*)ROW(p, k0, 32 + sr); S.sf3 = *(const f32x4*)(ROW(p, k0, 32 + sr) + 4); } while (0)
#define SWRITE_KF(bf) do { *(bf16x8*)(K_lds + (bf) * SHM_K + kws) = pack8(S.sf0, S.sf1); *(bf16x8*)(K_lds + (bf) * SHM_K + kws + 32 * 256) = pack8(S.sf2, S.sf3); } while (0)
#define SWRITE_VF(bf) do { *(bf16x8*)(V_lds + (bf) * SHM_V + vst0) = pack8(S.sf0, S.sf1); *(bf16x8*)(V_lds + (bf) * SHM_V + vst1) = pack8(S.sf2, S.sf3); } while (0)
template <class TIn, class TOut>
__device__ __forceinline__ void causal_swa_prime(const BlockRef<TIn, TOut>& cur, int W, char* lds, Seam<TIn>& S) {
    constexpr bool F32 = same_t<TIn, float>::v;
    const int tid = ltid(), wid = __builtin_amdgcn_readfirstlane(tid >> 6), lane = tid & 63, r32 = lane & 31, hi = lane >> 5;
    const int sr = tid >> 4, sc = (tid & 15) * 8, kws = KSWZ(sr, sc * 2); char* K_lds = lds + 2 * SHM_V;
    const int kb0 = swa_jlo(cur.P0, W) * KVBLK;
    for (int d0 = 0; d0 < 8; ++d0) S.qr[d0] = load8<TIn>(cur.Q + (size_t)(wid * QBLK + r32) * LDQ + d0 * 16 + hi * 8);
    if constexpr (F32) { SLOAD_F((const float*)cur.K, kb0); VMW(); SWRITE_KF(0); SBAR(); SLOAD_F((const float*)cur.V, kb0); }
    else { SLOAD_H(cur.K, cur.V, kb0); VMW(); SWRITE_HK(0); }
    __syncthreads();
}
template <class TIn, class TOut>
__device__ __forceinline__ void causal_swa_block(const BlockRef<TIn, TOut>& cur, const BlockRef<TIn, TOut>& nxt, int skv, int W, char* lds, Seam<TIn>& S, const float* bias_l) {
    constexpr bool F32 = same_t<TIn, float>::v;
    const int tid = ltid(), wid = __builtin_amdgcn_readfirstlane(tid >> 6), lane = tid & 63, r32 = lane & 31, hi = lane >> 5;
    const int j_lo = swa_jlo(cur.P0, W);
    int j_hi = (cur.P0 + QB - 1) / KVBLK + 1; if (j_hi > skv / KVBLK) j_hi = skv / KVBLK;
    const int NT = j_hi - j_lo;
    const int kbn = swa_jlo(nxt.P0, W) * KVBLK;
    const int qlo = cur.P0 + wid * QBLK, qm = qlo + r32 - 4 * hi;
    char* V_lds = lds; char* K_lds = lds + 2 * SHM_V;
    float* ws = (float*)(lds + 2 * SHM_V + 2 * SHM_K) + wid * 64; float* li_l = ws, * al_l = ws + 32;
    float m_reg = -1e30f, l_reg = 0; f32x16 o[4] = {};
    const int sr = tid >> 4, sc = (tid & 15) * 8, vst0 = v_st(sr, sc), vst1 = v_st(32 + sr, sc), kws = KSWZ(sr, sc * 2);
    const int vb0 = (int)(uintptr_t)V_lds + v_rd_base(lane);
    const TIn* Kh = cur.K; const TIn* Vh = cur.V;
#define RESC(a) do { if (__any((a) < 1.f)) { if (hi == 0) al_l[r32] = (a); asm volatile("s_waitcnt lgkmcnt(0)" ::: "memory");              \
                     for (int d_ = 0; d_ < 4; ++d_) for (int r = 0; r < 16; ++r) o[d_][r] *= al_l[crow(r, hi)]; } } while (0)
#define KBASE(t) ((j_lo + (t)) * KVBLK)
#define ACT(t) (KBASE(t) <= qlo + QBLK - 1 && KBASE(t) + KVBLK - 1 >= qlo - W + 1)
#define MASKT(P0_, P1_, t) do { const int kb_ = KBASE(t); if ((!SK || ACT(t)) && (kb_ + KVBLK - 1 > qlo || kb_ <= qlo + QBLK - 1 - W)) mask_tile(P0_, P1_, qm - kb_, (unsigned)W); } while (0)
    constexpr int NQL = F32 ? 16 : 8;
    constexpr bool SK = WSKIP && !F32;
#define SEAM_K0() do { VMWN(NQL); if constexpr (F32) { SWRITE_KF(0); SBAR(); SLOAD_F((const float*)nxt.V, kbn); } else { SWRITE_HK(0); } SBAR(); } while (0)
    f32x16 pA0, pA1, pB0, pB1; float mnA, mnB, alA, alB; bf16x8 pa0, pa1, pa2, pa3;
    if constexpr (F32) { VMW(); SWRITE_VF(0); SBAR(); } else { SWRITE_HV(0); SBAR(); }
    if (NT > 1) { if constexpr (F32) SLOAD_F((const float*)Kh, KBASE(1)); else SLOAD_H(Kh, Vh, KBASE(1)); }
    SBAR(); qkt<0, SK>(pA0, pA1, K_lds, r32, hi, S.qr, ACT(0), bias_l + KBASE(0));
    if constexpr (F32) { if (NT > 1) { VMW(); SWRITE_KF(1); SBAR(); SLOAD_F((const float*)Vh, KBASE(1)); } }
    MASKT(pA0, pA1, 0); partialSM(pA0, pA1, m_reg, mnA, alA);
    if (NT > 1) { VMW(); if constexpr (F32) { SWRITE_VF(1); SBAR(); if (NT > 2) SLOAD_F((const float*)Kh, KBASE(2)); } else SWRITE_H(1); }
    __syncthreads();
#define HALF_STEP(PX0, PX1, mnX, alX, PY0, PY1, alY, t, KB, VB, SB) do {                                                      \
        SBAR(); qkt<KB, SK>(PX0, PX1, K_lds, r32, hi, S.qr, ACT(t), bias_l + KBASE(t));                                             \
        finishSM(PY0, PY1, alY, l_reg, pa0, pa1, pa2, pa3); SBAR();                                                           \
        if ((t) + 1 < NT) { if constexpr (F32) { VMW(); SWRITE_KF(SB); SBAR(); SLOAD_F((const float*)Vh, KBASE((t) + 1)); }  \
                            else { SLOAD_H(Kh, Vh, KBASE((t) + 1)); } SBAR(); }                                               \
        pv_tile<VB, SK>(o, vb0, pa0, pa1, pa2, pa3, ACT((t) - 1)); MASKT(PX0, PX1, (t)); partialSM(PX0, PX1, m_reg, mnX, alX);                                        \
        __syncthreads();                                                                                                      \
        if ((t) + 1 < NT) { VMW(); if constexpr (F32) { SWRITE_VF(SB); SBAR(); if ((t) + 2 < NT) SLOAD_F((const float*)Kh, KBASE((t) + 2)); } \
                            else { SWRITE_H(SB); } }                                                                          \
        RESC(alX); __syncthreads(); } while (0)
    for (int t = 1; t + 1 < NT; t += 2) {
        HALF_STEP(pB0, pB1, mnB, alB, pA0, pA1, alA, t, 1, 0, 0);
        HALF_STEP(pA0, pA1, mnA, alA, pB0, pB1, alB, t + 1, 0, 1, 1);
    }
    const bool even = (NT & 1) == 0;
    if (even) { SBAR(); qkt<1, SK>(pB0, pB1, K_lds, r32, hi, S.qr, ACT(NT - 1), bias_l + KBASE(NT - 1)); SBAR(); }
#define QROW(e) (nxt.Q + (size_t)(wid * QBLK + r32) * LDQ + ((e) >> 1) * 16 + hi * 8 + ((e) & 1) * 4)
    if constexpr (F32) { SLOAD_F((const float*)nxt.K, kbn); SBAR();
#pragma unroll
        for (int e = 0; e < 8; ++e) S.tq[e] = *(const f32x4*)QROW(e); }
    else { SLOAD_H(nxt.K, nxt.V, kbn); SBAR();
#pragma unroll
        for (int d0 = 0; d0 < 8; ++d0) S.qr[d0] = load8<TIn>(nxt.Q + (size_t)(wid * QBLK + r32) * LDQ + d0 * 16 + hi * 8); }
    SBAR();
    finishSM(pA0, pA1, alA, l_reg, pa0, pa1, pa2, pa3); SBAR();
    if constexpr (F32) {
#pragma unroll
        for (int e = 8; e < 16; ++e) S.tq[e] = *(const f32x4*)QROW(e); SBAR(); }
#undef QROW
    pv_tile<0, SK>(o, vb0, pa0, pa1, pa2, pa3, ACT(even ? NT - 2 : NT - 1));
    if (even) { MASKT(pB0, pB1, NT - 1); partialSM(pB0, pB1, m_reg, mnB, alB); __syncthreads(); RESC(alB);
        finishSM(pB0, pB1, alB, l_reg, pa0, pa1, pa2, pa3); SBAR(); pv_tile<1, SK>(o, vb0, pa0, pa1, pa2, pa3, ACT(NT - 1)); }
    SBAR(); SEAM_K0();
    if (hi == 0) li_l[r32] = l_reg; asm volatile("s_waitcnt lgkmcnt(0)" ::: "memory");
    float rli[16];
#pragma unroll
    for (int r = 0; r < 16; ++r) rli[r] = __builtin_amdgcn_rcpf(li_l[crow(r, hi)]);
    TOut* Ow = cur.O + (size_t)(wid * QBLK) * LDO;
#pragma unroll
    for (int r = 0; r < 16; ++r) { const int orow = crow(r, hi);
#pragma unroll
        for (int d0 = 0; d0 < 4; ++d0) { const float v = o[d0][r] * rli[r];
            if constexpr (same_t<TOut, float>::v) { Ow[(size_t)orow * LDO + d0 * 32 + r32] = v; }
            else { const float vn = __shfl_xor(v, 1);
                   if ((r32 & 1) == 0) *(unsigned*)(Ow + (size_t)orow * LDO + d0 * 32 + r32) = cvtpk(v, vn); } } }
    if constexpr (F32) {
#pragma unroll
        for (int d0 = 0; d0 < 8; ++d0) S.qr[d0] = pack8(S.tq[2 * d0], S.tq[2 * d0 + 1]); }
    __syncthreads();
#undef RESC
#undef KBASE
#undef ACT
#undef MASKT
#undef SEAM_K0
#undef HALF_STEP
}
#undef ROW
#undef VMW
#undef VMWN
#undef SLOAD_H
#undef SWRITE_HK
#undef SWRITE_HV
#undef SWRITE_H
#undef SLOAD_F
#undef SWRITE_KF

}

__device__ __forceinline__ void fox_bias(PP P, int l, int b, int h, float* bias, float* scr) {
    using namespace cfg;
    const int tid = ltid(), lane = tid & 63, wave = tid >> 6;
    const float* PS = (const float*)(P->ws + WS_PS); const float bf = P->in[I_BF][l * FNH + h];
    float lf[9]; float loc = 0.f;
#pragma unroll
    for (int i = 0; i < 9; ++i) { const int pos = tid * 9 + i; float v = 0.f;
        if (pos < NMETA + SEQ) { const int row = pos < NMETA ? MMAIN + pos : b * SEQ + pos - NMETA; const float z = PS[(size_t)row * PSW + 288 + h] + bf;
            v = fminf(z, 0.f) - log1pf(__expf(-fabsf(z))); }
        loc += v; lf[i] = loc; }
    float inc = loc;
#pragma unroll
    for (int o = 1; o < 64; o <<= 1) { const float t = __shfl_up(inc, o); if (lane >= o) inc += t; }
    if (lane == 63) scr[wave] = inc;
    __syncthreads();
    float base = inc - loc;
    for (int w = 0; w < wave; ++w) base += scr[w];
    constexpr float INV = 1.0f / fox::SCALE;
#pragma unroll
    for (int i = 0; i < 9; ++i) { const int pos = tid * 9 + i; if (pos < NMETA + SEQ) bias[48 + pos] = -(base + lf[i]) * INV; }
    if (tid < 48) bias[tid] = -__builtin_inff();
    __syncthreads();
}
__device__ __forceinline__ void fox_meta(PP P, int h, const float* bias) {
    using namespace cfg;
    const int lane = ltid() & 63, wave = ltid() >> 6;
    const bf16_t* QKV = (const bf16_t*)(P->ws + WS_QKV); bf16_t* Y = (bf16_t*)(P->ws + WS_Y);
    for (int rep = 0; rep < 2; ++rep) { const int i = wave + 8 * rep;
        float s = -__builtin_inff();
        if (lane <= i) { const bf16_t* q = QKV + (size_t)(48 + i) * QKVW + h * 128; const bf16_t* k = QKV + (size_t)(48 + lane) * QKVW + 1024 + h * 128; float dot = 0.f;
            for (int d = 0; d < 128; ++d) dot += bf2f(q[d]) * bf2f(k[d]);
            s = (dot + bias[48 + lane]) * fox::SCALE; }
        const float m = wave_max(s); const float p = (lane <= i) ? __expf(s - m) : 0.f; const float lsum = wave_sum(p);
        float o0 = 0.f, o1 = 0.f;
        for (int j = 0; j <= i; ++j) { const float pj = __shfl(p, j); const bf16_t* v = QKV + (size_t)(48 + j) * QKVW + 2048 + h * 128; o0 += pj * bf2f(v[lane]); o1 += pj * bf2f(v[64 + lane]); }
        const float il = 1.0f / lsum;
        Y[(size_t)(MMAIN + i) * DM + 1024 + h * 128 + lane] = (bf16_t)(pk_bf16(o0 * il, 0.f) & 0xffffu);
        Y[(size_t)(MMAIN + i) * DM + 1024 + h * 128 + 64 + lane] = (bf16_t)(pk_bf16(o1 * il, 0.f) & 0xffffu); }
}
__device__ __forceinline__ fox::BlockRef<__hip_bfloat16, __hip_bfloat16> fox_mk(int a, int idx, const __hip_bfloat16* Qb, const __hip_bfloat16* Kb, const __hip_bfloat16* Vb, __hip_bfloat16* Ob) {
    const int pr = 4 * (a & 1) + (idx >> 1); const int x = (idx & 1) ? 15 - pr : pr;
    fox::BlockRef<__hip_bfloat16, __hip_bfloat16> r; r.Q = Qb + (size_t)x * 256 * cfg::QKVW; r.K = Kb; r.V = Vb; r.O = Ob + (size_t)x * 256 * cfg::DM; r.P0 = 64 + 256 * x; return r; }
__device__ __forceinline__ void fox_wg(PP P, int l, int a, char* lds) {
    using namespace cfg;
    typedef __hip_bfloat16 bf;
    const int bh = a >> 1, b = bh >> 3, h = bh & 7;
    float* bias = (float*)(lds + fox::BIAS_OFF); float* scr = (float*)(lds + fox::SCAN_OFF);
    fox_bias(P, l, b, h, bias, scr);
    const bf* QKV = (const bf*)(P->ws + WS_QKV); bf* Y = (bf*)(P->ws + WS_Y);
    const bf* Kb = QKV + (size_t)b * SEQP * QKVW + 1024 + h * 128; const bf* Vb = Kb + 1024; const bf* Qb = QKV + ((size_t)b * SEQP + 64) * QKVW + h * 128;
    bf* Ob = Y + (size_t)b * SEQ * DM + 1024 + h * 128;
    constexpr int W = 1 << 30;
    fox::Seam<bf> S;
    fox::BlockRef<bf, bf> cur = fox_mk(a, 0, Qb, Kb, Vb, Ob);
    fox::causal_swa_prime<bf, bf>(cur, W, lds, S);
#pragma unroll 1
    for (int idx = 0; idx < 8; ++idx) {
        const fox::BlockRef<bf, bf> nxt = (idx < 7) ? fox_mk(a, idx + 1, Qb, Kb, Vb, Ob) : cur;
        fox::causal_swa_block<bf, bf>(cur, nxt, SEQP, W, lds, S, bias);
        cur = nxt;
    }
    if (b == 0) fox_meta(P, h, bias);
}

#define WS_PTR(T, off) ((T*)(Q->ws + (off)))
#define SEAM() do { PP Qb_ = launder(P); XcdBarrier b_; b_.bar = (unsigned*)(Qb_->ws + WS_CTL); b_.x = xb_xcc_id(); b_.st = (volatile LAS unsigned*)(lds + LDS_BARW); xcd_barrier(b_); } while (0)
__global__ void __launch_bounds__(512, 2) hymba_fwd(Params Pv) {
    using namespace cfg;
    PP P = (PP)__builtin_amdgcn_kernarg_segment_ptr();
    extern __shared__ __attribute__((aligned(16))) unsigned char lds_raw[];
    LAS unsigned char* lds = (LAS unsigned char*)lds_raw;
    if (threadIdx.x < 4) ((LAS unsigned*)(lds + LDS_BARW))[threadIdx.x] = 0u;
    __syncthreads();
    { PP Q = launder(P); (void)xcd_barrier_post((unsigned*)(Q->ws + WS_CTL), (volatile LAS unsigned*)(lds + LDS_BARW)); }

    { PP Q = launder(P); phase_convert(Q, lds, 0, 1, lbid(), (int)gridDim.x); phase_init(Q); }
    SEAM();
    {
        PP Q = launder(P); const unsigned char* wl = Q->ws + WS_W + (size_t)0 * W_LAYER;
        pg8::Gemm g{WS_PTR(const bf16_t, WS_HB), (const bf16_t*)(wl + WO_GU1), MMAIN, NGU, DM}; pg8::StaticOrder S; S.init(MMAIN, NGU, (int)gridDim.x, lbid());
        pg8::EpiGU E{WS_PTR(bf16_t, WS_ACT), WS_PTR(const float, WS_SS) + (size_t)(0) * 8 * MROWS, (LAS float*)(lds + 131072 + 4096)};
        pg8::gemm_phase<pg8::EpiGU, pg8::StaticOrder, true, true>(lds, g, S, E);
        skinny_gu(WS_PTR(const bf16_t, WS_HB), g.Bt, WS_PTR(const float, WS_SSM) + (0) * 2048, WS_PTR(bf16_t, WS_ACT), lds);
    }
    SEAM();
    {
        PP Q = launder(P); const unsigned char* wl = Q->ws + WS_W + (size_t)0 * W_LAYER;
        pg8::Gemm g{WS_PTR(const bf16_t, WS_ACT), (const bf16_t*)(wl + WO_D1), MMAIN, DM, DFF}; pg8::StaticOrder S; S.init(MMAIN, DM, (int)gridDim.x, lbid());
        pg8::EpiRes E{WS_PTR(bf16_t, WS_HB), WS_PTR(float, WS_SS) + (size_t)(1) * 8 * MROWS, 0.5f, (LAS float*)(lds + 131072)};
        pg8::gemm_phase<pg8::EpiRes, pg8::StaticOrder, true, true>(lds, g, S, E);
        skinny_res(WS_PTR(const bf16_t, WS_ACT) + (size_t)MMAIN * DFF, DFF, g.Bt, WS_PTR(bf16_t, WS_HB), WS_PTR(float, WS_SSM) + (1) * 2048, 0.5f, lds);
    }
    SEAM();
    {
        PP Q = launder(P); const unsigned char* wl = Q->ws + WS_W + (size_t)0 * W_LAYER;
        pg8::Gemm g{WS_PTR(const bf16_t, WS_HB), (const bf16_t*)(wl + WO_IN), MMAIN, NIN, DM}; pg8::StaticOrder S; S.init(MMAIN, NIN, (int)gridDim.x, lbid());
        pg8::EpiP E{WS_PTR(bf16_t, WS_PR), WS_PTR(float, WS_PS), WS_PTR(bf16_t, WS_QKV), WS_PTR(const float, WS_SS) + (size_t)(1) * 8 * MROWS, (LAS float*)(lds + 131072 + 4096)};
        pg8::gemm_phase<pg8::EpiP, pg8::StaticOrder, true, true>(lds, g, S, E);
        skinny_p(WS_PTR(const bf16_t, WS_HB), g.Bt, WS_PTR(const float, WS_SSM) + (1) * 2048, WS_PTR(bf16_t, WS_PR), WS_PTR(float, WS_PS), WS_PTR(bf16_t, WS_QKV), lds);
    }
    SEAM();
    { PP Q = launder(P); phase_lx(Q, 0); }
    SEAM();
    {
        PP Q = launder(P); const int u = lbid();
        if (u < 128) { rwkv_chunked(Q, 0, u >> 4, u & 15, lds); __syncthreads(); phase_convert(launder(P), lds, 1, 2, u, 128, 17024, 21248); }
        else { fox_wg(Q, 0, u - 128, (char*)lds_raw); __syncthreads(); phase_convert(launder(P), lds, 1, 2, u - 128, 128, 0, 17024); }
    }
    SEAM();
    { PP Q = launder(P); phase_foxnorm(Q); }
    SEAM();
    {
        PP Q = launder(P); const unsigned char* wl = Q->ws + WS_W + (size_t)0 * W_LAYER;
        pg8::Gemm g{WS_PTR(const bf16_t, WS_Y), (const bf16_t*)(wl + WO_OUT), MMAIN, DM, DM}; pg8::StaticOrder S; S.init(MMAIN, DM, (int)gridDim.x, lbid());
        pg8::EpiRes E{WS_PTR(bf16_t, WS_HB), WS_PTR(float, WS_SS) + (size_t)(2) * 8 * MROWS, 1.0f, (LAS float*)(lds + 131072)};
        pg8::gemm_phase<pg8::EpiRes, pg8::StaticOrder, true, true>(lds, g, S, E);
        skinny_res(WS_PTR(const bf16_t, WS_Y) + (size_t)MMAIN * DM, DM, g.Bt, WS_PTR(bf16_t, WS_HB), WS_PTR(float, WS_SSM) + (2) * 2048, 1.0f, lds);
    }
    SEAM();
    {
        PP Q = launder(P); const unsigned char* wl = Q->ws + WS_W + (size_t)0 * W_LAYER;
        pg8::Gemm g{WS_PTR(const bf16_t, WS_HB), (const bf16_t*)(wl + WO_GU2), MMAIN, NGU, DM}; pg8::StaticOrder S; S.init(MMAIN, NGU, (int)gridDim.x, lbid());
        pg8::EpiGU E{WS_PTR(bf16_t, WS_ACT), WS_PTR(const float, WS_SS) + (size_t)(2) * 8 * MROWS, (LAS float*)(lds + 131072 + 4096)};
        pg8::gemm_phase<pg8::EpiGU, pg8::StaticOrder, true, true>(lds, g, S, E);
        skinny_gu(WS_PTR(const bf16_t, WS_HB), g.Bt, WS_PTR(const float, WS_SSM) + (2) * 2048, WS_PTR(bf16_t, WS_ACT), lds);
    }
    SEAM();
    {
        PP Q = launder(P); const unsigned char* wl = Q->ws + WS_W + (size_t)0 * W_LAYER;
        pg8::Gemm g{WS_PTR(const bf16_t, WS_ACT), (const bf16_t*)(wl + WO_D2), MMAIN, DM, DFF}; pg8::StaticOrder S; S.init(MMAIN, DM, (int)gridDim.x, lbid());
        pg8::EpiRes E{WS_PTR(bf16_t, WS_HB), WS_PTR(float, WS_SS) + (size_t)(3) * 8 * MROWS, 0.5f, (LAS float*)(lds + 131072)};
        pg8::gemm_phase<pg8::EpiRes, pg8::StaticOrder, true, true>(lds, g, S, E);
        skinny_res(WS_PTR(const bf16_t, WS_ACT) + (size_t)MMAIN * DFF, DFF, g.Bt, WS_PTR(bf16_t, WS_HB), WS_PTR(float, WS_SSM) + (3) * 2048, 0.5f, lds);
    }
    SEAM();
    {
        PP Q = launder(P); const unsigned char* wl = Q->ws + WS_W + (size_t)1 * W_LAYER;
        pg8::Gemm g{WS_PTR(const bf16_t, WS_HB), (const bf16_t*)(wl + WO_GU1), MMAIN, NGU, DM}; pg8::StaticOrder S; S.init(MMAIN, NGU, (int)gridDim.x, lbid());
        pg8::EpiGU E{WS_PTR(bf16_t, WS_ACT), WS_PTR(const float, WS_SS) + (size_t)(3) * 8 * MROWS, (LAS float*)(lds + 131072 + 4096)};
        pg8::gemm_phase<pg8::EpiGU, pg8::StaticOrder, true, true>(lds, g, S, E);
        skinny_gu(WS_PTR(const bf16_t, WS_HB), g.Bt, WS_PTR(const float, WS_SSM) + (3) * 2048, WS_PTR(bf16_t, WS_ACT), lds);
    }
    SEAM();
    {
        PP Q = launder(P); const unsigned char* wl = Q->ws + WS_W + (size_t)1 * W_LAYER;
        pg8::Gemm g{WS_PTR(const bf16_t, WS_ACT), (const bf16_t*)(wl + WO_D1), MMAIN, DM, DFF}; pg8::StaticOrder S; S.init(MMAIN, DM, (int)gridDim.x, lbid());
        pg8::EpiRes E{WS_PTR(bf16_t, WS_HB), WS_PTR(float, WS_SS) + (size_t)(4) * 8 * MROWS, 0.5f, (LAS float*)(lds + 131072)};
        pg8::gemm_phase<pg8::EpiRes, pg8::StaticOrder, true, true>(lds, g, S, E);
        skinny_res(WS_PTR(const bf16_t, WS_ACT) + (size_t)MMAIN * DFF, DFF, g.Bt, WS_PTR(bf16_t, WS_HB), WS_PTR(float, WS_SSM) + (4) * 2048, 0.5f, lds);
    }
    SEAM();
    {
        PP Q = launder(P); const unsigned char* wl = Q->ws + WS_W + (size_t)1 * W_LAYER;
        pg8::Gemm g{WS_PTR(const bf16_t, WS_HB), (const bf16_t*)(wl + WO_IN), MMAIN, NIN, DM}; pg8::StaticOrder S; S.init(MMAIN, NIN, (int)gridDim.x, lbid());
        pg8::EpiP E{WS_PTR(bf16_t, WS_PR), WS_PTR(float, WS_PS), WS_PTR(bf16_t, WS_QKV), WS_PTR(const float, WS_SS) + (size_t)(4) * 8 * MROWS, (LAS float*)(lds + 131072 + 4096)};
        pg8::gemm_phase<pg8::EpiP, pg8::StaticOrder, true, true>(lds, g, S, E);
        skinny_p(WS_PTR(const bf16_t, WS_HB), g.Bt, WS_PTR(const float, WS_SSM) + (4) * 2048, WS_PTR(bf16_t, WS_PR), WS_PTR(float, WS_PS), WS_PTR(bf16_t, WS_QKV), lds);
    }
    SEAM();
    { PP Q = launder(P); phase_lx(Q, 1); }
    SEAM();
    {
        PP Q = launder(P); const int u = lbid();
        if (u < 128) { rwkv_chunked(Q, 1, u >> 4, u & 15, lds); __syncthreads(); phase_convert(launder(P), lds, 2, 3, u, 128, 17024, 21248); }
        else { fox_wg(Q, 1, u - 128, (char*)lds_raw); __syncthreads(); phase_convert(launder(P), lds, 2, 3, u - 128, 128, 0, 17024); }
    }
    SEAM();
    { PP Q = launder(P); phase_foxnorm(Q); }
    SEAM();
    {
        PP Q = launder(P); const unsigned char* wl = Q->ws + WS_W + (size_t)1 * W_LAYER;
        pg8::Gemm g{WS_PTR(const bf16_t, WS_Y), (const bf16_t*)(wl + WO_OUT), MMAIN, DM, DM}; pg8::StaticOrder S; S.init(MMAIN, DM, (int)gridDim.x, lbid());
        pg8::EpiRes E{WS_PTR(bf16_t, WS_HB), WS_PTR(float, WS_SS) + (size_t)(5) * 8 * MROWS, 1.0f, (LAS float*)(lds + 131072)};
        pg8::gemm_phase<pg8::EpiRes, pg8::StaticOrder, true, true>(lds, g, S, E);
        skinny_res(WS_PTR(const bf16_t, WS_Y) + (size_t)MMAIN * DM, DM, g.Bt, WS_PTR(bf16_t, WS_HB), WS_PTR(float, WS_SSM) + (5) * 2048, 1.0f, lds);
    }
    SEAM();
    {
        PP Q = launder(P); const unsigned char* wl = Q->ws + WS_W + (size_t)1 * W_LAYER;
        pg8::Gemm g{WS_PTR(const bf16_t, WS_HB), (const bf16_t*)(wl + WO_GU2), MMAIN, NGU, DM}; pg8::StaticOrder S; S.init(MMAIN, NGU, (int)gridDim.x, lbid());
        pg8::EpiGU E{WS_PTR(bf16_t, WS_ACT), WS_PTR(const float, WS_SS) + (size_t)(5) * 8 * MROWS, (LAS float*)(lds + 131072 + 4096)};
        pg8::gemm_phase<pg8::EpiGU, pg8::StaticOrder, true, true>(lds, g, S, E);
        skinny_gu(WS_PTR(const bf16_t, WS_HB), g.Bt, WS_PTR(const float, WS_SSM) + (5) * 2048, WS_PTR(bf16_t, WS_ACT), lds);
    }
    SEAM();
    {
        PP Q = launder(P); const unsigned char* wl = Q->ws + WS_W + (size_t)1 * W_LAYER;
        pg8::Gemm g{WS_PTR(const bf16_t, WS_ACT), (const bf16_t*)(wl + WO_D2), MMAIN, DM, DFF}; pg8::StaticOrder S; S.init(MMAIN, DM, (int)gridDim.x, lbid());
        pg8::EpiRes E{WS_PTR(bf16_t, WS_HB), WS_PTR(float, WS_SS) + (size_t)(6) * 8 * MROWS, 0.5f, (LAS float*)(lds + 131072)};
        pg8::gemm_phase<pg8::EpiRes, pg8::StaticOrder, true, true>(lds, g, S, E);
        skinny_res(WS_PTR(const bf16_t, WS_ACT) + (size_t)MMAIN * DFF, DFF, g.Bt, WS_PTR(bf16_t, WS_HB), WS_PTR(float, WS_SSM) + (6) * 2048, 0.5f, lds);
    }
    SEAM();
    {
        PP Q = launder(P); const unsigned char* wl = Q->ws + WS_W + (size_t)2 * W_LAYER;
        pg8::Gemm g{WS_PTR(const bf16_t, WS_HB), (const bf16_t*)(wl + WO_GU1), MMAIN, NGU, DM}; pg8::StaticOrder S; S.init(MMAIN, NGU, (int)gridDim.x, lbid());
        pg8::EpiGU E{WS_PTR(bf16_t, WS_ACT), WS_PTR(const float, WS_SS) + (size_t)(6) * 8 * MROWS, (LAS float*)(lds + 131072 + 4096)};
        pg8::gemm_phase<pg8::EpiGU, pg8::StaticOrder, true, true>(lds, g, S, E);
        skinny_gu(WS_PTR(const bf16_t, WS_HB), g.Bt, WS_PTR(const float, WS_SSM) + (6) * 2048, WS_PTR(bf16_t, WS_ACT), lds);
    }
    SEAM();
    {
        PP Q = launder(P); const unsigned char* wl = Q->ws + WS_W + (size_t)2 * W_LAYER;
        pg8::Gemm g{WS_PTR(const bf16_t, WS_ACT), (const bf16_t*)(wl + WO_D1), MMAIN, DM, DFF}; pg8::StaticOrder S; S.init(MMAIN, DM, (int)gridDim.x, lbid());
        pg8::EpiRes E{WS_PTR(bf16_t, WS_HB), WS_PTR(float, WS_SS) + (size_t)(7) * 8 * MROWS, 0.5f, (LAS float*)(lds + 131072)};
        pg8::gemm_phase<pg8::EpiRes, pg8::StaticOrder, true, true>(lds, g, S, E);
        skinny_res(WS_PTR(const bf16_t, WS_ACT) + (size_t)MMAIN * DFF, DFF, g.Bt, WS_PTR(bf16_t, WS_HB), WS_PTR(float, WS_SSM) + (7) * 2048, 0.5f, lds);
    }
    SEAM();
    {
        PP Q = launder(P); const unsigned char* wl = Q->ws + WS_W + (size_t)2 * W_LAYER;
        pg8::Gemm g{WS_PTR(const bf16_t, WS_HB), (const bf16_t*)(wl + WO_IN), MMAIN, NIN, DM}; pg8::StaticOrder S; S.init(MMAIN, NIN, (int)gridDim.x, lbid());
        pg8::EpiP E{WS_PTR(bf16_t, WS_PR), WS_PTR(float, WS_PS), WS_PTR(bf16_t, WS_QKV), WS_PTR(const float, WS_SS) + (size_t)(7) * 8 * MROWS, (LAS float*)(lds + 131072 + 4096)};
        pg8::gemm_phase<pg8::EpiP, pg8::StaticOrder, true, true>(lds, g, S, E);
        skinny_p(WS_PTR(const bf16_t, WS_HB), g.Bt, WS_PTR(const float, WS_SSM) + (7) * 2048, WS_PTR(bf16_t, WS_PR), WS_PTR(float, WS_PS), WS_PTR(bf16_t, WS_QKV), lds);
    }
    SEAM();
    { PP Q = launder(P); phase_lx(Q, 2); }
    SEAM();
    {
        PP Q = launder(P); const int u = lbid();
        if (u < 128) { rwkv_chunked(Q, 2, u >> 4, u & 15, lds); __syncthreads(); phase_convert(launder(P), lds, 3, 4, u, 128, 17024, 21248); }
        else { fox_wg(Q, 2, u - 128, (char*)lds_raw); __syncthreads(); phase_convert(launder(P), lds, 3, 4, u - 128, 128, 0, 17024); }
    }
    SEAM();
    { PP Q = launder(P); phase_foxnorm(Q); }
    SEAM();
    {
        PP Q = launder(P); const unsigned char* wl = Q->ws + WS_W + (size_t)2 * W_LAYER;
        pg8::Gemm g{WS_PTR(const bf16_t, WS_Y), (const bf16_t*)(wl + WO_OUT), MMAIN, DM, DM}; pg8::StaticOrder S; S.init(MMAIN, DM, (int)gridDim.x, lbid());
        pg8::EpiRes E{WS_PTR(bf16_t, WS_HB), WS_PTR(float, WS_SS) + (size_t)(8) * 8 * MROWS, 1.0f, (LAS float*)(lds + 131072)};
        pg8::gemm_phase<pg8::EpiRes, pg8::StaticOrder, true, true>(lds, g, S, E);
        skinny_res(WS_PTR(const bf16_t, WS_Y) + (size_t)MMAIN * DM, DM, g.Bt, WS_PTR(bf16_t, WS_HB), WS_PTR(float, WS_SSM) + (8) * 2048, 1.0f, lds);
    }
    SEAM();
    {
        PP Q = launder(P); const unsigned char* wl = Q->ws + WS_W + (size_t)2 * W_LAYER;
        pg8::Gemm g{WS_PTR(const bf16_t, WS_HB), (const bf16_t*)(wl + WO_GU2), MMAIN, NGU, DM}; pg8::StaticOrder S; S.init(MMAIN, NGU, (int)gridDim.x, lbid());
        pg8::EpiGU E{WS_PTR(bf16_t, WS_ACT), WS_PTR(const float, WS_SS) + (size_t)(8) * 8 * MROWS, (LAS float*)(lds + 131072 + 4096)};
        pg8::gemm_phase<pg8::EpiGU, pg8::StaticOrder, true, true>(lds, g, S, E);
        skinny_gu(WS_PTR(const bf16_t, WS_HB), g.Bt, WS_PTR(const float, WS_SSM) + (8) * 2048, WS_PTR(bf16_t, WS_ACT), lds);
    }
    SEAM();
    {
        PP Q = launder(P); const unsigned char* wl = Q->ws + WS_W + (size_t)2 * W_LAYER;
        pg8::Gemm g{WS_PTR(const bf16_t, WS_ACT), (const bf16_t*)(wl + WO_D2), MMAIN, DM, DFF}; pg8::StaticOrder S; S.init(MMAIN, DM, (int)gridDim.x, lbid());
        pg8::EpiRes E{WS_PTR(bf16_t, WS_HB), WS_PTR(float, WS_SS) + (size_t)(9) * 8 * MROWS, 0.5f, (LAS float*)(lds + 131072)};
        pg8::gemm_phase<pg8::EpiRes, pg8::StaticOrder, true, true>(lds, g, S, E);
        skinny_res(WS_PTR(const bf16_t, WS_ACT) + (size_t)MMAIN * DFF, DFF, g.Bt, WS_PTR(bf16_t, WS_HB), WS_PTR(float, WS_SSM) + (9) * 2048, 0.5f, lds);
    }
    SEAM();
    {
        PP Q = launder(P); const unsigned char* wl = Q->ws + WS_W + (size_t)3 * W_LAYER;
        pg8::Gemm g{WS_PTR(const bf16_t, WS_HB), (const bf16_t*)(wl + WO_GU1), MMAIN, NGU, DM}; pg8::StaticOrder S; S.init(MMAIN, NGU, (int)gridDim.x, lbid());
        pg8::EpiGU E{WS_PTR(bf16_t, WS_ACT), WS_PTR(const float, WS_SS) + (size_t)(9) * 8 * MROWS, (LAS float*)(lds + 131072 + 4096)};
        pg8::gemm_phase<pg8::EpiGU, pg8::StaticOrder, true, true>(lds, g, S, E);
        skinny_gu(WS_PTR(const bf16_t, WS_HB), g.Bt, WS_PTR(const float, WS_SSM) + (9) * 2048, WS_PTR(bf16_t, WS_ACT), lds);
    }
    SEAM();
    {
        PP Q = launder(P); const unsigned char* wl = Q->ws + WS_W + (size_t)3 * W_LAYER;
        pg8::Gemm g{WS_PTR(const bf16_t, WS_ACT), (const bf16_t*)(wl + WO_D1), MMAIN, DM, DFF}; pg8::StaticOrder S; S.init(MMAIN, DM, (int)gridDim.x, lbid());
        pg8::EpiRes E{WS_PTR(bf16_t, WS_HB), WS_PTR(float, WS_SS) + (size_t)(10) * 8 * MROWS, 0.5f, (LAS float*)(lds + 131072)};
        pg8::gemm_phase<pg8::EpiRes, pg8::StaticOrder, true, true>(lds, g, S, E);
        skinny_res(WS_PTR(const bf16_t, WS_ACT) + (size_t)MMAIN * DFF, DFF, g.Bt, WS_PTR(bf16_t, WS_HB), WS_PTR(float, WS_SSM) + (10) * 2048, 0.5f, lds);
    }
    SEAM();
    {
        PP Q = launder(P); const unsigned char* wl = Q->ws + WS_W + (size_t)3 * W_LAYER;
        pg8::Gemm g{WS_PTR(const bf16_t, WS_HB), (const bf16_t*)(wl + WO_IN), MMAIN, NIN, DM}; pg8::StaticOrder S; S.init(MMAIN, NIN, (int)gridDim.x, lbid());
        pg8::EpiP E{WS_PTR(bf16_t, WS_PR), WS_PTR(float, WS_PS), WS_PTR(bf16_t, WS_QKV), WS_PTR(const float, WS_SS) + (size_t)(10) * 8 * MROWS, (LAS float*)(lds + 131072 + 4096)};
        pg8::gemm_phase<pg8::EpiP, pg8::StaticOrder, true, true>(lds, g, S, E);
        skinny_p(WS_PTR(const bf16_t, WS_HB), g.Bt, WS_PTR(const float, WS_SSM) + (10) * 2048, WS_PTR(bf16_t, WS_PR), WS_PTR(float, WS_PS), WS_PTR(bf16_t, WS_QKV), lds);
    }
    SEAM();
    { PP Q = launder(P); phase_lx(Q, 3); }
    SEAM();
    {
        PP Q = launder(P); const int u = lbid();
        if (u < 128) { rwkv_chunked(Q, 3, u >> 4, u & 15, lds); }
        else { fox_wg(Q, 3, u - 128, (char*)lds_raw);  }
    }
    SEAM();
    { PP Q = launder(P); phase_foxnorm(Q); }
    SEAM();
    {
        PP Q = launder(P); const unsigned char* wl = Q->ws + WS_W + (size_t)3 * W_LAYER;
        pg8::Gemm g{WS_PTR(const bf16_t, WS_Y), (const bf16_t*)(wl + WO_OUT), MMAIN, DM, DM}; pg8::StaticOrder S; S.init(MMAIN, DM, (int)gridDim.x, lbid());
        pg8::EpiRes E{WS_PTR(bf16_t, WS_HB), WS_PTR(float, WS_SS) + (size_t)(11) * 8 * MROWS, 1.0f, (LAS float*)(lds + 131072)};
        pg8::gemm_phase<pg8::EpiRes, pg8::StaticOrder, true, true>(lds, g, S, E);
        skinny_res(WS_PTR(const bf16_t, WS_Y) + (size_t)MMAIN * DM, DM, g.Bt, WS_PTR(bf16_t, WS_HB), WS_PTR(float, WS_SSM) + (11) * 2048, 1.0f, lds);
    }
    SEAM();
    {
        PP Q = launder(P); const unsigned char* wl = Q->ws + WS_W + (size_t)3 * W_LAYER;
        pg8::Gemm g{WS_PTR(const bf16_t, WS_HB), (const bf16_t*)(wl + WO_GU2), MMAIN, NGU, DM}; pg8::StaticOrder S; S.init(MMAIN, NGU, (int)gridDim.x, lbid());
        pg8::EpiGU E{WS_PTR(bf16_t, WS_ACT), WS_PTR(const float, WS_SS) + (size_t)(11) * 8 * MROWS, (LAS float*)(lds + 131072 + 4096)};
        pg8::gemm_phase<pg8::EpiGU, pg8::StaticOrder, true, true>(lds, g, S, E);
        skinny_gu(WS_PTR(const bf16_t, WS_HB), g.Bt, WS_PTR(const float, WS_SSM) + (11) * 2048, WS_PTR(bf16_t, WS_ACT), lds);
    }
    SEAM();
    {
        PP Q = launder(P); const unsigned char* wl = Q->ws + WS_W + (size_t)3 * W_LAYER;
        pg8::Gemm g{WS_PTR(const bf16_t, WS_ACT), (const bf16_t*)(wl + WO_D2), MMAIN, DM, DFF}; pg8::StaticOrder S; S.init(MMAIN, DM, (int)gridDim.x, lbid());
        pg8::EpiRes E{WS_PTR(bf16_t, WS_HB), WS_PTR(float, WS_SS) + (size_t)(12) * 8 * MROWS, 0.5f, (LAS float*)(lds + 131072)};
        pg8::gemm_phase<pg8::EpiRes, pg8::StaticOrder, true, true>(lds, g, S, E);
        skinny_res(WS_PTR(const bf16_t, WS_ACT) + (size_t)MMAIN * DFF, DFF, g.Bt, WS_PTR(bf16_t, WS_HB), WS_PTR(float, WS_SSM) + (12) * 2048, 0.5f, lds);
    }
    SEAM();
    { PP Q = launder(P); phase_final(Q); }
}

extern "C" void kernel_launch(void* const* d_in, const int* in_sizes, int n_in, void* d_out, int out_size, void* d_ws, size_t ws_size, hipStream_t stream) {
    using namespace cfg;
    static int grid = 0;
    if (grid == 0) {
        if (n_in != 25 || out_size != MMAIN * DM || ws_size < WS_END) { fprintf(stderr, "kernel_launch: need 25 inputs, out %d, ws >= %zu; got n_in %d out %d ws %zu\n", MMAIN * DM, (size_t)WS_END, n_in, out_size, ws_size); grid = -1; return; }
        int dev = 0, cus = 0, per_cu = 0;
        if (hipGetDevice(&dev) != hipSuccess || hipDeviceGetAttribute(&cus, hipDeviceAttributeMultiprocessorCount, dev) != hipSuccess) { grid = -1; return; }
        if (hipFuncSetAttribute((const void*)hymba_fwd, hipFuncAttributeMaxDynamicSharedMemorySize, LDS_BYTES) != hipSuccess) { fprintf(stderr, "kernel_launch: hipFuncSetAttribute failed\n"); grid = -1; return; }
        if (hipOccupancyMaxActiveBlocksPerMultiprocessor(&per_cu, (const void*)hymba_fwd, 512, LDS_BYTES) != hipSuccess || per_cu < 1) fprintf(stderr, "kernel_launch: occupancy query says %d\n", per_cu);
        (void)hipGetLastError();
        if (cus < 256) { fprintf(stderr, "kernel_launch: built for a 256-CU device (one resident workgroup per CU), found %d CUs\n", cus); grid = -1; return; }
        grid = 256;
    }
    if (grid < 0) return;
    if (hipMemsetAsync((char*)d_ws + WS_CTL, 0, CTL_BYTES, stream) != hipSuccess) return;
    Params p{};
    for (int i = 0; i < 25; ++i) p.in[i] = (const float*)d_in[i];
    p.out = (float*)d_out; p.ws = (unsigned char*)d_ws; p.ph_lo = 0; p.ph_hi = 0;
    hipLaunchKernelGGL(hymba_fwd, dim3(grid), dim3(512), LDS_BYTES, stream, p);
}
```

```cpp
#include <hip/hip_runtime.h>
#include <hip/hip_bf16.h>
#include <cstdio>
#include <cstdint>

#define LAS __attribute__((address_space(3)))
namespace cfg {
constexpr int DM = 2048, NBATCH = 8, SEQ = 4096, NMETA = 16, DEPTH = 4;
constexpr int MMAIN = NBATCH * SEQ;
constexpr int MROWS = MMAIN + 256;
constexpr int DFF = 5632, NGU = 2 * DFF;
constexpr int RW = 1024, RH = 64, RNH = 16;
constexpr int FW = 1024, FH = 128, FNH = 8;
constexpr int RWKV_COLS = 3360, DIN = 6440;
constexpr int NIN = 6656;
constexpr int PRW = 3072, PSW = 512, QKVW = 3072;
constexpr int SEQP = 4160;
constexpr float NORM_EPS = 1e-6f, LNX_EPS = 64e-5f;
constexpr int NSS = 13;
constexpr size_t al256(size_t x) { return (x + 255) & ~(size_t)255; }
constexpr size_t WS_CTL = 0;
constexpr size_t CTL_BYTES = 65536;
constexpr size_t WS_SS = WS_CTL + CTL_BYTES;
constexpr size_t SS_BYTES = al256((size_t)NSS * 8 * MROWS * 4);
constexpr size_t ZERO_BYTES = CTL_BYTES + SS_BYTES;
constexpr size_t WS_SSM = WS_SS + SS_BYTES;
constexpr size_t SSM_BYTES = (size_t)NSS * 2048 * 4;
constexpr size_t WS_HMETA = WS_SSM + SSM_BYTES;
constexpr size_t WS_HB = WS_HMETA + (size_t)256 * DM * 4;
constexpr size_t WS_Y = WS_HB + (size_t)MROWS * DM * 2;
constexpr size_t WS_OVL = WS_Y + (size_t)MROWS * DM * 2;
constexpr size_t WS_ACT = WS_OVL;
constexpr size_t WS_PR = WS_OVL;
constexpr size_t WS_PS = WS_PR + (size_t)MROWS * PRW * 2;
constexpr size_t WS_QKV = WS_PS + (size_t)MROWS * PSW * 4;
constexpr size_t OVL_A = (size_t)MROWS * DFF * 2, OVL_B = (size_t)MROWS * PRW * 2 + (size_t)MROWS * PSW * 4 + (size_t)NBATCH * SEQP * QKVW * 2;
constexpr size_t WS_W = WS_OVL + al256(OVL_A > OVL_B ? OVL_A : OVL_B);
constexpr size_t W_GU = (size_t)NGU * DM * 2, W_D = (size_t)DM * DFF * 2, W_IN = (size_t)NIN * DM * 2, W_OUT = (size_t)DM * DM * 2;
constexpr size_t WO_GU1 = 0, WO_D1 = WO_GU1 + W_GU, WO_IN = WO_D1 + W_D, WO_OUT = WO_IN + W_IN, WO_GU2 = WO_OUT + W_OUT, WO_D2 = WO_GU2 + W_GU, W_LAYER = WO_D2 + W_D;
constexpr size_t WS_LXG = WS_W + (size_t)DEPTH * W_LAYER;
constexpr size_t WS_END = WS_LXG + (size_t)MROWS * 320 * 2;
constexpr int LDS_BYTES = 147456;
constexpr int LDS_BARW = LDS_BYTES - 16;
}
__device__ __forceinline__ int ltid() { int t = (int)threadIdx.x; asm volatile("" : "+v"(t)); return t; }
__device__ __forceinline__ int lbid() { int t = (int)blockIdx.x; asm volatile("" : "+s"(t)); return t; }
__device__ __forceinline__ int lzero() { int t = 0; asm volatile("" : "+v"(t)); return t; }
namespace pg8 {
#define PG8_LAS __attribute__((address_space(3)))
typedef unsigned short bf16_t;
typedef short bf16x8 __attribute__((ext_vector_type(8)));
typedef float f32x4 __attribute__((ext_vector_type(4)));
typedef unsigned u32x4 __attribute__((ext_vector_type(4)));
constexpr int BM = 256, BK = 64, HALF = 128, HTB = HALF * BK * 2  , STAGE_BYTES = 8 * HTB, NXCD = 8, WGM = 8;

__host__ __device__ __forceinline__ int lds_byte(int r, int c) { const int st = (r >> 4) * 2 + (c >> 5), rr = r & 15, cc = c & 31, ob = rr * 64 + cc * 2; return st * 1024 + (ob ^ (((ob >> 9) & 1) << 5)); }
__host__ __device__ __forceinline__ void stage_rc(int b, int& R, int& C) { const int st = b / 1024, sb = b % 1024, swz = sb ^ (((sb >> 9) & 1) << 5); R = (st >> 1) * 16 + swz / 64; C = (st & 1) * 32 + (swz % 64) / 2; }
__host__ __device__ __forceinline__ int perm32(int rho) { const int n = rho >> 4, i = rho & 15; return 8 * (i >> 2) + 4 * n + (i & 3); }

struct Unit { int pm, pn; };
struct Gemm { const bf16_t* A; const bf16_t* Bt; int M, N, K; };

struct StaticOrder {
    int nM, nN, nwg, G, c;
    __host__ __device__ void init(int M, int N, int G_, int c_) { nM = M / BM; nN = N / BM; nwg = nM * nN; G = G_; c = c_; }
    __host__ __device__ bool next(int i, Unit& u) const {
        const long L = (long)i * G + c; if (L >= nwg) return false;
        int wgid = (int)L; { const int q = nwg / NXCD, r = nwg % NXCD, xcd = wgid % NXCD, off = wgid / NXCD; wgid = (xcd < r ? xcd * (q + 1) : r * (q + 1) + (xcd - r) * q) + off; }
        const int nig = WGM * nN, gid = wgid / nig, fm = gid * WGM, gsz = (nM - fm) < WGM ? (nM - fm) : WGM;
        u.pm = fm + ((wgid % nig) % gsz); u.pn = (wgid % nig) / gsz; return true;
    }
    __device__ __forceinline__ void a_ready(const Unit&) const {}
    __device__ __forceinline__ void done(const Unit&) const {}
};

__device__ __forceinline__ unsigned cvt_pk_bf16(float lo, float hi) { unsigned r; asm volatile("v_cvt_pk_bf16_f32 %0, %1, %2" : "=v"(r) : "v"(lo), "v"(hi)); return r; }
typedef float f32x2 __attribute__((ext_vector_type(2)));
__device__ __forceinline__ f32x2 gelu_pk(f32x2 v) {
    const f32x2 av = __builtin_elementwise_abs(v), d = av * 0.2316418882f + 1.0f;
    f32x2 t; t.x = __builtin_amdgcn_rcpf(d.x); t.y = __builtin_amdgcn_rcpf(d.y);
    f32x2 q = t * 0.5307027145f + (-0.7265760135f); q = q * t + 0.7107068705f; q = q * t + (-0.142248368f); q = q * t + 0.127414796f; q = q * t;
    const f32x2 s = (v * v) * (-0.72134752044f);
    f32x2 e; e.x = __builtin_amdgcn_exp2f(s.x); e.y = __builtin_amdgcn_exp2f(s.y);
    const f32x2 m = v * (q * e), r = v - m;
    f32x2 o; o.x = v.x < 0.f ? m.x : r.x; o.y = v.y < 0.f ? m.y : r.y; return o;
}
__device__ __forceinline__ float rs_of(const float* ss, int row) { float s = 0.f;
#pragma unroll
    for (int t = 0; t < 8; ++t) s += ss[(size_t)t * 33024 + row];
    return __builtin_amdgcn_rsqf(s * (1.0f / 2048.0f) + 1e-6f); }
__device__ __forceinline__ float silu_f(float x) { return x * __builtin_amdgcn_rcpf(1.0f + __builtin_amdgcn_exp2f(-1.4426950408889634f * x)); }

struct EpiGU {
    static constexpr bool PERM = true, AFTER_DRAIN = false;
    bf16_t* act; const float* ss; PG8_LAS float* rsb;
    __device__ __forceinline__ void operator()(const f32x4 (&acc)[2][2][4][2], const Unit& u, int wr, int wc, int fr, int fq) const {
        if (wr == 0) { const int rl = wc * 64 + fq * 16 + fr; rsb[rl] = rs_of(ss, u.pm * BM + rl); }
        asm volatile("s_waitcnt lgkmcnt(0)" ::: "memory"); __builtin_amdgcn_s_barrier(); asm volatile("" ::: "memory");
        const int rl0 = wr * 64 + fr, row0 = u.pm * BM + rl0, col0 = u.pn * 128 + wc * 32 + 8 * fq;
#pragma unroll
        for (int ai = 0; ai < 2; ++ai)
#pragma unroll
            for (int m = 0; m < 4; ++m) { const int row = row0 + ai * HALF + m * 16; const float rs = rsb[rl0 + ai * HALF + m * 16];
                const f32x4 g0 = acc[ai][0][m][0] * rs, g1 = acc[ai][0][m][1] * rs, u0 = acc[ai][1][m][0] * rs, u1 = acc[ai][1][m][1] * rs;
                u32x4 w;
                w.x = cvt_pk_bf16(silu_f(g0[0]) * u0[0], silu_f(g0[1]) * u0[1]); w.y = cvt_pk_bf16(silu_f(g0[2]) * u0[2], silu_f(g0[3]) * u0[3]);
                w.z = cvt_pk_bf16(silu_f(g1[0]) * u1[0], silu_f(g1[1]) * u1[1]); w.w = cvt_pk_bf16(silu_f(g1[2]) * u1[2], silu_f(g1[3]) * u1[3]);
                *(u32x4*)(act + (size_t)row * 5632 + col0) = w; }
        asm volatile("s_waitcnt lgkmcnt(0)" ::: "memory"); __builtin_amdgcn_s_barrier(); asm volatile("" ::: "memory");
    }
};
struct EpiRes {
    static constexpr bool PERM = true, AFTER_DRAIN = false;
    bf16_t* hb; float* ssn; float alpha; PG8_LAS float* red;
    __device__ __forceinline__ void operator()(const f32x4 (&acc)[2][2][4][2], const Unit& u, int wr, int wc, int fr, int fq) const {
        bf16_t* bbase = hb + (size_t)u.pm * BM * 2048;
        const int rl0 = wr * 64 + fr; unsigned off = (unsigned)(rl0 * 2048 + u.pn * BM + wc * 32 + 8 * fq);
#pragma unroll
        for (int ai = 0; ai < 2; ++ai) {
            u32x4 hv[4][2];
#pragma unroll
            for (int m = 0; m < 4; ++m)
#pragma unroll
                for (int bj = 0; bj < 2; ++bj) hv[m][bj] = *(const u32x4*)(bbase + (off + (unsigned)((ai * HALF + m * 16) * 2048) + bj * HALF));
#pragma unroll
            for (int m = 0; m < 4; ++m) { const unsigned o = off + (unsigned)((ai * HALF + m * 16) * 2048); float sq = 0.f;
#pragma unroll
                for (int bj = 0; bj < 2; ++bj) { const u32x4 x = hv[m][bj];
                    const f32x4 h0 = (f32x4){__uint_as_float(x.x << 16), __uint_as_float(x.x & 0xffff0000u), __uint_as_float(x.y << 16), __uint_as_float(x.y & 0xffff0000u)} + acc[ai][bj][m][0] * alpha;
                    const f32x4 h1 = (f32x4){__uint_as_float(x.z << 16), __uint_as_float(x.z & 0xffff0000u), __uint_as_float(x.w << 16), __uint_as_float(x.w & 0xffff0000u)} + acc[ai][bj][m][1] * alpha;
                    sq += ((h0[0] * h0[0] + h0[1] * h0[1]) + (h0[2] * h0[2] + h0[3] * h0[3])) + ((h1[0] * h1[0] + h1[1] * h1[1]) + (h1[2] * h1[2] + h1[3] * h1[3]));
                    u32x4 w; w.x = cvt_pk_bf16(h0[0], h0[1]); w.y = cvt_pk_bf16(h0[2], h0[3]); w.z = cvt_pk_bf16(h1[0], h1[1]); w.w = cvt_pk_bf16(h1[2], h1[3]); *(u32x4*)(bbase + o + bj * HALF) = w; }
                sq += __shfl_xor(sq, 16); sq += __shfl_xor(sq, 32);
                if (fq == 0) red[(rl0 + ai * HALF + m * 16) * 4 + wc] = sq; }
            asm volatile("" ::: "memory"); }
        asm volatile("s_waitcnt lgkmcnt(0)" ::: "memory"); __builtin_amdgcn_s_barrier(); asm volatile("" ::: "memory");
        if (wr == 0) { const int row = wc * 64 + fq * 16 + fr; const float s4 = (red[row * 4] + red[row * 4 + 1]) + (red[row * 4 + 2] + red[row * 4 + 3]); ssn[(size_t)u.pn * 33024 + u.pm * BM + row] = s4; }
    }
};
struct EpiP {
    static constexpr bool PERM = true, AFTER_DRAIN = false;
    bf16_t* pr; float* ps; bf16_t* qkv; const float* ss; PG8_LAS float* rsb;
    __device__ __forceinline__ void operator()(const f32x4 (&acc)[2][2][4][2], const Unit& u, int wr, int wc, int fr, int fq) const {
        if (wr == 0) { const int rl = wc * 64 + fq * 16 + fr; rsb[rl] = rs_of(ss, u.pm * BM + rl); }
        asm volatile("s_waitcnt lgkmcnt(0)" ::: "memory"); __builtin_amdgcn_s_barrier(); asm volatile("" ::: "memory");
        const int rl0 = wr * 64 + fr, row0 = u.pm * BM + rl0, cl = wc * 32 + 8 * fq;
#pragma unroll
        for (int ai = 0; ai < 2; ++ai)
#pragma unroll
            for (int m = 0; m < 4; ++m) { const int row = row0 + ai * HALF + m * 16; const float rs = rsb[rl0 + ai * HALF + m * 16];
#pragma unroll
                for (int bj = 0; bj < 2; ++bj) { const f32x4 v0 = acc[ai][bj][m][0] * rs, v1 = acc[ai][bj][m][1] * rs;
                    if (u.pn >= 12 && u.pn < 14) { float* d = ps + (size_t)row * 512 + (u.pn - 12) * 256 + bj * HALF + cl; *(f32x4*)d = v0; *(f32x4*)(d + 4) = v1; }
                    else { u32x4 w; w.x = cvt_pk_bf16(v0[0], v0[1]); w.y = cvt_pk_bf16(v0[2], v0[3]); w.z = cvt_pk_bf16(v1[0], v1[1]); w.w = cvt_pk_bf16(v1[2], v1[3]);
                        if (u.pn < 12) *(u32x4*)(pr + (size_t)row * 3072 + u.pn * 256 + bj * HALF + cl) = w;
                        else { const int c = (u.pn - 14) * 256 + bj * HALF + cl;
                            const int b = row >> 12, s = row & 4095; *(u32x4*)(qkv + ((size_t)b * 4160 + 64 + s) * 3072 + c) = w; } } } }
        asm volatile("s_waitcnt lgkmcnt(0)" ::: "memory"); __builtin_amdgcn_s_barrier(); asm volatile("" ::: "memory");
    }
};
template <class Epi, class Sched, bool ALIGN_EPI = false, bool SP2 = false>
__device__ __forceinline__ void gemm_phase(PG8_LAS unsigned char* lds, const Gemm g, const Sched& S, const Epi& E) {
    const int tid = ltid(), wid = __builtin_amdgcn_readfirstlane(tid >> 6), lane = tid & 63, wr = wid >> 2, wc = wid & 3, fr = lane & 15, fq = lane >> 4;
    const int K = g.K, nt = K / BK;
    unsigned voffA[2], voffB[2];
#pragma unroll
    for (int i = 0; i < 2; ++i) { int R, C; stage_rc(tid * 16 + i * 8192, R, C); const int Rb = Epi::PERM ? ((R & ~31) + perm32(R & 31)) : R;
        voffA[i] = (unsigned)(R * K + C) * 2u; voffB[i] = (unsigned)(Rb * K + C) * 2u; }
    const size_t kstep = (size_t)(BK * 2);
    const size_t hstep = (size_t)HALF * K * 2;
    const size_t tstep = 2 * hstep;
    const unsigned ldsw = (unsigned)wid * 1024u;
    const int aoff = lds_byte(wr * 64 + fr, fq * 8), boff = lds_byte(wc * 32 + fr, fq * 8);
#define PG8_SA(b, h) (((b) * 2 + (h)) * HTB)
#define PG8_SB(b, h) ((4 + (b) * 2 + (h)) * HTB)
#define PG8_STAGE(bufoff, gbase, voff) do { _Pragma("unroll") for (int _i = 0; _i < 2; ++_i) \
        __builtin_amdgcn_global_load_lds((const unsigned*)((const char*)(gbase) + (voff)[_i]), (PG8_LAS unsigned*)(lds + (bufoff) + ldsw + _i * 8192), 16, 0, 0); } while (0)
#define PG8_LDA(dst, b, h) do { _Pragma("unroll") for (int m = 0; m < 4; ++m) _Pragma("unroll") for (int k = 0; k < 2; ++k) dst[m][k] = *(const PG8_LAS bf16x8*)(lds + PG8_SA(b, h) + aoff + m * 2048 + k * 1024); } while (0)
#define PG8_LDB(dst, b, h) do { _Pragma("unroll") for (int n = 0; n < 2; ++n) _Pragma("unroll") for (int k = 0; k < 2; ++k) dst[n][k] = *(const PG8_LAS bf16x8*)(lds + PG8_SB(b, h) + boff + n * 2048 + k * 1024); } while (0)
#define PG8_MMA(ai, bj, At, Bt) do { __builtin_amdgcn_s_setprio(1); _Pragma("unroll") for (int m = 0; m < 4; ++m) _Pragma("unroll") for (int n = 0; n < 2; ++n) _Pragma("unroll") for (int k = 0; k < 2; ++k) \
        acc[ai][bj][m][n] = __builtin_amdgcn_mfma_f32_16x16x32_bf16(Bt[n][k], At[m][k], acc[ai][bj][m][n], 0, 0, 0); __builtin_amdgcn_s_setprio(0); } while (0)
#define PG8_WAIT_V(n) asm volatile("s_waitcnt vmcnt(" #n ")" ::: "memory")
#define PG8_WAIT_L(n) asm volatile("s_waitcnt lgkmcnt(" #n ")" ::: "memory")
#define PG8_BAR __builtin_amdgcn_s_barrier()
#define PG8_SCHED __builtin_amdgcn_sched_barrier(0)
    Unit cur, nxt; int ui = 0;
    if (!S.next(0, cur)) return;
    f32x4 acc[2][2][4][2];
#pragma unroll
    for (int a = 0; a < 2; ++a)
#pragma unroll
        for (int b = 0; b < 2; ++b)
#pragma unroll
            for (int m = 0; m < 4; ++m)
#pragma unroll
                for (int n = 0; n < 2; ++n) acc[a][b][m][n] = (f32x4){0.f, 0.f, 0.f, 0.f};
    bf16x8 At[4][2], B0[2][2], B1[2][2];
    const char* cA = (const char*)g.A + (size_t)cur.pm * tstep; const char* cB = (const char*)g.Bt + (size_t)cur.pn * tstep;
    S.a_ready(cur);
    if constexpr (SP2) {
        PG8_STAGE(PG8_SB(0, 0), cB, voffB); PG8_STAGE(PG8_SB(0, 1), cB + hstep, voffB); PG8_STAGE(PG8_SA(0, 0), cA, voffA); PG8_STAGE(PG8_SA(0, 1), cA + hstep, voffA);
        if (wr == 1) PG8_BAR;
        PG8_WAIT_V(2); PG8_BAR;
        PG8_STAGE(PG8_SB(1, 0), cB + kstep, voffB); PG8_STAGE(PG8_SA(1, 0), cA + kstep, voffA); PG8_STAGE(PG8_SB(1, 1), cB + hstep + kstep, voffB);
        PG8_WAIT_V(6); PG8_BAR;
    } else {
        PG8_STAGE(PG8_SB(0, 0), cB, voffB); PG8_STAGE(PG8_SA(0, 0), cA, voffA); PG8_STAGE(PG8_SB(0, 1), cB + hstep, voffB); PG8_STAGE(PG8_SA(0, 1), cA + hstep, voffA);
        if (wr == 1) PG8_BAR;
        PG8_WAIT_V(4); PG8_BAR;
        PG8_STAGE(PG8_SB(1, 0), cB + kstep, voffB); PG8_STAGE(PG8_SA(1, 0), cA + kstep, voffA); PG8_STAGE(PG8_SB(1, 1), cB + hstep + kstep, voffB);
        PG8_WAIT_V(6); PG8_BAR;
    }
    for (;;) {
        const bool has_next = S.next(ui + 1, nxt);
        const char* nA = has_next ? (const char*)g.A + (size_t)nxt.pm * tstep : cA; const char* nB = has_next ? (const char*)g.Bt + (size_t)nxt.pn * tstep : cB;
        for (int t = 0; t < nt; t += 2) {
            const bool last = (t == nt - 2);
            const char* a1 = cA + (size_t)(t + 1) * kstep;
            const char* a2 = last ? nA : cA + (size_t)(t + 2) * kstep; const char* b2 = last ? nB : cB + (size_t)(t + 2) * kstep;
            const char* a3 = a2 + kstep; const char* b3 = b2 + kstep;
            if (last && has_next) S.a_ready(nxt);
            if constexpr (SP2) {
            PG8_LDB(B0, 0, 0); PG8_LDB(B1, 0, 1); PG8_SCHED; PG8_LDA(At, 0, 0); PG8_STAGE(PG8_SA(1, 1), a1 + hstep, voffA);
            PG8_WAIT_V(8); PG8_WAIT_L(0); PG8_BAR; PG8_MMA(0, 0, At, B0); PG8_MMA(0, 1, At, B1); PG8_BAR; PG8_SCHED;
            PG8_LDA(At, 0, 1); PG8_STAGE(PG8_SB(0, 0), b2, voffB); PG8_STAGE(PG8_SB(0, 1), b2 + hstep, voffB); PG8_STAGE(PG8_SA(0, 0), a2, voffA);
            PG8_WAIT_V(8); PG8_WAIT_L(0); PG8_BAR; PG8_MMA(1, 0, At, B0); PG8_MMA(1, 1, At, B1); PG8_BAR; PG8_SCHED;
            PG8_LDB(B0, 1, 0); PG8_LDB(B1, 1, 1); PG8_SCHED; PG8_LDA(At, 1, 0); PG8_STAGE(PG8_SA(0, 1), a2 + hstep, voffA);
            PG8_WAIT_V(8); PG8_WAIT_L(0); PG8_BAR; PG8_MMA(0, 0, At, B0); PG8_MMA(0, 1, At, B1); PG8_BAR; PG8_SCHED;
            PG8_LDA(At, 1, 1); PG8_STAGE(PG8_SB(1, 0), b3, voffB); PG8_STAGE(PG8_SB(1, 1), b3 + hstep, voffB); PG8_STAGE(PG8_SA(1, 0), a3, voffA);
            PG8_WAIT_V(8); PG8_WAIT_L(0); PG8_BAR; PG8_MMA(1, 0, At, B0); PG8_MMA(1, 1, At, B1); PG8_BAR; PG8_SCHED;
            } else {
            PG8_LDB(B0, 0, 0); PG8_SCHED; PG8_LDA(At, 0, 0); PG8_STAGE(PG8_SA(1, 1), a1 + hstep, voffA);
            PG8_WAIT_L(8); PG8_BAR; PG8_WAIT_L(0); PG8_MMA(0, 0, At, B0); PG8_BAR; PG8_SCHED;
            PG8_LDB(B1, 0, 1); PG8_STAGE(PG8_SB(0, 0), b2, voffB);
            PG8_BAR; PG8_WAIT_L(0); PG8_MMA(0, 1, At, B1); PG8_BAR;
            PG8_LDA(At, 0, 1); PG8_STAGE(PG8_SA(0, 0), a2, voffA);
            PG8_BAR; PG8_WAIT_L(0); PG8_MMA(1, 0, At, B0); PG8_BAR; PG8_SCHED;
            PG8_STAGE(PG8_SB(0, 1), b2 + hstep, voffB);
            PG8_WAIT_V(6); PG8_BAR; PG8_MMA(1, 1, At, B1); PG8_BAR;
            PG8_LDB(B0, 1, 0); PG8_SCHED; PG8_LDA(At, 1, 0); PG8_STAGE(PG8_SA(0, 1), a2 + hstep, voffA);
            PG8_WAIT_L(8); PG8_BAR; PG8_WAIT_L(0); PG8_MMA(0, 0, At, B0); PG8_BAR; PG8_SCHED;
            PG8_LDB(B1, 1, 1); PG8_STAGE(PG8_SB(1, 0), b3, voffB);
            PG8_BAR; PG8_WAIT_L(0); PG8_MMA(0, 1, At, B1); PG8_BAR;
            PG8_LDA(At, 1, 1); PG8_STAGE(PG8_SA(1, 0), a3, voffA);
            PG8_BAR; PG8_WAIT_L(0); PG8_MMA(1, 0, At, B0); PG8_BAR; PG8_SCHED;
            PG8_STAGE(PG8_SB(1, 1), b3 + hstep, voffB);
            PG8_WAIT_V(6); PG8_BAR; PG8_MMA(1, 1, At, B1); PG8_BAR;
            }
        }
        if constexpr (ALIGN_EPI) { if (wr == 0) PG8_BAR; }
        if constexpr (!Epi::AFTER_DRAIN) { E(acc, cur, wr, wc, fr, fq); S.done(cur); }
        if (!has_next) break;
#pragma unroll
        for (int a = 0; a < 2; ++a)
#pragma unroll
            for (int b = 0; b < 2; ++b)
#pragma unroll
                for (int m = 0; m < 4; ++m)
#pragma unroll
                    for (int n = 0; n < 2; ++n) acc[a][b][m][n] = (f32x4){0.f, 0.f, 0.f, 0.f};
        cur = nxt; cA = nA; cB = nB; ++ui;
        if constexpr (ALIGN_EPI) { if (wr == 1) PG8_BAR; }
    }
    PG8_WAIT_V(0);
    if constexpr (!ALIGN_EPI) { if (wr == 0) PG8_BAR; }
    PG8_BAR;
    if constexpr (Epi::AFTER_DRAIN) { E.fused(acc, cur, wr, wc, fr, fq, lds, wid, lane); S.done(cur); }
#undef PG8_SA
#undef PG8_SB
#undef PG8_STAGE
#undef PG8_LDA
#undef PG8_LDB
#undef PG8_MMA
#undef PG8_WAIT_V
#undef PG8_WAIT_L
#undef PG8_BAR
#undef PG8_SCHED
}
}


#define XB_TMO      128
#define XB_XCNT(j)  (256  + 64 * (j))
#define XB_XSUB(j)  (1280 + 64 * (j))
#define XB_XGEN(j)  (2304 + 64 * (j))
#define XB_TOP      3328
#define XB_TOPGEN   3392
#define XCD_BAR_WORDS 3456
#define XB_SPIN_CAP (1u << 22)

__device__ __forceinline__ unsigned xb_ld(unsigned* p)              { return __hip_atomic_load(p, __ATOMIC_RELAXED, __HIP_MEMORY_SCOPE_AGENT); }
__device__ __forceinline__ unsigned xb_add(unsigned* p, unsigned v) { return __hip_atomic_fetch_add(p, v, __ATOMIC_RELAXED, __HIP_MEMORY_SCOPE_AGENT); }
__device__ __forceinline__ unsigned xb_xcc_id() { return (unsigned)__builtin_amdgcn_s_getreg((3 << 11) | 20) & 0xFu; }
#define XB_SPIN(cond, bar) do { unsigned _sp = 0; while (cond) { __builtin_amdgcn_s_sleep(1); \
    if ((++_sp & 255u) == 0u) { if (xb_ld(&(bar)[XB_TMO])) break; if (_sp > XB_SPIN_CAP) { atomicAdd(&(bar)[XB_TMO], 1u); break; } } } } while (0)

struct XcdBarrier {
    unsigned* bar; unsigned x;
    volatile LAS unsigned* st;
};

__device__ __forceinline__ XcdBarrier xcd_barrier_post(unsigned* bar, volatile LAS unsigned* st) {
    XcdBarrier b; b.bar = bar; b.x = xb_xcc_id(); b.st = st;
    if (threadIdx.x == 0) (void)xb_add(&bar[XB_XCNT(b.x)], 1u);
    return b;
}
__device__ __forceinline__ void xcd_barrier_complete(unsigned* bar, unsigned x, unsigned& nloc, unsigned& nx) {
    const unsigned G = gridDim.x * gridDim.y * gridDim.z;
    unsigned sum, cnt, mine, sp = 0u;
    for (;;) {
        sum = 0u; cnt = 0u; mine = 0u;
#pragma unroll
        for (unsigned j = 0; j < 16; ++j) { const unsigned c = xb_ld(&bar[XB_XCNT(j)]); sum += c; cnt += (c > 0u) ? 1u : 0u; mine = (j == x) ? c : mine; }
        if (sum == G) break;
        __builtin_amdgcn_s_sleep(1);
        if ((++sp & 255u) == 0u) { if (xb_ld(&bar[XB_TMO])) break; if (sp > XB_SPIN_CAP) { atomicAdd(&bar[XB_TMO], 1u); break; } }
    }
    nloc = mine > 0u ? mine : 1u; nx = cnt > 0u ? cnt : 1u;
}

__device__ __forceinline__ void xcd_barrier(const XcdBarrier& b) {
    asm volatile("s_waitcnt vmcnt(0)" ::: "memory");
    __syncthreads();
    if (threadIdx.x == 0) {
        unsigned* bar = b.bar;
        __builtin_amdgcn_s_waitcnt(0);
        unsigned nloc = b.st[0], nx = b.st[1];
        if (nloc == 0u) { xcd_barrier_complete(bar, b.x, nloc, nx); b.st[0] = nloc; b.st[1] = nx; }
        const unsigned old = xb_add(&bar[XB_XSUB(b.x)], 1u);
        const unsigned gen = old / nloc;
        if (old + 1u == (gen + 1u) * nloc) {
            __builtin_amdgcn_fence(__ATOMIC_RELEASE, "agent");
            asm volatile("s_waitcnt vmcnt(0)" ::: "memory");
            const unsigned og = xb_add(&bar[XB_TOP], 1u);
            const unsigned tg = og / nx;
            if (og + 1u == (tg + 1u) * nx) xb_add(&bar[XB_TOPGEN], 1u);
            else XB_SPIN(xb_ld(&bar[XB_TOPGEN]) == tg, bar);
            __builtin_amdgcn_fence(__ATOMIC_ACQUIRE, "agent");
            xb_add(&bar[XB_XGEN(b.x)], 1u);
            asm volatile("s_waitcnt vmcnt(0)" ::: "memory");
        } else {
            XB_SPIN(xb_ld(&bar[XB_XGEN(b.x)]) == gen, bar);
            __builtin_amdgcn_fence(__ATOMIC_ACQUIRE, "agent");
            asm volatile("s_waitcnt vmcnt(0)" ::: "memory");
        }
    }
    __syncthreads();
}


typedef unsigned short bf16_t;
typedef float f32x4 __attribute__((ext_vector_type(4)));
typedef unsigned u32x4 __attribute__((ext_vector_type(4)));
typedef unsigned u32x2 __attribute__((ext_vector_type(2)));
struct Params { const float* in[25]; float* out; unsigned char* ws; int ph_lo, ph_hi; };
#define CAS __attribute__((address_space(4)))
typedef const CAS Params* PP;
__device__ __forceinline__ PP launder(PP p) { asm volatile("" : "+s"(p)); return p; }
enum { I_X = 0, I_META, I_F1N, I_F1GU, I_F1D, I_MIXN, I_WIN, I_MU, I_W0, I_WUP, I_A0, I_AUP, I_GUP, I_KK, I_KA, I_RK, I_LNW, I_LNB, I_BF, I_FON, I_WOUT, I_F2N, I_F2GU, I_F2D, I_FINN };

typedef float f32x2_t __attribute__((ext_vector_type(2))); typedef __bf16 bf16x2v_t __attribute__((ext_vector_type(2)));
__device__ __forceinline__ unsigned pk_bf16(float lo, float hi) { f32x2_t v = {lo, hi}; bf16x2v_t b = __builtin_convertvector(v, bf16x2v_t); return __builtin_bit_cast(unsigned, b); }
__device__ __forceinline__ float bf2f(bf16_t b) { return __uint_as_float(((unsigned)b) << 16); }
__device__ __forceinline__ float wave_sum(float v) {
#pragma unroll
    for (int o = 32; o >= 1; o >>= 1) v += __shfl_xor(v, o);
    return v; }
__device__ __forceinline__ float wave_max(float v) {
#pragma unroll
    for (int o = 32; o >= 1; o >>= 1) v = fmaxf(v, __shfl_xor(v, o));
    return v; }
template <int CTRL> __device__ __forceinline__ float dpp_f(float v) { return __builtin_bit_cast(float, __builtin_amdgcn_update_dpp(0, __builtin_bit_cast(int, v), CTRL, 0xf, 0xf, true)); }
__device__ __forceinline__ float row_sum16(float v) { v += dpp_f<0xB1>(v); v += dpp_f<0x4E>(v); v += dpp_f<0x141>(v); v += dpp_f<0x140>(v); return v; }
__device__ __forceinline__ float rdlane(float v, int l) { return __builtin_bit_cast(float, __builtin_amdgcn_readlane(__builtin_bit_cast(int, v), l)); }
__device__ __forceinline__ float wave_sum_dpp(float v) { v = row_sum16(v); return (rdlane(v, 0) + rdlane(v, 16)) + (rdlane(v, 32) + rdlane(v, 48)); }
__device__ __forceinline__ float sigmoid_f(float x) { return __builtin_amdgcn_rcpf(1.0f + __expf(-x)); }

__device__ __forceinline__ void convert_tile(const float* __restrict__ src, bf16_t* __restrict__ dst, const float* __restrict__ gain, int K, int Nsrc, int kind, int tk, int tn, LAS float* T) {
    const int tid = ltid();
    {
        const int nl = (tid & 15) * 4, np = tn * 64 + nl; int sc;
        if (kind == 1) { const int pn = np >> 8, bj = (np >> 7) & 1, i = np & 127; sc = bj * cfg::DFF + pn * 128 + i; }
        else if (kind == 2) { sc = np < 3360 ? np : (np < 3368 ? 6432 + (np - 3360) : (np < 3584 ? -1 : 3360 + (np - 3584))); }
        else sc = np;
#pragma unroll
        for (int i = 0; i < 2; ++i) { const int kl = (tid >> 4) + 32 * i, k = tk * 64 + kl;
            f32x4 v = (f32x4){0.f, 0.f, 0.f, 0.f};
            if (sc >= 0) v = *(const f32x4*)(src + (size_t)k * Nsrc + sc);
            float g = 1.f; if (kind == 1 || kind == 2) g = gain[k]; else if (kind == 3) g = (k >= 1024) ? gain[k - 1024] : 1.f;
            T[kl * 65 + nl] = v[0] * g; T[kl * 65 + nl + 1] = v[1] * g; T[kl * 65 + nl + 2] = v[2] * g; T[kl * 65 + nl + 3] = v[3] * g; }
    }
    __syncthreads();
    {
        const int nl = tid >> 3, k8 = (tid & 7) * 8; u32x4 w;
        w.x = pk_bf16(T[(k8 + 0) * 65 + nl], T[(k8 + 1) * 65 + nl]); w.y = pk_bf16(T[(k8 + 2) * 65 + nl], T[(k8 + 3) * 65 + nl]);
        w.z = pk_bf16(T[(k8 + 4) * 65 + nl], T[(k8 + 5) * 65 + nl]); w.w = pk_bf16(T[(k8 + 6) * 65 + nl], T[(k8 + 7) * 65 + nl]);
        *(u32x4*)(dst + (size_t)(tn * 64 + nl) * K + tk * 64 + k8) = w;
    }
    __syncthreads();
}
__device__ __forceinline__ void phase_convert(PP P, LAS unsigned char* lds, int l0, int l1, int first, int nwg, int t0 = 0, int t1 = 0) {
    using namespace cfg;
    LAS float* T = (LAS float*)lds;
    constexpr int T_GU = (DM / 64) * (NGU / 64), T_D = (DFF / 64) * (DM / 64), T_IN = (DM / 64) * (NIN / 64), T_OUT = (DM / 64) * (DM / 64);
    constexpr int T_LAYER = 2 * T_GU + 2 * T_D + T_IN + T_OUT;
    if (t1 <= 0) t1 = T_LAYER;
    for (int t = l0 * T_LAYER + first; t < l1 * T_LAYER; t += nwg) {
        const int l = t / T_LAYER; int r = t - l * T_LAYER; if (r < t0 || r >= t1) continue;
        bf16_t* wl = (bf16_t*)(P->ws + WS_W + (size_t)l * W_LAYER);
        const float* src; bf16_t* dst; const float* gain = nullptr; int K, Nsrc, kind, ntn;
        if (r < T_GU) { src = P->in[I_F1GU] + (size_t)l * DM * NGU; dst = (bf16_t*)((unsigned char*)wl + WO_GU1); gain = P->in[I_F1N] + l * DM; K = DM; Nsrc = NGU; kind = 1; ntn = NGU / 64; }
        else if ((r -= T_GU) < T_D) { src = P->in[I_F1D] + (size_t)l * DFF * DM; dst = (bf16_t*)((unsigned char*)wl + WO_D1); K = DFF; Nsrc = DM; kind = 0; ntn = DM / 64; }
        else if ((r -= T_D) < T_IN) { src = P->in[I_WIN] + (size_t)l * DM * DIN; dst = (bf16_t*)((unsigned char*)wl + WO_IN); gain = P->in[I_MIXN] + l * DM; K = DM; Nsrc = DIN; kind = 2; ntn = NIN / 64; }
        else if ((r -= T_IN) < T_OUT) { src = P->in[I_WOUT] + (size_t)l * DM * DM; dst = (bf16_t*)((unsigned char*)wl + WO_OUT); gain = P->in[I_FON] + l * FW; K = DM; Nsrc = DM; kind = 3; ntn = DM / 64; }
        else if ((r -= T_OUT) < T_GU) { src = P->in[I_F2GU] + (size_t)l * DM * NGU; dst = (bf16_t*)((unsigned char*)wl + WO_GU2); gain = P->in[I_F2N] + l * DM; K = DM; Nsrc = NGU; kind = 1; ntn = NGU / 64; }
        else { r -= T_GU; src = P->in[I_F2D] + (size_t)l * DFF * DM; dst = (bf16_t*)((unsigned char*)wl + WO_D2); K = DFF; Nsrc = DM; kind = 0; ntn = DM / 64; }
        convert_tile(src, dst, gain, K, Nsrc, kind, r / ntn, r % ntn, T);
    }
}
__device__ __forceinline__ void phase_init(PP P) {
    using namespace cfg;
    const int lane = ltid() & 63, gw = lbid() * 8 + (ltid() >> 6), nw = gridDim.x * 8;
    bf16_t* hb = (bf16_t*)(P->ws + WS_HB); float* ss0 = (float*)(P->ws + WS_SS);
    for (int row = gw; row < MROWS; row += nw) {
        const float* s = row < MMAIN ? P->in[I_X] + (size_t)row * DM : P->in[I_META] + (size_t)(row - MMAIN) * DM;
        float sq = 0.f;
#pragma unroll
        for (int i = 0; i < 4; ++i) { f32x4 v0 = (f32x4){0.f, 0.f, 0.f, 0.f}, v1 = v0; if (row < MMAIN + NMETA) { v0 = *(const f32x4*)(s + i * 512 + lane * 8); v1 = *(const f32x4*)(s + i * 512 + lane * 8 + 4); }
            sq += ((v0[0] * v0[0] + v0[1] * v0[1]) + (v0[2] * v0[2] + v0[3] * v0[3])) + ((v1[0] * v1[0] + v1[1] * v1[1]) + (v1[2] * v1[2] + v1[3] * v1[3]));
            u32x4 w; w.x = pk_bf16(v0[0], v0[1]); w.y = pk_bf16(v0[2], v0[3]); w.z = pk_bf16(v1[0], v1[1]); w.w = pk_bf16(v1[2], v1[3]); *(u32x4*)(hb + (size_t)row * DM + i * 512 + lane * 8) = w; }
        sq = wave_sum(sq);
        if (lane < 8) ss0[(size_t)lane * MROWS + row] = lane == 0 ? sq : 0.f;
        if (row >= MMAIN && row < MMAIN + NMETA) { float* ssm0 = (float*)(P->ws + WS_SSM); ssm0[lane * 16 + (row - MMAIN)] = lane == 0 ? sq : 0.f; ssm0[(64 + lane) * 16 + (row - MMAIN)] = 0.f; }
    }
}
__device__ __forceinline__ void phase_foxnorm(PP P) {
    using namespace cfg;
    const int lane = ltid() & 63, gw = lbid() * 8 + (ltid() >> 6), nw = gridDim.x * 8;
    bf16_t* y = (bf16_t*)(P->ws + WS_Y);
    for (int row0 = gw; row0 < MMAIN + NMETA; row0 += 4 * nw) {
        u32x4 a[4], b[4];
#pragma unroll
        for (int j = 0; j < 4; ++j) { const int row = row0 + j * nw; if (row < MMAIN + NMETA) { const bf16_t* p = y + (size_t)row * DM + 1024 + lane * 16; a[j] = *(const u32x4*)p; b[j] = *(const u32x4*)(p + 8); } else { a[j] = (u32x4){0u, 0u, 0u, 0u}; b[j] = a[j]; } }
#pragma unroll
        for (int j = 0; j < 4; ++j) { const int row = row0 + j * nw; float v[16];
#pragma unroll
            for (int i = 0; i < 4; ++i) { v[2 * i] = __uint_as_float(a[j][i] << 16); v[2 * i + 1] = __uint_as_float(a[j][i] & 0xffff0000u); v[8 + 2 * i] = __uint_as_float(b[j][i] << 16); v[8 + 2 * i + 1] = __uint_as_float(b[j][i] & 0xffff0000u); }
            float sq = 0.f;
#pragma unroll
            for (int i = 0; i < 16; ++i) sq += v[i] * v[i];
            sq = wave_sum_dpp(sq); const float rs = __builtin_amdgcn_rsqf(sq * (1.0f / 1024.0f) + NORM_EPS);
            u32x4 oa, ob;
#pragma unroll
            for (int i = 0; i < 4; ++i) { oa[i] = pk_bf16(v[2 * i] * rs, v[2 * i + 1] * rs); ob[i] = pk_bf16(v[8 + 2 * i] * rs, v[8 + 2 * i + 1] * rs); }
            if (row < MMAIN + NMETA) { bf16_t* p = y + (size_t)row * DM + 1024 + lane * 16; *(u32x4*)p = oa; *(u32x4*)(p + 8) = ob; } }
    }
}
__device__ __forceinline__ void phase_final(PP P) {
    using namespace cfg;
    const int lane = ltid() & 63, gw = lbid() * 8 + (ltid() >> 6), nw = gridDim.x * 8;
    const float* g = P->in[I_FINN]; const bf16_t* hb = (const bf16_t*)(P->ws + WS_HB);
    for (int row = gw; row < MMAIN; row += nw) {
        float* d = P->out + (size_t)row * DM; f32x4 v[8]; float sq = 0.f;
#pragma unroll
        for (int i = 0; i < 4; ++i) { const u32x4 x = *(const u32x4*)(hb + (size_t)row * DM + i * 512 + lane * 8);
            v[2 * i] = (f32x4){__uint_as_float(x.x << 16), __uint_as_float(x.x & 0xffff0000u), __uint_as_float(x.y << 16), __uint_as_float(x.y & 0xffff0000u)};
            v[2 * i + 1] = (f32x4){__uint_as_float(x.z << 16), __uint_as_float(x.z & 0xffff0000u), __uint_as_float(x.w << 16), __uint_as_float(x.w & 0xffff0000u)}; }
#pragma unroll
        for (int i = 0; i < 8; ++i) sq += (v[i][0] * v[i][0] + v[i][1] * v[i][1]) + (v[i][2] * v[i][2] + v[i][3] * v[i][3]);
        sq = wave_sum(sq); const float rs = __builtin_amdgcn_rsqf(sq * (1.0f / 2048.0f) + NORM_EPS);
#pragma unroll
        for (int i = 0; i < 4; ++i) { const f32x4 g0 = *(const f32x4*)(g + i * 512 + lane * 8), g1 = *(const f32x4*)(g + i * 512 + lane * 8 + 4);
            *(f32x4*)(d + i * 512 + lane * 8) = v[2 * i] * rs * g0; *(f32x4*)(d + i * 512 + lane * 8 + 4) = v[2 * i + 1] * rs * g1; }
    }
}


__device__ __forceinline__ void phase_lx(PP P, int l) {
    using namespace cfg;
    const int lane = ltid() & 63, gw = lbid() * 8 + (ltid() >> 6), nw = gridDim.x * 8;
    const float* PS = (const float*)(P->ws + WS_PS); bf16_t* LXG = (bf16_t*)(P->ws + WS_LXG); const float* mu = P->in[I_MU] + l * RWKV_COLS + 3072;
    if (lane < 36) {
        const f32x4 m0 = *(const f32x4*)(mu + lane * 8), m1 = *(const f32x4*)(mu + lane * 8 + 4);
#pragma unroll 4
        for (int row = gw; row < MMAIN + NMETA; row += nw) {
            int prev; if (row >= MMAIN) prev = (row == MMAIN) ? -1 : row - 1; else prev = ((row & (SEQ - 1)) == 0) ? MMAIN + NMETA - 1 : row - 1;
            const f32x4 c0 = *(const f32x4*)(PS + (size_t)row * PSW + lane * 8), c1 = *(const f32x4*)(PS + (size_t)row * PSW + lane * 8 + 4);
            f32x4 p0 = (f32x4){0.f, 0.f, 0.f, 0.f}, p1 = p0; if (prev >= 0) { p0 = *(const f32x4*)(PS + (size_t)prev * PSW + lane * 8); p1 = *(const f32x4*)(PS + (size_t)prev * PSW + lane * 8 + 4); }
            float x[8];
#pragma unroll
            for (int j = 0; j < 4; ++j) { x[j] = c0[j] + (p0[j] - c0[j]) * m0[j]; x[4 + j] = c1[j] + (p1[j] - c1[j]) * m1[j]; }
#pragma unroll
            for (int j = 0; j < 8; ++j) x[j] = lane < 8 ? 1.0f - 2.0f * __builtin_amdgcn_rcpf(__expf(2.0f * x[j]) + 1.0f) : (lane < 16 ? x[j] : __builtin_amdgcn_rcpf(1.0f + __expf(-x[j])));
            u32x4 w; w.x = pk_bf16(x[0], x[1]); w.y = pk_bf16(x[2], x[3]); w.z = pk_bf16(x[4], x[5]); w.w = pk_bf16(x[6], x[7]);
            *(u32x4*)(LXG + (size_t)row * 320 + lane * 8) = w;
        }
    }
}

typedef short bf16x8_t __attribute__((ext_vector_type(8)));
typedef short bf16x4_t __attribute__((ext_vector_type(4)));
namespace rk {
constexpr int LXS = 0, LXS_SZ = 18432, RAWH = 55296, RAWH_SZ = 6144, LXB = 73728, RS = 82944, KS = 87040, VS = 91136, KKN = 95232, ATP = 99328, RTP = 101376, BTP = 103424, KTP = 105472,
              BHT = 107520, KHT = 109568, VT = 111616, GT = 113664, AAK = 113920, RB = 114432, RKM = 114944, TINV = 115456, GG = 115968  , VF = 124160  , YR = 132352, BONP = 136448  , LDS_END = 136960;
}
#define RK_BAR() do { asm volatile("s_waitcnt lgkmcnt(0)" ::: "memory"); __builtin_amdgcn_s_barrier(); asm volatile("" ::: "memory"); } while (0)
__device__ __forceinline__ bf16_t bf1(float x) { return (bf16_t)(pk_bf16(x, 0.f) & 0xffffu); }
__device__ __forceinline__ bf16x4_t pack4(float a, float b, float c, float d) { u32x2 w; w.x = pk_bf16(a, b); w.y = pk_bf16(c, d); return __builtin_bit_cast(bf16x4_t, w); }
__device__ __forceinline__ float fast_sigmoid(float x) { return __builtin_amdgcn_rcpf(1.0f + __expf(-x)); }
__device__ __forceinline__ float fast_tanh(float x) { return 1.0f - 2.0f * __builtin_amdgcn_rcpf(__expf(2.0f * x) + 1.0f); }

__device__ __forceinline__ void rwkv_chunked(PP P, int l, int b, int h, LAS unsigned char* lds) {
    using namespace cfg;
    const int tid = ltid(), lane = tid & 63, wave = __builtin_amdgcn_readfirstlane(tid >> 6), n = lane & 15, g = lane >> 4;
    const bf16_t* PR = (const bf16_t*)(P->ws + WS_PR); const float* PS = (const float*)(P->ws + WS_PS); bf16_t* Y = (bf16_t*)(P->ws + WS_Y);
    const float* mu = P->in[I_MU] + l * RWKV_COLS; const bf16_t* LXGp = (const bf16_t*)(P->ws + WS_LXG);
    LAS float* RSm = (LAS float*)(lds + rk::RS); LAS float* KSm = (LAS float*)(lds + rk::KS); LAS float* VSm = (LAS float*)(lds + rk::VS); LAS float* KKNm = (LAS float*)(lds + rk::KKN);
    LAS bf16_t* ATp = (LAS bf16_t*)(lds + rk::ATP); LAS bf16_t* RTp = (LAS bf16_t*)(lds + rk::RTP); LAS bf16_t* BTp = (LAS bf16_t*)(lds + rk::BTP); LAS bf16_t* KTp = (LAS bf16_t*)(lds + rk::KTP);
    LAS bf16_t* BHt = (LAS bf16_t*)(lds + rk::BHT); LAS bf16_t* KHt = (LAS bf16_t*)(lds + rk::KHT); LAS bf16_t* Vt = (LAS bf16_t*)(lds + rk::VT);
    LAS float* GTm = (LAS float*)(lds + rk::GT);
    LAS bf16_t* AAKm = (LAS bf16_t*)(lds + rk::AAK); LAS bf16_t* RBm = (LAS bf16_t*)(lds + rk::RB); LAS bf16_t* RKm = (LAS bf16_t*)(lds + rk::RKM); LAS bf16_t* TINVm = (LAS bf16_t*)(lds + rk::TINV);
    LAS float* YRm = (LAS float*)(lds + rk::YR);
    const int hj = h * 64 + lane;
    const float mur = mu[hj], muk = mu[1024 + hj], muv = mu[2048 + hj], kkw = P->in[I_KK][l * RW + hj], lnw = P->in[I_LNW][l * RW + hj], lnb = P->in[I_LNB][l * RW + hj];
    const int kw = wave & 3, key = 16 * kw + n, hk = h * 64 + key;
    const float w0k = P->in[I_W0][l * RW + hk], a0k = P->in[I_A0][l * RW + hk], kak = P->in[I_KA][l * RW + hk], rkk = P->in[I_RK][l * RW + hk];
    const int pp = 32 * (key >> 5) + 8 * ((key >> 2) & 3) + 4 * ((key >> 4) & 1) + (key & 3);
    bf16x8_t fA[2], fB[5];
    {
        const float* wu = P->in[I_WUP] + (size_t)l * 64 * RW + hk; const float* au = P->in[I_AUP] + (size_t)l * 64 * RW + hk; const float* gu = P->in[I_GUP] + (size_t)l * 160 * RW + hk;
#pragma unroll
        for (int s = 0; s < 5; ++s) { float v[8], u[8];
#pragma unroll
            for (int j = 0; j < 8; ++j) { const int k = 32 * s + 8 * g + j; v[j] = (wave < 4) ? (s < 2 ? au[(size_t)k * RW] : 0.f) : gu[(size_t)k * RW]; u[j] = (wave < 4 && s < 2) ? wu[(size_t)k * RW] : 0.f; }
            u32x4 w; w.x = pk_bf16(v[0], v[1]); w.y = pk_bf16(v[2], v[3]); w.z = pk_bf16(v[4], v[5]); w.w = pk_bf16(v[6], v[7]); fB[s] = __builtin_bit_cast(bf16x8_t, w);
            if (s < 2) { u32x4 x; x.x = pk_bf16(u[0], u[1]); x.y = pk_bf16(u[2], u[3]); x.z = pk_bf16(u[4], u[5]); x.w = pk_bf16(u[6], u[7]); fA[s] = __builtin_bit_cast(bf16x8_t, x); } }
    }
    f32x4 ST[4];
#pragma unroll
    for (int kb = 0; kb < 4; ++kb) ST[kb] = (f32x4){0.f, 0.f, 0.f, 0.f};
#define RK_DMA(c_) do { const int cc_ = (c_); const int row0_ = (cc_ == 0) ? MMAIN : b * SEQ + (cc_ - 1) * 16; const int bi_ = cc_ % 3; \
        _Pragma("unroll") for (int i_ = 0; i_ < 2; ++i_) { const int wp_ = (i_ == 0) ? wave : 8; if (i_ == 0 || wave == 6) { const int x_ = wp_ * 64 + lane; \
            __builtin_amdgcn_global_load_lds((const unsigned*)(LXGp + (size_t)(row0_ + x_ / 36) * 320 + (x_ % 36) * 8), (LAS unsigned*)(lds + rk::LXS + (cc_ & 1) * rk::LXS_SZ + wp_ * 1024), 16, 0, 0); } } \
        if (wave < 6) { const int y_ = wave * 64 + lane; \
            __builtin_amdgcn_global_load_lds((const unsigned*)(PR + (size_t)(row0_ + y_ / 24) * PRW + ((y_ % 24) >> 3) * 1024 + h * 64 + (y_ & 7) * 8), (LAS unsigned*)(lds + rk::RAWH + bi_ * rk::RAWH_SZ + wave * 1024), 16, 0, 0); } } while (0)
#define RK_STAGE_A(ca_, t_) do { const int t = (t_); const int bc_ = (ca_) % 3, bp_ = ((ca_) + 2) % 3; \
        LAS const bf16_t* cH_ = (LAS const bf16_t*)(lds + rk::RAWH + bc_ * rk::RAWH_SZ); LAS const bf16_t* pH_ = (LAS const bf16_t*)(lds + rk::RAWH + bp_ * rk::RAWH_SZ); \
        LAS const bf16_t* ctH = cH_ + t * 192; LAS const bf16_t* ptH = (t == 0) ? pH_ + 15 * 192 : cH_ + (t - 1) * 192; \
        const float rc = bf2f(ctH[lane]), kc = bf2f(ctH[64 + lane]), vc = bf2f(ctH[128 + lane]); \
        const float rs = rc + (bf2f(ptH[lane]) - rc) * mur, ks = kc + (bf2f(ptH[64 + lane]) - kc) * muk, vs = vc + (bf2f(ptH[128 + lane]) - vc) * muv; \
        RSm[t * 64 + lane] = rs; KSm[t * 64 + lane] = ks; VSm[t * 64 + lane] = vs; \
        const float kkr = ks * kkw; const float n2 = wave_sum_dpp(kkr * kkr); KKNm[t * 64 + lane] = kkr * __builtin_amdgcn_rsqf(fmaxf(n2, 1e-24f)); } while (0)
#define RK_STAGE_F(cf_, t_) do { const int t = (t_); const int par_ = (cf_) & 1; const int rowF_ = ((cf_) == 0) ? MMAIN : b * SEQ + ((cf_) - 1) * 16; \
        LAS const float* Gp_ = (LAS const float*)(lds + rk::GG + par_ * 4096); LAS const float* Vp_ = (LAS const float*)(lds + rk::VF + par_ * 4096); LAS const float* Bp_ = (LAS const float*)(lds + rk::BONP + par_ * 256); \
        const float yv = YRm[t * 64 + lane]; \
        const float mean = wave_sum_dpp(yv) * (1.0f / 64.0f); const float d = yv - mean; const float var = wave_sum_dpp(d * d) * (1.0f / 64.0f); \
        const float yn = d * __builtin_amdgcn_rsqf(var + LNX_EPS) * lnw + lnb; \
        const float bonus = (Bp_[t] + Bp_[16 + t]) + (Bp_[32 + t] + Bp_[48 + t]); \
        const float o = (yn + bonus * Vp_[t * 64 + lane]) * Gp_[t * 64 + lane]; \
        if ((cf_) > 0 || b == 0) Y[(size_t)(rowF_ + t) * DM + hj] = bf1(o); } while (0)
    RK_DMA(0); RK_DMA(1);
    for (int e = tid; e < 96; e += 512) ((LAS unsigned*)(lds + rk::RAWH + 2 * rk::RAWH_SZ))[15 * 96 + e] = 0u;
    asm volatile("s_waitcnt vmcnt(0)" ::: "memory");
    RK_BAR();
    RK_STAGE_A(0, wave); RK_STAGE_A(0, wave + 8);
    RK_BAR();
#pragma unroll 1
    for (int c = 0; c < 257; ++c) {
        if (wave < 4) {
            LAS float* BONPc = (LAS float*)(lds + rk::BONP + (c & 1) * 256); LAS const bf16_t* LXB = (LAS const bf16_t*)(lds + rk::LXS + (c & 1) * rk::LXS_SZ);
            f32x4 accW = (f32x4){0.f, 0.f, 0.f, 0.f}, accA = accW;
#pragma unroll
            for (int s = 0; s < 2; ++s) { const bf16x8_t aw = *(const LAS bf16x8_t*)(LXB + n * 288 + 32 * s + 8 * g), aa = *(const LAS bf16x8_t*)(LXB + n * 288 + 64 + 32 * s + 8 * g);
                accW = __builtin_amdgcn_mfma_f32_16x16x32_bf16(aw, fA[s], accW, 0, 0, 0); accA = __builtin_amdgcn_mfma_f32_16x16x32_bf16(aa, fB[s], accA, 0, 0, 0); }
            float lw[4], alr[4], pfx[4];
#pragma unroll
            for (int r = 0; r < 4; ++r) { lw[r] = -0.6065306597126334f * fast_sigmoid(accW[r] + w0k); alr[r] = fast_sigmoid(accA[r] + a0k); }
            pfx[0] = lw[0]; pfx[1] = pfx[0] + lw[1]; pfx[2] = pfx[1] + lw[2]; pfx[3] = pfx[2] + lw[3];
            const float t0 = __shfl(pfx[3], n), t1 = __shfl(pfx[3], n + 16), t2 = __shfl(pfx[3], n + 32), t3 = __shfl(pfx[3], n + 48);
            const float base = (g > 0 ? t0 : 0.f) + (g > 1 ? t1 : 0.f) + (g > 2 ? t2 : 0.f), lamT = (t0 + t1) + (t2 + t3);
            float bh[4], kh[4], bon[4], epos[4];
            const float eb = __expf(base), eT = __expf(lamT);
#pragma unroll
            for (int r = 0; r < 4; ++r) epos[r] = __expf(base + pfx[r]);
#pragma unroll
            for (int r = 0; r < 4; ++r) { const int t = 4 * g + r;
                const float e_pos = epos[r], e_neg = __builtin_amdgcn_rcpf(epos[r]), e_prev = (r == 0) ? eb : epos[r > 0 ? r - 1 : 0], e_hat = eT * e_neg;
                const float rs = RSm[t * 64 + key], ks = KSm[t * 64 + key], kk = KKNm[t * 64 + key];
                const float kmod = ks * (1.0f + (alr[r] - 1.0f) * kak), bb = kk * alr[r];
                ATp[t * 64 + pp] = bf1(-kk * e_prev); RTp[t * 64 + pp] = bf1(rs * e_pos); BTp[t * 64 + pp] = bf1(bb * e_neg); KTp[t * 64 + pp] = bf1(kmod * e_neg);
                bh[r] = bb * e_hat; kh[r] = kmod * e_hat; bon[r] = rs * kmod * rkk; }
            *(LAS bf16x4_t*)(BHt + key * 16 + 4 * g) = pack4(bh[0], bh[1], bh[2], bh[3]); *(LAS bf16x4_t*)(KHt + key * 16 + 4 * g) = pack4(kh[0], kh[1], kh[2], kh[3]);
#pragma unroll
            for (int r = 0; r < 4; ++r) { const float x = row_sum16(bon[r]); if (n == 0) BONPc[kw * 16 + 4 * g + r] = x; }
            if (g == 0) GTm[key] = eT;
        } else {
            LAS float* Gc = (LAS float*)(lds + rk::GG + (c & 1) * 4096); LAS float* VFc = (LAS float*)(lds + rk::VF + (c & 1) * 4096); LAS const bf16_t* LXB = (LAS const bf16_t*)(lds + rk::LXS + (c & 1) * rk::LXS_SZ);
            f32x4 accG = (f32x4){0.f, 0.f, 0.f, 0.f};
#pragma unroll
            for (int s = 0; s < 5; ++s) { const bf16x8_t ag = *(const LAS bf16x8_t*)(LXB + n * 288 + 128 + 32 * s + 8 * g); accG = __builtin_amdgcn_mfma_f32_16x16x32_bf16(ag, fB[s], accG, 0, 0, 0); }
            float vv[4];
#pragma unroll
            for (int r = 0; r < 4; ++r) { Gc[(4 * g + r) * 64 + key] = accG[r]; vv[r] = VSm[(4 * g + r) * 64 + key]; VFc[(4 * g + r) * 64 + key] = vv[r]; }
            *(LAS bf16x4_t*)(Vt + key * 16 + 4 * g) = pack4(vv[0], vv[1], vv[2], vv[3]);
            if (c >= 1) { RK_STAGE_F(c - 1, 4 * kw); RK_STAGE_F(c - 1, 4 * kw + 1); RK_STAGE_F(c - 1, 4 * kw + 2); RK_STAGE_F(c - 1, 4 * kw + 3); }
        }
        asm volatile("s_waitcnt vmcnt(0)" ::: "memory");
        RK_BAR();
        if (c + 2 < 257) RK_DMA(c + 2);
        if (wave < 4) {
            LAS const bf16_t* X = (wave < 2) ? ATp : RTp; LAS const bf16_t* Yi = (wave & 1) ? KTp : BTp;
            f32x4 acc = (f32x4){0.f, 0.f, 0.f, 0.f};
#pragma unroll
            for (int s = 0; s < 2; ++s) { const bf16x8_t xa = *(const LAS bf16x8_t*)(X + n * 64 + 32 * s + 8 * g), yb = *(const LAS bf16x8_t*)(Yi + n * 64 + 32 * s + 8 * g);
                acc = __builtin_amdgcn_mfma_f32_16x16x32_bf16(xa, yb, acc, 0, 0, 0); }
            float mv[4];
#pragma unroll
            for (int r = 0; r < 4; ++r) { const int t = 4 * g + r; const bool keep = (wave < 2) ? (n < t) : (n <= t); mv[r] = keep ? acc[r] : 0.f;
                if (wave == 1) AAKm[t * 16 + n] = bf1(mv[r]); else if (wave == 2) RBm[t * 16 + n] = bf1(mv[r]); else if (wave == 3) RKm[t * 16 + n] = bf1(mv[r]); }
            if (wave == 0) {
                float Tc[16];
#pragma unroll
                for (int t = 0; t < 16; ++t) { float v0 = (t == n) ? 1.0f : 0.0f, v1 = 0.f;
#pragma unroll
                    for (int i = 0; i < t; ++i) { const float a = rdlane(mv[t & 3], i + 16 * (t >> 2)); if (i & 1) v1 += a * Tc[i]; else v0 += a * Tc[i]; }
                    Tc[t] = v0 + v1; asm volatile("" : "+v"(mv[0]), "+v"(mv[1]), "+v"(mv[2]), "+v"(mv[3]));     }
                if (g == 0) {
#pragma unroll
                    for (int t = 0; t < 16; ++t) TINVm[t * 16 + n] = bf1(Tc[t]); }
            }
        }
        if (wave >= 1) {
            if (c + 1 < 257 && wave != 4) { const int t0_ = (wave < 4) ? 3 * (wave - 1) : (wave == 5 ? 9 : 12 + 2 * (wave - 6));
                RK_STAGE_A(c + 1, t0_); RK_STAGE_A(c + 1, t0_ + 1); if (wave < 6) RK_STAGE_A(c + 1, t0_ + 2); }
        }
        RK_BAR();
        if (wave < 4) {
            bf16x8_t sb[2];
#pragma unroll
            for (int s = 0; s < 2; ++s) { u32x4 w; w.x = pk_bf16(ST[2 * s][0], ST[2 * s][1]); w.y = pk_bf16(ST[2 * s][2], ST[2 * s][3]); w.z = pk_bf16(ST[2 * s + 1][0], ST[2 * s + 1][1]); w.w = pk_bf16(ST[2 * s + 1][2], ST[2 * s + 1][3]);
                sb[s] = __builtin_bit_cast(bf16x8_t, w); }
            const bf16x4_t vfr = *(const LAS bf16x4_t*)(Vt + key * 16 + 4 * g);
            f32x4 W1 = (f32x4){0.f, 0.f, 0.f, 0.f}, Yc = W1;
#pragma unroll
            for (int s = 0; s < 2; ++s) { const bf16x8_t af = *(const LAS bf16x8_t*)(ATp + n * 64 + 32 * s + 8 * g), rf = *(const LAS bf16x8_t*)(RTp + n * 64 + 32 * s + 8 * g);
                W1 = __builtin_amdgcn_mfma_f32_16x16x32_bf16(af, sb[s], W1, 0, 0, 0); Yc = __builtin_amdgcn_mfma_f32_16x16x32_bf16(rf, sb[s], Yc, 0, 0, 0); }
            W1 = __builtin_amdgcn_mfma_f32_16x16x16bf16_1k(*(const LAS bf16x4_t*)(AAKm + n * 16 + 4 * g), vfr, W1, 0, 0, 0);
            const bf16x4_t w1f = pack4(W1[0], W1[1], W1[2], W1[3]);
            f32x4 U = __builtin_amdgcn_mfma_f32_16x16x16bf16_1k(*(const LAS bf16x4_t*)(TINVm + n * 16 + 4 * g), w1f, (f32x4){0.f, 0.f, 0.f, 0.f}, 0, 0, 0);
            const bf16x4_t uf = pack4(U[0], U[1], U[2], U[3]);
            Yc = __builtin_amdgcn_mfma_f32_16x16x16bf16_1k(*(const LAS bf16x4_t*)(RBm + n * 16 + 4 * g), uf, Yc, 0, 0, 0);
            Yc = __builtin_amdgcn_mfma_f32_16x16x16bf16_1k(*(const LAS bf16x4_t*)(RKm + n * 16 + 4 * g), vfr, Yc, 0, 0, 0);
#pragma unroll
            for (int r = 0; r < 4; ++r) YRm[(4 * g + r) * 64 + key] = Yc[r];
#pragma unroll
            for (int kb = 0; kb < 4; ++kb) { const f32x4 gt = *(const LAS f32x4*)(GTm + 16 * kb + 4 * g); f32x4 a = ST[kb] * gt;
                a = __builtin_amdgcn_mfma_f32_16x16x16bf16_1k(*(const LAS bf16x4_t*)(BHt + (16 * kb + n) * 16 + 4 * g), uf, a, 0, 0, 0);
                a = __builtin_amdgcn_mfma_f32_16x16x16bf16_1k(*(const LAS bf16x4_t*)(KHt + (16 * kb + n) * 16 + 4 * g), vfr, a, 0, 0, 0);
                ST[kb] = a; }
        }
        RK_BAR();
    }
    RK_STAGE_F(256, wave); RK_STAGE_F(256, wave + 8);
    asm volatile("s_waitcnt vmcnt(0)" ::: "memory");
    RK_BAR();
#undef RK_DMA
#undef RK_STAGE_A
#undef RK_STAGE_F
}

__device__ __forceinline__ f32x4 sk_dot(const bf16_t* a, const bf16_t* b, int nsteps) {
    f32x4 acc = (f32x4){0.f, 0.f, 0.f, 0.f};
#pragma unroll 8
    for (int s = 0; s < nsteps; ++s) { const bf16x8_t av = *(const bf16x8_t*)(a + 32 * s), bv = *(const bf16x8_t*)(b + 32 * s); acc = __builtin_amdgcn_mfma_f32_16x16x32_bf16(av, bv, acc, 0, 0, 0); }
    return acc; }
__device__ __forceinline__ void meta_rs(const float* ssm, int lane, float (&rs)[4]) {
    const int row = lane & 15, part = lane >> 4; float s = 0.f;
#pragma unroll 8
    for (int i = 0; i < 32; ++i) s += ssm[(part + 4 * i) * 16 + row];
    s = s + __shfl_xor(s, 16); s = s + __shfl_xor(s, 32);
    const float rv = __builtin_amdgcn_rsqf(s * (1.0f / 2048.0f) + 1e-6f);
#pragma unroll
    for (int r = 0; r < 4; ++r) rs[r] = __shfl(rv, 4 * part + r); }
#define SK_HEAD const int tid = ltid(), lane = tid & 63, wave = __builtin_amdgcn_readfirstlane(tid >> 6), n = lane & 15, g = lane >> 4, kq = wave & 3, ti = lbid() + 256 * (wave >> 2); LAS f32x4* part = (LAS f32x4*)lds;
#define SK_COMBINE(dst, slot) do { dst = (part[((wave) * 2 + (slot)) * 64 + lane] + part[((wave + 1) * 2 + (slot)) * 64 + lane]) + (part[((wave + 2) * 2 + (slot)) * 64 + lane] + part[((wave + 3) * 2 + (slot)) * 64 + lane]); } while (0)
__device__ __forceinline__ void skinny_gu(const bf16_t* hb, const bf16_t* Bt, const float* ssm, bf16_t* act, LAS unsigned char* lds) {
    using namespace cfg; SK_HEAD
    if (ti < DFF / 16) { const int c0 = 16 * ti, brow = (c0 >> 7) * 256 + (c0 & 127) + n; const bf16_t* a = hb + (size_t)(MMAIN + n) * DM + 512 * kq + 8 * g;
        part[(wave * 2) * 64 + lane] = sk_dot(a, Bt + (size_t)brow * DM + 512 * kq + 8 * g, 16); part[(wave * 2 + 1) * 64 + lane] = sk_dot(a, Bt + (size_t)(brow + 128) * DM + 512 * kq + 8 * g, 16); }
    __syncthreads();
    if (ti < DFF / 16 && kq == 0) { f32x4 gt, up; SK_COMBINE(gt, 0); SK_COMBINE(up, 1); float rs[4]; meta_rs(ssm, lane, rs);
#pragma unroll
        for (int r = 0; r < 4; ++r) { const float gv = gt[r] * rs[r], uv = up[r] * rs[r]; act[(size_t)(MMAIN + 4 * g + r) * DFF + 16 * ti + n] = bf1(gv * __builtin_amdgcn_rcpf(1.0f + __builtin_amdgcn_exp2f(-1.4426950408889634f * gv)) * uv); } }
    __syncthreads();
}
__device__ __forceinline__ void skinny_res(const bf16_t* A16, int K, const bf16_t* Bt, bf16_t* hb, float* ssm_out, float alpha, LAS unsigned char* lds) {
    using namespace cfg;
    const int tid = ltid(), lane = tid & 63, wave = __builtin_amdgcn_readfirstlane(tid >> 6), n = lane & 15, g = lane >> 4, ti = lbid(); LAS f32x4* part = (LAS f32x4*)lds;
    const int k8 = K / 8;
    if (ti < DM / 16) part[wave * 64 + lane] = sk_dot(A16 + (size_t)n * K + k8 * wave + 8 * g, Bt + (size_t)(16 * ti + n) * K + k8 * wave + 8 * g, k8 / 32);
    __syncthreads();
    if (ti < DM / 16 && wave == 0) { const f32x4 acc = ((part[lane] + part[64 + lane]) + (part[128 + lane] + part[192 + lane])) + ((part[256 + lane] + part[320 + lane]) + (part[384 + lane] + part[448 + lane]));
#pragma unroll
        for (int r = 0; r < 4; ++r) { const int m = 4 * g + r, col = 16 * ti + n; bf16_t* p = hb + (size_t)(MMAIN + m) * DM + col; const float hv = bf2f(*p) + alpha * acc[r]; *p = bf1(hv);
            const float sq = row_sum16(hv * hv); if (n == 0) ssm_out[ti * 16 + m] = sq; } }
    __syncthreads();
}
__device__ __forceinline__ void skinny_p(const bf16_t* hb, const bf16_t* Bt, const float* ssm, bf16_t* pr, float* ps, bf16_t* qkv, LAS unsigned char* lds) {
    using namespace cfg; SK_HEAD
    if (ti < NIN / 16) part[(wave * 2) * 64 + lane] = sk_dot(hb + (size_t)(MMAIN + n) * DM + 512 * kq + 8 * g, Bt + (size_t)(16 * ti + n) * DM + 512 * kq + 8 * g, 16);
    __syncthreads();
    if (ti < NIN / 16 && kq == 0) { f32x4 acc; SK_COMBINE(acc, 0); float rs[4]; meta_rs(ssm, lane, rs); const int np = 16 * ti + n;
#pragma unroll
        for (int r = 0; r < 4; ++r) { const int m = 4 * g + r; const float v = acc[r] * rs[r];
            if (np < 3072) pr[(size_t)(MMAIN + m) * PRW + np] = bf1(v);
            else if (np < 3584) ps[(size_t)(MMAIN + m) * PSW + (np - 3072)] = v;
            else { const bf16_t w = bf1(v);
#pragma unroll
                for (int b = 0; b < NBATCH; ++b) qkv[((size_t)b * SEQP + 48 + m) * QKVW + (np - 3584)] = w; } } }
    __syncthreads();
}
#undef SK_HEAD
#undef SK_COMBINE

namespace fox {
constexpr int D = 128, NW = 8, QBLK = 32, KVBLK = 64, QB = NW * QBLK;
constexpr int LDQ = cfg::QKVW, LDK = cfg::QKVW, LDO = cfg::DM;
constexpr float SCALE = 0.08838834764831845f, THR = 8.f;
constexpr bool WSKIP = false;
constexpr int SHM_V = KVBLK * D * 2, SHM_K = KVBLK * D * 2;
constexpr int ATT_LDS = 2 * SHM_V + 2 * SHM_K + NW * 64 * 4;
constexpr int BIAS_OFF = ATT_LDS;
constexpr int SCAN_OFF = BIAS_OFF + cfg::SEQP * 4;

using bf16 = __hip_bfloat16;
typedef short bf16x8 __attribute__((ext_vector_type(8)));
typedef short s16x4 __attribute__((ext_vector_type(4)));
typedef float f32x16 __attribute__((ext_vector_type(16)));
typedef float f32x4 __attribute__((ext_vector_type(4)));
typedef unsigned u32x4 __attribute__((ext_vector_type(4)));
template <class A, class Bt> struct same_t { static constexpr bool v = false; };
template <class A> struct same_t<A, A> { static constexpr bool v = true; };

#define KSWZ(row, colB) ((row) * 256 + ((colB) ^ (((row) & 7) << 4)))
#define SBAR() __builtin_amdgcn_sched_barrier(0)
__device__ __forceinline__ int v_st(int k, int c) { const int kk = (k & ~0xC) | ((k & 4) << 1) | ((k & 8) >> 1); return ((kk >> 3) * 4 + (c >> 5)) * 512 + ((kk & 7) * 32 + (c & 31)) * 2; }
__device__ __forceinline__ int v_rd_base(int lane) { return ((lane & 3) << 3) | (((lane >> 2) & 3) << 6) | (((lane >> 4) & 1) << 5) | (((lane >> 5) & 1) << 8); }
constexpr int v_rd_off(int d0, int ks, int half) { return d0 * 512 + ks * 4096 + half * 2048; }
__device__ __forceinline__ int crow(int r, int hi) { return (r & 3) + 8 * (r >> 2) + 4 * hi; }
__device__ __forceinline__ unsigned cvtpk(float lo, float hi) {
    unsigned r; asm volatile("v_cvt_pk_bf16_f32 %0, %1, %2" : "=v"(r) : "v"(lo), "v"(hi)); return r;
}
__device__ __forceinline__ bf16x8 pack8(f32x4 a, f32x4 b) {
    u32x4 w = {cvtpk(a[0], a[1]), cvtpk(a[2], a[3]), cvtpk(b[0], b[1]), cvtpk(b[2], b[3])};
    return *reinterpret_cast<bf16x8*>(&w);
}
template <class T> __device__ __forceinline__ bf16x8 load8(const T* p) {
    if constexpr (same_t<T, float>::v) { return pack8(*(const f32x4*)p, *(const f32x4*)(p + 4)); }
    else { return *reinterpret_cast<const bf16x8*>(p); }
}
__device__ __forceinline__ void mask_tile(f32x16& p0, f32x16& p1, int dq, unsigned W) {
    const float NEG = -__builtin_inff();
#pragma unroll
    for (int r = 0; r < 16; ++r) {
        const int c = (r & 3) + 8 * (r >> 2);
        if ((unsigned)(dq - c) >= W) p0[r] = NEG;
        if ((unsigned)(dq - c - 32) >= W) p1[r] = NEG;
    }
}
__device__ __forceinline__ void partialSM(f32x16& p0, f32x16& p1, float& m_reg, float& mn, float& alpha) {
    float pmax = p0[0]; for (int r = 1; r < 16; ++r) pmax = fmaxf(pmax, p0[r]); for (int r = 0; r < 16; ++r) pmax = fmaxf(pmax, p1[r]);
    { auto rr = __builtin_amdgcn_permlane32_swap(__float_as_uint(pmax), __float_as_uint(pmax), false, false);
      pmax = fmaxf(__uint_as_float(rr[0]), __uint_as_float(rr[1])); }
    constexpr float C2 = 1.4426950408889634f * SCALE;
    if (__builtin_expect(__all((pmax - m_reg) * SCALE <= THR), 1)) { mn = m_reg; alpha = 1.f; }
    else { mn = fmaxf(m_reg, pmax); alpha = __builtin_amdgcn_exp2f((m_reg - mn) * C2); m_reg = mn; }
    const float mnL = -mn * C2;
    for (int r = 0; r < 16; ++r) p0[r] = fmaf(p0[r], C2, mnL); for (int r = 0; r < 16; ++r) p1[r] = fmaf(p1[r], C2, mnL);
    for (int r = 0; r < 16; ++r) p0[r] = __builtin_amdgcn_exp2f(p0[r]);
}
__device__ __forceinline__ void finishSM(f32x16& p0, f32x16& p1, float alpha, float& l_reg, bf16x8& pa0, bf16x8& pa1, bf16x8& pa2, bf16x8& pa3) {
    for (int r = 0; r < 16; ++r) p1[r] = __builtin_amdgcn_exp2f(p1[r]);
    float ps = 0; for (int r = 0; r < 16; ++r) ps += p0[r]; for (int r = 0; r < 16; ++r) ps += p1[r];
    { auto rr = __builtin_amdgcn_permlane32_swap(__float_as_uint(ps), __float_as_uint(ps), false, false);
      ps = __uint_as_float(rr[0]) + __uint_as_float(rr[1]); }
    l_reg = l_reg * alpha + ps;
#define PK4(P, B_, OUT) do { unsigned a0 = cvtpk(P[B_+0], P[B_+1]), a1 = cvtpk(P[B_+2], P[B_+3]);                          \
        unsigned b0 = cvtpk(P[B_+4], P[B_+5]), b1 = cvtpk(P[B_+6], P[B_+7]);                                             \
        auto r0 = __builtin_amdgcn_permlane32_swap(a0, b0, false, false); auto r1 = __builtin_amdgcn_permlane32_swap(a1, b1, false, false); \
        u32x4 w = {r0[0], r1[0], r0[1], r1[1]}; OUT = *reinterpret_cast<bf16x8*>(&w); } while (0)
    PK4(p0, 0, pa0); PK4(p0, 8, pa1); PK4(p1, 0, pa2); PK4(p1, 8, pa3);
#undef PK4
}
template <int KB, bool SK>
__device__ __forceinline__ void qkt(f32x16& p0, f32x16& p1, const char* K_lds, int r32, int hi, const bf16x8* qr, bool act, const float* bias_t) {
    if (SK && !act) { const float NEG = -__builtin_inff();
#pragma unroll
        for (int r = 0; r < 16; ++r) { p0[r] = NEG; p1[r] = NEG; } return; }
    {
#pragma unroll
        for (int g_ = 0; g_ < 4; ++g_) { const f32x4 b0_ = *(const f32x4*)(bias_t + 8 * g_ + 4 * hi); const f32x4 b1_ = *(const f32x4*)(bias_t + 32 + 8 * g_ + 4 * hi);
            p0[4 * g_] = b0_[0]; p0[4 * g_ + 1] = b0_[1]; p0[4 * g_ + 2] = b0_[2]; p0[4 * g_ + 3] = b0_[3];
            p1[4 * g_] = b1_[0]; p1[4 * g_ + 1] = b1_[1]; p1[4 * g_ + 2] = b1_[2]; p1[4 * g_ + 3] = b1_[3]; } }
    const char* kb[4];
#pragma unroll
    for (int dd = 0; dd < 4; ++dd) kb[dd] = K_lds + KB * SHM_K + KSWZ(r32, (dd * 16 + hi * 8) * 2);
#pragma unroll
    for (int d0 = 0; d0 < 8; ++d0) { const char* a = kb[d0 & 3] + (d0 >> 2) * 128;
        bf16x8 b0 = *reinterpret_cast<const bf16x8*>(a);
        bf16x8 b1 = *reinterpret_cast<const bf16x8*>(a + 32 * 256);
        p0 = __builtin_amdgcn_mfma_f32_32x32x16_bf16(b0, qr[d0], p0, 0, 0, 0);
        p1 = __builtin_amdgcn_mfma_f32_32x32x16_bf16(b1, qr[d0], p1, 0, 0, 0); }
}
template <int VB, bool SK>
__device__ __forceinline__ void pv_tile(f32x16* o, int vb0, bf16x8 pa0, bf16x8 pa1, bf16x8 pa2, bf16x8 pa3, bool act) {
    if (SK && !act) return;
#define TRRD(dst, off) asm volatile("ds_read_b64_tr_b16 %0, %1 offset:%2" : "=&v"(dst) : "v"(vb0), "i"(off) : "memory")
#define PV_D0(d0) do { s16x4 l0, l1, l2, l3, h0, h1, h2, h3; constexpr int b_ = VB * SHM_V + v_rd_off(d0, 0, 0);     \
        TRRD(l0, b_); TRRD(h0, b_ + 2048); TRRD(l1, b_ + 4096); TRRD(h1, b_ + 6144); TRRD(l2, b_ + 8192); TRRD(h2, b_ + 10240); TRRD(l3, b_ + 12288); TRRD(h3, b_ + 14336); \
        asm volatile("s_waitcnt lgkmcnt(0)" ::: "memory"); SBAR();                 \
        o[d0] = __builtin_amdgcn_mfma_f32_32x32x16_bf16(pa0, (bf16x8){l0[0], l0[1], l0[2], l0[3], h0[0], h0[1], h0[2], h0[3]}, o[d0], 0, 0, 0);   \
        o[d0] = __builtin_amdgcn_mfma_f32_32x32x16_bf16(pa1, (bf16x8){l1[0], l1[1], l1[2], l1[3], h1[0], h1[1], h1[2], h1[3]}, o[d0], 0, 0, 0);   \
        o[d0] = __builtin_amdgcn_mfma_f32_32x32x16_bf16(pa2, (bf16x8){l2[0], l2[1], l2[2], l2[3], h2[0], h2[1], h2[2], h2[3]}, o[d0], 0, 0, 0);   \
        o[d0] = __builtin_amdgcn_mfma_f32_32x32x16_bf16(pa3, (bf16x8){l3[0], l3[1], l3[2], l3[3], h3[0], h3[1], h3[2], h3[3]}, o[d0], 0, 0, 0); } while (0)
    PV_D0(0); PV_D0(1); PV_D0(2); PV_D0(3);
#undef PV_D0
#undef TRRD
}

template <class TIn, class TOut> struct BlockRef { const TIn* Q; const TIn* K; const TIn* V; TOut* O; int P0; };
template <class TIn> struct Seam {
    bf16x8 qr[8];
    bf16x8 st_v0, st_v1, st_k0, st_k1; f32x4 sf0, sf1, sf2, sf3;
    f32x4 tq[16];
};
__device__ __forceinline__ int swa_jlo(int P0, int W) { const int lowk = P0 - W + 1; return lowk > 0 ? lowk / KVBLK : 0; }
#define ROW(p, k0, rr) ((p) + (size_t)((k0) + (rr)) * LDK + sc)
#define VMW() asm volatile("s_waitcnt vmcnt(0)" ::: "memory")
#define VMWN(n) asm volatile("s_waitcnt vmcnt(%0)" :: "i"(n) : "memory")
#define SLOAD_H(Kp, Vp, k0) do { S.st_v0 = load8<TIn>(ROW(Vp, k0, sr)); S.st_v1 = load8<TIn>(ROW(Vp, k0, 32 + sr));              \
                         S.st_k0 = load8<TIn>(ROW(Kp, k0, sr)); S.st_k1 = load8<TIn>(ROW(Kp, k0, 32 + sr)); } while (0)
#define SWRITE_HK(bf) do { *(bf16x8*)(K_lds + (bf) * SHM_K + kws) = S.st_k0; *(bf16x8*)(K_lds + (bf) * SHM_K + kws + 32 * 256) = S.st_k1; } while (0)
#define SWRITE_HV(bf) do { *(bf16x8*)(V_lds + (bf) * SHM_V + vst0) = S.st_v0; *(bf16x8*)(V_lds + (bf) * SHM_V + vst1) = S.st_v1; } while (0)
#define SWRITE_H(bf) do { SWRITE_HV(bf); SWRITE_HK(bf); } while (0)
#define SLOAD_F(p, k0) do { S.sf0 = *(const f32x4*)ROW(p, k0, sr); S.sf1 = *(const f32x4*)(ROW(p, k0, sr) + 4);                \
                            S.sf2 = *(const f32x4*)ROW(p, k0, 32 + sr); S.sf3 = *(const f32x4*)(ROW(p, k0, 32 + sr) + 4); } while (0)
#define SWRITE_KF(bf) do { *(bf16x8*)(K_lds + (bf) * SHM_K + kws) = pack8(S.sf0, S.sf1); *(bf16x8*)(K_lds + (bf) * SHM_K + kws + 32 * 256) = pack8(S.sf2, S.sf3); } while (0)
#define SWRITE_VF(bf) do { *(bf16x8*)(V_lds + (bf) * SHM_V + vst0) = pack8(S.sf0, S.sf1); *(bf16x8*)(V_lds + (bf) * SHM_V + vst1) = pack8(S.sf2, S.sf3); } while (0)
template <class TIn, class TOut>
__device__ __forceinline__ void causal_swa_prime(const BlockRef<TIn, TOut>& cur, int W, char* lds, Seam<TIn>& S) {
    constexpr bool F32 = same_t<TIn, float>::v;
    const int tid = ltid(), wid = __builtin_amdgcn_readfirstlane(tid >> 6), lane = tid & 63, r32 = lane & 31, hi = lane >> 5;
    const int sr = tid >> 4, sc = (tid & 15) * 8, kws = KSWZ(sr, sc * 2); char* K_lds = lds + 2 * SHM_V;
    const int kb0 = swa_jlo(cur.P0, W) * KVBLK;
    for (int d0 = 0; d0 < 8; ++d0) S.qr[d0] = load8<TIn>(cur.Q + (size_t)(wid * QBLK + r32) * LDQ + d0 * 16 + hi * 8);
    if constexpr (F32) { SLOAD_F((const float*)cur.K, kb0); VMW(); SWRITE_KF(0); SBAR(); SLOAD_F((const float*)cur.V, kb0); }
    else { SLOAD_H(cur.K, cur.V, kb0); VMW(); SWRITE_HK(0); }
    __syncthreads();
}
template <class TIn, class TOut>
__device__ __forceinline__ void causal_swa_block(const BlockRef<TIn, TOut>& cur, const BlockRef<TIn, TOut>& nxt, int skv, int W, char* lds, Seam<TIn>& S, const float* bias_l) {
    constexpr bool F32 = same_t<TIn, float>::v;
    const int tid = ltid(), wid = __builtin_amdgcn_readfirstlane(tid >> 6), lane = tid & 63, r32 = lane & 31, hi = lane >> 5;
    const int j_lo = swa_jlo(cur.P0, W);
    int j_hi = (cur.P0 + QB - 1) / KVBLK + 1; if (j_hi > skv / KVBLK) j_hi = skv / KVBLK;
    const int NT = j_hi - j_lo;
    const int kbn = swa_jlo(nxt.P0, W) * KVBLK;
    const int qlo = cur.P0 + wid * QBLK, qm = qlo + r32 - 4 * hi;
    char* V_lds = lds; char* K_lds = lds + 2 * SHM_V;
    float* ws = (float*)(lds + 2 * SHM_V + 2 * SHM_K) + wid * 64; float* li_l = ws, * al_l = ws + 32;
    float m_reg = -1e30f, l_reg = 0; f32x16 o[4] = {};
    const int sr = tid >> 4, sc = (tid & 15) * 8, vst0 = v_st(sr, sc), vst1 = v_st(32 + sr, sc), kws = KSWZ(sr, sc * 2);
    const int vb0 = (int)(uintptr_t)V_lds + v_rd_base(lane);
    const TIn* Kh = cur.K; const TIn* Vh = cur.V;
#define RESC(a) do { if (__any((a) < 1.f)) { if (hi == 0) al_l[r32] = (a); asm volatile("s_waitcnt lgkmcnt(0)" ::: "memory");              \
                     for (int d_ = 0; d_ < 4; ++d_) for (int r = 0; r < 16; ++r) o[d_][r] *= al_l[crow(r, hi)]; } } while (0)
#define KBASE(t) ((j_lo + (t)) * KVBLK)
#define ACT(t) (KBASE(t) <= qlo + QBLK - 1 && KBASE(t) + KVBLK - 1 >= qlo - W + 1)
#define MASKT(P0_, P1_, t) do { const int kb_ = KBASE(t); if ((!SK || ACT(t)) && (kb_ + KVBLK - 1 > qlo || kb_ <= qlo + QBLK - 1 - W)) mask_tile(P0_, P1_, qm - kb_, (unsigned)W); } while (0)
    constexpr int NQL = F32 ? 16 : 8;
    constexpr bool SK = WSKIP && !F32;
#define SEAM_K0() do { VMWN(NQL); if constexpr (F32) { SWRITE_KF(0); SBAR(); SLOAD_F((const float*)nxt.V, kbn); } else { SWRITE_HK(0); } SBAR(); } while (0)
    f32x16 pA0, pA1, pB0, pB1; float mnA, mnB, alA, alB; bf16x8 pa0, pa1, pa2, pa3;
    if constexpr (F32) { VMW(); SWRITE_VF(0); SBAR(); } else { SWRITE_HV(0); SBAR(); }
    if (NT > 1) { if constexpr (F32) SLOAD_F((const float*)Kh, KBASE(1)); else SLOAD_H(Kh, Vh, KBASE(1)); }
    SBAR(); qkt<0, SK>(pA0, pA1, K_lds, r32, hi, S.qr, ACT(0), bias_l + KBASE(0));
    if constexpr (F32) { if (NT > 1) { VMW(); SWRITE_KF(1); SBAR(); SLOAD_F((const float*)Vh, KBASE(1)); } }
    MASKT(pA0, pA1, 0); partialSM(pA0, pA1, m_reg, mnA, alA);
    if (NT > 1) { VMW(); if constexpr (F32) { SWRITE_VF(1); SBAR(); if (NT > 2) SLOAD_F((const float*)Kh, KBASE(2)); } else SWRITE_H(1); }
    __syncthreads();
#define HALF_STEP(PX0, PX1, mnX, alX, PY0, PY1, alY, t, KB, VB, SB) do {                                                      \
        SBAR(); qkt<KB, SK>(PX0, PX1, K_lds, r32, hi, S.qr, ACT(t), bias_l + KBASE(t));                                             \
        finishSM(PY0, PY1, alY, l_reg, pa0, pa1, pa2, pa3); SBAR();                                                           \
        if ((t) + 1 < NT) { if constexpr (F32) { VMW(); SWRITE_KF(SB); SBAR(); SLOAD_F((const float*)Vh, KBASE((t) + 1)); }  \
                            else { SLOAD_H(Kh, Vh, KBASE((t) + 1)); } SBAR(); }                                               \
        pv_tile<VB, SK>(o, vb0, pa0, pa1, pa2, pa3, ACT((t) - 1)); MASKT(PX0, PX1, (t)); partialSM(PX0, PX1, m_reg, mnX, alX);                                        \
        __syncthreads();                                                                                                      \
        if ((t) + 1 < NT) { VMW(); if constexpr (F32) { SWRITE_VF(SB); SBAR(); if ((t) + 2 < NT) SLOAD_F((const float*)Kh, KBASE((t) + 2)); } \
                            else { SWRITE_H(SB); } }                                                                          \
        RESC(alX); __syncthreads(); } while (0)
    for (int t = 1; t + 1 < NT; t += 2) {
        HALF_STEP(pB0, pB1, mnB, alB, pA0, pA1, alA, t, 1, 0, 0);
        HALF_STEP(pA0, pA1, mnA, alA, pB0, pB1, alB, t + 1, 0, 1, 1);
    }
    const bool even = (NT & 1) == 0;
    if (even) { SBAR(); qkt<1, SK>(pB0, pB1, K_lds, r32, hi, S.qr, ACT(NT - 1), bias_l + KBASE(NT - 1)); SBAR(); }
#define QROW(e) (nxt.Q + (size_t)(wid * QBLK + r32) * LDQ + ((e) >> 1) * 16 + hi * 8 + ((e) & 1) * 4)
    if constexpr (F32) { SLOAD_F((const float*)nxt.K, kbn); SBAR();
#pragma unroll
        for (int e = 0; e < 8; ++e) S.tq[e] = *(const f32x4*)QROW(e); }
    else { SLOAD_H(nxt.K, nxt.V, kbn); SBAR();
#pragma unroll
        for (int d0 = 0; d0 < 8; ++d0) S.qr[d0] = load8<TIn>(nxt.Q + (size_t)(wid * QBLK + r32) * LDQ + d0 * 16 + hi * 8); }
    SBAR();
    finishSM(pA0, pA1, alA, l_reg, pa0, pa1, pa2, pa3); SBAR();
    if constexpr (F32) {
#pragma unroll
        for (int e = 8; e < 16; ++e) S.tq[e] = *(const f32x4*)QROW(e); SBAR(); }
#undef QROW
    pv_tile<0, SK>(o, vb0, pa0, pa1, pa2, pa3, ACT(even ? NT - 2 : NT - 1));
    if (even) { MASKT(pB0, pB1, NT - 1); partialSM(pB0, pB1, m_reg, mnB, alB); __syncthreads(); RESC(alB);
        finishSM(pB0, pB1, alB, l_reg, pa0, pa1, pa2, pa3); SBAR(); pv_tile<1, SK>(o, vb0, pa0, pa1, pa2, pa3, ACT(NT - 1)); }
    SBAR(); SEAM_K0();
    if (hi == 0) li_l[r32] = l_reg; asm volatile("s_waitcnt lgkmcnt(0)" ::: "memory");
    float rli[16];
#pragma unroll
    for (int r = 0; r < 16; ++r) rli[r] = __builtin_amdgcn_rcpf(li_l[crow(r, hi)]);
    TOut* Ow = cur.O + (size_t)(wid * QBLK) * LDO;
#pragma unroll
    for (int r = 0; r < 16; ++r) { const int orow = crow(r, hi);
#pragma unroll
        for (int d0 = 0; d0 < 4; ++d0) { const float v = o[d0][r] * rli[r];
            if constexpr (same_t<TOut, float>::v) { Ow[(size_t)orow * LDO + d0 * 32 + r32] = v; }
            else { const float vn = __shfl_xor(v, 1);
                   if ((r32 & 1) == 0) *(unsigned*)(Ow + (size_t)orow * LDO + d0 * 32 + r32) = cvtpk(v, vn); } } }
    if constexpr (F32) {
#pragma unroll
        for (int d0 = 0; d0 < 8; ++d0) S.qr[d0] = pack8(S.tq[2 * d0], S.tq[2 * d0 + 1]); }
    __syncthreads();
#undef RESC
#undef KBASE
#undef ACT
#undef MASKT
#undef SEAM_K0
#undef HALF_STEP
}
#undef ROW
#undef VMW
#undef VMWN
#undef SLOAD_H
#undef SWRITE_HK
#undef SWRITE_HV
#undef SWRITE_H
#undef SLOAD_F
#undef SWRITE_KF

}

__device__ __forceinline__ void fox_bias(PP P, int l, int b, int h, float* bias, float* scr) {
    using namespace cfg;
    const int tid = ltid(), lane = tid & 63, wave = tid >> 6;
    const float* PS = (const float*)(P->ws + WS_PS); const float bf = P->in[I_BF][l * FNH + h];
    float lf[9]; float loc = 0.f;
#pragma unroll
    for (int i = 0; i < 9; ++i) { const int pos = tid * 9 + i; float v = 0.f;
        if (pos < NMETA + SEQ) { const int row = pos < NMETA ? MMAIN + pos : b * SEQ + pos - NMETA; const float z = PS[(size_t)row * PSW + 288 + h] + bf;
            v = fminf(z, 0.f) - log1pf(__expf(-fabsf(z))); }
        loc += v; lf[i] = loc; }
    float inc = loc;
#pragma unroll
    for (int o = 1; o < 64; o <<= 1) { const float t = __shfl_up(inc, o); if (lane >= o) inc += t; }
    if (lane == 63) scr[wave] = inc;
    __syncthreads();
    float base = inc - loc;
    for (int w = 0; w < wave; ++w) base += scr[w];
    constexpr float INV = 1.0f / fox::SCALE;
#pragma unroll
    for (int i = 0; i < 9; ++i) { const int pos = tid * 9 + i; if (pos < NMETA + SEQ) bias[48 + pos] = -(base + lf[i]) * INV; }
    if (tid < 48) bias[tid] = -__builtin_inff();
    __syncthreads();
}
__device__ __forceinline__ void fox_meta(PP P, int h, const float* bias) {
    using namespace cfg;
    const int lane = ltid() & 63, wave = ltid() >> 6;
    const bf16_t* QKV = (const bf16_t*)(P->ws + WS_QKV); bf16_t* Y = (bf16_t*)(P->ws + WS_Y);
    for (int rep = 0; rep < 2; ++rep) { const int i = wave + 8 * rep;
        float s = -__builtin_inff();
        if (lane <= i) { const bf16_t* q = QKV + (size_t)(48 + i) * QKVW + h * 128; const bf16_t* k = QKV + (size_t)(48 + lane) * QKVW + 1024 + h * 128; float dot = 0.f;
            for (int d = 0; d < 128; ++d) dot += bf2f(q[d]) * bf2f(k[d]);
            s = (dot + bias[48 + lane]) * fox::SCALE; }
        const float m = wave_max(s); const float p = (lane <= i) ? __expf(s - m) : 0.f; const float lsum = wave_sum(p);
        float o0 = 0.f, o1 = 0.f;
        for (int j = 0; j <= i; ++j) { const float pj = __shfl(p, j); const bf16_t* v = QKV + (size_t)(48 + j) * QKVW + 2048 + h * 128; o0 += pj * bf2f(v[lane]); o1 += pj * bf2f(v[64 + lane]); }
        const float il = 1.0f / lsum;
        Y[(size_t)(MMAIN + i) * DM + 1024 + h * 128 + lane] = (bf16_t)(pk_bf16(o0 * il, 0.f) & 0xffffu);
        Y[(size_t)(MMAIN + i) * DM + 1024 + h * 128 + 64 + lane] = (bf16_t)(pk_bf16(o1 * il, 0.f) & 0xffffu); }
}
__device__ __forceinline__ fox::BlockRef<__hip_bfloat16, __hip_bfloat16> fox_mk(int a, int idx, const __hip_bfloat16* Qb, const __hip_bfloat16* Kb, const __hip_bfloat16* Vb, __hip_bfloat16* Ob) {
    const int pr = 4 * (a & 1) + (idx >> 1); const int x = (idx & 1) ? 15 - pr : pr;
    fox::BlockRef<__hip_bfloat16, __hip_bfloat16> r; r.Q = Qb + (size_t)x * 256 * cfg::QKVW; r.K = Kb; r.V = Vb; r.O = Ob + (size_t)x * 256 * cfg::DM; r.P0 = 64 + 256 * x; return r; }
__device__ __forceinline__ void fox_wg(PP P, int l, int a, char* lds) {
    using namespace cfg;
    typedef __hip_bfloat16 bf;
    const int bh = a >> 1, b = bh >> 3, h = bh & 7;
    float* bias = (float*)(lds + fox::BIAS_OFF); float* scr = (float*)(lds + fox::SCAN_OFF);
    fox_bias(P, l, b, h, bias, scr);
    const bf* QKV = (const bf*)(P->ws + WS_QKV); bf* Y = (bf*)(P->ws + WS_Y);
    const bf* Kb = QKV + (size_t)b * SEQP * QKVW + 1024 + h * 128; const bf* Vb = Kb + 1024; const bf* Qb = QKV + ((size_t)b * SEQP + 64) * QKVW + h * 128;
    bf* Ob = Y + (size_t)b * SEQ * DM + 1024 + h * 128;
    constexpr int W = 1 << 30;
    fox::Seam<bf> S;
    fox::BlockRef<bf, bf> cur = fox_mk(a, 0, Qb, Kb, Vb, Ob);
    fox::causal_swa_prime<bf, bf>(cur, W, lds, S);
#pragma unroll 1
    for (int idx = 0; idx < 8; ++idx) {
        const fox::BlockRef<bf, bf> nxt = (idx < 7) ? fox_mk(a, idx + 1, Qb, Kb, Vb, Ob) : cur;
        fox::causal_swa_block<bf, bf>(cur, nxt, SEQP, W, lds, S, bias);
        cur = nxt;
    }
    if (b == 0) fox_meta(P, h, bias);
}

#define WS_PTR(T, off) ((T*)(Q->ws + (off)))
#define SEAM() do { PP Qb_ = launder(P); XcdBarrier b_; b_.bar = (unsigned*)(Qb_->ws + WS_CTL); b_.x = xb_xcc_id(); b_.st = (volatile LAS unsigned*)(lds + LDS_BARW); xcd_barrier(b_); } while (0)
__global__ void __launch_bounds__(512, 2) hymba_fwd(Params Pv) {
    using namespace cfg;
    PP P = (PP)__builtin_amdgcn_kernarg_segment_ptr();
    extern __shared__ __attribute__((aligned(16))) unsigned char lds_raw[];
    LAS unsigned char* lds = (LAS unsigned char*)lds_raw;
    if (threadIdx.x < 4) ((LAS unsigned*)(lds + LDS_BARW))[threadIdx.x] = 0u;
    __syncthreads();
    { PP Q = launder(P); (void)xcd_barrier_post((unsigned*)(Q->ws + WS_CTL), (volatile LAS unsigned*)(lds + LDS_BARW)); }

    { PP Q = launder(P); phase_convert(Q, lds, 0, 1, lbid(), (int)gridDim.x); phase_init(Q); }
    SEAM();
    {
        PP Q = launder(P); const unsigned char* wl = Q->ws + WS_W + (size_t)0 * W_LAYER;
        pg8::Gemm g{WS_PTR(const bf16_t, WS_HB), (const bf16_t*)(wl + WO_GU1), MMAIN, NGU, DM}; pg8::StaticOrder S; S.init(MMAIN, NGU, (int)gridDim.x, lbid());
        pg8::EpiGU E{WS_PTR(bf16_t, WS_ACT), WS_PTR(const float, WS_SS) + (size_t)(0) * 8 * MROWS, (LAS float*)(lds + 131072 + 4096)};
        pg8::gemm_phase<pg8::EpiGU, pg8::StaticOrder, true, true>(lds, g, S, E);
        skinny_gu(WS_PTR(const bf16_t, WS_HB), g.Bt, WS_PTR(const float, WS_SSM) + (0) * 2048, WS_PTR(bf16_t, WS_ACT), lds);
    }
    SEAM();
    {
        PP Q = launder(P); const unsigned char* wl = Q->ws + WS_W + (size_t)0 * W_LAYER;
        pg8::Gemm g{WS_PTR(const bf16_t, WS_ACT), (const bf16_t*)(wl + WO_D1), MMAIN, DM, DFF}; pg8::StaticOrder S; S.init(MMAIN, DM, (int)gridDim.x, lbid());
        pg8::EpiRes E{WS_PTR(bf16_t, WS_HB), WS_PTR(float, WS_SS) + (size_t)(1) * 8 * MROWS, 0.5f, (LAS float*)(lds + 131072)};
        pg8::gemm_phase<pg8::EpiRes, pg8::StaticOrder, true, true>(lds, g, S, E);
        skinny_res(WS_PTR(const bf16_t, WS_ACT) + (size_t)MMAIN * DFF, DFF, g.Bt, WS_PTR(bf16_t, WS_HB), WS_PTR(float, WS_SSM) + (1) * 2048, 0.5f, lds);
    }
    SEAM();
    {
        PP Q = launder(P); const unsigned char* wl = Q->ws + WS_W + (size_t)0 * W_LAYER;
        pg8::Gemm g{WS_PTR(const bf16_t, WS_HB), (const bf16_t*)(wl + WO_IN), MMAIN, NIN, DM}; pg8::StaticOrder S; S.init(MMAIN, NIN, (int)gridDim.x, lbid());
        pg8::EpiP E{WS_PTR(bf16_t, WS_PR), WS_PTR(float, WS_PS), WS_PTR(bf16_t, WS_QKV), WS_PTR(const float, WS_SS) + (size_t)(1) * 8 * MROWS, (LAS float*)(lds + 131072 + 4096)};
        pg8::gemm_phase<pg8::EpiP, pg8::StaticOrder, true, true>(lds, g, S, E);
        skinny_p(WS_PTR(const bf16_t, WS_HB), g.Bt, WS_PTR(const float, WS_SSM) + (1) * 2048, WS_PTR(bf16_t, WS_PR), WS_PTR(float, WS_PS), WS_PTR(bf16_t, WS_QKV), lds);
    }
    SEAM();
    { PP Q = launder(P); phase_lx(Q, 0); }
    SEAM();
    {
        PP Q = launder(P); const int u = lbid();
        if (u < 128) { rwkv_chunked(Q, 0, u >> 4, u & 15, lds); __syncthreads(); phase_convert(launder(P), lds, 1, 2, u, 128, 17024, 21248); }
        else { fox_wg(Q, 0, u - 128, (char*)lds_raw); __syncthreads(); phase_convert(launder(P), lds, 1, 2, u - 128, 128, 0, 17024); }
    }
    SEAM();
    { PP Q = launder(P); phase_foxnorm(Q); }
    SEAM();
    {
        PP Q = launder(P); const unsigned char* wl = Q->ws + WS_W + (size_t)0 * W_LAYER;
        pg8::Gemm g{WS_PTR(const bf16_t, WS_Y), (const bf16_t*)(wl + WO_OUT), MMAIN, DM, DM}; pg8::StaticOrder S; S.init(MMAIN, DM, (int)gridDim.x, lbid());
        pg8::EpiRes E{WS_PTR(bf16_t, WS_HB), WS_PTR(float, WS_SS) + (size_t)(2) * 8 * MROWS, 1.0f, (LAS float*)(lds + 131072)};
        pg8::gemm_phase<pg8::EpiRes, pg8::StaticOrder, true, true>(lds, g, S, E);
        skinny_res(WS_PTR(const bf16_t, WS_Y) + (size_t)MMAIN * DM, DM, g.Bt, WS_PTR(bf16_t, WS_HB), WS_PTR(float, WS_SSM) + (2) * 2048, 1.0f, lds);
    }
    SEAM();
    {
        PP Q = launder(P); const unsigned char* wl = Q->ws + WS_W + (size_t)0 * W_LAYER;
        pg8::Gemm g{WS_PTR(const bf16_t, WS_HB), (const bf16_t*)(wl + WO_GU2), MMAIN, NGU, DM}; pg8::StaticOrder S; S.init(MMAIN, NGU, (int)gridDim.x, lbid());
        pg8::EpiGU E{WS_PTR(bf16_t, WS_ACT), WS_PTR(const float, WS_SS) + (size_t)(2) * 8 * MROWS, (LAS float*)(lds + 131072 + 4096)};
        pg8::gemm_phase<pg8::EpiGU, pg8::StaticOrder, true, true>(lds, g, S, E);
        skinny_gu(WS_PTR(const bf16_t, WS_HB), g.Bt, WS_PTR(const float, WS_SSM) + (2) * 2048, WS_PTR(bf16_t, WS_ACT), lds);
    }
    SEAM();
    {
        PP Q = launder(P); const unsigned char* wl = Q->ws + WS_W + (size_t)0 * W_LAYER;
        pg8::Gemm g{WS_PTR(const bf16_t, WS_ACT), (const bf16_t*)(wl + WO_D2), MMAIN, DM, DFF}; pg8::StaticOrder S; S.init(MMAIN, DM, (int)gridDim.x, lbid());
        pg8::EpiRes E{WS_PTR(bf16_t, WS_HB), WS_PTR(float, WS_SS) + (size_t)(3) * 8 * MROWS, 0.5f, (LAS float*)(lds + 131072)};
        pg8::gemm_phase<pg8::EpiRes, pg8::StaticOrder, true, true>(lds, g, S, E);
        skinny_res(WS_PTR(const bf16_t, WS_ACT) + (size_t)MMAIN * DFF, DFF, g.Bt, WS_PTR(bf16_t, WS_HB), WS_PTR(float, WS_SSM) + (3) * 2048, 0.5f, lds);
    }
    SEAM();
    {
        PP Q = launder(P); const unsigned char* wl = Q->ws + WS_W + (size_t)1 * W_LAYER;
        pg8::Gemm g{WS_PTR(const bf16_t, WS_HB), (const bf16_t*)(wl + WO_GU1), MMAIN, NGU, DM}; pg8::StaticOrder S; S.init(MMAIN, NGU, (int)gridDim.x, lbid());
        pg8::EpiGU E{WS_PTR(bf16_t, WS_ACT), WS_PTR(const float, WS_SS) + (size_t)(3) * 8 * MROWS, (LAS float*)(lds + 131072 + 4096)};
        pg8::gemm_phase<pg8::EpiGU, pg8::StaticOrder, true, true>(lds, g, S, E);
        skinny_gu(WS_PTR(const bf16_t, WS_HB), g.Bt, WS_PTR(const float, WS_SSM) + (3) * 2048, WS_PTR(bf16_t, WS_ACT), lds);
    }
    SEAM();
    {
        PP Q = launder(P); const unsigned char* wl = Q->ws + WS_W + (size_t)1 * W_LAYER;
        pg8::Gemm g{WS_PTR(const bf16_t, WS_ACT), (const bf16_t*)(wl + WO_D1), MMAIN, DM, DFF}; pg8::StaticOrder S; S.init(MMAIN, DM, (int)gridDim.x, lbid());
        pg8::EpiRes E{WS_PTR(bf16_t, WS_HB), WS_PTR(float, WS_SS) + (size_t)(4) * 8 * MROWS, 0.5f, (LAS float*)(lds + 131072)};
        pg8::gemm_phase<pg8::EpiRes, pg8::StaticOrder, true, true>(lds, g, S, E);
        skinny_res(WS_PTR(const bf16_t, WS_ACT) + (size_t)MMAIN * DFF, DFF, g.Bt, WS_PTR(bf16_t, WS_HB), WS_PTR(float, WS_SSM) + (4) * 2048, 0.5f, lds);
    }
    SEAM();
    {
        PP Q = launder(P); const unsigned char* wl = Q->ws + WS_W + (size_t)1 * W_LAYER;
        pg8::Gemm g{WS_PTR(const bf16_t, WS_HB), (const bf16_t*)(wl + WO_IN), MMAIN, NIN, DM}; pg8::StaticOrder S; S.init(MMAIN, NIN, (int)gridDim.x, lbid());
        pg8::EpiP E{WS_PTR(bf16_t, WS_PR), WS_PTR(float, WS_PS), WS_PTR(bf16_t, WS_QKV), WS_PTR(const float, WS_SS) + (size_t)(4) * 8 * MROWS, (LAS float*)(lds + 131072 + 4096)};
        pg8::gemm_phase<pg8::EpiP, pg8::StaticOrder, true, true>(lds, g, S, E);
        skinny_p(WS_PTR(const bf16_t, WS_HB), g.Bt, WS_PTR(const float, WS_SSM) + (4) * 2048, WS_PTR(bf16_t, WS_PR), WS_PTR(float, WS_PS), WS_PTR(bf16_t, WS_QKV), lds);
    }
    SEAM();
    { PP Q = launder(P); phase_lx(Q, 1); }
    SEAM();
    {
        PP Q = launder(P); const int u = lbid();
        if (u < 128) { rwkv_chunked(Q, 1, u >> 4, u & 15, lds); __syncthreads(); phase_convert(launder(P), lds, 2, 3, u, 128, 17024, 21248); }
        else { fox_wg(Q, 1, u - 128, (char*)lds_raw); __syncthreads(); phase_convert(launder(P), lds, 2, 3, u - 128, 128, 0, 17024); }
    }
    SEAM();
    { PP Q = launder(P); phase_foxnorm(Q); }
    SEAM();
    {
        PP Q = launder(P); const unsigned char* wl = Q->ws + WS_W + (size_t)1 * W_LAYER;
        pg8::Gemm g{WS_PTR(const bf16_t, WS_Y), (const bf16_t*)(wl + WO_OUT), MMAIN, DM, DM}; pg8::StaticOrder S; S.init(MMAIN, DM, (int)gridDim.x, lbid());
        pg8::EpiRes E{WS_PTR(bf16_t, WS_HB), WS_PTR(float, WS_SS) + (size_t)(5) * 8 * MROWS, 1.0f, (LAS float*)(lds + 131072)};
        pg8::gemm_phase<pg8::EpiRes, pg8::StaticOrder, true, true>(lds, g, S, E);
        skinny_res(WS_PTR(const bf16_t, WS_Y) + (size_t)MMAIN * DM, DM, g.Bt, WS_PTR(bf16_t, WS_HB), WS_PTR(float, WS_SSM) + (5) * 2048, 1.0f, lds);
    }
    SEAM();
    {
        PP Q = launder(P); const unsigned char* wl = Q->ws + WS_W + (size_t)1 * W_LAYER;
        pg8::Gemm g{WS_PTR(const bf16_t, WS_HB), (const bf16_t*)(wl + WO_GU2), MMAIN, NGU, DM}; pg8::StaticOrder S; S.init(MMAIN, NGU, (int)gridDim.x, lbid());
        pg8::EpiGU E{WS_PTR(bf16_t, WS_ACT), WS_PTR(const float, WS_SS) + (size_t)(5) * 8 * MROWS, (LAS float*)(lds + 131072 + 4096)};
        pg8::gemm_phase<pg8::EpiGU, pg8::StaticOrder, true, true>(lds, g, S, E);
        skinny_gu(WS_PTR(const bf16_t, WS_HB), g.Bt, WS_PTR(const float, WS_SSM) + (5) * 2048, WS_PTR(bf16_t, WS_ACT), lds);
    }
    SEAM();
    {
        PP Q = launder(P); const unsigned char* wl = Q->ws + WS_W + (size_t)1 * W_LAYER;
        pg8::Gemm g{WS_PTR(const bf16_t, WS_ACT), (const bf16_t*)(wl + WO_D2), MMAIN, DM, DFF}; pg8::StaticOrder S; S.init(MMAIN, DM, (int)gridDim.x, lbid());
        pg8::EpiRes E{WS_PTR(bf16_t, WS_HB), WS_PTR(float, WS_SS) + (size_t)(6) * 8 * MROWS, 0.5f, (LAS float*)(lds + 131072)};
        pg8::gemm_phase<pg8::EpiRes, pg8::StaticOrder, true, true>(lds, g, S, E);
        skinny_res(WS_PTR(const bf16_t, WS_ACT) + (size_t)MMAIN * DFF, DFF, g.Bt, WS_PTR(bf16_t, WS_HB), WS_PTR(float, WS_SSM) + (6) * 2048, 0.5f, lds);
    }
    SEAM();
    {
        PP Q = launder(P); const unsigned char* wl = Q->ws + WS_W + (size_t)2 * W_LAYER;
        pg8::Gemm g{WS_PTR(const bf16_t, WS_HB), (const bf16_t*)(wl + WO_GU1), MMAIN, NGU, DM}; pg8::StaticOrder S; S.init(MMAIN, NGU, (int)gridDim.x, lbid());
        pg8::EpiGU E{WS_PTR(bf16_t, WS_ACT), WS_PTR(const float, WS_SS) + (size_t)(6) * 8 * MROWS, (LAS float*)(lds + 131072 + 4096)};
        pg8::gemm_phase<pg8::EpiGU, pg8::StaticOrder, true, true>(lds, g, S, E);
        skinny_gu(WS_PTR(const bf16_t, WS_HB), g.Bt, WS_PTR(const float, WS_SSM) + (6) * 2048, WS_PTR(bf16_t, WS_ACT), lds);
    }
    SEAM();
    {
        PP Q = launder(P); const unsigned char* wl = Q->ws + WS_W + (size_t)2 * W_LAYER;
        pg8::Gemm g{WS_PTR(const bf16_t, WS_ACT), (const bf16_t*)(wl + WO_D1), MMAIN, DM, DFF}; pg8::StaticOrder S; S.init(MMAIN, DM, (int)gridDim.x, lbid());
        pg8::EpiRes E{WS_PTR(bf16_t, WS_HB), WS_PTR(float, WS_SS) + (size_t)(7) * 8 * MROWS, 0.5f, (LAS float*)(lds + 131072)};
        pg8::gemm_phase<pg8::EpiRes, pg8::StaticOrder, true, true>(lds, g, S, E);
        skinny_res(WS_PTR(const bf16_t, WS_ACT) + (size_t)MMAIN * DFF, DFF, g.Bt, WS_PTR(bf16_t, WS_HB), WS_PTR(float, WS_SSM) + (7) * 2048, 0.5f, lds);
    }
    SEAM();
    {
        PP Q = launder(P); const unsigned char* wl = Q->ws + WS_W + (size_t)2 * W_LAYER;
        pg8::Gemm g{WS_PTR(const bf16_t, WS_HB), (const bf16_t*)(wl + WO_IN), MMAIN, NIN, DM}; pg8::StaticOrder S; S.init(MMAIN, NIN, (int)gridDim.x, lbid());
        pg8::EpiP E{WS_PTR(bf16_t, WS_PR), WS_PTR(float, WS_PS), WS_PTR(bf16_t, WS_QKV), WS_PTR(const float, WS_SS) + (size_t)(7) * 8 * MROWS, (LAS float*)(lds + 131072 + 4096)};
        pg8::gemm_phase<pg8::EpiP, pg8::StaticOrder, true, true>(lds, g, S, E);
        skinny_p(WS_PTR(const bf16_t, WS_HB), g.Bt, WS_PTR(const float, WS_SSM) + (7) * 2048, WS_PTR(bf16_t, WS_PR), WS_PTR(float, WS_PS), WS_PTR(bf16_t, WS_QKV), lds);
    }
    SEAM();
    { PP Q = launder(P); phase_lx(Q, 2); }
    SEAM();
    {
        PP Q = launder(P); const int u = lbid();
        if (u < 128) { rwkv_chunked(Q, 2, u >> 4, u & 15, lds); __syncthreads(); phase_convert(launder(P), lds, 3, 4, u, 128, 17024, 21248); }
        else { fox_wg(Q, 2, u - 128, (char*)lds_raw); __syncthreads(); phase_convert(launder(P), lds, 3, 4, u - 128, 128, 0, 17024); }
    }
    SEAM();
    { PP Q = launder(P); phase_foxnorm(Q); }
    SEAM();
    {
        PP Q = launder(P); const unsigned char* wl = Q->ws + WS_W + (size_t)2 * W_LAYER;
        pg8::Gemm g{WS_PTR(const bf16_t, WS_Y), (const bf16_t*)(wl + WO_OUT), MMAIN, DM, DM}; pg8::StaticOrder S; S.init(MMAIN, DM, (int)gridDim.x, lbid());
        pg8::EpiRes E{WS_PTR(bf16_t, WS_HB), WS_PTR(float, WS_SS) + (size_t)(8) * 8 * MROWS, 1.0f, (LAS float*)(lds + 131072)};
        pg8::gemm_phase<pg8::EpiRes, pg8::StaticOrder, true, true>(lds, g, S, E);
        skinny_res(WS_PTR(const bf16_t, WS_Y) + (size_t)MMAIN * DM, DM, g.Bt, WS_PTR(bf16_t, WS_HB), WS_PTR(float, WS_SSM) + (8) * 2048, 1.0f, lds);
    }
    SEAM();
    {
        PP Q = launder(P); const unsigned char* wl = Q->ws + WS_W + (size_t)2 * W_LAYER;
        pg8::Gemm g{WS_PTR(const bf16_t, WS_HB), (const bf16_t*)(wl + WO_GU2), MMAIN, NGU, DM}; pg8::StaticOrder S; S.init(MMAIN, NGU, (int)gridDim.x, lbid());
        pg8::EpiGU E{WS_PTR(bf16_t, WS_ACT), WS_PTR(const float, WS_SS) + (size_t)(8) * 8 * MROWS, (LAS float*)(lds + 131072 + 4096)};
        pg8::gemm_phase<pg8::EpiGU, pg8::StaticOrder, true, true>(lds, g, S, E);
        skinny_gu(WS_PTR(const bf16_t, WS_HB), g.Bt, WS_PTR(const float, WS_SSM) + (8) * 2048, WS_PTR(bf16_t, WS_ACT), lds);
    }
    SEAM();
    {
        PP Q = launder(P); const unsigned char* wl = Q->ws + WS_W + (size_t)2 * W_LAYER;
        pg8::Gemm g{WS_PTR(const bf16_t, WS_ACT), (const bf16_t*)(wl + WO_D2), MMAIN, DM, DFF}; pg8::StaticOrder S; S.init(MMAIN, DM, (int)gridDim.x, lbid());
        pg8::EpiRes E{WS_PTR(bf16_t, WS_HB), WS_PTR(float, WS_SS) + (size_t)(9) * 8 * MROWS, 0.5f, (LAS float*)(lds + 131072)};
        pg8::gemm_phase<pg8::EpiRes, pg8::StaticOrder, true, true>(lds, g, S, E);
        skinny_res(WS_PTR(const bf16_t, WS_ACT) + (size_t)MMAIN * DFF, DFF, g.Bt, WS_PTR(bf16_t, WS_HB), WS_PTR(float, WS_SSM) + (9) * 2048, 0.5f, lds);
    }
    SEAM();
    {
        PP Q = launder(P); const unsigned char* wl = Q->ws + WS_W + (size_t)3 * W_LAYER;
        pg8::Gemm g{WS_PTR(const bf16_t, WS_HB), (const bf16_t*)(wl + WO_GU1), MMAIN, NGU, DM}; pg8::StaticOrder S; S.init(MMAIN, NGU, (int)gridDim.x, lbid());
        pg8::EpiGU E{WS_PTR(bf16_t, WS_ACT), WS_PTR(const float, WS_SS) + (size_t)(9) * 8 * MROWS, (LAS float*)(lds + 131072 + 4096)};
        pg8::gemm_phase<pg8::EpiGU, pg8::StaticOrder, true, true>(lds, g, S, E);
        skinny_gu(WS_PTR(const bf16_t, WS_HB), g.Bt, WS_PTR(const float, WS_SSM) + (9) * 2048, WS_PTR(bf16_t, WS_ACT), lds);
    }
    SEAM();
    {
        PP Q = launder(P); const unsigned char* wl = Q->ws + WS_W + (size_t)3 * W_LAYER;
        pg8::Gemm g{WS_PTR(const bf16_t, WS_ACT), (const bf16_t*)(wl + WO_D1), MMAIN, DM, DFF}; pg8::StaticOrder S; S.init(MMAIN, DM, (int)gridDim.x, lbid());
        pg8::EpiRes E{WS_PTR(bf16_t, WS_HB), WS_PTR(float, WS_SS) + (size_t)(10) * 8 * MROWS, 0.5f, (LAS float*)(lds + 131072)};
        pg8::gemm_phase<pg8::EpiRes, pg8::StaticOrder, true, true>(lds, g, S, E);
        skinny_res(WS_PTR(const bf16_t, WS_ACT) + (size_t)MMAIN * DFF, DFF, g.Bt, WS_PTR(bf16_t, WS_HB), WS_PTR(float, WS_SSM) + (10) * 2048, 0.5f, lds);
    }
    SEAM();
    {
        PP Q = launder(P); const unsigned char* wl = Q->ws + WS_W + (size_t)3 * W_LAYER;
        pg8::Gemm g{WS_PTR(const bf16_t, WS_HB), (const bf16_t*)(wl + WO_IN), MMAIN, NIN, DM}; pg8::StaticOrder S; S.init(MMAIN, NIN, (int)gridDim.x, lbid());
        pg8::EpiP E{WS_PTR(bf16_t, WS_PR), WS_PTR(float, WS_PS), WS_PTR(bf16_t, WS_QKV), WS_PTR(const float, WS_SS) + (size_t)(10) * 8 * MROWS, (LAS float*)(lds + 131072 + 4096)};
        pg8::gemm_phase<pg8::EpiP, pg8::StaticOrder, true, true>(lds, g, S, E);
        skinny_p(WS_PTR(const bf16_t, WS_HB), g.Bt, WS_PTR(const float, WS_SSM) + (10) * 2048, WS_PTR(bf16_t, WS_PR), WS_PTR(float, WS_PS), WS_PTR(bf16_t, WS_QKV), lds);
    }
    SEAM();
    { PP Q = launder(P); phase_lx(Q, 3); }
    SEAM();
    {
        PP Q = launder(P); const int u = lbid();
        if (u < 128) { rwkv_chunked(Q, 3, u >> 4, u & 15, lds); }
        else { fox_wg(Q, 3, u - 128, (char*)lds_raw);  }
    }
    SEAM();
    { PP Q = launder(P); phase_foxnorm(Q); }
    SEAM();
    {
        PP Q = launder(P); const unsigned char* wl = Q->ws + WS_W + (size_t)3 * W_LAYER;
        pg8::Gemm g{WS_PTR(const bf16_t, WS_Y), (const bf16_t*)(wl + WO_OUT), MMAIN, DM, DM}; pg8::StaticOrder S; S.init(MMAIN, DM, (int)gridDim.x, lbid());
        pg8::EpiRes E{WS_PTR(bf16_t, WS_HB), WS_PTR(float, WS_SS) + (size_t)(11) * 8 * MROWS, 1.0f, (LAS float*)(lds + 131072)};
        pg8::gemm_phase<pg8::EpiRes, pg8::StaticOrder, true, true>(lds, g, S, E);
        skinny_res(WS_PTR(const bf16_t, WS_Y) + (size_t)MMAIN * DM, DM, g.Bt, WS_PTR(bf16_t, WS_HB), WS_PTR(float, WS_SSM) + (11) * 2048, 1.0f, lds);
    }
    SEAM();
    {
        PP Q = launder(P); const unsigned char* wl = Q->ws + WS_W + (size_t)3 * W_LAYER;
        pg8::Gemm g{WS_PTR(const bf16_t, WS_HB), (const bf16_t*)(wl + WO_GU2), MMAIN, NGU, DM}; pg8::StaticOrder S; S.init(MMAIN, NGU, (int)gridDim.x, lbid());
        pg8::EpiGU E{WS_PTR(bf16_t, WS_ACT), WS_PTR(const float, WS_SS) + (size_t)(11) * 8 * MROWS, (LAS float*)(lds + 131072 + 4096)};
        pg8::gemm_phase<pg8::EpiGU, pg8::StaticOrder, true, true>(lds, g, S, E);
        skinny_gu(WS_PTR(const bf16_t, WS_HB), g.Bt, WS_PTR(const float, WS_SSM) + (11) * 2048, WS_PTR(bf16_t, WS_ACT), lds);
    }
    SEAM();
    {
        PP Q = launder(P); const unsigned char* wl = Q->ws + WS_W + (size_t)3 * W_LAYER;
        pg8::Gemm g{WS_PTR(const bf16_t, WS_ACT), (const bf16_t*)(wl + WO_D2), MMAIN, DM, DFF}; pg8::StaticOrder S; S.init(MMAIN, DM, (int)gridDim.x, lbid());
        pg8::EpiRes E{WS_PTR(bf16_t, WS_HB), WS_PTR(float, WS_SS) + (size_t)(12) * 8 * MROWS, 0.5f, (LAS float*)(lds + 131072)};
        pg8::gemm_phase<pg8::EpiRes, pg8::StaticOrder, true, true>(lds, g, S, E);
        skinny_res(WS_PTR(const bf16_t, WS_ACT) + (size_t)MMAIN * DFF, DFF, g.Bt, WS_PTR(bf16_t, WS_HB), WS_PTR(float, WS_SSM) + (12) * 2048, 0.5f, lds);
    }
    SEAM();
    { PP Q = launder(P); phase_final(Q); }
}

extern "C" void kernel_launch(void* const* d_in, const int* in_sizes, int n_in, void* d_out, int out_size, void* d_ws, size_t ws_size, hipStream_t stream) {
    using namespace cfg;
    static int grid = 0;
    if (grid == 0) {
        if (n_in != 25 || out_size != MMAIN * DM || ws_size < WS_END) { fprintf(stderr, "kernel_launch: need 25 inputs, out %d, ws >= %zu; got n_in %d out %d ws %zu\n", MMAIN * DM, (size_t)WS_END, n_in, out_size, ws_size); grid = -1; return; }
        int dev = 0, cus = 0, per_cu = 0;
        if (hipGetDevice(&dev) != hipSuccess || hipDeviceGetAttribute(&cus, hipDeviceAttributeMultiprocessorCount, dev) != hipSuccess) { grid = -1; return; }
        if (hipFuncSetAttribute((const void*)hymba_fwd, hipFuncAttributeMaxDynamicSharedMemorySize, LDS_BYTES) != hipSuccess) { fprintf(stderr, "kernel_launch: hipFuncSetAttribute failed\n"); grid = -1; return; }
        if (hipOccupancyMaxActiveBlocksPerMultiprocessor(&per_cu, (const void*)hymba_fwd, 512, LDS_BYTES) != hipSuccess || per_cu < 1) fprintf(stderr, "kernel_launch: occupancy query says %d\n", per_cu);
        (void)hipGetLastError();
        if (cus < 256) { fprintf(stderr, "kernel_launch: built for a 256-CU device (one resident workgroup per CU), found %d CUs\n", cus); grid = -1; return; }
        grid = 256;
    }
    if (grid < 0) return;
    if (hipMemsetAsync((char*)d_ws + WS_CTL, 0, CTL_BYTES, stream) != hipSuccess) return;
    Params p{};
    for (int i = 0; i < 25; ++i) p.in[i] = (const float*)d_in[i];
    p.out = (float*)d_out; p.ws = (unsigned char*)d_ws; p.ph_lo = 0; p.ph_hi = 0;
    hipLaunchKernelGGL(hymba_fwd, dim3(grid), dim3(512), LDS_BYTES, stream, p);
}
```

```cpp
#include <hip/hip_runtime.h>
#include <hip/hip_bf16.h>
#include <cstdio>
#include <cstdint>

#define LAS __attribute__((address_space(3)))
namespace cfg {
constexpr int DM = 2048, NBATCH = 8, SEQ = 4096, NMETA = 16, DEPTH = 4;
constexpr int MMAIN = NBATCH * SEQ;
constexpr int MROWS = MMAIN + 256;
constexpr int DFF = 5632, NGU = 2 * DFF;
constexpr int RW = 1024, RH = 64, RNH = 16;
constexpr int FW = 1024, FH = 128, FNH = 8;
constexpr int RWKV_COLS = 3360, DIN = 6440;
constexpr int NIN = 6656;
constexpr int PRW = 3072, PSW = 512, QKVW = 3072;
constexpr int SEQP = 4160;
constexpr float NORM_EPS = 1e-6f, LNX_EPS = 64e-5f;
constexpr int NSS = 13;
constexpr size_t al256(size_t x) { return (x + 255) & ~(size_t)255; }
constexpr size_t WS_CTL = 0;
constexpr size_t CTL_BYTES = 65536;
constexpr size_t WS_SS = WS_CTL + CTL_BYTES;
constexpr size_t SS_BYTES = al256((size_t)NSS * 8 * MROWS * 4);
constexpr size_t ZERO_BYTES = CTL_BYTES + SS_BYTES;
constexpr size_t WS_SSM = WS_SS + SS_BYTES;
constexpr size_t SSM_BYTES = (size_t)NSS * 2048 * 4;
constexpr size_t WS_HMETA = WS_SSM + SSM_BYTES;
constexpr size_t WS_HB = WS_HMETA + (size_t)256 * DM * 4;
constexpr size_t WS_Y = WS_HB + (size_t)MROWS * DM * 2;
constexpr size_t WS_OVL = WS_Y + (size_t)MROWS * DM * 2;
constexpr size_t WS_ACT = WS_OVL;
constexpr size_t WS_PR = WS_OVL;
constexpr size_t WS_PS = WS_PR + (size_t)MROWS * PRW * 2;
constexpr size_t WS_QKV = WS_PS + (size_t)MROWS * PSW * 4;
constexpr size_t OVL_A = (size_t)MROWS * DFF * 2, OVL_B = (size_t)MROWS * PRW * 2 + (size_t)MROWS * PSW * 4 + (size_t)NBATCH * SEQP * QKVW * 2;
constexpr size_t WS_W = WS_OVL + al256(OVL_A > OVL_B ? OVL_A : OVL_B);
constexpr size_t W_GU = (size_t)NGU * DM * 2, W_D = (size_t)DM * DFF * 2, W_IN = (size_t)NIN * DM * 2, W_OUT = (size_t)DM * DM * 2;
constexpr size_t WO_GU1 = 0, WO_D1 = WO_GU1 + W_GU, WO_IN = WO_D1 + W_D, WO_OUT = WO_IN + W_IN, WO_GU2 = WO_OUT + W_OUT, WO_D2 = WO_GU2 + W_GU, W_LAYER = WO_D2 + W_D;
constexpr size_t WS_LXG = WS_W + (size_t)DEPTH * W_LAYER;
constexpr size_t WS_END = WS_LXG + (size_t)MROWS * 320 * 2;
constexpr int LDS_BYTES = 147456;
constexpr int LDS_BARW = LDS_BYTES - 16;
}
__device__ __forceinline__ int ltid() { int t = (int)threadIdx.x; asm volatile("" : "+v"(t)); return t; }
__device__ __forceinline__ int lbid() { int t = (int)blockIdx.x; asm volatile("" : "+s"(t)); return t; }
__device__ __forceinline__ int lzero() { int t = 0; asm volatile("" : "+v"(t)); return t; }
namespace pg8 {
#define PG8_LAS __attribute__((address_space(3)))
typedef unsigned short bf16_t;
typedef short bf16x8 __attribute__((ext_vector_type(8)));
typedef float f32x4 __attribute__((ext_vector_type(4)));
typedef unsigned u32x4 __attribute__((ext_vector_type(4)));
constexpr int BM = 256, BK = 64, HALF = 128, HTB = HALF * BK * 2  , STAGE_BYTES = 8 * HTB, NXCD = 8, WGM = 8;

__host__ __device__ __forceinline__ int lds_byte(int r, int c) { const int st = (r >> 4) * 2 + (c >> 5), rr = r & 15, cc = c & 31, ob = rr * 64 + cc * 2; return st * 1024 + (ob ^ (((ob >> 9) & 1) << 5)); }
__host__ __device__ __forceinline__ void stage_rc(int b, int& R, int& C) { const int st = b / 1024, sb = b % 1024, swz = sb ^ (((sb >> 9) & 1) << 5); R = (st >> 1) * 16 + swz / 64; C = (st & 1) * 32 + (swz % 64) / 2; }
__host__ __device__ __forceinline__ int perm32(int rho) { const int n = rho >> 4, i = rho & 15; return 8 * (i >> 2) + 4 * n + (i & 3); }

struct Unit { int pm, pn; };
struct Gemm { const bf16_t* A; const bf16_t* Bt; int M, N, K; };

struct StaticOrder {
    int nM, nN, nwg, G, c;
    __host__ __device__ void init(int M, int N, int G_, int c_) { nM = M / BM; nN = N / BM; nwg = nM * nN; G = G_; c = c_; }
    __host__ __device__ bool next(int i, Unit& u) const {
        const long L = (long)i * G + c; if (L >= nwg) return false;
        int wgid = (int)L; { const int q = nwg / NXCD, r = nwg % NXCD, xcd = wgid % NXCD, off = wgid / NXCD; wgid = (xcd < r ? xcd * (q + 1) : r * (q + 1) + (xcd - r) * q) + off; }
        const int nig = WGM * nN, gid = wgid / nig, fm = gid * WGM, gsz = (nM - fm) < WGM ? (nM - fm) : WGM;
        u.pm = fm + ((wgid % nig) % gsz); u.pn = (wgid % nig) / gsz; return true;
    }
    __device__ __forceinline__ void a_ready(const Unit&) const {}
    __device__ __forceinline__ void done(const Unit&) const {}
};

__device__ __forceinline__ unsigned cvt_pk_bf16(float lo, float hi) { unsigned r; asm volatile("v_cvt_pk_bf16_f32 %0, %1, %2" : "=v"(r) : "v"(lo), "v"(hi)); return r; }
typedef float f32x2 __attribute__((ext_vector_type(2)));
__device__ __forceinline__ f32x2 gelu_pk(f32x2 v) {
    const f32x2 av = __builtin_elementwise_abs(v), d = av * 0.2316418882f + 1.0f;
    f32x2 t; t.x = __builtin_amdgcn_rcpf(d.x); t.y = __builtin_amdgcn_rcpf(d.y);
    f32x2 q = t * 0.5307027145f + (-0.7265760135f); q = q * t + 0.7107068705f; q = q * t + (-0.142248368f); q = q * t + 0.127414796f; q = q * t;
    const f32x2 s = (v * v) * (-0.72134752044f);
    f32x2 e; e.x = __builtin_amdgcn_exp2f(s.x); e.y = __builtin_amdgcn_exp2f(s.y);
    const f32x2 m = v * (q * e), r = v - m;
    f32x2 o; o.x = v.x < 0.f ? m.x : r.x; o.y = v.y < 0.f ? m.y : r.y; return o;
}
__device__ __forceinline__ float rs_of(const float* ss, int row) { float s = 0.f;
#pragma unroll
    for (int t = 0; t < 8; ++t) s += ss[(size_t)t * 33024 + row];
    return __builtin_amdgcn_rsqf(s * (1.0f / 2048.0f) + 1e-6f); }
__device__ __forceinline__ float silu_f(float x) { return x * __builtin_amdgcn_rcpf(1.0f + __builtin_amdgcn_exp2f(-1.4426950408889634f * x)); }

struct EpiGU {
    static constexpr bool PERM = true, AFTER_DRAIN = false;
    bf16_t* act; const float* ss; PG8_LAS float* rsb;
    __device__ __forceinline__ void operator()(const f32x4 (&acc)[2][2][4][2], const Unit& u, int wr, int wc, int fr, int fq, bool newpanel) const {
        if (newpanel) {
            if (wr == 0) { const int rl = wc * 64 + fq * 16 + fr; rsb[rl] = rs_of(ss, u.pm * BM + rl); }
            asm volatile("s_waitcnt lgkmcnt(0)" ::: "memory"); __builtin_amdgcn_s_barrier(); asm volatile("" ::: "memory"); }
        const int rl0 = wr * 64 + fr, row0 = u.pm * BM + rl0, col0 = u.pn * 128 + wc * 32 + 8 * fq;
#pragma unroll
        for (int ai = 0; ai < 2; ++ai)
#pragma unroll
            for (int m = 0; m < 4; ++m) { const int row = row0 + ai * HALF + m * 16; const float rs = rsb[rl0 + ai * HALF + m * 16];
                const f32x4 g0 = acc[ai][0][m][0] * rs, g1 = acc[ai][0][m][1] * rs, u0 = acc[ai][1][m][0] * rs, u1 = acc[ai][1][m][1] * rs;
                u32x4 w;
                w.x = cvt_pk_bf16(silu_f(g0[0]) * u0[0], silu_f(g0[1]) * u0[1]); w.y = cvt_pk_bf16(silu_f(g0[2]) * u0[2], silu_f(g0[3]) * u0[3]);
                w.z = cvt_pk_bf16(silu_f(g1[0]) * u1[0], silu_f(g1[1]) * u1[1]); w.w = cvt_pk_bf16(silu_f(g1[2]) * u1[2], silu_f(g1[3]) * u1[3]);
                *(u32x4*)(act + (size_t)row * 5632 + col0) = w; }
    }
};
struct EpiRes {
    static constexpr bool PERM = true, AFTER_DRAIN = false;
    bf16_t* hb; float* ssn; float alpha; PG8_LAS float* red;
    __device__ __forceinline__ void operator()(const f32x4 (&acc)[2][2][4][2], const Unit& u, int wr, int wc, int fr, int fq, bool) const {
        bf16_t* bbase = hb + (size_t)u.pm * BM * 2048;
        const int rl0 = wr * 64 + fr; unsigned off = (unsigned)(rl0 * 2048 + u.pn * BM + wc * 32 + 8 * fq);
#pragma unroll
        for (int ai = 0; ai < 2; ++ai) {
            u32x4 hv[4][2];
#pragma unroll
            for (int m = 0; m < 4; ++m)
#pragma unroll
                for (int bj = 0; bj < 2; ++bj) hv[m][bj] = *(const u32x4*)(bbase + (off + (unsigned)((ai * HALF + m * 16) * 2048) + bj * HALF));
#pragma unroll
            for (int m = 0; m < 4; ++m) { const unsigned o = off + (unsigned)((ai * HALF + m * 16) * 2048); float sq = 0.f;
#pragma unroll
                for (int bj = 0; bj < 2; ++bj) { const u32x4 x = hv[m][bj];
                    const f32x4 h0 = (f32x4){__uint_as_float(x.x << 16), __uint_as_float(x.x & 0xffff0000u), __uint_as_float(x.y << 16), __uint_as_float(x.y & 0xffff0000u)} + acc[ai][bj][m][0] * alpha;
                    const f32x4 h1 = (f32x4){__uint_as_float(x.z << 16), __uint_as_float(x.z & 0xffff0000u), __uint_as_float(x.w << 16), __uint_as_float(x.w & 0xffff0000u)} + acc[ai][bj][m][1] * alpha;
                    sq += ((h0[0] * h0[0] + h0[1] * h0[1]) + (h0[2] * h0[2] + h0[3] * h0[3])) + ((h1[0] * h1[0] + h1[1] * h1[1]) + (h1[2] * h1[2] + h1[3] * h1[3]));
                    u32x4 w; w.x = cvt_pk_bf16(h0[0], h0[1]); w.y = cvt_pk_bf16(h0[2], h0[3]); w.z = cvt_pk_bf16(h1[0], h1[1]); w.w = cvt_pk_bf16(h1[2], h1[3]); *(u32x4*)(bbase + o + bj * HALF) = w; }
                sq += __shfl_xor(sq, 16); sq += __shfl_xor(sq, 32);
                if (fq == 0) red[(rl0 + ai * HALF + m * 16) * 4 + wc] = sq; }
            asm volatile("" ::: "memory"); }
        asm volatile("s_waitcnt lgkmcnt(0)" ::: "memory"); __builtin_amdgcn_s_barrier(); asm volatile("" ::: "memory");
        if (wr == 0) { const int row = wc * 64 + fq * 16 + fr; const float s4 = (red[row * 4] + red[row * 4 + 1]) + (red[row * 4 + 2] + red[row * 4 + 3]); ssn[(size_t)u.pn * 33024 + u.pm * BM + row] = s4; }
    }
};
struct EpiP {
    static constexpr bool PERM = true, AFTER_DRAIN = false;
    bf16_t* pr; float* ps; bf16_t* qkv; const float* ss; PG8_LAS float* rsb;
    __device__ __forceinline__ void operator()(const f32x4 (&acc)[2][2][4][2], const Unit& u, int wr, int wc, int fr, int fq, bool newpanel) const {
        if (newpanel) {
            if (wr == 0) { const int rl = wc * 64 + fq * 16 + fr; rsb[rl] = rs_of(ss, u.pm * BM + rl); }
            asm volatile("s_waitcnt lgkmcnt(0)" ::: "memory"); __builtin_amdgcn_s_barrier(); asm volatile("" ::: "memory"); }
        const int rl0 = wr * 64 + fr, row0 = u.pm * BM + rl0, cl = wc * 32 + 8 * fq;
#pragma unroll
        for (int ai = 0; ai < 2; ++ai)
#pragma unroll
            for (int m = 0; m < 4; ++m) { const int row = row0 + ai * HALF + m * 16; const float rs = rsb[rl0 + ai * HALF + m * 16];
#pragma unroll
                for (int bj = 0; bj < 2; ++bj) { const f32x4 v0 = acc[ai][bj][m][0] * rs, v1 = acc[ai][bj][m][1] * rs;
                    if (u.pn >= 12 && u.pn < 14) { float* d = ps + (size_t)row * 512 + (u.pn - 12) * 256 + bj * HALF + cl; *(f32x4*)d = v0; *(f32x4*)(d + 4) = v1; }
                    else { u32x4 w; w.x = cvt_pk_bf16(v0[0], v0[1]); w.y = cvt_pk_bf16(v0[2], v0[3]); w.z = cvt_pk_bf16(v1[0], v1[1]); w.w = cvt_pk_bf16(v1[2], v1[3]);
                        if (u.pn < 12) *(u32x4*)(pr + (size_t)row * 3072 + u.pn * 256 + bj * HALF + cl) = w;
                        else { const int c = (u.pn - 14) * 256 + bj * HALF + cl;
                            const int b = row >> 12, s = row & 4095; *(u32x4*)(qkv + ((size_t)b * 4160 + 64 + s) * 3072 + c) = w; } } } }
    }
};
template <class Epi, class Sched, bool ALIGN_EPI = false, bool SP2 = false>
__device__ __forceinline__ void gemm_phase(PG8_LAS unsigned char* lds, const Gemm g, const Sched& S, const Epi& E) {
    const int tid = ltid(), wid = __builtin_amdgcn_readfirstlane(tid >> 6), lane = tid & 63, wr = wid >> 2, wc = wid & 3, fr = lane & 15, fq = lane >> 4;
    const int K = g.K, nt = K / BK;
    unsigned voffA[2], voffB[2];
#pragma unroll
    for (int i = 0; i < 2; ++i) { int R, C; stage_rc(tid * 16 + i * 8192, R, C); const int Rb = Epi::PERM ? ((R & ~31) + perm32(R & 31)) : R;
        voffA[i] = (unsigned)(R * K + C) * 2u; voffB[i] = (unsigned)(Rb * K + C) * 2u; }
    const size_t kstep = (size_t)(BK * 2);
    const size_t hstep = (size_t)HALF * K * 2;
    const size_t tstep = 2 * hstep;
    const unsigned ldsw = (unsigned)wid * 1024u;
    const int aoff = lds_byte(wr * 64 + fr, fq * 8), boff = lds_byte(wc * 32 + fr, fq * 8);
#define PG8_SA(b, h) (((b) * 2 + (h)) * HTB)
#define PG8_SB(b, h) ((4 + (b) * 2 + (h)) * HTB)
#define PG8_STAGE(bufoff, gbase, voff) do { _Pragma("unroll") for (int _i = 0; _i < 2; ++_i) \
        __builtin_amdgcn_global_load_lds((const unsigned*)((const char*)(gbase) + (voff)[_i]), (PG8_LAS unsigned*)(lds + (bufoff) + ldsw + _i * 8192), 16, 0, 0); } while (0)
#define PG8_LDA(dst, b, h) do { _Pragma("unroll") for (int m = 0; m < 4; ++m) _Pragma("unroll") for (int k = 0; k < 2; ++k) dst[m][k] = *(const PG8_LAS bf16x8*)(lds + PG8_SA(b, h) + aoff + m * 2048 + k * 1024); } while (0)
#define PG8_LDB(dst, b, h) do { _Pragma("unroll") for (int n = 0; n < 2; ++n) _Pragma("unroll") for (int k = 0; k < 2; ++k) dst[n][k] = *(const PG8_LAS bf16x8*)(lds + PG8_SB(b, h) + boff + n * 2048 + k * 1024); } while (0)
#define PG8_MMA(ai, bj, At, Bt) do { __builtin_amdgcn_s_setprio(1); _Pragma("unroll") for (int m = 0; m < 4; ++m) _Pragma("unroll") for (int n = 0; n < 2; ++n) _Pragma("unroll") for (int k = 0; k < 2; ++k) \
        acc[ai][bj][m][n] = __builtin_amdgcn_mfma_f32_16x16x32_bf16(Bt[n][k], At[m][k], acc[ai][bj][m][n], 0, 0, 0); __builtin_amdgcn_s_setprio(0); } while (0)
#define PG8_WAIT_V(n) asm volatile("s_waitcnt vmcnt(" #n ")" ::: "memory")
#define PG8_WAIT_L(n) asm volatile("s_waitcnt lgkmcnt(" #n ")" ::: "memory")
#define PG8_BAR __builtin_amdgcn_s_barrier()
#define PG8_SCHED __builtin_amdgcn_sched_barrier(0)
    Unit cur, nxt; int ui = 0, prev_pm = -1;
    if (!S.next(0, cur)) return;
    f32x4 acc[2][2][4][2];
#pragma unroll
    for (int a = 0; a < 2; ++a)
#pragma unroll
        for (int b = 0; b < 2; ++b)
#pragma unroll
            for (int m = 0; m < 4; ++m)
#pragma unroll
                for (int n = 0; n < 2; ++n) acc[a][b][m][n] = (f32x4){0.f, 0.f, 0.f, 0.f};
    bf16x8 At[4][2], B0[2][2], B1[2][2];
    const char* cA = (const char*)g.A + (size_t)cur.pm * tstep; const char* cB = (const char*)g.Bt + (size_t)cur.pn * tstep;
    S.a_ready(cur);
    if constexpr (SP2) {
        PG8_STAGE(PG8_SB(0, 0), cB, voffB); PG8_STAGE(PG8_SB(0, 1), cB + hstep, voffB); PG8_STAGE(PG8_SA(0, 0), cA, voffA); PG8_STAGE(PG8_SA(0, 1), cA + hstep, voffA);
        if (wr == 1) PG8_BAR;
        PG8_WAIT_V(2); PG8_BAR;
        PG8_STAGE(PG8_SB(1, 0), cB + kstep, voffB); PG8_STAGE(PG8_SA(1, 0), cA + kstep, voffA); PG8_STAGE(PG8_SB(1, 1), cB + hstep + kstep, voffB);
        PG8_WAIT_V(6); PG8_BAR;
    } else {
        PG8_STAGE(PG8_SB(0, 0), cB, voffB); PG8_STAGE(PG8_SA(0, 0), cA, voffA); PG8_STAGE(PG8_SB(0, 1), cB + hstep, voffB); PG8_STAGE(PG8_SA(0, 1), cA + hstep, voffA);
        if (wr == 1) PG8_BAR;
        PG8_WAIT_V(4); PG8_BAR;
        PG8_STAGE(PG8_SB(1, 0), cB + kstep, voffB); PG8_STAGE(PG8_SA(1, 0), cA + kstep, voffA); PG8_STAGE(PG8_SB(1, 1), cB + hstep + kstep, voffB);
        PG8_WAIT_V(6); PG8_BAR;
    }
    for (;;) {
        const bool has_next = S.next(ui + 1, nxt);
        const char* nA = has_next ? (const char*)g.A + (size_t)nxt.pm * tstep : cA; const char* nB = has_next ? (const char*)g.Bt + (size_t)nxt.pn * tstep : cB;
        for (int t = 0; t < nt; t += 2) {
            const bool last = (t == nt - 2);
            const char* a1 = cA + (size_t)(t + 1) * kstep;
            const char* a2 = last ? nA : cA + (size_t)(t + 2) * kstep; const char* b2 = last ? nB : cB + (size_t)(t + 2) * kstep;
            const char* a3 = a2 + kstep; const char* b3 = b2 + kstep;
            if (last && has_next) S.a_ready(nxt);
            if constexpr (SP2) {
            PG8_LDB(B0, 0, 0); PG8_LDB(B1, 0, 1); PG8_SCHED; PG8_LDA(At, 0, 0); PG8_STAGE(PG8_SA(1, 1), a1 + hstep, voffA);
            PG8_WAIT_V(8); PG8_WAIT_L(0); PG8_BAR; PG8_MMA(0, 0, At, B0); PG8_MMA(0, 1, At, B1); PG8_BAR; PG8_SCHED;
            PG8_LDA(At, 0, 1); PG8_STAGE(PG8_SB(0, 0), b2, voffB); PG8_STAGE(PG8_SB(0, 1), b2 + hstep, voffB); PG8_STAGE(PG8_SA(0, 0), a2, voffA);
            PG8_WAIT_V(8); PG8_WAIT_L(0); PG8_BAR; PG8_MMA(1, 0, At, B0); PG8_MMA(1, 1, At, B1); PG8_BAR; PG8_SCHED;
            PG8_LDB(B0, 1, 0); PG8_LDB(B1, 1, 1); PG8_SCHED; PG8_LDA(At, 1, 0); PG8_STAGE(PG8_SA(0, 1), a2 + hstep, voffA);
            PG8_WAIT_V(8); PG8_WAIT_L(0); PG8_BAR; PG8_MMA(0, 0, At, B0); PG8_MMA(0, 1, At, B1); PG8_BAR; PG8_SCHED;
            PG8_LDA(At, 1, 1); PG8_STAGE(PG8_SB(1, 0), b3, voffB); PG8_STAGE(PG8_SB(1, 1), b3 + hstep, voffB); PG8_STAGE(PG8_SA(1, 0), a3, voffA);
            PG8_WAIT_V(8); PG8_WAIT_L(0); PG8_BAR; PG8_MMA(1, 0, At, B0); PG8_MMA(1, 1, At, B1); PG8_BAR; PG8_SCHED;
            } else {
            PG8_LDB(B0, 0, 0); PG8_SCHED; PG8_LDA(At, 0, 0); PG8_STAGE(PG8_SA(1, 1), a1 + hstep, voffA);
            PG8_WAIT_L(8); PG8_BAR; PG8_WAIT_L(0); PG8_MMA(0, 0, At, B0); PG8_BAR; PG8_SCHED;
            PG8_LDB(B1, 0, 1); PG8_STAGE(PG8_SB(0, 0), b2, voffB);
            PG8_BAR; PG8_WAIT_L(0); PG8_MMA(0, 1, At, B1); PG8_BAR;
            PG8_LDA(At, 0, 1); PG8_STAGE(PG8_SA(0, 0), a2, voffA);
            PG8_BAR; PG8_WAIT_L(0); PG8_MMA(1, 0, At, B0); PG8_BAR; PG8_SCHED;
            PG8_STAGE(PG8_SB(0, 1), b2 + hstep, voffB);
            PG8_WAIT_V(6); PG8_BAR; PG8_MMA(1, 1, At, B1); PG8_BAR;
            PG8_LDB(B0, 1, 0); PG8_SCHED; PG8_LDA(At, 1, 0); PG8_STAGE(PG8_SA(0, 1), a2 + hstep, voffA);
            PG8_WAIT_L(8); PG8_BAR; PG8_WAIT_L(0); PG8_MMA(0, 0, At, B0); PG8_BAR; PG8_SCHED;
            PG8_LDB(B1, 1, 1); PG8_STAGE(PG8_SB(1, 0), b3, voffB);
            PG8_BAR; PG8_WAIT_L(0); PG8_MMA(0, 1, At, B1); PG8_BAR;
            PG8_LDA(At, 1, 1); PG8_STAGE(PG8_SA(1, 0), a3, voffA);
            PG8_BAR; PG8_WAIT_L(0); PG8_MMA(1, 0, At, B0); PG8_BAR; PG8_SCHED;
            PG8_STAGE(PG8_SB(1, 1), b3 + hstep, voffB);
            PG8_WAIT_V(6); PG8_BAR; PG8_MMA(1, 1, At, B1); PG8_BAR;
            }
        }
        if constexpr (ALIGN_EPI) { if (wr == 0) PG8_BAR; }
        if constexpr (!Epi::AFTER_DRAIN) { E(acc, cur, wr, wc, fr, fq, cur.pm != prev_pm); prev_pm = cur.pm; S.done(cur); }
        if (!has_next) break;
#pragma unroll
        for (int a = 0; a < 2; ++a)
#pragma unroll
            for (int b = 0; b < 2; ++b)
#pragma unroll
                for (int m = 0; m < 4; ++m)
#pragma unroll
                    for (int n = 0; n < 2; ++n) acc[a][b][m][n] = (f32x4){0.f, 0.f, 0.f, 0.f};
        cur = nxt; cA = nA; cB = nB; ++ui;
        if constexpr (ALIGN_EPI) { if (wr == 1) PG8_BAR; }
    }
    PG8_WAIT_V(0);
    if constexpr (!ALIGN_EPI) { if (wr == 0) PG8_BAR; }
    PG8_BAR;
    if constexpr (Epi::AFTER_DRAIN) { E.fused(acc, cur, wr, wc, fr, fq, lds, wid, lane); S.done(cur); }
#undef PG8_SA
#undef PG8_SB
#undef PG8_STAGE
#undef PG8_LDA
#undef PG8_LDB
#undef PG8_MMA
#undef PG8_WAIT_V
#undef PG8_WAIT_L
#undef PG8_BAR
#undef PG8_SCHED
}
}


#define XB_TMO      128
#define XB_XCNT(j)  (256  + 64 * (j))
#define XB_XSUB(j)  (1280 + 64 * (j))
#define XB_XGEN(j)  (2304 + 64 * (j))
#define XB_TOP      3328
#define XB_TOPGEN   3392
#define XCD_BAR_WORDS 3456
#define XB_SPIN_CAP (1u << 22)

__device__ __forceinline__ unsigned xb_ld(unsigned* p)              { return __hip_atomic_load(p, __ATOMIC_RELAXED, __HIP_MEMORY_SCOPE_AGENT); }
__device__ __forceinline__ unsigned xb_add(unsigned* p, unsigned v) { return __hip_atomic_fetch_add(p, v, __ATOMIC_RELAXED, __HIP_MEMORY_SCOPE_AGENT); }
__device__ __forceinline__ unsigned xb_xcc_id() { return (unsigned)__builtin_amdgcn_s_getreg((3 << 11) | 20) & 0xFu; }
#define XB_SPIN(cond, bar) do { unsigned _sp = 0; while (cond) { __builtin_amdgcn_s_sleep(1); \
    if ((++_sp & 255u) == 0u) { if (xb_ld(&(bar)[XB_TMO])) break; if (_sp > XB_SPIN_CAP) { atomicAdd(&(bar)[XB_TMO], 1u); break; } } } } while (0)

struct XcdBarrier {
    unsigned* bar; unsigned x;
    volatile LAS unsigned* st;
};

__device__ __forceinline__ XcdBarrier xcd_barrier_post(unsigned* bar, volatile LAS unsigned* st) {
    XcdBarrier b; b.bar = bar; b.x = xb_xcc_id(); b.st = st;
    if (threadIdx.x == 0) (void)xb_add(&bar[XB_XCNT(b.x)], 1u);
    return b;
}
__device__ __forceinline__ void xcd_barrier_complete(unsigned* bar, unsigned x, unsigned& nloc, unsigned& nx) {
    const unsigned G = gridDim.x * gridDim.y * gridDim.z;
    unsigned sum, cnt, mine, sp = 0u;
    for (;;) {
        sum = 0u; cnt = 0u; mine = 0u;
#pragma unroll
        for (unsigned j = 0; j < 16; ++j) { const unsigned c = xb_ld(&bar[XB_XCNT(j)]); sum += c; cnt += (c > 0u) ? 1u : 0u; mine = (j == x) ? c : mine; }
        if (sum == G) break;
        __builtin_amdgcn_s_sleep(1);
        if ((++sp & 255u) == 0u) { if (xb_ld(&bar[XB_TMO])) break; if (sp > XB_SPIN_CAP) { atomicAdd(&bar[XB_TMO], 1u); break; } }
    }
    nloc = mine > 0u ? mine : 1u; nx = cnt > 0u ? cnt : 1u;
}

__device__ __forceinline__ void xcd_barrier(const XcdBarrier& b) {
    asm volatile("s_waitcnt vmcnt(0)" ::: "memory");
    __syncthreads();
    if (threadIdx.x == 0) {
        unsigned* bar = b.bar;
        __builtin_amdgcn_s_waitcnt(0);
        unsigned nloc = b.st[0], nx = b.st[1];
        if (nloc == 0u) { xcd_barrier_complete(bar, b.x, nloc, nx); b.st[0] = nloc; b.st[1] = nx; }
        const unsigned old = xb_add(&bar[XB_XSUB(b.x)], 1u);
        const unsigned gen = old / nloc;
        if (old + 1u == (gen + 1u) * nloc) {
            __builtin_amdgcn_fence(__ATOMIC_RELEASE, "agent");
            asm volatile("s_waitcnt vmcnt(0)" ::: "memory");
            const unsigned og = xb_add(&bar[XB_TOP], 1u);
            const unsigned tg = og / nx;
            if (og + 1u == (tg + 1u) * nx) xb_add(&bar[XB_TOPGEN], 1u);
            else XB_SPIN(xb_ld(&bar[XB_TOPGEN]) == tg, bar);
            __builtin_amdgcn_fence(__ATOMIC_ACQUIRE, "agent");
            xb_add(&bar[XB_XGEN(b.x)], 1u);
            asm volatile("s_waitcnt vmcnt(0)" ::: "memory");
        } else {
            XB_SPIN(xb_ld(&bar[XB_XGEN(b.x)]) == gen, bar);
            __builtin_amdgcn_fence(__ATOMIC_ACQUIRE, "agent");
            asm volatile("s_waitcnt vmcnt(0)" ::: "memory");
        }
    }
    __syncthreads();
}


typedef unsigned short bf16_t;
typedef float f32x4 __attribute__((ext_vector_type(4)));
typedef unsigned u32x4 __attribute__((ext_vector_type(4)));
typedef unsigned u32x2 __attribute__((ext_vector_type(2)));
struct Params { const float* in[25]; float* out; unsigned char* ws; int ph_lo, ph_hi; };
#define CAS __attribute__((address_space(4)))
typedef const CAS Params* PP;
__device__ __forceinline__ PP launder(PP p) { asm volatile("" : "+s"(p)); return p; }
enum { I_X = 0, I_META, I_F1N, I_F1GU, I_F1D, I_MIXN, I_WIN, I_MU, I_W0, I_WUP, I_A0, I_AUP, I_GUP, I_KK, I_KA, I_RK, I_LNW, I_LNB, I_BF, I_FON, I_WOUT, I_F2N, I_F2GU, I_F2D, I_FINN };

typedef float f32x2_t __attribute__((ext_vector_type(2))); typedef __bf16 bf16x2v_t __attribute__((ext_vector_type(2)));
__device__ __forceinline__ unsigned pk_bf16(float lo, float hi) { f32x2_t v = {lo, hi}; bf16x2v_t b = __builtin_convertvector(v, bf16x2v_t); return __builtin_bit_cast(unsigned, b); }
__device__ __forceinline__ float bf2f(bf16_t b) { return __uint_as_float(((unsigned)b) << 16); }
__device__ __forceinline__ float wave_sum(float v) {
#pragma unroll
    for (int o = 32; o >= 1; o >>= 1) v += __shfl_xor(v, o);
    return v; }
__device__ __forceinline__ float wave_max(float v) {
#pragma unroll
    for (int o = 32; o >= 1; o >>= 1) v = fmaxf(v, __shfl_xor(v, o));
    return v; }
template <int CTRL> __device__ __forceinline__ float dpp_f(float v) { return __builtin_bit_cast(float, __builtin_amdgcn_update_dpp(0, __builtin_bit_cast(int, v), CTRL, 0xf, 0xf, true)); }
__device__ __forceinline__ float row_sum16(float v) { v += dpp_f<0xB1>(v); v += dpp_f<0x4E>(v); v += dpp_f<0x141>(v); v += dpp_f<0x140>(v); return v; }
__device__ __forceinline__ float rdlane(float v, int l) { return __builtin_bit_cast(float, __builtin_amdgcn_readlane(__builtin_bit_cast(int, v), l)); }
__device__ __forceinline__ float wave_sum_dpp(float v) { v = row_sum16(v); return (rdlane(v, 0) + rdlane(v, 16)) + (rdlane(v, 32) + rdlane(v, 48)); }
__device__ __forceinline__ float sigmoid_f(float x) { return __builtin_amdgcn_rcpf(1.0f + __expf(-x)); }

__device__ __forceinline__ void convert_tile(const float* __restrict__ src, bf16_t* __restrict__ dst, const float* __restrict__ gain, int K, int Nsrc, int kind, int tk, int tn, LAS float* T) {
    const int tid = ltid();
    {
        const int nl = (tid & 15) * 4, np = tn * 64 + nl; int sc;
        if (kind == 1) { const int pn = np >> 8, bj = (np >> 7) & 1, i = np & 127; sc = bj * cfg::DFF + pn * 128 + i; }
        else if (kind == 2) { sc = np < 3360 ? np : (np < 3368 ? 6432 + (np - 3360) : (np < 3584 ? -1 : 3360 + (np - 3584))); }
        else sc = np;
#pragma unroll
        for (int i = 0; i < 2; ++i) { const int kl = (tid >> 4) + 32 * i, k = tk * 64 + kl;
            f32x4 v = (f32x4){0.f, 0.f, 0.f, 0.f};
            if (sc >= 0) v = *(const f32x4*)(src + (size_t)k * Nsrc + sc);
            float g = 1.f; if (kind == 1 || kind == 2) g = gain[k]; else if (kind == 3) g = (k >= 1024) ? gain[k - 1024] : 1.f;
            T[kl * 65 + nl] = v[0] * g; T[kl * 65 + nl + 1] = v[1] * g; T[kl * 65 + nl + 2] = v[2] * g; T[kl * 65 + nl + 3] = v[3] * g; }
    }
    __syncthreads();
    {
        const int nl = tid >> 3, k8 = (tid & 7) * 8; u32x4 w;
        w.x = pk_bf16(T[(k8 + 0) * 65 + nl], T[(k8 + 1) * 65 + nl]); w.y = pk_bf16(T[(k8 + 2) * 65 + nl], T[(k8 + 3) * 65 + nl]);
        w.z = pk_bf16(T[(k8 + 4) * 65 + nl], T[(k8 + 5) * 65 + nl]); w.w = pk_bf16(T[(k8 + 6) * 65 + nl], T[(k8 + 7) * 65 + nl]);
        *(u32x4*)(dst + (size_t)(tn * 64 + nl) * K + tk * 64 + k8) = w;
    }
    __syncthreads();
}
__device__ __forceinline__ void phase_convert(PP P, LAS unsigned char* lds, int l0, int l1, int first, int nwg, int t0 = 0, int t1 = 0) {
    using namespace cfg;
    LAS float* T = (LAS float*)lds;
    constexpr int T_GU = (DM / 64) * (NGU / 64), T_D = (DFF / 64) * (DM / 64), T_IN = (DM / 64) * (NIN / 64), T_OUT = (DM / 64) * (DM / 64);
    constexpr int T_LAYER = 2 * T_GU + 2 * T_D + T_IN + T_OUT;
    if (t1 <= 0) t1 = T_LAYER;
    for (int t = l0 * T_LAYER + first; t < l1 * T_LAYER; t += nwg) {
        const int l = t / T_LAYER; int r = t - l * T_LAYER; if (r < t0 || r >= t1) continue;
        bf16_t* wl = (bf16_t*)(P->ws + WS_W + (size_t)l * W_LAYER);
        const float* src; bf16_t* dst; const float* gain = nullptr; int K, Nsrc, kind, ntn;
        if (r < T_GU) { src = P->in[I_F1GU] + (size_t)l * DM * NGU; dst = (bf16_t*)((unsigned char*)wl + WO_GU1); gain = P->in[I_F1N] + l * DM; K = DM; Nsrc = NGU; kind = 1; ntn = NGU / 64; }
        else if ((r -= T_GU) < T_D) { src = P->in[I_F1D] + (size_t)l * DFF * DM; dst = (bf16_t*)((unsigned char*)wl + WO_D1); K = DFF; Nsrc = DM; kind = 0; ntn = DM / 64; }
        else if ((r -= T_D) < T_IN) { src = P->in[I_WIN] + (size_t)l * DM * DIN; dst = (bf16_t*)((unsigned char*)wl + WO_IN); gain = P->in[I_MIXN] + l * DM; K = DM; Nsrc = DIN; kind = 2; ntn = NIN / 64; }
        else if ((r -= T_IN) < T_OUT) { src = P->in[I_WOUT] + (size_t)l * DM * DM; dst = (bf16_t*)((unsigned char*)wl + WO_OUT); gain = P->in[I_FON] + l * FW; K = DM; Nsrc = DM; kind = 3; ntn = DM / 64; }
        else if ((r -= T_OUT) < T_GU) { src = P->in[I_F2GU] + (size_t)l * DM * NGU; dst = (bf16_t*)((unsigned char*)wl + WO_GU2); gain = P->in[I_F2N] + l * DM; K = DM; Nsrc = NGU; kind = 1; ntn = NGU / 64; }
        else { r -= T_GU; src = P->in[I_F2D] + (size_t)l * DFF * DM; dst = (bf16_t*)((unsigned char*)wl + WO_D2); K = DFF; Nsrc = DM; kind = 0; ntn = DM / 64; }
        convert_tile(src, dst, gain, K, Nsrc, kind, r / ntn, r % ntn, T);
    }
}
__device__ __forceinline__ void phase_init(PP P) {
    using namespace cfg;
    const int lane = ltid() & 63, gw = lbid() * 8 + (ltid() >> 6), nw = gridDim.x * 8;
    bf16_t* hb = (bf16_t*)(P->ws + WS_HB); float* ss0 = (float*)(P->ws + WS_SS);
    for (int row = gw; row < MROWS; row += nw) {
        const float* s = row < MMAIN ? P->in[I_X] + (size_t)row * DM : P->in[I_META] + (size_t)(row - MMAIN) * DM;
        float sq = 0.f;
#pragma unroll
        for (int i = 0; i < 4; ++i) { f32x4 v0 = (f32x4){0.f, 0.f, 0.f, 0.f}, v1 = v0; if (row < MMAIN + NMETA) { v0 = *(const f32x4*)(s + i * 512 + lane * 8); v1 = *(const f32x4*)(s + i * 512 + lane * 8 + 4); }
            sq += ((v0[0] * v0[0] + v0[1] * v0[1]) + (v0[2] * v0[2] + v0[3] * v0[3])) + ((v1[0] * v1[0] + v1[1] * v1[1]) + (v1[2] * v1[2] + v1[3] * v1[3]));
            u32x4 w; w.x = pk_bf16(v0[0], v0[1]); w.y = pk_bf16(v0[2], v0[3]); w.z = pk_bf16(v1[0], v1[1]); w.w = pk_bf16(v1[2], v1[3]); *(u32x4*)(hb + (size_t)row * DM + i * 512 + lane * 8) = w; }
        sq = wave_sum(sq);
        if (lane < 8) ss0[(size_t)lane * MROWS + row] = lane == 0 ? sq : 0.f;
        if (row >= MMAIN && row < MMAIN + NMETA) { float* ssm0 = (float*)(P->ws + WS_SSM); ssm0[lane * 16 + (row - MMAIN)] = lane == 0 ? sq : 0.f; ssm0[(64 + lane) * 16 + (row - MMAIN)] = 0.f; }
    }
}
__device__ __forceinline__ void phase_foxnorm(PP P) {
    using namespace cfg;
    const int lane = ltid() & 63, gw = lbid() * 8 + (ltid() >> 6), nw = gridDim.x * 8;
    bf16_t* y = (bf16_t*)(P->ws + WS_Y);
    for (int row0 = gw; row0 < MMAIN + NMETA; row0 += 4 * nw) {
        u32x4 a[4], b[4];
#pragma unroll
        for (int j = 0; j < 4; ++j) { const int row = row0 + j * nw; if (row < MMAIN + NMETA) { const bf16_t* p = y + (size_t)row * DM + 1024 + lane * 16; a[j] = *(const u32x4*)p; b[j] = *(const u32x4*)(p + 8); } else { a[j] = (u32x4){0u, 0u, 0u, 0u}; b[j] = a[j]; } }
#pragma unroll
        for (int j = 0; j < 4; ++j) { const int row = row0 + j * nw; float v[16];
#pragma unroll
            for (int i = 0; i < 4; ++i) { v[2 * i] = __uint_as_float(a[j][i] << 16); v[2 * i + 1] = __uint_as_float(a[j][i] & 0xffff0000u); v[8 + 2 * i] = __uint_as_float(b[j][i] << 16); v[8 + 2 * i + 1] = __uint_as_float(b[j][i] & 0xffff0000u); }
            float sq = 0.f;
#pragma unroll
            for (int i = 0; i < 16; ++i) sq += v[i] * v[i];
            sq = wave_sum_dpp(sq); const float rs = __builtin_amdgcn_rsqf(sq * (1.0f / 1024.0f) + NORM_EPS);
            u32x4 oa, ob;
#pragma unroll
            for (int i = 0; i < 4; ++i) { oa[i] = pk_bf16(v[2 * i] * rs, v[2 * i + 1] * rs); ob[i] = pk_bf16(v[8 + 2 * i] * rs, v[8 + 2 * i + 1] * rs); }
            if (row < MMAIN + NMETA) { bf16_t* p = y + (size_t)row * DM + 1024 + lane * 16; *(u32x4*)p = oa; *(u32x4*)(p + 8) = ob; } }
    }
}
__device__ __forceinline__ void phase_final(PP P) {
    using namespace cfg;
    const int lane = ltid() & 63, gw = lbid() * 8 + (ltid() >> 6), nw = gridDim.x * 8;
    const float* g = P->in[I_FINN]; const bf16_t* hb = (const bf16_t*)(P->ws + WS_HB);
    for (int row = gw; row < MMAIN; row += nw) {
        float* d = P->out + (size_t)row * DM; f32x4 v[8]; float sq = 0.f;
#pragma unroll
        for (int i = 0; i < 4; ++i) { const u32x4 x = *(const u32x4*)(hb + (size_t)row * DM + i * 512 + lane * 8);
            v[2 * i] = (f32x4){__uint_as_float(x.x << 16), __uint_as_float(x.x & 0xffff0000u), __uint_as_float(x.y << 16), __uint_as_float(x.y & 0xffff0000u)};
            v[2 * i + 1] = (f32x4){__uint_as_float(x.z << 16), __uint_as_float(x.z & 0xffff0000u), __uint_as_float(x.w << 16), __uint_as_float(x.w & 0xffff0000u)}; }
#pragma unroll
        for (int i = 0; i < 8; ++i) sq += (v[i][0] * v[i][0] + v[i][1] * v[i][1]) + (v[i][2] * v[i][2] + v[i][3] * v[i][3]);
        sq = wave_sum(sq); const float rs = __builtin_amdgcn_rsqf(sq * (1.0f / 2048.0f) + NORM_EPS);
#pragma unroll
        for (int i = 0; i < 4; ++i) { const f32x4 g0 = *(const f32x4*)(g + i * 512 + lane * 8), g1 = *(const f32x4*)(g + i * 512 + lane * 8 + 4);
            *(f32x4*)(d + i * 512 + lane * 8) = v[2 * i] * rs * g0; *(f32x4*)(d + i * 512 + lane * 8 + 4) = v[2 * i + 1] * rs * g1; }
    }
}


__device__ __forceinline__ void phase_lx(PP P, int l) {
    using namespace cfg;
    const int lane = ltid() & 63, gw = lbid() * 8 + (ltid() >> 6), nw = gridDim.x * 8;
    const float* PS = (const float*)(P->ws + WS_PS); bf16_t* LXG = (bf16_t*)(P->ws + WS_LXG); const float* mu = P->in[I_MU] + l * RWKV_COLS + 3072;
    if (lane < 36) {
        const f32x4 m0 = *(const f32x4*)(mu + lane * 8), m1 = *(const f32x4*)(mu + lane * 8 + 4);
#pragma unroll 4
        for (int row = gw; row < MMAIN + NMETA; row += nw) {
            int prev; if (row >= MMAIN) prev = (row == MMAIN) ? -1 : row - 1; else prev = ((row & (SEQ - 1)) == 0) ? MMAIN + NMETA - 1 : row - 1;
            const f32x4 c0 = *(const f32x4*)(PS + (size_t)row * PSW + lane * 8), c1 = *(const f32x4*)(PS + (size_t)row * PSW + lane * 8 + 4);
            f32x4 p0 = (f32x4){0.f, 0.f, 0.f, 0.f}, p1 = p0; if (prev >= 0) { p0 = *(const f32x4*)(PS + (size_t)prev * PSW + lane * 8); p1 = *(const f32x4*)(PS + (size_t)prev * PSW + lane * 8 + 4); }
            float x[8];
#pragma unroll
            for (int j = 0; j < 4; ++j) { x[j] = c0[j] + (p0[j] - c0[j]) * m0[j]; x[4 + j] = c1[j] + (p1[j] - c1[j]) * m1[j]; }
#pragma unroll
            for (int j = 0; j < 8; ++j) x[j] = lane < 8 ? 1.0f - 2.0f * __builtin_amdgcn_rcpf(__expf(2.0f * x[j]) + 1.0f) : (lane < 16 ? x[j] : __builtin_amdgcn_rcpf(1.0f + __expf(-x[j])));
            u32x4 w; w.x = pk_bf16(x[0], x[1]); w.y = pk_bf16(x[2], x[3]); w.z = pk_bf16(x[4], x[5]); w.w = pk_bf16(x[6], x[7]);
            *(u32x4*)(LXG + (size_t)row * 320 + lane * 8) = w;
        }
    }
}

typedef short bf16x8_t __attribute__((ext_vector_type(8)));
typedef short bf16x4_t __attribute__((ext_vector_type(4)));
namespace rk {
constexpr int LXS = 0, LXS_SZ = 18432, RAWH = 55296, RAWH_SZ = 6144, LXB = 73728, RS = 82944, KS = 87040, VS = 91136, KKN = 95232, ATP = 99328, RTP = 101376, BTP = 103424, KTP = 105472,
              BHT = 107520, KHT = 109568, VT = 111616, GT = 113664, AAK = 113920, RB = 114432, RKM = 114944, TINV = 115456, GG = 115968  , VF = 124160  , YR = 132352, BONP = 136448  , LDS_END = 136960;
}
#define RK_BAR() do { asm volatile("s_waitcnt lgkmcnt(0)" ::: "memory"); __builtin_amdgcn_s_barrier(); asm volatile("" ::: "memory"); } while (0)
__device__ __forceinline__ bf16_t bf1(float x) { return (bf16_t)(pk_bf16(x, 0.f) & 0xffffu); }
__device__ __forceinline__ bf16x4_t pack4(float a, float b, float c, float d) { u32x2 w; w.x = pk_bf16(a, b); w.y = pk_bf16(c, d); return __builtin_bit_cast(bf16x4_t, w); }
__device__ __forceinline__ float fast_sigmoid(float x) { return __builtin_amdgcn_rcpf(1.0f + __expf(-x)); }
__device__ __forceinline__ float fast_tanh(float x) { return 1.0f - 2.0f * __builtin_amdgcn_rcpf(__expf(2.0f * x) + 1.0f); }

__device__ __forceinline__ void rwkv_chunked(PP P, int l, int b, int h, LAS unsigned char* lds) {
    using namespace cfg;
    const int tid = ltid(), lane = tid & 63, wave = __builtin_amdgcn_readfirstlane(tid >> 6), n = lane & 15, g = lane >> 4;
    const bf16_t* PR = (const bf16_t*)(P->ws + WS_PR); const float* PS = (const float*)(P->ws + WS_PS); bf16_t* Y = (bf16_t*)(P->ws + WS_Y);
    const float* mu = P->in[I_MU] + l * RWKV_COLS; const bf16_t* LXGp = (const bf16_t*)(P->ws + WS_LXG);
    LAS float* RSm = (LAS float*)(lds + rk::RS); LAS float* KSm = (LAS float*)(lds + rk::KS); LAS float* VSm = (LAS float*)(lds + rk::VS); LAS float* KKNm = (LAS float*)(lds + rk::KKN);
    LAS bf16_t* ATp = (LAS bf16_t*)(lds + rk::ATP); LAS bf16_t* RTp = (LAS bf16_t*)(lds + rk::RTP); LAS bf16_t* BTp = (LAS bf16_t*)(lds + rk::BTP); LAS bf16_t* KTp = (LAS bf16_t*)(lds + rk::KTP);
    LAS bf16_t* BHt = (LAS bf16_t*)(lds + rk::BHT); LAS bf16_t* KHt = (LAS bf16_t*)(lds + rk::KHT); LAS bf16_t* Vt = (LAS bf16_t*)(lds + rk::VT);
    LAS float* GTm = (LAS float*)(lds + rk::GT);
    LAS bf16_t* AAKm = (LAS bf16_t*)(lds + rk::AAK); LAS bf16_t* RBm = (LAS bf16_t*)(lds + rk::RB); LAS bf16_t* RKm = (LAS bf16_t*)(lds + rk::RKM); LAS bf16_t* TINVm = (LAS bf16_t*)(lds + rk::TINV);
    LAS float* YRm = (LAS float*)(lds + rk::YR);
    const int hj = h * 64 + lane;
    const float mur = mu[hj], muk = mu[1024 + hj], muv = mu[2048 + hj], kkw = P->in[I_KK][l * RW + hj], lnw = P->in[I_LNW][l * RW + hj], lnb = P->in[I_LNB][l * RW + hj];
    const int kw = wave & 3, key = 16 * kw + n, hk = h * 64 + key;
    const float w0k = P->in[I_W0][l * RW + hk], a0k = P->in[I_A0][l * RW + hk], kak = P->in[I_KA][l * RW + hk], rkk = P->in[I_RK][l * RW + hk];
    const int pp = 32 * (key >> 5) + 8 * ((key >> 2) & 3) + 4 * ((key >> 4) & 1) + (key & 3);
    bf16x8_t fA[2], fB[5];
    {
        const float* wu = P->in[I_WUP] + (size_t)l * 64 * RW + hk; const float* au = P->in[I_AUP] + (size_t)l * 64 * RW + hk; const float* gu = P->in[I_GUP] + (size_t)l * 160 * RW + hk;
#pragma unroll
        for (int s = 0; s < 5; ++s) { float v[8], u[8];
#pragma unroll
            for (int j = 0; j < 8; ++j) { const int k = 32 * s + 8 * g + j; v[j] = (wave < 4) ? (s < 2 ? au[(size_t)k * RW] : 0.f) : gu[(size_t)k * RW]; u[j] = (wave < 4 && s < 2) ? wu[(size_t)k * RW] : 0.f; }
            u32x4 w; w.x = pk_bf16(v[0], v[1]); w.y = pk_bf16(v[2], v[3]); w.z = pk_bf16(v[4], v[5]); w.w = pk_bf16(v[6], v[7]); fB[s] = __builtin_bit_cast(bf16x8_t, w);
            if (s < 2) { u32x4 x; x.x = pk_bf16(u[0], u[1]); x.y = pk_bf16(u[2], u[3]); x.z = pk_bf16(u[4], u[5]); x.w = pk_bf16(u[6], u[7]); fA[s] = __builtin_bit_cast(bf16x8_t, x); } }
    }
    f32x4 ST[4];
#pragma unroll
    for (int kb = 0; kb < 4; ++kb) ST[kb] = (f32x4){0.f, 0.f, 0.f, 0.f};
#define RK_DMA(c_) do { const int cc_ = (c_); const int row0_ = (cc_ == 0) ? MMAIN : b * SEQ + (cc_ - 1) * 16; const int bi_ = cc_ % 3; \
        _Pragma("unroll") for (int i_ = 0; i_ < 2; ++i_) { const int wp_ = (i_ == 0) ? wave : 8; if (i_ == 0 || wave == 6) { const int x_ = wp_ * 64 + lane; \
            __builtin_amdgcn_global_load_lds((const unsigned*)(LXGp + (size_t)(row0_ + x_ / 36) * 320 + (x_ % 36) * 8), (LAS unsigned*)(lds + rk::LXS + (cc_ & 1) * rk::LXS_SZ + wp_ * 1024), 16, 0, 0); } } \
        if (wave < 6) { const int y_ = wave * 64 + lane; \
            __builtin_amdgcn_global_load_lds((const unsigned*)(PR + (size_t)(row0_ + y_ / 24) * PRW + ((y_ % 24) >> 3) * 1024 + h * 64 + (y_ & 7) * 8), (LAS unsigned*)(lds + rk::RAWH + bi_ * rk::RAWH_SZ + wave * 1024), 16, 0, 0); } } while (0)
#define RK_STAGE_A(ca_, t_) do { const int t = (t_); const int bc_ = (ca_) % 3, bp_ = ((ca_) + 2) % 3; \
        LAS const bf16_t* cH_ = (LAS const bf16_t*)(lds + rk::RAWH + bc_ * rk::RAWH_SZ); LAS const bf16_t* pH_ = (LAS const bf16_t*)(lds + rk::RAWH + bp_ * rk::RAWH_SZ); \
        LAS const bf16_t* ctH = cH_ + t * 192; LAS const bf16_t* ptH = (t == 0) ? pH_ + 15 * 192 : cH_ + (t - 1) * 192; \
        const float rc = bf2f(ctH[lane]), kc = bf2f(ctH[64 + lane]), vc = bf2f(ctH[128 + lane]); \
        const float rs = rc + (bf2f(ptH[lane]) - rc) * mur, ks = kc + (bf2f(ptH[64 + lane]) - kc) * muk, vs = vc + (bf2f(ptH[128 + lane]) - vc) * muv; \
        RSm[t * 64 + lane] = rs; KSm[t * 64 + lane] = ks; VSm[t * 64 + lane] = vs; \
        const float kkr = ks * kkw; const float n2 = wave_sum_dpp(kkr * kkr); KKNm[t * 64 + lane] = kkr * __builtin_amdgcn_rsqf(fmaxf(n2, 1e-24f)); } while (0)
#define RK_STAGE_F(cf_, t_) do { const int t = (t_); const int par_ = (cf_) & 1; const int rowF_ = ((cf_) == 0) ? MMAIN : b * SEQ + ((cf_) - 1) * 16; \
        LAS const float* Gp_ = (LAS const float*)(lds + rk::GG + par_ * 4096); LAS const float* Vp_ = (LAS const float*)(lds + rk::VF + par_ * 4096); LAS const float* Bp_ = (LAS const float*)(lds + rk::BONP + par_ * 256); \
        const float yv = YRm[t * 64 + lane]; \
        const float mean = wave_sum_dpp(yv) * (1.0f / 64.0f); const float d = yv - mean; const float var = wave_sum_dpp(d * d) * (1.0f / 64.0f); \
        const float yn = d * __builtin_amdgcn_rsqf(var + LNX_EPS) * lnw + lnb; \
        const float bonus = (Bp_[t] + Bp_[16 + t]) + (Bp_[32 + t] + Bp_[48 + t]); \
        const float o = (yn + bonus * Vp_[t * 64 + lane]) * Gp_[t * 64 + lane]; \
        if ((cf_) > 0 || b == 0) Y[(size_t)(rowF_ + t) * DM + hj] = bf1(o); } while (0)
    RK_DMA(0); RK_DMA(1);
    for (int e = tid; e < 96; e += 512) ((LAS unsigned*)(lds + rk::RAWH + 2 * rk::RAWH_SZ))[15 * 96 + e] = 0u;
    asm volatile("s_waitcnt vmcnt(0)" ::: "memory");
    RK_BAR();
    RK_STAGE_A(0, wave); RK_STAGE_A(0, wave + 8);
    RK_BAR();
#pragma unroll 1
    for (int c = 0; c < 257; ++c) {
        if (wave < 4) {
            LAS float* BONPc = (LAS float*)(lds + rk::BONP + (c & 1) * 256); LAS const bf16_t* LXB = (LAS const bf16_t*)(lds + rk::LXS + (c & 1) * rk::LXS_SZ);
            f32x4 accW = (f32x4){0.f, 0.f, 0.f, 0.f}, accA = accW;
#pragma unroll
            for (int s = 0; s < 2; ++s) { const bf16x8_t aw = *(const LAS bf16x8_t*)(LXB + n * 288 + 32 * s + 8 * g), aa = *(const LAS bf16x8_t*)(LXB + n * 288 + 64 + 32 * s + 8 * g);
                accW = __builtin_amdgcn_mfma_f32_16x16x32_bf16(aw, fA[s], accW, 0, 0, 0); accA = __builtin_amdgcn_mfma_f32_16x16x32_bf16(aa, fB[s], accA, 0, 0, 0); }
            float lw[4], alr[4], pfx[4];
#pragma unroll
            for (int r = 0; r < 4; ++r) { lw[r] = -0.6065306597126334f * fast_sigmoid(accW[r] + w0k); alr[r] = fast_sigmoid(accA[r] + a0k); }
            pfx[0] = lw[0]; pfx[1] = pfx[0] + lw[1]; pfx[2] = pfx[1] + lw[2]; pfx[3] = pfx[2] + lw[3];
            const float t0 = __shfl(pfx[3], n), t1 = __shfl(pfx[3], n + 16), t2 = __shfl(pfx[3], n + 32), t3 = __shfl(pfx[3], n + 48);
            const float base = (g > 0 ? t0 : 0.f) + (g > 1 ? t1 : 0.f) + (g > 2 ? t2 : 0.f), lamT = (t0 + t1) + (t2 + t3);
            float bh[4], kh[4], bon[4], epos[4];
            const float eb = __expf(base), eT = __expf(lamT);
#pragma unroll
            for (int r = 0; r < 4; ++r) epos[r] = __expf(base + pfx[r]);
#pragma unroll
            for (int r = 0; r < 4; ++r) { const int t = 4 * g + r;
                const float e_pos = epos[r], e_neg = __builtin_amdgcn_rcpf(epos[r]), e_prev = (r == 0) ? eb : epos[r > 0 ? r - 1 : 0], e_hat = eT * e_neg;
                const float rs = RSm[t * 64 + key], ks = KSm[t * 64 + key], kk = KKNm[t * 64 + key];
                const float kmod = ks * (1.0f + (alr[r] - 1.0f) * kak), bb = kk * alr[r];
                ATp[t * 64 + pp] = bf1(-kk * e_prev); RTp[t * 64 + pp] = bf1(rs * e_pos); BTp[t * 64 + pp] = bf1(bb * e_neg); KTp[t * 64 + pp] = bf1(kmod * e_neg);
                bh[r] = bb * e_hat; kh[r] = kmod * e_hat; bon[r] = rs * kmod * rkk; }
            *(LAS bf16x4_t*)(BHt + key * 16 + 4 * g) = pack4(bh[0], bh[1], bh[2], bh[3]); *(LAS bf16x4_t*)(KHt + key * 16 + 4 * g) = pack4(kh[0], kh[1], kh[2], kh[3]);
#pragma unroll
            for (int r = 0; r < 4; ++r) { const float x = row_sum16(bon[r]); if (n == 0) BONPc[kw * 16 + 4 * g + r] = x; }
            if (g == 0) GTm[key] = eT;
        } else {
            LAS float* Gc = (LAS float*)(lds + rk::GG + (c & 1) * 4096); LAS float* VFc = (LAS float*)(lds + rk::VF + (c & 1) * 4096); LAS const bf16_t* LXB = (LAS const bf16_t*)(lds + rk::LXS + (c & 1) * rk::LXS_SZ);
            f32x4 accG = (f32x4){0.f, 0.f, 0.f, 0.f};
#pragma unroll
            for (int s = 0; s < 5; ++s) { const bf16x8_t ag = *(const LAS bf16x8_t*)(LXB + n * 288 + 128 + 32 * s + 8 * g); accG = __builtin_amdgcn_mfma_f32_16x16x32_bf16(ag, fB[s], accG, 0, 0, 0); }
            float vv[4];
#pragma unroll
            for (int r = 0; r < 4; ++r) { Gc[(4 * g + r) * 64 + key] = accG[r]; vv[r] = VSm[(4 * g + r) * 64 + key]; VFc[(4 * g + r) * 64 + key] = vv[r]; }
            *(LAS bf16x4_t*)(Vt + key * 16 + 4 * g) = pack4(vv[0], vv[1], vv[2], vv[3]);
            if (c >= 1) { RK_STAGE_F(c - 1, 4 * kw); RK_STAGE_F(c - 1, 4 * kw + 1); RK_STAGE_F(c - 1, 4 * kw + 2); RK_STAGE_F(c - 1, 4 * kw + 3); }
        }
        asm volatile("s_waitcnt vmcnt(0)" ::: "memory");
        RK_BAR();
        if (c + 2 < 257) RK_DMA(c + 2);
        if (wave < 4) {
            LAS const bf16_t* X = (wave < 2) ? ATp : RTp; LAS const bf16_t* Yi = (wave & 1) ? KTp : BTp;
            f32x4 acc = (f32x4){0.f, 0.f, 0.f, 0.f};
#pragma unroll
            for (int s = 0; s < 2; ++s) { const bf16x8_t xa = *(const LAS bf16x8_t*)(X + n * 64 + 32 * s + 8 * g), yb = *(const LAS bf16x8_t*)(Yi + n * 64 + 32 * s + 8 * g);
                acc = __builtin_amdgcn_mfma_f32_16x16x32_bf16(xa, yb, acc, 0, 0, 0); }
            float mv[4];
#pragma unroll
            for (int r = 0; r < 4; ++r) { const int t = 4 * g + r; const bool keep = (wave < 2) ? (n < t) : (n <= t); mv[r] = keep ? acc[r] : 0.f;
                if (wave == 1) AAKm[t * 16 + n] = bf1(mv[r]); else if (wave == 2) RBm[t * 16 + n] = bf1(mv[r]); else if (wave == 3) RKm[t * 16 + n] = bf1(mv[r]); }
            if (wave == 0) {
                float Tc[16];
#pragma unroll
                for (int t = 0; t < 16; ++t) { float v0 = (t == n) ? 1.0f : 0.0f, v1 = 0.f;
#pragma unroll
                    for (int i = 0; i < t; ++i) { const float a = rdlane(mv[t & 3], i + 16 * (t >> 2)); if (i & 1) v1 += a * Tc[i]; else v0 += a * Tc[i]; }
                    Tc[t] = v0 + v1; asm volatile("" : "+v"(mv[0]), "+v"(mv[1]), "+v"(mv[2]), "+v"(mv[3]));     }
                if (g == 0) {
#pragma unroll
                    for (int t = 0; t < 16; ++t) TINVm[t * 16 + n] = bf1(Tc[t]); }
            }
        }
        if (wave >= 1) {
            if (c + 1 < 257 && wave != 4) { const int t0_ = (wave < 4) ? 3 * (wave - 1) : (wave == 5 ? 9 : 12 + 2 * (wave - 6));
                RK_STAGE_A(c + 1, t0_); RK_STAGE_A(c + 1, t0_ + 1); if (wave < 6) RK_STAGE_A(c + 1, t0_ + 2); }
        }
        RK_BAR();
        if (wave < 4) {
            bf16x8_t sb[2];
#pragma unroll
            for (int s = 0; s < 2; ++s) { u32x4 w; w.x = pk_bf16(ST[2 * s][0], ST[2 * s][1]); w.y = pk_bf16(ST[2 * s][2], ST[2 * s][3]); w.z = pk_bf16(ST[2 * s + 1][0], ST[2 * s + 1][1]); w.w = pk_bf16(ST[2 * s + 1][2], ST[2 * s + 1][3]);
                sb[s] = __builtin_bit_cast(bf16x8_t, w); }
            const bf16x4_t vfr = *(const LAS bf16x4_t*)(Vt + key * 16 + 4 * g);
            f32x4 W1 = (f32x4){0.f, 0.f, 0.f, 0.f}, Yc = W1;
#pragma unroll
            for (int s = 0; s < 2; ++s) { const bf16x8_t af = *(const LAS bf16x8_t*)(ATp + n * 64 + 32 * s + 8 * g), rf = *(const LAS bf16x8_t*)(RTp + n * 64 + 32 * s + 8 * g);
                W1 = __builtin_amdgcn_mfma_f32_16x16x32_bf16(af, sb[s], W1, 0, 0, 0); Yc = __builtin_amdgcn_mfma_f32_16x16x32_bf16(rf, sb[s], Yc, 0, 0, 0); }
            W1 = __builtin_amdgcn_mfma_f32_16x16x16bf16_1k(*(const LAS bf16x4_t*)(AAKm + n * 16 + 4 * g), vfr, W1, 0, 0, 0);
            const bf16x4_t w1f = pack4(W1[0], W1[1], W1[2], W1[3]);
            f32x4 U = __builtin_amdgcn_mfma_f32_16x16x16bf16_1k(*(const LAS bf16x4_t*)(TINVm + n * 16 + 4 * g), w1f, (f32x4){0.f, 0.f, 0.f, 0.f}, 0, 0, 0);
            const bf16x4_t uf = pack4(U[0], U[1], U[2], U[3]);
            Yc = __builtin_amdgcn_mfma_f32_16x16x16bf16_1k(*(const LAS bf16x4_t*)(RBm + n * 16 + 4 * g), uf, Yc, 0, 0, 0);
            Yc = __builtin_amdgcn_mfma_f32_16x16x16bf16_1k(*(const LAS bf16x4_t*)(RKm + n * 16 + 4 * g), vfr, Yc, 0, 0, 0);
#pragma unroll
            for (int r = 0; r < 4; ++r) YRm[(4 * g + r) * 64 + key] = Yc[r];
#pragma unroll
            for (int kb = 0; kb < 4; ++kb) { const f32x4 gt = *(const LAS f32x4*)(GTm + 16 * kb + 4 * g); f32x4 a = ST[kb] * gt;
                a = __builtin_amdgcn_mfma_f32_16x16x16bf16_1k(*(const LAS bf16x4_t*)(BHt + (16 * kb + n) * 16 + 4 * g), uf, a, 0, 0, 0);
                a = __builtin_amdgcn_mfma_f32_16x16x16bf16_1k(*(const LAS bf16x4_t*)(KHt + (16 * kb + n) * 16 + 4 * g), vfr, a, 0, 0, 0);
                ST[kb] = a; }
        }
        RK_BAR();
    }
    RK_STAGE_F(256, wave); RK_STAGE_F(256, wave + 8);
    asm volatile("s_waitcnt vmcnt(0)" ::: "memory");
    RK_BAR();
#undef RK_DMA
#undef RK_STAGE_A
#undef RK_STAGE_F
}

__device__ __forceinline__ f32x4 sk_dot(const bf16_t* a, const bf16_t* b, int nsteps) {
    f32x4 acc = (f32x4){0.f, 0.f, 0.f, 0.f};
#pragma unroll 8
    for (int s = 0; s < nsteps; ++s) { const bf16x8_t av = *(const bf16x8_t*)(a + 32 * s), bv = *(const bf16x8_t*)(b + 32 * s); acc = __builtin_amdgcn_mfma_f32_16x16x32_bf16(av, bv, acc, 0, 0, 0); }
    return acc; }
__device__ __forceinline__ void meta_rs(const float* ssm, int lane, float (&rs)[4]) {
    const int row = lane & 15, part = lane >> 4; float s = 0.f;
#pragma unroll 8
    for (int i = 0; i < 32; ++i) s += ssm[(part + 4 * i) * 16 + row];
    s = s + __shfl_xor(s, 16); s = s + __shfl_xor(s, 32);
    const float rv = __builtin_amdgcn_rsqf(s * (1.0f / 2048.0f) + 1e-6f);
#pragma unroll
    for (int r = 0; r < 4; ++r) rs[r] = __shfl(rv, 4 * part + r); }
#define SK_HEAD const int tid = ltid(), lane = tid & 63, wave = __builtin_amdgcn_readfirstlane(tid >> 6), n = lane & 15, g = lane >> 4, kq = wave & 3, ti = lbid() + 256 * (wave >> 2); LAS f32x4* part = (LAS f32x4*)lds;
#define SK_COMBINE(dst, slot) do { dst = (part[((wave) * 2 + (slot)) * 64 + lane] + part[((wave + 1) * 2 + (slot)) * 64 + lane]) + (part[((wave + 2) * 2 + (slot)) * 64 + lane] + part[((wave + 3) * 2 + (slot)) * 64 + lane]); } while (0)
__device__ __forceinline__ void skinny_gu(const bf16_t* hb, const bf16_t* Bt, const float* ssm, bf16_t* act, LAS unsigned char* lds) {
    using namespace cfg; SK_HEAD
    if (ti < DFF / 16) { const int c0 = 16 * ti, brow = (c0 >> 7) * 256 + (c0 & 127) + n; const bf16_t* a = hb + (size_t)(MMAIN + n) * DM + 512 * kq + 8 * g;
        part[(wave * 2) * 64 + lane] = sk_dot(a, Bt + (size_t)brow * DM + 512 * kq + 8 * g, 16); part[(wave * 2 + 1) * 64 + lane] = sk_dot(a, Bt + (size_t)(brow + 128) * DM + 512 * kq + 8 * g, 16); }
    __syncthreads();
    if (ti < DFF / 16 && kq == 0) { f32x4 gt, up; SK_COMBINE(gt, 0); SK_COMBINE(up, 1); float rs[4]; meta_rs(ssm, lane, rs);
#pragma unroll
        for (int r = 0; r < 4; ++r) { const float gv = gt[r] * rs[r], uv = up[r] * rs[r]; act[(size_t)(MMAIN + 4 * g + r) * DFF + 16 * ti + n] = bf1(gv * __builtin_amdgcn_rcpf(1.0f + __builtin_amdgcn_exp2f(-1.4426950408889634f * gv)) * uv); } }
    __syncthreads();
}
__device__ __forceinline__ void skinny_res(const bf16_t* A16, int K, const bf16_t* Bt, bf16_t* hb, float* ssm_out, float alpha, LAS unsigned char* lds) {
    using namespace cfg;
    const int tid = ltid(), lane = tid & 63, wave = __builtin_amdgcn_readfirstlane(tid >> 6), n = lane & 15, g = lane >> 4, ti = lbid(); LAS f32x4* part = (LAS f32x4*)lds;
    const int k8 = K / 8;
    if (ti < DM / 16) part[wave * 64 + lane] = sk_dot(A16 + (size_t)n * K + k8 * wave + 8 * g, Bt + (size_t)(16 * ti + n) * K + k8 * wave + 8 * g, k8 / 32);
    __syncthreads();
    if (ti < DM / 16 && wave == 0) { const f32x4 acc = ((part[lane] + part[64 + lane]) + (part[128 + lane] + part[192 + lane])) + ((part[256 + lane] + part[320 + lane]) + (part[384 + lane] + part[448 + lane]));
#pragma unroll
        for (int r = 0; r < 4; ++r) { const int m = 4 * g + r, col = 16 * ti + n; bf16_t* p = hb + (size_t)(MMAIN + m) * DM + col; const float hv = bf2f(*p) + alpha * acc[r]; *p = bf1(hv);
            const float sq = row_sum16(hv * hv); if (n == 0) ssm_out[ti * 16 + m] = sq; } }
    __syncthreads();
}
__device__ __forceinline__ void skinny_p(const bf16_t* hb, const bf16_t* Bt, const float* ssm, bf16_t* pr, float* ps, bf16_t* qkv, LAS unsigned char* lds) {
    using namespace cfg; SK_HEAD
    if (ti < NIN / 16) part[(wave * 2) * 64 + lane] = sk_dot(hb + (size_t)(MMAIN + n) * DM + 512 * kq + 8 * g, Bt + (size_t)(16 * ti + n) * DM + 512 * kq + 8 * g, 16);
    __syncthreads();
    if (ti < NIN / 16 && kq == 0) { f32x4 acc; SK_COMBINE(acc, 0); float rs[4]; meta_rs(ssm, lane, rs); const int np = 16 * ti + n;
#pragma unroll
        for (int r = 0; r < 4; ++r) { const int m = 4 * g + r; const float v = acc[r] * rs[r];
            if (np < 3072) pr[(size_t)(MMAIN + m) * PRW + np] = bf1(v);
            else if (np < 3584) ps[(size_t)(MMAIN + m) * PSW + (np - 3072)] = v;
            else { const bf16_t w = bf1(v);
#pragma unroll
                for (int b = 0; b < NBATCH; ++b) qkv[((size_t)b * SEQP + 48 + m) * QKVW + (np - 3584)] = w; } } }
    __syncthreads();
}
#undef SK_HEAD
#undef SK_COMBINE

namespace fox {
constexpr int D = 128, NW = 8, QBLK = 32, KVBLK = 64, QB = NW * QBLK;
constexpr int LDQ = cfg::QKVW, LDK = cfg::QKVW, LDO = cfg::DM;
constexpr float SCALE = 0.08838834764831845f, THR = 8.f;
constexpr bool WSKIP = false;
constexpr int SHM_V = KVBLK * D * 2, SHM_K = KVBLK * D * 2;
constexpr int ATT_LDS = 2 * SHM_V + 2 * SHM_K + NW * 64 * 4;
constexpr int BIAS_OFF = ATT_LDS;
constexpr int SCAN_OFF = BIAS_OFF + cfg::SEQP * 4;

using bf16 = __hip_bfloat16;
typedef short bf16x8 __attribute__((ext_vector_type(8)));
typedef short s16x4 __attribute__((ext_vector_type(4)));
typedef float f32x16 __attribute__((ext_vector_type(16)));
typedef float f32x4 __attribute__((ext_vector_type(4)));
typedef unsigned u32x4 __attribute__((ext_vector_type(4)));
template <class A, class Bt> struct same_t { static constexpr bool v = false; };
template <class A> struct same_t<A, A> { static constexpr bool v = true; };

#define KSWZ(row, colB) ((row) * 256 + ((colB) ^ (((row) & 7) << 4)))
#define SBAR() __builtin_amdgcn_sched_barrier(0)
__device__ __forceinline__ int v_st(int k, int c) { const int kk = (k & ~0xC) | ((k & 4) << 1) | ((k & 8) >> 1); return ((kk >> 3) * 4 + (c >> 5)) * 512 + ((kk & 7) * 32 + (c & 31)) * 2; }
__device__ __forceinline__ int v_rd_base(int lane) { return ((lane & 3) << 3) | (((lane >> 2) & 3) << 6) | (((lane >> 4) & 1) << 5) | (((lane >> 5) & 1) << 8); }
constexpr int v_rd_off(int d0, int ks, int half) { return d0 * 512 + ks * 4096 + half * 2048; }
__device__ __forceinline__ int crow(int r, int hi) { return (r & 3) + 8 * (r >> 2) + 4 * hi; }
__device__ __forceinline__ unsigned cvtpk(float lo, float hi) {
    unsigned r; asm volatile("v_cvt_pk_bf16_f32 %0, %1, %2" : "=v"(r) : "v"(lo), "v"(hi)); return r;
}
__device__ __forceinline__ bf16x8 pack8(f32x4 a, f32x4 b) {
    u32x4 w = {cvtpk(a[0], a[1]), cvtpk(a[2], a[3]), cvtpk(b[0], b[1]), cvtpk(b[2], b[3])};
    return *reinterpret_cast<bf16x8*>(&w);
}
template <class T> __device__ __forceinline__ bf16x8 load8(const T* p) {
    if constexpr (same_t<T, float>::v) { return pack8(*(const f32x4*)p, *(const f32x4*)(p + 4)); }
    else { return *reinterpret_cast<const bf16x8*>(p); }
}
__device__ __forceinline__ void mask_tile(f32x16& p0, f32x16& p1, int dq, unsigned W) {
    const float NEG = -__builtin_inff();
#pragma unroll
    for (int r = 0; r < 16; ++r) {
        const int c = (r & 3) + 8 * (r >> 2);
        if ((unsigned)(dq - c) >= W) p0[r] = NEG;
        if ((unsigned)(dq - c - 32) >= W) p1[r] = NEG;
    }
}
__device__ __forceinline__ void partialSM(f32x16& p0, f32x16& p1, float& m_reg, float& mn, float& alpha) {
    float pmax = p0[0]; for (int r = 1; r < 16; ++r) pmax = fmaxf(pmax, p0[r]); for (int r = 0; r < 16; ++r) pmax = fmaxf(pmax, p1[r]);
    { auto rr = __builtin_amdgcn_permlane32_swap(__float_as_uint(pmax), __float_as_uint(pmax), false, false);
      pmax = fmaxf(__uint_as_float(rr[0]), __uint_as_float(rr[1])); }
    constexpr float C2 = 1.4426950408889634f * SCALE;
    if (__builtin_expect(__all((pmax - m_reg) * SCALE <= THR), 1)) { mn = m_reg; alpha = 1.f; }
    else { mn = fmaxf(m_reg, pmax); alpha = __builtin_amdgcn_exp2f((m_reg - mn) * C2); m_reg = mn; }
    const float mnL = -mn * C2;
    for (int r = 0; r < 16; ++r) p0[r] = fmaf(p0[r], C2, mnL); for (int r = 0; r < 16; ++r) p1[r] = fmaf(p1[r], C2, mnL);
    for (int r = 0; r < 16; ++r) p0[r] = __builtin_amdgcn_exp2f(p0[r]);
}
__device__ __forceinline__ void finishSM(f32x16& p0, f32x16& p1, float alpha, float& l_reg, bf16x8& pa0, bf16x8& pa1, bf16x8& pa2, bf16x8& pa3) {
    for (int r = 0; r < 16; ++r) p1[r] = __builtin_amdgcn_exp2f(p1[r]);
    float ps = 0; for (int r = 0; r < 16; ++r) ps += p0[r]; for (int r = 0; r < 16; ++r) ps += p1[r];
    { auto rr = __builtin_amdgcn_permlane32_swap(__float_as_uint(ps), __float_as_uint(ps), false, false);
      ps = __uint_as_float(rr[0]) + __uint_as_float(rr[1]); }
    l_reg = l_reg * alpha + ps;
#define PK4(P, B_, OUT) do { unsigned a0 = cvtpk(P[B_+0], P[B_+1]), a1 = cvtpk(P[B_+2], P[B_+3]);                          \
        unsigned b0 = cvtpk(P[B_+4], P[B_+5]), b1 = cvtpk(P[B_+6], P[B_+7]);                                             \
        auto r0 = __builtin_amdgcn_permlane32_swap(a0, b0, false, false); auto r1 = __builtin_amdgcn_permlane32_swap(a1, b1, false, false); \
        u32x4 w = {r0[0], r1[0], r0[1], r1[1]}; OUT = *reinterpret_cast<bf16x8*>(&w); } while (0)
    PK4(p0, 0, pa0); PK4(p0, 8, pa1); PK4(p1, 0, pa2); PK4(p1, 8, pa3);
#undef PK4
}
template <int KB, bool SK>
__device__ __forceinline__ void qkt(f32x16& p0, f32x16& p1, const char* K_lds, int r32, int hi, const bf16x8* qr, bool act, const float* bias_t) {
    if (SK && !act) { const float NEG = -__builtin_inff();
#pragma unroll
        for (int r = 0; r < 16; ++r) { p0[r] = NEG; p1[r] = NEG; } return; }
    {
#pragma unroll
        for (int g_ = 0; g_ < 4; ++g_) { const f32x4 b0_ = *(const f32x4*)(bias_t + 8 * g_ + 4 * hi); const f32x4 b1_ = *(const f32x4*)(bias_t + 32 + 8 * g_ + 4 * hi);
            p0[4 * g_] = b0_[0]; p0[4 * g_ + 1] = b0_[1]; p0[4 * g_ + 2] = b0_[2]; p0[4 * g_ + 3] = b0_[3];
            p1[4 * g_] = b1_[0]; p1[4 * g_ + 1] = b1_[1]; p1[4 * g_ + 2] = b1_[2]; p1[4 * g_ + 3] = b1_[3]; } }
    const char* kb[4];
#pragma unroll
    for (int dd = 0; dd < 4; ++dd) kb[dd] = K_lds + KB * SHM_K + KSWZ(r32, (dd * 16 + hi * 8) * 2);
#pragma unroll
    for (int d0 = 0; d0 < 8; ++d0) { const char* a = kb[d0 & 3] + (d0 >> 2) * 128;
        bf16x8 b0 = *reinterpret_cast<const bf16x8*>(a);
        bf16x8 b1 = *reinterpret_cast<const bf16x8*>(a + 32 * 256);
        p0 = __builtin_amdgcn_mfma_f32_32x32x16_bf16(b0, qr[d0], p0, 0, 0, 0);
        p1 = __builtin_amdgcn_mfma_f32_32x32x16_bf16(b1, qr[d0], p1, 0, 0, 0); }
}
template <int VB, bool SK>
__device__ __forceinline__ void pv_tile(f32x16* o, int vb0, bf16x8 pa0, bf16x8 pa1, bf16x8 pa2, bf16x8 pa3, bool act) {
    if (SK && !act) return;
#define TRRD(dst, off) asm volatile("ds_read_b64_tr_b16 %0, %1 offset:%2" : "=&v"(dst) : "v"(vb0), "i"(off) : "memory")
#define PV_D0(d0) do { s16x4 l0, l1, l2, l3, h0, h1, h2, h3; constexpr int b_ = VB * SHM_V + v_rd_off(d0, 0, 0);     \
        TRRD(l0, b_); TRRD(h0, b_ + 2048); TRRD(l1, b_ + 4096); TRRD(h1, b_ + 6144); TRRD(l2, b_ + 8192); TRRD(h2, b_ + 10240); TRRD(l3, b_ + 12288); TRRD(h3, b_ + 14336); \
        asm volatile("s_waitcnt lgkmcnt(0)" ::: "memory"); SBAR();                 \
        o[d0] = __builtin_amdgcn_mfma_f32_32x32x16_bf16(pa0, (bf16x8){l0[0], l0[1], l0[2], l0[3], h0[0], h0[1], h0[2], h0[3]}, o[d0], 0, 0, 0);   \
        o[d0] = __builtin_amdgcn_mfma_f32_32x32x16_bf16(pa1, (bf16x8){l1[0], l1[1], l1[2], l1[3], h1[0], h1[1], h1[2], h1[3]}, o[d0], 0, 0, 0);   \
        o[d0] = __builtin_amdgcn_mfma_f32_32x32x16_bf16(pa2, (bf16x8){l2[0], l2[1], l2[2], l2[3], h2[0], h2[1], h2[2], h2[3]}, o[d0], 0, 0, 0);   \
        o[d0] = __builtin_amdgcn_mfma_f32_32x32x16_bf16(pa3, (bf16x8){l3[0], l3[1], l3[2], l3[3], h3[0], h3[1], h3[2], h3[3]}, o[d0], 0, 0, 0); } while (0)
    PV_D0(0); PV_D0(1); PV_D0(2); PV_D0(3);
#undef PV_D0
#undef TRRD
}

template <class TIn, class TOut> struct BlockRef { const TIn* Q; const TIn* K; const TIn* V; TOut* O; int P0; };
template <class TIn> struct Seam {
    bf16x8 qr[8];
    bf16x8 st_v0, st_v1, st_k0, st_k1; f32x4 sf0, sf1, sf2, sf3;
    f32x4 tq[16];
};
__device__ __forceinline__ int swa_jlo(int P0, int W) { const int lowk = P0 - W + 1; return lowk > 0 ? lowk / KVBLK : 0; }
#define ROW(p, k0, rr) ((p) + (size_t)((k0) + (rr)) * LDK + sc)
#define VMW() asm volatile("s_waitcnt vmcnt(0)" ::: "memory")
#define VMWN(n) asm volatile("s_waitcnt vmcnt(%0)" :: "i"(n) : "memory")
#define SLOAD_H(Kp, Vp, k0) do { S.st_v0 = load8<TIn>(ROW(Vp, k0, sr)); S.st_v1 = load8<TIn>(ROW(Vp, k0, 32 + sr));              \
                         S.st_k0 = load8<TIn>(ROW(Kp, k0, sr)); S.st_k1 = load8<TIn>(ROW(Kp, k0, 32 + sr)); } while (0)
#define SWRITE_HK(bf) do { *(bf16x8*)(K_lds + (bf) * SHM_K + kws) = S.st_k0; *(bf16x8*)(K_lds + (bf) * SHM_K + kws + 32 * 256) = S.st_k1; } while (0)
#define SWRITE_HV(bf) do { *(bf16x8*)(V_lds + (bf) * SHM_V + vst0) = S.st_v0; *(bf16x8*)(V_lds + (bf) * SHM_V + vst1) = S.st_v1; } while (0)
#define SWRITE_H(bf) do { SWRITE_HV(bf); SWRITE_HK(bf); } while (0)
#define SLOAD_F(p, k0) do { S.sf0 = *(const f32x4*)ROW(p, k0, sr); S.sf1 = *(const f32x4*)(ROW(p, k0, sr) + 4);                \
                            S.sf2 = *(const f32x4*)ROW(p, k0, 32 + sr); S.sf3 = *(const f32x4*)(ROW(p, k0, 32 + sr) + 4); } while (0)
#define SWRITE_KF(bf) do { *(bf16x8*)(K_lds + (bf) * SHM_K + kws) = pack8(S.sf0, S.sf1); *(bf16x8*)(K_lds + (bf) * SHM_K + kws + 32 * 256) = pack8(S.sf2, S.sf3); } while (0)
#define SWRITE_VF(bf) do { *(bf16x8*)(V_lds + (bf) * SHM_V + vst0) = pack8(S.sf0, S.sf1); *(bf16x8*)(V_lds + (bf) * SHM_V + vst1) = pack8(S.sf2, S.sf3); } while (0)
template <class TIn, class TOut>
__device__ __forceinline__ void causal_swa_prime(const BlockRef<TIn, TOut>& cur, int W, char* lds, Seam<TIn>& S) {
    constexpr bool F32 = same_t<TIn, float>::v;
    const int tid = ltid(), wid = __builtin_amdgcn_readfirstlane(tid >> 6), lane = tid & 63, r32 = lane & 31, hi = lane >> 5;
    const int sr = tid >> 4, sc = (tid & 15) * 8, kws = KSWZ(sr, sc * 2); char* K_lds = lds + 2 * SHM_V;
    const int kb0 = swa_jlo(cur.P0, W) * KVBLK;
    for (int d0 = 0; d0 < 8; ++d0) S.qr[d0] = load8<TIn>(cur.Q + (size_t)(wid * QBLK + r32) * LDQ + d0 * 16 + hi * 8);
    if constexpr (F32) { SLOAD_F((const float*)cur.K, kb0); VMW(); SWRITE_KF(0); SBAR(); SLOAD_F((const float*)cur.V, kb0); }
    else { SLOAD_H(cur.K, cur.V, kb0); VMW(); SWRITE_HK(0); }
    __syncthreads();
}
template <class TIn, class TOut>
__device__ __forceinline__ void causal_swa_block(const BlockRef<TIn, TOut>& cur, const BlockRef<TIn, TOut>& nxt, int skv, int W, char* lds, Seam<TIn>& S, const float* bias_l) {
    constexpr bool F32 = same_t<TIn, float>::v;
    const int tid = ltid(), wid = __builtin_amdgcn_readfirstlane(tid >> 6), lane = tid & 63, r32 = lane & 31, hi = lane >> 5;
    const int j_lo = swa_jlo(cur.P0, W);
    int j_hi = (cur.P0 + QB - 1) / KVBLK + 1; if (j_hi > skv / KVBLK) j_hi = skv / KVBLK;
    const int NT = j_hi - j_lo;
    const int kbn = swa_jlo(nxt.P0, W) * KVBLK;
    const int qlo = cur.P0 + wid * QBLK, qm = qlo + r32 - 4 * hi;
    char* V_lds = lds; char* K_lds = lds + 2 * SHM_V;
    float* ws = (float*)(lds + 2 * SHM_V + 2 * SHM_K) + wid * 64; float* li_l = ws, * al_l = ws + 32;
    float m_reg = -1e30f, l_reg = 0; f32x16 o[4] = {};
    const int sr = tid >> 4, sc = (tid & 15) * 8, vst0 = v_st(sr, sc), vst1 = v_st(32 + sr, sc), kws = KSWZ(sr, sc * 2);
    const int vb0 = (int)(uintptr_t)V_lds + v_rd_base(lane);
    const TIn* Kh = cur.K; const TIn* Vh = cur.V;
#define RESC(a) do { if (__any((a) < 1.f)) { if (hi == 0) al_l[r32] = (a); asm volatile("s_waitcnt lgkmcnt(0)" ::: "memory");              \
                     for (int d_ = 0; d_ < 4; ++d_) for (int r = 0; r < 16; ++r) o[d_][r] *= al_l[crow(r, hi)]; } } while (0)
#define KBASE(t) ((j_lo + (t)) * KVBLK)
#define ACT(t) (KBASE(t) <= qlo + QBLK - 1 && KBASE(t) + KVBLK - 1 >= qlo - W + 1)
#define MASKT(P0_, P1_, t) do { const int kb_ = KBASE(t); if ((!SK || ACT(t)) && (kb_ + KVBLK - 1 > qlo || kb_ <= qlo + QBLK - 1 - W)) mask_tile(P0_, P1_, qm - kb_, (unsigned)W); } while (0)
    constexpr int NQL = F32 ? 16 : 8;
    constexpr bool SK = WSKIP && !F32;
#define SEAM_K0() do { VMWN(NQL); if constexpr (F32) { SWRITE_KF(0); SBAR(); SLOAD_F((const float*)nxt.V, kbn); } else { SWRITE_HK(0); } SBAR(); } while (0)
    f32x16 pA0, pA1, pB0, pB1; float mnA, mnB, alA, alB; bf16x8 pa0, pa1, pa2, pa3;
    if constexpr (F32) { VMW(); SWRITE_VF(0); SBAR(); } else { SWRITE_HV(0); SBAR(); }
    if (NT > 1) { if constexpr (F32) SLOAD_F((const float*)Kh, KBASE(1)); else SLOAD_H(Kh, Vh, KBASE(1)); }
    SBAR(); qkt<0, SK>(pA0, pA1, K_lds, r32, hi, S.qr, ACT(0), bias_l + KBASE(0));
    if constexpr (F32) { if (NT > 1) { VMW(); SWRITE_KF(1); SBAR(); SLOAD_F((const float*)Vh, KBASE(1)); } }
    MASKT(pA0, pA1, 0); partialSM(pA0, pA1, m_reg, mnA, alA);
    if (NT > 1) { VMW(); if constexpr (F32) { SWRITE_VF(1); SBAR(); if (NT > 2) SLOAD_F((const float*)Kh, KBASE(2)); } else SWRITE_H(1); }
    __syncthreads();
#define HALF_STEP(PX0, PX1, mnX, alX, PY0, PY1, alY, t, KB, VB, SB) do {                                                      \
        SBAR(); qkt<KB, SK>(PX0, PX1, K_lds, r32, hi, S.qr, ACT(t), bias_l + KBASE(t));                                             \
        finishSM(PY0, PY1, alY, l_reg, pa0, pa1, pa2, pa3); SBAR();                                                           \
        if ((t) + 1 < NT) { if constexpr (F32) { VMW(); SWRITE_KF(SB); SBAR(); SLOAD_F((const float*)Vh, KBASE((t) + 1)); }  \
                            else { SLOAD_H(Kh, Vh, KBASE((t) + 1)); } SBAR(); }                                               \
        pv_tile<VB, SK>(o, vb0, pa0, pa1, pa2, pa3, ACT((t) - 1)); MASKT(PX0, PX1, (t)); partialSM(PX0, PX1, m_reg, mnX, alX);                                        \
        __syncthreads();                                                                                                      \
        if ((t) + 1 < NT) { VMW(); if constexpr (F32) { SWRITE_VF(SB); SBAR(); if ((t) + 2 < NT) SLOAD_F((const float*)Kh, KBASE((t) + 2)); } \
                            else { SWRITE_H(SB); } }                                                                          \
        RESC(alX); __syncthreads(); } while (0)
    for (int t = 1; t + 1 < NT; t += 2) {
        HALF_STEP(pB0, pB1, mnB, alB, pA0, pA1, alA, t, 1, 0, 0);
        HALF_STEP(pA0, pA1, mnA, alA, pB0, pB1, alB, t + 1, 0, 1, 1);
    }
    const bool even = (NT & 1) == 0;
    if (even) { SBAR(); qkt<1, SK>(pB0, pB1, K_lds, r32, hi, S.qr, ACT(NT - 1), bias_l + KBASE(NT - 1)); SBAR(); }
#define QROW(e) (nxt.Q + (size_t)(wid * QBLK + r32) * LDQ + ((e) >> 1) * 16 + hi * 8 + ((e) & 1) * 4)
    if constexpr (F32) { SLOAD_F((const float*)nxt.K, kbn); SBAR();
#pragma unroll
        for (int e = 0; e < 8; ++e) S.tq[e] = *(const f32x4*)QROW(e); }
    else { SLOAD_H(nxt.K, nxt.V, kbn); SBAR();
#pragma unroll
        for (int d0 = 0; d0 < 8; ++d0) S.qr[d0] = load8<TIn>(nxt.Q + (size_t)(wid * QBLK + r32) * LDQ + d0 * 16 + hi * 8); }
    SBAR();
    finishSM(pA0, pA1, alA, l_reg, pa0, pa1, pa2, pa3); SBAR();
    if constexpr (F32) {
#pragma unroll
        for (int e = 8; e < 16; ++e) S.tq[e] = *(const f32x4*)QROW(e); SBAR(); }
#undef QROW
    pv_tile<0, SK>(o, vb0, pa0, pa1, pa2, pa3, ACT(even ? NT - 2 : NT - 1));
    if (even) { MASKT(pB0, pB1, NT - 1); partialSM(pB0, pB1, m_reg, mnB, alB); __syncthreads(); RESC(alB);
        finishSM(pB0, pB1, alB, l_reg, pa0, pa1, pa2, pa3); SBAR(); pv_tile<1, SK>(o, vb0, pa0, pa1, pa2, pa3, ACT(NT - 1)); }
    SBAR(); SEAM_K0();
    if (hi == 0) li_l[r32] = l_reg; asm volatile("s_waitcnt lgkmcnt(0)" ::: "memory");
    float rli[16];
#pragma unroll
    for (int r = 0; r < 16; ++r) rli[r] = __builtin_amdgcn_rcpf(li_l[crow(r, hi)]);
    TOut* Ow = cur.O + (size_t)(wid * QBLK) * LDO;
#pragma unroll
    for (int r = 0; r < 16; ++r) { const int orow = crow(r, hi);
#pragma unroll
        for (int d0 = 0; d0 < 4; ++d0) { const float v = o[d0][r] * rli[r];
            if constexpr (same_t<TOut, float>::v) { Ow[(size_t)orow * LDO + d0 * 32 + r32] = v; }
            else { const float vn = __shfl_xor(v, 1);
                   if ((r32 & 1) == 0) *(unsigned*)(Ow + (size_t)orow * LDO + d0 * 32 + r32) = cvtpk(v, vn); } } }
    if constexpr (F32) {
#pragma unroll
        for (int d0 = 0; d0 < 8; ++d0) S.qr[d0] = pack8(S.tq[2 * d0], S.tq[2 * d0 + 1]); }
    __syncthreads();
#undef RESC
#undef KBASE
#undef ACT
#undef MASKT
#undef SEAM_K0
#undef HALF_STEP
}
#undef ROW
#undef VMW
#undef VMWN
#undef SLOAD_H
#undef SWRITE_HK
#undef SWRITE_HV
#undef SWRITE_H
#undef SLOAD_F
#undef SWRITE_KF

}

__device__ __forceinline__ void fox_bias(PP P, int l, int b, int h, float* bias, float* scr) {
    using namespace cfg;
    const int tid = ltid(), lane = tid & 63, wave = tid >> 6;
    const float* PS = (const float*)(P->ws + WS_PS); const float bf = P->in[I_BF][l * FNH + h];
    float lf[9]; float loc = 0.f;
#pragma unroll
    for (int i = 0; i < 9; ++i) { const int pos = tid * 9 + i; float v = 0.f;
        if (pos < NMETA + SEQ) { const int row = pos < NMETA ? MMAIN + pos : b * SEQ + pos - NMETA; const float z = PS[(size_t)row * PSW + 288 + h] + bf;
            v = fminf(z, 0.f) - log1pf(__expf(-fabsf(z))); }
        loc += v; lf[i] = loc; }
    float inc = loc;
#pragma unroll
    for (int o = 1; o < 64; o <<= 1) { const float t = __shfl_up(inc, o); if (lane >= o) inc += t; }
    if (lane == 63) scr[wave] = inc;
    __syncthreads();
    float base = inc - loc;
    for (int w = 0; w < wave; ++w) base += scr[w];
    constexpr float INV = 1.0f / fox::SCALE;
#pragma unroll
    for (int i = 0; i < 9; ++i) { const int pos = tid * 9 + i; if (pos < NMETA + SEQ) bias[48 + pos] = -(base + lf[i]) * INV; }
    if (tid < 48) bias[tid] = -__builtin_inff();
    __syncthreads();
}
__device__ __forceinline__ void fox_meta(PP P, int h, const float* bias) {
    using namespace cfg;
    const int lane = ltid() & 63, wave = ltid() >> 6;
    const bf16_t* QKV = (const bf16_t*)(P->ws + WS_QKV); bf16_t* Y = (bf16_t*)(P->ws + WS_Y);
    for (int rep = 0; rep < 2; ++rep) { const int i = wave + 8 * rep;
        float s = -__builtin_inff();
        if (lane <= i) { const bf16_t* q = QKV + (size_t)(48 + i) * QKVW + h * 128; const bf16_t* k = QKV + (size_t)(48 + lane) * QKVW + 1024 + h * 128; float dot = 0.f;
            for (int d = 0; d < 128; ++d) dot += bf2f(q[d]) * bf2f(k[d]);
            s = (dot + bias[48 + lane]) * fox::SCALE; }
        const float m = wave_max(s); const float p = (lane <= i) ? __expf(s - m) : 0.f; const float lsum = wave_sum(p);
        float o0 = 0.f, o1 = 0.f;
        for (int j = 0; j <= i; ++j) { const float pj = __shfl(p, j); const bf16_t* v = QKV + (size_t)(48 + j) * QKVW + 2048 + h * 128; o0 += pj * bf2f(v[lane]); o1 += pj * bf2f(v[64 + lane]); }
        const float il = 1.0f / lsum;
        Y[(size_t)(MMAIN + i) * DM + 1024 + h * 128 + lane] = (bf16_t)(pk_bf16(o0 * il, 0.f) & 0xffffu);
        Y[(size_t)(MMAIN + i) * DM + 1024 + h * 128 + 64 + lane] = (bf16_t)(pk_bf16(o1 * il, 0.f) & 0xffffu); }
}
__device__ __forceinline__ fox::BlockRef<__hip_bfloat16, __hip_bfloat16> fox_mk(int a, int idx, const __hip_bfloat16* Qb, const __hip_bfloat16* Kb, const __hip_bfloat16* Vb, __hip_bfloat16* Ob) {
    const int pr = 4 * (a & 1) + (idx >> 1); const int x = (idx & 1) ? 15 - pr : pr;
    fox::BlockRef<__hip_bfloat16, __hip_bfloat16> r; r.Q = Qb + (size_t)x * 256 * cfg::QKVW; r.K = Kb; r.V = Vb; r.O = Ob + (size_t)x * 256 * cfg::DM; r.P0 = 64 + 256 * x; return r; }
__device__ __forceinline__ void fox_wg(PP P, int l, int a, char* lds) {
    using namespace cfg;
    typedef __hip_bfloat16 bf;
    const int bh = a >> 1, b = bh >> 3, h = bh & 7;
    float* bias = (float*)(lds + fox::BIAS_OFF); float* scr = (float*)(lds + fox::SCAN_OFF);
    fox_bias(P, l, b, h, bias, scr);
    const bf* QKV = (const bf*)(P->ws + WS_QKV); bf* Y = (bf*)(P->ws + WS_Y);
    const bf* Kb = QKV + (size_t)b * SEQP * QKVW + 1024 + h * 128; const bf* Vb = Kb + 1024; const bf* Qb = QKV + ((size_t)b * SEQP + 64) * QKVW + h * 128;
    bf* Ob = Y + (size_t)b * SEQ * DM + 1024 + h * 128;
    constexpr int W = 1 << 30;
    fox::Seam<bf> S;
    fox::BlockRef<bf, bf> cur = fox_mk(a, 0, Qb, Kb, Vb, Ob);
    fox::causal_swa_prime<bf, bf>(cur, W, lds, S);
#pragma unroll 1
    for (int idx = 0; idx < 8; ++idx) {
        const fox::BlockRef<bf, bf> nxt = (idx < 7) ? fox_mk(a, idx + 1, Qb, Kb, Vb, Ob) : cur;
        fox::causal_swa_block<bf, bf>(cur, nxt, SEQP, W, lds, S, bias);
        cur = nxt;
    }
    if (b == 0) fox_meta(P, h, bias);
}

#define WS_PTR(T, off) ((T*)(Q->ws + (off)))
#define SEAM() do { PP Qb_ = launder(P); XcdBarrier b_; b_.bar = (unsigned*)(Qb_->ws + WS_CTL); b_.x = xb_xcc_id(); b_.st = (volatile LAS unsigned*)(lds + LDS_BARW); xcd_barrier(b_); } while (0)
__global__ void __launch_bounds__(512, 2) hymba_fwd(Params Pv) {
    using namespace cfg;
    PP P = (PP)__builtin_amdgcn_kernarg_segment_ptr();
    extern __shared__ __attribute__((aligned(16))) unsigned char lds_raw[];
    LAS unsigned char* lds = (LAS unsigned char*)lds_raw;
    if (threadIdx.x < 4) ((LAS unsigned*)(lds + LDS_BARW))[threadIdx.x] = 0u;
    __syncthreads();
    { PP Q = launder(P); (void)xcd_barrier_post((unsigned*)(Q->ws + WS_CTL), (volatile LAS unsigned*)(lds + LDS_BARW)); }

    { PP Q = launder(P); phase_convert(Q, lds, 0, 1, lbid(), (int)gridDim.x); phase_init(Q); }
    SEAM();
    {
        PP Q = launder(P); const unsigned char* wl = Q->ws + WS_W + (size_t)0 * W_LAYER;
        pg8::Gemm g{WS_PTR(const bf16_t, WS_HB), (const bf16_t*)(wl + WO_GU1), MMAIN, NGU, DM}; pg8::StaticOrder S; S.init(MMAIN, NGU, (int)gridDim.x, lbid());
        pg8::EpiGU E{WS_PTR(bf16_t, WS_ACT), WS_PTR(const float, WS_SS) + (size_t)(0) * 8 * MROWS, (LAS float*)(lds + 131072 + 4096)};
        pg8::gemm_phase<pg8::EpiGU, pg8::StaticOrder, true, true>(lds, g, S, E);
        skinny_gu(WS_PTR(const bf16_t, WS_HB), g.Bt, WS_PTR(const float, WS_SSM) + (0) * 2048, WS_PTR(bf16_t, WS_ACT), lds);
    }
    SEAM();
    {
        PP Q = launder(P); const unsigned char* wl = Q->ws + WS_W + (size_t)0 * W_LAYER;
        pg8::Gemm g{WS_PTR(const bf16_t, WS_ACT), (const bf16_t*)(wl + WO_D1), MMAIN, DM, DFF}; pg8::StaticOrder S; S.init(MMAIN, DM, (int)gridDim.x, lbid());
        pg8::EpiRes E{WS_PTR(bf16_t, WS_HB), WS_PTR(float, WS_SS) + (size_t)(1) * 8 * MROWS, 0.5f, (LAS float*)(lds + 131072)};
        pg8::gemm_phase<pg8::EpiRes, pg8::StaticOrder, true, true>(lds, g, S, E);
        skinny_res(WS_PTR(const bf16_t, WS_ACT) + (size_t)MMAIN * DFF, DFF, g.Bt, WS_PTR(bf16_t, WS_HB), WS_PTR(float, WS_SSM) + (1) * 2048, 0.5f, lds);
    }
    SEAM();
    {
        PP Q = launder(P); const unsigned char* wl = Q->ws + WS_W + (size_t)0 * W_LAYER;
        pg8::Gemm g{WS_PTR(const bf16_t, WS_HB), (const bf16_t*)(wl + WO_IN), MMAIN, NIN, DM}; pg8::StaticOrder S; S.init(MMAIN, NIN, (int)gridDim.x, lbid());
        pg8::EpiP E{WS_PTR(bf16_t, WS_PR), WS_PTR(float, WS_PS), WS_PTR(bf16_t, WS_QKV), WS_PTR(const float, WS_SS) + (size_t)(1) * 8 * MROWS, (LAS float*)(lds + 131072 + 4096)};
        pg8::gemm_phase<pg8::EpiP, pg8::StaticOrder, true, true>(lds, g, S, E);
        skinny_p(WS_PTR(const bf16_t, WS_HB), g.Bt, WS_PTR(const float, WS_SSM) + (1) * 2048, WS_PTR(bf16_t, WS_PR), WS_PTR(float, WS_PS), WS_PTR(bf16_t, WS_QKV), lds);
    }
    SEAM();
    { PP Q = launder(P); phase_lx(Q, 0); }
    SEAM();
    {
        PP Q = launder(P); const int u = lbid();
        if (u < 128) { rwkv_chunked(Q, 0, u >> 4, u & 15, lds); __syncthreads(); phase_convert(launder(P), lds, 1, 2, u, 128, 17024, 21248); }
        else { fox_wg(Q, 0, u - 128, (char*)lds_raw); __syncthreads(); phase_convert(launder(P), lds, 1, 2, u - 128, 128, 0, 17024); }
    }
    SEAM();
    { PP Q = launder(P); phase_foxnorm(Q); }
    SEAM();
    {
        PP Q = launder(P); const unsigned char* wl = Q->ws + WS_W + (size_t)0 * W_LAYER;
        pg8::Gemm g{WS_PTR(const bf16_t, WS_Y), (const bf16_t*)(wl + WO_OUT), MMAIN, DM, DM}; pg8::StaticOrder S; S.init(MMAIN, DM, (int)gridDim.x, lbid());
        pg8::EpiRes E{WS_PTR(bf16_t, WS_HB), WS_PTR(float, WS_SS) + (size_t)(2) * 8 * MROWS, 1.0f, (LAS float*)(lds + 131072)};
        pg8::gemm_phase<pg8::EpiRes, pg8::StaticOrder, true, true>(lds, g, S, E);
        skinny_res(WS_PTR(const bf16_t, WS_Y) + (size_t)MMAIN * DM, DM, g.Bt, WS_PTR(bf16_t, WS_HB), WS_PTR(float, WS_SSM) + (2) * 2048, 1.0f, lds);
    }
    SEAM();
    {
        PP Q = launder(P); const unsigned char* wl = Q->ws + WS_W + (size_t)0 * W_LAYER;
        pg8::Gemm g{WS_PTR(const bf16_t, WS_HB), (const bf16_t*)(wl + WO_GU2), MMAIN, NGU, DM}; pg8::StaticOrder S; S.init(MMAIN, NGU, (int)gridDim.x, lbid());
        pg8::EpiGU E{WS_PTR(bf16_t, WS_ACT), WS_PTR(const float, WS_SS) + (size_t)(2) * 8 * MROWS, (LAS float*)(lds + 131072 + 4096)};
        pg8::gemm_phase<pg8::EpiGU, pg8::StaticOrder, true, true>(lds, g, S, E);
        skinny_gu(WS_PTR(const bf16_t, WS_HB), g.Bt, WS_PTR(const float, WS_SSM) + (2) * 2048, WS_PTR(bf16_t, WS_ACT), lds);
    }
    SEAM();
    {
        PP Q = launder(P); const unsigned char* wl = Q->ws + WS_W + (size_t)0 * W_LAYER;
        pg8::Gemm g{WS_PTR(const bf16_t, WS_ACT), (const bf16_t*)(wl + WO_D2), MMAIN, DM, DFF}; pg8::StaticOrder S; S.init(MMAIN, DM, (int)gridDim.x, lbid());
        pg8::EpiRes E{WS_PTR(bf16_t, WS_HB), WS_PTR(float, WS_SS) + (size_t)(3) * 8 * MROWS, 0.5f, (LAS float*)(lds + 131072)};
        pg8::gemm_phase<pg8::EpiRes, pg8::StaticOrder, true, true>(lds, g, S, E);
        skinny_res(WS_PTR(const bf16_t, WS_ACT) + (size_t)MMAIN * DFF, DFF, g.Bt, WS_PTR(bf16_t, WS_HB), WS_PTR(float, WS_SSM) + (3) * 2048, 0.5f, lds);
    }
    SEAM();
    {
        PP Q = launder(P); const unsigned char* wl = Q->ws + WS_W + (size_t)1 * W_LAYER;
        pg8::Gemm g{WS_PTR(const bf16_t, WS_HB), (const bf16_t*)(wl + WO_GU1), MMAIN, NGU, DM}; pg8::StaticOrder S; S.init(MMAIN, NGU, (int)gridDim.x, lbid());
        pg8::EpiGU E{WS_PTR(bf16_t, WS_ACT), WS_PTR(const float, WS_SS) + (size_t)(3) * 8 * MROWS, (LAS float*)(lds + 131072 + 4096)};
        pg8::gemm_phase<pg8::EpiGU, pg8::StaticOrder, true, true>(lds, g, S, E);
        skinny_gu(WS_PTR(const bf16_t, WS_HB), g.Bt, WS_PTR(const float, WS_SSM) + (3) * 2048, WS_PTR(bf16_t, WS_ACT), lds);
    }
    SEAM();
    {
        PP Q = launder(P); const unsigned char* wl = Q->ws + WS_W + (size_t)1 * W_LAYER;
        pg8::Gemm g{WS_PTR(const bf16_t, WS_ACT), (const bf16_t*)(wl + WO_D1), MMAIN, DM, DFF}; pg8::StaticOrder S; S.init(MMAIN, DM, (int)gridDim.x, lbid());
        pg8::EpiRes E{WS_PTR(bf16_t, WS_HB), WS_PTR(float, WS_SS) + (size_t)(4) * 8 * MROWS, 0.5f, (LAS float*)(lds + 131072)};
        pg8::gemm_phase<pg8::EpiRes, pg8::StaticOrder, true, true>(lds, g, S, E);
        skinny_res(WS_PTR(const bf16_t, WS_ACT) + (size_t)MMAIN * DFF, DFF, g.Bt, WS_PTR(bf16_t, WS_HB), WS_PTR(float, WS_SSM) + (4) * 2048, 0.5f, lds);
    }
    SEAM();
    {
        PP Q = launder(P); const unsigned char* wl = Q->ws + WS_W + (size_t)1 * W_LAYER;
        pg8::Gemm g{WS_PTR(const bf16_t, WS_HB), (const bf16_t*)(wl + WO_IN), MMAIN, NIN, DM}; pg8::StaticOrder S; S.init(MMAIN, NIN, (int)gridDim.x, lbid());
        pg8::EpiP E{WS_PTR(bf16_t, WS_PR), WS_PTR(float, WS_PS), WS_PTR(bf16_t, WS_QKV), WS_PTR(const float, WS_SS) + (size_t)(4) * 8 * MROWS, (LAS float*)(lds + 131072 + 4096)};
        pg8::gemm_phase<pg8::EpiP, pg8::StaticOrder, true, true>(lds, g, S, E);
        skinny_p(WS_PTR(const bf16_t, WS_HB), g.Bt, WS_PTR(const float, WS_SSM) + (4) * 2048, WS_PTR(bf16_t, WS_PR), WS_PTR(float, WS_PS), WS_PTR(bf16_t, WS_QKV), lds);
    }
    SEAM();
    { PP Q = launder(P); phase_lx(Q, 1); }
    SEAM();
    {
        PP Q = launder(P); const int u = lbid();
        if (u < 128) { rwkv_chunked(Q, 1, u >> 4, u & 15, lds); __syncthreads(); phase_convert(launder(P), lds, 2, 3, u, 128, 17024, 21248); }
        else { fox_wg(Q, 1, u - 128, (char*)lds_raw); __syncthreads(); phase_convert(launder(P), lds, 2, 3, u - 128, 128, 0, 17024); }
    }
    SEAM();
    { PP Q = launder(P); phase_foxnorm(Q); }
    SEAM();
    {
        PP Q = launder(P); const unsigned char* wl = Q->ws + WS_W + (size_t)1 * W_LAYER;
        pg8::Gemm g{WS_PTR(const bf16_t, WS_Y), (const bf16_t*)(wl + WO_OUT), MMAIN, DM, DM}; pg8::StaticOrder S; S.init(MMAIN, DM, (int)gridDim.x, lbid());
        pg8::EpiRes E{WS_PTR(bf16_t, WS_HB), WS_PTR(float, WS_SS) + (size_t)(5) * 8 * MROWS, 1.0f, (LAS float*)(lds + 131072)};
        pg8::gemm_phase<pg8::EpiRes, pg8::StaticOrder, true, true>(lds, g, S, E);
        skinny_res(WS_PTR(const bf16_t, WS_Y) + (size_t)MMAIN * DM, DM, g.Bt, WS_PTR(bf16_t, WS_HB), WS_PTR(float, WS_SSM) + (5) * 2048, 1.0f, lds);
    }
    SEAM();
    {
        PP Q = launder(P); const unsigned char* wl = Q->ws + WS_W + (size_t)1 * W_LAYER;
        pg8::Gemm g{WS_PTR(const bf16_t, WS_HB), (const bf16_t*)(wl + WO_GU2), MMAIN, NGU, DM}; pg8::StaticOrder S; S.init(MMAIN, NGU, (int)gridDim.x, lbid());
        pg8::EpiGU E{WS_PTR(bf16_t, WS_ACT), WS_PTR(const float, WS_SS) + (size_t)(5) * 8 * MROWS, (LAS float*)(lds + 131072 + 4096)};
        pg8::gemm_phase<pg8::EpiGU, pg8::StaticOrder, true, true>(lds, g, S, E);
        skinny_gu(WS_PTR(const bf16_t, WS_HB), g.Bt, WS_PTR(const float, WS_SSM) + (5) * 2048, WS_PTR(bf16_t, WS_ACT), lds);
    }
    SEAM();
    {
        PP Q = launder(P); const unsigned char* wl = Q->ws + WS_W + (size_t)1 * W_LAYER;
        pg8::Gemm g{WS_PTR(const bf16_t, WS_ACT), (const bf16_t*)(wl + WO_D2), MMAIN, DM, DFF}; pg8::StaticOrder S; S.init(MMAIN, DM, (int)gridDim.x, lbid());
        pg8::EpiRes E{WS_PTR(bf16_t, WS_HB), WS_PTR(float, WS_SS) + (size_t)(6) * 8 * MROWS, 0.5f, (LAS float*)(lds + 131072)};
        pg8::gemm_phase<pg8::EpiRes, pg8::StaticOrder, true, true>(lds, g, S, E);
        skinny_res(WS_PTR(const bf16_t, WS_ACT) + (size_t)MMAIN * DFF, DFF, g.Bt, WS_PTR(bf16_t, WS_HB), WS_PTR(float, WS_SSM) + (6) * 2048, 0.5f, lds);
    }
    SEAM();
    {
        PP Q = launder(P); const unsigned char* wl = Q->ws + WS_W + (size_t)2 * W_LAYER;
        pg8::Gemm g{WS_PTR(const bf16_t, WS_HB), (const bf16_t*)(wl + WO_GU1), MMAIN, NGU, DM}; pg8::StaticOrder S; S.init(MMAIN, NGU, (int)gridDim.x, lbid());
        pg8::EpiGU E{WS_PTR(bf16_t, WS_ACT), WS_PTR(const float, WS_SS) + (size_t)(6) * 8 * MROWS, (LAS float*)(lds + 131072 + 4096)};
        pg8::gemm_phase<pg8::EpiGU, pg8::StaticOrder, true, true>(lds, g, S, E);
        skinny_gu(WS_PTR(const bf16_t, WS_HB), g.Bt, WS_PTR(const float, WS_SSM) + (6) * 2048, WS_PTR(bf16_t, WS_ACT), lds);
    }
    SEAM();
    {
        PP Q = launder(P); const unsigned char* wl = Q->ws + WS_W + (size_t)2 * W_LAYER;
        pg8::Gemm g{WS_PTR(const bf16_t, WS_ACT), (const bf16_t*)(wl + WO_D1), MMAIN, DM, DFF}; pg8::StaticOrder S; S.init(MMAIN, DM, (int)gridDim.x, lbid());
        pg8::EpiRes E{WS_PTR(bf16_t, WS_HB), WS_PTR(float, WS_SS) + (size_t)(7) * 8 * MROWS, 0.5f, (LAS float*)(lds + 131072)};
        pg8::gemm_phase<pg8::EpiRes, pg8::StaticOrder, true, true>(lds, g, S, E);
        skinny_res(WS_PTR(const bf16_t, WS_ACT) + (size_t)MMAIN * DFF, DFF, g.Bt, WS_PTR(bf16_t, WS_HB), WS_PTR(float, WS_SSM) + (7) * 2048, 0.5f, lds);
    }
    SEAM();
    {
        PP Q = launder(P); const unsigned char* wl = Q->ws + WS_W + (size_t)2 * W_LAYER;
        pg8::Gemm g{WS_PTR(const bf16_t, WS_HB), (const bf16_t*)(wl + WO_IN), MMAIN, NIN, DM}; pg8::StaticOrder S; S.init(MMAIN, NIN, (int)gridDim.x, lbid());
        pg8::EpiP E{WS_PTR(bf16_t, WS_PR), WS_PTR(float, WS_PS), WS_PTR(bf16_t, WS_QKV), WS_PTR(const float, WS_SS) + (size_t)(7) * 8 * MROWS, (LAS float*)(lds + 131072 + 4096)};
        pg8::gemm_phase<pg8::EpiP, pg8::StaticOrder, true, true>(lds, g, S, E);
        skinny_p(WS_PTR(const bf16_t, WS_HB), g.Bt, WS_PTR(const float, WS_SSM) + (7) * 2048, WS_PTR(bf16_t, WS_PR), WS_PTR(float, WS_PS), WS_PTR(bf16_t, WS_QKV), lds);
    }
    SEAM();
    { PP Q = launder(P); phase_lx(Q, 2); }
    SEAM();
    {
        PP Q = launder(P); const int u = lbid();
        if (u < 128) { rwkv_chunked(Q, 2, u >> 4, u & 15, lds); __syncthreads(); phase_convert(launder(P), lds, 3, 4, u, 128, 17024, 21248); }
        else { fox_wg(Q, 2, u - 128, (char*)lds_raw); __syncthreads(); phase_convert(launder(P), lds, 3, 4, u - 128, 128, 0, 17024); }
    }
    SEAM();
    { PP Q = launder(P); phase_foxnorm(Q); }
    SEAM();
    {
        PP Q = launder(P); const unsigned char* wl = Q->ws + WS_W + (size_t)2 * W_LAYER;
        pg8::Gemm g{WS_PTR(const bf16_t, WS_Y), (const bf16_t*)(wl + WO_OUT), MMAIN, DM, DM}; pg8::StaticOrder S; S.init(MMAIN, DM, (int)gridDim.x, lbid());
        pg8::EpiRes E{WS_PTR(bf16_t, WS_HB), WS_PTR(float, WS_SS) + (size_t)(8) * 8 * MROWS, 1.0f, (LAS float*)(lds + 131072)};
        pg8::gemm_phase<pg8::EpiRes, pg8::StaticOrder, true, true>(lds, g, S, E);
        skinny_res(WS_PTR(const bf16_t, WS_Y) + (size_t)MMAIN * DM, DM, g.Bt, WS_PTR(bf16_t, WS_HB), WS_PTR(float, WS_SSM) + (8) * 2048, 1.0f, lds);
    }
    SEAM();
    {
        PP Q = launder(P); const unsigned char* wl = Q->ws + WS_W + (size_t)2 * W_LAYER;
        pg8::Gemm g{WS_PTR(const bf16_t, WS_HB), (const bf16_t*)(wl + WO_GU2), MMAIN, NGU, DM}; pg8::StaticOrder S; S.init(MMAIN, NGU, (int)gridDim.x, lbid());
        pg8::EpiGU E{WS_PTR(bf16_t, WS_ACT), WS_PTR(const float, WS_SS) + (size_t)(8) * 8 * MROWS, (LAS float*)(lds + 131072 + 4096)};
        pg8::gemm_phase<pg8::EpiGU, pg8::StaticOrder, true, true>(lds, g, S, E);
        skinny_gu(WS_PTR(const bf16_t, WS_HB), g.Bt, WS_PTR(const float, WS_SSM) + (8) * 2048, WS_PTR(bf16_t, WS_ACT), lds);
    }
    SEAM();
    {
        PP Q = launder(P); const unsigned char* wl = Q->ws + WS_W + (size_t)2 * W_LAYER;
        pg8::Gemm g{WS_PTR(const bf16_t, WS_ACT), (const bf16_t*)(wl + WO_D2), MMAIN, DM, DFF}; pg8::StaticOrder S; S.init(MMAIN, DM, (int)gridDim.x, lbid());
        pg8::EpiRes E{WS_PTR(bf16_t, WS_HB), WS_PTR(float, WS_SS) + (size_t)(9) * 8 * MROWS, 0.5f, (LAS float*)(lds + 131072)};
        pg8::gemm_phase<pg8::EpiRes, pg8::StaticOrder, true, true>(lds, g, S, E);
        skinny_res(WS_PTR(const bf16_t, WS_ACT) + (size_t)MMAIN * DFF, DFF, g.Bt, WS_PTR(bf16_t, WS_HB), WS_PTR(float, WS_SSM) + (9) * 2048, 0.5f, lds);
    }
    SEAM();
    {
        PP Q = launder(P); const unsigned char* wl = Q->ws + WS_W + (size_t)3 * W_LAYER;
        pg8::Gemm g{WS_PTR(const bf16_t, WS_HB), (const bf16_t*)(wl + WO_GU1), MMAIN, NGU, DM}; pg8::StaticOrder S; S.init(MMAIN, NGU, (int)gridDim.x, lbid());
        pg8::EpiGU E{WS_PTR(bf16_t, WS_ACT), WS_PTR(const float, WS_SS) + (size_t)(9) * 8 * MROWS, (LAS float*)(lds + 131072 + 4096)};
        pg8::gemm_phase<pg8::EpiGU, pg8::StaticOrder, true, true>(lds, g, S, E);
        skinny_gu(WS_PTR(const bf16_t, WS_HB), g.Bt, WS_PTR(const float, WS_SSM) + (9) * 2048, WS_PTR(bf16_t, WS_ACT), lds);
    }
    SEAM();
    {
        PP Q = launder(P); const unsigned char* wl = Q->ws + WS_W + (size_t)3 * W_LAYER;
        pg8::Gemm g{WS_PTR(const bf16_t, WS_ACT), (const bf16_t*)(wl + WO_D1), MMAIN, DM, DFF}; pg8::StaticOrder S; S.init(MMAIN, DM, (int)gridDim.x, lbid());
        pg8::EpiRes E{WS_PTR(bf16_t, WS_HB), WS_PTR(float, WS_SS) + (size_t)(10) * 8 * MROWS, 0.5f, (LAS float*)(lds + 131072)};
        pg8::gemm_phase<pg8::EpiRes, pg8::StaticOrder, true, true>(lds, g, S, E);
        skinny_res(WS_PTR(const bf16_t, WS_ACT) + (size_t)MMAIN * DFF, DFF, g.Bt, WS_PTR(bf16_t, WS_HB), WS_PTR(float, WS_SSM) + (10) * 2048, 0.5f, lds);
    }
    SEAM();
    {
        PP Q = launder(P); const unsigned char* wl = Q->ws + WS_W + (size_t)3 * W_LAYER;
        pg8::Gemm g{WS_PTR(const bf16_t, WS_HB), (const bf16_t*)(wl + WO_IN), MMAIN, NIN, DM}; pg8::StaticOrder S; S.init(MMAIN, NIN, (int)gridDim.x, lbid());
        pg8::EpiP E{WS_PTR(bf16_t, WS_PR), WS_PTR(float, WS_PS), WS_PTR(bf16_t, WS_QKV), WS_PTR(const float, WS_SS) + (size_t)(10) * 8 * MROWS, (LAS float*)(lds + 131072 + 4096)};
        pg8::gemm_phase<pg8::EpiP, pg8::StaticOrder, true, true>(lds, g, S, E);
        skinny_p(WS_PTR(const bf16_t, WS_HB), g.Bt, WS_PTR(const float, WS_SSM) + (10) * 2048, WS_PTR(bf16_t, WS_PR), WS_PTR(float, WS_PS), WS_PTR(bf16_t, WS_QKV), lds);
    }
    SEAM();
    { PP Q = launder(P); phase_lx(Q, 3); }
    SEAM();
    {
        PP Q = launder(P); const int u = lbid();
        if (u < 128) { rwkv_chunked(Q, 3, u >> 4, u & 15, lds); }
        else { fox_wg(Q, 3, u - 128, (char*)lds_raw);  }
    }
    SEAM();
    { PP Q = launder(P); phase_foxnorm(Q); }
    SEAM();
    {
        PP Q = launder(P); const unsigned char* wl = Q->ws + WS_W + (size_t)3 * W_LAYER;
        pg8::Gemm g{WS_PTR(const bf16_t, WS_Y), (const bf16_t*)(wl + WO_OUT), MMAIN, DM, DM}; pg8::StaticOrder S; S.init(MMAIN, DM, (int)gridDim.x, lbid());
        pg8::EpiRes E{WS_PTR(bf16_t, WS_HB), WS_PTR(float, WS_SS) + (size_t)(11) * 8 * MROWS, 1.0f, (LAS float*)(lds + 131072)};
        pg8::gemm_phase<pg8::EpiRes, pg8::StaticOrder, true, true>(lds, g, S, E);
        skinny_res(WS_PTR(const bf16_t, WS_Y) + (size_t)MMAIN * DM, DM, g.Bt, WS_PTR(bf16_t, WS_HB), WS_PTR(float, WS_SSM) + (11) * 2048, 1.0f, lds);
    }
    SEAM();
    {
        PP Q = launder(P); const unsigned char* wl = Q->ws + WS_W + (size_t)3 * W_LAYER;
        pg8::Gemm g{WS_PTR(const bf16_t, WS_HB), (const bf16_t*)(wl + WO_GU2), MMAIN, NGU, DM}; pg8::StaticOrder S; S.init(MMAIN, NGU, (int)gridDim.x, lbid());
        pg8::EpiGU E{WS_PTR(bf16_t, WS_ACT), WS_PTR(const float, WS_SS) + (size_t)(11) * 8 * MROWS, (LAS float*)(lds + 131072 + 4096)};
        pg8::gemm_phase<pg8::EpiGU, pg8::StaticOrder, true, true>(lds, g, S, E);
        skinny_gu(WS_PTR(const bf16_t, WS_HB), g.Bt, WS_PTR(const float, WS_SSM) + (11) * 2048, WS_PTR(bf16_t, WS_ACT), lds);
    }
    SEAM();
    {
        PP Q = launder(P); const unsigned char* wl = Q->ws + WS_W + (size_t)3 * W_LAYER;
        pg8::Gemm g{WS_PTR(const bf16_t, WS_ACT), (const bf16_t*)(wl + WO_D2), MMAIN, DM, DFF}; pg8::StaticOrder S; S.init(MMAIN, DM, (int)gridDim.x, lbid());
        pg8::EpiRes E{WS_PTR(bf16_t, WS_HB), WS_PTR(float, WS_SS) + (size_t)(12) * 8 * MROWS, 0.5f, (LAS float*)(lds + 131072)};
        pg8::gemm_phase<pg8::EpiRes, pg8::StaticOrder, true, true>(lds, g, S, E);
        skinny_res(WS_PTR(const bf16_t, WS_ACT) + (size_t)MMAIN * DFF, DFF, g.Bt, WS_PTR(bf16_t, WS_HB), WS_PTR(float, WS_SSM) + (12) * 2048, 0.5f, lds);
    }
    SEAM();
    { PP Q = launder(P); phase_final(Q); }
}

extern "C" void kernel_launch(void* const* d_in, const int* in_sizes, int n_in, void* d_out, int out_size, void* d_ws, size_t ws_size, hipStream_t stream) {
    using namespace cfg;
    static int grid = 0;
    if (grid == 0) {
        if (n_in != 25 || out_size != MMAIN * DM || ws_size < WS_END) { fprintf(stderr, "kernel_launch: need 25 inputs, out %d, ws >= %zu; got n_in %d out %d ws %zu\n", MMAIN * DM, (size_t)WS_END, n_in, out_size, ws_size); grid = -1; return; }
        int dev = 0, cus = 0, per_cu = 0;
        if (hipGetDevice(&dev) != hipSuccess || hipDeviceGetAttribute(&cus, hipDeviceAttributeMultiprocessorCount, dev) != hipSuccess) { grid = -1; return; }
        if (hipFuncSetAttribute((const void*)hymba_fwd, hipFuncAttributeMaxDynamicSharedMemorySize, LDS_BYTES) != hipSuccess) { fprintf(stderr, "kernel_launch: hipFuncSetAttribute failed\n"); grid = -1; return; }
        if (hipOccupancyMaxActiveBlocksPerMultiprocessor(&per_cu, (const void*)hymba_fwd, 512, LDS_BYTES) != hipSuccess || per_cu < 1) fprintf(stderr, "kernel_launch: occupancy query says %d\n", per_cu);
        (void)hipGetLastError();
        if (cus < 256) { fprintf(stderr, "kernel_launch: built for a 256-CU device (one resident workgroup per CU), found %d CUs\n", cus); grid = -1; return; }
        grid = 256;
    }
    if (grid < 0) return;
    if (hipMemsetAsync((char*)d_ws + WS_CTL, 0, CTL_BYTES, stream) != hipSuccess) return;
    Params p{};
    for (int i = 0; i < 25; ++i) p.in[i] = (const float*)d_in[i];
    p.out = (float*)d_out; p.ws = (unsigned char*)d_ws; p.ph_lo = 0; p.ph_hi = 0;
    hipLaunchKernelGGL(hymba_fwd, dim3(grid), dim3(512), LDS_BYTES, stream, p);
}
```

```cpp
#include <hip/hip_runtime.h>
#include <hip/hip_bf16.h>
#include <cstdio>
#include <cstdint>

#define LAS __attribute__((address_space(3)))
namespace cfg {
constexpr int DM = 2048, NBATCH = 8, SEQ = 4096, NMETA = 16, DEPTH = 4;
constexpr int MMAIN = NBATCH * SEQ;
constexpr int MROWS = MMAIN + 256;
constexpr int DFF = 5632, NGU = 2 * DFF;
constexpr int RW = 1024, RH = 64, RNH = 16;
constexpr int FW = 1024, FH = 128, FNH = 8;
constexpr int RWKV_COLS = 3360, DIN = 6440;
constexpr int NIN = 6656;
constexpr int PRW = 3072, PSW = 512, QKVW = 3072;
constexpr int SEQP = 4160;
constexpr float NORM_EPS = 1e-6f, LNX_EPS = 64e-5f;
constexpr int NSS = 13;
constexpr size_t al256(size_t x) { return (x + 255) & ~(size_t)255; }
constexpr size_t WS_CTL = 0;
constexpr size_t CTL_BYTES = 65536;
constexpr size_t WS_SS = WS_CTL + CTL_BYTES;
constexpr size_t SS_BYTES = al256((size_t)NSS * 8 * MROWS * 4);
constexpr size_t ZERO_BYTES = CTL_BYTES + SS_BYTES;
constexpr size_t WS_SSM = WS_SS + SS_BYTES;
constexpr size_t SSM_BYTES = (size_t)NSS * 2048 * 4;
constexpr size_t WS_HMETA = WS_SSM + SSM_BYTES;
constexpr size_t WS_HB = WS_HMETA + (size_t)256 * DM * 4;
constexpr size_t WS_Y = WS_HB + (size_t)MROWS * DM * 2;
constexpr size_t WS_OVL = WS_Y + (size_t)MROWS * DM * 2;
constexpr size_t WS_ACT = WS_OVL;
constexpr size_t WS_PR = WS_OVL;
constexpr size_t WS_PS = WS_PR + (size_t)MROWS * PRW * 2;
constexpr size_t WS_QKV = WS_PS + (size_t)MROWS * PSW * 4;
constexpr size_t OVL_A = (size_t)MROWS * DFF * 2, OVL_B = (size_t)MROWS * PRW * 2 + (size_t)MROWS * PSW * 4 + (size_t)NBATCH * SEQP * QKVW * 2;
constexpr size_t WS_W = WS_OVL + al256(OVL_A > OVL_B ? OVL_A : OVL_B);
constexpr size_t W_GU = (size_t)NGU * DM * 2, W_D = (size_t)DM * DFF * 2, W_IN = (size_t)NIN * DM * 2, W_OUT = (size_t)DM * DM * 2;
constexpr size_t WO_GU1 = 0, WO_D1 = WO_GU1 + W_GU, WO_IN = WO_D1 + W_D, WO_OUT = WO_IN + W_IN, WO_GU2 = WO_OUT + W_OUT, WO_D2 = WO_GU2 + W_GU, W_LAYER = WO_D2 + W_D;
constexpr size_t WS_LXG = WS_W + (size_t)DEPTH * W_LAYER;
constexpr size_t WS_END = WS_LXG + (size_t)MROWS * 320 * 2;
constexpr int LDS_BYTES = 147456;
constexpr int LDS_BARW = LDS_BYTES - 16;
}
__device__ __forceinline__ int ltid() { int t = (int)threadIdx.x; asm volatile("" : "+v"(t)); return t; }
__device__ __forceinline__ int lbid() { int t = (int)blockIdx.x; asm volatile("" : "+s"(t)); return t; }
__device__ __forceinline__ int lzero() { int t = 0; asm volatile("" : "+v"(t)); return t; }
namespace pg8 {
#define PG8_LAS __attribute__((address_space(3)))
typedef unsigned short bf16_t;
typedef short bf16x8 __attribute__((ext_vector_type(8)));
typedef float f32x4 __attribute__((ext_vector_type(4)));
typedef unsigned u32x4 __attribute__((ext_vector_type(4)));
constexpr int BM = 256, BK = 64, HALF = 128, HTB = HALF * BK * 2  , STAGE_BYTES = 8 * HTB, NXCD = 8, WGM = 4;

__host__ __device__ __forceinline__ int lds_byte(int r, int c) { const int st = (r >> 4) * 2 + (c >> 5), rr = r & 15, cc = c & 31, ob = rr * 64 + cc * 2; return st * 1024 + (ob ^ (((ob >> 9) & 1) << 5)); }
__host__ __device__ __forceinline__ void stage_rc(int b, int& R, int& C) { const int st = b / 1024, sb = b % 1024, swz = sb ^ (((sb >> 9) & 1) << 5); R = (st >> 1) * 16 + swz / 64; C = (st & 1) * 32 + (swz % 64) / 2; }
__host__ __device__ __forceinline__ int perm32(int rho) { const int n = rho >> 4, i = rho & 15; return 8 * (i >> 2) + 4 * n + (i & 3); }

struct Unit { int pm, pn; };
struct Gemm { const bf16_t* A; const bf16_t* Bt; int M, N, K; };

struct StaticOrder {
    int nM, nN, nwg, G, c, wgm, rev;
    __host__ __device__ void init(int M, int N, int G_, int c_, int wgm_ = WGM, int rev_ = 0) { nM = M / BM; nN = N / BM; nwg = nM * nN; G = G_; c = c_; wgm = wgm_; rev = rev_; }
    __host__ __device__ bool next(int i, Unit& u) const {
        const int nr = (nwg + G - 1) / G; if (i >= nr) return false;
        const long L = (long)(rev ? nr - 1 - i : i) * G + c; if (L >= nwg) return false;
        int wgid = (int)L; { const int q = nwg / NXCD, r = nwg % NXCD, xcd = wgid % NXCD, off = wgid / NXCD; wgid = (xcd < r ? xcd * (q + 1) : r * (q + 1) + (xcd - r) * q) + off; }
        const int nig = wgm * nN, gid = wgid / nig, fm = gid * wgm, gsz = (nM - fm) < wgm ? (nM - fm) : wgm;
        u.pm = fm + ((wgid % nig) % gsz); u.pn = (wgid % nig) / gsz; return true;
    }
    __device__ __forceinline__ void a_ready(const Unit&) const {}
    __device__ __forceinline__ void done(const Unit&) const {}
};

__device__ __forceinline__ unsigned cvt_pk_bf16(float lo, float hi) { unsigned r; asm volatile("v_cvt_pk_bf16_f32 %0, %1, %2" : "=v"(r) : "v"(lo), "v"(hi)); return r; }
typedef float f32x2 __attribute__((ext_vector_type(2)));
__device__ __forceinline__ f32x2 gelu_pk(f32x2 v) {
    const f32x2 av = __builtin_elementwise_abs(v), d = av * 0.2316418882f + 1.0f;
    f32x2 t; t.x = __builtin_amdgcn_rcpf(d.x); t.y = __builtin_amdgcn_rcpf(d.y);
    f32x2 q = t * 0.5307027145f + (-0.7265760135f); q = q * t + 0.7107068705f; q = q * t + (-0.142248368f); q = q * t + 0.127414796f; q = q * t;
    const f32x2 s = (v * v) * (-0.72134752044f);
    f32x2 e; e.x = __builtin_amdgcn_exp2f(s.x); e.y = __builtin_amdgcn_exp2f(s.y);
    const f32x2 m = v * (q * e), r = v - m;
    f32x2 o; o.x = v.x < 0.f ? m.x : r.x; o.y = v.y < 0.f ? m.y : r.y; return o;
}
__device__ __forceinline__ float rs_of(const float* ss, int row) { float s = 0.f;
#pragma unroll
    for (int t = 0; t < 8; ++t) s += ss[(size_t)t * 33024 + row];
    return __builtin_amdgcn_rsqf(s * (1.0f / 2048.0f) + 1e-6f); }
__device__ __forceinline__ float silu_f(float x) { return x * __builtin_amdgcn_rcpf(1.0f + __builtin_amdgcn_exp2f(-1.4426950408889634f * x)); }

struct EpiGU {
    static constexpr bool PERM = true, AFTER_DRAIN = false; static constexpr int NVM = 8;
    bf16_t* act; const float* ss; PG8_LAS float* rsb;
    __device__ __forceinline__ void operator()(const f32x4 (&acc)[2][2][4][2], const Unit& u, int wr, int wc, int fr, int fq, bool newpanel) const {
        if (newpanel) {
            if (wr == 0) { const int rl = wc * 64 + fq * 16 + fr; rsb[rl] = rs_of(ss, u.pm * BM + rl); }
            asm volatile("s_waitcnt lgkmcnt(0)" ::: "memory"); __builtin_amdgcn_s_barrier(); asm volatile("" ::: "memory"); }
        const int rl0 = wr * 64 + fr, row0 = u.pm * BM + rl0, col0 = u.pn * 128 + wc * 32 + 8 * fq;
#pragma unroll
        for (int ai = 0; ai < 2; ++ai)
#pragma unroll
            for (int m = 0; m < 4; ++m) { const int row = row0 + ai * HALF + m * 16; const float rs = rsb[rl0 + ai * HALF + m * 16];
                const f32x4 g0 = acc[ai][0][m][0] * rs, g1 = acc[ai][0][m][1] * rs, u0 = acc[ai][1][m][0] * rs, u1 = acc[ai][1][m][1] * rs;
                u32x4 w;
                w.x = cvt_pk_bf16(silu_f(g0[0]) * u0[0], silu_f(g0[1]) * u0[1]); w.y = cvt_pk_bf16(silu_f(g0[2]) * u0[2], silu_f(g0[3]) * u0[3]);
                w.z = cvt_pk_bf16(silu_f(g1[0]) * u1[0], silu_f(g1[1]) * u1[1]); w.w = cvt_pk_bf16(silu_f(g1[2]) * u1[2], silu_f(g1[3]) * u1[3]);
                *(u32x4*)(act + (size_t)row * 5632 + col0) = w; }
    }
};
struct EpiRes {
    static constexpr bool PERM = true, AFTER_DRAIN = false; static constexpr int NVM = 32;
    bf16_t* hb; float* ssn; float alpha; PG8_LAS float* red;
    __device__ __forceinline__ void operator()(const f32x4 (&acc)[2][2][4][2], const Unit& u, int wr, int wc, int fr, int fq, bool) const {
        bf16_t* bbase = hb + (size_t)u.pm * BM * 2048;
        const int rl0 = wr * 64 + fr; unsigned off = (unsigned)(rl0 * 2048 + u.pn * BM + wc * 32 + 8 * fq);
#pragma unroll
        for (int ai = 0; ai < 2; ++ai) {
            u32x4 hv[4][2];
#pragma unroll
            for (int m = 0; m < 4; ++m)
#pragma unroll
                for (int bj = 0; bj < 2; ++bj) hv[m][bj] = *(const u32x4*)(bbase + (off + (unsigned)((ai * HALF + m * 16) * 2048) + bj * HALF));
#pragma unroll
            for (int m = 0; m < 4; ++m) { const unsigned o = off + (unsigned)((ai * HALF + m * 16) * 2048); float sq = 0.f;
#pragma unroll
                for (int bj = 0; bj < 2; ++bj) { const u32x4 x = hv[m][bj];
                    const f32x4 h0 = (f32x4){__uint_as_float(x.x << 16), __uint_as_float(x.x & 0xffff0000u), __uint_as_float(x.y << 16), __uint_as_float(x.y & 0xffff0000u)} + acc[ai][bj][m][0] * alpha;
                    const f32x4 h1 = (f32x4){__uint_as_float(x.z << 16), __uint_as_float(x.z & 0xffff0000u), __uint_as_float(x.w << 16), __uint_as_float(x.w & 0xffff0000u)} + acc[ai][bj][m][1] * alpha;
                    sq += ((h0[0] * h0[0] + h0[1] * h0[1]) + (h0[2] * h0[2] + h0[3] * h0[3])) + ((h1[0] * h1[0] + h1[1] * h1[1]) + (h1[2] * h1[2] + h1[3] * h1[3]));
                    u32x4 w; w.x = cvt_pk_bf16(h0[0], h0[1]); w.y = cvt_pk_bf16(h0[2], h0[3]); w.z = cvt_pk_bf16(h1[0], h1[1]); w.w = cvt_pk_bf16(h1[2], h1[3]); *(u32x4*)(bbase + o + bj * HALF) = w; }
                sq += __shfl_xor(sq, 16); sq += __shfl_xor(sq, 32);
                if (fq == 0) red[(rl0 + ai * HALF + m * 16) * 4 + wc] = sq; }
            asm volatile("" ::: "memory"); }
        asm volatile("s_waitcnt lgkmcnt(0)" ::: "memory"); __builtin_amdgcn_s_barrier(); asm volatile("" ::: "memory");
        if (wr == 0) { const int row = wc * 64 + fq * 16 + fr; const float s4 = (red[row * 4] + red[row * 4 + 1]) + (red[row * 4 + 2] + red[row * 4 + 3]); ssn[(size_t)u.pn * 33024 + u.pm * BM + row] = s4; }
    }
};
struct EpiP {
    static constexpr bool PERM = true, AFTER_DRAIN = false; static constexpr int NVM = 16;
    bf16_t* pr; float* ps; bf16_t* qkv; const float* ss; PG8_LAS float* rsb;
    __device__ __forceinline__ void operator()(const f32x4 (&acc)[2][2][4][2], const Unit& u, int wr, int wc, int fr, int fq, bool newpanel) const {
        if (newpanel) {
            if (wr == 0) { const int rl = wc * 64 + fq * 16 + fr; rsb[rl] = rs_of(ss, u.pm * BM + rl); }
            asm volatile("s_waitcnt lgkmcnt(0)" ::: "memory"); __builtin_amdgcn_s_barrier(); asm volatile("" ::: "memory"); }
        const int rl0 = wr * 64 + fr, row0 = u.pm * BM + rl0, cl = wc * 32 + 8 * fq;
#pragma unroll
        for (int ai = 0; ai < 2; ++ai)
#pragma unroll
            for (int m = 0; m < 4; ++m) { const int row = row0 + ai * HALF + m * 16; const float rs = rsb[rl0 + ai * HALF + m * 16];
#pragma unroll
                for (int bj = 0; bj < 2; ++bj) { const f32x4 v0 = acc[ai][bj][m][0] * rs, v1 = acc[ai][bj][m][1] * rs;
                    if (u.pn >= 12 && u.pn < 14) { float* d = ps + (size_t)row * 512 + (u.pn - 12) * 256 + bj * HALF + cl; *(f32x4*)d = v0; *(f32x4*)(d + 4) = v1; }
                    else { u32x4 w; w.x = cvt_pk_bf16(v0[0], v0[1]); w.y = cvt_pk_bf16(v0[2], v0[3]); w.z = cvt_pk_bf16(v1[0], v1[1]); w.w = cvt_pk_bf16(v1[2], v1[3]);
                        if (u.pn < 12) *(u32x4*)(pr + (size_t)row * 3072 + u.pn * 256 + bj * HALF + cl) = w;
                        else { const int c = (u.pn - 14) * 256 + bj * HALF + cl;
                            const int b = row >> 12, s = row & 4095; *(u32x4*)(qkv + ((size_t)b * 4160 + 64 + s) * 3072 + c) = w; } } } }
    }
};
template <class Epi, class Sched, bool ALIGN_EPI = false, bool SP2 = false>
__device__ __forceinline__ void gemm_phase(PG8_LAS unsigned char* lds, const Gemm g, const Sched& S, const Epi& E) {
    const int tid = ltid(), wid = __builtin_amdgcn_readfirstlane(tid >> 6), lane = tid & 63, wr = wid >> 2, wc = wid & 3, fr = lane & 15, fq = lane >> 4;
    const int K = g.K, nt = K / BK;
    unsigned voffA[2], voffB[2];
#pragma unroll
    for (int i = 0; i < 2; ++i) { int R, C; stage_rc(tid * 16 + i * 8192, R, C); const int Rb = Epi::PERM ? ((R & ~31) + perm32(R & 31)) : R;
        voffA[i] = (unsigned)(R * K + C) * 2u; voffB[i] = (unsigned)(Rb * K + C) * 2u; }
    const size_t kstep = (size_t)(BK * 2);
    const size_t hstep = (size_t)HALF * K * 2;
    const size_t tstep = 2 * hstep;
    const unsigned ldsw = (unsigned)wid * 1024u;
    const int aoff = lds_byte(wr * 64 + fr, fq * 8), boff = lds_byte(wc * 32 + fr, fq * 8);
#define PG8_SA(b, h) (((b) * 2 + (h)) * HTB)
#define PG8_SB(b, h) ((4 + (b) * 2 + (h)) * HTB)
#define PG8_STAGE(bufoff, gbase, voff) do { _Pragma("unroll") for (int _i = 0; _i < 2; ++_i) \
        __builtin_amdgcn_global_load_lds((const unsigned*)((const char*)(gbase) + (voff)[_i]), (PG8_LAS unsigned*)(lds + (bufoff) + ldsw + _i * 8192), 16, 0, 0); } while (0)
#define PG8_LDA(dst, b, h) do { _Pragma("unroll") for (int m = 0; m < 4; ++m) _Pragma("unroll") for (int k = 0; k < 2; ++k) dst[m][k] = *(const PG8_LAS bf16x8*)(lds + PG8_SA(b, h) + aoff + m * 2048 + k * 1024); } while (0)
#define PG8_LDB(dst, b, h) do { _Pragma("unroll") for (int n = 0; n < 2; ++n) _Pragma("unroll") for (int k = 0; k < 2; ++k) dst[n][k] = *(const PG8_LAS bf16x8*)(lds + PG8_SB(b, h) + boff + n * 2048 + k * 1024); } while (0)
#define PG8_MMA(ai, bj, At, Bt) do { __builtin_amdgcn_s_setprio(1); _Pragma("unroll") for (int m = 0; m < 4; ++m) _Pragma("unroll") for (int n = 0; n < 2; ++n) _Pragma("unroll") for (int k = 0; k < 2; ++k) \
        acc[ai][bj][m][n] = __builtin_amdgcn_mfma_f32_16x16x32_bf16(Bt[n][k], At[m][k], acc[ai][bj][m][n], 0, 0, 0); __builtin_amdgcn_s_setprio(0); } while (0)
#define PG8_WAIT_V(n) asm volatile("s_waitcnt vmcnt(" #n ")" ::: "memory")
#define PG8_WAIT_VR(flag, n) asm volatile("s_cmp_lg_u32 %0, 0\n\ts_cbranch_scc1 .Lpg8rx%=\n\ts_waitcnt vmcnt(8)\n.Lpg8rx%=:\n\ts_waitcnt vmcnt(%1)" :: "s"(flag), "n"(n) : "memory", "scc")
#define PG8_WAIT_L(n) asm volatile("s_waitcnt lgkmcnt(" #n ")" ::: "memory")
#define PG8_BAR __builtin_amdgcn_s_barrier()
#define PG8_SCHED __builtin_amdgcn_sched_barrier(0)
    Unit cur, nxt; int ui = 0, prev_pm = -1;
    if (!S.next(0, cur)) return;
    f32x4 acc[2][2][4][2];
#pragma unroll
    for (int a = 0; a < 2; ++a)
#pragma unroll
        for (int b = 0; b < 2; ++b)
#pragma unroll
            for (int m = 0; m < 4; ++m)
#pragma unroll
                for (int n = 0; n < 2; ++n) acc[a][b][m][n] = (f32x4){0.f, 0.f, 0.f, 0.f};
    bf16x8 At[4][2], B0[2][2], B1[2][2];
    const char* cA = (const char*)g.A + (size_t)cur.pm * tstep; const char* cB = (const char*)g.Bt + (size_t)cur.pn * tstep;
    S.a_ready(cur);
    if constexpr (SP2) {
        PG8_STAGE(PG8_SB(0, 0), cB, voffB); PG8_STAGE(PG8_SB(0, 1), cB + hstep, voffB); PG8_STAGE(PG8_SA(0, 0), cA, voffA); PG8_STAGE(PG8_SA(0, 1), cA + hstep, voffA);
        if (wr == 1) PG8_BAR;
        PG8_WAIT_V(2); PG8_BAR;
        PG8_STAGE(PG8_SB(1, 0), cB + kstep, voffB); PG8_STAGE(PG8_SA(1, 0), cA + kstep, voffA); PG8_STAGE(PG8_SB(1, 1), cB + hstep + kstep, voffB);
        PG8_WAIT_V(6); PG8_BAR;
    } else {
        PG8_STAGE(PG8_SB(0, 0), cB, voffB); PG8_STAGE(PG8_SA(0, 0), cA, voffA); PG8_STAGE(PG8_SB(0, 1), cB + hstep, voffB); PG8_STAGE(PG8_SA(0, 1), cA + hstep, voffA);
        if (wr == 1) PG8_BAR;
        PG8_WAIT_V(4); PG8_BAR;
        PG8_STAGE(PG8_SB(1, 0), cB + kstep, voffB); PG8_STAGE(PG8_SA(1, 0), cA + kstep, voffA); PG8_STAGE(PG8_SB(1, 1), cB + hstep + kstep, voffB);
        PG8_WAIT_V(6); PG8_BAR;
    }
    for (;;) {
        const bool has_next = S.next(ui + 1, nxt);
        const char* nA = has_next ? (const char*)g.A + (size_t)nxt.pm * tstep : cA; const char* nB = has_next ? (const char*)g.Bt + (size_t)nxt.pn * tstep : cB;
        for (int t = 0; t < nt; t += 2) {
            const bool last = (t == nt - 2);
            const char* a1 = cA + (size_t)(t + 1) * kstep;
            const char* a2 = last ? nA : cA + (size_t)(t + 2) * kstep; const char* b2 = last ? nB : cB + (size_t)(t + 2) * kstep;
            const char* a3 = a2 + kstep; const char* b3 = b2 + kstep;
            if (last && has_next) S.a_ready(nxt);
            if constexpr (SP2) {
            const int relax = __builtin_amdgcn_readfirstlane(((t == 0) && (ui > 0)) ? 1 : 0);
            PG8_LDB(B0, 0, 0); PG8_LDB(B1, 0, 1); PG8_SCHED; PG8_LDA(At, 0, 0); PG8_STAGE(PG8_SA(1, 1), a1 + hstep, voffA);
            PG8_WAIT_VR(relax, 8 + Epi::NVM);
            PG8_WAIT_L(0); PG8_BAR; PG8_MMA(0, 0, At, B0); PG8_MMA(0, 1, At, B1); PG8_BAR; PG8_SCHED;
            PG8_LDA(At, 0, 1); PG8_STAGE(PG8_SB(0, 0), b2, voffB); PG8_STAGE(PG8_SB(0, 1), b2 + hstep, voffB); PG8_STAGE(PG8_SA(0, 0), a2, voffA);
            PG8_WAIT_VR(relax, 8 + Epi::NVM);
            PG8_WAIT_L(0); PG8_BAR; PG8_MMA(1, 0, At, B0); PG8_MMA(1, 1, At, B1); PG8_BAR; PG8_SCHED;
            PG8_LDB(B0, 1, 0); PG8_LDB(B1, 1, 1); PG8_SCHED; PG8_LDA(At, 1, 0); PG8_STAGE(PG8_SA(0, 1), a2 + hstep, voffA);
            PG8_WAIT_V(8); PG8_WAIT_L(0); PG8_BAR; PG8_MMA(0, 0, At, B0); PG8_MMA(0, 1, At, B1); PG8_BAR; PG8_SCHED;
            PG8_LDA(At, 1, 1); PG8_STAGE(PG8_SB(1, 0), b3, voffB); PG8_STAGE(PG8_SB(1, 1), b3 + hstep, voffB); PG8_STAGE(PG8_SA(1, 0), a3, voffA);
            PG8_WAIT_V(8); PG8_WAIT_L(0); PG8_BAR; PG8_MMA(1, 0, At, B0); PG8_MMA(1, 1, At, B1); PG8_BAR; PG8_SCHED;
            } else {
            PG8_LDB(B0, 0, 0); PG8_SCHED; PG8_LDA(At, 0, 0); PG8_STAGE(PG8_SA(1, 1), a1 + hstep, voffA);
            PG8_WAIT_L(8); PG8_BAR; PG8_WAIT_L(0); PG8_MMA(0, 0, At, B0); PG8_BAR; PG8_SCHED;
            PG8_LDB(B1, 0, 1); PG8_STAGE(PG8_SB(0, 0), b2, voffB);
            PG8_BAR; PG8_WAIT_L(0); PG8_MMA(0, 1, At, B1); PG8_BAR;
            PG8_LDA(At, 0, 1); PG8_STAGE(PG8_SA(0, 0), a2, voffA);
            PG8_BAR; PG8_WAIT_L(0); PG8_MMA(1, 0, At, B0); PG8_BAR; PG8_SCHED;
            PG8_STAGE(PG8_SB(0, 1), b2 + hstep, voffB);
            PG8_WAIT_V(6); PG8_BAR; PG8_MMA(1, 1, At, B1); PG8_BAR;
            PG8_LDB(B0, 1, 0); PG8_SCHED; PG8_LDA(At, 1, 0); PG8_STAGE(PG8_SA(0, 1), a2 + hstep, voffA);
            PG8_WAIT_L(8); PG8_BAR; PG8_WAIT_L(0); PG8_MMA(0, 0, At, B0); PG8_BAR; PG8_SCHED;
            PG8_LDB(B1, 1, 1); PG8_STAGE(PG8_SB(1, 0), b3, voffB);
            PG8_BAR; PG8_WAIT_L(0); PG8_MMA(0, 1, At, B1); PG8_BAR;
            PG8_LDA(At, 1, 1); PG8_STAGE(PG8_SA(1, 0), a3, voffA);
            PG8_BAR; PG8_WAIT_L(0); PG8_MMA(1, 0, At, B0); PG8_BAR; PG8_SCHED;
            PG8_STAGE(PG8_SB(1, 1), b3 + hstep, voffB);
            PG8_WAIT_V(6); PG8_BAR; PG8_MMA(1, 1, At, B1); PG8_BAR;
            }
        }
        if constexpr (ALIGN_EPI) { if (wr == 0) PG8_BAR; }
        if constexpr (!Epi::AFTER_DRAIN) { E(acc, cur, wr, wc, fr, fq, cur.pm != prev_pm); prev_pm = cur.pm; S.done(cur); }
        if (!has_next) break;
#pragma unroll
        for (int a = 0; a < 2; ++a)
#pragma unroll
            for (int b = 0; b < 2; ++b)
#pragma unroll
                for (int m = 0; m < 4; ++m)
#pragma unroll
                    for (int n = 0; n < 2; ++n) acc[a][b][m][n] = (f32x4){0.f, 0.f, 0.f, 0.f};
        cur = nxt; cA = nA; cB = nB; ++ui;
        if constexpr (ALIGN_EPI) { if (wr == 1) PG8_BAR; }
    }
    PG8_WAIT_V(0);
    if constexpr (!ALIGN_EPI) { if (wr == 0) PG8_BAR; }
    PG8_BAR;
    if constexpr (Epi::AFTER_DRAIN) { E.fused(acc, cur, wr, wc, fr, fq, lds, wid, lane); S.done(cur); }
#undef PG8_SA
#undef PG8_SB
#undef PG8_STAGE
#undef PG8_LDA
#undef PG8_LDB
#undef PG8_MMA
#undef PG8_WAIT_V
#undef PG8_WAIT_VR
#undef PG8_WAIT_L
#undef PG8_BAR
#undef PG8_SCHED
}
}


#define XB_TMO      128
#define XB_XCNT(j)  (256  + 64 * (j))
#define XB_XSUB(j)  (1280 + 64 * (j))
#define XB_XGEN(j)  (2304 + 64 * (j))
#define XB_TOP      3328
#define XB_TOPGEN   3392
#define XCD_BAR_WORDS 3456
#define XB_SPIN_CAP (1u << 22)

__device__ __forceinline__ unsigned xb_ld(unsigned* p)              { return __hip_atomic_load(p, __ATOMIC_RELAXED, __HIP_MEMORY_SCOPE_AGENT); }
__device__ __forceinline__ unsigned xb_add(unsigned* p, unsigned v) { return __hip_atomic_fetch_add(p, v, __ATOMIC_RELAXED, __HIP_MEMORY_SCOPE_AGENT); }
__device__ __forceinline__ unsigned xb_xcc_id() { return (unsigned)__builtin_amdgcn_s_getreg((3 << 11) | 20) & 0xFu; }
#define XB_SPIN(cond, bar) do { unsigned _sp = 0; while (cond) { __builtin_amdgcn_s_sleep(1); \
    if ((++_sp & 255u) == 0u) { if (xb_ld(&(bar)[XB_TMO])) break; if (_sp > XB_SPIN_CAP) { atomicAdd(&(bar)[XB_TMO], 1u); break; } } } } while (0)

struct XcdBarrier {
    unsigned* bar; unsigned x;
    volatile LAS unsigned* st;
};

__device__ __forceinline__ XcdBarrier xcd_barrier_post(unsigned* bar, volatile LAS unsigned* st) {
    XcdBarrier b; b.bar = bar; b.x = xb_xcc_id(); b.st = st;
    if (threadIdx.x == 0) (void)xb_add(&bar[XB_XCNT(b.x)], 1u);
    return b;
}
__device__ __forceinline__ void xcd_barrier_complete(unsigned* bar, unsigned x, unsigned& nloc, unsigned& nx) {
    const unsigned G = gridDim.x * gridDim.y * gridDim.z;
    unsigned sum, cnt, mine, sp = 0u;
    for (;;) {
        sum = 0u; cnt = 0u; mine = 0u;
#pragma unroll
        for (unsigned j = 0; j < 16; ++j) { const unsigned c = xb_ld(&bar[XB_XCNT(j)]); sum += c; cnt += (c > 0u) ? 1u : 0u; mine = (j == x) ? c : mine; }
        if (sum == G) break;
        __builtin_amdgcn_s_sleep(1);
        if ((++sp & 255u) == 0u) { if (xb_ld(&bar[XB_TMO])) break; if (sp > XB_SPIN_CAP) { atomicAdd(&bar[XB_TMO], 1u); break; } }
    }
    nloc = mine > 0u ? mine : 1u; nx = cnt > 0u ? cnt : 1u;
}

__device__ __forceinline__ void xcd_barrier(const XcdBarrier& b) {
    asm volatile("s_waitcnt vmcnt(0)" ::: "memory");
    __syncthreads();
    if (threadIdx.x == 0) {
        unsigned* bar = b.bar;
        __builtin_amdgcn_s_waitcnt(0);
        unsigned nloc = b.st[0], nx = b.st[1];
        if (nloc == 0u) { xcd_barrier_complete(bar, b.x, nloc, nx); b.st[0] = nloc; b.st[1] = nx; }
        const unsigned old = xb_add(&bar[XB_XSUB(b.x)], 1u);
        const unsigned gen = old / nloc;
        if (old + 1u == (gen + 1u) * nloc) {
            __builtin_amdgcn_fence(__ATOMIC_RELEASE, "agent");
            asm volatile("s_waitcnt vmcnt(0)" ::: "memory");
            const unsigned og = xb_add(&bar[XB_TOP], 1u);
            const unsigned tg = og / nx;
            if (og + 1u == (tg + 1u) * nx) xb_add(&bar[XB_TOPGEN], 1u);
            else XB_SPIN(xb_ld(&bar[XB_TOPGEN]) == tg, bar);
            __builtin_amdgcn_fence(__ATOMIC_ACQUIRE, "agent");
            xb_add(&bar[XB_XGEN(b.x)], 1u);
            asm volatile("s_waitcnt vmcnt(0)" ::: "memory");
        } else {
            XB_SPIN(xb_ld(&bar[XB_XGEN(b.x)]) == gen, bar);
            __builtin_amdgcn_fence(__ATOMIC_ACQUIRE, "agent");
            asm volatile("s_waitcnt vmcnt(0)" ::: "memory");
        }
    }
    __syncthreads();
}


typedef unsigned short bf16_t;
typedef float f32x4 __attribute__((ext_vector_type(4)));
typedef unsigned u32x4 __attribute__((ext_vector_type(4)));
typedef unsigned u32x2 __attribute__((ext_vector_type(2)));
struct Params { const float* in[25]; float* out; unsigned char* ws; int ph_lo, ph_hi; };
#define CAS __attribute__((address_space(4)))
typedef const CAS Params* PP;
__device__ __forceinline__ PP launder(PP p) { asm volatile("" : "+s"(p)); return p; }
enum { I_X = 0, I_META, I_F1N, I_F1GU, I_F1D, I_MIXN, I_WIN, I_MU, I_W0, I_WUP, I_A0, I_AUP, I_GUP, I_KK, I_KA, I_RK, I_LNW, I_LNB, I_BF, I_FON, I_WOUT, I_F2N, I_F2GU, I_F2D, I_FINN };

typedef float f32x2_t __attribute__((ext_vector_type(2))); typedef __bf16 bf16x2v_t __attribute__((ext_vector_type(2)));
__device__ __forceinline__ unsigned pk_bf16(float lo, float hi) { f32x2_t v = {lo, hi}; bf16x2v_t b = __builtin_convertvector(v, bf16x2v_t); return __builtin_bit_cast(unsigned, b); }
__device__ __forceinline__ float bf2f(bf16_t b) { return __uint_as_float(((unsigned)b) << 16); }
__device__ __forceinline__ float wave_sum(float v) {
#pragma unroll
    for (int o = 32; o >= 1; o >>= 1) v += __shfl_xor(v, o);
    return v; }
__device__ __forceinline__ float wave_max(float v) {
#pragma unroll
    for (int o = 32; o >= 1; o >>= 1) v = fmaxf(v, __shfl_xor(v, o));
    return v; }
template <int CTRL> __device__ __forceinline__ float dpp_f(float v) { return __builtin_bit_cast(float, __builtin_amdgcn_update_dpp(0, __builtin_bit_cast(int, v), CTRL, 0xf, 0xf, true)); }
__device__ __forceinline__ float row_sum16(float v) { v += dpp_f<0xB1>(v); v += dpp_f<0x4E>(v); v += dpp_f<0x141>(v); v += dpp_f<0x140>(v); return v; }
__device__ __forceinline__ float rdlane(float v, int l) { return __builtin_bit_cast(float, __builtin_amdgcn_readlane(__builtin_bit_cast(int, v), l)); }
__device__ __forceinline__ float wave_sum_dpp(float v) { v = row_sum16(v); return (rdlane(v, 0) + rdlane(v, 16)) + (rdlane(v, 32) + rdlane(v, 48)); }
__device__ __forceinline__ float sigmoid_f(float x) { return __builtin_amdgcn_rcpf(1.0f + __expf(-x)); }

struct CvT { const float* src; bf16_t* dst; const float* gain; int K, Nsrc, kind, tk, tn; };
__device__ __forceinline__ CvT cv_desc(PP P, int l, int r) {
    using namespace cfg;
    constexpr int T_GU = (DM / 64) * (NGU / 64), T_D = (DFF / 64) * (DM / 64), T_IN = (DM / 64) * (NIN / 64), T_OUT = (DM / 64) * (DM / 64);
    bf16_t* wl = (bf16_t*)(P->ws + WS_W + (size_t)l * W_LAYER);
    CvT d; int ntn;
    if (r < T_GU) { d.src = P->in[I_F1GU] + (size_t)l * DM * NGU; d.dst = (bf16_t*)((unsigned char*)wl + WO_GU1); d.gain = P->in[I_F1N] + l * DM; d.K = DM; d.Nsrc = NGU; d.kind = 1; ntn = NGU / 64; }
    else if ((r -= T_GU) < T_D) { d.src = P->in[I_F1D] + (size_t)l * DFF * DM; d.dst = (bf16_t*)((unsigned char*)wl + WO_D1); d.gain = d.src; d.K = DFF; d.Nsrc = DM; d.kind = 0; ntn = DM / 64; }
    else if ((r -= T_D) < T_IN) { d.src = P->in[I_WIN] + (size_t)l * DM * DIN; d.dst = (bf16_t*)((unsigned char*)wl + WO_IN); d.gain = P->in[I_MIXN] + l * DM; d.K = DM; d.Nsrc = DIN; d.kind = 2; ntn = NIN / 64; }
    else if ((r -= T_IN) < T_OUT) { d.src = P->in[I_WOUT] + (size_t)l * DM * DM; d.dst = (bf16_t*)((unsigned char*)wl + WO_OUT); d.gain = P->in[I_FON] + l * FW; d.K = DM; d.Nsrc = DM; d.kind = 3; ntn = DM / 64; }
    else if ((r -= T_OUT) < T_GU) { d.src = P->in[I_F2GU] + (size_t)l * DM * NGU; d.dst = (bf16_t*)((unsigned char*)wl + WO_GU2); d.gain = P->in[I_F2N] + l * DM; d.K = DM; d.Nsrc = NGU; d.kind = 1; ntn = NGU / 64; }
    else { r -= T_GU; d.src = P->in[I_F2D] + (size_t)l * DFF * DM; d.dst = (bf16_t*)((unsigned char*)wl + WO_D2); d.gain = d.src; d.K = DFF; d.Nsrc = DM; d.kind = 0; ntn = DM / 64; }
    d.tk = r / ntn; d.tn = r - d.tk * ntn; return d; }
__device__ __forceinline__ int cv_srccol(const CvT& d, int np) {
    const int sc1 = ((np >> 7) & 1) * cfg::DFF + (np >> 8) * 128 + (np & 127);
    const int sc2 = np < 3360 ? np : (np < 3368 ? 6432 + (np - 3360) : (np < 3584 ? 0 : 3360 + (np - 3584)));
    return d.kind == 1 ? sc1 : (d.kind == 2 ? sc2 : np); }
__device__ __forceinline__ void cv_load(const CvT& d, f32x4 (&v)[2], float (&g)[2]) {
    const int tid = ltid(); const int nl = (tid & 15) * 4, np = d.tn * 64 + nl; const int sc = cv_srccol(d, np);
#pragma unroll
    for (int i = 0; i < 2; ++i) { const int kl = (tid >> 4) + 32 * i, k = d.tk * 64 + kl;
        v[i] = *(const f32x4*)(d.src + (size_t)k * d.Nsrc + sc);
        const int gk = d.kind == 3 ? (k >= 1024 ? k - 1024 : 0) : (d.kind == 0 ? 0 : k);
        g[i] = d.gain[gk]; } }
__device__ __forceinline__ void cv_finish(const CvT& d, const f32x4 (&v)[2], const float (&g)[2], LAS float* T) {
    const int tid = ltid();
    { const int nl = (tid & 15) * 4, np = d.tn * 64 + nl; const bool zero = d.kind == 2 && np >= 3368 && np < 3584;
#pragma unroll
      for (int i = 0; i < 2; ++i) { const int kl = (tid >> 4) + 32 * i, k = d.tk * 64 + kl;
          float gg = (d.kind == 0 || (d.kind == 3 && k < 1024)) ? 1.f : g[i]; const f32x4 x = zero ? (f32x4){0.f, 0.f, 0.f, 0.f} : v[i] * gg;
          T[kl * 65 + nl] = x[0]; T[kl * 65 + nl + 1] = x[1]; T[kl * 65 + nl + 2] = x[2]; T[kl * 65 + nl + 3] = x[3]; } }
    asm volatile("s_waitcnt lgkmcnt(0)" ::: "memory"); __builtin_amdgcn_s_barrier(); asm volatile("" ::: "memory");
    { const int nl = tid >> 3, k8 = (tid & 7) * 8; u32x4 w;
      w.x = pk_bf16(T[(k8 + 0) * 65 + nl], T[(k8 + 1) * 65 + nl]); w.y = pk_bf16(T[(k8 + 2) * 65 + nl], T[(k8 + 3) * 65 + nl]);
      w.z = pk_bf16(T[(k8 + 4) * 65 + nl], T[(k8 + 5) * 65 + nl]); w.w = pk_bf16(T[(k8 + 6) * 65 + nl], T[(k8 + 7) * 65 + nl]);
      *(u32x4*)(d.dst + (size_t)(d.tn * 64 + nl) * d.K + d.tk * 64 + k8) = w; } }
__device__ __forceinline__ void phase_convert(PP P, LAS unsigned char* lds, int l0, int l1, int first, int nwg, int t0 = 0, int t1 = 0) {
    using namespace cfg;
    constexpr int T_GU = (DM / 64) * (NGU / 64), T_D = (DFF / 64) * (DM / 64), T_IN = (DM / 64) * (NIN / 64), T_OUT = (DM / 64) * (DM / 64);
    constexpr int T_LAYER = 2 * T_GU + 2 * T_D + T_IN + T_OUT;
    if (t1 <= 0) t1 = T_LAYER;
    for (int l = l0; l < l1; ++l) {
        int r = first; if (r < t0) r += ((t0 - r + nwg - 1) / nwg) * nwg;
        if (r >= t1) continue;
        const int ntile = (t1 - r + nwg - 1) / nwg, rlast = r + (ntile - 1) * nwg;
#define CV_R(j) ((r + (j) * nwg) < rlast ? (r + (j) * nwg) : rlast)
        CvT dA = cv_desc(P, l, r), dB = cv_desc(P, l, CV_R(1)), dC = dA; f32x4 vA[2], vB[2], vC[2]; float gA[2], gB[2], gC[2];
        cv_load(dA, vA, gA); cv_load(dB, vB, gB);
        int buf = 0;
#define CV_STEP(dX, vX, gX, dN, vN, gN) { dN = cv_desc(P, l, CV_R(2)); cv_load(dN, vN, gN); cv_finish(dX, vX, gX, (LAS float*)lds + buf * (64 * 65)); buf ^= 1; r += nwg; }
        for (int it = 0; it < (ntile + 2) / 3; ++it) {
            CV_STEP(dA, vA, gA, dC, vC, gC)
            CV_STEP(dB, vB, gB, dA, vA, gA)
            CV_STEP(dC, vC, gC, dB, vB, gB)
        }
#undef CV_STEP
#undef CV_R
        __syncthreads();
    }
}
__device__ __forceinline__ void phase_init(PP P) {
    using namespace cfg;
    const int lane = ltid() & 63, gw = lbid() * 8 + (ltid() >> 6), nw = gridDim.x * 8;
    bf16_t* hb = (bf16_t*)(P->ws + WS_HB); float* ss0 = (float*)(P->ws + WS_SS);
    for (int row = gw; row < MROWS; row += nw) {
        const float* s = row < MMAIN ? P->in[I_X] + (size_t)row * DM : P->in[I_META] + (size_t)(row - MMAIN) * DM;
        float sq = 0.f;
#pragma unroll
        for (int i = 0; i < 4; ++i) { f32x4 v0 = (f32x4){0.f, 0.f, 0.f, 0.f}, v1 = v0; if (row < MMAIN + NMETA) { v0 = *(const f32x4*)(s + i * 512 + lane * 8); v1 = *(const f32x4*)(s + i * 512 + lane * 8 + 4); }
            sq += ((v0[0] * v0[0] + v0[1] * v0[1]) + (v0[2] * v0[2] + v0[3] * v0[3])) + ((v1[0] * v1[0] + v1[1] * v1[1]) + (v1[2] * v1[2] + v1[3] * v1[3]));
            u32x4 w; w.x = pk_bf16(v0[0], v0[1]); w.y = pk_bf16(v0[2], v0[3]); w.z = pk_bf16(v1[0], v1[1]); w.w = pk_bf16(v1[2], v1[3]); *(u32x4*)(hb + (size_t)row * DM + i * 512 + lane * 8) = w; }
        sq = wave_sum(sq);
        if (lane < 8) ss0[(size_t)lane * MROWS + row] = lane == 0 ? sq : 0.f;
        if (row >= MMAIN && row < MMAIN + NMETA) { float* ssm0 = (float*)(P->ws + WS_SSM); ssm0[lane * 16 + (row - MMAIN)] = lane == 0 ? sq : 0.f; ssm0[(64 + lane) * 16 + (row - MMAIN)] = 0.f; }
    }
}
__device__ __forceinline__ void phase_foxnorm(PP P) {
    using namespace cfg;
    const int lane = ltid() & 63, gw = lbid() * 8 + (ltid() >> 6), nw = gridDim.x * 8;
    bf16_t* y = (bf16_t*)(P->ws + WS_Y);
    for (int row0 = gw; row0 < MMAIN + NMETA; row0 += 4 * nw) {
        u32x4 a[4], b[4];
#pragma unroll
        for (int j = 0; j < 4; ++j) { const int row = row0 + j * nw; if (row < MMAIN + NMETA) { const bf16_t* p = y + (size_t)row * DM + 1024 + lane * 8; a[j] = *(const u32x4*)p; b[j] = *(const u32x4*)(p + 512); } else { a[j] = (u32x4){0u, 0u, 0u, 0u}; b[j] = a[j]; } }
#pragma unroll
        for (int j = 0; j < 4; ++j) { const int row = row0 + j * nw; float v[16];
#pragma unroll
            for (int i = 0; i < 4; ++i) { v[2 * i] = __uint_as_float(a[j][i] << 16); v[2 * i + 1] = __uint_as_float(a[j][i] & 0xffff0000u); v[8 + 2 * i] = __uint_as_float(b[j][i] << 16); v[8 + 2 * i + 1] = __uint_as_float(b[j][i] & 0xffff0000u); }
            float sq = 0.f;
#pragma unroll
            for (int i = 0; i < 16; ++i) sq += v[i] * v[i];
            sq = wave_sum_dpp(sq); const float rs = __builtin_amdgcn_rsqf(sq * (1.0f / 1024.0f) + NORM_EPS);
            u32x4 oa, ob;
#pragma unroll
            for (int i = 0; i < 4; ++i) { oa[i] = pk_bf16(v[2 * i] * rs, v[2 * i + 1] * rs); ob[i] = pk_bf16(v[8 + 2 * i] * rs, v[8 + 2 * i + 1] * rs); }
            if (row < MMAIN + NMETA) { bf16_t* p = y + (size_t)row * DM + 1024 + lane * 8; *(u32x4*)p = oa; *(u32x4*)(p + 512) = ob; } }
    }
}
__device__ __forceinline__ void phase_final(PP P) {
    using namespace cfg;
    const int lane = ltid() & 63, gw = lbid() * 8 + (ltid() >> 6), nw = gridDim.x * 8;
    const float* g = P->in[I_FINN]; const bf16_t* hb = (const bf16_t*)(P->ws + WS_HB);
    typedef unsigned u32x2 __attribute__((ext_vector_type(2)));
    for (int rowf = gw; rowf < MMAIN; rowf += nw) { const int row = MMAIN - nw + 2 * gw - rowf;
        float* d = P->out + (size_t)row * DM; f32x4 v[8]; float sq = 0.f;
#pragma unroll
        for (int i = 0; i < 8; ++i) { const u32x2 x = *(const u32x2*)(hb + (size_t)row * DM + i * 256 + lane * 4);
            v[i] = (f32x4){__uint_as_float(x.x << 16), __uint_as_float(x.x & 0xffff0000u), __uint_as_float(x.y << 16), __uint_as_float(x.y & 0xffff0000u)}; }
#pragma unroll
        for (int i = 0; i < 8; ++i) sq += (v[i][0] * v[i][0] + v[i][1] * v[i][1]) + (v[i][2] * v[i][2] + v[i][3] * v[i][3]);
        sq = wave_sum(sq); const float rs = __builtin_amdgcn_rsqf(sq * (1.0f / 2048.0f) + NORM_EPS);
#pragma unroll
        for (int i = 0; i < 8; ++i) { const f32x4 g0 = *(const f32x4*)(g + i * 256 + lane * 4); *(f32x4*)(d + i * 256 + lane * 4) = v[i] * rs * g0; }
    }
}


__device__ __forceinline__ void phase_lx(PP P, int l) {
    using namespace cfg;
    const int lane = ltid() & 63, gw = lbid() * 8 + (ltid() >> 6), nw = gridDim.x * 8;
    const float* PS = (const float*)(P->ws + WS_PS); bf16_t* LXG = (bf16_t*)(P->ws + WS_LXG); const float* mu = P->in[I_MU] + l * RWKV_COLS + 3072;
    if (lane < 36) {
        const f32x4 m0 = *(const f32x4*)(mu + lane * 8), m1 = *(const f32x4*)(mu + lane * 8 + 4);
#pragma unroll 4
        for (int row = gw; row < MMAIN + NMETA; row += nw) {
            int prev; if (row >= MMAIN) prev = (row == MMAIN) ? -1 : row - 1; else prev = ((row & (SEQ - 1)) == 0) ? MMAIN + NMETA - 1 : row - 1;
            const f32x4 c0 = *(const f32x4*)(PS + (size_t)row * PSW + lane * 8), c1 = *(const f32x4*)(PS + (size_t)row * PSW + lane * 8 + 4);
            f32x4 p0 = (f32x4){0.f, 0.f, 0.f, 0.f}, p1 = p0; if (prev >= 0) { p0 = *(const f32x4*)(PS + (size_t)prev * PSW + lane * 8); p1 = *(const f32x4*)(PS + (size_t)prev * PSW + lane * 8 + 4); }
            float x[8];
#pragma unroll
            for (int j = 0; j < 4; ++j) { x[j] = c0[j] + (p0[j] - c0[j]) * m0[j]; x[4 + j] = c1[j] + (p1[j] - c1[j]) * m1[j]; }
#pragma unroll
            for (int j = 0; j < 8; ++j) x[j] = lane < 8 ? 1.0f - 2.0f * __builtin_amdgcn_rcpf(__expf(2.0f * x[j]) + 1.0f) : (lane < 16 ? x[j] : __builtin_amdgcn_rcpf(1.0f + __expf(-x[j])));
            u32x4 w; w.x = pk_bf16(x[0], x[1]); w.y = pk_bf16(x[2], x[3]); w.z = pk_bf16(x[4], x[5]); w.w = pk_bf16(x[6], x[7]);
            *(u32x4*)(LXG + (size_t)row * 320 + lane * 8) = w;
        }
    }
}

typedef short bf16x8_t __attribute__((ext_vector_type(8)));
typedef short bf16x4_t __attribute__((ext_vector_type(4)));
namespace rk {
constexpr int LXS = 0, LXS_SZ = 18432, RAWH = 55296, RAWH_SZ = 6144, LXB = 73728, RS = 82944, KS = 87040, VS = 91136, KKN = 95232, ATP = 99328, RTP = 101376, BTP = 103424, KTP = 105472,
              BHT = 107520, KHT = 109568, VT = 111616, GT = 113664, AAK = 113920, RB = 114432, RKM = 114944, TINV = 115456, GG = 115968  , VF = 124160  , YR = 132352, BONP = 136448  , LDS_END = 136960;
}
#define RK_BAR() do { asm volatile("s_waitcnt lgkmcnt(0)" ::: "memory"); __builtin_amdgcn_s_barrier(); asm volatile("" ::: "memory"); } while (0)
__device__ __forceinline__ bf16_t bf1(float x) { return (bf16_t)(pk_bf16(x, 0.f) & 0xffffu); }
__device__ __forceinline__ bf16x4_t pack4(float a, float b, float c, float d) { u32x2 w; w.x = pk_bf16(a, b); w.y = pk_bf16(c, d); return __builtin_bit_cast(bf16x4_t, w); }
__device__ __forceinline__ float fast_sigmoid(float x) { return __builtin_amdgcn_rcpf(1.0f + __expf(-x)); }
__device__ __forceinline__ float fast_tanh(float x) { return 1.0f - 2.0f * __builtin_amdgcn_rcpf(__expf(2.0f * x) + 1.0f); }

__device__ __forceinline__ void rwkv_chunked(PP P, int l, int b, int h, LAS unsigned char* lds) {
    using namespace cfg;
    const int tid = ltid(), lane = tid & 63, wave = __builtin_amdgcn_readfirstlane(tid >> 6), n = lane & 15, g = lane >> 4;
    const bf16_t* PR = (const bf16_t*)(P->ws + WS_PR); const float* PS = (const float*)(P->ws + WS_PS); bf16_t* Y = (bf16_t*)(P->ws + WS_Y);
    const float* mu = P->in[I_MU] + l * RWKV_COLS; const bf16_t* LXGp = (const bf16_t*)(P->ws + WS_LXG);
    LAS float* RSm = (LAS float*)(lds + rk::RS); LAS float* KSm = (LAS float*)(lds + rk::KS); LAS float* VSm = (LAS float*)(lds + rk::VS); LAS float* KKNm = (LAS float*)(lds + rk::KKN);
    LAS bf16_t* ATp = (LAS bf16_t*)(lds + rk::ATP); LAS bf16_t* RTp = (LAS bf16_t*)(lds + rk::RTP); LAS bf16_t* BTp = (LAS bf16_t*)(lds + rk::BTP); LAS bf16_t* KTp = (LAS bf16_t*)(lds + rk::KTP);
    LAS bf16_t* BHt = (LAS bf16_t*)(lds + rk::BHT); LAS bf16_t* KHt = (LAS bf16_t*)(lds + rk::KHT); LAS bf16_t* Vt = (LAS bf16_t*)(lds + rk::VT);
    LAS float* GTm = (LAS float*)(lds + rk::GT);
    LAS bf16_t* AAKm = (LAS bf16_t*)(lds + rk::AAK); LAS bf16_t* RBm = (LAS bf16_t*)(lds + rk::RB); LAS bf16_t* RKm = (LAS bf16_t*)(lds + rk::RKM); LAS bf16_t* TINVm = (LAS bf16_t*)(lds + rk::TINV);
    LAS float* YRm = (LAS float*)(lds + rk::YR);
    const int hj = h * 64 + lane;
    const float mur = mu[hj], muk = mu[1024 + hj], muv = mu[2048 + hj], kkw = P->in[I_KK][l * RW + hj], lnw = P->in[I_LNW][l * RW + hj], lnb = P->in[I_LNB][l * RW + hj];
    const int kw = wave & 3, key = 16 * kw + n, hk = h * 64 + key;
    const float w0k = P->in[I_W0][l * RW + hk], a0k = P->in[I_A0][l * RW + hk], kak = P->in[I_KA][l * RW + hk], rkk = P->in[I_RK][l * RW + hk];
    const int pp = 32 * (key >> 5) + 8 * ((key >> 2) & 3) + 4 * ((key >> 4) & 1) + (key & 3);
    bf16x8_t fA[2], fB[5];
    {
        const float* wu = P->in[I_WUP] + (size_t)l * 64 * RW + hk; const float* au = P->in[I_AUP] + (size_t)l * 64 * RW + hk; const float* gu = P->in[I_GUP] + (size_t)l * 160 * RW + hk;
#pragma unroll
        for (int s = 0; s < 5; ++s) { float v[8], u[8];
#pragma unroll
            for (int j = 0; j < 8; ++j) { const int k = 32 * s + 8 * g + j; v[j] = (wave < 4) ? (s < 2 ? au[(size_t)k * RW] : 0.f) : gu[(size_t)k * RW]; u[j] = (wave < 4 && s < 2) ? wu[(size_t)k * RW] : 0.f; }
            u32x4 w; w.x = pk_bf16(v[0], v[1]); w.y = pk_bf16(v[2], v[3]); w.z = pk_bf16(v[4], v[5]); w.w = pk_bf16(v[6], v[7]); fB[s] = __builtin_bit_cast(bf16x8_t, w);
            if (s < 2) { u32x4 x; x.x = pk_bf16(u[0], u[1]); x.y = pk_bf16(u[2], u[3]); x.z = pk_bf16(u[4], u[5]); x.w = pk_bf16(u[6], u[7]); fA[s] = __builtin_bit_cast(bf16x8_t, x); } }
    }
    f32x4 ST[4];
#pragma unroll
    for (int kb = 0; kb < 4; ++kb) ST[kb] = (f32x4){0.f, 0.f, 0.f, 0.f};
#define RK_DMA(c_) do { const int cc_ = (c_); const int row0_ = (cc_ == 0) ? MMAIN : b * SEQ + (cc_ - 1) * 16; const int bi_ = cc_ % 3; \
        _Pragma("unroll") for (int i_ = 0; i_ < 2; ++i_) { const int wp_ = (i_ == 0) ? wave : 8; if (i_ == 0 || wave == 6) { const int x_ = wp_ * 64 + lane; \
            __builtin_amdgcn_global_load_lds((const unsigned*)(LXGp + (size_t)(row0_ + x_ / 36) * 320 + (x_ % 36) * 8), (LAS unsigned*)(lds + rk::LXS + (cc_ & 1) * rk::LXS_SZ + wp_ * 1024), 16, 0, 0); } } \
        if (wave < 6) { const int y_ = wave * 64 + lane; \
            __builtin_amdgcn_global_load_lds((const unsigned*)(PR + (size_t)(row0_ + y_ / 24) * PRW + ((y_ % 24) >> 3) * 1024 + h * 64 + (y_ & 7) * 8), (LAS unsigned*)(lds + rk::RAWH + bi_ * rk::RAWH_SZ + wave * 1024), 16, 0, 0); } } while (0)
#define RK_STAGE_A(ca_, t_) do { const int t = (t_); const int bc_ = (ca_) % 3, bp_ = ((ca_) + 2) % 3; \
        LAS const bf16_t* cH_ = (LAS const bf16_t*)(lds + rk::RAWH + bc_ * rk::RAWH_SZ); LAS const bf16_t* pH_ = (LAS const bf16_t*)(lds + rk::RAWH + bp_ * rk::RAWH_SZ); \
        LAS const bf16_t* ctH = cH_ + t * 192; LAS const bf16_t* ptH = (t == 0) ? pH_ + 15 * 192 : cH_ + (t - 1) * 192; \
        const float rc = bf2f(ctH[lane]), kc = bf2f(ctH[64 + lane]), vc = bf2f(ctH[128 + lane]); \
        const float rs = rc + (bf2f(ptH[lane]) - rc) * mur, ks = kc + (bf2f(ptH[64 + lane]) - kc) * muk, vs = vc + (bf2f(ptH[128 + lane]) - vc) * muv; \
        RSm[t * 64 + lane] = rs; KSm[t * 64 + lane] = ks; VSm[t * 64 + lane] = vs; \
        const float kkr = ks * kkw; const float n2 = wave_sum_dpp(kkr * kkr); KKNm[t * 64 + lane] = kkr * __builtin_amdgcn_rsqf(fmaxf(n2, 1e-24f)); } while (0)
#define RK_STAGE_F(cf_, t_) do { const int t = (t_); const int par_ = (cf_) & 1; const int rowF_ = ((cf_) == 0) ? MMAIN : b * SEQ + ((cf_) - 1) * 16; \
        LAS const float* Gp_ = (LAS const float*)(lds + rk::GG + par_ * 4096); LAS const float* Vp_ = (LAS const float*)(lds + rk::VF + par_ * 4096); LAS const float* Bp_ = (LAS const float*)(lds + rk::BONP + par_ * 256); \
        const float yv = YRm[t * 64 + lane]; \
        const float mean = wave_sum_dpp(yv) * (1.0f / 64.0f); const float d = yv - mean; const float var = wave_sum_dpp(d * d) * (1.0f / 64.0f); \
        const float yn = d * __builtin_amdgcn_rsqf(var + LNX_EPS) * lnw + lnb; \
        const float bonus = (Bp_[t] + Bp_[16 + t]) + (Bp_[32 + t] + Bp_[48 + t]); \
        const float o = (yn + bonus * Vp_[t * 64 + lane]) * Gp_[t * 64 + lane]; \
        if ((cf_) > 0 || b == 0) Y[(size_t)(rowF_ + t) * DM + hj] = bf1(o); } while (0)
    RK_DMA(0); RK_DMA(1);
    for (int e = tid; e < 96; e += 512) ((LAS unsigned*)(lds + rk::RAWH + 2 * rk::RAWH_SZ))[15 * 96 + e] = 0u;
    asm volatile("s_waitcnt vmcnt(0)" ::: "memory");
    RK_BAR();
    RK_STAGE_A(0, wave); RK_STAGE_A(0, wave + 8);
    RK_BAR();
#pragma unroll 1
    for (int c = 0; c < 257; ++c) {
        if (wave < 4) {
            LAS float* BONPc = (LAS float*)(lds + rk::BONP + (c & 1) * 256); LAS const bf16_t* LXB = (LAS const bf16_t*)(lds + rk::LXS + (c & 1) * rk::LXS_SZ);
            f32x4 accW = (f32x4){0.f, 0.f, 0.f, 0.f}, accA = accW;
#pragma unroll
            for (int s = 0; s < 2; ++s) { const bf16x8_t aw = *(const LAS bf16x8_t*)(LXB + n * 288 + 32 * s + 8 * g), aa = *(const LAS bf16x8_t*)(LXB + n * 288 + 64 + 32 * s + 8 * g);
                accW = __builtin_amdgcn_mfma_f32_16x16x32_bf16(aw, fA[s], accW, 0, 0, 0); accA = __builtin_amdgcn_mfma_f32_16x16x32_bf16(aa, fB[s], accA, 0, 0, 0); }
            float lw[4], alr[4], pfx[4];
#pragma unroll
            for (int r = 0; r < 4; ++r) { lw[r] = -0.6065306597126334f * fast_sigmoid(accW[r] + w0k); alr[r] = fast_sigmoid(accA[r] + a0k); }
            pfx[0] = lw[0]; pfx[1] = pfx[0] + lw[1]; pfx[2] = pfx[1] + lw[2]; pfx[3] = pfx[2] + lw[3];
            const float t0 = __shfl(pfx[3], n), t1 = __shfl(pfx[3], n + 16), t2 = __shfl(pfx[3], n + 32), t3 = __shfl(pfx[3], n + 48);
            const float base = (g > 0 ? t0 : 0.f) + (g > 1 ? t1 : 0.f) + (g > 2 ? t2 : 0.f), lamT = (t0 + t1) + (t2 + t3);
            float bh[4], kh[4], bon[4], epos[4];
            const float eb = __expf(base), eT = __expf(lamT);
#pragma unroll
            for (int r = 0; r < 4; ++r) epos[r] = __expf(base + pfx[r]);
#pragma unroll
            for (int r = 0; r < 4; ++r) { const int t = 4 * g + r;
                const float e_pos = epos[r], e_neg = __builtin_amdgcn_rcpf(epos[r]), e_prev = (r == 0) ? eb : epos[r > 0 ? r - 1 : 0], e_hat = eT * e_neg;
                const float rs = RSm[t * 64 + key], ks = KSm[t * 64 + key], kk = KKNm[t * 64 + key];
                const float kmod = ks * (1.0f + (alr[r] - 1.0f) * kak), bb = kk * alr[r];
                ATp[t * 64 + pp] = bf1(-kk * e_prev); RTp[t * 64 + pp] = bf1(rs * e_pos); BTp[t * 64 + pp] = bf1(bb * e_neg); KTp[t * 64 + pp] = bf1(kmod * e_neg);
                bh[r] = bb * e_hat; kh[r] = kmod * e_hat; bon[r] = rs * kmod * rkk; }
            *(LAS bf16x4_t*)(BHt + key * 16 + 4 * g) = pack4(bh[0], bh[1], bh[2], bh[3]); *(LAS bf16x4_t*)(KHt + key * 16 + 4 * g) = pack4(kh[0], kh[1], kh[2], kh[3]);
#pragma unroll
            for (int r = 0; r < 4; ++r) { const float x = row_sum16(bon[r]); if (n == 0) BONPc[kw * 16 + 4 * g + r] = x; }
            if (g == 0) GTm[key] = eT;
        } else {
            LAS float* Gc = (LAS float*)(lds + rk::GG + (c & 1) * 4096); LAS float* VFc = (LAS float*)(lds + rk::VF + (c & 1) * 4096); LAS const bf16_t* LXB = (LAS const bf16_t*)(lds + rk::LXS + (c & 1) * rk::LXS_SZ);
            f32x4 accG = (f32x4){0.f, 0.f, 0.f, 0.f};
#pragma unroll
            for (int s = 0; s < 5; ++s) { const bf16x8_t ag = *(const LAS bf16x8_t*)(LXB + n * 288 + 128 + 32 * s + 8 * g); accG = __builtin_amdgcn_mfma_f32_16x16x32_bf16(ag, fB[s], accG, 0, 0, 0); }
            float vv[4];
#pragma unroll
            for (int r = 0; r < 4; ++r) { Gc[(4 * g + r) * 64 + key] = accG[r]; vv[r] = VSm[(4 * g + r) * 64 + key]; VFc[(4 * g + r) * 64 + key] = vv[r]; }
            *(LAS bf16x4_t*)(Vt + key * 16 + 4 * g) = pack4(vv[0], vv[1], vv[2], vv[3]);
            if (c >= 1) { RK_STAGE_F(c - 1, 4 * kw); RK_STAGE_F(c - 1, 4 * kw + 1); RK_STAGE_F(c - 1, 4 * kw + 2); RK_STAGE_F(c - 1, 4 * kw + 3); }
        }
        asm volatile("s_waitcnt vmcnt(0)" ::: "memory");
        RK_BAR();
        if (c + 2 < 257) RK_DMA(c + 2);
        if (wave < 4) {
            LAS const bf16_t* X = (wave < 2) ? ATp : RTp; LAS const bf16_t* Yi = (wave & 1) ? KTp : BTp;
            f32x4 acc = (f32x4){0.f, 0.f, 0.f, 0.f};
#pragma unroll
            for (int s = 0; s < 2; ++s) { const bf16x8_t xa = *(const LAS bf16x8_t*)(X + n * 64 + 32 * s + 8 * g), yb = *(const LAS bf16x8_t*)(Yi + n * 64 + 32 * s + 8 * g);
                acc = __builtin_amdgcn_mfma_f32_16x16x32_bf16(xa, yb, acc, 0, 0, 0); }
            float mv[4];
#pragma unroll
            for (int r = 0; r < 4; ++r) { const int t = 4 * g + r; const bool keep = (wave < 2) ? (n < t) : (n <= t); mv[r] = keep ? acc[r] : 0.f;
                if (wave == 1) AAKm[t * 16 + n] = bf1(mv[r]); else if (wave == 2) RBm[t * 16 + n] = bf1(mv[r]); else if (wave == 3) RKm[t * 16 + n] = bf1(mv[r]); }
            if (wave == 0) {
                float Tc[16];
#pragma unroll
                for (int t = 0; t < 16; ++t) { float v0 = (t == n) ? 1.0f : 0.0f, v1 = 0.f;
#pragma unroll
                    for (int i = 0; i < t; ++i) { const float a = rdlane(mv[t & 3], i + 16 * (t >> 2)); if (i & 1) v1 += a * Tc[i]; else v0 += a * Tc[i]; }
                    Tc[t] = v0 + v1; asm volatile("" : "+v"(mv[0]), "+v"(mv[1]), "+v"(mv[2]), "+v"(mv[3]));     }
                if (g == 0) {
#pragma unroll
                    for (int t = 0; t < 16; ++t) TINVm[t * 16 + n] = bf1(Tc[t]); }
            }
        }
        if (wave >= 1) {
            if (c + 1 < 257 && wave != 4) { const int t0_ = (wave < 4) ? 3 * (wave - 1) : (wave == 5 ? 9 : 12 + 2 * (wave - 6));
                RK_STAGE_A(c + 1, t0_); RK_STAGE_A(c + 1, t0_ + 1); if (wave < 6) RK_STAGE_A(c + 1, t0_ + 2); }
        }
        RK_BAR();
        if (wave < 4) {
            bf16x8_t sb[2];
#pragma unroll
            for (int s = 0; s < 2; ++s) { u32x4 w; w.x = pk_bf16(ST[2 * s][0], ST[2 * s][1]); w.y = pk_bf16(ST[2 * s][2], ST[2 * s][3]); w.z = pk_bf16(ST[2 * s + 1][0], ST[2 * s + 1][1]); w.w = pk_bf16(ST[2 * s + 1][2], ST[2 * s + 1][3]);
                sb[s] = __builtin_bit_cast(bf16x8_t, w); }
            const bf16x4_t vfr = *(const LAS bf16x4_t*)(Vt + key * 16 + 4 * g);
            f32x4 W1 = (f32x4){0.f, 0.f, 0.f, 0.f}, Yc = W1;
#pragma unroll
            for (int s = 0; s < 2; ++s) { const bf16x8_t af = *(const LAS bf16x8_t*)(ATp + n * 64 + 32 * s + 8 * g), rf = *(const LAS bf16x8_t*)(RTp + n * 64 + 32 * s + 8 * g);
                W1 = __builtin_amdgcn_mfma_f32_16x16x32_bf16(af, sb[s], W1, 0, 0, 0); Yc = __builtin_amdgcn_mfma_f32_16x16x32_bf16(rf, sb[s], Yc, 0, 0, 0); }
            W1 = __builtin_amdgcn_mfma_f32_16x16x16bf16_1k(*(const LAS bf16x4_t*)(AAKm + n * 16 + 4 * g), vfr, W1, 0, 0, 0);
            const bf16x4_t w1f = pack4(W1[0], W1[1], W1[2], W1[3]);
            f32x4 U = __builtin_amdgcn_mfma_f32_16x16x16bf16_1k(*(const LAS bf16x4_t*)(TINVm + n * 16 + 4 * g), w1f, (f32x4){0.f, 0.f, 0.f, 0.f}, 0, 0, 0);
            const bf16x4_t uf = pack4(U[0], U[1], U[2], U[3]);
            Yc = __builtin_amdgcn_mfma_f32_16x16x16bf16_1k(*(const LAS bf16x4_t*)(RBm + n * 16 + 4 * g), uf, Yc, 0, 0, 0);
            Yc = __builtin_amdgcn_mfma_f32_16x16x16bf16_1k(*(const LAS bf16x4_t*)(RKm + n * 16 + 4 * g), vfr, Yc, 0, 0, 0);
#pragma unroll
            for (int r = 0; r < 4; ++r) YRm[(4 * g + r) * 64 + key] = Yc[r];
#pragma unroll
            for (int kb = 0; kb < 4; ++kb) { const f32x4 gt = *(const LAS f32x4*)(GTm + 16 * kb + 4 * g); f32x4 a = ST[kb] * gt;
                a = __builtin_amdgcn_mfma_f32_16x16x16bf16_1k(*(const LAS bf16x4_t*)(BHt + (16 * kb + n) * 16 + 4 * g), uf, a, 0, 0, 0);
                a = __builtin_amdgcn_mfma_f32_16x16x16bf16_1k(*(const LAS bf16x4_t*)(KHt + (16 * kb + n) * 16 + 4 * g), vfr, a, 0, 0, 0);
                ST[kb] = a; }
        }
        RK_BAR();
    }
    RK_STAGE_F(256, wave); RK_STAGE_F(256, wave + 8);
    asm volatile("s_waitcnt vmcnt(0)" ::: "memory");
    RK_BAR();
#undef RK_DMA
#undef RK_STAGE_A
#undef RK_STAGE_F
}

template <int NSTEPS>
__device__ __forceinline__ f32x4 sk_dot(const bf16_t* a, const bf16_t* b) {
    f32x4 acc = (f32x4){0.f, 0.f, 0.f, 0.f};
#pragma unroll
    for (int s = 0; s < NSTEPS; ++s) { const bf16x8_t av = *(const bf16x8_t*)(a + 32 * s), bv = *(const bf16x8_t*)(b + 32 * s); acc = __builtin_amdgcn_mfma_f32_16x16x32_bf16(av, bv, acc, 0, 0, 0); }
    return acc; }
__device__ __forceinline__ void meta_rs(const float* ssm, int lane, float (&rs)[4]) {
    const int row = lane & 15, part = lane >> 4; float s = 0.f;
#pragma unroll
    for (int i = 0; i < 32; ++i) s += ssm[(part + 4 * i) * 16 + row];
    s = s + __shfl_xor(s, 16); s = s + __shfl_xor(s, 32);
    const float rv = __builtin_amdgcn_rsqf(s * (1.0f / 2048.0f) + 1e-6f);
#pragma unroll
    for (int r = 0; r < 4; ++r) rs[r] = __shfl(rv, 4 * part + r); }
#define SK_HEAD const int tid = ltid(), lane = tid & 63, wave = __builtin_amdgcn_readfirstlane(tid >> 6), n = lane & 15, g = lane >> 4, kq = wave & 3, ti = lbid() + 256 * (wave >> 2); LAS f32x4* part = (LAS f32x4*)lds;
#define SK_COMBINE(dst, slot) do { dst = (part[((wave) * 2 + (slot)) * 64 + lane] + part[((wave + 1) * 2 + (slot)) * 64 + lane]) + (part[((wave + 2) * 2 + (slot)) * 64 + lane] + part[((wave + 3) * 2 + (slot)) * 64 + lane]); } while (0)
__device__ __forceinline__ void skinny_gu(const bf16_t* hb, const bf16_t* Bt, const float* ssm, bf16_t* act, LAS unsigned char* lds) {
    using namespace cfg; SK_HEAD
    float rs[4] = {0.f, 0.f, 0.f, 0.f};
    if (ti < DFF / 16 && kq == 0) meta_rs(ssm, lane, rs);
    if (ti < DFF / 16) { const int c0 = 16 * ti, brow = (c0 >> 7) * 256 + (c0 & 127) + n; const bf16_t* a = hb + (size_t)(MMAIN + n) * DM + 512 * kq + 8 * g;
        part[(wave * 2) * 64 + lane] = sk_dot<16>(a, Bt + (size_t)brow * DM + 512 * kq + 8 * g); part[(wave * 2 + 1) * 64 + lane] = sk_dot<16>(a, Bt + (size_t)(brow + 128) * DM + 512 * kq + 8 * g); }
    __syncthreads();
    if (ti < DFF / 16 && kq == 0) { f32x4 gt, up; SK_COMBINE(gt, 0); SK_COMBINE(up, 1);
#pragma unroll
        for (int r = 0; r < 4; ++r) { const float gv = gt[r] * rs[r], uv = up[r] * rs[r]; act[(size_t)(MMAIN + 4 * g + r) * DFF + 16 * ti + n] = bf1(gv * __builtin_amdgcn_rcpf(1.0f + __builtin_amdgcn_exp2f(-1.4426950408889634f * gv)) * uv); } }
    __syncthreads();
}
template <int K>
__device__ __forceinline__ void skinny_res(const bf16_t* A16, const bf16_t* Bt, bf16_t* hb, float* ssm_out, float alpha, LAS unsigned char* lds) {
    using namespace cfg;
    const int tid = ltid(), lane = tid & 63, wave = __builtin_amdgcn_readfirstlane(tid >> 6), n = lane & 15, g = lane >> 4, ti = lbid(); LAS f32x4* part = (LAS f32x4*)lds;
    constexpr int k8 = K / 8;
    float h0[4] = {0.f, 0.f, 0.f, 0.f};
    if (ti < DM / 16 && wave == 0) {
#pragma unroll
        for (int r = 0; r < 4; ++r) h0[r] = bf2f(hb[(size_t)(MMAIN + 4 * g + r) * DM + 16 * ti + n]); }
    if (ti < DM / 16) part[wave * 64 + lane] = sk_dot<k8 / 32>(A16 + (size_t)n * K + k8 * wave + 8 * g, Bt + (size_t)(16 * ti + n) * K + k8 * wave + 8 * g);
    __syncthreads();
    if (ti < DM / 16 && wave == 0) { const f32x4 acc = ((part[lane] + part[64 + lane]) + (part[128 + lane] + part[192 + lane])) + ((part[256 + lane] + part[320 + lane]) + (part[384 + lane] + part[448 + lane]));
#pragma unroll
        for (int r = 0; r < 4; ++r) { const int m = 4 * g + r, col = 16 * ti + n; bf16_t* p = hb + (size_t)(MMAIN + m) * DM + col; const float hv = h0[r] + alpha * acc[r]; *p = bf1(hv);
            const float sq = row_sum16(hv * hv); if (n == 0) ssm_out[ti * 16 + m] = sq; } }
    __syncthreads();
}
__device__ __forceinline__ void skinny_p(const bf16_t* hb, const bf16_t* Bt, const float* ssm, bf16_t* pr, float* ps, bf16_t* qkv, LAS unsigned char* lds) {
    using namespace cfg; SK_HEAD
    float rs[4] = {0.f, 0.f, 0.f, 0.f};
    if (ti < NIN / 16 && kq == 0) meta_rs(ssm, lane, rs);
    if (ti < NIN / 16) part[(wave * 2) * 64 + lane] = sk_dot<16>(hb + (size_t)(MMAIN + n) * DM + 512 * kq + 8 * g, Bt + (size_t)(16 * ti + n) * DM + 512 * kq + 8 * g);
    __syncthreads();
    if (ti < NIN / 16 && kq == 0) { f32x4 acc; SK_COMBINE(acc, 0); const int np = 16 * ti + n;
#pragma unroll
        for (int r = 0; r < 4; ++r) { const int m = 4 * g + r; const float v = acc[r] * rs[r];
            if (np < 3072) pr[(size_t)(MMAIN + m) * PRW + np] = bf1(v);
            else if (np < 3584) ps[(size_t)(MMAIN + m) * PSW + (np - 3072)] = v;
            else { const bf16_t w = bf1(v);
#pragma unroll
                for (int b = 0; b < NBATCH; ++b) qkv[((size_t)b * SEQP + 48 + m) * QKVW + (np - 3584)] = w; } } }
    __syncthreads();
}
#undef SK_HEAD
#undef SK_COMBINE

namespace fox {
constexpr int D = 128, NW = 8, QBLK = 32, KVBLK = 64, QB = NW * QBLK;
constexpr int LDQ = cfg::QKVW, LDK = cfg::QKVW, LDO = cfg::DM;
constexpr float SCALE = 0.08838834764831845f, THR = 8.f;
constexpr bool WSKIP = false;
constexpr int SHM_V = KVBLK * D * 2, SHM_K = KVBLK * D * 2;
constexpr int ATT_LDS = 2 * SHM_V + 2 * SHM_K + NW * 64 * 4;
constexpr int BIAS_OFF = ATT_LDS;
constexpr int SCAN_OFF = BIAS_OFF + cfg::SEQP * 4;

using bf16 = __hip_bfloat16;
typedef short bf16x8 __attribute__((ext_vector_type(8)));
typedef short s16x4 __attribute__((ext_vector_type(4)));
typedef float f32x16 __attribute__((ext_vector_type(16)));
typedef float f32x4 __attribute__((ext_vector_type(4)));
typedef unsigned u32x4 __attribute__((ext_vector_type(4)));
template <class A, class Bt> struct same_t { static constexpr bool v = false; };
template <class A> struct same_t<A, A> { static constexpr bool v = true; };

#define KSWZ(row, colB) ((row) * 256 + ((colB) ^ (((row) & 7) << 4)))
#define SBAR() __builtin_amdgcn_sched_barrier(0)
__device__ __forceinline__ int v_st(int k, int c) { const int kk = (k & ~0xC) | ((k & 4) << 1) | ((k & 8) >> 1); return ((kk >> 3) * 4 + (c >> 5)) * 512 + ((kk & 7) * 32 + (c & 31)) * 2; }
__device__ __forceinline__ int v_rd_base(int lane) { return ((lane & 3) << 3) | (((lane >> 2) & 3) << 6) | (((lane >> 4) & 1) << 5) | (((lane >> 5) & 1) << 8); }
constexpr int v_rd_off(int d0, int ks, int half) { return d0 * 512 + ks * 4096 + half * 2048; }
__device__ __forceinline__ int crow(int r, int hi) { return (r & 3) + 8 * (r >> 2) + 4 * hi; }
__device__ __forceinline__ unsigned cvtpk(float lo, float hi) {
    unsigned r; asm volatile("v_cvt_pk_bf16_f32 %0, %1, %2" : "=v"(r) : "v"(lo), "v"(hi)); return r;
}
__device__ __forceinline__ bf16x8 pack8(f32x4 a, f32x4 b) {
    u32x4 w = {cvtpk(a[0], a[1]), cvtpk(a[2], a[3]), cvtpk(b[0], b[1]), cvtpk(b[2], b[3])};
    return *reinterpret_cast<bf16x8*>(&w);
}
template <class T> __device__ __forceinline__ bf16x8 load8(const T* p) {
    if constexpr (same_t<T, float>::v) { return pack8(*(const f32x4*)p, *(const f32x4*)(p + 4)); }
    else { return *reinterpret_cast<const bf16x8*>(p); }
}
__device__ __forceinline__ void mask_tile(f32x16& p0, f32x16& p1, int dq, unsigned W) {
    const float NEG = -__builtin_inff();
#pragma unroll
    for (int r = 0; r < 16; ++r) {
        const int c = (r & 3) + 8 * (r >> 2);
        if ((unsigned)(dq - c) >= W) p0[r] = NEG;
        if ((unsigned)(dq - c - 32) >= W) p1[r] = NEG;
    }
}
__device__ __forceinline__ void partialSM(f32x16& p0, f32x16& p1, float& m_reg, float& mn, float& alpha) {
    float pmax = p0[0]; for (int r = 1; r < 16; ++r) pmax = fmaxf(pmax, p0[r]); for (int r = 0; r < 16; ++r) pmax = fmaxf(pmax, p1[r]);
    { auto rr = __builtin_amdgcn_permlane32_swap(__float_as_uint(pmax), __float_as_uint(pmax), false, false);
      pmax = fmaxf(__uint_as_float(rr[0]), __uint_as_float(rr[1])); }
    constexpr float C2 = 1.4426950408889634f * SCALE;
    if (__builtin_expect(__all((pmax - m_reg) * SCALE <= THR), 1)) { mn = m_reg; alpha = 1.f; }
    else { mn = fmaxf(m_reg, pmax); alpha = __builtin_amdgcn_exp2f((m_reg - mn) * C2); m_reg = mn; }
    const float mnL = -mn * C2;
    for (int r = 0; r < 16; ++r) p0[r] = fmaf(p0[r], C2, mnL); for (int r = 0; r < 16; ++r) p1[r] = fmaf(p1[r], C2, mnL);
    for (int r = 0; r < 16; ++r) p0[r] = __builtin_amdgcn_exp2f(p0[r]);
}
__device__ __forceinline__ void finishSM(f32x16& p0, f32x16& p1, float alpha, float& l_reg, bf16x8& pa0, bf16x8& pa1, bf16x8& pa2, bf16x8& pa3) {
    for (int r = 0; r < 16; ++r) p1[r] = __builtin_amdgcn_exp2f(p1[r]);
    float ps = 0; for (int r = 0; r < 16; ++r) ps += p0[r]; for (int r = 0; r < 16; ++r) ps += p1[r];
    { auto rr = __builtin_amdgcn_permlane32_swap(__float_as_uint(ps), __float_as_uint(ps), false, false);
      ps = __uint_as_float(rr[0]) + __uint_as_float(rr[1]); }
    l_reg = l_reg * alpha + ps;
#define PK4(P, B_, OUT) do { unsigned a0 = cvtpk(P[B_+0], P[B_+1]), a1 = cvtpk(P[B_+2], P[B_+3]);                          \
        unsigned b0 = cvtpk(P[B_+4], P[B_+5]), b1 = cvtpk(P[B_+6], P[B_+7]);                                             \
        auto r0 = __builtin_amdgcn_permlane32_swap(a0, b0, false, false); auto r1 = __builtin_amdgcn_permlane32_swap(a1, b1, false, false); \
        u32x4 w = {r0[0], r1[0], r0[1], r1[1]}; OUT = *reinterpret_cast<bf16x8*>(&w); } while (0)
    PK4(p0, 0, pa0); PK4(p0, 8, pa1); PK4(p1, 0, pa2); PK4(p1, 8, pa3);
#undef PK4
}
template <int KB, bool SK>
__device__ __forceinline__ void qkt(f32x16& p0, f32x16& p1, const char* K_lds, int r32, int hi, const bf16x8* qr, bool act, const float* bias_t) {
    if (SK && !act) { const float NEG = -__builtin_inff();
#pragma unroll
        for (int r = 0; r < 16; ++r) { p0[r] = NEG; p1[r] = NEG; } return; }
    {
#pragma unroll
        for (int g_ = 0; g_ < 4; ++g_) { const f32x4 b0_ = *(const f32x4*)(bias_t + 8 * g_ + 4 * hi); const f32x4 b1_ = *(const f32x4*)(bias_t + 32 + 8 * g_ + 4 * hi);
            p0[4 * g_] = b0_[0]; p0[4 * g_ + 1] = b0_[1]; p0[4 * g_ + 2] = b0_[2]; p0[4 * g_ + 3] = b0_[3];
            p1[4 * g_] = b1_[0]; p1[4 * g_ + 1] = b1_[1]; p1[4 * g_ + 2] = b1_[2]; p1[4 * g_ + 3] = b1_[3]; } }
    const char* kb[4];
#pragma unroll
    for (int dd = 0; dd < 4; ++dd) kb[dd] = K_lds + KB * SHM_K + KSWZ(r32, (dd * 16 + hi * 8) * 2);
#pragma unroll
    for (int d0 = 0; d0 < 8; ++d0) { const char* a = kb[d0 & 3] + (d0 >> 2) * 128;
        bf16x8 b0 = *reinterpret_cast<const bf16x8*>(a);
        bf16x8 b1 = *reinterpret_cast<const bf16x8*>(a + 32 * 256);
        p0 = __builtin_amdgcn_mfma_f32_32x32x16_bf16(b0, qr[d0], p0, 0, 0, 0);
        p1 = __builtin_amdgcn_mfma_f32_32x32x16_bf16(b1, qr[d0], p1, 0, 0, 0); }
}
template <int VB, bool SK>
__device__ __forceinline__ void pv_tile(f32x16* o, int vb0, bf16x8 pa0, bf16x8 pa1, bf16x8 pa2, bf16x8 pa3, bool act) {
    if (SK && !act) return;
#define TRRD(dst, off) asm volatile("ds_read_b64_tr_b16 %0, %1 offset:%2" : "=&v"(dst) : "v"(vb0), "i"(off) : "memory")
#define PV_D0(d0) do { s16x4 l0, l1, l2, l3, h0, h1, h2, h3; constexpr int b_ = VB * SHM_V + v_rd_off(d0, 0, 0);     \
        TRRD(l0, b_); TRRD(h0, b_ + 2048); TRRD(l1, b_ + 4096); TRRD(h1, b_ + 6144); TRRD(l2, b_ + 8192); TRRD(h2, b_ + 10240); TRRD(l3, b_ + 12288); TRRD(h3, b_ + 14336); \
        asm volatile("s_waitcnt lgkmcnt(0)" ::: "memory"); SBAR();                 \
        o[d0] = __builtin_amdgcn_mfma_f32_32x32x16_bf16(pa0, (bf16x8){l0[0], l0[1], l0[2], l0[3], h0[0], h0[1], h0[2], h0[3]}, o[d0], 0, 0, 0);   \
        o[d0] = __builtin_amdgcn_mfma_f32_32x32x16_bf16(pa1, (bf16x8){l1[0], l1[1], l1[2], l1[3], h1[0], h1[1], h1[2], h1[3]}, o[d0], 0, 0, 0);   \
        o[d0] = __builtin_amdgcn_mfma_f32_32x32x16_bf16(pa2, (bf16x8){l2[0], l2[1], l2[2], l2[3], h2[0], h2[1], h2[2], h2[3]}, o[d0], 0, 0, 0);   \
        o[d0] = __builtin_amdgcn_mfma_f32_32x32x16_bf16(pa3, (bf16x8){l3[0], l3[1], l3[2], l3[3], h3[0], h3[1], h3[2], h3[3]}, o[d0], 0, 0, 0); } while (0)
    PV_D0(0); PV_D0(1); PV_D0(2); PV_D0(3);
#undef PV_D0
#undef TRRD
}

template <class TIn, class TOut> struct BlockRef { const TIn* Q; const TIn* K; const TIn* V; TOut* O; int P0; };
template <class TIn> struct Seam {
    bf16x8 qr[8];
    bf16x8 st_v0, st_v1, st_k0, st_k1; f32x4 sf0, sf1, sf2, sf3;
    f32x4 tq[16];
};
__device__ __forceinline__ int swa_jlo(int P0, int W) { const int lowk = P0 - W + 1; return lowk > 0 ? lowk / KVBLK : 0; }
#define ROW(p, k0, rr) ((p) + (size_t)((k0) + (rr)) * LDK + sc)
#define VMW() asm volatile("s_waitcnt vmcnt(0)" ::: "memory")
#define VMWN(n) asm volatile("s_waitcnt vmcnt(%0)" :: "i"(n) : "memory")
#define SLOAD_H(Kp, Vp, k0) do { S.st_v0 = load8<TIn>(ROW(Vp, k0, sr)); S.st_v1 = load8<TIn>(ROW(Vp, k0, 32 + sr));              \
                         S.st_k0 = load8<TIn>(ROW(Kp, k0, sr)); S.st_k1 = load8<TIn>(ROW(Kp, k0, 32 + sr)); } while (0)
#define SWRITE_HK(bf) do { *(bf16x8*)(K_lds + (bf) * SHM_K + kws) = S.st_k0; *(bf16x8*)(K_lds + (bf) * SHM_K + kws + 32 * 256) = S.st_k1; } while (0)
#define SWRITE_HV(bf) do { *(bf16x8*)(V_lds + (bf) * SHM_V + vst0) = S.st_v0; *(bf16x8*)(V_lds + (bf) * SHM_V + vst1) = S.st_v1; } while (0)
#define SWRITE_H(bf) do { SWRITE_HV(bf); SWRITE_HK(bf); } while (0)
#define SLOAD_F(p, k0) do { S.sf0 = *(const f32x4*)ROW(p, k0, sr); S.sf1 = *(const f32x4*)(ROW(p, k0, sr) + 4);                \
                            S.sf2 = *(const f32x4*)ROW(p, k0, 32 + sr); S.sf3 = *(const f32x4*)(ROW(p, k0, 32 + sr) + 4); } while (0)
#define SWRITE_KF(bf) do { *(bf16x8*)(K_lds + (bf) * SHM_K + kws) = pack8(S.sf0, S.sf1); *(bf16x8*)(K_lds + (bf) * SHM_K + kws + 32 * 256) = pack8(S.sf2, S.sf3); } while (0)
#define SWRITE_VF(bf) do { *(bf16x8*)(V_lds + (bf) * SHM_V + vst0) = pack8(S.sf0, S.sf1); *(bf16x8*)(V_lds + (bf) * SHM_V + vst1) = pack8(S.sf2, S.sf3); } while (0)
template <class TIn, class TOut>
__device__ __forceinline__ void causal_swa_prime(const BlockRef<TIn, TOut>& cur, int W, char* lds, Seam<TIn>& S) {
    constexpr bool F32 = same_t<TIn, float>::v;
    const int tid = ltid(), wid = __builtin_amdgcn_readfirstlane(tid >> 6), lane = tid & 63, r32 = lane & 31, hi = lane >> 5;
    const int sr = tid >> 4, sc = (tid & 15) * 8, kws = KSWZ(sr, sc * 2); char* K_lds = lds + 2 * SHM_V;
    const int kb0 = swa_jlo(cur.P0, W) * KVBLK;
    for (int d0 = 0; d0 < 8; ++d0) S.qr[d0] = load8<TIn>(cur.Q + (size_t)(wid * QBLK + r32) * LDQ + d0 * 16 + hi * 8);
    if constexpr (F32) { SLOAD_F((const float*)cur.K, kb0); VMW(); SWRITE_KF(0); SBAR(); SLOAD_F((const float*)cur.V, kb0); }
    else { SLOAD_H(cur.K, cur.V, kb0); VMW(); SWRITE_HK(0); }
    __syncthreads();
}
template <class TIn, class TOut>
__device__ __forceinline__ void causal_swa_block(const BlockRef<TIn, TOut>& cur, const BlockRef<TIn, TOut>& nxt, int skv, int W, char* lds, Seam<TIn>& S, const float* bias_l) {
    constexpr bool F32 = same_t<TIn, float>::v;
    const int tid = ltid(), wid = __builtin_amdgcn_readfirstlane(tid >> 6), lane = tid & 63, r32 = lane & 31, hi = lane >> 5;
    const int j_lo = swa_jlo(cur.P0, W);
    int j_hi = (cur.P0 + QB - 1) / KVBLK + 1; if (j_hi > skv / KVBLK) j_hi = skv / KVBLK;
    const int NT = j_hi - j_lo;
    const int kbn = swa_jlo(nxt.P0, W) * KVBLK;
    const int qlo = cur.P0 + wid * QBLK, qm = qlo + r32 - 4 * hi;
    char* V_lds = lds; char* K_lds = lds + 2 * SHM_V;
    float* ws = (float*)(lds + 2 * SHM_V + 2 * SHM_K) + wid * 64; float* li_l = ws, * al_l = ws + 32;
    float m_reg = -1e30f, l_reg = 0; f32x16 o[4] = {};
    const int sr = tid >> 4, sc = (tid & 15) * 8, vst0 = v_st(sr, sc), vst1 = v_st(32 + sr, sc), kws = KSWZ(sr, sc * 2);
    const int vb0 = (int)(uintptr_t)V_lds + v_rd_base(lane);
    const TIn* Kh = cur.K; const TIn* Vh = cur.V;
#define RESC(a) do { if (__any((a) < 1.f)) { if (hi == 0) al_l[r32] = (a); asm volatile("s_waitcnt lgkmcnt(0)" ::: "memory");              \
                     for (int d_ = 0; d_ < 4; ++d_) for (int r = 0; r < 16; ++r) o[d_][r] *= al_l[crow(r, hi)]; } } while (0)
#define KBASE(t) ((j_lo + (t)) * KVBLK)
#define ACT(t) (KBASE(t) <= qlo + QBLK - 1 && KBASE(t) + KVBLK - 1 >= qlo - W + 1)
#define MASKT(P0_, P1_, t) do { const int kb_ = KBASE(t); if ((!SK || ACT(t)) && (kb_ + KVBLK - 1 > qlo || kb_ <= qlo + QBLK - 1 - W)) mask_tile(P0_, P1_, qm - kb_, (unsigned)W); } while (0)
    constexpr int NQL = F32 ? 16 : 8;
    constexpr bool SK = WSKIP && !F32;
#define SEAM_K0() do { VMWN(NQL); if constexpr (F32) { SWRITE_KF(0); SBAR(); SLOAD_F((const float*)nxt.V, kbn); } else { SWRITE_HK(0); } SBAR(); } while (0)
    f32x16 pA0, pA1, pB0, pB1; float mnA, mnB, alA, alB; bf16x8 pa0, pa1, pa2, pa3;
    if constexpr (F32) { VMW(); SWRITE_VF(0); SBAR(); } else { SWRITE_HV(0); SBAR(); }
    if (NT > 1) { if constexpr (F32) SLOAD_F((const float*)Kh, KBASE(1)); else SLOAD_H(Kh, Vh, KBASE(1)); }
    SBAR(); qkt<0, SK>(pA0, pA1, K_lds, r32, hi, S.qr, ACT(0), bias_l + KBASE(0));
    if constexpr (F32) { if (NT > 1) { VMW(); SWRITE_KF(1); SBAR(); SLOAD_F((const float*)Vh, KBASE(1)); } }
    MASKT(pA0, pA1, 0); partialSM(pA0, pA1, m_reg, mnA, alA);
    if (NT > 1) { VMW(); if constexpr (F32) { SWRITE_VF(1); SBAR(); if (NT > 2) SLOAD_F((const float*)Kh, KBASE(2)); } else SWRITE_H(1); }
    __syncthreads();
#define HALF_STEP(PX0, PX1, mnX, alX, PY0, PY1, alY, t, KB, VB, SB) do {                                                      \
        SBAR(); qkt<KB, SK>(PX0, PX1, K_lds, r32, hi, S.qr, ACT(t), bias_l + KBASE(t));                                             \
        finishSM(PY0, PY1, alY, l_reg, pa0, pa1, pa2, pa3); SBAR();                                                           \
        if ((t) + 1 < NT) { if constexpr (F32) { VMW(); SWRITE_KF(SB); SBAR(); SLOAD_F((const float*)Vh, KBASE((t) + 1)); }  \
                            else { SLOAD_H(Kh, Vh, KBASE((t) + 1)); } SBAR(); }                                               \
        pv_tile<VB, SK>(o, vb0, pa0, pa1, pa2, pa3, ACT((t) - 1)); MASKT(PX0, PX1, (t)); partialSM(PX0, PX1, m_reg, mnX, alX);                                        \
        __syncthreads();                                                                                                      \
        if ((t) + 1 < NT) { VMW(); if constexpr (F32) { SWRITE_VF(SB); SBAR(); if ((t) + 2 < NT) SLOAD_F((const float*)Kh, KBASE((t) + 2)); } \
                            else { SWRITE_H(SB); } }                                                                          \
        RESC(alX); __syncthreads(); } while (0)
    for (int t = 1; t + 1 < NT; t += 2) {
        HALF_STEP(pB0, pB1, mnB, alB, pA0, pA1, alA, t, 1, 0, 0);
        HALF_STEP(pA0, pA1, mnA, alA, pB0, pB1, alB, t + 1, 0, 1, 1);
    }
    const bool even = (NT & 1) == 0;
    if (even) { SBAR(); qkt<1, SK>(pB0, pB1, K_lds, r32, hi, S.qr, ACT(NT - 1), bias_l + KBASE(NT - 1)); SBAR(); }
#define QROW(e) (nxt.Q + (size_t)(wid * QBLK + r32) * LDQ + ((e) >> 1) * 16 + hi * 8 + ((e) & 1) * 4)
    if constexpr (F32) { SLOAD_F((const float*)nxt.K, kbn); SBAR();
#pragma unroll
        for (int e = 0; e < 8; ++e) S.tq[e] = *(const f32x4*)QROW(e); }
    else { SLOAD_H(nxt.K, nxt.V, kbn); SBAR();
#pragma unroll
        for (int d0 = 0; d0 < 8; ++d0) S.qr[d0] = load8<TIn>(nxt.Q + (size_t)(wid * QBLK + r32) * LDQ + d0 * 16 + hi * 8); }
    SBAR();
    finishSM(pA0, pA1, alA, l_reg, pa0, pa1, pa2, pa3); SBAR();
    if constexpr (F32) {
#pragma unroll
        for (int e = 8; e < 16; ++e) S.tq[e] = *(const f32x4*)QROW(e); SBAR(); }
#undef QROW
    pv_tile<0, SK>(o, vb0, pa0, pa1, pa2, pa3, ACT(even ? NT - 2 : NT - 1));
    if (even) { MASKT(pB0, pB1, NT - 1); partialSM(pB0, pB1, m_reg, mnB, alB); __syncthreads(); RESC(alB);
        finishSM(pB0, pB1, alB, l_reg, pa0, pa1, pa2, pa3); SBAR(); pv_tile<1, SK>(o, vb0, pa0, pa1, pa2, pa3, ACT(NT - 1)); }
    SBAR(); SEAM_K0();
    if (hi == 0) li_l[r32] = l_reg; asm volatile("s_waitcnt lgkmcnt(0)" ::: "memory");
    float rli[16];
#pragma unroll
    for (int r = 0; r < 16; ++r) rli[r] = __builtin_amdgcn_rcpf(li_l[crow(r, hi)]);
    TOut* Ow = cur.O + (size_t)(wid * QBLK) * LDO;
#pragma unroll
    for (int r = 0; r < 16; ++r) { const int orow = crow(r, hi);
#pragma unroll
        for (int d0 = 0; d0 < 4; ++d0) { const float v = o[d0][r] * rli[r];
            if constexpr (same_t<TOut, float>::v) { Ow[(size_t)orow * LDO + d0 * 32 + r32] = v; }
            else { const float vn = __shfl_xor(v, 1);
                   if ((r32 & 1) == 0) *(unsigned*)(Ow + (size_t)orow * LDO + d0 * 32 + r32) = cvtpk(v, vn); } } }
    if constexpr (F32) {
#pragma unroll
        for (int d0 = 0; d0 < 8; ++d0) S.qr[d0] = pack8(S.tq[2 * d0], S.tq[2 * d0 + 1]); }
    __syncthreads();
#undef RESC
#undef KBASE
#undef ACT
#undef MASKT
#undef SEAM_K0
#undef HALF_STEP
}
#undef ROW
#undef VMW
#undef VMWN
#undef SLOAD_H
#undef SWRITE_HK
#undef SWRITE_HV
#undef SWRITE_H
#undef SLOAD_F
#undef SWRITE_KF

}

__device__ __forceinline__ void fox_bias(PP P, int l, int b, int h, float* bias, float* scr) {
    using namespace cfg;
    const int tid = ltid(), lane = tid & 63, wave = tid >> 6;
    const float* PS = (const float*)(P->ws + WS_PS); const float bf = P->in[I_BF][l * FNH + h];
    float lf[9]; float loc = 0.f;
#pragma unroll
    for (int i = 0; i < 9; ++i) { const int pos = tid * 9 + i; float v = 0.f;
        if (pos < NMETA + SEQ) { const int row = pos < NMETA ? MMAIN + pos : b * SEQ + pos - NMETA; const float z = PS[(size_t)row * PSW + 288 + h] + bf;
            v = fminf(z, 0.f) - log1pf(__expf(-fabsf(z))); }
        loc += v; lf[i] = loc; }
    float inc = loc;
#pragma unroll
    for (int o = 1; o < 64; o <<= 1) { const float t = __shfl_up(inc, o); if (lane >= o) inc += t; }
    if (lane == 63) scr[wave] = inc;
    __syncthreads();
    float base = inc - loc;
    for (int w = 0; w < wave; ++w) base += scr[w];
    constexpr float INV = 1.0f / fox::SCALE;
#pragma unroll
    for (int i = 0; i < 9; ++i) { const int pos = tid * 9 + i; if (pos < NMETA + SEQ) bias[48 + pos] = -(base + lf[i]) * INV; }
    if (tid < 48) bias[tid] = -__builtin_inff();
    __syncthreads();
}
__device__ __forceinline__ void fox_meta(PP P, int h, const float* bias) {
    using namespace cfg;
    const int lane = ltid() & 63, wave = ltid() >> 6;
    const bf16_t* QKV = (const bf16_t*)(P->ws + WS_QKV); bf16_t* Y = (bf16_t*)(P->ws + WS_Y);
    for (int rep = 0; rep < 2; ++rep) { const int i = wave + 8 * rep;
        float s = -__builtin_inff();
        if (lane <= i) { const bf16_t* q = QKV + (size_t)(48 + i) * QKVW + h * 128; const bf16_t* k = QKV + (size_t)(48 + lane) * QKVW + 1024 + h * 128; float dot = 0.f;
            for (int d = 0; d < 128; ++d) dot += bf2f(q[d]) * bf2f(k[d]);
            s = (dot + bias[48 + lane]) * fox::SCALE; }
        const float m = wave_max(s); const float p = (lane <= i) ? __expf(s - m) : 0.f; const float lsum = wave_sum(p);
        float o0 = 0.f, o1 = 0.f;
        for (int j = 0; j <= i; ++j) { const float pj = __shfl(p, j); const bf16_t* v = QKV + (size_t)(48 + j) * QKVW + 2048 + h * 128; o0 += pj * bf2f(v[lane]); o1 += pj * bf2f(v[64 + lane]); }
        const float il = 1.0f / lsum;
        Y[(size_t)(MMAIN + i) * DM + 1024 + h * 128 + lane] = (bf16_t)(pk_bf16(o0 * il, 0.f) & 0xffffu);
        Y[(size_t)(MMAIN + i) * DM + 1024 + h * 128 + 64 + lane] = (bf16_t)(pk_bf16(o1 * il, 0.f) & 0xffffu); }
}
__device__ __forceinline__ fox::BlockRef<__hip_bfloat16, __hip_bfloat16> fox_mk(int a, int idx, const __hip_bfloat16* Qb, const __hip_bfloat16* Kb, const __hip_bfloat16* Vb, __hip_bfloat16* Ob) {
    const int pr = 4 * (a & 1) + (idx >> 1); const int x = (idx & 1) ? 15 - pr : pr;
    fox::BlockRef<__hip_bfloat16, __hip_bfloat16> r; r.Q = Qb + (size_t)x * 256 * cfg::QKVW; r.K = Kb; r.V = Vb; r.O = Ob + (size_t)x * 256 * cfg::DM; r.P0 = 64 + 256 * x; return r; }
__device__ __forceinline__ void fox_wg(PP P, int l, int a, char* lds) {
    using namespace cfg;
    typedef __hip_bfloat16 bf;
    const int bh = a >> 1, b = bh >> 3, h = bh & 7;
    float* bias = (float*)(lds + fox::BIAS_OFF); float* scr = (float*)(lds + fox::SCAN_OFF);
    fox_bias(P, l, b, h, bias, scr);
    const bf* QKV = (const bf*)(P->ws + WS_QKV); bf* Y = (bf*)(P->ws + WS_Y);
    const bf* Kb = QKV + (size_t)b * SEQP * QKVW + 1024 + h * 128; const bf* Vb = Kb + 1024; const bf* Qb = QKV + ((size_t)b * SEQP + 64) * QKVW + h * 128;
    bf* Ob = Y + (size_t)b * SEQ * DM + 1024 + h * 128;
    constexpr int W = 1 << 30;
    fox::Seam<bf> S;
    fox::BlockRef<bf, bf> cur = fox_mk(a, 0, Qb, Kb, Vb, Ob);
    fox::causal_swa_prime<bf, bf>(cur, W, lds, S);
#pragma unroll 1
    for (int idx = 0; idx < 8; ++idx) {
        const fox::BlockRef<bf, bf> nxt = (idx < 7) ? fox_mk(a, idx + 1, Qb, Kb, Vb, Ob) : cur;
        fox::causal_swa_block<bf, bf>(cur, nxt, SEQP, W, lds, S, bias);
        cur = nxt;
    }
    if (b == 0) fox_meta(P, h, bias);
}

#define WS_PTR(T, off) ((T*)(Q->ws + (off)))
#define SEAM() do { PP Qb_ = launder(P); XcdBarrier b_; b_.bar = (unsigned*)(Qb_->ws + WS_CTL); b_.x = xb_xcc_id(); b_.st = (volatile LAS unsigned*)(lds + LDS_BARW); xcd_barrier(b_); } while (0)
__global__ void __launch_bounds__(512, 2) hymba_fwd(Params Pv) {
    using namespace cfg;
    PP P = (PP)__builtin_amdgcn_kernarg_segment_ptr();
    extern __shared__ __attribute__((aligned(16))) unsigned char lds_raw[];
    LAS unsigned char* lds = (LAS unsigned char*)lds_raw;
    if (threadIdx.x < 4) ((LAS unsigned*)(lds + LDS_BARW))[threadIdx.x] = 0u;
    __syncthreads();
    { PP Q = launder(P); (void)xcd_barrier_post((unsigned*)(Q->ws + WS_CTL), (volatile LAS unsigned*)(lds + LDS_BARW)); }

    { PP Q = launder(P); phase_convert(Q, lds, 0, 1, lbid(), (int)gridDim.x); phase_init(Q); }
    SEAM();
    {
        PP Q = launder(P); const unsigned char* wl = Q->ws + WS_W + (size_t)0 * W_LAYER;
        pg8::Gemm g{WS_PTR(const bf16_t, WS_HB), (const bf16_t*)(wl + WO_GU1), MMAIN, NGU, DM}; pg8::StaticOrder S; S.init(MMAIN, NGU, (int)gridDim.x, lbid(), 4, 1);
        pg8::EpiGU E{WS_PTR(bf16_t, WS_ACT), WS_PTR(const float, WS_SS) + (size_t)(0) * 8 * MROWS, (LAS float*)(lds + 131072 + 4096)};
        pg8::gemm_phase<pg8::EpiGU, pg8::StaticOrder, true, true>(lds, g, S, E);
        skinny_gu(WS_PTR(const bf16_t, WS_HB), g.Bt, WS_PTR(const float, WS_SSM) + (0) * 2048, WS_PTR(bf16_t, WS_ACT), lds);
    }
    SEAM();
    {
        PP Q = launder(P); const unsigned char* wl = Q->ws + WS_W + (size_t)0 * W_LAYER;
        pg8::Gemm g{WS_PTR(const bf16_t, WS_ACT), (const bf16_t*)(wl + WO_D1), MMAIN, DM, DFF}; pg8::StaticOrder S; S.init(MMAIN, DM, (int)gridDim.x, lbid(), 4, 0);
        pg8::EpiRes E{WS_PTR(bf16_t, WS_HB), WS_PTR(float, WS_SS) + (size_t)(1) * 8 * MROWS, 0.5f, (LAS float*)(lds + 131072)};
        pg8::gemm_phase<pg8::EpiRes, pg8::StaticOrder, true, true>(lds, g, S, E);
        skinny_res<DFF>(WS_PTR(const bf16_t, WS_ACT) + (size_t)MMAIN * DFF, g.Bt, WS_PTR(bf16_t, WS_HB), WS_PTR(float, WS_SSM) + (1) * 2048, 0.5f, lds);
    }
    SEAM();
    {
        PP Q = launder(P); const unsigned char* wl = Q->ws + WS_W + (size_t)0 * W_LAYER;
        pg8::Gemm g{WS_PTR(const bf16_t, WS_HB), (const bf16_t*)(wl + WO_IN), MMAIN, NIN, DM}; pg8::StaticOrder S; S.init(MMAIN, NIN, (int)gridDim.x, lbid(), 8, 1);
        pg8::EpiP E{WS_PTR(bf16_t, WS_PR), WS_PTR(float, WS_PS), WS_PTR(bf16_t, WS_QKV), WS_PTR(const float, WS_SS) + (size_t)(1) * 8 * MROWS, (LAS float*)(lds + 131072 + 4096)};
        pg8::gemm_phase<pg8::EpiP, pg8::StaticOrder, true, true>(lds, g, S, E);
        skinny_p(WS_PTR(const bf16_t, WS_HB), g.Bt, WS_PTR(const float, WS_SSM) + (1) * 2048, WS_PTR(bf16_t, WS_PR), WS_PTR(float, WS_PS), WS_PTR(bf16_t, WS_QKV), lds);
    }
    SEAM();
    { PP Q = launder(P); phase_lx(Q, 0); }
    SEAM();
    {
        PP Q = launder(P); const int u = lbid();
        if (u < 128) { rwkv_chunked(Q, 0, u >> 4, u & 15, lds); __syncthreads(); phase_convert(launder(P), lds, 1, 2, u, 128, 19968, 21248); }
        else { fox_wg(Q, 0, u - 128, (char*)lds_raw); __syncthreads(); phase_convert(launder(P), lds, 1, 2, u - 128, 128, 0, 19968); }
    }
    SEAM();
    { PP Q = launder(P); phase_foxnorm(Q); }
    SEAM();
    {
        PP Q = launder(P); const unsigned char* wl = Q->ws + WS_W + (size_t)0 * W_LAYER;
        pg8::Gemm g{WS_PTR(const bf16_t, WS_Y), (const bf16_t*)(wl + WO_OUT), MMAIN, DM, DM}; pg8::StaticOrder S; S.init(MMAIN, DM, (int)gridDim.x, lbid(), 4, 0);
        pg8::EpiRes E{WS_PTR(bf16_t, WS_HB), WS_PTR(float, WS_SS) + (size_t)(2) * 8 * MROWS, 1.0f, (LAS float*)(lds + 131072)};
        pg8::gemm_phase<pg8::EpiRes, pg8::StaticOrder, true, true>(lds, g, S, E);
        skinny_res<DM>(WS_PTR(const bf16_t, WS_Y) + (size_t)MMAIN * DM, g.Bt, WS_PTR(bf16_t, WS_HB), WS_PTR(float, WS_SSM) + (2) * 2048, 1.0f, lds);
    }
    SEAM();
    {
        PP Q = launder(P); const unsigned char* wl = Q->ws + WS_W + (size_t)0 * W_LAYER;
        pg8::Gemm g{WS_PTR(const bf16_t, WS_HB), (const bf16_t*)(wl + WO_GU2), MMAIN, NGU, DM}; pg8::StaticOrder S; S.init(MMAIN, NGU, (int)gridDim.x, lbid(), 4, 1);
        pg8::EpiGU E{WS_PTR(bf16_t, WS_ACT), WS_PTR(const float, WS_SS) + (size_t)(2) * 8 * MROWS, (LAS float*)(lds + 131072 + 4096)};
        pg8::gemm_phase<pg8::EpiGU, pg8::StaticOrder, true, true>(lds, g, S, E);
        skinny_gu(WS_PTR(const bf16_t, WS_HB), g.Bt, WS_PTR(const float, WS_SSM) + (2) * 2048, WS_PTR(bf16_t, WS_ACT), lds);
    }
    SEAM();
    {
        PP Q = launder(P); const unsigned char* wl = Q->ws + WS_W + (size_t)0 * W_LAYER;
        pg8::Gemm g{WS_PTR(const bf16_t, WS_ACT), (const bf16_t*)(wl + WO_D2), MMAIN, DM, DFF}; pg8::StaticOrder S; S.init(MMAIN, DM, (int)gridDim.x, lbid(), 4, 0);
        pg8::EpiRes E{WS_PTR(bf16_t, WS_HB), WS_PTR(float, WS_SS) + (size_t)(3) * 8 * MROWS, 0.5f, (LAS float*)(lds + 131072)};
        pg8::gemm_phase<pg8::EpiRes, pg8::StaticOrder, true, true>(lds, g, S, E);
        skinny_res<DFF>(WS_PTR(const bf16_t, WS_ACT) + (size_t)MMAIN * DFF, g.Bt, WS_PTR(bf16_t, WS_HB), WS_PTR(float, WS_SSM) + (3) * 2048, 0.5f, lds);
    }
    SEAM();
    {
        PP Q = launder(P); const unsigned char* wl = Q->ws + WS_W + (size_t)1 * W_LAYER;
        pg8::Gemm g{WS_PTR(const bf16_t, WS_HB), (const bf16_t*)(wl + WO_GU1), MMAIN, NGU, DM}; pg8::StaticOrder S; S.init(MMAIN, NGU, (int)gridDim.x, lbid(), 4, 1);
        pg8::EpiGU E{WS_PTR(bf16_t, WS_ACT), WS_PTR(const float, WS_SS) + (size_t)(3) * 8 * MROWS, (LAS float*)(lds + 131072 + 4096)};
        pg8::gemm_phase<pg8::EpiGU, pg8::StaticOrder, true, true>(lds, g, S, E);
        skinny_gu(WS_PTR(const bf16_t, WS_HB), g.Bt, WS_PTR(const float, WS_SSM) + (3) * 2048, WS_PTR(bf16_t, WS_ACT), lds);
    }
    SEAM();
    {
        PP Q = launder(P); const unsigned char* wl = Q->ws + WS_W + (size_t)1 * W_LAYER;
        pg8::Gemm g{WS_PTR(const bf16_t, WS_ACT), (const bf16_t*)(wl + WO_D1), MMAIN, DM, DFF}; pg8::StaticOrder S; S.init(MMAIN, DM, (int)gridDim.x, lbid(), 4, 0);
        pg8::EpiRes E{WS_PTR(bf16_t, WS_HB), WS_PTR(float, WS_SS) + (size_t)(4) * 8 * MROWS, 0.5f, (LAS float*)(lds + 131072)};
        pg8::gemm_phase<pg8::EpiRes, pg8::StaticOrder, true, true>(lds, g, S, E);
        skinny_res<DFF>(WS_PTR(const bf16_t, WS_ACT) + (size_t)MMAIN * DFF, g.Bt, WS_PTR(bf16_t, WS_HB), WS_PTR(float, WS_SSM) + (4) * 2048, 0.5f, lds);
    }
    SEAM();
    {
        PP Q = launder(P); const unsigned char* wl = Q->ws + WS_W + (size_t)1 * W_LAYER;
        pg8::Gemm g{WS_PTR(const bf16_t, WS_HB), (const bf16_t*)(wl + WO_IN), MMAIN, NIN, DM}; pg8::StaticOrder S; S.init(MMAIN, NIN, (int)gridDim.x, lbid(), 8, 1);
        pg8::EpiP E{WS_PTR(bf16_t, WS_PR), WS_PTR(float, WS_PS), WS_PTR(bf16_t, WS_QKV), WS_PTR(const float, WS_SS) + (size_t)(4) * 8 * MROWS, (LAS float*)(lds + 131072 + 4096)};
        pg8::gemm_phase<pg8::EpiP, pg8::StaticOrder, true, true>(lds, g, S, E);
        skinny_p(WS_PTR(const bf16_t, WS_HB), g.Bt, WS_PTR(const float, WS_SSM) + (4) * 2048, WS_PTR(bf16_t, WS_PR), WS_PTR(float, WS_PS), WS_PTR(bf16_t, WS_QKV), lds);
    }
    SEAM();
    { PP Q = launder(P); phase_lx(Q, 1); }
    SEAM();
    {
        PP Q = launder(P); const int u = lbid();
        if (u < 128) { rwkv_chunked(Q, 1, u >> 4, u & 15, lds); __syncthreads(); phase_convert(launder(P), lds, 2, 3, u, 128, 19968, 21248); }
        else { fox_wg(Q, 1, u - 128, (char*)lds_raw); __syncthreads(); phase_convert(launder(P), lds, 2, 3, u - 128, 128, 0, 19968); }
    }
    SEAM();
    { PP Q = launder(P); phase_foxnorm(Q); }
    SEAM();
    {
        PP Q = launder(P); const unsigned char* wl = Q->ws + WS_W + (size_t)1 * W_LAYER;
        pg8::Gemm g{WS_PTR(const bf16_t, WS_Y), (const bf16_t*)(wl + WO_OUT), MMAIN, DM, DM}; pg8::StaticOrder S; S.init(MMAIN, DM, (int)gridDim.x, lbid(), 4, 0);
        pg8::EpiRes E{WS_PTR(bf16_t, WS_HB), WS_PTR(float, WS_SS) + (size_t)(5) * 8 * MROWS, 1.0f, (LAS float*)(lds + 131072)};
        pg8::gemm_phase<pg8::EpiRes, pg8::StaticOrder, true, true>(lds, g, S, E);
        skinny_res<DM>(WS_PTR(const bf16_t, WS_Y) + (size_t)MMAIN * DM, g.Bt, WS_PTR(bf16_t, WS_HB), WS_PTR(float, WS_SSM) + (5) * 2048, 1.0f, lds);
    }
    SEAM();
    {
        PP Q = launder(P); const unsigned char* wl = Q->ws + WS_W + (size_t)1 * W_LAYER;
        pg8::Gemm g{WS_PTR(const bf16_t, WS_HB), (const bf16_t*)(wl + WO_GU2), MMAIN, NGU, DM}; pg8::StaticOrder S; S.init(MMAIN, NGU, (int)gridDim.x, lbid(), 4, 1);
        pg8::EpiGU E{WS_PTR(bf16_t, WS_ACT), WS_PTR(const float, WS_SS) + (size_t)(5) * 8 * MROWS, (LAS float*)(lds + 131072 + 4096)};
        pg8::gemm_phase<pg8::EpiGU, pg8::StaticOrder, true, true>(lds, g, S, E);
        skinny_gu(WS_PTR(const bf16_t, WS_HB), g.Bt, WS_PTR(const float, WS_SSM) + (5) * 2048, WS_PTR(bf16_t, WS_ACT), lds);
    }
    SEAM();
    {
        PP Q = launder(P); const unsigned char* wl = Q->ws + WS_W + (size_t)1 * W_LAYER;
        pg8::Gemm g{WS_PTR(const bf16_t, WS_ACT), (const bf16_t*)(wl + WO_D2), MMAIN, DM, DFF}; pg8::StaticOrder S; S.init(MMAIN, DM, (int)gridDim.x, lbid(), 4, 0);
        pg8::EpiRes E{WS_PTR(bf16_t, WS_HB), WS_PTR(float, WS_SS) + (size_t)(6) * 8 * MROWS, 0.5f, (LAS float*)(lds + 131072)};
        pg8::gemm_phase<pg8::EpiRes, pg8::StaticOrder, true, true>(lds, g, S, E);
        skinny_res<DFF>(WS_PTR(const bf16_t, WS_ACT) + (size_t)MMAIN * DFF, g.Bt, WS_PTR(bf16_t, WS_HB), WS_PTR(float, WS_SSM) + (6) * 2048, 0.5f, lds);
    }
    SEAM();
    {
        PP Q = launder(P); const unsigned char* wl = Q->ws + WS_W + (size_t)2 * W_LAYER;
        pg8::Gemm g{WS_PTR(const bf16_t, WS_HB), (const bf16_t*)(wl + WO_GU1), MMAIN, NGU, DM}; pg8::StaticOrder S; S.init(MMAIN, NGU, (int)gridDim.x, lbid(), 4, 1);
        pg8::EpiGU E{WS_PTR(bf16_t, WS_ACT), WS_PTR(const float, WS_SS) + (size_t)(6) * 8 * MROWS, (LAS float*)(lds + 131072 + 4096)};
        pg8::gemm_phase<pg8::EpiGU, pg8::StaticOrder, true, true>(lds, g, S, E);
        skinny_gu(WS_PTR(const bf16_t, WS_HB), g.Bt, WS_PTR(const float, WS_SSM) + (6) * 2048, WS_PTR(bf16_t, WS_ACT), lds);
    }
    SEAM();
    {
        PP Q = launder(P); const unsigned char* wl = Q->ws + WS_W + (size_t)2 * W_LAYER;
        pg8::Gemm g{WS_PTR(const bf16_t, WS_ACT), (const bf16_t*)(wl + WO_D1), MMAIN, DM, DFF}; pg8::StaticOrder S; S.init(MMAIN, DM, (int)gridDim.x, lbid(), 4, 0);
        pg8::EpiRes E{WS_PTR(bf16_t, WS_HB), WS_PTR(float, WS_SS) + (size_t)(7) * 8 * MROWS, 0.5f, (LAS float*)(lds + 131072)};
        pg8::gemm_phase<pg8::EpiRes, pg8::StaticOrder, true, true>(lds, g, S, E);
        skinny_res<DFF>(WS_PTR(const bf16_t, WS_ACT) + (size_t)MMAIN * DFF, g.Bt, WS_PTR(bf16_t, WS_HB), WS_PTR(float, WS_SSM) + (7) * 2048, 0.5f, lds);
    }
    SEAM();
    {
        PP Q = launder(P); const unsigned char* wl = Q->ws + WS_W + (size_t)2 * W_LAYER;
        pg8::Gemm g{WS_PTR(const bf16_t, WS_HB), (const bf16_t*)(wl + WO_IN), MMAIN, NIN, DM}; pg8::StaticOrder S; S.init(MMAIN, NIN, (int)gridDim.x, lbid(), 8, 1);
        pg8::EpiP E{WS_PTR(bf16_t, WS_PR), WS_PTR(float, WS_PS), WS_PTR(bf16_t, WS_QKV), WS_PTR(const float, WS_SS) + (size_t)(7) * 8 * MROWS, (LAS float*)(lds + 131072 + 4096)};
        pg8::gemm_phase<pg8::EpiP, pg8::StaticOrder, true, true>(lds, g, S, E);
        skinny_p(WS_PTR(const bf16_t, WS_HB), g.Bt, WS_PTR(const float, WS_SSM) + (7) * 2048, WS_PTR(bf16_t, WS_PR), WS_PTR(float, WS_PS), WS_PTR(bf16_t, WS_QKV), lds);
    }
    SEAM();
    { PP Q = launder(P); phase_lx(Q, 2); }
    SEAM();
    {
        PP Q = launder(P); const int u = lbid();
        if (u < 128) { rwkv_chunked(Q, 2, u >> 4, u & 15, lds); __syncthreads(); phase_convert(launder(P), lds, 3, 4, u, 128, 19968, 21248); }
        else { fox_wg(Q, 2, u - 128, (char*)lds_raw); __syncthreads(); phase_convert(launder(P), lds, 3, 4, u - 128, 128, 0, 19968); }
    }
    SEAM();
    { PP Q = launder(P); phase_foxnorm(Q); }
    SEAM();
    {
        PP Q = launder(P); const unsigned char* wl = Q->ws + WS_W + (size_t)2 * W_LAYER;
        pg8::Gemm g{WS_PTR(const bf16_t, WS_Y), (const bf16_t*)(wl + WO_OUT), MMAIN, DM, DM}; pg8::StaticOrder S; S.init(MMAIN, DM, (int)gridDim.x, lbid(), 4, 0);
        pg8::EpiRes E{WS_PTR(bf16_t, WS_HB), WS_PTR(float, WS_SS) + (size_t)(8) * 8 * MROWS, 1.0f, (LAS float*)(lds + 131072)};
        pg8::gemm_phase<pg8::EpiRes, pg8::StaticOrder, true, true>(lds, g, S, E);
        skinny_res<DM>(WS_PTR(const bf16_t, WS_Y) + (size_t)MMAIN * DM, g.Bt, WS_PTR(bf16_t, WS_HB), WS_PTR(float, WS_SSM) + (8) * 2048, 1.0f, lds);
    }
    SEAM();
    {
        PP Q = launder(P); const unsigned char* wl = Q->ws + WS_W + (size_t)2 * W_LAYER;
        pg8::Gemm g{WS_PTR(const bf16_t, WS_HB), (const bf16_t*)(wl + WO_GU2), MMAIN, NGU, DM}; pg8::StaticOrder S; S.init(MMAIN, NGU, (int)gridDim.x, lbid(), 4, 1);
        pg8::EpiGU E{WS_PTR(bf16_t, WS_ACT), WS_PTR(const float, WS_SS) + (size_t)(8) * 8 * MROWS, (LAS float*)(lds + 131072 + 4096)};
        pg8::gemm_phase<pg8::EpiGU, pg8::StaticOrder, true, true>(lds, g, S, E);
        skinny_gu(WS_PTR(const bf16_t, WS_HB), g.Bt, WS_PTR(const float, WS_SSM) + (8) * 2048, WS_PTR(bf16_t, WS_ACT), lds);
    }
    SEAM();
    {
        PP Q = launder(P); const unsigned char* wl = Q->ws + WS_W + (size_t)2 * W_LAYER;
        pg8::Gemm g{WS_PTR(const bf16_t, WS_ACT), (const bf16_t*)(wl + WO_D2), MMAIN, DM, DFF}; pg8::StaticOrder S; S.init(MMAIN, DM, (int)gridDim.x, lbid(), 4, 0);
        pg8::EpiRes E{WS_PTR(bf16_t, WS_HB), WS_PTR(float, WS_SS) + (size_t)(9) * 8 * MROWS, 0.5f, (LAS float*)(lds + 131072)};
        pg8::gemm_phase<pg8::EpiRes, pg8::StaticOrder, true, true>(lds, g, S, E);
        skinny_res<DFF>(WS_PTR(const bf16_t, WS_ACT) + (size_t)MMAIN * DFF, g.Bt, WS_PTR(bf16_t, WS_HB), WS_PTR(float, WS_SSM) + (9) * 2048, 0.5f, lds);
    }
    SEAM();
    {
        PP Q = launder(P); const unsigned char* wl = Q->ws + WS_W + (size_t)3 * W_LAYER;
        pg8::Gemm g{WS_PTR(const bf16_t, WS_HB), (const bf16_t*)(wl + WO_GU1), MMAIN, NGU, DM}; pg8::StaticOrder S; S.init(MMAIN, NGU, (int)gridDim.x, lbid(), 4, 1);
        pg8::EpiGU E{WS_PTR(bf16_t, WS_ACT), WS_PTR(const float, WS_SS) + (size_t)(9) * 8 * MROWS, (LAS float*)(lds + 131072 + 4096)};
        pg8::gemm_phase<pg8::EpiGU, pg8::StaticOrder, true, true>(lds, g, S, E);
        skinny_gu(WS_PTR(const bf16_t, WS_HB), g.Bt, WS_PTR(const float, WS_SSM) + (9) * 2048, WS_PTR(bf16_t, WS_ACT), lds);
    }
    SEAM();
    {
        PP Q = launder(P); const unsigned char* wl = Q->ws + WS_W + (size_t)3 * W_LAYER;
        pg8::Gemm g{WS_PTR(const bf16_t, WS_ACT), (const bf16_t*)(wl + WO_D1), MMAIN, DM, DFF}; pg8::StaticOrder S; S.init(MMAIN, DM, (int)gridDim.x, lbid(), 4, 0);
        pg8::EpiRes E{WS_PTR(bf16_t, WS_HB), WS_PTR(float, WS_SS) + (size_t)(10) * 8 * MROWS, 0.5f, (LAS float*)(lds + 131072)};
        pg8::gemm_phase<pg8::EpiRes, pg8::StaticOrder, true, true>(lds, g, S, E);
        skinny_res<DFF>(WS_PTR(const bf16_t, WS_ACT) + (size_t)MMAIN * DFF, g.Bt, WS_PTR(bf16_t, WS_HB), WS_PTR(float, WS_SSM) + (10) * 2048, 0.5f, lds);
    }
    SEAM();
    {
        PP Q = launder(P); const unsigned char* wl = Q->ws + WS_W + (size_t)3 * W_LAYER;
        pg8::Gemm g{WS_PTR(const bf16_t, WS_HB), (const bf16_t*)(wl + WO_IN), MMAIN, NIN, DM}; pg8::StaticOrder S; S.init(MMAIN, NIN, (int)gridDim.x, lbid(), 8, 1);
        pg8::EpiP E{WS_PTR(bf16_t, WS_PR), WS_PTR(float, WS_PS), WS_PTR(bf16_t, WS_QKV), WS_PTR(const float, WS_SS) + (size_t)(10) * 8 * MROWS, (LAS float*)(lds + 131072 + 4096)};
        pg8::gemm_phase<pg8::EpiP, pg8::StaticOrder, true, true>(lds, g, S, E);
        skinny_p(WS_PTR(const bf16_t, WS_HB), g.Bt, WS_PTR(const float, WS_SSM) + (10) * 2048, WS_PTR(bf16_t, WS_PR), WS_PTR(float, WS_PS), WS_PTR(bf16_t, WS_QKV), lds);
    }
    SEAM();
    { PP Q = launder(P); phase_lx(Q, 3); }
    SEAM();
    {
        PP Q = launder(P); const int u = lbid();
        if (u < 128) { rwkv_chunked(Q, 3, u >> 4, u & 15, lds); }
        else { fox_wg(Q, 3, u - 128, (char*)lds_raw);  }
    }
    SEAM();
    { PP Q = launder(P); phase_foxnorm(Q); }
    SEAM();
    {
        PP Q = launder(P); const unsigned char* wl = Q->ws + WS_W + (size_t)3 * W_LAYER;
        pg8::Gemm g{WS_PTR(const bf16_t, WS_Y), (const bf16_t*)(wl + WO_OUT), MMAIN, DM, DM}; pg8::StaticOrder S; S.init(MMAIN, DM, (int)gridDim.x, lbid(), 4, 0);
        pg8::EpiRes E{WS_PTR(bf16_t, WS_HB), WS_PTR(float, WS_SS) + (size_t)(11) * 8 * MROWS, 1.0f, (LAS float*)(lds + 131072)};
        pg8::gemm_phase<pg8::EpiRes, pg8::StaticOrder, true, true>(lds, g, S, E);
        skinny_res<DM>(WS_PTR(const bf16_t, WS_Y) + (size_t)MMAIN * DM, g.Bt, WS_PTR(bf16_t, WS_HB), WS_PTR(float, WS_SSM) + (11) * 2048, 1.0f, lds);
    }
    SEAM();
    {
        PP Q = launder(P); const unsigned char* wl = Q->ws + WS_W + (size_t)3 * W_LAYER;
        pg8::Gemm g{WS_PTR(const bf16_t, WS_HB), (const bf16_t*)(wl + WO_GU2), MMAIN, NGU, DM}; pg8::StaticOrder S; S.init(MMAIN, NGU, (int)gridDim.x, lbid(), 4, 1);
        pg8::EpiGU E{WS_PTR(bf16_t, WS_ACT), WS_PTR(const float, WS_SS) + (size_t)(11) * 8 * MROWS, (LAS float*)(lds + 131072 + 4096)};
        pg8::gemm_phase<pg8::EpiGU, pg8::StaticOrder, true, true>(lds, g, S, E);
        skinny_gu(WS_PTR(const bf16_t, WS_HB), g.Bt, WS_PTR(const float, WS_SSM) + (11) * 2048, WS_PTR(bf16_t, WS_ACT), lds);
    }
    SEAM();
    {
        PP Q = launder(P); const unsigned char* wl = Q->ws + WS_W + (size_t)3 * W_LAYER;
        pg8::Gemm g{WS_PTR(const bf16_t, WS_ACT), (const bf16_t*)(wl + WO_D2), MMAIN, DM, DFF}; pg8::StaticOrder S; S.init(MMAIN, DM, (int)gridDim.x, lbid(), 4, 0);
        pg8::EpiRes E{WS_PTR(bf16_t, WS_HB), WS_PTR(float, WS_SS) + (size_t)(12) * 8 * MROWS, 0.5f, (LAS float*)(lds + 131072)};
        pg8::gemm_phase<pg8::EpiRes, pg8::StaticOrder, true, true>(lds, g, S, E);
        skinny_res<DFF>(WS_PTR(const bf16_t, WS_ACT) + (size_t)MMAIN * DFF, g.Bt, WS_PTR(bf16_t, WS_HB), WS_PTR(float, WS_SSM) + (12) * 2048, 0.5f, lds);
    }
    SEAM();
    { PP Q = launder(P); phase_final(Q); }
}

extern "C" void kernel_launch(void* const* d_in, const int* in_sizes, int n_in, void* d_out, int out_size, void* d_ws, size_t ws_size, hipStream_t stream) {
    using namespace cfg;
    static int grid = 0;
    if (grid == 0) {
        if (n_in != 25 || out_size != MMAIN * DM || ws_size < WS_END) { fprintf(stderr, "kernel_launch: need 25 inputs, out %d, ws >= %zu; got n_in %d out %d ws %zu\n", MMAIN * DM, (size_t)WS_END, n_in, out_size, ws_size); grid = -1; return; }
        int dev = 0, cus = 0, per_cu = 0;
        if (hipGetDevice(&dev) != hipSuccess || hipDeviceGetAttribute(&cus, hipDeviceAttributeMultiprocessorCount, dev) != hipSuccess) { grid = -1; return; }
        if (hipFuncSetAttribute((const void*)hymba_fwd, hipFuncAttributeMaxDynamicSharedMemorySize, LDS_BYTES) != hipSuccess) { fprintf(stderr, "kernel_launch: hipFuncSetAttribute failed\n"); grid = -1; return; }
        if (hipOccupancyMaxActiveBlocksPerMultiprocessor(&per_cu, (const void*)hymba_fwd, 512, LDS_BYTES) != hipSuccess || per_cu < 1) fprintf(stderr, "kernel_launch: occupancy query says %d\n", per_cu);
        (void)hipGetLastError();
        if (cus < 256) { fprintf(stderr, "kernel_launch: built for a 256-CU device (one resident workgroup per CU), found %d CUs\n", cus); grid = -1; return; }
        grid = 256;
    }
    if (grid < 0) return;
    if (hipMemsetAsync((char*)d_ws + WS_CTL, 0, CTL_BYTES, stream) != hipSuccess) return;
    Params p{};
    for (int i = 0; i < 25; ++i) p.in[i] = (const float*)d_in[i];
    p.out = (float*)d_out; p.ws = (unsigned char*)d_ws; p.ph_lo = 0; p.ph_hi = 0;
    hipLaunchKernelGGL(hymba_fwd, dim3(grid), dim3(512), LDS_BYTES, stream, p);
}
```

```cpp
#include <hip/hip_runtime.h>
#include <hip/hip_bf16.h>
#include <cstdio>
#include <cstdint>

#define LAS __attribute__((address_space(3)))
namespace cfg {
constexpr int DM = 2048, NBATCH = 8, SEQ = 4096, NMETA = 16, DEPTH = 4;
constexpr int MMAIN = NBATCH * SEQ;
constexpr int MROWS = MMAIN + 256;
constexpr int DFF = 5632, NGU = 2 * DFF;
constexpr int RW = 1024, RH = 64, RNH = 16;
constexpr int FW = 1024, FH = 128, FNH = 8;
constexpr int RWKV_COLS = 3360, DIN = 6440;
constexpr int NIN = 6656;
constexpr int PRW = 3072, PSW = 512, QKVW = 3072;
constexpr int SEQP = 4160;
constexpr float NORM_EPS = 1e-6f, LNX_EPS = 64e-5f;
constexpr int NSS = 13;
constexpr size_t al256(size_t x) { return (x + 255) & ~(size_t)255; }
constexpr size_t WS_CTL = 0;
constexpr size_t CTL_BYTES = 65536;
constexpr size_t WS_SS = WS_CTL + CTL_BYTES;
constexpr size_t SS_BYTES = al256((size_t)NSS * 8 * MROWS * 4);
constexpr size_t ZERO_BYTES = CTL_BYTES + SS_BYTES;
constexpr size_t WS_SSM = WS_SS + SS_BYTES;
constexpr size_t SSM_BYTES = (size_t)NSS * 2048 * 4;
constexpr size_t WS_HMETA = WS_SSM + SSM_BYTES;
constexpr size_t WS_HB = WS_HMETA + (size_t)256 * DM * 4;
constexpr size_t WS_Y = WS_HB + (size_t)MROWS * DM * 2;
constexpr size_t WS_OVL = WS_Y + (size_t)MROWS * DM * 2;
constexpr size_t WS_ACT = WS_OVL;
constexpr size_t WS_PR = WS_OVL;
constexpr size_t WS_PS = WS_PR + (size_t)MROWS * PRW * 2;
constexpr size_t WS_QKV = WS_PS + (size_t)MROWS * PSW * 4;
constexpr size_t OVL_A = (size_t)MROWS * DFF * 2, OVL_B = (size_t)MROWS * PRW * 2 + (size_t)MROWS * PSW * 4 + (size_t)NBATCH * SEQP * QKVW * 2;
constexpr size_t WS_W = WS_OVL + al256(OVL_A > OVL_B ? OVL_A : OVL_B);
constexpr size_t W_GU = (size_t)NGU * DM * 2, W_D = (size_t)DM * DFF * 2, W_IN = (size_t)NIN * DM * 2, W_OUT = (size_t)DM * DM * 2;
constexpr size_t WO_GU1 = 0, WO_D1 = WO_GU1 + W_GU, WO_IN = WO_D1 + W_D, WO_OUT = WO_IN + W_IN, WO_GU2 = WO_OUT + W_OUT, WO_D2 = WO_GU2 + W_GU, W_LAYER = WO_D2 + W_D;
constexpr size_t WS_LXG = WS_W + (size_t)DEPTH * W_LAYER;
constexpr size_t WS_END = WS_LXG + (size_t)MROWS * 320 * 2;
constexpr int LDS_BYTES = 147456;
constexpr int LDS_BARW = LDS_BYTES - 16;
}
__device__ __forceinline__ int ltid() { int t = (int)threadIdx.x; asm volatile("" : "+v"(t)); return t; }
__device__ __forceinline__ int lbid() { int t = (int)blockIdx.x; asm volatile("" : "+s"(t)); return t; }
__device__ __forceinline__ int lzero() { int t = 0; asm volatile("" : "+v"(t)); return t; }
namespace pg8 {
#define PG8_LAS __attribute__((address_space(3)))
typedef unsigned short bf16_t;
typedef short bf16x8 __attribute__((ext_vector_type(8)));
typedef float f32x4 __attribute__((ext_vector_type(4)));
typedef unsigned u32x4 __attribute__((ext_vector_type(4)));
constexpr int BM = 256, BK = 64, HALF = 128, HTB = HALF * BK * 2  , STAGE_BYTES = 8 * HTB, NXCD = 8, WGM = 4;

__host__ __device__ __forceinline__ int lds_byte(int r, int c) { const int st = (r >> 4) * 2 + (c >> 5), rr = r & 15, cc = c & 31, ob = rr * 64 + cc * 2; return st * 1024 + (ob ^ (((ob >> 9) & 1) << 5)); }
__host__ __device__ __forceinline__ void stage_rc(int b, int& R, int& C) { const int st = b / 1024, sb = b % 1024, swz = sb ^ (((sb >> 9) & 1) << 5); R = (st >> 1) * 16 + swz / 64; C = (st & 1) * 32 + (swz % 64) / 2; }
__host__ __device__ __forceinline__ int perm32(int rho) { const int n = rho >> 4, i = rho & 15; return 8 * (i >> 2) + 4 * n + (i & 3); }

struct Unit { int pm, pn; };
struct Gemm { const bf16_t* A; const bf16_t* Bt; int M, N, K; };

struct StaticOrder {
    int nM, nN, nwg, G, c, wgm, rev;
    __host__ __device__ void init(int M, int N, int G_, int c_, int wgm_ = WGM, int rev_ = 0) { nM = M / BM; nN = N / BM; nwg = nM * nN; G = G_; c = c_; wgm = wgm_; rev = rev_; }
    __host__ __device__ bool next(int i, Unit& u) const {
        const int nr = (nwg + G - 1) / G; if (i >= nr) return false;
        const long L = (long)(rev ? nr - 1 - i : i) * G + c; if (L >= nwg) return false;
        int wgid = (int)L; { const int q = nwg / NXCD, r = nwg % NXCD, xcd = wgid % NXCD, off = wgid / NXCD; wgid = (xcd < r ? xcd * (q + 1) : r * (q + 1) + (xcd - r) * q) + off; }
        const int nig = wgm * nN, gid = wgid / nig, fm = gid * wgm, gsz = (nM - fm) < wgm ? (nM - fm) : wgm;
        u.pm = fm + ((wgid % nig) % gsz); u.pn = (wgid % nig) / gsz; return true;
    }
    __device__ __forceinline__ void a_ready(const Unit&) const {}
    __device__ __forceinline__ void done(const Unit&) const {}
};

__device__ __forceinline__ unsigned cvt_pk_bf16(float lo, float hi) { unsigned r; asm volatile("v_cvt_pk_bf16_f32 %0, %1, %2" : "=v"(r) : "v"(lo), "v"(hi)); return r; }
typedef float f32x2 __attribute__((ext_vector_type(2)));
__device__ __forceinline__ f32x2 gelu_pk(f32x2 v) {
    const f32x2 av = __builtin_elementwise_abs(v), d = av * 0.2316418882f + 1.0f;
    f32x2 t; t.x = __builtin_amdgcn_rcpf(d.x); t.y = __builtin_amdgcn_rcpf(d.y);
    f32x2 q = t * 0.5307027145f + (-0.7265760135f); q = q * t + 0.7107068705f; q = q * t + (-0.142248368f); q = q * t + 0.127414796f; q = q * t;
    const f32x2 s = (v * v) * (-0.72134752044f);
    f32x2 e; e.x = __builtin_amdgcn_exp2f(s.x); e.y = __builtin_amdgcn_exp2f(s.y);
    const f32x2 m = v * (q * e), r = v - m;
    f32x2 o; o.x = v.x < 0.f ? m.x : r.x; o.y = v.y < 0.f ? m.y : r.y; return o;
}
__device__ __forceinline__ float rs_of(const float* ss, int row) { float s = 0.f;
#pragma unroll
    for (int t = 0; t < 8; ++t) s += ss[(size_t)t * 33024 + row];
    return __builtin_amdgcn_rsqf(s * (1.0f / 2048.0f) + 1e-6f); }
__device__ __forceinline__ float silu_f(float x) { return x * __builtin_amdgcn_rcpf(1.0f + __builtin_amdgcn_exp2f(-1.4426950408889634f * x)); }

struct EpiGU {
    static constexpr bool PERM = true, AFTER_DRAIN = false; static constexpr int NVM = 8;
    bf16_t* act; const float* ss; PG8_LAS float* rsb;
    __device__ __forceinline__ void operator()(const f32x4 (&acc)[2][2][4][2], const Unit& u, int wr, int wc, int fr, int fq, bool newpanel) const {
        if (newpanel) {
            if (wr == 0) { const int rl = wc * 64 + fq * 16 + fr; rsb[rl] = rs_of(ss, u.pm * BM + rl); }
            asm volatile("s_waitcnt lgkmcnt(0)" ::: "memory"); __builtin_amdgcn_s_barrier(); asm volatile("" ::: "memory"); }
        const int rl0 = wr * 64 + fr, row0 = u.pm * BM + rl0, col0 = u.pn * 128 + wc * 32 + 8 * fq;
#pragma unroll
        for (int ai = 0; ai < 2; ++ai)
#pragma unroll
            for (int m = 0; m < 4; ++m) { const int row = row0 + ai * HALF + m * 16; const float rs = rsb[rl0 + ai * HALF + m * 16];
                const f32x4 g0 = acc[ai][0][m][0] * rs, g1 = acc[ai][0][m][1] * rs, u0 = acc[ai][1][m][0] * rs, u1 = acc[ai][1][m][1] * rs;
                u32x4 w;
                w.x = cvt_pk_bf16(silu_f(g0[0]) * u0[0], silu_f(g0[1]) * u0[1]); w.y = cvt_pk_bf16(silu_f(g0[2]) * u0[2], silu_f(g0[3]) * u0[3]);
                w.z = cvt_pk_bf16(silu_f(g1[0]) * u1[0], silu_f(g1[1]) * u1[1]); w.w = cvt_pk_bf16(silu_f(g1[2]) * u1[2], silu_f(g1[3]) * u1[3]);
                *(u32x4*)(act + (size_t)row * 5632 + col0) = w; }
    }
};
struct EpiRes {
    static constexpr bool PERM = true, AFTER_DRAIN = false; static constexpr int NVM = 32;
    bf16_t* hb; float* ssn; float alpha; PG8_LAS float* red;
    __device__ __forceinline__ void operator()(const f32x4 (&acc)[2][2][4][2], const Unit& u, int wr, int wc, int fr, int fq, bool) const {
        bf16_t* bbase = hb + (size_t)u.pm * BM * 2048;
        const int rl0 = wr * 64 + fr; unsigned off = (unsigned)(rl0 * 2048 + u.pn * BM + wc * 32 + 8 * fq);
#pragma unroll
        for (int ai = 0; ai < 2; ++ai) {
            u32x4 hv[4][2];
#pragma unroll
            for (int m = 0; m < 4; ++m)
#pragma unroll
                for (int bj = 0; bj < 2; ++bj) hv[m][bj] = *(const u32x4*)(bbase + (off + (unsigned)((ai * HALF + m * 16) * 2048) + bj * HALF));
#pragma unroll
            for (int m = 0; m < 4; ++m) { const unsigned o = off + (unsigned)((ai * HALF + m * 16) * 2048); float sq = 0.f;
#pragma unroll
                for (int bj = 0; bj < 2; ++bj) { const u32x4 x = hv[m][bj];
                    const f32x4 h0 = (f32x4){__uint_as_float(x.x << 16), __uint_as_float(x.x & 0xffff0000u), __uint_as_float(x.y << 16), __uint_as_float(x.y & 0xffff0000u)} + acc[ai][bj][m][0] * alpha;
                    const f32x4 h1 = (f32x4){__uint_as_float(x.z << 16), __uint_as_float(x.z & 0xffff0000u), __uint_as_float(x.w << 16), __uint_as_float(x.w & 0xffff0000u)} + acc[ai][bj][m][1] * alpha;
                    sq += ((h0[0] * h0[0] + h0[1] * h0[1]) + (h0[2] * h0[2] + h0[3] * h0[3])) + ((h1[0] * h1[0] + h1[1] * h1[1]) + (h1[2] * h1[2] + h1[3] * h1[3]));
                    u32x4 w; w.x = cvt_pk_bf16(h0[0], h0[1]); w.y = cvt_pk_bf16(h0[2], h0[3]); w.z = cvt_pk_bf16(h1[0], h1[1]); w.w = cvt_pk_bf16(h1[2], h1[3]); *(u32x4*)(bbase + o + bj * HALF) = w; }
                sq += __shfl_xor(sq, 16); sq += __shfl_xor(sq, 32);
                if (fq == 0) red[(rl0 + ai * HALF + m * 16) * 4 + wc] = sq; }
            asm volatile("" ::: "memory"); }
        asm volatile("s_waitcnt lgkmcnt(0)" ::: "memory"); __builtin_amdgcn_s_barrier(); asm volatile("" ::: "memory");
        if (wr == 0) { const int row = wc * 64 + fq * 16 + fr; const float s4 = (red[row * 4] + red[row * 4 + 1]) + (red[row * 4 + 2] + red[row * 4 + 3]); ssn[(size_t)u.pn * 33024 + u.pm * BM + row] = s4; }
    }
};
struct EpiP {
    static constexpr bool PERM = true, AFTER_DRAIN = false; static constexpr int NVM = 16;
    bf16_t* pr; float* ps; bf16_t* qkv; const float* ss; PG8_LAS float* rsb;
    __device__ __forceinline__ void operator()(const f32x4 (&acc)[2][2][4][2], const Unit& u, int wr, int wc, int fr, int fq, bool newpanel) const {
        if (newpanel) {
            if (wr == 0) { const int rl = wc * 64 + fq * 16 + fr; rsb[rl] = rs_of(ss, u.pm * BM + rl); }
            asm volatile("s_waitcnt lgkmcnt(0)" ::: "memory"); __builtin_amdgcn_s_barrier(); asm volatile("" ::: "memory"); }
        const int rl0 = wr * 64 + fr, row0 = u.pm * BM + rl0, cl = wc * 32 + 8 * fq;
#pragma unroll
        for (int ai = 0; ai < 2; ++ai)
#pragma unroll
            for (int m = 0; m < 4; ++m) { const int row = row0 + ai * HALF + m * 16; const float rs = rsb[rl0 + ai * HALF + m * 16];
#pragma unroll
                for (int bj = 0; bj < 2; ++bj) { const f32x4 v0 = acc[ai][bj][m][0] * rs, v1 = acc[ai][bj][m][1] * rs;
                    if (u.pn >= 12 && u.pn < 14) { float* d = ps + (size_t)row * 512 + (u.pn - 12) * 256 + bj * HALF + cl; *(f32x4*)d = v0; *(f32x4*)(d + 4) = v1; }
                    else { u32x4 w; w.x = cvt_pk_bf16(v0[0], v0[1]); w.y = cvt_pk_bf16(v0[2], v0[3]); w.z = cvt_pk_bf16(v1[0], v1[1]); w.w = cvt_pk_bf16(v1[2], v1[3]);
                        if (u.pn < 12) *(u32x4*)(pr + (size_t)row * 3072 + u.pn * 256 + bj * HALF + cl) = w;
                        else { const int c = (u.pn - 14) * 256 + bj * HALF + cl;
                            const int b = row >> 12, s = row & 4095; *(u32x4*)(qkv + ((size_t)b * 4160 + 64 + s) * 3072 + c) = w; } } } }
    }
};
template <class Epi, class Sched, bool ALIGN_EPI = false, bool SP2 = false>
__device__ __forceinline__ void gemm_phase(PG8_LAS unsigned char* lds, const Gemm g, const Sched& S, const Epi& E) {
    const int tid = ltid(), wid = __builtin_amdgcn_readfirstlane(tid >> 6), lane = tid & 63, wr = wid >> 2, wc = wid & 3, fr = lane & 15, fq = lane >> 4;
    const int K = g.K, nt = K / BK;
    unsigned voffA[2], voffB[2];
#pragma unroll
    for (int i = 0; i < 2; ++i) { int R, C; stage_rc(tid * 16 + i * 8192, R, C); const int Rb = Epi::PERM ? ((R & ~31) + perm32(R & 31)) : R;
        voffA[i] = (unsigned)(R * K + C) * 2u; voffB[i] = (unsigned)(Rb * K + C) * 2u; }
    const size_t kstep = (size_t)(BK * 2);
    const size_t hstep = (size_t)HALF * K * 2;
    const size_t tstep = 2 * hstep;
    const unsigned ldsw = (unsigned)wid * 1024u;
    const int aoff = lds_byte(wr * 64 + fr, fq * 8), boff = lds_byte(wc * 32 + fr, fq * 8);
#define PG8_SA(b, h) (((b) * 2 + (h)) * HTB)
#define PG8_SB(b, h) ((4 + (b) * 2 + (h)) * HTB)
#define PG8_STAGE(bufoff, gbase, voff) do { _Pragma("unroll") for (int _i = 0; _i < 2; ++_i) \
        __builtin_amdgcn_global_load_lds((const unsigned*)((const char*)(gbase) + (voff)[_i]), (PG8_LAS unsigned*)(lds + (bufoff) + ldsw + _i * 8192), 16, 0, 0); } while (0)
#define PG8_LDA(dst, b, h) do { _Pragma("unroll") for (int m = 0; m < 4; ++m) _Pragma("unroll") for (int k = 0; k < 2; ++k) dst[m][k] = *(const PG8_LAS bf16x8*)(lds + PG8_SA(b, h) + aoff + m * 2048 + k * 1024); } while (0)
#define PG8_LDB(dst, b, h) do { _Pragma("unroll") for (int n = 0; n < 2; ++n) _Pragma("unroll") for (int k = 0; k < 2; ++k) dst[n][k] = *(const PG8_LAS bf16x8*)(lds + PG8_SB(b, h) + boff + n * 2048 + k * 1024); } while (0)
#define PG8_MMA(ai, bj, At, Bt) do { __builtin_amdgcn_s_setprio(1); _Pragma("unroll") for (int m = 0; m < 4; ++m) _Pragma("unroll") for (int n = 0; n < 2; ++n) _Pragma("unroll") for (int k = 0; k < 2; ++k) \
        acc[ai][bj][m][n] = __builtin_amdgcn_mfma_f32_16x16x32_bf16(Bt[n][k], At[m][k], acc[ai][bj][m][n], 0, 0, 0); __builtin_amdgcn_s_setprio(0); } while (0)
#define PG8_WAIT_V(n) asm volatile("s_waitcnt vmcnt(" #n ")" ::: "memory")
#define PG8_WAIT_VR(flag, n) asm volatile("s_cmp_lg_u32 %0, 0\n\ts_cbranch_scc1 .Lpg8rx%=\n\ts_waitcnt vmcnt(8)\n.Lpg8rx%=:\n\ts_waitcnt vmcnt(%1)" :: "s"(flag), "n"(n) : "memory", "scc")
#define PG8_WAIT_L(n) asm volatile("s_waitcnt lgkmcnt(" #n ")" ::: "memory")
#define PG8_BAR __builtin_amdgcn_s_barrier()
#define PG8_SCHED __builtin_amdgcn_sched_barrier(0)
    Unit cur, nxt; int ui = 0, prev_pm = -1;
    if (!S.next(0, cur)) return;
    f32x4 acc[2][2][4][2];
#pragma unroll
    for (int a = 0; a < 2; ++a)
#pragma unroll
        for (int b = 0; b < 2; ++b)
#pragma unroll
            for (int m = 0; m < 4; ++m)
#pragma unroll
                for (int n = 0; n < 2; ++n) acc[a][b][m][n] = (f32x4){0.f, 0.f, 0.f, 0.f};
    bf16x8 At[4][2], B0[2][2], B1[2][2];
    const char* cA = (const char*)g.A + (size_t)cur.pm * tstep; const char* cB = (const char*)g.Bt + (size_t)cur.pn * tstep;
    S.a_ready(cur);
    if constexpr (SP2) {
        PG8_STAGE(PG8_SB(0, 0), cB, voffB); PG8_STAGE(PG8_SB(0, 1), cB + hstep, voffB); PG8_STAGE(PG8_SA(0, 0), cA, voffA); PG8_STAGE(PG8_SA(0, 1), cA + hstep, voffA);
        if (wr == 1) PG8_BAR;
        PG8_WAIT_V(2); PG8_BAR;
        PG8_STAGE(PG8_SB(1, 0), cB + kstep, voffB); PG8_STAGE(PG8_SA(1, 0), cA + kstep, voffA); PG8_STAGE(PG8_SB(1, 1), cB + hstep + kstep, voffB);
        PG8_WAIT_V(6); PG8_BAR;
    } else {
        PG8_STAGE(PG8_SB(0, 0), cB, voffB); PG8_STAGE(PG8_SA(0, 0), cA, voffA); PG8_STAGE(PG8_SB(0, 1), cB + hstep, voffB); PG8_STAGE(PG8_SA(0, 1), cA + hstep, voffA);
        if (wr == 1) PG8_BAR;
        PG8_WAIT_V(4); PG8_BAR;
        PG8_STAGE(PG8_SB(1, 0), cB + kstep, voffB); PG8_STAGE(PG8_SA(1, 0), cA + kstep, voffA); PG8_STAGE(PG8_SB(1, 1), cB + hstep + kstep, voffB);
        PG8_WAIT_V(6); PG8_BAR;
    }
    for (;;) {
        const bool has_next = S.next(ui + 1, nxt);
        const char* nA = has_next ? (const char*)g.A + (size_t)nxt.pm * tstep : cA; const char* nB = has_next ? (const char*)g.Bt + (size_t)nxt.pn * tstep : cB;
        for (int t = 0; t < nt; t += 2) {
            const bool last = (t == nt - 2);
            const char* a1 = cA + (size_t)(t + 1) * kstep;
            const char* a2 = last ? nA : cA + (size_t)(t + 2) * kstep; const char* b2 = last ? nB : cB + (size_t)(t + 2) * kstep;
            const char* a3 = a2 + kstep; const char* b3 = b2 + kstep;
            if (last && has_next) S.a_ready(nxt);
            if constexpr (SP2) {
            const int relax = __builtin_amdgcn_readfirstlane(((t == 0) && (ui > 0)) ? 1 : 0);
            PG8_LDB(B0, 0, 0); PG8_LDB(B1, 0, 1); PG8_SCHED; PG8_LDA(At, 0, 0); PG8_STAGE(PG8_SA(1, 1), a1 + hstep, voffA);
            PG8_WAIT_VR(relax, 8 + Epi::NVM);
            PG8_WAIT_L(0); PG8_BAR; PG8_MMA(0, 0, At, B0); PG8_MMA(0, 1, At, B1); PG8_BAR; PG8_SCHED;
            PG8_LDA(At, 0, 1); PG8_STAGE(PG8_SB(0, 0), b2, voffB); PG8_STAGE(PG8_SB(0, 1), b2 + hstep, voffB); PG8_STAGE(PG8_SA(0, 0), a2, voffA);
            PG8_WAIT_VR(relax, 8 + Epi::NVM);
            PG8_WAIT_L(0); PG8_BAR; PG8_MMA(1, 0, At, B0); PG8_MMA(1, 1, At, B1); PG8_BAR; PG8_SCHED;
            PG8_LDB(B0, 1, 0); PG8_LDB(B1, 1, 1); PG8_SCHED; PG8_LDA(At, 1, 0); PG8_STAGE(PG8_SA(0, 1), a2 + hstep, voffA);
            PG8_WAIT_V(8); PG8_WAIT_L(0); PG8_BAR; PG8_MMA(0, 0, At, B0); PG8_MMA(0, 1, At, B1); PG8_BAR; PG8_SCHED;
            PG8_LDA(At, 1, 1); PG8_STAGE(PG8_SB(1, 0), b3, voffB); PG8_STAGE(PG8_SB(1, 1), b3 + hstep, voffB); PG8_STAGE(PG8_SA(1, 0), a3, voffA);
            PG8_WAIT_V(8); PG8_WAIT_L(0); PG8_BAR; PG8_MMA(1, 0, At, B0); PG8_MMA(1, 1, At, B1); PG8_BAR; PG8_SCHED;
            } else {
            PG8_LDB(B0, 0, 0); PG8_SCHED; PG8_LDA(At, 0, 0); PG8_STAGE(PG8_SA(1, 1), a1 + hstep, voffA);
            PG8_WAIT_L(8); PG8_BAR; PG8_WAIT_L(0); PG8_MMA(0, 0, At, B0); PG8_BAR; PG8_SCHED;
            PG8_LDB(B1, 0, 1); PG8_STAGE(PG8_SB(0, 0), b2, voffB);
            PG8_BAR; PG8_WAIT_L(0); PG8_MMA(0, 1, At, B1); PG8_BAR;
            PG8_LDA(At, 0, 1); PG8_STAGE(PG8_SA(0, 0), a2, voffA);
            PG8_BAR; PG8_WAIT_L(0); PG8_MMA(1, 0, At, B0); PG8_BAR; PG8_SCHED;
            PG8_STAGE(PG8_SB(0, 1), b2 + hstep, voffB);
            PG8_WAIT_V(6); PG8_BAR; PG8_MMA(1, 1, At, B1); PG8_BAR;
            PG8_LDB(B0, 1, 0); PG8_SCHED; PG8_LDA(At, 1, 0); PG8_STAGE(PG8_SA(0, 1), a2 + hstep, voffA);
            PG8_WAIT_L(8); PG8_BAR; PG8_WAIT_L(0); PG8_MMA(0, 0, At, B0); PG8_BAR; PG8_SCHED;
            PG8_LDB(B1, 1, 1); PG8_STAGE(PG8_SB(1, 0), b3, voffB);
            PG8_BAR; PG8_WAIT_L(0); PG8_MMA(0, 1, At, B1); PG8_BAR;
            PG8_LDA(At, 1, 1); PG8_STAGE(PG8_SA(1, 0), a3, voffA);
            PG8_BAR; PG8_WAIT_L(0); PG8_MMA(1, 0, At, B0); PG8_BAR; PG8_SCHED;
            PG8_STAGE(PG8_SB(1, 1), b3 + hstep, voffB);
            PG8_WAIT_V(6); PG8_BAR; PG8_MMA(1, 1, At, B1); PG8_BAR;
            }
        }
        if constexpr (ALIGN_EPI) { if (wr == 0) PG8_BAR; }
        if constexpr (!Epi::AFTER_DRAIN) { E(acc, cur, wr, wc, fr, fq, cur.pm != prev_pm); prev_pm = cur.pm; S.done(cur); }
        if (!has_next) break;
#pragma unroll
        for (int a = 0; a < 2; ++a)
#pragma unroll
            for (int b = 0; b < 2; ++b)
#pragma unroll
                for (int m = 0; m < 4; ++m)
#pragma unroll
                    for (int n = 0; n < 2; ++n) acc[a][b][m][n] = (f32x4){0.f, 0.f, 0.f, 0.f};
        cur = nxt; cA = nA; cB = nB; ++ui;
        if constexpr (ALIGN_EPI) { if (wr == 1) PG8_BAR; }
    }
    PG8_WAIT_V(0);
    if constexpr (!ALIGN_EPI) { if (wr == 0) PG8_BAR; }
    PG8_BAR;
    if constexpr (Epi::AFTER_DRAIN) { E.fused(acc, cur, wr, wc, fr, fq, lds, wid, lane); S.done(cur); }
#undef PG8_SA
#undef PG8_SB
#undef PG8_STAGE
#undef PG8_LDA
#undef PG8_LDB
#undef PG8_MMA
#undef PG8_WAIT_V
#undef PG8_WAIT_VR
#undef PG8_WAIT_L
#undef PG8_BAR
#undef PG8_SCHED
}
}


#define XB_TMO      128
#define XB_XCNT(j)  (256  + 64 * (j))
#define XB_XSUB(j)  (1280 + 64 * (j))
#define XB_XGEN(j)  (2304 + 64 * (j))
#define XB_TOP      3328
#define XB_TOPGEN   3392
#define XCD_BAR_WORDS 3456
#define XB_SPIN_CAP (1u << 22)

__device__ __forceinline__ unsigned xb_ld(unsigned* p)              { return __hip_atomic_load(p, __ATOMIC_RELAXED, __HIP_MEMORY_SCOPE_AGENT); }
__device__ __forceinline__ unsigned xb_add(unsigned* p, unsigned v) { return __hip_atomic_fetch_add(p, v, __ATOMIC_RELAXED, __HIP_MEMORY_SCOPE_AGENT); }
__device__ __forceinline__ unsigned xb_xcc_id() { return (unsigned)__builtin_amdgcn_s_getreg((3 << 11) | 20) & 0xFu; }
#define XB_SPIN(cond, bar) do { unsigned _sp = 0; while (cond) { __builtin_amdgcn_s_sleep(1); \
    if ((++_sp & 255u) == 0u) { if (xb_ld(&(bar)[XB_TMO])) break; if (_sp > XB_SPIN_CAP) { atomicAdd(&(bar)[XB_TMO], 1u); break; } } } } while (0)

struct XcdBarrier {
    unsigned* bar; unsigned x;
    volatile LAS unsigned* st;
};

__device__ __forceinline__ XcdBarrier xcd_barrier_post(unsigned* bar, volatile LAS unsigned* st) {
    XcdBarrier b; b.bar = bar; b.x = xb_xcc_id(); b.st = st;
    if (threadIdx.x == 0) (void)xb_add(&bar[XB_XCNT(b.x)], 1u);
    return b;
}
__device__ __forceinline__ void xcd_barrier_complete(unsigned* bar, unsigned x, unsigned& nloc, unsigned& nx) {
    const unsigned G = gridDim.x * gridDim.y * gridDim.z;
    unsigned sum, cnt, mine, sp = 0u;
    for (;;) {
        sum = 0u; cnt = 0u; mine = 0u;
#pragma unroll
        for (unsigned j = 0; j < 16; ++j) { const unsigned c = xb_ld(&bar[XB_XCNT(j)]); sum += c; cnt += (c > 0u) ? 1u : 0u; mine = (j == x) ? c : mine; }
        if (sum == G) break;
        __builtin_amdgcn_s_sleep(1);
        if ((++sp & 255u) == 0u) { if (xb_ld(&bar[XB_TMO])) break; if (sp > XB_SPIN_CAP) { atomicAdd(&bar[XB_TMO], 1u); break; } }
    }
    nloc = mine > 0u ? mine : 1u; nx = cnt > 0u ? cnt : 1u;
}

__device__ __forceinline__ void xcd_barrier(const XcdBarrier& b) {
    asm volatile("s_waitcnt vmcnt(0)" ::: "memory");
    __syncthreads();
    if (threadIdx.x == 0) {
        unsigned* bar = b.bar;
        __builtin_amdgcn_s_waitcnt(0);
        unsigned nloc = b.st[0], nx = b.st[1];
        if (nloc == 0u) { xcd_barrier_complete(bar, b.x, nloc, nx); b.st[0] = nloc; b.st[1] = nx; }
        const unsigned old = xb_add(&bar[XB_XSUB(b.x)], 1u);
        const unsigned gen = old / nloc;
        if (old + 1u == (gen + 1u) * nloc) {
            __builtin_amdgcn_fence(__ATOMIC_RELEASE, "agent");
            asm volatile("s_waitcnt vmcnt(0)" ::: "memory");
            const unsigned og = xb_add(&bar[XB_TOP], 1u);
            const unsigned tg = og / nx;
            if (og + 1u == (tg + 1u) * nx) xb_add(&bar[XB_TOPGEN], 1u);
            else XB_SPIN(xb_ld(&bar[XB_TOPGEN]) == tg, bar);
            __builtin_amdgcn_fence(__ATOMIC_ACQUIRE, "agent");
            xb_add(&bar[XB_XGEN(b.x)], 1u);
            asm volatile("s_waitcnt vmcnt(0)" ::: "memory");
        } else {
            XB_SPIN(xb_ld(&bar[XB_XGEN(b.x)]) == gen, bar);
            __builtin_amdgcn_fence(__ATOMIC_ACQUIRE, "agent");
            asm volatile("s_waitcnt vmcnt(0)" ::: "memory");
        }
    }
    __syncthreads();
}


typedef unsigned short bf16_t;
typedef float f32x4 __attribute__((ext_vector_type(4)));
typedef unsigned u32x4 __attribute__((ext_vector_type(4)));
typedef unsigned u32x2 __attribute__((ext_vector_type(2)));
struct Params { const float* in[25]; float* out; unsigned char* ws; int ph_lo, ph_hi; };
#define CAS __attribute__((address_space(4)))
typedef const CAS Params* PP;
__device__ __forceinline__ PP launder(PP p) { asm volatile("" : "+s"(p)); return p; }
enum { I_X = 0, I_META, I_F1N, I_F1GU, I_F1D, I_MIXN, I_WIN, I_MU, I_W0, I_WUP, I_A0, I_AUP, I_GUP, I_KK, I_KA, I_RK, I_LNW, I_LNB, I_BF, I_FON, I_WOUT, I_F2N, I_F2GU, I_F2D, I_FINN };

typedef float f32x2_t __attribute__((ext_vector_type(2))); typedef __bf16 bf16x2v_t __attribute__((ext_vector_type(2)));
__device__ __forceinline__ unsigned pk_bf16(float lo, float hi) { f32x2_t v = {lo, hi}; bf16x2v_t b = __builtin_convertvector(v, bf16x2v_t); return __builtin_bit_cast(unsigned, b); }
__device__ __forceinline__ float bf2f(bf16_t b) { return __uint_as_float(((unsigned)b) << 16); }
__device__ __forceinline__ float wave_sum(float v) {
#pragma unroll
    for (int o = 32; o >= 1; o >>= 1) v += __shfl_xor(v, o);
    return v; }
__device__ __forceinline__ float wave_max(float v) {
#pragma unroll
    for (int o = 32; o >= 1; o >>= 1) v = fmaxf(v, __shfl_xor(v, o));
    return v; }
template <int CTRL> __device__ __forceinline__ float dpp_f(float v) { return __builtin_bit_cast(float, __builtin_amdgcn_update_dpp(0, __builtin_bit_cast(int, v), CTRL, 0xf, 0xf, true)); }
__device__ __forceinline__ float row_sum16(float v) { v += dpp_f<0xB1>(v); v += dpp_f<0x4E>(v); v += dpp_f<0x141>(v); v += dpp_f<0x140>(v); return v; }
__device__ __forceinline__ float rdlane(float v, int l) { return __builtin_bit_cast(float, __builtin_amdgcn_readlane(__builtin_bit_cast(int, v), l)); }
__device__ __forceinline__ float wave_sum_dpp(float v) { v = row_sum16(v); return (rdlane(v, 0) + rdlane(v, 16)) + (rdlane(v, 32) + rdlane(v, 48)); }
__device__ __forceinline__ float sigmoid_f(float x) { return __builtin_amdgcn_rcpf(1.0f + __expf(-x)); }

struct CvT { const float* src; bf16_t* dst; const float* gain; int K, Nsrc, kind, tk, tn; };
__device__ __forceinline__ CvT cv_desc(PP P, int l, int r) {
    using namespace cfg;
    constexpr int T_GU = (DM / 64) * (NGU / 64), T_D = (DFF / 64) * (DM / 64), T_IN = (DM / 64) * (NIN / 64), T_OUT = (DM / 64) * (DM / 64);
    bf16_t* wl = (bf16_t*)(P->ws + WS_W + (size_t)l * W_LAYER);
    CvT d; int ntn;
    if (r < T_GU) { d.src = P->in[I_F1GU] + (size_t)l * DM * NGU; d.dst = (bf16_t*)((unsigned char*)wl + WO_GU1); d.gain = P->in[I_F1N] + l * DM; d.K = DM; d.Nsrc = NGU; d.kind = 1; ntn = NGU / 64; }
    else if ((r -= T_GU) < T_D) { d.src = P->in[I_F1D] + (size_t)l * DFF * DM; d.dst = (bf16_t*)((unsigned char*)wl + WO_D1); d.gain = d.src; d.K = DFF; d.Nsrc = DM; d.kind = 0; ntn = DM / 64; }
    else if ((r -= T_D) < T_IN) { d.src = P->in[I_WIN] + (size_t)l * DM * DIN; d.dst = (bf16_t*)((unsigned char*)wl + WO_IN); d.gain = P->in[I_MIXN] + l * DM; d.K = DM; d.Nsrc = DIN; d.kind = 2; ntn = NIN / 64; }
    else if ((r -= T_IN) < T_OUT) { d.src = P->in[I_WOUT] + (size_t)l * DM * DM; d.dst = (bf16_t*)((unsigned char*)wl + WO_OUT); d.gain = P->in[I_FON] + l * FW; d.K = DM; d.Nsrc = DM; d.kind = 3; ntn = DM / 64; }
    else if ((r -= T_OUT) < T_GU) { d.src = P->in[I_F2GU] + (size_t)l * DM * NGU; d.dst = (bf16_t*)((unsigned char*)wl + WO_GU2); d.gain = P->in[I_F2N] + l * DM; d.K = DM; d.Nsrc = NGU; d.kind = 1; ntn = NGU / 64; }
    else { r -= T_GU; d.src = P->in[I_F2D] + (size_t)l * DFF * DM; d.dst = (bf16_t*)((unsigned char*)wl + WO_D2); d.gain = d.src; d.K = DFF; d.Nsrc = DM; d.kind = 0; ntn = DM / 64; }
    d.tk = r / ntn; d.tn = r - d.tk * ntn; return d; }
__device__ __forceinline__ int cv_srccol(const CvT& d, int np) {
    const int sc1 = ((np >> 7) & 1) * cfg::DFF + (np >> 8) * 128 + (np & 127);
    const int sc2 = np < 3360 ? np : (np < 3368 ? 6432 + (np - 3360) : (np < 3584 ? 0 : 3360 + (np - 3584)));
    return d.kind == 1 ? sc1 : (d.kind == 2 ? sc2 : np); }
__device__ __forceinline__ void cv_load(const CvT& d, f32x4 (&v)[2], float (&g)[2]) {
    const int tid = ltid(); const int nl = (tid & 15) * 4, np = d.tn * 64 + nl; const int sc = cv_srccol(d, np);
#pragma unroll
    for (int i = 0; i < 2; ++i) { const int kl = (tid >> 4) + 32 * i, k = d.tk * 64 + kl;
        v[i] = *(const f32x4*)(d.src + (size_t)k * d.Nsrc + sc);
        const int gk = d.kind == 3 ? (k >= 1024 ? k - 1024 : 0) : (d.kind == 0 ? 0 : k);
        g[i] = d.gain[gk]; } }
__device__ __forceinline__ void cv_finish(const CvT& d, const f32x4 (&v)[2], const float (&g)[2], LAS float* T) {
    const int tid = ltid();
    { const int nl = (tid & 15) * 4, np = d.tn * 64 + nl; const bool zero = d.kind == 2 && np >= 3368 && np < 3584;
#pragma unroll
      for (int i = 0; i < 2; ++i) { const int kl = (tid >> 4) + 32 * i, k = d.tk * 64 + kl;
          float gg = (d.kind == 0 || (d.kind == 3 && k < 1024)) ? 1.f : g[i]; const f32x4 x = zero ? (f32x4){0.f, 0.f, 0.f, 0.f} : v[i] * gg;
          T[kl * 65 + nl] = x[0]; T[kl * 65 + nl + 1] = x[1]; T[kl * 65 + nl + 2] = x[2]; T[kl * 65 + nl + 3] = x[3]; } }
    asm volatile("s_waitcnt lgkmcnt(0)" ::: "memory"); __builtin_amdgcn_s_barrier(); asm volatile("" ::: "memory");
    { const int nl = tid >> 3, k8 = (tid & 7) * 8; u32x4 w;
      w.x = pk_bf16(T[(k8 + 0) * 65 + nl], T[(k8 + 1) * 65 + nl]); w.y = pk_bf16(T[(k8 + 2) * 65 + nl], T[(k8 + 3) * 65 + nl]);
      w.z = pk_bf16(T[(k8 + 4) * 65 + nl], T[(k8 + 5) * 65 + nl]); w.w = pk_bf16(T[(k8 + 6) * 65 + nl], T[(k8 + 7) * 65 + nl]);
      *(u32x4*)(d.dst + (size_t)(d.tn * 64 + nl) * d.K + d.tk * 64 + k8) = w; } }
__device__ __forceinline__ void phase_convert(PP P, LAS unsigned char* lds, int l0, int l1, int first, int nwg, int t0 = 0, int t1 = 0) {
    using namespace cfg;
    constexpr int T_GU = (DM / 64) * (NGU / 64), T_D = (DFF / 64) * (DM / 64), T_IN = (DM / 64) * (NIN / 64), T_OUT = (DM / 64) * (DM / 64);
    constexpr int T_LAYER = 2 * T_GU + 2 * T_D + T_IN + T_OUT;
    if (t1 <= 0) t1 = T_LAYER;
    for (int l = l0; l < l1; ++l) {
        int r = first; if (r < t0) r += ((t0 - r + nwg - 1) / nwg) * nwg;
        if (r >= t1) continue;
        const int ntile = (t1 - r + nwg - 1) / nwg, rlast = r + (ntile - 1) * nwg;
#define CV_R(j) ((r + (j) * nwg) < rlast ? (r + (j) * nwg) : rlast)
        CvT dA = cv_desc(P, l, r), dB = cv_desc(P, l, CV_R(1)), dC = dA; f32x4 vA[2], vB[2], vC[2]; float gA[2], gB[2], gC[2];
        cv_load(dA, vA, gA); cv_load(dB, vB, gB);
        int buf = 0;
#define CV_STEP(dX, vX, gX, dN, vN, gN) { dN = cv_desc(P, l, CV_R(2)); cv_load(dN, vN, gN); cv_finish(dX, vX, gX, (LAS float*)lds + buf * (64 * 65)); buf ^= 1; r += nwg; }
        for (int it = 0; it < (ntile + 2) / 3; ++it) {
            CV_STEP(dA, vA, gA, dC, vC, gC)
            CV_STEP(dB, vB, gB, dA, vA, gA)
            CV_STEP(dC, vC, gC, dB, vB, gB)
        }
#undef CV_STEP
#undef CV_R
        __syncthreads();
    }
}
__device__ __forceinline__ void phase_init(PP P) {
    using namespace cfg;
    const int lane = ltid() & 63, gw = lbid() * 8 + (ltid() >> 6), nw = gridDim.x * 8;
    bf16_t* hb = (bf16_t*)(P->ws + WS_HB); float* ss0 = (float*)(P->ws + WS_SS);
    for (int row = gw; row < MROWS; row += nw) {
        const float* s = row < MMAIN ? P->in[I_X] + (size_t)row * DM : P->in[I_META] + (size_t)(row - MMAIN) * DM;
        float sq = 0.f;
#pragma unroll
        for (int i = 0; i < 4; ++i) { f32x4 v0 = (f32x4){0.f, 0.f, 0.f, 0.f}, v1 = v0; if (row < MMAIN + NMETA) { v0 = *(const f32x4*)(s + i * 512 + lane * 8); v1 = *(const f32x4*)(s + i * 512 + lane * 8 + 4); }
            sq += ((v0[0] * v0[0] + v0[1] * v0[1]) + (v0[2] * v0[2] + v0[3] * v0[3])) + ((v1[0] * v1[0] + v1[1] * v1[1]) + (v1[2] * v1[2] + v1[3] * v1[3]));
            u32x4 w; w.x = pk_bf16(v0[0], v0[1]); w.y = pk_bf16(v0[2], v0[3]); w.z = pk_bf16(v1[0], v1[1]); w.w = pk_bf16(v1[2], v1[3]); *(u32x4*)(hb + (size_t)row * DM + i * 512 + lane * 8) = w; }
        sq = wave_sum(sq);
        if (lane < 8) ss0[(size_t)lane * MROWS + row] = lane == 0 ? sq : 0.f;
        if (row >= MMAIN && row < MMAIN + NMETA) { float* ssm0 = (float*)(P->ws + WS_SSM); ssm0[lane * 16 + (row - MMAIN)] = lane == 0 ? sq : 0.f; ssm0[(64 + lane) * 16 + (row - MMAIN)] = 0.f; }
    }
}
__device__ __forceinline__ void phase_foxnorm(PP P) {
    using namespace cfg;
    const int lane = ltid() & 63, gw = lbid() * 8 + (ltid() >> 6), nw = gridDim.x * 8;
    bf16_t* y = (bf16_t*)(P->ws + WS_Y);
    for (int tr_ = (MMAIN + NMETA - 1) / (4 * nw); tr_ >= 0; --tr_) { const int row0 = gw + tr_ * 4 * nw; if (row0 >= MMAIN + NMETA) continue;
        u32x4 a[4], b[4];
#pragma unroll
        for (int j = 0; j < 4; ++j) { const int row = row0 + j * nw; if (row < MMAIN + NMETA) { const bf16_t* p = y + (size_t)row * DM + 1024 + lane * 8; a[j] = *(const u32x4*)p; b[j] = *(const u32x4*)(p + 512); } else { a[j] = (u32x4){0u, 0u, 0u, 0u}; b[j] = a[j]; } }
#pragma unroll
        for (int j = 0; j < 4; ++j) { const int row = row0 + j * nw; float v[16];
#pragma unroll
            for (int i = 0; i < 4; ++i) { v[2 * i] = __uint_as_float(a[j][i] << 16); v[2 * i + 1] = __uint_as_float(a[j][i] & 0xffff0000u); v[8 + 2 * i] = __uint_as_float(b[j][i] << 16); v[8 + 2 * i + 1] = __uint_as_float(b[j][i] & 0xffff0000u); }
            float sq = 0.f;
#pragma unroll
            for (int i = 0; i < 16; ++i) sq += v[i] * v[i];
            sq = wave_sum_dpp(sq); const float rs = __builtin_amdgcn_rsqf(sq * (1.0f / 1024.0f) + NORM_EPS);
            u32x4 oa, ob;
#pragma unroll
            for (int i = 0; i < 4; ++i) { oa[i] = pk_bf16(v[2 * i] * rs, v[2 * i + 1] * rs); ob[i] = pk_bf16(v[8 + 2 * i] * rs, v[8 + 2 * i + 1] * rs); }
            if (row < MMAIN + NMETA) { bf16_t* p = y + (size_t)row * DM + 1024 + lane * 8; *(u32x4*)p = oa; *(u32x4*)(p + 512) = ob; } }
    }
}
__device__ __forceinline__ void phase_final(PP P) {
    using namespace cfg;
    const int lane = ltid() & 63, gw = lbid() * 8 + (ltid() >> 6), nw = gridDim.x * 8;
    const float* g = P->in[I_FINN]; const bf16_t* hb = (const bf16_t*)(P->ws + WS_HB);
    typedef unsigned u32x2 __attribute__((ext_vector_type(2)));
    for (int row = gw; row < MMAIN; row += nw) {
        float* d = P->out + (size_t)row * DM; f32x4 v[8]; float sq = 0.f;
#pragma unroll
        for (int i = 0; i < 8; ++i) { const u32x2 x = *(const u32x2*)(hb + (size_t)row * DM + i * 256 + lane * 4);
            v[i] = (f32x4){__uint_as_float(x.x << 16), __uint_as_float(x.x & 0xffff0000u), __uint_as_float(x.y << 16), __uint_as_float(x.y & 0xffff0000u)}; }
#pragma unroll
        for (int i = 0; i < 8; ++i) sq += (v[i][0] * v[i][0] + v[i][1] * v[i][1]) + (v[i][2] * v[i][2] + v[i][3] * v[i][3]);
        sq = wave_sum(sq); const float rs = __builtin_amdgcn_rsqf(sq * (1.0f / 2048.0f) + NORM_EPS);
#pragma unroll
        for (int i = 0; i < 8; ++i) { const f32x4 g0 = *(const f32x4*)(g + i * 256 + lane * 4); *(f32x4*)(d + i * 256 + lane * 4) = v[i] * rs * g0; }
    }
}


__device__ __forceinline__ void phase_lx(PP P, int l) {
    using namespace cfg;
    const int lane = ltid() & 63, gw = lbid() * 8 + (ltid() >> 6), nw = gridDim.x * 8;
    const float* PS = (const float*)(P->ws + WS_PS); bf16_t* LXG = (bf16_t*)(P->ws + WS_LXG); const float* mu = P->in[I_MU] + l * RWKV_COLS + 3072;
    if (lane < 36) {
        const f32x4 m0 = *(const f32x4*)(mu + lane * 8), m1 = *(const f32x4*)(mu + lane * 8 + 4);
#pragma unroll 4
        for (int row = gw; row < MMAIN + NMETA; row += nw) {
            int prev; if (row >= MMAIN) prev = (row == MMAIN) ? -1 : row - 1; else prev = ((row & (SEQ - 1)) == 0) ? MMAIN + NMETA - 1 : row - 1;
            const f32x4 c0 = *(const f32x4*)(PS + (size_t)row * PSW + lane * 8), c1 = *(const f32x4*)(PS + (size_t)row * PSW + lane * 8 + 4);
            f32x4 p0 = (f32x4){0.f, 0.f, 0.f, 0.f}, p1 = p0; if (prev >= 0) { p0 = *(const f32x4*)(PS + (size_t)prev * PSW + lane * 8); p1 = *(const f32x4*)(PS + (size_t)prev * PSW + lane * 8 + 4); }
            float x[8];
#pragma unroll
            for (int j = 0; j < 4; ++j) { x[j] = c0[j] + (p0[j] - c0[j]) * m0[j]; x[4 + j] = c1[j] + (p1[j] - c1[j]) * m1[j]; }
#pragma unroll
            for (int j = 0; j < 8; ++j) x[j] = lane < 8 ? 1.0f - 2.0f * __builtin_amdgcn_rcpf(__expf(2.0f * x[j]) + 1.0f) : (lane < 16 ? x[j] : __builtin_amdgcn_rcpf(1.0f + __expf(-x[j])));
            u32x4 w; w.x = pk_bf16(x[0], x[1]); w.y = pk_bf16(x[2], x[3]); w.z = pk_bf16(x[4], x[5]); w.w = pk_bf16(x[6], x[7]);
            *(u32x4*)(LXG + (size_t)row * 320 + lane * 8) = w;
        }
    }
}

typedef short bf16x8_t __attribute__((ext_vector_type(8)));
typedef short bf16x4_t __attribute__((ext_vector_type(4)));
namespace rk {
constexpr int LXS = 0, LXS_SZ = 18432, RAWH = 55296, RAWH_SZ = 6144, LXB = 73728, RS = 82944, KS = 87040, VS = 91136, KKN = 95232, ATP = 99328, RTP = 101376, BTP = 103424, KTP = 105472,
              BHT = 107520, KHT = 109568, VT = 111616, GT = 113664, AAK = 113920, RB = 114432, RKM = 114944, TINV = 115456, GG = 115968  , VF = 124160  , YR = 132352, BONP = 136448  , LDS_END = 136960;
}
#define RK_BAR() do { asm volatile("s_waitcnt lgkmcnt(0)" ::: "memory"); __builtin_amdgcn_s_barrier(); asm volatile("" ::: "memory"); } while (0)
__device__ __forceinline__ bf16_t bf1(float x) { return (bf16_t)(pk_bf16(x, 0.f) & 0xffffu); }
__device__ __forceinline__ bf16x4_t pack4(float a, float b, float c, float d) { u32x2 w; w.x = pk_bf16(a, b); w.y = pk_bf16(c, d); return __builtin_bit_cast(bf16x4_t, w); }
__device__ __forceinline__ float fast_sigmoid(float x) { return __builtin_amdgcn_rcpf(1.0f + __expf(-x)); }
__device__ __forceinline__ float fast_tanh(float x) { return 1.0f - 2.0f * __builtin_amdgcn_rcpf(__expf(2.0f * x) + 1.0f); }

__device__ __forceinline__ void rwkv_chunked(PP P, int l, int b, int h, LAS unsigned char* lds) {
    using namespace cfg;
    const int tid = ltid(), lane = tid & 63, wave = __builtin_amdgcn_readfirstlane(tid >> 6), n = lane & 15, g = lane >> 4;
    const bf16_t* PR = (const bf16_t*)(P->ws + WS_PR); const float* PS = (const float*)(P->ws + WS_PS); bf16_t* Y = (bf16_t*)(P->ws + WS_Y);
    const float* mu = P->in[I_MU] + l * RWKV_COLS; const bf16_t* LXGp = (const bf16_t*)(P->ws + WS_LXG);
    LAS float* RSm = (LAS float*)(lds + rk::RS); LAS float* KSm = (LAS float*)(lds + rk::KS); LAS float* VSm = (LAS float*)(lds + rk::VS); LAS float* KKNm = (LAS float*)(lds + rk::KKN);
    LAS bf16_t* ATp = (LAS bf16_t*)(lds + rk::ATP); LAS bf16_t* RTp = (LAS bf16_t*)(lds + rk::RTP); LAS bf16_t* BTp = (LAS bf16_t*)(lds + rk::BTP); LAS bf16_t* KTp = (LAS bf16_t*)(lds + rk::KTP);
    LAS bf16_t* BHt = (LAS bf16_t*)(lds + rk::BHT); LAS bf16_t* KHt = (LAS bf16_t*)(lds + rk::KHT); LAS bf16_t* Vt = (LAS bf16_t*)(lds + rk::VT);
    LAS float* GTm = (LAS float*)(lds + rk::GT);
    LAS bf16_t* AAKm = (LAS bf16_t*)(lds + rk::AAK); LAS bf16_t* RBm = (LAS bf16_t*)(lds + rk::RB); LAS bf16_t* RKm = (LAS bf16_t*)(lds + rk::RKM); LAS bf16_t* TINVm = (LAS bf16_t*)(lds + rk::TINV);
    LAS float* YRm = (LAS float*)(lds + rk::YR);
    const int hj = h * 64 + lane;
    const float mur = mu[hj], muk = mu[1024 + hj], muv = mu[2048 + hj], kkw = P->in[I_KK][l * RW + hj], lnw = P->in[I_LNW][l * RW + hj], lnb = P->in[I_LNB][l * RW + hj];
    const int kw = wave & 3, key = 16 * kw + n, hk = h * 64 + key;
    const float w0k = P->in[I_W0][l * RW + hk], a0k = P->in[I_A0][l * RW + hk], kak = P->in[I_KA][l * RW + hk], rkk = P->in[I_RK][l * RW + hk];
    const int pp = 32 * (key >> 5) + 8 * ((key >> 2) & 3) + 4 * ((key >> 4) & 1) + (key & 3);
    bf16x8_t fA[2], fB[5];
    {
        const float* wu = P->in[I_WUP] + (size_t)l * 64 * RW + hk; const float* au = P->in[I_AUP] + (size_t)l * 64 * RW + hk; const float* gu = P->in[I_GUP] + (size_t)l * 160 * RW + hk;
#pragma unroll
        for (int s = 0; s < 5; ++s) { float v[8], u[8];
#pragma unroll
            for (int j = 0; j < 8; ++j) { const int k = 32 * s + 8 * g + j; v[j] = (wave < 4) ? (s < 2 ? au[(size_t)k * RW] : 0.f) : gu[(size_t)k * RW]; u[j] = (wave < 4 && s < 2) ? wu[(size_t)k * RW] : 0.f; }
            u32x4 w; w.x = pk_bf16(v[0], v[1]); w.y = pk_bf16(v[2], v[3]); w.z = pk_bf16(v[4], v[5]); w.w = pk_bf16(v[6], v[7]); fB[s] = __builtin_bit_cast(bf16x8_t, w);
            if (s < 2) { u32x4 x; x.x = pk_bf16(u[0], u[1]); x.y = pk_bf16(u[2], u[3]); x.z = pk_bf16(u[4], u[5]); x.w = pk_bf16(u[6], u[7]); fA[s] = __builtin_bit_cast(bf16x8_t, x); } }
    }
    f32x4 ST[4];
#pragma unroll
    for (int kb = 0; kb < 4; ++kb) ST[kb] = (f32x4){0.f, 0.f, 0.f, 0.f};
#define RK_DMA(c_) do { const int cc_ = (c_); const int row0_ = (cc_ == 0) ? MMAIN : b * SEQ + (cc_ - 1) * 16; const int bi_ = cc_ % 3; \
        _Pragma("unroll") for (int i_ = 0; i_ < 2; ++i_) { const int wp_ = (i_ == 0) ? wave : 8; if (i_ == 0 || wave == 6) { const int x_ = wp_ * 64 + lane; \
            __builtin_amdgcn_global_load_lds((const unsigned*)(LXGp + (size_t)(row0_ + x_ / 36) * 320 + (x_ % 36) * 8), (LAS unsigned*)(lds + rk::LXS + (cc_ & 1) * rk::LXS_SZ + wp_ * 1024), 16, 0, 0); } } \
        if (wave < 6) { const int y_ = wave * 64 + lane; \
            __builtin_amdgcn_global_load_lds((const unsigned*)(PR + (size_t)(row0_ + y_ / 24) * PRW + ((y_ % 24) >> 3) * 1024 + h * 64 + (y_ & 7) * 8), (LAS unsigned*)(lds + rk::RAWH + bi_ * rk::RAWH_SZ + wave * 1024), 16, 0, 0); } } while (0)
#define RK_STAGE_A(ca_, t_) do { const int t = (t_); const int bc_ = (ca_) % 3, bp_ = ((ca_) + 2) % 3; \
        LAS const bf16_t* cH_ = (LAS const bf16_t*)(lds + rk::RAWH + bc_ * rk::RAWH_SZ); LAS const bf16_t* pH_ = (LAS const bf16_t*)(lds + rk::RAWH + bp_ * rk::RAWH_SZ); \
        LAS const bf16_t* ctH = cH_ + t * 192; LAS const bf16_t* ptH = (t == 0) ? pH_ + 15 * 192 : cH_ + (t - 1) * 192; \
        const float rc = bf2f(ctH[lane]), kc = bf2f(ctH[64 + lane]), vc = bf2f(ctH[128 + lane]); \
        const float rs = rc + (bf2f(ptH[lane]) - rc) * mur, ks = kc + (bf2f(ptH[64 + lane]) - kc) * muk, vs = vc + (bf2f(ptH[128 + lane]) - vc) * muv; \
        RSm[t * 64 + lane] = rs; KSm[t * 64 + lane] = ks; VSm[t * 64 + lane] = vs; \
        const float kkr = ks * kkw; const float n2 = wave_sum_dpp(kkr * kkr); KKNm[t * 64 + lane] = kkr * __builtin_amdgcn_rsqf(fmaxf(n2, 1e-24f)); } while (0)
#define RK_STAGE_F(cf_, t_) do { const int t = (t_); const int par_ = (cf_) & 1; const int rowF_ = ((cf_) == 0) ? MMAIN : b * SEQ + ((cf_) - 1) * 16; \
        LAS const float* Gp_ = (LAS const float*)(lds + rk::GG + par_ * 4096); LAS const float* Vp_ = (LAS const float*)(lds + rk::VF + par_ * 4096); LAS const float* Bp_ = (LAS const float*)(lds + rk::BONP + par_ * 256); \
        const float yv = YRm[t * 64 + lane]; \
        const float mean = wave_sum_dpp(yv) * (1.0f / 64.0f); const float d = yv - mean; const float var = wave_sum_dpp(d * d) * (1.0f / 64.0f); \
        const float yn = d * __builtin_amdgcn_rsqf(var + LNX_EPS) * lnw + lnb; \
        const float bonus = (Bp_[t] + Bp_[16 + t]) + (Bp_[32 + t] + Bp_[48 + t]); \
        const float o = (yn + bonus * Vp_[t * 64 + lane]) * Gp_[t * 64 + lane]; \
        if ((cf_) > 0 || b == 0) Y[(size_t)(rowF_ + t) * DM + hj] = bf1(o); } while (0)
    RK_DMA(0); RK_DMA(1);
    for (int e = tid; e < 96; e += 512) ((LAS unsigned*)(lds + rk::RAWH + 2 * rk::RAWH_SZ))[15 * 96 + e] = 0u;
    asm volatile("s_waitcnt vmcnt(0)" ::: "memory");
    RK_BAR();
    RK_STAGE_A(0, wave); RK_STAGE_A(0, wave + 8);
    RK_BAR();
#pragma unroll 1
    for (int c = 0; c < 257; ++c) {
        if (wave < 4) {
            LAS float* BONPc = (LAS float*)(lds + rk::BONP + (c & 1) * 256); LAS const bf16_t* LXB = (LAS const bf16_t*)(lds + rk::LXS + (c & 1) * rk::LXS_SZ);
            f32x4 accW = (f32x4){0.f, 0.f, 0.f, 0.f}, accA = accW;
#pragma unroll
            for (int s = 0; s < 2; ++s) { const bf16x8_t aw = *(const LAS bf16x8_t*)(LXB + n * 288 + 32 * s + 8 * g), aa = *(const LAS bf16x8_t*)(LXB + n * 288 + 64 + 32 * s + 8 * g);
                accW = __builtin_amdgcn_mfma_f32_16x16x32_bf16(aw, fA[s], accW, 0, 0, 0); accA = __builtin_amdgcn_mfma_f32_16x16x32_bf16(aa, fB[s], accA, 0, 0, 0); }
            float lw[4], alr[4], pfx[4];
#pragma unroll
            for (int r = 0; r < 4; ++r) { lw[r] = -0.6065306597126334f * fast_sigmoid(accW[r] + w0k); alr[r] = fast_sigmoid(accA[r] + a0k); }
            pfx[0] = lw[0]; pfx[1] = pfx[0] + lw[1]; pfx[2] = pfx[1] + lw[2]; pfx[3] = pfx[2] + lw[3];
            const float t0 = __shfl(pfx[3], n), t1 = __shfl(pfx[3], n + 16), t2 = __shfl(pfx[3], n + 32), t3 = __shfl(pfx[3], n + 48);
            const float base = (g > 0 ? t0 : 0.f) + (g > 1 ? t1 : 0.f) + (g > 2 ? t2 : 0.f), lamT = (t0 + t1) + (t2 + t3);
            float bh[4], kh[4], bon[4], epos[4];
            const float eb = __expf(base), eT = __expf(lamT);
#pragma unroll
            for (int r = 0; r < 4; ++r) epos[r] = __expf(base + pfx[r]);
#pragma unroll
            for (int r = 0; r < 4; ++r) { const int t = 4 * g + r;
                const float e_pos = epos[r], e_neg = __builtin_amdgcn_rcpf(epos[r]), e_prev = (r == 0) ? eb : epos[r > 0 ? r - 1 : 0], e_hat = eT * e_neg;
                const float rs = RSm[t * 64 + key], ks = KSm[t * 64 + key], kk = KKNm[t * 64 + key];
                const float kmod = ks * (1.0f + (alr[r] - 1.0f) * kak), bb = kk * alr[r];
                ATp[t * 64 + pp] = bf1(-kk * e_prev); RTp[t * 64 + pp] = bf1(rs * e_pos); BTp[t * 64 + pp] = bf1(bb * e_neg); KTp[t * 64 + pp] = bf1(kmod * e_neg);
                bh[r] = bb * e_hat; kh[r] = kmod * e_hat; bon[r] = rs * kmod * rkk; }
            *(LAS bf16x4_t*)(BHt + key * 16 + 4 * g) = pack4(bh[0], bh[1], bh[2], bh[3]); *(LAS bf16x4_t*)(KHt + key * 16 + 4 * g) = pack4(kh[0], kh[1], kh[2], kh[3]);
#pragma unroll
            for (int r = 0; r < 4; ++r) { const float x = row_sum16(bon[r]); if (n == 0) BONPc[kw * 16 + 4 * g + r] = x; }
            if (g == 0) GTm[key] = eT;
        } else {
            LAS float* Gc = (LAS float*)(lds + rk::GG + (c & 1) * 4096); LAS float* VFc = (LAS float*)(lds + rk::VF + (c & 1) * 4096); LAS const bf16_t* LXB = (LAS const bf16_t*)(lds + rk::LXS + (c & 1) * rk::LXS_SZ);
            f32x4 accG = (f32x4){0.f, 0.f, 0.f, 0.f};
#pragma unroll
            for (int s = 0; s < 5; ++s) { const bf16x8_t ag = *(const LAS bf16x8_t*)(LXB + n * 288 + 128 + 32 * s + 8 * g); accG = __builtin_amdgcn_mfma_f32_16x16x32_bf16(ag, fB[s], accG, 0, 0, 0); }
            float vv[4];
#pragma unroll
            for (int r = 0; r < 4; ++r) { Gc[(4 * g + r) * 64 + key] = accG[r]; vv[r] = VSm[(4 * g + r) * 64 + key]; VFc[(4 * g + r) * 64 + key] = vv[r]; }
            *(LAS bf16x4_t*)(Vt + key * 16 + 4 * g) = pack4(vv[0], vv[1], vv[2], vv[3]);
            if (c >= 1) { RK_STAGE_F(c - 1, 4 * kw); RK_STAGE_F(c - 1, 4 * kw + 1); RK_STAGE_F(c - 1, 4 * kw + 2); RK_STAGE_F(c - 1, 4 * kw + 3); }
        }
        asm volatile("s_waitcnt vmcnt(0)" ::: "memory");
        RK_BAR();
        if (c + 2 < 257) RK_DMA(c + 2);
        if (wave < 4) {
            LAS const bf16_t* X = (wave < 2) ? ATp : RTp; LAS const bf16_t* Yi = (wave & 1) ? KTp : BTp;
            f32x4 acc = (f32x4){0.f, 0.f, 0.f, 0.f};
#pragma unroll
            for (int s = 0; s < 2; ++s) { const bf16x8_t xa = *(const LAS bf16x8_t*)(X + n * 64 + 32 * s + 8 * g), yb = *(const LAS bf16x8_t*)(Yi + n * 64 + 32 * s + 8 * g);
                acc = __builtin_amdgcn_mfma_f32_16x16x32_bf16(xa, yb, acc, 0, 0, 0); }
            float mv[4];
#pragma unroll
            for (int r = 0; r < 4; ++r) { const int t = 4 * g + r; const bool keep = (wave < 2) ? (n < t) : (n <= t); mv[r] = keep ? acc[r] : 0.f;
                if (wave == 1) AAKm[t * 16 + n] = bf1(mv[r]); else if (wave == 2) RBm[t * 16 + n] = bf1(mv[r]); else if (wave == 3) RKm[t * 16 + n] = bf1(mv[r]); }
            if (wave == 0) {
                float Tc[16];
#pragma unroll
                for (int t = 0; t < 16; ++t) { float v0 = (t == n) ? 1.0f : 0.0f, v1 = 0.f;
#pragma unroll
                    for (int i = 0; i < t; ++i) { const float a = rdlane(mv[t & 3], i + 16 * (t >> 2)); if (i & 1) v1 += a * Tc[i]; else v0 += a * Tc[i]; }
                    Tc[t] = v0 + v1; asm volatile("" : "+v"(mv[0]), "+v"(mv[1]), "+v"(mv[2]), "+v"(mv[3]));     }
                if (g == 0) {
#pragma unroll
                    for (int t = 0; t < 16; ++t) TINVm[t * 16 + n] = bf1(Tc[t]); }
            }
        }
        if (wave >= 1) {
            if (c + 1 < 257 && wave != 4) { const int t0_ = (wave < 4) ? 3 * (wave - 1) : (wave == 5 ? 9 : 12 + 2 * (wave - 6));
                RK_STAGE_A(c + 1, t0_); RK_STAGE_A(c + 1, t0_ + 1); if (wave < 6) RK_STAGE_A(c + 1, t0_ + 2); }
        }
        RK_BAR();
        if (wave < 4) {
            bf16x8_t sb[2];
#pragma unroll
            for (int s = 0; s < 2; ++s) { u32x4 w; w.x = pk_bf16(ST[2 * s][0], ST[2 * s][1]); w.y = pk_bf16(ST[2 * s][2], ST[2 * s][3]); w.z = pk_bf16(ST[2 * s + 1][0], ST[2 * s + 1][1]); w.w = pk_bf16(ST[2 * s + 1][2], ST[2 * s + 1][3]);
                sb[s] = __builtin_bit_cast(bf16x8_t, w); }
            const bf16x4_t vfr = *(const LAS bf16x4_t*)(Vt + key * 16 + 4 * g);
            f32x4 W1 = (f32x4){0.f, 0.f, 0.f, 0.f}, Yc = W1;
#pragma unroll
            for (int s = 0; s < 2; ++s) { const bf16x8_t af = *(const LAS bf16x8_t*)(ATp + n * 64 + 32 * s + 8 * g), rf = *(const LAS bf16x8_t*)(RTp + n * 64 + 32 * s + 8 * g);
                W1 = __builtin_amdgcn_mfma_f32_16x16x32_bf16(af, sb[s], W1, 0, 0, 0); Yc = __builtin_amdgcn_mfma_f32_16x16x32_bf16(rf, sb[s], Yc, 0, 0, 0); }
            W1 = __builtin_amdgcn_mfma_f32_16x16x16bf16_1k(*(const LAS bf16x4_t*)(AAKm + n * 16 + 4 * g), vfr, W1, 0, 0, 0);
            const bf16x4_t w1f = pack4(W1[0], W1[1], W1[2], W1[3]);
            f32x4 U = __builtin_amdgcn_mfma_f32_16x16x16bf16_1k(*(const LAS bf16x4_t*)(TINVm + n * 16 + 4 * g), w1f, (f32x4){0.f, 0.f, 0.f, 0.f}, 0, 0, 0);
            const bf16x4_t uf = pack4(U[0], U[1], U[2], U[3]);
            Yc = __builtin_amdgcn_mfma_f32_16x16x16bf16_1k(*(const LAS bf16x4_t*)(RBm + n * 16 + 4 * g), uf, Yc, 0, 0, 0);
            Yc = __builtin_amdgcn_mfma_f32_16x16x16bf16_1k(*(const LAS bf16x4_t*)(RKm + n * 16 + 4 * g), vfr, Yc, 0, 0, 0);
#pragma unroll
            for (int r = 0; r < 4; ++r) YRm[(4 * g + r) * 64 + key] = Yc[r];
#pragma unroll
            for (int kb = 0; kb < 4; ++kb) { const f32x4 gt = *(const LAS f32x4*)(GTm + 16 * kb + 4 * g); f32x4 a = ST[kb] * gt;
                a = __builtin_amdgcn_mfma_f32_16x16x16bf16_1k(*(const LAS bf16x4_t*)(BHt + (16 * kb + n) * 16 + 4 * g), uf, a, 0, 0, 0);
                a = __builtin_amdgcn_mfma_f32_16x16x16bf16_1k(*(const LAS bf16x4_t*)(KHt + (16 * kb + n) * 16 + 4 * g), vfr, a, 0, 0, 0);
                ST[kb] = a; }
        }
        RK_BAR();
    }
    RK_STAGE_F(256, wave); RK_STAGE_F(256, wave + 8);
    asm volatile("s_waitcnt vmcnt(0)" ::: "memory");
    RK_BAR();
#undef RK_DMA
#undef RK_STAGE_A
#undef RK_STAGE_F
}

template <int NSTEPS>
__device__ __forceinline__ f32x4 sk_dot(const bf16_t* a, const bf16_t* b) {
    f32x4 acc = (f32x4){0.f, 0.f, 0.f, 0.f};
#pragma unroll
    for (int s = 0; s < NSTEPS; ++s) { const bf16x8_t av = *(const bf16x8_t*)(a + 32 * s), bv = *(const bf16x8_t*)(b + 32 * s); acc = __builtin_amdgcn_mfma_f32_16x16x32_bf16(av, bv, acc, 0, 0, 0); }
    return acc; }
__device__ __forceinline__ void meta_rs(const float* ssm, int lane, float (&rs)[4]) {
    const int row = lane & 15, part = lane >> 4; float s = 0.f;
#pragma unroll
    for (int i = 0; i < 32; ++i) s += ssm[(part + 4 * i) * 16 + row];
    s = s + __shfl_xor(s, 16); s = s + __shfl_xor(s, 32);
    const float rv = __builtin_amdgcn_rsqf(s * (1.0f / 2048.0f) + 1e-6f);
#pragma unroll
    for (int r = 0; r < 4; ++r) rs[r] = __shfl(rv, 4 * part + r); }
#define SK_HEAD const int tid = ltid(), lane = tid & 63, wave = __builtin_amdgcn_readfirstlane(tid >> 6), n = lane & 15, g = lane >> 4, kq = wave & 3, ti = lbid() + 256 * (wave >> 2); LAS f32x4* part = (LAS f32x4*)lds;
#define SK_COMBINE(dst, slot) do { dst = (part[((wave) * 2 + (slot)) * 64 + lane] + part[((wave + 1) * 2 + (slot)) * 64 + lane]) + (part[((wave + 2) * 2 + (slot)) * 64 + lane] + part[((wave + 3) * 2 + (slot)) * 64 + lane]); } while (0)
__device__ __forceinline__ void skinny_gu(const bf16_t* hb, const bf16_t* Bt, const float* ssm, bf16_t* act, LAS unsigned char* lds) {
    using namespace cfg; SK_HEAD
    float rs[4] = {0.f, 0.f, 0.f, 0.f};
    if (ti < DFF / 16 && kq == 0) meta_rs(ssm, lane, rs);
    if (ti < DFF / 16) { const int c0 = 16 * ti, brow = (c0 >> 7) * 256 + (c0 & 127) + n; const bf16_t* a = hb + (size_t)(MMAIN + n) * DM + 512 * kq + 8 * g;
        part[(wave * 2) * 64 + lane] = sk_dot<16>(a, Bt + (size_t)brow * DM + 512 * kq + 8 * g); part[(wave * 2 + 1) * 64 + lane] = sk_dot<16>(a, Bt + (size_t)(brow + 128) * DM + 512 * kq + 8 * g); }
    __syncthreads();
    if (ti < DFF / 16 && kq == 0) { f32x4 gt, up; SK_COMBINE(gt, 0); SK_COMBINE(up, 1);
#pragma unroll
        for (int r = 0; r < 4; ++r) { const float gv = gt[r] * rs[r], uv = up[r] * rs[r]; act[(size_t)(MMAIN + 4 * g + r) * DFF + 16 * ti + n] = bf1(gv * __builtin_amdgcn_rcpf(1.0f + __builtin_amdgcn_exp2f(-1.4426950408889634f * gv)) * uv); } }
    __syncthreads();
}
template <int K>
__device__ __forceinline__ void skinny_res(const bf16_t* A16, const bf16_t* Bt, bf16_t* hb, float* ssm_out, float alpha, LAS unsigned char* lds) {
    using namespace cfg;
    const int tid = ltid(), lane = tid & 63, wave = __builtin_amdgcn_readfirstlane(tid >> 6), n = lane & 15, g = lane >> 4, ti = lbid(); LAS f32x4* part = (LAS f32x4*)lds;
    constexpr int k8 = K / 8;
    float h0[4] = {0.f, 0.f, 0.f, 0.f};
    if (ti < DM / 16 && wave == 0) {
#pragma unroll
        for (int r = 0; r < 4; ++r) h0[r] = bf2f(hb[(size_t)(MMAIN + 4 * g + r) * DM + 16 * ti + n]); }
    if (ti < DM / 16) part[wave * 64 + lane] = sk_dot<k8 / 32>(A16 + (size_t)n * K + k8 * wave + 8 * g, Bt + (size_t)(16 * ti + n) * K + k8 * wave + 8 * g);
    __syncthreads();
    if (ti < DM / 16 && wave == 0) { const f32x4 acc = ((part[lane] + part[64 + lane]) + (part[128 + lane] + part[192 + lane])) + ((part[256 + lane] + part[320 + lane]) + (part[384 + lane] + part[448 + lane]));
#pragma unroll
        for (int r = 0; r < 4; ++r) { const int m = 4 * g + r, col = 16 * ti + n; bf16_t* p = hb + (size_t)(MMAIN + m) * DM + col; const float hv = h0[r] + alpha * acc[r]; *p = bf1(hv);
            const float sq = row_sum16(hv * hv); if (n == 0) ssm_out[ti * 16 + m] = sq; } }
    __syncthreads();
}
__device__ __forceinline__ void skinny_p(const bf16_t* hb, const bf16_t* Bt, const float* ssm, bf16_t* pr, float* ps, bf16_t* qkv, LAS unsigned char* lds) {
    using namespace cfg; SK_HEAD
    float rs[4] = {0.f, 0.f, 0.f, 0.f};
    if (ti < NIN / 16 && kq == 0) meta_rs(ssm, lane, rs);
    if (ti < NIN / 16) part[(wave * 2) * 64 + lane] = sk_dot<16>(hb + (size_t)(MMAIN + n) * DM + 512 * kq + 8 * g, Bt + (size_t)(16 * ti + n) * DM + 512 * kq + 8 * g);
    __syncthreads();
    if (ti < NIN / 16 && kq == 0) { f32x4 acc; SK_COMBINE(acc, 0); const int np = 16 * ti + n;
#pragma unroll
        for (int r = 0; r < 4; ++r) { const int m = 4 * g + r; const float v = acc[r] * rs[r];
            if (np < 3072) pr[(size_t)(MMAIN + m) * PRW + np] = bf1(v);
            else if (np < 3584) ps[(size_t)(MMAIN + m) * PSW + (np - 3072)] = v;
            else { const bf16_t w = bf1(v);
#pragma unroll
                for (int b = 0; b < NBATCH; ++b) qkv[((size_t)b * SEQP + 48 + m) * QKVW + (np - 3584)] = w; } } }
    __syncthreads();
}
#undef SK_HEAD
#undef SK_COMBINE

namespace fox {
constexpr int D = 128, NW = 8, QBLK = 32, KVBLK = 64, QB = NW * QBLK;
constexpr int LDQ = cfg::QKVW, LDK = cfg::QKVW, LDO = cfg::DM;
constexpr float SCALE = 0.08838834764831845f, THR = 8.f;
constexpr bool WSKIP = false;
constexpr int SHM_V = KVBLK * D * 2, SHM_K = KVBLK * D * 2;
constexpr int ATT_LDS = 2 * SHM_V + 2 * SHM_K + NW * 64 * 4;
constexpr int BIAS_OFF = ATT_LDS;
constexpr int SCAN_OFF = BIAS_OFF + cfg::SEQP * 4;

using bf16 = __hip_bfloat16;
typedef short bf16x8 __attribute__((ext_vector_type(8)));
typedef short s16x4 __attribute__((ext_vector_type(4)));
typedef float f32x16 __attribute__((ext_vector_type(16)));
typedef float f32x4 __attribute__((ext_vector_type(4)));
typedef unsigned u32x4 __attribute__((ext_vector_type(4)));
template <class A, class Bt> struct same_t { static constexpr bool v = false; };
template <class A> struct same_t<A, A> { static constexpr bool v = true; };

#define KSWZ(row, colB) ((row) * 256 + ((colB) ^ (((row) & 7) << 4)))
#define SBAR() __builtin_amdgcn_sched_barrier(0)
__device__ __forceinline__ int v_st(int k, int c) { const int kk = (k & ~0xC) | ((k & 4) << 1) | ((k & 8) >> 1); return ((kk >> 3) * 4 + (c >> 5)) * 512 + ((kk & 7) * 32 + (c & 31)) * 2; }
__device__ __forceinline__ int v_rd_base(int lane) { return ((lane & 3) << 3) | (((lane >> 2) & 3) << 6) | (((lane >> 4) & 1) << 5) | (((lane >> 5) & 1) << 8); }
constexpr int v_rd_off(int d0, int ks, int half) { return d0 * 512 + ks * 4096 + half * 2048; }
__device__ __forceinline__ int crow(int r, int hi) { return (r & 3) + 8 * (r >> 2) + 4 * hi; }
__device__ __forceinline__ unsigned cvtpk(float lo, float hi) {
    unsigned r; asm volatile("v_cvt_pk_bf16_f32 %0, %1, %2" : "=v"(r) : "v"(lo), "v"(hi)); return r;
}
__device__ __forceinline__ bf16x8 pack8(f32x4 a, f32x4 b) {
    u32x4 w = {cvtpk(a[0], a[1]), cvtpk(a[2], a[3]), cvtpk(b[0], b[1]), cvtpk(b[2], b[3])};
    return *reinterpret_cast<bf16x8*>(&w);
}
template <class T> __device__ __forceinline__ bf16x8 load8(const T* p) {
    if constexpr (same_t<T, float>::v) { return pack8(*(const f32x4*)p, *(const f32x4*)(p + 4)); }
    else { return *reinterpret_cast<const bf16x8*>(p); }
}
__device__ __forceinline__ void mask_tile(f32x16& p0, f32x16& p1, int dq, unsigned W) {
    const float NEG = -__builtin_inff();
#pragma unroll
    for (int r = 0; r < 16; ++r) {
        const int c = (r & 3) + 8 * (r >> 2);
        if ((unsigned)(dq - c) >= W) p0[r] = NEG;
        if ((unsigned)(dq - c - 32) >= W) p1[r] = NEG;
    }
}
__device__ __forceinline__ void partialSM(f32x16& p0, f32x16& p1, float& m_reg, float& mn, float& alpha) {
    float pmax = p0[0]; for (int r = 1; r < 16; ++r) pmax = fmaxf(pmax, p0[r]); for (int r = 0; r < 16; ++r) pmax = fmaxf(pmax, p1[r]);
    { auto rr = __builtin_amdgcn_permlane32_swap(__float_as_uint(pmax), __float_as_uint(pmax), false, false);
      pmax = fmaxf(__uint_as_float(rr[0]), __uint_as_float(rr[1])); }
    constexpr float C2 = 1.4426950408889634f * SCALE;
    if (__builtin_expect(__all((pmax - m_reg) * SCALE <= THR), 1)) { mn = m_reg; alpha = 1.f; }
    else { mn = fmaxf(m_reg, pmax); alpha = __builtin_amdgcn_exp2f((m_reg - mn) * C2); m_reg = mn; }
    const float mnL = -mn * C2;
    for (int r = 0; r < 16; ++r) p0[r] = fmaf(p0[r], C2, mnL); for (int r = 0; r < 16; ++r) p1[r] = fmaf(p1[r], C2, mnL);
    for (int r = 0; r < 16; ++r) p0[r] = __builtin_amdgcn_exp2f(p0[r]);
}
__device__ __forceinline__ void finishSM(f32x16& p0, f32x16& p1, float alpha, float& l_reg, bf16x8& pa0, bf16x8& pa1, bf16x8& pa2, bf16x8& pa3) {
    for (int r = 0; r < 16; ++r) p1[r] = __builtin_amdgcn_exp2f(p1[r]);
    float ps = 0; for (int r = 0; r < 16; ++r) ps += p0[r]; for (int r = 0; r < 16; ++r) ps += p1[r];
    { auto rr = __builtin_amdgcn_permlane32_swap(__float_as_uint(ps), __float_as_uint(ps), false, false);
      ps = __uint_as_float(rr[0]) + __uint_as_float(rr[1]); }
    l_reg = l_reg * alpha + ps;
#define PK4(P, B_, OUT) do { unsigned a0 = cvtpk(P[B_+0], P[B_+1]), a1 = cvtpk(P[B_+2], P[B_+3]);                          \
        unsigned b0 = cvtpk(P[B_+4], P[B_+5]), b1 = cvtpk(P[B_+6], P[B_+7]);                                             \
        auto r0 = __builtin_amdgcn_permlane32_swap(a0, b0, false, false); auto r1 = __builtin_amdgcn_permlane32_swap(a1, b1, false, false); \
        u32x4 w = {r0[0], r1[0], r0[1], r1[1]}; OUT = *reinterpret_cast<bf16x8*>(&w); } while (0)
    PK4(p0, 0, pa0); PK4(p0, 8, pa1); PK4(p1, 0, pa2); PK4(p1, 8, pa3);
#undef PK4
}
template <int KB, bool SK>
__device__ __forceinline__ void qkt(f32x16& p0, f32x16& p1, const char* K_lds, int r32, int hi, const bf16x8* qr, bool act, const float* bias_t) {
    if (SK && !act) { const float NEG = -__builtin_inff();
#pragma unroll
        for (int r = 0; r < 16; ++r) { p0[r] = NEG; p1[r] = NEG; } return; }
    {
#pragma unroll
        for (int g_ = 0; g_ < 4; ++g_) { const f32x4 b0_ = *(const f32x4*)(bias_t + 8 * g_ + 4 * hi); const f32x4 b1_ = *(const f32x4*)(bias_t + 32 + 8 * g_ + 4 * hi);
            p0[4 * g_] = b0_[0]; p0[4 * g_ + 1] = b0_[1]; p0[4 * g_ + 2] = b0_[2]; p0[4 * g_ + 3] = b0_[3];
            p1[4 * g_] = b1_[0]; p1[4 * g_ + 1] = b1_[1]; p1[4 * g_ + 2] = b1_[2]; p1[4 * g_ + 3] = b1_[3]; } }
    const char* kb[4];
#pragma unroll
    for (int dd = 0; dd < 4; ++dd) kb[dd] = K_lds + KB * SHM_K + KSWZ(r32, (dd * 16 + hi * 8) * 2);
#pragma unroll
    for (int d0 = 0; d0 < 8; ++d0) { const char* a = kb[d0 & 3] + (d0 >> 2) * 128;
        bf16x8 b0 = *reinterpret_cast<const bf16x8*>(a);
        bf16x8 b1 = *reinterpret_cast<const bf16x8*>(a + 32 * 256);
        p0 = __builtin_amdgcn_mfma_f32_32x32x16_bf16(b0, qr[d0], p0, 0, 0, 0);
        p1 = __builtin_amdgcn_mfma_f32_32x32x16_bf16(b1, qr[d0], p1, 0, 0, 0); }
}
template <int VB, bool SK>
__device__ __forceinline__ void pv_tile(f32x16* o, int vb0, bf16x8 pa0, bf16x8 pa1, bf16x8 pa2, bf16x8 pa3, bool act) {
    if (SK && !act) return;
#define TRRD(dst, off) asm volatile("ds_read_b64_tr_b16 %0, %1 offset:%2" : "=&v"(dst) : "v"(vb0), "i"(off) : "memory")
#define PV_D0(d0) do { s16x4 l0, l1, l2, l3, h0, h1, h2, h3; constexpr int b_ = VB * SHM_V + v_rd_off(d0, 0, 0);     \
        TRRD(l0, b_); TRRD(h0, b_ + 2048); TRRD(l1, b_ + 4096); TRRD(h1, b_ + 6144); TRRD(l2, b_ + 8192); TRRD(h2, b_ + 10240); TRRD(l3, b_ + 12288); TRRD(h3, b_ + 14336); \
        asm volatile("s_waitcnt lgkmcnt(0)" ::: "memory"); SBAR();                 \
        o[d0] = __builtin_amdgcn_mfma_f32_32x32x16_bf16(pa0, (bf16x8){l0[0], l0[1], l0[2], l0[3], h0[0], h0[1], h0[2], h0[3]}, o[d0], 0, 0, 0);   \
        o[d0] = __builtin_amdgcn_mfma_f32_32x32x16_bf16(pa1, (bf16x8){l1[0], l1[1], l1[2], l1[3], h1[0], h1[1], h1[2], h1[3]}, o[d0], 0, 0, 0);   \
        o[d0] = __builtin_amdgcn_mfma_f32_32x32x16_bf16(pa2, (bf16x8){l2[0], l2[1], l2[2], l2[3], h2[0], h2[1], h2[2], h2[3]}, o[d0], 0, 0, 0);   \
        o[d0] = __builtin_amdgcn_mfma_f32_32x32x16_bf16(pa3, (bf16x8){l3[0], l3[1], l3[2], l3[3], h3[0], h3[1], h3[2], h3[3]}, o[d0], 0, 0, 0); } while (0)
    PV_D0(0); PV_D0(1); PV_D0(2); PV_D0(3);
#undef PV_D0
#undef TRRD
}

template <class TIn, class TOut> struct BlockRef { const TIn* Q; const TIn* K; const TIn* V; TOut* O; int P0; };
template <class TIn> struct Seam {
    bf16x8 qr[8];
    bf16x8 st_v0, st_v1, st_k0, st_k1; f32x4 sf0, sf1, sf2, sf3;
    f32x4 tq[16];
};
__device__ __forceinline__ int swa_jlo(int P0, int W) { const int lowk = P0 - W + 1; return lowk > 0 ? lowk / KVBLK : 0; }
#define ROW(p, k0, rr) ((p) + (size_t)((k0) + (rr)) * LDK + sc)
#define VMW() asm volatile("s_waitcnt vmcnt(0)" ::: "memory")
#define VMWN(n) asm volatile("s_waitcnt vmcnt(%0)" :: "i"(n) : "memory")
#define SLOAD_H(Kp, Vp, k0) do { S.st_v0 = load8<TIn>(ROW(Vp, k0, sr)); S.st_v1 = load8<TIn>(ROW(Vp, k0, 32 + sr));              \
                         S.st_k0 = load8<TIn>(ROW(Kp, k0, sr)); S.st_k1 = load8<TIn>(ROW(Kp, k0, 32 + sr)); } while (0)
#define SWRITE_HK(bf) do { *(bf16x8*)(K_lds + (bf) * SHM_K + kws) = S.st_k0; *(bf16x8*)(K_lds + (bf) * SHM_K + kws + 32 * 256) = S.st_k1; } while (0)
#define SWRITE_HV(bf) do { *(bf16x8*)(V_lds + (bf) * SHM_V + vst0) = S.st_v0; *(bf16x8*)(V_lds + (bf) * SHM_V + vst1) = S.st_v1; } while (0)
#define SWRITE_H(bf) do { SWRITE_HV(bf); SWRITE_HK(bf); } while (0)
#define SLOAD_F(p, k0) do { S.sf0 = *(const f32x4*)ROW(p, k0, sr); S.sf1 = *(const f32x4*)(ROW(p, k0, sr) + 4);                \
                            S.sf2 = *(const f32x4*)ROW(p, k0, 32 + sr); S.sf3 = *(const f32x4*)(ROW(p, k0, 32 + sr) + 4); } while (0)
#define SWRITE_KF(bf) do { *(bf16x8*)(K_lds + (bf) * SHM_K + kws) = pack8(S.sf0, S.sf1); *(bf16x8*)(K_lds + (bf) * SHM_K + kws + 32 * 256) = pack8(S.sf2, S.sf3); } while (0)
#define SWRITE_VF(bf) do { *(bf16x8*)(V_lds + (bf) * SHM_V + vst0) = pack8(S.sf0, S.sf1); *(bf16x8*)(V_lds + (bf) * SHM_V + vst1) = pack8(S.sf2, S.sf3); } while (0)
template <class TIn, class TOut>
__device__ __forceinline__ void causal_swa_prime(const BlockRef<TIn, TOut>& cur, int W, char* lds, Seam<TIn>& S) {
    constexpr bool F32 = same_t<TIn, float>::v;
    const int tid = ltid(), wid = __builtin_amdgcn_readfirstlane(tid >> 6), lane = tid & 63, r32 = lane & 31, hi = lane >> 5;
    const int sr = tid >> 4, sc = (tid & 15) * 8, kws = KSWZ(sr, sc * 2); char* K_lds = lds + 2 * SHM_V;
    const int kb0 = swa_jlo(cur.P0, W) * KVBLK;
    for (int d0 = 0; d0 < 8; ++d0) S.qr[d0] = load8<TIn>(cur.Q + (size_t)(wid * QBLK + r32) * LDQ + d0 * 16 + hi * 8);
    if constexpr (F32) { SLOAD_F((const float*)cur.K, kb0); VMW(); SWRITE_KF(0); SBAR(); SLOAD_F((const float*)cur.V, kb0); }
    else { SLOAD_H(cur.K, cur.V, kb0); VMW(); SWRITE_HK(0); }
    __syncthreads();
}
template <class TIn, class TOut>
__device__ __forceinline__ void causal_swa_block(const BlockRef<TIn, TOut>& cur, const BlockRef<TIn, TOut>& nxt, int skv, int W, char* lds, Seam<TIn>& S, const float* bias_l) {
    constexpr bool F32 = same_t<TIn, float>::v;
    const int tid = ltid(), wid = __builtin_amdgcn_readfirstlane(tid >> 6), lane = tid & 63, r32 = lane & 31, hi = lane >> 5;
    const int j_lo = swa_jlo(cur.P0, W);
    int j_hi = (cur.P0 + QB - 1) / KVBLK + 1; if (j_hi > skv / KVBLK) j_hi = skv / KVBLK;
    const int NT = j_hi - j_lo;
    const int kbn = swa_jlo(nxt.P0, W) * KVBLK;
    const int qlo = cur.P0 + wid * QBLK, qm = qlo + r32 - 4 * hi;
    char* V_lds = lds; char* K_lds = lds + 2 * SHM_V;
    float* ws = (float*)(lds + 2 * SHM_V + 2 * SHM_K) + wid * 64; float* li_l = ws, * al_l = ws + 32;
    float m_reg = -1e30f, l_reg = 0; f32x16 o[4] = {};
    const int sr = tid >> 4, sc = (tid & 15) * 8, vst0 = v_st(sr, sc), vst1 = v_st(32 + sr, sc), kws = KSWZ(sr, sc * 2);
    const int vb0 = (int)(uintptr_t)V_lds + v_rd_base(lane);
    const TIn* Kh = cur.K; const TIn* Vh = cur.V;
#define RESC(a) do { if (__any((a) < 1.f)) { if (hi == 0) al_l[r32] = (a); asm volatile("s_waitcnt lgkmcnt(0)" ::: "memory");              \
                     for (int d_ = 0; d_ < 4; ++d_) for (int r = 0; r < 16; ++r) o[d_][r] *= al_l[crow(r, hi)]; } } while (0)
#define KBASE(t) ((j_lo + (t)) * KVBLK)
#define ACT(t) (KBASE(t) <= qlo + QBLK - 1 && KBASE(t) + KVBLK - 1 >= qlo - W + 1)
#define MASKT(P0_, P1_, t) do { const int kb_ = KBASE(t); if ((!SK || ACT(t)) && (kb_ + KVBLK - 1 > qlo || kb_ <= qlo + QBLK - 1 - W)) mask_tile(P0_, P1_, qm - kb_, (unsigned)W); } while (0)
    constexpr int NQL = F32 ? 16 : 8;
    constexpr bool SK = WSKIP && !F32;
#define SEAM_K0() do { VMWN(NQL); if constexpr (F32) { SWRITE_KF(0); SBAR(); SLOAD_F((const float*)nxt.V, kbn); } else { SWRITE_HK(0); } SBAR(); } while (0)
    f32x16 pA0, pA1, pB0, pB1; float mnA, mnB, alA, alB; bf16x8 pa0, pa1, pa2, pa3;
    if constexpr (F32) { VMW(); SWRITE_VF(0); SBAR(); } else { SWRITE_HV(0); SBAR(); }
    if (NT > 1) { if constexpr (F32) SLOAD_F((const float*)Kh, KBASE(1)); else SLOAD_H(Kh, Vh, KBASE(1)); }
    SBAR(); qkt<0, SK>(pA0, pA1, K_lds, r32, hi, S.qr, ACT(0), bias_l + KBASE(0));
    if constexpr (F32) { if (NT > 1) { VMW(); SWRITE_KF(1); SBAR(); SLOAD_F((const float*)Vh, KBASE(1)); } }
    MASKT(pA0, pA1, 0); partialSM(pA0, pA1, m_reg, mnA, alA);
    if (NT > 1) { VMW(); if constexpr (F32) { SWRITE_VF(1); SBAR(); if (NT > 2) SLOAD_F((const float*)Kh, KBASE(2)); } else SWRITE_H(1); }
    __syncthreads();
#define HALF_STEP(PX0, PX1, mnX, alX, PY0, PY1, alY, t, KB, VB, SB) do {                                                      \
        SBAR(); qkt<KB, SK>(PX0, PX1, K_lds, r32, hi, S.qr, ACT(t), bias_l + KBASE(t));                                             \
        finishSM(PY0, PY1, alY, l_reg, pa0, pa1, pa2, pa3); SBAR();                                                           \
        if ((t) + 1 < NT) { if constexpr (F32) { VMW(); SWRITE_KF(SB); SBAR(); SLOAD_F((const float*)Vh, KBASE((t) + 1)); }  \
                            else { SLOAD_H(Kh, Vh, KBASE((t) + 1)); } SBAR(); }                                               \
        pv_tile<VB, SK>(o, vb0, pa0, pa1, pa2, pa3, ACT((t) - 1)); MASKT(PX0, PX1, (t)); partialSM(PX0, PX1, m_reg, mnX, alX);                                        \
        __syncthreads();                                                                                                      \
        if ((t) + 1 < NT) { VMW(); if constexpr (F32) { SWRITE_VF(SB); SBAR(); if ((t) + 2 < NT) SLOAD_F((const float*)Kh, KBASE((t) + 2)); } \
                            else { SWRITE_H(SB); } }                                                                          \
        RESC(alX); __syncthreads(); } while (0)
    for (int t = 1; t + 1 < NT; t += 2) {
        HALF_STEP(pB0, pB1, mnB, alB, pA0, pA1, alA, t, 1, 0, 0);
        HALF_STEP(pA0, pA1, mnA, alA, pB0, pB1, alB, t + 1, 0, 1, 1);
    }
    const bool even = (NT & 1) == 0;
    if (even) { SBAR(); qkt<1, SK>(pB0, pB1, K_lds, r32, hi, S.qr, ACT(NT - 1), bias_l + KBASE(NT - 1)); SBAR(); }
#define QROW(e) (nxt.Q + (size_t)(wid * QBLK + r32) * LDQ + ((e) >> 1) * 16 + hi * 8 + ((e) & 1) * 4)
    if constexpr (F32) { SLOAD_F((const float*)nxt.K, kbn); SBAR();
#pragma unroll
        for (int e = 0; e < 8; ++e) S.tq[e] = *(const f32x4*)QROW(e); }
    else { SLOAD_H(nxt.K, nxt.V, kbn); SBAR();
#pragma unroll
        for (int d0 = 0; d0 < 8; ++d0) S.qr[d0] = load8<TIn>(nxt.Q + (size_t)(wid * QBLK + r32) * LDQ + d0 * 16 + hi * 8); }
    SBAR();
    finishSM(pA0, pA1, alA, l_reg, pa0, pa1, pa2, pa3); SBAR();
    if constexpr (F32) {
#pragma unroll
        for (int e = 8; e < 16; ++e) S.tq[e] = *(const f32x4*)QROW(e); SBAR(); }
#undef QROW
    pv_tile<0, SK>(o, vb0, pa0, pa1, pa2, pa3, ACT(even ? NT - 2 : NT - 1));
    if (even) { MASKT(pB0, pB1, NT - 1); partialSM(pB0, pB1, m_reg, mnB, alB); __syncthreads(); RESC(alB);
        finishSM(pB0, pB1, alB, l_reg, pa0, pa1, pa2, pa3); SBAR(); pv_tile<1, SK>(o, vb0, pa0, pa1, pa2, pa3, ACT(NT - 1)); }
    SBAR(); SEAM_K0();
    if (hi == 0) li_l[r32] = l_reg; asm volatile("s_waitcnt lgkmcnt(0)" ::: "memory");
    float rli[16];
#pragma unroll
    for (int r = 0; r < 16; ++r) rli[r] = __builtin_amdgcn_rcpf(li_l[crow(r, hi)]);
    TOut* Ow = cur.O + (size_t)(wid * QBLK) * LDO;
#pragma unroll
    for (int r = 0; r < 16; ++r) { const int orow = crow(r, hi);
#pragma unroll
        for (int d0 = 0; d0 < 4; ++d0) { const float v = o[d0][r] * rli[r];
            if constexpr (same_t<TOut, float>::v) { Ow[(size_t)orow * LDO + d0 * 32 + r32] = v; }
            else { const float vn = __shfl_xor(v, 1);
                   if ((r32 & 1) == 0) *(unsigned*)(Ow + (size_t)orow * LDO + d0 * 32 + r32) = cvtpk(v, vn); } } }
    if constexpr (F32) {
#pragma unroll
        for (int d0 = 0; d0 < 8; ++d0) S.qr[d0] = pack8(S.tq[2 * d0], S.tq[2 * d0 + 1]); }
    __syncthreads();
#undef RESC
#undef KBASE
#undef ACT
#undef MASKT
#undef SEAM_K0
#undef HALF_STEP
}
#undef ROW
#undef VMW
#undef VMWN
#undef SLOAD_H
#undef SWRITE_HK
#undef SWRITE_HV
#undef SWRITE_H
#undef SLOAD_F
#undef SWRITE_KF

}

__device__ __forceinline__ void fox_bias(PP P, int l, int b, int h, float* bias, float* scr) {
    using namespace cfg;
    const int tid = ltid(), lane = tid & 63, wave = tid >> 6;
    const float* PS = (const float*)(P->ws + WS_PS); const float bf = P->in[I_BF][l * FNH + h];
    float lf[9]; float loc = 0.f;
#pragma unroll
    for (int i = 0; i < 9; ++i) { const int pos = tid * 9 + i; float v = 0.f;
        if (pos < NMETA + SEQ) { const int row = pos < NMETA ? MMAIN + pos : b * SEQ + pos - NMETA; const float z = PS[(size_t)row * PSW + 288 + h] + bf;
            v = fminf(z, 0.f) - log1pf(__expf(-fabsf(z))); }
        loc += v; lf[i] = loc; }
    float inc = loc;
#pragma unroll
    for (int o = 1; o < 64; o <<= 1) { const float t = __shfl_up(inc, o); if (lane >= o) inc += t; }
    if (lane == 63) scr[wave] = inc;
    __syncthreads();
    float base = inc - loc;
    for (int w = 0; w < wave; ++w) base += scr[w];
    constexpr float INV = 1.0f / fox::SCALE;
#pragma unroll
    for (int i = 0; i < 9; ++i) { const int pos = tid * 9 + i; if (pos < NMETA + SEQ) bias[48 + pos] = -(base + lf[i]) * INV; }
    if (tid < 48) bias[tid] = -__builtin_inff();
    __syncthreads();
}
__device__ __forceinline__ void fox_meta(PP P, int h, const float* bias) {
    using namespace cfg;
    const int lane = ltid() & 63, wave = ltid() >> 6;
    const bf16_t* QKV = (const bf16_t*)(P->ws + WS_QKV); bf16_t* Y = (bf16_t*)(P->ws + WS_Y);
    for (int rep = 0; rep < 2; ++rep) { const int i = wave + 8 * rep;
        float s = -__builtin_inff();
        if (lane <= i) { const bf16_t* q = QKV + (size_t)(48 + i) * QKVW + h * 128; const bf16_t* k = QKV + (size_t)(48 + lane) * QKVW + 1024 + h * 128; float dot = 0.f;
            for (int d = 0; d < 128; ++d) dot += bf2f(q[d]) * bf2f(k[d]);
            s = (dot + bias[48 + lane]) * fox::SCALE; }
        const float m = wave_max(s); const float p = (lane <= i) ? __expf(s - m) : 0.f; const float lsum = wave_sum(p);
        float o0 = 0.f, o1 = 0.f;
        for (int j = 0; j <= i; ++j) { const float pj = __shfl(p, j); const bf16_t* v = QKV + (size_t)(48 + j) * QKVW + 2048 + h * 128; o0 += pj * bf2f(v[lane]); o1 += pj * bf2f(v[64 + lane]); }
        const float il = 1.0f / lsum;
        Y[(size_t)(MMAIN + i) * DM + 1024 + h * 128 + lane] = (bf16_t)(pk_bf16(o0 * il, 0.f) & 0xffffu);
        Y[(size_t)(MMAIN + i) * DM + 1024 + h * 128 + 64 + lane] = (bf16_t)(pk_bf16(o1 * il, 0.f) & 0xffffu); }
}
__device__ __forceinline__ fox::BlockRef<__hip_bfloat16, __hip_bfloat16> fox_mk(int a, int idx, const __hip_bfloat16* Qb, const __hip_bfloat16* Kb, const __hip_bfloat16* Vb, __hip_bfloat16* Ob) {
    const int pr = 4 * (a & 1) + (idx >> 1); const int x = (idx & 1) ? 15 - pr : pr;
    fox::BlockRef<__hip_bfloat16, __hip_bfloat16> r; r.Q = Qb + (size_t)x * 256 * cfg::QKVW; r.K = Kb; r.V = Vb; r.O = Ob + (size_t)x * 256 * cfg::DM; r.P0 = 64 + 256 * x; return r; }
__device__ __forceinline__ void fox_wg(PP P, int l, int a, char* lds) {
    using namespace cfg;
    typedef __hip_bfloat16 bf;
    const int bh = a >> 1, b = bh >> 3, h = bh & 7;
    float* bias = (float*)(lds + fox::BIAS_OFF); float* scr = (float*)(lds + fox::SCAN_OFF);
    fox_bias(P, l, b, h, bias, scr);
    const bf* QKV = (const bf*)(P->ws + WS_QKV); bf* Y = (bf*)(P->ws + WS_Y);
    const bf* Kb = QKV + (size_t)b * SEQP * QKVW + 1024 + h * 128; const bf* Vb = Kb + 1024; const bf* Qb = QKV + ((size_t)b * SEQP + 64) * QKVW + h * 128;
    bf* Ob = Y + (size_t)b * SEQ * DM + 1024 + h * 128;
    constexpr int W = 1 << 30;
    fox::Seam<bf> S;
    fox::BlockRef<bf, bf> cur = fox_mk(a, 0, Qb, Kb, Vb, Ob);
    fox::causal_swa_prime<bf, bf>(cur, W, lds, S);
#pragma unroll 1
    for (int idx = 0; idx < 8; ++idx) {
        const fox::BlockRef<bf, bf> nxt = (idx < 7) ? fox_mk(a, idx + 1, Qb, Kb, Vb, Ob) : cur;
        fox::causal_swa_block<bf, bf>(cur, nxt, SEQP, W, lds, S, bias);
        cur = nxt;
    }
    if (b == 0) fox_meta(P, h, bias);
}

#define WS_PTR(T, off) ((T*)(Q->ws + (off)))
#define SEAM() do { PP Qb_ = launder(P); XcdBarrier b_; b_.bar = (unsigned*)(Qb_->ws + WS_CTL); b_.x = xb_xcc_id(); b_.st = (volatile LAS unsigned*)(lds + LDS_BARW); xcd_barrier(b_); } while (0)
__global__ void __launch_bounds__(512, 2) hymba_fwd(Params Pv) {
    using namespace cfg;
    PP P = (PP)__builtin_amdgcn_kernarg_segment_ptr();
    extern __shared__ __attribute__((aligned(16))) unsigned char lds_raw[];
    LAS unsigned char* lds = (LAS unsigned char*)lds_raw;
    if (threadIdx.x < 4) ((LAS unsigned*)(lds + LDS_BARW))[threadIdx.x] = 0u;
    __syncthreads();
    { PP Q = launder(P); (void)xcd_barrier_post((unsigned*)(Q->ws + WS_CTL), (volatile LAS unsigned*)(lds + LDS_BARW)); }

    { PP Q = launder(P); phase_convert(Q, lds, 0, 1, lbid(), (int)gridDim.x); phase_init(Q); }
    SEAM();
    {
        PP Q = launder(P); const unsigned char* wl = Q->ws + WS_W + (size_t)0 * W_LAYER;
        pg8::Gemm g{WS_PTR(const bf16_t, WS_HB), (const bf16_t*)(wl + WO_GU1), MMAIN, NGU, DM}; pg8::StaticOrder S; S.init(MMAIN, NGU, (int)gridDim.x, lbid(), 4, 1);
        pg8::EpiGU E{WS_PTR(bf16_t, WS_ACT), WS_PTR(const float, WS_SS) + (size_t)(0) * 8 * MROWS, (LAS float*)(lds + 131072 + 4096)};
        pg8::gemm_phase<pg8::EpiGU, pg8::StaticOrder, true, true>(lds, g, S, E);
        skinny_gu(WS_PTR(const bf16_t, WS_HB), g.Bt, WS_PTR(const float, WS_SSM) + (0) * 2048, WS_PTR(bf16_t, WS_ACT), lds);
    }
    SEAM();
    {
        PP Q = launder(P); const unsigned char* wl = Q->ws + WS_W + (size_t)0 * W_LAYER;
        pg8::Gemm g{WS_PTR(const bf16_t, WS_ACT), (const bf16_t*)(wl + WO_D1), MMAIN, DM, DFF}; pg8::StaticOrder S; S.init(MMAIN, DM, (int)gridDim.x, lbid(), 4, 0);
        pg8::EpiRes E{WS_PTR(bf16_t, WS_HB), WS_PTR(float, WS_SS) + (size_t)(1) * 8 * MROWS, 0.5f, (LAS float*)(lds + 131072)};
        pg8::gemm_phase<pg8::EpiRes, pg8::StaticOrder, true, true>(lds, g, S, E);
        skinny_res<DFF>(WS_PTR(const bf16_t, WS_ACT) + (size_t)MMAIN * DFF, g.Bt, WS_PTR(bf16_t, WS_HB), WS_PTR(float, WS_SSM) + (1) * 2048, 0.5f, lds);
    }
    SEAM();
    {
        PP Q = launder(P); const unsigned char* wl = Q->ws + WS_W + (size_t)0 * W_LAYER;
        pg8::Gemm g{WS_PTR(const bf16_t, WS_HB), (const bf16_t*)(wl + WO_IN), MMAIN, NIN, DM}; pg8::StaticOrder S; S.init(MMAIN, NIN, (int)gridDim.x, lbid(), 8, 1);
        pg8::EpiP E{WS_PTR(bf16_t, WS_PR), WS_PTR(float, WS_PS), WS_PTR(bf16_t, WS_QKV), WS_PTR(const float, WS_SS) + (size_t)(1) * 8 * MROWS, (LAS float*)(lds + 131072 + 4096)};
        pg8::gemm_phase<pg8::EpiP, pg8::StaticOrder, true, true>(lds, g, S, E);
        skinny_p(WS_PTR(const bf16_t, WS_HB), g.Bt, WS_PTR(const float, WS_SSM) + (1) * 2048, WS_PTR(bf16_t, WS_PR), WS_PTR(float, WS_PS), WS_PTR(bf16_t, WS_QKV), lds);
    }
    SEAM();
    { PP Q = launder(P); phase_lx(Q, 0); }
    SEAM();
    {
        PP Q = launder(P); const int u = lbid();
        if (u < 128) { rwkv_chunked(Q, 0, u >> 4, u & 15, lds); __syncthreads(); phase_convert(launder(P), lds, 1, 2, u, 128, 19968, 21248); }
        else { fox_wg(Q, 0, u - 128, (char*)lds_raw); __syncthreads(); phase_convert(launder(P), lds, 1, 2, u - 128, 128, 0, 19968); }
    }
    SEAM();
    { PP Q = launder(P); phase_foxnorm(Q); }
    SEAM();
    {
        PP Q = launder(P); const unsigned char* wl = Q->ws + WS_W + (size_t)0 * W_LAYER;
        pg8::Gemm g{WS_PTR(const bf16_t, WS_Y), (const bf16_t*)(wl + WO_OUT), MMAIN, DM, DM}; pg8::StaticOrder S; S.init(MMAIN, DM, (int)gridDim.x, lbid(), 4, 0);
        pg8::EpiRes E{WS_PTR(bf16_t, WS_HB), WS_PTR(float, WS_SS) + (size_t)(2) * 8 * MROWS, 1.0f, (LAS float*)(lds + 131072)};
        pg8::gemm_phase<pg8::EpiRes, pg8::StaticOrder, true, true>(lds, g, S, E);
        skinny_res<DM>(WS_PTR(const bf16_t, WS_Y) + (size_t)MMAIN * DM, g.Bt, WS_PTR(bf16_t, WS_HB), WS_PTR(float, WS_SSM) + (2) * 2048, 1.0f, lds);
    }
    SEAM();
    {
        PP Q = launder(P); const unsigned char* wl = Q->ws + WS_W + (size_t)0 * W_LAYER;
        pg8::Gemm g{WS_PTR(const bf16_t, WS_HB), (const bf16_t*)(wl + WO_GU2), MMAIN, NGU, DM}; pg8::StaticOrder S; S.init(MMAIN, NGU, (int)gridDim.x, lbid(), 4, 1);
        pg8::EpiGU E{WS_PTR(bf16_t, WS_ACT), WS_PTR(const float, WS_SS) + (size_t)(2) * 8 * MROWS, (LAS float*)(lds + 131072 + 4096)};
        pg8::gemm_phase<pg8::EpiGU, pg8::StaticOrder, true, true>(lds, g, S, E);
        skinny_gu(WS_PTR(const bf16_t, WS_HB), g.Bt, WS_PTR(const float, WS_SSM) + (2) * 2048, WS_PTR(bf16_t, WS_ACT), lds);
    }
    SEAM();
    {
        PP Q = launder(P); const unsigned char* wl = Q->ws + WS_W + (size_t)0 * W_LAYER;
        pg8::Gemm g{WS_PTR(const bf16_t, WS_ACT), (const bf16_t*)(wl + WO_D2), MMAIN, DM, DFF}; pg8::StaticOrder S; S.init(MMAIN, DM, (int)gridDim.x, lbid(), 4, 0);
        pg8::EpiRes E{WS_PTR(bf16_t, WS_HB), WS_PTR(float, WS_SS) + (size_t)(3) * 8 * MROWS, 0.5f, (LAS float*)(lds + 131072)};
        pg8::gemm_phase<pg8::EpiRes, pg8::StaticOrder, true, true>(lds, g, S, E);
        skinny_res<DFF>(WS_PTR(const bf16_t, WS_ACT) + (size_t)MMAIN * DFF, g.Bt, WS_PTR(bf16_t, WS_HB), WS_PTR(float, WS_SSM) + (3) * 2048, 0.5f, lds);
    }
    SEAM();
    {
        PP Q = launder(P); const unsigned char* wl = Q->ws + WS_W + (size_t)1 * W_LAYER;
        pg8::Gemm g{WS_PTR(const bf16_t, WS_HB), (const bf16_t*)(wl + WO_GU1), MMAIN, NGU, DM}; pg8::StaticOrder S; S.init(MMAIN, NGU, (int)gridDim.x, lbid(), 4, 1);
        pg8::EpiGU E{WS_PTR(bf16_t, WS_ACT), WS_PTR(const float, WS_SS) + (size_t)(3) * 8 * MROWS, (LAS float*)(lds + 131072 + 4096)};
        pg8::gemm_phase<pg8::EpiGU, pg8::StaticOrder, true, true>(lds, g, S, E);
        skinny_gu(WS_PTR(const bf16_t, WS_HB), g.Bt, WS_PTR(const float, WS_SSM) + (3) * 2048, WS_PTR(bf16_t, WS_ACT), lds);
    }
    SEAM();
    {
        PP Q = launder(P); const unsigned char* wl = Q->ws + WS_W + (size_t)1 * W_LAYER;
        pg8::Gemm g{WS_PTR(const bf16_t, WS_ACT), (const bf16_t*)(wl + WO_D1), MMAIN, DM, DFF}; pg8::StaticOrder S; S.init(MMAIN, DM, (int)gridDim.x, lbid(), 4, 0);
        pg8::EpiRes E{WS_PTR(bf16_t, WS_HB), WS_PTR(float, WS_SS) + (size_t)(4) * 8 * MROWS, 0.5f, (LAS float*)(lds + 131072)};
        pg8::gemm_phase<pg8::EpiRes, pg8::StaticOrder, true, true>(lds, g, S, E);
        skinny_res<DFF>(WS_PTR(const bf16_t, WS_ACT) + (size_t)MMAIN * DFF, g.Bt, WS_PTR(bf16_t, WS_HB), WS_PTR(float, WS_SSM) + (4) * 2048, 0.5f, lds);
    }
    SEAM();
    {
        PP Q = launder(P); const unsigned char* wl = Q->ws + WS_W + (size_t)1 * W_LAYER;
        pg8::Gemm g{WS_PTR(const bf16_t, WS_HB), (const bf16_t*)(wl + WO_IN), MMAIN, NIN, DM}; pg8::StaticOrder S; S.init(MMAIN, NIN, (int)gridDim.x, lbid(), 8, 1);
        pg8::EpiP E{WS_PTR(bf16_t, WS_PR), WS_PTR(float, WS_PS), WS_PTR(bf16_t, WS_QKV), WS_PTR(const float, WS_SS) + (size_t)(4) * 8 * MROWS, (LAS float*)(lds + 131072 + 4096)};
        pg8::gemm_phase<pg8::EpiP, pg8::StaticOrder, true, true>(lds, g, S, E);
        skinny_p(WS_PTR(const bf16_t, WS_HB), g.Bt, WS_PTR(const float, WS_SSM) + (4) * 2048, WS_PTR(bf16_t, WS_PR), WS_PTR(float, WS_PS), WS_PTR(bf16_t, WS_QKV), lds);
    }
    SEAM();
    { PP Q = launder(P); phase_lx(Q, 1); }
    SEAM();
    {
        PP Q = launder(P); const int u = lbid();
        if (u < 128) { rwkv_chunked(Q, 1, u >> 4, u & 15, lds); __syncthreads(); phase_convert(launder(P), lds, 2, 3, u, 128, 19968, 21248); }
        else { fox_wg(Q, 1, u - 128, (char*)lds_raw); __syncthreads(); phase_convert(launder(P), lds, 2, 3, u - 128, 128, 0, 19968); }
    }
    SEAM();
    { PP Q = launder(P); phase_foxnorm(Q); }
    SEAM();
    {
        PP Q = launder(P); const unsigned char* wl = Q->ws + WS_W + (size_t)1 * W_LAYER;
        pg8::Gemm g{WS_PTR(const bf16_t, WS_Y), (const bf16_t*)(wl + WO_OUT), MMAIN, DM, DM}; pg8::StaticOrder S; S.init(MMAIN, DM, (int)gridDim.x, lbid(), 4, 0);
        pg8::EpiRes E{WS_PTR(bf16_t, WS_HB), WS_PTR(float, WS_SS) + (size_t)(5) * 8 * MROWS, 1.0f, (LAS float*)(lds + 131072)};
        pg8::gemm_phase<pg8::EpiRes, pg8::StaticOrder, true, true>(lds, g, S, E);
        skinny_res<DM>(WS_PTR(const bf16_t, WS_Y) + (size_t)MMAIN * DM, g.Bt, WS_PTR(bf16_t, WS_HB), WS_PTR(float, WS_SSM) + (5) * 2048, 1.0f, lds);
    }
    SEAM();
    {
        PP Q = launder(P); const unsigned char* wl = Q->ws + WS_W + (size_t)1 * W_LAYER;
        pg8::Gemm g{WS_PTR(const bf16_t, WS_HB), (const bf16_t*)(wl + WO_GU2), MMAIN, NGU, DM}; pg8::StaticOrder S; S.init(MMAIN, NGU, (int)gridDim.x, lbid(), 4, 1);
        pg8::EpiGU E{WS_PTR(bf16_t, WS_ACT), WS_PTR(const float, WS_SS) + (size_t)(5) * 8 * MROWS, (LAS float*)(lds + 131072 + 4096)};
        pg8::gemm_phase<pg8::EpiGU, pg8::StaticOrder, true, true>(lds, g, S, E);
        skinny_gu(WS_PTR(const bf16_t, WS_HB), g.Bt, WS_PTR(const float, WS_SSM) + (5) * 2048, WS_PTR(bf16_t, WS_ACT), lds);
    }
    SEAM();
    {
        PP Q = launder(P); const unsigned char* wl = Q->ws + WS_W + (size_t)1 * W_LAYER;
        pg8::Gemm g{WS_PTR(const bf16_t, WS_ACT), (const bf16_t*)(wl + WO_D2), MMAIN, DM, DFF}; pg8::StaticOrder S; S.init(MMAIN, DM, (int)gridDim.x, lbid(), 4, 0);
        pg8::EpiRes E{WS_PTR(bf16_t, WS_HB), WS_PTR(float, WS_SS) + (size_t)(6) * 8 * MROWS, 0.5f, (LAS float*)(lds + 131072)};
        pg8::gemm_phase<pg8::EpiRes, pg8::StaticOrder, true, true>(lds, g, S, E);
        skinny_res<DFF>(WS_PTR(const bf16_t, WS_ACT) + (size_t)MMAIN * DFF, g.Bt, WS_PTR(bf16_t, WS_HB), WS_PTR(float, WS_SSM) + (6) * 2048, 0.5f, lds);
    }
    SEAM();
    {
        PP Q = launder(P); const unsigned char* wl = Q->ws + WS_W + (size_t)2 * W_LAYER;
        pg8::Gemm g{WS_PTR(const bf16_t, WS_HB), (const bf16_t*)(wl + WO_GU1), MMAIN, NGU, DM}; pg8::StaticOrder S; S.init(MMAIN, NGU, (int)gridDim.x, lbid(), 4, 1);
        pg8::EpiGU E{WS_PTR(bf16_t, WS_ACT), WS_PTR(const float, WS_SS) + (size_t)(6) * 8 * MROWS, (LAS float*)(lds + 131072 + 4096)};
        pg8::gemm_phase<pg8::EpiGU, pg8::StaticOrder, true, true>(lds, g, S, E);
        skinny_gu(WS_PTR(const bf16_t, WS_HB), g.Bt, WS_PTR(const float, WS_SSM) + (6) * 2048, WS_PTR(bf16_t, WS_ACT), lds);
    }
    SEAM();
    {
        PP Q = launder(P); const unsigned char* wl = Q->ws + WS_W + (size_t)2 * W_LAYER;
        pg8::Gemm g{WS_PTR(const bf16_t, WS_ACT), (const bf16_t*)(wl + WO_D1), MMAIN, DM, DFF}; pg8::StaticOrder S; S.init(MMAIN, DM, (int)gridDim.x, lbid(), 4, 0);
        pg8::EpiRes E{WS_PTR(bf16_t, WS_HB), WS_PTR(float, WS_SS) + (size_t)(7) * 8 * MROWS, 0.5f, (LAS float*)(lds + 131072)};
        pg8::gemm_phase<pg8::EpiRes, pg8::StaticOrder, true, true>(lds, g, S, E);
        skinny_res<DFF>(WS_PTR(const bf16_t, WS_ACT) + (size_t)MMAIN * DFF, g.Bt, WS_PTR(bf16_t, WS_HB), WS_PTR(float, WS_SSM) + (7) * 2048, 0.5f, lds);
    }
    SEAM();
    {
        PP Q = launder(P); const unsigned char* wl = Q->ws + WS_W + (size_t)2 * W_LAYER;
        pg8::Gemm g{WS_PTR(const bf16_t, WS_HB), (const bf16_t*)(wl + WO_IN), MMAIN, NIN, DM}; pg8::StaticOrder S; S.init(MMAIN, NIN, (int)gridDim.x, lbid(), 8, 1);
        pg8::EpiP E{WS_PTR(bf16_t, WS_PR), WS_PTR(float, WS_PS), WS_PTR(bf16_t, WS_QKV), WS_PTR(const float, WS_SS) + (size_t)(7) * 8 * MROWS, (LAS float*)(lds + 131072 + 4096)};
        pg8::gemm_phase<pg8::EpiP, pg8::StaticOrder, true, true>(lds, g, S, E);
        skinny_p(WS_PTR(const bf16_t, WS_HB), g.Bt, WS_PTR(const float, WS_SSM) + (7) * 2048, WS_PTR(bf16_t, WS_PR), WS_PTR(float, WS_PS), WS_PTR(bf16_t, WS_QKV), lds);
    }
    SEAM();
    { PP Q = launder(P); phase_lx(Q, 2); }
    SEAM();
    {
        PP Q = launder(P); const int u = lbid();
        if (u < 128) { rwkv_chunked(Q, 2, u >> 4, u & 15, lds); __syncthreads(); phase_convert(launder(P), lds, 3, 4, u, 128, 19968, 21248); }
        else { fox_wg(Q, 2, u - 128, (char*)lds_raw); __syncthreads(); phase_convert(launder(P), lds, 3, 4, u - 128, 128, 0, 19968); }
    }
    SEAM();
    { PP Q = launder(P); phase_foxnorm(Q); }
    SEAM();
    {
        PP Q = launder(P); const unsigned char* wl = Q->ws + WS_W + (size_t)2 * W_LAYER;
        pg8::Gemm g{WS_PTR(const bf16_t, WS_Y), (const bf16_t*)(wl + WO_OUT), MMAIN, DM, DM}; pg8::StaticOrder S; S.init(MMAIN, DM, (int)gridDim.x, lbid(), 4, 0);
        pg8::EpiRes E{WS_PTR(bf16_t, WS_HB), WS_PTR(float, WS_SS) + (size_t)(8) * 8 * MROWS, 1.0f, (LAS float*)(lds + 131072)};
        pg8::gemm_phase<pg8::EpiRes, pg8::StaticOrder, true, true>(lds, g, S, E);
        skinny_res<DM>(WS_PTR(const bf16_t, WS_Y) + (size_t)MMAIN * DM, g.Bt, WS_PTR(bf16_t, WS_HB), WS_PTR(float, WS_SSM) + (8) * 2048, 1.0f, lds);
    }
    SEAM();
    {
        PP Q = launder(P); const unsigned char* wl = Q->ws + WS_W + (size_t)2 * W_LAYER;
        pg8::Gemm g{WS_PTR(const bf16_t, WS_HB), (const bf16_t*)(wl + WO_GU2), MMAIN, NGU, DM}; pg8::StaticOrder S; S.init(MMAIN, NGU, (int)gridDim.x, lbid(), 4, 1);
        pg8::EpiGU E{WS_PTR(bf16_t, WS_ACT), WS_PTR(const float, WS_SS) + (size_t)(8) * 8 * MROWS, (LAS float*)(lds + 131072 + 4096)};
        pg8::gemm_phase<pg8::EpiGU, pg8::StaticOrder, true, true>(lds, g, S, E);
        skinny_gu(WS_PTR(const bf16_t, WS_HB), g.Bt, WS_PTR(const float, WS_SSM) + (8) * 2048, WS_PTR(bf16_t, WS_ACT), lds);
    }
    SEAM();
    {
        PP Q = launder(P); const unsigned char* wl = Q->ws + WS_W + (size_t)2 * W_LAYER;
        pg8::Gemm g{WS_PTR(const bf16_t, WS_ACT), (const bf16_t*)(wl + WO_D2), MMAIN, DM, DFF}; pg8::StaticOrder S; S.init(MMAIN, DM, (int)gridDim.x, lbid(), 4, 0);
        pg8::EpiRes E{WS_PTR(bf16_t, WS_HB), WS_PTR(float, WS_SS) + (size_t)(9) * 8 * MROWS, 0.5f, (LAS float*)(lds + 131072)};
        pg8::gemm_phase<pg8::EpiRes, pg8::StaticOrder, true, true>(lds, g, S, E);
        skinny_res<DFF>(WS_PTR(const bf16_t, WS_ACT) + (size_t)MMAIN * DFF, g.Bt, WS_PTR(bf16_t, WS_HB), WS_PTR(float, WS_SSM) + (9) * 2048, 0.5f, lds);
    }
    SEAM();
    {
        PP Q = launder(P); const unsigned char* wl = Q->ws + WS_W + (size_t)3 * W_LAYER;
        pg8::Gemm g{WS_PTR(const bf16_t, WS_HB), (const bf16_t*)(wl + WO_GU1), MMAIN, NGU, DM}; pg8::StaticOrder S; S.init(MMAIN, NGU, (int)gridDim.x, lbid(), 4, 1);
        pg8::EpiGU E{WS_PTR(bf16_t, WS_ACT), WS_PTR(const float, WS_SS) + (size_t)(9) * 8 * MROWS, (LAS float*)(lds + 131072 + 4096)};
        pg8::gemm_phase<pg8::EpiGU, pg8::StaticOrder, true, true>(lds, g, S, E);
        skinny_gu(WS_PTR(const bf16_t, WS_HB), g.Bt, WS_PTR(const float, WS_SSM) + (9) * 2048, WS_PTR(bf16_t, WS_ACT), lds);
    }
    SEAM();
    {
        PP Q = launder(P); const unsigned char* wl = Q->ws + WS_W + (size_t)3 * W_LAYER;
        pg8::Gemm g{WS_PTR(const bf16_t, WS_ACT), (const bf16_t*)(wl + WO_D1), MMAIN, DM, DFF}; pg8::StaticOrder S; S.init(MMAIN, DM, (int)gridDim.x, lbid(), 4, 0);
        pg8::EpiRes E{WS_PTR(bf16_t, WS_HB), WS_PTR(float, WS_SS) + (size_t)(10) * 8 * MROWS, 0.5f, (LAS float*)(lds + 131072)};
        pg8::gemm_phase<pg8::EpiRes, pg8::StaticOrder, true, true>(lds, g, S, E);
        skinny_res<DFF>(WS_PTR(const bf16_t, WS_ACT) + (size_t)MMAIN * DFF, g.Bt, WS_PTR(bf16_t, WS_HB), WS_PTR(float, WS_SSM) + (10) * 2048, 0.5f, lds);
    }
    SEAM();
    {
        PP Q = launder(P); const unsigned char* wl = Q->ws + WS_W + (size_t)3 * W_LAYER;
        pg8::Gemm g{WS_PTR(const bf16_t, WS_HB), (const bf16_t*)(wl + WO_IN), MMAIN, NIN, DM}; pg8::StaticOrder S; S.init(MMAIN, NIN, (int)gridDim.x, lbid(), 8, 1);
        pg8::EpiP E{WS_PTR(bf16_t, WS_PR), WS_PTR(float, WS_PS), WS_PTR(bf16_t, WS_QKV), WS_PTR(const float, WS_SS) + (size_t)(10) * 8 * MROWS, (LAS float*)(lds + 131072 + 4096)};
        pg8::gemm_phase<pg8::EpiP, pg8::StaticOrder, true, true>(lds, g, S, E);
        skinny_p(WS_PTR(const bf16_t, WS_HB), g.Bt, WS_PTR(const float, WS_SSM) + (10) * 2048, WS_PTR(bf16_t, WS_PR), WS_PTR(float, WS_PS), WS_PTR(bf16_t, WS_QKV), lds);
    }
    SEAM();
    { PP Q = launder(P); phase_lx(Q, 3); }
    SEAM();
    {
        PP Q = launder(P); const int u = lbid();
        if (u < 128) { rwkv_chunked(Q, 3, u >> 4, u & 15, lds); }
        else { fox_wg(Q, 3, u - 128, (char*)lds_raw);  }
    }
    SEAM();
    { PP Q = launder(P); phase_foxnorm(Q); }
    SEAM();
    {
        PP Q = launder(P); const unsigned char* wl = Q->ws + WS_W + (size_t)3 * W_LAYER;
        pg8::Gemm g{WS_PTR(const bf16_t, WS_Y), (const bf16_t*)(wl + WO_OUT), MMAIN, DM, DM}; pg8::StaticOrder S; S.init(MMAIN, DM, (int)gridDim.x, lbid(), 4, 0);
        pg8::EpiRes E{WS_PTR(bf16_t, WS_HB), WS_PTR(float, WS_SS) + (size_t)(11) * 8 * MROWS, 1.0f, (LAS float*)(lds + 131072)};
        pg8::gemm_phase<pg8::EpiRes, pg8::StaticOrder, true, true>(lds, g, S, E);
        skinny_res<DM>(WS_PTR(const bf16_t, WS_Y) + (size_t)MMAIN * DM, g.Bt, WS_PTR(bf16_t, WS_HB), WS_PTR(float, WS_SSM) + (11) * 2048, 1.0f, lds);
    }
    SEAM();
    {
        PP Q = launder(P); const unsigned char* wl = Q->ws + WS_W + (size_t)3 * W_LAYER;
        pg8::Gemm g{WS_PTR(const bf16_t, WS_HB), (const bf16_t*)(wl + WO_GU2), MMAIN, NGU, DM}; pg8::StaticOrder S; S.init(MMAIN, NGU, (int)gridDim.x, lbid(), 4, 1);
        pg8::EpiGU E{WS_PTR(bf16_t, WS_ACT), WS_PTR(const float, WS_SS) + (size_t)(11) * 8 * MROWS, (LAS float*)(lds + 131072 + 4096)};
        pg8::gemm_phase<pg8::EpiGU, pg8::StaticOrder, true, true>(lds, g, S, E);
        skinny_gu(WS_PTR(const bf16_t, WS_HB), g.Bt, WS_PTR(const float, WS_SSM) + (11) * 2048, WS_PTR(bf16_t, WS_ACT), lds);
    }
    SEAM();
    {
        PP Q = launder(P); const unsigned char* wl = Q->ws + WS_W + (size_t)3 * W_LAYER;
        pg8::Gemm g{WS_PTR(const bf16_t, WS_ACT), (const bf16_t*)(wl + WO_D2), MMAIN, DM, DFF}; pg8::StaticOrder S; S.init(MMAIN, DM, (int)gridDim.x, lbid(), 4, 0);
        pg8::EpiRes E{WS_PTR(bf16_t, WS_HB), WS_PTR(float, WS_SS) + (size_t)(12) * 8 * MROWS, 0.5f, (LAS float*)(lds + 131072)};
        pg8::gemm_phase<pg8::EpiRes, pg8::StaticOrder, true, true>(lds, g, S, E);
        skinny_res<DFF>(WS_PTR(const bf16_t, WS_ACT) + (size_t)MMAIN * DFF, g.Bt, WS_PTR(bf16_t, WS_HB), WS_PTR(float, WS_SSM) + (12) * 2048, 0.5f, lds);
    }
    SEAM();
    { PP Q = launder(P); phase_final(Q); }
}

extern "C" void kernel_launch(void* const* d_in, const int* in_sizes, int n_in, void* d_out, int out_size, void* d_ws, size_t ws_size, hipStream_t stream) {
    using namespace cfg;
    static int grid = 0;
    if (grid == 0) {
        if (n_in != 25 || out_size != MMAIN * DM || ws_size < WS_END) { fprintf(stderr, "kernel_launch: need 25 inputs, out %d, ws >= %zu; got n_in %d out %d ws %zu\n", MMAIN * DM, (size_t)WS_END, n_in, out_size, ws_size); grid = -1; return; }
        int dev = 0, cus = 0, per_cu = 0;
        if (hipGetDevice(&dev) != hipSuccess || hipDeviceGetAttribute(&cus, hipDeviceAttributeMultiprocessorCount, dev) != hipSuccess) { grid = -1; return; }
        if (hipFuncSetAttribute((const void*)hymba_fwd, hipFuncAttributeMaxDynamicSharedMemorySize, LDS_BYTES) != hipSuccess) { fprintf(stderr, "kernel_launch: hipFuncSetAttribute failed\n"); grid = -1; return; }
        if (hipOccupancyMaxActiveBlocksPerMultiprocessor(&per_cu, (const void*)hymba_fwd, 512, LDS_BYTES) != hipSuccess || per_cu < 1) fprintf(stderr, "kernel_launch: occupancy query says %d\n", per_cu);
        (void)hipGetLastError();
        if (cus < 256) { fprintf(stderr, "kernel_launch: built for a 256-CU device (one resident workgroup per CU), found %d CUs\n", cus); grid = -1; return; }
        grid = 256;
    }
    if (grid < 0) return;
    if (hipMemsetAsync((char*)d_ws + WS_CTL, 0, CTL_BYTES, stream) != hipSuccess) return;
    Params p{};
    for (int i = 0; i < 25; ++i) p.in[i] = (const float*)d_in[i];
    p.out = (float*)d_out; p.ws = (unsigned char*)d_ws; p.ph_lo = 0; p.ph_hi = 0;
    hipLaunchKernelGGL(hymba_fwd, dim3(grid), dim3(512), LDS_BYTES, stream, p);
}
```
